# Optimizing an MI355X kernel written in HIP

```python
import jax
import jax.numpy as jnp
from jax import lax
import numpy as np

D_MODEL = 1024
BATCH = 8
SEQ = 4096
DEPTH = 1

N_META = 16
RWKV_HEADS = 8
HEAD_SIZE = 64
RWKV_WIDTH = RWKV_HEADS * HEAD_SIZE
CONV_GROUPS = 8
CONV_WIDTH = D_MODEL // 2
CONV_K = 3
DECAY_LORA = 64
AAA_LORA = 64
GATE_LORA = 128
N_EXPERTS = 32
TOP_K = 4
D_FF = D_MODEL
SWIGLU_ALPHA = 1.702
SWIGLU_LIMIT = 7.0
MOE_BLOCK = 128
NORM_EPS = 1e-5
LNX_EPS = 64e-5
IN_COLS = 3 * RWKV_WIDTH + 3 * CONV_WIDTH + 2 * D_MODEL

kernel_name = "hybrid_rwkv7_shortconv_moe_block"


def _rmsnorm(x, g):
    xf = x.astype(jnp.float32)
    y = xf * lax.rsqrt(jnp.mean(xf * xf, axis=-1, keepdims=True) + NORM_EPS)
    return (y * g.astype(jnp.float32)).astype(x.dtype)


def _token_shift(z):
    return jnp.pad(z[:, :-1], ((0, 0), (1, 0), (0, 0)))


def _wkv7_scan(r, decay, k, v, kk, a):
    b, _, h, n = r.shape

    def step(S, inp):
        r_t, w_t, k_t, v_t, kk_t, a_t = inp
        sa = jnp.einsum('bhij,bhj->bhi', S, -kk_t)
        S = (S * w_t[:, :, None, :]
             + sa[..., None] * (kk_t * a_t)[:, :, None, :]
             + v_t[..., None] * k_t[:, :, None, :])
        y_t = jnp.einsum('bhij,bhj->bhi', S, r_t)
        return S, y_t

    s0 = jnp.zeros((b, h, n, n), jnp.float32)
    seq_major = tuple(jnp.moveaxis(z, 1, 0) for z in (r, decay, k, v, kk, a))
    _, y = lax.scan(step, s0, seq_major)
    return jnp.moveaxis(y, 0, 1)


def _rwkv7_branch(x_n, pr, pk, pv, mu_r, mu_k, mu_v, mu_w, mu_a, mu_g, w0, w_w1, w_w2,
                  a0, w_a1, w_a2, w_g1, w_g2, k_k, k_a, r_k, lnx_g, lnx_b, w_o_rwkv):
    b, L, _ = x_n.shape
    dt = x_n.dtype
    r = pr + (_token_shift(pr) - pr) * mu_r
    k = pk + (_token_shift(pk) - pk) * mu_k
    v = pv + (_token_shift(pv) - pv) * mu_v
    dx = _token_shift(x_n) - x_n
    xw = x_n + dx * mu_w
    xa = x_n + dx * mu_a
    xg = x_n + dx * mu_g
    w_log = -jax.nn.softplus(-(w0 + jnp.tanh(xw @ w_w1) @ w_w2)) - 0.5
    a = jax.nn.sigmoid(a0 + (xa @ w_a1) @ w_a2)
    g = jax.nn.sigmoid(xg @ w_g1) @ w_g2

    heads = lambda z: z.astype(jnp.float32).reshape(b, L, RWKV_HEADS, HEAD_SIZE)
    kk = heads(k * k_k)
    kk = kk / jnp.maximum(jnp.sqrt(jnp.sum(kk * kk, axis=-1, keepdims=True)), 1e-12)
    k = k * (1.0 + (a - 1.0) * k_a)
    r_h, k_h, v_h, a_h = heads(r), heads(k), heads(v), heads(a)
    decay = jnp.exp(-jnp.exp(heads(w_log)))

    y = _wkv7_scan(r_h, decay, k_h, v_h, kk, a_h)
    mean = jnp.mean(y, axis=-1, keepdims=True)
    var = jnp.mean((y - mean) ** 2, axis=-1, keepdims=True)
    yn = ((y - mean) * lax.rsqrt(var + LNX_EPS)).reshape(b, L, RWKV_WIDTH)
    yn = yn * lnx_g.astype(jnp.float32) + lnx_b.astype(jnp.float32)
    rk = r_k.astype(jnp.float32).reshape(RWKV_HEADS, HEAD_SIZE)
    bonus = (jnp.sum(r_h * k_h * rk, axis=-1, keepdims=True) * v_h).reshape(b, L, RWKV_WIDTH)
    return ((yn + bonus).astype(dt) * g) @ w_o_rwkv


def _short_conv_branch(cb, cc, ch, conv_w, w_o_conv):
    L = ch.shape[1]
    u = cc * ch
    upad = jnp.pad(u, ((0, 0), (CONV_K - 1, 0), (0, 0)))
    conv = sum(conv_w[j] * upad[:, j:j + L] for j in range(CONV_K))
    return (cb * conv) @ w_o_conv


def _moe(h, w_router, b_router, w_e_gate, b_e_gate, w_e_up, b_e_up, w_e_down, b_e_down):
    b, L, d = h.shape
    dt = h.dtype
    T = b * L
    xf = h.reshape(T, d)
    logits = (xf @ w_router + b_router).astype(jnp.float32)
    top_v, top_i = lax.top_k(logits, TOP_K)
    gates = jax.nn.softmax(top_v, axis=-1).astype(dt)

    n_assign = T * TOP_K
    flat_e = top_i.reshape(-1)
    flat_w = gates.reshape(-1)
    flat_tok = jnp.repeat(jnp.arange(T, dtype=jnp.int32), TOP_K)
    order = jnp.argsort(flat_e)
    sorted_e = flat_e[order]
    counts = jnp.bincount(flat_e, length=N_EXPERTS).astype(jnp.int32)
    padded = ((counts + MOE_BLOCK - 1) // MOE_BLOCK) * MOE_BLOCK
    start = jnp.cumsum(counts) - counts
    pend = jnp.cumsum(padded)
    pstart = pend - padded
    rank = jnp.arange(n_assign, dtype=jnp.int32) - start[sorted_e]
    dest = pstart[sorted_e] + rank
    P = -(-n_assign // MOE_BLOCK) * MOE_BLOCK + N_EXPERTS * MOE_BLOCK
    n_blk = P // MOE_BLOCK
    row_tok = jnp.zeros((P,), jnp.int32).at[dest].set(flat_tok[order])
    row_w = jnp.zeros((P,), dt).at[dest].set(flat_w[order])
    blk_start = jnp.arange(n_blk, dtype=jnp.int32) * MOE_BLOCK
    blk_e = jnp.minimum(jnp.searchsorted(pend, blk_start, side='right'), N_EXPERTS - 1)

    def expert_block(args):
        e, toks, wts = args
        xb = xf[toks]
        gt = jnp.minimum(xb @ w_e_gate[e] + b_e_gate[e], SWIGLU_LIMIT)
        up = jnp.clip(xb @ w_e_up[e] + b_e_up[e], -SWIGLU_LIMIT, SWIGLU_LIMIT)
        act = (up + 1.0) * (gt * jax.nn.sigmoid(gt * SWIGLU_ALPHA))
        return (act @ w_e_down[e] + b_e_down[e]) * wts[:, None]

    ys = lax.map(expert_block, (blk_e, row_tok.reshape(n_blk, MOE_BLOCK),
                                row_w.reshape(n_blk, MOE_BLOCK)))
    out = jnp.zeros((T, d), dt).at[row_tok].add(ys.reshape(P, d))
    return out.reshape(b, L, d)


def setup_inputs(seed: int = 0) -> dict:
    key = jax.random.key(seed)
    ks = iter(jax.random.split(key, 48))
    f32 = jnp.float32
    R, C, D = RWKV_WIDTH, CONV_WIDTH, D_MODEL

    def nrm(shape, scale):
        return scale * jax.random.normal(next(ks), shape, f32)

    def uni(shape):
        return jax.random.uniform(next(ks), shape, f32, 0.2, 0.8)

    n = jnp.arange(R, dtype=f32) / (R - 1)
    w0_base = (-6.5 + 5.0 * n ** 0.85)[None, :]
    return {
        "x": nrm((BATCH, SEQ, D), 1.0),
        "meta_tokens": nrm((N_META, D), 1.0),
        "ln1_g": 1.0 + nrm((DEPTH, D), 0.01),
        "w_in": nrm((DEPTH, D, IN_COLS), D ** -0.5),
        "mu_r": uni((DEPTH, R)),
        "mu_k": uni((DEPTH, R)),
        "mu_v": uni((DEPTH, R)),
        "mu_w": uni((DEPTH, D)),
        "mu_a": uni((DEPTH, D)),
        "mu_g": uni((DEPTH, D)),
        "w0": w0_base + nrm((DEPTH, R), 0.1),
        "w_w1": nrm((DEPTH, D, DECAY_LORA), D ** -0.5),
        "w_w2": nrm((DEPTH, DECAY_LORA, R), 0.1 * DECAY_LORA ** -0.5),
        "a0": nrm((DEPTH, R), 0.1),
        "w_a1": nrm((DEPTH, D, AAA_LORA), D ** -0.5),
        "w_a2": nrm((DEPTH, AAA_LORA, R), AAA_LORA ** -0.5),
        "w_g1": nrm((DEPTH, D, GATE_LORA), D ** -0.5),
        "w_g2": nrm((DEPTH, GATE_LORA, R), GATE_LORA ** -0.5),
        "k_k": 0.85 + nrm((DEPTH, R), 0.05),
        "k_a": 1.0 + nrm((DEPTH, R), 0.05),
        "r_k": nrm((DEPTH, R), 0.1),
        "lnx_g": 1.0 + nrm((DEPTH, R), 0.01),
        "lnx_b": nrm((DEPTH, R), 0.01),
        "w_o_rwkv": nrm((DEPTH, R, D), R ** -0.5),
        "conv_w": nrm((DEPTH, CONV_K, C), CONV_K ** -0.5),
        "w_o_conv": nrm((DEPTH, C, D), C ** -0.5),
        "w_o": nrm((DEPTH, D, D), D ** -0.5),
        "ln2_g": 1.0 + nrm((DEPTH, D), 0.01),
        "w_router": nrm((DEPTH, D, N_EXPERTS), D ** -0.5),
        "b_router": nrm((DEPTH, N_EXPERTS), 0.01),
        "w_e_gate": nrm((DEPTH, N_EXPERTS, D, D_FF), D ** -0.5),
        "b_e_gate": nrm((DEPTH, N_EXPERTS, D_FF), 0.01),
        "w_e_up": nrm((DEPTH, N_EXPERTS, D, D_FF), D ** -0.5),
        "b_e_up": nrm((DEPTH, N_EXPERTS, D_FF), 0.01),
        "w_e_down": nrm((DEPTH, N_EXPERTS, D_FF, D), D_FF ** -0.5),
        "b_e_down": nrm((DEPTH, N_EXPERTS, D), 0.01),
        "lnf_g": 1.0 + nrm((D,), 0.01),
    }


def reference(x, meta_tokens, ln1_g, w_in, mu_r, mu_k, mu_v, mu_w, mu_a, mu_g, w0, w_w1, w_w2,
              a0, w_a1, w_a2, w_g1, w_g2, k_k, k_a, r_k, lnx_g, lnx_b, w_o_rwkv, conv_w,
              w_o_conv, w_o, ln2_g, w_router, b_router, w_e_gate, b_e_gate, w_e_up, b_e_up,
              w_e_down, b_e_down, lnf_g):
    b = x.shape[0]
    R, C, D = RWKV_WIDTH, CONV_WIDTH, D_MODEL
    meta = jnp.broadcast_to(meta_tokens[None].astype(x.dtype), (b, N_META, D))
    h = jnp.concatenate([meta, x], axis=1)
    cuts = [R, 2 * R, 3 * R, 3 * R + C, 3 * R + 2 * C, 3 * R + 3 * C, 3 * R + 3 * C + D]
    for l in range(DEPTH):
        x_n = _rmsnorm(h, ln1_g[l])
        proj = x_n @ w_in[l]
        pr, pk, pv, cb, cc, ch, gate_a, gate_b = jnp.split(proj, cuts, axis=-1)
        y_a = _rwkv7_branch(x_n, pr, pk, pv, mu_r[l], mu_k[l], mu_v[l], mu_w[l], mu_a[l], mu_g[l],
                            w0[l], w_w1[l], w_w2[l], a0[l], w_a1[l], w_a2[l], w_g1[l], w_g2[l],
                            k_k[l], k_a[l], r_k[l], lnx_g[l], lnx_b[l], w_o_rwkv[l])
        y_b = _short_conv_branch(cb, cc, ch, conv_w[l], w_o_conv[l])
        merged = jax.nn.sigmoid(gate_a) * y_a + jax.nn.sigmoid(gate_b) * y_b
        h = h + merged @ w_o[l]
        h = h + _moe(_rmsnorm(h, ln2_g[l]), w_router[l], b_router[l], w_e_gate[l], b_e_gate[l],
                     w_e_up[l], b_e_up[l], w_e_down[l], b_e_down[l])
    h = _rmsnorm(h, lnf_g)
    return h[:, N_META:]
```

```cpp
#include <hip/hip_runtime.h>
#include <hip/hip_cooperative_groups.h>
#include <cstdio>
namespace cg = cooperative_groups;

#define LAS __attribute__((address_space(3)))
typedef unsigned short bf16_t;
typedef short bf16x8 __attribute__((ext_vector_type(8)));
typedef float f32x4 __attribute__((ext_vector_type(4)));
typedef float f32x2 __attribute__((ext_vector_type(2)));
typedef unsigned u32x4 __attribute__((ext_vector_type(4)));
typedef unsigned u32x2 __attribute__((ext_vector_type(2)));

constexpr int D = 1024, NBATCH = 8, SEQ = 4096, NMETA = 16;
constexpr int T = NBATCH * SEQ;
constexpr int NR = T + NMETA;
constexpr int NRP = 33024;
constexpr int PCOLS = 3584;
constexpr int NCOLS1 = 5632;
constexpr int NE = 32, TOPK = 4, DFF = 1024;
constexpr int MAXROWS = T * TOPK + NE * 256;
constexpr int MAXTILES = MAXROWS / 256;
constexpr float NORM_EPS = 1e-5f, LNX_EPS = 64e-5f;

constexpr size_t SZ_ACT = (size_t)MAXROWS * 1024 * 2;
constexpr size_t SZ_WGU = (size_t)NE * 2048 * 1024 * 2;
constexpr size_t SZ_WD = (size_t)NE * 1024 * 1024 * 2;
constexpr size_t SZ_HB = (size_t)T * 1024 * 2;
constexpr size_t OFF_ACT = 0;
constexpr size_t OFF_WGU = OFF_ACT + SZ_ACT;
constexpr size_t OFF_WD = OFF_WGU + SZ_WGU;
constexpr size_t OFF_HB2 = OFF_WD + SZ_WD;
constexpr size_t OFF_RT = OFF_HB2 + SZ_HB;
constexpr size_t OFF_TOPI = OFF_RT;
constexpr size_t OFF_TOPW = OFF_TOPI + (size_t)T * 16;
constexpr size_t OFF_RANK = OFF_TOPW + (size_t)T * 16;
constexpr size_t OFF_RSTD2 = OFF_RANK + (size_t)T * 16;
constexpr size_t OFF_ROWTOK = OFF_RSTD2 + (size_t)T * 4;
constexpr size_t OFF_ROWSLOT = OFF_ROWTOK + (size_t)MAXROWS * 4;
constexpr size_t OFF_ROWW = OFF_ROWSLOT + (size_t)MAXROWS * 4;
constexpr size_t OFF_ROWRS = OFF_ROWW + (size_t)MAXROWS * 4;
constexpr size_t OFF_TILEE = OFF_ROWRS + (size_t)MAXROWS * 4;
constexpr size_t OFF_GCNT = OFF_TILEE + 4096;
constexpr size_t OFF_SM = OFF_GCNT + 256;
constexpr size_t OFF_WR = OFF_SM;
constexpr size_t OFF_WC = OFF_WR + (size_t)1024 * 512 * 2;
constexpr size_t OFF_WO = OFF_WC + (size_t)1024 * 512 * 2;
constexpr size_t OFF_W2 = OFF_WO + (size_t)1024 * 1024 * 2;
constexpr size_t OFF_RSTD1 = OFF_W2 + (size_t)1536 * 256 * 2;
constexpr size_t OFF_WRG = OFF_RSTD1 + (size_t)NRP * 4;
constexpr size_t WS_NEED = OFF_WRG + (size_t)1024 * 32 * 4;
constexpr size_t OFF_PROJ = 0;
constexpr size_t SZ_PROJ = (size_t)NR * PCOLS * 2;
constexpr size_t OFF_HB = ((SZ_PROJ + 4095) / 4096) * 4096;
constexpr size_t OFF_MERGED = OFF_HB;
constexpr size_t OFF_L = OFF_HB + SZ_HB;
constexpr size_t OFF_LD = OFF_L + (size_t)NRP * 256 * 2;
constexpr size_t OFF_A = OFF_LD + (size_t)NRP * 512 * 4;
constexpr size_t OFF_G = OFF_A + (size_t)NRP * 512 * 2;
constexpr size_t OFF_C = OFF_G + (size_t)NRP * 512 * 2;
constexpr size_t OFF_Z = OFF_C + (size_t)T * 512 * 2;
constexpr size_t OFF_WIN = OFF_Z + (size_t)T * 512 * 2;
constexpr size_t EARLY_END = OFF_WIN + (size_t)NCOLS1 * 1024 * 2;
static_assert(EARLY_END <= OFF_RT, "early buffers overflow");
static_assert(OFF_HB + SZ_HB <= OFF_HB2 && OFF_Z >= OFF_HB + SZ_HB, "layout");

struct Params {
    const float* in[37];
    float* out;
    unsigned char* ws;
    int ph_lo, ph_hi;
};

__device__ __forceinline__ unsigned cvt_pk_bf16(float lo, float hi) { unsigned r; asm volatile("v_cvt_pk_bf16_f32 %0, %1, %2" : "=v"(r) : "v"(lo), "v"(hi)); return r; }
__device__ __forceinline__ bf16_t f2bf(float f) { unsigned u = __float_as_uint(f); u += 0x7FFFu + ((u >> 16) & 1u); return (bf16_t)(u >> 16); }
__device__ __forceinline__ float bf2f(bf16_t b) { return __uint_as_float(((unsigned)b) << 16); }
__device__ __forceinline__ float bflo(unsigned w) { return __uint_as_float(w << 16); }
__device__ __forceinline__ float bfhi(unsigned w) { return __uint_as_float(w & 0xFFFF0000u); }
__device__ __forceinline__ float sigmoidf_(float x) { return 1.0f / (1.0f + __expf(-x)); }
__device__ __forceinline__ float wave_sum(float v) {
#pragma unroll
    for (int o = 32; o >= 1; o >>= 1) v += __shfl_xor(v, o);
    return v;
}
__device__ __forceinline__ int prev_row(int row, int d) {
    if (row < NMETA) return row - d >= 0 ? row - d : -1;
    const int s = (row - NMETA) & (SEQ - 1);
    return s >= d ? row - d : NMETA + s - d;
}

constexpr int BM = 256, BK = 64, HALF = 128, HTB = HALF * BK * 2, STAGE_BYTES = 8 * HTB, NXCD = 8, WGM = 8;
__device__ __forceinline__ int lds_byte(int r, int c) { const int st = (r >> 4) * 2 + (c >> 5), rr = r & 15, cc = c & 31, ob = rr * 64 + cc * 2; return st * 1024 + (ob ^ (((ob >> 9) & 1) << 5)); }
__device__ __forceinline__ void stage_rc(int b, int& R, int& C) { const int st = b / 1024, sb = b % 1024, swz = sb ^ (((sb >> 9) & 1) << 5); R = (st >> 1) * 16 + swz / 64; C = (st & 1) * 32 + (swz % 64) / 2; }
__device__ __forceinline__ int perm32(int rho) { const int n = rho >> 4, i = rho & 15; return 8 * (i >> 2) + 4 * n + (i & 3); }

struct Unit { int pm, pn, aux; };

struct StaticOrder {
    const char* A; const char* Bt; int K;
    int nM, nN, nwg, G, c;
    __device__ void init(const void* A_, const void* Bt_, int M, int N, int K_, int G_, int c_) { A = (const char*)A_; Bt = (const char*)Bt_; K = K_; nM = M / BM; nN = N / BM; nwg = nM * nN; G = G_; c = c_; }
    __device__ bool next(int i, Unit& u) const {
        const long L = (long)i * G + c; if (L >= nwg) return false;
        int wgid = (int)L; { const int q = nwg / NXCD, r = nwg % NXCD, xcd = wgid % NXCD, off = wgid / NXCD; wgid = (xcd < r ? xcd * (q + 1) : r * (q + 1) + (xcd - r) * q) + off; }
        const int nig = WGM * nN, gid = wgid / nig, fm = gid * WGM, gsz = (nM - fm) < WGM ? (nM - fm) : WGM;
        u.pm = fm + ((wgid % nig) % gsz); u.pn = (wgid % nig) / gsz; u.aux = 0; return true;
    }
    __device__ __forceinline__ const char* a_ptr(const Unit& u) const { return A + (size_t)u.pm * 256 * K * 2; }
    __device__ __forceinline__ const char* b_ptr(const Unit& u) const { return Bt + (size_t)u.pn * 256 * K * 2; }
    __device__ __forceinline__ int gather_row(const Unit&, int) const { return 0; }
};
struct MoeOrder {
    const char* A; const char* Bt; int K; size_t estride;
    const int* tile_e; const int* rowtok; int ntiles, nnt, G, c; bool gather;
    __device__ bool next(int i, Unit& u) const {
        const long L = (long)i * G + c; const int mt = (int)(L / nnt); if (mt >= ntiles) return false;
        u.pm = mt; u.pn = (int)(L % nnt); u.aux = tile_e[mt]; return true;
    }
    __device__ __forceinline__ const char* a_ptr(const Unit& u) const { return gather ? A : A + (size_t)u.pm * 256 * K * 2; }
    __device__ __forceinline__ const char* b_ptr(const Unit& u) const { return Bt + (size_t)u.aux * estride + (size_t)u.pn * 256 * K * 2; }
    __device__ __forceinline__ int gather_row(const Unit& u, int r) const { return rowtok[u.pm * 256 + r]; }
};

template <bool GATHER, class Epi, class Sched>
__device__ __forceinline__ void gemm_phase(LAS unsigned char* lds, const int K_, const Sched& S, const Epi& E) {
    int K = K_; asm volatile("" : "+s"(K));
    const int tid = threadIdx.x, wid = __builtin_amdgcn_readfirstlane(tid >> 6), lane = tid & 63, wr = wid >> 2, wc = wid & 3, fr = lane & 15, fq = lane >> 4;
    const int nt = K / BK;
    unsigned voffA[2], voffB[2]; int Rr[2], Cc[2];
#pragma unroll
    for (int i = 0; i < 2; ++i) { int R, C; stage_rc(tid * 16 + i * 8192, R, C); const int Rb = (R & ~31) + perm32(R & 31);
        Rr[i] = R; Cc[i] = C; voffA[i] = (unsigned)(R * K + C) * 2u; voffB[i] = (unsigned)(Rb * K + C) * 2u; }
    const size_t kstep = (size_t)(BK * 2);
    const size_t hstep = (size_t)HALF * K * 2;
    const unsigned ldsw = (unsigned)wid * 1024u;
    const int aoff = lds_byte(wr * 64 + fr, fq * 8), boff = lds_byte(wc * 32 + fr, fq * 8);
    unsigned vgc[2][2], vgn[2][2];
#define G_SA(b, h) (((b) * 2 + (h)) * HTB)
#define G_SB(b, h) ((4 + (b) * 2 + (h)) * HTB)
#define G_STAGE(bufoff, gbase, voff) do { _Pragma("unroll") for (int _i = 0; _i < 2; ++_i) \
        __builtin_amdgcn_global_load_lds((const unsigned*)((const char*)(gbase) + (voff)[_i]), (LAS unsigned*)(lds + (bufoff) + ldsw + _i * 8192), 16, 0, 0); } while (0)
#define G_STAGE_A(bufoff, kptr, h, VG) do { if (GATHER) { G_STAGE(bufoff, kptr, VG[h]); } else { G_STAGE(bufoff, (kptr) + (h) * hstep, voffA); } } while (0)
#define G_LDA(dst, b, h) do { _Pragma("unroll") for (int m = 0; m < 4; ++m) _Pragma("unroll") for (int k = 0; k < 2; ++k) dst[m][k] = *(const LAS bf16x8*)(lds + G_SA(b, h) + aoff + m * 2048 + k * 1024); } while (0)
#define G_LDB(dst, b, h) do { _Pragma("unroll") for (int n = 0; n < 2; ++n) _Pragma("unroll") for (int k = 0; k < 2; ++k) dst[n][k] = *(const LAS bf16x8*)(lds + G_SB(b, h) + boff + n * 2048 + k * 1024); } while (0)
#define G_MMA(ai, bj, At, Bt) do { __builtin_amdgcn_s_setprio(1); _Pragma("unroll") for (int m = 0; m < 4; ++m) _Pragma("unroll") for (int n = 0; n < 2; ++n) _Pragma("unroll") for (int k = 0; k < 2; ++k) \
        acc[ai][bj][m][n] = __builtin_amdgcn_mfma_f32_16x16x32_bf16(Bt[n][k], At[m][k], acc[ai][bj][m][n], 0, 0, 0); __builtin_amdgcn_s_setprio(0); } while (0)
#define G_WAIT_V(n) asm volatile("s_waitcnt vmcnt(" #n ")" ::: "memory")
#define G_WAIT_L(n) asm volatile("s_waitcnt lgkmcnt(" #n ")" ::: "memory")
#define G_BAR __builtin_amdgcn_s_barrier()
#define G_SCHED __builtin_amdgcn_sched_barrier(0)
    Unit cur, nxt;
    int ui = 0;
    if (!S.next(0, cur)) return;
    f32x4 acc[2][2][4][2];
#pragma unroll
    for (int a = 0; a < 2; ++a)
#pragma unroll
        for (int b = 0; b < 2; ++b)
#pragma unroll
            for (int m = 0; m < 4; ++m)
#pragma unroll
                for (int n = 0; n < 2; ++n) acc[a][b][m][n] = (f32x4){0.f, 0.f, 0.f, 0.f};
    bf16x8 At[4][2], B0[2][2], B1[2][2];
    const char* cA = S.a_ptr(cur); const char* cB = S.b_ptr(cur);
    if (GATHER) {
#pragma unroll
        for (int h = 0; h < 2; ++h)
#pragma unroll
            for (int i = 0; i < 2; ++i) vgc[h][i] = (unsigned)(S.gather_row(cur, h * HALF + Rr[i]) * K + Cc[i]) * 2u;
    }
    G_STAGE(G_SB(0, 0), cB, voffB); G_STAGE_A(G_SA(0, 0), cA, 0, vgc); G_STAGE(G_SB(0, 1), cB + hstep, voffB); G_STAGE_A(G_SA(0, 1), cA, 1, vgc);
    if (wr == 1) G_BAR;
    G_WAIT_V(4); G_BAR;
    G_STAGE(G_SB(1, 0), cB + kstep, voffB); G_STAGE_A(G_SA(1, 0), cA + kstep, 0, vgc); G_STAGE(G_SB(1, 1), cB + hstep + kstep, voffB);
    G_WAIT_V(6); G_BAR;
    for (;;) {
        const bool has_next = S.next(ui + 1, nxt);
        const char* nA = has_next ? S.a_ptr(nxt) : cA; const char* nB = has_next ? S.b_ptr(nxt) : cB;
        if (GATHER) {
#pragma unroll
            for (int h = 0; h < 2; ++h)
#pragma unroll
                for (int i = 0; i < 2; ++i) vgn[h][i] = has_next ? (unsigned)(S.gather_row(nxt, h * HALF + Rr[i]) * K + Cc[i]) * 2u : vgc[h][i];
        }
        for (int t = 0; t < nt; t += 2) {
            const bool last = (t == nt - 2);
            const char* a1 = cA + (size_t)(t + 1) * kstep;
            const char* a2 = last ? nA : cA + (size_t)(t + 2) * kstep; const char* b2 = last ? nB : cB + (size_t)(t + 2) * kstep;
            const char* a3 = a2 + kstep; const char* b3 = b2 + kstep;
            unsigned vg2[2][2];
            if (GATHER) {
#pragma unroll
                for (int h = 0; h < 2; ++h)
#pragma unroll
                    for (int i = 0; i < 2; ++i) vg2[h][i] = last ? vgn[h][i] : vgc[h][i];
            }
            G_LDB(B0, 0, 0); G_SCHED; G_LDA(At, 0, 0); G_STAGE_A(G_SA(1, 1), a1, 1, vgc);
            G_WAIT_L(8); G_BAR; G_WAIT_L(0); G_MMA(0, 0, At, B0); G_BAR; G_SCHED;
            G_LDB(B1, 0, 1); G_STAGE(G_SB(0, 0), b2, voffB);
            G_BAR; G_WAIT_L(0); G_MMA(0, 1, At, B1); G_BAR;
            G_LDA(At, 0, 1); G_STAGE_A(G_SA(0, 0), a2, 0, vg2);
            G_BAR; G_WAIT_L(0); G_MMA(1, 0, At, B0); G_BAR; G_SCHED;
            G_STAGE(G_SB(0, 1), b2 + hstep, voffB);
            G_WAIT_V(6); G_BAR; G_MMA(1, 1, At, B1); G_BAR;
            G_LDB(B0, 1, 0); G_SCHED; G_LDA(At, 1, 0); G_STAGE_A(G_SA(0, 1), a2, 1, vg2);
            G_WAIT_L(8); G_BAR; G_WAIT_L(0); G_MMA(0, 0, At, B0); G_BAR; G_SCHED;
            G_LDB(B1, 1, 1); G_STAGE(G_SB(1, 0), b3, voffB);
            G_BAR; G_WAIT_L(0); G_MMA(0, 1, At, B1); G_BAR;
            G_LDA(At, 1, 1); G_STAGE_A(G_SA(1, 0), a3, 0, vg2);
            G_BAR; G_WAIT_L(0); G_MMA(1, 0, At, B0); G_BAR; G_SCHED;
            G_STAGE(G_SB(1, 1), b3 + hstep, voffB);
            G_WAIT_V(6); G_BAR; G_MMA(1, 1, At, B1); G_BAR;
        }
        E(acc, cur, wr, wc, fr, fq);
        if (!has_next) break;
#pragma unroll
        for (int a = 0; a < 2; ++a)
#pragma unroll
            for (int b = 0; b < 2; ++b)
#pragma unroll
                for (int m = 0; m < 4; ++m)
#pragma unroll
                    for (int n = 0; n < 2; ++n) acc[a][b][m][n] = (f32x4){0.f, 0.f, 0.f, 0.f};
        cur = nxt; cA = nA; cB = nB; ++ui;
        if (GATHER) {
#pragma unroll
            for (int h = 0; h < 2; ++h)
#pragma unroll
                for (int i = 0; i < 2; ++i) vgc[h][i] = vgn[h][i];
        }
    }
    G_WAIT_V(0);
    if (wr == 0) G_BAR;
    G_BAR;
#undef G_SA
#undef G_SB
#undef G_STAGE
#undef G_STAGE_A
#undef G_LDA
#undef G_LDB
#undef G_MMA
#undef G_WAIT_V
#undef G_WAIT_L
#undef G_BAR
#undef G_SCHED
}

struct EpiProj {
    bf16_t* proj; bf16_t* gates; const float* rstd1;
    __device__ __forceinline__ void operator()(const f32x4 (&acc)[2][2][4][2], const Unit& u, int wr, int wc, int fr, int fq) const {
        const int row0 = u.pm * BM + wr * 64 + fr;
        const bool isg = u.pn >= 14;
#pragma unroll
        for (int ai = 0; ai < 2; ++ai)
#pragma unroll
            for (int m = 0; m < 4; ++m) {
                const int row = row0 + ai * HALF + m * 16;
                const float rs = rstd1[NMETA + row];
                bf16_t* rowp = isg ? gates + (size_t)row * 2048 + (u.pn - 14) * 256 + wc * 32 + 8 * fq : proj + (size_t)(NMETA + row) * PCOLS + u.pn * 256 + wc * 32 + 8 * fq;
#pragma unroll
                for (int bj = 0; bj < 2; ++bj) {
                    f32x4 v0 = acc[ai][bj][m][0] * rs, v1 = acc[ai][bj][m][1] * rs;
                    if (isg) {
#pragma unroll
                        for (int j = 0; j < 4; ++j) { v0[j] = sigmoidf_(v0[j]); v1[j] = sigmoidf_(v1[j]); }
                    }
                    u32x4 w; w.x = cvt_pk_bf16(v0[0], v0[1]); w.y = cvt_pk_bf16(v0[2], v0[3]); w.z = cvt_pk_bf16(v1[0], v1[1]); w.w = cvt_pk_bf16(v1[2], v1[3]);
                    *(u32x4*)(rowp + bj * HALF) = w;
                }
            }
    }
};
struct EpiL {
    float* LD; bf16_t* Ab; bf16_t* Gb; const float* w0; const float* a0;
    __device__ __forceinline__ void operator()(const f32x4 (&acc)[2][2][4][2], const Unit& u, int wr, int wc, int fr, int fq) const {
        const int row0 = u.pm * BM + wr * 64 + fr;
        const int seg = u.pn >> 1;
        const int cb = (u.pn & 1) * 256 + wc * 32 + 8 * fq;
        const float* bias = seg == 0 ? w0 : a0;
        f32x4 bv[2][2];
#pragma unroll
        for (int bj = 0; bj < 2; ++bj) {
            bv[bj][0] = seg < 2 ? *(const f32x4*)(bias + cb + bj * HALF) : (f32x4){0.f, 0.f, 0.f, 0.f};
            bv[bj][1] = seg < 2 ? *(const f32x4*)(bias + cb + bj * HALF + 4) : (f32x4){0.f, 0.f, 0.f, 0.f};
        }
        const float sc = seg == 0 ? -0.60653065971f : 1.0f;
        bf16_t* ob = seg == 1 ? Ab : Gb;
#pragma unroll
        for (int ai = 0; ai < 2; ++ai)
#pragma unroll
            for (int m = 0; m < 4; ++m) {
                const int row = row0 + ai * HALF + m * 16;
#pragma unroll
                for (int bj = 0; bj < 2; ++bj) {
                    const int c = cb + bj * HALF;
                    f32x4 v0 = acc[ai][bj][m][0] + bv[bj][0], v1 = acc[ai][bj][m][1] + bv[bj][1];
                    if (seg < 2) {
#pragma unroll
                        for (int j = 0; j < 4; ++j) { v0[j] = sc * sigmoidf_(v0[j]); v1[j] = sc * sigmoidf_(v1[j]); }
                    }
                    if (seg == 0) {
                        float* p = LD + (size_t)row * 512 + c;
                        *(f32x4*)p = v0; *(f32x4*)(p + 4) = v1;
                    } else {
                        u32x4 w; w.x = cvt_pk_bf16(v0[0], v0[1]); w.y = cvt_pk_bf16(v0[2], v0[3]); w.z = cvt_pk_bf16(v1[0], v1[1]); w.w = cvt_pk_bf16(v1[2], v1[3]);
                        *(u32x4*)(ob + (size_t)row * 512 + c) = w;
                    }
                }
            }
    }
};
template <int SECOND> struct EpiMerge {
    bf16_t* merged; const bf16_t* gates;
    __device__ __forceinline__ void operator()(const f32x4 (&acc)[2][2][4][2], const Unit& u, int wr, int wc, int fr, int fq) const {
        const int row0 = u.pm * BM + wr * 64 + fr, col0 = u.pn * BM + wc * 32 + 8 * fq;
#pragma unroll
        for (int ai = 0; ai < 2; ++ai)
#pragma unroll
            for (int m = 0; m < 4; ++m) {
                const int row = row0 + ai * HALF + m * 16;
#pragma unroll
                for (int bj = 0; bj < 2; ++bj) {
                    const int c = col0 + bj * HALF;
                    const u32x4 gw = *(const u32x4*)(gates + (size_t)row * 2048 + SECOND * 1024 + c);
                    f32x4 g0 = (f32x4){bflo(gw.x), bfhi(gw.x), bflo(gw.y), bfhi(gw.y)}, g1 = (f32x4){bflo(gw.z), bfhi(gw.z), bflo(gw.w), bfhi(gw.w)};
                    f32x4 v0 = acc[ai][bj][m][0] * g0, v1 = acc[ai][bj][m][1] * g1;
                    bf16_t* p = merged + (size_t)row * 1024 + c;
                    if (SECOND) {
                        const u32x4 ow = *(const u32x4*)p;
                        v0 += (f32x4){bflo(ow.x), bfhi(ow.x), bflo(ow.y), bfhi(ow.y)}; v1 += (f32x4){bflo(ow.z), bfhi(ow.z), bflo(ow.w), bfhi(ow.w)};
                    }
                    u32x4 w; w.x = cvt_pk_bf16(v0[0], v0[1]); w.y = cvt_pk_bf16(v0[2], v0[3]); w.z = cvt_pk_bf16(v1[0], v1[1]); w.w = cvt_pk_bf16(v1[2], v1[3]);
                    *(u32x4*)p = w;
                }
            }
    }
};
struct EpiO {
    const float* x; float* h1; bf16_t* hb2;
    __device__ __forceinline__ void operator()(const f32x4 (&acc)[2][2][4][2], const Unit& u, int wr, int wc, int fr, int fq) const {
        const int row0 = u.pm * BM + wr * 64 + fr, col0 = u.pn * BM + wc * 32 + 8 * fq;
#pragma unroll
        for (int ai = 0; ai < 2; ++ai)
#pragma unroll
            for (int m = 0; m < 4; ++m) {
                const int row = row0 + ai * HALF + m * 16;
#pragma unroll
                for (int bj = 0; bj < 2; ++bj) {
                    const size_t o = (size_t)row * 1024 + col0 + bj * HALF;
                    const f32x4 v0 = acc[ai][bj][m][0] + *(const f32x4*)(x + o), v1 = acc[ai][bj][m][1] + *(const f32x4*)(x + o + 4);
                    *(f32x4*)(h1 + o) = v0; *(f32x4*)(h1 + o + 4) = v1;
                    u32x4 w; w.x = cvt_pk_bf16(v0[0], v0[1]); w.y = cvt_pk_bf16(v0[2], v0[3]); w.z = cvt_pk_bf16(v1[0], v1[1]); w.w = cvt_pk_bf16(v1[2], v1[3]);
                    *(u32x4*)(hb2 + o) = w;
                }
            }
    }
};
struct EpiMoe1 {
    bf16_t* act; const float* rowrs; const float* bg; const float* bu;
    __device__ __forceinline__ void operator()(const f32x4 (&acc)[2][2][4][2], const Unit& u, int wr, int wc, int fr, int fq) const {
        const int row0 = u.pm * BM + wr * 64 + fr, ff0 = u.pn * 128 + wc * 32 + 8 * fq;
        const float* bgp = bg + (size_t)u.aux * DFF + ff0; const float* bup = bu + (size_t)u.aux * DFF + ff0;
        const f32x4 bg0 = *(const f32x4*)bgp, bg1 = *(const f32x4*)(bgp + 4), bu0 = *(const f32x4*)bup, bu1 = *(const f32x4*)(bup + 4);
#pragma unroll
        for (int ai = 0; ai < 2; ++ai)
#pragma unroll
            for (int m = 0; m < 4; ++m) {
                const int row = row0 + ai * HALF + m * 16;
                const float rs = rowrs[row];
                f32x4 g0 = acc[ai][0][m][0] * rs + bg0, g1 = acc[ai][0][m][1] * rs + bg1, u0 = acc[ai][1][m][0] * rs + bu0, u1 = acc[ai][1][m][1] * rs + bu1;
                f32x4 r0, r1;
#pragma unroll
                for (int j = 0; j < 4; ++j) {
                    { const float gt = fminf(g0[j], 7.0f), up = fminf(fmaxf(u0[j], -7.0f), 7.0f); r0[j] = (up + 1.0f) * gt * sigmoidf_(1.702f * gt); }
                    { const float gt = fminf(g1[j], 7.0f), up = fminf(fmaxf(u1[j], -7.0f), 7.0f); r1[j] = (up + 1.0f) * gt * sigmoidf_(1.702f * gt); }
                }
                u32x4 w; w.x = cvt_pk_bf16(r0[0], r0[1]); w.y = cvt_pk_bf16(r0[2], r0[3]); w.z = cvt_pk_bf16(r1[0], r1[1]); w.w = cvt_pk_bf16(r1[2], r1[3]);
                *(u32x4*)(act + (size_t)row * DFF + ff0) = w;
            }
    }
};
struct EpiMoe2 {
    bf16_t* ya; bf16_t* yb; const int* rowslot; const float* roww; const float* bd;
    __device__ __forceinline__ void operator()(const f32x4 (&acc)[2][2][4][2], const Unit& u, int wr, int wc, int fr, int fq) const {
        const int row0 = u.pm * BM + wr * 64 + fr, col0 = u.pn * BM + wc * 32 + 8 * fq;
        bf16_t* ybase = (u.pn < 2) ? ya : yb; const int yc0 = col0 & 511;
        const float* bp = bd + (size_t)u.aux * D + col0;
        f32x4 bv[2][2];
#pragma unroll
        for (int bj = 0; bj < 2; ++bj) { bv[bj][0] = *(const f32x4*)(bp + bj * HALF); bv[bj][1] = *(const f32x4*)(bp + bj * HALF + 4); }
#pragma unroll
        for (int ai = 0; ai < 2; ++ai)
#pragma unroll
            for (int m = 0; m < 4; ++m) {
                const int row = row0 + ai * HALF + m * 16;
                const int slot = rowslot[row];
                if (slot >= 0) {
                    const float w8 = roww[row];
#pragma unroll
                    for (int bj = 0; bj < 2; ++bj) {
                        const f32x4 v0 = (acc[ai][bj][m][0] + bv[bj][0]) * w8, v1 = (acc[ai][bj][m][1] + bv[bj][1]) * w8;
                        u32x4 w; w.x = cvt_pk_bf16(v0[0], v0[1]); w.y = cvt_pk_bf16(v0[2], v0[3]); w.z = cvt_pk_bf16(v1[0], v1[1]); w.w = cvt_pk_bf16(v1[2], v1[3]);
                        *(u32x4*)(ybase + (size_t)slot * 512 + yc0 + bj * HALF) = w;
                    }
                }
            }
    }
};

__device__ __forceinline__ void transpose_tile(LAS float* tile, const float* src, int ldsrc, int k0, int n0, bf16_t* dst, int ldd, int drow0, const float* sa, const float* mu, int mode, bool zero) {
    const int tid = threadIdx.x;
    if (!zero) {
#pragma unroll
        for (int i = 0; i < 2; ++i) {
            const int r = (tid >> 4) + 32 * i, c4 = (tid & 15) * 4;
            const f32x4 v = *(const f32x4*)(src + (size_t)(k0 + r) * ldsrc + n0 + c4);
            LAS float* t = tile + r * 65 + c4;
            t[0] = v[0]; t[1] = v[1]; t[2] = v[2]; t[3] = v[3];
        }
    }
    __syncthreads();
    {
        const int n = tid >> 3, kq = tid & 7;
        float v[8];
#pragma unroll
        for (int j = 0; j < 8; ++j) {
            const int k = k0 + 8 * kq + j;
            float s = sa ? sa[k] : 1.0f;
            if (mode == 1) s *= (1.0f - mu[k]);
            if (mode == 2) s *= mu[k];
            v[j] = zero ? 0.f : tile[(8 * kq + j) * 65 + n] * s;
        }
        u32x4 w; w.x = cvt_pk_bf16(v[0], v[1]); w.y = cvt_pk_bf16(v[2], v[3]); w.z = cvt_pk_bf16(v[4], v[5]); w.w = cvt_pk_bf16(v[6], v[7]);
        *(u32x4*)(dst + (size_t)(drow0 + n) * ldd + k0 + 8 * kq) = w;
    }
    __syncthreads();
}

__device__ void phase_prep(const Params& p, LAS unsigned char* lds) {
    const int tid = threadIdx.x, bid = blockIdx.x, nb = gridDim.x, lane = tid & 63, wave = tid >> 6;
    unsigned char* ws = p.ws;
    const float* x = p.in[0]; const float* meta = p.in[1]; const float* g1 = p.in[2];
    if (bid == 0 && tid < 64) ((int*)(ws + OFF_GCNT))[tid] = 0;
    {
        bf16_t* HB = (bf16_t*)(ws + OFF_HB); float* rstd1 = (float*)(ws + OFF_RSTD1);
        for (int row = bid * 8 + wave; row < NR; row += nb * 8) {
            const float* src = row < NMETA ? meta + (size_t)row * D : x + (size_t)(row - NMETA) * D;
            float ss = 0.f; f32x4 v[4];
#pragma unroll
            for (int i = 0; i < 4; ++i) { v[i] = *(const f32x4*)(src + i * 256 + lane * 4); ss += v[i][0] * v[i][0] + v[i][1] * v[i][1] + v[i][2] * v[i][2] + v[i][3] * v[i][3]; }
            ss = wave_sum(ss);
            if (lane == 0) rstd1[row] = rsqrtf(ss * (1.0f / D) + NORM_EPS);
            if (row >= NMETA) {
                bf16_t* d = HB + (size_t)(row - NMETA) * D;
#pragma unroll
                for (int i = 0; i < 4; ++i) { u32x2 w; w.x = cvt_pk_bf16(v[i][0], v[i][1]); w.y = cvt_pk_bf16(v[i][2], v[i][3]); *(u32x2*)(d + i * 256 + lane * 4) = w; }
            }
        }
    }
    LAS float* tile = (LAS float*)lds;
    {
        bf16_t* WIN = (bf16_t*)(ws + OFF_WIN);
        const float* w_in = p.in[3];
        for (int j = bid; j < 16 * 88; j += nb) {
            const int kt = j & 15, ntile = j >> 4, n0 = ntile * 64;
            const float* src; int ld, sn0, mode = 0; const float* mu = nullptr;
            if (n0 < 3072) { src = w_in; ld = 5120; sn0 = n0; }
            else if (n0 < 3584) {
                const int seg = (n0 - 3072) >> 6;
                if (seg < 2) { src = p.in[11]; ld = 64; sn0 = 0; mu = p.in[7]; mode = 1 + seg; }
                else if (seg < 4) { src = p.in[14]; ld = 64; sn0 = 0; mu = p.in[8]; mode = 1 + (seg - 2); }
                else { src = p.in[16]; ld = 128; sn0 = (seg & 1) * 64; mu = p.in[9]; mode = seg < 6 ? 1 : 2; }
            } else { src = w_in; ld = 5120; sn0 = n0 - 512; }
            transpose_tile(tile, src, ld, kt * 64, sn0, WIN, 1024, n0, g1, mu, mode, false);
        }
        for (int j = bid; j < 2 * 128; j += nb) {
            const int which = j >> 7, jj = j & 127, kt = jj & 7, ntile = jj >> 3;
            transpose_tile(tile, which ? p.in[25] : p.in[23], 1024, kt * 64, ntile * 64, (bf16_t*)(ws + (which ? OFF_WC : OFF_WR)), 512, ntile * 64, nullptr, nullptr, 0, false);
        }
        for (int j = bid; j < 256; j += nb) {
            const int kt = j & 15, ntile = j >> 4;
            transpose_tile(tile, p.in[26], 1024, kt * 64, ntile * 64, (bf16_t*)(ws + OFF_WO), 1024, ntile * 64, nullptr, nullptr, 0, false);
        }
        for (int j = bid; j < 96; j += nb) {
            const int kt = j & 3, ntile = j >> 2, seg = ntile >> 3, nn0 = (ntile & 7) * 64;
            const float* src = nullptr; int sk0 = 0; bool zero = true;
            if (seg == 0 && kt == 0) { src = p.in[12]; sk0 = 0; zero = false; }
            if (seg == 1 && kt == 1) { src = p.in[15]; sk0 = 0; zero = false; }
            if (seg == 2 && kt >= 2) { src = p.in[17]; sk0 = (kt - 2) * 64; zero = false; }
            const float* srcs = zero ? p.in[12] : src + (size_t)(sk0 - kt * 64) * 512;
            transpose_tile(tile, srcs, 512, kt * 64, nn0, (bf16_t*)(ws + OFF_W2), 256, ntile * 64, nullptr, nullptr, 0, zero);
        }
        {
            float* WRG = (float*)(ws + OFF_WRG); const float* g2 = p.in[27]; const float* wr_ = p.in[28];
            for (int i = bid * 512 + tid; i < 1024 * 32; i += nb * 512) WRG[i] = g2[i >> 5] * wr_[i];
        }
    }
}

__device__ void phase_meta_proj(const Params& p, LAS unsigned char* lds) {
    const int tid = threadIdx.x, bid = blockIdx.x;
    unsigned char* ws = p.ws;
    LAS float* sm = (LAS float*)lds;
    const float* meta = p.in[1];
    for (int i = tid; i < 16 * 256; i += 512) { const int r = i >> 8, c4 = (i & 255) * 4; const f32x4 v = *(const f32x4*)(meta + r * 1024 + c4); LAS float* d = sm + r * 1028 + c4; d[0] = v[0]; d[1] = v[1]; d[2] = v[2]; d[3] = v[3]; }
    __syncthreads();
    for (int nbase = bid * 14; nbase < PCOLS; nbase += gridDim.x * 14) if (tid < 224) {
        const int n = nbase + (tid >> 4), pr = tid & 15;
        const bf16_t* wrow = (const bf16_t*)(ws + OFF_WIN) + (size_t)n * 1024;
        float acc = 0.f;
        for (int k = 0; k < 1024; k += 8) {
            const u32x4 w = *(const u32x4*)(wrow + k);
            const LAS float* m = sm + pr * 1028 + k;
            acc += m[0] * bflo(w.x) + m[1] * bfhi(w.x) + m[2] * bflo(w.y) + m[3] * bfhi(w.y) + m[4] * bflo(w.z) + m[5] * bfhi(w.z) + m[6] * bflo(w.w) + m[7] * bfhi(w.w);
        }
        const float rs = ((const float*)(ws + OFF_RSTD1))[pr];
        ((bf16_t*)(ws + OFF_PROJ))[(size_t)pr * PCOLS + n] = f2bf(acc * rs);
    }
    __syncthreads();
}

__device__ void phase_lprep_conv(const Params& p) {
    const int tid = threadIdx.x, bid = blockIdx.x, nb = gridDim.x;
    unsigned char* ws = p.ws;
    const bf16_t* PROJ = (const bf16_t*)(ws + OFF_PROJ);
    bf16_t* L = (bf16_t*)(ws + OFF_L);
    for (int i = bid * 512 + tid; i < NRP * 32; i += nb * 512) {
        const int row = i >> 5, gq = i & 31;
        u32x4 w = (u32x4){0u, 0u, 0u, 0u};
        if (row < NR) {
            int ca, cb;
            if (gq < 8) { ca = 3072 + gq * 8; cb = ca + 64; }
            else if (gq < 16) { ca = 3072 + 128 + (gq - 8) * 8; cb = ca + 64; }
            else { ca = 3072 + 256 + (gq - 16) * 8; cb = ca + 128; }
            const u32x4 va = *(const u32x4*)(PROJ + (size_t)row * PCOLS + ca);
            const int pr = prev_row(row, 1);
            u32x4 vb = (u32x4){0u, 0u, 0u, 0u};
            if (pr >= 0) vb = *(const u32x4*)(PROJ + (size_t)pr * PCOLS + cb);
            float v[8] = {bflo(va.x) + bflo(vb.x), bfhi(va.x) + bfhi(vb.x), bflo(va.y) + bflo(vb.y), bfhi(va.y) + bfhi(vb.y), bflo(va.z) + bflo(vb.z), bfhi(va.z) + bfhi(vb.z), bflo(va.w) + bflo(vb.w), bfhi(va.w) + bfhi(vb.w)};
#pragma unroll
            for (int j = 0; j < 8; ++j) { if (gq < 8) v[j] = tanhf(v[j]); else if (gq >= 16) v[j] = sigmoidf_(v[j]); }
            w.x = cvt_pk_bf16(v[0], v[1]); w.y = cvt_pk_bf16(v[2], v[3]); w.z = cvt_pk_bf16(v[4], v[5]); w.w = cvt_pk_bf16(v[6], v[7]);
        }
        *(u32x4*)(L + (size_t)row * 256 + gq * 8) = w;
    }
    bf16_t* C = (bf16_t*)(ws + OFF_C);
    const float* cw = p.in[24];
    for (int i = bid * 512 + tid; i < T * 64; i += nb * 512) {
        const int m = i >> 6, ch = (i & 63) * 8, row = NMETA + m;
        const int r1 = prev_row(row, 1), r2 = prev_row(row, 2);
        const bf16_t* p0 = PROJ + (size_t)row * PCOLS; const bf16_t* p1 = PROJ + (size_t)r1 * PCOLS; const bf16_t* p2 = PROJ + (size_t)r2 * PCOLS;
        const u32x4 vb = *(const u32x4*)(p0 + 1536 + ch);
        const u32x4 c0 = *(const u32x4*)(p0 + 2048 + ch), h0 = *(const u32x4*)(p0 + 2560 + ch);
        const u32x4 c1 = *(const u32x4*)(p1 + 2048 + ch), h1 = *(const u32x4*)(p1 + 2560 + ch);
        const u32x4 c2 = *(const u32x4*)(p2 + 2048 + ch), h2 = *(const u32x4*)(p2 + 2560 + ch);
        float o[8];
#pragma unroll
        for (int j = 0; j < 8; ++j) {
            const unsigned wb = j < 2 ? vb.x : j < 4 ? vb.y : j < 6 ? vb.z : vb.w;
            const unsigned wc0 = j < 2 ? c0.x : j < 4 ? c0.y : j < 6 ? c0.z : c0.w, wh0 = j < 2 ? h0.x : j < 4 ? h0.y : j < 6 ? h0.z : h0.w;
            const unsigned wc1 = j < 2 ? c1.x : j < 4 ? c1.y : j < 6 ? c1.z : c1.w, wh1 = j < 2 ? h1.x : j < 4 ? h1.y : j < 6 ? h1.z : h1.w;
            const unsigned wc2 = j < 2 ? c2.x : j < 4 ? c2.y : j < 6 ? c2.z : c2.w, wh2 = j < 2 ? h2.x : j < 4 ? h2.y : j < 6 ? h2.z : h2.w;
            const bool hi = j & 1;
            const float b = hi ? bfhi(wb) : bflo(wb);
            const float u0 = (hi ? bfhi(wc0) : bflo(wc0)) * (hi ? bfhi(wh0) : bflo(wh0));
            const float u1 = (hi ? bfhi(wc1) : bflo(wc1)) * (hi ? bfhi(wh1) : bflo(wh1));
            const float u2 = (hi ? bfhi(wc2) : bflo(wc2)) * (hi ? bfhi(wh2) : bflo(wh2));
            const float conv = cw[ch + j] * u2 + cw[512 + ch + j] * u1 + cw[1024 + ch + j] * u0;
            o[j] = b * conv;
        }
        u32x4 w; w.x = cvt_pk_bf16(o[0], o[1]); w.y = cvt_pk_bf16(o[2], o[3]); w.z = cvt_pk_bf16(o[4], o[5]); w.w = cvt_pk_bf16(o[6], o[7]);
        *(u32x4*)(C + (size_t)m * 512 + ch) = w;
    }
}

__device__ void phase_scan(const Params& p, LAS unsigned char* lds) {
    const int tid = threadIdx.x, bid = blockIdx.x, lane = tid & 63, wave = tid >> 6;
    if (bid >= 64) return;
    unsigned char* ws = p.ws;
    const int b = bid >> 3, h = bid & 7;
    const bf16_t* PROJ = (const bf16_t*)(ws + OFF_PROJ);
    const float* LD = (const float*)(ws + OFF_LD);
    const bf16_t* Ab = (const bf16_t*)(ws + OFF_A);
    const bf16_t* Gb = (const bf16_t*)(ws + OFF_G);
    bf16_t* Z = (bf16_t*)(ws + OFF_Z);
    LAS float* sr = (LAS float*)lds;
    LAS float* sw = sr + 1024; LAS float* sk = sw + 1024; LAS float* sv = sk + 1024; LAS float* skk = sv + 1024; LAS float* sb = skk + 1024; LAS float* sy = sb + 1024;
    LAS float* scoef = sy + 1024;
    const int col = h * 64 + lane;
    const float mur = p.in[4][col], muk = p.in[5][col], muv = p.in[6][col], kkw = p.in[18][col], kaw = p.in[19][col], rkw = p.in[20][col], lng = p.in[21][col], lnb = p.in[22][col];
    const int i = tid >> 3, q = tid & 7;
    float S[8];
#pragma unroll
    for (int j = 0; j < 8; ++j) S[j] = 0.f;
    for (int c = 0; c < 257; ++c) {
#pragma unroll
        for (int s = 0; s < 2; ++s) {
            const int tl = wave * 2 + s, pos = c * 16 + tl;
            const int row = pos < NMETA ? pos : b * SEQ + pos;
            const int pr = prev_row(row, 1);
            const bf16_t* p0 = PROJ + (size_t)row * PCOLS + col;
            float r0 = bf2f(p0[0]), k0 = bf2f(p0[512]), v0 = bf2f(p0[1024]);
            float r1 = 0.f, k1 = 0.f, v1 = 0.f;
            if (pr >= 0) { const bf16_t* p1 = PROJ + (size_t)pr * PCOLS + col; r1 = bf2f(p1[0]); k1 = bf2f(p1[512]); v1 = bf2f(p1[1024]); }
            const float r = r0 + (r1 - r0) * mur, k = k0 + (k1 - k0) * muk, v = v0 + (v1 - v0) * muv;
            const float a = bf2f(Ab[(size_t)row * 512 + col]);
            const float w = __expf(LD[(size_t)row * 512 + col]);
            const float kkv = k * kkw;
            const float nrm = sqrtf(wave_sum(kkv * kkv));
            const float kk = kkv / fmaxf(nrm, 1e-12f);
            const float k2 = k * (1.0f + (a - 1.0f) * kaw);
            const float coef = wave_sum(r * k2 * rkw);
            sr[tl * 64 + lane] = r; sw[tl * 64 + lane] = w; sk[tl * 64 + lane] = k2; sv[tl * 64 + lane] = v; skk[tl * 64 + lane] = kk; sb[tl * 64 + lane] = kk * a;
            if (lane == 0) scoef[tl] = coef;
        }
        __syncthreads();
        for (int t = 0; t < 16; ++t) {
            const f32x4 kk0 = *(const LAS f32x4*)(skk + t * 64 + q * 8), kk1 = *(const LAS f32x4*)(skk + t * 64 + q * 8 + 4);
            const f32x4 w0 = *(const LAS f32x4*)(sw + t * 64 + q * 8), w1 = *(const LAS f32x4*)(sw + t * 64 + q * 8 + 4);
            const f32x4 b0 = *(const LAS f32x4*)(sb + t * 64 + q * 8), b1 = *(const LAS f32x4*)(sb + t * 64 + q * 8 + 4);
            const f32x4 k0 = *(const LAS f32x4*)(sk + t * 64 + q * 8), k1 = *(const LAS f32x4*)(sk + t * 64 + q * 8 + 4);
            const f32x4 r0 = *(const LAS f32x4*)(sr + t * 64 + q * 8), r1 = *(const LAS f32x4*)(sr + t * 64 + q * 8 + 4);
            const float vi = sv[t * 64 + i];
            float sa = S[0] * kk0[0] + S[1] * kk0[1] + S[2] * kk0[2] + S[3] * kk0[3] + S[4] * kk1[0] + S[5] * kk1[1] + S[6] * kk1[2] + S[7] * kk1[3];
            sa += __shfl_xor(sa, 1); sa += __shfl_xor(sa, 2); sa += __shfl_xor(sa, 4);
            sa = -sa;
            S[0] = S[0] * w0[0] + sa * b0[0] + vi * k0[0]; S[1] = S[1] * w0[1] + sa * b0[1] + vi * k0[1]; S[2] = S[2] * w0[2] + sa * b0[2] + vi * k0[2]; S[3] = S[3] * w0[3] + sa * b0[3] + vi * k0[3];
            S[4] = S[4] * w1[0] + sa * b1[0] + vi * k1[0]; S[5] = S[5] * w1[1] + sa * b1[1] + vi * k1[1]; S[6] = S[6] * w1[2] + sa * b1[2] + vi * k1[2]; S[7] = S[7] * w1[3] + sa * b1[3] + vi * k1[3];
            float y = S[0] * r0[0] + S[1] * r0[1] + S[2] * r0[2] + S[3] * r0[3] + S[4] * r1[0] + S[5] * r1[1] + S[6] * r1[2] + S[7] * r1[3];
            y += __shfl_xor(y, 1); y += __shfl_xor(y, 2); y += __shfl_xor(y, 4);
            if (q == 0) sy[t * 64 + i] = y;
        }
        __syncthreads();
        if (c > 0) {
#pragma unroll
            for (int s = 0; s < 2; ++s) {
                const int tl = wave * 2 + s, pos = c * 16 + tl, row = b * SEQ + pos;
                const float y = sy[tl * 64 + lane];
                const float mean = wave_sum(y) * (1.0f / 64.0f);
                const float dlt = y - mean;
                const float var = wave_sum(dlt * dlt) * (1.0f / 64.0f);
                const float yn = dlt * rsqrtf(var + LNX_EPS) * lng + lnb;
                const float bonus = scoef[tl] * sv[tl * 64 + lane];
                const float g = bf2f(Gb[(size_t)row * 512 + col]);
                Z[(size_t)(row - NMETA) * 512 + col] = f2bf((yn + bonus) * g);
            }
        }
        __syncthreads();
    }
}

__device__ void phase_router(const Params& p, LAS unsigned char* lds) {
    const int tid = threadIdx.x, bid = blockIdx.x, nb = gridDim.x, lane = tid & 63, wave = tid >> 6;
    unsigned char* ws = p.ws;
    const float* h1 = p.out;
    const float* WRG = (const float*)(ws + OFF_WRG);
    const float* brt = p.in[29];
    LAS float* slog = (LAS float*)lds;
    LAS float* srs = slog + 8 * 16 * 32;
    LAS int* lcnt = (LAS int*)(srs + 128);
    LAS int* gbase = lcnt + 32;
    LAS int* ltopi = gbase + 32;
    LAS int* lrank = ltopi + 512;
    int* TOPI = (int*)(ws + OFF_TOPI); float* TOPW = (float*)(ws + OFF_TOPW); int* RANK = (int*)(ws + OFF_RANK); float* RSTD2 = (float*)(ws + OFF_RSTD2);
    int* GCNT = (int*)(ws + OFF_GCNT);
    for (int tb = bid; tb < T / 128; tb += nb) {
        if (tid < 32) lcnt[tid] = 0;
        __syncthreads();
        const int t0 = tb * 128 + wave * 16;
        {
            const int row = lane & 15, kq = lane >> 4;
            const float* ap = h1 + (size_t)(t0 + row) * D + 4 * kq;
            const float* bp = WRG + (size_t)(4 * kq) * 32 + row;
            f32x4 acc0 = (f32x4){0.f, 0.f, 0.f, 0.f}, acc1 = acc0;
            float ss = 0.f;
            for (int j = 0; j < 64; ++j) {
                const f32x4 av = *(const f32x4*)(ap + 16 * j);
                ss += av[0] * av[0] + av[1] * av[1] + av[2] * av[2] + av[3] * av[3];
                const float* bj = bp + (size_t)(16 * j) * 32;
#pragma unroll
                for (int s = 0; s < 4; ++s) {
                    const float b0 = bj[s * 32], b1 = bj[s * 32 + 16];
                    acc0 = __builtin_amdgcn_mfma_f32_16x16x4f32(av[s], b0, acc0, 0, 0, 0);
                    acc1 = __builtin_amdgcn_mfma_f32_16x16x4f32(av[s], b1, acc1, 0, 0, 0);
                }
            }
            ss += __shfl_xor(ss, 16); ss += __shfl_xor(ss, 32);
#pragma unroll
            for (int reg = 0; reg < 4; ++reg) {
                slog[(wave * 16 + 4 * kq + reg) * 32 + row] = acc0[reg];
                slog[(wave * 16 + 4 * kq + reg) * 32 + 16 + row] = acc1[reg];
            }
            if (lane < 16) srs[wave * 16 + lane] = rsqrtf(ss * (1.0f / D) + NORM_EPS);
        }
        __syncthreads();
        if (lane < 16) {
            const int tl = wave * 16 + lane, t = tb * 128 + tl;
            const float rs = srs[tl];
            float lg[32];
#pragma unroll
            for (int e = 0; e < 32; ++e) lg[e] = slog[tl * 32 + e] * rs + brt[e];
            int ti[4]; float tv[4];
#pragma unroll
            for (int k = 0; k < 4; ++k) {
                float best = -3.0e38f; int bi = 0;
#pragma unroll
                for (int e = 0; e < 32; ++e) { const bool tk = lg[e] > best; best = tk ? lg[e] : best; bi = tk ? e : bi; }
                ti[k] = bi; tv[k] = best;
#pragma unroll
                for (int e = 0; e < 32; ++e) lg[e] = (e == bi) ? -3.0e38f : lg[e];
            }
            const float e0 = 1.0f, e1 = __expf(tv[1] - tv[0]), e2 = __expf(tv[2] - tv[0]), e3 = __expf(tv[3] - tv[0]);
            const float inv = 1.0f / (e0 + e1 + e2 + e3);
            *(f32x4*)(TOPW + (size_t)t * 4) = (f32x4){e0 * inv, e1 * inv, e2 * inv, e3 * inv};
            RSTD2[t] = rs;
#pragma unroll
            for (int k = 0; k < 4; ++k) { ltopi[tl * 4 + k] = ti[k]; lrank[tl * 4 + k] = __hip_atomic_fetch_add(lcnt + ti[k], 1, __ATOMIC_RELAXED, __HIP_MEMORY_SCOPE_WORKGROUP); }
        }
        __syncthreads();
        if (tid < 32) gbase[tid] = atomicAdd(GCNT + tid, lcnt[tid]);
        __syncthreads();
        {
            const int e = ltopi[tid];
            TOPI[(size_t)tb * 512 + tid] = e;
            RANK[(size_t)tb * 512 + tid] = gbase[e] + lrank[tid];
        }
        __syncthreads();
    }
    LAS float* tile = (LAS float*)lds;
    const float* g2 = p.in[27];
    bf16_t* WGU = (bf16_t*)(ws + OFF_WGU); bf16_t* WD = (bf16_t*)(ws + OFF_WD);
    for (int j = bid; j < NE * 3 * 256; j += nb) {
        const int e = j / 768, r = j % 768, which = r >> 8, tt = r & 255, kt = tt & 15, ntile = tt >> 4;
        if (which < 2) {
            const float* src = (which == 0 ? p.in[30] : p.in[32]) + (size_t)e * 1024 * 1024;
            const int drow0 = 256 * (ntile >> 1) + 128 * which + 64 * (ntile & 1);
            transpose_tile(tile, src, 1024, kt * 64, ntile * 64, WGU + (size_t)e * 2048 * 1024, 1024, drow0, g2, nullptr, 0, false);
        } else {
            const float* src = p.in[34] + (size_t)e * 1024 * 1024;
            transpose_tile(tile, src, 1024, kt * 64, ntile * 64, WD + (size_t)e * 1024 * 1024, 1024, ntile * 64, nullptr, nullptr, 0, false);
        }
    }
}

__device__ void phase_lists(const Params& p, LAS unsigned char* lds) {
    const int tid = threadIdx.x, bid = blockIdx.x, nb = gridDim.x;
    unsigned char* ws = p.ws;
    LAS int* pstart = (LAS int*)lds;
    LAS int* cnt = pstart + 64;
    const int* GCNT = (const int*)(ws + OFF_GCNT);
    if (tid < 32) cnt[tid] = GCNT[tid];
    __syncthreads();
    if (tid == 0) { int s = 0; for (int e = 0; e < 32; ++e) { pstart[e] = s; s += ((cnt[e] + 255) >> 8) << 8; } pstart[32] = s; }
    __syncthreads();
    const int* TOPI = (const int*)(ws + OFF_TOPI); const float* TOPW = (const float*)(ws + OFF_TOPW); const int* RANK = (const int*)(ws + OFF_RANK); const float* RSTD2 = (const float*)(ws + OFF_RSTD2);
    int* ROWTOK = (int*)(ws + OFF_ROWTOK); int* ROWSLOT = (int*)(ws + OFF_ROWSLOT); float* ROWW = (float*)(ws + OFF_ROWW); float* ROWRS = (float*)(ws + OFF_ROWRS);
    for (int i = bid * 512 + tid; i < T * 4; i += nb * 512) {
        const int e = TOPI[i], pos = pstart[e] + RANK[i], t = i >> 2;
        ROWTOK[pos] = t; ROWSLOT[pos] = i; ROWW[pos] = TOPW[i]; ROWRS[pos] = RSTD2[t];
    }
    for (int e = bid; e < 32; e += nb) {
        for (int pos = pstart[e] + cnt[e] + tid; pos < pstart[e + 1]; pos += 512) { ROWTOK[pos] = 0; ROWSLOT[pos] = -1; ROWW[pos] = 0.f; ROWRS[pos] = 0.f; }
    }
    if (bid == 0) {
        int* TILEE = (int*)(ws + OFF_TILEE);
        const int ntiles = pstart[32] >> 8;
        for (int mt = tid; mt < ntiles; mt += 512) { int e = 0; for (int q = 0; q < 32; ++q) if (pstart[q] <= mt * 256) e = q; TILEE[mt] = e; }
        if (tid == 0) TILEE[1000] = ntiles;
    }
    __syncthreads();
}

__device__ void phase_final(const Params& p) {
    const int tid = threadIdx.x, bid = blockIdx.x, nb = gridDim.x, lane = tid & 63, wave = tid >> 6;
    unsigned char* ws = p.ws;
    const bf16_t* HB2 = (const bf16_t*)(ws + OFF_HB2);
    const bf16_t* YA = (const bf16_t*)p.out; const bf16_t* YB = (const bf16_t*)(ws + OFF_WGU);
    const float* gf = p.in[36];
    const f32x4 ga0 = *(const f32x4*)(gf + 8 * lane), ga1 = *(const f32x4*)(gf + 8 * lane + 4), gb0 = *(const f32x4*)(gf + 512 + 8 * lane), gb1 = *(const f32x4*)(gf + 512 + 8 * lane + 4);
    for (int t = bid * 8 + wave; t < T; t += nb * 8) {
        const u32x4 ha = *(const u32x4*)(HB2 + (size_t)t * D + 8 * lane), hb = *(const u32x4*)(HB2 + (size_t)t * D + 512 + 8 * lane);
        float va[8] = {bflo(ha.x), bfhi(ha.x), bflo(ha.y), bfhi(ha.y), bflo(ha.z), bfhi(ha.z), bflo(ha.w), bfhi(ha.w)};
        float vb[8] = {bflo(hb.x), bfhi(hb.x), bflo(hb.y), bfhi(hb.y), bflo(hb.z), bfhi(hb.z), bflo(hb.w), bfhi(hb.w)};
#pragma unroll
        for (int k = 0; k < 4; ++k) {
            const u32x4 ya = *(const u32x4*)(YA + (size_t)(4 * t + k) * 512 + 8 * lane), yb = *(const u32x4*)(YB + (size_t)(4 * t + k) * 512 + 8 * lane);
            va[0] += bflo(ya.x); va[1] += bfhi(ya.x); va[2] += bflo(ya.y); va[3] += bfhi(ya.y); va[4] += bflo(ya.z); va[5] += bfhi(ya.z); va[6] += bflo(ya.w); va[7] += bfhi(ya.w);
            vb[0] += bflo(yb.x); vb[1] += bfhi(yb.x); vb[2] += bflo(yb.y); vb[3] += bfhi(yb.y); vb[4] += bflo(yb.z); vb[5] += bfhi(yb.z); vb[6] += bflo(yb.w); vb[7] += bfhi(yb.w);
        }
        float ss = 0.f;
#pragma unroll
        for (int j = 0; j < 8; ++j) ss += va[j] * va[j] + vb[j] * vb[j];
        ss = wave_sum(ss);
        const float rs = rsqrtf(ss * (1.0f / D) + NORM_EPS);
        float* o = p.out + (size_t)t * D;
        *(f32x4*)(o + 8 * lane) = (f32x4){va[0] * rs * ga0[0], va[1] * rs * ga0[1], va[2] * rs * ga0[2], va[3] * rs * ga0[3]};
        *(f32x4*)(o + 8 * lane + 4) = (f32x4){va[4] * rs * ga1[0], va[5] * rs * ga1[1], va[6] * rs * ga1[2], va[7] * rs * ga1[3]};
        *(f32x4*)(o + 512 + 8 * lane) = (f32x4){vb[0] * rs * gb0[0], vb[1] * rs * gb0[1], vb[2] * rs * gb0[2], vb[3] * rs * gb0[3]};
        *(f32x4*)(o + 512 + 8 * lane + 4) = (f32x4){vb[4] * rs * gb1[0], vb[5] * rs * gb1[1], vb[6] * rs * gb1[2], vb[7] * rs * gb1[3]};
    }
}

constexpr int N_PHASES = 13;
__global__ void __launch_bounds__(512, 2) mega(Params p) {
    extern __shared__ __attribute__((aligned(16))) unsigned char lds_raw[];
    LAS unsigned char* lds = (LAS unsigned char*)lds_raw;
    cg::grid_group grid = cg::this_grid();
    unsigned char* ws = p.ws;
    const int G = gridDim.x, bid = blockIdx.x;
#ifndef ONLY_PHASE
#define ONLY_PHASE -1
#endif
#define IN(k) ((ONLY_PHASE < 0 || ONLY_PHASE == (k)) && p.ph_lo <= (k) && (k) < p.ph_hi)
#define SEAM(k) do { if ((k) + 1 < p.ph_hi) grid.sync(); } while (0)
    if (IN(0)) { phase_prep(p, lds); SEAM(0); }
    if (IN(1)) {
        phase_meta_proj(p, lds);
        StaticOrder S; S.init(ws + OFF_HB, ws + OFF_WIN, T, NCOLS1, 1024, G, bid);
        EpiProj E{(bf16_t*)(ws + OFF_PROJ), (bf16_t*)p.out, (const float*)(ws + OFF_RSTD1)};
        gemm_phase<false>(lds, 1024, S, E);
        SEAM(1);
    }
    if (IN(2)) { phase_lprep_conv(p); SEAM(2); }
    if (IN(3)) {
        StaticOrder S; S.init(ws + OFF_L, ws + OFF_W2, NRP, 1536, 256, G, bid);
        EpiL E{(float*)(ws + OFF_LD), (bf16_t*)(ws + OFF_A), (bf16_t*)(ws + OFF_G), p.in[10], p.in[13]};
        gemm_phase<false>(lds, 256, S, E);
        SEAM(3);
    }
    if (IN(4)) { phase_scan(p, lds); SEAM(4); }
    if (IN(5)) {
        StaticOrder S; S.init(ws + OFF_Z, ws + OFF_WR, T, 1024, 512, G, bid);
        EpiMerge<0> E{(bf16_t*)(ws + OFF_MERGED), (const bf16_t*)p.out};
        gemm_phase<false>(lds, 512, S, E);
        SEAM(5);
    }
    if (IN(6)) {
        StaticOrder S; S.init(ws + OFF_C, ws + OFF_WC, T, 1024, 512, G, bid);
        EpiMerge<1> E{(bf16_t*)(ws + OFF_MERGED), (const bf16_t*)p.out};
        gemm_phase<false>(lds, 512, S, E);
        SEAM(6);
    }
    if (IN(7)) {
        StaticOrder S; S.init(ws + OFF_MERGED, ws + OFF_WO, T, 1024, 1024, G, bid);
        EpiO E{p.in[0], p.out, (bf16_t*)(ws + OFF_HB2)};
        gemm_phase<false>(lds, 1024, S, E);
        SEAM(7);
    }
    if (IN(8)) { phase_router(p, lds); SEAM(8); }
    if (IN(9)) { phase_lists(p, lds); SEAM(9); }
    if (IN(10)) {
        const int* TILEE = (const int*)(ws + OFF_TILEE);
        MoeOrder S; S.A = (const char*)(ws + OFF_HB2); S.Bt = (const char*)(ws + OFF_WGU); S.K = 1024; S.estride = (size_t)2048 * 1024 * 2;
        S.tile_e = TILEE; S.rowtok = (const int*)(ws + OFF_ROWTOK); S.ntiles = TILEE[1000]; S.nnt = 8; S.G = G; S.c = bid; S.gather = true;
        EpiMoe1 E{(bf16_t*)(ws + OFF_ACT), (const float*)(ws + OFF_ROWRS), p.in[31], p.in[33]};
        gemm_phase<true>(lds, 1024, S, E);
        SEAM(10);
    }
    if (IN(11)) {
        const int* TILEE = (const int*)(ws + OFF_TILEE);
        MoeOrder S; S.A = (const char*)(ws + OFF_ACT); S.Bt = (const char*)(ws + OFF_WD); S.K = 1024; S.estride = (size_t)1024 * 1024 * 2;
        S.tile_e = TILEE; S.rowtok = nullptr; S.ntiles = TILEE[1000]; S.nnt = 4; S.G = G; S.c = bid; S.gather = false;
        EpiMoe2 E{(bf16_t*)p.out, (bf16_t*)(ws + OFF_WGU), (const int*)(ws + OFF_ROWSLOT), (const float*)(ws + OFF_ROWW), p.in[35]};
        gemm_phase<false>(lds, 1024, S, E);
        SEAM(11);
    }
    if (IN(12)) { phase_final(p); }
}

extern "C" void kernel_launch(void* const* d_in, const int* in_sizes, int n_in, void* d_out, int out_size, void* d_ws, size_t ws_size,
                              hipStream_t stream) {
    constexpr size_t kDynLds = 160 * 1024;
    static int grid_blocks = 0;
    if (!grid_blocks) {
        int dev = 0, cus = 0, per_cu = 0;
        (void)hipGetDevice(&dev);
        (void)hipDeviceGetAttribute(&cus, hipDeviceAttributeMultiprocessorCount, dev);
        (void)hipFuncSetAttribute((const void*)mega, hipFuncAttributeMaxDynamicSharedMemorySize, (int)kDynLds);
        (void)hipOccupancyMaxActiveBlocksPerMultiprocessor(&per_cu, mega, 512, kDynLds);
        if (per_cu > 1) per_cu = 1;
        grid_blocks = cus * per_cu;
        fprintf(stderr, "cus=%d per_cu=%d ws_size=%zu need=%zu\n", cus, per_cu, ws_size, (size_t)WS_NEED);
    }
    if (ws_size < WS_NEED || n_in < 37 || grid_blocks < 64) { fprintf(stderr, "kernel_launch: unsupported configuration\n"); return; }
    Params p{};
    for (int i = 0; i < 37; ++i) p.in[i] = (const float*)d_in[i];
    p.out = (float*)d_out;
    p.ws = (unsigned char*)d_ws;
    p.ph_lo = 0; p.ph_hi = N_PHASES;
    void* args[] = {&p};
    hipError_t e = hipLaunchCooperativeKernel((void*)mega, dim3(grid_blocks), dim3(512), args, kDynLds, stream);
    if (e != hipSuccess) fprintf(stderr, "cooperative launch failed: %s (grid %d)\n", hipGetErrorString(e), grid_blocks);
}
```

```cpp
#include <hip/hip_runtime.h>
#include <hip/hip_cooperative_groups.h>
#include <cstdio>
namespace cg = cooperative_groups;

#define LAS __attribute__((address_space(3)))
typedef unsigned short bf16_t;
typedef short bf16x8 __attribute__((ext_vector_type(8)));
typedef float f32x4 __attribute__((ext_vector_type(4)));
typedef float f32x2 __attribute__((ext_vector_type(2)));
typedef unsigned u32x4 __attribute__((ext_vector_type(4)));
typedef unsigned u32x2 __attribute__((ext_vector_type(2)));

constexpr int D = 1024, NBATCH = 8, SEQ = 4096, NMETA = 16;
constexpr int T = NBATCH * SEQ;
constexpr int NR = T + NMETA;
constexpr int NRP = 33024;
constexpr int PCOLS1 = 3584;
constexpr int NCOLS1 = 5632;
constexpr int NE = 32, TOPK = 4, DFF = 1024;
constexpr int MAXROWS = T * TOPK + NE * 256;
constexpr int MAXTILES = MAXROWS / 256;
constexpr float NORM_EPS = 1e-5f, LNX_EPS = 64e-5f;

constexpr int NCHUNK = 257, NUNITS = 64 * NCHUNK;
constexpr int REC_BYTES = 13568;
constexpr int RO_WH = 0, RO_RT = 2048, RO_U0T = 4096, RO_VT = 6144, RO_BKT = 8192, RO_ARK = 12288, RO_WCC = 13312;
constexpr int SLOT_BYTES = 15680, SO_G = 13568, SO_COEF = 15616, NSLOT = 9;
constexpr size_t SZ_ACT = (size_t)MAXROWS * 1024 * 2;
constexpr size_t SZ_WGU = (size_t)NE * 2048 * 1024 * 2;
constexpr size_t SZ_WD = (size_t)NE * 1024 * 1024 * 2;
constexpr size_t SZ_HB = (size_t)T * 1024 * 2;
constexpr size_t OFF_WGU = 0;
constexpr size_t OFF_WD = OFF_WGU + SZ_WGU;
constexpr size_t OFF_ACT = OFF_WD + SZ_WD;
constexpr size_t OFF_HB2 = OFF_ACT + SZ_ACT;
constexpr size_t OFF_RT = OFF_HB2 + SZ_HB;
constexpr size_t OFF_TOPI = OFF_RT;
constexpr size_t OFF_TOPW = OFF_TOPI + (size_t)T * 16;
constexpr size_t OFF_RANK = OFF_TOPW + (size_t)T * 16;
constexpr size_t OFF_RSTD2 = OFF_RANK + (size_t)T * 16;
constexpr size_t OFF_ROWTOK = OFF_RSTD2 + (size_t)T * 4;
constexpr size_t OFF_ROWSLOT = OFF_ROWTOK + (size_t)MAXROWS * 4;
constexpr size_t OFF_ROWW = OFF_ROWSLOT + (size_t)MAXROWS * 4;
constexpr size_t OFF_ROWRS = OFF_ROWW + (size_t)MAXROWS * 4;
constexpr size_t OFF_TILEE = OFF_ROWRS + (size_t)MAXROWS * 4;
constexpr size_t OFF_GCNT = OFF_TILEE + 4096;
constexpr size_t OFF_SM = OFF_GCNT + 256;
constexpr size_t OFF_WR = OFF_SM;
constexpr size_t OFF_WC = OFF_WR + (size_t)1024 * 512 * 2;
constexpr size_t OFF_WO = OFF_WC + (size_t)1024 * 512 * 2;
constexpr size_t OFF_W2 = OFF_WO + (size_t)1024 * 1024 * 2;
constexpr size_t OFF_RSTD1 = OFF_W2 + (size_t)1536 * 256 * 2;
constexpr size_t OFF_WRG = OFF_RSTD1 + (size_t)NRP * 4;
constexpr size_t WS_NEED = OFF_WRG + (size_t)1024 * 32 * 4;
constexpr size_t OFF_PRKV = 0;
constexpr size_t SZ_PRKV = (size_t)NR * 1536 * 2;
constexpr size_t OFF_LD = OFF_PRKV + SZ_PRKV;
constexpr size_t OFF_A = OFF_LD + (size_t)NRP * 512 * 4;
constexpr size_t OFF_CH = OFF_A + (size_t)NRP * 512 * 2;
constexpr size_t OFF_PCONV = OFF_CH;
constexpr size_t SZ_PCONV = (size_t)NR * 2048 * 2;
constexpr size_t OFF_HB = OFF_PCONV + SZ_PCONV;
constexpr size_t OFF_L = OFF_HB + SZ_HB;
constexpr size_t OFF_WIN = OFF_L + (size_t)NRP * 256 * 2;
constexpr size_t CH_END = OFF_WIN + (size_t)NCOLS1 * 1024 * 2;
constexpr size_t OFF_MERGED = OFF_CH;
constexpr size_t OFF_G = CH_END;
constexpr size_t OFF_C = OFF_G + (size_t)NRP * 512 * 2;
constexpr size_t OFF_Z = OFF_C + (size_t)T * 512 * 2;
constexpr size_t OFF_COEF = OFF_Z + (size_t)T * 512 * 2;
constexpr size_t EARLY_END = OFF_COEF + (size_t)NR * 8 * 4;
static_assert(EARLY_END <= OFF_RT, "early buffers overflow");
static_assert(OFF_CH + (size_t)NUNITS * REC_BYTES <= CH_END, "chunk records overflow");
static_assert(OFF_CH >= OFF_WD + SZ_WD, "expert weights (written during the scan) must not touch live scan buffers");
static_assert(OFF_MERGED + SZ_HB <= OFF_HB2, "layout");
static_assert(OFF_PRKV % 16 == 0 && OFF_LD % 16 == 0 && OFF_A % 16 == 0 && OFF_CH % 16 == 0 && OFF_HB % 16 == 0 && OFF_L % 16 == 0 && OFF_WIN % 16 == 0 && OFF_G % 16 == 0 && OFF_C % 16 == 0 && OFF_Z % 16 == 0 && OFF_COEF % 16 == 0, "align");

struct Params {
    const float* in[37];
    float* out;
    unsigned char* ws;
    int ph_lo, ph_hi;
};

typedef __bf16 bf16x2v __attribute__((ext_vector_type(2)));
__device__ __forceinline__ unsigned cvt_pk_bf16(float lo, float hi) { const f32x2 v = {lo, hi}; return __builtin_bit_cast(unsigned, __builtin_convertvector(v, bf16x2v)); }
__device__ __forceinline__ bf16_t f2bf(float f) { unsigned u = __float_as_uint(f); u += 0x7FFFu + ((u >> 16) & 1u); return (bf16_t)(u >> 16); }
__device__ __forceinline__ float bf2f(bf16_t b) { return __uint_as_float(((unsigned)b) << 16); }
__device__ __forceinline__ float bflo(unsigned w) { return __uint_as_float(w << 16); }
__device__ __forceinline__ float bfhi(unsigned w) { return __uint_as_float(w & 0xFFFF0000u); }
__device__ __forceinline__ float sigmoidf_(float x) { return 1.0f / (1.0f + __expf(-x)); }
__device__ __forceinline__ float wave_sum(float v) {
#pragma unroll
    for (int o = 32; o >= 1; o >>= 1) v += __shfl_xor(v, o);
    return v;
}
__device__ __forceinline__ int prev_row(int row, int d) {
    if (row < NMETA) return row - d >= 0 ? row - d : -1;
    const int s = (row - NMETA) & (SEQ - 1);
    return s >= d ? row - d : NMETA + s - d;
}

constexpr int BM = 256, BK = 64, HALF = 128, HTB = HALF * BK * 2, STAGE_BYTES = 8 * HTB, NXCD = 8, WGM = 8;
__device__ __forceinline__ int lds_byte(int r, int c) { const int st = (r >> 4) * 2 + (c >> 5), rr = r & 15, cc = c & 31, ob = rr * 64 + cc * 2; return st * 1024 + (ob ^ (((ob >> 9) & 1) << 5)); }
__device__ __forceinline__ void stage_rc(int b, int& R, int& C) { const int st = b / 1024, sb = b % 1024, swz = sb ^ (((sb >> 9) & 1) << 5); R = (st >> 1) * 16 + swz / 64; C = (st & 1) * 32 + (swz % 64) / 2; }
__device__ __forceinline__ int perm32(int rho) { const int n = rho >> 4, i = rho & 15; return 8 * (i >> 2) + 4 * n + (i & 3); }

struct Unit { int pm, pn, aux; };

struct StaticOrder {
    const char* A; const char* Bt; int K;
    int nM, nN, nwg, G, c;
    __device__ void init(const void* A_, const void* Bt_, int M, int N, int K_, int G_, int c_) { A = (const char*)A_; Bt = (const char*)Bt_; K = K_; nM = M / BM; nN = N / BM; nwg = nM * nN; G = G_; c = c_; }
    __device__ bool next(int i, Unit& u) const {
        const long L = (long)i * G + c; if (L >= nwg) return false;
        int wgid = (int)L; { const int q = nwg / NXCD, r = nwg % NXCD, xcd = wgid % NXCD, off = wgid / NXCD; wgid = (xcd < r ? xcd * (q + 1) : r * (q + 1) + (xcd - r) * q) + off; }
        const int nig = WGM * nN, gid = wgid / nig, fm = gid * WGM, gsz = (nM - fm) < WGM ? (nM - fm) : WGM;
        u.pm = fm + ((wgid % nig) % gsz); u.pn = (wgid % nig) / gsz; u.aux = 0; return true;
    }
    __device__ __forceinline__ const char* a_ptr(const Unit& u) const { return A + (size_t)u.pm * 256 * K * 2; }
    __device__ __forceinline__ const char* b_ptr(const Unit& u) const { return Bt + (size_t)u.pn * 256 * K * 2; }
    __device__ __forceinline__ int gather_row(const Unit&, int) const { return 0; }
};
struct MoeOrder {
    const char* A; const char* Bt; int K; size_t estride;
    const int* tile_e; const int* rowtok; int ntiles, nnt, G, c; bool gather;
    __device__ bool next(int i, Unit& u) const {
        const long L = (long)i * G + c; const int mt = (int)(L / nnt); if (mt >= ntiles) return false;
        u.pm = mt; u.pn = (int)(L % nnt); u.aux = tile_e[mt]; return true;
    }
    __device__ __forceinline__ const char* a_ptr(const Unit& u) const { return gather ? A : A + (size_t)u.pm * 256 * K * 2; }
    __device__ __forceinline__ const char* b_ptr(const Unit& u) const { return Bt + (size_t)u.aux * estride + (size_t)u.pn * 256 * K * 2; }
    __device__ __forceinline__ int gather_row(const Unit& u, int r) const { return rowtok[u.pm * 256 + r]; }
};

template <bool GATHER, class Epi, class Sched>
__device__ __forceinline__ void gemm_phase(LAS unsigned char* lds, const int K_, const Sched& S, const Epi& E) {
    int K = K_; asm volatile("" : "+s"(K));
    const int tid = threadIdx.x, wid = __builtin_amdgcn_readfirstlane(tid >> 6), lane = tid & 63, wr = wid >> 2, wc = wid & 3, fr = lane & 15, fq = lane >> 4;
    const int nt = K / BK;
    unsigned voffA[2], voffB[2]; int Rr[2], Cc[2];
#pragma unroll
    for (int i = 0; i < 2; ++i) { int R, C; stage_rc(tid * 16 + i * 8192, R, C); const int Rb = (R & ~31) + perm32(R & 31);
        Rr[i] = R; Cc[i] = C; voffA[i] = (unsigned)(R * K + C) * 2u; voffB[i] = (unsigned)(Rb * K + C) * 2u; }
    const size_t kstep = (size_t)(BK * 2);
    const size_t hstep = (size_t)HALF * K * 2;
    const unsigned ldsw = (unsigned)wid * 1024u;
    const int aoff = lds_byte(wr * 64 + fr, fq * 8), boff = lds_byte(wc * 32 + fr, fq * 8);
    unsigned vgc[2][2], vgn[2][2];
#define G_SA(b, h) (((b) * 2 + (h)) * HTB)
#define G_SB(b, h) ((4 + (b) * 2 + (h)) * HTB)
#define G_STAGE(bufoff, gbase, voff) do { _Pragma("unroll") for (int _i = 0; _i < 2; ++_i) \
        __builtin_amdgcn_global_load_lds((const unsigned*)((const char*)(gbase) + (voff)[_i]), (LAS unsigned*)(lds + (bufoff) + ldsw + _i * 8192), 16, 0, 0); } while (0)
#define G_STAGE_A(bufoff, kptr, h, VG) do { if (GATHER) { G_STAGE(bufoff, kptr, VG[h]); } else { G_STAGE(bufoff, (kptr) + (h) * hstep, voffA); } } while (0)
#define G_LDA(dst, b, h) do { _Pragma("unroll") for (int m = 0; m < 4; ++m) _Pragma("unroll") for (int k = 0; k < 2; ++k) dst[m][k] = *(const LAS bf16x8*)(lds + G_SA(b, h) + aoff + m * 2048 + k * 1024); } while (0)
#define G_LDB(dst, b, h) do { _Pragma("unroll") for (int n = 0; n < 2; ++n) _Pragma("unroll") for (int k = 0; k < 2; ++k) dst[n][k] = *(const LAS bf16x8*)(lds + G_SB(b, h) + boff + n * 2048 + k * 1024); } while (0)
#define G_MMA(ai, bj, At, Bt) do { __builtin_amdgcn_s_setprio(1); _Pragma("unroll") for (int m = 0; m < 4; ++m) _Pragma("unroll") for (int n = 0; n < 2; ++n) _Pragma("unroll") for (int k = 0; k < 2; ++k) \
        acc[ai][bj][m][n] = __builtin_amdgcn_mfma_f32_16x16x32_bf16(Bt[n][k], At[m][k], acc[ai][bj][m][n], 0, 0, 0); __builtin_amdgcn_s_setprio(0); } while (0)
#define G_WAIT_V(n) asm volatile("s_waitcnt vmcnt(" #n ")" ::: "memory")
#define G_WAIT_L(n) asm volatile("s_waitcnt lgkmcnt(" #n ")" ::: "memory")
#define G_BAR __builtin_amdgcn_s_barrier()
#define G_SCHED __builtin_amdgcn_sched_barrier(0)
    Unit cur, nxt;
    int ui = 0;
    if (!S.next(0, cur)) return;
    f32x4 acc[2][2][4][2];
#pragma unroll
    for (int a = 0; a < 2; ++a)
#pragma unroll
        for (int b = 0; b < 2; ++b)
#pragma unroll
            for (int m = 0; m < 4; ++m)
#pragma unroll
                for (int n = 0; n < 2; ++n) acc[a][b][m][n] = (f32x4){0.f, 0.f, 0.f, 0.f};
    bf16x8 At[4][2], B0[2][2], B1[2][2];
    const char* cA = S.a_ptr(cur); const char* cB = S.b_ptr(cur);
    if (GATHER) {
#pragma unroll
        for (int h = 0; h < 2; ++h)
#pragma unroll
            for (int i = 0; i < 2; ++i) vgc[h][i] = (unsigned)(S.gather_row(cur, h * HALF + Rr[i]) * K + Cc[i]) * 2u;
    }
    G_STAGE(G_SB(0, 0), cB, voffB); G_STAGE_A(G_SA(0, 0), cA, 0, vgc); G_STAGE(G_SB(0, 1), cB + hstep, voffB); G_STAGE_A(G_SA(0, 1), cA, 1, vgc);
    if (wr == 1) G_BAR;
    G_WAIT_V(4); G_BAR;
    G_STAGE(G_SB(1, 0), cB + kstep, voffB); G_STAGE_A(G_SA(1, 0), cA + kstep, 0, vgc); G_STAGE(G_SB(1, 1), cB + hstep + kstep, voffB);
    G_WAIT_V(6); G_BAR;
    for (;;) {
        const bool has_next = S.next(ui + 1, nxt);
        const char* nA = has_next ? S.a_ptr(nxt) : cA; const char* nB = has_next ? S.b_ptr(nxt) : cB;
        if (GATHER) {
#pragma unroll
            for (int h = 0; h < 2; ++h)
#pragma unroll
                for (int i = 0; i < 2; ++i) vgn[h][i] = has_next ? (unsigned)(S.gather_row(nxt, h * HALF + Rr[i]) * K + Cc[i]) * 2u : vgc[h][i];
        }
        for (int t = 0; t < nt; t += 2) {
            const bool last = (t == nt - 2);
            const char* a1 = cA + (size_t)(t + 1) * kstep;
            const char* a2 = last ? nA : cA + (size_t)(t + 2) * kstep; const char* b2 = last ? nB : cB + (size_t)(t + 2) * kstep;
            const char* a3 = a2 + kstep; const char* b3 = b2 + kstep;
            unsigned vg2[2][2];
            if (GATHER) {
#pragma unroll
                for (int h = 0; h < 2; ++h)
#pragma unroll
                    for (int i = 0; i < 2; ++i) vg2[h][i] = last ? vgn[h][i] : vgc[h][i];
            }
            G_LDB(B0, 0, 0); G_SCHED; G_LDA(At, 0, 0); G_STAGE_A(G_SA(1, 1), a1, 1, vgc);
            G_WAIT_L(8); G_BAR; G_WAIT_L(0); G_MMA(0, 0, At, B0); G_BAR; G_SCHED;
            G_LDB(B1, 0, 1); G_STAGE(G_SB(0, 0), b2, voffB);
            G_BAR; G_WAIT_L(0); G_MMA(0, 1, At, B1); G_BAR;
            G_LDA(At, 0, 1); G_STAGE_A(G_SA(0, 0), a2, 0, vg2);
            G_BAR; G_WAIT_L(0); G_MMA(1, 0, At, B0); G_BAR; G_SCHED;
            G_STAGE(G_SB(0, 1), b2 + hstep, voffB);
            G_WAIT_V(6); G_BAR; G_MMA(1, 1, At, B1); G_BAR;
            G_LDB(B0, 1, 0); G_SCHED; G_LDA(At, 1, 0); G_STAGE_A(G_SA(0, 1), a2, 1, vg2);
            G_WAIT_L(8); G_BAR; G_WAIT_L(0); G_MMA(0, 0, At, B0); G_BAR; G_SCHED;
            G_LDB(B1, 1, 1); G_STAGE(G_SB(1, 0), b3, voffB);
            G_BAR; G_WAIT_L(0); G_MMA(0, 1, At, B1); G_BAR;
            G_LDA(At, 1, 1); G_STAGE_A(G_SA(1, 0), a3, 0, vg2);
            G_BAR; G_WAIT_L(0); G_MMA(1, 0, At, B0); G_BAR; G_SCHED;
            G_STAGE(G_SB(1, 1), b3 + hstep, voffB);
            G_WAIT_V(6); G_BAR; G_MMA(1, 1, At, B1); G_BAR;
        }
        E(acc, cur, wr, wc, fr, fq);
        if (!has_next) break;
#pragma unroll
        for (int a = 0; a < 2; ++a)
#pragma unroll
            for (int b = 0; b < 2; ++b)
#pragma unroll
                for (int m = 0; m < 4; ++m)
#pragma unroll
                    for (int n = 0; n < 2; ++n) acc[a][b][m][n] = (f32x4){0.f, 0.f, 0.f, 0.f};
        cur = nxt; cA = nA; cB = nB; ++ui;
        if (GATHER) {
#pragma unroll
            for (int h = 0; h < 2; ++h)
#pragma unroll
                for (int i = 0; i < 2; ++i) vgc[h][i] = vgn[h][i];
        }
    }
    G_WAIT_V(0);
    if (wr == 0) G_BAR;
    G_BAR;
#undef G_SA
#undef G_SB
#undef G_STAGE
#undef G_STAGE_A
#undef G_LDA
#undef G_LDB
#undef G_MMA
#undef G_WAIT_V
#undef G_WAIT_L
#undef G_BAR
#undef G_SCHED
}

struct EpiProj {
    bf16_t* prkv; bf16_t* pconv; bf16_t* gates; const float* rstd1;
    __device__ __forceinline__ void operator()(const f32x4 (&acc)[2][2][4][2], const Unit& u, int wr, int wc, int fr, int fq) const {
        const int row0 = u.pm * BM + wr * 64 + fr;
        const bool isg = u.pn >= 14;
#pragma unroll
        for (int ai = 0; ai < 2; ++ai)
#pragma unroll
            for (int m = 0; m < 4; ++m) {
                const int row = row0 + ai * HALF + m * 16;
                const float rs = rstd1[NMETA + row];
                bf16_t* rowp = isg ? gates + (size_t)row * 2048 + (u.pn - 14) * 256 + wc * 32 + 8 * fq
                             : (u.pn < 6 ? prkv + (size_t)(NMETA + row) * 1536 + u.pn * 256 : pconv + (size_t)(NMETA + row) * 2048 + (u.pn - 6) * 256) + wc * 32 + 8 * fq;
#pragma unroll
                for (int bj = 0; bj < 2; ++bj) {
                    f32x4 v0 = acc[ai][bj][m][0] * rs, v1 = acc[ai][bj][m][1] * rs;
                    if (isg) {
#pragma unroll
                        for (int j = 0; j < 4; ++j) { v0[j] = sigmoidf_(v0[j]); v1[j] = sigmoidf_(v1[j]); }
                    }
                    u32x4 w; w.x = cvt_pk_bf16(v0[0], v0[1]); w.y = cvt_pk_bf16(v0[2], v0[3]); w.z = cvt_pk_bf16(v1[0], v1[1]); w.w = cvt_pk_bf16(v1[2], v1[3]);
                    *(u32x4*)(rowp + bj * HALF) = w;
                }
            }
    }
};
struct EpiL {
    float* LD; bf16_t* Ab; bf16_t* Gb; const float* w0; const float* a0;
    __device__ __forceinline__ void operator()(const f32x4 (&acc)[2][2][4][2], const Unit& u, int wr, int wc, int fr, int fq) const {
        const int row0 = u.pm * BM + wr * 64 + fr;
        const int seg = u.pn >> 1;
        const int cb = (u.pn & 1) * 256 + wc * 32 + 8 * fq;
        const float* bias = seg == 0 ? w0 : a0;
        f32x4 bv[2][2];
#pragma unroll
        for (int bj = 0; bj < 2; ++bj) {
            bv[bj][0] = seg < 2 ? *(const f32x4*)(bias + cb + bj * HALF) : (f32x4){0.f, 0.f, 0.f, 0.f};
            bv[bj][1] = seg < 2 ? *(const f32x4*)(bias + cb + bj * HALF + 4) : (f32x4){0.f, 0.f, 0.f, 0.f};
        }
        const float sc = seg == 0 ? -0.60653065971f : 1.0f;
        bf16_t* ob = seg == 1 ? Ab : Gb;
#pragma unroll
        for (int ai = 0; ai < 2; ++ai)
#pragma unroll
            for (int m = 0; m < 4; ++m) {
                const int row = row0 + ai * HALF + m * 16;
#pragma unroll
                for (int bj = 0; bj < 2; ++bj) {
                    const int c = cb + bj * HALF;
                    f32x4 v0 = acc[ai][bj][m][0] + bv[bj][0], v1 = acc[ai][bj][m][1] + bv[bj][1];
                    if (seg < 2) {
#pragma unroll
                        for (int j = 0; j < 4; ++j) { v0[j] = sc * sigmoidf_(v0[j]); v1[j] = sc * sigmoidf_(v1[j]); }
                    }
                    if (seg == 0) {
                        float* p = LD + (size_t)row * 512 + c;
                        *(f32x4*)p = v0; *(f32x4*)(p + 4) = v1;
                    } else {
                        u32x4 w; w.x = cvt_pk_bf16(v0[0], v0[1]); w.y = cvt_pk_bf16(v0[2], v0[3]); w.z = cvt_pk_bf16(v1[0], v1[1]); w.w = cvt_pk_bf16(v1[2], v1[3]);
                        *(u32x4*)(ob + (size_t)row * 512 + c) = w;
                    }
                }
            }
    }
};
template <int SECOND> struct EpiMerge {
    bf16_t* merged; const bf16_t* gates;
    __device__ __forceinline__ void operator()(const f32x4 (&acc)[2][2][4][2], const Unit& u, int wr, int wc, int fr, int fq) const {
        const int row0 = u.pm * BM + wr * 64 + fr, col0 = u.pn * BM + wc * 32 + 8 * fq;
#pragma unroll
        for (int ai = 0; ai < 2; ++ai)
#pragma unroll
            for (int m = 0; m < 4; ++m) {
                const int row = row0 + ai * HALF + m * 16;
#pragma unroll
                for (int bj = 0; bj < 2; ++bj) {
                    const int c = col0 + bj * HALF;
                    const u32x4 gw = *(const u32x4*)(gates + (size_t)row * 2048 + SECOND * 1024 + c);
                    f32x4 g0 = (f32x4){bflo(gw.x), bfhi(gw.x), bflo(gw.y), bfhi(gw.y)}, g1 = (f32x4){bflo(gw.z), bfhi(gw.z), bflo(gw.w), bfhi(gw.w)};
                    f32x4 v0 = acc[ai][bj][m][0] * g0, v1 = acc[ai][bj][m][1] * g1;
                    bf16_t* p = merged + (size_t)row * 1024 + c;
                    if (SECOND) {
                        const u32x4 ow = *(const u32x4*)p;
                        v0 += (f32x4){bflo(ow.x), bfhi(ow.x), bflo(ow.y), bfhi(ow.y)}; v1 += (f32x4){bflo(ow.z), bfhi(ow.z), bflo(ow.w), bfhi(ow.w)};
                    }
                    u32x4 w; w.x = cvt_pk_bf16(v0[0], v0[1]); w.y = cvt_pk_bf16(v0[2], v0[3]); w.z = cvt_pk_bf16(v1[0], v1[1]); w.w = cvt_pk_bf16(v1[2], v1[3]);
                    *(u32x4*)p = w;
                }
            }
    }
};
struct EpiO {
    const float* x; float* h1; bf16_t* hb2;
    __device__ __forceinline__ void operator()(const f32x4 (&acc)[2][2][4][2], const Unit& u, int wr, int wc, int fr, int fq) const {
        const int row0 = u.pm * BM + wr * 64 + fr, col0 = u.pn * BM + wc * 32 + 8 * fq;
#pragma unroll
        for (int ai = 0; ai < 2; ++ai)
#pragma unroll
            for (int m = 0; m < 4; ++m) {
                const int row = row0 + ai * HALF + m * 16;
#pragma unroll
                for (int bj = 0; bj < 2; ++bj) {
                    const size_t o = (size_t)row * 1024 + col0 + bj * HALF;
                    const f32x4 v0 = acc[ai][bj][m][0] + *(const f32x4*)(x + o), v1 = acc[ai][bj][m][1] + *(const f32x4*)(x + o + 4);
                    *(f32x4*)(h1 + o) = v0; *(f32x4*)(h1 + o + 4) = v1;
                    u32x4 w; w.x = cvt_pk_bf16(v0[0], v0[1]); w.y = cvt_pk_bf16(v0[2], v0[3]); w.z = cvt_pk_bf16(v1[0], v1[1]); w.w = cvt_pk_bf16(v1[2], v1[3]);
                    *(u32x4*)(hb2 + o) = w;
                }
            }
    }
};
struct EpiMoe1 {
    bf16_t* act; const float* rowrs; const float* bg; const float* bu;
    __device__ __forceinline__ void operator()(const f32x4 (&acc)[2][2][4][2], const Unit& u, int wr, int wc, int fr, int fq) const {
        const int row0 = u.pm * BM + wr * 64 + fr, ff0 = u.pn * 128 + wc * 32 + 8 * fq;
        const float* bgp = bg + (size_t)u.aux * DFF + ff0; const float* bup = bu + (size_t)u.aux * DFF + ff0;
        const f32x4 bg0 = *(const f32x4*)bgp, bg1 = *(const f32x4*)(bgp + 4), bu0 = *(const f32x4*)bup, bu1 = *(const f32x4*)(bup + 4);
#pragma unroll
        for (int ai = 0; ai < 2; ++ai)
#pragma unroll
            for (int m = 0; m < 4; ++m) {
                const int row = row0 + ai * HALF + m * 16;
                const float rs = rowrs[row];
                f32x4 g0 = acc[ai][0][m][0] * rs + bg0, g1 = acc[ai][0][m][1] * rs + bg1, u0 = acc[ai][1][m][0] * rs + bu0, u1 = acc[ai][1][m][1] * rs + bu1;
                f32x4 r0, r1;
#pragma unroll
                for (int j = 0; j < 4; ++j) {
                    { const float gt = fminf(g0[j], 7.0f), up = fminf(fmaxf(u0[j], -7.0f), 7.0f); r0[j] = (up + 1.0f) * gt * sigmoidf_(1.702f * gt); }
                    { const float gt = fminf(g1[j], 7.0f), up = fminf(fmaxf(u1[j], -7.0f), 7.0f); r1[j] = (up + 1.0f) * gt * sigmoidf_(1.702f * gt); }
                }
                u32x4 w; w.x = cvt_pk_bf16(r0[0], r0[1]); w.y = cvt_pk_bf16(r0[2], r0[3]); w.z = cvt_pk_bf16(r1[0], r1[1]); w.w = cvt_pk_bf16(r1[2], r1[3]);
                *(u32x4*)(act + (size_t)row * DFF + ff0) = w;
            }
    }
};
struct EpiMoe2 {
    bf16_t* ya; bf16_t* yb; const int* rowslot; const float* roww; const float* bd;
    __device__ __forceinline__ void operator()(const f32x4 (&acc)[2][2][4][2], const Unit& u, int wr, int wc, int fr, int fq) const {
        const int row0 = u.pm * BM + wr * 64 + fr, col0 = u.pn * BM + wc * 32 + 8 * fq;
        bf16_t* ybase = (u.pn < 2) ? ya : yb; const int yc0 = col0 & 511;
        const float* bp = bd + (size_t)u.aux * D + col0;
        f32x4 bv[2][2];
#pragma unroll
        for (int bj = 0; bj < 2; ++bj) { bv[bj][0] = *(const f32x4*)(bp + bj * HALF); bv[bj][1] = *(const f32x4*)(bp + bj * HALF + 4); }
#pragma unroll
        for (int ai = 0; ai < 2; ++ai)
#pragma unroll
            for (int m = 0; m < 4; ++m) {
                const int row = row0 + ai * HALF + m * 16;
                const int slot = rowslot[row];
                if (slot >= 0) {
                    const float w8 = roww[row];
#pragma unroll
                    for (int bj = 0; bj < 2; ++bj) {
                        const f32x4 v0 = (acc[ai][bj][m][0] + bv[bj][0]) * w8, v1 = (acc[ai][bj][m][1] + bv[bj][1]) * w8;
                        u32x4 w; w.x = cvt_pk_bf16(v0[0], v0[1]); w.y = cvt_pk_bf16(v0[2], v0[3]); w.z = cvt_pk_bf16(v1[0], v1[1]); w.w = cvt_pk_bf16(v1[2], v1[3]);
                        *(u32x4*)(ybase + (size_t)slot * 512 + yc0 + bj * HALF) = w;
                    }
                }
            }
    }
};

__device__ __forceinline__ void transpose_tile(LAS float* tile, const float* src, int ldsrc, int k0, int n0, bf16_t* dst, int ldd, int drow0, const float* sa, const float* mu, int mode, bool zero) {
    const int tid = threadIdx.x;
    if (!zero) {
#pragma unroll
        for (int i = 0; i < 2; ++i) {
            const int r = (tid >> 4) + 32 * i, c4 = (tid & 15) * 4;
            const f32x4 v = *(const f32x4*)(src + (size_t)(k0 + r) * ldsrc + n0 + c4);
            LAS float* t = tile + r * 65 + c4;
            t[0] = v[0]; t[1] = v[1]; t[2] = v[2]; t[3] = v[3];
        }
    }
    __syncthreads();
    {
        const int n = tid >> 3, kq = tid & 7;
        float v[8];
#pragma unroll
        for (int j = 0; j < 8; ++j) {
            const int k = k0 + 8 * kq + j;
            float s = sa ? sa[k] : 1.0f;
            if (mode == 1) s *= (1.0f - mu[k]);
            if (mode == 2) s *= mu[k];
            v[j] = zero ? 0.f : tile[(8 * kq + j) * 65 + n] * s;
        }
        u32x4 w; w.x = cvt_pk_bf16(v[0], v[1]); w.y = cvt_pk_bf16(v[2], v[3]); w.z = cvt_pk_bf16(v[4], v[5]); w.w = cvt_pk_bf16(v[6], v[7]);
        *(u32x4*)(dst + (size_t)(drow0 + n) * ldd + k0 + 8 * kq) = w;
    }
    __syncthreads();
}

__device__ void phase_prep(const Params& p, LAS unsigned char* lds) {
    const int tid = threadIdx.x, bid = blockIdx.x, nb = gridDim.x, lane = tid & 63, wave = tid >> 6;
    unsigned char* ws = p.ws;
    const float* x = p.in[0]; const float* meta = p.in[1]; const float* g1 = p.in[2];
    if (bid == 0 && tid < 64) ((int*)(ws + OFF_GCNT))[tid] = 0;
    {
        bf16_t* HB = (bf16_t*)(ws + OFF_HB); float* rstd1 = (float*)(ws + OFF_RSTD1);
        for (int row = bid * 8 + wave; row < NR; row += nb * 8) {
            const float* src = row < NMETA ? meta + (size_t)row * D : x + (size_t)(row - NMETA) * D;
            float ss = 0.f; f32x4 v[4];
#pragma unroll
            for (int i = 0; i < 4; ++i) { v[i] = *(const f32x4*)(src + i * 256 + lane * 4); ss += v[i][0] * v[i][0] + v[i][1] * v[i][1] + v[i][2] * v[i][2] + v[i][3] * v[i][3]; }
            ss = wave_sum(ss);
            if (lane == 0) rstd1[row] = rsqrtf(ss * (1.0f / D) + NORM_EPS);
            if (row >= NMETA) {
                bf16_t* d = HB + (size_t)(row - NMETA) * D;
#pragma unroll
                for (int i = 0; i < 4; ++i) { u32x2 w; w.x = cvt_pk_bf16(v[i][0], v[i][1]); w.y = cvt_pk_bf16(v[i][2], v[i][3]); *(u32x2*)(d + i * 256 + lane * 4) = w; }
            }
        }
    }
    LAS float* tile = (LAS float*)lds;
    {
        bf16_t* WIN = (bf16_t*)(ws + OFF_WIN);
        const float* w_in = p.in[3];
        for (int j = bid; j < 16 * 88; j += nb) {
            const int kt = j & 15, ntile = j >> 4, n0 = ntile * 64;
            const float* src; int ld, sn0, mode = 0; const float* mu = nullptr;
            if (n0 < 3072) { src = w_in; ld = 5120; sn0 = n0; }
            else if (n0 < 3584) {
                const int seg = (n0 - 3072) >> 6;
                if (seg < 2) { src = p.in[11]; ld = 64; sn0 = 0; mu = p.in[7]; mode = 1 + seg; }
                else if (seg < 4) { src = p.in[14]; ld = 64; sn0 = 0; mu = p.in[8]; mode = 1 + (seg - 2); }
                else { src = p.in[16]; ld = 128; sn0 = (seg & 1) * 64; mu = p.in[9]; mode = seg < 6 ? 1 : 2; }
            } else { src = w_in; ld = 5120; sn0 = n0 - 512; }
            transpose_tile(tile, src, ld, kt * 64, sn0, WIN, 1024, n0, g1, mu, mode, false);
        }
        for (int j = bid; j < 2 * 128; j += nb) {
            const int which = j >> 7, jj = j & 127, kt = jj & 7, ntile = jj >> 3;
            transpose_tile(tile, which ? p.in[25] : p.in[23], 1024, kt * 64, ntile * 64, (bf16_t*)(ws + (which ? OFF_WC : OFF_WR)), 512, ntile * 64, nullptr, nullptr, 0, false);
        }
        for (int j = bid; j < 256; j += nb) {
            const int kt = j & 15, ntile = j >> 4;
            transpose_tile(tile, p.in[26], 1024, kt * 64, ntile * 64, (bf16_t*)(ws + OFF_WO), 1024, ntile * 64, nullptr, nullptr, 0, false);
        }
        for (int j = bid; j < 96; j += nb) {
            const int kt = j & 3, ntile = j >> 2, seg = ntile >> 3, nn0 = (ntile & 7) * 64;
            const float* src = nullptr; int sk0 = 0; bool zero = true;
            if (seg == 0 && kt == 0) { src = p.in[12]; sk0 = 0; zero = false; }
            if (seg == 1 && kt == 1) { src = p.in[15]; sk0 = 0; zero = false; }
            if (seg == 2 && kt >= 2) { src = p.in[17]; sk0 = (kt - 2) * 64; zero = false; }
            const float* srcs = zero ? p.in[12] : src + (size_t)(sk0 - kt * 64) * 512;
            transpose_tile(tile, srcs, 512, kt * 64, nn0, (bf16_t*)(ws + OFF_W2), 256, ntile * 64, nullptr, nullptr, 0, zero);
        }
        {
            float* WRG = (float*)(ws + OFF_WRG); const float* g2 = p.in[27]; const float* wr_ = p.in[28];
            for (int i = bid * 512 + tid; i < 1024 * 32; i += nb * 512) WRG[i] = g2[i >> 5] * wr_[i];
        }
    }
}

__device__ void phase_meta_proj(const Params& p, LAS unsigned char* lds) {
    const int tid = threadIdx.x, bid = blockIdx.x;
    unsigned char* ws = p.ws;
    LAS float* sm = (LAS float*)lds;
    const float* meta = p.in[1];
    for (int i = tid; i < 16 * 256; i += 512) { const int r = i >> 8, c4 = (i & 255) * 4; const f32x4 v = *(const f32x4*)(meta + r * 1024 + c4); LAS float* d = sm + r * 1028 + c4; d[0] = v[0]; d[1] = v[1]; d[2] = v[2]; d[3] = v[3]; }
    __syncthreads();
    for (int nbase = bid * 14; nbase < PCOLS1; nbase += gridDim.x * 14) if (tid < 224) {
        const int n = nbase + (tid >> 4), pr = tid & 15;
        const bf16_t* wrow = (const bf16_t*)(ws + OFF_WIN) + (size_t)n * 1024;
        float acc = 0.f;
        for (int k = 0; k < 1024; k += 8) {
            const u32x4 w = *(const u32x4*)(wrow + k);
            const LAS float* m = sm + pr * 1028 + k;
            acc += m[0] * bflo(w.x) + m[1] * bfhi(w.x) + m[2] * bflo(w.y) + m[3] * bfhi(w.y) + m[4] * bflo(w.z) + m[5] * bfhi(w.z) + m[6] * bflo(w.w) + m[7] * bfhi(w.w);
        }
        const float rs = ((const float*)(ws + OFF_RSTD1))[pr];
        if (n < 1536) ((bf16_t*)(ws + OFF_PRKV))[(size_t)pr * 1536 + n] = f2bf(acc * rs);
        else ((bf16_t*)(ws + OFF_PCONV))[(size_t)pr * 2048 + n - 1536] = f2bf(acc * rs);
    }
    __syncthreads();
}

__device__ void phase_lprep_conv(const Params& p) {
    const int tid = threadIdx.x, bid = blockIdx.x, nb = gridDim.x;
    unsigned char* ws = p.ws;
    const bf16_t* PROJ = (const bf16_t*)(ws + OFF_PCONV);
    constexpr int PCOLS = 2048;
    bf16_t* L = (bf16_t*)(ws + OFF_L);
    for (int i = bid * 512 + tid; i < NRP * 32; i += nb * 512) {
        const int row = i >> 5, gq = i & 31;
        u32x4 w = (u32x4){0u, 0u, 0u, 0u};
        if (row < NR) {
            int ca, cb;
            if (gq < 8) { ca = 1536 + gq * 8; cb = ca + 64; }
            else if (gq < 16) { ca = 1536 + 128 + (gq - 8) * 8; cb = ca + 64; }
            else { ca = 1536 + 256 + (gq - 16) * 8; cb = ca + 128; }
            const u32x4 va = *(const u32x4*)(PROJ + (size_t)row * PCOLS + ca);
            const int pr = prev_row(row, 1);
            u32x4 vb = (u32x4){0u, 0u, 0u, 0u};
            if (pr >= 0) vb = *(const u32x4*)(PROJ + (size_t)pr * PCOLS + cb);
            float v[8] = {bflo(va.x) + bflo(vb.x), bfhi(va.x) + bfhi(vb.x), bflo(va.y) + bflo(vb.y), bfhi(va.y) + bfhi(vb.y), bflo(va.z) + bflo(vb.z), bfhi(va.z) + bfhi(vb.z), bflo(va.w) + bflo(vb.w), bfhi(va.w) + bfhi(vb.w)};
#pragma unroll
            for (int j = 0; j < 8; ++j) { if (gq < 8) v[j] = tanhf(v[j]); else if (gq >= 16) v[j] = sigmoidf_(v[j]); }
            w.x = cvt_pk_bf16(v[0], v[1]); w.y = cvt_pk_bf16(v[2], v[3]); w.z = cvt_pk_bf16(v[4], v[5]); w.w = cvt_pk_bf16(v[6], v[7]);
        }
        *(u32x4*)(L + (size_t)row * 256 + gq * 8) = w;
    }
    bf16_t* C = (bf16_t*)(ws + OFF_C);
    const float* cw = p.in[24];
    for (int i = bid * 512 + tid; i < T * 64; i += nb * 512) {
        const int m = i >> 6, ch = (i & 63) * 8, row = NMETA + m;
        const int r1 = prev_row(row, 1), r2 = prev_row(row, 2);
        const bf16_t* p0 = PROJ + (size_t)row * PCOLS; const bf16_t* p1 = PROJ + (size_t)r1 * PCOLS; const bf16_t* p2 = PROJ + (size_t)r2 * PCOLS;
        const u32x4 vb = *(const u32x4*)(p0 + ch);
        const u32x4 c0 = *(const u32x4*)(p0 + 512 + ch), h0 = *(const u32x4*)(p0 + 1024 + ch);
        const u32x4 c1 = *(const u32x4*)(p1 + 512 + ch), h1 = *(const u32x4*)(p1 + 1024 + ch);
        const u32x4 c2 = *(const u32x4*)(p2 + 512 + ch), h2 = *(const u32x4*)(p2 + 1024 + ch);
        float o[8];
#pragma unroll
        for (int j = 0; j < 8; ++j) {
            const unsigned wb = j < 2 ? vb.x : j < 4 ? vb.y : j < 6 ? vb.z : vb.w;
            const unsigned wc0 = j < 2 ? c0.x : j < 4 ? c0.y : j < 6 ? c0.z : c0.w, wh0 = j < 2 ? h0.x : j < 4 ? h0.y : j < 6 ? h0.z : h0.w;
            const unsigned wc1 = j < 2 ? c1.x : j < 4 ? c1.y : j < 6 ? c1.z : c1.w, wh1 = j < 2 ? h1.x : j < 4 ? h1.y : j < 6 ? h1.z : h1.w;
            const unsigned wc2 = j < 2 ? c2.x : j < 4 ? c2.y : j < 6 ? c2.z : c2.w, wh2 = j < 2 ? h2.x : j < 4 ? h2.y : j < 6 ? h2.z : h2.w;
            const bool hi = j & 1;
            const float b = hi ? bfhi(wb) : bflo(wb);
            const float u0 = (hi ? bfhi(wc0) : bflo(wc0)) * (hi ? bfhi(wh0) : bflo(wh0));
            const float u1 = (hi ? bfhi(wc1) : bflo(wc1)) * (hi ? bfhi(wh1) : bflo(wh1));
            const float u2 = (hi ? bfhi(wc2) : bflo(wc2)) * (hi ? bfhi(wh2) : bflo(wh2));
            const float conv = cw[ch + j] * u2 + cw[512 + ch + j] * u1 + cw[1024 + ch + j] * u0;
            o[j] = b * conv;
        }
        u32x4 w; w.x = cvt_pk_bf16(o[0], o[1]); w.y = cvt_pk_bf16(o[2], o[3]); w.z = cvt_pk_bf16(o[4], o[5]); w.w = cvt_pk_bf16(o[6], o[7]);
        *(u32x4*)(C + (size_t)m * 512 + ch) = w;
    }
}

template <int CTRL> __device__ __forceinline__ float dppmov(float v) { return __builtin_bit_cast(float, __builtin_amdgcn_update_dpp(0, __builtin_bit_cast(int, v), CTRL, 0xF, 0xF, true)); }
__device__ __forceinline__ float wave_sum_dpp(float v) {
    return wave_sum(v);
    v += dppmov<0xB1>(v);
    v += dppmov<0x4E>(v);
    v += dppmov<0x141>(v);
    v += dppmov<0x140>(v);
    { const u32x2 r = __builtin_amdgcn_permlane16_swap(__builtin_bit_cast(unsigned, v), __builtin_bit_cast(unsigned, v), false, false); v = __builtin_bit_cast(float, r.x) + __builtin_bit_cast(float, r.y); }
    { const u32x2 r = __builtin_amdgcn_permlane32_swap(__builtin_bit_cast(unsigned, v), __builtin_bit_cast(unsigned, v), false, false); v = __builtin_bit_cast(float, r.x) + __builtin_bit_cast(float, r.y); }
    return v;
}
typedef float f32x16 __attribute__((ext_vector_type(16)));

struct RawTok { bf16_t r, k, v, a; float ld; };
__device__ __forceinline__ RawTok load_raw(const bf16_t* PRKV, const bf16_t* Ab, const float* LD, int row, int col) {
    RawTok q; const bf16_t* p0 = PRKV + (size_t)row * 1536 + col;
    q.r = p0[0]; q.k = p0[512]; q.v = p0[1024]; q.a = Ab[(size_t)row * 512 + col]; q.ld = LD[(size_t)row * 512 + col];
    return q;
}
__device__ __forceinline__ void unit_geom(int uid, int lane, int& b, int& h, int& c, int& col, int& row0) {
    const int bh = uid / NCHUNK; c = uid - bh * NCHUNK; b = bh >> 3; h = bh & 7; col = h * 64 + lane;
    row0 = c == 0 ? 0 : b * SEQ + c * 16;
}
__device__ void phase_scanprep(const Params& p, LAS unsigned char* lds) {
    const int tid = threadIdx.x, bid = blockIdx.x, nb = gridDim.x, lane = tid & 63, wave = tid >> 6;
    unsigned char* ws = p.ws;
    const bf16_t* PRKV = (const bf16_t*)(ws + OFF_PRKV);
    const float* LD = (const float*)(ws + OFF_LD);
    const bf16_t* Ab = (const bf16_t*)(ws + OFF_A);
    float* COEF = (float*)(ws + OFF_COEF);
    LAS unsigned char* wl = lds + wave * 13824;
    LAS bf16_t* AR = (LAS bf16_t*)wl;
    LAS bf16_t* BK = (LAS bf16_t*)(wl + 4608);
    LAS float* DM = (LAS float*)(wl + 9216);
    const int qperm = (lane & 32) | (((lane >> 2) & 3) << 3) | (((lane >> 4) & 1) << 2) | (lane & 3);
    int uid = bid * 8 + wave;
    if (uid >= NUNITS) return;
    int b, h, c, col, row0;
    unit_geom(uid, lane, b, h, c, col, row0);
    RawTok q[16];
    bf16_t prr = 0, prk = 0, prv = 0;
#pragma unroll
    for (int t = 0; t < 4; ++t) q[t] = load_raw(PRKV, Ab, LD, row0 + t, col);
    { const int pr = prev_row(row0, 1); if (pr >= 0) { const bf16_t* p1 = PRKV + (size_t)pr * 1536 + col; prr = p1[0]; prk = p1[512]; prv = p1[1024]; } }
    for (;;) {
        const float mur = p.in[4][col], muk = p.in[5][col], muv = p.in[6][col], kkw = p.in[18][col], kaw = p.in[19][col], rkw = p.in[20][col];
        const int nuid = uid + nb * 8; const bool has_next = nuid < NUNITS;
        int nb_, nh, nc, ncol = col, nrow0 = row0;
        if (has_next) unit_geom(nuid, lane, nb_, nh, nc, ncol, nrow0);
        float at[16], vt[16]; unsigned btp[8], ktp[8]; float bprev = 0.f, kprev = 0.f;
        float cl = 0.f;
        float rp = bf2f(prr), kp = bf2f(prk), vp = bf2f(prv);
#pragma unroll
        for (int t = 0; t < 16; ++t) {
            if (t < 12) q[t + 4] = load_raw(PRKV, Ab, LD, row0 + t + 4, col);
            else if (has_next) q[t - 12] = load_raw(PRKV, Ab, LD, nrow0 + t - 12, ncol);
            if (t == 15 && has_next) { prr = 0; prk = 0; prv = 0; const int pr = prev_row(nrow0, 1); if (pr >= 0) { const bf16_t* p1 = PRKV + (size_t)pr * 1536 + ncol; prr = p1[0]; prk = p1[512]; prv = p1[1024]; } }
            const RawTok qq = q[t < 12 ? t : t];
            const int row = row0 + t;
            const float r0 = bf2f(qq.r), k0 = bf2f(qq.k), v0 = bf2f(qq.v);
            const float r = r0 + (rp - r0) * mur, k = k0 + (kp - k0) * muk, v = v0 + (vp - v0) * muv;
            rp = r0; kp = k0; vp = v0;
            const float a = bf2f(qq.a);
            const float kkv = k * kkw;
            const float n2 = wave_sum_dpp(kkv * kkv);
            const float kk = kkv * __builtin_amdgcn_rsqf(fmaxf(n2, 1e-24f));
            const float k2 = k * (1.0f + (a - 1.0f) * kaw);
            const float cf = wave_sum_dpp(r * k2 * rkw);
            if (lane == 0) COEF[(size_t)row * 8 + h] = cf;
            const float wcp = __expf(cl);
            cl += qq.ld;
            const float wcn = __expf(cl), iw = __expf(-cl);
            const float btv = kk * a * iw, ktv = k2 * iw;
            at[t] = -kk * wcp; vt[t] = v;
            { const unsigned w = cvt_pk_bf16(at[t], r * wcn); AR[t * 72 + qperm] = (bf16_t)(w & 0xFFFFu); AR[(16 + t) * 72 + qperm] = (bf16_t)(w >> 16); }
            if (t & 1) {
                btp[t >> 1] = cvt_pk_bf16(bprev, btv); ktp[t >> 1] = cvt_pk_bf16(kprev, ktv);
                BK[(t - 1) * 72 + qperm] = (bf16_t)(btp[t >> 1] & 0xFFFFu); BK[t * 72 + qperm] = (bf16_t)(btp[t >> 1] >> 16);
                BK[(16 + t - 1) * 72 + qperm] = (bf16_t)(ktp[t >> 1] & 0xFFFFu); BK[(16 + t) * 72 + qperm] = (bf16_t)(ktp[t >> 1] >> 16);
            } else { bprev = btv; kprev = ktv; }
            __builtin_amdgcn_sched_barrier(0);
        }
        const float wcc = __expf(cl);
        {
            f32x16 dm;
#pragma unroll
            for (int i = 0; i < 16; ++i) dm[i] = 0.f;
            const int rr = lane & 31, hh = lane >> 5;
#pragma unroll
            for (int ks = 0; ks < 4; ++ks) {
                const bf16x8 fa = *(const LAS bf16x8*)(AR + rr * 72 + 16 * ks + 8 * hh);
                const bf16x8 fb = *(const LAS bf16x8*)(BK + rr * 72 + 16 * ks + 8 * hh);
                dm = __builtin_amdgcn_mfma_f32_32x32x16_bf16(fa, fb, dm, 0, 0, 0);
            }
#pragma unroll
            for (int reg = 0; reg < 16; ++reg) DM[((reg & 3) + 8 * (reg >> 2) + 4 * hh) * 36 + rr] = dm[reg];
        }
        __builtin_amdgcn_sched_barrier(0);
        float uh[16];
#pragma unroll
        for (int t = 0; t < 16; ++t) {
            float wv = at[t], uv = 0.f;
#pragma unroll
            for (int s4 = 0; s4 < 4; ++s4) {
                if (s4 * 4 < t) {
                    const f32x4 ab = *(const LAS f32x4*)(DM + t * 36 + s4 * 4), ak = *(const LAS f32x4*)(DM + t * 36 + 16 + s4 * 4);
#pragma unroll
                    for (int j = 0; j < 4; ++j) {
                        const int s_ = s4 * 4 + j;
                        if (s_ < t) { wv += ab[j] * at[s_]; uv += ak[j] * vt[s_] + ab[j] * uh[s_]; }
                    }
                }
            }
            at[t] = wv; uh[t] = uv;
            asm volatile("" : "+v"(at[t]), "+v"(uh[t]));
        }
        __builtin_amdgcn_sched_barrier(0);
#pragma unroll
        for (int t = 0; t < 16; t += 2) { const unsigned w = cvt_pk_bf16(at[t], at[t + 1]); AR[t * 72 + qperm] = (bf16_t)(w & 0xFFFFu); AR[(t + 1) * 72 + qperm] = (bf16_t)(w >> 16); }
        unsigned char* rec = ws + OFF_CH + (size_t)uid * REC_BYTES;
#pragma unroll
        for (int i = 0; i < 2; ++i) {
            const int pc = i * 64 + lane, row = pc >> 3, part = pc & 7;
            *(u32x4*)(rec + RO_WH + pc * 16) = *(const LAS u32x4*)((LAS unsigned char*)AR + row * 144 + part * 16);
            *(u32x4*)(rec + RO_RT + pc * 16) = *(const LAS u32x4*)((LAS unsigned char*)AR + (16 + row) * 144 + part * 16);
        }
        {
            u32x4 w0, w1;
            w0.x = cvt_pk_bf16(uh[0], uh[1]); w0.y = cvt_pk_bf16(uh[2], uh[3]); w0.z = cvt_pk_bf16(uh[4], uh[5]); w0.w = cvt_pk_bf16(uh[6], uh[7]);
            w1.x = cvt_pk_bf16(uh[8], uh[9]); w1.y = cvt_pk_bf16(uh[10], uh[11]); w1.z = cvt_pk_bf16(uh[12], uh[13]); w1.w = cvt_pk_bf16(uh[14], uh[15]);
            *(u32x4*)(rec + RO_U0T + lane * 32) = w0; *(u32x4*)(rec + RO_U0T + lane * 32 + 16) = w1;
            w0.x = cvt_pk_bf16(vt[0], vt[1]); w0.y = cvt_pk_bf16(vt[2], vt[3]); w0.z = cvt_pk_bf16(vt[4], vt[5]); w0.w = cvt_pk_bf16(vt[6], vt[7]);
            w1.x = cvt_pk_bf16(vt[8], vt[9]); w1.y = cvt_pk_bf16(vt[10], vt[11]); w1.z = cvt_pk_bf16(vt[12], vt[13]); w1.w = cvt_pk_bf16(vt[14], vt[15]);
            *(u32x4*)(rec + RO_VT + lane * 32) = w0; *(u32x4*)(rec + RO_VT + lane * 32 + 16) = w1;
        }
#pragma unroll
        for (int g = 0; g < 4; ++g) {
            u32x4 w; w.x = btp[2 * g]; w.y = btp[2 * g + 1]; w.z = ktp[2 * g]; w.w = ktp[2 * g + 1];
            *(u32x4*)(rec + RO_BKT + lane * 64 + g * 16) = w;
        }
        {
            const int t = lane >> 2, g = lane & 3;
            const f32x4 rb = *(const LAS f32x4*)(DM + (16 + t) * 36 + 4 * g), rk = *(const LAS f32x4*)(DM + (16 + t) * 36 + 16 + 4 * g);
            float o[8];
#pragma unroll
            for (int j = 0; j < 4; ++j) { const bool keep = (4 * g + j) <= t; o[j] = keep ? rb[j] : 0.f; o[4 + j] = keep ? rk[j] : 0.f; }
            u32x4 w; w.x = cvt_pk_bf16(o[0], o[1]); w.y = cvt_pk_bf16(o[2], o[3]); w.z = cvt_pk_bf16(o[4], o[5]); w.w = cvt_pk_bf16(o[6], o[7]);
            *(u32x4*)(rec + RO_ARK + t * 64 + g * 16) = w;
        }
        *(float*)(rec + RO_WCC + lane * 4) = wcc;
        if (!has_next) break;
        uid = nuid; b = nb_; h = nh; c = nc; col = ncol; row0 = nrow0;
        __builtin_amdgcn_sched_barrier(0);
    }
}

__device__ void convert_expert_weights(const Params& p, LAS unsigned char* lds, int first, int stride);
__device__ void phase_recur(const Params& p, LAS unsigned char* lds) {
    const int tid = threadIdx.x, bid = blockIdx.x, nb = gridDim.x, lane = tid & 63, wave = __builtin_amdgcn_readfirstlane(tid >> 6);
    unsigned char* ws = p.ws;
    if (bid >= 64) { convert_expert_weights(p, lds, bid - 64, nb - 64); return; }
    const int b = bid >> 3, h = bid & 7;
    const unsigned char* CHb = ws + OFF_CH + (size_t)(bid * NCHUNK) * REC_BYTES;
    LAS float* YB = (LAS float*)(lds + NSLOT * SLOT_BYTES);
#define R_BAR() do { asm volatile("s_waitcnt lgkmcnt(0)" ::: "memory"); __builtin_amdgcn_s_barrier(); asm volatile("" ::: "memory"); } while (0)
    if (wave == 4 || wave == 5) {
        const int lw = wave - 4;
        const bf16_t* Gb = (const bf16_t*)(ws + OFF_G); const float* COEF = (const float*)(ws + OFF_COEF);
#define R_ISSUE(x) do { \
            LAS unsigned char* _s = lds + ((x) % NSLOT) * SLOT_BYTES; const unsigned char* _r = CHb + (size_t)(x) * REC_BYTES + lane * 16; \
            _Pragma("unroll") for (int _pc = 0; _pc < 13; ++_pc) __builtin_amdgcn_global_load_lds((const unsigned*)(_r + _pc * 1024), (LAS unsigned*)(_s + _pc * 1024), 16, 0, 0); \
            if (lane < 16) __builtin_amdgcn_global_load_lds((const unsigned*)(_r + 13312), (LAS unsigned*)(_s + 13312), 16, 0, 0); \
            _Pragma("unroll") for (int _k = 0; _k < 2; ++_k) { const int _tt = (_k * 64 + lane) >> 3, _pos = (x) * 16 + _tt, _row = _pos < NMETA ? _pos : b * SEQ + _pos; \
                __builtin_amdgcn_global_load_lds((const unsigned*)(Gb + (size_t)_row * 512 + h * 64 + (lane & 7) * 8), (LAS unsigned*)(_s + SO_G + _k * 1024), 16, 0, 0); } \
            if (lane < 16) { const int _pos = (x) * 16 + lane, _row = _pos < NMETA ? _pos : b * SEQ + _pos; \
                __builtin_amdgcn_global_load_lds((const unsigned*)(COEF + (size_t)_row * 8 + h), (LAS unsigned*)(_s + SO_COEF), 4, 0, 0); } } while (0)
        for (int x = 0; x < 7; ++x) if ((x & 1) == lw) R_ISSUE(x);
        asm volatile("s_waitcnt vmcnt(0)" ::: "memory");
        R_BAR();
        for (int c = 0; c <= NCHUNK; ++c) {
            const int x = c + 7;
            if (x < NCHUNK && (x & 1) == lw) R_ISSUE(x);
            if (((c + 1) & 1) == lw) { if (x < NCHUNK) asm volatile("s_waitcnt vmcnt(51)" ::: "memory"); else asm volatile("s_waitcnt vmcnt(0)" ::: "memory"); }
            R_BAR();
        }
#undef R_ISSUE
    } else if (wave < 4) {
        const int vs = wave, fr = lane & 15, g = lane >> 4;
        f32x4 H[4];
#pragma unroll
        for (int m = 0; m < 4; ++m) H[m] = (f32x4){0.f, 0.f, 0.f, 0.f};
        R_BAR();
        for (int c = 0; c <= NCHUNK; ++c) {
            if (c < NCHUNK) {
                LAS unsigned char* S = lds + (c % NSLOT) * SLOT_BYTES;
                const bf16x8 wA0 = *(const LAS bf16x8*)(S + RO_WH + fr * 128 + g * 16), wA1 = *(const LAS bf16x8*)(S + RO_WH + fr * 128 + 64 + g * 16);
                const bf16x8 rA0 = *(const LAS bf16x8*)(S + RO_RT + fr * 128 + g * 16), rA1 = *(const LAS bf16x8*)(S + RO_RT + fr * 128 + 64 + g * 16);
                const u32x2 u0 = *(const LAS u32x2*)(S + RO_U0T + (16 * vs + fr) * 32 + g * 8);
                const u32x2 vv = *(const LAS u32x2*)(S + RO_VT + (16 * vs + fr) * 32 + g * 8);
                const bf16x8 ark = *(const LAS bf16x8*)(S + RO_ARK + fr * 64 + g * 16);
                bf16x8 bk[4]; f32x4 wc[4];
#pragma unroll
                for (int m = 0; m < 4; ++m) { bk[m] = *(const LAS bf16x8*)(S + RO_BKT + (16 * m + fr) * 64 + g * 16); wc[m] = *(const LAS f32x4*)(S + RO_WCC + (16 * m + 4 * g) * 4); }
                u32x4 hb0, hb1;
                hb0.x = cvt_pk_bf16(H[0][0], H[0][1]); hb0.y = cvt_pk_bf16(H[0][2], H[0][3]); hb0.z = cvt_pk_bf16(H[1][0], H[1][1]); hb0.w = cvt_pk_bf16(H[1][2], H[1][3]);
                hb1.x = cvt_pk_bf16(H[2][0], H[2][1]); hb1.y = cvt_pk_bf16(H[2][2], H[2][3]); hb1.z = cvt_pk_bf16(H[3][0], H[3][1]); hb1.w = cvt_pk_bf16(H[3][2], H[3][3]);
                const bf16x8 hB0 = __builtin_bit_cast(bf16x8, hb0), hB1 = __builtin_bit_cast(bf16x8, hb1);
                f32x4 U = (f32x4){bflo(u0.x), bfhi(u0.x), bflo(u0.y), bfhi(u0.y)};
                U = __builtin_amdgcn_mfma_f32_16x16x32_bf16(wA0, hB0, U, 0, 0, 0);
                U = __builtin_amdgcn_mfma_f32_16x16x32_bf16(wA1, hB1, U, 0, 0, 0);
                f32x4 Y = (f32x4){0.f, 0.f, 0.f, 0.f};
                Y = __builtin_amdgcn_mfma_f32_16x16x32_bf16(rA0, hB0, Y, 0, 0, 0);
                Y = __builtin_amdgcn_mfma_f32_16x16x32_bf16(rA1, hB1, Y, 0, 0, 0);
                u32x4 uvw; uvw.x = cvt_pk_bf16(U[0], U[1]); uvw.y = cvt_pk_bf16(U[2], U[3]); uvw.z = vv.x; uvw.w = vv.y;
                const bf16x8 uv = __builtin_bit_cast(bf16x8, uvw);
                Y = __builtin_amdgcn_mfma_f32_16x16x32_bf16(ark, uv, Y, 0, 0, 0);
#pragma unroll
                for (int m = 0; m < 4; ++m) { H[m] = __builtin_amdgcn_mfma_f32_16x16x32_bf16(bk[m], uv, H[m], 0, 0, 0); H[m] *= wc[m]; }
                LAS float* yb = YB + (c & 1) * 1024 + 16 * vs + fr;
#pragma unroll
                for (int reg = 0; reg < 4; ++reg) yb[(4 * g + reg) * 64] = Y[reg];
            }
            R_BAR();
        }
    } else {
        const int gw = wave - 6, col = h * 64 + lane;
        const float lng = p.in[21][col], lnb = p.in[22][col];
        bf16_t* Z = (bf16_t*)(ws + OFF_Z);
        R_BAR();
        for (int c = 0; c <= NCHUNK; ++c) {
            if (c >= 2) {
                const int cc = c - 1;
                LAS unsigned char* S = lds + (cc % NSLOT) * SLOT_BYTES;
                const LAS float* yb = YB + (cc & 1) * 1024;
#pragma unroll
                for (int tt = 0; tt < 8; ++tt) {
                    const int t = gw * 8 + tt;
                    const float y = yb[t * 64 + lane];
                    const float mean = wave_sum_dpp(y) * (1.0f / 64.0f);
                    const float dlt = y - mean;
                    const float var = wave_sum_dpp(dlt * dlt) * (1.0f / 64.0f);
                    const float yn = dlt * rsqrtf(var + LNX_EPS) * lng + lnb;
                    const float cf = *(const LAS float*)(S + SO_COEF + t * 4);
                    const float v = bf2f(*(const LAS bf16_t*)(S + RO_VT + lane * 32 + t * 2));
                    const float gg = bf2f(*(const LAS bf16_t*)(S + SO_G + (t * 64 + lane) * 2));
                    const int m = b * SEQ + cc * 16 + t - NMETA;
                    Z[(size_t)m * 512 + col] = f2bf((yn + cf * v) * gg);
                }
            }
            R_BAR();
        }
    }
#undef R_BAR
}

__device__ void convert_expert_weights(const Params& p, LAS unsigned char* lds, int first, int stride) {
    unsigned char* ws = p.ws;
    LAS float* tile = (LAS float*)lds;
    const float* g2 = p.in[27];
    bf16_t* WGU = (bf16_t*)(ws + OFF_WGU); bf16_t* WD = (bf16_t*)(ws + OFF_WD);
    for (int j = first; j < NE * 3 * 256; j += stride) {
        const int e = j / 768, r = j % 768, which = r >> 8, tt = r & 255, kt = tt & 15, ntile = tt >> 4;
        if (which < 2) {
            const float* src = (which == 0 ? p.in[30] : p.in[32]) + (size_t)e * 1024 * 1024;
            const int drow0 = 256 * (ntile >> 1) + 128 * which + 64 * (ntile & 1);
            transpose_tile(tile, src, 1024, kt * 64, ntile * 64, WGU + (size_t)e * 2048 * 1024, 1024, drow0, g2, nullptr, 0, false);
        } else {
            const float* src = p.in[34] + (size_t)e * 1024 * 1024;
            transpose_tile(tile, src, 1024, kt * 64, ntile * 64, WD + (size_t)e * 1024 * 1024, 1024, ntile * 64, nullptr, nullptr, 0, false);
        }
    }
}

__device__ void phase_router(const Params& p, LAS unsigned char* lds) {
    const int tid = threadIdx.x, bid = blockIdx.x, nb = gridDim.x, lane = tid & 63, wave = tid >> 6;
    unsigned char* ws = p.ws;
    const float* h1 = p.out;
    const float* WRG = (const float*)(ws + OFF_WRG);
    const float* brt = p.in[29];
    LAS float* slog = (LAS float*)lds;
    LAS float* srs = slog + 8 * 16 * 32;
    LAS int* lcnt = (LAS int*)(srs + 128);
    LAS int* gbase = lcnt + 32;
    LAS int* ltopi = gbase + 32;
    LAS int* lrank = ltopi + 512;
    int* TOPI = (int*)(ws + OFF_TOPI); float* TOPW = (float*)(ws + OFF_TOPW); int* RANK = (int*)(ws + OFF_RANK); float* RSTD2 = (float*)(ws + OFF_RSTD2);
    int* GCNT = (int*)(ws + OFF_GCNT);
    for (int tb = bid; tb < T / 128; tb += nb) {
        if (tid < 32) lcnt[tid] = 0;
        __syncthreads();
        const int t0 = tb * 128 + wave * 16;
        {
            const int row = lane & 15, kq = lane >> 4;
            const float* ap = h1 + (size_t)(t0 + row) * D + 4 * kq;
            const float* bp = WRG + (size_t)(4 * kq) * 32 + row;
            f32x4 acc0 = (f32x4){0.f, 0.f, 0.f, 0.f}, acc1 = acc0;
            float ss = 0.f;
            for (int j = 0; j < 64; ++j) {
                const f32x4 av = *(const f32x4*)(ap + 16 * j);
                ss += av[0] * av[0] + av[1] * av[1] + av[2] * av[2] + av[3] * av[3];
                const float* bj = bp + (size_t)(16 * j) * 32;
#pragma unroll
                for (int s = 0; s < 4; ++s) {
                    const float b0 = bj[s * 32], b1 = bj[s * 32 + 16];
                    acc0 = __builtin_amdgcn_mfma_f32_16x16x4f32(av[s], b0, acc0, 0, 0, 0);
                    acc1 = __builtin_amdgcn_mfma_f32_16x16x4f32(av[s], b1, acc1, 0, 0, 0);
                }
            }
            ss += __shfl_xor(ss, 16); ss += __shfl_xor(ss, 32);
#pragma unroll
            for (int reg = 0; reg < 4; ++reg) {
                slog[(wave * 16 + 4 * kq + reg) * 32 + row] = acc0[reg];
                slog[(wave * 16 + 4 * kq + reg) * 32 + 16 + row] = acc1[reg];
            }
            if (lane < 16) srs[wave * 16 + lane] = rsqrtf(ss * (1.0f / D) + NORM_EPS);
        }
        __syncthreads();
        if (lane < 16) {
            const int tl = wave * 16 + lane, t = tb * 128 + tl;
            const float rs = srs[tl];
            float lg[32];
#pragma unroll
            for (int e = 0; e < 32; ++e) lg[e] = slog[tl * 32 + e] * rs + brt[e];
            int ti[4]; float tv[4];
#pragma unroll
            for (int k = 0; k < 4; ++k) {
                float best = -3.0e38f; int bi = 0;
#pragma unroll
                for (int e = 0; e < 32; ++e) { const bool tk = lg[e] > best; best = tk ? lg[e] : best; bi = tk ? e : bi; }
                ti[k] = bi; tv[k] = best;
#pragma unroll
                for (int e = 0; e < 32; ++e) lg[e] = (e == bi) ? -3.0e38f : lg[e];
            }
            const float e0 = 1.0f, e1 = __expf(tv[1] - tv[0]), e2 = __expf(tv[2] - tv[0]), e3 = __expf(tv[3] - tv[0]);
            const float inv = 1.0f / (e0 + e1 + e2 + e3);
            *(f32x4*)(TOPW + (size_t)t * 4) = (f32x4){e0 * inv, e1 * inv, e2 * inv, e3 * inv};
            RSTD2[t] = rs;
#pragma unroll
            for (int k = 0; k < 4; ++k) { ltopi[tl * 4 + k] = ti[k]; lrank[tl * 4 + k] = __hip_atomic_fetch_add(lcnt + ti[k], 1, __ATOMIC_RELAXED, __HIP_MEMORY_SCOPE_WORKGROUP); }
        }
        __syncthreads();
        if (tid < 32) gbase[tid] = atomicAdd(GCNT + tid, lcnt[tid]);
        __syncthreads();
        {
            const int e = ltopi[tid];
            TOPI[(size_t)tb * 512 + tid] = e;
            RANK[(size_t)tb * 512 + tid] = gbase[e] + lrank[tid];
        }
        __syncthreads();
    }
}

__device__ void phase_lists(const Params& p, LAS unsigned char* lds) {
    const int tid = threadIdx.x, bid = blockIdx.x, nb = gridDim.x;
    unsigned char* ws = p.ws;
    LAS int* pstart = (LAS int*)lds;
    LAS int* cnt = pstart + 64;
    const int* GCNT = (const int*)(ws + OFF_GCNT);
    if (tid < 32) cnt[tid] = GCNT[tid];
    __syncthreads();
    if (tid == 0) { int s = 0; for (int e = 0; e < 32; ++e) { pstart[e] = s; s += ((cnt[e] + 255) >> 8) << 8; } pstart[32] = s; }
    __syncthreads();
    const int* TOPI = (const int*)(ws + OFF_TOPI); const float* TOPW = (const float*)(ws + OFF_TOPW); const int* RANK = (const int*)(ws + OFF_RANK); const float* RSTD2 = (const float*)(ws + OFF_RSTD2);
    int* ROWTOK = (int*)(ws + OFF_ROWTOK); int* ROWSLOT = (int*)(ws + OFF_ROWSLOT); float* ROWW = (float*)(ws + OFF_ROWW); float* ROWRS = (float*)(ws + OFF_ROWRS);
    for (int i = bid * 512 + tid; i < T * 4; i += nb * 512) {
        const int e = TOPI[i], pos = pstart[e] + RANK[i], t = i >> 2;
        ROWTOK[pos] = t; ROWSLOT[pos] = i; ROWW[pos] = TOPW[i]; ROWRS[pos] = RSTD2[t];
    }
    for (int e = bid; e < 32; e += nb) {
        for (int pos = pstart[e] + cnt[e] + tid; pos < pstart[e + 1]; pos += 512) { ROWTOK[pos] = 0; ROWSLOT[pos] = -1; ROWW[pos] = 0.f; ROWRS[pos] = 0.f; }
    }
    if (bid == 0) {
        int* TILEE = (int*)(ws + OFF_TILEE);
        const int ntiles = pstart[32] >> 8;
        for (int mt = tid; mt < ntiles; mt += 512) { int e = 0; for (int q = 0; q < 32; ++q) if (pstart[q] <= mt * 256) e = q; TILEE[mt] = e; }
        if (tid == 0) TILEE[1000] = ntiles;
    }
    __syncthreads();
}

__device__ void phase_final(const Params& p) {
    const int tid = threadIdx.x, bid = blockIdx.x, nb = gridDim.x, lane = tid & 63, wave = tid >> 6;
    unsigned char* ws = p.ws;
    const bf16_t* HB2 = (const bf16_t*)(ws + OFF_HB2);
    const bf16_t* YA = (const bf16_t*)p.out; const bf16_t* YB = (const bf16_t*)(ws + OFF_WGU);
    const float* gf = p.in[36];
    const f32x4 ga0 = *(const f32x4*)(gf + 8 * lane), ga1 = *(const f32x4*)(gf + 8 * lane + 4), gb0 = *(const f32x4*)(gf + 512 + 8 * lane), gb1 = *(const f32x4*)(gf + 512 + 8 * lane + 4);
    for (int t = bid * 8 + wave; t < T; t += nb * 8) {
        const u32x4 ha = *(const u32x4*)(HB2 + (size_t)t * D + 8 * lane), hb = *(const u32x4*)(HB2 + (size_t)t * D + 512 + 8 * lane);
        float va[8] = {bflo(ha.x), bfhi(ha.x), bflo(ha.y), bfhi(ha.y), bflo(ha.z), bfhi(ha.z), bflo(ha.w), bfhi(ha.w)};
        float vb[8] = {bflo(hb.x), bfhi(hb.x), bflo(hb.y), bfhi(hb.y), bflo(hb.z), bfhi(hb.z), bflo(hb.w), bfhi(hb.w)};
#pragma unroll
        for (int k = 0; k < 4; ++k) {
            const u32x4 ya = *(const u32x4*)(YA + (size_t)(4 * t + k) * 512 + 8 * lane), yb = *(const u32x4*)(YB + (size_t)(4 * t + k) * 512 + 8 * lane);
            va[0] += bflo(ya.x); va[1] += bfhi(ya.x); va[2] += bflo(ya.y); va[3] += bfhi(ya.y); va[4] += bflo(ya.z); va[5] += bfhi(ya.z); va[6] += bflo(ya.w); va[7] += bfhi(ya.w);
            vb[0] += bflo(yb.x); vb[1] += bfhi(yb.x); vb[2] += bflo(yb.y); vb[3] += bfhi(yb.y); vb[4] += bflo(yb.z); vb[5] += bfhi(yb.z); vb[6] += bflo(yb.w); vb[7] += bfhi(yb.w);
        }
        float ss = 0.f;
#pragma unroll
        for (int j = 0; j < 8; ++j) ss += va[j] * va[j] + vb[j] * vb[j];
        ss = wave_sum(ss);
        const float rs = rsqrtf(ss * (1.0f / D) + NORM_EPS);
        float* o = p.out + (size_t)t * D;
        *(f32x4*)(o + 8 * lane) = (f32x4){va[0] * rs * ga0[0], va[1] * rs * ga0[1], va[2] * rs * ga0[2], va[3] * rs * ga0[3]};
        *(f32x4*)(o + 8 * lane + 4) = (f32x4){va[4] * rs * ga1[0], va[5] * rs * ga1[1], va[6] * rs * ga1[2], va[7] * rs * ga1[3]};
        *(f32x4*)(o + 512 + 8 * lane) = (f32x4){vb[0] * rs * gb0[0], vb[1] * rs * gb0[1], vb[2] * rs * gb0[2], vb[3] * rs * gb0[3]};
        *(f32x4*)(o + 512 + 8 * lane + 4) = (f32x4){vb[4] * rs * gb1[0], vb[5] * rs * gb1[1], vb[6] * rs * gb1[2], vb[7] * rs * gb1[3]};
    }
}

constexpr int N_PHASES = 14;
__global__ void __launch_bounds__(512, 2) mega(Params p) {
    extern __shared__ __attribute__((aligned(16))) unsigned char lds_raw[];
    LAS unsigned char* lds = (LAS unsigned char*)lds_raw;
    cg::grid_group grid = cg::this_grid();
    unsigned char* ws = p.ws;
    const int G = gridDim.x, bid = blockIdx.x;
#ifndef ONLY_PHASE
#define ONLY_PHASE -1
#endif
#define IN(k) ((ONLY_PHASE < 0 || ONLY_PHASE == (k)) && p.ph_lo <= (k) && (k) < p.ph_hi)
#define SEAM(k) do { if ((k) + 1 < p.ph_hi) grid.sync(); } while (0)
    if (IN(0)) { phase_prep(p, lds); SEAM(0); }
    if (IN(1)) {
        phase_meta_proj(p, lds);
        StaticOrder S; S.init(ws + OFF_HB, ws + OFF_WIN, T, NCOLS1, 1024, G, bid);
        EpiProj E{(bf16_t*)(ws + OFF_PRKV), (bf16_t*)(ws + OFF_PCONV), (bf16_t*)p.out, (const float*)(ws + OFF_RSTD1)};
        gemm_phase<false>(lds, 1024, S, E);
        SEAM(1);
    }
    if (IN(2)) { phase_lprep_conv(p); SEAM(2); }
    if (IN(3)) {
        StaticOrder S; S.init(ws + OFF_L, ws + OFF_W2, NRP, 1536, 256, G, bid);
        EpiL E{(float*)(ws + OFF_LD), (bf16_t*)(ws + OFF_A), (bf16_t*)(ws + OFF_G), p.in[10], p.in[13]};
        gemm_phase<false>(lds, 256, S, E);
        SEAM(3);
    }
    if (IN(4)) { phase_scanprep(p, lds); SEAM(4); }
    if (IN(5)) { phase_recur(p, lds); SEAM(5); }
    if (IN(6)) {
        StaticOrder S; S.init(ws + OFF_Z, ws + OFF_WR, T, 1024, 512, G, bid);
        EpiMerge<0> E{(bf16_t*)(ws + OFF_MERGED), (const bf16_t*)p.out};
        gemm_phase<false>(lds, 512, S, E);
        SEAM(6);
    }
    if (IN(7)) {
        StaticOrder S; S.init(ws + OFF_C, ws + OFF_WC, T, 1024, 512, G, bid);
        EpiMerge<1> E{(bf16_t*)(ws + OFF_MERGED), (const bf16_t*)p.out};
        gemm_phase<false>(lds, 512, S, E);
        SEAM(7);
    }
    if (IN(8)) {
        StaticOrder S; S.init(ws + OFF_MERGED, ws + OFF_WO, T, 1024, 1024, G, bid);
        EpiO E{p.in[0], p.out, (bf16_t*)(ws + OFF_HB2)};
        gemm_phase<false>(lds, 1024, S, E);
        SEAM(8);
    }
    if (IN(9)) { phase_router(p, lds); SEAM(9); }
    if (IN(10)) { phase_lists(p, lds); SEAM(10); }
    if (IN(11)) {
        const int* TILEE = (const int*)(ws + OFF_TILEE);
        MoeOrder S; S.A = (const char*)(ws + OFF_HB2); S.Bt = (const char*)(ws + OFF_WGU); S.K = 1024; S.estride = (size_t)2048 * 1024 * 2;
        S.tile_e = TILEE; S.rowtok = (const int*)(ws + OFF_ROWTOK); S.ntiles = TILEE[1000]; S.nnt = 8; S.G = G; S.c = bid; S.gather = true;
        EpiMoe1 E{(bf16_t*)(ws + OFF_ACT), (const float*)(ws + OFF_ROWRS), p.in[31], p.in[33]};
        gemm_phase<true>(lds, 1024, S, E);
        SEAM(11);
    }
    if (IN(12)) {
        const int* TILEE = (const int*)(ws + OFF_TILEE);
        MoeOrder S; S.A = (const char*)(ws + OFF_ACT); S.Bt = (const char*)(ws + OFF_WD); S.K = 1024; S.estride = (size_t)1024 * 1024 * 2;
        S.tile_e = TILEE; S.rowtok = nullptr; S.ntiles = TILEE[1000]; S.nnt = 4; S.G = G; S.c = bid; S.gather = false;
        EpiMoe2 E{(bf16_t*)p.out, (bf16_t*)(ws + OFF_WGU), (const int*)(ws + OFF_ROWSLOT), (const float*)(ws + OFF_ROWW), p.in[35]};
        gemm_phase<false>(lds, 1024, S, E);
        SEAM(12);
    }
    if (IN(13)) { phase_final(p); }
}

extern "C" void kernel_launch(void* const* d_in, const int* in_sizes, int n_in, void* d_out, int out_size, void* d_ws, size_t ws_size,
                              hipStream_t stream) {
    constexpr size_t kDynLds = 160 * 1024;
    static int grid_blocks = 0;
    if (!grid_blocks) {
        int dev = 0, cus = 0, per_cu = 0;
        (void)hipGetDevice(&dev);
        (void)hipDeviceGetAttribute(&cus, hipDeviceAttributeMultiprocessorCount, dev);
        (void)hipFuncSetAttribute((const void*)mega, hipFuncAttributeMaxDynamicSharedMemorySize, (int)kDynLds);
        (void)hipOccupancyMaxActiveBlocksPerMultiprocessor(&per_cu, mega, 512, kDynLds);
        if (per_cu > 1) per_cu = 1;
        grid_blocks = cus * per_cu;
        fprintf(stderr, "cus=%d per_cu=%d ws_size=%zu need=%zu\n", cus, per_cu, ws_size, (size_t)WS_NEED);
    }
    if (ws_size < WS_NEED || n_in < 37 || grid_blocks < 64) { fprintf(stderr, "kernel_launch: unsupported configuration\n"); return; }
    Params p{};
    for (int i = 0; i < 37; ++i) p.in[i] = (const float*)d_in[i];
    p.out = (float*)d_out;
    p.ws = (unsigned char*)d_ws;
    p.ph_lo = 0; p.ph_hi = N_PHASES;
    void* args[] = {&p};
    hipError_t e = hipLaunchCooperativeKernel((void*)mega, dim3(grid_blocks), dim3(512), args, kDynLds, stream);
    if (e != hipSuccess) fprintf(stderr, "cooperative launch failed: %s (grid %d)\n", hipGetErrorString(e), grid_blocks);
}
```

```cpp
#include <hip/hip_runtime.h>
#include <hip/hip_cooperative_groups.h>
#include <cstdio>
namespace cg = cooperative_groups;

#define LAS __attribute__((address_space(3)))
typedef unsigned short bf16_t;
typedef short bf16x8 __attribute__((ext_vector_type(8)));
typedef float f32x4 __attribute__((ext_vector_type(4)));
typedef float f32x2 __attribute__((ext_vector_type(2)));
typedef unsigned u32x4 __attribute__((ext_vector_type(4)));
typedef unsigned u32x2 __attribute__((ext_vector_type(2)));

constexpr int D = 1024, NBATCH = 8, SEQ = 4096, NMETA = 16;
constexpr int T = NBATCH * SEQ;
constexpr int NR = T + NMETA;
constexpr int NRP = 33024;
constexpr int PCOLS1 = 3584;
constexpr int NCOLS1 = 5632;
constexpr int NE = 32, TOPK = 4, DFF = 1024;
constexpr int MAXROWS = T * TOPK + NE * 256;
constexpr int MAXTILES = MAXROWS / 256;
constexpr float NORM_EPS = 1e-5f, LNX_EPS = 64e-5f;

constexpr int NCHUNK = 257, NUNITS = 64 * NCHUNK;
constexpr int REC_BYTES = 13568;
constexpr int RO_WH = 0, RO_RT = 2048, RO_U0T = 4096, RO_VT = 6144, RO_BKT = 8192, RO_ARK = 12288, RO_WCC = 13312;
constexpr int SLOT_BYTES = 15680, SO_G = 13568, SO_COEF = 15616, NSLOT = 9;
constexpr size_t SZ_ACT = (size_t)MAXROWS * 1024 * 2;
constexpr size_t SZ_WGU = (size_t)NE * 2048 * 1024 * 2;
constexpr size_t SZ_WD = (size_t)NE * 1024 * 1024 * 2;
constexpr size_t SZ_HB = (size_t)T * 1024 * 2;
constexpr size_t OFF_WGU = 0;
constexpr size_t OFF_WD = OFF_WGU + SZ_WGU;
constexpr size_t OFF_ACT = OFF_WD + SZ_WD;
constexpr size_t OFF_HB2 = OFF_ACT + SZ_ACT;
constexpr size_t OFF_RT = OFF_HB2 + SZ_HB;
constexpr size_t OFF_TOPI = OFF_RT;
constexpr size_t OFF_TOPW = OFF_TOPI + (size_t)T * 16;
constexpr size_t OFF_RANK = OFF_TOPW + (size_t)T * 16;
constexpr size_t OFF_RSTD2 = OFF_RANK + (size_t)T * 16;
constexpr size_t OFF_ROWTOK = OFF_RSTD2 + (size_t)T * 4;
constexpr size_t OFF_ROWSLOT = OFF_ROWTOK + (size_t)MAXROWS * 4;
constexpr size_t OFF_ROWW = OFF_ROWSLOT + (size_t)MAXROWS * 4;
constexpr size_t OFF_ROWRS = OFF_ROWW + (size_t)MAXROWS * 4;
constexpr size_t OFF_TILEE = OFF_ROWRS + (size_t)MAXROWS * 4;
constexpr size_t OFF_GCNT = OFF_TILEE + 4096;
constexpr size_t OFF_SM = OFF_GCNT + 256;
constexpr size_t OFF_WR = OFF_SM;
constexpr size_t OFF_WC = OFF_WR + (size_t)1024 * 512 * 2;
constexpr size_t OFF_WO = OFF_WC + (size_t)1024 * 512 * 2;
constexpr size_t OFF_W2 = OFF_WO + (size_t)1024 * 1024 * 2;
constexpr size_t OFF_RSTD1 = OFF_W2 + (size_t)1536 * 256 * 2;
constexpr size_t OFF_WRG = OFF_RSTD1 + (size_t)NRP * 4;
constexpr size_t OFF_BAR = OFF_WRG + (size_t)1024 * 32 * 4;
constexpr size_t WS_NEED = OFF_BAR + 16384;
constexpr size_t OFF_PRKV = 0;
constexpr size_t SZ_PRKV = (size_t)NR * 1536 * 2;
constexpr size_t OFF_LD = OFF_PRKV + SZ_PRKV;
constexpr size_t OFF_A = OFF_LD + (size_t)NRP * 512 * 4;
constexpr size_t OFF_CH = OFF_A + (size_t)NRP * 512 * 2;
constexpr size_t OFF_PCONV = OFF_CH;
constexpr size_t SZ_PCONV = (size_t)NR * 2048 * 2;
constexpr size_t OFF_HB = OFF_PCONV + SZ_PCONV;
constexpr size_t OFF_L = OFF_HB + SZ_HB;
constexpr size_t OFF_WIN = OFF_L + (size_t)NRP * 256 * 2;
constexpr size_t CH_END = OFF_WIN + (size_t)NCOLS1 * 1024 * 2;
constexpr size_t OFF_MERGED = OFF_CH;
constexpr size_t OFF_G = CH_END;
constexpr size_t OFF_C = OFF_G + (size_t)NRP * 512 * 2;
constexpr size_t OFF_Z = OFF_C + (size_t)T * 512 * 2;
constexpr size_t OFF_COEF = OFF_Z + (size_t)T * 512 * 2;
constexpr size_t EARLY_END = OFF_COEF + (size_t)NR * 8 * 4;
static_assert(EARLY_END <= OFF_RT, "early buffers overflow");
static_assert(OFF_CH + (size_t)NUNITS * REC_BYTES <= CH_END, "chunk records overflow");
static_assert(OFF_CH >= OFF_WD + SZ_WD, "expert weights (written during the scan) must not touch live scan buffers");
static_assert(OFF_MERGED + SZ_HB <= OFF_HB2, "layout");
static_assert(OFF_PRKV % 16 == 0 && OFF_LD % 16 == 0 && OFF_A % 16 == 0 && OFF_CH % 16 == 0 && OFF_HB % 16 == 0 && OFF_L % 16 == 0 && OFF_WIN % 16 == 0 && OFF_G % 16 == 0 && OFF_C % 16 == 0 && OFF_Z % 16 == 0 && OFF_COEF % 16 == 0, "align");

struct Params {
    const float* in[37];
    float* out;
    unsigned char* ws;
    int ph_lo, ph_hi;
};

typedef __bf16 bf16x2v __attribute__((ext_vector_type(2)));
__device__ __forceinline__ unsigned cvt_pk_bf16(float lo, float hi) { const f32x2 v = {lo, hi}; return __builtin_bit_cast(unsigned, __builtin_convertvector(v, bf16x2v)); }
__device__ __forceinline__ bf16_t f2bf(float f) { unsigned u = __float_as_uint(f); u += 0x7FFFu + ((u >> 16) & 1u); return (bf16_t)(u >> 16); }
__device__ __forceinline__ float bf2f(bf16_t b) { return __uint_as_float(((unsigned)b) << 16); }
__device__ __forceinline__ float bflo(unsigned w) { return __uint_as_float(w << 16); }
__device__ __forceinline__ float bfhi(unsigned w) { return __uint_as_float(w & 0xFFFF0000u); }
__device__ __forceinline__ float sigmoidf_(float x) { return __builtin_amdgcn_rcpf(1.0f + __expf(-x)); }
__device__ __forceinline__ float wave_sum(float v) {
#pragma unroll
    for (int o = 32; o >= 1; o >>= 1) v += __shfl_xor(v, o);
    return v;
}
__device__ __forceinline__ float wave_sum_dpp(float v);
__device__ __forceinline__ int prev_row(int row, int d) {
    if (row < NMETA) return row - d >= 0 ? row - d : -1;
    const int s = (row - NMETA) & (SEQ - 1);
    return s >= d ? row - d : NMETA + s - d;
}

constexpr int BM = 256, BK = 64, HALF = 128, HTB = HALF * BK * 2, STAGE_BYTES = 8 * HTB, NXCD = 8, WGM = 8;
__device__ __forceinline__ int lds_byte(int r, int c) { const int st = (r >> 4) * 2 + (c >> 5), rr = r & 15, cc = c & 31, ob = rr * 64 + cc * 2; return st * 1024 + (ob ^ (((ob >> 9) & 1) << 5)); }
__device__ __forceinline__ void stage_rc(int b, int& R, int& C) { const int st = b / 1024, sb = b % 1024, swz = sb ^ (((sb >> 9) & 1) << 5); R = (st >> 1) * 16 + swz / 64; C = (st & 1) * 32 + (swz % 64) / 2; }
__device__ __forceinline__ int perm32(int rho) { const int n = rho >> 4, i = rho & 15; return 8 * (i >> 2) + 4 * n + (i & 3); }

struct Unit { int pm, pn, aux; };

struct StaticOrder {
    const char* A; const char* Bt; int K;
    int nM, nN, nwg, G, c;
    __device__ void init(const void* A_, const void* Bt_, int M, int N, int K_, int G_, int c_) { A = (const char*)A_; Bt = (const char*)Bt_; K = K_; nM = M / BM; nN = N / BM; nwg = nM * nN; G = G_; c = c_; }
    __device__ bool next(int i, Unit& u) const {
        const long L = (long)i * G + c; if (L >= nwg) return false;
        int wgid = (int)L; { const int q = nwg / NXCD, r = nwg % NXCD, xcd = wgid % NXCD, off = wgid / NXCD; wgid = (xcd < r ? xcd * (q + 1) : r * (q + 1) + (xcd - r) * q) + off; }
        const int nig = WGM * nN, gid = wgid / nig, fm = gid * WGM, gsz = (nM - fm) < WGM ? (nM - fm) : WGM;
        u.pm = fm + ((wgid % nig) % gsz); u.pn = (wgid % nig) / gsz; u.aux = 0; return true;
    }
    __device__ __forceinline__ const char* a_ptr(const Unit& u) const { return A + (size_t)u.pm * 256 * K * 2; }
    __device__ __forceinline__ const char* b_ptr(const Unit& u) const { return Bt + (size_t)u.pn * 256 * K * 2; }
    __device__ __forceinline__ int gather_row(const Unit&, int) const { return 0; }
};
struct MoeOrder {
    const char* A; const char* Bt; int K; size_t estride;
    const int* tile_e; const int* rowtok; int ntiles, nnt, G, c; bool gather;
    __device__ bool next(int i, Unit& u) const {
        int mt, nt;
        if ((G & 7) == 0 && ((G >> 3) % nnt) == 0) {
            const int x = c & 7, j = c >> 3, per = (G >> 3) / nnt;
            mt = (i * 8 + x) * per + j / nnt; nt = j % nnt;
        } else { const long L = (long)i * G + c; mt = (int)(L / nnt); nt = (int)(L % nnt); }
        if (mt >= ntiles) return false;
        u.pm = mt; u.pn = nt; u.aux = tile_e[mt]; return true;
    }
    __device__ __forceinline__ const char* a_ptr(const Unit& u) const { return gather ? A : A + (size_t)u.pm * 256 * K * 2; }
    __device__ __forceinline__ const char* b_ptr(const Unit& u) const { return Bt + (size_t)u.aux * estride + (size_t)u.pn * 256 * K * 2; }
    __device__ __forceinline__ int gather_row(const Unit& u, int r) const { return rowtok[u.pm * 256 + r]; }
};

template <bool GATHER, class Epi, class Sched>
__device__ __forceinline__ void gemm_phase(LAS unsigned char* lds, const int K_, const Sched& S, const Epi& E) {
    int K = K_; asm volatile("" : "+s"(K));
    const int tid = threadIdx.x, wid = __builtin_amdgcn_readfirstlane(tid >> 6), lane = tid & 63, wr = wid >> 2, wc = wid & 3, fr = lane & 15, fq = lane >> 4;
    const int nt = K / BK;
    unsigned voffA[2], voffB[2]; int Rr[2], Cc[2];
#pragma unroll
    for (int i = 0; i < 2; ++i) { int R, C; stage_rc(tid * 16 + i * 8192, R, C); const int Rb = (R & ~31) + perm32(R & 31);
        Rr[i] = R; Cc[i] = C; voffA[i] = (unsigned)(R * K + C) * 2u; voffB[i] = (unsigned)(Rb * K + C) * 2u; }
    const size_t kstep = (size_t)(BK * 2);
    const size_t hstep = (size_t)HALF * K * 2;
    const unsigned ldsw = (unsigned)wid * 1024u;
    const int aoff = lds_byte(wr * 64 + fr, fq * 8), boff = lds_byte(wc * 32 + fr, fq * 8);
    unsigned vgc[2][2], vgn[2][2];
#define G_SA(b, h) (((b) * 2 + (h)) * HTB)
#define G_SB(b, h) ((4 + (b) * 2 + (h)) * HTB)
#define G_STAGE(bufoff, gbase, voff) do { _Pragma("unroll") for (int _i = 0; _i < 2; ++_i) \
        __builtin_amdgcn_global_load_lds((const unsigned*)((const char*)(gbase) + (voff)[_i]), (LAS unsigned*)(lds + (bufoff) + ldsw + _i * 8192), 16, 0, 0); } while (0)
#define G_STAGE_A(bufoff, kptr, h, VG) do { if (GATHER) { G_STAGE(bufoff, kptr, VG[h]); } else { G_STAGE(bufoff, (kptr) + (h) * hstep, voffA); } } while (0)
#define G_LDA(dst, b, h) do { _Pragma("unroll") for (int m = 0; m < 4; ++m) _Pragma("unroll") for (int k = 0; k < 2; ++k) dst[m][k] = *(const LAS bf16x8*)(lds + G_SA(b, h) + aoff + m * 2048 + k * 1024); } while (0)
#define G_LDB(dst, b, h) do { _Pragma("unroll") for (int n = 0; n < 2; ++n) _Pragma("unroll") for (int k = 0; k < 2; ++k) dst[n][k] = *(const LAS bf16x8*)(lds + G_SB(b, h) + boff + n * 2048 + k * 1024); } while (0)
#define G_MMA(ai, bj, At, Bt) do { __builtin_amdgcn_s_setprio(1); _Pragma("unroll") for (int m = 0; m < 4; ++m) _Pragma("unroll") for (int n = 0; n < 2; ++n) _Pragma("unroll") for (int k = 0; k < 2; ++k) \
        acc[ai][bj][m][n] = __builtin_amdgcn_mfma_f32_16x16x32_bf16(Bt[n][k], At[m][k], acc[ai][bj][m][n], 0, 0, 0); __builtin_amdgcn_s_setprio(0); } while (0)
#define G_WAIT_V(n) asm volatile("s_waitcnt vmcnt(" #n ")" ::: "memory")
#define G_WAIT_L(n) asm volatile("s_waitcnt lgkmcnt(" #n ")" ::: "memory")
#define G_BAR __builtin_amdgcn_s_barrier()
#define G_SCHED __builtin_amdgcn_sched_barrier(0)
    Unit cur, nxt;
    int ui = 0;
    if (!S.next(0, cur)) return;
    f32x4 acc[2][2][4][2];
#pragma unroll
    for (int a = 0; a < 2; ++a)
#pragma unroll
        for (int b = 0; b < 2; ++b)
#pragma unroll
            for (int m = 0; m < 4; ++m)
#pragma unroll
                for (int n = 0; n < 2; ++n) acc[a][b][m][n] = (f32x4){0.f, 0.f, 0.f, 0.f};
    bf16x8 At[4][2], B0[2][2], B1[2][2];
    const char* cA = S.a_ptr(cur); const char* cB = S.b_ptr(cur);
    if (GATHER) {
#pragma unroll
        for (int h = 0; h < 2; ++h)
#pragma unroll
            for (int i = 0; i < 2; ++i) vgc[h][i] = (unsigned)(S.gather_row(cur, h * HALF + Rr[i]) * K + Cc[i]) * 2u;
    }
    G_STAGE(G_SB(0, 0), cB, voffB); G_STAGE_A(G_SA(0, 0), cA, 0, vgc); G_STAGE(G_SB(0, 1), cB + hstep, voffB); G_STAGE_A(G_SA(0, 1), cA, 1, vgc);
    if (wr == 1) G_BAR;
    G_WAIT_V(4); G_BAR;
    G_STAGE(G_SB(1, 0), cB + kstep, voffB); G_STAGE_A(G_SA(1, 0), cA + kstep, 0, vgc); G_STAGE(G_SB(1, 1), cB + hstep + kstep, voffB);
    G_WAIT_V(6); G_BAR;
    for (;;) {
        const bool has_next = S.next(ui + 1, nxt);
        const char* nA = has_next ? S.a_ptr(nxt) : cA; const char* nB = has_next ? S.b_ptr(nxt) : cB;
        if (GATHER) {
#pragma unroll
            for (int h = 0; h < 2; ++h)
#pragma unroll
                for (int i = 0; i < 2; ++i) vgn[h][i] = has_next ? (unsigned)(S.gather_row(nxt, h * HALF + Rr[i]) * K + Cc[i]) * 2u : vgc[h][i];
        }
        for (int t = 0; t < nt; t += 2) {
            const bool last = (t == nt - 2);
            const char* a1 = cA + (size_t)(t + 1) * kstep;
            const char* a2 = last ? nA : cA + (size_t)(t + 2) * kstep; const char* b2 = last ? nB : cB + (size_t)(t + 2) * kstep;
            const char* a3 = a2 + kstep; const char* b3 = b2 + kstep;
            unsigned vg2[2][2];
            if (GATHER) {
#pragma unroll
                for (int h = 0; h < 2; ++h)
#pragma unroll
                    for (int i = 0; i < 2; ++i) vg2[h][i] = last ? vgn[h][i] : vgc[h][i];
            }
            G_LDB(B0, 0, 0); G_SCHED; G_LDA(At, 0, 0); G_STAGE_A(G_SA(1, 1), a1, 1, vgc);
            G_WAIT_L(8); G_BAR; G_WAIT_L(0); G_MMA(0, 0, At, B0); G_BAR; G_SCHED;
            G_LDB(B1, 0, 1); G_STAGE(G_SB(0, 0), b2, voffB);
            G_BAR; G_WAIT_L(0); G_MMA(0, 1, At, B1); G_BAR;
            G_LDA(At, 0, 1); G_STAGE_A(G_SA(0, 0), a2, 0, vg2);
            G_BAR; G_WAIT_L(0); G_MMA(1, 0, At, B0); G_BAR; G_SCHED;
            G_STAGE(G_SB(0, 1), b2 + hstep, voffB);
            G_WAIT_V(6); G_BAR; G_MMA(1, 1, At, B1); G_BAR;
            G_LDB(B0, 1, 0); G_SCHED; G_LDA(At, 1, 0); G_STAGE_A(G_SA(0, 1), a2, 1, vg2);
            G_WAIT_L(8); G_BAR; G_WAIT_L(0); G_MMA(0, 0, At, B0); G_BAR; G_SCHED;
            G_LDB(B1, 1, 1); G_STAGE(G_SB(1, 0), b3, voffB);
            G_BAR; G_WAIT_L(0); G_MMA(0, 1, At, B1); G_BAR;
            G_LDA(At, 1, 1); G_STAGE_A(G_SA(1, 0), a3, 0, vg2);
            G_BAR; G_WAIT_L(0); G_MMA(1, 0, At, B0); G_BAR; G_SCHED;
            G_STAGE(G_SB(1, 1), b3 + hstep, voffB);
            G_WAIT_V(6); G_BAR; G_MMA(1, 1, At, B1); G_BAR;
        }
        E(acc, cur, wr, wc, fr, fq);
        if (!has_next) break;
#pragma unroll
        for (int a = 0; a < 2; ++a)
#pragma unroll
            for (int b = 0; b < 2; ++b)
#pragma unroll
                for (int m = 0; m < 4; ++m)
#pragma unroll
                    for (int n = 0; n < 2; ++n) acc[a][b][m][n] = (f32x4){0.f, 0.f, 0.f, 0.f};
        cur = nxt; cA = nA; cB = nB; ++ui;
        if (GATHER) {
#pragma unroll
            for (int h = 0; h < 2; ++h)
#pragma unroll
                for (int i = 0; i < 2; ++i) vgc[h][i] = vgn[h][i];
        }
    }
    G_WAIT_V(0);
    if (wr == 0) G_BAR;
    G_BAR;
#undef G_SA
#undef G_SB
#undef G_STAGE
#undef G_STAGE_A
#undef G_LDA
#undef G_LDB
#undef G_MMA
#undef G_WAIT_V
#undef G_WAIT_L
#undef G_BAR
#undef G_SCHED
}

struct EpiProj {
    bf16_t* prkv; bf16_t* pconv; bf16_t* gates; const float* rstd1;
    __device__ __forceinline__ void operator()(const f32x4 (&acc)[2][2][4][2], const Unit& u, int wr, int wc, int fr, int fq) const {
        const int row0 = u.pm * BM + wr * 64 + fr;
        const bool isg = u.pn >= 14;
#pragma unroll
        for (int ai = 0; ai < 2; ++ai)
#pragma unroll
            for (int m = 0; m < 4; ++m) {
                const int row = row0 + ai * HALF + m * 16;
                const float rs = rstd1[NMETA + row];
                bf16_t* rowp = isg ? gates + (size_t)row * 2048 + (u.pn - 14) * 256 + wc * 32 + 8 * fq
                             : (u.pn < 6 ? prkv + (size_t)(NMETA + row) * 1536 + u.pn * 256 : pconv + (size_t)(NMETA + row) * 2048 + (u.pn - 6) * 256) + wc * 32 + 8 * fq;
#pragma unroll
                for (int bj = 0; bj < 2; ++bj) {
                    f32x4 v0 = acc[ai][bj][m][0] * rs, v1 = acc[ai][bj][m][1] * rs;
                    if (isg) {
#pragma unroll
                        for (int j = 0; j < 4; ++j) { v0[j] = sigmoidf_(v0[j]); v1[j] = sigmoidf_(v1[j]); }
                    }
                    u32x4 w; w.x = cvt_pk_bf16(v0[0], v0[1]); w.y = cvt_pk_bf16(v0[2], v0[3]); w.z = cvt_pk_bf16(v1[0], v1[1]); w.w = cvt_pk_bf16(v1[2], v1[3]);
                    *(u32x4*)(rowp + bj * HALF) = w;
                }
            }
    }
};
struct EpiL {
    float* LD; bf16_t* Ab; bf16_t* Gb; const float* w0; const float* a0;
    __device__ __forceinline__ void operator()(const f32x4 (&acc)[2][2][4][2], const Unit& u, int wr, int wc, int fr, int fq) const {
        const int row0 = u.pm * BM + wr * 64 + fr;
        const int seg = u.pn >> 1;
        const int cb = (u.pn & 1) * 256 + wc * 32 + 8 * fq;
        const float* bias = seg == 0 ? w0 : a0;
        f32x4 bv[2][2];
#pragma unroll
        for (int bj = 0; bj < 2; ++bj) {
            bv[bj][0] = seg < 2 ? *(const f32x4*)(bias + cb + bj * HALF) : (f32x4){0.f, 0.f, 0.f, 0.f};
            bv[bj][1] = seg < 2 ? *(const f32x4*)(bias + cb + bj * HALF + 4) : (f32x4){0.f, 0.f, 0.f, 0.f};
        }
        const float sc = seg == 0 ? -0.60653065971f : 1.0f;
        bf16_t* ob = seg == 1 ? Ab : Gb;
#pragma unroll
        for (int ai = 0; ai < 2; ++ai)
#pragma unroll
            for (int m = 0; m < 4; ++m) {
                const int row = row0 + ai * HALF + m * 16;
#pragma unroll
                for (int bj = 0; bj < 2; ++bj) {
                    const int c = cb + bj * HALF;
                    f32x4 v0 = acc[ai][bj][m][0] + bv[bj][0], v1 = acc[ai][bj][m][1] + bv[bj][1];
                    if (seg < 2) {
#pragma unroll
                        for (int j = 0; j < 4; ++j) { v0[j] = sc * sigmoidf_(v0[j]); v1[j] = sc * sigmoidf_(v1[j]); }
                    }
                    if (seg == 0) {
                        float* p = LD + (size_t)row * 512 + c;
                        *(f32x4*)p = v0; *(f32x4*)(p + 4) = v1;
                    } else {
                        u32x4 w; w.x = cvt_pk_bf16(v0[0], v0[1]); w.y = cvt_pk_bf16(v0[2], v0[3]); w.z = cvt_pk_bf16(v1[0], v1[1]); w.w = cvt_pk_bf16(v1[2], v1[3]);
                        *(u32x4*)(ob + (size_t)row * 512 + c) = w;
                    }
                }
            }
    }
};
template <int SECOND> struct EpiMerge {
    bf16_t* merged; const bf16_t* gates;
    __device__ __forceinline__ void operator()(const f32x4 (&acc)[2][2][4][2], const Unit& u, int wr, int wc, int fr, int fq) const {
        const int row0 = u.pm * BM + wr * 64 + fr, col0 = u.pn * BM + wc * 32 + 8 * fq;
#pragma unroll
        for (int ai = 0; ai < 2; ++ai)
#pragma unroll
            for (int m = 0; m < 4; ++m) {
                const int row = row0 + ai * HALF + m * 16;
#pragma unroll
                for (int bj = 0; bj < 2; ++bj) {
                    const int c = col0 + bj * HALF;
                    const u32x4 gw = *(const u32x4*)(gates + (size_t)row * 2048 + SECOND * 1024 + c);
                    f32x4 g0 = (f32x4){bflo(gw.x), bfhi(gw.x), bflo(gw.y), bfhi(gw.y)}, g1 = (f32x4){bflo(gw.z), bfhi(gw.z), bflo(gw.w), bfhi(gw.w)};
                    f32x4 v0 = acc[ai][bj][m][0] * g0, v1 = acc[ai][bj][m][1] * g1;
                    bf16_t* p = merged + (size_t)row * 1024 + c;
                    if (SECOND) {
                        const u32x4 ow = *(const u32x4*)p;
                        v0 += (f32x4){bflo(ow.x), bfhi(ow.x), bflo(ow.y), bfhi(ow.y)}; v1 += (f32x4){bflo(ow.z), bfhi(ow.z), bflo(ow.w), bfhi(ow.w)};
                    }
                    u32x4 w; w.x = cvt_pk_bf16(v0[0], v0[1]); w.y = cvt_pk_bf16(v0[2], v0[3]); w.z = cvt_pk_bf16(v1[0], v1[1]); w.w = cvt_pk_bf16(v1[2], v1[3]);
                    *(u32x4*)p = w;
                }
            }
    }
};
struct EpiO {
    const float* x; float* h1; bf16_t* hb2;
    __device__ __forceinline__ void operator()(const f32x4 (&acc)[2][2][4][2], const Unit& u, int wr, int wc, int fr, int fq) const {
        const int row0 = u.pm * BM + wr * 64 + fr, col0 = u.pn * BM + wc * 32 + 8 * fq;
#pragma unroll
        for (int ai = 0; ai < 2; ++ai)
#pragma unroll
            for (int m = 0; m < 4; ++m) {
                const int row = row0 + ai * HALF + m * 16;
#pragma unroll
                for (int bj = 0; bj < 2; ++bj) {
                    const size_t o = (size_t)row * 1024 + col0 + bj * HALF;
                    const f32x4 v0 = acc[ai][bj][m][0] + *(const f32x4*)(x + o), v1 = acc[ai][bj][m][1] + *(const f32x4*)(x + o + 4);
                    *(f32x4*)(h1 + o) = v0; *(f32x4*)(h1 + o + 4) = v1;
                    u32x4 w; w.x = cvt_pk_bf16(v0[0], v0[1]); w.y = cvt_pk_bf16(v0[2], v0[3]); w.z = cvt_pk_bf16(v1[0], v1[1]); w.w = cvt_pk_bf16(v1[2], v1[3]);
                    *(u32x4*)(hb2 + o) = w;
                }
            }
    }
};
struct EpiMoe1 {
    bf16_t* act; const float* rowrs; const float* bg; const float* bu;
    __device__ __forceinline__ void operator()(const f32x4 (&acc)[2][2][4][2], const Unit& u, int wr, int wc, int fr, int fq) const {
        const int row0 = u.pm * BM + wr * 64 + fr, ff0 = u.pn * 128 + wc * 32 + 8 * fq;
        const float* bgp = bg + (size_t)u.aux * DFF + ff0; const float* bup = bu + (size_t)u.aux * DFF + ff0;
        const f32x4 bg0 = *(const f32x4*)bgp, bg1 = *(const f32x4*)(bgp + 4), bu0 = *(const f32x4*)bup, bu1 = *(const f32x4*)(bup + 4);
#pragma unroll
        for (int ai = 0; ai < 2; ++ai)
#pragma unroll
            for (int m = 0; m < 4; ++m) {
                const int row = row0 + ai * HALF + m * 16;
                const float rs = rowrs[row];
                f32x4 g0 = acc[ai][0][m][0] * rs + bg0, g1 = acc[ai][0][m][1] * rs + bg1, u0 = acc[ai][1][m][0] * rs + bu0, u1 = acc[ai][1][m][1] * rs + bu1;
                f32x4 r0, r1;
#pragma unroll
                for (int j = 0; j < 4; ++j) {
                    { const float gt = fminf(g0[j], 7.0f), up = fminf(fmaxf(u0[j], -7.0f), 7.0f); r0[j] = (up + 1.0f) * gt * sigmoidf_(1.702f * gt); }
                    { const float gt = fminf(g1[j], 7.0f), up = fminf(fmaxf(u1[j], -7.0f), 7.0f); r1[j] = (up + 1.0f) * gt * sigmoidf_(1.702f * gt); }
                }
                u32x4 w; w.x = cvt_pk_bf16(r0[0], r0[1]); w.y = cvt_pk_bf16(r0[2], r0[3]); w.z = cvt_pk_bf16(r1[0], r1[1]); w.w = cvt_pk_bf16(r1[2], r1[3]);
                *(u32x4*)(act + (size_t)row * DFF + ff0) = w;
            }
    }
};
struct EpiMoe2 {
    bf16_t* ya; bf16_t* yb; const int* rowslot; const float* roww; const float* bd;
    __device__ __forceinline__ void operator()(const f32x4 (&acc)[2][2][4][2], const Unit& u, int wr, int wc, int fr, int fq) const {
        const int row0 = u.pm * BM + wr * 64 + fr, col0 = u.pn * BM + wc * 32 + 8 * fq;
        bf16_t* ybase = (u.pn < 2) ? ya : yb; const int yc0 = col0 & 511;
        const float* bp = bd + (size_t)u.aux * D + col0;
        f32x4 bv[2][2];
#pragma unroll
        for (int bj = 0; bj < 2; ++bj) { bv[bj][0] = *(const f32x4*)(bp + bj * HALF); bv[bj][1] = *(const f32x4*)(bp + bj * HALF + 4); }
#pragma unroll
        for (int ai = 0; ai < 2; ++ai)
#pragma unroll
            for (int m = 0; m < 4; ++m) {
                const int row = row0 + ai * HALF + m * 16;
                const int slot = rowslot[row];
                if (slot >= 0) {
                    const float w8 = roww[row];
#pragma unroll
                    for (int bj = 0; bj < 2; ++bj) {
                        const f32x4 v0 = (acc[ai][bj][m][0] + bv[bj][0]) * w8, v1 = (acc[ai][bj][m][1] + bv[bj][1]) * w8;
                        u32x4 w; w.x = cvt_pk_bf16(v0[0], v0[1]); w.y = cvt_pk_bf16(v0[2], v0[3]); w.z = cvt_pk_bf16(v1[0], v1[1]); w.w = cvt_pk_bf16(v1[2], v1[3]);
                        *(u32x4*)(ybase + (size_t)slot * 512 + yc0 + bj * HALF) = w;
                    }
                }
            }
    }
};

__device__ __forceinline__ void transpose_tile(LAS float* tile, const float* src, int ldsrc, int k0, int n0, bf16_t* dst, int ldd, int drow0, const float* sa, const float* mu, int mode, bool zero) {
    const int tid = threadIdx.x;
    if (!zero) {
#pragma unroll
        for (int i = 0; i < 2; ++i) {
            const int r = (tid >> 4) + 32 * i, c4 = (tid & 15) * 4;
            const f32x4 v = *(const f32x4*)(src + (size_t)(k0 + r) * ldsrc + n0 + c4);
            LAS float* t = tile + r * 65 + c4;
            t[0] = v[0]; t[1] = v[1]; t[2] = v[2]; t[3] = v[3];
        }
    }
    __syncthreads();
    {
        const int n = tid >> 3, kq = tid & 7;
        float v[8];
#pragma unroll
        for (int j = 0; j < 8; ++j) {
            const int k = k0 + 8 * kq + j;
            float s = sa ? sa[k] : 1.0f;
            if (mode == 1) s *= (1.0f - mu[k]);
            if (mode == 2) s *= mu[k];
            v[j] = zero ? 0.f : tile[(8 * kq + j) * 65 + n] * s;
        }
        u32x4 w; w.x = cvt_pk_bf16(v[0], v[1]); w.y = cvt_pk_bf16(v[2], v[3]); w.z = cvt_pk_bf16(v[4], v[5]); w.w = cvt_pk_bf16(v[6], v[7]);
        *(u32x4*)(dst + (size_t)(drow0 + n) * ldd + k0 + 8 * kq) = w;
    }
    __syncthreads();
}

__device__ __forceinline__ void phase_prep(const Params& p, LAS unsigned char* lds) {
    const int tid = threadIdx.x, bid = blockIdx.x, nb = gridDim.x, lane = tid & 63, wave = tid >> 6;
    unsigned char* ws = p.ws;
    const float* x = p.in[0]; const float* meta = p.in[1]; const float* g1 = p.in[2];
    if (bid == 0 && tid < 64) ((int*)(ws + OFF_GCNT))[tid] = 0;
    {
        bf16_t* HB = (bf16_t*)(ws + OFF_HB); float* rstd1 = (float*)(ws + OFF_RSTD1);
        for (int row = bid * 8 + wave; row < NR; row += nb * 8) {
            const float* src = row < NMETA ? meta + (size_t)row * D : x + (size_t)(row - NMETA) * D;
            float ss = 0.f; f32x4 v[4];
#pragma unroll
            for (int i = 0; i < 4; ++i) { v[i] = *(const f32x4*)(src + i * 256 + lane * 4); ss += v[i][0] * v[i][0] + v[i][1] * v[i][1] + v[i][2] * v[i][2] + v[i][3] * v[i][3]; }
            ss = wave_sum(ss);
            if (lane == 0) rstd1[row] = rsqrtf(ss * (1.0f / D) + NORM_EPS);
            if (row >= NMETA) {
                bf16_t* d = HB + (size_t)(row - NMETA) * D;
#pragma unroll
                for (int i = 0; i < 4; ++i) { u32x2 w; w.x = cvt_pk_bf16(v[i][0], v[i][1]); w.y = cvt_pk_bf16(v[i][2], v[i][3]); *(u32x2*)(d + i * 256 + lane * 4) = w; }
            }
        }
    }
    LAS float* tile = (LAS float*)lds;
    {
        bf16_t* WIN = (bf16_t*)(ws + OFF_WIN);
        const float* w_in = p.in[3];
        for (int j = bid; j < 16 * 88; j += nb) {
            const int kt = j & 15, ntile = j >> 4, n0 = ntile * 64;
            const float* src; int ld, sn0, mode = 0; const float* mu = nullptr;
            if (n0 < 3072) { src = w_in; ld = 5120; sn0 = n0; }
            else if (n0 < 3584) {
                const int seg = (n0 - 3072) >> 6;
                if (seg < 2) { src = p.in[11]; ld = 64; sn0 = 0; mu = p.in[7]; mode = 1 + seg; }
                else if (seg < 4) { src = p.in[14]; ld = 64; sn0 = 0; mu = p.in[8]; mode = 1 + (seg - 2); }
                else { src = p.in[16]; ld = 128; sn0 = (seg & 1) * 64; mu = p.in[9]; mode = seg < 6 ? 1 : 2; }
            } else { src = w_in; ld = 5120; sn0 = n0 - 512; }
            transpose_tile(tile, src, ld, kt * 64, sn0, WIN, 1024, n0, g1, mu, mode, false);
        }
        for (int j = bid; j < 2 * 128; j += nb) {
            const int which = j >> 7, jj = j & 127, kt = jj & 7, ntile = jj >> 3;
            transpose_tile(tile, which ? p.in[25] : p.in[23], 1024, kt * 64, ntile * 64, (bf16_t*)(ws + (which ? OFF_WC : OFF_WR)), 512, ntile * 64, nullptr, nullptr, 0, false);
        }
        for (int j = bid; j < 256; j += nb) {
            const int kt = j & 15, ntile = j >> 4;
            transpose_tile(tile, p.in[26], 1024, kt * 64, ntile * 64, (bf16_t*)(ws + OFF_WO), 1024, ntile * 64, nullptr, nullptr, 0, false);
        }
        for (int j = bid; j < 96; j += nb) {
            const int kt = j & 3, ntile = j >> 2, seg = ntile >> 3, nn0 = (ntile & 7) * 64;
            const float* src = nullptr; int sk0 = 0; bool zero = true;
            if (seg == 0 && kt == 0) { src = p.in[12]; sk0 = 0; zero = false; }
            if (seg == 1 && kt == 1) { src = p.in[15]; sk0 = 0; zero = false; }
            if (seg == 2 && kt >= 2) { src = p.in[17]; sk0 = (kt - 2) * 64; zero = false; }
            const float* srcs = zero ? p.in[12] : src + (size_t)(sk0 - kt * 64) * 512;
            transpose_tile(tile, srcs, 512, kt * 64, nn0, (bf16_t*)(ws + OFF_W2), 256, ntile * 64, nullptr, nullptr, 0, zero);
        }
        {
            float* WRG = (float*)(ws + OFF_WRG); const float* g2 = p.in[27]; const float* wr_ = p.in[28];
            for (int i = bid * 512 + tid; i < 1024 * 32; i += nb * 512) WRG[i] = g2[i >> 5] * wr_[i];
        }
    }
}

__device__ __forceinline__ void phase_meta_proj(const Params& p, LAS unsigned char* lds) {
    const int tid = threadIdx.x, bid = blockIdx.x, lane = tid & 63, wave = tid >> 6;
    unsigned char* ws = p.ws;
    LAS float* sm = (LAS float*)lds;
    const float* meta = p.in[1];
    for (int i = tid; i < 16 * 256; i += 512) { const int r = i >> 8, c4 = (i & 255) * 4; const f32x4 v = *(const f32x4*)(meta + r * 1024 + c4); LAS float* d = sm + r * 1028 + c4; d[0] = v[0]; d[1] = v[1]; d[2] = v[2]; d[3] = v[3]; }
    __syncthreads();
    const float* rstd1 = (const float*)(ws + OFF_RSTD1);
    for (int nbase = bid * 14; nbase < PCOLS1; nbase += gridDim.x * 14) {
        for (int nn = wave; nn < 14; nn += 8) {
            const int n = nbase + nn;
            if (n >= PCOLS1) break;
            const bf16_t* wrow = (const bf16_t*)(ws + OFF_WIN) + (size_t)n * 1024;
            const u32x4 w0 = *(const u32x4*)(wrow + 8 * lane), w1 = *(const u32x4*)(wrow + 512 + 8 * lane);
            const float wf[16] = {bflo(w0.x), bfhi(w0.x), bflo(w0.y), bfhi(w0.y), bflo(w0.z), bfhi(w0.z), bflo(w0.w), bfhi(w0.w),
                                  bflo(w1.x), bfhi(w1.x), bflo(w1.y), bfhi(w1.y), bflo(w1.z), bfhi(w1.z), bflo(w1.w), bfhi(w1.w)};
            float outv = 0.f;
#pragma unroll
            for (int pr = 0; pr < 16; ++pr) {
                const LAS float* m0 = sm + pr * 1028 + 8 * lane;
                const f32x4 a0 = *(const LAS f32x4*)m0, a1 = *(const LAS f32x4*)(m0 + 4), a2 = *(const LAS f32x4*)(m0 + 512), a3 = *(const LAS f32x4*)(m0 + 516);
                float acc = a0[0] * wf[0] + a0[1] * wf[1] + a0[2] * wf[2] + a0[3] * wf[3] + a1[0] * wf[4] + a1[1] * wf[5] + a1[2] * wf[6] + a1[3] * wf[7]
                          + a2[0] * wf[8] + a2[1] * wf[9] + a2[2] * wf[10] + a2[3] * wf[11] + a3[0] * wf[12] + a3[1] * wf[13] + a3[2] * wf[14] + a3[3] * wf[15];
                acc = wave_sum_dpp(acc);
                outv = (lane == pr) ? acc * rstd1[pr] : outv;
            }
            if (lane < 16) {
                if (n < 1536) ((bf16_t*)(ws + OFF_PRKV))[(size_t)lane * 1536 + n] = f2bf(outv);
                else ((bf16_t*)(ws + OFF_PCONV))[(size_t)lane * 2048 + n - 1536] = f2bf(outv);
            }
        }
    }
    __syncthreads();
}

__device__ __forceinline__ void phase_lprep_conv(const Params& p) {
    const int tid = threadIdx.x, bid = blockIdx.x, nb = gridDim.x;
    unsigned char* ws = p.ws;
    const bf16_t* PROJ = (const bf16_t*)(ws + OFF_PCONV);
    constexpr int PCOLS = 2048;
    bf16_t* L = (bf16_t*)(ws + OFF_L);
    for (int i = bid * 512 + tid; i < NRP * 32; i += nb * 512) {
        const int row = i >> 5, gq = i & 31;
        u32x4 w = (u32x4){0u, 0u, 0u, 0u};
        if (row < NR) {
            int ca, cb;
            if (gq < 8) { ca = 1536 + gq * 8; cb = ca + 64; }
            else if (gq < 16) { ca = 1536 + 128 + (gq - 8) * 8; cb = ca + 64; }
            else { ca = 1536 + 256 + (gq - 16) * 8; cb = ca + 128; }
            const u32x4 va = *(const u32x4*)(PROJ + (size_t)row * PCOLS + ca);
            const int pr = prev_row(row, 1);
            u32x4 vb = (u32x4){0u, 0u, 0u, 0u};
            if (pr >= 0) vb = *(const u32x4*)(PROJ + (size_t)pr * PCOLS + cb);
            float v[8] = {bflo(va.x) + bflo(vb.x), bfhi(va.x) + bfhi(vb.x), bflo(va.y) + bflo(vb.y), bfhi(va.y) + bfhi(vb.y), bflo(va.z) + bflo(vb.z), bfhi(va.z) + bfhi(vb.z), bflo(va.w) + bflo(vb.w), bfhi(va.w) + bfhi(vb.w)};
#pragma unroll
            for (int j = 0; j < 8; ++j) { if (gq < 8) v[j] = tanhf(v[j]); else if (gq >= 16) v[j] = sigmoidf_(v[j]); }
            w.x = cvt_pk_bf16(v[0], v[1]); w.y = cvt_pk_bf16(v[2], v[3]); w.z = cvt_pk_bf16(v[4], v[5]); w.w = cvt_pk_bf16(v[6], v[7]);
        }
        *(u32x4*)(L + (size_t)row * 256 + gq * 8) = w;
    }
    bf16_t* C = (bf16_t*)(ws + OFF_C);
    const float* cw = p.in[24];
    for (int i = bid * 512 + tid; i < T * 64; i += nb * 512) {
        const int m = i >> 6, ch = (i & 63) * 8, row = NMETA + m;
        const int r1 = prev_row(row, 1), r2 = prev_row(row, 2);
        const bf16_t* p0 = PROJ + (size_t)row * PCOLS; const bf16_t* p1 = PROJ + (size_t)r1 * PCOLS; const bf16_t* p2 = PROJ + (size_t)r2 * PCOLS;
        const u32x4 vb = *(const u32x4*)(p0 + ch);
        const u32x4 c0 = *(const u32x4*)(p0 + 512 + ch), h0 = *(const u32x4*)(p0 + 1024 + ch);
        const u32x4 c1 = *(const u32x4*)(p1 + 512 + ch), h1 = *(const u32x4*)(p1 + 1024 + ch);
        const u32x4 c2 = *(const u32x4*)(p2 + 512 + ch), h2 = *(const u32x4*)(p2 + 1024 + ch);
        float o[8];
#pragma unroll
        for (int j = 0; j < 8; ++j) {
            const unsigned wb = j < 2 ? vb.x : j < 4 ? vb.y : j < 6 ? vb.z : vb.w;
            const unsigned wc0 = j < 2 ? c0.x : j < 4 ? c0.y : j < 6 ? c0.z : c0.w, wh0 = j < 2 ? h0.x : j < 4 ? h0.y : j < 6 ? h0.z : h0.w;
            const unsigned wc1 = j < 2 ? c1.x : j < 4 ? c1.y : j < 6 ? c1.z : c1.w, wh1 = j < 2 ? h1.x : j < 4 ? h1.y : j < 6 ? h1.z : h1.w;
            const unsigned wc2 = j < 2 ? c2.x : j < 4 ? c2.y : j < 6 ? c2.z : c2.w, wh2 = j < 2 ? h2.x : j < 4 ? h2.y : j < 6 ? h2.z : h2.w;
            const bool hi = j & 1;
            const float b = hi ? bfhi(wb) : bflo(wb);
            const float u0 = (hi ? bfhi(wc0) : bflo(wc0)) * (hi ? bfhi(wh0) : bflo(wh0));
            const float u1 = (hi ? bfhi(wc1) : bflo(wc1)) * (hi ? bfhi(wh1) : bflo(wh1));
            const float u2 = (hi ? bfhi(wc2) : bflo(wc2)) * (hi ? bfhi(wh2) : bflo(wh2));
            const float conv = cw[ch + j] * u2 + cw[512 + ch + j] * u1 + cw[1024 + ch + j] * u0;
            o[j] = b * conv;
        }
        u32x4 w; w.x = cvt_pk_bf16(o[0], o[1]); w.y = cvt_pk_bf16(o[2], o[3]); w.z = cvt_pk_bf16(o[4], o[5]); w.w = cvt_pk_bf16(o[6], o[7]);
        *(u32x4*)(C + (size_t)m * 512 + ch) = w;
    }
}

template <int CTRL> __device__ __forceinline__ float dppmov(float v) { return __builtin_bit_cast(float, __builtin_amdgcn_update_dpp(0, __builtin_bit_cast(int, v), CTRL, 0xF, 0xF, true)); }
__device__ __forceinline__ float wave_sum_dpp(float v) {
    v += dppmov<0xB1>(v);
    v += dppmov<0x4E>(v);
    v += dppmov<0x141>(v);
    v += dppmov<0x140>(v);
    { float c = v; asm volatile("v_nop\n\tv_nop\n\tv_permlane16_swap_b32 %0, %1\n\tv_nop\n\tv_nop" : "+v"(v), "+v"(c)); v += c; }
    { float c = v; asm volatile("v_nop\n\tv_nop\n\tv_permlane32_swap_b32 %0, %1\n\tv_nop\n\tv_nop" : "+v"(v), "+v"(c)); v += c; }
    return v;
}
typedef float f32x16 __attribute__((ext_vector_type(16)));

struct RawTok { bf16_t r, k, v, a; float ld; };
__device__ __forceinline__ RawTok load_raw(const bf16_t* PRKV, const bf16_t* Ab, const float* LD, int row, int col) {
    RawTok q; const bf16_t* p0 = PRKV + (size_t)row * 1536 + col;
    q.r = p0[0]; q.k = p0[512]; q.v = p0[1024]; q.a = Ab[(size_t)row * 512 + col]; q.ld = LD[(size_t)row * 512 + col];
    return q;
}
__device__ __forceinline__ void unit_geom(int uid, int lane, int& b, int& h, int& c, int& col, int& row0) {
    const int bh = uid / NCHUNK; c = uid - bh * NCHUNK; b = bh >> 3; h = bh & 7; col = h * 64 + lane;
    row0 = c == 0 ? 0 : b * SEQ + c * 16;
}
__device__ __forceinline__ void phase_scanprep(const Params& p, LAS unsigned char* lds) {
    const int tid = threadIdx.x, bid = blockIdx.x, nb = gridDim.x, lane = tid & 63, wave = tid >> 6;
    unsigned char* ws = p.ws;
    const bf16_t* PRKV = (const bf16_t*)(ws + OFF_PRKV);
    const float* LD = (const float*)(ws + OFF_LD);
    const bf16_t* Ab = (const bf16_t*)(ws + OFF_A);
    float* COEF = (float*)(ws + OFF_COEF);
    LAS unsigned char* wl = lds + wave * 13824;
    LAS bf16_t* AR = (LAS bf16_t*)wl;
    LAS bf16_t* BK = (LAS bf16_t*)(wl + 4608);
    LAS float* DM = (LAS float*)(wl + 9216);
    const int qperm = (lane & 32) | (((lane >> 2) & 3) << 3) | (((lane >> 4) & 1) << 2) | (lane & 3);
    int uid = bid * 8 + wave;
    if (uid >= NUNITS) return;
    int b, h, c, col, row0;
    unit_geom(uid, lane, b, h, c, col, row0);
    RawTok q[16];
    bf16_t prr = 0, prk = 0, prv = 0;
#pragma unroll
    for (int t = 0; t < 4; ++t) q[t] = load_raw(PRKV, Ab, LD, row0 + t, col);
    { const int pr = prev_row(row0, 1); if (pr >= 0) { const bf16_t* p1 = PRKV + (size_t)pr * 1536 + col; prr = p1[0]; prk = p1[512]; prv = p1[1024]; } }
    for (;;) {
        const float mur = p.in[4][col], muk = p.in[5][col], muv = p.in[6][col], kkw = p.in[18][col], kaw = p.in[19][col], rkw = p.in[20][col];
        const int nuid = uid + nb * 8; const bool has_next = nuid < NUNITS;
        int nb_, nh, nc, ncol = col, nrow0 = row0;
        if (has_next) unit_geom(nuid, lane, nb_, nh, nc, ncol, nrow0);
        float at[16], vt[16]; unsigned btp[8], ktp[8]; float bprev = 0.f, kprev = 0.f;
        float cl = 0.f;
        float rp = bf2f(prr), kp = bf2f(prk), vp = bf2f(prv);
#pragma unroll
        for (int t = 0; t < 16; ++t) {
            if (t < 12) q[t + 4] = load_raw(PRKV, Ab, LD, row0 + t + 4, col);
            else if (has_next) q[t - 12] = load_raw(PRKV, Ab, LD, nrow0 + t - 12, ncol);
            if (t == 15 && has_next) { prr = 0; prk = 0; prv = 0; const int pr = prev_row(nrow0, 1); if (pr >= 0) { const bf16_t* p1 = PRKV + (size_t)pr * 1536 + ncol; prr = p1[0]; prk = p1[512]; prv = p1[1024]; } }
            const RawTok qq = q[t < 12 ? t : t];
            const int row = row0 + t;
            const float r0 = bf2f(qq.r), k0 = bf2f(qq.k), v0 = bf2f(qq.v);
            const float r = r0 + (rp - r0) * mur, k = k0 + (kp - k0) * muk, v = v0 + (vp - v0) * muv;
            rp = r0; kp = k0; vp = v0;
            const float a = bf2f(qq.a);
            const float kkv = k * kkw;
            const float n2 = wave_sum_dpp(kkv * kkv);
            const float kk = kkv * __builtin_amdgcn_rsqf(fmaxf(n2, 1e-24f));
            const float k2 = k * (1.0f + (a - 1.0f) * kaw);
            const float cf = wave_sum_dpp(r * k2 * rkw);
            if (lane == 0) COEF[(size_t)row * 8 + h] = cf;
            const float wcp = __expf(cl);
            cl += qq.ld;
            const float wcn = __expf(cl), iw = __expf(-cl);
            const float btv = kk * a * iw, ktv = k2 * iw;
            at[t] = -kk * wcp; vt[t] = v;
            { const unsigned w = cvt_pk_bf16(at[t], r * wcn); AR[t * 72 + qperm] = (bf16_t)(w & 0xFFFFu); AR[(16 + t) * 72 + qperm] = (bf16_t)(w >> 16); }
            if (t & 1) {
                btp[t >> 1] = cvt_pk_bf16(bprev, btv); ktp[t >> 1] = cvt_pk_bf16(kprev, ktv);
                BK[(t - 1) * 72 + qperm] = (bf16_t)(btp[t >> 1] & 0xFFFFu); BK[t * 72 + qperm] = (bf16_t)(btp[t >> 1] >> 16);
                BK[(16 + t - 1) * 72 + qperm] = (bf16_t)(ktp[t >> 1] & 0xFFFFu); BK[(16 + t) * 72 + qperm] = (bf16_t)(ktp[t >> 1] >> 16);
            } else { bprev = btv; kprev = ktv; }
            __builtin_amdgcn_sched_barrier(0);
        }
        const float wcc = __expf(cl);
        {
            f32x16 dm;
#pragma unroll
            for (int i = 0; i < 16; ++i) dm[i] = 0.f;
            const int rr = lane & 31, hh = lane >> 5;
#pragma unroll
            for (int ks = 0; ks < 4; ++ks) {
                const bf16x8 fa = *(const LAS bf16x8*)(AR + rr * 72 + 16 * ks + 8 * hh);
                const bf16x8 fb = *(const LAS bf16x8*)(BK + rr * 72 + 16 * ks + 8 * hh);
                dm = __builtin_amdgcn_mfma_f32_32x32x16_bf16(fa, fb, dm, 0, 0, 0);
            }
#pragma unroll
            for (int reg = 0; reg < 16; ++reg) DM[((reg & 3) + 8 * (reg >> 2) + 4 * hh) * 36 + rr] = dm[reg];
        }
        __builtin_amdgcn_sched_barrier(0);
        float uh[16];
#pragma unroll
        for (int t = 0; t < 16; ++t) {
            float wv = at[t], uv = 0.f;
#pragma unroll
            for (int s4 = 0; s4 < 4; ++s4) {
                if (s4 * 4 < t) {
                    const f32x4 ab = *(const LAS f32x4*)(DM + t * 36 + s4 * 4), ak = *(const LAS f32x4*)(DM + t * 36 + 16 + s4 * 4);
#pragma unroll
                    for (int j = 0; j < 4; ++j) {
                        const int s_ = s4 * 4 + j;
                        if (s_ < t) { wv += ab[j] * at[s_]; uv += ak[j] * vt[s_] + ab[j] * uh[s_]; }
                    }
                }
            }
            at[t] = wv; uh[t] = uv;
            asm volatile("" : "+v"(at[t]), "+v"(uh[t]));
        }
        __builtin_amdgcn_sched_barrier(0);
#pragma unroll
        for (int t = 0; t < 16; t += 2) { const unsigned w = cvt_pk_bf16(at[t], at[t + 1]); AR[t * 72 + qperm] = (bf16_t)(w & 0xFFFFu); AR[(t + 1) * 72 + qperm] = (bf16_t)(w >> 16); }
        unsigned char* rec = ws + OFF_CH + (size_t)uid * REC_BYTES;
#pragma unroll
        for (int i = 0; i < 2; ++i) {
            const int pc = i * 64 + lane, row = pc >> 3, part = pc & 7;
            *(u32x4*)(rec + RO_WH + pc * 16) = *(const LAS u32x4*)((LAS unsigned char*)AR + row * 144 + part * 16);
            *(u32x4*)(rec + RO_RT + pc * 16) = *(const LAS u32x4*)((LAS unsigned char*)AR + (16 + row) * 144 + part * 16);
        }
        {
            u32x4 w0, w1;
            w0.x = cvt_pk_bf16(uh[0], uh[1]); w0.y = cvt_pk_bf16(uh[2], uh[3]); w0.z = cvt_pk_bf16(uh[4], uh[5]); w0.w = cvt_pk_bf16(uh[6], uh[7]);
            w1.x = cvt_pk_bf16(uh[8], uh[9]); w1.y = cvt_pk_bf16(uh[10], uh[11]); w1.z = cvt_pk_bf16(uh[12], uh[13]); w1.w = cvt_pk_bf16(uh[14], uh[15]);
            *(u32x4*)(rec + RO_U0T + lane * 32) = w0; *(u32x4*)(rec + RO_U0T + lane * 32 + 16) = w1;
            w0.x = cvt_pk_bf16(vt[0], vt[1]); w0.y = cvt_pk_bf16(vt[2], vt[3]); w0.z = cvt_pk_bf16(vt[4], vt[5]); w0.w = cvt_pk_bf16(vt[6], vt[7]);
            w1.x = cvt_pk_bf16(vt[8], vt[9]); w1.y = cvt_pk_bf16(vt[10], vt[11]); w1.z = cvt_pk_bf16(vt[12], vt[13]); w1.w = cvt_pk_bf16(vt[14], vt[15]);
            *(u32x4*)(rec + RO_VT + lane * 32) = w0; *(u32x4*)(rec + RO_VT + lane * 32 + 16) = w1;
        }
#pragma unroll
        for (int g = 0; g < 4; ++g) {
            u32x4 w; w.x = btp[2 * g]; w.y = btp[2 * g + 1]; w.z = ktp[2 * g]; w.w = ktp[2 * g + 1];
            *(u32x4*)(rec + RO_BKT + lane * 64 + g * 16) = w;
        }
        {
            const int t = lane >> 2, g = lane & 3;
            const f32x4 rb = *(const LAS f32x4*)(DM + (16 + t) * 36 + 4 * g), rk = *(const LAS f32x4*)(DM + (16 + t) * 36 + 16 + 4 * g);
            float o[8];
#pragma unroll
            for (int j = 0; j < 4; ++j) { const bool keep = (4 * g + j) <= t; o[j] = keep ? rb[j] : 0.f; o[4 + j] = keep ? rk[j] : 0.f; }
            u32x4 w; w.x = cvt_pk_bf16(o[0], o[1]); w.y = cvt_pk_bf16(o[2], o[3]); w.z = cvt_pk_bf16(o[4], o[5]); w.w = cvt_pk_bf16(o[6], o[7]);
            *(u32x4*)(rec + RO_ARK + t * 64 + g * 16) = w;
        }
        *(float*)(rec + RO_WCC + lane * 4) = wcc;
        if (!has_next) break;
        uid = nuid; b = nb_; h = nh; c = nc; col = ncol; row0 = nrow0;
        __builtin_amdgcn_sched_barrier(0);
    }
}

__device__ __forceinline__ void convert_expert_weights(const Params& p, LAS unsigned char* lds, int first, int stride);
struct RecOps { bf16x8 wA0, wA1, rA0, rA1, ark, bk[4]; u32x2 u0, vv; f32x4 wc[4]; };
__device__ __forceinline__ void load_ops(RecOps& o, LAS unsigned char* S, int vs, int fr, int g) {
    o.wA0 = *(const LAS bf16x8*)(S + RO_WH + fr * 128 + g * 16); o.wA1 = *(const LAS bf16x8*)(S + RO_WH + fr * 128 + 64 + g * 16);
    o.rA0 = *(const LAS bf16x8*)(S + RO_RT + fr * 128 + g * 16); o.rA1 = *(const LAS bf16x8*)(S + RO_RT + fr * 128 + 64 + g * 16);
    o.u0 = *(const LAS u32x2*)(S + RO_U0T + (16 * vs + fr) * 32 + g * 8);
    o.vv = *(const LAS u32x2*)(S + RO_VT + (16 * vs + fr) * 32 + g * 8);
    o.ark = *(const LAS bf16x8*)(S + RO_ARK + fr * 64 + g * 16);
#pragma unroll
    for (int m = 0; m < 4; ++m) { o.bk[m] = *(const LAS bf16x8*)(S + RO_BKT + (16 * m + fr) * 64 + g * 16); o.wc[m] = *(const LAS f32x4*)(S + RO_WCC + (16 * m + 4 * g) * 4); }
}
__device__ __forceinline__ void phase_recur(const Params& p, LAS unsigned char* lds) {
    const int tid = threadIdx.x, bid = blockIdx.x, nb = gridDim.x, lane = tid & 63, wave = __builtin_amdgcn_readfirstlane(tid >> 6);
    unsigned char* ws = p.ws;
    if (bid >= 64) { convert_expert_weights(p, lds, bid - 64, nb - 64); return; }
    unsigned char* CHb = ws + OFF_CH + (size_t)(bid * NCHUNK) * REC_BYTES;
    constexpr int RSLOT = REC_BYTES, RN = 10, PF = 7;
#define R_BAR() do { asm volatile("s_waitcnt lgkmcnt(0)" ::: "memory"); __builtin_amdgcn_s_barrier(); asm volatile("" ::: "memory"); } while (0)
    if (wave >= 4) {
        const int lw = wave - 4;
#define R_ISSUE(x) do { \
            LAS unsigned char* _s = lds + ((x) % RN) * RSLOT; const unsigned char* _r = CHb + (size_t)(x) * REC_BYTES + lane * 16; \
            _Pragma("unroll") for (int _i = 0; _i < 3; ++_i) { const int _pc = lw + 4 * _i; __builtin_amdgcn_global_load_lds((const unsigned*)(_r + _pc * 1024), (LAS unsigned*)(_s + _pc * 1024), 16, 0, 0); } \
            if (lw == 0) __builtin_amdgcn_global_load_lds((const unsigned*)(_r + 12 * 1024), (LAS unsigned*)(_s + 12 * 1024), 16, 0, 0); \
            if (lw == 1) { if (lane < 16) __builtin_amdgcn_global_load_lds((const unsigned*)(_r + 13 * 1024), (LAS unsigned*)(_s + 13 * 1024), 16, 0, 0); } } while (0)
        for (int x = 0; x < PF; ++x) R_ISSUE(x);
        asm volatile("s_waitcnt vmcnt(0)" ::: "memory");
        R_BAR();
        for (int c = 0; c < NCHUNK; ++c) {
            const int x = c + PF;
            if (x < NCHUNK) R_ISSUE(x);
            if (x < NCHUNK) { if (lw < 2) asm volatile("s_waitcnt vmcnt(20)" ::: "memory"); else asm volatile("s_waitcnt vmcnt(15)" ::: "memory"); }
            else asm volatile("s_waitcnt vmcnt(0)" ::: "memory");
            R_BAR();
        }
#undef R_ISSUE
    } else {
        const int vs = wave, fr = lane & 15, g = lane >> 4;
        f32x4 H[4];
#pragma unroll
        for (int m = 0; m < 4; ++m) H[m] = (f32x4){0.f, 0.f, 0.f, 0.f};
        R_BAR();
        RecOps cur, nxt;
        load_ops(cur, lds, vs, fr, g);
        for (int c = 0; c < NCHUNK; ++c) {
            if (c + 1 < NCHUNK) load_ops(nxt, lds + ((c + 1) % RN) * RSLOT, vs, fr, g); else nxt = cur;
            u32x4 hb0, hb1;
            hb0.x = cvt_pk_bf16(H[0][0], H[0][1]); hb0.y = cvt_pk_bf16(H[0][2], H[0][3]); hb0.z = cvt_pk_bf16(H[1][0], H[1][1]); hb0.w = cvt_pk_bf16(H[1][2], H[1][3]);
            hb1.x = cvt_pk_bf16(H[2][0], H[2][1]); hb1.y = cvt_pk_bf16(H[2][2], H[2][3]); hb1.z = cvt_pk_bf16(H[3][0], H[3][1]); hb1.w = cvt_pk_bf16(H[3][2], H[3][3]);
            const bf16x8 hB0 = __builtin_bit_cast(bf16x8, hb0), hB1 = __builtin_bit_cast(bf16x8, hb1);
            f32x4 U = (f32x4){bflo(cur.u0.x), bfhi(cur.u0.x), bflo(cur.u0.y), bfhi(cur.u0.y)};
            U = __builtin_amdgcn_mfma_f32_16x16x32_bf16(cur.wA0, hB0, U, 0, 0, 0);
            U = __builtin_amdgcn_mfma_f32_16x16x32_bf16(cur.wA1, hB1, U, 0, 0, 0);
            f32x4 Y = (f32x4){0.f, 0.f, 0.f, 0.f};
            Y = __builtin_amdgcn_mfma_f32_16x16x32_bf16(cur.rA0, hB0, Y, 0, 0, 0);
            Y = __builtin_amdgcn_mfma_f32_16x16x32_bf16(cur.rA1, hB1, Y, 0, 0, 0);
            u32x4 uvw; uvw.x = cvt_pk_bf16(U[0], U[1]); uvw.y = cvt_pk_bf16(U[2], U[3]); uvw.z = cur.vv.x; uvw.w = cur.vv.y;
            const bf16x8 uv = __builtin_bit_cast(bf16x8, uvw);
            Y = __builtin_amdgcn_mfma_f32_16x16x32_bf16(cur.ark, uv, Y, 0, 0, 0);
#pragma unroll
            for (int m = 0; m < 4; ++m) { H[m] = __builtin_amdgcn_mfma_f32_16x16x32_bf16(cur.bk[m], uv, H[m], 0, 0, 0); H[m] *= cur.wc[m]; }
            u32x2 yw; yw.x = cvt_pk_bf16(Y[0], Y[1]); yw.y = cvt_pk_bf16(Y[2], Y[3]);
            *(u32x2*)(CHb + (size_t)c * REC_BYTES + RO_U0T + (16 * vs + fr) * 32 + g * 8) = yw;
            R_BAR();
            cur = nxt;
        }
    }
#undef R_BAR
}

__device__ __forceinline__ void phase_gn(const Params& p) {
    const int tid = threadIdx.x, bid = blockIdx.x, nb = gridDim.x, lane = tid & 63, wave = tid >> 6;
    unsigned char* ws = p.ws;
    const bf16_t* Gb = (const bf16_t*)(ws + OFF_G); const float* COEF = (const float*)(ws + OFF_COEF);
    bf16_t* Z = (bf16_t*)(ws + OFF_Z);
    for (int uid = bid * 8 + wave; uid < NUNITS; uid += nb * 8) {
        const int bh = uid / NCHUNK, c = uid - bh * NCHUNK, b = bh >> 3, h = bh & 7;
        if (c == 0) continue;
        const int col = h * 64 + lane, row0 = b * SEQ + c * 16;
        const float lng = p.in[21][col], lnb = p.in[22][col];
        const unsigned char* rec = ws + OFF_CH + (size_t)uid * REC_BYTES;
        const u32x4 y0 = *(const u32x4*)(rec + RO_U0T + lane * 32), y1 = *(const u32x4*)(rec + RO_U0T + lane * 32 + 16);
        const u32x4 v0 = *(const u32x4*)(rec + RO_VT + lane * 32), v1 = *(const u32x4*)(rec + RO_VT + lane * 32 + 16);
        const unsigned yw[8] = {y0.x, y0.y, y0.z, y0.w, y1.x, y1.y, y1.z, y1.w}, vw[8] = {v0.x, v0.y, v0.z, v0.w, v1.x, v1.y, v1.z, v1.w};
#pragma unroll
        for (int t = 0; t < 16; ++t) {
            const float y = (t & 1) ? bfhi(yw[t >> 1]) : bflo(yw[t >> 1]);
            const float v = (t & 1) ? bfhi(vw[t >> 1]) : bflo(vw[t >> 1]);
            const float mean = wave_sum_dpp(y) * (1.0f / 64.0f);
            const float dlt = y - mean;
            const float var = wave_sum_dpp(dlt * dlt) * (1.0f / 64.0f);
            const float yn = dlt * rsqrtf(var + LNX_EPS) * lng + lnb;
            const float cf = COEF[(size_t)(row0 + t) * 8 + h];
            const float gg = bf2f(Gb[(size_t)(row0 + t) * 512 + col]);
            Z[(size_t)(row0 + t - NMETA) * 512 + col] = f2bf((yn + cf * v) * gg);
        }
    }
}

__device__ __forceinline__ void convert_expert_weights(const Params& p, LAS unsigned char* lds, int first, int stride) {
    unsigned char* ws = p.ws;
    const int tid = threadIdx.x;
    LAS float* tile = (LAS float*)lds;
    const float* g2 = p.in[27];
    bf16_t* WGU = (bf16_t*)(ws + OFF_WGU); bf16_t* WD = (bf16_t*)(ws + OFF_WD);
    constexpr int NBLK = NE * 3 * 64;
    const int lr = tid >> 6, lc = (tid & 63) * 4;
    f32x4 cur[8];
    int j = first;
    if (j >= NBLK) return;
    {
        const int mat = j >> 6, e = mat / 3, which = mat - 3 * e, bb = j & 63, kb = bb & 15, nbk = bb >> 4;
        const float* src = (which == 0 ? p.in[30] : which == 1 ? p.in[32] : p.in[34]) + (size_t)e * 1024 * 1024 + (size_t)(kb * 64) * 1024 + nbk * 256;
#pragma unroll
        for (int i = 0; i < 8; ++i) cur[i] = *(const f32x4*)(src + (size_t)(lr + 8 * i) * 1024 + lc);
    }
    for (;;) {
        const int jn = j + stride; const bool has_next = jn < NBLK;
        f32x4 nxt[8];
        if (has_next) {
            const int mat = jn >> 6, e = mat / 3, which = mat - 3 * e, bb = jn & 63, kb = bb & 15, nbk = bb >> 4;
            const float* src = (which == 0 ? p.in[30] : which == 1 ? p.in[32] : p.in[34]) + (size_t)e * 1024 * 1024 + (size_t)(kb * 64) * 1024 + nbk * 256;
#pragma unroll
            for (int i = 0; i < 8; ++i) nxt[i] = *(const f32x4*)(src + (size_t)(lr + 8 * i) * 1024 + lc);
        }
        const int mat = j >> 6, e = mat / 3, which = mat - 3 * e, bb = j & 63, kb = bb & 15, nbk = bb >> 4;
#pragma unroll
        for (int i = 0; i < 8; ++i) { LAS float* t = tile + (lr + 8 * i) * 257 + lc; t[0] = cur[i][0]; t[1] = cur[i][1]; t[2] = cur[i][2]; t[3] = cur[i][3]; }
        __syncthreads();
        {
            const int kq = tid & 7, k0 = kb * 64 + 8 * kq;
            float sc[8];
#pragma unroll
            for (int jj = 0; jj < 8; ++jj) sc[jj] = which < 2 ? g2[k0 + jj] : 1.0f;
#pragma unroll
            for (int i = 0; i < 4; ++i) {
                const int nn = (tid >> 3) + 64 * i, n = nbk * 256 + nn;
                float v[8];
#pragma unroll
                for (int jj = 0; jj < 8; ++jj) v[jj] = tile[(8 * kq + jj) * 257 + nn] * sc[jj];
                u32x4 w; w.x = cvt_pk_bf16(v[0], v[1]); w.y = cvt_pk_bf16(v[2], v[3]); w.z = cvt_pk_bf16(v[4], v[5]); w.w = cvt_pk_bf16(v[6], v[7]);
                bf16_t* dst = which < 2 ? WGU + (size_t)e * 2048 * 1024 + (size_t)(256 * (n >> 7) + 128 * which + (n & 127)) * 1024
                                        : WD + (size_t)e * 1024 * 1024 + (size_t)n * 1024;
                *(u32x4*)(dst + k0) = w;
            }
        }
        __syncthreads();
        if (!has_next) break;
        j = jn;
#pragma unroll
        for (int i = 0; i < 8; ++i) cur[i] = nxt[i];
    }
}

__device__ __forceinline__ void phase_router(const Params& p, LAS unsigned char* lds) {
    const int tid = threadIdx.x, bid = blockIdx.x, nb = gridDim.x, lane = tid & 63, wave = tid >> 6;
    unsigned char* ws = p.ws;
    const float* h1 = p.out;
    const float* WRG = (const float*)(ws + OFF_WRG);
    const float* brt = p.in[29];
    LAS float* slog = (LAS float*)lds;
    LAS float* srs = slog + 8 * 16 * 32;
    LAS int* lcnt = (LAS int*)(srs + 128);
    LAS int* gbase = lcnt + 32;
    LAS int* ltopi = gbase + 32;
    LAS int* lrank = ltopi + 512;
    int* TOPI = (int*)(ws + OFF_TOPI); float* TOPW = (float*)(ws + OFF_TOPW); int* RANK = (int*)(ws + OFF_RANK); float* RSTD2 = (float*)(ws + OFF_RSTD2);
    int* GCNT = (int*)(ws + OFF_GCNT);
    for (int tb = bid; tb < T / 128; tb += nb) {
        if (tid < 32) lcnt[tid] = 0;
        __syncthreads();
        const int t0 = tb * 128 + wave * 16;
        {
            const int row = lane & 15, kq = lane >> 4;
            const float* ap = h1 + (size_t)(t0 + row) * D + 4 * kq;
            const float* bp = WRG + (size_t)(4 * kq) * 32 + row;
            f32x4 acc0 = (f32x4){0.f, 0.f, 0.f, 0.f}, acc1 = acc0;
            float ss = 0.f;
            for (int j = 0; j < 64; ++j) {
                const f32x4 av = *(const f32x4*)(ap + 16 * j);
                ss += av[0] * av[0] + av[1] * av[1] + av[2] * av[2] + av[3] * av[3];
                const float* bj = bp + (size_t)(16 * j) * 32;
#pragma unroll
                for (int s = 0; s < 4; ++s) {
                    const float b0 = bj[s * 32], b1 = bj[s * 32 + 16];
                    acc0 = __builtin_amdgcn_mfma_f32_16x16x4f32(av[s], b0, acc0, 0, 0, 0);
                    acc1 = __builtin_amdgcn_mfma_f32_16x16x4f32(av[s], b1, acc1, 0, 0, 0);
                }
            }
            ss += __shfl_xor(ss, 16); ss += __shfl_xor(ss, 32);
#pragma unroll
            for (int reg = 0; reg < 4; ++reg) {
                slog[(wave * 16 + 4 * kq + reg) * 32 + row] = acc0[reg];
                slog[(wave * 16 + 4 * kq + reg) * 32 + 16 + row] = acc1[reg];
            }
            if (lane < 16) srs[wave * 16 + lane] = rsqrtf(ss * (1.0f / D) + NORM_EPS);
        }
        __syncthreads();
        if (lane < 16) {
            const int tl = wave * 16 + lane, t = tb * 128 + tl;
            const float rs = srs[tl];
            float lg[32];
#pragma unroll
            for (int e = 0; e < 32; ++e) lg[e] = slog[tl * 32 + e] * rs + brt[e];
            int ti[4]; float tv[4];
#pragma unroll
            for (int k = 0; k < 4; ++k) {
                float best = -3.0e38f; int bi = 0;
#pragma unroll
                for (int e = 0; e < 32; ++e) { const bool tk = lg[e] > best; best = tk ? lg[e] : best; bi = tk ? e : bi; }
                ti[k] = bi; tv[k] = best;
#pragma unroll
                for (int e = 0; e < 32; ++e) lg[e] = (e == bi) ? -3.0e38f : lg[e];
            }
            const float e0 = 1.0f, e1 = __expf(tv[1] - tv[0]), e2 = __expf(tv[2] - tv[0]), e3 = __expf(tv[3] - tv[0]);
            const float inv = 1.0f / (e0 + e1 + e2 + e3);
            *(f32x4*)(TOPW + (size_t)t * 4) = (f32x4){e0 * inv, e1 * inv, e2 * inv, e3 * inv};
            RSTD2[t] = rs;
#pragma unroll
            for (int k = 0; k < 4; ++k) { ltopi[tl * 4 + k] = ti[k]; lrank[tl * 4 + k] = __hip_atomic_fetch_add(lcnt + ti[k], 1, __ATOMIC_RELAXED, __HIP_MEMORY_SCOPE_WORKGROUP); }
        }
        __syncthreads();
        if (tid < 32) gbase[tid] = atomicAdd(GCNT + tid, lcnt[tid]);
        __syncthreads();
        {
            const int e = ltopi[tid];
            TOPI[(size_t)tb * 512 + tid] = e;
            RANK[(size_t)tb * 512 + tid] = gbase[e] + lrank[tid];
        }
        __syncthreads();
    }
}

__device__ __forceinline__ void phase_lists(const Params& p, LAS unsigned char* lds) {
    const int tid = threadIdx.x, bid = blockIdx.x, nb = gridDim.x;
    unsigned char* ws = p.ws;
    LAS int* pstart = (LAS int*)lds;
    LAS int* cnt = pstart + 64;
    const int* GCNT = (const int*)(ws + OFF_GCNT);
    if (tid < 32) cnt[tid] = GCNT[tid];
    __syncthreads();
    if (tid == 0) { int s = 0; for (int e = 0; e < 32; ++e) { pstart[e] = s; s += ((cnt[e] + 255) >> 8) << 8; } pstart[32] = s; }
    __syncthreads();
    const int* TOPI = (const int*)(ws + OFF_TOPI); const float* TOPW = (const float*)(ws + OFF_TOPW); const int* RANK = (const int*)(ws + OFF_RANK); const float* RSTD2 = (const float*)(ws + OFF_RSTD2);
    int* ROWTOK = (int*)(ws + OFF_ROWTOK); int* ROWSLOT = (int*)(ws + OFF_ROWSLOT); float* ROWW = (float*)(ws + OFF_ROWW); float* ROWRS = (float*)(ws + OFF_ROWRS);
    for (int i = bid * 512 + tid; i < T * 4; i += nb * 512) {
        const int e = TOPI[i], pos = pstart[e] + RANK[i], t = i >> 2;
        ROWTOK[pos] = t; ROWSLOT[pos] = i; ROWW[pos] = TOPW[i]; ROWRS[pos] = RSTD2[t];
    }
    for (int e = bid; e < 32; e += nb) {
        for (int pos = pstart[e] + cnt[e] + tid; pos < pstart[e + 1]; pos += 512) { ROWTOK[pos] = 0; ROWSLOT[pos] = -1; ROWW[pos] = 0.f; ROWRS[pos] = 0.f; }
    }
    if (bid == 0) {
        int* TILEE = (int*)(ws + OFF_TILEE);
        const int ntiles = pstart[32] >> 8;
        for (int mt = tid; mt < ntiles; mt += 512) { int e = 0; for (int q = 0; q < 32; ++q) if (pstart[q] <= mt * 256) e = q; TILEE[mt] = e; }
        if (tid == 0) TILEE[1000] = ntiles;
    }
    __syncthreads();
}

__device__ __forceinline__ void phase_final(const Params& p) {
    const int tid = threadIdx.x, bid = blockIdx.x, nb = gridDim.x, lane = tid & 63, wave = tid >> 6;
    unsigned char* ws = p.ws;
    const bf16_t* HB2 = (const bf16_t*)(ws + OFF_HB2);
    const bf16_t* YA = (const bf16_t*)p.out; const bf16_t* YB = (const bf16_t*)(ws + OFF_WGU);
    const float* gf = p.in[36];
    const f32x4 ga0 = *(const f32x4*)(gf + 8 * lane), ga1 = *(const f32x4*)(gf + 8 * lane + 4), gb0 = *(const f32x4*)(gf + 512 + 8 * lane), gb1 = *(const f32x4*)(gf + 512 + 8 * lane + 4);
    for (int t = bid * 8 + wave; t < T; t += nb * 8) {
        const u32x4 ha = *(const u32x4*)(HB2 + (size_t)t * D + 8 * lane), hb = *(const u32x4*)(HB2 + (size_t)t * D + 512 + 8 * lane);
        float va[8] = {bflo(ha.x), bfhi(ha.x), bflo(ha.y), bfhi(ha.y), bflo(ha.z), bfhi(ha.z), bflo(ha.w), bfhi(ha.w)};
        float vb[8] = {bflo(hb.x), bfhi(hb.x), bflo(hb.y), bfhi(hb.y), bflo(hb.z), bfhi(hb.z), bflo(hb.w), bfhi(hb.w)};
#pragma unroll
        for (int k = 0; k < 4; ++k) {
            const u32x4 ya = *(const u32x4*)(YA + (size_t)(4 * t + k) * 512 + 8 * lane), yb = *(const u32x4*)(YB + (size_t)(4 * t + k) * 512 + 8 * lane);
            va[0] += bflo(ya.x); va[1] += bfhi(ya.x); va[2] += bflo(ya.y); va[3] += bfhi(ya.y); va[4] += bflo(ya.z); va[5] += bfhi(ya.z); va[6] += bflo(ya.w); va[7] += bfhi(ya.w);
            vb[0] += bflo(yb.x); vb[1] += bfhi(yb.x); vb[2] += bflo(yb.y); vb[3] += bfhi(yb.y); vb[4] += bflo(yb.z); vb[5] += bfhi(yb.z); vb[6] += bflo(yb.w); vb[7] += bfhi(yb.w);
        }
        float ss = 0.f;
#pragma unroll
        for (int j = 0; j < 8; ++j) ss += va[j] * va[j] + vb[j] * vb[j];
        ss = wave_sum(ss);
        const float rs = rsqrtf(ss * (1.0f / D) + NORM_EPS);
        float* o = p.out + (size_t)t * D;
        *(f32x4*)(o + 8 * lane) = (f32x4){va[0] * rs * ga0[0], va[1] * rs * ga0[1], va[2] * rs * ga0[2], va[3] * rs * ga0[3]};
        *(f32x4*)(o + 8 * lane + 4) = (f32x4){va[4] * rs * ga1[0], va[5] * rs * ga1[1], va[6] * rs * ga1[2], va[7] * rs * ga1[3]};
        *(f32x4*)(o + 512 + 8 * lane) = (f32x4){vb[0] * rs * gb0[0], vb[1] * rs * gb0[1], vb[2] * rs * gb0[2], vb[3] * rs * gb0[3]};
        *(f32x4*)(o + 512 + 8 * lane + 4) = (f32x4){vb[4] * rs * gb1[0], vb[5] * rs * gb1[1], vb[6] * rs * gb1[2], vb[7] * rs * gb1[3]};
    }
}

#define XB_TMO      128
#define XB_XCNT(j)  (256  + 64 * (j))
#define XB_XSUB(j)  (1280 + 64 * (j))
#define XB_XGEN(j)  (2304 + 64 * (j))
#define XB_TOP      3328
#define XB_TOPGEN   3392
#define XCD_BAR_WORDS 3456
#define XB_SPIN_CAP (1u << 18)
__device__ __forceinline__ unsigned xb_ld(unsigned* p)              { return __hip_atomic_load(p, __ATOMIC_RELAXED, __HIP_MEMORY_SCOPE_AGENT); }
__device__ __forceinline__ unsigned xb_add(unsigned* p, unsigned v) { return __hip_atomic_fetch_add(p, v, __ATOMIC_RELAXED, __HIP_MEMORY_SCOPE_AGENT); }
__device__ __forceinline__ unsigned xb_xcc_id() { return (unsigned)__builtin_amdgcn_s_getreg((3 << 11) | 20) & 0xFu; }
#define XB_SPIN(cond, bar) do { unsigned _sp = 0; while (cond) { __builtin_amdgcn_s_sleep(1); \
    if ((++_sp & 255u) == 0u) { if (xb_ld(&(bar)[XB_TMO])) break; if (_sp > XB_SPIN_CAP) { atomicAdd(&(bar)[XB_TMO], 1u); break; } } } } while (0)
struct XcdBarrier { unsigned* bar; unsigned x; volatile LAS unsigned* st; };
__device__ __forceinline__ XcdBarrier xcd_barrier_post(unsigned* bar, volatile LAS unsigned* st) {
    XcdBarrier b; b.bar = bar; b.x = xb_xcc_id(); b.st = st;
    if (threadIdx.x == 0) (void)xb_add(&bar[XB_XCNT(b.x)], 1u);
    return b;
}
__device__ __forceinline__ void xcd_barrier_complete(unsigned* bar, unsigned x, unsigned& nloc, unsigned& nx) {
    const unsigned G = gridDim.x * gridDim.y * gridDim.z;
    unsigned sum, cnt, mine, sp = 0u;
    for (;;) {
        sum = 0u; cnt = 0u; mine = 0u;
#pragma unroll
        for (unsigned j = 0; j < 16; ++j) { const unsigned c = xb_ld(&bar[XB_XCNT(j)]); sum += c; cnt += (c > 0u) ? 1u : 0u; mine = (j == x) ? c : mine; }
        if (sum == G) break;
        __builtin_amdgcn_s_sleep(1);
        if ((++sp & 255u) == 0u) { if (xb_ld(&bar[XB_TMO])) break; if (sp > XB_SPIN_CAP) { atomicAdd(&bar[XB_TMO], 1u); break; } }
    }
    nloc = mine > 0u ? mine : 1u; nx = cnt > 0u ? cnt : 1u;
}
__device__ __forceinline__ void xcd_barrier(const XcdBarrier& b) {
    asm volatile("s_waitcnt vmcnt(0)" ::: "memory");
    __syncthreads();
    if (threadIdx.x == 0) {
        unsigned* bar = b.bar;
        __builtin_amdgcn_s_waitcnt(0);
        unsigned nloc = b.st[0], nx = b.st[1];
        if (nloc == 0u) { xcd_barrier_complete(bar, b.x, nloc, nx); b.st[0] = nloc; b.st[1] = nx; }
        const unsigned old = xb_add(&bar[XB_XSUB(b.x)], 1u);
        const unsigned gen = old / nloc;
        if (old + 1u == (gen + 1u) * nloc) {
            __builtin_amdgcn_fence(__ATOMIC_RELEASE, "agent");
            asm volatile("s_waitcnt vmcnt(0)" ::: "memory");
            const unsigned og = xb_add(&bar[XB_TOP], 1u);
            const unsigned tg = og / nx;
            if (og + 1u == (tg + 1u) * nx) xb_add(&bar[XB_TOPGEN], 1u);
            else XB_SPIN(xb_ld(&bar[XB_TOPGEN]) == tg, bar);
            __builtin_amdgcn_fence(__ATOMIC_ACQUIRE, "agent");
            xb_add(&bar[XB_XGEN(b.x)], 1u);
            asm volatile("s_waitcnt vmcnt(0)" ::: "memory");
        } else {
            XB_SPIN(xb_ld(&bar[XB_XGEN(b.x)]) == gen, bar);
            __builtin_amdgcn_fence(__ATOMIC_ACQUIRE, "agent");
            asm volatile("s_waitcnt vmcnt(0)" ::: "memory");
        }
    }
    __syncthreads();
}

constexpr int N_PHASES = 15;
__global__ void __launch_bounds__(512, 2) mega(Params p) {
    extern __shared__ __attribute__((aligned(16))) unsigned char lds_raw[];
    LAS unsigned char* lds = (LAS unsigned char*)lds_raw;
    cg::grid_group grid = cg::this_grid();
    unsigned char* ws = p.ws;
    const int G = gridDim.x, bid = blockIdx.x;
#ifndef ONLY_PHASE
#define ONLY_PHASE -1
#endif
#define IN(k) ((ONLY_PHASE < 0 || ONLY_PHASE == (k)) && p.ph_lo <= (k) && (k) < p.ph_hi)
    volatile LAS unsigned* xst = (volatile LAS unsigned*)(lds + 163840 - 16);
    if (threadIdx.x < 4) xst[threadIdx.x] = 0u;
    __syncthreads();
    const XcdBarrier xbar = xcd_barrier_post((unsigned*)(ws + OFF_BAR), xst);
#define PP() (*({ const Params* _pp = (const Params*)__builtin_amdgcn_kernarg_segment_ptr(); asm volatile("" : "+s"(_pp)); _pp; }))
    if (p.ph_hi < 0) grid.sync();
#define SEAM(k) do { if ((k) + 1 < p.ph_hi) xcd_barrier(xbar); } while (0)
    if (IN(0)) { const Params& q = PP(); phase_prep(q, lds); SEAM(0); }
    if (IN(1)) { const Params& q = PP();
        phase_meta_proj(q, lds);
        StaticOrder S; S.init(ws + OFF_HB, ws + OFF_WIN, T, NCOLS1, 1024, G, bid);
        EpiProj E{(bf16_t*)(ws + OFF_PRKV), (bf16_t*)(ws + OFF_PCONV), (bf16_t*)q.out, (const float*)(ws + OFF_RSTD1)};
        gemm_phase<false>(lds, 1024, S, E);
        SEAM(1);
    }
    if (IN(2)) { const Params& q = PP(); phase_lprep_conv(q); SEAM(2); }
    if (IN(3)) { const Params& q = PP();
        StaticOrder S; S.init(ws + OFF_L, ws + OFF_W2, NRP, 1536, 256, G, bid);
        EpiL E{(float*)(ws + OFF_LD), (bf16_t*)(ws + OFF_A), (bf16_t*)(ws + OFF_G), q.in[10], q.in[13]};
        gemm_phase<false>(lds, 256, S, E);
        SEAM(3);
    }
    if (IN(4)) { const Params& q = PP(); phase_scanprep(q, lds); SEAM(4); }
    if (IN(5)) { const Params& q = PP(); phase_recur(q, lds); SEAM(5); }
    if (IN(6)) { const Params& q = PP(); phase_gn(q); SEAM(6); }
    if (IN(7)) { const Params& q = PP();
        StaticOrder S; S.init(ws + OFF_Z, ws + OFF_WR, T, 1024, 512, G, bid);
        EpiMerge<0> E{(bf16_t*)(ws + OFF_MERGED), (const bf16_t*)q.out};
        gemm_phase<false>(lds, 512, S, E);
        SEAM(7);
    }
    if (IN(8)) { const Params& q = PP();
        StaticOrder S; S.init(ws + OFF_C, ws + OFF_WC, T, 1024, 512, G, bid);
        EpiMerge<1> E{(bf16_t*)(ws + OFF_MERGED), (const bf16_t*)q.out};
        gemm_phase<false>(lds, 512, S, E);
        SEAM(8);
    }
    if (IN(9)) { const Params& q = PP();
        StaticOrder S; S.init(ws + OFF_MERGED, ws + OFF_WO, T, 1024, 1024, G, bid);
        EpiO E{q.in[0], q.out, (bf16_t*)(ws + OFF_HB2)};
        gemm_phase<false>(lds, 1024, S, E);
        SEAM(9);
    }
    if (IN(10)) { const Params& q = PP(); phase_router(q, lds); SEAM(10); }
    if (IN(11)) { const Params& q = PP(); phase_lists(q, lds); SEAM(11); }
    if (IN(12)) { const Params& q = PP();
        const int* TILEE = (const int*)(ws + OFF_TILEE);
        MoeOrder S; S.A = (const char*)(ws + OFF_HB2); S.Bt = (const char*)(ws + OFF_WGU); S.K = 1024; S.estride = (size_t)2048 * 1024 * 2;
        S.tile_e = TILEE; S.rowtok = (const int*)(ws + OFF_ROWTOK); S.ntiles = TILEE[1000]; S.nnt = 8; S.G = G; S.c = bid; S.gather = true;
        EpiMoe1 E{(bf16_t*)(ws + OFF_ACT), (const float*)(ws + OFF_ROWRS), q.in[31], q.in[33]};
        gemm_phase<true>(lds, 1024, S, E);
        SEAM(12);
    }
    if (IN(13)) { const Params& q = PP();
        const int* TILEE = (const int*)(ws + OFF_TILEE);
        MoeOrder S; S.A = (const char*)(ws + OFF_ACT); S.Bt = (const char*)(ws + OFF_WD); S.K = 1024; S.estride = (size_t)1024 * 1024 * 2;
        S.tile_e = TILEE; S.rowtok = nullptr; S.ntiles = TILEE[1000]; S.nnt = 4; S.G = G; S.c = bid; S.gather = false;
        EpiMoe2 E{(bf16_t*)q.out, (bf16_t*)(ws + OFF_WGU), (const int*)(ws + OFF_ROWSLOT), (const float*)(ws + OFF_ROWW), q.in[35]};
        gemm_phase<false>(lds, 1024, S, E);
        SEAM(13);
    }
    if (IN(14)) { const Params& q = PP(); phase_final(q); }
}

extern "C" void kernel_launch(void* const* d_in, const int* in_sizes, int n_in, void* d_out, int out_size, void* d_ws, size_t ws_size,
                              hipStream_t stream) {
    constexpr size_t kDynLds = 160 * 1024;
    static int grid_blocks = 0;
    if (!grid_blocks) {
        int dev = 0, cus = 0, per_cu = 0;
        (void)hipGetDevice(&dev);
        (void)hipDeviceGetAttribute(&cus, hipDeviceAttributeMultiprocessorCount, dev);
        (void)hipFuncSetAttribute((const void*)mega, hipFuncAttributeMaxDynamicSharedMemorySize, (int)kDynLds);
        (void)hipOccupancyMaxActiveBlocksPerMultiprocessor(&per_cu, mega, 512, kDynLds);
        if (per_cu > 1) per_cu = 1;
        grid_blocks = cus * per_cu;
        fprintf(stderr, "cus=%d per_cu=%d ws_size=%zu need=%zu\n", cus, per_cu, ws_size, (size_t)WS_NEED);
    }
    if (ws_size < WS_NEED || n_in < 37 || grid_blocks < 64) { fprintf(stderr, "kernel_launch: unsupported configuration\n"); return; }
    Params p{};
    for (int i = 0; i < 37; ++i) p.in[i] = (const float*)d_in[i];
    p.out = (float*)d_out;
    p.ws = (unsigned char*)d_ws;
    p.ph_lo = 0; p.ph_hi = N_PHASES;
    (void)hipMemsetAsync((unsigned char*)d_ws + OFF_BAR, 0, 16384, stream);
    void* args[] = {&p};
    hipError_t e = hipLaunchCooperativeKernel((void*)mega, dim3(grid_blocks), dim3(512), args, kDynLds, stream);
    if (e != hipSuccess) fprintf(stderr, "cooperative launch failed: %s (grid %d)\n", hipGetErrorString(e), grid_blocks);
}
```

```cpp
#include <hip/hip_runtime.h>
#include <hip/hip_cooperative_groups.h>
#include <cstdio>
namespace cg = cooperative_groups;

#define LAS __attribute__((address_space(3)))
typedef unsigned short bf16_t;
typedef short bf16x8 __attribute__((ext_vector_type(8)));
typedef float f32x4 __attribute__((ext_vector_type(4)));
typedef float f32x2 __attribute__((ext_vector_type(2)));
typedef unsigned u32x4 __attribute__((ext_vector_type(4)));
typedef unsigned u32x2 __attribute__((ext_vector_type(2)));

constexpr int D = 1024, NBATCH = 8, SEQ = 4096, NMETA = 16;
constexpr int T = NBATCH * SEQ;
constexpr int NR = T + NMETA;
constexpr int NRP = 33024;
constexpr int PCOLS1 = 3584;
constexpr int NCOLS1 = 5632;
constexpr int NE = 32, TOPK = 4, DFF = 1024;
constexpr int MAXROWS = T * TOPK + NE * 256;
constexpr int MAXTILES = MAXROWS / 256;
constexpr float NORM_EPS = 1e-5f, LNX_EPS = 64e-5f;

constexpr int NCHUNK = 257, NUNITS = 64 * NCHUNK;
constexpr int REC_BYTES = 13568;
constexpr int RO_WH = 0, RO_RT = 2048, RO_U0T = 4096, RO_VT = 6144, RO_BKT = 8192, RO_ARK = 12288, RO_WCC = 13312;
constexpr int SLOT_BYTES = 15680, SO_G = 13568, SO_COEF = 15616, NSLOT = 9;
constexpr size_t SZ_ACT = (size_t)MAXROWS * 1024 * 2;
constexpr size_t SZ_WGU = (size_t)NE * 2048 * 1024 * 2;
constexpr size_t SZ_WD = (size_t)NE * 1024 * 1024 * 2;
constexpr size_t SZ_HB = (size_t)T * 1024 * 2;
constexpr size_t OFF_WGU = 0;
constexpr size_t OFF_WD = OFF_WGU + SZ_WGU;
constexpr size_t OFF_ACT = OFF_WD + SZ_WD;
constexpr size_t OFF_HB2 = OFF_ACT + SZ_ACT;
constexpr size_t OFF_RT = OFF_HB2 + SZ_HB;
constexpr size_t OFF_TOPI = OFF_RT;
constexpr size_t OFF_TOPW = OFF_TOPI + (size_t)T * 16;
constexpr size_t OFF_RANK = OFF_TOPW + (size_t)T * 16;
constexpr size_t OFF_RSTD2 = OFF_RANK + (size_t)T * 16;
constexpr size_t OFF_ROWTOK = OFF_RSTD2 + (size_t)T * 4;
constexpr size_t OFF_ROWSLOT = OFF_ROWTOK + (size_t)MAXROWS * 4;
constexpr size_t OFF_ROWW = OFF_ROWSLOT + (size_t)MAXROWS * 4;
constexpr size_t OFF_ROWRS = OFF_ROWW + (size_t)MAXROWS * 4;
constexpr size_t OFF_TILEE = OFF_ROWRS + (size_t)MAXROWS * 4;
constexpr size_t OFF_GCNT = OFF_TILEE + 4096;
constexpr size_t OFF_SM = OFF_GCNT + 256;
constexpr size_t OFF_WR = OFF_SM;
constexpr size_t OFF_WC = OFF_WR + (size_t)1024 * 512 * 2;
constexpr size_t OFF_WO = OFF_WC + (size_t)1024 * 512 * 2;
constexpr size_t OFF_W2 = OFF_WO + (size_t)1024 * 1024 * 2;
constexpr size_t OFF_RSTD1 = OFF_W2 + (size_t)1536 * 256 * 2;
constexpr size_t OFF_WRG = OFF_RSTD1 + (size_t)NRP * 4;
constexpr size_t OFF_BAR = OFF_WRG + (size_t)1024 * 32 * 4;
constexpr size_t WS_NEED = OFF_BAR + 16384;
constexpr size_t OFF_PRKV = 0;
constexpr size_t SZ_PRKV = (size_t)NR * 1536 * 2;
constexpr size_t OFF_LD = OFF_PRKV + SZ_PRKV;
constexpr size_t OFF_A = OFF_LD + (size_t)NRP * 512 * 4;
constexpr size_t OFF_CH = OFF_A + (size_t)NRP * 512 * 2;
constexpr size_t OFF_PCONV = OFF_CH;
constexpr size_t SZ_PCONV = (size_t)NR * 2048 * 2;
constexpr size_t OFF_HB = OFF_PCONV + SZ_PCONV;
constexpr size_t OFF_L = OFF_HB + SZ_HB;
constexpr size_t OFF_WIN = OFF_L + (size_t)NRP * 256 * 2;
constexpr size_t CH_END = OFF_WIN + (size_t)NCOLS1 * 1024 * 2;
constexpr size_t OFF_MERGED = OFF_CH;
constexpr size_t OFF_G = CH_END;
constexpr size_t OFF_C = OFF_G + (size_t)NRP * 512 * 2;
constexpr size_t OFF_Z = OFF_C + (size_t)T * 512 * 2;
constexpr size_t OFF_COEF = OFF_Z + (size_t)T * 512 * 2;
constexpr size_t EARLY_END = OFF_COEF + (size_t)NR * 8 * 4;
static_assert(EARLY_END <= OFF_RT, "early buffers overflow");
static_assert(OFF_CH + (size_t)NUNITS * REC_BYTES <= CH_END, "chunk records overflow");
static_assert(OFF_CH >= OFF_WD + SZ_WD, "expert weights (written during the scan) must not touch live scan buffers");
static_assert(OFF_MERGED + SZ_HB <= OFF_HB2, "layout");
static_assert(OFF_PRKV % 16 == 0 && OFF_LD % 16 == 0 && OFF_A % 16 == 0 && OFF_CH % 16 == 0 && OFF_HB % 16 == 0 && OFF_L % 16 == 0 && OFF_WIN % 16 == 0 && OFF_G % 16 == 0 && OFF_C % 16 == 0 && OFF_Z % 16 == 0 && OFF_COEF % 16 == 0, "align");

#define GAS __attribute__((address_space(1)))
#define CAS __attribute__((address_space(4)))
struct Params {
    const float* in[37];
    float* out;
    unsigned char* ws;
    int ph_lo, ph_hi;
};
struct ParamsD {
    const GAS float* in[37];
    GAS float* out;
    GAS unsigned char* ws;
    int ph_lo, ph_hi;
};
static_assert(sizeof(Params) == sizeof(ParamsD), "argument views");
struct PPv {
    const CAS ParamsD* k;
    __device__ __forceinline__ const float* gin(int i) const { return (const float*)k->in[i]; }
    __device__ __forceinline__ float* gout() const { return (float*)k->out; }
    __device__ __forceinline__ unsigned char* gws() const { return (unsigned char*)k->ws; }
};
__device__ __forceinline__ PPv getpp() { const CAS ParamsD* k = (const CAS ParamsD*)__builtin_amdgcn_kernarg_segment_ptr(); asm volatile("" : "+s"(k)); return PPv{k}; }

typedef __bf16 bf16x2v __attribute__((ext_vector_type(2)));
__device__ __forceinline__ unsigned cvt_pk_bf16(float lo, float hi) { const f32x2 v = {lo, hi}; return __builtin_bit_cast(unsigned, __builtin_convertvector(v, bf16x2v)); }
__device__ __forceinline__ bf16_t f2bf(float f) { unsigned u = __float_as_uint(f); u += 0x7FFFu + ((u >> 16) & 1u); return (bf16_t)(u >> 16); }
__device__ __forceinline__ float bf2f(bf16_t b) { return __uint_as_float(((unsigned)b) << 16); }
__device__ __forceinline__ float bflo(unsigned w) { return __uint_as_float(w << 16); }
__device__ __forceinline__ float bfhi(unsigned w) { return __uint_as_float(w & 0xFFFF0000u); }
__device__ __forceinline__ float sigmoidf_(float x) { return __builtin_amdgcn_rcpf(1.0f + __expf(-x)); }
__device__ __forceinline__ float wave_sum(float v) {
#pragma unroll
    for (int o = 32; o >= 1; o >>= 1) v += __shfl_xor(v, o);
    return v;
}
__device__ __forceinline__ float wave_sum_dpp(float v);
__device__ __forceinline__ int prev_row(int row, int d) {
    if (row < NMETA) return row - d >= 0 ? row - d : -1;
    const int s = (row - NMETA) & (SEQ - 1);
    return s >= d ? row - d : NMETA + s - d;
}

constexpr int BM = 256, BK = 64, HALF = 128, HTB = HALF * BK * 2, STAGE_BYTES = 8 * HTB, NXCD = 8, WGM = 8;
__device__ __forceinline__ int lds_byte(int r, int c) { const int st = (r >> 4) * 2 + (c >> 5), rr = r & 15, cc = c & 31, ob = rr * 64 + cc * 2; return st * 1024 + (ob ^ (((ob >> 9) & 1) << 5)); }
__device__ __forceinline__ void stage_rc(int b, int& R, int& C) { const int st = b / 1024, sb = b % 1024, swz = sb ^ (((sb >> 9) & 1) << 5); R = (st >> 1) * 16 + swz / 64; C = (st & 1) * 32 + (swz % 64) / 2; }
__device__ __forceinline__ int perm32(int rho) { const int n = rho >> 4, i = rho & 15; return 8 * (i >> 2) + 4 * n + (i & 3); }

struct Unit { int pm, pn, aux; };

struct StaticOrder {
    const char* A; const char* Bt; int K;
    int nM, nN, nwg, G, c;
    __device__ void init(const void* A_, const void* Bt_, int M, int N, int K_, int G_, int c_) { A = (const char*)A_; Bt = (const char*)Bt_; K = K_; nM = M / BM; nN = N / BM; nwg = nM * nN; G = G_; c = c_; }
    __device__ bool next(int i, Unit& u) const {
        const long L = (long)i * G + c; if (L >= nwg) return false;
        int wgid = (int)L; { const int q = nwg / NXCD, r = nwg % NXCD, xcd = wgid % NXCD, off = wgid / NXCD; wgid = (xcd < r ? xcd * (q + 1) : r * (q + 1) + (xcd - r) * q) + off; }
        const int nig = WGM * nN, gid = wgid / nig, fm = gid * WGM, gsz = (nM - fm) < WGM ? (nM - fm) : WGM;
        u.pm = fm + ((wgid % nig) % gsz); u.pn = (wgid % nig) / gsz; u.aux = 0; return true;
    }
    __device__ __forceinline__ const char* a_ptr(const Unit& u) const { return A + (size_t)u.pm * 256 * K * 2; }
    __device__ __forceinline__ const char* b_ptr(const Unit& u) const { return Bt + (size_t)u.pn * 256 * K * 2; }
    __device__ __forceinline__ int gather_row(const Unit&, int) const { return 0; }
};
struct MoeOrder {
    const char* A; const char* Bt; int K; size_t estride;
    const int* tile_e; const int* rowtok; int ntiles, nnt, G, c; bool gather;
    __device__ bool next(int i, Unit& u) const {
        int mt, nt;
        if ((G & 7) == 0 && ((G >> 3) % nnt) == 0) {
            const int x = c & 7, j = c >> 3, per = (G >> 3) / nnt;
            mt = (i * 8 + x) * per + j / nnt; nt = j % nnt;
        } else { const long L = (long)i * G + c; mt = (int)(L / nnt); nt = (int)(L % nnt); }
        if (mt >= ntiles) return false;
        u.pm = mt; u.pn = nt; u.aux = tile_e[mt]; return true;
    }
    __device__ __forceinline__ const char* a_ptr(const Unit& u) const { return gather ? A : A + (size_t)u.pm * 256 * K * 2; }
    __device__ __forceinline__ const char* b_ptr(const Unit& u) const { return Bt + (size_t)u.aux * estride + (size_t)u.pn * 256 * K * 2; }
    __device__ __forceinline__ int gather_row(const Unit& u, int r) const { return rowtok[u.pm * 256 + r]; }
};

template <bool GATHER, class Epi, class Sched>
__device__ __forceinline__ void gemm_phase(LAS unsigned char* lds, const int K_, const Sched& S, const Epi& E) {
    int K = K_; asm volatile("" : "+s"(K));
    const int tid = threadIdx.x, wid = __builtin_amdgcn_readfirstlane(tid >> 6), lane = tid & 63, wr = wid >> 2, wc = wid & 3, fr = lane & 15, fq = lane >> 4;
    const int nt = K / BK;
    unsigned voffA[2], voffB[2]; int Rr[2], Cc[2];
#pragma unroll
    for (int i = 0; i < 2; ++i) { int R, C; stage_rc(tid * 16 + i * 8192, R, C); const int Rb = (R & ~31) + perm32(R & 31);
        Rr[i] = R; Cc[i] = C; voffA[i] = (unsigned)(R * K + C) * 2u; voffB[i] = (unsigned)(Rb * K + C) * 2u; }
    const size_t kstep = (size_t)(BK * 2);
    const size_t hstep = (size_t)HALF * K * 2;
    const unsigned ldsw = (unsigned)wid * 1024u;
    const int aoff = lds_byte(wr * 64 + fr, fq * 8), boff = lds_byte(wc * 32 + fr, fq * 8);
    unsigned vgc[2][2], vgn[2][2];
#define G_SA(b, h) (((b) * 2 + (h)) * HTB)
#define G_SB(b, h) ((4 + (b) * 2 + (h)) * HTB)
#define G_STAGE(bufoff, gbase, voff) do { _Pragma("unroll") for (int _i = 0; _i < 2; ++_i) \
        __builtin_amdgcn_global_load_lds((const unsigned*)((const char*)(gbase) + (voff)[_i]), (LAS unsigned*)(lds + (bufoff) + ldsw + _i * 8192), 16, 0, 0); } while (0)
#define G_STAGE_A(bufoff, kptr, h, VG) do { if (GATHER) { G_STAGE(bufoff, kptr, VG[h]); } else { G_STAGE(bufoff, (kptr) + (h) * hstep, voffA); } } while (0)
#define G_LDA(dst, b, h) do { _Pragma("unroll") for (int m = 0; m < 4; ++m) _Pragma("unroll") for (int k = 0; k < 2; ++k) dst[m][k] = *(const LAS bf16x8*)(lds + G_SA(b, h) + aoff + m * 2048 + k * 1024); } while (0)
#define G_LDB(dst, b, h) do { _Pragma("unroll") for (int n = 0; n < 2; ++n) _Pragma("unroll") for (int k = 0; k < 2; ++k) dst[n][k] = *(const LAS bf16x8*)(lds + G_SB(b, h) + boff + n * 2048 + k * 1024); } while (0)
#define G_MMA(ai, bj, At, Bt) do { __builtin_amdgcn_s_setprio(1); _Pragma("unroll") for (int m = 0; m < 4; ++m) _Pragma("unroll") for (int n = 0; n < 2; ++n) _Pragma("unroll") for (int k = 0; k < 2; ++k) \
        acc[ai][bj][m][n] = __builtin_amdgcn_mfma_f32_16x16x32_bf16(Bt[n][k], At[m][k], acc[ai][bj][m][n], 0, 0, 0); __builtin_amdgcn_s_setprio(0); } while (0)
#define G_WAIT_V(n) asm volatile("s_waitcnt vmcnt(" #n ")" ::: "memory")
#define G_WAIT_L(n) asm volatile("s_waitcnt lgkmcnt(" #n ")" ::: "memory")
#define G_BAR __builtin_amdgcn_s_barrier()
#define G_SCHED __builtin_amdgcn_sched_barrier(0)
    Unit cur, nxt;
    int ui = 0;
    if (!S.next(0, cur)) return;
    f32x4 acc[2][2][4][2];
#pragma unroll
    for (int a = 0; a < 2; ++a)
#pragma unroll
        for (int b = 0; b < 2; ++b)
#pragma unroll
            for (int m = 0; m < 4; ++m)
#pragma unroll
                for (int n = 0; n < 2; ++n) acc[a][b][m][n] = (f32x4){0.f, 0.f, 0.f, 0.f};
    bf16x8 At[4][2], B0[2][2], B1[2][2];
    const char* cA = S.a_ptr(cur); const char* cB = S.b_ptr(cur);
    if (GATHER) {
#pragma unroll
        for (int h = 0; h < 2; ++h)
#pragma unroll
            for (int i = 0; i < 2; ++i) vgc[h][i] = (unsigned)(S.gather_row(cur, h * HALF + Rr[i]) * K + Cc[i]) * 2u;
    }
    G_STAGE(G_SB(0, 0), cB, voffB); G_STAGE_A(G_SA(0, 0), cA, 0, vgc); G_STAGE(G_SB(0, 1), cB + hstep, voffB); G_STAGE_A(G_SA(0, 1), cA, 1, vgc);
    if (wr == 1) G_BAR;
    G_WAIT_V(4); G_BAR;
    G_STAGE(G_SB(1, 0), cB + kstep, voffB); G_STAGE_A(G_SA(1, 0), cA + kstep, 0, vgc); G_STAGE(G_SB(1, 1), cB + hstep + kstep, voffB);
    G_WAIT_V(6); G_BAR;
    for (;;) {
        const bool has_next = S.next(ui + 1, nxt);
        const char* nA = has_next ? S.a_ptr(nxt) : cA; const char* nB = has_next ? S.b_ptr(nxt) : cB;
        if (GATHER) {
#pragma unroll
            for (int h = 0; h < 2; ++h)
#pragma unroll
                for (int i = 0; i < 2; ++i) vgn[h][i] = has_next ? (unsigned)(S.gather_row(nxt, h * HALF + Rr[i]) * K + Cc[i]) * 2u : vgc[h][i];
        }
        for (int t = 0; t < nt; t += 2) {
            const bool last = (t == nt - 2);
            const char* a1 = cA + (size_t)(t + 1) * kstep;
            const char* a2 = last ? nA : cA + (size_t)(t + 2) * kstep; const char* b2 = last ? nB : cB + (size_t)(t + 2) * kstep;
            const char* a3 = a2 + kstep; const char* b3 = b2 + kstep;
            unsigned vg2[2][2];
            if (GATHER) {
#pragma unroll
                for (int h = 0; h < 2; ++h)
#pragma unroll
                    for (int i = 0; i < 2; ++i) vg2[h][i] = last ? vgn[h][i] : vgc[h][i];
            }
            G_LDB(B0, 0, 0); G_SCHED; G_LDA(At, 0, 0); G_STAGE_A(G_SA(1, 1), a1, 1, vgc);
            G_WAIT_L(8); G_BAR; G_WAIT_L(0); G_MMA(0, 0, At, B0); G_BAR; G_SCHED;
            G_LDB(B1, 0, 1); G_STAGE(G_SB(0, 0), b2, voffB);
            G_BAR; G_WAIT_L(0); G_MMA(0, 1, At, B1); G_BAR;
            G_LDA(At, 0, 1); G_STAGE_A(G_SA(0, 0), a2, 0, vg2);
            G_BAR; G_WAIT_L(0); G_MMA(1, 0, At, B0); G_BAR; G_SCHED;
            G_STAGE(G_SB(0, 1), b2 + hstep, voffB);
            G_WAIT_V(6); G_BAR; G_MMA(1, 1, At, B1); G_BAR;
            G_LDB(B0, 1, 0); G_SCHED; G_LDA(At, 1, 0); G_STAGE_A(G_SA(0, 1), a2, 1, vg2);
            G_WAIT_L(8); G_BAR; G_WAIT_L(0); G_MMA(0, 0, At, B0); G_BAR; G_SCHED;
            G_LDB(B1, 1, 1); G_STAGE(G_SB(1, 0), b3, voffB);
            G_BAR; G_WAIT_L(0); G_MMA(0, 1, At, B1); G_BAR;
            G_LDA(At, 1, 1); G_STAGE_A(G_SA(1, 0), a3, 0, vg2);
            G_BAR; G_WAIT_L(0); G_MMA(1, 0, At, B0); G_BAR; G_SCHED;
            G_STAGE(G_SB(1, 1), b3 + hstep, voffB);
            G_WAIT_V(6); G_BAR; G_MMA(1, 1, At, B1); G_BAR;
        }
        const bool keep_acc = E(acc, cur, wr, wc, fr, fq);
        if (!has_next) break;
        if (!keep_acc)
#pragma unroll
        for (int a = 0; a < 2; ++a)
#pragma unroll
            for (int b = 0; b < 2; ++b)
#pragma unroll
                for (int m = 0; m < 4; ++m)
#pragma unroll
                    for (int n = 0; n < 2; ++n) acc[a][b][m][n] = (f32x4){0.f, 0.f, 0.f, 0.f};
        cur = nxt; cA = nA; cB = nB; ++ui;
        if (GATHER) {
#pragma unroll
            for (int h = 0; h < 2; ++h)
#pragma unroll
                for (int i = 0; i < 2; ++i) vgc[h][i] = vgn[h][i];
        }
    }
    G_WAIT_V(0);
    if (wr == 0) G_BAR;
    G_BAR;
#undef G_SA
#undef G_SB
#undef G_STAGE
#undef G_STAGE_A
#undef G_LDA
#undef G_LDB
#undef G_MMA
#undef G_WAIT_V
#undef G_WAIT_L
#undef G_BAR
#undef G_SCHED
}

struct EpiProj {
    bf16_t* prkv; bf16_t* pconv; bf16_t* gates; const float* rstd1;
    __device__ __forceinline__ bool operator()(const f32x4 (&acc)[2][2][4][2], const Unit& u, int wr, int wc, int fr, int fq) const {
        const int row0 = u.pm * BM + wr * 64 + fr;
        const bool isg = u.pn >= 14;
        float rsv[2][4];
#pragma unroll
        for (int ai = 0; ai < 2; ++ai)
#pragma unroll
            for (int m = 0; m < 4; ++m) rsv[ai][m] = rstd1[NMETA + row0 + ai * HALF + m * 16];
#pragma unroll
        for (int ai = 0; ai < 2; ++ai)
#pragma unroll
            for (int m = 0; m < 4; ++m) {
                const int row = row0 + ai * HALF + m * 16;
                const float rs = rsv[ai][m];
                bf16_t* rowp = isg ? gates + (size_t)row * 2048 + (u.pn - 14) * 256 + wc * 32 + 8 * fq
                             : (u.pn < 6 ? prkv + (size_t)(NMETA + row) * 1536 + u.pn * 256 : pconv + (size_t)(NMETA + row) * 2048 + (u.pn - 6) * 256) + wc * 32 + 8 * fq;
#pragma unroll
                for (int bj = 0; bj < 2; ++bj) {
                    f32x4 v0 = acc[ai][bj][m][0] * rs, v1 = acc[ai][bj][m][1] * rs;
                    if (isg) {
#pragma unroll
                        for (int j = 0; j < 4; ++j) { v0[j] = sigmoidf_(v0[j]); v1[j] = sigmoidf_(v1[j]); }
                    }
                    u32x4 w; w.x = cvt_pk_bf16(v0[0], v0[1]); w.y = cvt_pk_bf16(v0[2], v0[3]); w.z = cvt_pk_bf16(v1[0], v1[1]); w.w = cvt_pk_bf16(v1[2], v1[3]);
                    *(u32x4*)(rowp + bj * HALF) = w;
                }
            }
        return false;
    }
};
struct EpiL {
    float* LD; bf16_t* Ab; bf16_t* Gb; const float* w0; const float* a0;
    __device__ __forceinline__ bool operator()(const f32x4 (&acc)[2][2][4][2], const Unit& u, int wr, int wc, int fr, int fq) const {
        const int row0 = u.pm * BM + wr * 64 + fr;
        const int seg = u.pn >> 1;
        const int cb = (u.pn & 1) * 256 + wc * 32 + 8 * fq;
        const float* bias = seg == 0 ? w0 : a0;
        f32x4 bv[2][2];
#pragma unroll
        for (int bj = 0; bj < 2; ++bj) {
            bv[bj][0] = seg < 2 ? *(const f32x4*)(bias + cb + bj * HALF) : (f32x4){0.f, 0.f, 0.f, 0.f};
            bv[bj][1] = seg < 2 ? *(const f32x4*)(bias + cb + bj * HALF + 4) : (f32x4){0.f, 0.f, 0.f, 0.f};
        }
        const float sc = seg == 0 ? -0.60653065971f : 1.0f;
        bf16_t* ob = seg == 1 ? Ab : Gb;
#pragma unroll
        for (int ai = 0; ai < 2; ++ai)
#pragma unroll
            for (int m = 0; m < 4; ++m) {
                const int row = row0 + ai * HALF + m * 16;
#pragma unroll
                for (int bj = 0; bj < 2; ++bj) {
                    const int c = cb + bj * HALF;
                    f32x4 v0 = acc[ai][bj][m][0] + bv[bj][0], v1 = acc[ai][bj][m][1] + bv[bj][1];
                    if (seg < 2) {
#pragma unroll
                        for (int j = 0; j < 4; ++j) { v0[j] = sc * sigmoidf_(v0[j]); v1[j] = sc * sigmoidf_(v1[j]); }
                    }
                    if (seg == 0) {
                        float* p = LD + (size_t)row * 512 + c;
                        *(f32x4*)p = v0; *(f32x4*)(p + 4) = v1;
                    } else {
                        u32x4 w; w.x = cvt_pk_bf16(v0[0], v0[1]); w.y = cvt_pk_bf16(v0[2], v0[3]); w.z = cvt_pk_bf16(v1[0], v1[1]); w.w = cvt_pk_bf16(v1[2], v1[3]);
                        *(u32x4*)(ob + (size_t)row * 512 + c) = w;
                    }
                }
            }
        return false;
    }
};
template <int SECOND> struct EpiMerge {
    bf16_t* merged; const bf16_t* gates;
    __device__ __forceinline__ bool operator()(const f32x4 (&acc)[2][2][4][2], const Unit& u, int wr, int wc, int fr, int fq) const {
        const int row0 = u.pm * BM + wr * 64 + fr, col0 = u.pn * BM + wc * 32 + 8 * fq;
#pragma unroll
        for (int ai = 0; ai < 2; ++ai)
#pragma unroll
            for (int m = 0; m < 4; ++m) {
                const int row = row0 + ai * HALF + m * 16;
#pragma unroll
                for (int bj = 0; bj < 2; ++bj) {
                    const int c = col0 + bj * HALF;
                    const u32x4 gw = *(const u32x4*)(gates + (size_t)row * 2048 + SECOND * 1024 + c);
                    f32x4 g0 = (f32x4){bflo(gw.x), bfhi(gw.x), bflo(gw.y), bfhi(gw.y)}, g1 = (f32x4){bflo(gw.z), bfhi(gw.z), bflo(gw.w), bfhi(gw.w)};
                    f32x4 v0 = acc[ai][bj][m][0] * g0, v1 = acc[ai][bj][m][1] * g1;
                    bf16_t* p = merged + (size_t)row * 1024 + c;
                    if (SECOND) {
                        const u32x4 ow = *(const u32x4*)p;
                        v0 += (f32x4){bflo(ow.x), bfhi(ow.x), bflo(ow.y), bfhi(ow.y)}; v1 += (f32x4){bflo(ow.z), bfhi(ow.z), bflo(ow.w), bfhi(ow.w)};
                    }
                    u32x4 w; w.x = cvt_pk_bf16(v0[0], v0[1]); w.y = cvt_pk_bf16(v0[2], v0[3]); w.z = cvt_pk_bf16(v1[0], v1[1]); w.w = cvt_pk_bf16(v1[2], v1[3]);
                    *(u32x4*)p = w;
                }
            }
        return false;
    }
};
struct MergeOrder {
    StaticOrder so; const char* A1; const char* B1;
    __device__ bool next(int i, Unit& u) const { const bool ok = so.next(i >> 1, u); u.aux = i & 1; return ok; }
    __device__ __forceinline__ const char* a_ptr(const Unit& u) const { return (u.aux ? A1 : so.A) + (size_t)u.pm * 256 * so.K * 2; }
    __device__ __forceinline__ const char* b_ptr(const Unit& u) const { return (u.aux ? B1 : so.Bt) + (size_t)u.pn * 256 * so.K * 2; }
    __device__ __forceinline__ int gather_row(const Unit&, int) const { return 0; }
};
struct EpiMergeFused {
    bf16_t* merged; const bf16_t* gates;
    __device__ __forceinline__ bool operator()(f32x4 (&acc)[2][2][4][2], const Unit& u, int wr, int wc, int fr, int fq) const {
        const int row0 = u.pm * BM + wr * 64 + fr, col0 = u.pn * BM + wc * 32 + 8 * fq;
#pragma unroll
        for (int ai = 0; ai < 2; ++ai) {
            u32x4 gbw[4][2], gaw[4][2];
#pragma unroll
            for (int m = 0; m < 4; ++m)
#pragma unroll
                for (int bj = 0; bj < 2; ++bj) {
                    const bf16_t* gp = gates + (size_t)(row0 + ai * HALF + m * 16) * 2048 + col0 + bj * HALF;
                    gbw[m][bj] = *(const u32x4*)(gp + 1024);
                    gaw[m][bj] = u.aux == 0 ? *(const u32x4*)gp : (u32x4){0u, 0u, 0u, 0u};
                }
#pragma unroll
            for (int m = 0; m < 4; ++m)
#pragma unroll
                for (int bj = 0; bj < 2; ++bj) {
                    const int row = row0 + ai * HALF + m * 16, c = col0 + bj * HALF;
                    f32x4 gb0 = (f32x4){bflo(gbw[m][bj].x), bfhi(gbw[m][bj].x), bflo(gbw[m][bj].y), bfhi(gbw[m][bj].y)}, gb1 = (f32x4){bflo(gbw[m][bj].z), bfhi(gbw[m][bj].z), bflo(gbw[m][bj].w), bfhi(gbw[m][bj].w)};
#pragma unroll
                    for (int j = 0; j < 4; ++j) { gb0[j] = fmaxf(gb0[j], 1e-6f); gb1[j] = fmaxf(gb1[j], 1e-6f); }
                    if (u.aux == 0) {
                        const f32x4 ga0 = (f32x4){bflo(gaw[m][bj].x), bfhi(gaw[m][bj].x), bflo(gaw[m][bj].y), bfhi(gaw[m][bj].y)}, ga1 = (f32x4){bflo(gaw[m][bj].z), bfhi(gaw[m][bj].z), bflo(gaw[m][bj].w), bfhi(gaw[m][bj].w)};
#pragma unroll
                        for (int j = 0; j < 4; ++j) { acc[ai][bj][m][0][j] *= ga0[j] * __builtin_amdgcn_rcpf(gb0[j]); acc[ai][bj][m][1][j] *= ga1[j] * __builtin_amdgcn_rcpf(gb1[j]); }
                    } else {
                        const f32x4 v0 = acc[ai][bj][m][0] * gb0, v1 = acc[ai][bj][m][1] * gb1;
                        u32x4 w; w.x = cvt_pk_bf16(v0[0], v0[1]); w.y = cvt_pk_bf16(v0[2], v0[3]); w.z = cvt_pk_bf16(v1[0], v1[1]); w.w = cvt_pk_bf16(v1[2], v1[3]);
                        *(u32x4*)(merged + (size_t)row * 1024 + c) = w;
                    }
                }
        }
        return u.aux == 0;
    }
};
struct EpiO {
    const float* x; float* h1; bf16_t* hb2;
    __device__ __forceinline__ bool operator()(const f32x4 (&acc)[2][2][4][2], const Unit& u, int wr, int wc, int fr, int fq) const {
        const int row0 = u.pm * BM + wr * 64 + fr, col0 = u.pn * BM + wc * 32 + 8 * fq;
#pragma unroll
        for (int ai = 0; ai < 2; ++ai) {
            f32x4 xv[4][2][2];
#pragma unroll
            for (int m = 0; m < 4; ++m)
#pragma unroll
                for (int bj = 0; bj < 2; ++bj) {
                    const size_t o = (size_t)(row0 + ai * HALF + m * 16) * 1024 + col0 + bj * HALF;
                    xv[m][bj][0] = *(const f32x4*)(x + o); xv[m][bj][1] = *(const f32x4*)(x + o + 4);
                }
#pragma unroll
            for (int m = 0; m < 4; ++m)
#pragma unroll
                for (int bj = 0; bj < 2; ++bj) {
                    const size_t o = (size_t)(row0 + ai * HALF + m * 16) * 1024 + col0 + bj * HALF;
                    const f32x4 v0 = acc[ai][bj][m][0] + xv[m][bj][0], v1 = acc[ai][bj][m][1] + xv[m][bj][1];
                    *(f32x4*)(h1 + o) = v0; *(f32x4*)(h1 + o + 4) = v1;
                    u32x4 w; w.x = cvt_pk_bf16(v0[0], v0[1]); w.y = cvt_pk_bf16(v0[2], v0[3]); w.z = cvt_pk_bf16(v1[0], v1[1]); w.w = cvt_pk_bf16(v1[2], v1[3]);
                    *(u32x4*)(hb2 + o) = w;
                }
        }
        return false;
    }
};
struct EpiMoe1 {
    bf16_t* act; const float* rowrs; const float* bg; const float* bu;
    __device__ __forceinline__ bool operator()(const f32x4 (&acc)[2][2][4][2], const Unit& u, int wr, int wc, int fr, int fq) const {
        const int row0 = u.pm * BM + wr * 64 + fr, ff0 = u.pn * 128 + wc * 32 + 8 * fq;
        const float* bgp = bg + (size_t)u.aux * DFF + ff0; const float* bup = bu + (size_t)u.aux * DFF + ff0;
        const f32x4 bg0 = *(const f32x4*)bgp, bg1 = *(const f32x4*)(bgp + 4), bu0 = *(const f32x4*)bup, bu1 = *(const f32x4*)(bup + 4);
        float rsv[2][4];
#pragma unroll
        for (int ai = 0; ai < 2; ++ai)
#pragma unroll
            for (int m = 0; m < 4; ++m) rsv[ai][m] = rowrs[row0 + ai * HALF + m * 16];
#pragma unroll
        for (int ai = 0; ai < 2; ++ai)
#pragma unroll
            for (int m = 0; m < 4; ++m) {
                const int row = row0 + ai * HALF + m * 16;
                const float rs = rsv[ai][m];
                f32x4 g0 = acc[ai][0][m][0] * rs + bg0, g1 = acc[ai][0][m][1] * rs + bg1, u0 = acc[ai][1][m][0] * rs + bu0, u1 = acc[ai][1][m][1] * rs + bu1;
                f32x4 r0, r1;
#pragma unroll
                for (int j = 0; j < 4; ++j) {
                    { const float gt = fminf(g0[j], 7.0f), up = fminf(fmaxf(u0[j], -7.0f), 7.0f); r0[j] = (up + 1.0f) * gt * sigmoidf_(1.702f * gt); }
                    { const float gt = fminf(g1[j], 7.0f), up = fminf(fmaxf(u1[j], -7.0f), 7.0f); r1[j] = (up + 1.0f) * gt * sigmoidf_(1.702f * gt); }
                }
                u32x4 w; w.x = cvt_pk_bf16(r0[0], r0[1]); w.y = cvt_pk_bf16(r0[2], r0[3]); w.z = cvt_pk_bf16(r1[0], r1[1]); w.w = cvt_pk_bf16(r1[2], r1[3]);
                *(u32x4*)(act + (size_t)row * DFF + ff0) = w;
            }
        return false;
    }
};
struct EpiMoe2 {
    bf16_t* ya; bf16_t* yb; const int* rowslot; const float* roww; const float* bd;
    __device__ __forceinline__ bool operator()(const f32x4 (&acc)[2][2][4][2], const Unit& u, int wr, int wc, int fr, int fq) const {
        const int row0 = u.pm * BM + wr * 64 + fr, col0 = u.pn * BM + wc * 32 + 8 * fq;
        bf16_t* ybase = (u.pn < 2) ? ya : yb; const int yc0 = col0 & 511;
        const float* bp = bd + (size_t)u.aux * D + col0;
        f32x4 bv[2][2];
#pragma unroll
        for (int bj = 0; bj < 2; ++bj) { bv[bj][0] = *(const f32x4*)(bp + bj * HALF); bv[bj][1] = *(const f32x4*)(bp + bj * HALF + 4); }
        int slotv[2][4]; float wv8[2][4];
#pragma unroll
        for (int ai = 0; ai < 2; ++ai)
#pragma unroll
            for (int m = 0; m < 4; ++m) { slotv[ai][m] = rowslot[row0 + ai * HALF + m * 16]; wv8[ai][m] = roww[row0 + ai * HALF + m * 16]; }
#pragma unroll
        for (int ai = 0; ai < 2; ++ai)
#pragma unroll
            for (int m = 0; m < 4; ++m) {
                const int slot = slotv[ai][m];
                if (slot >= 0) {
                    const float w8 = wv8[ai][m];
#pragma unroll
                    for (int bj = 0; bj < 2; ++bj) {
                        const f32x4 v0 = (acc[ai][bj][m][0] + bv[bj][0]) * w8, v1 = (acc[ai][bj][m][1] + bv[bj][1]) * w8;
                        u32x4 w; w.x = cvt_pk_bf16(v0[0], v0[1]); w.y = cvt_pk_bf16(v0[2], v0[3]); w.z = cvt_pk_bf16(v1[0], v1[1]); w.w = cvt_pk_bf16(v1[2], v1[3]);
                        *(u32x4*)(ybase + (size_t)slot * 512 + yc0 + bj * HALF) = w;
                    }
                }
            }
        return false;
    }
};

__device__ __forceinline__ void transpose_tile(LAS float* tile, const float* src, int ldsrc, int k0, int n0, bf16_t* dst, int ldd, int drow0, const float* sa, const float* mu, int mode, bool zero) {
    const int tid = threadIdx.x;
    if (!zero) {
#pragma unroll
        for (int i = 0; i < 2; ++i) {
            const int r = (tid >> 4) + 32 * i, c4 = (tid & 15) * 4;
            const f32x4 v = *(const f32x4*)(src + (size_t)(k0 + r) * ldsrc + n0 + c4);
            LAS float* t = tile + r * 65 + c4;
            t[0] = v[0]; t[1] = v[1]; t[2] = v[2]; t[3] = v[3];
        }
    }
    __syncthreads();
    {
        const int n = tid >> 3, kq = tid & 7;
        float v[8];
#pragma unroll
        for (int j = 0; j < 8; ++j) {
            const int k = k0 + 8 * kq + j;
            float s = sa ? sa[k] : 1.0f;
            if (mode == 1) s *= (1.0f - mu[k]);
            if (mode == 2) s *= mu[k];
            v[j] = zero ? 0.f : tile[(8 * kq + j) * 65 + n] * s;
        }
        u32x4 w; w.x = cvt_pk_bf16(v[0], v[1]); w.y = cvt_pk_bf16(v[2], v[3]); w.z = cvt_pk_bf16(v[4], v[5]); w.w = cvt_pk_bf16(v[6], v[7]);
        *(u32x4*)(dst + (size_t)(drow0 + n) * ldd + k0 + 8 * kq) = w;
    }
    __syncthreads();
}

__device__ __forceinline__ void phase_prep(const PPv& p, LAS unsigned char* lds) {
    const int tid = threadIdx.x, bid = blockIdx.x, nb = gridDim.x, lane = tid & 63, wave = tid >> 6;
    unsigned char* ws = p.gws();
    const float* x = p.gin(0); const float* meta = p.gin(1); const float* g1 = p.gin(2);
    if (bid == 0 && tid < 64) ((int*)(ws + OFF_GCNT))[tid] = 0;
    {
        bf16_t* HB = (bf16_t*)(ws + OFF_HB); float* rstd1 = (float*)(ws + OFF_RSTD1);
        for (int row = bid * 8 + wave; row < NR; row += nb * 8) {
            const float* src = row < NMETA ? meta + (size_t)row * D : x + (size_t)(row - NMETA) * D;
            float ss = 0.f; f32x4 v[4];
#pragma unroll
            for (int i = 0; i < 4; ++i) { v[i] = *(const f32x4*)(src + i * 256 + lane * 4); ss += v[i][0] * v[i][0] + v[i][1] * v[i][1] + v[i][2] * v[i][2] + v[i][3] * v[i][3]; }
            ss = wave_sum(ss);
            if (lane == 0) rstd1[row] = rsqrtf(ss * (1.0f / D) + NORM_EPS);
            if (row >= NMETA) {
                bf16_t* d = HB + (size_t)(row - NMETA) * D;
#pragma unroll
                for (int i = 0; i < 4; ++i) { u32x2 w; w.x = cvt_pk_bf16(v[i][0], v[i][1]); w.y = cvt_pk_bf16(v[i][2], v[i][3]); *(u32x2*)(d + i * 256 + lane * 4) = w; }
            }
        }
    }
    LAS float* tile = (LAS float*)lds;
    {
        bf16_t* WIN = (bf16_t*)(ws + OFF_WIN);
        const float* w_in = p.gin(3);
        for (int j = bid; j < 16 * 88; j += nb) {
            const int kt = j & 15, ntile = j >> 4, n0 = ntile * 64;
            const float* src; int ld, sn0, mode = 0; const float* mu = nullptr;
            if (n0 < 3072) { src = w_in; ld = 5120; sn0 = n0; }
            else if (n0 < 3584) {
                const int seg = (n0 - 3072) >> 6;
                if (seg < 2) { src = p.gin(11); ld = 64; sn0 = 0; mu = p.gin(7); mode = 1 + seg; }
                else if (seg < 4) { src = p.gin(14); ld = 64; sn0 = 0; mu = p.gin(8); mode = 1 + (seg - 2); }
                else { src = p.gin(16); ld = 128; sn0 = (seg & 1) * 64; mu = p.gin(9); mode = seg < 6 ? 1 : 2; }
            } else { src = w_in; ld = 5120; sn0 = n0 - 512; }
            transpose_tile(tile, src, ld, kt * 64, sn0, WIN, 1024, n0, g1, mu, mode, false);
        }
        for (int j = bid; j < 2 * 128; j += nb) {
            const int which = j >> 7, jj = j & 127, kt = jj & 7, ntile = jj >> 3;
            transpose_tile(tile, which ? p.gin(25) : p.gin(23), 1024, kt * 64, ntile * 64, (bf16_t*)(ws + (which ? OFF_WC : OFF_WR)), 512, ntile * 64, nullptr, nullptr, 0, false);
        }
        for (int j = bid; j < 256; j += nb) {
            const int kt = j & 15, ntile = j >> 4;
            transpose_tile(tile, p.gin(26), 1024, kt * 64, ntile * 64, (bf16_t*)(ws + OFF_WO), 1024, ntile * 64, nullptr, nullptr, 0, false);
        }
        for (int j = bid; j < 96; j += nb) {
            const int kt = j & 3, ntile = j >> 2, seg = ntile >> 3, nn0 = (ntile & 7) * 64;
            const float* src = nullptr; int sk0 = 0; bool zero = true;
            if (seg == 0 && kt == 0) { src = p.gin(12); sk0 = 0; zero = false; }
            if (seg == 1 && kt == 1) { src = p.gin(15); sk0 = 0; zero = false; }
            if (seg == 2 && kt >= 2) { src = p.gin(17); sk0 = (kt - 2) * 64; zero = false; }
            const float* srcs = zero ? p.gin(12) : src + (size_t)(sk0 - kt * 64) * 512;
            transpose_tile(tile, srcs, 512, kt * 64, nn0, (bf16_t*)(ws + OFF_W2), 256, ntile * 64, nullptr, nullptr, 0, zero);
        }
        {
            float* WRG = (float*)(ws + OFF_WRG); const float* g2 = p.gin(27); const float* wr_ = p.gin(28);
            for (int i = bid * 512 + tid; i < 1024 * 32; i += nb * 512) WRG[i] = g2[i >> 5] * wr_[i];
        }
    }
}

__device__ __forceinline__ void phase_meta_proj(const PPv& p, LAS unsigned char* lds) {
    const int tid = threadIdx.x, bid = blockIdx.x, lane = tid & 63, wave = tid >> 6;
    unsigned char* ws = p.gws();
    LAS float* sm = (LAS float*)lds;
    const float* meta = p.gin(1);
    for (int i = tid; i < 16 * 256; i += 512) { const int r = i >> 8, c4 = (i & 255) * 4; const f32x4 v = *(const f32x4*)(meta + r * 1024 + c4); LAS float* d = sm + r * 1028 + c4; d[0] = v[0]; d[1] = v[1]; d[2] = v[2]; d[3] = v[3]; }
    __syncthreads();
    const float* rstd1 = (const float*)(ws + OFF_RSTD1);
    for (int nbase = bid * 14; nbase < PCOLS1; nbase += gridDim.x * 14) {
        for (int nn = wave; nn < 14; nn += 8) {
            const int n = nbase + nn;
            if (n >= PCOLS1) break;
            const bf16_t* wrow = (const bf16_t*)(ws + OFF_WIN) + (size_t)n * 1024;
            const u32x4 w0 = *(const u32x4*)(wrow + 8 * lane), w1 = *(const u32x4*)(wrow + 512 + 8 * lane);
            const float wf[16] = {bflo(w0.x), bfhi(w0.x), bflo(w0.y), bfhi(w0.y), bflo(w0.z), bfhi(w0.z), bflo(w0.w), bfhi(w0.w),
                                  bflo(w1.x), bfhi(w1.x), bflo(w1.y), bfhi(w1.y), bflo(w1.z), bfhi(w1.z), bflo(w1.w), bfhi(w1.w)};
            float outv = 0.f;
#pragma unroll
            for (int pr = 0; pr < 16; ++pr) {
                const LAS float* m0 = sm + pr * 1028 + 8 * lane;
                const f32x4 a0 = *(const LAS f32x4*)m0, a1 = *(const LAS f32x4*)(m0 + 4), a2 = *(const LAS f32x4*)(m0 + 512), a3 = *(const LAS f32x4*)(m0 + 516);
                float acc = a0[0] * wf[0] + a0[1] * wf[1] + a0[2] * wf[2] + a0[3] * wf[3] + a1[0] * wf[4] + a1[1] * wf[5] + a1[2] * wf[6] + a1[3] * wf[7]
                          + a2[0] * wf[8] + a2[1] * wf[9] + a2[2] * wf[10] + a2[3] * wf[11] + a3[0] * wf[12] + a3[1] * wf[13] + a3[2] * wf[14] + a3[3] * wf[15];
                acc = wave_sum_dpp(acc);
                outv = (lane == pr) ? acc * rstd1[pr] : outv;
            }
            if (lane < 16) {
                if (n < 1536) ((bf16_t*)(ws + OFF_PRKV))[(size_t)lane * 1536 + n] = f2bf(outv);
                else ((bf16_t*)(ws + OFF_PCONV))[(size_t)lane * 2048 + n - 1536] = f2bf(outv);
            }
        }
    }
    __syncthreads();
}

__device__ __forceinline__ void phase_lprep_conv(const PPv& p) {
    const int tid = threadIdx.x, bid = blockIdx.x, nb = gridDim.x;
    unsigned char* ws = p.gws();
    const bf16_t* PROJ = (const bf16_t*)(ws + OFF_PCONV);
    constexpr int PCOLS = 2048;
    bf16_t* L = (bf16_t*)(ws + OFF_L);
    for (int i = bid * 512 + tid; i < NRP * 32; i += nb * 512) {
        const int row = i >> 5, gq = i & 31;
        u32x4 w = (u32x4){0u, 0u, 0u, 0u};
        if (row < NR) {
            int ca, cb;
            if (gq < 8) { ca = 1536 + gq * 8; cb = ca + 64; }
            else if (gq < 16) { ca = 1536 + 128 + (gq - 8) * 8; cb = ca + 64; }
            else { ca = 1536 + 256 + (gq - 16) * 8; cb = ca + 128; }
            const u32x4 va = *(const u32x4*)(PROJ + (size_t)row * PCOLS + ca);
            const int pr = prev_row(row, 1);
            u32x4 vb = (u32x4){0u, 0u, 0u, 0u};
            if (pr >= 0) vb = *(const u32x4*)(PROJ + (size_t)pr * PCOLS + cb);
            float v[8] = {bflo(va.x) + bflo(vb.x), bfhi(va.x) + bfhi(vb.x), bflo(va.y) + bflo(vb.y), bfhi(va.y) + bfhi(vb.y), bflo(va.z) + bflo(vb.z), bfhi(va.z) + bfhi(vb.z), bflo(va.w) + bflo(vb.w), bfhi(va.w) + bfhi(vb.w)};
#pragma unroll
            for (int j = 0; j < 8; ++j) { if (gq < 8) v[j] = tanhf(v[j]); else if (gq >= 16) v[j] = sigmoidf_(v[j]); }
            w.x = cvt_pk_bf16(v[0], v[1]); w.y = cvt_pk_bf16(v[2], v[3]); w.z = cvt_pk_bf16(v[4], v[5]); w.w = cvt_pk_bf16(v[6], v[7]);
        }
        *(u32x4*)(L + (size_t)row * 256 + gq * 8) = w;
    }
    bf16_t* C = (bf16_t*)(ws + OFF_C);
    const float* cw = p.gin(24);
    for (int i = bid * 512 + tid; i < T * 64; i += nb * 512) {
        const int m = i >> 6, ch = (i & 63) * 8, row = NMETA + m;
        const int r1 = prev_row(row, 1), r2 = prev_row(row, 2);
        const bf16_t* p0 = PROJ + (size_t)row * PCOLS; const bf16_t* p1 = PROJ + (size_t)r1 * PCOLS; const bf16_t* p2 = PROJ + (size_t)r2 * PCOLS;
        const u32x4 vb = *(const u32x4*)(p0 + ch);
        const u32x4 c0 = *(const u32x4*)(p0 + 512 + ch), h0 = *(const u32x4*)(p0 + 1024 + ch);
        const u32x4 c1 = *(const u32x4*)(p1 + 512 + ch), h1 = *(const u32x4*)(p1 + 1024 + ch);
        const u32x4 c2 = *(const u32x4*)(p2 + 512 + ch), h2 = *(const u32x4*)(p2 + 1024 + ch);
        float o[8];
#pragma unroll
        for (int j = 0; j < 8; ++j) {
            const unsigned wb = j < 2 ? vb.x : j < 4 ? vb.y : j < 6 ? vb.z : vb.w;
            const unsigned wc0 = j < 2 ? c0.x : j < 4 ? c0.y : j < 6 ? c0.z : c0.w, wh0 = j < 2 ? h0.x : j < 4 ? h0.y : j < 6 ? h0.z : h0.w;
            const unsigned wc1 = j < 2 ? c1.x : j < 4 ? c1.y : j < 6 ? c1.z : c1.w, wh1 = j < 2 ? h1.x : j < 4 ? h1.y : j < 6 ? h1.z : h1.w;
            const unsigned wc2 = j < 2 ? c2.x : j < 4 ? c2.y : j < 6 ? c2.z : c2.w, wh2 = j < 2 ? h2.x : j < 4 ? h2.y : j < 6 ? h2.z : h2.w;
            const bool hi = j & 1;
            const float b = hi ? bfhi(wb) : bflo(wb);
            const float u0 = (hi ? bfhi(wc0) : bflo(wc0)) * (hi ? bfhi(wh0) : bflo(wh0));
            const float u1 = (hi ? bfhi(wc1) : bflo(wc1)) * (hi ? bfhi(wh1) : bflo(wh1));
            const float u2 = (hi ? bfhi(wc2) : bflo(wc2)) * (hi ? bfhi(wh2) : bflo(wh2));
            const float conv = cw[ch + j] * u2 + cw[512 + ch + j] * u1 + cw[1024 + ch + j] * u0;
            o[j] = b * conv;
        }
        u32x4 w; w.x = cvt_pk_bf16(o[0], o[1]); w.y = cvt_pk_bf16(o[2], o[3]); w.z = cvt_pk_bf16(o[4], o[5]); w.w = cvt_pk_bf16(o[6], o[7]);
        *(u32x4*)(C + (size_t)m * 512 + ch) = w;
    }
}

template <int CTRL> __device__ __forceinline__ float dppmov(float v) { return __builtin_bit_cast(float, __builtin_amdgcn_update_dpp(0, __builtin_bit_cast(int, v), CTRL, 0xF, 0xF, true)); }
__device__ __forceinline__ float wave_sum_dpp(float v) {
    v += dppmov<0xB1>(v);
    v += dppmov<0x4E>(v);
    v += dppmov<0x141>(v);
    v += dppmov<0x140>(v);
    { float c = v; asm volatile("v_nop\n\tv_nop\n\tv_permlane16_swap_b32 %0, %1\n\tv_nop" : "+v"(v), "+v"(c)); v += c; }
    { float c = v; asm volatile("v_nop\n\tv_nop\n\tv_permlane32_swap_b32 %0, %1\n\tv_nop" : "+v"(v), "+v"(c)); v += c; }
    return v;
}
typedef float f32x16 __attribute__((ext_vector_type(16)));

struct RawTok { bf16_t r, k, v, a; float ld; };
__device__ __forceinline__ RawTok load_raw(const bf16_t* PRKV, const bf16_t* Ab, const float* LD, int row, int col) {
    RawTok q; const bf16_t* p0 = PRKV + (size_t)row * 1536 + col;
    q.r = p0[0]; q.k = p0[512]; q.v = p0[1024]; q.a = Ab[(size_t)row * 512 + col]; q.ld = LD[(size_t)row * 512 + col];
    return q;
}
__device__ __forceinline__ void unit_geom(int uid, int lane, int& b, int& h, int& c, int& col, int& row0) {
    const int bh = uid / NCHUNK; c = uid - bh * NCHUNK; b = bh >> 3; h = bh & 7; col = h * 64 + lane;
    row0 = c == 0 ? 0 : b * SEQ + c * 16;
}
__device__ __forceinline__ void phase_scanprep(const PPv& p, LAS unsigned char* lds) {
    const int tid = threadIdx.x, bid = blockIdx.x, nb = gridDim.x, lane = tid & 63, wave = tid >> 6;
    unsigned char* ws = p.gws();
    const bf16_t* PRKV = (const bf16_t*)(ws + OFF_PRKV);
    const float* LD = (const float*)(ws + OFF_LD);
    const bf16_t* Ab = (const bf16_t*)(ws + OFF_A);
    float* COEF = (float*)(ws + OFF_COEF);
    LAS unsigned char* wl = lds + wave * 13824;
    LAS bf16_t* AR = (LAS bf16_t*)wl;
    LAS bf16_t* BK = (LAS bf16_t*)(wl + 4608);
    LAS float* DM = (LAS float*)(wl + 9216);
    const int qperm = (lane & 32) | (((lane >> 2) & 3) << 3) | (((lane >> 4) & 1) << 2) | (lane & 3);
    int uid = bid * 8 + wave;
    if (uid >= NUNITS) return;
    int b, h, c, col, row0;
    unit_geom(uid, lane, b, h, c, col, row0);
    RawTok q[16], qn[16];
    bf16_t prr = 0, prk = 0, prv = 0, nprr = 0, nprk = 0, nprv = 0;
#pragma unroll
    for (int t = 0; t < 16; ++t) q[t] = load_raw(PRKV, Ab, LD, row0 + t, col);
    { const int pr = prev_row(row0, 1); if (pr >= 0) { const bf16_t* p1 = PRKV + (size_t)pr * 1536 + col; prr = p1[0]; prk = p1[512]; prv = p1[1024]; } }
    for (;;) {
        const float mur = p.gin(4)[col], muk = p.gin(5)[col], muv = p.gin(6)[col], kkw = p.gin(18)[col], kaw = p.gin(19)[col], rkw = p.gin(20)[col];
        const int nuid = uid + nb * 8; const bool has_next = nuid < NUNITS;
        int nb_ = b, nh = h, nc = c, ncol = col, nrow0 = row0;
        if (has_next) {
            unit_geom(nuid, lane, nb_, nh, nc, ncol, nrow0);
#pragma unroll
            for (int t = 0; t < 16; ++t) qn[t] = load_raw(PRKV, Ab, LD, nrow0 + t, ncol);
            nprr = 0; nprk = 0; nprv = 0;
            const int pr = prev_row(nrow0, 1); if (pr >= 0) { const bf16_t* p1 = PRKV + (size_t)pr * 1536 + ncol; nprr = p1[0]; nprk = p1[512]; nprv = p1[1024]; }
        }
        __builtin_amdgcn_sched_barrier(0);
        float at[16], vt[16]; unsigned btp[8], ktp[8]; float bprev = 0.f, kprev = 0.f;
        float cl = 0.f;
        float rp = bf2f(prr), kp = bf2f(prk), vp = bf2f(prv);
#pragma unroll
        for (int t = 0; t < 16; ++t) {
            const RawTok qq = q[t];
            const int row = row0 + t;
            const float r0 = bf2f(qq.r), k0 = bf2f(qq.k), v0 = bf2f(qq.v);
            const float r = r0 + (rp - r0) * mur, k = k0 + (kp - k0) * muk, v = v0 + (vp - v0) * muv;
            rp = r0; kp = k0; vp = v0;
            const float a = bf2f(qq.a);
            const float kkv = k * kkw;
            const float n2 = wave_sum_dpp(kkv * kkv);
            const float kk = kkv * __builtin_amdgcn_rsqf(fmaxf(n2, 1e-24f));
            const float k2 = k * (1.0f + (a - 1.0f) * kaw);
            const float cf = wave_sum_dpp(r * k2 * rkw);
            if (lane == 0) COEF[(size_t)row * 8 + h] = cf;
            const float wcp = __expf(cl);
            cl += qq.ld;
            const float wcn = __expf(cl), iw = __expf(-cl);
            const float btv = kk * a * iw, ktv = k2 * iw;
            at[t] = -kk * wcp; vt[t] = v;
            { const unsigned w = cvt_pk_bf16(at[t], r * wcn); AR[t * 72 + qperm] = (bf16_t)(w & 0xFFFFu); AR[(16 + t) * 72 + qperm] = (bf16_t)(w >> 16); }
            if (t & 1) {
                btp[t >> 1] = cvt_pk_bf16(bprev, btv); ktp[t >> 1] = cvt_pk_bf16(kprev, ktv);
                BK[(t - 1) * 72 + qperm] = (bf16_t)(btp[t >> 1] & 0xFFFFu); BK[t * 72 + qperm] = (bf16_t)(btp[t >> 1] >> 16);
                BK[(16 + t - 1) * 72 + qperm] = (bf16_t)(ktp[t >> 1] & 0xFFFFu); BK[(16 + t) * 72 + qperm] = (bf16_t)(ktp[t >> 1] >> 16);
            } else { bprev = btv; kprev = ktv; }
            if (t & 1) __builtin_amdgcn_sched_barrier(0);
        }
        const float wcc = __expf(cl);
        {
            f32x16 dm;
#pragma unroll
            for (int i = 0; i < 16; ++i) dm[i] = 0.f;
            const int rr = lane & 31, hh = lane >> 5;
#pragma unroll
            for (int ks = 0; ks < 4; ++ks) {
                const bf16x8 fa = *(const LAS bf16x8*)(AR + rr * 72 + 16 * ks + 8 * hh);
                const bf16x8 fb = *(const LAS bf16x8*)(BK + rr * 72 + 16 * ks + 8 * hh);
                dm = __builtin_amdgcn_mfma_f32_32x32x16_bf16(fa, fb, dm, 0, 0, 0);
            }
#pragma unroll
            for (int reg = 0; reg < 16; ++reg) DM[((reg & 3) + 8 * (reg >> 2) + 4 * hh) * 36 + rr] = dm[reg];
        }
        __builtin_amdgcn_sched_barrier(0);
        float uh[16];
#pragma unroll
        for (int t = 0; t < 16; ++t) {
            float wv = at[t], uv = 0.f, wv2 = 0.f, uv2 = 0.f, uv3 = 0.f;
#pragma unroll
            for (int s4 = 0; s4 < 4; ++s4) {
                if (s4 * 4 < t) {
                    const f32x4 ab = *(const LAS f32x4*)(DM + t * 36 + s4 * 4), ak = *(const LAS f32x4*)(DM + t * 36 + 16 + s4 * 4);
#pragma unroll
                    for (int j = 0; j < 4; ++j) {
                        const int s_ = s4 * 4 + j;
                        if (s_ < t) {
                            if (j & 1) { wv2 += ab[j] * at[s_]; uv2 += ak[j] * vt[s_]; } else { wv += ab[j] * at[s_]; uv += ak[j] * vt[s_]; }
                            uv3 += ab[j] * uh[s_];
                        }
                    }
                }
            }
            wv += wv2; uv += uv2 + uv3;
            at[t] = wv; uh[t] = uv;
            asm volatile("" : "+v"(at[t]), "+v"(uh[t]));
        }
        __builtin_amdgcn_sched_barrier(0);
#pragma unroll
        for (int t = 0; t < 16; t += 2) { const unsigned w = cvt_pk_bf16(at[t], at[t + 1]); AR[t * 72 + qperm] = (bf16_t)(w & 0xFFFFu); AR[(t + 1) * 72 + qperm] = (bf16_t)(w >> 16); }
        unsigned char* rec = ws + OFF_CH + (size_t)uid * REC_BYTES;
#pragma unroll
        for (int i = 0; i < 2; ++i) {
            const int pc = i * 64 + lane, row = pc >> 3, part = pc & 7;
            *(u32x4*)(rec + RO_WH + pc * 16) = *(const LAS u32x4*)((LAS unsigned char*)AR + row * 144 + part * 16);
            *(u32x4*)(rec + RO_RT + pc * 16) = *(const LAS u32x4*)((LAS unsigned char*)AR + (16 + row) * 144 + part * 16);
        }
        {
            u32x4 w0, w1;
            w0.x = cvt_pk_bf16(uh[0], uh[1]); w0.y = cvt_pk_bf16(uh[2], uh[3]); w0.z = cvt_pk_bf16(uh[4], uh[5]); w0.w = cvt_pk_bf16(uh[6], uh[7]);
            w1.x = cvt_pk_bf16(uh[8], uh[9]); w1.y = cvt_pk_bf16(uh[10], uh[11]); w1.z = cvt_pk_bf16(uh[12], uh[13]); w1.w = cvt_pk_bf16(uh[14], uh[15]);
            *(u32x4*)(rec + RO_U0T + lane * 32) = w0; *(u32x4*)(rec + RO_U0T + lane * 32 + 16) = w1;
            w0.x = cvt_pk_bf16(vt[0], vt[1]); w0.y = cvt_pk_bf16(vt[2], vt[3]); w0.z = cvt_pk_bf16(vt[4], vt[5]); w0.w = cvt_pk_bf16(vt[6], vt[7]);
            w1.x = cvt_pk_bf16(vt[8], vt[9]); w1.y = cvt_pk_bf16(vt[10], vt[11]); w1.z = cvt_pk_bf16(vt[12], vt[13]); w1.w = cvt_pk_bf16(vt[14], vt[15]);
            *(u32x4*)(rec + RO_VT + lane * 32) = w0; *(u32x4*)(rec + RO_VT + lane * 32 + 16) = w1;
        }
#pragma unroll
        for (int g = 0; g < 4; ++g) {
            u32x4 w; w.x = btp[2 * g]; w.y = btp[2 * g + 1]; w.z = ktp[2 * g]; w.w = ktp[2 * g + 1];
            *(u32x4*)(rec + RO_BKT + lane * 64 + g * 16) = w;
        }
        {
            const int t = lane >> 2, g = lane & 3;
            const f32x4 rb = *(const LAS f32x4*)(DM + (16 + t) * 36 + 4 * g), rk = *(const LAS f32x4*)(DM + (16 + t) * 36 + 16 + 4 * g);
            float o[8];
#pragma unroll
            for (int j = 0; j < 4; ++j) { const bool keep = (4 * g + j) <= t; o[j] = keep ? rb[j] : 0.f; o[4 + j] = keep ? rk[j] : 0.f; }
            u32x4 w; w.x = cvt_pk_bf16(o[0], o[1]); w.y = cvt_pk_bf16(o[2], o[3]); w.z = cvt_pk_bf16(o[4], o[5]); w.w = cvt_pk_bf16(o[6], o[7]);
            *(u32x4*)(rec + RO_ARK + t * 64 + g * 16) = w;
        }
        *(float*)(rec + RO_WCC + lane * 4) = wcc;
        if (!has_next) break;
        uid = nuid; b = nb_; h = nh; c = nc; col = ncol; row0 = nrow0;
#pragma unroll
        for (int t = 0; t < 16; ++t) q[t] = qn[t];
        prr = nprr; prk = nprk; prv = nprv;
        __builtin_amdgcn_sched_barrier(0);
    }
}

__device__ __forceinline__ void convert_expert_weights(const PPv& p, LAS unsigned char* lds, int first, int stride);
struct RecOps { bf16x8 wA0, wA1, rA0, rA1, ark, bk[4]; u32x2 u0, vv; f32x4 wc[4]; };
__device__ __forceinline__ void load_ops(RecOps& o, LAS unsigned char* S, int vs, int fr, int g) {
    o.wA0 = *(const LAS bf16x8*)(S + RO_WH + fr * 128 + g * 16); o.wA1 = *(const LAS bf16x8*)(S + RO_WH + fr * 128 + 64 + g * 16);
    o.rA0 = *(const LAS bf16x8*)(S + RO_RT + fr * 128 + g * 16); o.rA1 = *(const LAS bf16x8*)(S + RO_RT + fr * 128 + 64 + g * 16);
    o.u0 = *(const LAS u32x2*)(S + RO_U0T + (16 * vs + fr) * 32 + g * 8);
    o.vv = *(const LAS u32x2*)(S + RO_VT + (16 * vs + fr) * 32 + g * 8);
    o.ark = *(const LAS bf16x8*)(S + RO_ARK + fr * 64 + g * 16);
#pragma unroll
    for (int m = 0; m < 4; ++m) { o.bk[m] = *(const LAS bf16x8*)(S + RO_BKT + (16 * m + fr) * 64 + g * 16); o.wc[m] = *(const LAS f32x4*)(S + RO_WCC + (16 * m + 4 * g) * 4); }
}
__device__ __forceinline__ void phase_recur(const PPv& p, LAS unsigned char* lds) {
    const int tid = threadIdx.x, bid = blockIdx.x, nb = gridDim.x, lane = tid & 63, wave = __builtin_amdgcn_readfirstlane(tid >> 6);
    unsigned char* ws = p.gws();
    if (bid >= 64) { convert_expert_weights(p, lds, bid - 64, nb - 64); return; }
    unsigned char* CHb = ws + OFF_CH + (size_t)(bid * NCHUNK) * REC_BYTES;
    constexpr int RSLOT = REC_BYTES, RN = 10, PF = 7;
#define R_BAR() do { asm volatile("s_waitcnt lgkmcnt(0)" ::: "memory"); __builtin_amdgcn_s_barrier(); asm volatile("" ::: "memory"); } while (0)
    if (wave >= 4) {
        const int lw = wave - 4;
#define R_ISSUE(x) do { \
            LAS unsigned char* _s = lds + ((x) % RN) * RSLOT; const unsigned char* _r = CHb + (size_t)(x) * REC_BYTES + lane * 16; \
            _Pragma("unroll") for (int _i = 0; _i < 3; ++_i) { const int _pc = lw + 4 * _i; __builtin_amdgcn_global_load_lds((const unsigned*)(_r + _pc * 1024), (LAS unsigned*)(_s + _pc * 1024), 16, 0, 0); } \
            if (lw == 0) __builtin_amdgcn_global_load_lds((const unsigned*)(_r + 12 * 1024), (LAS unsigned*)(_s + 12 * 1024), 16, 0, 0); \
            if (lw == 1) { if (lane < 16) __builtin_amdgcn_global_load_lds((const unsigned*)(_r + 13 * 1024), (LAS unsigned*)(_s + 13 * 1024), 16, 0, 0); } } while (0)
        for (int x = 0; x < PF; ++x) R_ISSUE(x);
        asm volatile("s_waitcnt vmcnt(0)" ::: "memory");
        R_BAR();
        for (int c = 0; c < NCHUNK; ++c) {
            const int x = c + PF;
            if (x < NCHUNK) R_ISSUE(x);
            if (x < NCHUNK) { if (lw < 2) asm volatile("s_waitcnt vmcnt(20)" ::: "memory"); else asm volatile("s_waitcnt vmcnt(15)" ::: "memory"); }
            else asm volatile("s_waitcnt vmcnt(0)" ::: "memory");
            R_BAR();
        }
#undef R_ISSUE
    } else {
        const int vs = wave, fr = lane & 15, g = lane >> 4;
        f32x4 H[4];
#pragma unroll
        for (int m = 0; m < 4; ++m) H[m] = (f32x4){0.f, 0.f, 0.f, 0.f};
        R_BAR();
        RecOps cur, nxt;
        load_ops(cur, lds, vs, fr, g);
        for (int c = 0; c < NCHUNK; ++c) {
            if (c + 1 < NCHUNK) load_ops(nxt, lds + ((c + 1) % RN) * RSLOT, vs, fr, g); else nxt = cur;
            u32x4 hb0, hb1;
            hb0.x = cvt_pk_bf16(H[0][0], H[0][1]); hb0.y = cvt_pk_bf16(H[0][2], H[0][3]); hb0.z = cvt_pk_bf16(H[1][0], H[1][1]); hb0.w = cvt_pk_bf16(H[1][2], H[1][3]);
            hb1.x = cvt_pk_bf16(H[2][0], H[2][1]); hb1.y = cvt_pk_bf16(H[2][2], H[2][3]); hb1.z = cvt_pk_bf16(H[3][0], H[3][1]); hb1.w = cvt_pk_bf16(H[3][2], H[3][3]);
            const bf16x8 hB0 = __builtin_bit_cast(bf16x8, hb0), hB1 = __builtin_bit_cast(bf16x8, hb1);
            f32x4 U = (f32x4){bflo(cur.u0.x), bfhi(cur.u0.x), bflo(cur.u0.y), bfhi(cur.u0.y)};
            U = __builtin_amdgcn_mfma_f32_16x16x32_bf16(cur.wA0, hB0, U, 0, 0, 0);
            U = __builtin_amdgcn_mfma_f32_16x16x32_bf16(cur.wA1, hB1, U, 0, 0, 0);
            f32x4 Y = (f32x4){0.f, 0.f, 0.f, 0.f};
            Y = __builtin_amdgcn_mfma_f32_16x16x32_bf16(cur.rA0, hB0, Y, 0, 0, 0);
            Y = __builtin_amdgcn_mfma_f32_16x16x32_bf16(cur.rA1, hB1, Y, 0, 0, 0);
            u32x4 uvw; uvw.x = cvt_pk_bf16(U[0], U[1]); uvw.y = cvt_pk_bf16(U[2], U[3]); uvw.z = cur.vv.x; uvw.w = cur.vv.y;
            const bf16x8 uv = __builtin_bit_cast(bf16x8, uvw);
            Y = __builtin_amdgcn_mfma_f32_16x16x32_bf16(cur.ark, uv, Y, 0, 0, 0);
#pragma unroll
            for (int m = 0; m < 4; ++m) { H[m] = __builtin_amdgcn_mfma_f32_16x16x32_bf16(cur.bk[m], uv, H[m], 0, 0, 0); H[m] *= cur.wc[m]; }
            u32x2 yw; yw.x = cvt_pk_bf16(Y[0], Y[1]); yw.y = cvt_pk_bf16(Y[2], Y[3]);
            *(u32x2*)(CHb + (size_t)c * REC_BYTES + RO_U0T + (16 * vs + fr) * 32 + g * 8) = yw;
            R_BAR();
            cur = nxt;
        }
    }
#undef R_BAR
}

__device__ __forceinline__ void phase_gn(const PPv& p) {
    const int tid = threadIdx.x, bid = blockIdx.x, nb = gridDim.x, lane = tid & 63, wave = tid >> 6;
    unsigned char* ws = p.gws();
    const bf16_t* Gb = (const bf16_t*)(ws + OFF_G); const float* COEF = (const float*)(ws + OFF_COEF);
    bf16_t* Z = (bf16_t*)(ws + OFF_Z);
    for (int uid = bid * 8 + wave; uid < NUNITS; uid += nb * 8) {
        const int bh = uid / NCHUNK, c = uid - bh * NCHUNK, b = bh >> 3, h = bh & 7;
        if (c == 0) continue;
        const int col = h * 64 + lane, row0 = b * SEQ + c * 16;
        const float lng = p.gin(21)[col], lnb = p.gin(22)[col];
        const unsigned char* rec = ws + OFF_CH + (size_t)uid * REC_BYTES;
        const u32x4 y0 = *(const u32x4*)(rec + RO_U0T + lane * 32), y1 = *(const u32x4*)(rec + RO_U0T + lane * 32 + 16);
        const u32x4 v0 = *(const u32x4*)(rec + RO_VT + lane * 32), v1 = *(const u32x4*)(rec + RO_VT + lane * 32 + 16);
        const unsigned yw[8] = {y0.x, y0.y, y0.z, y0.w, y1.x, y1.y, y1.z, y1.w}, vw[8] = {v0.x, v0.y, v0.z, v0.w, v1.x, v1.y, v1.z, v1.w};
#pragma unroll
        for (int t = 0; t < 16; ++t) {
            const float y = (t & 1) ? bfhi(yw[t >> 1]) : bflo(yw[t >> 1]);
            const float v = (t & 1) ? bfhi(vw[t >> 1]) : bflo(vw[t >> 1]);
            const float mean = wave_sum_dpp(y) * (1.0f / 64.0f);
            const float dlt = y - mean;
            const float var = wave_sum_dpp(dlt * dlt) * (1.0f / 64.0f);
            const float yn = dlt * rsqrtf(var + LNX_EPS) * lng + lnb;
            const float cf = COEF[(size_t)(row0 + t) * 8 + h];
            const float gg = bf2f(Gb[(size_t)(row0 + t) * 512 + col]);
            Z[(size_t)(row0 + t - NMETA) * 512 + col] = f2bf((yn + cf * v) * gg);
        }
    }
}

__device__ __forceinline__ void convert_expert_weights(const PPv& p, LAS unsigned char* lds, int first, int stride) {
    unsigned char* ws = p.gws();
    const int tid = threadIdx.x;
    LAS float* tile = (LAS float*)lds;
    const float* g2 = p.gin(27);
    bf16_t* WGU = (bf16_t*)(ws + OFF_WGU); bf16_t* WD = (bf16_t*)(ws + OFF_WD);
    constexpr int NBLK = NE * 3 * 64;
    const int lr = tid >> 6, lc = (tid & 63) * 4;
    f32x4 cur[8];
    int j = first;
    if (j >= NBLK) return;
    {
        const int mat = j >> 6, e = mat / 3, which = mat - 3 * e, bb = j & 63, kb = bb & 15, nbk = bb >> 4;
        const float* src = (which == 0 ? p.gin(30) : which == 1 ? p.gin(32) : p.gin(34)) + (size_t)e * 1024 * 1024 + (size_t)(kb * 64) * 1024 + nbk * 256;
#pragma unroll
        for (int i = 0; i < 8; ++i) cur[i] = *(const f32x4*)(src + (size_t)(lr + 8 * i) * 1024 + lc);
    }
    for (;;) {
        const int jn = j + stride; const bool has_next = jn < NBLK;
        f32x4 nxt[8];
        if (has_next) {
            const int mat = jn >> 6, e = mat / 3, which = mat - 3 * e, bb = jn & 63, kb = bb & 15, nbk = bb >> 4;
            const float* src = (which == 0 ? p.gin(30) : which == 1 ? p.gin(32) : p.gin(34)) + (size_t)e * 1024 * 1024 + (size_t)(kb * 64) * 1024 + nbk * 256;
#pragma unroll
            for (int i = 0; i < 8; ++i) nxt[i] = *(const f32x4*)(src + (size_t)(lr + 8 * i) * 1024 + lc);
        }
        const int mat = j >> 6, e = mat / 3, which = mat - 3 * e, bb = j & 63, kb = bb & 15, nbk = bb >> 4;
#pragma unroll
        for (int i = 0; i < 8; ++i) { LAS float* t = tile + (lr + 8 * i) * 257 + lc; t[0] = cur[i][0]; t[1] = cur[i][1]; t[2] = cur[i][2]; t[3] = cur[i][3]; }
        __syncthreads();
        {
            const int kq = tid & 7, k0 = kb * 64 + 8 * kq;
            float sc[8];
#pragma unroll
            for (int jj = 0; jj < 8; ++jj) sc[jj] = which < 2 ? g2[k0 + jj] : 1.0f;
#pragma unroll
            for (int i = 0; i < 4; ++i) {
                const int nn = (tid >> 3) + 64 * i, n = nbk * 256 + nn;
                float v[8];
#pragma unroll
                for (int jj = 0; jj < 8; ++jj) v[jj] = tile[(8 * kq + jj) * 257 + nn] * sc[jj];
                u32x4 w; w.x = cvt_pk_bf16(v[0], v[1]); w.y = cvt_pk_bf16(v[2], v[3]); w.z = cvt_pk_bf16(v[4], v[5]); w.w = cvt_pk_bf16(v[6], v[7]);
                bf16_t* dst = which < 2 ? WGU + (size_t)e * 2048 * 1024 + (size_t)(256 * (n >> 7) + 128 * which + (n & 127)) * 1024
                                        : WD + (size_t)e * 1024 * 1024 + (size_t)n * 1024;
                *(u32x4*)(dst + k0) = w;
            }
        }
        __syncthreads();
        if (!has_next) break;
        j = jn;
#pragma unroll
        for (int i = 0; i < 8; ++i) cur[i] = nxt[i];
    }
}

__device__ __forceinline__ void phase_router(const PPv& p, LAS unsigned char* lds) {
    const int tid = threadIdx.x, bid = blockIdx.x, nb = gridDim.x, lane = tid & 63, wave = tid >> 6;
    unsigned char* ws = p.gws();
    const float* h1 = p.gout();
    const float* WRG = (const float*)(ws + OFF_WRG);
    const float* brt = p.gin(29);
    LAS float* slog = (LAS float*)lds;
    LAS float* srs = slog + 8 * 16 * 32;
    LAS int* lcnt = (LAS int*)(srs + 128);
    LAS int* gbase = lcnt + 32;
    LAS int* ltopi = gbase + 32;
    LAS int* lrank = ltopi + 512;
    int* TOPI = (int*)(ws + OFF_TOPI); float* TOPW = (float*)(ws + OFF_TOPW); int* RANK = (int*)(ws + OFF_RANK); float* RSTD2 = (float*)(ws + OFF_RSTD2);
    int* GCNT = (int*)(ws + OFF_GCNT);
    for (int tb = bid; tb < T / 128; tb += nb) {
        if (tid < 32) lcnt[tid] = 0;
        __syncthreads();
        const int t0 = tb * 128 + wave * 16;
        {
            const int row = lane & 15, kq = lane >> 4;
            const float* ap = h1 + (size_t)(t0 + row) * D + 4 * kq;
            const float* bp = WRG + (size_t)(4 * kq) * 32 + row;
            f32x4 acc0 = (f32x4){0.f, 0.f, 0.f, 0.f}, acc1 = acc0;
            float ss = 0.f;
            for (int j = 0; j < 64; ++j) {
                const f32x4 av = *(const f32x4*)(ap + 16 * j);
                ss += av[0] * av[0] + av[1] * av[1] + av[2] * av[2] + av[3] * av[3];
                const float* bj = bp + (size_t)(16 * j) * 32;
#pragma unroll
                for (int s = 0; s < 4; ++s) {
                    const float b0 = bj[s * 32], b1 = bj[s * 32 + 16];
                    acc0 = __builtin_amdgcn_mfma_f32_16x16x4f32(av[s], b0, acc0, 0, 0, 0);
                    acc1 = __builtin_amdgcn_mfma_f32_16x16x4f32(av[s], b1, acc1, 0, 0, 0);
                }
            }
            ss += __shfl_xor(ss, 16); ss += __shfl_xor(ss, 32);
#pragma unroll
            for (int reg = 0; reg < 4; ++reg) {
                slog[(wave * 16 + 4 * kq + reg) * 32 + row] = acc0[reg];
                slog[(wave * 16 + 4 * kq + reg) * 32 + 16 + row] = acc1[reg];
            }
            if (lane < 16) srs[wave * 16 + lane] = rsqrtf(ss * (1.0f / D) + NORM_EPS);
        }
        __syncthreads();
        if (lane < 16) {
            const int tl = wave * 16 + lane, t = tb * 128 + tl;
            const float rs = srs[tl];
            float lg[32];
#pragma unroll
            for (int e = 0; e < 32; ++e) lg[e] = slog[tl * 32 + e] * rs + brt[e];
            int ti[4]; float tv[4];
#pragma unroll
            for (int k = 0; k < 4; ++k) {
                float best = -3.0e38f; int bi = 0;
#pragma unroll
                for (int e = 0; e < 32; ++e) { const bool tk = lg[e] > best; best = tk ? lg[e] : best; bi = tk ? e : bi; }
                ti[k] = bi; tv[k] = best;
#pragma unroll
                for (int e = 0; e < 32; ++e) lg[e] = (e == bi) ? -3.0e38f : lg[e];
            }
            const float e0 = 1.0f, e1 = __expf(tv[1] - tv[0]), e2 = __expf(tv[2] - tv[0]), e3 = __expf(tv[3] - tv[0]);
            const float inv = 1.0f / (e0 + e1 + e2 + e3);
            *(f32x4*)(TOPW + (size_t)t * 4) = (f32x4){e0 * inv, e1 * inv, e2 * inv, e3 * inv};
            RSTD2[t] = rs;
#pragma unroll
            for (int k = 0; k < 4; ++k) { ltopi[tl * 4 + k] = ti[k]; lrank[tl * 4 + k] = __hip_atomic_fetch_add(lcnt + ti[k], 1, __ATOMIC_RELAXED, __HIP_MEMORY_SCOPE_WORKGROUP); }
        }
        __syncthreads();
        if (tid < 32) gbase[tid] = atomicAdd(GCNT + tid, lcnt[tid]);
        __syncthreads();
        {
            const int e = ltopi[tid];
            TOPI[(size_t)tb * 512 + tid] = e;
            RANK[(size_t)tb * 512 + tid] = gbase[e] + lrank[tid];
        }
        __syncthreads();
    }
}

__device__ __forceinline__ void phase_lists(const PPv& p, LAS unsigned char* lds) {
    const int tid = threadIdx.x, bid = blockIdx.x, nb = gridDim.x;
    unsigned char* ws = p.gws();
    LAS int* pstart = (LAS int*)lds;
    LAS int* cnt = pstart + 64;
    const int* GCNT = (const int*)(ws + OFF_GCNT);
    if (tid < 32) cnt[tid] = GCNT[tid];
    __syncthreads();
    if (tid == 0) { int s = 0; for (int e = 0; e < 32; ++e) { pstart[e] = s; s += ((cnt[e] + 255) >> 8) << 8; } pstart[32] = s; }
    __syncthreads();
    const int* TOPI = (const int*)(ws + OFF_TOPI); const float* TOPW = (const float*)(ws + OFF_TOPW); const int* RANK = (const int*)(ws + OFF_RANK); const float* RSTD2 = (const float*)(ws + OFF_RSTD2);
    int* ROWTOK = (int*)(ws + OFF_ROWTOK); int* ROWSLOT = (int*)(ws + OFF_ROWSLOT); float* ROWW = (float*)(ws + OFF_ROWW); float* ROWRS = (float*)(ws + OFF_ROWRS);
    for (int i = bid * 512 + tid; i < T * 4; i += nb * 512) {
        const int e = TOPI[i], pos = pstart[e] + RANK[i], t = i >> 2;
        ROWTOK[pos] = t; ROWSLOT[pos] = i; ROWW[pos] = TOPW[i]; ROWRS[pos] = RSTD2[t];
    }
    for (int e = bid; e < 32; e += nb) {
        for (int pos = pstart[e] + cnt[e] + tid; pos < pstart[e + 1]; pos += 512) { ROWTOK[pos] = 0; ROWSLOT[pos] = -1; ROWW[pos] = 0.f; ROWRS[pos] = 0.f; }
    }
    if (bid == 0) {
        int* TILEE = (int*)(ws + OFF_TILEE);
        const int ntiles = pstart[32] >> 8;
        for (int mt = tid; mt < ntiles; mt += 512) { int e = 0; for (int q = 0; q < 32; ++q) if (pstart[q] <= mt * 256) e = q; TILEE[mt] = e; }
        if (tid == 0) TILEE[1000] = ntiles;
    }
    __syncthreads();
}

__device__ __forceinline__ void phase_final(const PPv& p) {
    const int tid = threadIdx.x, bid = blockIdx.x, nb = gridDim.x, lane = tid & 63, wave = tid >> 6;
    unsigned char* ws = p.gws();
    const bf16_t* HB2 = (const bf16_t*)(ws + OFF_HB2);
    const bf16_t* YA = (const bf16_t*)p.gout(); const bf16_t* YB = (const bf16_t*)(ws + OFF_WGU);
    const float* gf = p.gin(36);
    const f32x4 ga0 = *(const f32x4*)(gf + 8 * lane), ga1 = *(const f32x4*)(gf + 8 * lane + 4), gb0 = *(const f32x4*)(gf + 512 + 8 * lane), gb1 = *(const f32x4*)(gf + 512 + 8 * lane + 4);
    for (int t = bid * 8 + wave; t < T; t += nb * 8) {
        const u32x4 ha = *(const u32x4*)(HB2 + (size_t)t * D + 8 * lane), hb = *(const u32x4*)(HB2 + (size_t)t * D + 512 + 8 * lane);
        float va[8] = {bflo(ha.x), bfhi(ha.x), bflo(ha.y), bfhi(ha.y), bflo(ha.z), bfhi(ha.z), bflo(ha.w), bfhi(ha.w)};
        float vb[8] = {bflo(hb.x), bfhi(hb.x), bflo(hb.y), bfhi(hb.y), bflo(hb.z), bfhi(hb.z), bflo(hb.w), bfhi(hb.w)};
#pragma unroll
        for (int k = 0; k < 4; ++k) {
            const u32x4 ya = *(const u32x4*)(YA + (size_t)(4 * t + k) * 512 + 8 * lane), yb = *(const u32x4*)(YB + (size_t)(4 * t + k) * 512 + 8 * lane);
            va[0] += bflo(ya.x); va[1] += bfhi(ya.x); va[2] += bflo(ya.y); va[3] += bfhi(ya.y); va[4] += bflo(ya.z); va[5] += bfhi(ya.z); va[6] += bflo(ya.w); va[7] += bfhi(ya.w);
            vb[0] += bflo(yb.x); vb[1] += bfhi(yb.x); vb[2] += bflo(yb.y); vb[3] += bfhi(yb.y); vb[4] += bflo(yb.z); vb[5] += bfhi(yb.z); vb[6] += bflo(yb.w); vb[7] += bfhi(yb.w);
        }
        float ss = 0.f;
#pragma unroll
        for (int j = 0; j < 8; ++j) ss += va[j] * va[j] + vb[j] * vb[j];
        ss = wave_sum(ss);
        const float rs = rsqrtf(ss * (1.0f / D) + NORM_EPS);
        float* o = p.gout() + (size_t)t * D;
        *(f32x4*)(o + 8 * lane) = (f32x4){va[0] * rs * ga0[0], va[1] * rs * ga0[1], va[2] * rs * ga0[2], va[3] * rs * ga0[3]};
        *(f32x4*)(o + 8 * lane + 4) = (f32x4){va[4] * rs * ga1[0], va[5] * rs * ga1[1], va[6] * rs * ga1[2], va[7] * rs * ga1[3]};
        *(f32x4*)(o + 512 + 8 * lane) = (f32x4){vb[0] * rs * gb0[0], vb[1] * rs * gb0[1], vb[2] * rs * gb0[2], vb[3] * rs * gb0[3]};
        *(f32x4*)(o + 512 + 8 * lane + 4) = (f32x4){vb[4] * rs * gb1[0], vb[5] * rs * gb1[1], vb[6] * rs * gb1[2], vb[7] * rs * gb1[3]};
    }
}

#define XB_TMO      128
#define XB_XCNT(j)  (256  + 64 * (j))
#define XB_XSUB(j)  (1280 + 64 * (j))
#define XB_XGEN(j)  (2304 + 64 * (j))
#define XB_TOP      3328
#define XB_TOPGEN   3392
#define XCD_BAR_WORDS 3456
#define XB_SPIN_CAP (1u << 18)
__device__ __forceinline__ unsigned xb_ld(unsigned* p)              { return __hip_atomic_load(p, __ATOMIC_RELAXED, __HIP_MEMORY_SCOPE_AGENT); }
__device__ __forceinline__ unsigned xb_add(unsigned* p, unsigned v) { return __hip_atomic_fetch_add(p, v, __ATOMIC_RELAXED, __HIP_MEMORY_SCOPE_AGENT); }
__device__ __forceinline__ unsigned xb_xcc_id() { return (unsigned)__builtin_amdgcn_s_getreg((3 << 11) | 20) & 0xFu; }
#define XB_SPIN(cond, bar) do { unsigned _sp = 0; while (cond) { __builtin_amdgcn_s_sleep(1); \
    if ((++_sp & 255u) == 0u) { if (xb_ld(&(bar)[XB_TMO])) break; if (_sp > XB_SPIN_CAP) { atomicAdd(&(bar)[XB_TMO], 1u); break; } } } } while (0)
struct XcdBarrier { unsigned* bar; unsigned x; volatile LAS unsigned* st; };
__device__ __forceinline__ XcdBarrier xcd_barrier_post(unsigned* bar, volatile LAS unsigned* st) {
    XcdBarrier b; b.bar = bar; b.x = xb_xcc_id(); b.st = st;
    if (threadIdx.x == 0) (void)xb_add(&bar[XB_XCNT(b.x)], 1u);
    return b;
}
__device__ __forceinline__ void xcd_barrier_complete(unsigned* bar, unsigned x, unsigned& nloc, unsigned& nx) {
    const unsigned G = gridDim.x * gridDim.y * gridDim.z;
    unsigned sum, cnt, mine, sp = 0u;
    for (;;) {
        sum = 0u; cnt = 0u; mine = 0u;
#pragma unroll
        for (unsigned j = 0; j < 16; ++j) { const unsigned c = xb_ld(&bar[XB_XCNT(j)]); sum += c; cnt += (c > 0u) ? 1u : 0u; mine = (j == x) ? c : mine; }
        if (sum == G) break;
        __builtin_amdgcn_s_sleep(1);
        if ((++sp & 255u) == 0u) { if (xb_ld(&bar[XB_TMO])) break; if (sp > XB_SPIN_CAP) { atomicAdd(&bar[XB_TMO], 1u); break; } }
    }
    nloc = mine > 0u ? mine : 1u; nx = cnt > 0u ? cnt : 1u;
}
__device__ __forceinline__ void xcd_barrier(const XcdBarrier& b) {
    asm volatile("s_waitcnt vmcnt(0)" ::: "memory");
    __syncthreads();
    if (threadIdx.x == 0) {
        unsigned* bar = b.bar;
        __builtin_amdgcn_s_waitcnt(0);
        unsigned nloc = b.st[0], nx = b.st[1];
        if (nloc == 0u) { xcd_barrier_complete(bar, b.x, nloc, nx); b.st[0] = nloc; b.st[1] = nx; }
        const unsigned old = xb_add(&bar[XB_XSUB(b.x)], 1u);
        const unsigned gen = old / nloc;
        if (old + 1u == (gen + 1u) * nloc) {
            __builtin_amdgcn_fence(__ATOMIC_RELEASE, "agent");
            asm volatile("s_waitcnt vmcnt(0)" ::: "memory");
            const unsigned og = xb_add(&bar[XB_TOP], 1u);
            const unsigned tg = og / nx;
            if (og + 1u == (tg + 1u) * nx) xb_add(&bar[XB_TOPGEN], 1u);
            else XB_SPIN(xb_ld(&bar[XB_TOPGEN]) == tg, bar);
            __builtin_amdgcn_fence(__ATOMIC_ACQUIRE, "agent");
            xb_add(&bar[XB_XGEN(b.x)], 1u);
            asm volatile("s_waitcnt vmcnt(0)" ::: "memory");
        } else {
            XB_SPIN(xb_ld(&bar[XB_XGEN(b.x)]) == gen, bar);
            __builtin_amdgcn_fence(__ATOMIC_ACQUIRE, "agent");
            asm volatile("s_waitcnt vmcnt(0)" ::: "memory");
        }
    }
    __syncthreads();
}

constexpr int N_PHASES = 15;
__global__ void __launch_bounds__(512, 2) mega(Params p) {
    extern __shared__ __attribute__((aligned(16))) unsigned char lds_raw[];
    LAS unsigned char* lds = (LAS unsigned char*)lds_raw;
    cg::grid_group grid = cg::this_grid();
    unsigned char* ws = getpp().gws();
    const int G = gridDim.x, bid = blockIdx.x;
#ifndef ONLY_PHASE
#define ONLY_PHASE -1
#endif
#define IN(k) ((ONLY_PHASE < 0 || ONLY_PHASE == (k)) && p.ph_lo <= (k) && (k) < p.ph_hi)
    volatile LAS unsigned* xst = (volatile LAS unsigned*)(lds + 163840 - 16);
    if (threadIdx.x < 4) xst[threadIdx.x] = 0u;
    __syncthreads();
    const XcdBarrier xbar = xcd_barrier_post((unsigned*)(ws + OFF_BAR), xst);
    if (p.ph_hi < 0) grid.sync();
#define SEAM(k) do { if ((k) + 1 < p.ph_hi) xcd_barrier(xbar); } while (0)
    if (IN(0)) { const PPv q = getpp(); phase_prep(q, lds); SEAM(0); }
    if (IN(1)) { const PPv q = getpp();
        phase_meta_proj(q, lds);
        StaticOrder S; S.init(ws + OFF_HB, ws + OFF_WIN, T, NCOLS1, 1024, G, bid);
        EpiProj E{(bf16_t*)(ws + OFF_PRKV), (bf16_t*)(ws + OFF_PCONV), (bf16_t*)q.gout(), (const float*)(ws + OFF_RSTD1)};
        gemm_phase<false>(lds, 1024, S, E);
        SEAM(1);
    }
    if (IN(2)) { const PPv q = getpp(); phase_lprep_conv(q); SEAM(2); }
    if (IN(3)) { const PPv q = getpp();
        StaticOrder S; S.init(ws + OFF_L, ws + OFF_W2, NRP, 1536, 256, G, bid);
        EpiL E{(float*)(ws + OFF_LD), (bf16_t*)(ws + OFF_A), (bf16_t*)(ws + OFF_G), q.gin(10), q.gin(13)};
        gemm_phase<false>(lds, 256, S, E);
        SEAM(3);
    }
    if (IN(4)) { const PPv q = getpp(); phase_scanprep(q, lds); SEAM(4); }
    if (IN(5)) { const PPv q = getpp(); phase_recur(q, lds); SEAM(5); }
    if (IN(6)) { const PPv q = getpp(); phase_gn(q); SEAM(6); }
    if (IN(7)) { const PPv q = getpp();
        MergeOrder S; S.so.init(ws + OFF_Z, ws + OFF_WR, T, 1024, 512, G, bid); S.A1 = (const char*)(ws + OFF_C); S.B1 = (const char*)(ws + OFF_WC);
        EpiMergeFused E{(bf16_t*)(ws + OFF_MERGED), (const bf16_t*)q.gout()};
        gemm_phase<false>(lds, 512, S, E);
        SEAM(7);
    }
    if (IN(9)) { const PPv q = getpp();
        StaticOrder S; S.init(ws + OFF_MERGED, ws + OFF_WO, T, 1024, 1024, G, bid);
        EpiO E{q.gin(0), q.gout(), (bf16_t*)(ws + OFF_HB2)};
        gemm_phase<false>(lds, 1024, S, E);
        SEAM(9);
    }
    if (IN(10)) { const PPv q = getpp(); phase_router(q, lds); SEAM(10); }
    if (IN(11)) { const PPv q = getpp(); phase_lists(q, lds); SEAM(11); }
    if (IN(12)) { const PPv q = getpp();
        const int* TILEE = (const int*)(ws + OFF_TILEE);
        MoeOrder S; S.A = (const char*)(ws + OFF_HB2); S.Bt = (const char*)(ws + OFF_WGU); S.K = 1024; S.estride = (size_t)2048 * 1024 * 2;
        S.tile_e = TILEE; S.rowtok = (const int*)(ws + OFF_ROWTOK); S.ntiles = TILEE[1000]; S.nnt = 8; S.G = G; S.c = bid; S.gather = true;
        EpiMoe1 E{(bf16_t*)(ws + OFF_ACT), (const float*)(ws + OFF_ROWRS), q.gin(31), q.gin(33)};
        gemm_phase<true>(lds, 1024, S, E);
        SEAM(12);
    }
    if (IN(13)) { const PPv q = getpp();
        const int* TILEE = (const int*)(ws + OFF_TILEE);
        MoeOrder S; S.A = (const char*)(ws + OFF_ACT); S.Bt = (const char*)(ws + OFF_WD); S.K = 1024; S.estride = (size_t)1024 * 1024 * 2;
        S.tile_e = TILEE; S.rowtok = nullptr; S.ntiles = TILEE[1000]; S.nnt = 4; S.G = G; S.c = bid; S.gather = false;
        EpiMoe2 E{(bf16_t*)q.gout(), (bf16_t*)(ws + OFF_WGU), (const int*)(ws + OFF_ROWSLOT), (const float*)(ws + OFF_ROWW), q.gin(35)};
        gemm_phase<false>(lds, 1024, S, E);
        SEAM(13);
    }
    if (IN(14)) { const PPv q = getpp(); phase_final(q); }
}

extern "C" void kernel_launch(void* const* d_in, const int* in_sizes, int n_in, void* d_out, int out_size, void* d_ws, size_t ws_size,
                              hipStream_t stream) {
    constexpr size_t kDynLds = 160 * 1024;
    static int grid_blocks = 0;
    if (!grid_blocks) {
        int dev = 0, cus = 0, per_cu = 0;
        (void)hipGetDevice(&dev);
        (void)hipDeviceGetAttribute(&cus, hipDeviceAttributeMultiprocessorCount, dev);
        (void)hipFuncSetAttribute((const void*)mega, hipFuncAttributeMaxDynamicSharedMemorySize, (int)kDynLds);
        (void)hipOccupancyMaxActiveBlocksPerMultiprocessor(&per_cu, mega, 512, kDynLds);
        if (per_cu > 1) per_cu = 1;
        grid_blocks = cus * per_cu;
        fprintf(stderr, "cus=%d per_cu=%d ws_size=%zu need=%zu\n", cus, per_cu, ws_size, (size_t)WS_NEED);
    }
    if (ws_size < WS_NEED || n_in < 37 || grid_blocks < 64) { fprintf(stderr, "kernel_launch: unsupported configuration\n"); return; }
    Params p{};
    for (int i = 0; i < 37; ++i) p.in[i] = (const float*)d_in[i];
    p.out = (float*)d_out;
    p.ws = (unsigned char*)d_ws;
    p.ph_lo = 0; p.ph_hi = N_PHASES;
    (void)hipMemsetAsync((unsigned char*)d_ws + OFF_BAR, 0, 16384, stream);
    void* args[] = {&p};
    hipError_t e = hipLaunchCooperativeKernel((void*)mega, dim3(grid_blocks), dim3(512), args, kDynLds, stream);
    if (e != hipSuccess) fprintf(stderr, "cooperative launch failed: %s (grid %d)\n", hipGetErrorString(e), grid_blocks);
}
```

```cpp
#include <hip/hip_runtime.h>
#include <hip/hip_cooperative_groups.h>
#include <cstdio>
namespace cg = cooperative_groups;

#define LAS __attribute__((address_space(3)))
typedef unsigned short bf16_t;
typedef short bf16x8 __attribute__((ext_vector_type(8)));
typedef float f32x4 __attribute__((ext_vector_type(4)));
typedef float f32x2 __attribute__((ext_vector_type(2)));
typedef unsigned u32x4 __attribute__((ext_vector_type(4)));
typedef unsigned u32x2 __attribute__((ext_vector_type(2)));

constexpr int D = 1024, NBATCH = 8, SEQ = 4096, NMETA = 16;
constexpr int T = NBATCH * SEQ;
constexpr int NR = T + NMETA;
constexpr int NRP = 33024;
constexpr int PCOLS1 = 3584;
constexpr int NCOLS1 = 5632;
constexpr int NE = 32, TOPK = 4, DFF = 1024;
constexpr int MAXROWS = T * TOPK + NE * 256;
constexpr int MAXTILES = MAXROWS / 256;
constexpr float NORM_EPS = 1e-5f, LNX_EPS = 64e-5f;

constexpr int NCHUNK = 257, NUNITS = 64 * NCHUNK;
constexpr int REC_BYTES = 13568;
constexpr int RO_WH = 0, RO_RT = 2048, RO_U0T = 4096, RO_VT = 6144, RO_BKT = 8192, RO_ARK = 12288, RO_WCC = 13312;
constexpr int SLOT_BYTES = 15680, SO_G = 13568, SO_COEF = 15616, NSLOT = 9;
constexpr size_t SZ_ACT = (size_t)MAXROWS * 1024 * 2;
constexpr size_t SZ_WGU = (size_t)NE * 2048 * 1024 * 2;
constexpr size_t SZ_WD = (size_t)NE * 1024 * 1024 * 2;
constexpr size_t SZ_HB = (size_t)T * 1024 * 2;
constexpr size_t OFF_WGU = 0;
constexpr size_t OFF_WD = OFF_WGU + SZ_WGU;
constexpr size_t OFF_ACT = OFF_WD + SZ_WD;
constexpr size_t OFF_HB2 = OFF_ACT + SZ_ACT;
constexpr size_t OFF_RT = OFF_HB2 + SZ_HB;
constexpr size_t OFF_TOPI = OFF_RT;
constexpr size_t OFF_TOPW = OFF_TOPI + (size_t)T * 16;
constexpr size_t OFF_RANK = OFF_TOPW + (size_t)T * 16;
constexpr size_t OFF_RSTD2 = OFF_RANK + (size_t)T * 16;
constexpr size_t OFF_ROWTOK = OFF_RSTD2 + (size_t)T * 4;
constexpr size_t OFF_ROWSLOT = OFF_ROWTOK + (size_t)MAXROWS * 4;
constexpr size_t OFF_ROWW = OFF_ROWSLOT + (size_t)MAXROWS * 4;
constexpr size_t OFF_ROWRS = OFF_ROWW + (size_t)MAXROWS * 4;
constexpr size_t OFF_TILEE = OFF_ROWRS + (size_t)MAXROWS * 4;
constexpr size_t OFF_GCNT = OFF_TILEE + 4096;
constexpr size_t OFF_SM = OFF_GCNT + 256;
constexpr size_t OFF_WR = OFF_SM;
constexpr size_t OFF_WC = OFF_WR + (size_t)1024 * 512 * 2;
constexpr size_t OFF_WO = OFF_WC + (size_t)1024 * 512 * 2;
constexpr size_t OFF_W2 = OFF_WO + (size_t)1024 * 1024 * 2;
constexpr size_t OFF_RSTD1 = OFF_W2 + (size_t)1536 * 256 * 2;
constexpr size_t OFF_WRG = OFF_RSTD1 + (size_t)NRP * 4;
constexpr size_t OFF_BAR = OFF_WRG + (size_t)1024 * 32 * 4;
constexpr size_t WS_NEED = OFF_BAR + 16384;
constexpr size_t OFF_PRKV = 0;
constexpr size_t SZ_PRKV = (size_t)NR * 1536 * 2;
constexpr size_t OFF_LD = OFF_PRKV + SZ_PRKV;
constexpr size_t OFF_A = OFF_LD + (size_t)NRP * 512 * 4;
constexpr size_t OFF_CH = OFF_A + (size_t)NRP * 512 * 2;
constexpr size_t OFF_PCONV = OFF_CH;
constexpr size_t SZ_PCONV = (size_t)NR * 2048 * 2;
constexpr size_t OFF_HB = OFF_PCONV + SZ_PCONV;
constexpr size_t OFF_L = OFF_HB + SZ_HB;
constexpr size_t OFF_WIN = OFF_L + (size_t)NRP * 256 * 2;
constexpr size_t CH_END = OFF_WIN + (size_t)NCOLS1 * 1024 * 2;
constexpr size_t OFF_MERGED = OFF_CH;
constexpr size_t OFF_G = CH_END;
constexpr size_t OFF_C = OFF_G + (size_t)NRP * 512 * 2;
constexpr size_t OFF_Z = OFF_C + (size_t)T * 512 * 2;
constexpr size_t OFF_COEF = OFF_Z + (size_t)T * 512 * 2;
constexpr size_t EARLY_END = OFF_COEF + (size_t)NR * 8 * 4;
static_assert(EARLY_END <= OFF_RT, "early buffers overflow");
static_assert(OFF_CH + (size_t)NUNITS * REC_BYTES <= CH_END, "chunk records overflow");
static_assert(OFF_CH >= OFF_WD + SZ_WD, "expert weights (written during the scan) must not touch live scan buffers");
static_assert(OFF_MERGED + SZ_HB <= OFF_HB2, "layout");
static_assert(OFF_PRKV % 16 == 0 && OFF_LD % 16 == 0 && OFF_A % 16 == 0 && OFF_CH % 16 == 0 && OFF_HB % 16 == 0 && OFF_L % 16 == 0 && OFF_WIN % 16 == 0 && OFF_G % 16 == 0 && OFF_C % 16 == 0 && OFF_Z % 16 == 0 && OFF_COEF % 16 == 0, "align");

#define GAS __attribute__((address_space(1)))
#define CAS __attribute__((address_space(4)))
struct Params {
    const float* in[37];
    float* out;
    unsigned char* ws;
    int ph_lo, ph_hi;
};
struct ParamsD {
    const GAS float* in[37];
    GAS float* out;
    GAS unsigned char* ws;
    int ph_lo, ph_hi;
};
static_assert(sizeof(Params) == sizeof(ParamsD), "argument views");
struct PPv {
    const CAS ParamsD* k;
    __device__ __forceinline__ const float* gin(int i) const { return (const float*)k->in[i]; }
    __device__ __forceinline__ float* gout() const { return (float*)k->out; }
    __device__ __forceinline__ unsigned char* gws() const { return (unsigned char*)k->ws; }
};
__device__ __forceinline__ PPv getpp() { const CAS ParamsD* k = (const CAS ParamsD*)__builtin_amdgcn_kernarg_segment_ptr(); asm volatile("" : "+s"(k)); return PPv{k}; }

typedef __bf16 bf16x2v __attribute__((ext_vector_type(2)));
__device__ __forceinline__ unsigned cvt_pk_bf16(float lo, float hi) { const f32x2 v = {lo, hi}; return __builtin_bit_cast(unsigned, __builtin_convertvector(v, bf16x2v)); }
__device__ __forceinline__ bf16_t f2bf(float f) { unsigned u = __float_as_uint(f); u += 0x7FFFu + ((u >> 16) & 1u); return (bf16_t)(u >> 16); }
__device__ __forceinline__ float bf2f(bf16_t b) { return __uint_as_float(((unsigned)b) << 16); }
__device__ __forceinline__ float bflo(unsigned w) { return __uint_as_float(w << 16); }
__device__ __forceinline__ float bfhi(unsigned w) { return __uint_as_float(w & 0xFFFF0000u); }
__device__ __forceinline__ float sigmoidf_(float x) { return __builtin_amdgcn_rcpf(1.0f + __expf(-x)); }
__device__ __forceinline__ float wave_sum(float v) {
#pragma unroll
    for (int o = 32; o >= 1; o >>= 1) v += __shfl_xor(v, o);
    return v;
}
__device__ __forceinline__ float wave_sum_dpp(float v);
__device__ __forceinline__ int prev_row(int row, int d) {
    if (row < NMETA) return row - d >= 0 ? row - d : -1;
    const int s = (row - NMETA) & (SEQ - 1);
    return s >= d ? row - d : NMETA + s - d;
}

constexpr int BM = 256, BK = 64, HALF = 128, HTB = HALF * BK * 2, STAGE_BYTES = 8 * HTB, NXCD = 8, WGM = 8;
__device__ __forceinline__ int lds_byte(int r, int c) { const int st = (r >> 4) * 2 + (c >> 5), rr = r & 15, cc = c & 31, ob = rr * 64 + cc * 2; return st * 1024 + (ob ^ (((ob >> 9) & 1) << 5)); }
__device__ __forceinline__ void stage_rc(int b, int& R, int& C) { const int st = b / 1024, sb = b % 1024, swz = sb ^ (((sb >> 9) & 1) << 5); R = (st >> 1) * 16 + swz / 64; C = (st & 1) * 32 + (swz % 64) / 2; }
__device__ __forceinline__ int perm32(int rho) { const int n = rho >> 4, i = rho & 15; return 8 * (i >> 2) + 4 * n + (i & 3); }

struct Unit { int pm, pn, aux; };

struct StaticOrder {
    const char* A; const char* Bt; int K;
    int nM, nN, nwg, G, c;
    __device__ void init(const void* A_, const void* Bt_, int M, int N, int K_, int G_, int c_) { A = (const char*)A_; Bt = (const char*)Bt_; K = K_; nM = M / BM; nN = N / BM; nwg = nM * nN; G = G_; c = c_; }
    __device__ bool next(int i, Unit& u) const {
        const long L = (long)i * G + c; if (L >= nwg) return false;
        int wgid = (int)L; { const int q = nwg / NXCD, r = nwg % NXCD, xcd = wgid % NXCD, off = wgid / NXCD; wgid = (xcd < r ? xcd * (q + 1) : r * (q + 1) + (xcd - r) * q) + off; }
        const int nig = WGM * nN, gid = wgid / nig, fm = gid * WGM, gsz = (nM - fm) < WGM ? (nM - fm) : WGM;
        u.pm = fm + ((wgid % nig) % gsz); u.pn = (wgid % nig) / gsz; u.aux = 0; return true;
    }
    __device__ __forceinline__ const char* a_ptr(const Unit& u) const { return A + (size_t)u.pm * 256 * K * 2; }
    __device__ __forceinline__ const char* b_ptr(const Unit& u) const { return Bt + (size_t)u.pn * 256 * K * 2; }
    __device__ __forceinline__ int gather_row(const Unit&, int) const { return 0; }
    __device__ __forceinline__ const void* gather_src(const Unit&, int) const { return nullptr; }
};
struct MoeOrder {
    const char* A; const char* Bt; int K; size_t estride;
    const int* tile_e; const int* rowtok; int ntiles, nnt, G, c; bool gather;
    __device__ bool next(int i, Unit& u) const {
        int mt, nt;
        if ((G & 7) == 0 && ((G >> 3) % nnt) == 0) {
            const int x = c & 7, j = c >> 3, per = (G >> 3) / nnt;
            mt = (i * 8 + x) * per + j / nnt; nt = j % nnt;
        } else { const long L = (long)i * G + c; mt = (int)(L / nnt); nt = (int)(L % nnt); }
        if (mt >= ntiles) return false;
        u.pm = mt; u.pn = nt; u.aux = tile_e[mt]; return true;
    }
    __device__ __forceinline__ const char* a_ptr(const Unit& u) const { return gather ? A : A + (size_t)u.pm * 256 * K * 2; }
    __device__ __forceinline__ const char* b_ptr(const Unit& u) const { return Bt + (size_t)u.aux * estride + (size_t)u.pn * 256 * K * 2; }
    __device__ __forceinline__ int gather_row(const Unit& u, int r) const { return rowtok[u.pm * 256 + r]; }
    __device__ __forceinline__ const void* gather_src(const Unit& u, int lane) const { return rowtok + u.pm * 256 + lane * 4; }
};

template <bool GATHER, class Epi, class Sched>
__device__ __forceinline__ void gemm_phase(LAS unsigned char* lds, const int K_, const Sched& S, const Epi& E) {
    int K = K_; asm volatile("" : "+s"(K));
    const int tid = threadIdx.x, wid = __builtin_amdgcn_readfirstlane(tid >> 6), lane = tid & 63, wr = wid >> 2, wc = wid & 3, fr = lane & 15, fq = lane >> 4;
    const int nt = K / BK;
    unsigned voffA[2], voffB[2]; int Rr[2], Cc[2];
#pragma unroll
    for (int i = 0; i < 2; ++i) { int R, C; stage_rc(tid * 16 + i * 8192, R, C); const int Rb = (R & ~31) + perm32(R & 31);
        Rr[i] = R; Cc[i] = C; voffA[i] = (unsigned)(R * K + C) * 2u; voffB[i] = (unsigned)(Rb * K + C) * 2u; }
    const size_t kstep = (size_t)(BK * 2);
    const size_t hstep = (size_t)HALF * K * 2;
    const unsigned ldsw = (unsigned)wid * 1024u;
    const int aoff = lds_byte(wr * 64 + fr, fq * 8), boff = lds_byte(wc * 32 + fr, fq * 8);
    unsigned vgc[2][2], vgn[2][2];
    LAS unsigned char* const parbase = lds + STAGE_BYTES;
    constexpr int NPAR = Epi::NPAR;
#define G_PAR_ISSUE(unit, uidx, hasnx, nxunit) do { \
        LAS unsigned char* _ps = parbase + ((uidx) & 1) * 4096; \
        if (wid < NPAR) __builtin_amdgcn_global_load_lds((const unsigned*)E.par_src(unit, wid, lane), (LAS unsigned*)(_ps + wid * 1024), 16, 0, 0); \
        if (GATHER && (hasnx) && wid == NPAR) __builtin_amdgcn_global_load_lds((const unsigned*)S.gather_src(nxunit, lane), (LAS unsigned*)(_ps + NPAR * 1024), 16, 0, 0); } while (0)
#define G_SA(b, h) (((b) * 2 + (h)) * HTB)
#define G_SB(b, h) ((4 + (b) * 2 + (h)) * HTB)
#define G_STAGE(bufoff, gbase, voff) do { _Pragma("unroll") for (int _i = 0; _i < 2; ++_i) \
        __builtin_amdgcn_global_load_lds((const unsigned*)((const char*)(gbase) + (voff)[_i]), (LAS unsigned*)(lds + (bufoff) + ldsw + _i * 8192), 16, 0, 0); } while (0)
#define G_STAGE_A(bufoff, kptr, h, VG) do { if (GATHER) { G_STAGE(bufoff, kptr, VG[h]); } else { G_STAGE(bufoff, (kptr) + (h) * hstep, voffA); } } while (0)
#define G_LDA(dst, b, h) do { _Pragma("unroll") for (int m = 0; m < 4; ++m) _Pragma("unroll") for (int k = 0; k < 2; ++k) dst[m][k] = *(const LAS bf16x8*)(lds + G_SA(b, h) + aoff + m * 2048 + k * 1024); } while (0)
#define G_LDB(dst, b, h) do { _Pragma("unroll") for (int n = 0; n < 2; ++n) _Pragma("unroll") for (int k = 0; k < 2; ++k) dst[n][k] = *(const LAS bf16x8*)(lds + G_SB(b, h) + boff + n * 2048 + k * 1024); } while (0)
#define G_MMA(ai, bj, At, Bt) do { __builtin_amdgcn_s_setprio(1); _Pragma("unroll") for (int m = 0; m < 4; ++m) _Pragma("unroll") for (int n = 0; n < 2; ++n) _Pragma("unroll") for (int k = 0; k < 2; ++k) \
        acc[ai][bj][m][n] = __builtin_amdgcn_mfma_f32_16x16x32_bf16(Bt[n][k], At[m][k], acc[ai][bj][m][n], 0, 0, 0); __builtin_amdgcn_s_setprio(0); } while (0)
#define G_WAIT_V(n) asm volatile("s_waitcnt vmcnt(" #n ")" ::: "memory")
#define G_WAIT_L(n) asm volatile("s_waitcnt lgkmcnt(" #n ")" ::: "memory")
#define G_BAR __builtin_amdgcn_s_barrier()
#define G_SCHED __builtin_amdgcn_sched_barrier(0)
    Unit cur, nxt;
    int ui = 0;
    if (!S.next(0, cur)) return;
    f32x4 acc[2][2][4][2];
#pragma unroll
    for (int a = 0; a < 2; ++a)
#pragma unroll
        for (int b = 0; b < 2; ++b)
#pragma unroll
            for (int m = 0; m < 4; ++m)
#pragma unroll
                for (int n = 0; n < 2; ++n) acc[a][b][m][n] = (f32x4){0.f, 0.f, 0.f, 0.f};
    bf16x8 At[4][2], B0[2][2], B1[2][2];
    const char* cA = S.a_ptr(cur); const char* cB = S.b_ptr(cur);
    if (GATHER) {
#pragma unroll
        for (int h = 0; h < 2; ++h)
#pragma unroll
            for (int i = 0; i < 2; ++i) vgc[h][i] = (unsigned)(S.gather_row(cur, h * HALF + Rr[i]) * K + Cc[i]) * 2u;
    }
    { Unit n1; const bool hn1 = S.next(1, n1); G_PAR_ISSUE(cur, 0, hn1, n1); }
    G_STAGE(G_SB(0, 0), cB, voffB); G_STAGE_A(G_SA(0, 0), cA, 0, vgc); G_STAGE(G_SB(0, 1), cB + hstep, voffB); G_STAGE_A(G_SA(0, 1), cA, 1, vgc);
    if (wr == 1) G_BAR;
    G_WAIT_V(4); G_BAR;
    G_STAGE(G_SB(1, 0), cB + kstep, voffB); G_STAGE_A(G_SA(1, 0), cA + kstep, 0, vgc); G_STAGE(G_SB(1, 1), cB + hstep + kstep, voffB);
    G_WAIT_V(6); G_BAR;
    for (;;) {
        const bool has_next = S.next(ui + 1, nxt);
        const char* nA = has_next ? S.a_ptr(nxt) : cA; const char* nB = has_next ? S.b_ptr(nxt) : cB;
        if (ui > 0) G_PAR_ISSUE(cur, ui, has_next, nxt);
        if (GATHER) {
#pragma unroll
            for (int h = 0; h < 2; ++h)
#pragma unroll
                for (int i = 0; i < 2; ++i) vgn[h][i] = vgc[h][i];
        }
        for (int t = 0; t < nt; t += 2) {
            const bool last = (t == nt - 2);
            const char* a1 = cA + (size_t)(t + 1) * kstep;
            const char* a2 = last ? nA : cA + (size_t)(t + 2) * kstep; const char* b2 = last ? nB : cB + (size_t)(t + 2) * kstep;
            const char* a3 = a2 + kstep; const char* b3 = b2 + kstep;
            unsigned vg2[2][2];
            if (GATHER) {
#pragma unroll
                for (int h = 0; h < 2; ++h)
#pragma unroll
                    for (int i = 0; i < 2; ++i) vg2[h][i] = last ? vgn[h][i] : vgc[h][i];
            }
            G_LDB(B0, 0, 0); G_SCHED; G_LDA(At, 0, 0); G_STAGE_A(G_SA(1, 1), a1, 1, vgc);
            G_WAIT_L(8); G_BAR; G_WAIT_L(0); G_MMA(0, 0, At, B0); G_BAR; G_SCHED;
            G_LDB(B1, 0, 1); G_STAGE(G_SB(0, 0), b2, voffB);
            G_BAR; G_WAIT_L(0); G_MMA(0, 1, At, B1); G_BAR;
            G_LDA(At, 0, 1); G_STAGE_A(G_SA(0, 0), a2, 0, vg2);
            G_BAR; G_WAIT_L(0); G_MMA(1, 0, At, B0); G_BAR; G_SCHED;
            G_STAGE(G_SB(0, 1), b2 + hstep, voffB);
            G_WAIT_V(6); G_BAR; G_MMA(1, 1, At, B1); G_BAR;
            G_LDB(B0, 1, 0); G_SCHED; G_LDA(At, 1, 0); G_STAGE_A(G_SA(0, 1), a2, 1, vg2);
            G_WAIT_L(8); G_BAR; G_WAIT_L(0); G_MMA(0, 0, At, B0); G_BAR; G_SCHED;
            G_LDB(B1, 1, 1); G_STAGE(G_SB(1, 0), b3, voffB);
            G_BAR; G_WAIT_L(0); G_MMA(0, 1, At, B1); G_BAR;
            G_LDA(At, 1, 1); G_STAGE_A(G_SA(1, 0), a3, 0, vg2);
            G_BAR; G_WAIT_L(0); G_MMA(1, 0, At, B0); G_BAR; G_SCHED;
            G_STAGE(G_SB(1, 1), b3 + hstep, voffB);
            G_WAIT_V(6); G_BAR; G_MMA(1, 1, At, B1); G_BAR;
            if (GATHER && t == 0 && has_next) {
                const LAS int* rows = (const LAS int*)(parbase + (ui & 1) * 4096 + NPAR * 1024);
#pragma unroll
                for (int h = 0; h < 2; ++h)
#pragma unroll
                    for (int i = 0; i < 2; ++i) vgn[h][i] = (unsigned)(rows[h * HALF + Rr[i]] * K + Cc[i]) * 2u;
            }
        }
        const bool keep_acc = E(acc, cur, wr, wc, fr, fq, (const LAS unsigned char*)(parbase + (ui & 1) * 4096));
        if (!has_next) break;
        if (!keep_acc)
#pragma unroll
        for (int a = 0; a < 2; ++a)
#pragma unroll
            for (int b = 0; b < 2; ++b)
#pragma unroll
                for (int m = 0; m < 4; ++m)
#pragma unroll
                    for (int n = 0; n < 2; ++n) acc[a][b][m][n] = (f32x4){0.f, 0.f, 0.f, 0.f};
        cur = nxt; cA = nA; cB = nB; ++ui;
        if (GATHER) {
#pragma unroll
            for (int h = 0; h < 2; ++h)
#pragma unroll
                for (int i = 0; i < 2; ++i) vgc[h][i] = vgn[h][i];
        }
    }
    G_WAIT_V(0);
    if (wr == 0) G_BAR;
    G_BAR;
#undef G_PAR_ISSUE
#undef G_SA
#undef G_SB
#undef G_STAGE
#undef G_STAGE_A
#undef G_LDA
#undef G_LDB
#undef G_MMA
#undef G_WAIT_V
#undef G_WAIT_L
#undef G_BAR
#undef G_SCHED
}

struct EpiProj {
    bf16_t* prkv; bf16_t* pconv; bf16_t* gates; const float* rstd1;
    static constexpr int NPAR = 1;
    __device__ __forceinline__ const void* par_src(const Unit& u, int, int lane) const { return rstd1 + NMETA + u.pm * BM + lane * 4; }
    __device__ __forceinline__ bool operator()(const f32x4 (&acc)[2][2][4][2], const Unit& u, int wr, int wc, int fr, int fq, const LAS unsigned char* par) const {
        const int row0 = u.pm * BM + wr * 64 + fr;
        const bool isg = u.pn >= 14;
        float rsv[2][4];
#pragma unroll
        for (int ai = 0; ai < 2; ++ai)
#pragma unroll
            for (int m = 0; m < 4; ++m) rsv[ai][m] = ((const LAS float*)par)[wr * 64 + fr + ai * HALF + m * 16];
#pragma unroll
        for (int ai = 0; ai < 2; ++ai)
#pragma unroll
            for (int m = 0; m < 4; ++m) {
                const int row = row0 + ai * HALF + m * 16;
                const float rs = rsv[ai][m];
                bf16_t* rowp = isg ? gates + (size_t)row * 2048 + (u.pn - 14) * 256 + wc * 32 + 8 * fq
                             : (u.pn < 6 ? prkv + (size_t)(NMETA + row) * 1536 + u.pn * 256 : pconv + (size_t)(NMETA + row) * 2048 + (u.pn - 6) * 256) + wc * 32 + 8 * fq;
#pragma unroll
                for (int bj = 0; bj < 2; ++bj) {
                    f32x4 v0 = acc[ai][bj][m][0] * rs, v1 = acc[ai][bj][m][1] * rs;
                    if (isg) {
#pragma unroll
                        for (int j = 0; j < 4; ++j) { v0[j] = sigmoidf_(v0[j]); v1[j] = sigmoidf_(v1[j]); }
                    }
                    u32x4 w; w.x = cvt_pk_bf16(v0[0], v0[1]); w.y = cvt_pk_bf16(v0[2], v0[3]); w.z = cvt_pk_bf16(v1[0], v1[1]); w.w = cvt_pk_bf16(v1[2], v1[3]);
                    *(u32x4*)(rowp + bj * HALF) = w;
                }
            }
        return false;
    }
};
struct EpiL {
    static constexpr int NPAR = 0;
    __device__ __forceinline__ const void* par_src(const Unit&, int, int) const { return nullptr; }
    float* LD; bf16_t* Ab; bf16_t* Gb; const float* w0; const float* a0;
    __device__ __forceinline__ bool operator()(const f32x4 (&acc)[2][2][4][2], const Unit& u, int wr, int wc, int fr, int fq, const LAS unsigned char* par) const {
        const int row0 = u.pm * BM + wr * 64 + fr;
        const int seg = u.pn >> 1;
        const int cb = (u.pn & 1) * 256 + wc * 32 + 8 * fq;
        const float* bias = seg == 0 ? w0 : a0;
        f32x4 bv[2][2];
#pragma unroll
        for (int bj = 0; bj < 2; ++bj) {
            bv[bj][0] = seg < 2 ? *(const f32x4*)(bias + cb + bj * HALF) : (f32x4){0.f, 0.f, 0.f, 0.f};
            bv[bj][1] = seg < 2 ? *(const f32x4*)(bias + cb + bj * HALF + 4) : (f32x4){0.f, 0.f, 0.f, 0.f};
        }
        const float sc = seg == 0 ? -0.60653065971f : 1.0f;
        bf16_t* ob = seg == 1 ? Ab : Gb;
#pragma unroll
        for (int ai = 0; ai < 2; ++ai)
#pragma unroll
            for (int m = 0; m < 4; ++m) {
                const int row = row0 + ai * HALF + m * 16;
#pragma unroll
                for (int bj = 0; bj < 2; ++bj) {
                    const int c = cb + bj * HALF;
                    f32x4 v0 = acc[ai][bj][m][0] + bv[bj][0], v1 = acc[ai][bj][m][1] + bv[bj][1];
                    if (seg < 2) {
#pragma unroll
                        for (int j = 0; j < 4; ++j) { v0[j] = sc * sigmoidf_(v0[j]); v1[j] = sc * sigmoidf_(v1[j]); }
                    }
                    if (seg == 0) {
                        float* p = LD + (size_t)row * 512 + c;
                        *(f32x4*)p = v0; *(f32x4*)(p + 4) = v1;
                    } else {
                        u32x4 w; w.x = cvt_pk_bf16(v0[0], v0[1]); w.y = cvt_pk_bf16(v0[2], v0[3]); w.z = cvt_pk_bf16(v1[0], v1[1]); w.w = cvt_pk_bf16(v1[2], v1[3]);
                        *(u32x4*)(ob + (size_t)row * 512 + c) = w;
                    }
                }
            }
        return false;
    }
};
template <int SECOND> struct EpiMerge {
    static constexpr int NPAR = 0;
    __device__ __forceinline__ const void* par_src(const Unit&, int, int) const { return nullptr; }
    bf16_t* merged; const bf16_t* gates;
    __device__ __forceinline__ bool operator()(const f32x4 (&acc)[2][2][4][2], const Unit& u, int wr, int wc, int fr, int fq, const LAS unsigned char* par) const {
        const int row0 = u.pm * BM + wr * 64 + fr, col0 = u.pn * BM + wc * 32 + 8 * fq;
#pragma unroll
        for (int ai = 0; ai < 2; ++ai)
#pragma unroll
            for (int m = 0; m < 4; ++m) {
                const int row = row0 + ai * HALF + m * 16;
#pragma unroll
                for (int bj = 0; bj < 2; ++bj) {
                    const int c = col0 + bj * HALF;
                    const u32x4 gw = *(const u32x4*)(gates + (size_t)row * 2048 + SECOND * 1024 + c);
                    f32x4 g0 = (f32x4){bflo(gw.x), bfhi(gw.x), bflo(gw.y), bfhi(gw.y)}, g1 = (f32x4){bflo(gw.z), bfhi(gw.z), bflo(gw.w), bfhi(gw.w)};
                    f32x4 v0 = acc[ai][bj][m][0] * g0, v1 = acc[ai][bj][m][1] * g1;
                    bf16_t* p = merged + (size_t)row * 1024 + c;
                    if (SECOND) {
                        const u32x4 ow = *(const u32x4*)p;
                        v0 += (f32x4){bflo(ow.x), bfhi(ow.x), bflo(ow.y), bfhi(ow.y)}; v1 += (f32x4){bflo(ow.z), bfhi(ow.z), bflo(ow.w), bfhi(ow.w)};
                    }
                    u32x4 w; w.x = cvt_pk_bf16(v0[0], v0[1]); w.y = cvt_pk_bf16(v0[2], v0[3]); w.z = cvt_pk_bf16(v1[0], v1[1]); w.w = cvt_pk_bf16(v1[2], v1[3]);
                    *(u32x4*)p = w;
                }
            }
        return false;
    }
};
struct MergeOrder {
    StaticOrder so; const char* A1; const char* B1;
    __device__ bool next(int i, Unit& u) const { const bool ok = so.next(i >> 1, u); u.aux = i & 1; return ok; }
    __device__ __forceinline__ const char* a_ptr(const Unit& u) const { return (u.aux ? A1 : so.A) + (size_t)u.pm * 256 * so.K * 2; }
    __device__ __forceinline__ const char* b_ptr(const Unit& u) const { return (u.aux ? B1 : so.Bt) + (size_t)u.pn * 256 * so.K * 2; }
    __device__ __forceinline__ int gather_row(const Unit&, int) const { return 0; }
    __device__ __forceinline__ const void* gather_src(const Unit&, int) const { return nullptr; }
};
struct EpiMergeFused {
    static constexpr int NPAR = 0;
    __device__ __forceinline__ const void* par_src(const Unit&, int, int) const { return nullptr; }
    bf16_t* merged; const bf16_t* gates;
    __device__ __forceinline__ bool operator()(f32x4 (&acc)[2][2][4][2], const Unit& u, int wr, int wc, int fr, int fq, const LAS unsigned char* par) const {
        const int row0 = u.pm * BM + wr * 64 + fr, col0 = u.pn * BM + wc * 32 + 8 * fq;
#pragma unroll
        for (int ai = 0; ai < 2; ++ai) {
            u32x4 gbw[4][2], gaw[4][2];
#pragma unroll
            for (int m = 0; m < 4; ++m)
#pragma unroll
                for (int bj = 0; bj < 2; ++bj) {
                    const bf16_t* gp = gates + (size_t)(row0 + ai * HALF + m * 16) * 2048 + col0 + bj * HALF;
                    gbw[m][bj] = *(const u32x4*)(gp + 1024);
                    gaw[m][bj] = u.aux == 0 ? *(const u32x4*)gp : (u32x4){0u, 0u, 0u, 0u};
                }
#pragma unroll
            for (int m = 0; m < 4; ++m)
#pragma unroll
                for (int bj = 0; bj < 2; ++bj) {
                    const int row = row0 + ai * HALF + m * 16, c = col0 + bj * HALF;
                    f32x4 gb0 = (f32x4){bflo(gbw[m][bj].x), bfhi(gbw[m][bj].x), bflo(gbw[m][bj].y), bfhi(gbw[m][bj].y)}, gb1 = (f32x4){bflo(gbw[m][bj].z), bfhi(gbw[m][bj].z), bflo(gbw[m][bj].w), bfhi(gbw[m][bj].w)};
#pragma unroll
                    for (int j = 0; j < 4; ++j) { gb0[j] = fmaxf(gb0[j], 1e-6f); gb1[j] = fmaxf(gb1[j], 1e-6f); }
                    if (u.aux == 0) {
                        const f32x4 ga0 = (f32x4){bflo(gaw[m][bj].x), bfhi(gaw[m][bj].x), bflo(gaw[m][bj].y), bfhi(gaw[m][bj].y)}, ga1 = (f32x4){bflo(gaw[m][bj].z), bfhi(gaw[m][bj].z), bflo(gaw[m][bj].w), bfhi(gaw[m][bj].w)};
#pragma unroll
                        for (int j = 0; j < 4; ++j) { acc[ai][bj][m][0][j] *= ga0[j] * __builtin_amdgcn_rcpf(gb0[j]); acc[ai][bj][m][1][j] *= ga1[j] * __builtin_amdgcn_rcpf(gb1[j]); }
                    } else {
                        const f32x4 v0 = acc[ai][bj][m][0] * gb0, v1 = acc[ai][bj][m][1] * gb1;
                        u32x4 w; w.x = cvt_pk_bf16(v0[0], v0[1]); w.y = cvt_pk_bf16(v0[2], v0[3]); w.z = cvt_pk_bf16(v1[0], v1[1]); w.w = cvt_pk_bf16(v1[2], v1[3]);
                        *(u32x4*)(merged + (size_t)row * 1024 + c) = w;
                    }
                }
        }
        return u.aux == 0;
    }
};
struct EpiO {
    static constexpr int NPAR = 0;
    __device__ __forceinline__ const void* par_src(const Unit&, int, int) const { return nullptr; }
    const float* x; float* h1; bf16_t* hb2;
    __device__ __forceinline__ bool operator()(const f32x4 (&acc)[2][2][4][2], const Unit& u, int wr, int wc, int fr, int fq, const LAS unsigned char* par) const {
        const int row0 = u.pm * BM + wr * 64 + fr, col0 = u.pn * BM + wc * 32 + 8 * fq;
#pragma unroll
        for (int ai = 0; ai < 2; ++ai) {
            f32x4 xv[4][2][2];
#pragma unroll
            for (int m = 0; m < 4; ++m)
#pragma unroll
                for (int bj = 0; bj < 2; ++bj) {
                    const size_t o = (size_t)(row0 + ai * HALF + m * 16) * 1024 + col0 + bj * HALF;
                    xv[m][bj][0] = *(const f32x4*)(x + o); xv[m][bj][1] = *(const f32x4*)(x + o + 4);
                }
#pragma unroll
            for (int m = 0; m < 4; ++m)
#pragma unroll
                for (int bj = 0; bj < 2; ++bj) {
                    const size_t o = (size_t)(row0 + ai * HALF + m * 16) * 1024 + col0 + bj * HALF;
                    const f32x4 v0 = acc[ai][bj][m][0] + xv[m][bj][0], v1 = acc[ai][bj][m][1] + xv[m][bj][1];
                    *(f32x4*)(h1 + o) = v0; *(f32x4*)(h1 + o + 4) = v1;
                    u32x4 w; w.x = cvt_pk_bf16(v0[0], v0[1]); w.y = cvt_pk_bf16(v0[2], v0[3]); w.z = cvt_pk_bf16(v1[0], v1[1]); w.w = cvt_pk_bf16(v1[2], v1[3]);
                    *(u32x4*)(hb2 + o) = w;
                }
        }
        return false;
    }
};
struct EpiMoe1 {
    bf16_t* act; const float* rowrs; const float* bg; const float* bu;
    static constexpr int NPAR = 2;
    __device__ __forceinline__ const void* par_src(const Unit& u, int piece, int lane) const {
        if (piece == 0) return rowrs + u.pm * BM + lane * 4;
        return (lane < 32 ? bg : bu) + (size_t)u.aux * DFF + u.pn * 128 + (lane & 31) * 4;
    }
    __device__ __forceinline__ bool operator()(const f32x4 (&acc)[2][2][4][2], const Unit& u, int wr, int wc, int fr, int fq, const LAS unsigned char* par) const {
        const int row0 = u.pm * BM + wr * 64 + fr, ff0 = u.pn * 128 + wc * 32 + 8 * fq;
        const LAS float* bgp = (const LAS float*)(par + 1024) + wc * 32 + 8 * fq; const LAS float* bup = bgp + 128;
        const f32x4 bg0 = *(const LAS f32x4*)bgp, bg1 = *(const LAS f32x4*)(bgp + 4), bu0 = *(const LAS f32x4*)bup, bu1 = *(const LAS f32x4*)(bup + 4);
        float rsv[2][4];
#pragma unroll
        for (int ai = 0; ai < 2; ++ai)
#pragma unroll
            for (int m = 0; m < 4; ++m) rsv[ai][m] = ((const LAS float*)par)[wr * 64 + fr + ai * HALF + m * 16];
#pragma unroll
        for (int ai = 0; ai < 2; ++ai)
#pragma unroll
            for (int m = 0; m < 4; ++m) {
                const int row = row0 + ai * HALF + m * 16;
                const float rs = rsv[ai][m];
                f32x4 g0 = acc[ai][0][m][0] * rs + bg0, g1 = acc[ai][0][m][1] * rs + bg1, u0 = acc[ai][1][m][0] * rs + bu0, u1 = acc[ai][1][m][1] * rs + bu1;
                f32x4 r0, r1;
#pragma unroll
                for (int j = 0; j < 4; ++j) {
                    { const float gt = fminf(g0[j], 7.0f), up = fminf(fmaxf(u0[j], -7.0f), 7.0f); r0[j] = (up + 1.0f) * gt * sigmoidf_(1.702f * gt); }
                    { const float gt = fminf(g1[j], 7.0f), up = fminf(fmaxf(u1[j], -7.0f), 7.0f); r1[j] = (up + 1.0f) * gt * sigmoidf_(1.702f * gt); }
                }
                u32x4 w; w.x = cvt_pk_bf16(r0[0], r0[1]); w.y = cvt_pk_bf16(r0[2], r0[3]); w.z = cvt_pk_bf16(r1[0], r1[1]); w.w = cvt_pk_bf16(r1[2], r1[3]);
                *(u32x4*)(act + (size_t)row * DFF + ff0) = w;
            }
        return false;
    }
};
struct EpiMoe2 {
    bf16_t* ya; bf16_t* yb; const int* rowslot; const float* roww; const float* bd;
    static constexpr int NPAR = 3;
    __device__ __forceinline__ const void* par_src(const Unit& u, int piece, int lane) const {
        if (piece == 0) return rowslot + u.pm * BM + lane * 4;
        if (piece == 1) return roww + u.pm * BM + lane * 4;
        return bd + (size_t)u.aux * D + u.pn * BM + lane * 4;
    }
    __device__ __forceinline__ bool operator()(const f32x4 (&acc)[2][2][4][2], const Unit& u, int wr, int wc, int fr, int fq, const LAS unsigned char* par) const {
        const int row0 = u.pm * BM + wr * 64 + fr, col0 = u.pn * BM + wc * 32 + 8 * fq;
        bf16_t* ybase = (u.pn < 2) ? ya : yb; const int yc0 = col0 & 511;
        const LAS float* bp = (const LAS float*)(par + 2048) + wc * 32 + 8 * fq;
        f32x4 bv[2][2];
#pragma unroll
        for (int bj = 0; bj < 2; ++bj) { bv[bj][0] = *(const LAS f32x4*)(bp + bj * HALF); bv[bj][1] = *(const LAS f32x4*)(bp + bj * HALF + 4); }
        int slotv[2][4]; float wv8[2][4];
#pragma unroll
        for (int ai = 0; ai < 2; ++ai)
#pragma unroll
            for (int m = 0; m < 4; ++m) { const int rl = wr * 64 + fr + ai * HALF + m * 16; slotv[ai][m] = ((const LAS int*)par)[rl]; wv8[ai][m] = ((const LAS float*)(par + 1024))[rl]; }
#pragma unroll
        for (int ai = 0; ai < 2; ++ai)
#pragma unroll
            for (int m = 0; m < 4; ++m) {
                const int slot = slotv[ai][m];
                if (slot >= 0) {
                    const float w8 = wv8[ai][m];
#pragma unroll
                    for (int bj = 0; bj < 2; ++bj) {
                        const f32x4 v0 = (acc[ai][bj][m][0] + bv[bj][0]) * w8, v1 = (acc[ai][bj][m][1] + bv[bj][1]) * w8;
                        u32x4 w; w.x = cvt_pk_bf16(v0[0], v0[1]); w.y = cvt_pk_bf16(v0[2], v0[3]); w.z = cvt_pk_bf16(v1[0], v1[1]); w.w = cvt_pk_bf16(v1[2], v1[3]);
                        *(u32x4*)(ybase + (size_t)slot * 512 + yc0 + bj * HALF) = w;
                    }
                }
            }
        return false;
    }
};

__device__ __forceinline__ void transpose_tile(LAS float* tile, const float* src, int ldsrc, int k0, int n0, bf16_t* dst, int ldd, int drow0, const float* sa, const float* mu, int mode, bool zero) {
    const int tid = threadIdx.x;
    if (!zero) {
#pragma unroll
        for (int i = 0; i < 2; ++i) {
            const int r = (tid >> 4) + 32 * i, c4 = (tid & 15) * 4;
            const f32x4 v = *(const f32x4*)(src + (size_t)(k0 + r) * ldsrc + n0 + c4);
            LAS float* t = tile + r * 65 + c4;
            t[0] = v[0]; t[1] = v[1]; t[2] = v[2]; t[3] = v[3];
        }
    }
    __syncthreads();
    {
        const int n = tid >> 3, kq = tid & 7;
        float v[8];
#pragma unroll
        for (int j = 0; j < 8; ++j) {
            const int k = k0 + 8 * kq + j;
            float s = sa ? sa[k] : 1.0f;
            if (mode == 1) s *= (1.0f - mu[k]);
            if (mode == 2) s *= mu[k];
            v[j] = zero ? 0.f : tile[(8 * kq + j) * 65 + n] * s;
        }
        u32x4 w; w.x = cvt_pk_bf16(v[0], v[1]); w.y = cvt_pk_bf16(v[2], v[3]); w.z = cvt_pk_bf16(v[4], v[5]); w.w = cvt_pk_bf16(v[6], v[7]);
        *(u32x4*)(dst + (size_t)(drow0 + n) * ldd + k0 + 8 * kq) = w;
    }
    __syncthreads();
}

__device__ __forceinline__ void phase_prep(const PPv& p, LAS unsigned char* lds) {
    const int tid = threadIdx.x, bid = blockIdx.x, nb = gridDim.x, lane = tid & 63, wave = tid >> 6;
    unsigned char* ws = p.gws();
    const float* x = p.gin(0); const float* meta = p.gin(1); const float* g1 = p.gin(2);
    if (bid == 0 && tid < 64) ((int*)(ws + OFF_GCNT))[tid] = 0;
    {
        bf16_t* HB = (bf16_t*)(ws + OFF_HB); float* rstd1 = (float*)(ws + OFF_RSTD1);
        for (int row0 = (bid * 8 + wave) * 4; row0 < NR; row0 += nb * 32) {
            f32x4 v[4][4];
#pragma unroll
            for (int u = 0; u < 4; ++u) {
                const int row = row0 + u < NR ? row0 + u : NR - 1;
                const float* src = row < NMETA ? meta + (size_t)row * D : x + (size_t)(row - NMETA) * D;
#pragma unroll
                for (int i = 0; i < 4; ++i) v[u][i] = *(const f32x4*)(src + i * 256 + lane * 4);
            }
#pragma unroll
            for (int u = 0; u < 4; ++u) {
                const int row = row0 + u;
                if (row < NR) {
                    float ss = 0.f;
#pragma unroll
                    for (int i = 0; i < 4; ++i) ss += v[u][i][0] * v[u][i][0] + v[u][i][1] * v[u][i][1] + v[u][i][2] * v[u][i][2] + v[u][i][3] * v[u][i][3];
                    ss = wave_sum_dpp(ss);
                    if (lane == 0) rstd1[row] = rsqrtf(ss * (1.0f / D) + NORM_EPS);
                    if (row >= NMETA) {
                        bf16_t* d = HB + (size_t)(row - NMETA) * D;
#pragma unroll
                        for (int i = 0; i < 4; ++i) { u32x2 w; w.x = cvt_pk_bf16(v[u][i][0], v[u][i][1]); w.y = cvt_pk_bf16(v[u][i][2], v[u][i][3]); *(u32x2*)(d + i * 256 + lane * 4) = w; }
                    }
                }
            }
        }
    }
    LAS float* tile = (LAS float*)lds;
    {
        bf16_t* WIN = (bf16_t*)(ws + OFF_WIN);
        const float* w_in = p.gin(3);
        for (int j = bid; j < 16 * 88; j += nb) {
            const int kt = j & 15, ntile = j >> 4, n0 = ntile * 64;
            const float* src; int ld, sn0, mode = 0; const float* mu = nullptr;
            if (n0 < 3072) { src = w_in; ld = 5120; sn0 = n0; }
            else if (n0 < 3584) {
                const int seg = (n0 - 3072) >> 6;
                if (seg < 2) { src = p.gin(11); ld = 64; sn0 = 0; mu = p.gin(7); mode = 1 + seg; }
                else if (seg < 4) { src = p.gin(14); ld = 64; sn0 = 0; mu = p.gin(8); mode = 1 + (seg - 2); }
                else { src = p.gin(16); ld = 128; sn0 = (seg & 1) * 64; mu = p.gin(9); mode = seg < 6 ? 1 : 2; }
            } else { src = w_in; ld = 5120; sn0 = n0 - 512; }
            transpose_tile(tile, src, ld, kt * 64, sn0, WIN, 1024, n0, g1, mu, mode, false);
        }
        for (int j = bid; j < 2 * 128; j += nb) {
            const int which = j >> 7, jj = j & 127, kt = jj & 7, ntile = jj >> 3;
            transpose_tile(tile, which ? p.gin(25) : p.gin(23), 1024, kt * 64, ntile * 64, (bf16_t*)(ws + (which ? OFF_WC : OFF_WR)), 512, ntile * 64, nullptr, nullptr, 0, false);
        }
        for (int j = bid; j < 256; j += nb) {
            const int kt = j & 15, ntile = j >> 4;
            transpose_tile(tile, p.gin(26), 1024, kt * 64, ntile * 64, (bf16_t*)(ws + OFF_WO), 1024, ntile * 64, nullptr, nullptr, 0, false);
        }
        for (int j = bid; j < 96; j += nb) {
            const int kt = j & 3, ntile = j >> 2, seg = ntile >> 3, nn0 = (ntile & 7) * 64;
            const float* src = nullptr; int sk0 = 0; bool zero = true;
            if (seg == 0 && kt == 0) { src = p.gin(12); sk0 = 0; zero = false; }
            if (seg == 1 && kt == 1) { src = p.gin(15); sk0 = 0; zero = false; }
            if (seg == 2 && kt >= 2) { src = p.gin(17); sk0 = (kt - 2) * 64; zero = false; }
            const float* srcs = zero ? p.gin(12) : src + (size_t)(sk0 - kt * 64) * 512;
            transpose_tile(tile, srcs, 512, kt * 64, nn0, (bf16_t*)(ws + OFF_W2), 256, ntile * 64, nullptr, nullptr, 0, zero);
        }
        {
            float* WRG = (float*)(ws + OFF_WRG); const float* g2 = p.gin(27); const float* wr_ = p.gin(28);
            for (int i = bid * 512 + tid; i < 1024 * 32; i += nb * 512) WRG[i] = g2[i >> 5] * wr_[i];
        }
    }
}

__device__ __forceinline__ void phase_meta_proj(const PPv& p, LAS unsigned char* lds) {
    const int tid = threadIdx.x, bid = blockIdx.x, lane = tid & 63, wave = tid >> 6;
    unsigned char* ws = p.gws();
    LAS float* sm = (LAS float*)lds;
    const float* meta = p.gin(1);
    for (int i = tid; i < 16 * 256; i += 512) { const int r = i >> 8, c4 = (i & 255) * 4; const f32x4 v = *(const f32x4*)(meta + r * 1024 + c4); LAS float* d = sm + r * 1028 + c4; d[0] = v[0]; d[1] = v[1]; d[2] = v[2]; d[3] = v[3]; }
    __syncthreads();
    const float* rstd1 = (const float*)(ws + OFF_RSTD1);
    for (int nbase = bid * 14; nbase < PCOLS1; nbase += gridDim.x * 14) {
        for (int nn = wave; nn < 14; nn += 8) {
            const int n = nbase + nn;
            if (n >= PCOLS1) break;
            const bf16_t* wrow = (const bf16_t*)(ws + OFF_WIN) + (size_t)n * 1024;
            const u32x4 w0 = *(const u32x4*)(wrow + 8 * lane), w1 = *(const u32x4*)(wrow + 512 + 8 * lane);
            const float wf[16] = {bflo(w0.x), bfhi(w0.x), bflo(w0.y), bfhi(w0.y), bflo(w0.z), bfhi(w0.z), bflo(w0.w), bfhi(w0.w),
                                  bflo(w1.x), bfhi(w1.x), bflo(w1.y), bfhi(w1.y), bflo(w1.z), bfhi(w1.z), bflo(w1.w), bfhi(w1.w)};
            float outv = 0.f;
#pragma unroll
            for (int pr = 0; pr < 16; ++pr) {
                const LAS float* m0 = sm + pr * 1028 + 8 * lane;
                const f32x4 a0 = *(const LAS f32x4*)m0, a1 = *(const LAS f32x4*)(m0 + 4), a2 = *(const LAS f32x4*)(m0 + 512), a3 = *(const LAS f32x4*)(m0 + 516);
                float acc = a0[0] * wf[0] + a0[1] * wf[1] + a0[2] * wf[2] + a0[3] * wf[3] + a1[0] * wf[4] + a1[1] * wf[5] + a1[2] * wf[6] + a1[3] * wf[7]
                          + a2[0] * wf[8] + a2[1] * wf[9] + a2[2] * wf[10] + a2[3] * wf[11] + a3[0] * wf[12] + a3[1] * wf[13] + a3[2] * wf[14] + a3[3] * wf[15];
                acc = wave_sum_dpp(acc);
                outv = (lane == pr) ? acc * rstd1[pr] : outv;
            }
            if (lane < 16) {
                if (n < 1536) ((bf16_t*)(ws + OFF_PRKV))[(size_t)lane * 1536 + n] = f2bf(outv);
                else ((bf16_t*)(ws + OFF_PCONV))[(size_t)lane * 2048 + n - 1536] = f2bf(outv);
            }
        }
    }
    __syncthreads();
}

__device__ __forceinline__ void phase_lprep_conv(const PPv& p) {
    const int tid = threadIdx.x, bid = blockIdx.x, nb = gridDim.x;
    unsigned char* ws = p.gws();
    const bf16_t* PROJ = (const bf16_t*)(ws + OFF_PCONV);
    constexpr int PCOLS = 2048;
    bf16_t* L = (bf16_t*)(ws + OFF_L);
    for (int i = bid * 512 + tid; i < NRP * 32; i += nb * 512) {
        const int row = i >> 5, gq = i & 31;
        u32x4 w = (u32x4){0u, 0u, 0u, 0u};
        if (row < NR) {
            int ca, cb;
            if (gq < 8) { ca = 1536 + gq * 8; cb = ca + 64; }
            else if (gq < 16) { ca = 1536 + 128 + (gq - 8) * 8; cb = ca + 64; }
            else { ca = 1536 + 256 + (gq - 16) * 8; cb = ca + 128; }
            const u32x4 va = *(const u32x4*)(PROJ + (size_t)row * PCOLS + ca);
            const int pr = prev_row(row, 1);
            u32x4 vb = (u32x4){0u, 0u, 0u, 0u};
            if (pr >= 0) vb = *(const u32x4*)(PROJ + (size_t)pr * PCOLS + cb);
            float v[8] = {bflo(va.x) + bflo(vb.x), bfhi(va.x) + bfhi(vb.x), bflo(va.y) + bflo(vb.y), bfhi(va.y) + bfhi(vb.y), bflo(va.z) + bflo(vb.z), bfhi(va.z) + bfhi(vb.z), bflo(va.w) + bflo(vb.w), bfhi(va.w) + bfhi(vb.w)};
#pragma unroll
            for (int j = 0; j < 8; ++j) { if (gq < 8) v[j] = tanhf(v[j]); else if (gq >= 16) v[j] = sigmoidf_(v[j]); }
            w.x = cvt_pk_bf16(v[0], v[1]); w.y = cvt_pk_bf16(v[2], v[3]); w.z = cvt_pk_bf16(v[4], v[5]); w.w = cvt_pk_bf16(v[6], v[7]);
        }
        *(u32x4*)(L + (size_t)row * 256 + gq * 8) = w;
    }
    bf16_t* C = (bf16_t*)(ws + OFF_C);
    const float* cw = p.gin(24);
    for (int i = bid * 512 + tid; i < T * 64; i += nb * 512) {
        const int m = i >> 6, ch = (i & 63) * 8, row = NMETA + m;
        const int r1 = prev_row(row, 1), r2 = prev_row(row, 2);
        const bf16_t* p0 = PROJ + (size_t)row * PCOLS; const bf16_t* p1 = PROJ + (size_t)r1 * PCOLS; const bf16_t* p2 = PROJ + (size_t)r2 * PCOLS;
        const u32x4 vb = *(const u32x4*)(p0 + ch);
        const u32x4 c0 = *(const u32x4*)(p0 + 512 + ch), h0 = *(const u32x4*)(p0 + 1024 + ch);
        const u32x4 c1 = *(const u32x4*)(p1 + 512 + ch), h1 = *(const u32x4*)(p1 + 1024 + ch);
        const u32x4 c2 = *(const u32x4*)(p2 + 512 + ch), h2 = *(const u32x4*)(p2 + 1024 + ch);
        float o[8];
#pragma unroll
        for (int j = 0; j < 8; ++j) {
            const unsigned wb = j < 2 ? vb.x : j < 4 ? vb.y : j < 6 ? vb.z : vb.w;
            const unsigned wc0 = j < 2 ? c0.x : j < 4 ? c0.y : j < 6 ? c0.z : c0.w, wh0 = j < 2 ? h0.x : j < 4 ? h0.y : j < 6 ? h0.z : h0.w;
            const unsigned wc1 = j < 2 ? c1.x : j < 4 ? c1.y : j < 6 ? c1.z : c1.w, wh1 = j < 2 ? h1.x : j < 4 ? h1.y : j < 6 ? h1.z : h1.w;
            const unsigned wc2 = j < 2 ? c2.x : j < 4 ? c2.y : j < 6 ? c2.z : c2.w, wh2 = j < 2 ? h2.x : j < 4 ? h2.y : j < 6 ? h2.z : h2.w;
            const bool hi = j & 1;
            const float b = hi ? bfhi(wb) : bflo(wb);
            const float u0 = (hi ? bfhi(wc0) : bflo(wc0)) * (hi ? bfhi(wh0) : bflo(wh0));
            const float u1 = (hi ? bfhi(wc1) : bflo(wc1)) * (hi ? bfhi(wh1) : bflo(wh1));
            const float u2 = (hi ? bfhi(wc2) : bflo(wc2)) * (hi ? bfhi(wh2) : bflo(wh2));
            const float conv = cw[ch + j] * u2 + cw[512 + ch + j] * u1 + cw[1024 + ch + j] * u0;
            o[j] = b * conv;
        }
        u32x4 w; w.x = cvt_pk_bf16(o[0], o[1]); w.y = cvt_pk_bf16(o[2], o[3]); w.z = cvt_pk_bf16(o[4], o[5]); w.w = cvt_pk_bf16(o[6], o[7]);
        *(u32x4*)(C + (size_t)m * 512 + ch) = w;
    }
}

template <int CTRL> __device__ __forceinline__ float dppmov(float v) { return __builtin_bit_cast(float, __builtin_amdgcn_update_dpp(0, __builtin_bit_cast(int, v), CTRL, 0xF, 0xF, true)); }
__device__ __forceinline__ float wave_sum_dpp(float v) {
    v += dppmov<0xB1>(v);
    v += dppmov<0x4E>(v);
    v += dppmov<0x141>(v);
    v += dppmov<0x140>(v);
    { float c = v; asm volatile("v_nop\n\tv_nop\n\tv_permlane16_swap_b32 %0, %1\n\tv_nop" : "+v"(v), "+v"(c)); v += c; }
    { float c = v; asm volatile("v_nop\n\tv_nop\n\tv_permlane32_swap_b32 %0, %1\n\tv_nop" : "+v"(v), "+v"(c)); v += c; }
    return v;
}
typedef float f32x16 __attribute__((ext_vector_type(16)));

struct RawTok { bf16_t r, k, v, a; float ld; };
__device__ __forceinline__ RawTok load_raw(const bf16_t* PRKV, const bf16_t* Ab, const float* LD, int row, int col) {
    RawTok q; const bf16_t* p0 = PRKV + (size_t)row * 1536 + col;
    q.r = p0[0]; q.k = p0[512]; q.v = p0[1024]; q.a = Ab[(size_t)row * 512 + col]; q.ld = LD[(size_t)row * 512 + col];
    return q;
}
__device__ __forceinline__ void unit_geom(int uid, int lane, int& b, int& h, int& c, int& col, int& row0) {
    const int bh = uid / NCHUNK; c = uid - bh * NCHUNK; b = bh >> 3; h = bh & 7; col = h * 64 + lane;
    row0 = c == 0 ? 0 : b * SEQ + c * 16;
}
__device__ __forceinline__ void phase_scanprep(const PPv& p, LAS unsigned char* lds) {
    const int tid = threadIdx.x, bid = blockIdx.x, nb = gridDim.x, lane = tid & 63, wave = tid >> 6;
    unsigned char* ws = p.gws();
    const bf16_t* PRKV = (const bf16_t*)(ws + OFF_PRKV);
    const float* LD = (const float*)(ws + OFF_LD);
    const bf16_t* Ab = (const bf16_t*)(ws + OFF_A);
    float* COEF = (float*)(ws + OFF_COEF);
    LAS unsigned char* wl = lds + wave * 13824;
    LAS bf16_t* AR = (LAS bf16_t*)wl;
    LAS bf16_t* BK = (LAS bf16_t*)(wl + 4608);
    LAS float* DM = (LAS float*)(wl + 9216);
    const int qperm = (lane & 32) | (((lane >> 2) & 3) << 3) | (((lane >> 4) & 1) << 2) | (lane & 3);
    int uid = bid * 8 + wave;
    if (uid >= NUNITS) return;
    int b, h, c, col, row0;
    unit_geom(uid, lane, b, h, c, col, row0);
    RawTok q[16], qn[16];
    bf16_t prr = 0, prk = 0, prv = 0, nprr = 0, nprk = 0, nprv = 0;
#pragma unroll
    for (int t = 0; t < 16; ++t) q[t] = load_raw(PRKV, Ab, LD, row0 + t, col);
    { const int pr = prev_row(row0, 1); if (pr >= 0) { const bf16_t* p1 = PRKV + (size_t)pr * 1536 + col; prr = p1[0]; prk = p1[512]; prv = p1[1024]; } }
    for (;;) {
        const float mur = p.gin(4)[col], muk = p.gin(5)[col], muv = p.gin(6)[col], kkw = p.gin(18)[col], kaw = p.gin(19)[col], rkw = p.gin(20)[col];
        const int nuid = uid + nb * 8; const bool has_next = nuid < NUNITS;
        int nb_ = b, nh = h, nc = c, ncol = col, nrow0 = row0;
        if (has_next) {
            unit_geom(nuid, lane, nb_, nh, nc, ncol, nrow0);
#pragma unroll
            for (int t = 0; t < 16; ++t) qn[t] = load_raw(PRKV, Ab, LD, nrow0 + t, ncol);
            nprr = 0; nprk = 0; nprv = 0;
            const int pr = prev_row(nrow0, 1); if (pr >= 0) { const bf16_t* p1 = PRKV + (size_t)pr * 1536 + ncol; nprr = p1[0]; nprk = p1[512]; nprv = p1[1024]; }
        }
        __builtin_amdgcn_sched_barrier(0);
        float at[16], vt[16]; unsigned btp[8], ktp[8]; float bprev = 0.f, kprev = 0.f;
        float cl = 0.f;
        float rp = bf2f(prr), kp = bf2f(prk), vp = bf2f(prv);
#pragma unroll
        for (int t = 0; t < 16; ++t) {
            const RawTok qq = q[t];
            const int row = row0 + t;
            const float r0 = bf2f(qq.r), k0 = bf2f(qq.k), v0 = bf2f(qq.v);
            const float r = r0 + (rp - r0) * mur, k = k0 + (kp - k0) * muk, v = v0 + (vp - v0) * muv;
            rp = r0; kp = k0; vp = v0;
            const float a = bf2f(qq.a);
            const float kkv = k * kkw;
            const float n2 = wave_sum_dpp(kkv * kkv);
            const float kk = kkv * __builtin_amdgcn_rsqf(fmaxf(n2, 1e-24f));
            const float k2 = k * (1.0f + (a - 1.0f) * kaw);
            const float cf = wave_sum_dpp(r * k2 * rkw);
            if (lane == 0) COEF[(size_t)row * 8 + h] = cf;
            const float wcp = __expf(cl);
            cl += qq.ld;
            const float wcn = __expf(cl), iw = __expf(-cl);
            const float btv = kk * a * iw, ktv = k2 * iw;
            at[t] = -kk * wcp; vt[t] = v;
            { const unsigned w = cvt_pk_bf16(at[t], r * wcn); AR[t * 72 + qperm] = (bf16_t)(w & 0xFFFFu); AR[(16 + t) * 72 + qperm] = (bf16_t)(w >> 16); }
            if (t & 1) {
                btp[t >> 1] = cvt_pk_bf16(bprev, btv); ktp[t >> 1] = cvt_pk_bf16(kprev, ktv);
                BK[(t - 1) * 72 + qperm] = (bf16_t)(btp[t >> 1] & 0xFFFFu); BK[t * 72 + qperm] = (bf16_t)(btp[t >> 1] >> 16);
                BK[(16 + t - 1) * 72 + qperm] = (bf16_t)(ktp[t >> 1] & 0xFFFFu); BK[(16 + t) * 72 + qperm] = (bf16_t)(ktp[t >> 1] >> 16);
            } else { bprev = btv; kprev = ktv; }
            if (t & 1) __builtin_amdgcn_sched_barrier(0);
        }
        const float wcc = __expf(cl);
        {
            f32x16 dm;
#pragma unroll
            for (int i = 0; i < 16; ++i) dm[i] = 0.f;
            const int rr = lane & 31, hh = lane >> 5;
#pragma unroll
            for (int ks = 0; ks < 4; ++ks) {
                const bf16x8 fa = *(const LAS bf16x8*)(AR + rr * 72 + 16 * ks + 8 * hh);
                const bf16x8 fb = *(const LAS bf16x8*)(BK + rr * 72 + 16 * ks + 8 * hh);
                dm = __builtin_amdgcn_mfma_f32_32x32x16_bf16(fa, fb, dm, 0, 0, 0);
            }
#pragma unroll
            for (int reg = 0; reg < 16; ++reg) DM[((reg & 3) + 8 * (reg >> 2) + 4 * hh) * 36 + rr] = dm[reg];
        }
        __builtin_amdgcn_sched_barrier(0);
        float uh[16];
#pragma unroll
        for (int t = 0; t < 16; ++t) {
            float wv = at[t], uv = 0.f, wv2 = 0.f, uv2 = 0.f, uv3 = 0.f;
#pragma unroll
            for (int s4 = 0; s4 < 4; ++s4) {
                if (s4 * 4 < t) {
                    const f32x4 ab = *(const LAS f32x4*)(DM + t * 36 + s4 * 4), ak = *(const LAS f32x4*)(DM + t * 36 + 16 + s4 * 4);
#pragma unroll
                    for (int j = 0; j < 4; ++j) {
                        const int s_ = s4 * 4 + j;
                        if (s_ < t) {
                            if (j & 1) { wv2 += ab[j] * at[s_]; uv2 += ak[j] * vt[s_]; } else { wv += ab[j] * at[s_]; uv += ak[j] * vt[s_]; }
                            uv3 += ab[j] * uh[s_];
                        }
                    }
                }
            }
            wv += wv2; uv += uv2 + uv3;
            at[t] = wv; uh[t] = uv;
            asm volatile("" : "+v"(at[t]), "+v"(uh[t]));
        }
        __builtin_amdgcn_sched_barrier(0);
#pragma unroll
        for (int t = 0; t < 16; t += 2) { const unsigned w = cvt_pk_bf16(at[t], at[t + 1]); AR[t * 72 + qperm] = (bf16_t)(w & 0xFFFFu); AR[(t + 1) * 72 + qperm] = (bf16_t)(w >> 16); }
        unsigned char* rec = ws + OFF_CH + (size_t)uid * REC_BYTES;
#pragma unroll
        for (int i = 0; i < 2; ++i) {
            const int pc = i * 64 + lane, row = pc >> 3, part = pc & 7;
            *(u32x4*)(rec + RO_WH + pc * 16) = *(const LAS u32x4*)((LAS unsigned char*)AR + row * 144 + part * 16);
            *(u32x4*)(rec + RO_RT + pc * 16) = *(const LAS u32x4*)((LAS unsigned char*)AR + (16 + row) * 144 + part * 16);
        }
        {
            u32x4 w0, w1;
            w0.x = cvt_pk_bf16(uh[0], uh[1]); w0.y = cvt_pk_bf16(uh[2], uh[3]); w0.z = cvt_pk_bf16(uh[4], uh[5]); w0.w = cvt_pk_bf16(uh[6], uh[7]);
            w1.x = cvt_pk_bf16(uh[8], uh[9]); w1.y = cvt_pk_bf16(uh[10], uh[11]); w1.z = cvt_pk_bf16(uh[12], uh[13]); w1.w = cvt_pk_bf16(uh[14], uh[15]);
            *(u32x4*)(rec + RO_U0T + lane * 32) = w0; *(u32x4*)(rec + RO_U0T + lane * 32 + 16) = w1;
            w0.x = cvt_pk_bf16(vt[0], vt[1]); w0.y = cvt_pk_bf16(vt[2], vt[3]); w0.z = cvt_pk_bf16(vt[4], vt[5]); w0.w = cvt_pk_bf16(vt[6], vt[7]);
            w1.x = cvt_pk_bf16(vt[8], vt[9]); w1.y = cvt_pk_bf16(vt[10], vt[11]); w1.z = cvt_pk_bf16(vt[12], vt[13]); w1.w = cvt_pk_bf16(vt[14], vt[15]);
            *(u32x4*)(rec + RO_VT + lane * 32) = w0; *(u32x4*)(rec + RO_VT + lane * 32 + 16) = w1;
        }
#pragma unroll
        for (int g = 0; g < 4; ++g) {
            u32x4 w; w.x = btp[2 * g]; w.y = btp[2 * g + 1]; w.z = ktp[2 * g]; w.w = ktp[2 * g + 1];
            *(u32x4*)(rec + RO_BKT + lane * 64 + g * 16) = w;
        }
        {
            const int t = lane >> 2, g = lane & 3;
            const f32x4 rb = *(const LAS f32x4*)(DM + (16 + t) * 36 + 4 * g), rk = *(const LAS f32x4*)(DM + (16 + t) * 36 + 16 + 4 * g);
            float o[8];
#pragma unroll
            for (int j = 0; j < 4; ++j) { const bool keep = (4 * g + j) <= t; o[j] = keep ? rb[j] : 0.f; o[4 + j] = keep ? rk[j] : 0.f; }
            u32x4 w; w.x = cvt_pk_bf16(o[0], o[1]); w.y = cvt_pk_bf16(o[2], o[3]); w.z = cvt_pk_bf16(o[4], o[5]); w.w = cvt_pk_bf16(o[6], o[7]);
            *(u32x4*)(rec + RO_ARK + t * 64 + g * 16) = w;
        }
        *(float*)(rec + RO_WCC + lane * 4) = wcc;
        if (!has_next) break;
        uid = nuid; b = nb_; h = nh; c = nc; col = ncol; row0 = nrow0;
#pragma unroll
        for (int t = 0; t < 16; ++t) q[t] = qn[t];
        prr = nprr; prk = nprk; prv = nprv;
        __builtin_amdgcn_sched_barrier(0);
    }
}

__device__ __forceinline__ void convert_expert_weights(const PPv& p, LAS unsigned char* lds, int first, int stride);
struct RecOps { bf16x8 wA0, wA1, rA0, rA1, ark, bk[4]; u32x2 u0, vv; f32x4 wc[4]; };
__device__ __forceinline__ void load_ops(RecOps& o, LAS unsigned char* S, int vs, int fr, int g) {
    o.wA0 = *(const LAS bf16x8*)(S + RO_WH + fr * 128 + g * 16); o.wA1 = *(const LAS bf16x8*)(S + RO_WH + fr * 128 + 64 + g * 16);
    o.rA0 = *(const LAS bf16x8*)(S + RO_RT + fr * 128 + g * 16); o.rA1 = *(const LAS bf16x8*)(S + RO_RT + fr * 128 + 64 + g * 16);
    o.u0 = *(const LAS u32x2*)(S + RO_U0T + (16 * vs + fr) * 32 + g * 8);
    o.vv = *(const LAS u32x2*)(S + RO_VT + (16 * vs + fr) * 32 + g * 8);
    o.ark = *(const LAS bf16x8*)(S + RO_ARK + fr * 64 + g * 16);
#pragma unroll
    for (int m = 0; m < 4; ++m) { o.bk[m] = *(const LAS bf16x8*)(S + RO_BKT + (16 * m + fr) * 64 + g * 16); o.wc[m] = *(const LAS f32x4*)(S + RO_WCC + (16 * m + 4 * g) * 4); }
}
__device__ __forceinline__ void phase_recur(const PPv& p, LAS unsigned char* lds) {
    const int tid = threadIdx.x, bid = blockIdx.x, nb = gridDim.x, lane = tid & 63, wave = __builtin_amdgcn_readfirstlane(tid >> 6);
    unsigned char* ws = p.gws();
    if (bid >= 64) { convert_expert_weights(p, lds, bid - 64, nb - 64); return; }
    unsigned char* CHb = ws + OFF_CH + (size_t)(bid * NCHUNK) * REC_BYTES;
    constexpr int RSLOT = REC_BYTES, RN = 10, PF = 7;
#define R_BAR() do { asm volatile("s_waitcnt lgkmcnt(0)" ::: "memory"); __builtin_amdgcn_s_barrier(); asm volatile("" ::: "memory"); } while (0)
    if (wave >= 4) {
        const int lw = wave - 4;
#define R_ISSUE(x) do { \
            LAS unsigned char* _s = lds + ((x) % RN) * RSLOT; const unsigned char* _r = CHb + (size_t)(x) * REC_BYTES + lane * 16; \
            _Pragma("unroll") for (int _i = 0; _i < 3; ++_i) { const int _pc = lw + 4 * _i; __builtin_amdgcn_global_load_lds((const unsigned*)(_r + _pc * 1024), (LAS unsigned*)(_s + _pc * 1024), 16, 0, 0); } \
            if (lw == 0) __builtin_amdgcn_global_load_lds((const unsigned*)(_r + 12 * 1024), (LAS unsigned*)(_s + 12 * 1024), 16, 0, 0); \
            if (lw == 1) { if (lane < 16) __builtin_amdgcn_global_load_lds((const unsigned*)(_r + 13 * 1024), (LAS unsigned*)(_s + 13 * 1024), 16, 0, 0); } } while (0)
        for (int x = 0; x < PF; ++x) R_ISSUE(x);
        asm volatile("s_waitcnt vmcnt(0)" ::: "memory");
        R_BAR();
        for (int c = 0; c < NCHUNK; ++c) {
            const int x = c + PF;
            if (x < NCHUNK) R_ISSUE(x);
            if (x < NCHUNK) { if (lw < 2) asm volatile("s_waitcnt vmcnt(20)" ::: "memory"); else asm volatile("s_waitcnt vmcnt(15)" ::: "memory"); }
            else asm volatile("s_waitcnt vmcnt(0)" ::: "memory");
            R_BAR();
        }
#undef R_ISSUE
    } else {
        const int vs = wave, fr = lane & 15, g = lane >> 4;
        f32x4 H[4];
#pragma unroll
        for (int m = 0; m < 4; ++m) H[m] = (f32x4){0.f, 0.f, 0.f, 0.f};
        R_BAR();
        RecOps cur, nxt;
        load_ops(cur, lds, vs, fr, g);
        for (int c = 0; c < NCHUNK; ++c) {
            if (c + 1 < NCHUNK) load_ops(nxt, lds + ((c + 1) % RN) * RSLOT, vs, fr, g); else nxt = cur;
            u32x4 hb0, hb1;
            hb0.x = cvt_pk_bf16(H[0][0], H[0][1]); hb0.y = cvt_pk_bf16(H[0][2], H[0][3]); hb0.z = cvt_pk_bf16(H[1][0], H[1][1]); hb0.w = cvt_pk_bf16(H[1][2], H[1][3]);
            hb1.x = cvt_pk_bf16(H[2][0], H[2][1]); hb1.y = cvt_pk_bf16(H[2][2], H[2][3]); hb1.z = cvt_pk_bf16(H[3][0], H[3][1]); hb1.w = cvt_pk_bf16(H[3][2], H[3][3]);
            const bf16x8 hB0 = __builtin_bit_cast(bf16x8, hb0), hB1 = __builtin_bit_cast(bf16x8, hb1);
            f32x4 U = (f32x4){bflo(cur.u0.x), bfhi(cur.u0.x), bflo(cur.u0.y), bfhi(cur.u0.y)};
            U = __builtin_amdgcn_mfma_f32_16x16x32_bf16(cur.wA0, hB0, U, 0, 0, 0);
            U = __builtin_amdgcn_mfma_f32_16x16x32_bf16(cur.wA1, hB1, U, 0, 0, 0);
            f32x4 Y = (f32x4){0.f, 0.f, 0.f, 0.f};
            Y = __builtin_amdgcn_mfma_f32_16x16x32_bf16(cur.rA0, hB0, Y, 0, 0, 0);
            Y = __builtin_amdgcn_mfma_f32_16x16x32_bf16(cur.rA1, hB1, Y, 0, 0, 0);
            u32x4 uvw; uvw.x = cvt_pk_bf16(U[0], U[1]); uvw.y = cvt_pk_bf16(U[2], U[3]); uvw.z = cur.vv.x; uvw.w = cur.vv.y;
            const bf16x8 uv = __builtin_bit_cast(bf16x8, uvw);
            Y = __builtin_amdgcn_mfma_f32_16x16x32_bf16(cur.ark, uv, Y, 0, 0, 0);
#pragma unroll
            for (int m = 0; m < 4; ++m) { H[m] = __builtin_amdgcn_mfma_f32_16x16x32_bf16(cur.bk[m], uv, H[m], 0, 0, 0); H[m] *= cur.wc[m]; }
            u32x2 yw; yw.x = cvt_pk_bf16(Y[0], Y[1]); yw.y = cvt_pk_bf16(Y[2], Y[3]);
            *(u32x2*)(CHb + (size_t)c * REC_BYTES + RO_U0T + (16 * vs + fr) * 32 + g * 8) = yw;
            R_BAR();
            cur = nxt;
        }
    }
#undef R_BAR
}

__device__ __forceinline__ void phase_gn(const PPv& p) {
    const int tid = threadIdx.x, bid = blockIdx.x, nb = gridDim.x, lane = tid & 63, wave = tid >> 6;
    unsigned char* ws = p.gws();
    const bf16_t* Gb = (const bf16_t*)(ws + OFF_G); const float* COEF = (const float*)(ws + OFF_COEF);
    bf16_t* Z = (bf16_t*)(ws + OFF_Z);
    for (int uid = bid * 8 + wave; uid < NUNITS; uid += nb * 8) {
        const int bh = uid / NCHUNK, c = uid - bh * NCHUNK, b = bh >> 3, h = bh & 7;
        if (c == 0) continue;
        const int col = h * 64 + lane, row0 = b * SEQ + c * 16;
        const float lng = p.gin(21)[col], lnb = p.gin(22)[col];
        const unsigned char* rec = ws + OFF_CH + (size_t)uid * REC_BYTES;
        const u32x4 y0 = *(const u32x4*)(rec + RO_U0T + lane * 32), y1 = *(const u32x4*)(rec + RO_U0T + lane * 32 + 16);
        const u32x4 v0 = *(const u32x4*)(rec + RO_VT + lane * 32), v1 = *(const u32x4*)(rec + RO_VT + lane * 32 + 16);
        const unsigned yw[8] = {y0.x, y0.y, y0.z, y0.w, y1.x, y1.y, y1.z, y1.w}, vw[8] = {v0.x, v0.y, v0.z, v0.w, v1.x, v1.y, v1.z, v1.w};
        float cfv[16]; bf16_t ggv[16];
#pragma unroll
        for (int t = 0; t < 16; ++t) { cfv[t] = COEF[(size_t)(row0 + t) * 8 + h]; ggv[t] = Gb[(size_t)(row0 + t) * 512 + col]; }
#pragma unroll
        for (int t = 0; t < 16; ++t) {
            const float y = (t & 1) ? bfhi(yw[t >> 1]) : bflo(yw[t >> 1]);
            const float v = (t & 1) ? bfhi(vw[t >> 1]) : bflo(vw[t >> 1]);
            const float mean = wave_sum_dpp(y) * (1.0f / 64.0f);
            const float dlt = y - mean;
            const float var = wave_sum_dpp(dlt * dlt) * (1.0f / 64.0f);
            const float yn = dlt * rsqrtf(var + LNX_EPS) * lng + lnb;
            const float cf = cfv[t];
            const float gg = bf2f(ggv[t]);
            Z[(size_t)(row0 + t - NMETA) * 512 + col] = f2bf((yn + cf * v) * gg);
        }
    }
}

__device__ __forceinline__ void convert_expert_weights(const PPv& p, LAS unsigned char* lds, int first, int stride) {
    unsigned char* ws = p.gws();
    const int tid = threadIdx.x;
    LAS float* tile = (LAS float*)lds;
    const float* g2 = p.gin(27);
    bf16_t* WGU = (bf16_t*)(ws + OFF_WGU); bf16_t* WD = (bf16_t*)(ws + OFF_WD);
    constexpr int NBLK = NE * 3 * 64;
    const int lr = tid >> 6, lc = (tid & 63) * 4;
    f32x4 cur[8];
    int j = first;
    if (j >= NBLK) return;
    {
        const int mat = j >> 6, e = mat / 3, which = mat - 3 * e, bb = j & 63, kb = bb & 15, nbk = bb >> 4;
        const float* src = (which == 0 ? p.gin(30) : which == 1 ? p.gin(32) : p.gin(34)) + (size_t)e * 1024 * 1024 + (size_t)(kb * 64) * 1024 + nbk * 256;
#pragma unroll
        for (int i = 0; i < 8; ++i) cur[i] = *(const f32x4*)(src + (size_t)(lr + 8 * i) * 1024 + lc);
    }
    for (;;) {
        const int jn = j + stride; const bool has_next = jn < NBLK;
        f32x4 nxt[8];
        if (has_next) {
            const int mat = jn >> 6, e = mat / 3, which = mat - 3 * e, bb = jn & 63, kb = bb & 15, nbk = bb >> 4;
            const float* src = (which == 0 ? p.gin(30) : which == 1 ? p.gin(32) : p.gin(34)) + (size_t)e * 1024 * 1024 + (size_t)(kb * 64) * 1024 + nbk * 256;
#pragma unroll
            for (int i = 0; i < 8; ++i) nxt[i] = *(const f32x4*)(src + (size_t)(lr + 8 * i) * 1024 + lc);
        }
        const int mat = j >> 6, e = mat / 3, which = mat - 3 * e, bb = j & 63, kb = bb & 15, nbk = bb >> 4;
#pragma unroll
        for (int i = 0; i < 8; ++i) { LAS float* t = tile + (lr + 8 * i) * 257 + lc; t[0] = cur[i][0]; t[1] = cur[i][1]; t[2] = cur[i][2]; t[3] = cur[i][3]; }
        __syncthreads();
        {
            const int kq = tid & 7, k0 = kb * 64 + 8 * kq;
            float sc[8];
#pragma unroll
            for (int jj = 0; jj < 8; ++jj) sc[jj] = which < 2 ? g2[k0 + jj] : 1.0f;
#pragma unroll
            for (int i = 0; i < 4; ++i) {
                const int nn = (tid >> 3) + 64 * i, n = nbk * 256 + nn;
                float v[8];
#pragma unroll
                for (int jj = 0; jj < 8; ++jj) v[jj] = tile[(8 * kq + jj) * 257 + nn] * sc[jj];
                u32x4 w; w.x = cvt_pk_bf16(v[0], v[1]); w.y = cvt_pk_bf16(v[2], v[3]); w.z = cvt_pk_bf16(v[4], v[5]); w.w = cvt_pk_bf16(v[6], v[7]);
                bf16_t* dst = which < 2 ? WGU + (size_t)e * 2048 * 1024 + (size_t)(256 * (n >> 7) + 128 * which + (n & 127)) * 1024
                                        : WD + (size_t)e * 1024 * 1024 + (size_t)n * 1024;
                *(u32x4*)(dst + k0) = w;
            }
        }
        __syncthreads();
        if (!has_next) break;
        j = jn;
#pragma unroll
        for (int i = 0; i < 8; ++i) cur[i] = nxt[i];
    }
}

__device__ __forceinline__ void phase_router(const PPv& p, LAS unsigned char* lds) {
    const int tid = threadIdx.x, bid = blockIdx.x, nb = gridDim.x, lane = tid & 63, wave = tid >> 6;
    unsigned char* ws = p.gws();
    const float* h1 = p.gout();
    const float* WRG = (const float*)(ws + OFF_WRG);
    const float* brt = p.gin(29);
    LAS float* slog = (LAS float*)lds;
    LAS float* srs = slog + 8 * 16 * 32;
    LAS int* lcnt = (LAS int*)(srs + 128);
    LAS int* gbase = lcnt + 32;
    LAS int* ltopi = gbase + 32;
    LAS int* lrank = ltopi + 512;
    int* TOPI = (int*)(ws + OFF_TOPI); float* TOPW = (float*)(ws + OFF_TOPW); int* RANK = (int*)(ws + OFF_RANK); float* RSTD2 = (float*)(ws + OFF_RSTD2);
    int* GCNT = (int*)(ws + OFF_GCNT);
    for (int tb = bid; tb < T / 128; tb += nb) {
        if (tid < 32) lcnt[tid] = 0;
        __syncthreads();
        const int t0 = tb * 128 + wave * 16;
        {
            const int row = lane & 15, kq = lane >> 4;
            const float* ap = h1 + (size_t)(t0 + row) * D + 4 * kq;
            const float* bp = WRG + (size_t)(4 * kq) * 32 + row;
            f32x4 acc0 = (f32x4){0.f, 0.f, 0.f, 0.f}, acc1 = acc0;
            float ss = 0.f;
            for (int j = 0; j < 64; ++j) {
                const f32x4 av = *(const f32x4*)(ap + 16 * j);
                ss += av[0] * av[0] + av[1] * av[1] + av[2] * av[2] + av[3] * av[3];
                const float* bj = bp + (size_t)(16 * j) * 32;
#pragma unroll
                for (int s = 0; s < 4; ++s) {
                    const float b0 = bj[s * 32], b1 = bj[s * 32 + 16];
                    acc0 = __builtin_amdgcn_mfma_f32_16x16x4f32(av[s], b0, acc0, 0, 0, 0);
                    acc1 = __builtin_amdgcn_mfma_f32_16x16x4f32(av[s], b1, acc1, 0, 0, 0);
                }
            }
            ss += __shfl_xor(ss, 16); ss += __shfl_xor(ss, 32);
#pragma unroll
            for (int reg = 0; reg < 4; ++reg) {
                slog[(wave * 16 + 4 * kq + reg) * 32 + row] = acc0[reg];
                slog[(wave * 16 + 4 * kq + reg) * 32 + 16 + row] = acc1[reg];
            }
            if (lane < 16) srs[wave * 16 + lane] = rsqrtf(ss * (1.0f / D) + NORM_EPS);
        }
        __syncthreads();
        if (lane < 16) {
            const int tl = wave * 16 + lane, t = tb * 128 + tl;
            const float rs = srs[tl];
            float lg[32];
#pragma unroll
            for (int e = 0; e < 32; ++e) lg[e] = slog[tl * 32 + e] * rs + brt[e];
            int ti[4]; float tv[4];
#pragma unroll
            for (int k = 0; k < 4; ++k) {
                float best = -3.0e38f; int bi = 0;
#pragma unroll
                for (int e = 0; e < 32; ++e) { const bool tk = lg[e] > best; best = tk ? lg[e] : best; bi = tk ? e : bi; }
                ti[k] = bi; tv[k] = best;
#pragma unroll
                for (int e = 0; e < 32; ++e) lg[e] = (e == bi) ? -3.0e38f : lg[e];
            }
            const float e0 = 1.0f, e1 = __expf(tv[1] - tv[0]), e2 = __expf(tv[2] - tv[0]), e3 = __expf(tv[3] - tv[0]);
            const float inv = 1.0f / (e0 + e1 + e2 + e3);
            *(f32x4*)(TOPW + (size_t)t * 4) = (f32x4){e0 * inv, e1 * inv, e2 * inv, e3 * inv};
            RSTD2[t] = rs;
#pragma unroll
            for (int k = 0; k < 4; ++k) { ltopi[tl * 4 + k] = ti[k]; lrank[tl * 4 + k] = __hip_atomic_fetch_add(lcnt + ti[k], 1, __ATOMIC_RELAXED, __HIP_MEMORY_SCOPE_WORKGROUP); }
        }
        __syncthreads();
        if (tid < 32) gbase[tid] = atomicAdd(GCNT + tid, lcnt[tid]);
        __syncthreads();
        {
            const int e = ltopi[tid];
            TOPI[(size_t)tb * 512 + tid] = e;
            RANK[(size_t)tb * 512 + tid] = gbase[e] + lrank[tid];
        }
        __syncthreads();
    }
}

__device__ __forceinline__ void phase_lists(const PPv& p, LAS unsigned char* lds) {
    const int tid = threadIdx.x, bid = blockIdx.x, nb = gridDim.x;
    unsigned char* ws = p.gws();
    LAS int* pstart = (LAS int*)lds;
    LAS int* cnt = pstart + 64;
    const int* GCNT = (const int*)(ws + OFF_GCNT);
    if (tid < 32) cnt[tid] = GCNT[tid];
    __syncthreads();
    if (tid == 0) { int s = 0; for (int e = 0; e < 32; ++e) { pstart[e] = s; s += ((cnt[e] + 255) >> 8) << 8; } pstart[32] = s; }
    __syncthreads();
    const int* TOPI = (const int*)(ws + OFF_TOPI); const float* TOPW = (const float*)(ws + OFF_TOPW); const int* RANK = (const int*)(ws + OFF_RANK); const float* RSTD2 = (const float*)(ws + OFF_RSTD2);
    int* ROWTOK = (int*)(ws + OFF_ROWTOK); int* ROWSLOT = (int*)(ws + OFF_ROWSLOT); float* ROWW = (float*)(ws + OFF_ROWW); float* ROWRS = (float*)(ws + OFF_ROWRS);
    for (int i = bid * 512 + tid; i < T * 4; i += nb * 512) {
        const int e = TOPI[i], pos = pstart[e] + RANK[i], t = i >> 2;
        ROWTOK[pos] = t; ROWSLOT[pos] = i; ROWW[pos] = TOPW[i]; ROWRS[pos] = RSTD2[t];
    }
    for (int e = bid; e < 32; e += nb) {
        for (int pos = pstart[e] + cnt[e] + tid; pos < pstart[e + 1]; pos += 512) { ROWTOK[pos] = 0; ROWSLOT[pos] = -1; ROWW[pos] = 0.f; ROWRS[pos] = 0.f; }
    }
    if (bid == 0) {
        int* TILEE = (int*)(ws + OFF_TILEE);
        const int ntiles = pstart[32] >> 8;
        for (int mt = tid; mt < ntiles; mt += 512) { int e = 0; for (int q = 0; q < 32; ++q) if (pstart[q] <= mt * 256) e = q; TILEE[mt] = e; }
        if (tid == 0) TILEE[1000] = ntiles;
    }
    __syncthreads();
}

__device__ __forceinline__ void phase_final(const PPv& p) {
    const int tid = threadIdx.x, bid = blockIdx.x, nb = gridDim.x, lane = tid & 63, wave = tid >> 6;
    unsigned char* ws = p.gws();
    const bf16_t* HB2 = (const bf16_t*)(ws + OFF_HB2);
    const bf16_t* YA = (const bf16_t*)p.gout(); const bf16_t* YB = (const bf16_t*)(ws + OFF_WGU);
    const float* gf = p.gin(36);
    const f32x4 ga0 = *(const f32x4*)(gf + 8 * lane), ga1 = *(const f32x4*)(gf + 8 * lane + 4), gb0 = *(const f32x4*)(gf + 512 + 8 * lane), gb1 = *(const f32x4*)(gf + 512 + 8 * lane + 4);
    for (int t0 = (bid * 8 + wave) * 2; t0 < T; t0 += nb * 16) {
        u32x4 ha[2], hb[2], ya[2][4], yb[2][4];
#pragma unroll
        for (int u = 0; u < 2; ++u) {
            const int t = t0 + u;
            ha[u] = *(const u32x4*)(HB2 + (size_t)t * D + 8 * lane); hb[u] = *(const u32x4*)(HB2 + (size_t)t * D + 512 + 8 * lane);
#pragma unroll
            for (int k = 0; k < 4; ++k) { ya[u][k] = *(const u32x4*)(YA + (size_t)(4 * t + k) * 512 + 8 * lane); yb[u][k] = *(const u32x4*)(YB + (size_t)(4 * t + k) * 512 + 8 * lane); }
        }
#pragma unroll
        for (int u = 0; u < 2; ++u) {
            const int t = t0 + u;
            float va[8] = {bflo(ha[u].x), bfhi(ha[u].x), bflo(ha[u].y), bfhi(ha[u].y), bflo(ha[u].z), bfhi(ha[u].z), bflo(ha[u].w), bfhi(ha[u].w)};
            float vb[8] = {bflo(hb[u].x), bfhi(hb[u].x), bflo(hb[u].y), bfhi(hb[u].y), bflo(hb[u].z), bfhi(hb[u].z), bflo(hb[u].w), bfhi(hb[u].w)};
#pragma unroll
            for (int k = 0; k < 4; ++k) {
                const u32x4 a4 = ya[u][k], b4 = yb[u][k];
                va[0] += bflo(a4.x); va[1] += bfhi(a4.x); va[2] += bflo(a4.y); va[3] += bfhi(a4.y); va[4] += bflo(a4.z); va[5] += bfhi(a4.z); va[6] += bflo(a4.w); va[7] += bfhi(a4.w);
                vb[0] += bflo(b4.x); vb[1] += bfhi(b4.x); vb[2] += bflo(b4.y); vb[3] += bfhi(b4.y); vb[4] += bflo(b4.z); vb[5] += bfhi(b4.z); vb[6] += bflo(b4.w); vb[7] += bfhi(b4.w);
            }
            float ss = 0.f;
#pragma unroll
            for (int j = 0; j < 8; ++j) ss += va[j] * va[j] + vb[j] * vb[j];
            ss = wave_sum_dpp(ss);
            const float rs = rsqrtf(ss * (1.0f / D) + NORM_EPS);
            float* o = p.gout() + (size_t)t * D;
            *(f32x4*)(o + 8 * lane) = (f32x4){va[0] * rs * ga0[0], va[1] * rs * ga0[1], va[2] * rs * ga0[2], va[3] * rs * ga0[3]};
            *(f32x4*)(o + 8 * lane + 4) = (f32x4){va[4] * rs * ga1[0], va[5] * rs * ga1[1], va[6] * rs * ga1[2], va[7] * rs * ga1[3]};
            *(f32x4*)(o + 512 + 8 * lane) = (f32x4){vb[0] * rs * gb0[0], vb[1] * rs * gb0[1], vb[2] * rs * gb0[2], vb[3] * rs * gb0[3]};
            *(f32x4*)(o + 512 + 8 * lane + 4) = (f32x4){vb[4] * rs * gb1[0], vb[5] * rs * gb1[1], vb[6] * rs * gb1[2], vb[7] * rs * gb1[3]};
        }
    }
}

#define XB_TMO      128
#define XB_XCNT(j)  (256  + 64 * (j))
#define XB_XSUB(j)  (1280 + 64 * (j))
#define XB_XGEN(j)  (2304 + 64 * (j))
#define XB_TOP      3328
#define XB_TOPGEN   3392
#define XCD_BAR_WORDS 3456
#define XB_SPIN_CAP (1u << 18)
__device__ __forceinline__ unsigned xb_ld(unsigned* p)              { return __hip_atomic_load(p, __ATOMIC_RELAXED, __HIP_MEMORY_SCOPE_AGENT); }
__device__ __forceinline__ unsigned xb_add(unsigned* p, unsigned v) { return __hip_atomic_fetch_add(p, v, __ATOMIC_RELAXED, __HIP_MEMORY_SCOPE_AGENT); }
__device__ __forceinline__ unsigned xb_xcc_id() { return (unsigned)__builtin_amdgcn_s_getreg((3 << 11) | 20) & 0xFu; }
#define XB_SPIN(cond, bar) do { unsigned _sp = 0; while (cond) { __builtin_amdgcn_s_sleep(1); \
    if ((++_sp & 255u) == 0u) { if (xb_ld(&(bar)[XB_TMO])) break; if (_sp > XB_SPIN_CAP) { atomicAdd(&(bar)[XB_TMO], 1u); break; } } } } while (0)
struct XcdBarrier { unsigned* bar; unsigned x; volatile LAS unsigned* st; };
__device__ __forceinline__ XcdBarrier xcd_barrier_post(unsigned* bar, volatile LAS unsigned* st) {
    XcdBarrier b; b.bar = bar; b.x = xb_xcc_id(); b.st = st;
    if (threadIdx.x == 0) (void)xb_add(&bar[XB_XCNT(b.x)], 1u);
    return b;
}
__device__ __forceinline__ void xcd_barrier_complete(unsigned* bar, unsigned x, unsigned& nloc, unsigned& nx) {
    const unsigned G = gridDim.x * gridDim.y * gridDim.z;
    unsigned sum, cnt, mine, sp = 0u;
    for (;;) {
        sum = 0u; cnt = 0u; mine = 0u;
#pragma unroll
        for (unsigned j = 0; j < 16; ++j) { const unsigned c = xb_ld(&bar[XB_XCNT(j)]); sum += c; cnt += (c > 0u) ? 1u : 0u; mine = (j == x) ? c : mine; }
        if (sum == G) break;
        __builtin_amdgcn_s_sleep(1);
        if ((++sp & 255u) == 0u) { if (xb_ld(&bar[XB_TMO])) break; if (sp > XB_SPIN_CAP) { atomicAdd(&bar[XB_TMO], 1u); break; } }
    }
    nloc = mine > 0u ? mine : 1u; nx = cnt > 0u ? cnt : 1u;
}
__device__ __forceinline__ void xcd_barrier(const XcdBarrier& b) {
    asm volatile("s_waitcnt vmcnt(0)" ::: "memory");
    __syncthreads();
    if (threadIdx.x == 0) {
        unsigned* bar = b.bar;
        __builtin_amdgcn_s_waitcnt(0);
        unsigned nloc = b.st[0], nx = b.st[1];
        if (nloc == 0u) { xcd_barrier_complete(bar, b.x, nloc, nx); b.st[0] = nloc; b.st[1] = nx; }
        const unsigned old = xb_add(&bar[XB_XSUB(b.x)], 1u);
        const unsigned gen = old / nloc;
        if (old + 1u == (gen + 1u) * nloc) {
            __builtin_amdgcn_fence(__ATOMIC_RELEASE, "agent");
            asm volatile("s_waitcnt vmcnt(0)" ::: "memory");
            const unsigned og = xb_add(&bar[XB_TOP], 1u);
            const unsigned tg = og / nx;
            if (og + 1u == (tg + 1u) * nx) xb_add(&bar[XB_TOPGEN], 1u);
            else XB_SPIN(xb_ld(&bar[XB_TOPGEN]) == tg, bar);
            __builtin_amdgcn_fence(__ATOMIC_ACQUIRE, "agent");
            xb_add(&bar[XB_XGEN(b.x)], 1u);
            asm volatile("s_waitcnt vmcnt(0)" ::: "memory");
        } else {
            XB_SPIN(xb_ld(&bar[XB_XGEN(b.x)]) == gen, bar);
            __builtin_amdgcn_fence(__ATOMIC_ACQUIRE, "agent");
            asm volatile("s_waitcnt vmcnt(0)" ::: "memory");
        }
    }
    __syncthreads();
}

constexpr int N_PHASES = 15;
__global__ void __launch_bounds__(512, 2) mega(Params p) {
    extern __shared__ __attribute__((aligned(16))) unsigned char lds_raw[];
    LAS unsigned char* lds = (LAS unsigned char*)lds_raw;
    cg::grid_group grid = cg::this_grid();
    unsigned char* ws = getpp().gws();
    const int G = gridDim.x, bid = blockIdx.x;
#ifndef ONLY_PHASE
#define ONLY_PHASE -1
#endif
#define IN(k) ((ONLY_PHASE < 0 || ONLY_PHASE == (k)) && p.ph_lo <= (k) && (k) < p.ph_hi)
    volatile LAS unsigned* xst = (volatile LAS unsigned*)(lds + 163840 - 16);
    if (threadIdx.x < 4) xst[threadIdx.x] = 0u;
    __syncthreads();
    const XcdBarrier xbar = xcd_barrier_post((unsigned*)(ws + OFF_BAR), xst);
    if (p.ph_hi < 0) grid.sync();
#define SEAM(k) do { if ((k) + 1 < p.ph_hi) xcd_barrier(xbar); } while (0)
    if (IN(0)) { const PPv q = getpp(); phase_prep(q, lds); SEAM(0); }
    if (IN(1)) { const PPv q = getpp();
        phase_meta_proj(q, lds);
        StaticOrder S; S.init(ws + OFF_HB, ws + OFF_WIN, T, NCOLS1, 1024, G, bid);
        EpiProj E{(bf16_t*)(ws + OFF_PRKV), (bf16_t*)(ws + OFF_PCONV), (bf16_t*)q.gout(), (const float*)(ws + OFF_RSTD1)};
        gemm_phase<false>(lds, 1024, S, E);
        SEAM(1);
    }
    if (IN(2)) { const PPv q = getpp(); phase_lprep_conv(q); SEAM(2); }
    if (IN(3)) { const PPv q = getpp();
        StaticOrder S; S.init(ws + OFF_L, ws + OFF_W2, NRP, 1536, 256, G, bid);
        EpiL E{(float*)(ws + OFF_LD), (bf16_t*)(ws + OFF_A), (bf16_t*)(ws + OFF_G), q.gin(10), q.gin(13)};
        gemm_phase<false>(lds, 256, S, E);
        SEAM(3);
    }
    if (IN(4)) { const PPv q = getpp(); phase_scanprep(q, lds); SEAM(4); }
    if (IN(5)) { const PPv q = getpp(); phase_recur(q, lds); SEAM(5); }
    if (IN(6)) { const PPv q = getpp(); phase_gn(q); SEAM(6); }
    if (IN(7)) { const PPv q = getpp();
        MergeOrder S; S.so.init(ws + OFF_Z, ws + OFF_WR, T, 1024, 512, G, bid); S.A1 = (const char*)(ws + OFF_C); S.B1 = (const char*)(ws + OFF_WC);
        EpiMergeFused E{(bf16_t*)(ws + OFF_MERGED), (const bf16_t*)q.gout()};
        gemm_phase<false>(lds, 512, S, E);
        SEAM(7);
    }
    if (IN(9)) { const PPv q = getpp();
        StaticOrder S; S.init(ws + OFF_MERGED, ws + OFF_WO, T, 1024, 1024, G, bid);
        EpiO E{q.gin(0), q.gout(), (bf16_t*)(ws + OFF_HB2)};
        gemm_phase<false>(lds, 1024, S, E);
        SEAM(9);
    }
    if (IN(10)) { const PPv q = getpp(); phase_router(q, lds); SEAM(10); }
    if (IN(11)) { const PPv q = getpp(); phase_lists(q, lds); SEAM(11); }
    if (IN(12)) { const PPv q = getpp();
        const int* TILEE = (const int*)(ws + OFF_TILEE);
        MoeOrder S; S.A = (const char*)(ws + OFF_HB2); S.Bt = (const char*)(ws + OFF_WGU); S.K = 1024; S.estride = (size_t)2048 * 1024 * 2;
        S.tile_e = TILEE; S.rowtok = (const int*)(ws + OFF_ROWTOK); S.ntiles = TILEE[1000]; S.nnt = 8; S.G = G; S.c = bid; S.gather = true;
        EpiMoe1 E{(bf16_t*)(ws + OFF_ACT), (const float*)(ws + OFF_ROWRS), q.gin(31), q.gin(33)};
        gemm_phase<true>(lds, 1024, S, E);
        SEAM(12);
    }
    if (IN(13)) { const PPv q = getpp();
        const int* TILEE = (const int*)(ws + OFF_TILEE);
        MoeOrder S; S.A = (const char*)(ws + OFF_ACT); S.Bt = (const char*)(ws + OFF_WD); S.K = 1024; S.estride = (size_t)1024 * 1024 * 2;
        S.tile_e = TILEE; S.rowtok = nullptr; S.ntiles = TILEE[1000]; S.nnt = 4; S.G = G; S.c = bid; S.gather = false;
        EpiMoe2 E{(bf16_t*)q.gout(), (bf16_t*)(ws + OFF_WGU), (const int*)(ws + OFF_ROWSLOT), (const float*)(ws + OFF_ROWW), q.gin(35)};
        gemm_phase<false>(lds, 1024, S, E);
        SEAM(13);
    }
    if (IN(14)) { const PPv q = getpp(); phase_final(q); }
}

extern "C" void kernel_launch(void* const* d_in, const int* in_sizes, int n_in, void* d_out, int out_size, void* d_ws, size_t ws_size,
                              hipStream_t stream) {
    constexpr size_t kDynLds = 160 * 1024;
    static int grid_blocks = 0;
    if (!grid_blocks) {
        int dev = 0, cus = 0, per_cu = 0;
        (void)hipGetDevice(&dev);
        (void)hipDeviceGetAttribute(&cus, hipDeviceAttributeMultiprocessorCount, dev);
        (void)hipFuncSetAttribute((const void*)mega, hipFuncAttributeMaxDynamicSharedMemorySize, (int)kDynLds);
        (void)hipOccupancyMaxActiveBlocksPerMultiprocessor(&per_cu, mega, 512, kDynLds);
        if (per_cu > 1) per_cu = 1;
        grid_blocks = cus * per_cu;
        fprintf(stderr, "cus=%d per_cu=%d ws_size=%zu need=%zu\n", cus, per_cu, ws_size, (size_t)WS_NEED);
    }
    if (ws_size < WS_NEED || n_in < 37 || grid_blocks < 64) { fprintf(stderr, "kernel_launch: unsupported configuration\n"); return; }
    Params p{};
    for (int i = 0; i < 37; ++i) p.in[i] = (const float*)d_in[i];
    p.out = (float*)d_out;
    p.ws = (unsigned char*)d_ws;
    p.ph_lo = 0; p.ph_hi = N_PHASES;
    (void)hipMemsetAsync((unsigned char*)d_ws + OFF_BAR, 0, 16384, stream);
    void* args[] = {&p};
    hipError_t e = hipLaunchCooperativeKernel((void*)mega, dim3(grid_blocks), dim3(512), args, kDynLds, stream);
    if (e != hipSuccess) fprintf(stderr, "cooperative launch failed: %s (grid %d)\n", hipGetErrorString(e), grid_blocks);
}
```

```cpp
#include <hip/hip_runtime.h>
#include <hip/hip_cooperative_groups.h>
#include <cstdio>
namespace cg = cooperative_groups;

#define LAS __attribute__((address_space(3)))
typedef unsigned short bf16_t;
typedef short bf16x8 __attribute__((ext_vector_type(8)));
typedef float f32x4 __attribute__((ext_vector_type(4)));
typedef float f32x2 __attribute__((ext_vector_type(2)));
typedef unsigned u32x4 __attribute__((ext_vector_type(4)));
typedef unsigned u32x2 __attribute__((ext_vector_type(2)));

constexpr int D = 1024, NBATCH = 8, SEQ = 4096, NMETA = 16;
constexpr int T = NBATCH * SEQ;
constexpr int NR = T + NMETA;
constexpr int NRP = 33024;
constexpr int PCOLS1 = 3584;
constexpr int NCOLS1 = 5632;
constexpr int NE = 32, TOPK = 4, DFF = 1024;
constexpr int MAXROWS = T * TOPK + NE * 256;
constexpr int MAXTILES = MAXROWS / 256;
constexpr float NORM_EPS = 1e-5f, LNX_EPS = 64e-5f;

constexpr int NCHUNK = 257, NUNITS = 64 * NCHUNK;
constexpr int REC_BYTES = 13568;
constexpr int RO_WH = 0, RO_RT = 2048, RO_U0T = 4096, RO_VT = 6144, RO_BKT = 8192, RO_ARK = 12288, RO_WCC = 13312;
constexpr int SLOT_BYTES = 15680, SO_G = 13568, SO_COEF = 15616, NSLOT = 9;
constexpr size_t SZ_ACT = (size_t)MAXROWS * 1024 * 2;
constexpr size_t SZ_WGU = (size_t)NE * 2048 * 1024 * 2;
constexpr size_t SZ_WD = (size_t)NE * 1024 * 1024 * 2;
constexpr size_t SZ_HB = (size_t)T * 1024 * 2;
constexpr size_t OFF_WGU = 0;
constexpr size_t OFF_WD = OFF_WGU + SZ_WGU;
constexpr size_t OFF_ACT = OFF_WD + SZ_WD;
constexpr size_t OFF_HB2 = OFF_ACT + SZ_ACT;
constexpr size_t OFF_RT = OFF_HB2 + SZ_HB;
constexpr size_t OFF_TOPI = OFF_RT;
constexpr size_t OFF_TOPW = OFF_TOPI + (size_t)T * 16;
constexpr size_t OFF_RANK = OFF_TOPW + (size_t)T * 16;
constexpr size_t OFF_RSTD2 = OFF_RANK + (size_t)T * 16;
constexpr size_t OFF_ROWTOK = OFF_RSTD2 + (size_t)T * 4;
constexpr size_t OFF_ROWSLOT = OFF_ROWTOK + (size_t)MAXROWS * 4;
constexpr size_t OFF_ROWW = OFF_ROWSLOT + (size_t)MAXROWS * 4;
constexpr size_t OFF_ROWRS = OFF_ROWW + (size_t)MAXROWS * 4;
constexpr size_t OFF_TILEE = OFF_ROWRS + (size_t)MAXROWS * 4;
constexpr size_t OFF_GCNT = OFF_TILEE + 4096;
constexpr size_t OFF_SM = OFF_GCNT + 256;
constexpr size_t OFF_WR = OFF_SM;
constexpr size_t OFF_WC = OFF_WR + (size_t)1024 * 512 * 2;
constexpr size_t OFF_WO = OFF_WC + (size_t)1024 * 512 * 2;
constexpr size_t OFF_W2 = OFF_WO + (size_t)1024 * 1024 * 2;
constexpr size_t OFF_RSTD1 = OFF_W2 + (size_t)1536 * 256 * 2;
constexpr size_t OFF_WRG = OFF_RSTD1 + (size_t)NRP * 4;
constexpr size_t OFF_BAR = OFF_WRG + (size_t)1024 * 32 * 4;
constexpr size_t WS_NEED = OFF_BAR + 16384;
constexpr size_t OFF_PRKV = 0;
constexpr size_t SZ_PRKV = (size_t)NR * 1536 * 2;
constexpr size_t OFF_LD = OFF_PRKV + SZ_PRKV;
constexpr size_t OFF_A = OFF_LD + (size_t)NRP * 512 * 4;
constexpr size_t OFF_CH = OFF_A + (size_t)NRP * 512 * 2;
constexpr size_t OFF_PCONV = OFF_CH;
constexpr size_t SZ_PCONV = (size_t)NR * 2048 * 2;
constexpr size_t OFF_HB = OFF_PCONV + SZ_PCONV;
constexpr size_t OFF_L = OFF_HB + SZ_HB;
constexpr size_t OFF_WIN = OFF_L + (size_t)NRP * 256 * 2;
constexpr size_t CH_END = OFF_WIN + (size_t)NCOLS1 * 1024 * 2;
constexpr size_t OFF_MERGED = OFF_CH;
constexpr size_t OFF_G = CH_END;
constexpr size_t OFF_C = OFF_G + (size_t)NRP * 512 * 2;
constexpr size_t OFF_Z = OFF_C + (size_t)T * 512 * 2;
constexpr size_t OFF_COEF = OFF_Z + (size_t)T * 512 * 2;
constexpr size_t EARLY_END = OFF_COEF + (size_t)NR * 8 * 4;
static_assert(EARLY_END <= OFF_RT, "early buffers overflow");
static_assert(OFF_CH + (size_t)NUNITS * REC_BYTES <= CH_END, "chunk records overflow");
static_assert(OFF_CH >= OFF_WD + SZ_WD, "expert weights (written during the scan) must not touch live scan buffers");
static_assert(OFF_MERGED + SZ_HB <= OFF_HB2, "layout");
static_assert(OFF_PRKV % 16 == 0 && OFF_LD % 16 == 0 && OFF_A % 16 == 0 && OFF_CH % 16 == 0 && OFF_HB % 16 == 0 && OFF_L % 16 == 0 && OFF_WIN % 16 == 0 && OFF_G % 16 == 0 && OFF_C % 16 == 0 && OFF_Z % 16 == 0 && OFF_COEF % 16 == 0, "align");

#define GAS __attribute__((address_space(1)))
#define CAS __attribute__((address_space(4)))
struct Params {
    const float* in[37];
    float* out;
    unsigned char* ws;
    int ph_lo, ph_hi;
};
struct ParamsD {
    const GAS float* in[37];
    GAS float* out;
    GAS unsigned char* ws;
    int ph_lo, ph_hi;
};
static_assert(sizeof(Params) == sizeof(ParamsD), "argument views");
struct PPv {
    const CAS ParamsD* k;
    __device__ __forceinline__ const float* gin(int i) const { return (const float*)k->in[i]; }
    __device__ __forceinline__ float* gout() const { return (float*)k->out; }
    __device__ __forceinline__ unsigned char* gws() const { return (unsigned char*)k->ws; }
};
__device__ __forceinline__ PPv getpp() { const CAS ParamsD* k = (const CAS ParamsD*)__builtin_amdgcn_kernarg_segment_ptr(); asm volatile("" : "+s"(k)); return PPv{k}; }

typedef __bf16 bf16x2v __attribute__((ext_vector_type(2)));
__device__ __forceinline__ unsigned cvt_pk_bf16(float lo, float hi) { const f32x2 v = {lo, hi}; return __builtin_bit_cast(unsigned, __builtin_convertvector(v, bf16x2v)); }
__device__ __forceinline__ bf16_t f2bf(float f) { unsigned u = __float_as_uint(f); u += 0x7FFFu + ((u >> 16) & 1u); return (bf16_t)(u >> 16); }
__device__ __forceinline__ float bf2f(bf16_t b) { return __uint_as_float(((unsigned)b) << 16); }
__device__ __forceinline__ float bflo(unsigned w) { return __uint_as_float(w << 16); }
__device__ __forceinline__ float bfhi(unsigned w) { return __uint_as_float(w & 0xFFFF0000u); }
__device__ __forceinline__ float sigmoidf_(float x) { return __builtin_amdgcn_rcpf(1.0f + __expf(-x)); }
__device__ __forceinline__ float wave_sum(float v) {
#pragma unroll
    for (int o = 32; o >= 1; o >>= 1) v += __shfl_xor(v, o);
    return v;
}
__device__ __forceinline__ float wave_sum_dpp(float v);
__device__ __forceinline__ int prev_row(int row, int d) {
    if (row < NMETA) return row - d >= 0 ? row - d : -1;
    const int s = (row - NMETA) & (SEQ - 1);
    return s >= d ? row - d : NMETA + s - d;
}

constexpr int BM = 256, BK = 64, HALF = 128, HTB = HALF * BK * 2, STAGE_BYTES = 8 * HTB, NXCD = 8, WGM = 8;
__device__ __forceinline__ int lds_byte(int r, int c) { const int st = (r >> 4) * 2 + (c >> 5), rr = r & 15, cc = c & 31, ob = rr * 64 + cc * 2; return st * 1024 + (ob ^ (((ob >> 9) & 1) << 5)); }
__device__ __forceinline__ void stage_rc(int b, int& R, int& C) { const int st = b / 1024, sb = b % 1024, swz = sb ^ (((sb >> 9) & 1) << 5); R = (st >> 1) * 16 + swz / 64; C = (st & 1) * 32 + (swz % 64) / 2; }
__device__ __forceinline__ int perm32(int rho) { const int n = rho >> 4, i = rho & 15; return 8 * (i >> 2) + 4 * n + (i & 3); }

struct Unit { int pm, pn, aux; };

struct StaticOrder {
    const char* A; const char* Bt; int K;
    int nM, nN, nwg, G, c;
    __device__ void init(const void* A_, const void* Bt_, int M, int N, int K_, int G_, int c_) { A = (const char*)A_; Bt = (const char*)Bt_; K = K_; nM = M / BM; nN = N / BM; nwg = nM * nN; G = G_; c = c_; }
    __device__ bool next(int i, Unit& u) const {
        const long L = (long)i * G + c; if (L >= nwg) return false;
        int wgid = (int)L; { const int q = nwg / NXCD, r = nwg % NXCD, xcd = wgid % NXCD, off = wgid / NXCD; wgid = (xcd < r ? xcd * (q + 1) : r * (q + 1) + (xcd - r) * q) + off; }
        const int nig = WGM * nN, gid = wgid / nig, fm = gid * WGM, gsz = (nM - fm) < WGM ? (nM - fm) : WGM;
        u.pm = fm + ((wgid % nig) % gsz); u.pn = (wgid % nig) / gsz; u.aux = 0; return true;
    }
    __device__ __forceinline__ const char* a_ptr(const Unit& u) const { return A + (size_t)u.pm * 256 * K * 2; }
    __device__ __forceinline__ const char* b_ptr(const Unit& u) const { return Bt + (size_t)u.pn * 256 * K * 2; }
    __device__ __forceinline__ int gather_row(const Unit&, int) const { return 0; }
    __device__ __forceinline__ const void* gather_src(const Unit&, int) const { return nullptr; }
};
struct MoeOrder {
    const char* A; const char* Bt; int K; size_t estride;
    const int* tile_e; const int* rowtok; int ntiles, nnt, G, c; bool gather;
    __device__ bool next(int i, Unit& u) const {
        int mt, nt;
        if ((G & 7) == 0 && ((G >> 3) % nnt) == 0) {
            const int x = c & 7, j = c >> 3, per = (G >> 3) / nnt;
            mt = (i * 8 + x) * per + j / nnt; nt = j % nnt;
        } else { const long L = (long)i * G + c; mt = (int)(L / nnt); nt = (int)(L % nnt); }
        if (mt >= ntiles) return false;
        u.pm = mt; u.pn = nt; u.aux = tile_e[mt]; return true;
    }
    __device__ __forceinline__ const char* a_ptr(const Unit& u) const { return gather ? A : A + (size_t)u.pm * 256 * K * 2; }
    __device__ __forceinline__ const char* b_ptr(const Unit& u) const { return Bt + (size_t)u.aux * estride + (size_t)u.pn * 256 * K * 2; }
    __device__ __forceinline__ int gather_row(const Unit& u, int r) const { return rowtok[u.pm * 256 + r]; }
    __device__ __forceinline__ const void* gather_src(const Unit& u, int lane) const { return rowtok + u.pm * 256 + lane * 4; }
};

template <bool GATHER, class Epi, class Sched>
__device__ __forceinline__ void gemm_phase(LAS unsigned char* lds, const int K_, const Sched& S, const Epi& E) {
    int K = K_; asm volatile("" : "+s"(K));
    const int tid = threadIdx.x, wid = __builtin_amdgcn_readfirstlane(tid >> 6), lane = tid & 63, wr = wid >> 2, wc = wid & 3, fr = lane & 15, fq = lane >> 4;
    const int nt = K / BK;
    unsigned voffA[2], voffB[2]; int Rr[2], Cc[2];
#pragma unroll
    for (int i = 0; i < 2; ++i) { int R, C; stage_rc(tid * 16 + i * 8192, R, C); const int Rb = (R & ~31) + perm32(R & 31);
        Rr[i] = R; Cc[i] = C; voffA[i] = (unsigned)(R * K + C) * 2u; voffB[i] = (unsigned)(Rb * K + C) * 2u; }
    const size_t kstep = (size_t)(BK * 2);
    const size_t hstep = (size_t)HALF * K * 2;
    const unsigned ldsw = (unsigned)wid * 1024u;
    const int aoff = lds_byte(wr * 64 + fr, fq * 8), boff = lds_byte(wc * 32 + fr, fq * 8);
    unsigned vgc[2][2], vgn[2][2];
    LAS unsigned char* const parbase = lds + STAGE_BYTES;
    constexpr int NPAR = Epi::NPAR;
#define G_PAR_ISSUE(unit, uidx, hasnx, nxunit) do { \
        LAS unsigned char* _ps = parbase + ((uidx) & 1) * 4096; \
        if (wid < NPAR) __builtin_amdgcn_global_load_lds((const unsigned*)E.par_src(unit, wid, lane), (LAS unsigned*)(_ps + wid * 1024), 16, 0, 0); \
        if (GATHER && (hasnx) && wid == NPAR) __builtin_amdgcn_global_load_lds((const unsigned*)S.gather_src(nxunit, lane), (LAS unsigned*)(_ps + NPAR * 1024), 16, 0, 0); } while (0)
#define G_SA(b, h) (((b) * 2 + (h)) * HTB)
#define G_SB(b, h) ((4 + (b) * 2 + (h)) * HTB)
#define G_STAGE(bufoff, gbase, voff) do { _Pragma("unroll") for (int _i = 0; _i < 2; ++_i) \
        __builtin_amdgcn_global_load_lds((const unsigned*)((const char*)(gbase) + (voff)[_i]), (LAS unsigned*)(lds + (bufoff) + ldsw + _i * 8192), 16, 0, 0); } while (0)
#define G_STAGE_A(bufoff, kptr, h, VG) do { if (GATHER) { G_STAGE(bufoff, kptr, VG[h]); } else { G_STAGE(bufoff, (kptr) + (h) * hstep, voffA); } } while (0)
#define G_LDA(dst, b, h) do { _Pragma("unroll") for (int m = 0; m < 4; ++m) _Pragma("unroll") for (int k = 0; k < 2; ++k) dst[m][k] = *(const LAS bf16x8*)(lds + G_SA(b, h) + aoff + m * 2048 + k * 1024); } while (0)
#define G_LDB(dst, b, h) do { _Pragma("unroll") for (int n = 0; n < 2; ++n) _Pragma("unroll") for (int k = 0; k < 2; ++k) dst[n][k] = *(const LAS bf16x8*)(lds + G_SB(b, h) + boff + n * 2048 + k * 1024); } while (0)
#define G_MMA(ai, bj, At, Bt) do { __builtin_amdgcn_s_setprio(1); _Pragma("unroll") for (int m = 0; m < 4; ++m) _Pragma("unroll") for (int n = 0; n < 2; ++n) _Pragma("unroll") for (int k = 0; k < 2; ++k) \
        acc[ai][bj][m][n] = __builtin_amdgcn_mfma_f32_16x16x32_bf16(Bt[n][k], At[m][k], acc[ai][bj][m][n], 0, 0, 0); __builtin_amdgcn_s_setprio(0); } while (0)
#define G_WAIT_V(n) asm volatile("s_waitcnt vmcnt(" #n ")" ::: "memory")
#define G_WAIT_L(n) asm volatile("s_waitcnt lgkmcnt(" #n ")" ::: "memory")
#define G_BAR __builtin_amdgcn_s_barrier()
#define G_SCHED __builtin_amdgcn_sched_barrier(0)
    Unit cur, nxt;
    int ui = 0;
    if (!S.next(0, cur)) return;
    f32x4 acc[2][2][4][2];
#pragma unroll
    for (int a = 0; a < 2; ++a)
#pragma unroll
        for (int b = 0; b < 2; ++b)
#pragma unroll
            for (int m = 0; m < 4; ++m)
#pragma unroll
                for (int n = 0; n < 2; ++n) acc[a][b][m][n] = (f32x4){0.f, 0.f, 0.f, 0.f};
    bf16x8 At[4][2], B0[2][2], B1[2][2];
    const char* cA = S.a_ptr(cur); const char* cB = S.b_ptr(cur);
    if (GATHER) {
#pragma unroll
        for (int h = 0; h < 2; ++h)
#pragma unroll
            for (int i = 0; i < 2; ++i) vgc[h][i] = (unsigned)(S.gather_row(cur, h * HALF + Rr[i]) * K + Cc[i]) * 2u;
    }
    { Unit n1; const bool hn1 = S.next(1, n1); G_PAR_ISSUE(cur, 0, hn1, n1); }
    G_STAGE(G_SB(0, 0), cB, voffB); G_STAGE_A(G_SA(0, 0), cA, 0, vgc); G_STAGE(G_SB(0, 1), cB + hstep, voffB); G_STAGE_A(G_SA(0, 1), cA, 1, vgc);
    if (wr == 1) G_BAR;
    G_WAIT_V(4); G_BAR;
    G_STAGE(G_SB(1, 0), cB + kstep, voffB); G_STAGE_A(G_SA(1, 0), cA + kstep, 0, vgc); G_STAGE(G_SB(1, 1), cB + hstep + kstep, voffB);
    G_WAIT_V(6); G_BAR;
    for (;;) {
        const bool has_next = S.next(ui + 1, nxt);
        const char* nA = has_next ? S.a_ptr(nxt) : cA; const char* nB = has_next ? S.b_ptr(nxt) : cB;
        if (ui > 0) G_PAR_ISSUE(cur, ui, has_next, nxt);
        if (GATHER) {
#pragma unroll
            for (int h = 0; h < 2; ++h)
#pragma unroll
                for (int i = 0; i < 2; ++i) vgn[h][i] = vgc[h][i];
        }
        for (int t = 0; t < nt; t += 2) {
            const bool last = (t == nt - 2);
            const char* a1 = cA + (size_t)(t + 1) * kstep;
            const char* a2 = last ? nA : cA + (size_t)(t + 2) * kstep; const char* b2 = last ? nB : cB + (size_t)(t + 2) * kstep;
            const char* a3 = a2 + kstep; const char* b3 = b2 + kstep;
            unsigned vg2[2][2];
            if (GATHER) {
#pragma unroll
                for (int h = 0; h < 2; ++h)
#pragma unroll
                    for (int i = 0; i < 2; ++i) vg2[h][i] = last ? vgn[h][i] : vgc[h][i];
            }
            G_LDB(B0, 0, 0); G_SCHED; G_LDA(At, 0, 0); G_STAGE_A(G_SA(1, 1), a1, 1, vgc);
            G_WAIT_L(8); G_BAR; G_WAIT_L(0); G_MMA(0, 0, At, B0); G_BAR; G_SCHED;
            G_LDB(B1, 0, 1); G_STAGE(G_SB(0, 0), b2, voffB);
            G_BAR; G_WAIT_L(0); G_MMA(0, 1, At, B1); G_BAR;
            G_LDA(At, 0, 1); G_STAGE_A(G_SA(0, 0), a2, 0, vg2);
            G_BAR; G_WAIT_L(0); G_MMA(1, 0, At, B0); G_BAR; G_SCHED;
            G_STAGE(G_SB(0, 1), b2 + hstep, voffB);
            G_WAIT_V(6); G_BAR; G_MMA(1, 1, At, B1); G_BAR;
            G_LDB(B0, 1, 0); G_SCHED; G_LDA(At, 1, 0); G_STAGE_A(G_SA(0, 1), a2, 1, vg2);
            G_WAIT_L(8); G_BAR; G_WAIT_L(0); G_MMA(0, 0, At, B0); G_BAR; G_SCHED;
            G_LDB(B1, 1, 1); G_STAGE(G_SB(1, 0), b3, voffB);
            G_BAR; G_WAIT_L(0); G_MMA(0, 1, At, B1); G_BAR;
            G_LDA(At, 1, 1); G_STAGE_A(G_SA(1, 0), a3, 0, vg2);
            G_BAR; G_WAIT_L(0); G_MMA(1, 0, At, B0); G_BAR; G_SCHED;
            G_STAGE(G_SB(1, 1), b3 + hstep, voffB);
            G_WAIT_V(6); G_BAR; G_MMA(1, 1, At, B1); G_BAR;
            if (GATHER && t == 0 && has_next) {
                const LAS int* rows = (const LAS int*)(parbase + (ui & 1) * 4096 + NPAR * 1024);
#pragma unroll
                for (int h = 0; h < 2; ++h)
#pragma unroll
                    for (int i = 0; i < 2; ++i) vgn[h][i] = (unsigned)(rows[h * HALF + Rr[i]] * K + Cc[i]) * 2u;
            }
        }
        const bool keep_acc = E(acc, cur, wr, wc, fr, fq, (const LAS unsigned char*)(parbase + (ui & 1) * 4096));
        if (!has_next) break;
        if (!keep_acc)
#pragma unroll
        for (int a = 0; a < 2; ++a)
#pragma unroll
            for (int b = 0; b < 2; ++b)
#pragma unroll
                for (int m = 0; m < 4; ++m)
#pragma unroll
                    for (int n = 0; n < 2; ++n) acc[a][b][m][n] = (f32x4){0.f, 0.f, 0.f, 0.f};
        cur = nxt; cA = nA; cB = nB; ++ui;
        if (GATHER) {
#pragma unroll
            for (int h = 0; h < 2; ++h)
#pragma unroll
                for (int i = 0; i < 2; ++i) vgc[h][i] = vgn[h][i];
        }
    }
    G_WAIT_V(0);
    if (wr == 0) G_BAR;
    G_BAR;
#undef G_PAR_ISSUE
#undef G_SA
#undef G_SB
#undef G_STAGE
#undef G_STAGE_A
#undef G_LDA
#undef G_LDB
#undef G_MMA
#undef G_WAIT_V
#undef G_WAIT_L
#undef G_BAR
#undef G_SCHED
}

struct EpiProj {
    bf16_t* prkv; bf16_t* pconv; bf16_t* gates; const float* rstd1;
    static constexpr int NPAR = 1;
    __device__ __forceinline__ const void* par_src(const Unit& u, int, int lane) const { return rstd1 + NMETA + u.pm * BM + lane * 4; }
    __device__ __forceinline__ bool operator()(const f32x4 (&acc)[2][2][4][2], const Unit& u, int wr, int wc, int fr, int fq, const LAS unsigned char* par) const {
        const int row0 = u.pm * BM + wr * 64 + fr;
        const bool isg = u.pn >= 14;
        float rsv[2][4];
#pragma unroll
        for (int ai = 0; ai < 2; ++ai)
#pragma unroll
            for (int m = 0; m < 4; ++m) rsv[ai][m] = ((const LAS float*)par)[wr * 64 + fr + ai * HALF + m * 16];
#pragma unroll
        for (int ai = 0; ai < 2; ++ai)
#pragma unroll
            for (int m = 0; m < 4; ++m) {
                const int row = row0 + ai * HALF + m * 16;
                const float rs = rsv[ai][m];
                bf16_t* rowp = isg ? gates + (size_t)row * 2048 + (u.pn - 14) * 256 + wc * 32 + 8 * fq
                             : (u.pn < 6 ? prkv + (size_t)(NMETA + row) * 1536 + u.pn * 256 : pconv + (size_t)(NMETA + row) * 2048 + (u.pn - 6) * 256) + wc * 32 + 8 * fq;
#pragma unroll
                for (int bj = 0; bj < 2; ++bj) {
                    f32x4 v0 = acc[ai][bj][m][0] * rs, v1 = acc[ai][bj][m][1] * rs;
                    if (isg) {
#pragma unroll
                        for (int j = 0; j < 4; ++j) { v0[j] = sigmoidf_(v0[j]); v1[j] = sigmoidf_(v1[j]); }
                    }
                    u32x4 w; w.x = cvt_pk_bf16(v0[0], v0[1]); w.y = cvt_pk_bf16(v0[2], v0[3]); w.z = cvt_pk_bf16(v1[0], v1[1]); w.w = cvt_pk_bf16(v1[2], v1[3]);
                    *(u32x4*)(rowp + bj * HALF) = w;
                }
            }
        return false;
    }
};
struct EpiL {
    static constexpr int NPAR = 0;
    __device__ __forceinline__ const void* par_src(const Unit&, int, int) const { return nullptr; }
    unsigned char* wsb; const float* w0; const float* a0;
    __device__ __forceinline__ bool operator()(const f32x4 (&acc)[2][2][4][2], const Unit& u, int wr, int wc, int fr, int fq, const LAS unsigned char* par) const {
        const int row0 = u.pm * BM + wr * 64 + fr;
        const int seg = u.pn >> 1;
        const int cb = (u.pn & 1) * 256 + wc * 32 + 8 * fq;
        const float* bias = seg == 0 ? w0 : a0;
        f32x4 bv[2][2];
#pragma unroll
        for (int bj = 0; bj < 2; ++bj) {
            bv[bj][0] = seg < 2 ? *(const f32x4*)(bias + cb + bj * HALF) : (f32x4){0.f, 0.f, 0.f, 0.f};
            bv[bj][1] = seg < 2 ? *(const f32x4*)(bias + cb + bj * HALF + 4) : (f32x4){0.f, 0.f, 0.f, 0.f};
        }
        const float sc = seg == 0 ? -0.60653065971f : 1.0f;
        bf16_t* ob = (bf16_t*)(wsb + (seg == 0 ? OFF_LD : seg == 1 ? OFF_A : OFF_G));
#pragma unroll
        for (int ai = 0; ai < 2; ++ai)
#pragma unroll
            for (int m = 0; m < 4; ++m) {
                const int row = row0 + ai * HALF + m * 16;
#pragma unroll
                for (int bj = 0; bj < 2; ++bj) {
                    const int c = cb + bj * HALF;
                    f32x4 v0 = acc[ai][bj][m][0] + bv[bj][0], v1 = acc[ai][bj][m][1] + bv[bj][1];
                    if (seg < 2) {
#pragma unroll
                        for (int j = 0; j < 4; ++j) { v0[j] = sc * sigmoidf_(v0[j]); v1[j] = sc * sigmoidf_(v1[j]); }
                    }
                    {
                        u32x4 w; w.x = cvt_pk_bf16(v0[0], v0[1]); w.y = cvt_pk_bf16(v0[2], v0[3]); w.z = cvt_pk_bf16(v1[0], v1[1]); w.w = cvt_pk_bf16(v1[2], v1[3]);
                        *(u32x4*)(ob + (size_t)row * 512 + c) = w;
                    }
                }
            }
        return false;
    }
};
template <int SECOND> struct EpiMerge {
    static constexpr int NPAR = 0;
    __device__ __forceinline__ const void* par_src(const Unit&, int, int) const { return nullptr; }
    bf16_t* merged; const bf16_t* gates;
    __device__ __forceinline__ bool operator()(const f32x4 (&acc)[2][2][4][2], const Unit& u, int wr, int wc, int fr, int fq, const LAS unsigned char* par) const {
        const int row0 = u.pm * BM + wr * 64 + fr, col0 = u.pn * BM + wc * 32 + 8 * fq;
#pragma unroll
        for (int ai = 0; ai < 2; ++ai)
#pragma unroll
            for (int m = 0; m < 4; ++m) {
                const int row = row0 + ai * HALF + m * 16;
#pragma unroll
                for (int bj = 0; bj < 2; ++bj) {
                    const int c = col0 + bj * HALF;
                    const u32x4 gw = *(const u32x4*)(gates + (size_t)row * 2048 + SECOND * 1024 + c);
                    f32x4 g0 = (f32x4){bflo(gw.x), bfhi(gw.x), bflo(gw.y), bfhi(gw.y)}, g1 = (f32x4){bflo(gw.z), bfhi(gw.z), bflo(gw.w), bfhi(gw.w)};
                    f32x4 v0 = acc[ai][bj][m][0] * g0, v1 = acc[ai][bj][m][1] * g1;
                    bf16_t* p = merged + (size_t)row * 1024 + c;
                    if (SECOND) {
                        const u32x4 ow = *(const u32x4*)p;
                        v0 += (f32x4){bflo(ow.x), bfhi(ow.x), bflo(ow.y), bfhi(ow.y)}; v1 += (f32x4){bflo(ow.z), bfhi(ow.z), bflo(ow.w), bfhi(ow.w)};
                    }
                    u32x4 w; w.x = cvt_pk_bf16(v0[0], v0[1]); w.y = cvt_pk_bf16(v0[2], v0[3]); w.z = cvt_pk_bf16(v1[0], v1[1]); w.w = cvt_pk_bf16(v1[2], v1[3]);
                    *(u32x4*)p = w;
                }
            }
        return false;
    }
};
struct MergeOrder {
    StaticOrder so; const char* A1; const char* B1;
    __device__ bool next(int i, Unit& u) const { const bool ok = so.next(i >> 1, u); u.aux = i & 1; return ok; }
    __device__ __forceinline__ const char* a_ptr(const Unit& u) const { return (u.aux ? A1 : so.A) + (size_t)u.pm * 256 * so.K * 2; }
    __device__ __forceinline__ const char* b_ptr(const Unit& u) const { return (u.aux ? B1 : so.Bt) + (size_t)u.pn * 256 * so.K * 2; }
    __device__ __forceinline__ int gather_row(const Unit&, int) const { return 0; }
    __device__ __forceinline__ const void* gather_src(const Unit&, int) const { return nullptr; }
};
struct EpiMergeFused {
    static constexpr int NPAR = 0;
    __device__ __forceinline__ const void* par_src(const Unit&, int, int) const { return nullptr; }
    bf16_t* merged; const bf16_t* gates;
    __device__ __forceinline__ bool operator()(f32x4 (&acc)[2][2][4][2], const Unit& u, int wr, int wc, int fr, int fq, const LAS unsigned char* par) const {
        const int row0 = u.pm * BM + wr * 64 + fr, col0 = u.pn * BM + wc * 32 + 8 * fq;
#pragma unroll
        for (int ai = 0; ai < 2; ++ai) {
            u32x4 gbw[4][2], gaw[4][2];
#pragma unroll
            for (int m = 0; m < 4; ++m)
#pragma unroll
                for (int bj = 0; bj < 2; ++bj) {
                    const bf16_t* gp = gates + (size_t)(row0 + ai * HALF + m * 16) * 2048 + col0 + bj * HALF;
                    gbw[m][bj] = *(const u32x4*)(gp + 1024);
                    gaw[m][bj] = u.aux == 0 ? *(const u32x4*)gp : (u32x4){0u, 0u, 0u, 0u};
                }
#pragma unroll
            for (int m = 0; m < 4; ++m)
#pragma unroll
                for (int bj = 0; bj < 2; ++bj) {
                    const int row = row0 + ai * HALF + m * 16, c = col0 + bj * HALF;
                    f32x4 gb0 = (f32x4){bflo(gbw[m][bj].x), bfhi(gbw[m][bj].x), bflo(gbw[m][bj].y), bfhi(gbw[m][bj].y)}, gb1 = (f32x4){bflo(gbw[m][bj].z), bfhi(gbw[m][bj].z), bflo(gbw[m][bj].w), bfhi(gbw[m][bj].w)};
#pragma unroll
                    for (int j = 0; j < 4; ++j) { gb0[j] = fmaxf(gb0[j], 1e-6f); gb1[j] = fmaxf(gb1[j], 1e-6f); }
                    if (u.aux == 0) {
                        const f32x4 ga0 = (f32x4){bflo(gaw[m][bj].x), bfhi(gaw[m][bj].x), bflo(gaw[m][bj].y), bfhi(gaw[m][bj].y)}, ga1 = (f32x4){bflo(gaw[m][bj].z), bfhi(gaw[m][bj].z), bflo(gaw[m][bj].w), bfhi(gaw[m][bj].w)};
#pragma unroll
                        for (int j = 0; j < 4; ++j) { acc[ai][bj][m][0][j] *= ga0[j] * __builtin_amdgcn_rcpf(gb0[j]); acc[ai][bj][m][1][j] *= ga1[j] * __builtin_amdgcn_rcpf(gb1[j]); }
                    } else {
                        const f32x4 v0 = acc[ai][bj][m][0] * gb0, v1 = acc[ai][bj][m][1] * gb1;
                        u32x4 w; w.x = cvt_pk_bf16(v0[0], v0[1]); w.y = cvt_pk_bf16(v0[2], v0[3]); w.z = cvt_pk_bf16(v1[0], v1[1]); w.w = cvt_pk_bf16(v1[2], v1[3]);
                        *(u32x4*)(merged + (size_t)row * 1024 + c) = w;
                    }
                }
        }
        return u.aux == 0;
    }
};
struct EpiO {
    static constexpr int NPAR = 0;
    __device__ __forceinline__ const void* par_src(const Unit&, int, int) const { return nullptr; }
    const float* x; float* h1; bf16_t* hb2;
    __device__ __forceinline__ bool operator()(const f32x4 (&acc)[2][2][4][2], const Unit& u, int wr, int wc, int fr, int fq, const LAS unsigned char* par) const {
        const int row0 = u.pm * BM + wr * 64 + fr, col0 = u.pn * BM + wc * 32 + 8 * fq;
#pragma unroll
        for (int ai = 0; ai < 2; ++ai) {
            f32x4 xv[4][2][2];
#pragma unroll
            for (int m = 0; m < 4; ++m)
#pragma unroll
                for (int bj = 0; bj < 2; ++bj) {
                    const size_t o = (size_t)(row0 + ai * HALF + m * 16) * 1024 + col0 + bj * HALF;
                    xv[m][bj][0] = *(const f32x4*)(x + o); xv[m][bj][1] = *(const f32x4*)(x + o + 4);
                }
#pragma unroll
            for (int m = 0; m < 4; ++m)
#pragma unroll
                for (int bj = 0; bj < 2; ++bj) {
                    const size_t o = (size_t)(row0 + ai * HALF + m * 16) * 1024 + col0 + bj * HALF;
                    const f32x4 v0 = acc[ai][bj][m][0] + xv[m][bj][0], v1 = acc[ai][bj][m][1] + xv[m][bj][1];
                    u32x4 w; w.x = cvt_pk_bf16(v0[0], v0[1]); w.y = cvt_pk_bf16(v0[2], v0[3]); w.z = cvt_pk_bf16(v1[0], v1[1]); w.w = cvt_pk_bf16(v1[2], v1[3]);
                    *(u32x4*)(hb2 + o) = w;
                }
        }
        return false;
    }
};
struct EpiMoe1 {
    bf16_t* act; const float* rowrs; const float* bg; const float* bu;
    static constexpr int NPAR = 2;
    __device__ __forceinline__ const void* par_src(const Unit& u, int piece, int lane) const {
        if (piece == 0) return rowrs + u.pm * BM + lane * 4;
        return (lane < 32 ? bg : bu) + (size_t)u.aux * DFF + u.pn * 128 + (lane & 31) * 4;
    }
    __device__ __forceinline__ bool operator()(const f32x4 (&acc)[2][2][4][2], const Unit& u, int wr, int wc, int fr, int fq, const LAS unsigned char* par) const {
        const int row0 = u.pm * BM + wr * 64 + fr, ff0 = u.pn * 128 + wc * 32 + 8 * fq;
        const LAS float* bgp = (const LAS float*)(par + 1024) + wc * 32 + 8 * fq; const LAS float* bup = bgp + 128;
        const f32x4 bg0 = *(const LAS f32x4*)bgp, bg1 = *(const LAS f32x4*)(bgp + 4), bu0 = *(const LAS f32x4*)bup, bu1 = *(const LAS f32x4*)(bup + 4);
        float rsv[2][4];
#pragma unroll
        for (int ai = 0; ai < 2; ++ai)
#pragma unroll
            for (int m = 0; m < 4; ++m) rsv[ai][m] = ((const LAS float*)par)[wr * 64 + fr + ai * HALF + m * 16];
#pragma unroll
        for (int ai = 0; ai < 2; ++ai)
#pragma unroll
            for (int m = 0; m < 4; ++m) {
                const int row = row0 + ai * HALF + m * 16;
                const float rs = rsv[ai][m];
                f32x4 g0 = acc[ai][0][m][0] * rs + bg0, g1 = acc[ai][0][m][1] * rs + bg1, u0 = acc[ai][1][m][0] * rs + bu0, u1 = acc[ai][1][m][1] * rs + bu1;
                f32x4 r0, r1;
#pragma unroll
                for (int j = 0; j < 4; ++j) {
                    { const float gt = fminf(g0[j], 7.0f), up = fminf(fmaxf(u0[j], -7.0f), 7.0f); r0[j] = (up + 1.0f) * gt * sigmoidf_(1.702f * gt); }
                    { const float gt = fminf(g1[j], 7.0f), up = fminf(fmaxf(u1[j], -7.0f), 7.0f); r1[j] = (up + 1.0f) * gt * sigmoidf_(1.702f * gt); }
                }
                u32x4 w; w.x = cvt_pk_bf16(r0[0], r0[1]); w.y = cvt_pk_bf16(r0[2], r0[3]); w.z = cvt_pk_bf16(r1[0], r1[1]); w.w = cvt_pk_bf16(r1[2], r1[3]);
                *(u32x4*)(act + (size_t)row * DFF + ff0) = w;
            }
        return false;
    }
};
struct EpiMoe2 {
    bf16_t* ya; bf16_t* yb; const int* rowslot; const float* roww; const float* bd;
    static constexpr int NPAR = 3;
    __device__ __forceinline__ const void* par_src(const Unit& u, int piece, int lane) const {
        if (piece == 0) return rowslot + u.pm * BM + lane * 4;
        if (piece == 1) return roww + u.pm * BM + lane * 4;
        return bd + (size_t)u.aux * D + u.pn * BM + lane * 4;
    }
    __device__ __forceinline__ bool operator()(const f32x4 (&acc)[2][2][4][2], const Unit& u, int wr, int wc, int fr, int fq, const LAS unsigned char* par) const {
        const int row0 = u.pm * BM + wr * 64 + fr, col0 = u.pn * BM + wc * 32 + 8 * fq;
        bf16_t* ybase = (u.pn < 2) ? ya : yb; const int yc0 = col0 & 511;
        const LAS float* bp = (const LAS float*)(par + 2048) + wc * 32 + 8 * fq;
        f32x4 bv[2][2];
#pragma unroll
        for (int bj = 0; bj < 2; ++bj) { bv[bj][0] = *(const LAS f32x4*)(bp + bj * HALF); bv[bj][1] = *(const LAS f32x4*)(bp + bj * HALF + 4); }
        int slotv[2][4]; float wv8[2][4];
#pragma unroll
        for (int ai = 0; ai < 2; ++ai)
#pragma unroll
            for (int m = 0; m < 4; ++m) { const int rl = wr * 64 + fr + ai * HALF + m * 16; slotv[ai][m] = ((const LAS int*)par)[rl]; wv8[ai][m] = ((const LAS float*)(par + 1024))[rl]; }
#pragma unroll
        for (int ai = 0; ai < 2; ++ai)
#pragma unroll
            for (int m = 0; m < 4; ++m) {
                const int slot = slotv[ai][m];
                if (slot >= 0) {
                    const float w8 = wv8[ai][m];
#pragma unroll
                    for (int bj = 0; bj < 2; ++bj) {
                        const f32x4 v0 = (acc[ai][bj][m][0] + bv[bj][0]) * w8, v1 = (acc[ai][bj][m][1] + bv[bj][1]) * w8;
                        u32x4 w; w.x = cvt_pk_bf16(v0[0], v0[1]); w.y = cvt_pk_bf16(v0[2], v0[3]); w.z = cvt_pk_bf16(v1[0], v1[1]); w.w = cvt_pk_bf16(v1[2], v1[3]);
                        *(u32x4*)(ybase + (size_t)slot * 512 + yc0 + bj * HALF) = w;
                    }
                }
            }
        return false;
    }
};

__device__ __forceinline__ void transpose_tile(LAS float* tile, const float* src, int ldsrc, int k0, int n0, bf16_t* dst, int ldd, int drow0, const float* sa, const float* mu, int mode, bool zero) {
    const int tid = threadIdx.x;
    if (!zero) {
#pragma unroll
        for (int i = 0; i < 2; ++i) {
            const int r = (tid >> 4) + 32 * i, c4 = (tid & 15) * 4;
            const f32x4 v = *(const f32x4*)(src + (size_t)(k0 + r) * ldsrc + n0 + c4);
            LAS float* t = tile + r * 65 + c4;
            t[0] = v[0]; t[1] = v[1]; t[2] = v[2]; t[3] = v[3];
        }
    }
    __syncthreads();
    {
        const int n = tid >> 3, kq = tid & 7;
        float v[8];
#pragma unroll
        for (int j = 0; j < 8; ++j) {
            const int k = k0 + 8 * kq + j;
            float s = sa ? sa[k] : 1.0f;
            if (mode == 1) s *= (1.0f - mu[k]);
            if (mode == 2) s *= mu[k];
            v[j] = zero ? 0.f : tile[(8 * kq + j) * 65 + n] * s;
        }
        u32x4 w; w.x = cvt_pk_bf16(v[0], v[1]); w.y = cvt_pk_bf16(v[2], v[3]); w.z = cvt_pk_bf16(v[4], v[5]); w.w = cvt_pk_bf16(v[6], v[7]);
        *(u32x4*)(dst + (size_t)(drow0 + n) * ldd + k0 + 8 * kq) = w;
    }
    __syncthreads();
}

__device__ __forceinline__ void phase_prep(const PPv& p, LAS unsigned char* lds) {
    const int tid = threadIdx.x, bid = blockIdx.x, nb = gridDim.x, lane = tid & 63, wave = tid >> 6;
    unsigned char* ws = p.gws();
    const float* x = p.gin(0); const float* meta = p.gin(1); const float* g1 = p.gin(2);
    if (bid == 0 && tid < 64) ((int*)(ws + OFF_GCNT))[tid] = 0;
    {
        bf16_t* HB = (bf16_t*)(ws + OFF_HB); float* rstd1 = (float*)(ws + OFF_RSTD1);
        for (int row0 = (bid * 8 + wave) * 4; row0 < NR; row0 += nb * 32) {
            f32x4 v[4][4];
#pragma unroll
            for (int u = 0; u < 4; ++u) {
                const int row = row0 + u < NR ? row0 + u : NR - 1;
                const float* src = row < NMETA ? meta + (size_t)row * D : x + (size_t)(row - NMETA) * D;
#pragma unroll
                for (int i = 0; i < 4; ++i) v[u][i] = __builtin_nontemporal_load((const f32x4*)(src + i * 256 + lane * 4));
            }
#pragma unroll
            for (int u = 0; u < 4; ++u) {
                const int row = row0 + u;
                if (row < NR) {
                    float ss = 0.f;
#pragma unroll
                    for (int i = 0; i < 4; ++i) ss += v[u][i][0] * v[u][i][0] + v[u][i][1] * v[u][i][1] + v[u][i][2] * v[u][i][2] + v[u][i][3] * v[u][i][3];
                    ss = wave_sum_dpp(ss);
                    if (lane == 0) rstd1[row] = rsqrtf(ss * (1.0f / D) + NORM_EPS);
                    if (row >= NMETA) {
                        bf16_t* d = HB + (size_t)(row - NMETA) * D;
#pragma unroll
                        for (int i = 0; i < 4; ++i) { u32x2 w; w.x = cvt_pk_bf16(v[u][i][0], v[u][i][1]); w.y = cvt_pk_bf16(v[u][i][2], v[u][i][3]); *(u32x2*)(d + i * 256 + lane * 4) = w; }
                    }
                }
            }
        }
    }
    LAS float* tile = (LAS float*)lds;
    {
        bf16_t* WIN = (bf16_t*)(ws + OFF_WIN);
        const float* w_in = p.gin(3);
        for (int j = bid; j < 16 * 88; j += nb) {
            const int kt = j & 15, ntile = j >> 4, n0 = ntile * 64;
            const float* src; int ld, sn0, mode = 0; const float* mu = nullptr;
            if (n0 < 3072) { src = w_in; ld = 5120; sn0 = n0; }
            else if (n0 < 3584) {
                const int seg = (n0 - 3072) >> 6;
                if (seg < 2) { src = p.gin(11); ld = 64; sn0 = 0; mu = p.gin(7); mode = 1 + seg; }
                else if (seg < 4) { src = p.gin(14); ld = 64; sn0 = 0; mu = p.gin(8); mode = 1 + (seg - 2); }
                else { src = p.gin(16); ld = 128; sn0 = (seg & 1) * 64; mu = p.gin(9); mode = seg < 6 ? 1 : 2; }
            } else { src = w_in; ld = 5120; sn0 = n0 - 512; }
            transpose_tile(tile, src, ld, kt * 64, sn0, WIN, 1024, n0, g1, mu, mode, false);
        }
        for (int j = bid; j < 2 * 128; j += nb) {
            const int which = j >> 7, jj = j & 127, kt = jj & 7, ntile = jj >> 3;
            transpose_tile(tile, which ? p.gin(25) : p.gin(23), 1024, kt * 64, ntile * 64, (bf16_t*)(ws + (which ? OFF_WC : OFF_WR)), 512, ntile * 64, nullptr, nullptr, 0, false);
        }
        for (int j = bid; j < 256; j += nb) {
            const int kt = j & 15, ntile = j >> 4;
            transpose_tile(tile, p.gin(26), 1024, kt * 64, ntile * 64, (bf16_t*)(ws + OFF_WO), 1024, ntile * 64, nullptr, nullptr, 0, false);
        }
        for (int j = bid; j < 96; j += nb) {
            const int kt = j & 3, ntile = j >> 2, seg = ntile >> 3, nn0 = (ntile & 7) * 64;
            const float* src = nullptr; int sk0 = 0; bool zero = true;
            if (seg == 0 && kt == 0) { src = p.gin(12); sk0 = 0; zero = false; }
            if (seg == 1 && kt == 1) { src = p.gin(15); sk0 = 0; zero = false; }
            if (seg == 2 && kt >= 2) { src = p.gin(17); sk0 = (kt - 2) * 64; zero = false; }
            const float* srcs = zero ? p.gin(12) : src + (size_t)(sk0 - kt * 64) * 512;
            transpose_tile(tile, srcs, 512, kt * 64, nn0, (bf16_t*)(ws + OFF_W2), 256, ntile * 64, nullptr, nullptr, 0, zero);
        }
        {
            float* WRG = (float*)(ws + OFF_WRG); const float* g2 = p.gin(27); const float* wr_ = p.gin(28);
            for (int i = bid * 512 + tid; i < 1024 * 32; i += nb * 512) WRG[i] = g2[i >> 5] * wr_[i];
        }
    }
}

__device__ __forceinline__ void phase_meta_proj(const PPv& p, LAS unsigned char* lds) {
    const int tid = threadIdx.x, bid = blockIdx.x, lane = tid & 63, wave = tid >> 6;
    unsigned char* ws = p.gws();
    LAS float* sm = (LAS float*)lds;
    const float* meta = p.gin(1);
    for (int i = tid; i < 16 * 256; i += 512) { const int r = i >> 8, c4 = (i & 255) * 4; const f32x4 v = *(const f32x4*)(meta + r * 1024 + c4); LAS float* d = sm + r * 1028 + c4; d[0] = v[0]; d[1] = v[1]; d[2] = v[2]; d[3] = v[3]; }
    __syncthreads();
    const float* rstd1 = (const float*)(ws + OFF_RSTD1);
    for (int nbase = bid * 14; nbase < PCOLS1; nbase += gridDim.x * 14) {
        for (int nn = wave; nn < 14; nn += 8) {
            const int n = nbase + nn;
            if (n >= PCOLS1) break;
            const bf16_t* wrow = (const bf16_t*)(ws + OFF_WIN) + (size_t)n * 1024;
            const u32x4 w0 = *(const u32x4*)(wrow + 8 * lane), w1 = *(const u32x4*)(wrow + 512 + 8 * lane);
            const float wf[16] = {bflo(w0.x), bfhi(w0.x), bflo(w0.y), bfhi(w0.y), bflo(w0.z), bfhi(w0.z), bflo(w0.w), bfhi(w0.w),
                                  bflo(w1.x), bfhi(w1.x), bflo(w1.y), bfhi(w1.y), bflo(w1.z), bfhi(w1.z), bflo(w1.w), bfhi(w1.w)};
            float outv = 0.f;
#pragma unroll
            for (int pr = 0; pr < 16; ++pr) {
                const LAS float* m0 = sm + pr * 1028 + 8 * lane;
                const f32x4 a0 = *(const LAS f32x4*)m0, a1 = *(const LAS f32x4*)(m0 + 4), a2 = *(const LAS f32x4*)(m0 + 512), a3 = *(const LAS f32x4*)(m0 + 516);
                float acc = a0[0] * wf[0] + a0[1] * wf[1] + a0[2] * wf[2] + a0[3] * wf[3] + a1[0] * wf[4] + a1[1] * wf[5] + a1[2] * wf[6] + a1[3] * wf[7]
                          + a2[0] * wf[8] + a2[1] * wf[9] + a2[2] * wf[10] + a2[3] * wf[11] + a3[0] * wf[12] + a3[1] * wf[13] + a3[2] * wf[14] + a3[3] * wf[15];
                acc = wave_sum_dpp(acc);
                outv = (lane == pr) ? acc * rstd1[pr] : outv;
            }
            if (lane < 16) {
                if (n < 1536) ((bf16_t*)(ws + OFF_PRKV))[(size_t)lane * 1536 + n] = f2bf(outv);
                else ((bf16_t*)(ws + OFF_PCONV))[(size_t)lane * 2048 + n - 1536] = f2bf(outv);
            }
        }
    }
    __syncthreads();
}

__device__ __forceinline__ void phase_lprep_conv(const PPv& p) {
    const int tid = threadIdx.x, bid = blockIdx.x, nb = gridDim.x;
    unsigned char* ws = p.gws();
    const bf16_t* PROJ = (const bf16_t*)(ws + OFF_PCONV);
    constexpr int PCOLS = 2048;
    bf16_t* L = (bf16_t*)(ws + OFF_L);
    for (int i = bid * 512 + tid; i < NRP * 32; i += nb * 512) {
        const int row = i >> 5, gq = i & 31;
        u32x4 w = (u32x4){0u, 0u, 0u, 0u};
        if (row < NR) {
            int ca, cb;
            if (gq < 8) { ca = 1536 + gq * 8; cb = ca + 64; }
            else if (gq < 16) { ca = 1536 + 128 + (gq - 8) * 8; cb = ca + 64; }
            else { ca = 1536 + 256 + (gq - 16) * 8; cb = ca + 128; }
            const u32x4 va = *(const u32x4*)(PROJ + (size_t)row * PCOLS + ca);
            const int pr = prev_row(row, 1);
            u32x4 vb = (u32x4){0u, 0u, 0u, 0u};
            if (pr >= 0) vb = *(const u32x4*)(PROJ + (size_t)pr * PCOLS + cb);
            float v[8] = {bflo(va.x) + bflo(vb.x), bfhi(va.x) + bfhi(vb.x), bflo(va.y) + bflo(vb.y), bfhi(va.y) + bfhi(vb.y), bflo(va.z) + bflo(vb.z), bfhi(va.z) + bfhi(vb.z), bflo(va.w) + bflo(vb.w), bfhi(va.w) + bfhi(vb.w)};
#pragma unroll
            for (int j = 0; j < 8; ++j) { if (gq < 8) v[j] = tanhf(v[j]); else if (gq >= 16) v[j] = sigmoidf_(v[j]); }
            w.x = cvt_pk_bf16(v[0], v[1]); w.y = cvt_pk_bf16(v[2], v[3]); w.z = cvt_pk_bf16(v[4], v[5]); w.w = cvt_pk_bf16(v[6], v[7]);
        }
        *(u32x4*)(L + (size_t)row * 256 + gq * 8) = w;
    }
    bf16_t* C = (bf16_t*)(ws + OFF_C);
    const float* cw = p.gin(24);
    for (int i = bid * 512 + tid; i < T * 64; i += nb * 512) {
        const int m = i >> 6, ch = (i & 63) * 8, row = NMETA + m;
        const int r1 = prev_row(row, 1), r2 = prev_row(row, 2);
        const bf16_t* p0 = PROJ + (size_t)row * PCOLS; const bf16_t* p1 = PROJ + (size_t)r1 * PCOLS; const bf16_t* p2 = PROJ + (size_t)r2 * PCOLS;
        const u32x4 vb = *(const u32x4*)(p0 + ch);
        const u32x4 c0 = *(const u32x4*)(p0 + 512 + ch), h0 = *(const u32x4*)(p0 + 1024 + ch);
        const u32x4 c1 = *(const u32x4*)(p1 + 512 + ch), h1 = *(const u32x4*)(p1 + 1024 + ch);
        const u32x4 c2 = *(const u32x4*)(p2 + 512 + ch), h2 = *(const u32x4*)(p2 + 1024 + ch);
        float o[8];
#pragma unroll
        for (int j = 0; j < 8; ++j) {
            const unsigned wb = j < 2 ? vb.x : j < 4 ? vb.y : j < 6 ? vb.z : vb.w;
            const unsigned wc0 = j < 2 ? c0.x : j < 4 ? c0.y : j < 6 ? c0.z : c0.w, wh0 = j < 2 ? h0.x : j < 4 ? h0.y : j < 6 ? h0.z : h0.w;
            const unsigned wc1 = j < 2 ? c1.x : j < 4 ? c1.y : j < 6 ? c1.z : c1.w, wh1 = j < 2 ? h1.x : j < 4 ? h1.y : j < 6 ? h1.z : h1.w;
            const unsigned wc2 = j < 2 ? c2.x : j < 4 ? c2.y : j < 6 ? c2.z : c2.w, wh2 = j < 2 ? h2.x : j < 4 ? h2.y : j < 6 ? h2.z : h2.w;
            const bool hi = j & 1;
            const float b = hi ? bfhi(wb) : bflo(wb);
            const float u0 = (hi ? bfhi(wc0) : bflo(wc0)) * (hi ? bfhi(wh0) : bflo(wh0));
            const float u1 = (hi ? bfhi(wc1) : bflo(wc1)) * (hi ? bfhi(wh1) : bflo(wh1));
            const float u2 = (hi ? bfhi(wc2) : bflo(wc2)) * (hi ? bfhi(wh2) : bflo(wh2));
            const float conv = cw[ch + j] * u2 + cw[512 + ch + j] * u1 + cw[1024 + ch + j] * u0;
            o[j] = b * conv;
        }
        u32x4 w; w.x = cvt_pk_bf16(o[0], o[1]); w.y = cvt_pk_bf16(o[2], o[3]); w.z = cvt_pk_bf16(o[4], o[5]); w.w = cvt_pk_bf16(o[6], o[7]);
        *(u32x4*)(C + (size_t)m * 512 + ch) = w;
    }
}

template <int CTRL> __device__ __forceinline__ float dppmov(float v) { return __builtin_bit_cast(float, __builtin_amdgcn_update_dpp(0, __builtin_bit_cast(int, v), CTRL, 0xF, 0xF, true)); }
__device__ __forceinline__ float wave_sum_dpp(float v) {
    v += dppmov<0xB1>(v);
    v += dppmov<0x4E>(v);
    v += dppmov<0x141>(v);
    v += dppmov<0x140>(v);
    { float c = v; asm volatile("v_nop\n\tv_nop\n\tv_permlane16_swap_b32 %0, %1\n\tv_nop" : "+v"(v), "+v"(c)); v += c; }
    { float c = v; asm volatile("v_nop\n\tv_nop\n\tv_permlane32_swap_b32 %0, %1\n\tv_nop" : "+v"(v), "+v"(c)); v += c; }
    return v;
}
typedef float f32x16 __attribute__((ext_vector_type(16)));

struct RawTok { bf16_t r, k, v, a, ld; };
__device__ __forceinline__ RawTok load_raw(const bf16_t* PRKV, const bf16_t* Ab, const bf16_t* LD, int row, int col) {
    RawTok q; const bf16_t* p0 = PRKV + (size_t)row * 1536 + col;
    q.r = p0[0]; q.k = p0[512]; q.v = p0[1024]; q.a = Ab[(size_t)row * 512 + col]; q.ld = LD[(size_t)row * 512 + col];
    return q;
}
__device__ __forceinline__ void unit_geom(int uid, int lane, int& b, int& h, int& c, int& col, int& row0) {
    const int bh = uid / NCHUNK; c = uid - bh * NCHUNK; b = bh >> 3; h = bh & 7; col = h * 64 + lane;
    row0 = c == 0 ? 0 : b * SEQ + c * 16;
}
__device__ __forceinline__ void phase_scanprep(const PPv& p, LAS unsigned char* lds) {
    const int tid = threadIdx.x, bid = blockIdx.x, nb = gridDim.x, lane = tid & 63, wave = tid >> 6;
    unsigned char* ws = p.gws();
    const bf16_t* PRKV = (const bf16_t*)(ws + OFF_PRKV);
    const bf16_t* LD = (const bf16_t*)(ws + OFF_LD);
    const bf16_t* Ab = (const bf16_t*)(ws + OFF_A);
    float* COEF = (float*)(ws + OFF_COEF);
    LAS unsigned char* wl = lds + wave * 13824;
    LAS bf16_t* AR = (LAS bf16_t*)wl;
    LAS bf16_t* BK = (LAS bf16_t*)(wl + 4608);
    LAS float* DM = (LAS float*)(wl + 9216);
    const int qperm = (lane & 32) | (((lane >> 2) & 3) << 3) | (((lane >> 4) & 1) << 2) | (lane & 3);
    int uid = bid * 8 + wave;
    if (uid >= NUNITS) return;
    int b, h, c, col, row0;
    unit_geom(uid, lane, b, h, c, col, row0);
    RawTok q[16], qn[16];
    bf16_t prr = 0, prk = 0, prv = 0, nprr = 0, nprk = 0, nprv = 0;
#pragma unroll
    for (int t = 0; t < 16; ++t) q[t] = load_raw(PRKV, Ab, LD, row0 + t, col);
    { const int pr = prev_row(row0, 1); if (pr >= 0) { const bf16_t* p1 = PRKV + (size_t)pr * 1536 + col; prr = p1[0]; prk = p1[512]; prv = p1[1024]; } }
    for (;;) {
        const float mur = p.gin(4)[col], muk = p.gin(5)[col], muv = p.gin(6)[col], kkw = p.gin(18)[col], kaw = p.gin(19)[col], rkw = p.gin(20)[col];
        const int nuid = uid + nb * 8; const bool has_next = nuid < NUNITS;
        int nb_ = b, nh = h, nc = c, ncol = col, nrow0 = row0;
        if (has_next) {
            unit_geom(nuid, lane, nb_, nh, nc, ncol, nrow0);
#pragma unroll
            for (int t = 0; t < 16; ++t) qn[t] = load_raw(PRKV, Ab, LD, nrow0 + t, ncol);
            nprr = 0; nprk = 0; nprv = 0;
            const int pr = prev_row(nrow0, 1); if (pr >= 0) { const bf16_t* p1 = PRKV + (size_t)pr * 1536 + ncol; nprr = p1[0]; nprk = p1[512]; nprv = p1[1024]; }
        }
        __builtin_amdgcn_sched_barrier(0);
        float at[16], vt[16]; unsigned btp[8], ktp[8]; float bprev = 0.f, kprev = 0.f;
        float cl = 0.f;
        float rp = bf2f(prr), kp = bf2f(prk), vp = bf2f(prv);
#pragma unroll
        for (int t = 0; t < 16; ++t) {
            const RawTok qq = q[t];
            const int row = row0 + t;
            const float r0 = bf2f(qq.r), k0 = bf2f(qq.k), v0 = bf2f(qq.v);
            const float r = r0 + (rp - r0) * mur, k = k0 + (kp - k0) * muk, v = v0 + (vp - v0) * muv;
            rp = r0; kp = k0; vp = v0;
            const float a = bf2f(qq.a);
            const float kkv = k * kkw;
            const float n2 = wave_sum_dpp(kkv * kkv);
            const float kk = kkv * __builtin_amdgcn_rsqf(fmaxf(n2, 1e-24f));
            const float k2 = k * (1.0f + (a - 1.0f) * kaw);
            const float cf = wave_sum_dpp(r * k2 * rkw);
            if (lane == 0) COEF[(size_t)row * 8 + h] = cf;
            const float wcp = __expf(cl);
            cl += bf2f(qq.ld);
            const float wcn = __expf(cl), iw = __expf(-cl);
            const float btv = kk * a * iw, ktv = k2 * iw;
            at[t] = -kk * wcp; vt[t] = v;
            { const unsigned w = cvt_pk_bf16(at[t], r * wcn); AR[t * 72 + qperm] = (bf16_t)(w & 0xFFFFu); AR[(16 + t) * 72 + qperm] = (bf16_t)(w >> 16); }
            if (t & 1) {
                btp[t >> 1] = cvt_pk_bf16(bprev, btv); ktp[t >> 1] = cvt_pk_bf16(kprev, ktv);
                BK[(t - 1) * 72 + qperm] = (bf16_t)(btp[t >> 1] & 0xFFFFu); BK[t * 72 + qperm] = (bf16_t)(btp[t >> 1] >> 16);
                BK[(16 + t - 1) * 72 + qperm] = (bf16_t)(ktp[t >> 1] & 0xFFFFu); BK[(16 + t) * 72 + qperm] = (bf16_t)(ktp[t >> 1] >> 16);
            } else { bprev = btv; kprev = ktv; }
            if (t & 1) __builtin_amdgcn_sched_barrier(0);
        }
        const float wcc = __expf(cl);
        {
            f32x16 dm;
#pragma unroll
            for (int i = 0; i < 16; ++i) dm[i] = 0.f;
            const int rr = lane & 31, hh = lane >> 5;
#pragma unroll
            for (int ks = 0; ks < 4; ++ks) {
                const bf16x8 fa = *(const LAS bf16x8*)(AR + rr * 72 + 16 * ks + 8 * hh);
                const bf16x8 fb = *(const LAS bf16x8*)(BK + rr * 72 + 16 * ks + 8 * hh);
                dm = __builtin_amdgcn_mfma_f32_32x32x16_bf16(fa, fb, dm, 0, 0, 0);
            }
#pragma unroll
            for (int reg = 0; reg < 16; ++reg) DM[((reg & 3) + 8 * (reg >> 2) + 4 * hh) * 36 + rr] = dm[reg];
        }
        __builtin_amdgcn_sched_barrier(0);
        float uh[16];
#pragma unroll
        for (int t = 0; t < 16; ++t) {
            float wv = at[t], uv = 0.f, wv2 = 0.f, uv2 = 0.f, uv3 = 0.f;
#pragma unroll
            for (int s4 = 0; s4 < 4; ++s4) {
                if (s4 * 4 < t) {
                    const f32x4 ab = *(const LAS f32x4*)(DM + t * 36 + s4 * 4), ak = *(const LAS f32x4*)(DM + t * 36 + 16 + s4 * 4);
#pragma unroll
                    for (int j = 0; j < 4; ++j) {
                        const int s_ = s4 * 4 + j;
                        if (s_ < t) {
                            if (j & 1) { wv2 += ab[j] * at[s_]; uv2 += ak[j] * vt[s_]; } else { wv += ab[j] * at[s_]; uv += ak[j] * vt[s_]; }
                            uv3 += ab[j] * uh[s_];
                        }
                    }
                }
            }
            wv += wv2; uv += uv2 + uv3;
            at[t] = wv; uh[t] = uv;
            asm volatile("" : "+v"(at[t]), "+v"(uh[t]));
        }
        __builtin_amdgcn_sched_barrier(0);
#pragma unroll
        for (int t = 0; t < 16; t += 2) { const unsigned w = cvt_pk_bf16(at[t], at[t + 1]); AR[t * 72 + qperm] = (bf16_t)(w & 0xFFFFu); AR[(t + 1) * 72 + qperm] = (bf16_t)(w >> 16); }
        unsigned char* rec = ws + OFF_CH + (size_t)uid * REC_BYTES;
#pragma unroll
        for (int i = 0; i < 2; ++i) {
            const int pc = i * 64 + lane, row = pc >> 3, part = pc & 7;
            *(u32x4*)(rec + RO_WH + pc * 16) = *(const LAS u32x4*)((LAS unsigned char*)AR + row * 144 + part * 16);
            *(u32x4*)(rec + RO_RT + pc * 16) = *(const LAS u32x4*)((LAS unsigned char*)AR + (16 + row) * 144 + part * 16);
        }
        {
            u32x4 w0, w1;
            w0.x = cvt_pk_bf16(uh[0], uh[1]); w0.y = cvt_pk_bf16(uh[2], uh[3]); w0.z = cvt_pk_bf16(uh[4], uh[5]); w0.w = cvt_pk_bf16(uh[6], uh[7]);
            w1.x = cvt_pk_bf16(uh[8], uh[9]); w1.y = cvt_pk_bf16(uh[10], uh[11]); w1.z = cvt_pk_bf16(uh[12], uh[13]); w1.w = cvt_pk_bf16(uh[14], uh[15]);
            *(u32x4*)(rec + RO_U0T + lane * 32) = w0; *(u32x4*)(rec + RO_U0T + lane * 32 + 16) = w1;
            w0.x = cvt_pk_bf16(vt[0], vt[1]); w0.y = cvt_pk_bf16(vt[2], vt[3]); w0.z = cvt_pk_bf16(vt[4], vt[5]); w0.w = cvt_pk_bf16(vt[6], vt[7]);
            w1.x = cvt_pk_bf16(vt[8], vt[9]); w1.y = cvt_pk_bf16(vt[10], vt[11]); w1.z = cvt_pk_bf16(vt[12], vt[13]); w1.w = cvt_pk_bf16(vt[14], vt[15]);
            *(u32x4*)(rec + RO_VT + lane * 32) = w0; *(u32x4*)(rec + RO_VT + lane * 32 + 16) = w1;
        }
#pragma unroll
        for (int g = 0; g < 4; ++g) {
            u32x4 w; w.x = btp[2 * g]; w.y = btp[2 * g + 1]; w.z = ktp[2 * g]; w.w = ktp[2 * g + 1];
            *(u32x4*)(rec + RO_BKT + lane * 64 + g * 16) = w;
        }
        {
            const int t = lane >> 2, g = lane & 3;
            const f32x4 rb = *(const LAS f32x4*)(DM + (16 + t) * 36 + 4 * g), rk = *(const LAS f32x4*)(DM + (16 + t) * 36 + 16 + 4 * g);
            float o[8];
#pragma unroll
            for (int j = 0; j < 4; ++j) { const bool keep = (4 * g + j) <= t; o[j] = keep ? rb[j] : 0.f; o[4 + j] = keep ? rk[j] : 0.f; }
            u32x4 w; w.x = cvt_pk_bf16(o[0], o[1]); w.y = cvt_pk_bf16(o[2], o[3]); w.z = cvt_pk_bf16(o[4], o[5]); w.w = cvt_pk_bf16(o[6], o[7]);
            *(u32x4*)(rec + RO_ARK + t * 64 + g * 16) = w;
        }
        *(float*)(rec + RO_WCC + lane * 4) = wcc;
        if (!has_next) break;
        uid = nuid; b = nb_; h = nh; c = nc; col = ncol; row0 = nrow0;
#pragma unroll
        for (int t = 0; t < 16; ++t) q[t] = qn[t];
        prr = nprr; prk = nprk; prv = nprv;
        __builtin_amdgcn_sched_barrier(0);
    }
}

__device__ __forceinline__ void convert_expert_weights(const PPv& p, LAS unsigned char* lds, int first, int stride);
struct RecOps { bf16x8 wA0, wA1, rA0, rA1, ark, bk[4]; u32x2 u0, vv; f32x4 wc[4]; };
__device__ __forceinline__ void load_ops(RecOps& o, LAS unsigned char* S, int vs, int fr, int g) {
    o.wA0 = *(const LAS bf16x8*)(S + RO_WH + fr * 128 + g * 16); o.wA1 = *(const LAS bf16x8*)(S + RO_WH + fr * 128 + 64 + g * 16);
    o.rA0 = *(const LAS bf16x8*)(S + RO_RT + fr * 128 + g * 16); o.rA1 = *(const LAS bf16x8*)(S + RO_RT + fr * 128 + 64 + g * 16);
    o.u0 = *(const LAS u32x2*)(S + RO_U0T + (16 * vs + fr) * 32 + g * 8);
    o.vv = *(const LAS u32x2*)(S + RO_VT + (16 * vs + fr) * 32 + g * 8);
    o.ark = *(const LAS bf16x8*)(S + RO_ARK + fr * 64 + g * 16);
#pragma unroll
    for (int m = 0; m < 4; ++m) { o.bk[m] = *(const LAS bf16x8*)(S + RO_BKT + (16 * m + fr) * 64 + g * 16); o.wc[m] = *(const LAS f32x4*)(S + RO_WCC + (16 * m + 4 * g) * 4); }
}
__device__ __forceinline__ void phase_recur(const PPv& p, LAS unsigned char* lds) {
    const int tid = threadIdx.x, bid = blockIdx.x, nb = gridDim.x, lane = tid & 63, wave = __builtin_amdgcn_readfirstlane(tid >> 6);
    unsigned char* ws = p.gws();
    if (bid >= 64) { convert_expert_weights(p, lds, bid - 64, nb - 64); return; }
    unsigned char* CHb = ws + OFF_CH + (size_t)(bid * NCHUNK) * REC_BYTES;
    constexpr int RSLOT = REC_BYTES, RN = 10, PF = 7;
#define R_BAR() do { asm volatile("s_waitcnt lgkmcnt(0)" ::: "memory"); __builtin_amdgcn_s_barrier(); asm volatile("" ::: "memory"); } while (0)
    if (wave >= 4) {
        const int lw = wave - 4;
#define R_ISSUE(x) do { \
            LAS unsigned char* _s = lds + ((x) % RN) * RSLOT; const unsigned char* _r = CHb + (size_t)(x) * REC_BYTES + lane * 16; \
            _Pragma("unroll") for (int _i = 0; _i < 3; ++_i) { const int _pc = lw + 4 * _i; __builtin_amdgcn_global_load_lds((const unsigned*)(_r + _pc * 1024), (LAS unsigned*)(_s + _pc * 1024), 16, 0, 0); } \
            if (lw == 0) __builtin_amdgcn_global_load_lds((const unsigned*)(_r + 12 * 1024), (LAS unsigned*)(_s + 12 * 1024), 16, 0, 0); \
            if (lw == 1) { if (lane < 16) __builtin_amdgcn_global_load_lds((const unsigned*)(_r + 13 * 1024), (LAS unsigned*)(_s + 13 * 1024), 16, 0, 0); } } while (0)
        for (int x = 0; x < PF; ++x) R_ISSUE(x);
        asm volatile("s_waitcnt vmcnt(0)" ::: "memory");
        R_BAR();
        for (int c = 0; c < NCHUNK; ++c) {
            const int x = c + PF;
            if (x < NCHUNK) R_ISSUE(x);
            if (x < NCHUNK) { if (lw < 2) asm volatile("s_waitcnt vmcnt(20)" ::: "memory"); else asm volatile("s_waitcnt vmcnt(15)" ::: "memory"); }
            else asm volatile("s_waitcnt vmcnt(0)" ::: "memory");
            R_BAR();
        }
#undef R_ISSUE
    } else {
        const int vs = wave, fr = lane & 15, g = lane >> 4;
        f32x4 H[4];
#pragma unroll
        for (int m = 0; m < 4; ++m) H[m] = (f32x4){0.f, 0.f, 0.f, 0.f};
        R_BAR();
        RecOps cur, nxt;
        load_ops(cur, lds, vs, fr, g);
        for (int c = 0; c < NCHUNK; ++c) {
            if (c + 1 < NCHUNK) load_ops(nxt, lds + ((c + 1) % RN) * RSLOT, vs, fr, g); else nxt = cur;
            u32x4 hb0, hb1;
            hb0.x = cvt_pk_bf16(H[0][0], H[0][1]); hb0.y = cvt_pk_bf16(H[0][2], H[0][3]); hb0.z = cvt_pk_bf16(H[1][0], H[1][1]); hb0.w = cvt_pk_bf16(H[1][2], H[1][3]);
            hb1.x = cvt_pk_bf16(H[2][0], H[2][1]); hb1.y = cvt_pk_bf16(H[2][2], H[2][3]); hb1.z = cvt_pk_bf16(H[3][0], H[3][1]); hb1.w = cvt_pk_bf16(H[3][2], H[3][3]);
            const bf16x8 hB0 = __builtin_bit_cast(bf16x8, hb0), hB1 = __builtin_bit_cast(bf16x8, hb1);
            f32x4 U = (f32x4){bflo(cur.u0.x), bfhi(cur.u0.x), bflo(cur.u0.y), bfhi(cur.u0.y)};
            U = __builtin_amdgcn_mfma_f32_16x16x32_bf16(cur.wA0, hB0, U, 0, 0, 0);
            U = __builtin_amdgcn_mfma_f32_16x16x32_bf16(cur.wA1, hB1, U, 0, 0, 0);
            f32x4 Y = (f32x4){0.f, 0.f, 0.f, 0.f};
            Y = __builtin_amdgcn_mfma_f32_16x16x32_bf16(cur.rA0, hB0, Y, 0, 0, 0);
            Y = __builtin_amdgcn_mfma_f32_16x16x32_bf16(cur.rA1, hB1, Y, 0, 0, 0);
            u32x4 uvw; uvw.x = cvt_pk_bf16(U[0], U[1]); uvw.y = cvt_pk_bf16(U[2], U[3]); uvw.z = cur.vv.x; uvw.w = cur.vv.y;
            const bf16x8 uv = __builtin_bit_cast(bf16x8, uvw);
            Y = __builtin_amdgcn_mfma_f32_16x16x32_bf16(cur.ark, uv, Y, 0, 0, 0);
#pragma unroll
            for (int m = 0; m < 4; ++m) { H[m] = __builtin_amdgcn_mfma_f32_16x16x32_bf16(cur.bk[m], uv, H[m], 0, 0, 0); H[m] *= cur.wc[m]; }
            u32x2 yw; yw.x = cvt_pk_bf16(Y[0], Y[1]); yw.y = cvt_pk_bf16(Y[2], Y[3]);
            *(u32x2*)(CHb + (size_t)c * REC_BYTES + RO_U0T + (16 * vs + fr) * 32 + g * 8) = yw;
            R_BAR();
            cur = nxt;
        }
    }
#undef R_BAR
}

__device__ __forceinline__ void phase_gn(const PPv& p) {
    const int tid = threadIdx.x, bid = blockIdx.x, nb = gridDim.x, lane = tid & 63, wave = tid >> 6;
    unsigned char* ws = p.gws();
    const bf16_t* Gb = (const bf16_t*)(ws + OFF_G); const float* COEF = (const float*)(ws + OFF_COEF);
    bf16_t* Z = (bf16_t*)(ws + OFF_Z);
    constexpr int NREAL = 64 * 256;
    for (int r0 = bid * 8 + wave; r0 < NREAL; r0 += nb * 16) {
        u32x4 y0[2], y1[2], v0[2], v1[2]; float cfv[2][16]; bf16_t ggv[2][16]; int colv[2], row0v[2], hv[2]; bool okv[2];
#pragma unroll
        for (int u = 0; u < 2; ++u) {
            const int r = r0 + u * nb * 8; okv[u] = r < NREAL;
            const int rr = okv[u] ? r : r0;
            const int bh = rr >> 8, c = (rr & 255) + 1, b = bh >> 3, h = bh & 7, uid = bh * NCHUNK + c;
            hv[u] = h; colv[u] = h * 64 + lane; row0v[u] = b * SEQ + c * 16;
            const unsigned char* rec = ws + OFF_CH + (size_t)uid * REC_BYTES;
            y0[u] = *(const u32x4*)(rec + RO_U0T + lane * 32); y1[u] = *(const u32x4*)(rec + RO_U0T + lane * 32 + 16);
            v0[u] = *(const u32x4*)(rec + RO_VT + lane * 32); v1[u] = *(const u32x4*)(rec + RO_VT + lane * 32 + 16);
#pragma unroll
            for (int t = 0; t < 16; ++t) { cfv[u][t] = COEF[(size_t)(row0v[u] + t) * 8 + h]; ggv[u][t] = Gb[(size_t)(row0v[u] + t) * 512 + colv[u]]; }
        }
#pragma unroll
        for (int u = 0; u < 2; ++u) {
            if (!okv[u]) continue;
            const int col = colv[u], row0 = row0v[u];
            const float lng = p.gin(21)[col], lnb = p.gin(22)[col];
            const unsigned yw[8] = {y0[u].x, y0[u].y, y0[u].z, y0[u].w, y1[u].x, y1[u].y, y1[u].z, y1[u].w}, vw[8] = {v0[u].x, v0[u].y, v0[u].z, v0[u].w, v1[u].x, v1[u].y, v1[u].z, v1[u].w};
#pragma unroll
            for (int t = 0; t < 16; ++t) {
                const float y = (t & 1) ? bfhi(yw[t >> 1]) : bflo(yw[t >> 1]);
                const float v = (t & 1) ? bfhi(vw[t >> 1]) : bflo(vw[t >> 1]);
                const float mean = wave_sum_dpp(y) * (1.0f / 64.0f);
                const float dlt = y - mean;
                const float var = wave_sum_dpp(dlt * dlt) * (1.0f / 64.0f);
                const float yn = dlt * rsqrtf(var + LNX_EPS) * lng + lnb;
                Z[(size_t)(row0 + t - NMETA) * 512 + col] = f2bf((yn + cfv[u][t] * v) * bf2f(ggv[u][t]));
            }
        }
    }
}

__device__ __forceinline__ void convert_expert_weights(const PPv& p, LAS unsigned char* lds, int first, int stride) {
    unsigned char* ws = p.gws();
    const int tid = threadIdx.x;
    LAS float* tile = (LAS float*)lds;
    const float* g2 = p.gin(27);
    bf16_t* WGU = (bf16_t*)(ws + OFF_WGU); bf16_t* WD = (bf16_t*)(ws + OFF_WD);
    constexpr int NBLK = NE * 3 * 64;
    const int lr = tid >> 6, lc = (tid & 63) * 4;
    f32x4 cur[8];
    int j = first;
    if (j >= NBLK) return;
    {
        const int mat = j >> 6, e = mat / 3, which = mat - 3 * e, bb = j & 63, kb = bb & 15, nbk = bb >> 4;
        const float* src = (which == 0 ? p.gin(30) : which == 1 ? p.gin(32) : p.gin(34)) + (size_t)e * 1024 * 1024 + (size_t)(kb * 64) * 1024 + nbk * 256;
#pragma unroll
        for (int i = 0; i < 8; ++i) cur[i] = __builtin_nontemporal_load((const f32x4*)(src + (size_t)(lr + 8 * i) * 1024 + lc));
    }
    for (;;) {
        const int jn = j + stride; const bool has_next = jn < NBLK;
        f32x4 nxt[8];
        if (has_next) {
            const int mat = jn >> 6, e = mat / 3, which = mat - 3 * e, bb = jn & 63, kb = bb & 15, nbk = bb >> 4;
            const float* src = (which == 0 ? p.gin(30) : which == 1 ? p.gin(32) : p.gin(34)) + (size_t)e * 1024 * 1024 + (size_t)(kb * 64) * 1024 + nbk * 256;
#pragma unroll
            for (int i = 0; i < 8; ++i) nxt[i] = __builtin_nontemporal_load((const f32x4*)(src + (size_t)(lr + 8 * i) * 1024 + lc));
        }
        const int mat = j >> 6, e = mat / 3, which = mat - 3 * e, bb = j & 63, kb = bb & 15, nbk = bb >> 4;
#pragma unroll
        for (int i = 0; i < 8; ++i) { LAS float* t = tile + (lr + 8 * i) * 257 + lc; t[0] = cur[i][0]; t[1] = cur[i][1]; t[2] = cur[i][2]; t[3] = cur[i][3]; }
        __syncthreads();
        {
            const int kq = tid & 7, k0 = kb * 64 + 8 * kq;
            float sc[8];
#pragma unroll
            for (int jj = 0; jj < 8; ++jj) sc[jj] = which < 2 ? g2[k0 + jj] : 1.0f;
#pragma unroll
            for (int i = 0; i < 4; ++i) {
                const int nn = (tid >> 3) + 64 * i, n = nbk * 256 + nn;
                float v[8];
#pragma unroll
                for (int jj = 0; jj < 8; ++jj) v[jj] = tile[(8 * kq + jj) * 257 + nn] * sc[jj];
                u32x4 w; w.x = cvt_pk_bf16(v[0], v[1]); w.y = cvt_pk_bf16(v[2], v[3]); w.z = cvt_pk_bf16(v[4], v[5]); w.w = cvt_pk_bf16(v[6], v[7]);
                bf16_t* dst = which < 2 ? WGU + (size_t)e * 2048 * 1024 + (size_t)(256 * (n >> 7) + 128 * which + (n & 127)) * 1024
                                        : WD + (size_t)e * 1024 * 1024 + (size_t)n * 1024;
                __builtin_nontemporal_store(w, (u32x4*)(dst + k0));
            }
        }
        __syncthreads();
        if (!has_next) break;
        j = jn;
#pragma unroll
        for (int i = 0; i < 8; ++i) cur[i] = nxt[i];
    }
}

__device__ __forceinline__ void phase_router(const PPv& p, LAS unsigned char* lds) {
    const int tid = threadIdx.x, bid = blockIdx.x, nb = gridDim.x, lane = tid & 63, wave = tid >> 6;
    unsigned char* ws = p.gws();
    const bf16_t* h1 = (const bf16_t*)(ws + OFF_HB2);
    const float* WRG = (const float*)(ws + OFF_WRG);
    const float* brt = p.gin(29);
    LAS float* slog = (LAS float*)lds;
    LAS float* srs = slog + 8 * 16 * 32;
    LAS int* lcnt = (LAS int*)(srs + 128);
    LAS int* gbase = lcnt + 32;
    LAS int* ltopi = gbase + 32;
    LAS int* lrank = ltopi + 512;
    int* TOPI = (int*)(ws + OFF_TOPI); float* TOPW = (float*)(ws + OFF_TOPW); int* RANK = (int*)(ws + OFF_RANK); float* RSTD2 = (float*)(ws + OFF_RSTD2);
    int* GCNT = (int*)(ws + OFF_GCNT);
    for (int tb = bid; tb < T / 128; tb += nb) {
        if (tid < 32) lcnt[tid] = 0;
        __syncthreads();
        const int t0 = tb * 128 + wave * 16;
        {
            const int row = lane & 15, kq = lane >> 4;
            const bf16_t* ap = h1 + (size_t)(t0 + row) * D + 4 * kq;
            const float* bp = WRG + (size_t)(4 * kq) * 32 + row;
            f32x4 acc0 = (f32x4){0.f, 0.f, 0.f, 0.f}, acc1 = acc0;
            float ss = 0.f;
            for (int j = 0; j < 64; ++j) {
                const u32x2 aw = *(const u32x2*)(ap + 16 * j);
                const f32x4 av = (f32x4){bflo(aw.x), bfhi(aw.x), bflo(aw.y), bfhi(aw.y)};
                ss += av[0] * av[0] + av[1] * av[1] + av[2] * av[2] + av[3] * av[3];
                const float* bj = bp + (size_t)(16 * j) * 32;
#pragma unroll
                for (int s = 0; s < 4; ++s) {
                    const float b0 = bj[s * 32], b1 = bj[s * 32 + 16];
                    acc0 = __builtin_amdgcn_mfma_f32_16x16x4f32(av[s], b0, acc0, 0, 0, 0);
                    acc1 = __builtin_amdgcn_mfma_f32_16x16x4f32(av[s], b1, acc1, 0, 0, 0);
                }
            }
            ss += __shfl_xor(ss, 16); ss += __shfl_xor(ss, 32);
#pragma unroll
            for (int reg = 0; reg < 4; ++reg) {
                slog[(wave * 16 + 4 * kq + reg) * 32 + row] = acc0[reg];
                slog[(wave * 16 + 4 * kq + reg) * 32 + 16 + row] = acc1[reg];
            }
            if (lane < 16) srs[wave * 16 + lane] = rsqrtf(ss * (1.0f / D) + NORM_EPS);
        }
        __syncthreads();
        if (lane < 16) {
            const int tl = wave * 16 + lane, t = tb * 128 + tl;
            const float rs = srs[tl];
            float lg[32];
#pragma unroll
            for (int e = 0; e < 32; ++e) lg[e] = slog[tl * 32 + e] * rs + brt[e];
            int ti[4]; float tv[4];
#pragma unroll
            for (int k = 0; k < 4; ++k) {
                float best = -3.0e38f; int bi = 0;
#pragma unroll
                for (int e = 0; e < 32; ++e) { const bool tk = lg[e] > best; best = tk ? lg[e] : best; bi = tk ? e : bi; }
                ti[k] = bi; tv[k] = best;
#pragma unroll
                for (int e = 0; e < 32; ++e) lg[e] = (e == bi) ? -3.0e38f : lg[e];
            }
            const float e0 = 1.0f, e1 = __expf(tv[1] - tv[0]), e2 = __expf(tv[2] - tv[0]), e3 = __expf(tv[3] - tv[0]);
            const float inv = 1.0f / (e0 + e1 + e2 + e3);
            *(f32x4*)(TOPW + (size_t)t * 4) = (f32x4){e0 * inv, e1 * inv, e2 * inv, e3 * inv};
            RSTD2[t] = rs;
#pragma unroll
            for (int k = 0; k < 4; ++k) { ltopi[tl * 4 + k] = ti[k]; lrank[tl * 4 + k] = __hip_atomic_fetch_add(lcnt + ti[k], 1, __ATOMIC_RELAXED, __HIP_MEMORY_SCOPE_WORKGROUP); }
        }
        __syncthreads();
        if (tid < 32) gbase[tid] = atomicAdd(GCNT + tid, lcnt[tid]);
        __syncthreads();
        {
            const int e = ltopi[tid];
            TOPI[(size_t)tb * 512 + tid] = e;
            RANK[(size_t)tb * 512 + tid] = gbase[e] + lrank[tid];
        }
        __syncthreads();
    }
}

__device__ __forceinline__ void phase_lists(const PPv& p, LAS unsigned char* lds) {
    const int tid = threadIdx.x, bid = blockIdx.x, nb = gridDim.x;
    unsigned char* ws = p.gws();
    LAS int* pstart = (LAS int*)lds;
    LAS int* cnt = pstart + 64;
    const int* GCNT = (const int*)(ws + OFF_GCNT);
    if (tid < 32) cnt[tid] = GCNT[tid];
    __syncthreads();
    if (tid == 0) { int s = 0; for (int e = 0; e < 32; ++e) { pstart[e] = s; s += ((cnt[e] + 255) >> 8) << 8; } pstart[32] = s; }
    __syncthreads();
    const int* TOPI = (const int*)(ws + OFF_TOPI); const float* TOPW = (const float*)(ws + OFF_TOPW); const int* RANK = (const int*)(ws + OFF_RANK); const float* RSTD2 = (const float*)(ws + OFF_RSTD2);
    int* ROWTOK = (int*)(ws + OFF_ROWTOK); int* ROWSLOT = (int*)(ws + OFF_ROWSLOT); float* ROWW = (float*)(ws + OFF_ROWW); float* ROWRS = (float*)(ws + OFF_ROWRS);
    for (int i = bid * 512 + tid; i < T * 4; i += nb * 512) {
        const int e = TOPI[i], pos = pstart[e] + RANK[i], t = i >> 2;
        ROWTOK[pos] = t; ROWSLOT[pos] = i; ROWW[pos] = TOPW[i]; ROWRS[pos] = RSTD2[t];
    }
    for (int e = bid; e < 32; e += nb) {
        for (int pos = pstart[e] + cnt[e] + tid; pos < pstart[e + 1]; pos += 512) { ROWTOK[pos] = 0; ROWSLOT[pos] = -1; ROWW[pos] = 0.f; ROWRS[pos] = 0.f; }
    }
    if (bid == 0) {
        int* TILEE = (int*)(ws + OFF_TILEE);
        const int ntiles = pstart[32] >> 8;
        for (int mt = tid; mt < ntiles; mt += 512) { int e = 0; for (int q = 0; q < 32; ++q) if (pstart[q] <= mt * 256) e = q; TILEE[mt] = e; }
        if (tid == 0) TILEE[1000] = ntiles;
    }
    __syncthreads();
}

__device__ __forceinline__ void phase_final(const PPv& p) {
    const int tid = threadIdx.x, bid = blockIdx.x, nb = gridDim.x, lane = tid & 63, wave = tid >> 6;
    unsigned char* ws = p.gws();
    const bf16_t* HB2 = (const bf16_t*)(ws + OFF_HB2);
    const bf16_t* YA = (const bf16_t*)p.gout(); const bf16_t* YB = (const bf16_t*)(ws + OFF_WGU);
    const float* gf = p.gin(36);
    const f32x4 ga0 = *(const f32x4*)(gf + 8 * lane), ga1 = *(const f32x4*)(gf + 8 * lane + 4), gb0 = *(const f32x4*)(gf + 512 + 8 * lane), gb1 = *(const f32x4*)(gf + 512 + 8 * lane + 4);
    for (int t0 = (bid * 8 + wave) * 2; t0 < T; t0 += nb * 16) {
        u32x4 ha[2], hb[2], ya[2][4], yb[2][4];
#pragma unroll
        for (int u = 0; u < 2; ++u) {
            const int t = t0 + u;
            ha[u] = __builtin_nontemporal_load((const u32x4*)(HB2 + (size_t)t * D + 8 * lane)); hb[u] = __builtin_nontemporal_load((const u32x4*)(HB2 + (size_t)t * D + 512 + 8 * lane));
#pragma unroll
            for (int k = 0; k < 4; ++k) { ya[u][k] = __builtin_nontemporal_load((const u32x4*)(YA + (size_t)(4 * t + k) * 512 + 8 * lane)); yb[u][k] = __builtin_nontemporal_load((const u32x4*)(YB + (size_t)(4 * t + k) * 512 + 8 * lane)); }
        }
#pragma unroll
        for (int u = 0; u < 2; ++u) {
            const int t = t0 + u;
            float va[8] = {bflo(ha[u].x), bfhi(ha[u].x), bflo(ha[u].y), bfhi(ha[u].y), bflo(ha[u].z), bfhi(ha[u].z), bflo(ha[u].w), bfhi(ha[u].w)};
            float vb[8] = {bflo(hb[u].x), bfhi(hb[u].x), bflo(hb[u].y), bfhi(hb[u].y), bflo(hb[u].z), bfhi(hb[u].z), bflo(hb[u].w), bfhi(hb[u].w)};
#pragma unroll
            for (int k = 0; k < 4; ++k) {
                const u32x4 a4 = ya[u][k], b4 = yb[u][k];
                va[0] += bflo(a4.x); va[1] += bfhi(a4.x); va[2] += bflo(a4.y); va[3] += bfhi(a4.y); va[4] += bflo(a4.z); va[5] += bfhi(a4.z); va[6] += bflo(a4.w); va[7] += bfhi(a4.w);
                vb[0] += bflo(b4.x); vb[1] += bfhi(b4.x); vb[2] += bflo(b4.y); vb[3] += bfhi(b4.y); vb[4] += bflo(b4.z); vb[5] += bfhi(b4.z); vb[6] += bflo(b4.w); vb[7] += bfhi(b4.w);
            }
            float ss = 0.f;
#pragma unroll
            for (int j = 0; j < 8; ++j) ss += va[j] * va[j] + vb[j] * vb[j];
            ss = wave_sum_dpp(ss);
            const float rs = rsqrtf(ss * (1.0f / D) + NORM_EPS);
            float* o = p.gout() + (size_t)t * D;
            __builtin_nontemporal_store((f32x4){va[0] * rs * ga0[0], va[1] * rs * ga0[1], va[2] * rs * ga0[2], va[3] * rs * ga0[3]}, (f32x4*)(o + 8 * lane));
            __builtin_nontemporal_store((f32x4){va[4] * rs * ga1[0], va[5] * rs * ga1[1], va[6] * rs * ga1[2], va[7] * rs * ga1[3]}, (f32x4*)(o + 8 * lane + 4));
            __builtin_nontemporal_store((f32x4){vb[0] * rs * gb0[0], vb[1] * rs * gb0[1], vb[2] * rs * gb0[2], vb[3] * rs * gb0[3]}, (f32x4*)(o + 512 + 8 * lane));
            __builtin_nontemporal_store((f32x4){vb[4] * rs * gb1[0], vb[5] * rs * gb1[1], vb[6] * rs * gb1[2], vb[7] * rs * gb1[3]}, (f32x4*)(o + 512 + 8 * lane + 4));
        }
    }
}

#define XB_TMO      128
#define XB_XCNT(j)  (256  + 64 * (j))
#define XB_XSUB(j)  (1280 + 64 * (j))
#define XB_XGEN(j)  (2304 + 64 * (j))
#define XB_TOP      3328
#define XB_TOPGEN   3392
#define XCD_BAR_WORDS 3456
#define XB_SPIN_CAP (1u << 18)
__device__ __forceinline__ unsigned xb_ld(unsigned* p)              { return __hip_atomic_load(p, __ATOMIC_RELAXED, __HIP_MEMORY_SCOPE_AGENT); }
__device__ __forceinline__ unsigned xb_add(unsigned* p, unsigned v) { return __hip_atomic_fetch_add(p, v, __ATOMIC_RELAXED, __HIP_MEMORY_SCOPE_AGENT); }
__device__ __forceinline__ unsigned xb_xcc_id() { return (unsigned)__builtin_amdgcn_s_getreg((3 << 11) | 20) & 0xFu; }
#define XB_SPIN(cond, bar) do { unsigned _sp = 0; while (cond) { __builtin_amdgcn_s_sleep(1); \
    if ((++_sp & 255u) == 0u) { if (xb_ld(&(bar)[XB_TMO])) break; if (_sp > XB_SPIN_CAP) { atomicAdd(&(bar)[XB_TMO], 1u); break; } } } } while (0)
struct XcdBarrier { unsigned* bar; unsigned x; volatile LAS unsigned* st; };
__device__ __forceinline__ XcdBarrier xcd_barrier_post(unsigned* bar, volatile LAS unsigned* st) {
    XcdBarrier b; b.bar = bar; b.x = xb_xcc_id(); b.st = st;
    if (threadIdx.x == 0) (void)xb_add(&bar[XB_XCNT(b.x)], 1u);
    return b;
}
__device__ __forceinline__ void xcd_barrier_complete(unsigned* bar, unsigned x, unsigned& nloc, unsigned& nx) {
    const unsigned G = gridDim.x * gridDim.y * gridDim.z;
    unsigned sum, cnt, mine, sp = 0u;
    for (;;) {
        sum = 0u; cnt = 0u; mine = 0u;
#pragma unroll
        for (unsigned j = 0; j < 16; ++j) { const unsigned c = xb_ld(&bar[XB_XCNT(j)]); sum += c; cnt += (c > 0u) ? 1u : 0u; mine = (j == x) ? c : mine; }
        if (sum == G) break;
        __builtin_amdgcn_s_sleep(1);
        if ((++sp & 255u) == 0u) { if (xb_ld(&bar[XB_TMO])) break; if (sp > XB_SPIN_CAP) { atomicAdd(&bar[XB_TMO], 1u); break; } }
    }
    nloc = mine > 0u ? mine : 1u; nx = cnt > 0u ? cnt : 1u;
}
__device__ __forceinline__ void xcd_barrier(const XcdBarrier& b) {
    asm volatile("s_waitcnt vmcnt(0)" ::: "memory");
    __syncthreads();
    if (threadIdx.x == 0) {
        unsigned* bar = b.bar;
        __builtin_amdgcn_s_waitcnt(0);
        unsigned nloc = b.st[0], nx = b.st[1];
        if (nloc == 0u) { xcd_barrier_complete(bar, b.x, nloc, nx); b.st[0] = nloc; b.st[1] = nx; }
        const unsigned old = xb_add(&bar[XB_XSUB(b.x)], 1u);
        const unsigned gen = old / nloc;
        if (old + 1u == (gen + 1u) * nloc) {
            __builtin_amdgcn_fence(__ATOMIC_RELEASE, "agent");
            asm volatile("s_waitcnt vmcnt(0)" ::: "memory");
            const unsigned og = xb_add(&bar[XB_TOP], 1u);
            const unsigned tg = og / nx;
            if (og + 1u == (tg + 1u) * nx) xb_add(&bar[XB_TOPGEN], 1u);
            else XB_SPIN(xb_ld(&bar[XB_TOPGEN]) == tg, bar);
            __builtin_amdgcn_fence(__ATOMIC_ACQUIRE, "agent");
            xb_add(&bar[XB_XGEN(b.x)], 1u);
            asm volatile("s_waitcnt vmcnt(0)" ::: "memory");
        } else {
            XB_SPIN(xb_ld(&bar[XB_XGEN(b.x)]) == gen, bar);
            __builtin_amdgcn_fence(__ATOMIC_ACQUIRE, "agent");
            asm volatile("s_waitcnt vmcnt(0)" ::: "memory");
        }
    }
    __syncthreads();
}

constexpr int N_PHASES = 15;
__global__ void __launch_bounds__(512, 2) mega(Params p) {
    extern __shared__ __attribute__((aligned(16))) unsigned char lds_raw[];
    LAS unsigned char* lds = (LAS unsigned char*)lds_raw;
    cg::grid_group grid = cg::this_grid();
    unsigned char* ws = getpp().gws();
    const int G = gridDim.x, bid = blockIdx.x;
#ifndef ONLY_PHASE
#define ONLY_PHASE -1
#endif
#define IN(k) ((ONLY_PHASE < 0 || ONLY_PHASE == (k)) && p.ph_lo <= (k) && (k) < p.ph_hi)
    volatile LAS unsigned* xst = (volatile LAS unsigned*)(lds + 163840 - 16);
    if (threadIdx.x < 4) xst[threadIdx.x] = 0u;
    __syncthreads();
    const XcdBarrier xbar = xcd_barrier_post((unsigned*)(ws + OFF_BAR), xst);
    if (p.ph_hi < 0) grid.sync();
#define SEAM(k) do { if ((k) + 1 < p.ph_hi) xcd_barrier(xbar); } while (0)
    if (IN(0)) { const PPv q = getpp(); phase_prep(q, lds); SEAM(0); }
    if (IN(1)) { const PPv q = getpp();
        phase_meta_proj(q, lds);
        StaticOrder S; S.init(ws + OFF_HB, ws + OFF_WIN, T, NCOLS1, 1024, G, bid);
        EpiProj E{(bf16_t*)(ws + OFF_PRKV), (bf16_t*)(ws + OFF_PCONV), (bf16_t*)q.gout(), (const float*)(ws + OFF_RSTD1)};
        gemm_phase<false>(lds, 1024, S, E);
        SEAM(1);
    }
    if (IN(2)) { const PPv q = getpp(); phase_lprep_conv(q); SEAM(2); }
    if (IN(3)) { const PPv q = getpp();
        StaticOrder S; S.init(ws + OFF_L, ws + OFF_W2, NRP, 1536, 256, G, bid);
        EpiL E{ws, q.gin(10), q.gin(13)};
        gemm_phase<false>(lds, 256, S, E);
        SEAM(3);
    }
    if (IN(4)) { const PPv q = getpp(); phase_scanprep(q, lds); SEAM(4); }
    if (IN(5)) { const PPv q = getpp(); phase_recur(q, lds); SEAM(5); }
    if (IN(6)) { const PPv q = getpp(); phase_gn(q); SEAM(6); }
    if (IN(7)) { const PPv q = getpp();
        MergeOrder S; S.so.init(ws + OFF_Z, ws + OFF_WR, T, 1024, 512, G, bid); S.A1 = (const char*)(ws + OFF_C); S.B1 = (const char*)(ws + OFF_WC);
        EpiMergeFused E{(bf16_t*)(ws + OFF_MERGED), (const bf16_t*)q.gout()};
        gemm_phase<false>(lds, 512, S, E);
        SEAM(7);
    }
    if (IN(9)) { const PPv q = getpp();
        StaticOrder S; S.init(ws + OFF_MERGED, ws + OFF_WO, T, 1024, 1024, G, bid);
        EpiO E{q.gin(0), q.gout(), (bf16_t*)(ws + OFF_HB2)};
        gemm_phase<false>(lds, 1024, S, E);
        SEAM(9);
    }
    if (IN(10)) { const PPv q = getpp(); phase_router(q, lds); SEAM(10); }
    if (IN(11)) { const PPv q = getpp(); phase_lists(q, lds); SEAM(11); }
    if (IN(12)) { const PPv q = getpp();
        const int* TILEE = (const int*)(ws + OFF_TILEE);
        MoeOrder S; S.A = (const char*)(ws + OFF_HB2); S.Bt = (const char*)(ws + OFF_WGU); S.K = 1024; S.estride = (size_t)2048 * 1024 * 2;
        S.tile_e = TILEE; S.rowtok = (const int*)(ws + OFF_ROWTOK); S.ntiles = TILEE[1000]; S.nnt = 8; S.G = G; S.c = bid; S.gather = true;
        EpiMoe1 E{(bf16_t*)(ws + OFF_ACT), (const float*)(ws + OFF_ROWRS), q.gin(31), q.gin(33)};
        gemm_phase<true>(lds, 1024, S, E);
        SEAM(12);
    }
    if (IN(13)) { const PPv q = getpp();
        const int* TILEE = (const int*)(ws + OFF_TILEE);
        MoeOrder S; S.A = (const char*)(ws + OFF_ACT); S.Bt = (const char*)(ws + OFF_WD); S.K = 1024; S.estride = (size_t)1024 * 1024 * 2;
        S.tile_e = TILEE; S.rowtok = nullptr; S.ntiles = TILEE[1000]; S.nnt = 4; S.G = G; S.c = bid; S.gather = false;
        EpiMoe2 E{(bf16_t*)q.gout(), (bf16_t*)(ws + OFF_WGU), (const int*)(ws + OFF_ROWSLOT), (const float*)(ws + OFF_ROWW), q.gin(35)};
        gemm_phase<false>(lds, 1024, S, E);
        SEAM(13);
    }
    if (IN(14)) { const PPv q = getpp(); phase_final(q); }
}

extern "C" void kernel_launch(void* const* d_in, const int* in_sizes, int n_in, void* d_out, int out_size, void* d_ws, size_t ws_size,
                              hipStream_t stream) {
    constexpr size_t kDynLds = 160 * 1024;
    static int grid_blocks = 0;
    if (!grid_blocks) {
        int dev = 0, cus = 0, per_cu = 0;
        (void)hipGetDevice(&dev);
        (void)hipDeviceGetAttribute(&cus, hipDeviceAttributeMultiprocessorCount, dev);
        (void)hipFuncSetAttribute((const void*)mega, hipFuncAttributeMaxDynamicSharedMemorySize, (int)kDynLds);
        (void)hipOccupancyMaxActiveBlocksPerMultiprocessor(&per_cu, mega, 512, kDynLds);
        if (per_cu > 1) per_cu = 1;
        grid_blocks = cus * per_cu;
        fprintf(stderr, "cus=%d per_cu=%d ws_size=%zu need=%zu\n", cus, per_cu, ws_size, (size_t)WS_NEED);
    }
    if (ws_size < WS_NEED || n_in < 37 || grid_blocks < 64) { fprintf(stderr, "kernel_launch: unsupported configuration\n"); return; }
    Params p{};
    for (int i = 0; i < 37; ++i) p.in[i] = (const float*)d_in[i];
    p.out = (float*)d_out;
    p.ws = (unsigned char*)d_ws;
    p.ph_lo = 0; p.ph_hi = N_PHASES;
    (void)hipMemsetAsync((unsigned char*)d_ws + OFF_BAR, 0, 16384, stream);
    void* args[] = {&p};
    hipError_t e = hipLaunchCooperativeKernel((void*)mega, dim3(grid_blocks), dim3(512), args, kDynLds, stream);
    if (e != hipSuccess) fprintf(stderr, "cooperative launch failed: %s (grid %d)\n", hipGetErrorString(e), grid_blocks);
}
```

```cpp
#include <hip/hip_runtime.h>
#include <hip/hip_cooperative_groups.h>
#include <cstdio>
namespace cg = cooperative_groups;

#define LAS __attribute__((address_space(3)))
typedef unsigned short bf16_t;
typedef short bf16x8 __attribute__((ext_vector_type(8)));
typedef float f32x4 __attribute__((ext_vector_type(4)));
typedef float f32x2 __attribute__((ext_vector_type(2)));
typedef unsigned u32x4 __attribute__((ext_vector_type(4)));
typedef unsigned u32x2 __attribute__((ext_vector_type(2)));

constexpr int D = 1024, NBATCH = 8, SEQ = 4096, NMETA = 16;
constexpr int T = NBATCH * SEQ;
constexpr int NR = T + NMETA;
constexpr int NRP = 33024;
constexpr int PCOLS1 = 3584;
constexpr int NCOLS1 = 5632;
constexpr int NE = 32, TOPK = 4, DFF = 1024;
constexpr int MAXROWS = T * TOPK + NE * 256;
constexpr int MAXTILES = MAXROWS / 256;
constexpr float NORM_EPS = 1e-5f, LNX_EPS = 64e-5f;

constexpr int NCHUNK = 257, NUNITS = 64 * NCHUNK;
constexpr int REC_BYTES = 13568;
constexpr int RO_WH = 0, RO_RT = 2048, RO_U0T = 4096, RO_VT = 6144, RO_BKT = 8192, RO_ARK = 12288, RO_WCC = 13312;
constexpr int SLOT_BYTES = 15680, SO_G = 13568, SO_COEF = 15616, NSLOT = 9;
constexpr size_t SZ_ACT = (size_t)MAXROWS * 1024 * 2;
constexpr size_t SZ_WGU = (size_t)NE * 2048 * 1024 * 2;
constexpr size_t SZ_WD = (size_t)NE * 1024 * 1024 * 2;
constexpr size_t SZ_HB = (size_t)T * 1024 * 2;
constexpr size_t OFF_WGU = 0;
constexpr size_t OFF_WD = OFF_WGU + SZ_WGU;
constexpr size_t OFF_ACT = OFF_WD + SZ_WD;
constexpr size_t OFF_HB2 = OFF_ACT + SZ_ACT;
constexpr size_t OFF_RT = OFF_HB2 + SZ_HB;
constexpr size_t OFF_TOPI = OFF_RT;
constexpr size_t OFF_TOPW = OFF_TOPI + (size_t)T * 16;
constexpr size_t OFF_RANK = OFF_TOPW + (size_t)T * 16;
constexpr size_t OFF_RSTD2 = OFF_RANK + (size_t)T * 16;
constexpr size_t OFF_ROWTOK = OFF_RSTD2 + (size_t)T * 4;
constexpr size_t OFF_ROWSLOT = OFF_ROWTOK + (size_t)MAXROWS * 4;
constexpr size_t OFF_ROWW = OFF_ROWSLOT + (size_t)MAXROWS * 4;
constexpr size_t OFF_ROWRS = OFF_ROWW + (size_t)MAXROWS * 4;
constexpr size_t OFF_TILEE = OFF_ROWRS + (size_t)MAXROWS * 4;
constexpr size_t OFF_GCNT = OFF_TILEE + 4096;
constexpr size_t OFF_SM = OFF_GCNT + 256;
constexpr size_t OFF_WR = OFF_SM;
constexpr size_t OFF_WC = OFF_WR + (size_t)1024 * 512 * 2;
constexpr size_t OFF_WO = OFF_WC + (size_t)1024 * 512 * 2;
constexpr size_t OFF_W2 = OFF_WO + (size_t)1024 * 1024 * 2;
constexpr size_t OFF_RSTD1 = OFF_W2 + (size_t)1536 * 256 * 2;
constexpr size_t OFF_WRG = OFF_RSTD1 + (size_t)NRP * 4;
constexpr size_t OFF_BAR = OFF_WRG + (size_t)1024 * 32 * 4;
constexpr size_t WS_NEED = OFF_BAR + 16384;
constexpr size_t OFF_PRKV = 0;
constexpr size_t SZ_PRKV = (size_t)NR * 1536 * 2;
constexpr size_t OFF_LD = OFF_PRKV + SZ_PRKV;
constexpr size_t OFF_A = OFF_LD + (size_t)NRP * 512 * 4;
constexpr size_t OFF_CH = OFF_A + (size_t)NRP * 512 * 2;
constexpr size_t OFF_PCONV = OFF_CH;
constexpr size_t SZ_PCONV = (size_t)NR * 2048 * 2;
constexpr size_t OFF_HB = OFF_PCONV + SZ_PCONV;
constexpr size_t OFF_L = OFF_HB + SZ_HB;
constexpr size_t OFF_WIN = OFF_L + (size_t)NRP * 256 * 2;
constexpr size_t CH_END = OFF_WIN + (size_t)NCOLS1 * 1024 * 2;
constexpr size_t OFF_MERGED = OFF_CH;
constexpr size_t OFF_G = CH_END;
constexpr size_t OFF_C = OFF_G + (size_t)NRP * 512 * 2;
constexpr size_t OFF_Z = OFF_C + (size_t)T * 512 * 2;
constexpr size_t OFF_COEF = OFF_Z + (size_t)T * 512 * 2;
constexpr size_t EARLY_END = OFF_COEF + (size_t)NR * 8 * 4;
static_assert(EARLY_END <= OFF_RT, "early buffers overflow");
static_assert(OFF_CH + (size_t)NUNITS * REC_BYTES <= CH_END, "chunk records overflow");
static_assert(OFF_CH >= OFF_WD + SZ_WD, "expert weights (written during the scan) must not touch live scan buffers");
static_assert(OFF_MERGED + SZ_HB <= OFF_HB2, "layout");
static_assert(OFF_PRKV % 16 == 0 && OFF_LD % 16 == 0 && OFF_A % 16 == 0 && OFF_CH % 16 == 0 && OFF_HB % 16 == 0 && OFF_L % 16 == 0 && OFF_WIN % 16 == 0 && OFF_G % 16 == 0 && OFF_C % 16 == 0 && OFF_Z % 16 == 0 && OFF_COEF % 16 == 0, "align");

#define GAS __attribute__((address_space(1)))
#define CAS __attribute__((address_space(4)))
struct Params {
    const float* in[37];
    float* out;
    unsigned char* ws;
    int ph_lo, ph_hi;
};
struct ParamsD {
    const GAS float* in[37];
    GAS float* out;
    GAS unsigned char* ws;
    int ph_lo, ph_hi;
};
static_assert(sizeof(Params) == sizeof(ParamsD), "argument views");
struct PPv {
    const CAS ParamsD* k;
    __device__ __forceinline__ const float* gin(int i) const { return (const float*)k->in[i]; }
    __device__ __forceinline__ float* gout() const { return (float*)k->out; }
    __device__ __forceinline__ unsigned char* gws() const { return (unsigned char*)k->ws; }
};
__device__ __forceinline__ PPv getpp() { const CAS ParamsD* k = (const CAS ParamsD*)__builtin_amdgcn_kernarg_segment_ptr(); asm volatile("" : "+s"(k)); return PPv{k}; }

typedef __bf16 bf16x2v __attribute__((ext_vector_type(2)));
__device__ __forceinline__ unsigned cvt_pk_bf16(float lo, float hi) { const f32x2 v = {lo, hi}; return __builtin_bit_cast(unsigned, __builtin_convertvector(v, bf16x2v)); }
__device__ __forceinline__ bf16_t f2bf(float f) { unsigned u = __float_as_uint(f); u += 0x7FFFu + ((u >> 16) & 1u); return (bf16_t)(u >> 16); }
__device__ __forceinline__ float bf2f(bf16_t b) { return __uint_as_float(((unsigned)b) << 16); }
__device__ __forceinline__ float bflo(unsigned w) { return __uint_as_float(w << 16); }
__device__ __forceinline__ float bfhi(unsigned w) { return __uint_as_float(w & 0xFFFF0000u); }
__device__ __forceinline__ float sigmoidf_(float x) { return __builtin_amdgcn_rcpf(1.0f + __expf(-x)); }
__device__ __forceinline__ float wave_sum(float v) {
#pragma unroll
    for (int o = 32; o >= 1; o >>= 1) v += __shfl_xor(v, o);
    return v;
}
__device__ __forceinline__ float wave_sum_dpp(float v);
__device__ __forceinline__ int prev_row(int row, int d) {
    if (row < NMETA) return row - d >= 0 ? row - d : -1;
    const int s = (row - NMETA) & (SEQ - 1);
    return s >= d ? row - d : NMETA + s - d;
}

constexpr int BM = 256, BK = 64, HALF = 128, HTB = HALF * BK * 2, STAGE_BYTES = 8 * HTB, NXCD = 8, WGM = 8;
__device__ __forceinline__ int lds_byte(int r, int c) { const int st = (r >> 4) * 2 + (c >> 5), rr = r & 15, cc = c & 31, ob = rr * 64 + cc * 2; return st * 1024 + (ob ^ (((ob >> 9) & 1) << 5)); }
__device__ __forceinline__ void stage_rc(int b, int& R, int& C) { const int st = b / 1024, sb = b % 1024, swz = sb ^ (((sb >> 9) & 1) << 5); R = (st >> 1) * 16 + swz / 64; C = (st & 1) * 32 + (swz % 64) / 2; }
__device__ __forceinline__ int perm32(int rho) { const int n = rho >> 4, i = rho & 15; return 8 * (i >> 2) + 4 * n + (i & 3); }

struct Unit { int pm, pn, aux; };

struct StaticOrder {
    const char* A; const char* Bt; int K;
    int nM, nN, nwg, G, c;
    __device__ void init(const void* A_, const void* Bt_, int M, int N, int K_, int G_, int c_) { A = (const char*)A_; Bt = (const char*)Bt_; K = K_; nM = M / BM; nN = N / BM; nwg = nM * nN; G = G_; c = c_; }
    __device__ bool next(int i, Unit& u) const {
        const long L = (long)i * G + c; if (L >= nwg) return false;
        int wgid = (int)L; { const int q = nwg / NXCD, r = nwg % NXCD, xcd = wgid % NXCD, off = wgid / NXCD; wgid = (xcd < r ? xcd * (q + 1) : r * (q + 1) + (xcd - r) * q) + off; }
        const int nig = WGM * nN, gid = wgid / nig, fm = gid * WGM, gsz = (nM - fm) < WGM ? (nM - fm) : WGM;
        u.pm = fm + ((wgid % nig) % gsz); u.pn = (wgid % nig) / gsz; u.aux = 0; return true;
    }
    __device__ __forceinline__ const char* a_ptr(const Unit& u) const { return A + (size_t)u.pm * 256 * K * 2; }
    __device__ __forceinline__ const char* b_ptr(const Unit& u) const { return Bt + (size_t)u.pn * 256 * K * 2; }
    __device__ __forceinline__ int gather_row(const Unit&, int) const { return 0; }
    __device__ __forceinline__ const void* gather_src(const Unit&, int) const { return nullptr; }
};
struct MoeOrder {
    const char* A; const char* Bt; int K; size_t estride;
    const int* tile_e; const int* rowtok; int ntiles, nnt, G, c; bool gather;
    __device__ bool next(int i, Unit& u) const {
        int mt, nt;
        if ((G & 7) == 0 && ((G >> 3) % nnt) == 0) {
            const int x = c & 7, j = c >> 3, per = (G >> 3) / nnt;
            mt = (i * 8 + x) * per + j / nnt; nt = j % nnt;
        } else { const long L = (long)i * G + c; mt = (int)(L / nnt); nt = (int)(L % nnt); }
        if (mt >= ntiles) return false;
        u.pm = mt; u.pn = nt; u.aux = tile_e[mt]; return true;
    }
    __device__ __forceinline__ const char* a_ptr(const Unit& u) const { return gather ? A : A + (size_t)u.pm * 256 * K * 2; }
    __device__ __forceinline__ const char* b_ptr(const Unit& u) const { return Bt + (size_t)u.aux * estride + (size_t)u.pn * 256 * K * 2; }
    __device__ __forceinline__ int gather_row(const Unit& u, int r) const { return rowtok[u.pm * 256 + r]; }
    __device__ __forceinline__ const void* gather_src(const Unit& u, int lane) const { return rowtok + u.pm * 256 + lane * 4; }
};

template <bool GATHER, class Epi, class Sched>
__device__ __forceinline__ void gemm_phase(LAS unsigned char* lds, const int K_, const Sched& S, const Epi& E) {
    int K = K_; asm volatile("" : "+s"(K));
    const int tid = threadIdx.x, wid = __builtin_amdgcn_readfirstlane(tid >> 6), lane = tid & 63, wr = wid >> 2, wc = wid & 3, fr = lane & 15, fq = lane >> 4;
    const int nt = K / BK;
    unsigned voffA[2], voffB[2]; int Rr[2], Cc[2];
#pragma unroll
    for (int i = 0; i < 2; ++i) { int R, C; stage_rc(tid * 16 + i * 8192, R, C); const int Rb = (R & ~31) + perm32(R & 31);
        Rr[i] = R; Cc[i] = C; voffA[i] = (unsigned)(R * K + C) * 2u; voffB[i] = (unsigned)(Rb * K + C) * 2u; }
    const size_t kstep = (size_t)(BK * 2);
    const size_t hstep = (size_t)HALF * K * 2;
    const unsigned ldsw = (unsigned)wid * 1024u;
    const int aoff = lds_byte(wr * 64 + fr, fq * 8), boff = lds_byte(wc * 32 + fr, fq * 8);
    unsigned vgc[2][2], vgn[2][2];
    LAS unsigned char* const parbase = lds + STAGE_BYTES;
    constexpr int NPAR = Epi::NPAR;
#define G_PAR_ISSUE(unit, uidx, hasnx, nxunit) do { \
        LAS unsigned char* _ps = parbase + ((uidx) & 1) * 4096; \
        if (wid < NPAR) __builtin_amdgcn_global_load_lds((const unsigned*)E.par_src(unit, wid, lane), (LAS unsigned*)(_ps + wid * 1024), 16, 0, 0); \
        if (GATHER && (hasnx) && wid == NPAR) __builtin_amdgcn_global_load_lds((const unsigned*)S.gather_src(nxunit, lane), (LAS unsigned*)(_ps + NPAR * 1024), 16, 0, 0); } while (0)
#define G_SA(b, h) (((b) * 2 + (h)) * HTB)
#define G_SB(b, h) ((4 + (b) * 2 + (h)) * HTB)
#define G_STAGE(bufoff, gbase, voff) do { _Pragma("unroll") for (int _i = 0; _i < 2; ++_i) \
        __builtin_amdgcn_global_load_lds((const unsigned*)((const char*)(gbase) + (voff)[_i]), (LAS unsigned*)(lds + (bufoff) + ldsw + _i * 8192), 16, 0, 0); } while (0)
#define G_STAGE_A(bufoff, kptr, h, VG) do { if (GATHER) { G_STAGE(bufoff, kptr, VG[h]); } else { G_STAGE(bufoff, (kptr) + (h) * hstep, voffA); } } while (0)
#define G_LDA(dst, b, h) do { _Pragma("unroll") for (int m = 0; m < 4; ++m) _Pragma("unroll") for (int k = 0; k < 2; ++k) dst[m][k] = *(const LAS bf16x8*)(lds + G_SA(b, h) + aoff + m * 2048 + k * 1024); } while (0)
#define G_LDB(dst, b, h) do { _Pragma("unroll") for (int n = 0; n < 2; ++n) _Pragma("unroll") for (int k = 0; k < 2; ++k) dst[n][k] = *(const LAS bf16x8*)(lds + G_SB(b, h) + boff + n * 2048 + k * 1024); } while (0)
#define G_MMA(ai, bj, At, Bt) do { __builtin_amdgcn_s_setprio(1); _Pragma("unroll") for (int m = 0; m < 4; ++m) _Pragma("unroll") for (int n = 0; n < 2; ++n) _Pragma("unroll") for (int k = 0; k < 2; ++k) \
        acc[ai][bj][m][n] = __builtin_amdgcn_mfma_f32_16x16x32_bf16(Bt[n][k], At[m][k], acc[ai][bj][m][n], 0, 0, 0); __builtin_amdgcn_s_setprio(0); } while (0)
#define G_WAIT_V(n) asm volatile("s_waitcnt vmcnt(" #n ")" ::: "memory")
#define G_WAIT_L(n) asm volatile("s_waitcnt lgkmcnt(" #n ")" ::: "memory")
#define G_BAR __builtin_amdgcn_s_barrier()
#define G_SCHED __builtin_amdgcn_sched_barrier(0)
    Unit cur, nxt;
    int ui = 0;
    if (!S.next(0, cur)) return;
    f32x4 acc[2][2][4][2];
#pragma unroll
    for (int a = 0; a < 2; ++a)
#pragma unroll
        for (int b = 0; b < 2; ++b)
#pragma unroll
            for (int m = 0; m < 4; ++m)
#pragma unroll
                for (int n = 0; n < 2; ++n) acc[a][b][m][n] = (f32x4){0.f, 0.f, 0.f, 0.f};
    bf16x8 At[4][2], B0[2][2], B1[2][2];
    const char* cA = S.a_ptr(cur); const char* cB = S.b_ptr(cur);
    if (GATHER) {
#pragma unroll
        for (int h = 0; h < 2; ++h)
#pragma unroll
            for (int i = 0; i < 2; ++i) vgc[h][i] = (unsigned)(S.gather_row(cur, h * HALF + Rr[i]) * K + Cc[i]) * 2u;
    }
    { Unit n1; const bool hn1 = S.next(1, n1); G_PAR_ISSUE(cur, 0, hn1, n1); }
    G_STAGE(G_SB(0, 0), cB, voffB); G_STAGE_A(G_SA(0, 0), cA, 0, vgc); G_STAGE(G_SB(0, 1), cB + hstep, voffB); G_STAGE_A(G_SA(0, 1), cA, 1, vgc);
    if (wr == 1) G_BAR;
    G_WAIT_V(4); G_BAR;
    G_STAGE(G_SB(1, 0), cB + kstep, voffB); G_STAGE_A(G_SA(1, 0), cA + kstep, 0, vgc); G_STAGE(G_SB(1, 1), cB + hstep + kstep, voffB);
    G_WAIT_V(6); G_BAR;
    for (;;) {
        const bool has_next = S.next(ui + 1, nxt);
        const char* nA = has_next ? S.a_ptr(nxt) : cA; const char* nB = has_next ? S.b_ptr(nxt) : cB;
        if (ui > 0) G_PAR_ISSUE(cur, ui, has_next, nxt);
        if (GATHER) {
#pragma unroll
            for (int h = 0; h < 2; ++h)
#pragma unroll
                for (int i = 0; i < 2; ++i) vgn[h][i] = vgc[h][i];
        }
        for (int t = 0; t < nt; t += 2) {
            const bool last = (t == nt - 2);
            const char* a1 = cA + (size_t)(t + 1) * kstep;
            const char* a2 = last ? nA : cA + (size_t)(t + 2) * kstep; const char* b2 = last ? nB : cB + (size_t)(t + 2) * kstep;
            const char* a3 = a2 + kstep; const char* b3 = b2 + kstep;
            unsigned vg2[2][2];
            if (GATHER) {
#pragma unroll
                for (int h = 0; h < 2; ++h)
#pragma unroll
                    for (int i = 0; i < 2; ++i) vg2[h][i] = last ? vgn[h][i] : vgc[h][i];
            }
            G_LDB(B0, 0, 0); G_SCHED; G_LDA(At, 0, 0); G_STAGE_A(G_SA(1, 1), a1, 1, vgc);
            G_WAIT_L(8); G_BAR; G_WAIT_L(0); G_MMA(0, 0, At, B0); G_BAR; G_SCHED;
            G_LDB(B1, 0, 1); G_STAGE(G_SB(0, 0), b2, voffB);
            G_BAR; G_WAIT_L(0); G_MMA(0, 1, At, B1); G_BAR;
            G_LDA(At, 0, 1); G_STAGE_A(G_SA(0, 0), a2, 0, vg2);
            G_BAR; G_WAIT_L(0); G_MMA(1, 0, At, B0); G_BAR; G_SCHED;
            G_STAGE(G_SB(0, 1), b2 + hstep, voffB);
            G_WAIT_V(6); G_BAR; G_MMA(1, 1, At, B1); G_BAR;
            G_LDB(B0, 1, 0); G_SCHED; G_LDA(At, 1, 0); G_STAGE_A(G_SA(0, 1), a2, 1, vg2);
            G_WAIT_L(8); G_BAR; G_WAIT_L(0); G_MMA(0, 0, At, B0); G_BAR; G_SCHED;
            G_LDB(B1, 1, 1); G_STAGE(G_SB(1, 0), b3, voffB);
            G_BAR; G_WAIT_L(0); G_MMA(0, 1, At, B1); G_BAR;
            G_LDA(At, 1, 1); G_STAGE_A(G_SA(1, 0), a3, 0, vg2);
            G_BAR; G_WAIT_L(0); G_MMA(1, 0, At, B0); G_BAR; G_SCHED;
            G_STAGE(G_SB(1, 1), b3 + hstep, voffB);
            G_WAIT_V(6); G_BAR; G_MMA(1, 1, At, B1); G_BAR;
            if (GATHER && t == 0 && has_next) {
                const LAS int* rows = (const LAS int*)(parbase + (ui & 1) * 4096 + NPAR * 1024);
#pragma unroll
                for (int h = 0; h < 2; ++h)
#pragma unroll
                    for (int i = 0; i < 2; ++i) vgn[h][i] = (unsigned)(rows[h * HALF + Rr[i]] * K + Cc[i]) * 2u;
            }
        }
        const bool keep_acc = E(acc, cur, wr, wc, fr, fq, (const LAS unsigned char*)(parbase + (ui & 1) * 4096));
        if (!has_next) break;
        if (!keep_acc)
#pragma unroll
        for (int a = 0; a < 2; ++a)
#pragma unroll
            for (int b = 0; b < 2; ++b)
#pragma unroll
                for (int m = 0; m < 4; ++m)
#pragma unroll
                    for (int n = 0; n < 2; ++n) acc[a][b][m][n] = (f32x4){0.f, 0.f, 0.f, 0.f};
        cur = nxt; cA = nA; cB = nB; ++ui;
        if (GATHER) {
#pragma unroll
            for (int h = 0; h < 2; ++h)
#pragma unroll
                for (int i = 0; i < 2; ++i) vgc[h][i] = vgn[h][i];
        }
    }
    G_WAIT_V(0);
    if (wr == 0) G_BAR;
    G_BAR;
#undef G_PAR_ISSUE
#undef G_SA
#undef G_SB
#undef G_STAGE
#undef G_STAGE_A
#undef G_LDA
#undef G_LDB
#undef G_MMA
#undef G_WAIT_V
#undef G_WAIT_L
#undef G_BAR
#undef G_SCHED
}

struct EpiProj {
    bf16_t* prkv; bf16_t* pconv; bf16_t* gates; const float* rstd1;
    static constexpr int NPAR = 1;
    __device__ __forceinline__ const void* par_src(const Unit& u, int, int lane) const { return rstd1 + NMETA + u.pm * BM + lane * 4; }
    __device__ __forceinline__ bool operator()(const f32x4 (&acc)[2][2][4][2], const Unit& u, int wr, int wc, int fr, int fq, const LAS unsigned char* par) const {
        const int row0 = u.pm * BM + wr * 64 + fr;
        const bool isg = u.pn >= 14;
        float rsv[2][4];
#pragma unroll
        for (int ai = 0; ai < 2; ++ai)
#pragma unroll
            for (int m = 0; m < 4; ++m) rsv[ai][m] = ((const LAS float*)par)[wr * 64 + fr + ai * HALF + m * 16];
#pragma unroll
        for (int ai = 0; ai < 2; ++ai)
#pragma unroll
            for (int m = 0; m < 4; ++m) {
                const int row = row0 + ai * HALF + m * 16;
                const float rs = rsv[ai][m];
                bf16_t* rowp = isg ? gates + (size_t)row * 2048 + (u.pn - 14) * 256 + wc * 32 + 8 * fq
                             : (u.pn < 6 ? prkv + (size_t)(NMETA + row) * 1536 + u.pn * 256 : pconv + (size_t)(NMETA + row) * 2048 + (u.pn - 6) * 256) + wc * 32 + 8 * fq;
#pragma unroll
                for (int bj = 0; bj < 2; ++bj) {
                    f32x4 v0 = acc[ai][bj][m][0] * rs, v1 = acc[ai][bj][m][1] * rs;
                    if (isg) {
#pragma unroll
                        for (int j = 0; j < 4; ++j) { v0[j] = sigmoidf_(v0[j]); v1[j] = sigmoidf_(v1[j]); }
                    }
                    u32x4 w; w.x = cvt_pk_bf16(v0[0], v0[1]); w.y = cvt_pk_bf16(v0[2], v0[3]); w.z = cvt_pk_bf16(v1[0], v1[1]); w.w = cvt_pk_bf16(v1[2], v1[3]);
                    *(u32x4*)(rowp + bj * HALF) = w;
                }
            }
        return false;
    }
};
struct EpiL {
    static constexpr int NPAR = 0;
    __device__ __forceinline__ const void* par_src(const Unit&, int, int) const { return nullptr; }
    unsigned char* wsb; const float* w0; const float* a0;
    __device__ __forceinline__ bool operator()(const f32x4 (&acc)[2][2][4][2], const Unit& u, int wr, int wc, int fr, int fq, const LAS unsigned char* par) const {
        const int row0 = NMETA + u.pm * BM + wr * 64 + fr;
        const int seg = u.pn >> 1;
        const int cb = (u.pn & 1) * 256 + wc * 32 + 8 * fq;
        const float* bias = seg == 0 ? w0 : a0;
        f32x4 bv[2][2];
#pragma unroll
        for (int bj = 0; bj < 2; ++bj) {
            bv[bj][0] = seg < 2 ? *(const f32x4*)(bias + cb + bj * HALF) : (f32x4){0.f, 0.f, 0.f, 0.f};
            bv[bj][1] = seg < 2 ? *(const f32x4*)(bias + cb + bj * HALF + 4) : (f32x4){0.f, 0.f, 0.f, 0.f};
        }
        const float sc = seg == 0 ? -0.60653065971f : 1.0f;
        bf16_t* ob = (bf16_t*)(wsb + (seg == 0 ? OFF_LD : seg == 1 ? OFF_A : OFF_G));
#pragma unroll
        for (int ai = 0; ai < 2; ++ai)
#pragma unroll
            for (int m = 0; m < 4; ++m) {
                const int row = row0 + ai * HALF + m * 16;
#pragma unroll
                for (int bj = 0; bj < 2; ++bj) {
                    const int c = cb + bj * HALF;
                    f32x4 v0 = acc[ai][bj][m][0] + bv[bj][0], v1 = acc[ai][bj][m][1] + bv[bj][1];
                    if (seg < 2) {
#pragma unroll
                        for (int j = 0; j < 4; ++j) { v0[j] = sc * sigmoidf_(v0[j]); v1[j] = sc * sigmoidf_(v1[j]); }
                    }
                    {
                        u32x4 w; w.x = cvt_pk_bf16(v0[0], v0[1]); w.y = cvt_pk_bf16(v0[2], v0[3]); w.z = cvt_pk_bf16(v1[0], v1[1]); w.w = cvt_pk_bf16(v1[2], v1[3]);
                        *(u32x4*)(ob + (size_t)row * 512 + c) = w;
                    }
                }
            }
        return false;
    }
};
template <int SECOND> struct EpiMerge {
    static constexpr int NPAR = 0;
    __device__ __forceinline__ const void* par_src(const Unit&, int, int) const { return nullptr; }
    bf16_t* merged; const bf16_t* gates;
    __device__ __forceinline__ bool operator()(const f32x4 (&acc)[2][2][4][2], const Unit& u, int wr, int wc, int fr, int fq, const LAS unsigned char* par) const {
        const int row0 = u.pm * BM + wr * 64 + fr, col0 = u.pn * BM + wc * 32 + 8 * fq;
#pragma unroll
        for (int ai = 0; ai < 2; ++ai)
#pragma unroll
            for (int m = 0; m < 4; ++m) {
                const int row = row0 + ai * HALF + m * 16;
#pragma unroll
                for (int bj = 0; bj < 2; ++bj) {
                    const int c = col0 + bj * HALF;
                    const u32x4 gw = *(const u32x4*)(gates + (size_t)row * 2048 + SECOND * 1024 + c);
                    f32x4 g0 = (f32x4){bflo(gw.x), bfhi(gw.x), bflo(gw.y), bfhi(gw.y)}, g1 = (f32x4){bflo(gw.z), bfhi(gw.z), bflo(gw.w), bfhi(gw.w)};
                    f32x4 v0 = acc[ai][bj][m][0] * g0, v1 = acc[ai][bj][m][1] * g1;
                    bf16_t* p = merged + (size_t)row * 1024 + c;
                    if (SECOND) {
                        const u32x4 ow = *(const u32x4*)p;
                        v0 += (f32x4){bflo(ow.x), bfhi(ow.x), bflo(ow.y), bfhi(ow.y)}; v1 += (f32x4){bflo(ow.z), bfhi(ow.z), bflo(ow.w), bfhi(ow.w)};
                    }
                    u32x4 w; w.x = cvt_pk_bf16(v0[0], v0[1]); w.y = cvt_pk_bf16(v0[2], v0[3]); w.z = cvt_pk_bf16(v1[0], v1[1]); w.w = cvt_pk_bf16(v1[2], v1[3]);
                    *(u32x4*)p = w;
                }
            }
        return false;
    }
};
struct MergeOrder {
    StaticOrder so; const char* A1; const char* B1;
    __device__ bool next(int i, Unit& u) const { const bool ok = so.next(i >> 1, u); u.aux = i & 1; return ok; }
    __device__ __forceinline__ const char* a_ptr(const Unit& u) const { return (u.aux ? A1 : so.A) + (size_t)u.pm * 256 * so.K * 2; }
    __device__ __forceinline__ const char* b_ptr(const Unit& u) const { return (u.aux ? B1 : so.Bt) + (size_t)u.pn * 256 * so.K * 2; }
    __device__ __forceinline__ int gather_row(const Unit&, int) const { return 0; }
    __device__ __forceinline__ const void* gather_src(const Unit&, int) const { return nullptr; }
};
struct EpiMergeFused {
    static constexpr int NPAR = 0;
    __device__ __forceinline__ const void* par_src(const Unit&, int, int) const { return nullptr; }
    bf16_t* merged; const bf16_t* gates;
    __device__ __forceinline__ bool operator()(f32x4 (&acc)[2][2][4][2], const Unit& u, int wr, int wc, int fr, int fq, const LAS unsigned char* par) const {
        const int row0 = u.pm * BM + wr * 64 + fr, col0 = u.pn * BM + wc * 32 + 8 * fq;
#pragma unroll
        for (int ai = 0; ai < 2; ++ai) {
            u32x4 gbw[4][2], gaw[4][2];
#pragma unroll
            for (int m = 0; m < 4; ++m)
#pragma unroll
                for (int bj = 0; bj < 2; ++bj) {
                    const bf16_t* gp = gates + (size_t)(row0 + ai * HALF + m * 16) * 2048 + col0 + bj * HALF;
                    gbw[m][bj] = *(const u32x4*)(gp + 1024);
                    gaw[m][bj] = u.aux == 0 ? *(const u32x4*)gp : (u32x4){0u, 0u, 0u, 0u};
                }
#pragma unroll
            for (int m = 0; m < 4; ++m)
#pragma unroll
                for (int bj = 0; bj < 2; ++bj) {
                    const int row = row0 + ai * HALF + m * 16, c = col0 + bj * HALF;
                    f32x4 gb0 = (f32x4){bflo(gbw[m][bj].x), bfhi(gbw[m][bj].x), bflo(gbw[m][bj].y), bfhi(gbw[m][bj].y)}, gb1 = (f32x4){bflo(gbw[m][bj].z), bfhi(gbw[m][bj].z), bflo(gbw[m][bj].w), bfhi(gbw[m][bj].w)};
#pragma unroll
                    for (int j = 0; j < 4; ++j) { gb0[j] = fmaxf(gb0[j], 1e-6f); gb1[j] = fmaxf(gb1[j], 1e-6f); }
                    if (u.aux == 0) {
                        const f32x4 ga0 = (f32x4){bflo(gaw[m][bj].x), bfhi(gaw[m][bj].x), bflo(gaw[m][bj].y), bfhi(gaw[m][bj].y)}, ga1 = (f32x4){bflo(gaw[m][bj].z), bfhi(gaw[m][bj].z), bflo(gaw[m][bj].w), bfhi(gaw[m][bj].w)};
#pragma unroll
                        for (int j = 0; j < 4; ++j) { acc[ai][bj][m][0][j] *= ga0[j] * __builtin_amdgcn_rcpf(gb0[j]); acc[ai][bj][m][1][j] *= ga1[j] * __builtin_amdgcn_rcpf(gb1[j]); }
                    } else {
                        const f32x4 v0 = acc[ai][bj][m][0] * gb0, v1 = acc[ai][bj][m][1] * gb1;
                        u32x4 w; w.x = cvt_pk_bf16(v0[0], v0[1]); w.y = cvt_pk_bf16(v0[2], v0[3]); w.z = cvt_pk_bf16(v1[0], v1[1]); w.w = cvt_pk_bf16(v1[2], v1[3]);
                        *(u32x4*)(merged + (size_t)row * 1024 + c) = w;
                    }
                }
        }
        return u.aux == 0;
    }
};
struct EpiO {
    static constexpr int NPAR = 0;
    __device__ __forceinline__ const void* par_src(const Unit&, int, int) const { return nullptr; }
    const float* x; float* h1; bf16_t* hb2;
    __device__ __forceinline__ bool operator()(const f32x4 (&acc)[2][2][4][2], const Unit& u, int wr, int wc, int fr, int fq, const LAS unsigned char* par) const {
        const int row0 = u.pm * BM + wr * 64 + fr, col0 = u.pn * BM + wc * 32 + 8 * fq;
#pragma unroll
        for (int ai = 0; ai < 2; ++ai) {
            f32x4 xv[4][2][2];
#pragma unroll
            for (int m = 0; m < 4; ++m)
#pragma unroll
                for (int bj = 0; bj < 2; ++bj) {
                    const size_t o = (size_t)(row0 + ai * HALF + m * 16) * 1024 + col0 + bj * HALF;
                    xv[m][bj][0] = *(const f32x4*)(x + o); xv[m][bj][1] = *(const f32x4*)(x + o + 4);
                }
#pragma unroll
            for (int m = 0; m < 4; ++m)
#pragma unroll
                for (int bj = 0; bj < 2; ++bj) {
                    const size_t o = (size_t)(row0 + ai * HALF + m * 16) * 1024 + col0 + bj * HALF;
                    const f32x4 v0 = acc[ai][bj][m][0] + xv[m][bj][0], v1 = acc[ai][bj][m][1] + xv[m][bj][1];
                    u32x4 w; w.x = cvt_pk_bf16(v0[0], v0[1]); w.y = cvt_pk_bf16(v0[2], v0[3]); w.z = cvt_pk_bf16(v1[0], v1[1]); w.w = cvt_pk_bf16(v1[2], v1[3]);
                    *(u32x4*)(hb2 + o) = w;
                }
        }
        return false;
    }
};
struct EpiMoe1 {
    bf16_t* act; const float* rowrs; const float* bg; const float* bu;
    static constexpr int NPAR = 2;
    __device__ __forceinline__ const void* par_src(const Unit& u, int piece, int lane) const {
        if (piece == 0) return rowrs + u.pm * BM + lane * 4;
        return (lane < 32 ? bg : bu) + (size_t)u.aux * DFF + u.pn * 128 + (lane & 31) * 4;
    }
    __device__ __forceinline__ bool operator()(const f32x4 (&acc)[2][2][4][2], const Unit& u, int wr, int wc, int fr, int fq, const LAS unsigned char* par) const {
        const int row0 = u.pm * BM + wr * 64 + fr, ff0 = u.pn * 128 + wc * 32 + 8 * fq;
        const LAS float* bgp = (const LAS float*)(par + 1024) + wc * 32 + 8 * fq; const LAS float* bup = bgp + 128;
        const f32x4 bg0 = *(const LAS f32x4*)bgp, bg1 = *(const LAS f32x4*)(bgp + 4), bu0 = *(const LAS f32x4*)bup, bu1 = *(const LAS f32x4*)(bup + 4);
        float rsv[2][4];
#pragma unroll
        for (int ai = 0; ai < 2; ++ai)
#pragma unroll
            for (int m = 0; m < 4; ++m) rsv[ai][m] = ((const LAS float*)par)[wr * 64 + fr + ai * HALF + m * 16];
#pragma unroll
        for (int ai = 0; ai < 2; ++ai)
#pragma unroll
            for (int m = 0; m < 4; ++m) {
                const int row = row0 + ai * HALF + m * 16;
                const float rs = rsv[ai][m];
                f32x4 g0 = acc[ai][0][m][0] * rs + bg0, g1 = acc[ai][0][m][1] * rs + bg1, u0 = acc[ai][1][m][0] * rs + bu0, u1 = acc[ai][1][m][1] * rs + bu1;
                f32x4 r0, r1;
#pragma unroll
                for (int j = 0; j < 4; ++j) {
                    { const float gt = fminf(g0[j], 7.0f), up = fminf(fmaxf(u0[j], -7.0f), 7.0f); r0[j] = (up + 1.0f) * gt * sigmoidf_(1.702f * gt); }
                    { const float gt = fminf(g1[j], 7.0f), up = fminf(fmaxf(u1[j], -7.0f), 7.0f); r1[j] = (up + 1.0f) * gt * sigmoidf_(1.702f * gt); }
                }
                u32x4 w; w.x = cvt_pk_bf16(r0[0], r0[1]); w.y = cvt_pk_bf16(r0[2], r0[3]); w.z = cvt_pk_bf16(r1[0], r1[1]); w.w = cvt_pk_bf16(r1[2], r1[3]);
                *(u32x4*)(act + (size_t)row * DFF + ff0) = w;
            }
        return false;
    }
};
struct EpiMoe2 {
    bf16_t* ya; bf16_t* yb; const int* rowslot; const float* roww; const float* bd;
    static constexpr int NPAR = 3;
    __device__ __forceinline__ const void* par_src(const Unit& u, int piece, int lane) const {
        if (piece == 0) return rowslot + u.pm * BM + lane * 4;
        if (piece == 1) return roww + u.pm * BM + lane * 4;
        return bd + (size_t)u.aux * D + u.pn * BM + lane * 4;
    }
    __device__ __forceinline__ bool operator()(const f32x4 (&acc)[2][2][4][2], const Unit& u, int wr, int wc, int fr, int fq, const LAS unsigned char* par) const {
        const int row0 = u.pm * BM + wr * 64 + fr, col0 = u.pn * BM + wc * 32 + 8 * fq;
        bf16_t* ybase = (u.pn < 2) ? ya : yb; const int yc0 = col0 & 511;
        const LAS float* bp = (const LAS float*)(par + 2048) + wc * 32 + 8 * fq;
        f32x4 bv[2][2];
#pragma unroll
        for (int bj = 0; bj < 2; ++bj) { bv[bj][0] = *(const LAS f32x4*)(bp + bj * HALF); bv[bj][1] = *(const LAS f32x4*)(bp + bj * HALF + 4); }
        int slotv[2][4]; float wv8[2][4];
#pragma unroll
        for (int ai = 0; ai < 2; ++ai)
#pragma unroll
            for (int m = 0; m < 4; ++m) { const int rl = wr * 64 + fr + ai * HALF + m * 16; slotv[ai][m] = ((const LAS int*)par)[rl]; wv8[ai][m] = ((const LAS float*)(par + 1024))[rl]; }
#pragma unroll
        for (int ai = 0; ai < 2; ++ai)
#pragma unroll
            for (int m = 0; m < 4; ++m) {
                const int slot = slotv[ai][m];
                if (slot >= 0) {
                    const float w8 = wv8[ai][m];
#pragma unroll
                    for (int bj = 0; bj < 2; ++bj) {
                        const f32x4 v0 = (acc[ai][bj][m][0] + bv[bj][0]) * w8, v1 = (acc[ai][bj][m][1] + bv[bj][1]) * w8;
                        u32x4 w; w.x = cvt_pk_bf16(v0[0], v0[1]); w.y = cvt_pk_bf16(v0[2], v0[3]); w.z = cvt_pk_bf16(v1[0], v1[1]); w.w = cvt_pk_bf16(v1[2], v1[3]);
                        *(u32x4*)(ybase + (size_t)slot * 512 + yc0 + bj * HALF) = w;
                    }
                }
            }
        return false;
    }
};

__device__ __forceinline__ void transpose_tile(LAS float* tile, const float* src, int ldsrc, int k0, int n0, bf16_t* dst, int ldd, int drow0, const float* sa, const float* mu, int mode, bool zero) {
    const int tid = threadIdx.x;
    if (!zero) {
#pragma unroll
        for (int i = 0; i < 2; ++i) {
            const int r = (tid >> 4) + 32 * i, c4 = (tid & 15) * 4;
            const f32x4 v = *(const f32x4*)(src + (size_t)(k0 + r) * ldsrc + n0 + c4);
            LAS float* t = tile + r * 65 + c4;
            t[0] = v[0]; t[1] = v[1]; t[2] = v[2]; t[3] = v[3];
        }
    }
    __syncthreads();
    {
        const int n = tid >> 3, kq = tid & 7;
        float v[8];
#pragma unroll
        for (int j = 0; j < 8; ++j) {
            const int k = k0 + 8 * kq + j;
            float s = sa ? sa[k] : 1.0f;
            if (mode == 1) s *= (1.0f - mu[k]);
            if (mode == 2) s *= mu[k];
            v[j] = zero ? 0.f : tile[(8 * kq + j) * 65 + n] * s;
        }
        u32x4 w; w.x = cvt_pk_bf16(v[0], v[1]); w.y = cvt_pk_bf16(v[2], v[3]); w.z = cvt_pk_bf16(v[4], v[5]); w.w = cvt_pk_bf16(v[6], v[7]);
        *(u32x4*)(dst + (size_t)(drow0 + n) * ldd + k0 + 8 * kq) = w;
    }
    __syncthreads();
}

__device__ __forceinline__ void phase_prep(const PPv& p, LAS unsigned char* lds) {
    const int tid = threadIdx.x, bid = blockIdx.x, nb = gridDim.x, lane = tid & 63, wave = tid >> 6;
    unsigned char* ws = p.gws();
    const float* x = p.gin(0); const float* meta = p.gin(1); const float* g1 = p.gin(2);
    if (bid == 0 && tid < 64) ((int*)(ws + OFF_GCNT))[tid] = 0;
    {
        bf16_t* HB = (bf16_t*)(ws + OFF_HB); float* rstd1 = (float*)(ws + OFF_RSTD1);
        for (int row0 = (bid * 8 + wave) * 4; row0 < NR; row0 += nb * 32) {
            f32x4 v[4][4];
#pragma unroll
            for (int u = 0; u < 4; ++u) {
                const int row = row0 + u < NR ? row0 + u : NR - 1;
                const float* src = row < NMETA ? meta + (size_t)row * D : x + (size_t)(row - NMETA) * D;
#pragma unroll
                for (int i = 0; i < 4; ++i) v[u][i] = __builtin_nontemporal_load((const f32x4*)(src + i * 256 + lane * 4));
            }
#pragma unroll
            for (int u = 0; u < 4; ++u) {
                const int row = row0 + u;
                if (row < NR) {
                    float ss = 0.f;
#pragma unroll
                    for (int i = 0; i < 4; ++i) ss += v[u][i][0] * v[u][i][0] + v[u][i][1] * v[u][i][1] + v[u][i][2] * v[u][i][2] + v[u][i][3] * v[u][i][3];
                    ss = wave_sum_dpp(ss);
                    if (lane == 0) rstd1[row] = rsqrtf(ss * (1.0f / D) + NORM_EPS);
                    if (row >= NMETA) {
                        bf16_t* d = HB + (size_t)(row - NMETA) * D;
#pragma unroll
                        for (int i = 0; i < 4; ++i) { u32x2 w; w.x = cvt_pk_bf16(v[u][i][0], v[u][i][1]); w.y = cvt_pk_bf16(v[u][i][2], v[u][i][3]); *(u32x2*)(d + i * 256 + lane * 4) = w; }
                    }
                }
            }
        }
    }
    LAS float* tile = (LAS float*)lds;
    {
        bf16_t* WIN = (bf16_t*)(ws + OFF_WIN);
        const float* w_in = p.gin(3);
        for (int j = bid; j < 16 * 88; j += nb) {
            const int kt = j & 15, ntile = j >> 4, n0 = ntile * 64;
            const float* src; int ld, sn0, mode = 0; const float* mu = nullptr;
            if (n0 < 3072) { src = w_in; ld = 5120; sn0 = n0; }
            else if (n0 < 3584) {
                const int seg = (n0 - 3072) >> 6;
                if (seg < 2) { src = p.gin(11); ld = 64; sn0 = 0; mu = p.gin(7); mode = 1 + seg; }
                else if (seg < 4) { src = p.gin(14); ld = 64; sn0 = 0; mu = p.gin(8); mode = 1 + (seg - 2); }
                else { src = p.gin(16); ld = 128; sn0 = (seg & 1) * 64; mu = p.gin(9); mode = seg < 6 ? 1 : 2; }
            } else { src = w_in; ld = 5120; sn0 = n0 - 512; }
            transpose_tile(tile, src, ld, kt * 64, sn0, WIN, 1024, n0, g1, mu, mode, false);
        }
        for (int j = bid; j < 2 * 128; j += nb) {
            const int which = j >> 7, jj = j & 127, kt = jj & 7, ntile = jj >> 3;
            transpose_tile(tile, which ? p.gin(25) : p.gin(23), 1024, kt * 64, ntile * 64, (bf16_t*)(ws + (which ? OFF_WC : OFF_WR)), 512, ntile * 64, nullptr, nullptr, 0, false);
        }
        for (int j = bid; j < 256; j += nb) {
            const int kt = j & 15, ntile = j >> 4;
            transpose_tile(tile, p.gin(26), 1024, kt * 64, ntile * 64, (bf16_t*)(ws + OFF_WO), 1024, ntile * 64, nullptr, nullptr, 0, false);
        }
        for (int j = bid; j < 96; j += nb) {
            const int kt = j & 3, ntile = j >> 2, seg = ntile >> 3, nn0 = (ntile & 7) * 64;
            const float* src = nullptr; int sk0 = 0; bool zero = true;
            if (seg == 0 && kt == 0) { src = p.gin(12); sk0 = 0; zero = false; }
            if (seg == 1 && kt == 1) { src = p.gin(15); sk0 = 0; zero = false; }
            if (seg == 2 && kt >= 2) { src = p.gin(17); sk0 = (kt - 2) * 64; zero = false; }
            const float* srcs = zero ? p.gin(12) : src + (size_t)(sk0 - kt * 64) * 512;
            transpose_tile(tile, srcs, 512, kt * 64, nn0, (bf16_t*)(ws + OFF_W2), 256, ntile * 64, nullptr, nullptr, 0, zero);
        }
        {
            float* WRG = (float*)(ws + OFF_WRG); const float* g2 = p.gin(27); const float* wr_ = p.gin(28);
            for (int i = bid * 512 + tid; i < 1024 * 32; i += nb * 512) WRG[i] = g2[i >> 5] * wr_[i];
        }
    }
}

__device__ __forceinline__ void phase_meta_proj(const PPv& p, LAS unsigned char* lds) {
    const int tid = threadIdx.x, bid = blockIdx.x, lane = tid & 63, wave = tid >> 6;
    unsigned char* ws = p.gws();
    LAS float* sm = (LAS float*)lds;
    const float* meta = p.gin(1);
    for (int i = tid; i < 16 * 256; i += 512) { const int r = i >> 8, c4 = (i & 255) * 4; const f32x4 v = *(const f32x4*)(meta + r * 1024 + c4); LAS float* d = sm + r * 1028 + c4; d[0] = v[0]; d[1] = v[1]; d[2] = v[2]; d[3] = v[3]; }
    __syncthreads();
    const float* rstd1 = (const float*)(ws + OFF_RSTD1);
    for (int nbase = bid * 14; nbase < PCOLS1; nbase += gridDim.x * 14) {
        for (int nn = wave; nn < 14; nn += 8) {
            const int n = nbase + nn;
            if (n >= PCOLS1) break;
            const bf16_t* wrow = (const bf16_t*)(ws + OFF_WIN) + (size_t)n * 1024;
            const u32x4 w0 = *(const u32x4*)(wrow + 8 * lane), w1 = *(const u32x4*)(wrow + 512 + 8 * lane);
            const float wf[16] = {bflo(w0.x), bfhi(w0.x), bflo(w0.y), bfhi(w0.y), bflo(w0.z), bfhi(w0.z), bflo(w0.w), bfhi(w0.w),
                                  bflo(w1.x), bfhi(w1.x), bflo(w1.y), bfhi(w1.y), bflo(w1.z), bfhi(w1.z), bflo(w1.w), bfhi(w1.w)};
            float outv = 0.f;
#pragma unroll
            for (int pr = 0; pr < 16; ++pr) {
                const LAS float* m0 = sm + pr * 1028 + 8 * lane;
                const f32x4 a0 = *(const LAS f32x4*)m0, a1 = *(const LAS f32x4*)(m0 + 4), a2 = *(const LAS f32x4*)(m0 + 512), a3 = *(const LAS f32x4*)(m0 + 516);
                float acc = a0[0] * wf[0] + a0[1] * wf[1] + a0[2] * wf[2] + a0[3] * wf[3] + a1[0] * wf[4] + a1[1] * wf[5] + a1[2] * wf[6] + a1[3] * wf[7]
                          + a2[0] * wf[8] + a2[1] * wf[9] + a2[2] * wf[10] + a2[3] * wf[11] + a3[0] * wf[12] + a3[1] * wf[13] + a3[2] * wf[14] + a3[3] * wf[15];
                acc = wave_sum_dpp(acc);
                outv = (lane == pr) ? acc * rstd1[pr] : outv;
            }
            if (lane < 16) {
                if (n < 1536) ((bf16_t*)(ws + OFF_PRKV))[(size_t)lane * 1536 + n] = f2bf(outv);
                else ((bf16_t*)(ws + OFF_PCONV))[(size_t)lane * 2048 + n - 1536] = f2bf(outv);
            }
        }
    }
    __syncthreads();
}

__device__ __forceinline__ void phase_meta_lora(const PPv& p) {
    const int tid = threadIdx.x, bid = blockIdx.x, nb = gridDim.x, lane = tid & 63, wave = tid >> 6;
    unsigned char* ws = p.gws();
    const bf16_t* L = (const bf16_t*)(ws + OFF_L); const bf16_t* W2 = (const bf16_t*)(ws + OFF_W2);
    for (int n = bid * 8 + wave; n < 1536; n += nb * 8) {
        const int seg = n >> 9, c = n & 511;
        const u32x2 wv = *(const u32x2*)(W2 + (size_t)n * 256 + 4 * lane);
        const float w0v = bflo(wv.x), w1v = bfhi(wv.x), w2v = bflo(wv.y), w3v = bfhi(wv.y);
        float outv = 0.f;
#pragma unroll
        for (int r = 0; r < 16; ++r) {
            const u32x2 lv = *(const u32x2*)(L + (size_t)r * 256 + 4 * lane);
            float acc = bflo(lv.x) * w0v + bfhi(lv.x) * w1v + bflo(lv.y) * w2v + bfhi(lv.y) * w3v;
            acc = wave_sum_dpp(acc);
            outv = (lane == r) ? acc : outv;
        }
        if (lane < 16) {
            float v = outv;
            if (seg == 0) v = -0.60653065971f * sigmoidf_(v + p.gin(10)[c]);
            if (seg == 1) v = sigmoidf_(v + p.gin(13)[c]);
            bf16_t* ob = (bf16_t*)(ws + (seg == 0 ? OFF_LD : seg == 1 ? OFF_A : OFF_G));
            ob[(size_t)lane * 512 + c] = f2bf(v);
        }
    }
}

__device__ __forceinline__ void phase_lprep_conv(const PPv& p) {
    const int tid = threadIdx.x, bid = blockIdx.x, nb = gridDim.x;
    unsigned char* ws = p.gws();
    const bf16_t* PROJ = (const bf16_t*)(ws + OFF_PCONV);
    constexpr int PCOLS = 2048;
    bf16_t* L = (bf16_t*)(ws + OFF_L);
    for (int i = bid * 512 + tid; i < NRP * 32; i += nb * 512) {
        const int row = i >> 5, gq = i & 31;
        u32x4 w = (u32x4){0u, 0u, 0u, 0u};
        if (row < NR) {
            int ca, cb;
            if (gq < 8) { ca = 1536 + gq * 8; cb = ca + 64; }
            else if (gq < 16) { ca = 1536 + 128 + (gq - 8) * 8; cb = ca + 64; }
            else { ca = 1536 + 256 + (gq - 16) * 8; cb = ca + 128; }
            const u32x4 va = *(const u32x4*)(PROJ + (size_t)row * PCOLS + ca);
            const int pr = prev_row(row, 1);
            u32x4 vb = (u32x4){0u, 0u, 0u, 0u};
            if (pr >= 0) vb = *(const u32x4*)(PROJ + (size_t)pr * PCOLS + cb);
            float v[8] = {bflo(va.x) + bflo(vb.x), bfhi(va.x) + bfhi(vb.x), bflo(va.y) + bflo(vb.y), bfhi(va.y) + bfhi(vb.y), bflo(va.z) + bflo(vb.z), bfhi(va.z) + bfhi(vb.z), bflo(va.w) + bflo(vb.w), bfhi(va.w) + bfhi(vb.w)};
#pragma unroll
            for (int j = 0; j < 8; ++j) { if (gq < 8) v[j] = tanhf(v[j]); else if (gq >= 16) v[j] = sigmoidf_(v[j]); }
            w.x = cvt_pk_bf16(v[0], v[1]); w.y = cvt_pk_bf16(v[2], v[3]); w.z = cvt_pk_bf16(v[4], v[5]); w.w = cvt_pk_bf16(v[6], v[7]);
        }
        *(u32x4*)(L + (size_t)row * 256 + gq * 8) = w;
    }
    bf16_t* C = (bf16_t*)(ws + OFF_C);
    const float* cw = p.gin(24);
    for (int i = bid * 512 + tid; i < T * 64; i += nb * 512) {
        const int m = i >> 6, ch = (i & 63) * 8, row = NMETA + m;
        const int r1 = prev_row(row, 1), r2 = prev_row(row, 2);
        const bf16_t* p0 = PROJ + (size_t)row * PCOLS; const bf16_t* p1 = PROJ + (size_t)r1 * PCOLS; const bf16_t* p2 = PROJ + (size_t)r2 * PCOLS;
        const u32x4 vb = *(const u32x4*)(p0 + ch);
        const u32x4 c0 = *(const u32x4*)(p0 + 512 + ch), h0 = *(const u32x4*)(p0 + 1024 + ch);
        const u32x4 c1 = *(const u32x4*)(p1 + 512 + ch), h1 = *(const u32x4*)(p1 + 1024 + ch);
        const u32x4 c2 = *(const u32x4*)(p2 + 512 + ch), h2 = *(const u32x4*)(p2 + 1024 + ch);
        float o[8];
#pragma unroll
        for (int j = 0; j < 8; ++j) {
            const unsigned wb = j < 2 ? vb.x : j < 4 ? vb.y : j < 6 ? vb.z : vb.w;
            const unsigned wc0 = j < 2 ? c0.x : j < 4 ? c0.y : j < 6 ? c0.z : c0.w, wh0 = j < 2 ? h0.x : j < 4 ? h0.y : j < 6 ? h0.z : h0.w;
            const unsigned wc1 = j < 2 ? c1.x : j < 4 ? c1.y : j < 6 ? c1.z : c1.w, wh1 = j < 2 ? h1.x : j < 4 ? h1.y : j < 6 ? h1.z : h1.w;
            const unsigned wc2 = j < 2 ? c2.x : j < 4 ? c2.y : j < 6 ? c2.z : c2.w, wh2 = j < 2 ? h2.x : j < 4 ? h2.y : j < 6 ? h2.z : h2.w;
            const bool hi = j & 1;
            const float b = hi ? bfhi(wb) : bflo(wb);
            const float u0 = (hi ? bfhi(wc0) : bflo(wc0)) * (hi ? bfhi(wh0) : bflo(wh0));
            const float u1 = (hi ? bfhi(wc1) : bflo(wc1)) * (hi ? bfhi(wh1) : bflo(wh1));
            const float u2 = (hi ? bfhi(wc2) : bflo(wc2)) * (hi ? bfhi(wh2) : bflo(wh2));
            const float conv = cw[ch + j] * u2 + cw[512 + ch + j] * u1 + cw[1024 + ch + j] * u0;
            o[j] = b * conv;
        }
        u32x4 w; w.x = cvt_pk_bf16(o[0], o[1]); w.y = cvt_pk_bf16(o[2], o[3]); w.z = cvt_pk_bf16(o[4], o[5]); w.w = cvt_pk_bf16(o[6], o[7]);
        *(u32x4*)(C + (size_t)m * 512 + ch) = w;
    }
}

template <int CTRL> __device__ __forceinline__ float dppmov(float v) { return __builtin_bit_cast(float, __builtin_amdgcn_update_dpp(0, __builtin_bit_cast(int, v), CTRL, 0xF, 0xF, true)); }
__device__ __forceinline__ float wave_sum_dpp(float v) {
    v += dppmov<0xB1>(v);
    v += dppmov<0x4E>(v);
    v += dppmov<0x141>(v);
    v += dppmov<0x140>(v);
    { float c = v; asm volatile("v_nop\n\tv_nop\n\tv_permlane16_swap_b32 %0, %1\n\tv_nop" : "+v"(v), "+v"(c)); v += c; }
    { float c = v; asm volatile("v_nop\n\tv_nop\n\tv_permlane32_swap_b32 %0, %1\n\tv_nop" : "+v"(v), "+v"(c)); v += c; }
    return v;
}
typedef float f32x16 __attribute__((ext_vector_type(16)));

struct RawTok { bf16_t r, k, v, a, ld; };
__device__ __forceinline__ RawTok load_raw(const bf16_t* PRKV, const bf16_t* Ab, const bf16_t* LD, int row, int col) {
    RawTok q; const bf16_t* p0 = PRKV + (size_t)row * 1536 + col;
    q.r = p0[0]; q.k = p0[512]; q.v = p0[1024]; q.a = Ab[(size_t)row * 512 + col]; q.ld = LD[(size_t)row * 512 + col];
    return q;
}
__device__ __forceinline__ void unit_geom(int uid, int lane, int& b, int& h, int& c, int& col, int& row0) {
    const int bh = uid / NCHUNK; c = uid - bh * NCHUNK; b = bh >> 3; h = bh & 7; col = h * 64 + lane;
    row0 = c == 0 ? 0 : b * SEQ + c * 16;
}
__device__ __forceinline__ void phase_scanprep(const PPv& p, LAS unsigned char* lds) {
    const int tid = threadIdx.x, bid = blockIdx.x, nb = gridDim.x, lane = tid & 63, wave = tid >> 6;
    unsigned char* ws = p.gws();
    const bf16_t* PRKV = (const bf16_t*)(ws + OFF_PRKV);
    const bf16_t* LD = (const bf16_t*)(ws + OFF_LD);
    const bf16_t* Ab = (const bf16_t*)(ws + OFF_A);
    float* COEF = (float*)(ws + OFF_COEF);
    LAS unsigned char* wl = lds + wave * 13824;
    LAS bf16_t* AR = (LAS bf16_t*)wl;
    LAS bf16_t* BK = (LAS bf16_t*)(wl + 4608);
    LAS float* DM = (LAS float*)(wl + 9216);
    const int qperm = (lane & 32) | (((lane >> 2) & 3) << 3) | (((lane >> 4) & 1) << 2) | (lane & 3);
    int uid = bid * 8 + wave;
    if (uid >= NUNITS) return;
    int b, h, c, col, row0;
    unit_geom(uid, lane, b, h, c, col, row0);
    RawTok q[16], qn[16];
    bf16_t prr = 0, prk = 0, prv = 0, nprr = 0, nprk = 0, nprv = 0;
#pragma unroll
    for (int t = 0; t < 16; ++t) q[t] = load_raw(PRKV, Ab, LD, row0 + t, col);
    { const int pr = prev_row(row0, 1); if (pr >= 0) { const bf16_t* p1 = PRKV + (size_t)pr * 1536 + col; prr = p1[0]; prk = p1[512]; prv = p1[1024]; } }
    for (;;) {
        const float mur = p.gin(4)[col], muk = p.gin(5)[col], muv = p.gin(6)[col], kkw = p.gin(18)[col], kaw = p.gin(19)[col], rkw = p.gin(20)[col];
        const int nuid = uid + nb * 8; const bool has_next = nuid < NUNITS;
        int nb_ = b, nh = h, nc = c, ncol = col, nrow0 = row0;
        if (has_next) {
            unit_geom(nuid, lane, nb_, nh, nc, ncol, nrow0);
#pragma unroll
            for (int t = 0; t < 16; ++t) qn[t] = load_raw(PRKV, Ab, LD, nrow0 + t, ncol);
            nprr = 0; nprk = 0; nprv = 0;
            const int pr = prev_row(nrow0, 1); if (pr >= 0) { const bf16_t* p1 = PRKV + (size_t)pr * 1536 + ncol; nprr = p1[0]; nprk = p1[512]; nprv = p1[1024]; }
        }
        __builtin_amdgcn_sched_barrier(0);
        float at[16], vt[16]; unsigned btp[8], ktp[8]; float bprev = 0.f, kprev = 0.f;
        float cl = 0.f;
        float rp = bf2f(prr), kp = bf2f(prk), vp = bf2f(prv);
#pragma unroll
        for (int t = 0; t < 16; ++t) {
            const RawTok qq = q[t];
            const int row = row0 + t;
            const float r0 = bf2f(qq.r), k0 = bf2f(qq.k), v0 = bf2f(qq.v);
            const float r = r0 + (rp - r0) * mur, k = k0 + (kp - k0) * muk, v = v0 + (vp - v0) * muv;
            rp = r0; kp = k0; vp = v0;
            const float a = bf2f(qq.a);
            const float kkv = k * kkw;
            const float n2 = wave_sum_dpp(kkv * kkv);
            const float kk = kkv * __builtin_amdgcn_rsqf(fmaxf(n2, 1e-24f));
            const float k2 = k * (1.0f + (a - 1.0f) * kaw);
            const float cf = wave_sum_dpp(r * k2 * rkw);
            if (lane == 0) COEF[(size_t)row * 8 + h] = cf;
            const float wcp = __expf(cl);
            cl += bf2f(qq.ld);
            const float wcn = __expf(cl), iw = __expf(-cl);
            const float btv = kk * a * iw, ktv = k2 * iw;
            at[t] = -kk * wcp; vt[t] = v;
            { const unsigned w = cvt_pk_bf16(at[t], r * wcn); AR[t * 72 + qperm] = (bf16_t)(w & 0xFFFFu); AR[(16 + t) * 72 + qperm] = (bf16_t)(w >> 16); }
            if (t & 1) {
                btp[t >> 1] = cvt_pk_bf16(bprev, btv); ktp[t >> 1] = cvt_pk_bf16(kprev, ktv);
                BK[(t - 1) * 72 + qperm] = (bf16_t)(btp[t >> 1] & 0xFFFFu); BK[t * 72 + qperm] = (bf16_t)(btp[t >> 1] >> 16);
                BK[(16 + t - 1) * 72 + qperm] = (bf16_t)(ktp[t >> 1] & 0xFFFFu); BK[(16 + t) * 72 + qperm] = (bf16_t)(ktp[t >> 1] >> 16);
            } else { bprev = btv; kprev = ktv; }
            if (t & 1) __builtin_amdgcn_sched_barrier(0);
        }
        const float wcc = __expf(cl);
        {
            f32x16 dm;
#pragma unroll
            for (int i = 0; i < 16; ++i) dm[i] = 0.f;
            const int rr = lane & 31, hh = lane >> 5;
#pragma unroll
            for (int ks = 0; ks < 4; ++ks) {
                const bf16x8 fa = *(const LAS bf16x8*)(AR + rr * 72 + 16 * ks + 8 * hh);
                const bf16x8 fb = *(const LAS bf16x8*)(BK + rr * 72 + 16 * ks + 8 * hh);
                dm = __builtin_amdgcn_mfma_f32_32x32x16_bf16(fa, fb, dm, 0, 0, 0);
            }
#pragma unroll
            for (int reg = 0; reg < 16; ++reg) DM[((reg & 3) + 8 * (reg >> 2) + 4 * hh) * 36 + rr] = dm[reg];
        }
        __builtin_amdgcn_sched_barrier(0);
        float uh[16];
#pragma unroll
        for (int t = 0; t < 16; ++t) {
            float wv = at[t], uv = 0.f, wv2 = 0.f, uv2 = 0.f, uv3 = 0.f;
#pragma unroll
            for (int s4 = 0; s4 < 4; ++s4) {
                if (s4 * 4 < t) {
                    const f32x4 ab = *(const LAS f32x4*)(DM + t * 36 + s4 * 4), ak = *(const LAS f32x4*)(DM + t * 36 + 16 + s4 * 4);
#pragma unroll
                    for (int j = 0; j < 4; ++j) {
                        const int s_ = s4 * 4 + j;
                        if (s_ < t) {
                            if (j & 1) { wv2 += ab[j] * at[s_]; uv2 += ak[j] * vt[s_]; } else { wv += ab[j] * at[s_]; uv += ak[j] * vt[s_]; }
                            uv3 += ab[j] * uh[s_];
                        }
                    }
                }
            }
            wv += wv2; uv += uv2 + uv3;
            at[t] = wv; uh[t] = uv;
            asm volatile("" : "+v"(at[t]), "+v"(uh[t]));
        }
        __builtin_amdgcn_sched_barrier(0);
#pragma unroll
        for (int t = 0; t < 16; t += 2) { const unsigned w = cvt_pk_bf16(at[t], at[t + 1]); AR[t * 72 + qperm] = (bf16_t)(w & 0xFFFFu); AR[(t + 1) * 72 + qperm] = (bf16_t)(w >> 16); }
        unsigned char* rec = ws + OFF_CH + (size_t)uid * REC_BYTES;
#pragma unroll
        for (int i = 0; i < 2; ++i) {
            const int pc = i * 64 + lane, row = pc >> 3, part = pc & 7;
            *(u32x4*)(rec + RO_WH + pc * 16) = *(const LAS u32x4*)((LAS unsigned char*)AR + row * 144 + part * 16);
            *(u32x4*)(rec + RO_RT + pc * 16) = *(const LAS u32x4*)((LAS unsigned char*)AR + (16 + row) * 144 + part * 16);
        }
        {
            u32x4 w0, w1;
            w0.x = cvt_pk_bf16(uh[0], uh[1]); w0.y = cvt_pk_bf16(uh[2], uh[3]); w0.z = cvt_pk_bf16(uh[4], uh[5]); w0.w = cvt_pk_bf16(uh[6], uh[7]);
            w1.x = cvt_pk_bf16(uh[8], uh[9]); w1.y = cvt_pk_bf16(uh[10], uh[11]); w1.z = cvt_pk_bf16(uh[12], uh[13]); w1.w = cvt_pk_bf16(uh[14], uh[15]);
            *(u32x4*)(rec + RO_U0T + lane * 32) = w0; *(u32x4*)(rec + RO_U0T + lane * 32 + 16) = w1;
            w0.x = cvt_pk_bf16(vt[0], vt[1]); w0.y = cvt_pk_bf16(vt[2], vt[3]); w0.z = cvt_pk_bf16(vt[4], vt[5]); w0.w = cvt_pk_bf16(vt[6], vt[7]);
            w1.x = cvt_pk_bf16(vt[8], vt[9]); w1.y = cvt_pk_bf16(vt[10], vt[11]); w1.z = cvt_pk_bf16(vt[12], vt[13]); w1.w = cvt_pk_bf16(vt[14], vt[15]);
            *(u32x4*)(rec + RO_VT + lane * 32) = w0; *(u32x4*)(rec + RO_VT + lane * 32 + 16) = w1;
        }
#pragma unroll
        for (int g = 0; g < 4; ++g) {
            u32x4 w; w.x = btp[2 * g]; w.y = btp[2 * g + 1]; w.z = ktp[2 * g]; w.w = ktp[2 * g + 1];
            *(u32x4*)(rec + RO_BKT + lane * 64 + g * 16) = w;
        }
        {
            const int t = lane >> 2, g = lane & 3;
            const f32x4 rb = *(const LAS f32x4*)(DM + (16 + t) * 36 + 4 * g), rk = *(const LAS f32x4*)(DM + (16 + t) * 36 + 16 + 4 * g);
            float o[8];
#pragma unroll
            for (int j = 0; j < 4; ++j) { const bool keep = (4 * g + j) <= t; o[j] = keep ? rb[j] : 0.f; o[4 + j] = keep ? rk[j] : 0.f; }
            u32x4 w; w.x = cvt_pk_bf16(o[0], o[1]); w.y = cvt_pk_bf16(o[2], o[3]); w.z = cvt_pk_bf16(o[4], o[5]); w.w = cvt_pk_bf16(o[6], o[7]);
            *(u32x4*)(rec + RO_ARK + t * 64 + g * 16) = w;
        }
        *(float*)(rec + RO_WCC + lane * 4) = wcc;
        if (!has_next) break;
        uid = nuid; b = nb_; h = nh; c = nc; col = ncol; row0 = nrow0;
#pragma unroll
        for (int t = 0; t < 16; ++t) q[t] = qn[t];
        prr = nprr; prk = nprk; prv = nprv;
        __builtin_amdgcn_sched_barrier(0);
    }
}

__device__ __forceinline__ void convert_expert_weights(const PPv& p, LAS unsigned char* lds, int first, int stride);
struct RecOps { bf16x8 wA0, wA1, rA0, rA1, ark, bk[4]; u32x2 u0, vv; f32x4 wc[4]; };
__device__ __forceinline__ void load_ops(RecOps& o, LAS unsigned char* S, int vs, int fr, int g) {
    o.wA0 = *(const LAS bf16x8*)(S + RO_WH + fr * 128 + g * 16); o.wA1 = *(const LAS bf16x8*)(S + RO_WH + fr * 128 + 64 + g * 16);
    o.rA0 = *(const LAS bf16x8*)(S + RO_RT + fr * 128 + g * 16); o.rA1 = *(const LAS bf16x8*)(S + RO_RT + fr * 128 + 64 + g * 16);
    o.u0 = *(const LAS u32x2*)(S + RO_U0T + (16 * vs + fr) * 32 + g * 8);
    o.vv = *(const LAS u32x2*)(S + RO_VT + (16 * vs + fr) * 32 + g * 8);
    o.ark = *(const LAS bf16x8*)(S + RO_ARK + fr * 64 + g * 16);
#pragma unroll
    for (int m = 0; m < 4; ++m) { o.bk[m] = *(const LAS bf16x8*)(S + RO_BKT + (16 * m + fr) * 64 + g * 16); o.wc[m] = *(const LAS f32x4*)(S + RO_WCC + (16 * m + 4 * g) * 4); }
}
__device__ __forceinline__ void phase_recur(const PPv& p, LAS unsigned char* lds) {
    const int tid = threadIdx.x, bid = blockIdx.x, nb = gridDim.x, lane = tid & 63, wave = __builtin_amdgcn_readfirstlane(tid >> 6);
    unsigned char* ws = p.gws();
    if (bid >= 64) { convert_expert_weights(p, lds, bid - 64, nb - 64); return; }
    unsigned char* CHb = ws + OFF_CH + (size_t)(bid * NCHUNK) * REC_BYTES;
    constexpr int RSLOT = REC_BYTES, RN = 10, PF = 7;
#define R_BAR() do { asm volatile("s_waitcnt lgkmcnt(0)" ::: "memory"); __builtin_amdgcn_s_barrier(); asm volatile("" ::: "memory"); } while (0)
    if (wave >= 4) {
        const int lw = wave - 4;
#define R_ISSUE(x) do { \
            LAS unsigned char* _s = lds + ((x) % RN) * RSLOT; const unsigned char* _r = CHb + (size_t)(x) * REC_BYTES + lane * 16; \
            _Pragma("unroll") for (int _i = 0; _i < 3; ++_i) { const int _pc = lw + 4 * _i; __builtin_amdgcn_global_load_lds((const unsigned*)(_r + _pc * 1024), (LAS unsigned*)(_s + _pc * 1024), 16, 0, 0); } \
            if (lw == 0) __builtin_amdgcn_global_load_lds((const unsigned*)(_r + 12 * 1024), (LAS unsigned*)(_s + 12 * 1024), 16, 0, 0); \
            if (lw == 1) { if (lane < 16) __builtin_amdgcn_global_load_lds((const unsigned*)(_r + 13 * 1024), (LAS unsigned*)(_s + 13 * 1024), 16, 0, 0); } } while (0)
        for (int x = 0; x < PF; ++x) R_ISSUE(x);
        asm volatile("s_waitcnt vmcnt(0)" ::: "memory");
        R_BAR();
        for (int c = 0; c < NCHUNK; ++c) {
            const int x = c + PF;
            if (x < NCHUNK) R_ISSUE(x);
            if (x < NCHUNK) { if (lw < 2) asm volatile("s_waitcnt vmcnt(20)" ::: "memory"); else asm volatile("s_waitcnt vmcnt(15)" ::: "memory"); }
            else asm volatile("s_waitcnt vmcnt(0)" ::: "memory");
            R_BAR();
        }
#undef R_ISSUE
    } else {
        const int vs = wave, fr = lane & 15, g = lane >> 4;
        f32x4 H[4];
#pragma unroll
        for (int m = 0; m < 4; ++m) H[m] = (f32x4){0.f, 0.f, 0.f, 0.f};
        R_BAR();
        RecOps cur, nxt;
        load_ops(cur, lds, vs, fr, g);
        for (int c = 0; c < NCHUNK; ++c) {
            if (c + 1 < NCHUNK) load_ops(nxt, lds + ((c + 1) % RN) * RSLOT, vs, fr, g); else nxt = cur;
            u32x4 hb0, hb1;
            hb0.x = cvt_pk_bf16(H[0][0], H[0][1]); hb0.y = cvt_pk_bf16(H[0][2], H[0][3]); hb0.z = cvt_pk_bf16(H[1][0], H[1][1]); hb0.w = cvt_pk_bf16(H[1][2], H[1][3]);
            hb1.x = cvt_pk_bf16(H[2][0], H[2][1]); hb1.y = cvt_pk_bf16(H[2][2], H[2][3]); hb1.z = cvt_pk_bf16(H[3][0], H[3][1]); hb1.w = cvt_pk_bf16(H[3][2], H[3][3]);
            const bf16x8 hB0 = __builtin_bit_cast(bf16x8, hb0), hB1 = __builtin_bit_cast(bf16x8, hb1);
            f32x4 U = (f32x4){bflo(cur.u0.x), bfhi(cur.u0.x), bflo(cur.u0.y), bfhi(cur.u0.y)};
            U = __builtin_amdgcn_mfma_f32_16x16x32_bf16(cur.wA0, hB0, U, 0, 0, 0);
            U = __builtin_amdgcn_mfma_f32_16x16x32_bf16(cur.wA1, hB1, U, 0, 0, 0);
            f32x4 Y = (f32x4){0.f, 0.f, 0.f, 0.f};
            Y = __builtin_amdgcn_mfma_f32_16x16x32_bf16(cur.rA0, hB0, Y, 0, 0, 0);
            Y = __builtin_amdgcn_mfma_f32_16x16x32_bf16(cur.rA1, hB1, Y, 0, 0, 0);
            u32x4 uvw; uvw.x = cvt_pk_bf16(U[0], U[1]); uvw.y = cvt_pk_bf16(U[2], U[3]); uvw.z = cur.vv.x; uvw.w = cur.vv.y;
            const bf16x8 uv = __builtin_bit_cast(bf16x8, uvw);
            Y = __builtin_amdgcn_mfma_f32_16x16x32_bf16(cur.ark, uv, Y, 0, 0, 0);
#pragma unroll
            for (int m = 0; m < 4; ++m) { H[m] = __builtin_amdgcn_mfma_f32_16x16x32_bf16(cur.bk[m], uv, H[m], 0, 0, 0); H[m] *= cur.wc[m]; }
            u32x2 yw; yw.x = cvt_pk_bf16(Y[0], Y[1]); yw.y = cvt_pk_bf16(Y[2], Y[3]);
            *(u32x2*)(CHb + (size_t)c * REC_BYTES + RO_U0T + (16 * vs + fr) * 32 + g * 8) = yw;
            R_BAR();
            cur = nxt;
        }
    }
#undef R_BAR
}

__device__ __forceinline__ void phase_gn(const PPv& p) {
    const int tid = threadIdx.x, bid = blockIdx.x, nb = gridDim.x, lane = tid & 63, wave = tid >> 6;
    unsigned char* ws = p.gws();
    const bf16_t* Gb = (const bf16_t*)(ws + OFF_G); const float* COEF = (const float*)(ws + OFF_COEF);
    bf16_t* Z = (bf16_t*)(ws + OFF_Z);
    constexpr int NREAL = 64 * 256;
    for (int r0 = bid * 8 + wave; r0 < NREAL; r0 += nb * 16) {
        u32x4 y0[2], y1[2], v0[2], v1[2]; float cfv[2][16]; bf16_t ggv[2][16]; int colv[2], row0v[2], hv[2]; bool okv[2];
#pragma unroll
        for (int u = 0; u < 2; ++u) {
            const int r = r0 + u * nb * 8; okv[u] = r < NREAL;
            const int rr = okv[u] ? r : r0;
            const int bh = rr >> 8, c = (rr & 255) + 1, b = bh >> 3, h = bh & 7, uid = bh * NCHUNK + c;
            hv[u] = h; colv[u] = h * 64 + lane; row0v[u] = b * SEQ + c * 16;
            const unsigned char* rec = ws + OFF_CH + (size_t)uid * REC_BYTES;
            y0[u] = *(const u32x4*)(rec + RO_U0T + lane * 32); y1[u] = *(const u32x4*)(rec + RO_U0T + lane * 32 + 16);
            v0[u] = *(const u32x4*)(rec + RO_VT + lane * 32); v1[u] = *(const u32x4*)(rec + RO_VT + lane * 32 + 16);
#pragma unroll
            for (int t = 0; t < 16; ++t) { cfv[u][t] = COEF[(size_t)(row0v[u] + t) * 8 + h]; ggv[u][t] = Gb[(size_t)(row0v[u] + t) * 512 + colv[u]]; }
        }
#pragma unroll
        for (int u = 0; u < 2; ++u) {
            if (!okv[u]) continue;
            const int col = colv[u], row0 = row0v[u];
            const float lng = p.gin(21)[col], lnb = p.gin(22)[col];
            const unsigned yw[8] = {y0[u].x, y0[u].y, y0[u].z, y0[u].w, y1[u].x, y1[u].y, y1[u].z, y1[u].w}, vw[8] = {v0[u].x, v0[u].y, v0[u].z, v0[u].w, v1[u].x, v1[u].y, v1[u].z, v1[u].w};
#pragma unroll
            for (int t = 0; t < 16; ++t) {
                const float y = (t & 1) ? bfhi(yw[t >> 1]) : bflo(yw[t >> 1]);
                const float v = (t & 1) ? bfhi(vw[t >> 1]) : bflo(vw[t >> 1]);
                const float mean = wave_sum_dpp(y) * (1.0f / 64.0f);
                const float dlt = y - mean;
                const float var = wave_sum_dpp(dlt * dlt) * (1.0f / 64.0f);
                const float yn = dlt * rsqrtf(var + LNX_EPS) * lng + lnb;
                Z[(size_t)(row0 + t - NMETA) * 512 + col] = f2bf((yn + cfv[u][t] * v) * bf2f(ggv[u][t]));
            }
        }
    }
}

__device__ __forceinline__ void convert_expert_weights(const PPv& p, LAS unsigned char* lds, int first, int stride) {
    unsigned char* ws = p.gws();
    const int tid = threadIdx.x;
    LAS float* tile = (LAS float*)lds;
    const float* g2 = p.gin(27);
    bf16_t* WGU = (bf16_t*)(ws + OFF_WGU); bf16_t* WD = (bf16_t*)(ws + OFF_WD);
    constexpr int NBLK = NE * 3 * 64;
    const int lr = tid >> 6, lc = (tid & 63) * 4;
    f32x4 cur[8];
    int j = first;
    if (j >= NBLK) return;
    {
        const int mat = j >> 6, e = mat / 3, which = mat - 3 * e, bb = j & 63, kb = bb & 15, nbk = bb >> 4;
        const float* src = (which == 0 ? p.gin(30) : which == 1 ? p.gin(32) : p.gin(34)) + (size_t)e * 1024 * 1024 + (size_t)(kb * 64) * 1024 + nbk * 256;
#pragma unroll
        for (int i = 0; i < 8; ++i) cur[i] = __builtin_nontemporal_load((const f32x4*)(src + (size_t)(lr + 8 * i) * 1024 + lc));
    }
    for (;;) {
        const int jn = j + stride; const bool has_next = jn < NBLK;
        f32x4 nxt[8];
        if (has_next) {
            const int mat = jn >> 6, e = mat / 3, which = mat - 3 * e, bb = jn & 63, kb = bb & 15, nbk = bb >> 4;
            const float* src = (which == 0 ? p.gin(30) : which == 1 ? p.gin(32) : p.gin(34)) + (size_t)e * 1024 * 1024 + (size_t)(kb * 64) * 1024 + nbk * 256;
#pragma unroll
            for (int i = 0; i < 8; ++i) nxt[i] = __builtin_nontemporal_load((const f32x4*)(src + (size_t)(lr + 8 * i) * 1024 + lc));
        }
        const int mat = j >> 6, e = mat / 3, which = mat - 3 * e, bb = j & 63, kb = bb & 15, nbk = bb >> 4;
#pragma unroll
        for (int i = 0; i < 8; ++i) { LAS float* t = tile + (lr + 8 * i) * 257 + lc; t[0] = cur[i][0]; t[1] = cur[i][1]; t[2] = cur[i][2]; t[3] = cur[i][3]; }
        __syncthreads();
        {
            const int kq = tid & 7, k0 = kb * 64 + 8 * kq;
            float sc[8];
#pragma unroll
            for (int jj = 0; jj < 8; ++jj) sc[jj] = which < 2 ? g2[k0 + jj] : 1.0f;
#pragma unroll
            for (int i = 0; i < 4; ++i) {
                const int nn = (tid >> 3) + 64 * i, n = nbk * 256 + nn;
                float v[8];
#pragma unroll
                for (int jj = 0; jj < 8; ++jj) v[jj] = tile[(8 * kq + jj) * 257 + nn] * sc[jj];
                u32x4 w; w.x = cvt_pk_bf16(v[0], v[1]); w.y = cvt_pk_bf16(v[2], v[3]); w.z = cvt_pk_bf16(v[4], v[5]); w.w = cvt_pk_bf16(v[6], v[7]);
                bf16_t* dst = which < 2 ? WGU + (size_t)e * 2048 * 1024 + (size_t)(256 * (n >> 7) + 128 * which + (n & 127)) * 1024
                                        : WD + (size_t)e * 1024 * 1024 + (size_t)n * 1024;
                __builtin_nontemporal_store(w, (u32x4*)(dst + k0));
            }
        }
        __syncthreads();
        if (!has_next) break;
        j = jn;
#pragma unroll
        for (int i = 0; i < 8; ++i) cur[i] = nxt[i];
    }
}

__device__ __forceinline__ void phase_router(const PPv& p, LAS unsigned char* lds) {
    const int tid = threadIdx.x, bid = blockIdx.x, nb = gridDim.x, lane = tid & 63, wave = tid >> 6;
    unsigned char* ws = p.gws();
    const bf16_t* h1 = (const bf16_t*)(ws + OFF_HB2);
    const float* WRG = (const float*)(ws + OFF_WRG);
    const float* brt = p.gin(29);
    LAS float* slog = (LAS float*)lds;
    LAS float* srs = slog + 8 * 16 * 32;
    LAS int* lcnt = (LAS int*)(srs + 128);
    LAS int* gbase = lcnt + 32;
    LAS int* ltopi = gbase + 32;
    LAS int* lrank = ltopi + 512;
    int* TOPI = (int*)(ws + OFF_TOPI); float* TOPW = (float*)(ws + OFF_TOPW); int* RANK = (int*)(ws + OFF_RANK); float* RSTD2 = (float*)(ws + OFF_RSTD2);
    int* GCNT = (int*)(ws + OFF_GCNT);
    for (int tb = bid; tb < T / 128; tb += nb) {
        if (tid < 32) lcnt[tid] = 0;
        __syncthreads();
        const int t0 = tb * 128 + wave * 16;
        {
            const int row = lane & 15, kq = lane >> 4;
            const bf16_t* ap = h1 + (size_t)(t0 + row) * D + 4 * kq;
            const float* bp = WRG + (size_t)(4 * kq) * 32 + row;
            f32x4 acc0 = (f32x4){0.f, 0.f, 0.f, 0.f}, acc1 = acc0;
            float ss = 0.f;
            for (int j = 0; j < 64; ++j) {
                const u32x2 aw = *(const u32x2*)(ap + 16 * j);
                const f32x4 av = (f32x4){bflo(aw.x), bfhi(aw.x), bflo(aw.y), bfhi(aw.y)};
                ss += av[0] * av[0] + av[1] * av[1] + av[2] * av[2] + av[3] * av[3];
                const float* bj = bp + (size_t)(16 * j) * 32;
#pragma unroll
                for (int s = 0; s < 4; ++s) {
                    const float b0 = bj[s * 32], b1 = bj[s * 32 + 16];
                    acc0 = __builtin_amdgcn_mfma_f32_16x16x4f32(av[s], b0, acc0, 0, 0, 0);
                    acc1 = __builtin_amdgcn_mfma_f32_16x16x4f32(av[s], b1, acc1, 0, 0, 0);
                }
            }
            ss += __shfl_xor(ss, 16); ss += __shfl_xor(ss, 32);
#pragma unroll
            for (int reg = 0; reg < 4; ++reg) {
                slog[(wave * 16 + 4 * kq + reg) * 32 + row] = acc0[reg];
                slog[(wave * 16 + 4 * kq + reg) * 32 + 16 + row] = acc1[reg];
            }
            if (lane < 16) srs[wave * 16 + lane] = rsqrtf(ss * (1.0f / D) + NORM_EPS);
        }
        __syncthreads();
        if (lane < 16) {
            const int tl = wave * 16 + lane, t = tb * 128 + tl;
            const float rs = srs[tl];
            float lg[32];
#pragma unroll
            for (int e = 0; e < 32; ++e) lg[e] = slog[tl * 32 + e] * rs + brt[e];
            int ti[4]; float tv[4];
#pragma unroll
            for (int k = 0; k < 4; ++k) {
                float best = -3.0e38f; int bi = 0;
#pragma unroll
                for (int e = 0; e < 32; ++e) { const bool tk = lg[e] > best; best = tk ? lg[e] : best; bi = tk ? e : bi; }
                ti[k] = bi; tv[k] = best;
#pragma unroll
                for (int e = 0; e < 32; ++e) lg[e] = (e == bi) ? -3.0e38f : lg[e];
            }
            const float e0 = 1.0f, e1 = __expf(tv[1] - tv[0]), e2 = __expf(tv[2] - tv[0]), e3 = __expf(tv[3] - tv[0]);
            const float inv = 1.0f / (e0 + e1 + e2 + e3);
            *(f32x4*)(TOPW + (size_t)t * 4) = (f32x4){e0 * inv, e1 * inv, e2 * inv, e3 * inv};
            RSTD2[t] = rs;
#pragma unroll
            for (int k = 0; k < 4; ++k) { ltopi[tl * 4 + k] = ti[k]; lrank[tl * 4 + k] = __hip_atomic_fetch_add(lcnt + ti[k], 1, __ATOMIC_RELAXED, __HIP_MEMORY_SCOPE_WORKGROUP); }
        }
        __syncthreads();
        if (tid < 32) gbase[tid] = atomicAdd(GCNT + tid, lcnt[tid]);
        __syncthreads();
        {
            const int e = ltopi[tid];
            TOPI[(size_t)tb * 512 + tid] = e;
            RANK[(size_t)tb * 512 + tid] = gbase[e] + lrank[tid];
        }
        __syncthreads();
    }
}

__device__ __forceinline__ void phase_lists(const PPv& p, LAS unsigned char* lds) {
    const int tid = threadIdx.x, bid = blockIdx.x, nb = gridDim.x;
    unsigned char* ws = p.gws();
    LAS int* pstart = (LAS int*)lds;
    LAS int* cnt = pstart + 64;
    const int* GCNT = (const int*)(ws + OFF_GCNT);
    if (tid < 32) cnt[tid] = GCNT[tid];
    __syncthreads();
    if (tid == 0) { int s = 0; for (int e = 0; e < 32; ++e) { pstart[e] = s; s += ((cnt[e] + 255) >> 8) << 8; } pstart[32] = s; }
    __syncthreads();
    const int* TOPI = (const int*)(ws + OFF_TOPI); const float* TOPW = (const float*)(ws + OFF_TOPW); const int* RANK = (const int*)(ws + OFF_RANK); const float* RSTD2 = (const float*)(ws + OFF_RSTD2);
    int* ROWTOK = (int*)(ws + OFF_ROWTOK); int* ROWSLOT = (int*)(ws + OFF_ROWSLOT); float* ROWW = (float*)(ws + OFF_ROWW); float* ROWRS = (float*)(ws + OFF_ROWRS);
    for (int i = bid * 512 + tid; i < T * 4; i += nb * 512) {
        const int e = TOPI[i], pos = pstart[e] + RANK[i], t = i >> 2;
        ROWTOK[pos] = t; ROWSLOT[pos] = i; ROWW[pos] = TOPW[i]; ROWRS[pos] = RSTD2[t];
    }
    for (int e = bid; e < 32; e += nb) {
        for (int pos = pstart[e] + cnt[e] + tid; pos < pstart[e + 1]; pos += 512) { ROWTOK[pos] = 0; ROWSLOT[pos] = -1; ROWW[pos] = 0.f; ROWRS[pos] = 0.f; }
    }
    if (bid == 0) {
        int* TILEE = (int*)(ws + OFF_TILEE);
        const int ntiles = pstart[32] >> 8;
        for (int mt = tid; mt < ntiles; mt += 512) { int e = 0; for (int q = 0; q < 32; ++q) if (pstart[q] <= mt * 256) e = q; TILEE[mt] = e; }
        if (tid == 0) TILEE[1000] = ntiles;
    }
    __syncthreads();
}

__device__ __forceinline__ void phase_final(const PPv& p) {
    const int tid = threadIdx.x, bid = blockIdx.x, nb = gridDim.x, lane = tid & 63, wave = tid >> 6;
    unsigned char* ws = p.gws();
    const bf16_t* HB2 = (const bf16_t*)(ws + OFF_HB2);
    const bf16_t* YA = (const bf16_t*)p.gout(); const bf16_t* YB = (const bf16_t*)(ws + OFF_WGU);
    const float* gf = p.gin(36);
    const f32x4 ga0 = *(const f32x4*)(gf + 8 * lane), ga1 = *(const f32x4*)(gf + 8 * lane + 4), gb0 = *(const f32x4*)(gf + 512 + 8 * lane), gb1 = *(const f32x4*)(gf + 512 + 8 * lane + 4);
    for (int t0 = (bid * 8 + wave) * 2; t0 < T; t0 += nb * 16) {
        u32x4 ha[2], hb[2], ya[2][4], yb[2][4];
#pragma unroll
        for (int u = 0; u < 2; ++u) {
            const int t = t0 + u;
            ha[u] = __builtin_nontemporal_load((const u32x4*)(HB2 + (size_t)t * D + 8 * lane)); hb[u] = __builtin_nontemporal_load((const u32x4*)(HB2 + (size_t)t * D + 512 + 8 * lane));
#pragma unroll
            for (int k = 0; k < 4; ++k) { ya[u][k] = __builtin_nontemporal_load((const u32x4*)(YA + (size_t)(4 * t + k) * 512 + 8 * lane)); yb[u][k] = __builtin_nontemporal_load((const u32x4*)(YB + (size_t)(4 * t + k) * 512 + 8 * lane)); }
        }
#pragma unroll
        for (int u = 0; u < 2; ++u) {
            const int t = t0 + u;
            float va[8] = {bflo(ha[u].x), bfhi(ha[u].x), bflo(ha[u].y), bfhi(ha[u].y), bflo(ha[u].z), bfhi(ha[u].z), bflo(ha[u].w), bfhi(ha[u].w)};
            float vb[8] = {bflo(hb[u].x), bfhi(hb[u].x), bflo(hb[u].y), bfhi(hb[u].y), bflo(hb[u].z), bfhi(hb[u].z), bflo(hb[u].w), bfhi(hb[u].w)};
#pragma unroll
            for (int k = 0; k < 4; ++k) {
                const u32x4 a4 = ya[u][k], b4 = yb[u][k];
                va[0] += bflo(a4.x); va[1] += bfhi(a4.x); va[2] += bflo(a4.y); va[3] += bfhi(a4.y); va[4] += bflo(a4.z); va[5] += bfhi(a4.z); va[6] += bflo(a4.w); va[7] += bfhi(a4.w);
                vb[0] += bflo(b4.x); vb[1] += bfhi(b4.x); vb[2] += bflo(b4.y); vb[3] += bfhi(b4.y); vb[4] += bflo(b4.z); vb[5] += bfhi(b4.z); vb[6] += bflo(b4.w); vb[7] += bfhi(b4.w);
            }
            float ss = 0.f;
#pragma unroll
            for (int j = 0; j < 8; ++j) ss += va[j] * va[j] + vb[j] * vb[j];
            ss = wave_sum_dpp(ss);
            const float rs = rsqrtf(ss * (1.0f / D) + NORM_EPS);
            float* o = p.gout() + (size_t)t * D;
            __builtin_nontemporal_store((f32x4){va[0] * rs * ga0[0], va[1] * rs * ga0[1], va[2] * rs * ga0[2], va[3] * rs * ga0[3]}, (f32x4*)(o + 8 * lane));
            __builtin_nontemporal_store((f32x4){va[4] * rs * ga1[0], va[5] * rs * ga1[1], va[6] * rs * ga1[2], va[7] * rs * ga1[3]}, (f32x4*)(o + 8 * lane + 4));
            __builtin_nontemporal_store((f32x4){vb[0] * rs * gb0[0], vb[1] * rs * gb0[1], vb[2] * rs * gb0[2], vb[3] * rs * gb0[3]}, (f32x4*)(o + 512 + 8 * lane));
            __builtin_nontemporal_store((f32x4){vb[4] * rs * gb1[0], vb[5] * rs * gb1[1], vb[6] * rs * gb1[2], vb[7] * rs * gb1[3]}, (f32x4*)(o + 512 + 8 * lane + 4));
        }
    }
}

#define XB_TMO      128
#define XB_XCNT(j)  (256  + 64 * (j))
#define XB_XSUB(j)  (1280 + 64 * (j))
#define XB_XGEN(j)  (2304 + 64 * (j))
#define XB_TOP      3328
#define XB_TOPGEN   3392
#define XCD_BAR_WORDS 3456
#define XB_SPIN_CAP (1u << 18)
__device__ __forceinline__ unsigned xb_ld(unsigned* p)              { return __hip_atomic_load(p, __ATOMIC_RELAXED, __HIP_MEMORY_SCOPE_AGENT); }
__device__ __forceinline__ unsigned xb_add(unsigned* p, unsigned v) { return __hip_atomic_fetch_add(p, v, __ATOMIC_RELAXED, __HIP_MEMORY_SCOPE_AGENT); }
__device__ __forceinline__ unsigned xb_xcc_id() { return (unsigned)__builtin_amdgcn_s_getreg((3 << 11) | 20) & 0xFu; }
#define XB_SPIN(cond, bar) do { unsigned _sp = 0; while (cond) { __builtin_amdgcn_s_sleep(1); \
    if ((++_sp & 255u) == 0u) { if (xb_ld(&(bar)[XB_TMO])) break; if (_sp > XB_SPIN_CAP) { atomicAdd(&(bar)[XB_TMO], 1u); break; } } } } while (0)
struct XcdBarrier { unsigned* bar; unsigned x; volatile LAS unsigned* st; };
__device__ __forceinline__ XcdBarrier xcd_barrier_post(unsigned* bar, volatile LAS unsigned* st) {
    XcdBarrier b; b.bar = bar; b.x = xb_xcc_id(); b.st = st;
    if (threadIdx.x == 0) (void)xb_add(&bar[XB_XCNT(b.x)], 1u);
    return b;
}
__device__ __forceinline__ void xcd_barrier_complete(unsigned* bar, unsigned x, unsigned& nloc, unsigned& nx) {
    const unsigned G = gridDim.x * gridDim.y * gridDim.z;
    unsigned sum, cnt, mine, sp = 0u;
    for (;;) {
        sum = 0u; cnt = 0u; mine = 0u;
#pragma unroll
        for (unsigned j = 0; j < 16; ++j) { const unsigned c = xb_ld(&bar[XB_XCNT(j)]); sum += c; cnt += (c > 0u) ? 1u : 0u; mine = (j == x) ? c : mine; }
        if (sum == G) break;
        __builtin_amdgcn_s_sleep(1);
        if ((++sp & 255u) == 0u) { if (xb_ld(&bar[XB_TMO])) break; if (sp > XB_SPIN_CAP) { atomicAdd(&bar[XB_TMO], 1u); break; } }
    }
    nloc = mine > 0u ? mine : 1u; nx = cnt > 0u ? cnt : 1u;
}
__device__ __forceinline__ void xcd_barrier(const XcdBarrier& b) {
    asm volatile("s_waitcnt vmcnt(0)" ::: "memory");
    __syncthreads();
    if (threadIdx.x == 0) {
        unsigned* bar = b.bar;
        __builtin_amdgcn_s_waitcnt(0);
        unsigned nloc = b.st[0], nx = b.st[1];
        if (nloc == 0u) { xcd_barrier_complete(bar, b.x, nloc, nx); b.st[0] = nloc; b.st[1] = nx; }
        const unsigned old = xb_add(&bar[XB_XSUB(b.x)], 1u);
        const unsigned gen = old / nloc;
        if (old + 1u == (gen + 1u) * nloc) {
            __builtin_amdgcn_fence(__ATOMIC_RELEASE, "agent");
            asm volatile("s_waitcnt vmcnt(0)" ::: "memory");
            const unsigned og = xb_add(&bar[XB_TOP], 1u);
            const unsigned tg = og / nx;
            if (og + 1u == (tg + 1u) * nx) xb_add(&bar[XB_TOPGEN], 1u);
            else XB_SPIN(xb_ld(&bar[XB_TOPGEN]) == tg, bar);
            __builtin_amdgcn_fence(__ATOMIC_ACQUIRE, "agent");
            xb_add(&bar[XB_XGEN(b.x)], 1u);
            asm volatile("s_waitcnt vmcnt(0)" ::: "memory");
        } else {
            XB_SPIN(xb_ld(&bar[XB_XGEN(b.x)]) == gen, bar);
            __builtin_amdgcn_fence(__ATOMIC_ACQUIRE, "agent");
            asm volatile("s_waitcnt vmcnt(0)" ::: "memory");
        }
    }
    __syncthreads();
}

constexpr int N_PHASES = 15;
__global__ void __launch_bounds__(512, 2) mega(Params p) {
    extern __shared__ __attribute__((aligned(16))) unsigned char lds_raw[];
    LAS unsigned char* lds = (LAS unsigned char*)lds_raw;
    cg::grid_group grid = cg::this_grid();
    unsigned char* ws = getpp().gws();
    const int G = gridDim.x, bid = blockIdx.x;
#ifndef ONLY_PHASE
#define ONLY_PHASE -1
#endif
#define IN(k) ((ONLY_PHASE < 0 || ONLY_PHASE == (k)) && p.ph_lo <= (k) && (k) < p.ph_hi)
    volatile LAS unsigned* xst = (volatile LAS unsigned*)(lds + 163840 - 16);
    if (threadIdx.x < 4) xst[threadIdx.x] = 0u;
    __syncthreads();
    const XcdBarrier xbar = xcd_barrier_post((unsigned*)(ws + OFF_BAR), xst);
    if (p.ph_hi < 0) grid.sync();
#define SEAM(k) do { if ((k) + 1 < p.ph_hi) xcd_barrier(xbar); } while (0)
    if (IN(0)) { const PPv q = getpp(); phase_prep(q, lds); SEAM(0); }
    if (IN(1)) { const PPv q = getpp();
        phase_meta_proj(q, lds);
        StaticOrder S; S.init(ws + OFF_HB, ws + OFF_WIN, T, NCOLS1, 1024, G, bid);
        EpiProj E{(bf16_t*)(ws + OFF_PRKV), (bf16_t*)(ws + OFF_PCONV), (bf16_t*)q.gout(), (const float*)(ws + OFF_RSTD1)};
        gemm_phase<false>(lds, 1024, S, E);
        SEAM(1);
    }
    if (IN(2)) { const PPv q = getpp(); phase_lprep_conv(q); SEAM(2); }
    if (IN(3)) { const PPv q = getpp();
        phase_meta_lora(q);
        StaticOrder S; S.init(ws + OFF_L + (size_t)NMETA * 256 * 2, ws + OFF_W2, T, 1536, 256, G, bid);
        EpiL E{ws, q.gin(10), q.gin(13)};
        gemm_phase<false>(lds, 256, S, E);
        SEAM(3);
    }
    if (IN(4)) { const PPv q = getpp(); phase_scanprep(q, lds); SEAM(4); }
    if (IN(5)) { const PPv q = getpp(); phase_recur(q, lds); SEAM(5); }
    if (IN(6)) { const PPv q = getpp(); phase_gn(q); SEAM(6); }
    if (IN(7)) { const PPv q = getpp();
        MergeOrder S; S.so.init(ws + OFF_Z, ws + OFF_WR, T, 1024, 512, G, bid); S.A1 = (const char*)(ws + OFF_C); S.B1 = (const char*)(ws + OFF_WC);
        EpiMergeFused E{(bf16_t*)(ws + OFF_MERGED), (const bf16_t*)q.gout()};
        gemm_phase<false>(lds, 512, S, E);
        SEAM(7);
    }
    if (IN(9)) { const PPv q = getpp();
        StaticOrder S; S.init(ws + OFF_MERGED, ws + OFF_WO, T, 1024, 1024, G, bid);
        EpiO E{q.gin(0), q.gout(), (bf16_t*)(ws + OFF_HB2)};
        gemm_phase<false>(lds, 1024, S, E);
        SEAM(9);
    }
    if (IN(10)) { const PPv q = getpp(); phase_router(q, lds); SEAM(10); }
    if (IN(11)) { const PPv q = getpp(); phase_lists(q, lds); SEAM(11); }
    if (IN(12)) { const PPv q = getpp();
        const int* TILEE = (const int*)(ws + OFF_TILEE);
        MoeOrder S; S.A = (const char*)(ws + OFF_HB2); S.Bt = (const char*)(ws + OFF_WGU); S.K = 1024; S.estride = (size_t)2048 * 1024 * 2;
        S.tile_e = TILEE; S.rowtok = (const int*)(ws + OFF_ROWTOK); S.ntiles = TILEE[1000]; S.nnt = 8; S.G = G; S.c = bid; S.gather = true;
        EpiMoe1 E{(bf16_t*)(ws + OFF_ACT), (const float*)(ws + OFF_ROWRS), q.gin(31), q.gin(33)};
        gemm_phase<true>(lds, 1024, S, E);
        SEAM(12);
    }
    if (IN(13)) { const PPv q = getpp();
        const int* TILEE = (const int*)(ws + OFF_TILEE);
        MoeOrder S; S.A = (const char*)(ws + OFF_ACT); S.Bt = (const char*)(ws + OFF_WD); S.K = 1024; S.estride = (size_t)1024 * 1024 * 2;
        S.tile_e = TILEE; S.rowtok = nullptr; S.ntiles = TILEE[1000]; S.nnt = 4; S.G = G; S.c = bid; S.gather = false;
        EpiMoe2 E{(bf16_t*)q.gout(), (bf16_t*)(ws + OFF_WGU), (const int*)(ws + OFF_ROWSLOT), (const float*)(ws + OFF_ROWW), q.gin(35)};
        gemm_phase<false>(lds, 1024, S, E);
        SEAM(13);
    }
    if (IN(14)) { const PPv q = getpp(); phase_final(q); }
}

extern "C" void kernel_launch(void* const* d_in, const int* in_sizes, int n_in, void* d_out, int out_size, void* d_ws, size_t ws_size,
                              hipStream_t stream) {
    constexpr size_t kDynLds = 160 * 1024;
    static int grid_blocks = 0;
    if (!grid_blocks) {
        int dev = 0, cus = 0, per_cu = 0;
        (void)hipGetDevice(&dev);
        (void)hipDeviceGetAttribute(&cus, hipDeviceAttributeMultiprocessorCount, dev);
        (void)hipFuncSetAttribute((const void*)mega, hipFuncAttributeMaxDynamicSharedMemorySize, (int)kDynLds);
        (void)hipOccupancyMaxActiveBlocksPerMultiprocessor(&per_cu, mega, 512, kDynLds);
        if (per_cu > 1) per_cu = 1;
        grid_blocks = cus * per_cu;
        fprintf(stderr, "cus=%d per_cu=%d ws_size=%zu need=%zu\n", cus, per_cu, ws_size, (size_t)WS_NEED);
    }
    if (ws_size < WS_NEED || n_in < 37 || grid_blocks < 64) { fprintf(stderr, "kernel_launch: unsupported configuration\n"); return; }
    Params p{};
    for (int i = 0; i < 37; ++i) p.in[i] = (const float*)d_in[i];
    p.out = (float*)d_out;
    p.ws = (unsigned char*)d_ws;
    p.ph_lo = 0; p.ph_hi = N_PHASES;
    (void)hipMemsetAsync((unsigned char*)d_ws + OFF_BAR, 0, 16384, stream);
    void* args[] = {&p};
    hipError_t e = hipLaunchCooperativeKernel((void*)mega, dim3(grid_blocks), dim3(512), args, kDynLds, stream);
    if (e != hipSuccess) fprintf(stderr, "cooperative launch failed: %s (grid %d)\n", hipGetErrorString(e), grid_blocks);
}
```

```cpp
#include <hip/hip_runtime.h>
#include <hip/hip_cooperative_groups.h>
#include <cstdio>
namespace cg = cooperative_groups;

#define LAS __attribute__((address_space(3)))
typedef unsigned short bf16_t;
typedef short bf16x8 __attribute__((ext_vector_type(8)));
typedef float f32x4 __attribute__((ext_vector_type(4)));
typedef float f32x2 __attribute__((ext_vector_type(2)));
typedef unsigned u32x4 __attribute__((ext_vector_type(4)));
typedef unsigned u32x2 __attribute__((ext_vector_type(2)));

constexpr int D = 1024, NBATCH = 8, SEQ = 4096, NMETA = 16;
constexpr int T = NBATCH * SEQ;
constexpr int NR = T + NMETA;
constexpr int NRP = 33024;
constexpr int PCOLS1 = 3584;
constexpr int NCOLS1 = 5632;
constexpr int NE = 32, TOPK = 4, DFF = 1024;
constexpr int MAXROWS = T * TOPK + NE * 256;
constexpr int MAXTILES = MAXROWS / 256;
constexpr float NORM_EPS = 1e-5f, LNX_EPS = 64e-5f;

constexpr int NCHUNK = 257, NUNITS = 64 * NCHUNK;
constexpr int REC_BYTES = 13568;
constexpr int RO_WH = 0, RO_RT = 2048, RO_U0T = 4096, RO_VT = 6144, RO_BKT = 8192, RO_ARK = 12288, RO_WCC = 13312;
constexpr int SLOT_BYTES = 15680, SO_G = 13568, SO_COEF = 15616, NSLOT = 9;
constexpr size_t SZ_ACT = (size_t)MAXROWS * 1024 * 2;
constexpr size_t SZ_WGU = (size_t)NE * 2048 * 1024 * 2;
constexpr size_t SZ_WD = (size_t)NE * 1024 * 1024 * 2;
constexpr size_t SZ_HB = (size_t)T * 1024 * 2;
constexpr size_t OFF_WGU = 0;
constexpr size_t OFF_WD = OFF_WGU + SZ_WGU;
constexpr size_t OFF_ACT = OFF_WD + SZ_WD;
constexpr size_t OFF_HB2 = OFF_ACT + SZ_ACT;
constexpr size_t OFF_RT = OFF_HB2 + SZ_HB;
constexpr size_t OFF_TOPI = OFF_RT;
constexpr size_t OFF_TOPW = OFF_TOPI + (size_t)T * 16;
constexpr size_t OFF_RANK = OFF_TOPW + (size_t)T * 16;
constexpr size_t OFF_RSTD2 = OFF_RANK + (size_t)T * 16;
constexpr size_t OFF_ROWTOK = OFF_RSTD2 + (size_t)T * 4;
constexpr size_t OFF_ROWSLOT = OFF_ROWTOK + (size_t)MAXROWS * 4;
constexpr size_t OFF_ROWW = OFF_ROWSLOT + (size_t)MAXROWS * 4;
constexpr size_t OFF_ROWRS = OFF_ROWW + (size_t)MAXROWS * 4;
constexpr size_t OFF_TILEE = OFF_ROWRS + (size_t)MAXROWS * 4;
constexpr size_t OFF_GCNT = OFF_TILEE + 4096;
constexpr size_t OFF_SM = OFF_GCNT + 256;
constexpr size_t OFF_WR = OFF_SM;
constexpr size_t OFF_WC = OFF_WR + (size_t)1024 * 512 * 2;
constexpr size_t OFF_WO = OFF_WC + (size_t)1024 * 512 * 2;
constexpr size_t OFF_W2 = OFF_WO + (size_t)1024 * 1024 * 2;
constexpr size_t OFF_RSTD1 = OFF_W2 + (size_t)1536 * 256 * 2;
constexpr size_t OFF_WRG = OFF_RSTD1 + (size_t)NRP * 4;
constexpr size_t OFF_BAR = OFF_WRG + (size_t)1024 * 32 * 4;
constexpr size_t WS_NEED = OFF_BAR + 16384;
constexpr size_t OFF_PRKV = 0;
constexpr size_t SZ_PRKV = (size_t)NR * 1536 * 2;
constexpr size_t OFF_LD = OFF_PRKV + SZ_PRKV;
constexpr size_t OFF_A = OFF_LD + (size_t)NRP * 512 * 4;
constexpr size_t OFF_CH = OFF_A + (size_t)NRP * 512 * 2;
constexpr size_t OFF_PCONV = OFF_CH;
constexpr size_t SZ_PCONV = (size_t)NR * 2048 * 2;
constexpr size_t OFF_HB = OFF_PCONV + SZ_PCONV;
constexpr size_t OFF_L = OFF_HB + SZ_HB;
constexpr size_t OFF_WIN = OFF_L + (size_t)NRP * 256 * 2;
constexpr size_t CH_END = OFF_WIN + (size_t)NCOLS1 * 1024 * 2;
constexpr size_t OFF_MERGED = OFF_CH;
constexpr size_t OFF_G = CH_END;
constexpr size_t OFF_C = OFF_G + (size_t)NRP * 512 * 2;
constexpr size_t OFF_Z = OFF_C + (size_t)T * 512 * 2;
constexpr size_t OFF_COEF = OFF_Z + (size_t)T * 512 * 2;
constexpr size_t EARLY_END = OFF_COEF + (size_t)NR * 8 * 4;
static_assert(EARLY_END <= OFF_RT, "early buffers overflow");
static_assert(OFF_CH + (size_t)NUNITS * REC_BYTES <= CH_END, "chunk records overflow");
static_assert(OFF_CH >= OFF_WD + SZ_WD, "expert weights (written during the scan) must not touch live scan buffers");
static_assert(OFF_MERGED + SZ_HB <= OFF_HB2, "layout");
static_assert(OFF_PRKV % 16 == 0 && OFF_LD % 16 == 0 && OFF_A % 16 == 0 && OFF_CH % 16 == 0 && OFF_HB % 16 == 0 && OFF_L % 16 == 0 && OFF_WIN % 16 == 0 && OFF_G % 16 == 0 && OFF_C % 16 == 0 && OFF_Z % 16 == 0 && OFF_COEF % 16 == 0, "align");

#define GAS __attribute__((address_space(1)))
#define CAS __attribute__((address_space(4)))
struct Params {
    const float* in[37];
    float* out;
    unsigned char* ws;
    int ph_lo, ph_hi;
};
struct ParamsD {
    const GAS float* in[37];
    GAS float* out;
    GAS unsigned char* ws;
    int ph_lo, ph_hi;
};
static_assert(sizeof(Params) == sizeof(ParamsD), "argument views");
struct PPv {
    const CAS ParamsD* k;
    __device__ __forceinline__ const float* gin(int i) const { return (const float*)k->in[i]; }
    __device__ __forceinline__ float* gout() const { return (float*)k->out; }
    __device__ __forceinline__ unsigned char* gws() const { return (unsigned char*)k->ws; }
};
__device__ __forceinline__ PPv getpp() { const CAS ParamsD* k = (const CAS ParamsD*)__builtin_amdgcn_kernarg_segment_ptr(); asm volatile("" : "+s"(k)); return PPv{k}; }

typedef __bf16 bf16x2v __attribute__((ext_vector_type(2)));
__device__ __forceinline__ unsigned cvt_pk_bf16(float lo, float hi) { const f32x2 v = {lo, hi}; return __builtin_bit_cast(unsigned, __builtin_convertvector(v, bf16x2v)); }
__device__ __forceinline__ bf16_t f2bf(float f) { unsigned u = __float_as_uint(f); u += 0x7FFFu + ((u >> 16) & 1u); return (bf16_t)(u >> 16); }
__device__ __forceinline__ float bf2f(bf16_t b) { return __uint_as_float(((unsigned)b) << 16); }
__device__ __forceinline__ float bflo(unsigned w) { return __uint_as_float(w << 16); }
__device__ __forceinline__ float bfhi(unsigned w) { return __uint_as_float(w & 0xFFFF0000u); }
__device__ __forceinline__ float sigmoidf_(float x) { return __builtin_amdgcn_rcpf(1.0f + __expf(-x)); }
__device__ __forceinline__ float wave_sum(float v) {
#pragma unroll
    for (int o = 32; o >= 1; o >>= 1) v += __shfl_xor(v, o);
    return v;
}
__device__ __forceinline__ float wave_sum_dpp(float v);
__device__ __forceinline__ int prev_row(int row, int d) {
    if (row < NMETA) return row - d >= 0 ? row - d : -1;
    const int s = (row - NMETA) & (SEQ - 1);
    return s >= d ? row - d : NMETA + s - d;
}

constexpr int BM = 256, BK = 64, HALF = 128, HTB = HALF * BK * 2, STAGE_BYTES = 8 * HTB, NXCD = 8, WGM = 8;
__device__ __forceinline__ int lds_byte(int r, int c) { const int st = (r >> 4) * 2 + (c >> 5), rr = r & 15, cc = c & 31, ob = rr * 64 + cc * 2; return st * 1024 + (ob ^ (((ob >> 9) & 1) << 5)); }
__device__ __forceinline__ void stage_rc(int b, int& R, int& C) { const int st = b / 1024, sb = b % 1024, swz = sb ^ (((sb >> 9) & 1) << 5); R = (st >> 1) * 16 + swz / 64; C = (st & 1) * 32 + (swz % 64) / 2; }
__device__ __forceinline__ int perm32(int rho) { const int n = rho >> 4, i = rho & 15; return 8 * (i >> 2) + 4 * n + (i & 3); }

struct Unit { int pm, pn, aux; };

struct StaticOrder {
    const char* A; const char* Bt; int K;
    int nM, nN, nwg, G, c;
    __device__ void init(const void* A_, const void* Bt_, int M, int N, int K_, int G_, int c_) { A = (const char*)A_; Bt = (const char*)Bt_; K = K_; nM = M / BM; nN = N / BM; nwg = nM * nN; G = G_; c = c_; }
    __device__ bool next(int i, Unit& u) const {
        const long L = (long)i * G + c; if (L >= nwg) return false;
        int wgid = (int)L; { const int q = nwg / NXCD, r = nwg % NXCD, xcd = wgid % NXCD, off = wgid / NXCD; wgid = (xcd < r ? xcd * (q + 1) : r * (q + 1) + (xcd - r) * q) + off; }
        const int nig = WGM * nN, gid = wgid / nig, fm = gid * WGM, gsz = (nM - fm) < WGM ? (nM - fm) : WGM;
        u.pm = fm + ((wgid % nig) % gsz); u.pn = (wgid % nig) / gsz; u.aux = 0; return true;
    }
    __device__ __forceinline__ const char* a_ptr(const Unit& u) const { return A + (size_t)u.pm * 256 * K * 2; }
    __device__ __forceinline__ const char* b_ptr(const Unit& u) const { return Bt + (size_t)u.pn * 256 * K * 2; }
    __device__ __forceinline__ int gather_row(const Unit&, int) const { return 0; }
    __device__ __forceinline__ const void* gather_src(const Unit&, int) const { return nullptr; }
};
struct MoeOrder {
    const char* A; const char* Bt; int K; size_t estride;
    const int* tile_e; const int* rowtok; int ntiles, nnt, G, c; bool gather;
    __device__ bool next(int i, Unit& u) const {
        int mt, nt;
        if ((G & 7) == 0 && ((G >> 3) % nnt) == 0) {
            const int x = c & 7, j = c >> 3, per = (G >> 3) / nnt;
            mt = (i * 8 + x) * per + j / nnt; nt = j % nnt;
        } else { const long L = (long)i * G + c; mt = (int)(L / nnt); nt = (int)(L % nnt); }
        if (mt >= ntiles) return false;
        u.pm = mt; u.pn = nt; u.aux = tile_e[mt]; return true;
    }
    __device__ __forceinline__ const char* a_ptr(const Unit& u) const { return gather ? A : A + (size_t)u.pm * 256 * K * 2; }
    __device__ __forceinline__ const char* b_ptr(const Unit& u) const { return Bt + (size_t)u.aux * estride + (size_t)u.pn * 256 * K * 2; }
    __device__ __forceinline__ int gather_row(const Unit& u, int r) const { return rowtok[u.pm * 256 + r]; }
    __device__ __forceinline__ const void* gather_src(const Unit& u, int lane) const { return rowtok + u.pm * 256 + lane * 4; }
};

template <bool GATHER, class Epi, class Sched>
__device__ __forceinline__ void gemm_phase(LAS unsigned char* lds, const int K_, const Sched& S, const Epi& E) {
    int K = K_; asm volatile("" : "+s"(K));
    const int tid = threadIdx.x, wid = __builtin_amdgcn_readfirstlane(tid >> 6), lane = tid & 63, wr = wid >> 2, wc = wid & 3, fr = lane & 15, fq = lane >> 4;
    const int nt = K / BK;
    unsigned voffA[2], voffB[2]; int Rr[2], Cc[2];
#pragma unroll
    for (int i = 0; i < 2; ++i) { int R, C; stage_rc(tid * 16 + i * 8192, R, C); const int Rb = (R & ~31) + perm32(R & 31);
        Rr[i] = R; Cc[i] = C; voffA[i] = (unsigned)(R * K + C) * 2u; voffB[i] = (unsigned)(Rb * K + C) * 2u; }
    const size_t kstep = (size_t)(BK * 2);
    const size_t hstep = (size_t)HALF * K * 2;
    const unsigned ldsw = (unsigned)wid * 1024u;
    const int aoff = lds_byte(wr * 64 + fr, fq * 8), boff = lds_byte(wc * 32 + fr, fq * 8);
    unsigned vgc[2][2], vgn[2][2];
    LAS unsigned char* const parbase = lds + STAGE_BYTES;
    constexpr int NPAR = Epi::NPAR;
#define G_PAR_ISSUE(unit, uidx, hasnx, nxunit) do { \
        LAS unsigned char* _ps = parbase + ((uidx) & 1) * 4096; \
        if (wid < NPAR) __builtin_amdgcn_global_load_lds((const unsigned*)E.par_src(unit, wid, lane), (LAS unsigned*)(_ps + wid * 1024), 16, 0, 0); \
        if (GATHER && (hasnx) && wid == NPAR) __builtin_amdgcn_global_load_lds((const unsigned*)S.gather_src(nxunit, lane), (LAS unsigned*)(_ps + NPAR * 1024), 16, 0, 0); } while (0)
#define G_SA(b, h) (((b) * 2 + (h)) * HTB)
#define G_SB(b, h) ((4 + (b) * 2 + (h)) * HTB)
#define G_STAGE(bufoff, gbase, voff) do { _Pragma("unroll") for (int _i = 0; _i < 2; ++_i) \
        __builtin_amdgcn_global_load_lds((const unsigned*)((const char*)(gbase) + (voff)[_i]), (LAS unsigned*)(lds + (bufoff) + ldsw + _i * 8192), 16, 0, 0); } while (0)
#define G_STAGE_A(bufoff, kptr, h, VG) do { if (GATHER) { G_STAGE(bufoff, kptr, VG[h]); } else { G_STAGE(bufoff, (kptr) + (h) * hstep, voffA); } } while (0)
#define G_LDA(dst, b, h) do { _Pragma("unroll") for (int m = 0; m < 4; ++m) _Pragma("unroll") for (int k = 0; k < 2; ++k) dst[m][k] = *(const LAS bf16x8*)(lds + G_SA(b, h) + aoff + m * 2048 + k * 1024); } while (0)
#define G_LDB(dst, b, h) do { _Pragma("unroll") for (int n = 0; n < 2; ++n) _Pragma("unroll") for (int k = 0; k < 2; ++k) dst[n][k] = *(const LAS bf16x8*)(lds + G_SB(b, h) + boff + n * 2048 + k * 1024); } while (0)
#define G_MMA(ai, bj, At, Bt) do { __builtin_amdgcn_s_setprio(1); _Pragma("unroll") for (int m = 0; m < 4; ++m) _Pragma("unroll") for (int n = 0; n < 2; ++n) _Pragma("unroll") for (int k = 0; k < 2; ++k) \
        acc[ai][bj][m][n] = __builtin_amdgcn_mfma_f32_16x16x32_bf16(Bt[n][k], At[m][k], acc[ai][bj][m][n], 0, 0, 0); __builtin_amdgcn_s_setprio(0); } while (0)
#define G_WAIT_V(n) asm volatile("s_waitcnt vmcnt(" #n ")" ::: "memory")
#define G_WAIT_L(n) asm volatile("s_waitcnt lgkmcnt(" #n ")" ::: "memory")
#define G_BAR __builtin_amdgcn_s_barrier()
#define G_SCHED __builtin_amdgcn_sched_barrier(0)
    Unit cur, nxt;
    int ui = 0;
    if (!S.next(0, cur)) return;
    f32x4 acc[2][2][4][2];
#pragma unroll
    for (int a = 0; a < 2; ++a)
#pragma unroll
        for (int b = 0; b < 2; ++b)
#pragma unroll
            for (int m = 0; m < 4; ++m)
#pragma unroll
                for (int n = 0; n < 2; ++n) acc[a][b][m][n] = (f32x4){0.f, 0.f, 0.f, 0.f};
    bf16x8 At[4][2], B0[2][2], B1[2][2];
    const char* cA = S.a_ptr(cur); const char* cB = S.b_ptr(cur);
    if (GATHER) {
#pragma unroll
        for (int h = 0; h < 2; ++h)
#pragma unroll
            for (int i = 0; i < 2; ++i) vgc[h][i] = (unsigned)(S.gather_row(cur, h * HALF + Rr[i]) * K + Cc[i]) * 2u;
    }
    { Unit n1; const bool hn1 = S.next(1, n1); G_PAR_ISSUE(cur, 0, hn1, n1); }
    G_STAGE(G_SB(0, 0), cB, voffB); G_STAGE_A(G_SA(0, 0), cA, 0, vgc); G_STAGE(G_SB(0, 1), cB + hstep, voffB); G_STAGE_A(G_SA(0, 1), cA, 1, vgc);
    if (wr == 1) G_BAR;
    G_WAIT_V(4); G_BAR;
    G_STAGE(G_SB(1, 0), cB + kstep, voffB); G_STAGE_A(G_SA(1, 0), cA + kstep, 0, vgc); G_STAGE(G_SB(1, 1), cB + hstep + kstep, voffB);
    G_WAIT_V(6); G_BAR;
    for (;;) {
        const bool has_next = S.next(ui + 1, nxt);
        const char* nA = has_next ? S.a_ptr(nxt) : cA; const char* nB = has_next ? S.b_ptr(nxt) : cB;
        if (ui > 0) G_PAR_ISSUE(cur, ui, has_next, nxt);
        if (GATHER) {
#pragma unroll
            for (int h = 0; h < 2; ++h)
#pragma unroll
                for (int i = 0; i < 2; ++i) vgn[h][i] = vgc[h][i];
        }
        for (int t = 0; t < nt; t += 2) {
            const bool last = (t == nt - 2);
            const char* a1 = cA + (size_t)(t + 1) * kstep;
            const char* a2 = last ? nA : cA + (size_t)(t + 2) * kstep; const char* b2 = last ? nB : cB + (size_t)(t + 2) * kstep;
            const char* a3 = a2 + kstep; const char* b3 = b2 + kstep;
            unsigned vg2[2][2];
            if (GATHER) {
#pragma unroll
                for (int h = 0; h < 2; ++h)
#pragma unroll
                    for (int i = 0; i < 2; ++i) vg2[h][i] = last ? vgn[h][i] : vgc[h][i];
            }
            G_LDB(B0, 0, 0); G_SCHED; G_LDA(At, 0, 0); G_STAGE_A(G_SA(1, 1), a1, 1, vgc);
            G_WAIT_L(8); G_BAR; G_WAIT_L(0); G_MMA(0, 0, At, B0); G_BAR; G_SCHED;
            G_LDB(B1, 0, 1); G_STAGE(G_SB(0, 0), b2, voffB);
            G_BAR; G_WAIT_L(0); G_MMA(0, 1, At, B1); G_BAR;
            G_LDA(At, 0, 1); G_STAGE_A(G_SA(0, 0), a2, 0, vg2);
            G_BAR; G_WAIT_L(0); G_MMA(1, 0, At, B0); G_BAR; G_SCHED;
            G_STAGE(G_SB(0, 1), b2 + hstep, voffB);
            G_WAIT_V(6); G_BAR; G_MMA(1, 1, At, B1); G_BAR;
            G_LDB(B0, 1, 0); G_SCHED; G_LDA(At, 1, 0); G_STAGE_A(G_SA(0, 1), a2, 1, vg2);
            G_WAIT_L(8); G_BAR; G_WAIT_L(0); G_MMA(0, 0, At, B0); G_BAR; G_SCHED;
            G_LDB(B1, 1, 1); G_STAGE(G_SB(1, 0), b3, voffB);
            G_BAR; G_WAIT_L(0); G_MMA(0, 1, At, B1); G_BAR;
            G_LDA(At, 1, 1); G_STAGE_A(G_SA(1, 0), a3, 0, vg2);
            G_BAR; G_WAIT_L(0); G_MMA(1, 0, At, B0); G_BAR; G_SCHED;
            G_STAGE(G_SB(1, 1), b3 + hstep, voffB);
            G_WAIT_V(6); G_BAR; G_MMA(1, 1, At, B1); G_BAR;
            if (GATHER && t == 0 && has_next) {
                const LAS int* rows = (const LAS int*)(parbase + (ui & 1) * 4096 + NPAR * 1024);
#pragma unroll
                for (int h = 0; h < 2; ++h)
#pragma unroll
                    for (int i = 0; i < 2; ++i) vgn[h][i] = (unsigned)(rows[h * HALF + Rr[i]] * K + Cc[i]) * 2u;
            }
        }
        const bool keep_acc = E(acc, cur, wr, wc, fr, fq, (const LAS unsigned char*)(parbase + (ui & 1) * 4096));
        if (!has_next) break;
        if (!keep_acc)
#pragma unroll
        for (int a = 0; a < 2; ++a)
#pragma unroll
            for (int b = 0; b < 2; ++b)
#pragma unroll
                for (int m = 0; m < 4; ++m)
#pragma unroll
                    for (int n = 0; n < 2; ++n) acc[a][b][m][n] = (f32x4){0.f, 0.f, 0.f, 0.f};
        cur = nxt; cA = nA; cB = nB; ++ui;
        if (GATHER) {
#pragma unroll
            for (int h = 0; h < 2; ++h)
#pragma unroll
                for (int i = 0; i < 2; ++i) vgc[h][i] = vgn[h][i];
        }
    }
    G_WAIT_V(0);
    if (wr == 0) G_BAR;
    G_BAR;
#undef G_PAR_ISSUE
#undef G_SA
#undef G_SB
#undef G_STAGE
#undef G_STAGE_A
#undef G_LDA
#undef G_LDB
#undef G_MMA
#undef G_WAIT_V
#undef G_WAIT_L
#undef G_BAR
#undef G_SCHED
}

struct EpiProj {
    bf16_t* prkv; bf16_t* pconv; bf16_t* gates; const float* rstd1;
    static constexpr int NPAR = 1;
    __device__ __forceinline__ const void* par_src(const Unit& u, int, int lane) const { return rstd1 + NMETA + u.pm * BM + lane * 4; }
    __device__ __forceinline__ bool operator()(const f32x4 (&acc)[2][2][4][2], const Unit& u, int wr, int wc, int fr, int fq, const LAS unsigned char* par) const {
        const int row0 = u.pm * BM + wr * 64 + fr;
        const bool isg = u.pn >= 14;
        float rsv[2][4];
#pragma unroll
        for (int ai = 0; ai < 2; ++ai)
#pragma unroll
            for (int m = 0; m < 4; ++m) rsv[ai][m] = ((const LAS float*)par)[wr * 64 + fr + ai * HALF + m * 16];
#pragma unroll
        for (int ai = 0; ai < 2; ++ai)
#pragma unroll
            for (int m = 0; m < 4; ++m) {
                const int row = row0 + ai * HALF + m * 16;
                const float rs = rsv[ai][m];
                bf16_t* rowp = isg ? gates + (size_t)row * 2048 + (u.pn - 14) * 256 + wc * 32 + 8 * fq
                             : (u.pn < 6 ? prkv + (size_t)(NMETA + row) * 1536 + u.pn * 256 : pconv + (size_t)(NMETA + row) * 2048 + (u.pn - 6) * 256) + wc * 32 + 8 * fq;
#pragma unroll
                for (int bj = 0; bj < 2; ++bj) {
                    f32x4 v0 = acc[ai][bj][m][0] * rs, v1 = acc[ai][bj][m][1] * rs;
                    if (isg) {
#pragma unroll
                        for (int j = 0; j < 4; ++j) { v0[j] = sigmoidf_(v0[j]); v1[j] = sigmoidf_(v1[j]); }
                    }
                    u32x4 w; w.x = cvt_pk_bf16(v0[0], v0[1]); w.y = cvt_pk_bf16(v0[2], v0[3]); w.z = cvt_pk_bf16(v1[0], v1[1]); w.w = cvt_pk_bf16(v1[2], v1[3]);
                    *(u32x4*)(rowp + bj * HALF) = w;
                }
            }
        return false;
    }
};
struct EpiL {
    static constexpr int NPAR = 0;
    __device__ __forceinline__ const void* par_src(const Unit&, int, int) const { return nullptr; }
    unsigned char* wsb; const float* w0; const float* a0;
    __device__ __forceinline__ bool operator()(const f32x4 (&acc)[2][2][4][2], const Unit& u, int wr, int wc, int fr, int fq, const LAS unsigned char* par) const {
        const int row0 = NMETA + u.pm * BM + wr * 64 + fr;
        const int seg = u.pn >> 1;
        const int cb = (u.pn & 1) * 256 + wc * 32 + 8 * fq;
        const float* bias = seg == 0 ? w0 : a0;
        f32x4 bv[2][2];
#pragma unroll
        for (int bj = 0; bj < 2; ++bj) {
            bv[bj][0] = seg < 2 ? *(const f32x4*)(bias + cb + bj * HALF) : (f32x4){0.f, 0.f, 0.f, 0.f};
            bv[bj][1] = seg < 2 ? *(const f32x4*)(bias + cb + bj * HALF + 4) : (f32x4){0.f, 0.f, 0.f, 0.f};
        }
        const float sc = seg == 0 ? -0.60653065971f : 1.0f;
        bf16_t* ob = (bf16_t*)(wsb + (seg == 0 ? OFF_LD : seg == 1 ? OFF_A : OFF_G));
#pragma unroll
        for (int ai = 0; ai < 2; ++ai)
#pragma unroll
            for (int m = 0; m < 4; ++m) {
                const int row = row0 + ai * HALF + m * 16;
#pragma unroll
                for (int bj = 0; bj < 2; ++bj) {
                    const int c = cb + bj * HALF;
                    f32x4 v0 = acc[ai][bj][m][0] + bv[bj][0], v1 = acc[ai][bj][m][1] + bv[bj][1];
                    if (seg < 2) {
#pragma unroll
                        for (int j = 0; j < 4; ++j) { v0[j] = sc * sigmoidf_(v0[j]); v1[j] = sc * sigmoidf_(v1[j]); }
                    }
                    {
                        u32x4 w; w.x = cvt_pk_bf16(v0[0], v0[1]); w.y = cvt_pk_bf16(v0[2], v0[3]); w.z = cvt_pk_bf16(v1[0], v1[1]); w.w = cvt_pk_bf16(v1[2], v1[3]);
                        *(u32x4*)(ob + (size_t)row * 512 + c) = w;
                    }
                }
            }
        return false;
    }
};
template <int SECOND> struct EpiMerge {
    static constexpr int NPAR = 0;
    __device__ __forceinline__ const void* par_src(const Unit&, int, int) const { return nullptr; }
    bf16_t* merged; const bf16_t* gates;
    __device__ __forceinline__ bool operator()(const f32x4 (&acc)[2][2][4][2], const Unit& u, int wr, int wc, int fr, int fq, const LAS unsigned char* par) const {
        const int row0 = u.pm * BM + wr * 64 + fr, col0 = u.pn * BM + wc * 32 + 8 * fq;
#pragma unroll
        for (int ai = 0; ai < 2; ++ai)
#pragma unroll
            for (int m = 0; m < 4; ++m) {
                const int row = row0 + ai * HALF + m * 16;
#pragma unroll
                for (int bj = 0; bj < 2; ++bj) {
                    const int c = col0 + bj * HALF;
                    const u32x4 gw = *(const u32x4*)(gates + (size_t)row * 2048 + SECOND * 1024 + c);
                    f32x4 g0 = (f32x4){bflo(gw.x), bfhi(gw.x), bflo(gw.y), bfhi(gw.y)}, g1 = (f32x4){bflo(gw.z), bfhi(gw.z), bflo(gw.w), bfhi(gw.w)};
                    f32x4 v0 = acc[ai][bj][m][0] * g0, v1 = acc[ai][bj][m][1] * g1;
                    bf16_t* p = merged + (size_t)row * 1024 + c;
                    if (SECOND) {
                        const u32x4 ow = *(const u32x4*)p;
                        v0 += (f32x4){bflo(ow.x), bfhi(ow.x), bflo(ow.y), bfhi(ow.y)}; v1 += (f32x4){bflo(ow.z), bfhi(ow.z), bflo(ow.w), bfhi(ow.w)};
                    }
                    u32x4 w; w.x = cvt_pk_bf16(v0[0], v0[1]); w.y = cvt_pk_bf16(v0[2], v0[3]); w.z = cvt_pk_bf16(v1[0], v1[1]); w.w = cvt_pk_bf16(v1[2], v1[3]);
                    *(u32x4*)p = w;
                }
            }
        return false;
    }
};
struct MergeOrder {
    StaticOrder so; const char* A1; const char* B1;
    __device__ bool next(int i, Unit& u) const { const bool ok = so.next(i >> 1, u); u.aux = i & 1; return ok; }
    __device__ __forceinline__ const char* a_ptr(const Unit& u) const { return (u.aux ? A1 : so.A) + (size_t)u.pm * 256 * so.K * 2; }
    __device__ __forceinline__ const char* b_ptr(const Unit& u) const { return (u.aux ? B1 : so.Bt) + (size_t)u.pn * 256 * so.K * 2; }
    __device__ __forceinline__ int gather_row(const Unit&, int) const { return 0; }
    __device__ __forceinline__ const void* gather_src(const Unit&, int) const { return nullptr; }
};
struct EpiMergeFused {
    static constexpr int NPAR = 0;
    __device__ __forceinline__ const void* par_src(const Unit&, int, int) const { return nullptr; }
    bf16_t* merged; const bf16_t* gates;
    __device__ __forceinline__ bool operator()(f32x4 (&acc)[2][2][4][2], const Unit& u, int wr, int wc, int fr, int fq, const LAS unsigned char* par) const {
        const int row0 = u.pm * BM + wr * 64 + fr, col0 = u.pn * BM + wc * 32 + 8 * fq;
#pragma unroll
        for (int ai = 0; ai < 2; ++ai) {
            u32x4 gbw[4][2], gaw[4][2];
#pragma unroll
            for (int m = 0; m < 4; ++m)
#pragma unroll
                for (int bj = 0; bj < 2; ++bj) {
                    const bf16_t* gp = gates + (size_t)(row0 + ai * HALF + m * 16) * 2048 + col0 + bj * HALF;
                    gbw[m][bj] = *(const u32x4*)(gp + 1024);
                    gaw[m][bj] = u.aux == 0 ? *(const u32x4*)gp : (u32x4){0u, 0u, 0u, 0u};
                }
#pragma unroll
            for (int m = 0; m < 4; ++m)
#pragma unroll
                for (int bj = 0; bj < 2; ++bj) {
                    const int row = row0 + ai * HALF + m * 16, c = col0 + bj * HALF;
                    f32x4 gb0 = (f32x4){bflo(gbw[m][bj].x), bfhi(gbw[m][bj].x), bflo(gbw[m][bj].y), bfhi(gbw[m][bj].y)}, gb1 = (f32x4){bflo(gbw[m][bj].z), bfhi(gbw[m][bj].z), bflo(gbw[m][bj].w), bfhi(gbw[m][bj].w)};
#pragma unroll
                    for (int j = 0; j < 4; ++j) { gb0[j] = fmaxf(gb0[j], 1e-6f); gb1[j] = fmaxf(gb1[j], 1e-6f); }
                    if (u.aux == 0) {
                        const f32x4 ga0 = (f32x4){bflo(gaw[m][bj].x), bfhi(gaw[m][bj].x), bflo(gaw[m][bj].y), bfhi(gaw[m][bj].y)}, ga1 = (f32x4){bflo(gaw[m][bj].z), bfhi(gaw[m][bj].z), bflo(gaw[m][bj].w), bfhi(gaw[m][bj].w)};
#pragma unroll
                        for (int j = 0; j < 4; ++j) { acc[ai][bj][m][0][j] *= ga0[j] * __builtin_amdgcn_rcpf(gb0[j]); acc[ai][bj][m][1][j] *= ga1[j] * __builtin_amdgcn_rcpf(gb1[j]); }
                    } else {
                        const f32x4 v0 = acc[ai][bj][m][0] * gb0, v1 = acc[ai][bj][m][1] * gb1;
                        u32x4 w; w.x = cvt_pk_bf16(v0[0], v0[1]); w.y = cvt_pk_bf16(v0[2], v0[3]); w.z = cvt_pk_bf16(v1[0], v1[1]); w.w = cvt_pk_bf16(v1[2], v1[3]);
                        *(u32x4*)(merged + (size_t)row * 1024 + c) = w;
                    }
                }
        }
        return u.aux == 0;
    }
};
struct EpiO {
    static constexpr int NPAR = 0;
    __device__ __forceinline__ const void* par_src(const Unit&, int, int) const { return nullptr; }
    const float* x; float* h1; bf16_t* hb2;
    __device__ __forceinline__ bool operator()(const f32x4 (&acc)[2][2][4][2], const Unit& u, int wr, int wc, int fr, int fq, const LAS unsigned char* par) const {
        const int row0 = u.pm * BM + wr * 64 + fr, col0 = u.pn * BM + wc * 32 + 8 * fq;
#pragma unroll
        for (int ai = 0; ai < 2; ++ai) {
            f32x4 xv[4][2][2];
#pragma unroll
            for (int m = 0; m < 4; ++m)
#pragma unroll
                for (int bj = 0; bj < 2; ++bj) {
                    const size_t o = (size_t)(row0 + ai * HALF + m * 16) * 1024 + col0 + bj * HALF;
                    xv[m][bj][0] = *(const f32x4*)(x + o); xv[m][bj][1] = *(const f32x4*)(x + o + 4);
                }
#pragma unroll
            for (int m = 0; m < 4; ++m)
#pragma unroll
                for (int bj = 0; bj < 2; ++bj) {
                    const size_t o = (size_t)(row0 + ai * HALF + m * 16) * 1024 + col0 + bj * HALF;
                    const f32x4 v0 = acc[ai][bj][m][0] + xv[m][bj][0], v1 = acc[ai][bj][m][1] + xv[m][bj][1];
                    u32x4 w; w.x = cvt_pk_bf16(v0[0], v0[1]); w.y = cvt_pk_bf16(v0[2], v0[3]); w.z = cvt_pk_bf16(v1[0], v1[1]); w.w = cvt_pk_bf16(v1[2], v1[3]);
                    *(u32x4*)(hb2 + o) = w;
                }
        }
        return false;
    }
};
struct EpiMoe1 {
    bf16_t* act; const float* rowrs; const float* bg; const float* bu;
    static constexpr int NPAR = 2;
    __device__ __forceinline__ const void* par_src(const Unit& u, int piece, int lane) const {
        if (piece == 0) return rowrs + u.pm * BM + lane * 4;
        return (lane < 32 ? bg : bu) + (size_t)u.aux * DFF + u.pn * 128 + (lane & 31) * 4;
    }
    __device__ __forceinline__ bool operator()(const f32x4 (&acc)[2][2][4][2], const Unit& u, int wr, int wc, int fr, int fq, const LAS unsigned char* par) const {
        const int row0 = u.pm * BM + wr * 64 + fr, ff0 = u.pn * 128 + wc * 32 + 8 * fq;
        const LAS float* bgp = (const LAS float*)(par + 1024) + wc * 32 + 8 * fq; const LAS float* bup = bgp + 128;
        const f32x4 bg0 = *(const LAS f32x4*)bgp, bg1 = *(const LAS f32x4*)(bgp + 4), bu0 = *(const LAS f32x4*)bup, bu1 = *(const LAS f32x4*)(bup + 4);
        float rsv[2][4];
#pragma unroll
        for (int ai = 0; ai < 2; ++ai)
#pragma unroll
            for (int m = 0; m < 4; ++m) rsv[ai][m] = ((const LAS float*)par)[wr * 64 + fr + ai * HALF + m * 16];
#pragma unroll
        for (int ai = 0; ai < 2; ++ai)
#pragma unroll
            for (int m = 0; m < 4; ++m) {
                const int row = row0 + ai * HALF + m * 16;
                const float rs = rsv[ai][m];
                f32x4 g0 = acc[ai][0][m][0] * rs + bg0, g1 = acc[ai][0][m][1] * rs + bg1, u0 = acc[ai][1][m][0] * rs + bu0, u1 = acc[ai][1][m][1] * rs + bu1;
                f32x4 r0, r1;
#pragma unroll
                for (int j = 0; j < 4; ++j) {
                    { const float gt = fminf(g0[j], 7.0f), up = fminf(fmaxf(u0[j], -7.0f), 7.0f); r0[j] = (up + 1.0f) * gt * sigmoidf_(1.702f * gt); }
                    { const float gt = fminf(g1[j], 7.0f), up = fminf(fmaxf(u1[j], -7.0f), 7.0f); r1[j] = (up + 1.0f) * gt * sigmoidf_(1.702f * gt); }
                }
                u32x4 w; w.x = cvt_pk_bf16(r0[0], r0[1]); w.y = cvt_pk_bf16(r0[2], r0[3]); w.z = cvt_pk_bf16(r1[0], r1[1]); w.w = cvt_pk_bf16(r1[2], r1[3]);
                *(u32x4*)(act + (size_t)row * DFF + ff0) = w;
            }
        return false;
    }
};
struct EpiMoe2 {
    bf16_t* ya; bf16_t* yb; const int* rowslot; const float* roww; const float* bd;
    static constexpr int NPAR = 3;
    __device__ __forceinline__ const void* par_src(const Unit& u, int piece, int lane) const {
        if (piece == 0) return rowslot + u.pm * BM + lane * 4;
        if (piece == 1) return roww + u.pm * BM + lane * 4;
        return bd + (size_t)u.aux * D + u.pn * BM + lane * 4;
    }
    __device__ __forceinline__ bool operator()(const f32x4 (&acc)[2][2][4][2], const Unit& u, int wr, int wc, int fr, int fq, const LAS unsigned char* par) const {
        const int row0 = u.pm * BM + wr * 64 + fr, col0 = u.pn * BM + wc * 32 + 8 * fq;
        bf16_t* ybase = (u.pn < 2) ? ya : yb; const int yc0 = col0 & 511;
        const LAS float* bp = (const LAS float*)(par + 2048) + wc * 32 + 8 * fq;
        f32x4 bv[2][2];
#pragma unroll
        for (int bj = 0; bj < 2; ++bj) { bv[bj][0] = *(const LAS f32x4*)(bp + bj * HALF); bv[bj][1] = *(const LAS f32x4*)(bp + bj * HALF + 4); }
        int slotv[2][4]; float wv8[2][4];
#pragma unroll
        for (int ai = 0; ai < 2; ++ai)
#pragma unroll
            for (int m = 0; m < 4; ++m) { const int rl = wr * 64 + fr + ai * HALF + m * 16; slotv[ai][m] = ((const LAS int*)par)[rl]; wv8[ai][m] = ((const LAS float*)(par + 1024))[rl]; }
#pragma unroll
        for (int ai = 0; ai < 2; ++ai)
#pragma unroll
            for (int m = 0; m < 4; ++m) {
                const int slot = slotv[ai][m];
                if (slot >= 0) {
                    const float w8 = wv8[ai][m];
#pragma unroll
                    for (int bj = 0; bj < 2; ++bj) {
                        const f32x4 v0 = (acc[ai][bj][m][0] + bv[bj][0]) * w8, v1 = (acc[ai][bj][m][1] + bv[bj][1]) * w8;
                        u32x4 w; w.x = cvt_pk_bf16(v0[0], v0[1]); w.y = cvt_pk_bf16(v0[2], v0[3]); w.z = cvt_pk_bf16(v1[0], v1[1]); w.w = cvt_pk_bf16(v1[2], v1[3]);
                        *(u32x4*)(ybase + (size_t)slot * 512 + yc0 + bj * HALF) = w;
                    }
                }
            }
        return false;
    }
};

__device__ __forceinline__ void transpose_tile(LAS float* tile, const float* src, int ldsrc, int k0, int n0, bf16_t* dst, int ldd, int drow0, const float* sa, const float* mu, int mode, bool zero) {
    const int tid = threadIdx.x;
    if (!zero) {
#pragma unroll
        for (int i = 0; i < 2; ++i) {
            const int r = (tid >> 4) + 32 * i, c4 = (tid & 15) * 4;
            const f32x4 v = *(const f32x4*)(src + (size_t)(k0 + r) * ldsrc + n0 + c4);
            LAS float* t = tile + r * 65 + c4;
            t[0] = v[0]; t[1] = v[1]; t[2] = v[2]; t[3] = v[3];
        }
    }
    __syncthreads();
    {
        const int n = tid >> 3, kq = tid & 7;
        float v[8];
#pragma unroll
        for (int j = 0; j < 8; ++j) {
            const int k = k0 + 8 * kq + j;
            float s = sa ? sa[k] : 1.0f;
            if (mode == 1) s *= (1.0f - mu[k]);
            if (mode == 2) s *= mu[k];
            v[j] = zero ? 0.f : tile[(8 * kq + j) * 65 + n] * s;
        }
        u32x4 w; w.x = cvt_pk_bf16(v[0], v[1]); w.y = cvt_pk_bf16(v[2], v[3]); w.z = cvt_pk_bf16(v[4], v[5]); w.w = cvt_pk_bf16(v[6], v[7]);
        *(u32x4*)(dst + (size_t)(drow0 + n) * ldd + k0 + 8 * kq) = w;
    }
    __syncthreads();
}

__device__ __forceinline__ void phase_prep(const PPv& p, LAS unsigned char* lds) {
    const int tid = threadIdx.x, bid = blockIdx.x, nb = gridDim.x, lane = tid & 63, wave = tid >> 6;
    unsigned char* ws = p.gws();
    const float* x = p.gin(0); const float* meta = p.gin(1); const float* g1 = p.gin(2);
    if (bid == 0 && tid < 64) ((int*)(ws + OFF_GCNT))[tid] = 0;
    {
        bf16_t* HB = (bf16_t*)(ws + OFF_HB); float* rstd1 = (float*)(ws + OFF_RSTD1);
        for (int row0 = (bid * 8 + wave) * 4; row0 < NR; row0 += nb * 32) {
            f32x4 v[4][4];
#pragma unroll
            for (int u = 0; u < 4; ++u) {
                const int row = row0 + u < NR ? row0 + u : NR - 1;
                const float* src = row < NMETA ? meta + (size_t)row * D : x + (size_t)(row - NMETA) * D;
#pragma unroll
                for (int i = 0; i < 4; ++i) v[u][i] = __builtin_nontemporal_load((const f32x4*)(src + i * 256 + lane * 4));
            }
#pragma unroll
            for (int u = 0; u < 4; ++u) {
                const int row = row0 + u;
                if (row < NR) {
                    float ss = 0.f;
#pragma unroll
                    for (int i = 0; i < 4; ++i) ss += v[u][i][0] * v[u][i][0] + v[u][i][1] * v[u][i][1] + v[u][i][2] * v[u][i][2] + v[u][i][3] * v[u][i][3];
                    ss = wave_sum_dpp(ss);
                    if (lane == 0) rstd1[row] = rsqrtf(ss * (1.0f / D) + NORM_EPS);
                    if (row >= NMETA) {
                        bf16_t* d = HB + (size_t)(row - NMETA) * D;
#pragma unroll
                        for (int i = 0; i < 4; ++i) { u32x2 w; w.x = cvt_pk_bf16(v[u][i][0], v[u][i][1]); w.y = cvt_pk_bf16(v[u][i][2], v[u][i][3]); *(u32x2*)(d + i * 256 + lane * 4) = w; }
                    }
                }
            }
        }
    }
    LAS float* tile = (LAS float*)lds;
    {
        bf16_t* WIN = (bf16_t*)(ws + OFF_WIN);
        const float* w_in = p.gin(3);
        for (int j = bid; j < 16 * 88; j += nb) {
            const int kt = j & 15, ntile = j >> 4, n0 = ntile * 64;
            const float* src; int ld, sn0, mode = 0; const float* mu = nullptr;
            if (n0 < 3072) { src = w_in; ld = 5120; sn0 = n0; }
            else if (n0 < 3584) {
                const int seg = (n0 - 3072) >> 6;
                if (seg < 2) { src = p.gin(11); ld = 64; sn0 = 0; mu = p.gin(7); mode = 1 + seg; }
                else if (seg < 4) { src = p.gin(14); ld = 64; sn0 = 0; mu = p.gin(8); mode = 1 + (seg - 2); }
                else { src = p.gin(16); ld = 128; sn0 = (seg & 1) * 64; mu = p.gin(9); mode = seg < 6 ? 1 : 2; }
            } else { src = w_in; ld = 5120; sn0 = n0 - 512; }
            transpose_tile(tile, src, ld, kt * 64, sn0, WIN, 1024, n0, g1, mu, mode, false);
        }
        for (int j = bid; j < 2 * 128; j += nb) {
            const int which = j >> 7, jj = j & 127, kt = jj & 7, ntile = jj >> 3;
            transpose_tile(tile, which ? p.gin(25) : p.gin(23), 1024, kt * 64, ntile * 64, (bf16_t*)(ws + (which ? OFF_WC : OFF_WR)), 512, ntile * 64, nullptr, nullptr, 0, false);
        }
        for (int j = bid; j < 256; j += nb) {
            const int kt = j & 15, ntile = j >> 4;
            transpose_tile(tile, p.gin(26), 1024, kt * 64, ntile * 64, (bf16_t*)(ws + OFF_WO), 1024, ntile * 64, nullptr, nullptr, 0, false);
        }
        for (int j = bid; j < 96; j += nb) {
            const int kt = j & 3, ntile = j >> 2, seg = ntile >> 3, nn0 = (ntile & 7) * 64;
            const float* src = nullptr; int sk0 = 0; bool zero = true;
            if (seg == 0 && kt == 0) { src = p.gin(12); sk0 = 0; zero = false; }
            if (seg == 1 && kt == 1) { src = p.gin(15); sk0 = 0; zero = false; }
            if (seg == 2 && kt >= 2) { src = p.gin(17); sk0 = (kt - 2) * 64; zero = false; }
            const float* srcs = zero ? p.gin(12) : src + (size_t)(sk0 - kt * 64) * 512;
            transpose_tile(tile, srcs, 512, kt * 64, nn0, (bf16_t*)(ws + OFF_W2), 256, ntile * 64, nullptr, nullptr, 0, zero);
        }
        {
            float* WRG = (float*)(ws + OFF_WRG); const float* g2 = p.gin(27); const float* wr_ = p.gin(28);
            for (int i = bid * 512 + tid; i < 1024 * 32; i += nb * 512) WRG[i] = g2[i >> 5] * wr_[i];
        }
    }
}

__device__ __forceinline__ void phase_meta_proj(const PPv& p, LAS unsigned char* lds) {
    const int tid = threadIdx.x, bid = blockIdx.x, lane = tid & 63, wave = tid >> 6;
    unsigned char* ws = p.gws();
    LAS float* sm = (LAS float*)lds;
    const float* meta = p.gin(1);
    for (int i = tid; i < 16 * 256; i += 512) { const int r = i >> 8, c4 = (i & 255) * 4; const f32x4 v = *(const f32x4*)(meta + r * 1024 + c4); LAS float* d = sm + r * 1028 + c4; d[0] = v[0]; d[1] = v[1]; d[2] = v[2]; d[3] = v[3]; }
    __syncthreads();
    const float* rstd1 = (const float*)(ws + OFF_RSTD1);
    for (int nbase = bid * 14; nbase < PCOLS1; nbase += gridDim.x * 14) {
        for (int nn = wave; nn < 14; nn += 8) {
            const int n = nbase + nn;
            if (n >= PCOLS1) break;
            const bf16_t* wrow = (const bf16_t*)(ws + OFF_WIN) + (size_t)n * 1024;
            const u32x4 w0 = *(const u32x4*)(wrow + 8 * lane), w1 = *(const u32x4*)(wrow + 512 + 8 * lane);
            const float wf[16] = {bflo(w0.x), bfhi(w0.x), bflo(w0.y), bfhi(w0.y), bflo(w0.z), bfhi(w0.z), bflo(w0.w), bfhi(w0.w),
                                  bflo(w1.x), bfhi(w1.x), bflo(w1.y), bfhi(w1.y), bflo(w1.z), bfhi(w1.z), bflo(w1.w), bfhi(w1.w)};
            float outv = 0.f;
#pragma unroll
            for (int pr = 0; pr < 16; ++pr) {
                const LAS float* m0 = sm + pr * 1028 + 8 * lane;
                const f32x4 a0 = *(const LAS f32x4*)m0, a1 = *(const LAS f32x4*)(m0 + 4), a2 = *(const LAS f32x4*)(m0 + 512), a3 = *(const LAS f32x4*)(m0 + 516);
                float acc = a0[0] * wf[0] + a0[1] * wf[1] + a0[2] * wf[2] + a0[3] * wf[3] + a1[0] * wf[4] + a1[1] * wf[5] + a1[2] * wf[6] + a1[3] * wf[7]
                          + a2[0] * wf[8] + a2[1] * wf[9] + a2[2] * wf[10] + a2[3] * wf[11] + a3[0] * wf[12] + a3[1] * wf[13] + a3[2] * wf[14] + a3[3] * wf[15];
                acc = wave_sum_dpp(acc);
                outv = (lane == pr) ? acc * rstd1[pr] : outv;
            }
            if (lane < 16) {
                if (n < 1536) ((bf16_t*)(ws + OFF_PRKV))[(size_t)lane * 1536 + n] = f2bf(outv);
                else ((bf16_t*)(ws + OFF_PCONV))[(size_t)lane * 2048 + n - 1536] = f2bf(outv);
            }
        }
    }
    __syncthreads();
}

__device__ __forceinline__ void phase_meta_lora(const PPv& p) {
    const int tid = threadIdx.x, bid = blockIdx.x, nb = gridDim.x, lane = tid & 63, wave = tid >> 6;
    unsigned char* ws = p.gws();
    const bf16_t* L = (const bf16_t*)(ws + OFF_L); const bf16_t* W2 = (const bf16_t*)(ws + OFF_W2);
    for (int n = bid * 8 + wave; n < 1536; n += nb * 8) {
        const int seg = n >> 9, c = n & 511;
        const u32x2 wv = *(const u32x2*)(W2 + (size_t)n * 256 + 4 * lane);
        const float w0v = bflo(wv.x), w1v = bfhi(wv.x), w2v = bflo(wv.y), w3v = bfhi(wv.y);
        float outv = 0.f;
#pragma unroll
        for (int r = 0; r < 16; ++r) {
            const u32x2 lv = *(const u32x2*)(L + (size_t)r * 256 + 4 * lane);
            float acc = bflo(lv.x) * w0v + bfhi(lv.x) * w1v + bflo(lv.y) * w2v + bfhi(lv.y) * w3v;
            acc = wave_sum_dpp(acc);
            outv = (lane == r) ? acc : outv;
        }
        if (lane < 16) {
            float v = outv;
            if (seg == 0) v = -0.60653065971f * sigmoidf_(v + p.gin(10)[c]);
            if (seg == 1) v = sigmoidf_(v + p.gin(13)[c]);
            bf16_t* ob = (bf16_t*)(ws + (seg == 0 ? OFF_LD : seg == 1 ? OFF_A : OFF_G));
            ob[(size_t)lane * 512 + c] = f2bf(v);
        }
    }
}

__device__ __forceinline__ void phase_lprep_conv(const PPv& p) {
    const int tid = threadIdx.x, bid = blockIdx.x, nb = gridDim.x;
    unsigned char* ws = p.gws();
    const bf16_t* PROJ = (const bf16_t*)(ws + OFF_PCONV);
    constexpr int PCOLS = 2048;
    bf16_t* L = (bf16_t*)(ws + OFF_L);
    for (int i = bid * 512 + tid; i < NRP * 32; i += nb * 512) {
        const int row = i >> 5, gq = i & 31;
        u32x4 w = (u32x4){0u, 0u, 0u, 0u};
        if (row < NR) {
            int ca, cb;
            if (gq < 8) { ca = 1536 + gq * 8; cb = ca + 64; }
            else if (gq < 16) { ca = 1536 + 128 + (gq - 8) * 8; cb = ca + 64; }
            else { ca = 1536 + 256 + (gq - 16) * 8; cb = ca + 128; }
            const u32x4 va = *(const u32x4*)(PROJ + (size_t)row * PCOLS + ca);
            const int pr = prev_row(row, 1);
            u32x4 vb = (u32x4){0u, 0u, 0u, 0u};
            if (pr >= 0) vb = *(const u32x4*)(PROJ + (size_t)pr * PCOLS + cb);
            float v[8] = {bflo(va.x) + bflo(vb.x), bfhi(va.x) + bfhi(vb.x), bflo(va.y) + bflo(vb.y), bfhi(va.y) + bfhi(vb.y), bflo(va.z) + bflo(vb.z), bfhi(va.z) + bfhi(vb.z), bflo(va.w) + bflo(vb.w), bfhi(va.w) + bfhi(vb.w)};
#pragma unroll
            for (int j = 0; j < 8; ++j) { if (gq < 8) v[j] = tanhf(v[j]); else if (gq >= 16) v[j] = sigmoidf_(v[j]); }
            w.x = cvt_pk_bf16(v[0], v[1]); w.y = cvt_pk_bf16(v[2], v[3]); w.z = cvt_pk_bf16(v[4], v[5]); w.w = cvt_pk_bf16(v[6], v[7]);
        }
        *(u32x4*)(L + (size_t)row * 256 + gq * 8) = w;
    }
    bf16_t* C = (bf16_t*)(ws + OFF_C);
    const float* cw = p.gin(24);
    for (int i = bid * 512 + tid; i < T * 64; i += nb * 512) {
        const int m = i >> 6, ch = (i & 63) * 8, row = NMETA + m;
        const int r1 = prev_row(row, 1), r2 = prev_row(row, 2);
        const bf16_t* p0 = PROJ + (size_t)row * PCOLS; const bf16_t* p1 = PROJ + (size_t)r1 * PCOLS; const bf16_t* p2 = PROJ + (size_t)r2 * PCOLS;
        const u32x4 vb = *(const u32x4*)(p0 + ch);
        const u32x4 c0 = *(const u32x4*)(p0 + 512 + ch), h0 = *(const u32x4*)(p0 + 1024 + ch);
        const u32x4 c1 = *(const u32x4*)(p1 + 512 + ch), h1 = *(const u32x4*)(p1 + 1024 + ch);
        const u32x4 c2 = *(const u32x4*)(p2 + 512 + ch), h2 = *(const u32x4*)(p2 + 1024 + ch);
        float o[8];
#pragma unroll
        for (int j = 0; j < 8; ++j) {
            const unsigned wb = j < 2 ? vb.x : j < 4 ? vb.y : j < 6 ? vb.z : vb.w;
            const unsigned wc0 = j < 2 ? c0.x : j < 4 ? c0.y : j < 6 ? c0.z : c0.w, wh0 = j < 2 ? h0.x : j < 4 ? h0.y : j < 6 ? h0.z : h0.w;
            const unsigned wc1 = j < 2 ? c1.x : j < 4 ? c1.y : j < 6 ? c1.z : c1.w, wh1 = j < 2 ? h1.x : j < 4 ? h1.y : j < 6 ? h1.z : h1.w;
            const unsigned wc2 = j < 2 ? c2.x : j < 4 ? c2.y : j < 6 ? c2.z : c2.w, wh2 = j < 2 ? h2.x : j < 4 ? h2.y : j < 6 ? h2.z : h2.w;
            const bool hi = j & 1;
            const float b = hi ? bfhi(wb) : bflo(wb);
            const float u0 = (hi ? bfhi(wc0) : bflo(wc0)) * (hi ? bfhi(wh0) : bflo(wh0));
            const float u1 = (hi ? bfhi(wc1) : bflo(wc1)) * (hi ? bfhi(wh1) : bflo(wh1));
            const float u2 = (hi ? bfhi(wc2) : bflo(wc2)) * (hi ? bfhi(wh2) : bflo(wh2));
            const float conv = cw[ch + j] * u2 + cw[512 + ch + j] * u1 + cw[1024 + ch + j] * u0;
            o[j] = b * conv;
        }
        u32x4 w; w.x = cvt_pk_bf16(o[0], o[1]); w.y = cvt_pk_bf16(o[2], o[3]); w.z = cvt_pk_bf16(o[4], o[5]); w.w = cvt_pk_bf16(o[6], o[7]);
        *(u32x4*)(C + (size_t)m * 512 + ch) = w;
    }
}

template <int CTRL> __device__ __forceinline__ float dppmov(float v) { return __builtin_bit_cast(float, __builtin_amdgcn_update_dpp(0, __builtin_bit_cast(int, v), CTRL, 0xF, 0xF, true)); }
__device__ __forceinline__ float wave_sum_dpp(float v) {
    v += dppmov<0xB1>(v);
    v += dppmov<0x4E>(v);
    v += dppmov<0x141>(v);
    v += dppmov<0x140>(v);
    { float c = v; asm volatile("v_nop\n\tv_nop\n\tv_permlane16_swap_b32 %0, %1\n\tv_nop" : "+v"(v), "+v"(c)); v += c; }
    { float c = v; asm volatile("v_nop\n\tv_nop\n\tv_permlane32_swap_b32 %0, %1\n\tv_nop" : "+v"(v), "+v"(c)); v += c; }
    return v;
}
typedef float f32x16 __attribute__((ext_vector_type(16)));

struct RawTok { bf16_t r, k, v, a, ld; };
__device__ __forceinline__ RawTok load_raw(const bf16_t* PRKV, const bf16_t* Ab, const bf16_t* LD, int row, int col) {
    RawTok q; const bf16_t* p0 = PRKV + (size_t)row * 1536 + col;
    q.r = p0[0]; q.k = p0[512]; q.v = p0[1024]; q.a = Ab[(size_t)row * 512 + col]; q.ld = LD[(size_t)row * 512 + col];
    return q;
}
__device__ __forceinline__ void unit_geom(int uid, int lane, int& b, int& h, int& c, int& col, int& row0) {
    const int bh = uid / NCHUNK; c = uid - bh * NCHUNK; b = bh >> 3; h = bh & 7; col = h * 64 + lane;
    row0 = c == 0 ? 0 : b * SEQ + c * 16;
}
__device__ __forceinline__ void phase_scanprep(const PPv& p, LAS unsigned char* lds) {
    const int tid = threadIdx.x, bid = blockIdx.x, nb = gridDim.x, lane = tid & 63, wave = tid >> 6;
    unsigned char* ws = p.gws();
    const bf16_t* PRKV = (const bf16_t*)(ws + OFF_PRKV);
    const bf16_t* LD = (const bf16_t*)(ws + OFF_LD);
    const bf16_t* Ab = (const bf16_t*)(ws + OFF_A);
    float* COEF = (float*)(ws + OFF_COEF);
    LAS unsigned char* wl = lds + wave * 13824;
    LAS bf16_t* AR = (LAS bf16_t*)wl;
    LAS bf16_t* BK = (LAS bf16_t*)(wl + 4608);
    LAS float* DM = (LAS float*)(wl + 9216);
    const int qperm = (lane & 32) | (((lane >> 2) & 3) << 3) | (((lane >> 4) & 1) << 2) | (lane & 3);
    int uid = bid * 8 + wave;
    if (uid >= NUNITS) return;
    int b, h, c, col, row0;
    unit_geom(uid, lane, b, h, c, col, row0);
    RawTok q[16], qn[16];
    bf16_t prr = 0, prk = 0, prv = 0, nprr = 0, nprk = 0, nprv = 0;
#pragma unroll
    for (int t = 0; t < 16; ++t) q[t] = load_raw(PRKV, Ab, LD, row0 + t, col);
    { const int pr = prev_row(row0, 1); if (pr >= 0) { const bf16_t* p1 = PRKV + (size_t)pr * 1536 + col; prr = p1[0]; prk = p1[512]; prv = p1[1024]; } }
    for (;;) {
        const float mur = p.gin(4)[col], muk = p.gin(5)[col], muv = p.gin(6)[col], kkw = p.gin(18)[col], kaw = p.gin(19)[col], rkw = p.gin(20)[col];
        const int nuid = uid + nb * 8; const bool has_next = nuid < NUNITS;
        int nb_ = b, nh = h, nc = c, ncol = col, nrow0 = row0;
        if (has_next) {
            unit_geom(nuid, lane, nb_, nh, nc, ncol, nrow0);
#pragma unroll
            for (int t = 0; t < 16; ++t) qn[t] = load_raw(PRKV, Ab, LD, nrow0 + t, ncol);
            nprr = 0; nprk = 0; nprv = 0;
            const int pr = prev_row(nrow0, 1); if (pr >= 0) { const bf16_t* p1 = PRKV + (size_t)pr * 1536 + ncol; nprr = p1[0]; nprk = p1[512]; nprv = p1[1024]; }
        }
        __builtin_amdgcn_sched_barrier(0);
        float at[16], vt[16]; unsigned btp[8], ktp[8]; float bprev = 0.f, kprev = 0.f;
        float cl = 0.f;
        float rp = bf2f(prr), kp = bf2f(prk), vp = bf2f(prv);
#pragma unroll
        for (int t = 0; t < 16; ++t) {
            const RawTok qq = q[t];
            const int row = row0 + t;
            const float r0 = bf2f(qq.r), k0 = bf2f(qq.k), v0 = bf2f(qq.v);
            const float r = r0 + (rp - r0) * mur, k = k0 + (kp - k0) * muk, v = v0 + (vp - v0) * muv;
            rp = r0; kp = k0; vp = v0;
            const float a = bf2f(qq.a);
            const float kkv = k * kkw;
            const float n2 = wave_sum_dpp(kkv * kkv);
            const float kk = kkv * __builtin_amdgcn_rsqf(fmaxf(n2, 1e-24f));
            const float k2 = k * (1.0f + (a - 1.0f) * kaw);
            const float cf = wave_sum_dpp(r * k2 * rkw);
            if (lane == 0) COEF[(size_t)row * 8 + h] = cf;
            const float wcp = __expf(cl);
            cl += bf2f(qq.ld);
            const float wcn = __expf(cl), iw = __expf(-cl);
            const float btv = kk * a * iw, ktv = k2 * iw;
            at[t] = -kk * wcp; vt[t] = v;
            { const unsigned w = cvt_pk_bf16(at[t], r * wcn); AR[t * 72 + qperm] = (bf16_t)(w & 0xFFFFu); AR[(16 + t) * 72 + qperm] = (bf16_t)(w >> 16); }
            if (t & 1) {
                btp[t >> 1] = cvt_pk_bf16(bprev, btv); ktp[t >> 1] = cvt_pk_bf16(kprev, ktv);
                BK[(t - 1) * 72 + qperm] = (bf16_t)(btp[t >> 1] & 0xFFFFu); BK[t * 72 + qperm] = (bf16_t)(btp[t >> 1] >> 16);
                BK[(16 + t - 1) * 72 + qperm] = (bf16_t)(ktp[t >> 1] & 0xFFFFu); BK[(16 + t) * 72 + qperm] = (bf16_t)(ktp[t >> 1] >> 16);
            } else { bprev = btv; kprev = ktv; }
            if (t & 1) __builtin_amdgcn_sched_barrier(0);
        }
        const float wcc = __expf(cl);
        {
            f32x16 dm;
#pragma unroll
            for (int i = 0; i < 16; ++i) dm[i] = 0.f;
            const int rr = lane & 31, hh = lane >> 5;
#pragma unroll
            for (int ks = 0; ks < 4; ++ks) {
                const bf16x8 fa = *(const LAS bf16x8*)(AR + rr * 72 + 16 * ks + 8 * hh);
                const bf16x8 fb = *(const LAS bf16x8*)(BK + rr * 72 + 16 * ks + 8 * hh);
                dm = __builtin_amdgcn_mfma_f32_32x32x16_bf16(fa, fb, dm, 0, 0, 0);
            }
#pragma unroll
            for (int reg = 0; reg < 16; ++reg) DM[((reg & 3) + 8 * (reg >> 2) + 4 * hh) * 36 + rr] = dm[reg];
        }
        __builtin_amdgcn_sched_barrier(0);
        float uh[16];
#pragma unroll
        for (int t = 0; t < 16; ++t) {
            float wv = at[t], uv = 0.f, wv2 = 0.f, uv2 = 0.f, uv3 = 0.f;
#pragma unroll
            for (int s4 = 0; s4 < 4; ++s4) {
                if (s4 * 4 < t) {
                    const f32x4 ab = *(const LAS f32x4*)(DM + t * 36 + s4 * 4), ak = *(const LAS f32x4*)(DM + t * 36 + 16 + s4 * 4);
#pragma unroll
                    for (int j = 0; j < 4; ++j) {
                        const int s_ = s4 * 4 + j;
                        if (s_ < t) {
                            if (j & 1) { wv2 += ab[j] * at[s_]; uv2 += ak[j] * vt[s_]; } else { wv += ab[j] * at[s_]; uv += ak[j] * vt[s_]; }
                            uv3 += ab[j] * uh[s_];
                        }
                    }
                }
            }
            wv += wv2; uv += uv2 + uv3;
            at[t] = wv; uh[t] = uv;
            asm volatile("" : "+v"(at[t]), "+v"(uh[t]));
        }
        __builtin_amdgcn_sched_barrier(0);
#pragma unroll
        for (int t = 0; t < 16; t += 2) { const unsigned w = cvt_pk_bf16(at[t], at[t + 1]); AR[t * 72 + qperm] = (bf16_t)(w & 0xFFFFu); AR[(t + 1) * 72 + qperm] = (bf16_t)(w >> 16); }
        unsigned char* rec = ws + OFF_CH + (size_t)uid * REC_BYTES;
#pragma unroll
        for (int i = 0; i < 2; ++i) {
            const int pc = i * 64 + lane, row = pc >> 3, part = pc & 7;
            *(u32x4*)(rec + RO_WH + pc * 16) = *(const LAS u32x4*)((LAS unsigned char*)AR + row * 144 + part * 16);
            *(u32x4*)(rec + RO_RT + pc * 16) = *(const LAS u32x4*)((LAS unsigned char*)AR + (16 + row) * 144 + part * 16);
        }
        {
            u32x4 w0, w1;
            w0.x = cvt_pk_bf16(uh[0], uh[1]); w0.y = cvt_pk_bf16(uh[2], uh[3]); w0.z = cvt_pk_bf16(uh[4], uh[5]); w0.w = cvt_pk_bf16(uh[6], uh[7]);
            w1.x = cvt_pk_bf16(uh[8], uh[9]); w1.y = cvt_pk_bf16(uh[10], uh[11]); w1.z = cvt_pk_bf16(uh[12], uh[13]); w1.w = cvt_pk_bf16(uh[14], uh[15]);
            *(u32x4*)(rec + RO_U0T + lane * 32) = w0; *(u32x4*)(rec + RO_U0T + lane * 32 + 16) = w1;
            w0.x = cvt_pk_bf16(vt[0], vt[1]); w0.y = cvt_pk_bf16(vt[2], vt[3]); w0.z = cvt_pk_bf16(vt[4], vt[5]); w0.w = cvt_pk_bf16(vt[6], vt[7]);
            w1.x = cvt_pk_bf16(vt[8], vt[9]); w1.y = cvt_pk_bf16(vt[10], vt[11]); w1.z = cvt_pk_bf16(vt[12], vt[13]); w1.w = cvt_pk_bf16(vt[14], vt[15]);
            *(u32x4*)(rec + RO_VT + lane * 32) = w0; *(u32x4*)(rec + RO_VT + lane * 32 + 16) = w1;
        }
#pragma unroll
        for (int g = 0; g < 4; ++g) {
            u32x4 w; w.x = btp[2 * g]; w.y = btp[2 * g + 1]; w.z = ktp[2 * g]; w.w = ktp[2 * g + 1];
            *(u32x4*)(rec + RO_BKT + lane * 64 + g * 16) = w;
        }
        {
            const int t = lane >> 2, g = lane & 3;
            const f32x4 rb = *(const LAS f32x4*)(DM + (16 + t) * 36 + 4 * g), rk = *(const LAS f32x4*)(DM + (16 + t) * 36 + 16 + 4 * g);
            float o[8];
#pragma unroll
            for (int j = 0; j < 4; ++j) { const bool keep = (4 * g + j) <= t; o[j] = keep ? rb[j] : 0.f; o[4 + j] = keep ? rk[j] : 0.f; }
            u32x4 w; w.x = cvt_pk_bf16(o[0], o[1]); w.y = cvt_pk_bf16(o[2], o[3]); w.z = cvt_pk_bf16(o[4], o[5]); w.w = cvt_pk_bf16(o[6], o[7]);
            *(u32x4*)(rec + RO_ARK + t * 64 + g * 16) = w;
        }
        *(float*)(rec + RO_WCC + lane * 4) = wcc;
        if (!has_next) break;
        uid = nuid; b = nb_; h = nh; c = nc; col = ncol; row0 = nrow0;
#pragma unroll
        for (int t = 0; t < 16; ++t) q[t] = qn[t];
        prr = nprr; prk = nprk; prv = nprv;
        __builtin_amdgcn_sched_barrier(0);
    }
}

__device__ __forceinline__ void convert_expert_weights(const PPv& p, LAS unsigned char* lds, int first, int stride);
struct RecOps { bf16x8 wA0, wA1, rA0, rA1, ark, bk[4]; u32x2 u0, vv; f32x4 wc[4]; };
__device__ __forceinline__ void load_ops(RecOps& o, LAS unsigned char* S, int vs, int fr, int g) {
    o.wA0 = *(const LAS bf16x8*)(S + RO_WH + fr * 128 + g * 16); o.wA1 = *(const LAS bf16x8*)(S + RO_WH + fr * 128 + 64 + g * 16);
    o.rA0 = *(const LAS bf16x8*)(S + RO_RT + fr * 128 + g * 16); o.rA1 = *(const LAS bf16x8*)(S + RO_RT + fr * 128 + 64 + g * 16);
    o.u0 = *(const LAS u32x2*)(S + RO_U0T + (16 * vs + fr) * 32 + g * 8);
    o.vv = *(const LAS u32x2*)(S + RO_VT + (16 * vs + fr) * 32 + g * 8);
    o.ark = *(const LAS bf16x8*)(S + RO_ARK + fr * 64 + g * 16);
#pragma unroll
    for (int m = 0; m < 4; ++m) { o.bk[m] = *(const LAS bf16x8*)(S + RO_BKT + (16 * m + fr) * 64 + g * 16); o.wc[m] = *(const LAS f32x4*)(S + RO_WCC + (16 * m + 4 * g) * 4); }
}
__device__ __forceinline__ void phase_recur(const PPv& p, LAS unsigned char* lds) {
    const int tid = threadIdx.x, bid = blockIdx.x, nb = gridDim.x, lane = tid & 63, wave = __builtin_amdgcn_readfirstlane(tid >> 6);
    unsigned char* ws = p.gws();
    if (bid >= 64) { convert_expert_weights(p, lds, bid - 64, nb - 64); return; }
    unsigned char* CHb = ws + OFF_CH + (size_t)(bid * NCHUNK) * REC_BYTES;
    constexpr int RSLOT = REC_BYTES, RN = 10, PF = 7;
#define R_BAR() do { asm volatile("s_waitcnt lgkmcnt(0)" ::: "memory"); __builtin_amdgcn_s_barrier(); asm volatile("" ::: "memory"); } while (0)
    if (wave >= 4) {
        const int lw = wave - 4;
#define R_ISSUE(x) do { \
            LAS unsigned char* _s = lds + ((x) % RN) * RSLOT; const unsigned char* _r = CHb + (size_t)(x) * REC_BYTES + lane * 16; \
            _Pragma("unroll") for (int _i = 0; _i < 3; ++_i) { const int _pc = lw + 4 * _i; __builtin_amdgcn_global_load_lds((const unsigned*)(_r + _pc * 1024), (LAS unsigned*)(_s + _pc * 1024), 16, 0, 0); } \
            if (lw == 0) __builtin_amdgcn_global_load_lds((const unsigned*)(_r + 12 * 1024), (LAS unsigned*)(_s + 12 * 1024), 16, 0, 0); \
            if (lw == 1) { if (lane < 16) __builtin_amdgcn_global_load_lds((const unsigned*)(_r + 13 * 1024), (LAS unsigned*)(_s + 13 * 1024), 16, 0, 0); } } while (0)
        for (int x = 0; x < PF; ++x) R_ISSUE(x);
        asm volatile("s_waitcnt vmcnt(0)" ::: "memory");
        R_BAR();
        for (int c = 0; c < NCHUNK; ++c) {
            const int x = c + PF;
            if (x < NCHUNK) R_ISSUE(x);
            if (x < NCHUNK) { if (lw < 2) asm volatile("s_waitcnt vmcnt(20)" ::: "memory"); else asm volatile("s_waitcnt vmcnt(15)" ::: "memory"); }
            else asm volatile("s_waitcnt vmcnt(0)" ::: "memory");
            R_BAR();
        }
#undef R_ISSUE
    } else {
        const int vs = wave, fr = lane & 15, g = lane >> 4;
        f32x4 H[4];
#pragma unroll
        for (int m = 0; m < 4; ++m) H[m] = (f32x4){0.f, 0.f, 0.f, 0.f};
        R_BAR();
        RecOps cur, nxt;
        load_ops(cur, lds, vs, fr, g);
        for (int c = 0; c < NCHUNK; ++c) {
            if (c + 1 < NCHUNK) load_ops(nxt, lds + ((c + 1) % RN) * RSLOT, vs, fr, g); else nxt = cur;
            u32x4 hb0, hb1;
            hb0.x = cvt_pk_bf16(H[0][0], H[0][1]); hb0.y = cvt_pk_bf16(H[0][2], H[0][3]); hb0.z = cvt_pk_bf16(H[1][0], H[1][1]); hb0.w = cvt_pk_bf16(H[1][2], H[1][3]);
            hb1.x = cvt_pk_bf16(H[2][0], H[2][1]); hb1.y = cvt_pk_bf16(H[2][2], H[2][3]); hb1.z = cvt_pk_bf16(H[3][0], H[3][1]); hb1.w = cvt_pk_bf16(H[3][2], H[3][3]);
            const bf16x8 hB0 = __builtin_bit_cast(bf16x8, hb0), hB1 = __builtin_bit_cast(bf16x8, hb1);
            f32x4 U = (f32x4){bflo(cur.u0.x), bfhi(cur.u0.x), bflo(cur.u0.y), bfhi(cur.u0.y)};
            U = __builtin_amdgcn_mfma_f32_16x16x32_bf16(cur.wA0, hB0, U, 0, 0, 0);
            U = __builtin_amdgcn_mfma_f32_16x16x32_bf16(cur.wA1, hB1, U, 0, 0, 0);
            f32x4 Y = (f32x4){0.f, 0.f, 0.f, 0.f};
            Y = __builtin_amdgcn_mfma_f32_16x16x32_bf16(cur.rA0, hB0, Y, 0, 0, 0);
            Y = __builtin_amdgcn_mfma_f32_16x16x32_bf16(cur.rA1, hB1, Y, 0, 0, 0);
            u32x4 uvw; uvw.x = cvt_pk_bf16(U[0], U[1]); uvw.y = cvt_pk_bf16(U[2], U[3]); uvw.z = cur.vv.x; uvw.w = cur.vv.y;
            const bf16x8 uv = __builtin_bit_cast(bf16x8, uvw);
            Y = __builtin_amdgcn_mfma_f32_16x16x32_bf16(cur.ark, uv, Y, 0, 0, 0);
#pragma unroll
            for (int m = 0; m < 4; ++m) { H[m] = __builtin_amdgcn_mfma_f32_16x16x32_bf16(cur.bk[m], uv, H[m], 0, 0, 0); H[m] *= cur.wc[m]; }
            u32x2 yw; yw.x = cvt_pk_bf16(Y[0], Y[1]); yw.y = cvt_pk_bf16(Y[2], Y[3]);
            *(u32x2*)(CHb + (size_t)c * REC_BYTES + RO_U0T + (16 * vs + fr) * 32 + g * 8) = yw;
            R_BAR();
            cur = nxt;
        }
    }
#undef R_BAR
}

__device__ __forceinline__ void phase_gn(const PPv& p) {
    const int tid = threadIdx.x, bid = blockIdx.x, nb = gridDim.x, lane = tid & 63, wave = tid >> 6;
    unsigned char* ws = p.gws();
    const bf16_t* Gb = (const bf16_t*)(ws + OFF_G); const float* COEF = (const float*)(ws + OFF_COEF);
    bf16_t* Z = (bf16_t*)(ws + OFF_Z);
    constexpr int NREAL = 64 * 256;
    for (int r0 = bid * 8 + wave; r0 < NREAL; r0 += nb * 16) {
        u32x4 y0[2], y1[2], v0[2], v1[2]; float cfv[2][16]; bf16_t ggv[2][16]; int colv[2], row0v[2], hv[2]; bool okv[2];
#pragma unroll
        for (int u = 0; u < 2; ++u) {
            const int r = r0 + u * nb * 8; okv[u] = r < NREAL;
            const int rr = okv[u] ? r : r0;
            const int bh = rr >> 8, c = (rr & 255) + 1, b = bh >> 3, h = bh & 7, uid = bh * NCHUNK + c;
            hv[u] = h; colv[u] = h * 64 + lane; row0v[u] = b * SEQ + c * 16;
            const unsigned char* rec = ws + OFF_CH + (size_t)uid * REC_BYTES;
            y0[u] = *(const u32x4*)(rec + RO_U0T + lane * 32); y1[u] = *(const u32x4*)(rec + RO_U0T + lane * 32 + 16);
            v0[u] = *(const u32x4*)(rec + RO_VT + lane * 32); v1[u] = *(const u32x4*)(rec + RO_VT + lane * 32 + 16);
#pragma unroll
            for (int t = 0; t < 16; ++t) { cfv[u][t] = COEF[(size_t)(row0v[u] + t) * 8 + h]; ggv[u][t] = Gb[(size_t)(row0v[u] + t) * 512 + colv[u]]; }
        }
#pragma unroll
        for (int u = 0; u < 2; ++u) {
            if (!okv[u]) continue;
            const int col = colv[u], row0 = row0v[u];
            const float lng = p.gin(21)[col], lnb = p.gin(22)[col];
            const unsigned yw[8] = {y0[u].x, y0[u].y, y0[u].z, y0[u].w, y1[u].x, y1[u].y, y1[u].z, y1[u].w}, vw[8] = {v0[u].x, v0[u].y, v0[u].z, v0[u].w, v1[u].x, v1[u].y, v1[u].z, v1[u].w};
#pragma unroll
            for (int t = 0; t < 16; ++t) {
                const float y = (t & 1) ? bfhi(yw[t >> 1]) : bflo(yw[t >> 1]);
                const float v = (t & 1) ? bfhi(vw[t >> 1]) : bflo(vw[t >> 1]);
                const float mean = wave_sum_dpp(y) * (1.0f / 64.0f);
                const float dlt = y - mean;
                const float var = wave_sum_dpp(dlt * dlt) * (1.0f / 64.0f);
                const float yn = dlt * rsqrtf(var + LNX_EPS) * lng + lnb;
                Z[(size_t)(row0 + t - NMETA) * 512 + col] = f2bf((yn + cfv[u][t] * v) * bf2f(ggv[u][t]));
            }
        }
    }
}

__device__ __forceinline__ void convert_expert_weights(const PPv& p, LAS unsigned char* lds, int first, int stride) {
    unsigned char* ws = p.gws();
    const int tid = threadIdx.x;
    LAS float* tile = (LAS float*)lds;
    const float* g2 = p.gin(27);
    bf16_t* WGU = (bf16_t*)(ws + OFF_WGU); bf16_t* WD = (bf16_t*)(ws + OFF_WD);
    constexpr int NBLK = NE * 3 * 64;
    const int lr = tid >> 6, lc = (tid & 63) * 4;
    f32x4 cur[8];
    int j = first;
    if (j >= NBLK) return;
    {
        const int mat = j >> 6, e = mat / 3, which = mat - 3 * e, bb = j & 63, kb = bb & 15, nbk = bb >> 4;
        const float* src = (which == 0 ? p.gin(30) : which == 1 ? p.gin(32) : p.gin(34)) + (size_t)e * 1024 * 1024 + (size_t)(kb * 64) * 1024 + nbk * 256;
#pragma unroll
        for (int i = 0; i < 8; ++i) cur[i] = __builtin_nontemporal_load((const f32x4*)(src + (size_t)(lr + 8 * i) * 1024 + lc));
    }
    for (;;) {
        const int jn = j + stride; const bool has_next = jn < NBLK;
        f32x4 nxt[8];
        if (has_next) {
            const int mat = jn >> 6, e = mat / 3, which = mat - 3 * e, bb = jn & 63, kb = bb & 15, nbk = bb >> 4;
            const float* src = (which == 0 ? p.gin(30) : which == 1 ? p.gin(32) : p.gin(34)) + (size_t)e * 1024 * 1024 + (size_t)(kb * 64) * 1024 + nbk * 256;
#pragma unroll
            for (int i = 0; i < 8; ++i) nxt[i] = __builtin_nontemporal_load((const f32x4*)(src + (size_t)(lr + 8 * i) * 1024 + lc));
        }
        const int mat = j >> 6, e = mat / 3, which = mat - 3 * e, bb = j & 63, kb = bb & 15, nbk = bb >> 4;
#pragma unroll
        for (int i = 0; i < 8; ++i) { LAS float* t = tile + (lr + 8 * i) * 257 + lc; t[0] = cur[i][0]; t[1] = cur[i][1]; t[2] = cur[i][2]; t[3] = cur[i][3]; }
        __syncthreads();
        {
            const int kq = tid & 7, k0 = kb * 64 + 8 * kq;
            float sc[8];
#pragma unroll
            for (int jj = 0; jj < 8; ++jj) sc[jj] = which < 2 ? g2[k0 + jj] : 1.0f;
#pragma unroll
            for (int i = 0; i < 4; ++i) {
                const int nn = (tid >> 3) + 64 * i, n = nbk * 256 + nn;
                float v[8];
#pragma unroll
                for (int jj = 0; jj < 8; ++jj) v[jj] = tile[(8 * kq + jj) * 257 + nn] * sc[jj];
                u32x4 w; w.x = cvt_pk_bf16(v[0], v[1]); w.y = cvt_pk_bf16(v[2], v[3]); w.z = cvt_pk_bf16(v[4], v[5]); w.w = cvt_pk_bf16(v[6], v[7]);
                bf16_t* dst = which < 2 ? WGU + (size_t)e * 2048 * 1024 + (size_t)(256 * (n >> 7) + 128 * which + (n & 127)) * 1024
                                        : WD + (size_t)e * 1024 * 1024 + (size_t)n * 1024;
                __builtin_nontemporal_store(w, (u32x4*)(dst + k0));
            }
        }
        __syncthreads();
        if (!has_next) break;
        j = jn;
#pragma unroll
        for (int i = 0; i < 8; ++i) cur[i] = nxt[i];
    }
}

__device__ __forceinline__ void phase_router(const PPv& p, LAS unsigned char* lds) {
    const int tid = threadIdx.x, bid = blockIdx.x, nb = gridDim.x, lane = tid & 63, wave = tid >> 6;
    unsigned char* ws = p.gws();
    const bf16_t* h1 = (const bf16_t*)(ws + OFF_HB2);
    const float* WRG = (const float*)(ws + OFF_WRG);
    const float* brt = p.gin(29);
    LAS float* slog = (LAS float*)lds;
    LAS float* srs = slog + 8 * 16 * 32;
    LAS int* lcnt = (LAS int*)(srs + 128);
    LAS int* gbase = lcnt + 32;
    LAS int* ltopi = gbase + 32;
    LAS int* lrank = ltopi + 512;
    int* TOPI = (int*)(ws + OFF_TOPI); float* TOPW = (float*)(ws + OFF_TOPW); int* RANK = (int*)(ws + OFF_RANK); float* RSTD2 = (float*)(ws + OFF_RSTD2);
    int* GCNT = (int*)(ws + OFF_GCNT);
    for (int tb = bid; tb < T / 128; tb += nb) {
        if (tid < 32) lcnt[tid] = 0;
        __syncthreads();
        const int t0 = tb * 128 + wave * 16;
        {
            const int row = lane & 15, kq = lane >> 4;
            const bf16_t* ap = h1 + (size_t)(t0 + row) * D + 4 * kq;
            const float* bp = WRG + (size_t)(4 * kq) * 32 + row;
            f32x4 acc0 = (f32x4){0.f, 0.f, 0.f, 0.f}, acc1 = acc0;
            float ss = 0.f;
            for (int j = 0; j < 64; ++j) {
                const u32x2 aw = *(const u32x2*)(ap + 16 * j);
                const f32x4 av = (f32x4){bflo(aw.x), bfhi(aw.x), bflo(aw.y), bfhi(aw.y)};
                ss += av[0] * av[0] + av[1] * av[1] + av[2] * av[2] + av[3] * av[3];
                const float* bj = bp + (size_t)(16 * j) * 32;
#pragma unroll
                for (int s = 0; s < 4; ++s) {
                    const float b0 = bj[s * 32], b1 = bj[s * 32 + 16];
                    acc0 = __builtin_amdgcn_mfma_f32_16x16x4f32(av[s], b0, acc0, 0, 0, 0);
                    acc1 = __builtin_amdgcn_mfma_f32_16x16x4f32(av[s], b1, acc1, 0, 0, 0);
                }
            }
            ss += __shfl_xor(ss, 16); ss += __shfl_xor(ss, 32);
#pragma unroll
            for (int reg = 0; reg < 4; ++reg) {
                slog[(wave * 16 + 4 * kq + reg) * 32 + row] = acc0[reg];
                slog[(wave * 16 + 4 * kq + reg) * 32 + 16 + row] = acc1[reg];
            }
            if (lane < 16) srs[wave * 16 + lane] = rsqrtf(ss * (1.0f / D) + NORM_EPS);
        }
        __syncthreads();
        if (lane < 16) {
            const int tl = wave * 16 + lane, t = tb * 128 + tl;
            const float rs = srs[tl];
            float lg[32];
#pragma unroll
            for (int e = 0; e < 32; ++e) lg[e] = slog[tl * 32 + e] * rs + brt[e];
            int ti[4]; float tv[4];
#pragma unroll
            for (int k = 0; k < 4; ++k) {
                float best = -3.0e38f; int bi = 0;
#pragma unroll
                for (int e = 0; e < 32; ++e) { const bool tk = lg[e] > best; best = tk ? lg[e] : best; bi = tk ? e : bi; }
                ti[k] = bi; tv[k] = best;
#pragma unroll
                for (int e = 0; e < 32; ++e) lg[e] = (e == bi) ? -3.0e38f : lg[e];
            }
            const float e0 = 1.0f, e1 = __expf(tv[1] - tv[0]), e2 = __expf(tv[2] - tv[0]), e3 = __expf(tv[3] - tv[0]);
            const float inv = 1.0f / (e0 + e1 + e2 + e3);
            *(f32x4*)(TOPW + (size_t)t * 4) = (f32x4){e0 * inv, e1 * inv, e2 * inv, e3 * inv};
            RSTD2[t] = rs;
#pragma unroll
            for (int k = 0; k < 4; ++k) { ltopi[tl * 4 + k] = ti[k]; lrank[tl * 4 + k] = __hip_atomic_fetch_add(lcnt + ti[k], 1, __ATOMIC_RELAXED, __HIP_MEMORY_SCOPE_WORKGROUP); }
        }
        __syncthreads();
        if (tid < 32) gbase[tid] = atomicAdd(GCNT + tid, lcnt[tid]);
        __syncthreads();
        {
            const int e = ltopi[tid];
            TOPI[(size_t)tb * 512 + tid] = e;
            RANK[(size_t)tb * 512 + tid] = gbase[e] + lrank[tid];
        }
        __syncthreads();
    }
}

__device__ __forceinline__ void phase_lists(const PPv& p, LAS unsigned char* lds) {
    const int tid = threadIdx.x, bid = blockIdx.x, nb = gridDim.x;
    unsigned char* ws = p.gws();
    LAS int* pstart = (LAS int*)lds;
    LAS int* cnt = pstart + 64;
    const int* GCNT = (const int*)(ws + OFF_GCNT);
    if (tid < 32) cnt[tid] = GCNT[tid];
    __syncthreads();
    if (tid == 0) { int s = 0; for (int e = 0; e < 32; ++e) { pstart[e] = s; s += ((cnt[e] + 255) >> 8) << 8; } pstart[32] = s; }
    __syncthreads();
    const int* TOPI = (const int*)(ws + OFF_TOPI); const float* TOPW = (const float*)(ws + OFF_TOPW); const int* RANK = (const int*)(ws + OFF_RANK); const float* RSTD2 = (const float*)(ws + OFF_RSTD2);
    int* ROWTOK = (int*)(ws + OFF_ROWTOK); int* ROWSLOT = (int*)(ws + OFF_ROWSLOT); float* ROWW = (float*)(ws + OFF_ROWW); float* ROWRS = (float*)(ws + OFF_ROWRS);
    for (int i = bid * 512 + tid; i < T * 4; i += nb * 512) {
        const int e = TOPI[i], pos = pstart[e] + RANK[i], t = i >> 2;
        ROWTOK[pos] = t; ROWSLOT[pos] = i; ROWW[pos] = TOPW[i]; ROWRS[pos] = RSTD2[t];
    }
    for (int e = bid; e < 32; e += nb) {
        for (int pos = pstart[e] + cnt[e] + tid; pos < pstart[e + 1]; pos += 512) { ROWTOK[pos] = 0; ROWSLOT[pos] = -1; ROWW[pos] = 0.f; ROWRS[pos] = 0.f; }
    }
    if (bid == 0) {
        int* TILEE = (int*)(ws + OFF_TILEE);
        const int ntiles = pstart[32] >> 8;
        for (int mt = tid; mt < ntiles; mt += 512) { int e = 0; for (int q = 0; q < 32; ++q) if (pstart[q] <= mt * 256) e = q; TILEE[mt] = e; }
        if (tid == 0) TILEE[1000] = ntiles;
    }
    __syncthreads();
}

__device__ __forceinline__ void phase_final(const PPv& p) {
    const int tid = threadIdx.x, bid = blockIdx.x, nb = gridDim.x, lane = tid & 63, wave = tid >> 6;
    unsigned char* ws = p.gws();
    const bf16_t* HB2 = (const bf16_t*)(ws + OFF_HB2);
    const bf16_t* YA = (const bf16_t*)p.gout(); const bf16_t* YB = (const bf16_t*)(ws + OFF_WGU);
    const float* gf = p.gin(36);
    const f32x4 ga0 = *(const f32x4*)(gf + 8 * lane), ga1 = *(const f32x4*)(gf + 8 * lane + 4), gb0 = *(const f32x4*)(gf + 512 + 8 * lane), gb1 = *(const f32x4*)(gf + 512 + 8 * lane + 4);
    for (int t0 = (bid * 8 + wave) * 2; t0 < T; t0 += nb * 16) {
        u32x4 ha[2], hb[2], ya[2][4], yb[2][4];
#pragma unroll
        for (int u = 0; u < 2; ++u) {
            const int t = t0 + u;
            ha[u] = __builtin_nontemporal_load((const u32x4*)(HB2 + (size_t)t * D + 8 * lane)); hb[u] = __builtin_nontemporal_load((const u32x4*)(HB2 + (size_t)t * D + 512 + 8 * lane));
#pragma unroll
            for (int k = 0; k < 4; ++k) { ya[u][k] = __builtin_nontemporal_load((const u32x4*)(YA + (size_t)(4 * t + k) * 512 + 8 * lane)); yb[u][k] = __builtin_nontemporal_load((const u32x4*)(YB + (size_t)(4 * t + k) * 512 + 8 * lane)); }
        }
#pragma unroll
        for (int u = 0; u < 2; ++u) {
            const int t = t0 + u;
            float va[8] = {bflo(ha[u].x), bfhi(ha[u].x), bflo(ha[u].y), bfhi(ha[u].y), bflo(ha[u].z), bfhi(ha[u].z), bflo(ha[u].w), bfhi(ha[u].w)};
            float vb[8] = {bflo(hb[u].x), bfhi(hb[u].x), bflo(hb[u].y), bfhi(hb[u].y), bflo(hb[u].z), bfhi(hb[u].z), bflo(hb[u].w), bfhi(hb[u].w)};
#pragma unroll
            for (int k = 0; k < 4; ++k) {
                const u32x4 a4 = ya[u][k], b4 = yb[u][k];
                va[0] += bflo(a4.x); va[1] += bfhi(a4.x); va[2] += bflo(a4.y); va[3] += bfhi(a4.y); va[4] += bflo(a4.z); va[5] += bfhi(a4.z); va[6] += bflo(a4.w); va[7] += bfhi(a4.w);
                vb[0] += bflo(b4.x); vb[1] += bfhi(b4.x); vb[2] += bflo(b4.y); vb[3] += bfhi(b4.y); vb[4] += bflo(b4.z); vb[5] += bfhi(b4.z); vb[6] += bflo(b4.w); vb[7] += bfhi(b4.w);
            }
            float ss = 0.f;
#pragma unroll
            for (int j = 0; j < 8; ++j) ss += va[j] * va[j] + vb[j] * vb[j];
            ss = wave_sum_dpp(ss);
            const float rs = rsqrtf(ss * (1.0f / D) + NORM_EPS);
            float* o = p.gout() + (size_t)t * D;
            __builtin_nontemporal_store((f32x4){va[0] * rs * ga0[0], va[1] * rs * ga0[1], va[2] * rs * ga0[2], va[3] * rs * ga0[3]}, (f32x4*)(o + 8 * lane));
            __builtin_nontemporal_store((f32x4){va[4] * rs * ga1[0], va[5] * rs * ga1[1], va[6] * rs * ga1[2], va[7] * rs * ga1[3]}, (f32x4*)(o + 8 * lane + 4));
            __builtin_nontemporal_store((f32x4){vb[0] * rs * gb0[0], vb[1] * rs * gb0[1], vb[2] * rs * gb0[2], vb[3] * rs * gb0[3]}, (f32x4*)(o + 512 + 8 * lane));
            __builtin_nontemporal_store((f32x4){vb[4] * rs * gb1[0], vb[5] * rs * gb1[1], vb[6] * rs * gb1[2], vb[7] * rs * gb1[3]}, (f32x4*)(o + 512 + 8 * lane + 4));
        }
    }
}

#define XB_TMO      128
#define XB_XCNT(j)  (256  + 64 * (j))
#define XB_XSUB(j)  (1280 + 64 * (j))
#define XB_XGEN(j)  (2304 + 64 * (j))
#define XB_TOP      3328
#define XB_TOPGEN   3392
#define XCD_BAR_WORDS 3456
#define XB_SPIN_CAP (1u << 18)
__device__ __forceinline__ unsigned xb_ld(unsigned* p)              { return __hip_atomic_load(p, __ATOMIC_RELAXED, __HIP_MEMORY_SCOPE_AGENT); }
__device__ __forceinline__ unsigned xb_add(unsigned* p, unsigned v) { return __hip_atomic_fetch_add(p, v, __ATOMIC_RELAXED, __HIP_MEMORY_SCOPE_AGENT); }
__device__ __forceinline__ unsigned xb_xcc_id() { return (unsigned)__builtin_amdgcn_s_getreg((3 << 11) | 20) & 0xFu; }
#define XB_SPIN(cond, bar) do { unsigned _sp = 0; while (cond) { __builtin_amdgcn_s_sleep(1); \
    if ((++_sp & 255u) == 0u) { if (xb_ld(&(bar)[XB_TMO])) break; if (_sp > XB_SPIN_CAP) { atomicAdd(&(bar)[XB_TMO], 1u); break; } } } } while (0)
struct XcdBarrier { unsigned* bar; unsigned x; volatile LAS unsigned* st; };
__device__ __forceinline__ XcdBarrier xcd_barrier_post(unsigned* bar, volatile LAS unsigned* st) {
    XcdBarrier b; b.bar = bar; b.x = xb_xcc_id(); b.st = st;
    if (threadIdx.x == 0) (void)xb_add(&bar[XB_XCNT(b.x)], 1u);
    return b;
}
__device__ __forceinline__ void xcd_barrier_complete(unsigned* bar, unsigned x, unsigned& nloc, unsigned& nx) {
    const unsigned G = gridDim.x * gridDim.y * gridDim.z;
    unsigned sum, cnt, mine, sp = 0u;
    for (;;) {
        sum = 0u; cnt = 0u; mine = 0u;
#pragma unroll
        for (unsigned j = 0; j < 16; ++j) { const unsigned c = xb_ld(&bar[XB_XCNT(j)]); sum += c; cnt += (c > 0u) ? 1u : 0u; mine = (j == x) ? c : mine; }
        if (sum == G) break;
        __builtin_amdgcn_s_sleep(1);
        if ((++sp & 255u) == 0u) { if (xb_ld(&bar[XB_TMO])) break; if (sp > XB_SPIN_CAP) { atomicAdd(&bar[XB_TMO], 1u); break; } }
    }
    nloc = mine > 0u ? mine : 1u; nx = cnt > 0u ? cnt : 1u;
}
__device__ __forceinline__ void xcd_barrier(const XcdBarrier& b) {
    asm volatile("s_waitcnt vmcnt(0)" ::: "memory");
    __syncthreads();
    if (threadIdx.x == 0) {
        unsigned* bar = b.bar;
        __builtin_amdgcn_s_waitcnt(0);
        unsigned nloc = b.st[0], nx = b.st[1];
        if (nloc == 0u) { xcd_barrier_complete(bar, b.x, nloc, nx); b.st[0] = nloc; b.st[1] = nx; }
        const unsigned old = xb_add(&bar[XB_XSUB(b.x)], 1u);
        const unsigned gen = old / nloc;
        if (old + 1u == (gen + 1u) * nloc) {
            __builtin_amdgcn_fence(__ATOMIC_RELEASE, "agent");
            asm volatile("s_waitcnt vmcnt(0)" ::: "memory");
            const unsigned og = xb_add(&bar[XB_TOP], 1u);
            const unsigned tg = og / nx;
            if (og + 1u == (tg + 1u) * nx) xb_add(&bar[XB_TOPGEN], 1u);
            else XB_SPIN(xb_ld(&bar[XB_TOPGEN]) == tg, bar);
            __builtin_amdgcn_fence(__ATOMIC_ACQUIRE, "agent");
            xb_add(&bar[XB_XGEN(b.x)], 1u);
            asm volatile("s_waitcnt vmcnt(0)" ::: "memory");
        } else {
            XB_SPIN(xb_ld(&bar[XB_XGEN(b.x)]) == gen, bar);
            __builtin_amdgcn_fence(__ATOMIC_ACQUIRE, "agent");
            asm volatile("s_waitcnt vmcnt(0)" ::: "memory");
        }
    }
    __syncthreads();
}

constexpr int N_PHASES = 15;
__global__ void __launch_bounds__(512, 2) mega(Params p) {
    extern __shared__ __attribute__((aligned(16))) unsigned char lds_raw[];
    LAS unsigned char* lds = (LAS unsigned char*)lds_raw;
    cg::grid_group grid = cg::this_grid();
    unsigned char* ws = getpp().gws();
    const int G = gridDim.x, bid = blockIdx.x;
#ifndef ONLY_PHASE
#define ONLY_PHASE -1
#endif
#define IN(k) ((ONLY_PHASE < 0 || ONLY_PHASE == (k)) && p.ph_lo <= (k) && (k) < p.ph_hi)
    volatile LAS unsigned* xst = (volatile LAS unsigned*)(lds + 163840 - 16);
    if (threadIdx.x < 4) xst[threadIdx.x] = 0u;
    __syncthreads();
    const XcdBarrier xbar = xcd_barrier_post((unsigned*)(ws + OFF_BAR), xst);
    if (p.ph_hi < 0) grid.sync();
#define SEAM(k) do { if ((k) + 1 < p.ph_hi) xcd_barrier(xbar); } while (0)
    if (IN(0)) { const PPv q = getpp(); phase_prep(q, lds); SEAM(0); }
    if (IN(1)) { const PPv q = getpp();
        phase_meta_proj(q, lds);
        StaticOrder S; S.init(ws + OFF_HB, ws + OFF_WIN, T, NCOLS1, 1024, G, bid);
        EpiProj E{(bf16_t*)(ws + OFF_PRKV), (bf16_t*)(ws + OFF_PCONV), (bf16_t*)q.gout(), (const float*)(ws + OFF_RSTD1)};
        gemm_phase<false>(lds, 1024, S, E);
        SEAM(1);
    }
    if (IN(2)) { const PPv q = getpp(); phase_lprep_conv(q); SEAM(2); }
    if (IN(3)) { const PPv q = getpp();
        phase_meta_lora(q);
        StaticOrder S; S.init(ws + OFF_L + (size_t)NMETA * 256 * 2, ws + OFF_W2, T, 1536, 256, G, bid);
        EpiL E{ws, q.gin(10), q.gin(13)};
        gemm_phase<false>(lds, 256, S, E);
        SEAM(3);
    }
    if (IN(4)) { const PPv q = getpp(); phase_scanprep(q, lds); SEAM(4); }
    if (IN(5)) { const PPv q = getpp(); phase_recur(q, lds); SEAM(5); }
    if (IN(6)) { const PPv q = getpp(); phase_gn(q); SEAM(6); }
    if (IN(7)) { const PPv q = getpp();
        MergeOrder S; S.so.init(ws + OFF_Z, ws + OFF_WR, T, 1024, 512, G, bid); S.A1 = (const char*)(ws + OFF_C); S.B1 = (const char*)(ws + OFF_WC);
        EpiMergeFused E{(bf16_t*)(ws + OFF_MERGED), (const bf16_t*)q.gout()};
        gemm_phase<false>(lds, 512, S, E);
        SEAM(7);
    }
    if (IN(9)) { const PPv q = getpp();
        StaticOrder S; S.init(ws + OFF_MERGED, ws + OFF_WO, T, 1024, 1024, G, bid);
        EpiO E{q.gin(0), q.gout(), (bf16_t*)(ws + OFF_HB2)};
        gemm_phase<false>(lds, 1024, S, E);
        SEAM(9);
    }
    if (IN(10)) { const PPv q = getpp(); phase_router(q, lds); SEAM(10); }
    if (IN(11)) { const PPv q = getpp(); phase_lists(q, lds); SEAM(11); }
    if (IN(12)) { const PPv q = getpp();
        const int* TILEE = (const int*)(ws + OFF_TILEE);
        MoeOrder S; S.A = (const char*)(ws + OFF_HB2); S.Bt = (const char*)(ws + OFF_WGU); S.K = 1024; S.estride = (size_t)2048 * 1024 * 2;
        S.tile_e = TILEE; S.rowtok = (const int*)(ws + OFF_ROWTOK); S.ntiles = TILEE[1000]; S.nnt = 8; S.G = G; S.c = bid; S.gather = true;
        EpiMoe1 E{(bf16_t*)(ws + OFF_ACT), (const float*)(ws + OFF_ROWRS), q.gin(31), q.gin(33)};
        gemm_phase<true>(lds, 1024, S, E);
        SEAM(12);
    }
    if (IN(13)) { const PPv q = getpp();
        const int* TILEE = (const int*)(ws + OFF_TILEE);
        MoeOrder S; S.A = (const char*)(ws + OFF_ACT); S.Bt = (const char*)(ws + OFF_WD); S.K = 1024; S.estride = (size_t)1024 * 1024 * 2;
        S.tile_e = TILEE; S.rowtok = nullptr; S.ntiles = TILEE[1000]; S.nnt = 4; S.G = G; S.c = bid; S.gather = false;
        EpiMoe2 E{(bf16_t*)q.gout(), (bf16_t*)(ws + OFF_WGU), (const int*)(ws + OFF_ROWSLOT), (const float*)(ws + OFF_ROWW), q.gin(35)};
        gemm_phase<false>(lds, 1024, S, E);
        SEAM(13);
    }
    if (IN(14)) { const PPv q = getpp(); phase_final(q); }
}

extern "C" void kernel_launch(void* const* d_in, const int* in_sizes, int n_in, void* d_out, int out_size, void* d_ws, size_t ws_size,
                              hipStream_t stream) {
    constexpr size_t kDynLds = 160 * 1024;
    static int grid_blocks = 0;
    if (!grid_blocks) {
        int dev = 0, cus = 0, per_cu = 0;
        (void)hipGetDevice(&dev);
        (void)hipDeviceGetAttribute(&cus, hipDeviceAttributeMultiprocessorCount, dev);
        (void)hipFuncSetAttribute((const void*)mega, hipFuncAttributeMaxDynamicSharedMemorySize, (int)kDynLds);
        (void)hipOccupancyMaxActiveBlocksPerMultiprocessor(&per_cu, mega, 512, kDynLds);
        if (per_cu > 1) per_cu = 1;
        grid_blocks = cus * per_cu;
        fprintf(stderr, "cus=%d per_cu=%d ws_size=%zu need=%zu\n", cus, per_cu, ws_size, (size_t)WS_NEED);
    }
    if (ws_size < WS_NEED || n_in < 37 || grid_blocks < 128) { fprintf(stderr, "kernel_launch: unsupported configuration\n"); return; }
    Params p{};
    for (int i = 0; i < 37; ++i) p.in[i] = (const float*)d_in[i];
    p.out = (float*)d_out;
    p.ws = (unsigned char*)d_ws;
    p.ph_lo = 0; p.ph_hi = N_PHASES;
    (void)hipMemsetAsync((unsigned char*)d_ws + OFF_BAR, 0, 16384, stream);
    void* args[] = {&p};
    hipError_t e = hipLaunchCooperativeKernel((void*)mega, dim3(grid_blocks), dim3(512), args, kDynLds, stream);
    if (e != hipSuccess) fprintf(stderr, "cooperative launch failed: %s (grid %d)\n", hipGetErrorString(e), grid_blocks);
}
```

```cpp
#include <hip/hip_runtime.h>
#include <hip/hip_cooperative_groups.h>
#include <cstdio>
namespace cg = cooperative_groups;

#define LAS __attribute__((address_space(3)))
typedef unsigned short bf16_t;
typedef short bf16x8 __attribute__((ext_vector_type(8)));
typedef float f32x4 __attribute__((ext_vector_type(4)));
typedef float f32x2 __attribute__((ext_vector_type(2)));
typedef unsigned u32x4 __attribute__((ext_vector_type(4)));
typedef unsigned u32x2 __attribute__((ext_vector_type(2)));

constexpr int D = 1024, NBATCH = 8, SEQ = 4096, NMETA = 16;
constexpr int T = NBATCH * SEQ;
constexpr int NR = T + NMETA;
constexpr int NRP = 33024;
constexpr int PCOLS1 = 3584;
constexpr int NCOLS1 = 5632;
constexpr int NE = 32, TOPK = 4, DFF = 1024;
constexpr int MAXROWS = T * TOPK + NE * 256;
constexpr int MAXTILES = MAXROWS / 256;
constexpr float NORM_EPS = 1e-5f, LNX_EPS = 64e-5f;

constexpr int NCHUNK = 257, NUNITS = 64 * NCHUNK;
constexpr int REC_BYTES = 13568;
constexpr int RO_WH = 0, RO_RT = 2048, RO_U0T = 4096, RO_VT = 6144, RO_BKT = 8192, RO_ARK = 12288, RO_WCC = 13312;
constexpr int SLOT_BYTES = 15680, SO_G = 13568, SO_COEF = 15616, NSLOT = 9;
constexpr size_t SZ_ACT = (size_t)MAXROWS * 1024 * 2;
constexpr size_t SZ_WGU = (size_t)NE * 2048 * 1024 * 2;
constexpr size_t SZ_WD = (size_t)NE * 1024 * 1024 * 2;
constexpr size_t SZ_HB = (size_t)T * 1024 * 2;
constexpr size_t OFF_WGU = 0;
constexpr size_t OFF_WD = OFF_WGU + SZ_WGU;
constexpr size_t OFF_ACT = OFF_WD + SZ_WD;
constexpr size_t OFF_HB2 = OFF_ACT + SZ_ACT;
constexpr size_t OFF_RT = OFF_HB2 + SZ_HB;
constexpr size_t OFF_TOPI = OFF_RT;
constexpr size_t OFF_TOPW = OFF_TOPI + (size_t)T * 16;
constexpr size_t OFF_RANK = OFF_TOPW + (size_t)T * 16;
constexpr size_t OFF_RSTD2 = OFF_RANK + (size_t)T * 16;
constexpr size_t OFF_ROWTOK = OFF_RSTD2 + (size_t)T * 4;
constexpr size_t OFF_ROWSLOT = OFF_ROWTOK + (size_t)MAXROWS * 4;
constexpr size_t OFF_ROWW = OFF_ROWSLOT + (size_t)MAXROWS * 4;
constexpr size_t OFF_ROWRS = OFF_ROWW + (size_t)MAXROWS * 4;
constexpr size_t OFF_TILEE = OFF_ROWRS + (size_t)MAXROWS * 4;
constexpr size_t OFF_GCNT = OFF_TILEE + 4096;
constexpr size_t OFF_SM = OFF_GCNT + 256;
constexpr size_t OFF_WR = OFF_SM;
constexpr size_t OFF_WC = OFF_WR + (size_t)1024 * 512 * 2;
constexpr size_t OFF_WO = OFF_WC + (size_t)1024 * 512 * 2;
constexpr size_t OFF_W2 = OFF_WO + (size_t)1024 * 1024 * 2;
constexpr size_t OFF_RSTD1 = OFF_W2 + (size_t)1536 * 256 * 2;
constexpr size_t OFF_WRG = OFF_RSTD1 + (size_t)NRP * 4;
constexpr size_t OFF_BAR = OFF_WRG + (size_t)1024 * 32 * 4;
constexpr size_t WS_NEED = OFF_BAR + 16384;
constexpr size_t OFF_PRKV = 0;
constexpr size_t SZ_PRKV = (size_t)NR * 1536 * 2;
constexpr size_t OFF_LD = OFF_PRKV + SZ_PRKV;
constexpr size_t OFF_A = OFF_LD + (size_t)NRP * 512 * 4;
constexpr size_t OFF_CH = OFF_A + (size_t)NRP * 512 * 2;
constexpr size_t OFF_PCONV = OFF_CH;
constexpr size_t SZ_PCONV = (size_t)NR * 2048 * 2;
constexpr size_t OFF_HB = OFF_PCONV + SZ_PCONV;
constexpr size_t OFF_L = OFF_HB + SZ_HB;
constexpr size_t OFF_WIN = OFF_L + (size_t)NRP * 256 * 2;
constexpr size_t CH_END = OFF_WIN + (size_t)NCOLS1 * 1024 * 2;
constexpr size_t OFF_MERGED = OFF_CH;
constexpr size_t OFF_G = CH_END;
constexpr size_t OFF_C = OFF_G + (size_t)NRP * 512 * 2;
constexpr size_t OFF_Z = OFF_C + (size_t)T * 512 * 2;
constexpr size_t OFF_COEF = OFF_Z + (size_t)T * 512 * 2;
constexpr size_t EARLY_END = OFF_COEF + (size_t)NR * 8 * 4;
static_assert(EARLY_END <= OFF_RT, "early buffers overflow");
static_assert(OFF_CH + (size_t)NUNITS * REC_BYTES <= CH_END, "chunk records overflow");
static_assert(OFF_CH >= OFF_WD + SZ_WD, "expert weights (written during the scan) must not touch live scan buffers");
static_assert(OFF_MERGED + SZ_HB <= OFF_HB2, "layout");
static_assert(OFF_PRKV % 16 == 0 && OFF_LD % 16 == 0 && OFF_A % 16 == 0 && OFF_CH % 16 == 0 && OFF_HB % 16 == 0 && OFF_L % 16 == 0 && OFF_WIN % 16 == 0 && OFF_G % 16 == 0 && OFF_C % 16 == 0 && OFF_Z % 16 == 0 && OFF_COEF % 16 == 0, "align");

#define GAS __attribute__((address_space(1)))
#define CAS __attribute__((address_space(4)))
struct Params {
    const float* in[37];
    float* out;
    unsigned char* ws;
    int ph_lo, ph_hi;
};
struct ParamsD {
    const GAS float* in[37];
    GAS float* out;
    GAS unsigned char* ws;
    int ph_lo, ph_hi;
};
static_assert(sizeof(Params) == sizeof(ParamsD), "argument views");
struct PPv {
    const CAS ParamsD* k;
    __device__ __forceinline__ const float* gin(int i) const { return (const float*)k->in[i]; }
    __device__ __forceinline__ float* gout() const { return (float*)k->out; }
    __device__ __forceinline__ unsigned char* gws() const { return (unsigned char*)k->ws; }
};
__device__ __forceinline__ PPv getpp() { const CAS ParamsD* k = (const CAS ParamsD*)__builtin_amdgcn_kernarg_segment_ptr(); asm volatile("" : "+s"(k)); return PPv{k}; }

typedef __bf16 bf16x2v __attribute__((ext_vector_type(2)));
__device__ __forceinline__ unsigned cvt_pk_bf16(float lo, float hi) { const f32x2 v = {lo, hi}; return __builtin_bit_cast(unsigned, __builtin_convertvector(v, bf16x2v)); }
__device__ __forceinline__ bf16_t f2bf(float f) { unsigned u = __float_as_uint(f); u += 0x7FFFu + ((u >> 16) & 1u); return (bf16_t)(u >> 16); }
__device__ __forceinline__ float bf2f(bf16_t b) { return __uint_as_float(((unsigned)b) << 16); }
__device__ __forceinline__ float bflo(unsigned w) { return __uint_as_float(w << 16); }
__device__ __forceinline__ float bfhi(unsigned w) { return __uint_as_float(w & 0xFFFF0000u); }
__device__ __forceinline__ float sigmoidf_(float x) { return __builtin_amdgcn_rcpf(1.0f + __expf(-x)); }
__device__ __forceinline__ float wave_sum(float v) {
#pragma unroll
    for (int o = 32; o >= 1; o >>= 1) v += __shfl_xor(v, o);
    return v;
}
__device__ __forceinline__ float wave_sum_dpp(float v);
__device__ __forceinline__ int prev_row(int row, int d) {
    if (row < NMETA) return row - d >= 0 ? row - d : -1;
    const int s = (row - NMETA) & (SEQ - 1);
    return s >= d ? row - d : NMETA + s - d;
}

constexpr int BM = 256, BK = 64, HALF = 128, HTB = HALF * BK * 2, STAGE_BYTES = 8 * HTB, NXCD = 8, WGM = 8;
__device__ __forceinline__ int lds_byte(int r, int c) { const int st = (r >> 4) * 2 + (c >> 5), rr = r & 15, cc = c & 31, ob = rr * 64 + cc * 2; return st * 1024 + (ob ^ (((ob >> 9) & 1) << 5)); }
__device__ __forceinline__ void stage_rc(int b, int& R, int& C) { const int st = b / 1024, sb = b % 1024, swz = sb ^ (((sb >> 9) & 1) << 5); R = (st >> 1) * 16 + swz / 64; C = (st & 1) * 32 + (swz % 64) / 2; }
__device__ __forceinline__ int perm32(int rho) { const int n = rho >> 4, i = rho & 15; return 8 * (i >> 2) + 4 * n + (i & 3); }

struct Unit { int pm, pn, aux; };

struct StaticOrder {
    const char* A; const char* Bt; int K;
    int nM, nN, nwg, G, c;
    __device__ void init(const void* A_, const void* Bt_, int M, int N, int K_, int G_, int c_) { A = (const char*)A_; Bt = (const char*)Bt_; K = K_; nM = M / BM; nN = N / BM; nwg = nM * nN; G = G_; c = c_; }
    __device__ bool next(int i, Unit& u) const {
        const long L = (long)i * G + c; if (L >= nwg) return false;
        int wgid = (int)L; { const int q = nwg / NXCD, r = nwg % NXCD, xcd = wgid % NXCD, off = wgid / NXCD; wgid = (xcd < r ? xcd * (q + 1) : r * (q + 1) + (xcd - r) * q) + off; }
        const int nig = WGM * nN, gid = wgid / nig, fm = gid * WGM, gsz = (nM - fm) < WGM ? (nM - fm) : WGM;
        u.pm = fm + ((wgid % nig) % gsz); u.pn = (wgid % nig) / gsz; u.aux = 0; return true;
    }
    __device__ __forceinline__ const char* a_ptr(const Unit& u) const { return A + (size_t)u.pm * 256 * K * 2; }
    __device__ __forceinline__ const char* b_ptr(const Unit& u) const { return Bt + (size_t)u.pn * 256 * K * 2; }
    __device__ __forceinline__ int gather_row(const Unit&, int) const { return 0; }
    __device__ __forceinline__ const void* gather_src(const Unit&, int) const { return nullptr; }
};
struct MoeOrder {
    const char* A; const char* Bt; int K; size_t estride;
    const int* tile_e; const int* rowtok; int ntiles, nnt, G, c; bool gather;
    __device__ bool next(int i, Unit& u) const {
        int mt, nt;
        if ((G & 7) == 0 && ((G >> 3) % nnt) == 0) {
            const int x = c & 7, j = c >> 3, per = (G >> 3) / nnt;
            mt = (i * 8 + x) * per + j / nnt; nt = j % nnt;
        } else { const long L = (long)i * G + c; mt = (int)(L / nnt); nt = (int)(L % nnt); }
        if (mt >= ntiles) return false;
        u.pm = mt; u.pn = nt; u.aux = tile_e[mt]; return true;
    }
    __device__ __forceinline__ const char* a_ptr(const Unit& u) const { return gather ? A : A + (size_t)u.pm * 256 * K * 2; }
    __device__ __forceinline__ const char* b_ptr(const Unit& u) const { return Bt + (size_t)u.aux * estride + (size_t)u.pn * 256 * K * 2; }
    __device__ __forceinline__ int gather_row(const Unit& u, int r) const { return rowtok[u.pm * 256 + r]; }
    __device__ __forceinline__ const void* gather_src(const Unit& u, int lane) const { return rowtok + u.pm * 256 + lane * 4; }
};

template <bool GATHER, class Epi, class Sched>
__device__ __forceinline__ void gemm_phase(LAS unsigned char* lds, const int K_, const Sched& S, const Epi& E) {
    int K = K_; asm volatile("" : "+s"(K));
    const int tid = threadIdx.x, wid = __builtin_amdgcn_readfirstlane(tid >> 6), lane = tid & 63, wr = wid >> 2, wc = wid & 3, fr = lane & 15, fq = lane >> 4;
    const int nt = K / BK;
    unsigned voffA[2], voffB[2]; int Rr[2], Cc[2];
#pragma unroll
    for (int i = 0; i < 2; ++i) { int R, C; stage_rc(tid * 16 + i * 8192, R, C); const int Rb = (R & ~31) + perm32(R & 31);
        Rr[i] = R; Cc[i] = C; voffA[i] = (unsigned)(R * K + C) * 2u; voffB[i] = (unsigned)(Rb * K + C) * 2u; }
    const size_t kstep = (size_t)(BK * 2);
    const size_t hstep = (size_t)HALF * K * 2;
    const unsigned ldsw = (unsigned)wid * 1024u;
    const int aoff = lds_byte(wr * 64 + fr, fq * 8), boff = lds_byte(wc * 32 + fr, fq * 8);
    unsigned vgc[2][2], vgn[2][2];
    LAS unsigned char* const parbase = lds + STAGE_BYTES;
    constexpr int NPAR = Epi::NPAR;
#define G_PAR_ISSUE(unit, uidx, hasnx, nxunit) do { \
        LAS unsigned char* _ps = parbase + ((uidx) & 1) * 4096; \
        if (wid < NPAR) __builtin_amdgcn_global_load_lds((const unsigned*)E.par_src(unit, wid, lane), (LAS unsigned*)(_ps + wid * 1024), 16, 0, 0); \
        if (GATHER && (hasnx) && wid == NPAR) __builtin_amdgcn_global_load_lds((const unsigned*)S.gather_src(nxunit, lane), (LAS unsigned*)(_ps + NPAR * 1024), 16, 0, 0); } while (0)
#define G_SA(b, h) (((b) * 2 + (h)) * HTB)
#define G_SB(b, h) ((4 + (b) * 2 + (h)) * HTB)
#define G_STAGE(bufoff, gbase, voff) do { _Pragma("unroll") for (int _i = 0; _i < 2; ++_i) \
        __builtin_amdgcn_global_load_lds((const unsigned*)((const char*)(gbase) + (voff)[_i]), (LAS unsigned*)(lds + (bufoff) + ldsw + _i * 8192), 16, 0, 0); } while (0)
#define G_STAGE_A(bufoff, kptr, h, VG) do { if (GATHER) { G_STAGE(bufoff, kptr, VG[h]); } else { G_STAGE(bufoff, (kptr) + (h) * hstep, voffA); } } while (0)
#define G_LDA(dst, b, h) do { _Pragma("unroll") for (int m = 0; m < 4; ++m) _Pragma("unroll") for (int k = 0; k < 2; ++k) dst[m][k] = *(const LAS bf16x8*)(lds + G_SA(b, h) + aoff + m * 2048 + k * 1024); } while (0)
#define G_LDB(dst, b, h) do { _Pragma("unroll") for (int n = 0; n < 2; ++n) _Pragma("unroll") for (int k = 0; k < 2; ++k) dst[n][k] = *(const LAS bf16x8*)(lds + G_SB(b, h) + boff + n * 2048 + k * 1024); } while (0)
#define G_MMA(ai, bj, At, Bt) do { __builtin_amdgcn_s_setprio(1); _Pragma("unroll") for (int m = 0; m < 4; ++m) _Pragma("unroll") for (int n = 0; n < 2; ++n) _Pragma("unroll") for (int k = 0; k < 2; ++k) \
        acc[ai][bj][m][n] = __builtin_amdgcn_mfma_f32_16x16x32_bf16(Bt[n][k], At[m][k], acc[ai][bj][m][n], 0, 0, 0); __builtin_amdgcn_s_setprio(0); } while (0)
#define G_WAIT_V(n) asm volatile("s_waitcnt vmcnt(" #n ")" ::: "memory")
#define G_WAIT_L(n) asm volatile("s_waitcnt lgkmcnt(" #n ")" ::: "memory")
#define G_BAR __builtin_amdgcn_s_barrier()
#define G_SCHED __builtin_amdgcn_sched_barrier(0)
    Unit cur, nxt;
    int ui = 0;
    if (!S.next(0, cur)) return;
    f32x4 acc[2][2][4][2];
#pragma unroll
    for (int a = 0; a < 2; ++a)
#pragma unroll
        for (int b = 0; b < 2; ++b)
#pragma unroll
            for (int m = 0; m < 4; ++m)
#pragma unroll
                for (int n = 0; n < 2; ++n) acc[a][b][m][n] = (f32x4){0.f, 0.f, 0.f, 0.f};
    bf16x8 At[4][2], B0[2][2], B1[2][2];
    const char* cA = S.a_ptr(cur); const char* cB = S.b_ptr(cur);
    if (GATHER) {
#pragma unroll
        for (int h = 0; h < 2; ++h)
#pragma unroll
            for (int i = 0; i < 2; ++i) vgc[h][i] = (unsigned)(S.gather_row(cur, h * HALF + Rr[i]) * K + Cc[i]) * 2u;
    }
    { Unit n1; const bool hn1 = S.next(1, n1); G_PAR_ISSUE(cur, 0, hn1, n1); }
    G_STAGE(G_SB(0, 0), cB, voffB); G_STAGE_A(G_SA(0, 0), cA, 0, vgc); G_STAGE(G_SB(0, 1), cB + hstep, voffB); G_STAGE_A(G_SA(0, 1), cA, 1, vgc);
    if (wr == 1) G_BAR;
    G_WAIT_V(4); G_BAR;
    G_STAGE(G_SB(1, 0), cB + kstep, voffB); G_STAGE_A(G_SA(1, 0), cA + kstep, 0, vgc); G_STAGE(G_SB(1, 1), cB + hstep + kstep, voffB);
    G_WAIT_V(6); G_BAR;
    for (;;) {
        const bool has_next = S.next(ui + 1, nxt);
        const char* nA = has_next ? S.a_ptr(nxt) : cA; const char* nB = has_next ? S.b_ptr(nxt) : cB;
        if (ui > 0) G_PAR_ISSUE(cur, ui, has_next, nxt);
        if (GATHER) {
#pragma unroll
            for (int h = 0; h < 2; ++h)
#pragma unroll
                for (int i = 0; i < 2; ++i) vgn[h][i] = vgc[h][i];
        }
        for (int t = 0; t < nt; t += 2) {
            const bool last = (t == nt - 2);
            const char* a1 = cA + (size_t)(t + 1) * kstep;
            const char* a2 = last ? nA : cA + (size_t)(t + 2) * kstep; const char* b2 = last ? nB : cB + (size_t)(t + 2) * kstep;
            const char* a3 = a2 + kstep; const char* b3 = b2 + kstep;
            unsigned vg2[2][2];
            if (GATHER) {
#pragma unroll
                for (int h = 0; h < 2; ++h)
#pragma unroll
                    for (int i = 0; i < 2; ++i) vg2[h][i] = last ? vgn[h][i] : vgc[h][i];
            }
            G_LDB(B0, 0, 0); G_SCHED; G_LDA(At, 0, 0); G_STAGE_A(G_SA(1, 1), a1, 1, vgc);
            G_WAIT_L(8); G_BAR; G_WAIT_L(0); G_MMA(0, 0, At, B0); G_BAR; G_SCHED;
            G_LDB(B1, 0, 1); G_STAGE(G_SB(0, 0), b2, voffB);
            G_BAR; G_WAIT_L(0); G_MMA(0, 1, At, B1); G_BAR;
            G_LDA(At, 0, 1); G_STAGE_A(G_SA(0, 0), a2, 0, vg2);
            G_BAR; G_WAIT_L(0); G_MMA(1, 0, At, B0); G_BAR; G_SCHED;
            G_STAGE(G_SB(0, 1), b2 + hstep, voffB);
            G_WAIT_V(6); G_BAR; G_MMA(1, 1, At, B1); G_BAR;
            G_LDB(B0, 1, 0); G_SCHED; G_LDA(At, 1, 0); G_STAGE_A(G_SA(0, 1), a2, 1, vg2);
            G_WAIT_L(8); G_BAR; G_WAIT_L(0); G_MMA(0, 0, At, B0); G_BAR; G_SCHED;
            G_LDB(B1, 1, 1); G_STAGE(G_SB(1, 0), b3, voffB);
            G_BAR; G_WAIT_L(0); G_MMA(0, 1, At, B1); G_BAR;
            G_LDA(At, 1, 1); G_STAGE_A(G_SA(1, 0), a3, 0, vg2);
            G_BAR; G_WAIT_L(0); G_MMA(1, 0, At, B0); G_BAR; G_SCHED;
            G_STAGE(G_SB(1, 1), b3 + hstep, voffB);
            G_WAIT_V(6); G_BAR; G_MMA(1, 1, At, B1); G_BAR;
            if (GATHER && t == 0 && has_next) {
                const LAS int* rows = (const LAS int*)(parbase + (ui & 1) * 4096 + NPAR * 1024);
#pragma unroll
                for (int h = 0; h < 2; ++h)
#pragma unroll
                    for (int i = 0; i < 2; ++i) vgn[h][i] = (unsigned)(rows[h * HALF + Rr[i]] * K + Cc[i]) * 2u;
            }
        }
        const bool keep_acc = E(acc, cur, wr, wc, fr, fq, (const LAS unsigned char*)(parbase + (ui & 1) * 4096));
        if (!has_next) break;
        if (!keep_acc)
#pragma unroll
        for (int a = 0; a < 2; ++a)
#pragma unroll
            for (int b = 0; b < 2; ++b)
#pragma unroll
                for (int m = 0; m < 4; ++m)
#pragma unroll
                    for (int n = 0; n < 2; ++n) acc[a][b][m][n] = (f32x4){0.f, 0.f, 0.f, 0.f};
        cur = nxt; cA = nA; cB = nB; ++ui;
        if (GATHER) {
#pragma unroll
            for (int h = 0; h < 2; ++h)
#pragma unroll
                for (int i = 0; i < 2; ++i) vgc[h][i] = vgn[h][i];
        }
    }
    G_WAIT_V(0);
    if (wr == 0) G_BAR;
    G_BAR;
#undef G_PAR_ISSUE
#undef G_SA
#undef G_SB
#undef G_STAGE
#undef G_STAGE_A
#undef G_LDA
#undef G_LDB
#undef G_MMA
#undef G_WAIT_V
#undef G_WAIT_L
#undef G_BAR
#undef G_SCHED
}

struct EpiProj {
    bf16_t* prkv; bf16_t* pconv; bf16_t* gates; const float* rstd1;
    static constexpr int NPAR = 1;
    __device__ __forceinline__ const void* par_src(const Unit& u, int, int lane) const { return rstd1 + NMETA + u.pm * BM + lane * 4; }
    __device__ __forceinline__ bool operator()(const f32x4 (&acc)[2][2][4][2], const Unit& u, int wr, int wc, int fr, int fq, const LAS unsigned char* par) const {
        const int row0 = u.pm * BM + wr * 64 + fr;
        const bool isg = u.pn >= 14;
        float rsv[2][4];
#pragma unroll
        for (int ai = 0; ai < 2; ++ai)
#pragma unroll
            for (int m = 0; m < 4; ++m) rsv[ai][m] = ((const LAS float*)par)[wr * 64 + fr + ai * HALF + m * 16];
#pragma unroll
        for (int ai = 0; ai < 2; ++ai)
#pragma unroll
            for (int m = 0; m < 4; ++m) {
                const int row = row0 + ai * HALF + m * 16;
                const float rs = rsv[ai][m];
                bf16_t* rowp = isg ? gates + (size_t)row * 2048 + (u.pn - 14) * 256 + wc * 32 + 8 * fq
                             : (u.pn < 6 ? prkv + (size_t)(NMETA + row) * 1536 + u.pn * 256 : pconv + (size_t)(NMETA + row) * 2048 + (u.pn - 6) * 256) + wc * 32 + 8 * fq;
#pragma unroll
                for (int bj = 0; bj < 2; ++bj) {
                    f32x4 v0 = acc[ai][bj][m][0] * rs, v1 = acc[ai][bj][m][1] * rs;
                    if (isg) {
#pragma unroll
                        for (int j = 0; j < 4; ++j) { v0[j] = sigmoidf_(v0[j]); v1[j] = sigmoidf_(v1[j]); }
                    }
                    u32x4 w; w.x = cvt_pk_bf16(v0[0], v0[1]); w.y = cvt_pk_bf16(v0[2], v0[3]); w.z = cvt_pk_bf16(v1[0], v1[1]); w.w = cvt_pk_bf16(v1[2], v1[3]);
                    *(u32x4*)(rowp + bj * HALF) = w;
                }
            }
        return false;
    }
};
struct EpiL {
    static constexpr int NPAR = 0;
    __device__ __forceinline__ const void* par_src(const Unit&, int, int) const { return nullptr; }
    unsigned char* wsb; const float* w0; const float* a0;
    __device__ __forceinline__ bool operator()(const f32x4 (&acc)[2][2][4][2], const Unit& u, int wr, int wc, int fr, int fq, const LAS unsigned char* par) const {
        const int row0 = NMETA + u.pm * BM + wr * 64 + fr;
        const int seg = u.pn >> 1;
        const int cb = (u.pn & 1) * 256 + wc * 32 + 8 * fq;
        const float* bias = seg == 0 ? w0 : a0;
        f32x4 bv[2][2];
#pragma unroll
        for (int bj = 0; bj < 2; ++bj) {
            bv[bj][0] = seg < 2 ? *(const f32x4*)(bias + cb + bj * HALF) : (f32x4){0.f, 0.f, 0.f, 0.f};
            bv[bj][1] = seg < 2 ? *(const f32x4*)(bias + cb + bj * HALF + 4) : (f32x4){0.f, 0.f, 0.f, 0.f};
        }
        const float sc = seg == 0 ? -0.60653065971f : 1.0f;
        bf16_t* ob = (bf16_t*)(wsb + (seg == 0 ? OFF_LD : seg == 1 ? OFF_A : OFF_G));
#pragma unroll
        for (int ai = 0; ai < 2; ++ai)
#pragma unroll
            for (int m = 0; m < 4; ++m) {
                const int row = row0 + ai * HALF + m * 16;
#pragma unroll
                for (int bj = 0; bj < 2; ++bj) {
                    const int c = cb + bj * HALF;
                    f32x4 v0 = acc[ai][bj][m][0] + bv[bj][0], v1 = acc[ai][bj][m][1] + bv[bj][1];
                    if (seg < 2) {
#pragma unroll
                        for (int j = 0; j < 4; ++j) { v0[j] = sc * sigmoidf_(v0[j]); v1[j] = sc * sigmoidf_(v1[j]); }
                    }
                    {
                        u32x4 w; w.x = cvt_pk_bf16(v0[0], v0[1]); w.y = cvt_pk_bf16(v0[2], v0[3]); w.z = cvt_pk_bf16(v1[0], v1[1]); w.w = cvt_pk_bf16(v1[2], v1[3]);
                        *(u32x4*)(ob + (size_t)row * 512 + c) = w;
                    }
                }
            }
        return false;
    }
};
template <int SECOND> struct EpiMerge {
    static constexpr int NPAR = 0;
    __device__ __forceinline__ const void* par_src(const Unit&, int, int) const { return nullptr; }
    bf16_t* merged; const bf16_t* gates;
    __device__ __forceinline__ bool operator()(const f32x4 (&acc)[2][2][4][2], const Unit& u, int wr, int wc, int fr, int fq, const LAS unsigned char* par) const {
        const int row0 = u.pm * BM + wr * 64 + fr, col0 = u.pn * BM + wc * 32 + 8 * fq;
#pragma unroll
        for (int ai = 0; ai < 2; ++ai)
#pragma unroll
            for (int m = 0; m < 4; ++m) {
                const int row = row0 + ai * HALF + m * 16;
#pragma unroll
                for (int bj = 0; bj < 2; ++bj) {
                    const int c = col0 + bj * HALF;
                    const u32x4 gw = *(const u32x4*)(gates + (size_t)row * 2048 + SECOND * 1024 + c);
                    f32x4 g0 = (f32x4){bflo(gw.x), bfhi(gw.x), bflo(gw.y), bfhi(gw.y)}, g1 = (f32x4){bflo(gw.z), bfhi(gw.z), bflo(gw.w), bfhi(gw.w)};
                    f32x4 v0 = acc[ai][bj][m][0] * g0, v1 = acc[ai][bj][m][1] * g1;
                    bf16_t* p = merged + (size_t)row * 1024 + c;
                    if (SECOND) {
                        const u32x4 ow = *(const u32x4*)p;
                        v0 += (f32x4){bflo(ow.x), bfhi(ow.x), bflo(ow.y), bfhi(ow.y)}; v1 += (f32x4){bflo(ow.z), bfhi(ow.z), bflo(ow.w), bfhi(ow.w)};
                    }
                    u32x4 w; w.x = cvt_pk_bf16(v0[0], v0[1]); w.y = cvt_pk_bf16(v0[2], v0[3]); w.z = cvt_pk_bf16(v1[0], v1[1]); w.w = cvt_pk_bf16(v1[2], v1[3]);
                    *(u32x4*)p = w;
                }
            }
        return false;
    }
};
struct MergeOrder {
    StaticOrder so; const char* A1; const char* B1;
    __device__ bool next(int i, Unit& u) const { const bool ok = so.next(i >> 1, u); u.aux = i & 1; return ok; }
    __device__ __forceinline__ const char* a_ptr(const Unit& u) const { return (u.aux ? A1 : so.A) + (size_t)u.pm * 256 * so.K * 2; }
    __device__ __forceinline__ const char* b_ptr(const Unit& u) const { return (u.aux ? B1 : so.Bt) + (size_t)u.pn * 256 * so.K * 2; }
    __device__ __forceinline__ int gather_row(const Unit&, int) const { return 0; }
    __device__ __forceinline__ const void* gather_src(const Unit&, int) const { return nullptr; }
};
struct EpiMergeFused {
    static constexpr int NPAR = 0;
    __device__ __forceinline__ const void* par_src(const Unit&, int, int) const { return nullptr; }
    bf16_t* merged; const bf16_t* gates;
    __device__ __forceinline__ bool operator()(f32x4 (&acc)[2][2][4][2], const Unit& u, int wr, int wc, int fr, int fq, const LAS unsigned char* par) const {
        const int row0 = u.pm * BM + wr * 64 + fr, col0 = u.pn * BM + wc * 32 + 8 * fq;
#pragma unroll
        for (int ai = 0; ai < 2; ++ai) {
            u32x4 gbw[4][2], gaw[4][2];
#pragma unroll
            for (int m = 0; m < 4; ++m)
#pragma unroll
                for (int bj = 0; bj < 2; ++bj) {
                    const bf16_t* gp = gates + (size_t)(row0 + ai * HALF + m * 16) * 2048 + col0 + bj * HALF;
                    gbw[m][bj] = *(const u32x4*)(gp + 1024);
                    gaw[m][bj] = u.aux == 0 ? *(const u32x4*)gp : (u32x4){0u, 0u, 0u, 0u};
                }
#pragma unroll
            for (int m = 0; m < 4; ++m)
#pragma unroll
                for (int bj = 0; bj < 2; ++bj) {
                    const int row = row0 + ai * HALF + m * 16, c = col0 + bj * HALF;
                    f32x4 gb0 = (f32x4){bflo(gbw[m][bj].x), bfhi(gbw[m][bj].x), bflo(gbw[m][bj].y), bfhi(gbw[m][bj].y)}, gb1 = (f32x4){bflo(gbw[m][bj].z), bfhi(gbw[m][bj].z), bflo(gbw[m][bj].w), bfhi(gbw[m][bj].w)};
#pragma unroll
                    for (int j = 0; j < 4; ++j) { gb0[j] = fmaxf(gb0[j], 1e-6f); gb1[j] = fmaxf(gb1[j], 1e-6f); }
                    if (u.aux == 0) {
                        const f32x4 ga0 = (f32x4){bflo(gaw[m][bj].x), bfhi(gaw[m][bj].x), bflo(gaw[m][bj].y), bfhi(gaw[m][bj].y)}, ga1 = (f32x4){bflo(gaw[m][bj].z), bfhi(gaw[m][bj].z), bflo(gaw[m][bj].w), bfhi(gaw[m][bj].w)};
#pragma unroll
                        for (int j = 0; j < 4; ++j) { acc[ai][bj][m][0][j] *= ga0[j] * __builtin_amdgcn_rcpf(gb0[j]); acc[ai][bj][m][1][j] *= ga1[j] * __builtin_amdgcn_rcpf(gb1[j]); }
                    } else {
                        const f32x4 v0 = acc[ai][bj][m][0] * gb0, v1 = acc[ai][bj][m][1] * gb1;
                        u32x4 w; w.x = cvt_pk_bf16(v0[0], v0[1]); w.y = cvt_pk_bf16(v0[2], v0[3]); w.z = cvt_pk_bf16(v1[0], v1[1]); w.w = cvt_pk_bf16(v1[2], v1[3]);
                        *(u32x4*)(merged + (size_t)row * 1024 + c) = w;
                    }
                }
        }
        return u.aux == 0;
    }
};
struct EpiO {
    static constexpr int NPAR = 0;
    __device__ __forceinline__ const void* par_src(const Unit&, int, int) const { return nullptr; }
    const float* x; float* h1; bf16_t* hb2;
    __device__ __forceinline__ bool operator()(const f32x4 (&acc)[2][2][4][2], const Unit& u, int wr, int wc, int fr, int fq, const LAS unsigned char* par) const {
        const int row0 = u.pm * BM + wr * 64 + fr, col0 = u.pn * BM + wc * 32 + 8 * fq;
#pragma unroll
        for (int ai = 0; ai < 2; ++ai) {
            f32x4 xv[4][2][2];
#pragma unroll
            for (int m = 0; m < 4; ++m)
#pragma unroll
                for (int bj = 0; bj < 2; ++bj) {
                    const size_t o = (size_t)(row0 + ai * HALF + m * 16) * 1024 + col0 + bj * HALF;
                    xv[m][bj][0] = *(const f32x4*)(x + o); xv[m][bj][1] = *(const f32x4*)(x + o + 4);
                }
#pragma unroll
            for (int m = 0; m < 4; ++m)
#pragma unroll
                for (int bj = 0; bj < 2; ++bj) {
                    const size_t o = (size_t)(row0 + ai * HALF + m * 16) * 1024 + col0 + bj * HALF;
                    const f32x4 v0 = acc[ai][bj][m][0] + xv[m][bj][0], v1 = acc[ai][bj][m][1] + xv[m][bj][1];
                    u32x4 w; w.x = cvt_pk_bf16(v0[0], v0[1]); w.y = cvt_pk_bf16(v0[2], v0[3]); w.z = cvt_pk_bf16(v1[0], v1[1]); w.w = cvt_pk_bf16(v1[2], v1[3]);
                    *(u32x4*)(hb2 + o) = w;
                }
        }
        return false;
    }
};
struct EpiMoe1 {
    bf16_t* act; const float* rowrs; const float* bg; const float* bu;
    static constexpr int NPAR = 2;
    __device__ __forceinline__ const void* par_src(const Unit& u, int piece, int lane) const {
        if (piece == 0) return rowrs + u.pm * BM + lane * 4;
        return (lane < 32 ? bg : bu) + (size_t)u.aux * DFF + u.pn * 128 + (lane & 31) * 4;
    }
    __device__ __forceinline__ bool operator()(const f32x4 (&acc)[2][2][4][2], const Unit& u, int wr, int wc, int fr, int fq, const LAS unsigned char* par) const {
        const int row0 = u.pm * BM + wr * 64 + fr, ff0 = u.pn * 128 + wc * 32 + 8 * fq;
        const LAS float* bgp = (const LAS float*)(par + 1024) + wc * 32 + 8 * fq; const LAS float* bup = bgp + 128;
        const f32x4 bg0 = *(const LAS f32x4*)bgp, bg1 = *(const LAS f32x4*)(bgp + 4), bu0 = *(const LAS f32x4*)bup, bu1 = *(const LAS f32x4*)(bup + 4);
        float rsv[2][4];
#pragma unroll
        for (int ai = 0; ai < 2; ++ai)
#pragma unroll
            for (int m = 0; m < 4; ++m) rsv[ai][m] = ((const LAS float*)par)[wr * 64 + fr + ai * HALF + m * 16];
#pragma unroll
        for (int ai = 0; ai < 2; ++ai)
#pragma unroll
            for (int m = 0; m < 4; ++m) {
                const int row = row0 + ai * HALF + m * 16;
                const float rs = rsv[ai][m];
                f32x4 g0 = acc[ai][0][m][0] * rs + bg0, g1 = acc[ai][0][m][1] * rs + bg1, u0 = acc[ai][1][m][0] * rs + bu0, u1 = acc[ai][1][m][1] * rs + bu1;
                f32x4 r0, r1;
#pragma unroll
                for (int j = 0; j < 4; ++j) {
                    { const float gt = fminf(g0[j], 7.0f), up = fminf(fmaxf(u0[j], -7.0f), 7.0f); r0[j] = (up + 1.0f) * gt * sigmoidf_(1.702f * gt); }
                    { const float gt = fminf(g1[j], 7.0f), up = fminf(fmaxf(u1[j], -7.0f), 7.0f); r1[j] = (up + 1.0f) * gt * sigmoidf_(1.702f * gt); }
                }
                u32x4 w; w.x = cvt_pk_bf16(r0[0], r0[1]); w.y = cvt_pk_bf16(r0[2], r0[3]); w.z = cvt_pk_bf16(r1[0], r1[1]); w.w = cvt_pk_bf16(r1[2], r1[3]);
                *(u32x4*)(act + (size_t)row * DFF + ff0) = w;
            }
        return false;
    }
};
struct EpiMoe2 {
    bf16_t* ya; bf16_t* yb; const int* rowslot; const float* roww; const float* bd;
    static constexpr int NPAR = 3;
    __device__ __forceinline__ const void* par_src(const Unit& u, int piece, int lane) const {
        if (piece == 0) return rowslot + u.pm * BM + lane * 4;
        if (piece == 1) return roww + u.pm * BM + lane * 4;
        return bd + (size_t)u.aux * D + u.pn * BM + lane * 4;
    }
    __device__ __forceinline__ bool operator()(const f32x4 (&acc)[2][2][4][2], const Unit& u, int wr, int wc, int fr, int fq, const LAS unsigned char* par) const {
        const int row0 = u.pm * BM + wr * 64 + fr, col0 = u.pn * BM + wc * 32 + 8 * fq;
        bf16_t* ybase = (u.pn < 2) ? ya : yb; const int yc0 = col0 & 511;
        const LAS float* bp = (const LAS float*)(par + 2048) + wc * 32 + 8 * fq;
        f32x4 bv[2][2];
#pragma unroll
        for (int bj = 0; bj < 2; ++bj) { bv[bj][0] = *(const LAS f32x4*)(bp + bj * HALF); bv[bj][1] = *(const LAS f32x4*)(bp + bj * HALF + 4); }
        int slotv[2][4]; float wv8[2][4];
#pragma unroll
        for (int ai = 0; ai < 2; ++ai)
#pragma unroll
            for (int m = 0; m < 4; ++m) { const int rl = wr * 64 + fr + ai * HALF + m * 16; slotv[ai][m] = ((const LAS int*)par)[rl]; wv8[ai][m] = ((const LAS float*)(par + 1024))[rl]; }
#pragma unroll
        for (int ai = 0; ai < 2; ++ai)
#pragma unroll
            for (int m = 0; m < 4; ++m) {
                const int slot = slotv[ai][m];
                if (slot >= 0) {
                    const float w8 = wv8[ai][m];
#pragma unroll
                    for (int bj = 0; bj < 2; ++bj) {
                        const f32x4 v0 = (acc[ai][bj][m][0] + bv[bj][0]) * w8, v1 = (acc[ai][bj][m][1] + bv[bj][1]) * w8;
                        u32x4 w; w.x = cvt_pk_bf16(v0[0], v0[1]); w.y = cvt_pk_bf16(v0[2], v0[3]); w.z = cvt_pk_bf16(v1[0], v1[1]); w.w = cvt_pk_bf16(v1[2], v1[3]);
                        *(u32x4*)(ybase + (size_t)slot * 512 + yc0 + bj * HALF) = w;
                    }
                }
            }
        return false;
    }
};

__device__ __forceinline__ void transpose_tile(LAS float* tile, const float* src, int ldsrc, int k0, int n0, bf16_t* dst, int ldd, int drow0, const float* sa, const float* mu, int mode, bool zero) {
    const int tid = threadIdx.x;
    if (!zero) {
#pragma unroll
        for (int i = 0; i < 2; ++i) {
            const int r = (tid >> 4) + 32 * i, c4 = (tid & 15) * 4;
            const f32x4 v = *(const f32x4*)(src + (size_t)(k0 + r) * ldsrc + n0 + c4);
            LAS float* t = tile + r * 65 + c4;
            t[0] = v[0]; t[1] = v[1]; t[2] = v[2]; t[3] = v[3];
        }
    }
    __syncthreads();
    {
        const int n = tid >> 3, kq = tid & 7;
        float v[8];
#pragma unroll
        for (int j = 0; j < 8; ++j) {
            const int k = k0 + 8 * kq + j;
            float s = sa ? sa[k] : 1.0f;
            if (mode == 1) s *= (1.0f - mu[k]);
            if (mode == 2) s *= mu[k];
            v[j] = zero ? 0.f : tile[(8 * kq + j) * 65 + n] * s;
        }
        u32x4 w; w.x = cvt_pk_bf16(v[0], v[1]); w.y = cvt_pk_bf16(v[2], v[3]); w.z = cvt_pk_bf16(v[4], v[5]); w.w = cvt_pk_bf16(v[6], v[7]);
        *(u32x4*)(dst + (size_t)(drow0 + n) * ldd + k0 + 8 * kq) = w;
    }
    __syncthreads();
}

__device__ __forceinline__ void phase_prep(const PPv& p, LAS unsigned char* lds) {
    const int tid = threadIdx.x, bid = blockIdx.x, nb = gridDim.x, lane = tid & 63, wave = tid >> 6;
    unsigned char* ws = p.gws();
    const float* x = p.gin(0); const float* meta = p.gin(1); const float* g1 = p.gin(2);
    if (bid == 0 && tid < 64) ((int*)(ws + OFF_GCNT))[tid] = 0;
    {
        bf16_t* HB = (bf16_t*)(ws + OFF_HB); float* rstd1 = (float*)(ws + OFF_RSTD1);
        for (int row0 = (bid * 8 + wave) * 4; row0 < NR; row0 += nb * 32) {
            f32x4 v[4][4];
#pragma unroll
            for (int u = 0; u < 4; ++u) {
                const int row = row0 + u < NR ? row0 + u : NR - 1;
                const float* src = row < NMETA ? meta + (size_t)row * D : x + (size_t)(row - NMETA) * D;
#pragma unroll
                for (int i = 0; i < 4; ++i) v[u][i] = __builtin_nontemporal_load((const f32x4*)(src + i * 256 + lane * 4));
            }
#pragma unroll
            for (int u = 0; u < 4; ++u) {
                const int row = row0 + u;
                if (row < NR) {
                    float ss = 0.f;
#pragma unroll
                    for (int i = 0; i < 4; ++i) ss += v[u][i][0] * v[u][i][0] + v[u][i][1] * v[u][i][1] + v[u][i][2] * v[u][i][2] + v[u][i][3] * v[u][i][3];
                    ss = wave_sum_dpp(ss);
                    if (lane == 0) rstd1[row] = rsqrtf(ss * (1.0f / D) + NORM_EPS);
                    if (row >= NMETA) {
                        bf16_t* d = HB + (size_t)(row - NMETA) * D;
#pragma unroll
                        for (int i = 0; i < 4; ++i) { u32x2 w; w.x = cvt_pk_bf16(v[u][i][0], v[u][i][1]); w.y = cvt_pk_bf16(v[u][i][2], v[u][i][3]); *(u32x2*)(d + i * 256 + lane * 4) = w; }
                    }
                }
            }
        }
    }
    LAS float* tile = (LAS float*)lds;
    {
        bf16_t* WIN = (bf16_t*)(ws + OFF_WIN);
        const float* w_in = p.gin(3);
        for (int j = bid; j < 16 * 88; j += nb) {
            const int kt = j & 15, ntile = j >> 4, n0 = ntile * 64;
            const float* src; int ld, sn0, mode = 0; const float* mu = nullptr;
            if (n0 < 3072) { src = w_in; ld = 5120; sn0 = n0; }
            else if (n0 < 3584) {
                const int seg = (n0 - 3072) >> 6;
                if (seg < 2) { src = p.gin(11); ld = 64; sn0 = 0; mu = p.gin(7); mode = 1 + seg; }
                else if (seg < 4) { src = p.gin(14); ld = 64; sn0 = 0; mu = p.gin(8); mode = 1 + (seg - 2); }
                else { src = p.gin(16); ld = 128; sn0 = (seg & 1) * 64; mu = p.gin(9); mode = seg < 6 ? 1 : 2; }
            } else { src = w_in; ld = 5120; sn0 = n0 - 512; }
            transpose_tile(tile, src, ld, kt * 64, sn0, WIN, 1024, n0, g1, mu, mode, false);
        }
        for (int j = bid; j < 2 * 128; j += nb) {
            const int which = j >> 7, jj = j & 127, kt = jj & 7, ntile = jj >> 3;
            transpose_tile(tile, which ? p.gin(25) : p.gin(23), 1024, kt * 64, ntile * 64, (bf16_t*)(ws + (which ? OFF_WC : OFF_WR)), 512, ntile * 64, nullptr, nullptr, 0, false);
        }
        for (int j = bid; j < 256; j += nb) {
            const int kt = j & 15, ntile = j >> 4;
            transpose_tile(tile, p.gin(26), 1024, kt * 64, ntile * 64, (bf16_t*)(ws + OFF_WO), 1024, ntile * 64, nullptr, nullptr, 0, false);
        }
        for (int j = bid; j < 96; j += nb) {
            const int kt = j & 3, ntile = j >> 2, seg = ntile >> 3, nn0 = (ntile & 7) * 64;
            const float* src = nullptr; int sk0 = 0; bool zero = true;
            if (seg == 0 && kt == 0) { src = p.gin(12); sk0 = 0; zero = false; }
            if (seg == 1 && kt == 1) { src = p.gin(15); sk0 = 0; zero = false; }
            if (seg == 2 && kt >= 2) { src = p.gin(17); sk0 = (kt - 2) * 64; zero = false; }
            const float* srcs = zero ? p.gin(12) : src + (size_t)(sk0 - kt * 64) * 512;
            transpose_tile(tile, srcs, 512, kt * 64, nn0, (bf16_t*)(ws + OFF_W2), 256, ntile * 64, nullptr, nullptr, 0, zero);
        }
        {
            float* WRG = (float*)(ws + OFF_WRG); const float* g2 = p.gin(27); const float* wr_ = p.gin(28);
            for (int i = bid * 512 + tid; i < 1024 * 32; i += nb * 512) WRG[i] = g2[i >> 5] * wr_[i];
        }
    }
}

__device__ __forceinline__ void phase_meta_proj(const PPv& p, LAS unsigned char* lds) {
    const int tid = threadIdx.x, bid = blockIdx.x, lane = tid & 63, wave = tid >> 6;
    unsigned char* ws = p.gws();
    LAS float* sm = (LAS float*)lds;
    const float* meta = p.gin(1);
    for (int i = tid; i < 16 * 256; i += 512) { const int r = i >> 8, c4 = (i & 255) * 4; const f32x4 v = *(const f32x4*)(meta + r * 1024 + c4); LAS float* d = sm + r * 1028 + c4; d[0] = v[0]; d[1] = v[1]; d[2] = v[2]; d[3] = v[3]; }
    __syncthreads();
    const float* rstd1 = (const float*)(ws + OFF_RSTD1);
    for (int nbase = bid * 14; nbase < PCOLS1; nbase += gridDim.x * 14) {
        for (int nn = wave; nn < 14; nn += 8) {
            const int n = nbase + nn;
            if (n >= PCOLS1) break;
            const bf16_t* wrow = (const bf16_t*)(ws + OFF_WIN) + (size_t)n * 1024;
            const u32x4 w0 = *(const u32x4*)(wrow + 8 * lane), w1 = *(const u32x4*)(wrow + 512 + 8 * lane);
            const float wf[16] = {bflo(w0.x), bfhi(w0.x), bflo(w0.y), bfhi(w0.y), bflo(w0.z), bfhi(w0.z), bflo(w0.w), bfhi(w0.w),
                                  bflo(w1.x), bfhi(w1.x), bflo(w1.y), bfhi(w1.y), bflo(w1.z), bfhi(w1.z), bflo(w1.w), bfhi(w1.w)};
            float outv = 0.f;
#pragma unroll
            for (int pr = 0; pr < 16; ++pr) {
                const LAS float* m0 = sm + pr * 1028 + 8 * lane;
                const f32x4 a0 = *(const LAS f32x4*)m0, a1 = *(const LAS f32x4*)(m0 + 4), a2 = *(const LAS f32x4*)(m0 + 512), a3 = *(const LAS f32x4*)(m0 + 516);
                float acc = a0[0] * wf[0] + a0[1] * wf[1] + a0[2] * wf[2] + a0[3] * wf[3] + a1[0] * wf[4] + a1[1] * wf[5] + a1[2] * wf[6] + a1[3] * wf[7]
                          + a2[0] * wf[8] + a2[1] * wf[9] + a2[2] * wf[10] + a2[3] * wf[11] + a3[0] * wf[12] + a3[1] * wf[13] + a3[2] * wf[14] + a3[3] * wf[15];
                acc = wave_sum_dpp(acc);
                outv = (lane == pr) ? acc * rstd1[pr] : outv;
            }
            if (lane < 16) {
                if (n < 1536) ((bf16_t*)(ws + OFF_PRKV))[(size_t)lane * 1536 + n] = f2bf(outv);
                else ((bf16_t*)(ws + OFF_PCONV))[(size_t)lane * 2048 + n - 1536] = f2bf(outv);
            }
        }
    }
    __syncthreads();
}

__device__ __forceinline__ void phase_meta_lora(const PPv& p) {
    const int tid = threadIdx.x, bid = blockIdx.x, nb = gridDim.x, lane = tid & 63, wave = tid >> 6;
    unsigned char* ws = p.gws();
    const bf16_t* L = (const bf16_t*)(ws + OFF_L); const bf16_t* W2 = (const bf16_t*)(ws + OFF_W2);
    for (int n = bid * 8 + wave; n < 1536; n += nb * 8) {
        const int seg = n >> 9, c = n & 511;
        const u32x2 wv = *(const u32x2*)(W2 + (size_t)n * 256 + 4 * lane);
        const float w0v = bflo(wv.x), w1v = bfhi(wv.x), w2v = bflo(wv.y), w3v = bfhi(wv.y);
        float outv = 0.f;
#pragma unroll
        for (int r = 0; r < 16; ++r) {
            const u32x2 lv = *(const u32x2*)(L + (size_t)r * 256 + 4 * lane);
            float acc = bflo(lv.x) * w0v + bfhi(lv.x) * w1v + bflo(lv.y) * w2v + bfhi(lv.y) * w3v;
            acc = wave_sum_dpp(acc);
            outv = (lane == r) ? acc : outv;
        }
        if (lane < 16) {
            float v = outv;
            if (seg == 0) v = -0.60653065971f * sigmoidf_(v + p.gin(10)[c]);
            if (seg == 1) v = sigmoidf_(v + p.gin(13)[c]);
            bf16_t* ob = (bf16_t*)(ws + (seg == 0 ? OFF_LD : seg == 1 ? OFF_A : OFF_G));
            ob[(size_t)lane * 512 + c] = f2bf(v);
        }
    }
}

__device__ __forceinline__ void phase_lprep_conv(const PPv& p) {
    const int tid = threadIdx.x, bid = blockIdx.x, nb = gridDim.x;
    unsigned char* ws = p.gws();
    const bf16_t* PROJ = (const bf16_t*)(ws + OFF_PCONV);
    constexpr int PCOLS = 2048;
    bf16_t* L = (bf16_t*)(ws + OFF_L);
    for (int i = bid * 512 + tid; i < NRP * 32; i += nb * 512) {
        const int row = i >> 5, gq = i & 31;
        u32x4 w = (u32x4){0u, 0u, 0u, 0u};
        if (row < NR) {
            int ca, cb;
            if (gq < 8) { ca = 1536 + gq * 8; cb = ca + 64; }
            else if (gq < 16) { ca = 1536 + 128 + (gq - 8) * 8; cb = ca + 64; }
            else { ca = 1536 + 256 + (gq - 16) * 8; cb = ca + 128; }
            const u32x4 va = *(const u32x4*)(PROJ + (size_t)row * PCOLS + ca);
            const int pr = prev_row(row, 1);
            u32x4 vb = (u32x4){0u, 0u, 0u, 0u};
            if (pr >= 0) vb = *(const u32x4*)(PROJ + (size_t)pr * PCOLS + cb);
            float v[8] = {bflo(va.x) + bflo(vb.x), bfhi(va.x) + bfhi(vb.x), bflo(va.y) + bflo(vb.y), bfhi(va.y) + bfhi(vb.y), bflo(va.z) + bflo(vb.z), bfhi(va.z) + bfhi(vb.z), bflo(va.w) + bflo(vb.w), bfhi(va.w) + bfhi(vb.w)};
#pragma unroll
            for (int j = 0; j < 8; ++j) { if (gq < 8) v[j] = tanhf(v[j]); else if (gq >= 16) v[j] = sigmoidf_(v[j]); }
            w.x = cvt_pk_bf16(v[0], v[1]); w.y = cvt_pk_bf16(v[2], v[3]); w.z = cvt_pk_bf16(v[4], v[5]); w.w = cvt_pk_bf16(v[6], v[7]);
        }
        *(u32x4*)(L + (size_t)row * 256 + gq * 8) = w;
    }
    bf16_t* C = (bf16_t*)(ws + OFF_C);
    const float* cw = p.gin(24);
    for (int i = bid * 512 + tid; i < T * 64; i += nb * 512) {
        const int m = i >> 6, ch = (i & 63) * 8, row = NMETA + m;
        const int r1 = prev_row(row, 1), r2 = prev_row(row, 2);
        const bf16_t* p0 = PROJ + (size_t)row * PCOLS; const bf16_t* p1 = PROJ + (size_t)r1 * PCOLS; const bf16_t* p2 = PROJ + (size_t)r2 * PCOLS;
        const u32x4 vb = *(const u32x4*)(p0 + ch);
        const u32x4 c0 = *(const u32x4*)(p0 + 512 + ch), h0 = *(const u32x4*)(p0 + 1024 + ch);
        const u32x4 c1 = *(const u32x4*)(p1 + 512 + ch), h1 = *(const u32x4*)(p1 + 1024 + ch);
        const u32x4 c2 = *(const u32x4*)(p2 + 512 + ch), h2 = *(const u32x4*)(p2 + 1024 + ch);
        float o[8];
#pragma unroll
        for (int j = 0; j < 8; ++j) {
            const unsigned wb = j < 2 ? vb.x : j < 4 ? vb.y : j < 6 ? vb.z : vb.w;
            const unsigned wc0 = j < 2 ? c0.x : j < 4 ? c0.y : j < 6 ? c0.z : c0.w, wh0 = j < 2 ? h0.x : j < 4 ? h0.y : j < 6 ? h0.z : h0.w;
            const unsigned wc1 = j < 2 ? c1.x : j < 4 ? c1.y : j < 6 ? c1.z : c1.w, wh1 = j < 2 ? h1.x : j < 4 ? h1.y : j < 6 ? h1.z : h1.w;
            const unsigned wc2 = j < 2 ? c2.x : j < 4 ? c2.y : j < 6 ? c2.z : c2.w, wh2 = j < 2 ? h2.x : j < 4 ? h2.y : j < 6 ? h2.z : h2.w;
            const bool hi = j & 1;
            const float b = hi ? bfhi(wb) : bflo(wb);
            const float u0 = (hi ? bfhi(wc0) : bflo(wc0)) * (hi ? bfhi(wh0) : bflo(wh0));
            const float u1 = (hi ? bfhi(wc1) : bflo(wc1)) * (hi ? bfhi(wh1) : bflo(wh1));
            const float u2 = (hi ? bfhi(wc2) : bflo(wc2)) * (hi ? bfhi(wh2) : bflo(wh2));
            const float conv = cw[ch + j] * u2 + cw[512 + ch + j] * u1 + cw[1024 + ch + j] * u0;
            o[j] = b * conv;
        }
        u32x4 w; w.x = cvt_pk_bf16(o[0], o[1]); w.y = cvt_pk_bf16(o[2], o[3]); w.z = cvt_pk_bf16(o[4], o[5]); w.w = cvt_pk_bf16(o[6], o[7]);
        *(u32x4*)(C + (size_t)m * 512 + ch) = w;
    }
}

template <int CTRL> __device__ __forceinline__ float dppmov(float v) { return __builtin_bit_cast(float, __builtin_amdgcn_update_dpp(0, __builtin_bit_cast(int, v), CTRL, 0xF, 0xF, true)); }
__device__ __forceinline__ float wave_sum_dpp(float v) {
    v += dppmov<0xB1>(v);
    v += dppmov<0x4E>(v);
    v += dppmov<0x141>(v);
    v += dppmov<0x140>(v);
    { float c = v; asm volatile("v_nop\n\tv_nop\n\tv_permlane16_swap_b32 %0, %1\n\tv_nop" : "+v"(v), "+v"(c)); v += c; }
    { float c = v; asm volatile("v_nop\n\tv_nop\n\tv_permlane32_swap_b32 %0, %1\n\tv_nop" : "+v"(v), "+v"(c)); v += c; }
    return v;
}
typedef float f32x16 __attribute__((ext_vector_type(16)));

struct RawTok { bf16_t r, k, v, a, ld; };
__device__ __forceinline__ RawTok load_raw(const bf16_t* PRKV, const bf16_t* Ab, const bf16_t* LD, int row, int col) {
    RawTok q; const bf16_t* p0 = PRKV + (size_t)row * 1536 + col;
    q.r = p0[0]; q.k = p0[512]; q.v = p0[1024]; q.a = Ab[(size_t)row * 512 + col]; q.ld = LD[(size_t)row * 512 + col];
    return q;
}
__device__ __forceinline__ void unit_geom(int uid, int lane, int& b, int& h, int& c, int& col, int& row0) {
    const int bh = uid / NCHUNK; c = uid - bh * NCHUNK; b = bh >> 3; h = bh & 7; col = h * 64 + lane;
    row0 = c == 0 ? 0 : b * SEQ + c * 16;
}
__device__ __forceinline__ void phase_scanprep(const PPv& p, LAS unsigned char* lds) {
    const int tid = threadIdx.x, bid = blockIdx.x, nb = gridDim.x, lane = tid & 63, wave = tid >> 6;
    unsigned char* ws = p.gws();
    const bf16_t* PRKV = (const bf16_t*)(ws + OFF_PRKV);
    const bf16_t* LD = (const bf16_t*)(ws + OFF_LD);
    const bf16_t* Ab = (const bf16_t*)(ws + OFF_A);
    float* COEF = (float*)(ws + OFF_COEF);
    LAS unsigned char* wl = lds + wave * 13824;
    LAS bf16_t* AR = (LAS bf16_t*)wl;
    LAS bf16_t* BK = (LAS bf16_t*)(wl + 4608);
    LAS float* DM = (LAS float*)(wl + 9216);
    const int qperm = (lane & 32) | (((lane >> 2) & 3) << 3) | (((lane >> 4) & 1) << 2) | (lane & 3);
    int uid = bid * 8 + wave;
    if (uid >= NUNITS) return;
    int b, h, c, col, row0;
    unit_geom(uid, lane, b, h, c, col, row0);
    RawTok q[16], qn[16];
    bf16_t prr = 0, prk = 0, prv = 0, nprr = 0, nprk = 0, nprv = 0;
#pragma unroll
    for (int t = 0; t < 16; ++t) q[t] = load_raw(PRKV, Ab, LD, row0 + t, col);
    { const int pr = prev_row(row0, 1); if (pr >= 0) { const bf16_t* p1 = PRKV + (size_t)pr * 1536 + col; prr = p1[0]; prk = p1[512]; prv = p1[1024]; } }
    for (;;) {
        const float mur = p.gin(4)[col], muk = p.gin(5)[col], muv = p.gin(6)[col], kkw = p.gin(18)[col], kaw = p.gin(19)[col], rkw = p.gin(20)[col];
        const int nuid = uid + nb * 8; const bool has_next = nuid < NUNITS;
        int nb_ = b, nh = h, nc = c, ncol = col, nrow0 = row0;
        if (has_next) {
            unit_geom(nuid, lane, nb_, nh, nc, ncol, nrow0);
#pragma unroll
            for (int t = 0; t < 16; ++t) qn[t] = load_raw(PRKV, Ab, LD, nrow0 + t, ncol);
            nprr = 0; nprk = 0; nprv = 0;
            const int pr = prev_row(nrow0, 1); if (pr >= 0) { const bf16_t* p1 = PRKV + (size_t)pr * 1536 + ncol; nprr = p1[0]; nprk = p1[512]; nprv = p1[1024]; }
        }
        __builtin_amdgcn_sched_barrier(0);
        LAS float* PM = (LAS float*)wl;
        LAS float* RS = DM;
        {
            float rp = bf2f(prr), kp = bf2f(prk);
#pragma unroll
            for (int t = 0; t < 16; ++t) {
                const RawTok qq = q[t];
                const float r0 = bf2f(qq.r), k0 = bf2f(qq.k);
                const float r = r0 + (rp - r0) * mur, k = k0 + (kp - k0) * muk;
                rp = r0; kp = k0;
                const float a = bf2f(qq.a);
                const float kkv = k * kkw, k2 = k * (1.0f + (a - 1.0f) * kaw);
                PM[t * 68 + lane] = kkv * kkv; PM[(16 + t) * 68 + lane] = r * k2 * rkw;
            }
            asm volatile("" ::: "memory");
            const int rw = lane & 31, hf = lane >> 5;
            f32x4 s4 = (f32x4){0.f, 0.f, 0.f, 0.f};
#pragma unroll
            for (int i = 0; i < 8; ++i) s4 += *(const LAS f32x4*)(PM + rw * 68 + hf * 32 + i * 4);
            float sm = (s4[0] + s4[1]) + (s4[2] + s4[3]);
            { float c2 = sm; asm volatile("v_nop\n\tv_nop\n\tv_permlane32_swap_b32 %0, %1\n\tv_nop" : "+v"(sm), "+v"(c2)); sm += c2; }
            if (lane < 32) RS[lane] = sm;
            asm volatile("" ::: "memory");
            const float cfl = __shfl(sm, (lane & 15) + 16);
            if (lane < 16) COEF[(size_t)(row0 + lane) * 8 + h] = cfl;
        }
        __builtin_amdgcn_sched_barrier(0);
        float at[16], vt[16]; unsigned btp[8], ktp[8]; float bprev = 0.f, kprev = 0.f;
        float cl = 0.f;
        float rp = bf2f(prr), kp = bf2f(prk), vp = bf2f(prv);
        f32x4 n2v[4];
#pragma unroll
        for (int i = 0; i < 4; ++i) n2v[i] = *(const LAS f32x4*)(RS + 4 * i);
        asm volatile("" ::: "memory"); __builtin_amdgcn_sched_barrier(0);
#pragma unroll
        for (int t = 0; t < 16; ++t) {
            const RawTok qq = q[t];
            const float r0 = bf2f(qq.r), k0 = bf2f(qq.k), v0 = bf2f(qq.v);
            const float r = r0 + (rp - r0) * mur, k = k0 + (kp - k0) * muk, v = v0 + (vp - v0) * muv;
            rp = r0; kp = k0; vp = v0;
            const float a = bf2f(qq.a);
            const float kkv = k * kkw;
            const float kk = kkv * __builtin_amdgcn_rsqf(fmaxf(n2v[t >> 2][t & 3], 1e-24f));
            const float k2 = k * (1.0f + (a - 1.0f) * kaw);
            const float wcp = __expf(cl);
            cl += bf2f(qq.ld);
            const float wcn = __expf(cl), iw = __expf(-cl);
            const float btv = kk * a * iw, ktv = k2 * iw;
            at[t] = -kk * wcp; vt[t] = v;
            { const unsigned w = cvt_pk_bf16(at[t], r * wcn); AR[t * 72 + qperm] = (bf16_t)(w & 0xFFFFu); AR[(16 + t) * 72 + qperm] = (bf16_t)(w >> 16); }
            if (t & 1) {
                btp[t >> 1] = cvt_pk_bf16(bprev, btv); ktp[t >> 1] = cvt_pk_bf16(kprev, ktv);
                BK[(t - 1) * 72 + qperm] = (bf16_t)(btp[t >> 1] & 0xFFFFu); BK[t * 72 + qperm] = (bf16_t)(btp[t >> 1] >> 16);
                BK[(16 + t - 1) * 72 + qperm] = (bf16_t)(ktp[t >> 1] & 0xFFFFu); BK[(16 + t) * 72 + qperm] = (bf16_t)(ktp[t >> 1] >> 16);
            } else { bprev = btv; kprev = ktv; }
            if ((t & 3) == 3) __builtin_amdgcn_sched_barrier(0);
        }
        const float wcc = __expf(cl);
        {
            f32x16 dm;
#pragma unroll
            for (int i = 0; i < 16; ++i) dm[i] = 0.f;
            const int rr = lane & 31, hh = lane >> 5;
#pragma unroll
            for (int ks = 0; ks < 4; ++ks) {
                const bf16x8 fa = *(const LAS bf16x8*)(AR + rr * 72 + 16 * ks + 8 * hh);
                const bf16x8 fb = *(const LAS bf16x8*)(BK + rr * 72 + 16 * ks + 8 * hh);
                dm = __builtin_amdgcn_mfma_f32_32x32x16_bf16(fa, fb, dm, 0, 0, 0);
            }
#pragma unroll
            for (int reg = 0; reg < 16; ++reg) DM[((reg & 3) + 8 * (reg >> 2) + 4 * hh) * 36 + rr] = dm[reg];
        }
        __builtin_amdgcn_sched_barrier(0);
        float uh[16];
#pragma unroll
        for (int t = 0; t < 16; ++t) {
            float wv = at[t], uv = 0.f, wv2 = 0.f, uv2 = 0.f, uv3 = 0.f;
#pragma unroll
            for (int s4 = 0; s4 < 4; ++s4) {
                if (s4 * 4 < t) {
                    const f32x4 ab = *(const LAS f32x4*)(DM + t * 36 + s4 * 4), ak = *(const LAS f32x4*)(DM + t * 36 + 16 + s4 * 4);
#pragma unroll
                    for (int j = 0; j < 4; ++j) {
                        const int s_ = s4 * 4 + j;
                        if (s_ < t) {
                            if (j & 1) { wv2 += ab[j] * at[s_]; uv2 += ak[j] * vt[s_]; } else { wv += ab[j] * at[s_]; uv += ak[j] * vt[s_]; }
                            uv3 += ab[j] * uh[s_];
                        }
                    }
                }
            }
            wv += wv2; uv += uv2 + uv3;
            at[t] = wv; uh[t] = uv;
            asm volatile("" : "+v"(at[t]), "+v"(uh[t]));
        }
        __builtin_amdgcn_sched_barrier(0);
#pragma unroll
        for (int t = 0; t < 16; t += 2) { const unsigned w = cvt_pk_bf16(at[t], at[t + 1]); AR[t * 72 + qperm] = (bf16_t)(w & 0xFFFFu); AR[(t + 1) * 72 + qperm] = (bf16_t)(w >> 16); }
        unsigned char* rec = ws + OFF_CH + (size_t)uid * REC_BYTES;
#pragma unroll
        for (int i = 0; i < 2; ++i) {
            const int pc = i * 64 + lane, row = pc >> 3, part = pc & 7;
            *(u32x4*)(rec + RO_WH + pc * 16) = *(const LAS u32x4*)((LAS unsigned char*)AR + row * 144 + part * 16);
            *(u32x4*)(rec + RO_RT + pc * 16) = *(const LAS u32x4*)((LAS unsigned char*)AR + (16 + row) * 144 + part * 16);
        }
        {
            u32x4 w0, w1;
            w0.x = cvt_pk_bf16(uh[0], uh[1]); w0.y = cvt_pk_bf16(uh[2], uh[3]); w0.z = cvt_pk_bf16(uh[4], uh[5]); w0.w = cvt_pk_bf16(uh[6], uh[7]);
            w1.x = cvt_pk_bf16(uh[8], uh[9]); w1.y = cvt_pk_bf16(uh[10], uh[11]); w1.z = cvt_pk_bf16(uh[12], uh[13]); w1.w = cvt_pk_bf16(uh[14], uh[15]);
            *(u32x4*)(rec + RO_U0T + lane * 32) = w0; *(u32x4*)(rec + RO_U0T + lane * 32 + 16) = w1;
            w0.x = cvt_pk_bf16(vt[0], vt[1]); w0.y = cvt_pk_bf16(vt[2], vt[3]); w0.z = cvt_pk_bf16(vt[4], vt[5]); w0.w = cvt_pk_bf16(vt[6], vt[7]);
            w1.x = cvt_pk_bf16(vt[8], vt[9]); w1.y = cvt_pk_bf16(vt[10], vt[11]); w1.z = cvt_pk_bf16(vt[12], vt[13]); w1.w = cvt_pk_bf16(vt[14], vt[15]);
            *(u32x4*)(rec + RO_VT + lane * 32) = w0; *(u32x4*)(rec + RO_VT + lane * 32 + 16) = w1;
        }
#pragma unroll
        for (int g = 0; g < 4; ++g) {
            u32x4 w; w.x = btp[2 * g]; w.y = btp[2 * g + 1]; w.z = ktp[2 * g]; w.w = ktp[2 * g + 1];
            *(u32x4*)(rec + RO_BKT + lane * 64 + g * 16) = w;
        }
        {
            const int t = lane >> 2, g = lane & 3;
            const f32x4 rb = *(const LAS f32x4*)(DM + (16 + t) * 36 + 4 * g), rk = *(const LAS f32x4*)(DM + (16 + t) * 36 + 16 + 4 * g);
            float o[8];
#pragma unroll
            for (int j = 0; j < 4; ++j) { const bool keep = (4 * g + j) <= t; o[j] = keep ? rb[j] : 0.f; o[4 + j] = keep ? rk[j] : 0.f; }
            u32x4 w; w.x = cvt_pk_bf16(o[0], o[1]); w.y = cvt_pk_bf16(o[2], o[3]); w.z = cvt_pk_bf16(o[4], o[5]); w.w = cvt_pk_bf16(o[6], o[7]);
            *(u32x4*)(rec + RO_ARK + t * 64 + g * 16) = w;
        }
        *(float*)(rec + RO_WCC + lane * 4) = wcc;
        if (!has_next) break;
        uid = nuid; b = nb_; h = nh; c = nc; col = ncol; row0 = nrow0;
#pragma unroll
        for (int t = 0; t < 16; ++t) q[t] = qn[t];
        prr = nprr; prk = nprk; prv = nprv;
        __builtin_amdgcn_sched_barrier(0);
    }
}

__device__ __forceinline__ void convert_expert_weights(const PPv& p, LAS unsigned char* lds, int first, int stride);
struct RecOps { bf16x8 wA0, wA1, rA0, rA1, ark, bk[4]; u32x2 u0, vv; f32x4 wc[4]; };
__device__ __forceinline__ void load_ops(RecOps& o, LAS unsigned char* S, int vs, int fr, int g) {
    o.wA0 = *(const LAS bf16x8*)(S + RO_WH + fr * 128 + g * 16); o.wA1 = *(const LAS bf16x8*)(S + RO_WH + fr * 128 + 64 + g * 16);
    o.rA0 = *(const LAS bf16x8*)(S + RO_RT + fr * 128 + g * 16); o.rA1 = *(const LAS bf16x8*)(S + RO_RT + fr * 128 + 64 + g * 16);
    o.u0 = *(const LAS u32x2*)(S + RO_U0T + (16 * vs + fr) * 32 + g * 8);
    o.vv = *(const LAS u32x2*)(S + RO_VT + (16 * vs + fr) * 32 + g * 8);
    o.ark = *(const LAS bf16x8*)(S + RO_ARK + fr * 64 + g * 16);
#pragma unroll
    for (int m = 0; m < 4; ++m) { o.bk[m] = *(const LAS bf16x8*)(S + RO_BKT + (16 * m + fr) * 64 + g * 16); o.wc[m] = *(const LAS f32x4*)(S + RO_WCC + (16 * m + 4 * g) * 4); }
}
__device__ __forceinline__ void phase_recur(const PPv& p, LAS unsigned char* lds) {
    const int tid = threadIdx.x, bid = blockIdx.x, nb = gridDim.x, lane = tid & 63, wave = __builtin_amdgcn_readfirstlane(tid >> 6);
    unsigned char* ws = p.gws();
    if (bid >= 64) { convert_expert_weights(p, lds, bid - 64, nb - 64); return; }
    unsigned char* CHb = ws + OFF_CH + (size_t)(bid * NCHUNK) * REC_BYTES;
    constexpr int RSLOT = REC_BYTES, RN = 10, PF = 7;
#define R_BAR() do { asm volatile("s_waitcnt lgkmcnt(0)" ::: "memory"); __builtin_amdgcn_s_barrier(); asm volatile("" ::: "memory"); } while (0)
    if (wave >= 4) {
        const int lw = wave - 4;
#define R_ISSUE(x) do { \
            LAS unsigned char* _s = lds + ((x) % RN) * RSLOT; const unsigned char* _r = CHb + (size_t)(x) * REC_BYTES + lane * 16; \
            _Pragma("unroll") for (int _i = 0; _i < 3; ++_i) { const int _pc = lw + 4 * _i; __builtin_amdgcn_global_load_lds((const unsigned*)(_r + _pc * 1024), (LAS unsigned*)(_s + _pc * 1024), 16, 0, 0); } \
            if (lw == 0) __builtin_amdgcn_global_load_lds((const unsigned*)(_r + 12 * 1024), (LAS unsigned*)(_s + 12 * 1024), 16, 0, 0); \
            if (lw == 1) { if (lane < 16) __builtin_amdgcn_global_load_lds((const unsigned*)(_r + 13 * 1024), (LAS unsigned*)(_s + 13 * 1024), 16, 0, 0); } } while (0)
        for (int x = 0; x < PF; ++x) R_ISSUE(x);
        asm volatile("s_waitcnt vmcnt(0)" ::: "memory");
        R_BAR();
        for (int c = 0; c < NCHUNK; ++c) {
            const int x = c + PF;
            if (x < NCHUNK) R_ISSUE(x);
            if (x < NCHUNK) { if (lw < 2) asm volatile("s_waitcnt vmcnt(20)" ::: "memory"); else asm volatile("s_waitcnt vmcnt(15)" ::: "memory"); }
            else asm volatile("s_waitcnt vmcnt(0)" ::: "memory");
            R_BAR();
        }
#undef R_ISSUE
    } else {
        const int vs = wave, fr = lane & 15, g = lane >> 4;
        f32x4 H[4];
#pragma unroll
        for (int m = 0; m < 4; ++m) H[m] = (f32x4){0.f, 0.f, 0.f, 0.f};
        R_BAR();
        RecOps cur, nxt;
        load_ops(cur, lds, vs, fr, g);
        for (int c = 0; c < NCHUNK; ++c) {
            if (c + 1 < NCHUNK) load_ops(nxt, lds + ((c + 1) % RN) * RSLOT, vs, fr, g); else nxt = cur;
            u32x4 hb0, hb1;
            hb0.x = cvt_pk_bf16(H[0][0], H[0][1]); hb0.y = cvt_pk_bf16(H[0][2], H[0][3]); hb0.z = cvt_pk_bf16(H[1][0], H[1][1]); hb0.w = cvt_pk_bf16(H[1][2], H[1][3]);
            hb1.x = cvt_pk_bf16(H[2][0], H[2][1]); hb1.y = cvt_pk_bf16(H[2][2], H[2][3]); hb1.z = cvt_pk_bf16(H[3][0], H[3][1]); hb1.w = cvt_pk_bf16(H[3][2], H[3][3]);
            const bf16x8 hB0 = __builtin_bit_cast(bf16x8, hb0), hB1 = __builtin_bit_cast(bf16x8, hb1);
            f32x4 U = (f32x4){bflo(cur.u0.x), bfhi(cur.u0.x), bflo(cur.u0.y), bfhi(cur.u0.y)};
            U = __builtin_amdgcn_mfma_f32_16x16x32_bf16(cur.wA0, hB0, U, 0, 0, 0);
            U = __builtin_amdgcn_mfma_f32_16x16x32_bf16(cur.wA1, hB1, U, 0, 0, 0);
            f32x4 Y = (f32x4){0.f, 0.f, 0.f, 0.f};
            Y = __builtin_amdgcn_mfma_f32_16x16x32_bf16(cur.rA0, hB0, Y, 0, 0, 0);
            Y = __builtin_amdgcn_mfma_f32_16x16x32_bf16(cur.rA1, hB1, Y, 0, 0, 0);
            u32x4 uvw; uvw.x = cvt_pk_bf16(U[0], U[1]); uvw.y = cvt_pk_bf16(U[2], U[3]); uvw.z = cur.vv.x; uvw.w = cur.vv.y;
            const bf16x8 uv = __builtin_bit_cast(bf16x8, uvw);
            Y = __builtin_amdgcn_mfma_f32_16x16x32_bf16(cur.ark, uv, Y, 0, 0, 0);
#pragma unroll
            for (int m = 0; m < 4; ++m) { H[m] = __builtin_amdgcn_mfma_f32_16x16x32_bf16(cur.bk[m], uv, H[m], 0, 0, 0); H[m] *= cur.wc[m]; }
            u32x2 yw; yw.x = cvt_pk_bf16(Y[0], Y[1]); yw.y = cvt_pk_bf16(Y[2], Y[3]);
            *(u32x2*)(CHb + (size_t)c * REC_BYTES + RO_U0T + (16 * vs + fr) * 32 + g * 8) = yw;
            R_BAR();
            cur = nxt;
        }
    }
#undef R_BAR
}

__device__ __forceinline__ void phase_gn(const PPv& p) {
    const int tid = threadIdx.x, bid = blockIdx.x, nb = gridDim.x, lane = tid & 63, wave = tid >> 6;
    unsigned char* ws = p.gws();
    const bf16_t* Gb = (const bf16_t*)(ws + OFF_G); const float* COEF = (const float*)(ws + OFF_COEF);
    bf16_t* Z = (bf16_t*)(ws + OFF_Z);
    constexpr int NREAL = 64 * 256;
    for (int r0 = bid * 8 + wave; r0 < NREAL; r0 += nb * 16) {
        u32x4 y0[2], y1[2], v0[2], v1[2]; float cfv[2][16]; bf16_t ggv[2][16]; int colv[2], row0v[2], hv[2]; bool okv[2];
#pragma unroll
        for (int u = 0; u < 2; ++u) {
            const int r = r0 + u * nb * 8; okv[u] = r < NREAL;
            const int rr = okv[u] ? r : r0;
            const int bh = rr >> 8, c = (rr & 255) + 1, b = bh >> 3, h = bh & 7, uid = bh * NCHUNK + c;
            hv[u] = h; colv[u] = h * 64 + lane; row0v[u] = b * SEQ + c * 16;
            const unsigned char* rec = ws + OFF_CH + (size_t)uid * REC_BYTES;
            y0[u] = *(const u32x4*)(rec + RO_U0T + lane * 32); y1[u] = *(const u32x4*)(rec + RO_U0T + lane * 32 + 16);
            v0[u] = *(const u32x4*)(rec + RO_VT + lane * 32); v1[u] = *(const u32x4*)(rec + RO_VT + lane * 32 + 16);
#pragma unroll
            for (int t = 0; t < 16; ++t) { cfv[u][t] = COEF[(size_t)(row0v[u] + t) * 8 + h]; ggv[u][t] = Gb[(size_t)(row0v[u] + t) * 512 + colv[u]]; }
        }
#pragma unroll
        for (int u = 0; u < 2; ++u) {
            if (!okv[u]) continue;
            const int col = colv[u], row0 = row0v[u];
            const float lng = p.gin(21)[col], lnb = p.gin(22)[col];
            const unsigned yw[8] = {y0[u].x, y0[u].y, y0[u].z, y0[u].w, y1[u].x, y1[u].y, y1[u].z, y1[u].w}, vw[8] = {v0[u].x, v0[u].y, v0[u].z, v0[u].w, v1[u].x, v1[u].y, v1[u].z, v1[u].w};
#pragma unroll
            for (int t = 0; t < 16; ++t) {
                const float y = (t & 1) ? bfhi(yw[t >> 1]) : bflo(yw[t >> 1]);
                const float v = (t & 1) ? bfhi(vw[t >> 1]) : bflo(vw[t >> 1]);
                const float mean = wave_sum_dpp(y) * (1.0f / 64.0f);
                const float dlt = y - mean;
                const float var = wave_sum_dpp(dlt * dlt) * (1.0f / 64.0f);
                const float yn = dlt * rsqrtf(var + LNX_EPS) * lng + lnb;
                Z[(size_t)(row0 + t - NMETA) * 512 + col] = f2bf((yn + cfv[u][t] * v) * bf2f(ggv[u][t]));
            }
        }
    }
}

__device__ __forceinline__ void convert_expert_weights(const PPv& p, LAS unsigned char* lds, int first, int stride) {
    unsigned char* ws = p.gws();
    const int tid = threadIdx.x;
    LAS float* tile = (LAS float*)lds;
    const float* g2 = p.gin(27);
    bf16_t* WGU = (bf16_t*)(ws + OFF_WGU); bf16_t* WD = (bf16_t*)(ws + OFF_WD);
    constexpr int NBLK = NE * 3 * 64;
    const int lr = tid >> 6, lc = (tid & 63) * 4;
    f32x4 cur[8];
    int j = first;
    if (j >= NBLK) return;
    {
        const int mat = j >> 6, e = mat / 3, which = mat - 3 * e, bb = j & 63, kb = bb & 15, nbk = bb >> 4;
        const float* src = (which == 0 ? p.gin(30) : which == 1 ? p.gin(32) : p.gin(34)) + (size_t)e * 1024 * 1024 + (size_t)(kb * 64) * 1024 + nbk * 256;
#pragma unroll
        for (int i = 0; i < 8; ++i) cur[i] = __builtin_nontemporal_load((const f32x4*)(src + (size_t)(lr + 8 * i) * 1024 + lc));
    }
    for (;;) {
        const int jn = j + stride; const bool has_next = jn < NBLK;
        f32x4 nxt[8];
        if (has_next) {
            const int mat = jn >> 6, e = mat / 3, which = mat - 3 * e, bb = jn & 63, kb = bb & 15, nbk = bb >> 4;
            const float* src = (which == 0 ? p.gin(30) : which == 1 ? p.gin(32) : p.gin(34)) + (size_t)e * 1024 * 1024 + (size_t)(kb * 64) * 1024 + nbk * 256;
#pragma unroll
            for (int i = 0; i < 8; ++i) nxt[i] = __builtin_nontemporal_load((const f32x4*)(src + (size_t)(lr + 8 * i) * 1024 + lc));
        }
        const int mat = j >> 6, e = mat / 3, which = mat - 3 * e, bb = j & 63, kb = bb & 15, nbk = bb >> 4;
#pragma unroll
        for (int i = 0; i < 8; ++i) { LAS float* t = tile + (lr + 8 * i) * 257 + lc; t[0] = cur[i][0]; t[1] = cur[i][1]; t[2] = cur[i][2]; t[3] = cur[i][3]; }
        __syncthreads();
        {
            const int kq = tid & 7, k0 = kb * 64 + 8 * kq;
            float sc[8];
#pragma unroll
            for (int jj = 0; jj < 8; ++jj) sc[jj] = which < 2 ? g2[k0 + jj] : 1.0f;
#pragma unroll
            for (int i = 0; i < 4; ++i) {
                const int nn = (tid >> 3) + 64 * i, n = nbk * 256 + nn;
                float v[8];
#pragma unroll
                for (int jj = 0; jj < 8; ++jj) v[jj] = tile[(8 * kq + jj) * 257 + nn] * sc[jj];
                u32x4 w; w.x = cvt_pk_bf16(v[0], v[1]); w.y = cvt_pk_bf16(v[2], v[3]); w.z = cvt_pk_bf16(v[4], v[5]); w.w = cvt_pk_bf16(v[6], v[7]);
                bf16_t* dst = which < 2 ? WGU + (size_t)e * 2048 * 1024 + (size_t)(256 * (n >> 7) + 128 * which + (n & 127)) * 1024
                                        : WD + (size_t)e * 1024 * 1024 + (size_t)n * 1024;
                __builtin_nontemporal_store(w, (u32x4*)(dst + k0));
            }
        }
        __syncthreads();
        if (!has_next) break;
        j = jn;
#pragma unroll
        for (int i = 0; i < 8; ++i) cur[i] = nxt[i];
    }
}

__device__ __forceinline__ void phase_router(const PPv& p, LAS unsigned char* lds) {
    const int tid = threadIdx.x, bid = blockIdx.x, nb = gridDim.x, lane = tid & 63, wave = tid >> 6;
    unsigned char* ws = p.gws();
    const bf16_t* h1 = (const bf16_t*)(ws + OFF_HB2);
    const float* WRG = (const float*)(ws + OFF_WRG);
    const float* brt = p.gin(29);
    LAS float* slog = (LAS float*)lds;
    LAS float* srs = slog + 8 * 16 * 32;
    LAS int* lcnt = (LAS int*)(srs + 128);
    LAS int* gbase = lcnt + 32;
    LAS int* ltopi = gbase + 32;
    LAS int* lrank = ltopi + 512;
    int* TOPI = (int*)(ws + OFF_TOPI); float* TOPW = (float*)(ws + OFF_TOPW); int* RANK = (int*)(ws + OFF_RANK); float* RSTD2 = (float*)(ws + OFF_RSTD2);
    int* GCNT = (int*)(ws + OFF_GCNT);
    for (int tb = bid; tb < T / 128; tb += nb) {
        if (tid < 32) lcnt[tid] = 0;
        __syncthreads();
        const int t0 = tb * 128 + wave * 16;
        {
            const int row = lane & 15, kq = lane >> 4;
            const bf16_t* ap = h1 + (size_t)(t0 + row) * D + 4 * kq;
            const float* bp = WRG + (size_t)(4 * kq) * 32 + row;
            f32x4 acc0 = (f32x4){0.f, 0.f, 0.f, 0.f}, acc1 = acc0;
            float ss = 0.f;
            for (int j = 0; j < 64; ++j) {
                const u32x2 aw = *(const u32x2*)(ap + 16 * j);
                const f32x4 av = (f32x4){bflo(aw.x), bfhi(aw.x), bflo(aw.y), bfhi(aw.y)};
                ss += av[0] * av[0] + av[1] * av[1] + av[2] * av[2] + av[3] * av[3];
                const float* bj = bp + (size_t)(16 * j) * 32;
#pragma unroll
                for (int s = 0; s < 4; ++s) {
                    const float b0 = bj[s * 32], b1 = bj[s * 32 + 16];
                    acc0 = __builtin_amdgcn_mfma_f32_16x16x4f32(av[s], b0, acc0, 0, 0, 0);
                    acc1 = __builtin_amdgcn_mfma_f32_16x16x4f32(av[s], b1, acc1, 0, 0, 0);
                }
            }
            ss += __shfl_xor(ss, 16); ss += __shfl_xor(ss, 32);
#pragma unroll
            for (int reg = 0; reg < 4; ++reg) {
                slog[(wave * 16 + 4 * kq + reg) * 32 + row] = acc0[reg];
                slog[(wave * 16 + 4 * kq + reg) * 32 + 16 + row] = acc1[reg];
            }
            if (lane < 16) srs[wave * 16 + lane] = rsqrtf(ss * (1.0f / D) + NORM_EPS);
        }
        __syncthreads();
        if (lane < 16) {
            const int tl = wave * 16 + lane, t = tb * 128 + tl;
            const float rs = srs[tl];
            float lg[32];
#pragma unroll
            for (int e = 0; e < 32; ++e) lg[e] = slog[tl * 32 + e] * rs + brt[e];
            int ti[4]; float tv[4];
#pragma unroll
            for (int k = 0; k < 4; ++k) {
                float best = -3.0e38f; int bi = 0;
#pragma unroll
                for (int e = 0; e < 32; ++e) { const bool tk = lg[e] > best; best = tk ? lg[e] : best; bi = tk ? e : bi; }
                ti[k] = bi; tv[k] = best;
#pragma unroll
                for (int e = 0; e < 32; ++e) lg[e] = (e == bi) ? -3.0e38f : lg[e];
            }
            const float e0 = 1.0f, e1 = __expf(tv[1] - tv[0]), e2 = __expf(tv[2] - tv[0]), e3 = __expf(tv[3] - tv[0]);
            const float inv = 1.0f / (e0 + e1 + e2 + e3);
            *(f32x4*)(TOPW + (size_t)t * 4) = (f32x4){e0 * inv, e1 * inv, e2 * inv, e3 * inv};
            RSTD2[t] = rs;
#pragma unroll
            for (int k = 0; k < 4; ++k) { ltopi[tl * 4 + k] = ti[k]; lrank[tl * 4 + k] = __hip_atomic_fetch_add(lcnt + ti[k], 1, __ATOMIC_RELAXED, __HIP_MEMORY_SCOPE_WORKGROUP); }
        }
        __syncthreads();
        if (tid < 32) gbase[tid] = atomicAdd(GCNT + tid, lcnt[tid]);
        __syncthreads();
        {
            const int e = ltopi[tid];
            TOPI[(size_t)tb * 512 + tid] = e;
            RANK[(size_t)tb * 512 + tid] = gbase[e] + lrank[tid];
        }
        __syncthreads();
    }
}

__device__ __forceinline__ void phase_lists(const PPv& p, LAS unsigned char* lds) {
    const int tid = threadIdx.x, bid = blockIdx.x, nb = gridDim.x;
    unsigned char* ws = p.gws();
    LAS int* pstart = (LAS int*)lds;
    LAS int* cnt = pstart + 64;
    const int* GCNT = (const int*)(ws + OFF_GCNT);
    if (tid < 32) cnt[tid] = GCNT[tid];
    __syncthreads();
    if (tid == 0) { int s = 0; for (int e = 0; e < 32; ++e) { pstart[e] = s; s += ((cnt[e] + 255) >> 8) << 8; } pstart[32] = s; }
    __syncthreads();
    const int* TOPI = (const int*)(ws + OFF_TOPI); const float* TOPW = (const float*)(ws + OFF_TOPW); const int* RANK = (const int*)(ws + OFF_RANK); const float* RSTD2 = (const float*)(ws + OFF_RSTD2);
    int* ROWTOK = (int*)(ws + OFF_ROWTOK); int* ROWSLOT = (int*)(ws + OFF_ROWSLOT); float* ROWW = (float*)(ws + OFF_ROWW); float* ROWRS = (float*)(ws + OFF_ROWRS);
    for (int i = bid * 512 + tid; i < T * 4; i += nb * 512) {
        const int e = TOPI[i], pos = pstart[e] + RANK[i], t = i >> 2;
        ROWTOK[pos] = t; ROWSLOT[pos] = i; ROWW[pos] = TOPW[i]; ROWRS[pos] = RSTD2[t];
    }
    for (int e = bid; e < 32; e += nb) {
        for (int pos = pstart[e] + cnt[e] + tid; pos < pstart[e + 1]; pos += 512) { ROWTOK[pos] = 0; ROWSLOT[pos] = -1; ROWW[pos] = 0.f; ROWRS[pos] = 0.f; }
    }
    if (bid == 0) {
        int* TILEE = (int*)(ws + OFF_TILEE);
        const int ntiles = pstart[32] >> 8;
        for (int mt = tid; mt < ntiles; mt += 512) { int e = 0; for (int q = 0; q < 32; ++q) if (pstart[q] <= mt * 256) e = q; TILEE[mt] = e; }
        if (tid == 0) TILEE[1000] = ntiles;
    }
    __syncthreads();
}

__device__ __forceinline__ void phase_final(const PPv& p) {
    const int tid = threadIdx.x, bid = blockIdx.x, nb = gridDim.x, lane = tid & 63, wave = tid >> 6;
    unsigned char* ws = p.gws();
    const bf16_t* HB2 = (const bf16_t*)(ws + OFF_HB2);
    const bf16_t* YA = (const bf16_t*)p.gout(); const bf16_t* YB = (const bf16_t*)(ws + OFF_WGU);
    const float* gf = p.gin(36);
    const f32x4 ga0 = *(const f32x4*)(gf + 8 * lane), ga1 = *(const f32x4*)(gf + 8 * lane + 4), gb0 = *(const f32x4*)(gf + 512 + 8 * lane), gb1 = *(const f32x4*)(gf + 512 + 8 * lane + 4);
    for (int t0 = (bid * 8 + wave) * 2; t0 < T; t0 += nb * 16) {
        u32x4 ha[2], hb[2], ya[2][4], yb[2][4];
#pragma unroll
        for (int u = 0; u < 2; ++u) {
            const int t = t0 + u;
            ha[u] = __builtin_nontemporal_load((const u32x4*)(HB2 + (size_t)t * D + 8 * lane)); hb[u] = __builtin_nontemporal_load((const u32x4*)(HB2 + (size_t)t * D + 512 + 8 * lane));
#pragma unroll
            for (int k = 0; k < 4; ++k) { ya[u][k] = __builtin_nontemporal_load((const u32x4*)(YA + (size_t)(4 * t + k) * 512 + 8 * lane)); yb[u][k] = __builtin_nontemporal_load((const u32x4*)(YB + (size_t)(4 * t + k) * 512 + 8 * lane)); }
        }
#pragma unroll
        for (int u = 0; u < 2; ++u) {
            const int t = t0 + u;
            float va[8] = {bflo(ha[u].x), bfhi(ha[u].x), bflo(ha[u].y), bfhi(ha[u].y), bflo(ha[u].z), bfhi(ha[u].z), bflo(ha[u].w), bfhi(ha[u].w)};
            float vb[8] = {bflo(hb[u].x), bfhi(hb[u].x), bflo(hb[u].y), bfhi(hb[u].y), bflo(hb[u].z), bfhi(hb[u].z), bflo(hb[u].w), bfhi(hb[u].w)};
#pragma unroll
            for (int k = 0; k < 4; ++k) {
                const u32x4 a4 = ya[u][k], b4 = yb[u][k];
                va[0] += bflo(a4.x); va[1] += bfhi(a4.x); va[2] += bflo(a4.y); va[3] += bfhi(a4.y); va[4] += bflo(a4.z); va[5] += bfhi(a4.z); va[6] += bflo(a4.w); va[7] += bfhi(a4.w);
                vb[0] += bflo(b4.x); vb[1] += bfhi(b4.x); vb[2] += bflo(b4.y); vb[3] += bfhi(b4.y); vb[4] += bflo(b4.z); vb[5] += bfhi(b4.z); vb[6] += bflo(b4.w); vb[7] += bfhi(b4.w);
            }
            float ss = 0.f;
#pragma unroll
            for (int j = 0; j < 8; ++j) ss += va[j] * va[j] + vb[j] * vb[j];
            ss = wave_sum_dpp(ss);
            const float rs = rsqrtf(ss * (1.0f / D) + NORM_EPS);
            float* o = p.gout() + (size_t)t * D;
            __builtin_nontemporal_store((f32x4){va[0] * rs * ga0[0], va[1] * rs * ga0[1], va[2] * rs * ga0[2], va[3] * rs * ga0[3]}, (f32x4*)(o + 8 * lane));
            __builtin_nontemporal_store((f32x4){va[4] * rs * ga1[0], va[5] * rs * ga1[1], va[6] * rs * ga1[2], va[7] * rs * ga1[3]}, (f32x4*)(o + 8 * lane + 4));
            __builtin_nontemporal_store((f32x4){vb[0] * rs * gb0[0], vb[1] * rs * gb0[1], vb[2] * rs * gb0[2], vb[3] * rs * gb0[3]}, (f32x4*)(o + 512 + 8 * lane));
            __builtin_nontemporal_store((f32x4){vb[4] * rs * gb1[0], vb[5] * rs * gb1[1], vb[6] * rs * gb1[2], vb[7] * rs * gb1[3]}, (f32x4*)(o + 512 + 8 * lane + 4));
        }
    }
}

#define XB_TMO      128
#define XB_XCNT(j)  (256  + 64 * (j))
#define XB_XSUB(j)  (1280 + 64 * (j))
#define XB_XGEN(j)  (2304 + 64 * (j))
#define XB_TOP      3328
#define XB_TOPGEN   3392
#define XCD_BAR_WORDS 3456
#define XB_SPIN_CAP (1u << 18)
__device__ __forceinline__ unsigned xb_ld(unsigned* p)              { return __hip_atomic_load(p, __ATOMIC_RELAXED, __HIP_MEMORY_SCOPE_AGENT); }
__device__ __forceinline__ unsigned xb_add(unsigned* p, unsigned v) { return __hip_atomic_fetch_add(p, v, __ATOMIC_RELAXED, __HIP_MEMORY_SCOPE_AGENT); }
__device__ __forceinline__ unsigned xb_xcc_id() { return (unsigned)__builtin_amdgcn_s_getreg((3 << 11) | 20) & 0xFu; }
#define XB_SPIN(cond, bar) do { unsigned _sp = 0; while (cond) { __builtin_amdgcn_s_sleep(1); \
    if ((++_sp & 255u) == 0u) { if (xb_ld(&(bar)[XB_TMO])) break; if (_sp > XB_SPIN_CAP) { atomicAdd(&(bar)[XB_TMO], 1u); break; } } } } while (0)
struct XcdBarrier { unsigned* bar; unsigned x; volatile LAS unsigned* st; };
__device__ __forceinline__ XcdBarrier xcd_barrier_post(unsigned* bar, volatile LAS unsigned* st) {
    XcdBarrier b; b.bar = bar; b.x = xb_xcc_id(); b.st = st;
    if (threadIdx.x == 0) (void)xb_add(&bar[XB_XCNT(b.x)], 1u);
    return b;
}
__device__ __forceinline__ void xcd_barrier_complete(unsigned* bar, unsigned x, unsigned& nloc, unsigned& nx) {
    const unsigned G = gridDim.x * gridDim.y * gridDim.z;
    unsigned sum, cnt, mine, sp = 0u;
    for (;;) {
        sum = 0u; cnt = 0u; mine = 0u;
#pragma unroll
        for (unsigned j = 0; j < 16; ++j) { const unsigned c = xb_ld(&bar[XB_XCNT(j)]); sum += c; cnt += (c > 0u) ? 1u : 0u; mine = (j == x) ? c : mine; }
        if (sum == G) break;
        __builtin_amdgcn_s_sleep(1);
        if ((++sp & 255u) == 0u) { if (xb_ld(&bar[XB_TMO])) break; if (sp > XB_SPIN_CAP) { atomicAdd(&bar[XB_TMO], 1u); break; } }
    }
    nloc = mine > 0u ? mine : 1u; nx = cnt > 0u ? cnt : 1u;
}
__device__ __forceinline__ void xcd_barrier(const XcdBarrier& b) {
    asm volatile("s_waitcnt vmcnt(0)" ::: "memory");
    __syncthreads();
    if (threadIdx.x == 0) {
        unsigned* bar = b.bar;
        __builtin_amdgcn_s_waitcnt(0);
        unsigned nloc = b.st[0], nx = b.st[1];
        if (nloc == 0u) { xcd_barrier_complete(bar, b.x, nloc, nx); b.st[0] = nloc; b.st[1] = nx; }
        const unsigned old = xb_add(&bar[XB_XSUB(b.x)], 1u);
        const unsigned gen = old / nloc;
        if (old + 1u == (gen + 1u) * nloc) {
            __builtin_amdgcn_fence(__ATOMIC_RELEASE, "agent");
            asm volatile("s_waitcnt vmcnt(0)" ::: "memory");
            const unsigned og = xb_add(&bar[XB_TOP], 1u);
            const unsigned tg = og / nx;
            if (og + 1u == (tg + 1u) * nx) xb_add(&bar[XB_TOPGEN], 1u);
            else XB_SPIN(xb_ld(&bar[XB_TOPGEN]) == tg, bar);
            __builtin_amdgcn_fence(__ATOMIC_ACQUIRE, "agent");
            xb_add(&bar[XB_XGEN(b.x)], 1u);
            asm volatile("s_waitcnt vmcnt(0)" ::: "memory");
        } else {
            XB_SPIN(xb_ld(&bar[XB_XGEN(b.x)]) == gen, bar);
            __builtin_amdgcn_fence(__ATOMIC_ACQUIRE, "agent");
            asm volatile("s_waitcnt vmcnt(0)" ::: "memory");
        }
    }
    __syncthreads();
}

constexpr int N_PHASES = 15;
__global__ void __launch_bounds__(512, 2) mega(Params p) {
    extern __shared__ __attribute__((aligned(16))) unsigned char lds_raw[];
    LAS unsigned char* lds = (LAS unsigned char*)lds_raw;
    cg::grid_group grid = cg::this_grid();
    unsigned char* ws = getpp().gws();
    const int G = gridDim.x, bid = blockIdx.x;
#ifndef ONLY_PHASE
#define ONLY_PHASE -1
#endif
#define IN(k) ((ONLY_PHASE < 0 || ONLY_PHASE == (k)) && p.ph_lo <= (k) && (k) < p.ph_hi)
    volatile LAS unsigned* xst = (volatile LAS unsigned*)(lds + 163840 - 16);
    if (threadIdx.x < 4) xst[threadIdx.x] = 0u;
    __syncthreads();
    const XcdBarrier xbar = xcd_barrier_post((unsigned*)(ws + OFF_BAR), xst);
    if (p.ph_hi < 0) grid.sync();
#define SEAM(k) do { if ((k) + 1 < p.ph_hi) xcd_barrier(xbar); } while (0)
    if (IN(0)) { const PPv q = getpp(); phase_prep(q, lds); SEAM(0); }
    if (IN(1)) { const PPv q = getpp();
        phase_meta_proj(q, lds);
        StaticOrder S; S.init(ws + OFF_HB, ws + OFF_WIN, T, NCOLS1, 1024, G, bid);
        EpiProj E{(bf16_t*)(ws + OFF_PRKV), (bf16_t*)(ws + OFF_PCONV), (bf16_t*)q.gout(), (const float*)(ws + OFF_RSTD1)};
        gemm_phase<false>(lds, 1024, S, E);
        SEAM(1);
    }
    if (IN(2)) { const PPv q = getpp(); phase_lprep_conv(q); SEAM(2); }
    if (IN(3)) { const PPv q = getpp();
        phase_meta_lora(q);
        StaticOrder S; S.init(ws + OFF_L + (size_t)NMETA * 256 * 2, ws + OFF_W2, T, 1536, 256, G, bid);
        EpiL E{ws, q.gin(10), q.gin(13)};
        gemm_phase<false>(lds, 256, S, E);
        SEAM(3);
    }
    if (IN(4)) { const PPv q = getpp(); phase_scanprep(q, lds); SEAM(4); }
    if (IN(5)) { const PPv q = getpp(); phase_recur(q, lds); SEAM(5); }
    if (IN(6)) { const PPv q = getpp(); phase_gn(q); SEAM(6); }
    if (IN(7)) { const PPv q = getpp();
        MergeOrder S; S.so.init(ws + OFF_Z, ws + OFF_WR, T, 1024, 512, G, bid); S.A1 = (const char*)(ws + OFF_C); S.B1 = (const char*)(ws + OFF_WC);
        EpiMergeFused E{(bf16_t*)(ws + OFF_MERGED), (const bf16_t*)q.gout()};
        gemm_phase<false>(lds, 512, S, E);
        SEAM(7);
    }
    if (IN(9)) { const PPv q = getpp();
        StaticOrder S; S.init(ws + OFF_MERGED, ws + OFF_WO, T, 1024, 1024, G, bid);
        EpiO E{q.gin(0), q.gout(), (bf16_t*)(ws + OFF_HB2)};
        gemm_phase<false>(lds, 1024, S, E);
        SEAM(9);
    }
    if (IN(10)) { const PPv q = getpp(); phase_router(q, lds); SEAM(10); }
    if (IN(11)) { const PPv q = getpp(); phase_lists(q, lds); SEAM(11); }
    if (IN(12)) { const PPv q = getpp();
        const int* TILEE = (const int*)(ws + OFF_TILEE);
        MoeOrder S; S.A = (const char*)(ws + OFF_HB2); S.Bt = (const char*)(ws + OFF_WGU); S.K = 1024; S.estride = (size_t)2048 * 1024 * 2;
        S.tile_e = TILEE; S.rowtok = (const int*)(ws + OFF_ROWTOK); S.ntiles = TILEE[1000]; S.nnt = 8; S.G = G; S.c = bid; S.gather = true;
        EpiMoe1 E{(bf16_t*)(ws + OFF_ACT), (const float*)(ws + OFF_ROWRS), q.gin(31), q.gin(33)};
        gemm_phase<true>(lds, 1024, S, E);
        SEAM(12);
    }
    if (IN(13)) { const PPv q = getpp();
        const int* TILEE = (const int*)(ws + OFF_TILEE);
        MoeOrder S; S.A = (const char*)(ws + OFF_ACT); S.Bt = (const char*)(ws + OFF_WD); S.K = 1024; S.estride = (size_t)1024 * 1024 * 2;
        S.tile_e = TILEE; S.rowtok = nullptr; S.ntiles = TILEE[1000]; S.nnt = 4; S.G = G; S.c = bid; S.gather = false;
        EpiMoe2 E{(bf16_t*)q.gout(), (bf16_t*)(ws + OFF_WGU), (const int*)(ws + OFF_ROWSLOT), (const float*)(ws + OFF_ROWW), q.gin(35)};
        gemm_phase<false>(lds, 1024, S, E);
        SEAM(13);
    }
    if (IN(14)) { const PPv q = getpp(); phase_final(q); }
}

extern "C" void kernel_launch(void* const* d_in, const int* in_sizes, int n_in, void* d_out, int out_size, void* d_ws, size_t ws_size,
                              hipStream_t stream) {
    constexpr size_t kDynLds = 160 * 1024;
    static int grid_blocks = 0;
    if (!grid_blocks) {
        int dev = 0, cus = 0, per_cu = 0;
        (void)hipGetDevice(&dev);
        (void)hipDeviceGetAttribute(&cus, hipDeviceAttributeMultiprocessorCount, dev);
        (void)hipFuncSetAttribute((const void*)mega, hipFuncAttributeMaxDynamicSharedMemorySize, (int)kDynLds);
        (void)hipOccupancyMaxActiveBlocksPerMultiprocessor(&per_cu, mega, 512, kDynLds);
        if (per_cu > 1) per_cu = 1;
        grid_blocks = cus * per_cu;
        fprintf(stderr, "cus=%d per_cu=%d ws_size=%zu need=%zu\n", cus, per_cu, ws_size, (size_t)WS_NEED);
    }
    if (ws_size < WS_NEED || n_in < 37 || grid_blocks < 128) { fprintf(stderr, "kernel_launch: unsupported configuration\n"); return; }
    Params p{};
    for (int i = 0; i < 37; ++i) p.in[i] = (const float*)d_in[i];
    p.out = (float*)d_out;
    p.ws = (unsigned char*)d_ws;
    p.ph_lo = 0; p.ph_hi = N_PHASES;
    (void)hipMemsetAsync((unsigned char*)d_ws + OFF_BAR, 0, 16384, stream);
    void* args[] = {&p};
    hipError_t e = hipLaunchCooperativeKernel((void*)mega, dim3(grid_blocks), dim3(512), args, kDynLds, stream);
    if (e != hipSuccess) fprintf(stderr, "cooperative launch failed: %s (grid %d)\n", hipGetErrorString(e), grid_blocks);
}
```

```cpp
#include <hip/hip_runtime.h>
#include <hip/hip_cooperative_groups.h>
#include <cstdio>
namespace cg = cooperative_groups;

#define LAS __attribute__((address_space(3)))
typedef unsigned short bf16_t;
typedef short bf16x8 __attribute__((ext_vector_type(8)));
typedef float f32x4 __attribute__((ext_vector_type(4)));
typedef float f32x2 __attribute__((ext_vector_type(2)));
typedef unsigned u32x4 __attribute__((ext_vector_type(4)));
typedef unsigned u32x2 __attribute__((ext_vector_type(2)));

constexpr int D = 1024, NBATCH = 8, SEQ = 4096, NMETA = 16;
constexpr int T = NBATCH * SEQ;
constexpr int NR = T + NMETA;
constexpr int NRP = 33024;
constexpr int PCOLS1 = 3584;
constexpr int NCOLS1 = 5632;
constexpr int NE = 32, TOPK = 4, DFF = 1024;
constexpr int MAXROWS = T * TOPK + NE * 256;
constexpr int MAXTILES = MAXROWS / 256;
constexpr float NORM_EPS = 1e-5f, LNX_EPS = 64e-5f;

constexpr int NCHUNK = 257, NUNITS = 64 * NCHUNK;
constexpr int REC_BYTES = 13568;
constexpr int RO_WH = 0, RO_RT = 2048, RO_U0T = 4096, RO_VT = 6144, RO_BKT = 8192, RO_ARK = 12288, RO_WCC = 13312;
constexpr int SLOT_BYTES = 15680, SO_G = 13568, SO_COEF = 15616, NSLOT = 9;
constexpr size_t SZ_ACT = (size_t)MAXROWS * 1024 * 2;
constexpr size_t SZ_WGU = (size_t)NE * 2048 * 1024 * 2;
constexpr size_t SZ_WD = (size_t)NE * 1024 * 1024 * 2;
constexpr size_t SZ_HB = (size_t)T * 1024 * 2;
constexpr size_t OFF_WGU = 0;
constexpr size_t OFF_HB8 = OFF_WGU + (size_t)NE * 2048 * 1024;
constexpr size_t OFF_WD = OFF_WGU + SZ_WGU;
constexpr size_t OFF_ACT = OFF_WD + SZ_WD;
constexpr size_t OFF_HB2 = OFF_ACT + SZ_ACT;
constexpr size_t OFF_RT = OFF_HB2 + SZ_HB;
constexpr size_t OFF_TOPI = OFF_RT;
constexpr size_t OFF_TOPW = OFF_TOPI + (size_t)T * 16;
constexpr size_t OFF_RANK = OFF_TOPW + (size_t)T * 16;
constexpr size_t OFF_RSTD2 = OFF_RANK + (size_t)T * 16;
constexpr size_t OFF_ROWTOK = OFF_RSTD2 + (size_t)T * 4;
constexpr size_t OFF_ROWSLOT = OFF_ROWTOK + (size_t)MAXROWS * 4;
constexpr size_t OFF_ROWW = OFF_ROWSLOT + (size_t)MAXROWS * 4;
constexpr size_t OFF_ROWRS = OFF_ROWW + (size_t)MAXROWS * 4;
constexpr size_t OFF_TILEE = OFF_ROWRS + (size_t)MAXROWS * 4;
constexpr size_t OFF_GCNT = OFF_TILEE + 4096;
constexpr size_t OFF_SM = OFF_GCNT + 256;
constexpr size_t OFF_WR = OFF_SM;
constexpr size_t OFF_WC = OFF_WR + (size_t)1024 * 512 * 2;
constexpr size_t OFF_WO = OFF_WC + (size_t)1024 * 512 * 2;
constexpr size_t OFF_W2 = OFF_WO + (size_t)1024 * 1024 * 2;
constexpr size_t OFF_RSTD1 = OFF_W2 + (size_t)1536 * 256 * 2;
constexpr size_t OFF_WRG = OFF_RSTD1 + (size_t)NRP * 4;
constexpr size_t OFF_BAR = OFF_WRG + (size_t)1024 * 32 * 4;
constexpr size_t WS_NEED = OFF_BAR + 16384;
constexpr size_t OFF_PRKV = 0;
constexpr size_t SZ_PRKV = (size_t)NR * 1536 * 2;
constexpr size_t OFF_LD = OFF_PRKV + SZ_PRKV;
constexpr size_t OFF_A = OFF_LD + (size_t)NRP * 512 * 4;
constexpr size_t OFF_CH = OFF_A + (size_t)NRP * 512 * 2;
constexpr size_t OFF_PCONV = OFF_CH;
constexpr size_t SZ_PCONV = (size_t)NR * 2048 * 2;
constexpr size_t OFF_HB = OFF_PCONV + SZ_PCONV;
constexpr size_t OFF_L = OFF_HB + SZ_HB;
constexpr size_t OFF_WIN = OFF_L + (size_t)NRP * 256 * 2;
constexpr size_t CH_END = OFF_WIN + (size_t)NCOLS1 * 1024 * 2;
constexpr size_t OFF_MERGED = OFF_CH;
constexpr size_t OFF_G = CH_END;
constexpr size_t OFF_C = OFF_G + (size_t)NRP * 512 * 2;
constexpr size_t OFF_Z = OFF_C + (size_t)T * 512 * 2;
constexpr size_t OFF_COEF = OFF_Z + (size_t)T * 512 * 2;
constexpr size_t EARLY_END = OFF_COEF + (size_t)NR * 8 * 4;
static_assert(EARLY_END <= OFF_RT, "early buffers overflow");
static_assert(OFF_CH + (size_t)NUNITS * REC_BYTES <= CH_END, "chunk records overflow");
static_assert(OFF_CH >= OFF_WD + SZ_WD, "expert weights (written during the scan) must not touch live scan buffers");
static_assert(OFF_MERGED + SZ_HB <= OFF_HB2, "layout");
static_assert(OFF_PRKV % 16 == 0 && OFF_LD % 16 == 0 && OFF_A % 16 == 0 && OFF_CH % 16 == 0 && OFF_HB % 16 == 0 && OFF_L % 16 == 0 && OFF_WIN % 16 == 0 && OFF_G % 16 == 0 && OFF_C % 16 == 0 && OFF_Z % 16 == 0 && OFF_COEF % 16 == 0, "align");

#define GAS __attribute__((address_space(1)))
#define CAS __attribute__((address_space(4)))
struct Params {
    const float* in[37];
    float* out;
    unsigned char* ws;
    int ph_lo, ph_hi;
};
struct ParamsD {
    const GAS float* in[37];
    GAS float* out;
    GAS unsigned char* ws;
    int ph_lo, ph_hi;
};
static_assert(sizeof(Params) == sizeof(ParamsD), "argument views");
struct PPv {
    const CAS ParamsD* k;
    __device__ __forceinline__ const float* gin(int i) const { return (const float*)k->in[i]; }
    __device__ __forceinline__ float* gout() const { return (float*)k->out; }
    __device__ __forceinline__ unsigned char* gws() const { return (unsigned char*)k->ws; }
};
__device__ __forceinline__ PPv getpp() { const CAS ParamsD* k = (const CAS ParamsD*)__builtin_amdgcn_kernarg_segment_ptr(); asm volatile("" : "+s"(k)); return PPv{k}; }

typedef __bf16 bf16x2v __attribute__((ext_vector_type(2)));
__device__ __forceinline__ unsigned cvt_pk_bf16(float lo, float hi) { const f32x2 v = {lo, hi}; return __builtin_bit_cast(unsigned, __builtin_convertvector(v, bf16x2v)); }
__device__ __forceinline__ unsigned pk4_fp8(float a, float b, float c, float d) { int w = __builtin_amdgcn_cvt_pk_fp8_f32(a, b, 0, false); w = __builtin_amdgcn_cvt_pk_fp8_f32(c, d, w, true); return (unsigned)w; }
constexpr float W8_SCALE = 32.0f, W8_INV = 1.0f / 32.0f;
__device__ __forceinline__ bf16_t f2bf(float f) { unsigned u = __float_as_uint(f); u += 0x7FFFu + ((u >> 16) & 1u); return (bf16_t)(u >> 16); }
__device__ __forceinline__ float bf2f(bf16_t b) { return __uint_as_float(((unsigned)b) << 16); }
__device__ __forceinline__ float bflo(unsigned w) { return __uint_as_float(w << 16); }
__device__ __forceinline__ float bfhi(unsigned w) { return __uint_as_float(w & 0xFFFF0000u); }
__device__ __forceinline__ float sigmoidf_(float x) { return __builtin_amdgcn_rcpf(1.0f + __expf(-x)); }
__device__ __forceinline__ float wave_sum(float v) {
#pragma unroll
    for (int o = 32; o >= 1; o >>= 1) v += __shfl_xor(v, o);
    return v;
}
__device__ __forceinline__ float wave_sum_dpp(float v);
__device__ __forceinline__ int prev_row(int row, int d) {
    if (row < NMETA) return row - d >= 0 ? row - d : -1;
    const int s = (row - NMETA) & (SEQ - 1);
    return s >= d ? row - d : NMETA + s - d;
}

constexpr int BM = 256, BK = 64, HALF = 128, HTB = HALF * BK * 2, STAGE_BYTES = 8 * HTB, NXCD = 8, WGM = 8;
__device__ __forceinline__ int lds_byte(int r, int c) { const int st = (r >> 4) * 2 + (c >> 5), rr = r & 15, cc = c & 31, ob = rr * 64 + cc * 2; return st * 1024 + (ob ^ (((ob >> 9) & 1) << 5)); }
__device__ __forceinline__ void stage_rc(int b, int& R, int& C) { const int st = b / 1024, sb = b % 1024, swz = sb ^ (((sb >> 9) & 1) << 5); R = (st >> 1) * 16 + swz / 64; C = (st & 1) * 32 + (swz % 64) / 2; }
__device__ __forceinline__ int perm32(int rho) { const int n = rho >> 4, i = rho & 15; return 8 * (i >> 2) + 4 * n + (i & 3); }

struct Unit { int pm, pn, aux; };

struct StaticOrder {
    const char* A; const char* Bt; int K;
    int nM, nN, nwg, G, c;
    __device__ void init(const void* A_, const void* Bt_, int M, int N, int K_, int G_, int c_) { A = (const char*)A_; Bt = (const char*)Bt_; K = K_; nM = M / BM; nN = N / BM; nwg = nM * nN; G = G_; c = c_; }
    __device__ bool next(int i, Unit& u) const {
        const long L = (long)i * G + c; if (L >= nwg) return false;
        int wgid = (int)L; { const int q = nwg / NXCD, r = nwg % NXCD, xcd = wgid % NXCD, off = wgid / NXCD; wgid = (xcd < r ? xcd * (q + 1) : r * (q + 1) + (xcd - r) * q) + off; }
        const int nig = WGM * nN, gid = wgid / nig, fm = gid * WGM, gsz = (nM - fm) < WGM ? (nM - fm) : WGM;
        u.pm = fm + ((wgid % nig) % gsz); u.pn = (wgid % nig) / gsz; u.aux = 0; return true;
    }
    __device__ __forceinline__ const char* a_ptr(const Unit& u) const { return A + (size_t)u.pm * 256 * K * 2; }
    __device__ __forceinline__ const char* b_ptr(const Unit& u) const { return Bt + (size_t)u.pn * 256 * K * 2; }
    __device__ __forceinline__ int gather_row(const Unit&, int) const { return 0; }
    __device__ __forceinline__ const void* gather_src(const Unit&, int) const { return nullptr; }
};
struct MoeOrder {
    const char* A; const char* Bt; int K; size_t estride;
    const int* tile_e; const int* rowtok; int ntiles, nnt, G, c; bool gather;
    __device__ bool next(int i, Unit& u) const {
        int mt, nt;
        if ((G & 7) == 0 && ((G >> 3) % nnt) == 0) {
            const int x = c & 7, j = c >> 3, per = (G >> 3) / nnt;
            mt = (i * 8 + x) * per + j / nnt; nt = j % nnt;
        } else { const long L = (long)i * G + c; mt = (int)(L / nnt); nt = (int)(L % nnt); }
        if (mt >= ntiles) return false;
        u.pm = mt; u.pn = nt; u.aux = tile_e[mt]; return true;
    }
    __device__ __forceinline__ const char* a_ptr(const Unit& u) const { return gather ? A : A + (size_t)u.pm * 256 * K * 2; }
    __device__ __forceinline__ const char* b_ptr(const Unit& u) const { return Bt + (size_t)u.aux * estride + (size_t)u.pn * 256 * K * 2; }
    __device__ __forceinline__ int gather_row(const Unit& u, int r) const { return rowtok[u.pm * 256 + r]; }
    __device__ __forceinline__ const void* gather_src(const Unit& u, int lane) const { return rowtok + u.pm * 256 + lane * 4; }
};

typedef int i32x4 __attribute__((ext_vector_type(4)));
typedef int i32x8 __attribute__((ext_vector_type(8)));
template <bool GATHER, bool FP8 = false, class Epi, class Sched>
__device__ __forceinline__ void gemm_phase(LAS unsigned char* lds, const int K_, const Sched& S, const Epi& E) {
    int K = K_; asm volatile("" : "+s"(K));
    const int tid = threadIdx.x, wid = __builtin_amdgcn_readfirstlane(tid >> 6), lane = tid & 63, wr = wid >> 2, wc = wid & 3, fr = lane & 15, fq = lane >> 4;
    const int nt = K / BK;
    unsigned voffA[2], voffB[2]; int Rr[2], Cc[2];
#pragma unroll
    for (int i = 0; i < 2; ++i) { int R, C; stage_rc(tid * 16 + i * 8192, R, C); const int Rb = (R & ~31) + perm32(R & 31);
        Rr[i] = R; Cc[i] = C; voffA[i] = (unsigned)(R * K + C) * 2u; voffB[i] = (unsigned)(Rb * K + C) * 2u; }
    const size_t kstep = (size_t)(BK * 2);
    const size_t hstep = (size_t)HALF * K * 2;
    const unsigned ldsw = (unsigned)wid * 1024u;
    const int aoff = lds_byte(wr * 64 + fr, fq * 8), boff = lds_byte(wc * 32 + fr, fq * 8);
    unsigned vgc[2][2], vgn[2][2];
    LAS unsigned char* const parbase = lds + STAGE_BYTES;
    constexpr int NPAR = Epi::NPAR;
#define G_PAR_ISSUE(unit, uidx, hasnx, nxunit) do { \
        LAS unsigned char* _ps = parbase + ((uidx) & 1) * 4096; \
        if (wid < NPAR) __builtin_amdgcn_global_load_lds((const unsigned*)E.par_src(unit, wid, lane), (LAS unsigned*)(_ps + wid * 1024), 16, 0, 0); \
        if (GATHER && (hasnx) && wid == NPAR) __builtin_amdgcn_global_load_lds((const unsigned*)S.gather_src(nxunit, lane), (LAS unsigned*)(_ps + NPAR * 1024), 16, 0, 0); } while (0)
#define G_CAT8(x0, x1) __builtin_shufflevector(__builtin_bit_cast(i32x4, x0), __builtin_bit_cast(i32x4, x1), 0, 1, 2, 3, 4, 5, 6, 7)
#define G_SA(b, h) (((b) * 2 + (h)) * HTB)
#define G_SB(b, h) ((4 + (b) * 2 + (h)) * HTB)
#define G_STAGE(bufoff, gbase, voff) do { _Pragma("unroll") for (int _i = 0; _i < 2; ++_i) \
        __builtin_amdgcn_global_load_lds((const unsigned*)((const char*)(gbase) + (voff)[_i]), (LAS unsigned*)(lds + (bufoff) + ldsw + _i * 8192), 16, 0, 0); } while (0)
#define G_STAGE_A(bufoff, kptr, h, VG) do { if (GATHER) { G_STAGE(bufoff, kptr, VG[h]); } else { G_STAGE(bufoff, (kptr) + (h) * hstep, voffA); } } while (0)
#define G_LDA(dst, b, h) do { _Pragma("unroll") for (int m = 0; m < 4; ++m) { \
        if (FP8) dst##8[m] = G_CAT8(*(const LAS bf16x8*)(lds + G_SA(b, h) + aoff + m * 2048), *(const LAS bf16x8*)(lds + G_SA(b, h) + aoff + m * 2048 + 1024)); \
        else { _Pragma("unroll") for (int k = 0; k < 2; ++k) dst[m][k] = *(const LAS bf16x8*)(lds + G_SA(b, h) + aoff + m * 2048 + k * 1024); } } } while (0)
#define G_LDB(dst, b, h) do { _Pragma("unroll") for (int n = 0; n < 2; ++n) { \
        if (FP8) dst##8[n] = G_CAT8(*(const LAS bf16x8*)(lds + G_SB(b, h) + boff + n * 2048), *(const LAS bf16x8*)(lds + G_SB(b, h) + boff + n * 2048 + 1024)); \
        else { _Pragma("unroll") for (int k = 0; k < 2; ++k) dst[n][k] = *(const LAS bf16x8*)(lds + G_SB(b, h) + boff + n * 2048 + k * 1024); } } } while (0)
#define G_MMA(ai, bj, At, Bt) do { __builtin_amdgcn_s_setprio(1); _Pragma("unroll") for (int m = 0; m < 4; ++m) _Pragma("unroll") for (int n = 0; n < 2; ++n) { \
        if (FP8) asm volatile("v_mfma_scale_f32_16x16x128_f8f6f4 %0, %1, %2, %0, %3, %3 op_sel_hi:[0,0,0]" : "+v"(acc[ai][bj][m][n]) : "v"(Bt##8[n]), "v"(At##8[m]), "v"(sc8)); \
        else { _Pragma("unroll") for (int k = 0; k < 2; ++k) acc[ai][bj][m][n] = __builtin_amdgcn_mfma_f32_16x16x32_bf16(Bt[n][k], At[m][k], acc[ai][bj][m][n], 0, 0, 0); } } \
        __builtin_amdgcn_s_setprio(0); } while (0)
#define G_WAIT_V(n) asm volatile("s_waitcnt vmcnt(" #n ")" ::: "memory")
#define G_WAIT_L(n) asm volatile("s_waitcnt lgkmcnt(" #n ")" ::: "memory")
#define G_BAR __builtin_amdgcn_s_barrier()
#define G_SCHED __builtin_amdgcn_sched_barrier(0)
    Unit cur, nxt;
    int ui = 0;
    if (!S.next(0, cur)) return;
    f32x4 acc[2][2][4][2];
#pragma unroll
    for (int a = 0; a < 2; ++a)
#pragma unroll
        for (int b = 0; b < 2; ++b)
#pragma unroll
            for (int m = 0; m < 4; ++m)
#pragma unroll
                for (int n = 0; n < 2; ++n) acc[a][b][m][n] = (f32x4){0.f, 0.f, 0.f, 0.f};
    bf16x8 At[4][2], B0[2][2], B1[2][2];
    i32x8 At8[4], B08[2], B18[2];
    int sc8 = 0x7F7F7F7F; asm volatile("" : "+v"(sc8));
    const char* cA = S.a_ptr(cur); const char* cB = S.b_ptr(cur);
    if (GATHER) {
#pragma unroll
        for (int h = 0; h < 2; ++h)
#pragma unroll
            for (int i = 0; i < 2; ++i) vgc[h][i] = (unsigned)(S.gather_row(cur, h * HALF + Rr[i]) * K + Cc[i]) * 2u;
    }
    { Unit n1; const bool hn1 = S.next(1, n1); G_PAR_ISSUE(cur, 0, hn1, n1); }
    G_STAGE(G_SB(0, 0), cB, voffB); G_STAGE_A(G_SA(0, 0), cA, 0, vgc); G_STAGE(G_SB(0, 1), cB + hstep, voffB); G_STAGE_A(G_SA(0, 1), cA, 1, vgc);
    if (wr == 1) G_BAR;
    G_WAIT_V(4); G_BAR;
    G_STAGE(G_SB(1, 0), cB + kstep, voffB); G_STAGE_A(G_SA(1, 0), cA + kstep, 0, vgc); G_STAGE(G_SB(1, 1), cB + hstep + kstep, voffB);
    G_WAIT_V(6); G_BAR;
    for (;;) {
        const bool has_next = S.next(ui + 1, nxt);
        const char* nA = has_next ? S.a_ptr(nxt) : cA; const char* nB = has_next ? S.b_ptr(nxt) : cB;
        if (ui > 0) G_PAR_ISSUE(cur, ui, has_next, nxt);
        if (GATHER) {
#pragma unroll
            for (int h = 0; h < 2; ++h)
#pragma unroll
                for (int i = 0; i < 2; ++i) vgn[h][i] = vgc[h][i];
        }
        for (int t = 0; t < nt; t += 2) {
            const bool last = (t == nt - 2);
            const char* a1 = cA + (size_t)(t + 1) * kstep;
            const char* a2 = last ? nA : cA + (size_t)(t + 2) * kstep; const char* b2 = last ? nB : cB + (size_t)(t + 2) * kstep;
            const char* a3 = a2 + kstep; const char* b3 = b2 + kstep;
            unsigned vg2[2][2];
            if (GATHER) {
#pragma unroll
                for (int h = 0; h < 2; ++h)
#pragma unroll
                    for (int i = 0; i < 2; ++i) vg2[h][i] = last ? vgn[h][i] : vgc[h][i];
            }
            G_LDB(B0, 0, 0); G_SCHED; G_LDA(At, 0, 0); G_STAGE_A(G_SA(1, 1), a1, 1, vgc);
            G_WAIT_L(8); G_BAR; G_WAIT_L(0); G_MMA(0, 0, At, B0); G_BAR; G_SCHED;
            G_LDB(B1, 0, 1); G_STAGE(G_SB(0, 0), b2, voffB);
            G_BAR; G_WAIT_L(0); G_MMA(0, 1, At, B1); G_BAR;
            G_LDA(At, 0, 1); G_STAGE_A(G_SA(0, 0), a2, 0, vg2);
            G_BAR; G_WAIT_L(0); G_MMA(1, 0, At, B0); G_BAR; G_SCHED;
            G_STAGE(G_SB(0, 1), b2 + hstep, voffB);
            G_WAIT_V(6); G_BAR; G_MMA(1, 1, At, B1); G_BAR;
            G_LDB(B0, 1, 0); G_SCHED; G_LDA(At, 1, 0); G_STAGE_A(G_SA(0, 1), a2, 1, vg2);
            G_WAIT_L(8); G_BAR; G_WAIT_L(0); G_MMA(0, 0, At, B0); G_BAR; G_SCHED;
            G_LDB(B1, 1, 1); G_STAGE(G_SB(1, 0), b3, voffB);
            G_BAR; G_WAIT_L(0); G_MMA(0, 1, At, B1); G_BAR;
            G_LDA(At, 1, 1); G_STAGE_A(G_SA(1, 0), a3, 0, vg2);
            G_BAR; G_WAIT_L(0); G_MMA(1, 0, At, B0); G_BAR; G_SCHED;
            G_STAGE(G_SB(1, 1), b3 + hstep, voffB);
            G_WAIT_V(6); G_BAR; G_MMA(1, 1, At, B1); G_BAR;
            if (GATHER && t == 0 && has_next) {
                const LAS int* rows = (const LAS int*)(parbase + (ui & 1) * 4096 + NPAR * 1024);
#pragma unroll
                for (int h = 0; h < 2; ++h)
#pragma unroll
                    for (int i = 0; i < 2; ++i) vgn[h][i] = (unsigned)(rows[h * HALF + Rr[i]] * K + Cc[i]) * 2u;
            }
        }
        if (FP8) asm volatile("s_nop 15\n\ts_nop 15" ::: "memory");
        const bool keep_acc = E(acc, cur, wr, wc, fr, fq, (const LAS unsigned char*)(parbase + (ui & 1) * 4096));
        if (!has_next) break;
        if (!keep_acc)
#pragma unroll
        for (int a = 0; a < 2; ++a)
#pragma unroll
            for (int b = 0; b < 2; ++b)
#pragma unroll
                for (int m = 0; m < 4; ++m)
#pragma unroll
                    for (int n = 0; n < 2; ++n) acc[a][b][m][n] = (f32x4){0.f, 0.f, 0.f, 0.f};
        cur = nxt; cA = nA; cB = nB; ++ui;
        if (GATHER) {
#pragma unroll
            for (int h = 0; h < 2; ++h)
#pragma unroll
                for (int i = 0; i < 2; ++i) vgc[h][i] = vgn[h][i];
        }
    }
    G_WAIT_V(0);
    if (wr == 0) G_BAR;
    G_BAR;
#undef G_PAR_ISSUE
#undef G_SA
#undef G_SB
#undef G_STAGE
#undef G_STAGE_A
#undef G_LDA
#undef G_LDB
#undef G_MMA
#undef G_CAT8
#undef G_WAIT_V
#undef G_WAIT_L
#undef G_BAR
#undef G_SCHED
}

struct EpiProj {
    bf16_t* prkv; bf16_t* pconv; bf16_t* gates; const float* rstd1;
    static constexpr int NPAR = 1;
    __device__ __forceinline__ const void* par_src(const Unit& u, int, int lane) const { return rstd1 + NMETA + u.pm * BM + lane * 4; }
    __device__ __forceinline__ bool operator()(const f32x4 (&acc)[2][2][4][2], const Unit& u, int wr, int wc, int fr, int fq, const LAS unsigned char* par) const {
        const int row0 = u.pm * BM + wr * 64 + fr;
        const bool isg = u.pn >= 14;
        float rsv[2][4];
#pragma unroll
        for (int ai = 0; ai < 2; ++ai)
#pragma unroll
            for (int m = 0; m < 4; ++m) rsv[ai][m] = ((const LAS float*)par)[wr * 64 + fr + ai * HALF + m * 16];
#pragma unroll
        for (int ai = 0; ai < 2; ++ai)
#pragma unroll
            for (int m = 0; m < 4; ++m) {
                const int row = row0 + ai * HALF + m * 16;
                const float rs = rsv[ai][m];
                bf16_t* rowp = isg ? gates + (size_t)row * 2048 + (u.pn - 14) * 256 + wc * 32 + 8 * fq
                             : (u.pn < 6 ? prkv + (size_t)(NMETA + row) * 1536 + u.pn * 256 : pconv + (size_t)(NMETA + row) * 2048 + (u.pn - 6) * 256) + wc * 32 + 8 * fq;
#pragma unroll
                for (int bj = 0; bj < 2; ++bj) {
                    f32x4 v0 = acc[ai][bj][m][0] * rs, v1 = acc[ai][bj][m][1] * rs;
                    if (isg) {
#pragma unroll
                        for (int j = 0; j < 4; ++j) { v0[j] = sigmoidf_(v0[j]); v1[j] = sigmoidf_(v1[j]); }
                    }
                    u32x4 w; w.x = cvt_pk_bf16(v0[0], v0[1]); w.y = cvt_pk_bf16(v0[2], v0[3]); w.z = cvt_pk_bf16(v1[0], v1[1]); w.w = cvt_pk_bf16(v1[2], v1[3]);
                    *(u32x4*)(rowp + bj * HALF) = w;
                }
            }
        return false;
    }
};
struct EpiL {
    static constexpr int NPAR = 0;
    __device__ __forceinline__ const void* par_src(const Unit&, int, int) const { return nullptr; }
    unsigned char* wsb; const float* w0; const float* a0;
    __device__ __forceinline__ bool operator()(const f32x4 (&acc)[2][2][4][2], const Unit& u, int wr, int wc, int fr, int fq, const LAS unsigned char* par) const {
        const int row0 = NMETA + u.pm * BM + wr * 64 + fr;
        const int seg = u.pn >> 1;
        const int cb = (u.pn & 1) * 256 + wc * 32 + 8 * fq;
        const float* bias = seg == 0 ? w0 : a0;
        f32x4 bv[2][2];
#pragma unroll
        for (int bj = 0; bj < 2; ++bj) {
            bv[bj][0] = seg < 2 ? *(const f32x4*)(bias + cb + bj * HALF) : (f32x4){0.f, 0.f, 0.f, 0.f};
            bv[bj][1] = seg < 2 ? *(const f32x4*)(bias + cb + bj * HALF + 4) : (f32x4){0.f, 0.f, 0.f, 0.f};
        }
        const float sc = seg == 0 ? -0.60653065971f : 1.0f;
        bf16_t* ob = (bf16_t*)(wsb + (seg == 0 ? OFF_LD : seg == 1 ? OFF_A : OFF_G));
#pragma unroll
        for (int ai = 0; ai < 2; ++ai)
#pragma unroll
            for (int m = 0; m < 4; ++m) {
                const int row = row0 + ai * HALF + m * 16;
#pragma unroll
                for (int bj = 0; bj < 2; ++bj) {
                    const int c = cb + bj * HALF;
                    f32x4 v0 = acc[ai][bj][m][0] + bv[bj][0], v1 = acc[ai][bj][m][1] + bv[bj][1];
                    if (seg < 2) {
#pragma unroll
                        for (int j = 0; j < 4; ++j) { v0[j] = sc * sigmoidf_(v0[j]); v1[j] = sc * sigmoidf_(v1[j]); }
                    }
                    {
                        u32x4 w; w.x = cvt_pk_bf16(v0[0], v0[1]); w.y = cvt_pk_bf16(v0[2], v0[3]); w.z = cvt_pk_bf16(v1[0], v1[1]); w.w = cvt_pk_bf16(v1[2], v1[3]);
                        *(u32x4*)(ob + (size_t)row * 512 + c) = w;
                    }
                }
            }
        return false;
    }
};
template <int SECOND> struct EpiMerge {
    static constexpr int NPAR = 0;
    __device__ __forceinline__ const void* par_src(const Unit&, int, int) const { return nullptr; }
    bf16_t* merged; const bf16_t* gates;
    __device__ __forceinline__ bool operator()(const f32x4 (&acc)[2][2][4][2], const Unit& u, int wr, int wc, int fr, int fq, const LAS unsigned char* par) const {
        const int row0 = u.pm * BM + wr * 64 + fr, col0 = u.pn * BM + wc * 32 + 8 * fq;
#pragma unroll
        for (int ai = 0; ai < 2; ++ai)
#pragma unroll
            for (int m = 0; m < 4; ++m) {
                const int row = row0 + ai * HALF + m * 16;
#pragma unroll
                for (int bj = 0; bj < 2; ++bj) {
                    const int c = col0 + bj * HALF;
                    const u32x4 gw = *(const u32x4*)(gates + (size_t)row * 2048 + SECOND * 1024 + c);
                    f32x4 g0 = (f32x4){bflo(gw.x), bfhi(gw.x), bflo(gw.y), bfhi(gw.y)}, g1 = (f32x4){bflo(gw.z), bfhi(gw.z), bflo(gw.w), bfhi(gw.w)};
                    f32x4 v0 = acc[ai][bj][m][0] * g0, v1 = acc[ai][bj][m][1] * g1;
                    bf16_t* p = merged + (size_t)row * 1024 + c;
                    if (SECOND) {
                        const u32x4 ow = *(const u32x4*)p;
                        v0 += (f32x4){bflo(ow.x), bfhi(ow.x), bflo(ow.y), bfhi(ow.y)}; v1 += (f32x4){bflo(ow.z), bfhi(ow.z), bflo(ow.w), bfhi(ow.w)};
                    }
                    u32x4 w; w.x = cvt_pk_bf16(v0[0], v0[1]); w.y = cvt_pk_bf16(v0[2], v0[3]); w.z = cvt_pk_bf16(v1[0], v1[1]); w.w = cvt_pk_bf16(v1[2], v1[3]);
                    *(u32x4*)p = w;
                }
            }
        return false;
    }
};
struct MergeOrder {
    StaticOrder so; const char* A1; const char* B1;
    __device__ bool next(int i, Unit& u) const { const bool ok = so.next(i >> 1, u); u.aux = i & 1; return ok; }
    __device__ __forceinline__ const char* a_ptr(const Unit& u) const { return (u.aux ? A1 : so.A) + (size_t)u.pm * 256 * so.K * 2; }
    __device__ __forceinline__ const char* b_ptr(const Unit& u) const { return (u.aux ? B1 : so.Bt) + (size_t)u.pn * 256 * so.K * 2; }
    __device__ __forceinline__ int gather_row(const Unit&, int) const { return 0; }
    __device__ __forceinline__ const void* gather_src(const Unit&, int) const { return nullptr; }
};
struct EpiMergeFused {
    static constexpr int NPAR = 0;
    __device__ __forceinline__ const void* par_src(const Unit&, int, int) const { return nullptr; }
    bf16_t* merged; const bf16_t* gates;
    __device__ __forceinline__ bool operator()(f32x4 (&acc)[2][2][4][2], const Unit& u, int wr, int wc, int fr, int fq, const LAS unsigned char* par) const {
        const int row0 = u.pm * BM + wr * 64 + fr, col0 = u.pn * BM + wc * 32 + 8 * fq;
#pragma unroll
        for (int ai = 0; ai < 2; ++ai) {
            u32x4 gbw[4][2], gaw[4][2];
#pragma unroll
            for (int m = 0; m < 4; ++m)
#pragma unroll
                for (int bj = 0; bj < 2; ++bj) {
                    const bf16_t* gp = gates + (size_t)(row0 + ai * HALF + m * 16) * 2048 + col0 + bj * HALF;
                    gbw[m][bj] = *(const u32x4*)(gp + 1024);
                    gaw[m][bj] = u.aux == 0 ? *(const u32x4*)gp : (u32x4){0u, 0u, 0u, 0u};
                }
#pragma unroll
            for (int m = 0; m < 4; ++m)
#pragma unroll
                for (int bj = 0; bj < 2; ++bj) {
                    const int row = row0 + ai * HALF + m * 16, c = col0 + bj * HALF;
                    f32x4 gb0 = (f32x4){bflo(gbw[m][bj].x), bfhi(gbw[m][bj].x), bflo(gbw[m][bj].y), bfhi(gbw[m][bj].y)}, gb1 = (f32x4){bflo(gbw[m][bj].z), bfhi(gbw[m][bj].z), bflo(gbw[m][bj].w), bfhi(gbw[m][bj].w)};
#pragma unroll
                    for (int j = 0; j < 4; ++j) { gb0[j] = fmaxf(gb0[j], 1e-6f); gb1[j] = fmaxf(gb1[j], 1e-6f); }
                    if (u.aux == 0) {
                        const f32x4 ga0 = (f32x4){bflo(gaw[m][bj].x), bfhi(gaw[m][bj].x), bflo(gaw[m][bj].y), bfhi(gaw[m][bj].y)}, ga1 = (f32x4){bflo(gaw[m][bj].z), bfhi(gaw[m][bj].z), bflo(gaw[m][bj].w), bfhi(gaw[m][bj].w)};
#pragma unroll
                        for (int j = 0; j < 4; ++j) { acc[ai][bj][m][0][j] *= ga0[j] * __builtin_amdgcn_rcpf(gb0[j]); acc[ai][bj][m][1][j] *= ga1[j] * __builtin_amdgcn_rcpf(gb1[j]); }
                    } else {
                        const f32x4 v0 = acc[ai][bj][m][0] * gb0, v1 = acc[ai][bj][m][1] * gb1;
                        u32x4 w; w.x = cvt_pk_bf16(v0[0], v0[1]); w.y = cvt_pk_bf16(v0[2], v0[3]); w.z = cvt_pk_bf16(v1[0], v1[1]); w.w = cvt_pk_bf16(v1[2], v1[3]);
                        *(u32x4*)(merged + (size_t)row * 1024 + c) = w;
                    }
                }
        }
        return u.aux == 0;
    }
};
struct EpiO {
    static constexpr int NPAR = 0;
    __device__ __forceinline__ const void* par_src(const Unit&, int, int) const { return nullptr; }
    const float* x; float* h1; bf16_t* hb2; unsigned char* hb8;
    __device__ __forceinline__ bool operator()(const f32x4 (&acc)[2][2][4][2], const Unit& u, int wr, int wc, int fr, int fq, const LAS unsigned char* par) const {
        const int row0 = u.pm * BM + wr * 64 + fr, col0 = u.pn * BM + wc * 32 + 8 * fq;
#pragma unroll
        for (int ai = 0; ai < 2; ++ai) {
            f32x4 xv[4][2][2];
#pragma unroll
            for (int m = 0; m < 4; ++m)
#pragma unroll
                for (int bj = 0; bj < 2; ++bj) {
                    const size_t o = (size_t)(row0 + ai * HALF + m * 16) * 1024 + col0 + bj * HALF;
                    xv[m][bj][0] = *(const f32x4*)(x + o); xv[m][bj][1] = *(const f32x4*)(x + o + 4);
                }
#pragma unroll
            for (int m = 0; m < 4; ++m)
#pragma unroll
                for (int bj = 0; bj < 2; ++bj) {
                    const size_t o = (size_t)(row0 + ai * HALF + m * 16) * 1024 + col0 + bj * HALF;
                    const f32x4 v0 = acc[ai][bj][m][0] + xv[m][bj][0], v1 = acc[ai][bj][m][1] + xv[m][bj][1];
                    u32x4 w; w.x = cvt_pk_bf16(v0[0], v0[1]); w.y = cvt_pk_bf16(v0[2], v0[3]); w.z = cvt_pk_bf16(v1[0], v1[1]); w.w = cvt_pk_bf16(v1[2], v1[3]);
                    *(u32x4*)(hb2 + o) = w;
                    u32x2 w8; w8.x = pk4_fp8(v0[0], v0[1], v0[2], v0[3]); w8.y = pk4_fp8(v1[0], v1[1], v1[2], v1[3]);
                    *(u32x2*)(hb8 + o) = w8;
                }
        }
        return false;
    }
};
struct EpiMoe1 {
    unsigned char* act; const float* rowrs; const float* bg; const float* bu;
    static constexpr int NPAR = 2;
    __device__ __forceinline__ const void* par_src(const Unit& u, int piece, int lane) const {
        if (piece == 0) return rowrs + u.pm * BM + lane * 4;
        return (lane < 32 ? bg : bu) + (size_t)u.aux * DFF + u.pn * 128 + (lane & 31) * 4;
    }
    __device__ __forceinline__ bool operator()(const f32x4 (&acc)[2][2][4][2], const Unit& u, int wr, int wc, int fr, int fq, const LAS unsigned char* par) const {
        const int row0 = u.pm * BM + wr * 64 + fr, ff0 = u.pn * 128 + wc * 32 + 8 * fq;
        const LAS float* bgp = (const LAS float*)(par + 1024) + wc * 32 + 8 * fq; const LAS float* bup = bgp + 128;
        const f32x4 bg0 = *(const LAS f32x4*)bgp, bg1 = *(const LAS f32x4*)(bgp + 4), bu0 = *(const LAS f32x4*)bup, bu1 = *(const LAS f32x4*)(bup + 4);
        float rsv[2][4];
#pragma unroll
        for (int ai = 0; ai < 2; ++ai)
#pragma unroll
            for (int m = 0; m < 4; ++m) rsv[ai][m] = ((const LAS float*)par)[wr * 64 + fr + ai * HALF + m * 16];
#pragma unroll
        for (int ai = 0; ai < 2; ++ai)
#pragma unroll
            for (int m = 0; m < 4; ++m) {
                const int row = row0 + ai * HALF + m * 16;
                const float rs = rsv[ai][m] * W8_INV;
                f32x4 g0 = acc[ai][0][m][0] * rs + bg0, g1 = acc[ai][0][m][1] * rs + bg1, u0 = acc[ai][1][m][0] * rs + bu0, u1 = acc[ai][1][m][1] * rs + bu1;
                f32x4 r0, r1;
#pragma unroll
                for (int j = 0; j < 4; ++j) {
                    { const float gt = fminf(g0[j], 7.0f), up = fminf(fmaxf(u0[j], -7.0f), 7.0f); r0[j] = (up + 1.0f) * gt * sigmoidf_(1.702f * gt); }
                    { const float gt = fminf(g1[j], 7.0f), up = fminf(fmaxf(u1[j], -7.0f), 7.0f); r1[j] = (up + 1.0f) * gt * sigmoidf_(1.702f * gt); }
                }
                u32x2 w; w.x = pk4_fp8(r0[0], r0[1], r0[2], r0[3]); w.y = pk4_fp8(r1[0], r1[1], r1[2], r1[3]);
                *(u32x2*)(act + (size_t)row * DFF + ff0) = w;
            }
        return false;
    }
};
struct EpiMoe2 {
    bf16_t* ya; bf16_t* yb; const int* rowslot; const float* roww; const float* bd;
    static constexpr int NPAR = 3;
    __device__ __forceinline__ const void* par_src(const Unit& u, int piece, int lane) const {
        if (piece == 0) return rowslot + u.pm * BM + lane * 4;
        if (piece == 1) return roww + u.pm * BM + lane * 4;
        return bd + (size_t)u.aux * D + u.pn * BM + lane * 4;
    }
    __device__ __forceinline__ bool operator()(const f32x4 (&acc)[2][2][4][2], const Unit& u, int wr, int wc, int fr, int fq, const LAS unsigned char* par) const {
        const int row0 = u.pm * BM + wr * 64 + fr, col0 = u.pn * BM + wc * 32 + 8 * fq;
        bf16_t* ybase = (u.pn < 2) ? ya : yb; const int yc0 = col0 & 511;
        const LAS float* bp = (const LAS float*)(par + 2048) + wc * 32 + 8 * fq;
        f32x4 bv[2][2];
#pragma unroll
        for (int bj = 0; bj < 2; ++bj) { bv[bj][0] = *(const LAS f32x4*)(bp + bj * HALF); bv[bj][1] = *(const LAS f32x4*)(bp + bj * HALF + 4); }
        int slotv[2][4]; float wv8[2][4];
#pragma unroll
        for (int ai = 0; ai < 2; ++ai)
#pragma unroll
            for (int m = 0; m < 4; ++m) { const int rl = wr * 64 + fr + ai * HALF + m * 16; slotv[ai][m] = ((const LAS int*)par)[rl]; wv8[ai][m] = ((const LAS float*)(par + 1024))[rl]; }
#pragma unroll
        for (int ai = 0; ai < 2; ++ai)
#pragma unroll
            for (int m = 0; m < 4; ++m) {
                const int slot = slotv[ai][m];
                if (slot >= 0) {
                    const float w8 = wv8[ai][m];
#pragma unroll
                    for (int bj = 0; bj < 2; ++bj) {
                        const f32x4 v0 = (acc[ai][bj][m][0] * W8_INV + bv[bj][0]) * w8, v1 = (acc[ai][bj][m][1] * W8_INV + bv[bj][1]) * w8;
                        u32x4 w; w.x = cvt_pk_bf16(v0[0], v0[1]); w.y = cvt_pk_bf16(v0[2], v0[3]); w.z = cvt_pk_bf16(v1[0], v1[1]); w.w = cvt_pk_bf16(v1[2], v1[3]);
                        *(u32x4*)(ybase + (size_t)slot * 512 + yc0 + bj * HALF) = w;
                    }
                }
            }
        return false;
    }
};

__device__ __forceinline__ void transpose_tile(LAS float* tile, const float* src, int ldsrc, int k0, int n0, bf16_t* dst, int ldd, int drow0, const float* sa, const float* mu, int mode, bool zero) {
    const int tid = threadIdx.x;
    if (!zero) {
#pragma unroll
        for (int i = 0; i < 2; ++i) {
            const int r = (tid >> 4) + 32 * i, c4 = (tid & 15) * 4;
            const f32x4 v = *(const f32x4*)(src + (size_t)(k0 + r) * ldsrc + n0 + c4);
            LAS float* t = tile + r * 65 + c4;
            t[0] = v[0]; t[1] = v[1]; t[2] = v[2]; t[3] = v[3];
        }
    }
    __syncthreads();
    {
        const int n = tid >> 3, kq = tid & 7;
        float v[8];
#pragma unroll
        for (int j = 0; j < 8; ++j) {
            const int k = k0 + 8 * kq + j;
            float s = sa ? sa[k] : 1.0f;
            if (mode == 1) s *= (1.0f - mu[k]);
            if (mode == 2) s *= mu[k];
            v[j] = zero ? 0.f : tile[(8 * kq + j) * 65 + n] * s;
        }
        u32x4 w; w.x = cvt_pk_bf16(v[0], v[1]); w.y = cvt_pk_bf16(v[2], v[3]); w.z = cvt_pk_bf16(v[4], v[5]); w.w = cvt_pk_bf16(v[6], v[7]);
        *(u32x4*)(dst + (size_t)(drow0 + n) * ldd + k0 + 8 * kq) = w;
    }
    __syncthreads();
}

__device__ __forceinline__ void phase_prep(const PPv& p, LAS unsigned char* lds) {
    const int tid = threadIdx.x, bid = blockIdx.x, nb = gridDim.x, lane = tid & 63, wave = tid >> 6;
    unsigned char* ws = p.gws();
    const float* x = p.gin(0); const float* meta = p.gin(1); const float* g1 = p.gin(2);
    if (bid == 0 && tid < 64) ((int*)(ws + OFF_GCNT))[tid] = 0;
    {
        bf16_t* HB = (bf16_t*)(ws + OFF_HB); float* rstd1 = (float*)(ws + OFF_RSTD1);
        for (int row0 = (bid * 8 + wave) * 4; row0 < NR; row0 += nb * 32) {
            f32x4 v[4][4];
#pragma unroll
            for (int u = 0; u < 4; ++u) {
                const int row = row0 + u < NR ? row0 + u : NR - 1;
                const float* src = row < NMETA ? meta + (size_t)row * D : x + (size_t)(row - NMETA) * D;
#pragma unroll
                for (int i = 0; i < 4; ++i) v[u][i] = __builtin_nontemporal_load((const f32x4*)(src + i * 256 + lane * 4));
            }
#pragma unroll
            for (int u = 0; u < 4; ++u) {
                const int row = row0 + u;
                if (row < NR) {
                    float ss = 0.f;
#pragma unroll
                    for (int i = 0; i < 4; ++i) ss += v[u][i][0] * v[u][i][0] + v[u][i][1] * v[u][i][1] + v[u][i][2] * v[u][i][2] + v[u][i][3] * v[u][i][3];
                    ss = wave_sum_dpp(ss);
                    if (lane == 0) rstd1[row] = rsqrtf(ss * (1.0f / D) + NORM_EPS);
                    if (row >= NMETA) {
                        bf16_t* d = HB + (size_t)(row - NMETA) * D;
#pragma unroll
                        for (int i = 0; i < 4; ++i) { u32x2 w; w.x = cvt_pk_bf16(v[u][i][0], v[u][i][1]); w.y = cvt_pk_bf16(v[u][i][2], v[u][i][3]); *(u32x2*)(d + i * 256 + lane * 4) = w; }
                    }
                }
            }
        }
    }
    LAS float* tile = (LAS float*)lds;
    {
        bf16_t* WIN = (bf16_t*)(ws + OFF_WIN);
        const float* w_in = p.gin(3);
        for (int j = bid; j < 16 * 88; j += nb) {
            const int kt = j & 15, ntile = j >> 4, n0 = ntile * 64;
            const float* src; int ld, sn0, mode = 0; const float* mu = nullptr;
            if (n0 < 3072) { src = w_in; ld = 5120; sn0 = n0; }
            else if (n0 < 3584) {
                const int seg = (n0 - 3072) >> 6;
                if (seg < 2) { src = p.gin(11); ld = 64; sn0 = 0; mu = p.gin(7); mode = 1 + seg; }
                else if (seg < 4) { src = p.gin(14); ld = 64; sn0 = 0; mu = p.gin(8); mode = 1 + (seg - 2); }
                else { src = p.gin(16); ld = 128; sn0 = (seg & 1) * 64; mu = p.gin(9); mode = seg < 6 ? 1 : 2; }
            } else { src = w_in; ld = 5120; sn0 = n0 - 512; }
            transpose_tile(tile, src, ld, kt * 64, sn0, WIN, 1024, n0, g1, mu, mode, false);
        }
        for (int j = bid; j < 2 * 128; j += nb) {
            const int which = j >> 7, jj = j & 127, kt = jj & 7, ntile = jj >> 3;
            transpose_tile(tile, which ? p.gin(25) : p.gin(23), 1024, kt * 64, ntile * 64, (bf16_t*)(ws + (which ? OFF_WC : OFF_WR)), 512, ntile * 64, nullptr, nullptr, 0, false);
        }
        for (int j = bid; j < 256; j += nb) {
            const int kt = j & 15, ntile = j >> 4;
            transpose_tile(tile, p.gin(26), 1024, kt * 64, ntile * 64, (bf16_t*)(ws + OFF_WO), 1024, ntile * 64, nullptr, nullptr, 0, false);
        }
        for (int j = bid; j < 96; j += nb) {
            const int kt = j & 3, ntile = j >> 2, seg = ntile >> 3, nn0 = (ntile & 7) * 64;
            const float* src = nullptr; int sk0 = 0; bool zero = true;
            if (seg == 0 && kt == 0) { src = p.gin(12); sk0 = 0; zero = false; }
            if (seg == 1 && kt == 1) { src = p.gin(15); sk0 = 0; zero = false; }
            if (seg == 2 && kt >= 2) { src = p.gin(17); sk0 = (kt - 2) * 64; zero = false; }
            const float* srcs = zero ? p.gin(12) : src + (size_t)(sk0 - kt * 64) * 512;
            transpose_tile(tile, srcs, 512, kt * 64, nn0, (bf16_t*)(ws + OFF_W2), 256, ntile * 64, nullptr, nullptr, 0, zero);
        }
        {
            float* WRG = (float*)(ws + OFF_WRG); const float* g2 = p.gin(27); const float* wr_ = p.gin(28);
            for (int i = bid * 512 + tid; i < 1024 * 32; i += nb * 512) WRG[i] = g2[i >> 5] * wr_[i];
        }
    }
}

__device__ __forceinline__ void phase_meta_proj(const PPv& p, LAS unsigned char* lds) {
    const int tid = threadIdx.x, bid = blockIdx.x, lane = tid & 63, wave = tid >> 6;
    unsigned char* ws = p.gws();
    LAS float* sm = (LAS float*)lds;
    const float* meta = p.gin(1);
    for (int i = tid; i < 16 * 256; i += 512) { const int r = i >> 8, c4 = (i & 255) * 4; const f32x4 v = *(const f32x4*)(meta + r * 1024 + c4); LAS float* d = sm + r * 1028 + c4; d[0] = v[0]; d[1] = v[1]; d[2] = v[2]; d[3] = v[3]; }
    __syncthreads();
    const float* rstd1 = (const float*)(ws + OFF_RSTD1);
    for (int nbase = bid * 14; nbase < PCOLS1; nbase += gridDim.x * 14) {
        for (int nn = wave; nn < 14; nn += 8) {
            const int n = nbase + nn;
            if (n >= PCOLS1) break;
            const bf16_t* wrow = (const bf16_t*)(ws + OFF_WIN) + (size_t)n * 1024;
            const u32x4 w0 = *(const u32x4*)(wrow + 8 * lane), w1 = *(const u32x4*)(wrow + 512 + 8 * lane);
            const float wf[16] = {bflo(w0.x), bfhi(w0.x), bflo(w0.y), bfhi(w0.y), bflo(w0.z), bfhi(w0.z), bflo(w0.w), bfhi(w0.w),
                                  bflo(w1.x), bfhi(w1.x), bflo(w1.y), bfhi(w1.y), bflo(w1.z), bfhi(w1.z), bflo(w1.w), bfhi(w1.w)};
            float outv = 0.f;
#pragma unroll
            for (int pr = 0; pr < 16; ++pr) {
                const LAS float* m0 = sm + pr * 1028 + 8 * lane;
                const f32x4 a0 = *(const LAS f32x4*)m0, a1 = *(const LAS f32x4*)(m0 + 4), a2 = *(const LAS f32x4*)(m0 + 512), a3 = *(const LAS f32x4*)(m0 + 516);
                float acc = a0[0] * wf[0] + a0[1] * wf[1] + a0[2] * wf[2] + a0[3] * wf[3] + a1[0] * wf[4] + a1[1] * wf[5] + a1[2] * wf[6] + a1[3] * wf[7]
                          + a2[0] * wf[8] + a2[1] * wf[9] + a2[2] * wf[10] + a2[3] * wf[11] + a3[0] * wf[12] + a3[1] * wf[13] + a3[2] * wf[14] + a3[3] * wf[15];
                acc = wave_sum_dpp(acc);
                outv = (lane == pr) ? acc * rstd1[pr] : outv;
            }
            if (lane < 16) {
                if (n < 1536) ((bf16_t*)(ws + OFF_PRKV))[(size_t)lane * 1536 + n] = f2bf(outv);
                else ((bf16_t*)(ws + OFF_PCONV))[(size_t)lane * 2048 + n - 1536] = f2bf(outv);
            }
        }
    }
    __syncthreads();
}

__device__ __forceinline__ void phase_meta_lora(const PPv& p) {
    const int tid = threadIdx.x, bid = blockIdx.x, nb = gridDim.x, lane = tid & 63, wave = tid >> 6;
    unsigned char* ws = p.gws();
    const bf16_t* L = (const bf16_t*)(ws + OFF_L); const bf16_t* W2 = (const bf16_t*)(ws + OFF_W2);
    for (int n = bid * 8 + wave; n < 1536; n += nb * 8) {
        const int seg = n >> 9, c = n & 511;
        const u32x2 wv = *(const u32x2*)(W2 + (size_t)n * 256 + 4 * lane);
        const float w0v = bflo(wv.x), w1v = bfhi(wv.x), w2v = bflo(wv.y), w3v = bfhi(wv.y);
        float outv = 0.f;
#pragma unroll
        for (int r = 0; r < 16; ++r) {
            const u32x2 lv = *(const u32x2*)(L + (size_t)r * 256 + 4 * lane);
            float acc = bflo(lv.x) * w0v + bfhi(lv.x) * w1v + bflo(lv.y) * w2v + bfhi(lv.y) * w3v;
            acc = wave_sum_dpp(acc);
            outv = (lane == r) ? acc : outv;
        }
        if (lane < 16) {
            float v = outv;
            if (seg == 0) v = -0.60653065971f * sigmoidf_(v + p.gin(10)[c]);
            if (seg == 1) v = sigmoidf_(v + p.gin(13)[c]);
            bf16_t* ob = (bf16_t*)(ws + (seg == 0 ? OFF_LD : seg == 1 ? OFF_A : OFF_G));
            ob[(size_t)lane * 512 + c] = f2bf(v);
        }
    }
}

__device__ __forceinline__ void phase_lprep_conv(const PPv& p) {
    const int tid = threadIdx.x, bid = blockIdx.x, nb = gridDim.x;
    unsigned char* ws = p.gws();
    const bf16_t* PROJ = (const bf16_t*)(ws + OFF_PCONV);
    constexpr int PCOLS = 2048;
    bf16_t* L = (bf16_t*)(ws + OFF_L);
    for (int i = bid * 512 + tid; i < NRP * 32; i += nb * 512) {
        const int row = i >> 5, gq = i & 31;
        u32x4 w = (u32x4){0u, 0u, 0u, 0u};
        if (row < NR) {
            int ca, cb;
            if (gq < 8) { ca = 1536 + gq * 8; cb = ca + 64; }
            else if (gq < 16) { ca = 1536 + 128 + (gq - 8) * 8; cb = ca + 64; }
            else { ca = 1536 + 256 + (gq - 16) * 8; cb = ca + 128; }
            const u32x4 va = *(const u32x4*)(PROJ + (size_t)row * PCOLS + ca);
            const int pr = prev_row(row, 1);
            u32x4 vb = (u32x4){0u, 0u, 0u, 0u};
            if (pr >= 0) vb = *(const u32x4*)(PROJ + (size_t)pr * PCOLS + cb);
            float v[8] = {bflo(va.x) + bflo(vb.x), bfhi(va.x) + bfhi(vb.x), bflo(va.y) + bflo(vb.y), bfhi(va.y) + bfhi(vb.y), bflo(va.z) + bflo(vb.z), bfhi(va.z) + bfhi(vb.z), bflo(va.w) + bflo(vb.w), bfhi(va.w) + bfhi(vb.w)};
#pragma unroll
            for (int j = 0; j < 8; ++j) { if (gq < 8) v[j] = tanhf(v[j]); else if (gq >= 16) v[j] = sigmoidf_(v[j]); }
            w.x = cvt_pk_bf16(v[0], v[1]); w.y = cvt_pk_bf16(v[2], v[3]); w.z = cvt_pk_bf16(v[4], v[5]); w.w = cvt_pk_bf16(v[6], v[7]);
        }
        *(u32x4*)(L + (size_t)row * 256 + gq * 8) = w;
    }
    bf16_t* C = (bf16_t*)(ws + OFF_C);
    const float* cw = p.gin(24);
    for (int i = bid * 512 + tid; i < T * 64; i += nb * 512) {
        const int m = i >> 6, ch = (i & 63) * 8, row = NMETA + m;
        const int r1 = prev_row(row, 1), r2 = prev_row(row, 2);
        const bf16_t* p0 = PROJ + (size_t)row * PCOLS; const bf16_t* p1 = PROJ + (size_t)r1 * PCOLS; const bf16_t* p2 = PROJ + (size_t)r2 * PCOLS;
        const u32x4 vb = *(const u32x4*)(p0 + ch);
        const u32x4 c0 = *(const u32x4*)(p0 + 512 + ch), h0 = *(const u32x4*)(p0 + 1024 + ch);
        const u32x4 c1 = *(const u32x4*)(p1 + 512 + ch), h1 = *(const u32x4*)(p1 + 1024 + ch);
        const u32x4 c2 = *(const u32x4*)(p2 + 512 + ch), h2 = *(const u32x4*)(p2 + 1024 + ch);
        float o[8];
#pragma unroll
        for (int j = 0; j < 8; ++j) {
            const unsigned wb = j < 2 ? vb.x : j < 4 ? vb.y : j < 6 ? vb.z : vb.w;
            const unsigned wc0 = j < 2 ? c0.x : j < 4 ? c0.y : j < 6 ? c0.z : c0.w, wh0 = j < 2 ? h0.x : j < 4 ? h0.y : j < 6 ? h0.z : h0.w;
            const unsigned wc1 = j < 2 ? c1.x : j < 4 ? c1.y : j < 6 ? c1.z : c1.w, wh1 = j < 2 ? h1.x : j < 4 ? h1.y : j < 6 ? h1.z : h1.w;
            const unsigned wc2 = j < 2 ? c2.x : j < 4 ? c2.y : j < 6 ? c2.z : c2.w, wh2 = j < 2 ? h2.x : j < 4 ? h2.y : j < 6 ? h2.z : h2.w;
            const bool hi = j & 1;
            const float b = hi ? bfhi(wb) : bflo(wb);
            const float u0 = (hi ? bfhi(wc0) : bflo(wc0)) * (hi ? bfhi(wh0) : bflo(wh0));
            const float u1 = (hi ? bfhi(wc1) : bflo(wc1)) * (hi ? bfhi(wh1) : bflo(wh1));
            const float u2 = (hi ? bfhi(wc2) : bflo(wc2)) * (hi ? bfhi(wh2) : bflo(wh2));
            const float conv = cw[ch + j] * u2 + cw[512 + ch + j] * u1 + cw[1024 + ch + j] * u0;
            o[j] = b * conv;
        }
        u32x4 w; w.x = cvt_pk_bf16(o[0], o[1]); w.y = cvt_pk_bf16(o[2], o[3]); w.z = cvt_pk_bf16(o[4], o[5]); w.w = cvt_pk_bf16(o[6], o[7]);
        *(u32x4*)(C + (size_t)m * 512 + ch) = w;
    }
}

template <int CTRL> __device__ __forceinline__ float dppmov(float v) { return __builtin_bit_cast(float, __builtin_amdgcn_update_dpp(0, __builtin_bit_cast(int, v), CTRL, 0xF, 0xF, true)); }
__device__ __forceinline__ float wave_sum_dpp(float v) {
    v += dppmov<0xB1>(v);
    v += dppmov<0x4E>(v);
    v += dppmov<0x141>(v);
    v += dppmov<0x140>(v);
    { float c = v; asm volatile("v_nop\n\tv_nop\n\tv_permlane16_swap_b32 %0, %1\n\tv_nop" : "+v"(v), "+v"(c)); v += c; }
    { float c = v; asm volatile("v_nop\n\tv_nop\n\tv_permlane32_swap_b32 %0, %1\n\tv_nop" : "+v"(v), "+v"(c)); v += c; }
    return v;
}
typedef float f32x16 __attribute__((ext_vector_type(16)));

struct RawTok { bf16_t r, k, v, a, ld; };
__device__ __forceinline__ RawTok load_raw(const bf16_t* PRKV, const bf16_t* Ab, const bf16_t* LD, int row, int col) {
    RawTok q; const bf16_t* p0 = PRKV + (size_t)row * 1536 + col;
    q.r = p0[0]; q.k = p0[512]; q.v = p0[1024]; q.a = Ab[(size_t)row * 512 + col]; q.ld = LD[(size_t)row * 512 + col];
    return q;
}
__device__ __forceinline__ void unit_geom(int uid, int lane, int& b, int& h, int& c, int& col, int& row0) {
    const int bh = uid / NCHUNK; c = uid - bh * NCHUNK; b = bh >> 3; h = bh & 7; col = h * 64 + lane;
    row0 = c == 0 ? 0 : b * SEQ + c * 16;
}
__device__ __forceinline__ void phase_scanprep(const PPv& p, LAS unsigned char* lds) {
    const int tid = threadIdx.x, bid = blockIdx.x, nb = gridDim.x, lane = tid & 63, wave = tid >> 6;
    unsigned char* ws = p.gws();
    const bf16_t* PRKV = (const bf16_t*)(ws + OFF_PRKV);
    const bf16_t* LD = (const bf16_t*)(ws + OFF_LD);
    const bf16_t* Ab = (const bf16_t*)(ws + OFF_A);
    float* COEF = (float*)(ws + OFF_COEF);
    LAS unsigned char* wl = lds + wave * 13824;
    LAS bf16_t* AR = (LAS bf16_t*)wl;
    LAS bf16_t* BK = (LAS bf16_t*)(wl + 4608);
    LAS float* DM = (LAS float*)(wl + 9216);
    const int qperm = (lane & 32) | (((lane >> 2) & 3) << 3) | (((lane >> 4) & 1) << 2) | (lane & 3);
    int uid = bid * 8 + wave;
    if (uid >= NUNITS) return;
    int b, h, c, col, row0;
    unit_geom(uid, lane, b, h, c, col, row0);
    RawTok q[16], qn[16];
    bf16_t prr = 0, prk = 0, prv = 0, nprr = 0, nprk = 0, nprv = 0;
#pragma unroll
    for (int t = 0; t < 16; ++t) q[t] = load_raw(PRKV, Ab, LD, row0 + t, col);
    { const int pr = prev_row(row0, 1); if (pr >= 0) { const bf16_t* p1 = PRKV + (size_t)pr * 1536 + col; prr = p1[0]; prk = p1[512]; prv = p1[1024]; } }
    for (;;) {
        const float mur = p.gin(4)[col], muk = p.gin(5)[col], muv = p.gin(6)[col], kkw = p.gin(18)[col], kaw = p.gin(19)[col], rkw = p.gin(20)[col];
        const int nuid = uid + nb * 8; const bool has_next = nuid < NUNITS;
        int nb_ = b, nh = h, nc = c, ncol = col, nrow0 = row0;
        if (has_next) {
            unit_geom(nuid, lane, nb_, nh, nc, ncol, nrow0);
#pragma unroll
            for (int t = 0; t < 16; ++t) qn[t] = load_raw(PRKV, Ab, LD, nrow0 + t, ncol);
            nprr = 0; nprk = 0; nprv = 0;
            const int pr = prev_row(nrow0, 1); if (pr >= 0) { const bf16_t* p1 = PRKV + (size_t)pr * 1536 + ncol; nprr = p1[0]; nprk = p1[512]; nprv = p1[1024]; }
        }
        __builtin_amdgcn_sched_barrier(0);
        LAS float* PM = (LAS float*)wl;
        LAS float* RS = DM;
        {
            float rp = bf2f(prr), kp = bf2f(prk);
#pragma unroll
            for (int t = 0; t < 16; ++t) {
                const RawTok qq = q[t];
                const float r0 = bf2f(qq.r), k0 = bf2f(qq.k);
                const float r = r0 + (rp - r0) * mur, k = k0 + (kp - k0) * muk;
                rp = r0; kp = k0;
                const float a = bf2f(qq.a);
                const float kkv = k * kkw, k2 = k * (1.0f + (a - 1.0f) * kaw);
                PM[t * 68 + lane] = kkv * kkv; PM[(16 + t) * 68 + lane] = r * k2 * rkw;
            }
            asm volatile("" ::: "memory");
            const int rw = lane & 31, hf = lane >> 5;
            f32x4 s4 = (f32x4){0.f, 0.f, 0.f, 0.f};
#pragma unroll
            for (int i = 0; i < 8; ++i) s4 += *(const LAS f32x4*)(PM + rw * 68 + hf * 32 + i * 4);
            float sm = (s4[0] + s4[1]) + (s4[2] + s4[3]);
            { float c2 = sm; asm volatile("v_nop\n\tv_nop\n\tv_permlane32_swap_b32 %0, %1\n\tv_nop" : "+v"(sm), "+v"(c2)); sm += c2; }
            if (lane < 32) RS[lane] = sm;
            asm volatile("" ::: "memory");
            const float cfl = __shfl(sm, (lane & 15) + 16);
            if (lane < 16) COEF[(size_t)(row0 + lane) * 8 + h] = cfl;
        }
        __builtin_amdgcn_sched_barrier(0);
        float at[16], vt[16]; unsigned btp[8], ktp[8]; float bprev = 0.f, kprev = 0.f;
        float cl = 0.f;
        float rp = bf2f(prr), kp = bf2f(prk), vp = bf2f(prv);
        f32x4 n2v[4];
#pragma unroll
        for (int i = 0; i < 4; ++i) n2v[i] = *(const LAS f32x4*)(RS + 4 * i);
        asm volatile("" ::: "memory"); __builtin_amdgcn_sched_barrier(0);
#pragma unroll
        for (int t = 0; t < 16; ++t) {
            const RawTok qq = q[t];
            const float r0 = bf2f(qq.r), k0 = bf2f(qq.k), v0 = bf2f(qq.v);
            const float r = r0 + (rp - r0) * mur, k = k0 + (kp - k0) * muk, v = v0 + (vp - v0) * muv;
            rp = r0; kp = k0; vp = v0;
            const float a = bf2f(qq.a);
            const float kkv = k * kkw;
            const float kk = kkv * __builtin_amdgcn_rsqf(fmaxf(n2v[t >> 2][t & 3], 1e-24f));
            const float k2 = k * (1.0f + (a - 1.0f) * kaw);
            const float wcp = __expf(cl);
            cl += bf2f(qq.ld);
            const float wcn = __expf(cl), iw = __expf(-cl);
            const float btv = kk * a * iw, ktv = k2 * iw;
            at[t] = -kk * wcp; vt[t] = v;
            { const unsigned w = cvt_pk_bf16(at[t], r * wcn); AR[t * 72 + qperm] = (bf16_t)(w & 0xFFFFu); AR[(16 + t) * 72 + qperm] = (bf16_t)(w >> 16); }
            if (t & 1) {
                btp[t >> 1] = cvt_pk_bf16(bprev, btv); ktp[t >> 1] = cvt_pk_bf16(kprev, ktv);
                BK[(t - 1) * 72 + qperm] = (bf16_t)(btp[t >> 1] & 0xFFFFu); BK[t * 72 + qperm] = (bf16_t)(btp[t >> 1] >> 16);
                BK[(16 + t - 1) * 72 + qperm] = (bf16_t)(ktp[t >> 1] & 0xFFFFu); BK[(16 + t) * 72 + qperm] = (bf16_t)(ktp[t >> 1] >> 16);
            } else { bprev = btv; kprev = ktv; }
            if ((t & 3) == 3) __builtin_amdgcn_sched_barrier(0);
        }
        const float wcc = __expf(cl);
        {
            f32x16 dm;
#pragma unroll
            for (int i = 0; i < 16; ++i) dm[i] = 0.f;
            const int rr = lane & 31, hh = lane >> 5;
#pragma unroll
            for (int ks = 0; ks < 4; ++ks) {
                const bf16x8 fa = *(const LAS bf16x8*)(AR + rr * 72 + 16 * ks + 8 * hh);
                const bf16x8 fb = *(const LAS bf16x8*)(BK + rr * 72 + 16 * ks + 8 * hh);
                dm = __builtin_amdgcn_mfma_f32_32x32x16_bf16(fa, fb, dm, 0, 0, 0);
            }
#pragma unroll
            for (int reg = 0; reg < 16; ++reg) DM[((reg & 3) + 8 * (reg >> 2) + 4 * hh) * 36 + rr] = dm[reg];
        }
        __builtin_amdgcn_sched_barrier(0);
        float uh[16];
#pragma unroll
        for (int t = 0; t < 16; ++t) {
            float wv = at[t], uv = 0.f, wv2 = 0.f, uv2 = 0.f, uv3 = 0.f;
#pragma unroll
            for (int s4 = 0; s4 < 4; ++s4) {
                if (s4 * 4 < t) {
                    const f32x4 ab = *(const LAS f32x4*)(DM + t * 36 + s4 * 4), ak = *(const LAS f32x4*)(DM + t * 36 + 16 + s4 * 4);
#pragma unroll
                    for (int j = 0; j < 4; ++j) {
                        const int s_ = s4 * 4 + j;
                        if (s_ < t) {
                            if (j & 1) { wv2 += ab[j] * at[s_]; uv2 += ak[j] * vt[s_]; } else { wv += ab[j] * at[s_]; uv += ak[j] * vt[s_]; }
                            uv3 += ab[j] * uh[s_];
                        }
                    }
                }
            }
            wv += wv2; uv += uv2 + uv3;
            at[t] = wv; uh[t] = uv;
            asm volatile("" : "+v"(at[t]), "+v"(uh[t]));
        }
        __builtin_amdgcn_sched_barrier(0);
#pragma unroll
        for (int t = 0; t < 16; t += 2) { const unsigned w = cvt_pk_bf16(at[t], at[t + 1]); AR[t * 72 + qperm] = (bf16_t)(w & 0xFFFFu); AR[(t + 1) * 72 + qperm] = (bf16_t)(w >> 16); }
        unsigned char* rec = ws + OFF_CH + (size_t)uid * REC_BYTES;
#pragma unroll
        for (int i = 0; i < 2; ++i) {
            const int pc = i * 64 + lane, row = pc >> 3, part = pc & 7;
            *(u32x4*)(rec + RO_WH + pc * 16) = *(const LAS u32x4*)((LAS unsigned char*)AR + row * 144 + part * 16);
            *(u32x4*)(rec + RO_RT + pc * 16) = *(const LAS u32x4*)((LAS unsigned char*)AR + (16 + row) * 144 + part * 16);
        }
        {
            u32x4 w0, w1;
            w0.x = cvt_pk_bf16(uh[0], uh[1]); w0.y = cvt_pk_bf16(uh[2], uh[3]); w0.z = cvt_pk_bf16(uh[4], uh[5]); w0.w = cvt_pk_bf16(uh[6], uh[7]);
            w1.x = cvt_pk_bf16(uh[8], uh[9]); w1.y = cvt_pk_bf16(uh[10], uh[11]); w1.z = cvt_pk_bf16(uh[12], uh[13]); w1.w = cvt_pk_bf16(uh[14], uh[15]);
            *(u32x4*)(rec + RO_U0T + lane * 32) = w0; *(u32x4*)(rec + RO_U0T + lane * 32 + 16) = w1;
            w0.x = cvt_pk_bf16(vt[0], vt[1]); w0.y = cvt_pk_bf16(vt[2], vt[3]); w0.z = cvt_pk_bf16(vt[4], vt[5]); w0.w = cvt_pk_bf16(vt[6], vt[7]);
            w1.x = cvt_pk_bf16(vt[8], vt[9]); w1.y = cvt_pk_bf16(vt[10], vt[11]); w1.z = cvt_pk_bf16(vt[12], vt[13]); w1.w = cvt_pk_bf16(vt[14], vt[15]);
            *(u32x4*)(rec + RO_VT + lane * 32) = w0; *(u32x4*)(rec + RO_VT + lane * 32 + 16) = w1;
        }
#pragma unroll
        for (int g = 0; g < 4; ++g) {
            u32x4 w; w.x = btp[2 * g]; w.y = btp[2 * g + 1]; w.z = ktp[2 * g]; w.w = ktp[2 * g + 1];
            *(u32x4*)(rec + RO_BKT + lane * 64 + g * 16) = w;
        }
        {
            const int t = lane >> 2, g = lane & 3;
            const f32x4 rb = *(const LAS f32x4*)(DM + (16 + t) * 36 + 4 * g), rk = *(const LAS f32x4*)(DM + (16 + t) * 36 + 16 + 4 * g);
            float o[8];
#pragma unroll
            for (int j = 0; j < 4; ++j) { const bool keep = (4 * g + j) <= t; o[j] = keep ? rb[j] : 0.f; o[4 + j] = keep ? rk[j] : 0.f; }
            u32x4 w; w.x = cvt_pk_bf16(o[0], o[1]); w.y = cvt_pk_bf16(o[2], o[3]); w.z = cvt_pk_bf16(o[4], o[5]); w.w = cvt_pk_bf16(o[6], o[7]);
            *(u32x4*)(rec + RO_ARK + t * 64 + g * 16) = w;
        }
        *(float*)(rec + RO_WCC + lane * 4) = wcc;
        if (!has_next) break;
        uid = nuid; b = nb_; h = nh; c = nc; col = ncol; row0 = nrow0;
#pragma unroll
        for (int t = 0; t < 16; ++t) q[t] = qn[t];
        prr = nprr; prk = nprk; prv = nprv;
        __builtin_amdgcn_sched_barrier(0);
    }
}

__device__ __forceinline__ void convert_expert_weights(const PPv& p, LAS unsigned char* lds, int first, int stride);
struct RecOps { bf16x8 wA0, wA1, rA0, rA1, ark, bk[4]; u32x2 u0, vv; f32x4 wc[4]; };
__device__ __forceinline__ void load_ops(RecOps& o, LAS unsigned char* S, int vs, int fr, int g) {
    o.wA0 = *(const LAS bf16x8*)(S + RO_WH + fr * 128 + g * 16); o.wA1 = *(const LAS bf16x8*)(S + RO_WH + fr * 128 + 64 + g * 16);
    o.rA0 = *(const LAS bf16x8*)(S + RO_RT + fr * 128 + g * 16); o.rA1 = *(const LAS bf16x8*)(S + RO_RT + fr * 128 + 64 + g * 16);
    o.u0 = *(const LAS u32x2*)(S + RO_U0T + (16 * vs + fr) * 32 + g * 8);
    o.vv = *(const LAS u32x2*)(S + RO_VT + (16 * vs + fr) * 32 + g * 8);
    o.ark = *(const LAS bf16x8*)(S + RO_ARK + fr * 64 + g * 16);
#pragma unroll
    for (int m = 0; m < 4; ++m) { o.bk[m] = *(const LAS bf16x8*)(S + RO_BKT + (16 * m + fr) * 64 + g * 16); o.wc[m] = *(const LAS f32x4*)(S + RO_WCC + (16 * m + 4 * g) * 4); }
}
__device__ __forceinline__ void phase_recur(const PPv& p, LAS unsigned char* lds) {
    const int tid = threadIdx.x, bid = blockIdx.x, nb = gridDim.x, lane = tid & 63, wave = __builtin_amdgcn_readfirstlane(tid >> 6);
    unsigned char* ws = p.gws();
    if (bid >= 64) { convert_expert_weights(p, lds, bid - 64, nb - 64); return; }
    unsigned char* CHb = ws + OFF_CH + (size_t)(bid * NCHUNK) * REC_BYTES;
    constexpr int RSLOT = REC_BYTES, RN = 10, PF = 7;
#define R_BAR() do { asm volatile("s_waitcnt lgkmcnt(0)" ::: "memory"); __builtin_amdgcn_s_barrier(); asm volatile("" ::: "memory"); } while (0)
    if (wave >= 4) {
        const int lw = wave - 4;
#define R_ISSUE(x) do { \
            LAS unsigned char* _s = lds + ((x) % RN) * RSLOT; const unsigned char* _r = CHb + (size_t)(x) * REC_BYTES + lane * 16; \
            _Pragma("unroll") for (int _i = 0; _i < 3; ++_i) { const int _pc = lw + 4 * _i; __builtin_amdgcn_global_load_lds((const unsigned*)(_r + _pc * 1024), (LAS unsigned*)(_s + _pc * 1024), 16, 0, 0); } \
            if (lw == 0) __builtin_amdgcn_global_load_lds((const unsigned*)(_r + 12 * 1024), (LAS unsigned*)(_s + 12 * 1024), 16, 0, 0); \
            if (lw == 1) { if (lane < 16) __builtin_amdgcn_global_load_lds((const unsigned*)(_r + 13 * 1024), (LAS unsigned*)(_s + 13 * 1024), 16, 0, 0); } } while (0)
        for (int x = 0; x < PF; ++x) R_ISSUE(x);
        asm volatile("s_waitcnt vmcnt(0)" ::: "memory");
        R_BAR();
        for (int c = 0; c < NCHUNK; ++c) {
            const int x = c + PF;
            if (x < NCHUNK) R_ISSUE(x);
            if (x < NCHUNK) { if (lw < 2) asm volatile("s_waitcnt vmcnt(20)" ::: "memory"); else asm volatile("s_waitcnt vmcnt(15)" ::: "memory"); }
            else asm volatile("s_waitcnt vmcnt(0)" ::: "memory");
            R_BAR();
        }
#undef R_ISSUE
    } else {
        const int vs = wave, fr = lane & 15, g = lane >> 4;
        f32x4 H[4];
#pragma unroll
        for (int m = 0; m < 4; ++m) H[m] = (f32x4){0.f, 0.f, 0.f, 0.f};
        R_BAR();
        RecOps cur, nxt;
        load_ops(cur, lds, vs, fr, g);
        for (int c = 0; c < NCHUNK; ++c) {
            if (c + 1 < NCHUNK) load_ops(nxt, lds + ((c + 1) % RN) * RSLOT, vs, fr, g); else nxt = cur;
            u32x4 hb0, hb1;
            hb0.x = cvt_pk_bf16(H[0][0], H[0][1]); hb0.y = cvt_pk_bf16(H[0][2], H[0][3]); hb0.z = cvt_pk_bf16(H[1][0], H[1][1]); hb0.w = cvt_pk_bf16(H[1][2], H[1][3]);
            hb1.x = cvt_pk_bf16(H[2][0], H[2][1]); hb1.y = cvt_pk_bf16(H[2][2], H[2][3]); hb1.z = cvt_pk_bf16(H[3][0], H[3][1]); hb1.w = cvt_pk_bf16(H[3][2], H[3][3]);
            const bf16x8 hB0 = __builtin_bit_cast(bf16x8, hb0), hB1 = __builtin_bit_cast(bf16x8, hb1);
            f32x4 U = (f32x4){bflo(cur.u0.x), bfhi(cur.u0.x), bflo(cur.u0.y), bfhi(cur.u0.y)};
            U = __builtin_amdgcn_mfma_f32_16x16x32_bf16(cur.wA0, hB0, U, 0, 0, 0);
            U = __builtin_amdgcn_mfma_f32_16x16x32_bf16(cur.wA1, hB1, U, 0, 0, 0);
            f32x4 Y = (f32x4){0.f, 0.f, 0.f, 0.f};
            Y = __builtin_amdgcn_mfma_f32_16x16x32_bf16(cur.rA0, hB0, Y, 0, 0, 0);
            Y = __builtin_amdgcn_mfma_f32_16x16x32_bf16(cur.rA1, hB1, Y, 0, 0, 0);
            u32x4 uvw; uvw.x = cvt_pk_bf16(U[0], U[1]); uvw.y = cvt_pk_bf16(U[2], U[3]); uvw.z = cur.vv.x; uvw.w = cur.vv.y;
            const bf16x8 uv = __builtin_bit_cast(bf16x8, uvw);
            Y = __builtin_amdgcn_mfma_f32_16x16x32_bf16(cur.ark, uv, Y, 0, 0, 0);
#pragma unroll
            for (int m = 0; m < 4; ++m) { H[m] = __builtin_amdgcn_mfma_f32_16x16x32_bf16(cur.bk[m], uv, H[m], 0, 0, 0); H[m] *= cur.wc[m]; }
            u32x2 yw; yw.x = cvt_pk_bf16(Y[0], Y[1]); yw.y = cvt_pk_bf16(Y[2], Y[3]);
            *(u32x2*)(CHb + (size_t)c * REC_BYTES + RO_U0T + (16 * vs + fr) * 32 + g * 8) = yw;
            R_BAR();
            cur = nxt;
        }
    }
#undef R_BAR
}

__device__ __forceinline__ void phase_gn(const PPv& p) {
    const int tid = threadIdx.x, bid = blockIdx.x, nb = gridDim.x, lane = tid & 63, wave = tid >> 6;
    unsigned char* ws = p.gws();
    const bf16_t* Gb = (const bf16_t*)(ws + OFF_G); const float* COEF = (const float*)(ws + OFF_COEF);
    bf16_t* Z = (bf16_t*)(ws + OFF_Z);
    constexpr int NREAL = 64 * 256;
    for (int r0 = bid * 8 + wave; r0 < NREAL; r0 += nb * 16) {
        u32x4 y0[2], y1[2], v0[2], v1[2]; float cfv[2][16]; bf16_t ggv[2][16]; int colv[2], row0v[2], hv[2]; bool okv[2];
#pragma unroll
        for (int u = 0; u < 2; ++u) {
            const int r = r0 + u * nb * 8; okv[u] = r < NREAL;
            const int rr = okv[u] ? r : r0;
            const int bh = rr >> 8, c = (rr & 255) + 1, b = bh >> 3, h = bh & 7, uid = bh * NCHUNK + c;
            hv[u] = h; colv[u] = h * 64 + lane; row0v[u] = b * SEQ + c * 16;
            const unsigned char* rec = ws + OFF_CH + (size_t)uid * REC_BYTES;
            y0[u] = *(const u32x4*)(rec + RO_U0T + lane * 32); y1[u] = *(const u32x4*)(rec + RO_U0T + lane * 32 + 16);
            v0[u] = *(const u32x4*)(rec + RO_VT + lane * 32); v1[u] = *(const u32x4*)(rec + RO_VT + lane * 32 + 16);
#pragma unroll
            for (int t = 0; t < 16; ++t) { cfv[u][t] = COEF[(size_t)(row0v[u] + t) * 8 + h]; ggv[u][t] = Gb[(size_t)(row0v[u] + t) * 512 + colv[u]]; }
        }
#pragma unroll
        for (int u = 0; u < 2; ++u) {
            if (!okv[u]) continue;
            const int col = colv[u], row0 = row0v[u];
            const float lng = p.gin(21)[col], lnb = p.gin(22)[col];
            const unsigned yw[8] = {y0[u].x, y0[u].y, y0[u].z, y0[u].w, y1[u].x, y1[u].y, y1[u].z, y1[u].w}, vw[8] = {v0[u].x, v0[u].y, v0[u].z, v0[u].w, v1[u].x, v1[u].y, v1[u].z, v1[u].w};
#pragma unroll
            for (int t = 0; t < 16; ++t) {
                const float y = (t & 1) ? bfhi(yw[t >> 1]) : bflo(yw[t >> 1]);
                const float v = (t & 1) ? bfhi(vw[t >> 1]) : bflo(vw[t >> 1]);
                const float mean = wave_sum_dpp(y) * (1.0f / 64.0f);
                const float dlt = y - mean;
                const float var = wave_sum_dpp(dlt * dlt) * (1.0f / 64.0f);
                const float yn = dlt * rsqrtf(var + LNX_EPS) * lng + lnb;
                Z[(size_t)(row0 + t - NMETA) * 512 + col] = f2bf((yn + cfv[u][t] * v) * bf2f(ggv[u][t]));
            }
        }
    }
}

__device__ __forceinline__ void convert_expert_weights(const PPv& p, LAS unsigned char* lds, int first, int stride) {
    unsigned char* ws = p.gws();
    const int tid = threadIdx.x;
    LAS float* tile = (LAS float*)lds;
    const float* g2 = p.gin(27);
    unsigned char* WGU = ws + OFF_WGU; unsigned char* WD = ws + OFF_WD;
    constexpr int NBLK = NE * 3 * 64;
    const int lr = tid >> 6, lc = (tid & 63) * 4;
    f32x4 cur[8];
    int j = first;
    if (j >= NBLK) return;
    {
        const int mat = j >> 6, e = mat / 3, which = mat - 3 * e, bb = j & 63, kb = bb & 15, nbk = bb >> 4;
        const float* src = (which == 0 ? p.gin(30) : which == 1 ? p.gin(32) : p.gin(34)) + (size_t)e * 1024 * 1024 + (size_t)(kb * 64) * 1024 + nbk * 256;
#pragma unroll
        for (int i = 0; i < 8; ++i) cur[i] = __builtin_nontemporal_load((const f32x4*)(src + (size_t)(lr + 8 * i) * 1024 + lc));
    }
    for (;;) {
        const int jn = j + stride; const bool has_next = jn < NBLK;
        f32x4 nxt[8];
        if (has_next) {
            const int mat = jn >> 6, e = mat / 3, which = mat - 3 * e, bb = jn & 63, kb = bb & 15, nbk = bb >> 4;
            const float* src = (which == 0 ? p.gin(30) : which == 1 ? p.gin(32) : p.gin(34)) + (size_t)e * 1024 * 1024 + (size_t)(kb * 64) * 1024 + nbk * 256;
#pragma unroll
            for (int i = 0; i < 8; ++i) nxt[i] = __builtin_nontemporal_load((const f32x4*)(src + (size_t)(lr + 8 * i) * 1024 + lc));
        }
        const int mat = j >> 6, e = mat / 3, which = mat - 3 * e, bb = j & 63, kb = bb & 15, nbk = bb >> 4;
#pragma unroll
        for (int i = 0; i < 8; ++i) { LAS float* t = tile + (lr + 8 * i) * 257 + lc; t[0] = cur[i][0]; t[1] = cur[i][1]; t[2] = cur[i][2]; t[3] = cur[i][3]; }
        __syncthreads();
        {
            const int kq = tid & 7, k0 = kb * 64 + 8 * kq;
            float sc[8];
#pragma unroll
            for (int jj = 0; jj < 8; ++jj) sc[jj] = (which < 2 ? g2[k0 + jj] : 1.0f) * W8_SCALE;
#pragma unroll
            for (int i = 0; i < 4; ++i) {
                const int nn = (tid >> 3) + 64 * i, n = nbk * 256 + nn;
                float v[8];
#pragma unroll
                for (int jj = 0; jj < 8; ++jj) v[jj] = tile[(8 * kq + jj) * 257 + nn] * sc[jj];
                u32x2 w; w.x = pk4_fp8(v[0], v[1], v[2], v[3]); w.y = pk4_fp8(v[4], v[5], v[6], v[7]);
                unsigned char* dst = which < 2 ? WGU + (size_t)e * 2048 * 1024 + (size_t)(256 * (n >> 7) + 128 * which + (n & 127)) * 1024
                                               : WD + (size_t)e * 1024 * 1024 + (size_t)n * 1024;
                __builtin_nontemporal_store(w, (u32x2*)(dst + k0));
            }
        }
        __syncthreads();
        if (!has_next) break;
        j = jn;
#pragma unroll
        for (int i = 0; i < 8; ++i) cur[i] = nxt[i];
    }
}

__device__ __forceinline__ void phase_router(const PPv& p, LAS unsigned char* lds) {
    const int tid = threadIdx.x, bid = blockIdx.x, nb = gridDim.x, lane = tid & 63, wave = tid >> 6;
    unsigned char* ws = p.gws();
    const bf16_t* h1 = (const bf16_t*)(ws + OFF_HB2);
    const float* WRG = (const float*)(ws + OFF_WRG);
    const float* brt = p.gin(29);
    LAS float* slog = (LAS float*)lds;
    LAS float* srs = slog + 8 * 16 * 32;
    LAS int* lcnt = (LAS int*)(srs + 128);
    LAS int* gbase = lcnt + 32;
    LAS int* ltopi = gbase + 32;
    LAS int* lrank = ltopi + 512;
    int* TOPI = (int*)(ws + OFF_TOPI); float* TOPW = (float*)(ws + OFF_TOPW); int* RANK = (int*)(ws + OFF_RANK); float* RSTD2 = (float*)(ws + OFF_RSTD2);
    int* GCNT = (int*)(ws + OFF_GCNT);
    for (int tb = bid; tb < T / 128; tb += nb) {
        if (tid < 32) lcnt[tid] = 0;
        __syncthreads();
        const int t0 = tb * 128 + wave * 16;
        {
            const int row = lane & 15, kq = lane >> 4;
            const bf16_t* ap = h1 + (size_t)(t0 + row) * D + 4 * kq;
            const float* bp = WRG + (size_t)(4 * kq) * 32 + row;
            f32x4 acc0 = (f32x4){0.f, 0.f, 0.f, 0.f}, acc1 = acc0;
            float ss = 0.f;
            for (int j = 0; j < 64; ++j) {
                const u32x2 aw = *(const u32x2*)(ap + 16 * j);
                const f32x4 av = (f32x4){bflo(aw.x), bfhi(aw.x), bflo(aw.y), bfhi(aw.y)};
                ss += av[0] * av[0] + av[1] * av[1] + av[2] * av[2] + av[3] * av[3];
                const float* bj = bp + (size_t)(16 * j) * 32;
#pragma unroll
                for (int s = 0; s < 4; ++s) {
                    const float b0 = bj[s * 32], b1 = bj[s * 32 + 16];
                    acc0 = __builtin_amdgcn_mfma_f32_16x16x4f32(av[s], b0, acc0, 0, 0, 0);
                    acc1 = __builtin_amdgcn_mfma_f32_16x16x4f32(av[s], b1, acc1, 0, 0, 0);
                }
            }
            ss += __shfl_xor(ss, 16); ss += __shfl_xor(ss, 32);
#pragma unroll
            for (int reg = 0; reg < 4; ++reg) {
                slog[(wave * 16 + 4 * kq + reg) * 32 + row] = acc0[reg];
                slog[(wave * 16 + 4 * kq + reg) * 32 + 16 + row] = acc1[reg];
            }
            if (lane < 16) srs[wave * 16 + lane] = rsqrtf(ss * (1.0f / D) + NORM_EPS);
        }
        __syncthreads();
        if (lane < 16) {
            const int tl = wave * 16 + lane, t = tb * 128 + tl;
            const float rs = srs[tl];
            float lg[32];
#pragma unroll
            for (int e = 0; e < 32; ++e) lg[e] = slog[tl * 32 + e] * rs + brt[e];
            int ti[4]; float tv[4];
#pragma unroll
            for (int k = 0; k < 4; ++k) {
                float best = -3.0e38f; int bi = 0;
#pragma unroll
                for (int e = 0; e < 32; ++e) { const bool tk = lg[e] > best; best = tk ? lg[e] : best; bi = tk ? e : bi; }
                ti[k] = bi; tv[k] = best;
#pragma unroll
                for (int e = 0; e < 32; ++e) lg[e] = (e == bi) ? -3.0e38f : lg[e];
            }
            const float e0 = 1.0f, e1 = __expf(tv[1] - tv[0]), e2 = __expf(tv[2] - tv[0]), e3 = __expf(tv[3] - tv[0]);
            const float inv = 1.0f / (e0 + e1 + e2 + e3);
            *(f32x4*)(TOPW + (size_t)t * 4) = (f32x4){e0 * inv, e1 * inv, e2 * inv, e3 * inv};
            RSTD2[t] = rs;
#pragma unroll
            for (int k = 0; k < 4; ++k) { ltopi[tl * 4 + k] = ti[k]; lrank[tl * 4 + k] = __hip_atomic_fetch_add(lcnt + ti[k], 1, __ATOMIC_RELAXED, __HIP_MEMORY_SCOPE_WORKGROUP); }
        }
        __syncthreads();
        if (tid < 32) gbase[tid] = atomicAdd(GCNT + tid, lcnt[tid]);
        __syncthreads();
        {
            const int e = ltopi[tid];
            TOPI[(size_t)tb * 512 + tid] = e;
            RANK[(size_t)tb * 512 + tid] = gbase[e] + lrank[tid];
        }
        __syncthreads();
    }
}

__device__ __forceinline__ void phase_lists(const PPv& p, LAS unsigned char* lds) {
    const int tid = threadIdx.x, bid = blockIdx.x, nb = gridDim.x;
    unsigned char* ws = p.gws();
    LAS int* pstart = (LAS int*)lds;
    LAS int* cnt = pstart + 64;
    const int* GCNT = (const int*)(ws + OFF_GCNT);
    if (tid < 32) cnt[tid] = GCNT[tid];
    __syncthreads();
    if (tid == 0) { int s = 0; for (int e = 0; e < 32; ++e) { pstart[e] = s; s += ((cnt[e] + 255) >> 8) << 8; } pstart[32] = s; }
    __syncthreads();
    const int* TOPI = (const int*)(ws + OFF_TOPI); const float* TOPW = (const float*)(ws + OFF_TOPW); const int* RANK = (const int*)(ws + OFF_RANK); const float* RSTD2 = (const float*)(ws + OFF_RSTD2);
    int* ROWTOK = (int*)(ws + OFF_ROWTOK); int* ROWSLOT = (int*)(ws + OFF_ROWSLOT); float* ROWW = (float*)(ws + OFF_ROWW); float* ROWRS = (float*)(ws + OFF_ROWRS);
    for (int i = bid * 512 + tid; i < T * 4; i += nb * 512) {
        const int e = TOPI[i], pos = pstart[e] + RANK[i], t = i >> 2;
        ROWTOK[pos] = t; ROWSLOT[pos] = i; ROWW[pos] = TOPW[i]; ROWRS[pos] = RSTD2[t];
    }
    for (int e = bid; e < 32; e += nb) {
        for (int pos = pstart[e] + cnt[e] + tid; pos < pstart[e + 1]; pos += 512) { ROWTOK[pos] = 0; ROWSLOT[pos] = -1; ROWW[pos] = 0.f; ROWRS[pos] = 0.f; }
    }
    if (bid == 0) {
        int* TILEE = (int*)(ws + OFF_TILEE);
        const int ntiles = pstart[32] >> 8;
        for (int mt = tid; mt < ntiles; mt += 512) { int e = 0; for (int q = 0; q < 32; ++q) if (pstart[q] <= mt * 256) e = q; TILEE[mt] = e; }
        if (tid == 0) TILEE[1000] = ntiles;
    }
    __syncthreads();
}

__device__ __forceinline__ void phase_final(const PPv& p) {
    const int tid = threadIdx.x, bid = blockIdx.x, nb = gridDim.x, lane = tid & 63, wave = tid >> 6;
    unsigned char* ws = p.gws();
    const bf16_t* HB2 = (const bf16_t*)(ws + OFF_HB2);
    const bf16_t* YA = (const bf16_t*)p.gout(); const bf16_t* YB = (const bf16_t*)(ws + OFF_WGU);
    const float* gf = p.gin(36);
    const f32x4 ga0 = *(const f32x4*)(gf + 8 * lane), ga1 = *(const f32x4*)(gf + 8 * lane + 4), gb0 = *(const f32x4*)(gf + 512 + 8 * lane), gb1 = *(const f32x4*)(gf + 512 + 8 * lane + 4);
    for (int t0 = (bid * 8 + wave) * 2; t0 < T; t0 += nb * 16) {
        u32x4 ha[2], hb[2], ya[2][4], yb[2][4];
#pragma unroll
        for (int u = 0; u < 2; ++u) {
            const int t = t0 + u;
            ha[u] = __builtin_nontemporal_load((const u32x4*)(HB2 + (size_t)t * D + 8 * lane)); hb[u] = __builtin_nontemporal_load((const u32x4*)(HB2 + (size_t)t * D + 512 + 8 * lane));
#pragma unroll
            for (int k = 0; k < 4; ++k) { ya[u][k] = __builtin_nontemporal_load((const u32x4*)(YA + (size_t)(4 * t + k) * 512 + 8 * lane)); yb[u][k] = __builtin_nontemporal_load((const u32x4*)(YB + (size_t)(4 * t + k) * 512 + 8 * lane)); }
        }
#pragma unroll
        for (int u = 0; u < 2; ++u) {
            const int t = t0 + u;
            float va[8] = {bflo(ha[u].x), bfhi(ha[u].x), bflo(ha[u].y), bfhi(ha[u].y), bflo(ha[u].z), bfhi(ha[u].z), bflo(ha[u].w), bfhi(ha[u].w)};
            float vb[8] = {bflo(hb[u].x), bfhi(hb[u].x), bflo(hb[u].y), bfhi(hb[u].y), bflo(hb[u].z), bfhi(hb[u].z), bflo(hb[u].w), bfhi(hb[u].w)};
#pragma unroll
            for (int k = 0; k < 4; ++k) {
                const u32x4 a4 = ya[u][k], b4 = yb[u][k];
                va[0] += bflo(a4.x); va[1] += bfhi(a4.x); va[2] += bflo(a4.y); va[3] += bfhi(a4.y); va[4] += bflo(a4.z); va[5] += bfhi(a4.z); va[6] += bflo(a4.w); va[7] += bfhi(a4.w);
                vb[0] += bflo(b4.x); vb[1] += bfhi(b4.x); vb[2] += bflo(b4.y); vb[3] += bfhi(b4.y); vb[4] += bflo(b4.z); vb[5] += bfhi(b4.z); vb[6] += bflo(b4.w); vb[7] += bfhi(b4.w);
            }
            float ss = 0.f;
#pragma unroll
            for (int j = 0; j < 8; ++j) ss += va[j] * va[j] + vb[j] * vb[j];
            ss = wave_sum_dpp(ss);
            const float rs = rsqrtf(ss * (1.0f / D) + NORM_EPS);
            float* o = p.gout() + (size_t)t * D;
            __builtin_nontemporal_store((f32x4){va[0] * rs * ga0[0], va[1] * rs * ga0[1], va[2] * rs * ga0[2], va[3] * rs * ga0[3]}, (f32x4*)(o + 8 * lane));
            __builtin_nontemporal_store((f32x4){va[4] * rs * ga1[0], va[5] * rs * ga1[1], va[6] * rs * ga1[2], va[7] * rs * ga1[3]}, (f32x4*)(o + 8 * lane + 4));
            __builtin_nontemporal_store((f32x4){vb[0] * rs * gb0[0], vb[1] * rs * gb0[1], vb[2] * rs * gb0[2], vb[3] * rs * gb0[3]}, (f32x4*)(o + 512 + 8 * lane));
            __builtin_nontemporal_store((f32x4){vb[4] * rs * gb1[0], vb[5] * rs * gb1[1], vb[6] * rs * gb1[2], vb[7] * rs * gb1[3]}, (f32x4*)(o + 512 + 8 * lane + 4));
        }
    }
}

#define XB_TMO      128
#define XB_XCNT(j)  (256  + 64 * (j))
#define XB_XSUB(j)  (1280 + 64 * (j))
#define XB_XGEN(j)  (2304 + 64 * (j))
#define XB_TOP      3328
#define XB_TOPGEN   3392
#define XCD_BAR_WORDS 3456
#define XB_SPIN_CAP (1u << 18)
__device__ __forceinline__ unsigned xb_ld(unsigned* p)              { return __hip_atomic_load(p, __ATOMIC_RELAXED, __HIP_MEMORY_SCOPE_AGENT); }
__device__ __forceinline__ unsigned xb_add(unsigned* p, unsigned v) { return __hip_atomic_fetch_add(p, v, __ATOMIC_RELAXED, __HIP_MEMORY_SCOPE_AGENT); }
__device__ __forceinline__ unsigned xb_xcc_id() { return (unsigned)__builtin_amdgcn_s_getreg((3 << 11) | 20) & 0xFu; }
#define XB_SPIN(cond, bar) do { unsigned _sp = 0; while (cond) { __builtin_amdgcn_s_sleep(1); \
    if ((++_sp & 255u) == 0u) { if (xb_ld(&(bar)[XB_TMO])) break; if (_sp > XB_SPIN_CAP) { atomicAdd(&(bar)[XB_TMO], 1u); break; } } } } while (0)
struct XcdBarrier { unsigned* bar; unsigned x; volatile LAS unsigned* st; };
__device__ __forceinline__ XcdBarrier xcd_barrier_post(unsigned* bar, volatile LAS unsigned* st) {
    XcdBarrier b; b.bar = bar; b.x = xb_xcc_id(); b.st = st;
    if (threadIdx.x == 0) (void)xb_add(&bar[XB_XCNT(b.x)], 1u);
    return b;
}
__device__ __forceinline__ void xcd_barrier_complete(unsigned* bar, unsigned x, unsigned& nloc, unsigned& nx) {
    const unsigned G = gridDim.x * gridDim.y * gridDim.z;
    unsigned sum, cnt, mine, sp = 0u;
    for (;;) {
        sum = 0u; cnt = 0u; mine = 0u;
#pragma unroll
        for (unsigned j = 0; j < 16; ++j) { const unsigned c = xb_ld(&bar[XB_XCNT(j)]); sum += c; cnt += (c > 0u) ? 1u : 0u; mine = (j == x) ? c : mine; }
        if (sum == G) break;
        __builtin_amdgcn_s_sleep(1);
        if ((++sp & 255u) == 0u) { if (xb_ld(&bar[XB_TMO])) break; if (sp > XB_SPIN_CAP) { atomicAdd(&bar[XB_TMO], 1u); break; } }
    }
    nloc = mine > 0u ? mine : 1u; nx = cnt > 0u ? cnt : 1u;
}
__device__ __forceinline__ void xcd_barrier(const XcdBarrier& b) {
    asm volatile("s_waitcnt vmcnt(0)" ::: "memory");
    __syncthreads();
    if (threadIdx.x == 0) {
        unsigned* bar = b.bar;
        __builtin_amdgcn_s_waitcnt(0);
        unsigned nloc = b.st[0], nx = b.st[1];
        if (nloc == 0u) { xcd_barrier_complete(bar, b.x, nloc, nx); b.st[0] = nloc; b.st[1] = nx; }
        const unsigned old = xb_add(&bar[XB_XSUB(b.x)], 1u);
        const unsigned gen = old / nloc;
        if (old + 1u == (gen + 1u) * nloc) {
            __builtin_amdgcn_fence(__ATOMIC_RELEASE, "agent");
            asm volatile("s_waitcnt vmcnt(0)" ::: "memory");
            const unsigned og = xb_add(&bar[XB_TOP], 1u);
            const unsigned tg = og / nx;
            if (og + 1u == (tg + 1u) * nx) xb_add(&bar[XB_TOPGEN], 1u);
            else XB_SPIN(xb_ld(&bar[XB_TOPGEN]) == tg, bar);
            __builtin_amdgcn_fence(__ATOMIC_ACQUIRE, "agent");
            xb_add(&bar[XB_XGEN(b.x)], 1u);
            asm volatile("s_waitcnt vmcnt(0)" ::: "memory");
        } else {
            XB_SPIN(xb_ld(&bar[XB_XGEN(b.x)]) == gen, bar);
            __builtin_amdgcn_fence(__ATOMIC_ACQUIRE, "agent");
            asm volatile("s_waitcnt vmcnt(0)" ::: "memory");
        }
    }
    __syncthreads();
}

constexpr int N_PHASES = 15;
__global__ void __launch_bounds__(512, 2) mega(Params p) {
    extern __shared__ __attribute__((aligned(16))) unsigned char lds_raw[];
    LAS unsigned char* lds = (LAS unsigned char*)lds_raw;
    cg::grid_group grid = cg::this_grid();
    unsigned char* ws = getpp().gws();
    const int G = gridDim.x, bid = blockIdx.x;
#ifndef ONLY_PHASE
#define ONLY_PHASE -1
#endif
#define IN(k) ((ONLY_PHASE < 0 || ONLY_PHASE == (k)) && p.ph_lo <= (k) && (k) < p.ph_hi)
    volatile LAS unsigned* xst = (volatile LAS unsigned*)(lds + 163840 - 16);
    if (threadIdx.x < 4) xst[threadIdx.x] = 0u;
    __syncthreads();
    const XcdBarrier xbar = xcd_barrier_post((unsigned*)(ws + OFF_BAR), xst);
    if (p.ph_hi < 0) grid.sync();
#define SEAM(k) do { if ((k) + 1 < p.ph_hi) xcd_barrier(xbar); } while (0)
    if (IN(0)) { const PPv q = getpp(); phase_prep(q, lds); SEAM(0); }
    if (IN(1)) { const PPv q = getpp();
        phase_meta_proj(q, lds);
        StaticOrder S; S.init(ws + OFF_HB, ws + OFF_WIN, T, NCOLS1, 1024, G, bid);
        EpiProj E{(bf16_t*)(ws + OFF_PRKV), (bf16_t*)(ws + OFF_PCONV), (bf16_t*)q.gout(), (const float*)(ws + OFF_RSTD1)};
        gemm_phase<false>(lds, 1024, S, E);
        SEAM(1);
    }
    if (IN(2)) { const PPv q = getpp(); phase_lprep_conv(q); SEAM(2); }
    if (IN(3)) { const PPv q = getpp();
        phase_meta_lora(q);
        StaticOrder S; S.init(ws + OFF_L + (size_t)NMETA * 256 * 2, ws + OFF_W2, T, 1536, 256, G, bid);
        EpiL E{ws, q.gin(10), q.gin(13)};
        gemm_phase<false>(lds, 256, S, E);
        SEAM(3);
    }
    if (IN(4)) { const PPv q = getpp(); phase_scanprep(q, lds); SEAM(4); }
    if (IN(5)) { const PPv q = getpp(); phase_recur(q, lds); SEAM(5); }
    if (IN(6)) { const PPv q = getpp(); phase_gn(q); SEAM(6); }
    if (IN(7)) { const PPv q = getpp();
        MergeOrder S; S.so.init(ws + OFF_Z, ws + OFF_WR, T, 1024, 512, G, bid); S.A1 = (const char*)(ws + OFF_C); S.B1 = (const char*)(ws + OFF_WC);
        EpiMergeFused E{(bf16_t*)(ws + OFF_MERGED), (const bf16_t*)q.gout()};
        gemm_phase<false>(lds, 512, S, E);
        SEAM(7);
    }
    if (IN(9)) { const PPv q = getpp();
        StaticOrder S; S.init(ws + OFF_MERGED, ws + OFF_WO, T, 1024, 1024, G, bid);
        EpiO E{q.gin(0), q.gout(), (bf16_t*)(ws + OFF_HB2), ws + OFF_HB8};
        gemm_phase<false>(lds, 1024, S, E);
        SEAM(9);
    }
    if (IN(10)) { const PPv q = getpp(); phase_router(q, lds); SEAM(10); }
    if (IN(11)) { const PPv q = getpp(); phase_lists(q, lds); SEAM(11); }
    if (IN(12)) { const PPv q = getpp();
        const int* TILEE = (const int*)(ws + OFF_TILEE);
        MoeOrder S; S.A = (const char*)(ws + OFF_HB8); S.Bt = (const char*)(ws + OFF_WGU); S.K = 512; S.estride = (size_t)2048 * 1024;
        S.tile_e = TILEE; S.rowtok = (const int*)(ws + OFF_ROWTOK); S.ntiles = TILEE[1000]; S.nnt = 8; S.G = G; S.c = bid; S.gather = true;
        EpiMoe1 E{ws + OFF_ACT, (const float*)(ws + OFF_ROWRS), q.gin(31), q.gin(33)};
        gemm_phase<true, true>(lds, 512, S, E);
        SEAM(12);
    }
    if (IN(13)) { const PPv q = getpp();
        const int* TILEE = (const int*)(ws + OFF_TILEE);
        MoeOrder S; S.A = (const char*)(ws + OFF_ACT); S.Bt = (const char*)(ws + OFF_WD); S.K = 512; S.estride = (size_t)1024 * 1024;
        S.tile_e = TILEE; S.rowtok = nullptr; S.ntiles = TILEE[1000]; S.nnt = 4; S.G = G; S.c = bid; S.gather = false;
        EpiMoe2 E{(bf16_t*)q.gout(), (bf16_t*)(ws + OFF_WGU), (const int*)(ws + OFF_ROWSLOT), (const float*)(ws + OFF_ROWW), q.gin(35)};
        gemm_phase<false, true>(lds, 512, S, E);
        SEAM(13);
    }
    if (IN(14)) { const PPv q = getpp(); phase_final(q); }
}

extern "C" void kernel_launch(void* const* d_in, const int* in_sizes, int n_in, void* d_out, int out_size, void* d_ws, size_t ws_size,
                              hipStream_t stream) {
    constexpr size_t kDynLds = 160 * 1024;
    static int grid_blocks = 0;
    if (!grid_blocks) {
        int dev = 0, cus = 0, per_cu = 0;
        (void)hipGetDevice(&dev);
        (void)hipDeviceGetAttribute(&cus, hipDeviceAttributeMultiprocessorCount, dev);
        (void)hipFuncSetAttribute((const void*)mega, hipFuncAttributeMaxDynamicSharedMemorySize, (int)kDynLds);
        (void)hipOccupancyMaxActiveBlocksPerMultiprocessor(&per_cu, mega, 512, kDynLds);
        if (per_cu > 1) per_cu = 1;
        grid_blocks = cus * per_cu;
        fprintf(stderr, "cus=%d per_cu=%d ws_size=%zu need=%zu\n", cus, per_cu, ws_size, (size_t)WS_NEED);
    }
    if (ws_size < WS_NEED || n_in < 37 || grid_blocks < 128) { fprintf(stderr, "kernel_launch: unsupported configuration\n"); return; }
    Params p{};
    for (int i = 0; i < 37; ++i) p.in[i] = (const float*)d_in[i];
    p.out = (float*)d_out;
    p.ws = (unsigned char*)d_ws;
    p.ph_lo = 0; p.ph_hi = N_PHASES;
    (void)hipMemsetAsync((unsigned char*)d_ws + OFF_BAR, 0, 16384, stream);
    void* args[] = {&p};
    hipError_t e = hipLaunchCooperativeKernel((void*)mega, dim3(grid_blocks), dim3(512), args, kDynLds, stream);
    if (e != hipSuccess) fprintf(stderr, "cooperative launch failed: %s (grid %d)\n", hipGetErrorString(e), grid_blocks);
}
```

```cpp
#include <hip/hip_runtime.h>
#include <hip/hip_cooperative_groups.h>
#include <cstdio>
namespace cg = cooperative_groups;

#define LAS __attribute__((address_space(3)))
typedef unsigned short bf16_t;
typedef short bf16x8 __attribute__((ext_vector_type(8)));
typedef float f32x4 __attribute__((ext_vector_type(4)));
typedef float f32x2 __attribute__((ext_vector_type(2)));
typedef unsigned u32x4 __attribute__((ext_vector_type(4)));
typedef unsigned u32x2 __attribute__((ext_vector_type(2)));

constexpr int D = 1024, NBATCH = 8, SEQ = 4096, NMETA = 16;
constexpr int T = NBATCH * SEQ;
constexpr int NR = T + NMETA;
constexpr int NRP = 33024;
constexpr int PCOLS1 = 3584;
constexpr int NCOLS1 = 5632;
constexpr int NE = 32, TOPK = 4, DFF = 1024;
constexpr int MAXROWS = T * TOPK + NE * 256;
constexpr int MAXTILES = MAXROWS / 256;
constexpr float NORM_EPS = 1e-5f, LNX_EPS = 64e-5f;

constexpr int NCHUNK = 257, NUNITS = 64 * NCHUNK;
constexpr int REC_BYTES = 13568;
constexpr int RO_WH = 0, RO_RT = 2048, RO_U0T = 4096, RO_VT = 6144, RO_BKT = 8192, RO_ARK = 12288, RO_WCC = 13312;
constexpr int SLOT_BYTES = 15680, SO_G = 13568, SO_COEF = 15616, NSLOT = 9;
constexpr size_t SZ_ACT = (size_t)MAXROWS * 1024 * 2;
constexpr size_t SZ_WGU = (size_t)NE * 2048 * 1024 * 2;
constexpr size_t SZ_WD = (size_t)NE * 1024 * 1024 * 2;
constexpr size_t SZ_HB = (size_t)T * 1024 * 2;
constexpr size_t OFF_WGU = 0;
constexpr size_t OFF_HB8 = OFF_WGU + (size_t)NE * 2048 * 1024;
constexpr size_t OFF_WD = OFF_WGU + SZ_WGU;
constexpr size_t OFF_ACT = OFF_WD + SZ_WD;
constexpr size_t OFF_HB2 = OFF_ACT + SZ_ACT;
constexpr size_t OFF_RT = OFF_HB2 + SZ_HB;
constexpr size_t OFF_TOPI = OFF_RT;
constexpr size_t OFF_TOPW = OFF_TOPI + (size_t)T * 16;
constexpr size_t OFF_RANK = OFF_TOPW + (size_t)T * 16;
constexpr size_t OFF_RSTD2 = OFF_RANK + (size_t)T * 16;
constexpr size_t OFF_ROWTOK = OFF_RSTD2 + (size_t)T * 4;
constexpr size_t OFF_ROWSLOT = OFF_ROWTOK + (size_t)MAXROWS * 4;
constexpr size_t OFF_ROWW = OFF_ROWSLOT + (size_t)MAXROWS * 4;
constexpr size_t OFF_ROWRS = OFF_ROWW + (size_t)MAXROWS * 4;
constexpr size_t OFF_TILEE = OFF_ROWRS + (size_t)MAXROWS * 4;
constexpr size_t OFF_GCNT = OFF_TILEE + 4096;
constexpr size_t OFF_SM = OFF_GCNT + 256;
constexpr size_t OFF_WR = OFF_SM;
constexpr size_t OFF_WC = OFF_WR + (size_t)1024 * 512 * 2;
constexpr size_t OFF_WO = OFF_WC + (size_t)1024 * 512 * 2;
constexpr size_t OFF_W2 = OFF_WO + (size_t)1024 * 1024 * 2;
constexpr size_t OFF_RSTD1 = OFF_W2 + (size_t)1536 * 256 * 2;
constexpr size_t OFF_WRG = OFF_RSTD1 + (size_t)NRP * 4;
constexpr size_t OFF_BAR = OFF_WRG + (size_t)1024 * 32 * 4;
constexpr size_t WS_NEED = OFF_BAR + 16384;
constexpr size_t OFF_PRKV = 0;
constexpr size_t SZ_PRKV = (size_t)NR * 1536 * 2;
constexpr size_t OFF_LD = OFF_PRKV + SZ_PRKV;
constexpr size_t OFF_A = OFF_LD + (size_t)NRP * 512 * 4;
constexpr size_t OFF_CH = OFF_A + (size_t)NRP * 512 * 2;
constexpr size_t OFF_PCONV = OFF_CH;
constexpr size_t SZ_PCONV = (size_t)NR * 2048 * 2;
constexpr size_t OFF_HB = OFF_PCONV + SZ_PCONV;
constexpr size_t OFF_L = OFF_HB + SZ_HB;
constexpr size_t OFF_WIN = OFF_L + (size_t)NRP * 256 * 2;
constexpr size_t CH_END = OFF_WIN + (size_t)NCOLS1 * 1024 * 2;
constexpr size_t OFF_MERGED = OFF_CH;
constexpr size_t OFF_G = CH_END;
constexpr size_t OFF_C = OFF_G + (size_t)NRP * 512 * 2;
constexpr size_t OFF_Z = OFF_C + (size_t)T * 512 * 2;
constexpr size_t OFF_COEF = OFF_Z + (size_t)T * 512 * 2;
constexpr size_t EARLY_END = OFF_COEF + (size_t)NR * 8 * 4;
static_assert(EARLY_END <= OFF_RT, "early buffers overflow");
static_assert(OFF_CH + (size_t)NUNITS * REC_BYTES <= CH_END, "chunk records overflow");
static_assert(OFF_CH >= OFF_WD + SZ_WD, "expert weights (written during the scan) must not touch live scan buffers");
static_assert(OFF_MERGED + SZ_HB <= OFF_HB2, "layout");
static_assert(OFF_PRKV % 16 == 0 && OFF_LD % 16 == 0 && OFF_A % 16 == 0 && OFF_CH % 16 == 0 && OFF_HB % 16 == 0 && OFF_L % 16 == 0 && OFF_WIN % 16 == 0 && OFF_G % 16 == 0 && OFF_C % 16 == 0 && OFF_Z % 16 == 0 && OFF_COEF % 16 == 0, "align");

#define GAS __attribute__((address_space(1)))
#define CAS __attribute__((address_space(4)))
struct Params {
    const float* in[37];
    float* out;
    unsigned char* ws;
    int ph_lo, ph_hi;
};
struct ParamsD {
    const GAS float* in[37];
    GAS float* out;
    GAS unsigned char* ws;
    int ph_lo, ph_hi;
};
static_assert(sizeof(Params) == sizeof(ParamsD), "argument views");
struct PPv {
    const CAS ParamsD* k;
    __device__ __forceinline__ const float* gin(int i) const { return (const float*)k->in[i]; }
    __device__ __forceinline__ float* gout() const { return (float*)k->out; }
    __device__ __forceinline__ unsigned char* gws() const { return (unsigned char*)k->ws; }
};
__device__ __forceinline__ PPv getpp() { const CAS ParamsD* k = (const CAS ParamsD*)__builtin_amdgcn_kernarg_segment_ptr(); asm volatile("" : "+s"(k)); return PPv{k}; }

typedef __bf16 bf16x2v __attribute__((ext_vector_type(2)));
__device__ __forceinline__ unsigned cvt_pk_bf16(float lo, float hi) { const f32x2 v = {lo, hi}; return __builtin_bit_cast(unsigned, __builtin_convertvector(v, bf16x2v)); }
__device__ __forceinline__ unsigned pk4_fp8(float a, float b, float c, float d) { int w = __builtin_amdgcn_cvt_pk_fp8_f32(a, b, 0, false); w = __builtin_amdgcn_cvt_pk_fp8_f32(c, d, w, true); return (unsigned)w; }
constexpr float W8_SCALE = 32.0f, W8_INV = 1.0f / 32.0f;
__device__ __forceinline__ bf16_t f2bf(float f) { unsigned u = __float_as_uint(f); u += 0x7FFFu + ((u >> 16) & 1u); return (bf16_t)(u >> 16); }
__device__ __forceinline__ float bf2f(bf16_t b) { return __uint_as_float(((unsigned)b) << 16); }
__device__ __forceinline__ float bflo(unsigned w) { return __uint_as_float(w << 16); }
__device__ __forceinline__ float bfhi(unsigned w) { return __uint_as_float(w & 0xFFFF0000u); }
__device__ __forceinline__ float sigmoidf_(float x) { return __builtin_amdgcn_rcpf(1.0f + __expf(-x)); }
__device__ __forceinline__ float wave_sum(float v) {
#pragma unroll
    for (int o = 32; o >= 1; o >>= 1) v += __shfl_xor(v, o);
    return v;
}
__device__ __forceinline__ float wave_sum_dpp(float v);
__device__ __forceinline__ int prev_row(int row, int d) {
    if (row < NMETA) return row - d >= 0 ? row - d : -1;
    const int s = (row - NMETA) & (SEQ - 1);
    return s >= d ? row - d : NMETA + s - d;
}

constexpr int BM = 256, BK = 64, HALF = 128, HTB = HALF * BK * 2, STAGE_BYTES = 8 * HTB, NXCD = 8, WGM = 8;
__device__ __forceinline__ int lds_byte(int r, int c) { const int st = (r >> 4) * 2 + (c >> 5), rr = r & 15, cc = c & 31, ob = rr * 64 + cc * 2; return st * 1024 + (ob ^ (((ob >> 9) & 1) << 5)); }
__device__ __forceinline__ void stage_rc(int b, int& R, int& C) { const int st = b / 1024, sb = b % 1024, swz = sb ^ (((sb >> 9) & 1) << 5); R = (st >> 1) * 16 + swz / 64; C = (st & 1) * 32 + (swz % 64) / 2; }
__device__ __forceinline__ int perm32(int rho) { const int n = rho >> 4, i = rho & 15; return 8 * (i >> 2) + 4 * n + (i & 3); }

struct Unit { int pm, pn, aux; };

struct StaticOrder {
    const char* A; const char* Bt; int K;
    int nM, nN, nwg, G, c;
    __device__ void init(const void* A_, const void* Bt_, int M, int N, int K_, int G_, int c_) { A = (const char*)A_; Bt = (const char*)Bt_; K = K_; nM = M / BM; nN = N / BM; nwg = nM * nN; G = G_; c = c_; }
    __device__ bool next(int i, Unit& u) const {
        const long L = (long)i * G + c; if (L >= nwg) return false;
        int wgid = (int)L; { const int q = nwg / NXCD, r = nwg % NXCD, xcd = wgid % NXCD, off = wgid / NXCD; wgid = (xcd < r ? xcd * (q + 1) : r * (q + 1) + (xcd - r) * q) + off; }
        const int nig = WGM * nN, gid = wgid / nig, fm = gid * WGM, gsz = (nM - fm) < WGM ? (nM - fm) : WGM;
        u.pm = fm + ((wgid % nig) % gsz); u.pn = (wgid % nig) / gsz; u.aux = 0; return true;
    }
    __device__ __forceinline__ const char* a_ptr(const Unit& u) const { return A + (size_t)u.pm * 256 * K * 2; }
    __device__ __forceinline__ const char* b_ptr(const Unit& u) const { return Bt + (size_t)u.pn * 256 * K * 2; }
    __device__ __forceinline__ int gather_row(const Unit&, int) const { return 0; }
    __device__ __forceinline__ const void* gather_src(const Unit&, int) const { return nullptr; }
};
struct MoeOrder {
    const char* A; const char* Bt; int K; size_t estride;
    const int* tile_e; const int* rowtok; int ntiles, nnt, G, c; bool gather;
    __device__ bool next(int i, Unit& u) const {
        int mt, nt;
        if ((G & 7) == 0 && ((G >> 3) % nnt) == 0) {
            const int x = c & 7, j = c >> 3, per = (G >> 3) / nnt;
            mt = (i * 8 + x) * per + j / nnt; nt = j % nnt;
        } else { const long L = (long)i * G + c; mt = (int)(L / nnt); nt = (int)(L % nnt); }
        if (mt >= ntiles) return false;
        u.pm = mt; u.pn = nt; u.aux = tile_e[mt]; return true;
    }
    __device__ __forceinline__ const char* a_ptr(const Unit& u) const { return gather ? A : A + (size_t)u.pm * 256 * K * 2; }
    __device__ __forceinline__ const char* b_ptr(const Unit& u) const { return Bt + (size_t)u.aux * estride + (size_t)u.pn * 256 * K * 2; }
    __device__ __forceinline__ int gather_row(const Unit& u, int r) const { return rowtok[u.pm * 256 + r]; }
    __device__ __forceinline__ const void* gather_src(const Unit& u, int lane) const { return rowtok + u.pm * 256 + lane * 4; }
};

typedef int i32x4 __attribute__((ext_vector_type(4)));
typedef int i32x8 __attribute__((ext_vector_type(8)));
template <bool GATHER, bool FP8 = false, class Epi, class Sched>
__device__ __forceinline__ void gemm_phase(LAS unsigned char* lds, const int K_, const Sched& S, const Epi& E) {
    int K = K_; asm volatile("" : "+s"(K));
    const int tid = threadIdx.x, wid = __builtin_amdgcn_readfirstlane(tid >> 6), lane = tid & 63, wr = wid >> 2, wc = wid & 3, fr = lane & 15, fq = lane >> 4;
    const int nt = K / BK;
    unsigned voffA[2], voffB[2]; int Rr[2], Cc[2];
#pragma unroll
    for (int i = 0; i < 2; ++i) { int R, C; stage_rc(tid * 16 + i * 8192, R, C); const int Rb = (R & ~31) + perm32(R & 31);
        Rr[i] = R; Cc[i] = C; voffA[i] = (unsigned)(R * K + C) * 2u; voffB[i] = (unsigned)(Rb * K + C) * 2u; }
    const size_t kstep = (size_t)(BK * 2);
    const size_t hstep = (size_t)HALF * K * 2;
    const unsigned ldsw = (unsigned)wid * 1024u;
    const int aoff = lds_byte(wr * 64 + fr, fq * 8), boff = lds_byte(wc * 32 + fr, fq * 8);
    unsigned vgc[2][2], vgn[2][2];
    LAS unsigned char* const parbase = lds + STAGE_BYTES;
    constexpr int NPAR = Epi::NPAR;
#define G_PAR_ISSUE(unit, uidx, hasnx, nxunit) do { \
        LAS unsigned char* _ps = parbase + ((uidx) & 1) * 4096; \
        if (wid < NPAR) __builtin_amdgcn_global_load_lds((const unsigned*)E.par_src(unit, wid, lane), (LAS unsigned*)(_ps + wid * 1024), 16, 0, 0); \
        if (GATHER && (hasnx) && wid == NPAR) __builtin_amdgcn_global_load_lds((const unsigned*)S.gather_src(nxunit, lane), (LAS unsigned*)(_ps + NPAR * 1024), 16, 0, 0); } while (0)
#define G_CAT8(x0, x1) __builtin_shufflevector(__builtin_bit_cast(i32x4, x0), __builtin_bit_cast(i32x4, x1), 0, 1, 2, 3, 4, 5, 6, 7)
#define G_SA(b, h) (((b) * 2 + (h)) * HTB)
#define G_SB(b, h) ((4 + (b) * 2 + (h)) * HTB)
#define G_STAGE(bufoff, gbase, voff) do { _Pragma("unroll") for (int _i = 0; _i < 2; ++_i) \
        __builtin_amdgcn_global_load_lds((const unsigned*)((const char*)(gbase) + (voff)[_i]), (LAS unsigned*)(lds + (bufoff) + ldsw + _i * 8192), 16, 0, 0); } while (0)
#define G_STAGE_A(bufoff, kptr, h, VG) do { if (GATHER) { G_STAGE(bufoff, kptr, VG[h]); } else { G_STAGE(bufoff, (kptr) + (h) * hstep, voffA); } } while (0)
#define G_LDA(dst, b, h) do { _Pragma("unroll") for (int m = 0; m < 4; ++m) { \
        if (FP8) dst##8[m] = G_CAT8(*(const LAS bf16x8*)(lds + G_SA(b, h) + aoff + m * 2048), *(const LAS bf16x8*)(lds + G_SA(b, h) + aoff + m * 2048 + 1024)); \
        else { _Pragma("unroll") for (int k = 0; k < 2; ++k) dst[m][k] = *(const LAS bf16x8*)(lds + G_SA(b, h) + aoff + m * 2048 + k * 1024); } } } while (0)
#define G_LDB(dst, b, h) do { _Pragma("unroll") for (int n = 0; n < 2; ++n) { \
        if (FP8) dst##8[n] = G_CAT8(*(const LAS bf16x8*)(lds + G_SB(b, h) + boff + n * 2048), *(const LAS bf16x8*)(lds + G_SB(b, h) + boff + n * 2048 + 1024)); \
        else { _Pragma("unroll") for (int k = 0; k < 2; ++k) dst[n][k] = *(const LAS bf16x8*)(lds + G_SB(b, h) + boff + n * 2048 + k * 1024); } } } while (0)
#define G_MMA(ai, bj, At, Bt) do { __builtin_amdgcn_s_setprio(1); _Pragma("unroll") for (int m = 0; m < 4; ++m) _Pragma("unroll") for (int n = 0; n < 2; ++n) { \
        if (FP8) asm volatile("v_mfma_scale_f32_16x16x128_f8f6f4 %0, %1, %2, %0, %3, %3 op_sel_hi:[0,0,0]" : "+v"(acc[ai][bj][m][n]) : "v"(Bt##8[n]), "v"(At##8[m]), "v"(sc8)); \
        else { _Pragma("unroll") for (int k = 0; k < 2; ++k) acc[ai][bj][m][n] = __builtin_amdgcn_mfma_f32_16x16x32_bf16(Bt[n][k], At[m][k], acc[ai][bj][m][n], 0, 0, 0); } } \
        __builtin_amdgcn_s_setprio(0); } while (0)
#define G_WAIT_V(n) asm volatile("s_waitcnt vmcnt(" #n ")" ::: "memory")
#define G_WAIT_L(n) asm volatile("s_waitcnt lgkmcnt(" #n ")" ::: "memory")
#define G_BAR __builtin_amdgcn_s_barrier()
#define G_SCHED __builtin_amdgcn_sched_barrier(0)
    Unit cur, nxt;
    int ui = 0;
    if (!S.next(0, cur)) return;
    f32x4 acc[2][2][4][2];
#pragma unroll
    for (int a = 0; a < 2; ++a)
#pragma unroll
        for (int b = 0; b < 2; ++b)
#pragma unroll
            for (int m = 0; m < 4; ++m)
#pragma unroll
                for (int n = 0; n < 2; ++n) acc[a][b][m][n] = (f32x4){0.f, 0.f, 0.f, 0.f};
    bf16x8 At[4][2], B0[2][2], B1[2][2];
    i32x8 At8[4], B08[2], B18[2];
    int sc8 = 0x7F7F7F7F; asm volatile("" : "+v"(sc8));
    const char* cA = S.a_ptr(cur); const char* cB = S.b_ptr(cur);
    if (GATHER) {
#pragma unroll
        for (int h = 0; h < 2; ++h)
#pragma unroll
            for (int i = 0; i < 2; ++i) vgc[h][i] = (unsigned)(S.gather_row(cur, h * HALF + Rr[i]) * K + Cc[i]) * 2u;
    }
    { Unit n1; const bool hn1 = S.next(1, n1); G_PAR_ISSUE(cur, 0, hn1, n1); }
    G_STAGE(G_SB(0, 0), cB, voffB); G_STAGE_A(G_SA(0, 0), cA, 0, vgc); G_STAGE(G_SB(0, 1), cB + hstep, voffB); G_STAGE_A(G_SA(0, 1), cA, 1, vgc);
    if (wr == 1) G_BAR;
    G_WAIT_V(4); G_BAR;
    G_STAGE(G_SB(1, 0), cB + kstep, voffB); G_STAGE_A(G_SA(1, 0), cA + kstep, 0, vgc); G_STAGE(G_SB(1, 1), cB + hstep + kstep, voffB);
    G_WAIT_V(6); G_BAR;
    for (;;) {
        const bool has_next = S.next(ui + 1, nxt);
        const char* nA = has_next ? S.a_ptr(nxt) : cA; const char* nB = has_next ? S.b_ptr(nxt) : cB;
        if (ui > 0) G_PAR_ISSUE(cur, ui, has_next, nxt);
        if (GATHER) {
#pragma unroll
            for (int h = 0; h < 2; ++h)
#pragma unroll
                for (int i = 0; i < 2; ++i) vgn[h][i] = vgc[h][i];
        }
        for (int t = 0; t < nt; t += 2) {
            const bool last = (t == nt - 2);
            const char* a1 = cA + (size_t)(t + 1) * kstep;
            const char* a2 = last ? nA : cA + (size_t)(t + 2) * kstep; const char* b2 = last ? nB : cB + (size_t)(t + 2) * kstep;
            const char* a3 = a2 + kstep; const char* b3 = b2 + kstep;
            unsigned vg2[2][2];
            if (GATHER) {
#pragma unroll
                for (int h = 0; h < 2; ++h)
#pragma unroll
                    for (int i = 0; i < 2; ++i) vg2[h][i] = last ? vgn[h][i] : vgc[h][i];
            }
            G_LDB(B0, 0, 0); G_SCHED; G_LDA(At, 0, 0); G_STAGE_A(G_SA(1, 1), a1, 1, vgc);
            G_WAIT_L(8); G_BAR; G_WAIT_L(0); G_MMA(0, 0, At, B0); G_BAR; G_SCHED;
            G_LDB(B1, 0, 1); G_STAGE(G_SB(0, 0), b2, voffB);
            G_BAR; G_WAIT_L(0); G_MMA(0, 1, At, B1); G_BAR;
            G_LDA(At, 0, 1); G_STAGE_A(G_SA(0, 0), a2, 0, vg2);
            G_BAR; G_WAIT_L(0); G_MMA(1, 0, At, B0); G_BAR; G_SCHED;
            G_STAGE(G_SB(0, 1), b2 + hstep, voffB);
            G_WAIT_V(6); G_BAR; G_MMA(1, 1, At, B1); G_BAR;
            G_LDB(B0, 1, 0); G_SCHED; G_LDA(At, 1, 0); G_STAGE_A(G_SA(0, 1), a2, 1, vg2);
            G_WAIT_L(8); G_BAR; G_WAIT_L(0); G_MMA(0, 0, At, B0); G_BAR; G_SCHED;
            G_LDB(B1, 1, 1); G_STAGE(G_SB(1, 0), b3, voffB);
            G_BAR; G_WAIT_L(0); G_MMA(0, 1, At, B1); G_BAR;
            G_LDA(At, 1, 1); G_STAGE_A(G_SA(1, 0), a3, 0, vg2);
            G_BAR; G_WAIT_L(0); G_MMA(1, 0, At, B0); G_BAR; G_SCHED;
            G_STAGE(G_SB(1, 1), b3 + hstep, voffB);
            G_WAIT_V(6); G_BAR; G_MMA(1, 1, At, B1); G_BAR;
            if (GATHER && t == 0 && has_next) {
                const LAS int* rows = (const LAS int*)(parbase + (ui & 1) * 4096 + NPAR * 1024);
#pragma unroll
                for (int h = 0; h < 2; ++h)
#pragma unroll
                    for (int i = 0; i < 2; ++i) vgn[h][i] = (unsigned)(rows[h * HALF + Rr[i]] * K + Cc[i]) * 2u;
            }
        }
        if (FP8) asm volatile("s_nop 15\n\ts_nop 15" ::: "memory");
        const bool keep_acc = E(acc, cur, wr, wc, fr, fq, (const LAS unsigned char*)(parbase + (ui & 1) * 4096));
        if (!has_next) break;
        if (!keep_acc)
#pragma unroll
        for (int a = 0; a < 2; ++a)
#pragma unroll
            for (int b = 0; b < 2; ++b)
#pragma unroll
                for (int m = 0; m < 4; ++m)
#pragma unroll
                    for (int n = 0; n < 2; ++n) acc[a][b][m][n] = (f32x4){0.f, 0.f, 0.f, 0.f};
        cur = nxt; cA = nA; cB = nB; ++ui;
        if (GATHER) {
#pragma unroll
            for (int h = 0; h < 2; ++h)
#pragma unroll
                for (int i = 0; i < 2; ++i) vgc[h][i] = vgn[h][i];
        }
    }
    G_WAIT_V(0);
    if (wr == 0) G_BAR;
    G_BAR;
#undef G_PAR_ISSUE
#undef G_SA
#undef G_SB
#undef G_STAGE
#undef G_STAGE_A
#undef G_LDA
#undef G_LDB
#undef G_MMA
#undef G_CAT8
#undef G_WAIT_V
#undef G_WAIT_L
#undef G_BAR
#undef G_SCHED
}

struct EpiProj {
    bf16_t* prkv; bf16_t* pconv; bf16_t* gates; const float* rstd1;
    static constexpr int NPAR = 1;
    __device__ __forceinline__ const void* par_src(const Unit& u, int, int lane) const { return rstd1 + NMETA + u.pm * BM + lane * 4; }
    __device__ __forceinline__ bool operator()(const f32x4 (&acc)[2][2][4][2], const Unit& u, int wr, int wc, int fr, int fq, const LAS unsigned char* par) const {
        const int row0 = u.pm * BM + wr * 64 + fr;
        const bool isg = u.pn >= 14;
        float rsv[2][4];
#pragma unroll
        for (int ai = 0; ai < 2; ++ai)
#pragma unroll
            for (int m = 0; m < 4; ++m) rsv[ai][m] = ((const LAS float*)par)[wr * 64 + fr + ai * HALF + m * 16];
#pragma unroll
        for (int ai = 0; ai < 2; ++ai)
#pragma unroll
            for (int m = 0; m < 4; ++m) {
                const int row = row0 + ai * HALF + m * 16;
                const float rs = rsv[ai][m];
                bf16_t* rowp = isg ? gates + (size_t)row * 2048 + (u.pn - 14) * 256 + wc * 32 + 8 * fq
                             : (u.pn < 6 ? prkv + (size_t)(NMETA + row) * 1536 + u.pn * 256 : pconv + (size_t)(NMETA + row) * 2048 + (u.pn - 6) * 256) + wc * 32 + 8 * fq;
#pragma unroll
                for (int bj = 0; bj < 2; ++bj) {
                    f32x4 v0 = acc[ai][bj][m][0] * rs, v1 = acc[ai][bj][m][1] * rs;
                    if (isg) {
#pragma unroll
                        for (int j = 0; j < 4; ++j) { v0[j] = sigmoidf_(v0[j]); v1[j] = sigmoidf_(v1[j]); }
                    }
                    u32x4 w; w.x = cvt_pk_bf16(v0[0], v0[1]); w.y = cvt_pk_bf16(v0[2], v0[3]); w.z = cvt_pk_bf16(v1[0], v1[1]); w.w = cvt_pk_bf16(v1[2], v1[3]);
                    *(u32x4*)(rowp + bj * HALF) = w;
                }
            }
        return false;
    }
};
struct EpiL {
    static constexpr int NPAR = 0;
    __device__ __forceinline__ const void* par_src(const Unit&, int, int) const { return nullptr; }
    unsigned char* wsb; const float* w0; const float* a0;
    __device__ __forceinline__ bool operator()(const f32x4 (&acc)[2][2][4][2], const Unit& u, int wr, int wc, int fr, int fq, const LAS unsigned char* par) const {
        const int row0 = NMETA + u.pm * BM + wr * 64 + fr;
        const int seg = u.pn >> 1;
        const int cb = (u.pn & 1) * 256 + wc * 32 + 8 * fq;
        const float* bias = seg == 0 ? w0 : a0;
        f32x4 bv[2][2];
#pragma unroll
        for (int bj = 0; bj < 2; ++bj) {
            bv[bj][0] = seg < 2 ? *(const f32x4*)(bias + cb + bj * HALF) : (f32x4){0.f, 0.f, 0.f, 0.f};
            bv[bj][1] = seg < 2 ? *(const f32x4*)(bias + cb + bj * HALF + 4) : (f32x4){0.f, 0.f, 0.f, 0.f};
        }
        const float sc = seg == 0 ? -0.60653065971f : 1.0f;
        bf16_t* ob = (bf16_t*)(wsb + (seg == 0 ? OFF_LD : seg == 1 ? OFF_A : OFF_G));
#pragma unroll
        for (int ai = 0; ai < 2; ++ai)
#pragma unroll
            for (int m = 0; m < 4; ++m) {
                const int row = row0 + ai * HALF + m * 16;
#pragma unroll
                for (int bj = 0; bj < 2; ++bj) {
                    const int c = cb + bj * HALF;
                    f32x4 v0 = acc[ai][bj][m][0] + bv[bj][0], v1 = acc[ai][bj][m][1] + bv[bj][1];
                    if (seg < 2) {
#pragma unroll
                        for (int j = 0; j < 4; ++j) { v0[j] = sc * sigmoidf_(v0[j]); v1[j] = sc * sigmoidf_(v1[j]); }
                    }
                    {
                        u32x4 w; w.x = cvt_pk_bf16(v0[0], v0[1]); w.y = cvt_pk_bf16(v0[2], v0[3]); w.z = cvt_pk_bf16(v1[0], v1[1]); w.w = cvt_pk_bf16(v1[2], v1[3]);
                        *(u32x4*)(ob + (size_t)row * 512 + c) = w;
                    }
                }
            }
        return false;
    }
};
template <int SECOND> struct EpiMerge {
    static constexpr int NPAR = 0;
    __device__ __forceinline__ const void* par_src(const Unit&, int, int) const { return nullptr; }
    bf16_t* merged; const bf16_t* gates;
    __device__ __forceinline__ bool operator()(const f32x4 (&acc)[2][2][4][2], const Unit& u, int wr, int wc, int fr, int fq, const LAS unsigned char* par) const {
        const int row0 = u.pm * BM + wr * 64 + fr, col0 = u.pn * BM + wc * 32 + 8 * fq;
#pragma unroll
        for (int ai = 0; ai < 2; ++ai)
#pragma unroll
            for (int m = 0; m < 4; ++m) {
                const int row = row0 + ai * HALF + m * 16;
#pragma unroll
                for (int bj = 0; bj < 2; ++bj) {
                    const int c = col0 + bj * HALF;
                    const u32x4 gw = *(const u32x4*)(gates + (size_t)row * 2048 + SECOND * 1024 + c);
                    f32x4 g0 = (f32x4){bflo(gw.x), bfhi(gw.x), bflo(gw.y), bfhi(gw.y)}, g1 = (f32x4){bflo(gw.z), bfhi(gw.z), bflo(gw.w), bfhi(gw.w)};
                    f32x4 v0 = acc[ai][bj][m][0] * g0, v1 = acc[ai][bj][m][1] * g1;
                    bf16_t* p = merged + (size_t)row * 1024 + c;
                    if (SECOND) {
                        const u32x4 ow = *(const u32x4*)p;
                        v0 += (f32x4){bflo(ow.x), bfhi(ow.x), bflo(ow.y), bfhi(ow.y)}; v1 += (f32x4){bflo(ow.z), bfhi(ow.z), bflo(ow.w), bfhi(ow.w)};
                    }
                    u32x4 w; w.x = cvt_pk_bf16(v0[0], v0[1]); w.y = cvt_pk_bf16(v0[2], v0[3]); w.z = cvt_pk_bf16(v1[0], v1[1]); w.w = cvt_pk_bf16(v1[2], v1[3]);
                    *(u32x4*)p = w;
                }
            }
        return false;
    }
};
struct MergeOrder {
    StaticOrder so; const char* A1; const char* B1;
    __device__ bool next(int i, Unit& u) const { const bool ok = so.next(i >> 1, u); u.aux = i & 1; return ok; }
    __device__ __forceinline__ const char* a_ptr(const Unit& u) const { return (u.aux ? A1 : so.A) + (size_t)u.pm * 256 * so.K * 2; }
    __device__ __forceinline__ const char* b_ptr(const Unit& u) const { return (u.aux ? B1 : so.Bt) + (size_t)u.pn * 256 * so.K * 2; }
    __device__ __forceinline__ int gather_row(const Unit&, int) const { return 0; }
    __device__ __forceinline__ const void* gather_src(const Unit&, int) const { return nullptr; }
};
struct EpiMergeFused {
    static constexpr int NPAR = 0;
    __device__ __forceinline__ const void* par_src(const Unit&, int, int) const { return nullptr; }
    bf16_t* merged; const bf16_t* gates;
    __device__ __forceinline__ bool operator()(f32x4 (&acc)[2][2][4][2], const Unit& u, int wr, int wc, int fr, int fq, const LAS unsigned char* par) const {
        const int row0 = u.pm * BM + wr * 64 + fr, col0 = u.pn * BM + wc * 32 + 8 * fq;
#pragma unroll
        for (int ai = 0; ai < 2; ++ai) {
            u32x4 gbw[4][2], gaw[4][2];
#pragma unroll
            for (int m = 0; m < 4; ++m)
#pragma unroll
                for (int bj = 0; bj < 2; ++bj) {
                    const bf16_t* gp = gates + (size_t)(row0 + ai * HALF + m * 16) * 2048 + col0 + bj * HALF;
                    gbw[m][bj] = *(const u32x4*)(gp + 1024);
                    gaw[m][bj] = u.aux == 0 ? *(const u32x4*)gp : (u32x4){0u, 0u, 0u, 0u};
                }
#pragma unroll
            for (int m = 0; m < 4; ++m)
#pragma unroll
                for (int bj = 0; bj < 2; ++bj) {
                    const int row = row0 + ai * HALF + m * 16, c = col0 + bj * HALF;
                    f32x4 gb0 = (f32x4){bflo(gbw[m][bj].x), bfhi(gbw[m][bj].x), bflo(gbw[m][bj].y), bfhi(gbw[m][bj].y)}, gb1 = (f32x4){bflo(gbw[m][bj].z), bfhi(gbw[m][bj].z), bflo(gbw[m][bj].w), bfhi(gbw[m][bj].w)};
#pragma unroll
                    for (int j = 0; j < 4; ++j) { gb0[j] = fmaxf(gb0[j], 1e-6f); gb1[j] = fmaxf(gb1[j], 1e-6f); }
                    if (u.aux == 0) {
                        const f32x4 ga0 = (f32x4){bflo(gaw[m][bj].x), bfhi(gaw[m][bj].x), bflo(gaw[m][bj].y), bfhi(gaw[m][bj].y)}, ga1 = (f32x4){bflo(gaw[m][bj].z), bfhi(gaw[m][bj].z), bflo(gaw[m][bj].w), bfhi(gaw[m][bj].w)};
#pragma unroll
                        for (int j = 0; j < 4; ++j) { acc[ai][bj][m][0][j] *= ga0[j] * __builtin_amdgcn_rcpf(gb0[j]); acc[ai][bj][m][1][j] *= ga1[j] * __builtin_amdgcn_rcpf(gb1[j]); }
                    } else {
                        const f32x4 v0 = acc[ai][bj][m][0] * gb0, v1 = acc[ai][bj][m][1] * gb1;
                        u32x4 w; w.x = cvt_pk_bf16(v0[0], v0[1]); w.y = cvt_pk_bf16(v0[2], v0[3]); w.z = cvt_pk_bf16(v1[0], v1[1]); w.w = cvt_pk_bf16(v1[2], v1[3]);
                        *(u32x4*)(merged + (size_t)row * 1024 + c) = w;
                    }
                }
        }
        return u.aux == 0;
    }
};
struct EpiO {
    static constexpr int NPAR = 0;
    __device__ __forceinline__ const void* par_src(const Unit&, int, int) const { return nullptr; }
    const float* x; float* h1; bf16_t* hb2; unsigned char* hb8;
    __device__ __forceinline__ bool operator()(const f32x4 (&acc)[2][2][4][2], const Unit& u, int wr, int wc, int fr, int fq, const LAS unsigned char* par) const {
        const int row0 = u.pm * BM + wr * 64 + fr, col0 = u.pn * BM + wc * 32 + 8 * fq;
#pragma unroll
        for (int ai = 0; ai < 2; ++ai) {
            f32x4 xv[4][2][2];
#pragma unroll
            for (int m = 0; m < 4; ++m)
#pragma unroll
                for (int bj = 0; bj < 2; ++bj) {
                    const size_t o = (size_t)(row0 + ai * HALF + m * 16) * 1024 + col0 + bj * HALF;
                    xv[m][bj][0] = *(const f32x4*)(x + o); xv[m][bj][1] = *(const f32x4*)(x + o + 4);
                }
#pragma unroll
            for (int m = 0; m < 4; ++m)
#pragma unroll
                for (int bj = 0; bj < 2; ++bj) {
                    const size_t o = (size_t)(row0 + ai * HALF + m * 16) * 1024 + col0 + bj * HALF;
                    const f32x4 v0 = acc[ai][bj][m][0] + xv[m][bj][0], v1 = acc[ai][bj][m][1] + xv[m][bj][1];
                    u32x4 w; w.x = cvt_pk_bf16(v0[0], v0[1]); w.y = cvt_pk_bf16(v0[2], v0[3]); w.z = cvt_pk_bf16(v1[0], v1[1]); w.w = cvt_pk_bf16(v1[2], v1[3]);
                    *(u32x4*)(hb2 + o) = w;
                    u32x2 w8; w8.x = pk4_fp8(v0[0], v0[1], v0[2], v0[3]); w8.y = pk4_fp8(v1[0], v1[1], v1[2], v1[3]);
                    *(u32x2*)(hb8 + o) = w8;
                }
        }
        return false;
    }
};
struct EpiMoe1 {
    unsigned char* act; const float* rowrs; const float* bg; const float* bu;
    static constexpr int NPAR = 2;
    __device__ __forceinline__ const void* par_src(const Unit& u, int piece, int lane) const {
        if (piece == 0) return rowrs + u.pm * BM + lane * 4;
        return (lane < 32 ? bg : bu) + (size_t)u.aux * DFF + u.pn * 128 + (lane & 31) * 4;
    }
    __device__ __forceinline__ bool operator()(const f32x4 (&acc)[2][2][4][2], const Unit& u, int wr, int wc, int fr, int fq, const LAS unsigned char* par) const {
        const int row0 = u.pm * BM + wr * 64 + fr, ff0 = u.pn * 128 + wc * 32 + 8 * fq;
        const LAS float* bgp = (const LAS float*)(par + 1024) + wc * 32 + 8 * fq; const LAS float* bup = bgp + 128;
        const f32x4 bg0 = *(const LAS f32x4*)bgp, bg1 = *(const LAS f32x4*)(bgp + 4), bu0 = *(const LAS f32x4*)bup, bu1 = *(const LAS f32x4*)(bup + 4);
        float rsv[2][4];
#pragma unroll
        for (int ai = 0; ai < 2; ++ai)
#pragma unroll
            for (int m = 0; m < 4; ++m) rsv[ai][m] = ((const LAS float*)par)[wr * 64 + fr + ai * HALF + m * 16];
#pragma unroll
        for (int ai = 0; ai < 2; ++ai)
#pragma unroll
            for (int m = 0; m < 4; ++m) {
                const int row = row0 + ai * HALF + m * 16;
                const float rs = rsv[ai][m] * W8_INV;
                f32x4 g0 = acc[ai][0][m][0] * rs + bg0, g1 = acc[ai][0][m][1] * rs + bg1, u0 = acc[ai][1][m][0] * rs + bu0, u1 = acc[ai][1][m][1] * rs + bu1;
                f32x4 r0, r1;
#pragma unroll
                for (int j = 0; j < 4; ++j) {
                    { const float gt = fminf(g0[j], 7.0f), up = fminf(fmaxf(u0[j], -7.0f), 7.0f); r0[j] = (up + 1.0f) * gt * sigmoidf_(1.702f * gt); }
                    { const float gt = fminf(g1[j], 7.0f), up = fminf(fmaxf(u1[j], -7.0f), 7.0f); r1[j] = (up + 1.0f) * gt * sigmoidf_(1.702f * gt); }
                }
                u32x2 w; w.x = pk4_fp8(r0[0], r0[1], r0[2], r0[3]); w.y = pk4_fp8(r1[0], r1[1], r1[2], r1[3]);
                *(u32x2*)(act + (size_t)row * DFF + ff0) = w;
            }
        return false;
    }
};
struct EpiMoe2 {
    unsigned char* y8; const int* rowslot; const float* roww; const float* bd;
    static constexpr int NPAR = 3;
    __device__ __forceinline__ const void* par_src(const Unit& u, int piece, int lane) const {
        if (piece == 0) return rowslot + u.pm * BM + lane * 4;
        if (piece == 1) return roww + u.pm * BM + lane * 4;
        return bd + (size_t)u.aux * D + u.pn * BM + lane * 4;
    }
    __device__ __forceinline__ bool operator()(const f32x4 (&acc)[2][2][4][2], const Unit& u, int wr, int wc, int fr, int fq, const LAS unsigned char* par) const {
        const int row0 = u.pm * BM + wr * 64 + fr, col0 = u.pn * BM + wc * 32 + 8 * fq;
        const LAS float* bp = (const LAS float*)(par + 2048) + wc * 32 + 8 * fq;
        f32x4 bv[2][2];
#pragma unroll
        for (int bj = 0; bj < 2; ++bj) { bv[bj][0] = *(const LAS f32x4*)(bp + bj * HALF); bv[bj][1] = *(const LAS f32x4*)(bp + bj * HALF + 4); }
        int slotv[2][4]; float wv8[2][4];
#pragma unroll
        for (int ai = 0; ai < 2; ++ai)
#pragma unroll
            for (int m = 0; m < 4; ++m) { const int rl = wr * 64 + fr + ai * HALF + m * 16; slotv[ai][m] = ((const LAS int*)par)[rl]; wv8[ai][m] = ((const LAS float*)(par + 1024))[rl]; }
#pragma unroll
        for (int ai = 0; ai < 2; ++ai)
#pragma unroll
            for (int m = 0; m < 4; ++m) {
                const int slot = slotv[ai][m];
                if (slot >= 0) {
                    const float w8 = wv8[ai][m];
#pragma unroll
                    for (int bj = 0; bj < 2; ++bj) {
                        const f32x4 v0 = (acc[ai][bj][m][0] * W8_INV + bv[bj][0]) * w8, v1 = (acc[ai][bj][m][1] * W8_INV + bv[bj][1]) * w8;
                        u32x2 w; w.x = pk4_fp8(v0[0], v0[1], v0[2], v0[3]); w.y = pk4_fp8(v1[0], v1[1], v1[2], v1[3]);
                        *(u32x2*)(y8 + (size_t)slot * 1024 + col0 + bj * HALF) = w;
                    }
                }
            }
        return false;
    }
};

__device__ __forceinline__ void transpose_tile(LAS float* tile, const float* src, int ldsrc, int k0, int n0, bf16_t* dst, int ldd, int drow0, const float* sa, const float* mu, int mode, bool zero) {
    const int tid = threadIdx.x;
    if (!zero) {
#pragma unroll
        for (int i = 0; i < 2; ++i) {
            const int r = (tid >> 4) + 32 * i, c4 = (tid & 15) * 4;
            const f32x4 v = *(const f32x4*)(src + (size_t)(k0 + r) * ldsrc + n0 + c4);
            LAS float* t = tile + r * 65 + c4;
            t[0] = v[0]; t[1] = v[1]; t[2] = v[2]; t[3] = v[3];
        }
    }
    __syncthreads();
    {
        const int n = tid >> 3, kq = tid & 7;
        float v[8];
#pragma unroll
        for (int j = 0; j < 8; ++j) {
            const int k = k0 + 8 * kq + j;
            float s = sa ? sa[k] : 1.0f;
            if (mode == 1) s *= (1.0f - mu[k]);
            if (mode == 2) s *= mu[k];
            v[j] = zero ? 0.f : tile[(8 * kq + j) * 65 + n] * s;
        }
        u32x4 w; w.x = cvt_pk_bf16(v[0], v[1]); w.y = cvt_pk_bf16(v[2], v[3]); w.z = cvt_pk_bf16(v[4], v[5]); w.w = cvt_pk_bf16(v[6], v[7]);
        *(u32x4*)(dst + (size_t)(drow0 + n) * ldd + k0 + 8 * kq) = w;
    }
    __syncthreads();
}

__device__ __forceinline__ void phase_prep(const PPv& p, LAS unsigned char* lds) {
    const int tid = threadIdx.x, bid = blockIdx.x, nb = gridDim.x, lane = tid & 63, wave = tid >> 6;
    unsigned char* ws = p.gws();
    const float* x = p.gin(0); const float* meta = p.gin(1); const float* g1 = p.gin(2);
    if (bid == 0 && tid < 64) ((int*)(ws + OFF_GCNT))[tid] = 0;
    {
        bf16_t* HB = (bf16_t*)(ws + OFF_HB); float* rstd1 = (float*)(ws + OFF_RSTD1);
        for (int row0 = (bid * 8 + wave) * 4; row0 < NR; row0 += nb * 32) {
            f32x4 v[4][4];
#pragma unroll
            for (int u = 0; u < 4; ++u) {
                const int row = row0 + u < NR ? row0 + u : NR - 1;
                const float* src = row < NMETA ? meta + (size_t)row * D : x + (size_t)(row - NMETA) * D;
#pragma unroll
                for (int i = 0; i < 4; ++i) v[u][i] = __builtin_nontemporal_load((const f32x4*)(src + i * 256 + lane * 4));
            }
#pragma unroll
            for (int u = 0; u < 4; ++u) {
                const int row = row0 + u;
                if (row < NR) {
                    float ss = 0.f;
#pragma unroll
                    for (int i = 0; i < 4; ++i) ss += v[u][i][0] * v[u][i][0] + v[u][i][1] * v[u][i][1] + v[u][i][2] * v[u][i][2] + v[u][i][3] * v[u][i][3];
                    ss = wave_sum_dpp(ss);
                    if (lane == 0) rstd1[row] = rsqrtf(ss * (1.0f / D) + NORM_EPS);
                    if (row >= NMETA) {
                        bf16_t* d = HB + (size_t)(row - NMETA) * D;
#pragma unroll
                        for (int i = 0; i < 4; ++i) { u32x2 w; w.x = cvt_pk_bf16(v[u][i][0], v[u][i][1]); w.y = cvt_pk_bf16(v[u][i][2], v[u][i][3]); *(u32x2*)(d + i * 256 + lane * 4) = w; }
                    }
                }
            }
        }
    }
    LAS float* tile = (LAS float*)lds;
    {
        bf16_t* WIN = (bf16_t*)(ws + OFF_WIN);
        const float* w_in = p.gin(3);
        for (int j = bid; j < 16 * 88; j += nb) {
            const int kt = j & 15, ntile = j >> 4, n0 = ntile * 64;
            const float* src; int ld, sn0, mode = 0; const float* mu = nullptr;
            if (n0 < 3072) { src = w_in; ld = 5120; sn0 = n0; }
            else if (n0 < 3584) {
                const int seg = (n0 - 3072) >> 6;
                if (seg < 2) { src = p.gin(11); ld = 64; sn0 = 0; mu = p.gin(7); mode = 1 + seg; }
                else if (seg < 4) { src = p.gin(14); ld = 64; sn0 = 0; mu = p.gin(8); mode = 1 + (seg - 2); }
                else { src = p.gin(16); ld = 128; sn0 = (seg & 1) * 64; mu = p.gin(9); mode = seg < 6 ? 1 : 2; }
            } else { src = w_in; ld = 5120; sn0 = n0 - 512; }
            transpose_tile(tile, src, ld, kt * 64, sn0, WIN, 1024, n0, g1, mu, mode, false);
        }
        for (int j = bid; j < 2 * 128; j += nb) {
            const int which = j >> 7, jj = j & 127, kt = jj & 7, ntile = jj >> 3;
            transpose_tile(tile, which ? p.gin(25) : p.gin(23), 1024, kt * 64, ntile * 64, (bf16_t*)(ws + (which ? OFF_WC : OFF_WR)), 512, ntile * 64, nullptr, nullptr, 0, false);
        }
        for (int j = bid; j < 256; j += nb) {
            const int kt = j & 15, ntile = j >> 4;
            transpose_tile(tile, p.gin(26), 1024, kt * 64, ntile * 64, (bf16_t*)(ws + OFF_WO), 1024, ntile * 64, nullptr, nullptr, 0, false);
        }
        for (int j = bid; j < 96; j += nb) {
            const int kt = j & 3, ntile = j >> 2, seg = ntile >> 3, nn0 = (ntile & 7) * 64;
            const float* src = nullptr; int sk0 = 0; bool zero = true;
            if (seg == 0 && kt == 0) { src = p.gin(12); sk0 = 0; zero = false; }
            if (seg == 1 && kt == 1) { src = p.gin(15); sk0 = 0; zero = false; }
            if (seg == 2 && kt >= 2) { src = p.gin(17); sk0 = (kt - 2) * 64; zero = false; }
            const float* srcs = zero ? p.gin(12) : src + (size_t)(sk0 - kt * 64) * 512;
            transpose_tile(tile, srcs, 512, kt * 64, nn0, (bf16_t*)(ws + OFF_W2), 256, ntile * 64, nullptr, nullptr, 0, zero);
        }
        {
            float* WRG = (float*)(ws + OFF_WRG); const float* g2 = p.gin(27); const float* wr_ = p.gin(28);
            for (int i = bid * 512 + tid; i < 1024 * 32; i += nb * 512) WRG[i] = g2[i >> 5] * wr_[i];
        }
    }
}

__device__ __forceinline__ void phase_meta_proj(const PPv& p, LAS unsigned char* lds) {
    const int tid = threadIdx.x, bid = blockIdx.x, lane = tid & 63, wave = tid >> 6;
    unsigned char* ws = p.gws();
    LAS float* sm = (LAS float*)lds;
    const float* meta = p.gin(1);
    for (int i = tid; i < 16 * 256; i += 512) { const int r = i >> 8, c4 = (i & 255) * 4; const f32x4 v = *(const f32x4*)(meta + r * 1024 + c4); LAS float* d = sm + r * 1028 + c4; d[0] = v[0]; d[1] = v[1]; d[2] = v[2]; d[3] = v[3]; }
    __syncthreads();
    const float* rstd1 = (const float*)(ws + OFF_RSTD1);
    for (int nbase = bid * 14; nbase < PCOLS1; nbase += gridDim.x * 14) {
        for (int nn = wave; nn < 14; nn += 8) {
            const int n = nbase + nn;
            if (n >= PCOLS1) break;
            const bf16_t* wrow = (const bf16_t*)(ws + OFF_WIN) + (size_t)n * 1024;
            const u32x4 w0 = *(const u32x4*)(wrow + 8 * lane), w1 = *(const u32x4*)(wrow + 512 + 8 * lane);
            const float wf[16] = {bflo(w0.x), bfhi(w0.x), bflo(w0.y), bfhi(w0.y), bflo(w0.z), bfhi(w0.z), bflo(w0.w), bfhi(w0.w),
                                  bflo(w1.x), bfhi(w1.x), bflo(w1.y), bfhi(w1.y), bflo(w1.z), bfhi(w1.z), bflo(w1.w), bfhi(w1.w)};
            float outv = 0.f;
#pragma unroll
            for (int pr = 0; pr < 16; ++pr) {
                const LAS float* m0 = sm + pr * 1028 + 8 * lane;
                const f32x4 a0 = *(const LAS f32x4*)m0, a1 = *(const LAS f32x4*)(m0 + 4), a2 = *(const LAS f32x4*)(m0 + 512), a3 = *(const LAS f32x4*)(m0 + 516);
                float acc = a0[0] * wf[0] + a0[1] * wf[1] + a0[2] * wf[2] + a0[3] * wf[3] + a1[0] * wf[4] + a1[1] * wf[5] + a1[2] * wf[6] + a1[3] * wf[7]
                          + a2[0] * wf[8] + a2[1] * wf[9] + a2[2] * wf[10] + a2[3] * wf[11] + a3[0] * wf[12] + a3[1] * wf[13] + a3[2] * wf[14] + a3[3] * wf[15];
                acc = wave_sum_dpp(acc);
                outv = (lane == pr) ? acc * rstd1[pr] : outv;
            }
            if (lane < 16) {
                if (n < 1536) ((bf16_t*)(ws + OFF_PRKV))[(size_t)lane * 1536 + n] = f2bf(outv);
                else ((bf16_t*)(ws + OFF_PCONV))[(size_t)lane * 2048 + n - 1536] = f2bf(outv);
            }
        }
    }
    __syncthreads();
}

__device__ __forceinline__ void phase_meta_lora(const PPv& p) {
    const int tid = threadIdx.x, bid = blockIdx.x, nb = gridDim.x, lane = tid & 63, wave = tid >> 6;
    unsigned char* ws = p.gws();
    const bf16_t* L = (const bf16_t*)(ws + OFF_L); const bf16_t* W2 = (const bf16_t*)(ws + OFF_W2);
    for (int n = bid * 8 + wave; n < 1536; n += nb * 8) {
        const int seg = n >> 9, c = n & 511;
        const u32x2 wv = *(const u32x2*)(W2 + (size_t)n * 256 + 4 * lane);
        const float w0v = bflo(wv.x), w1v = bfhi(wv.x), w2v = bflo(wv.y), w3v = bfhi(wv.y);
        float outv = 0.f;
#pragma unroll
        for (int r = 0; r < 16; ++r) {
            const u32x2 lv = *(const u32x2*)(L + (size_t)r * 256 + 4 * lane);
            float acc = bflo(lv.x) * w0v + bfhi(lv.x) * w1v + bflo(lv.y) * w2v + bfhi(lv.y) * w3v;
            acc = wave_sum_dpp(acc);
            outv = (lane == r) ? acc : outv;
        }
        if (lane < 16) {
            float v = outv;
            if (seg == 0) v = -0.60653065971f * sigmoidf_(v + p.gin(10)[c]);
            if (seg == 1) v = sigmoidf_(v + p.gin(13)[c]);
            bf16_t* ob = (bf16_t*)(ws + (seg == 0 ? OFF_LD : seg == 1 ? OFF_A : OFF_G));
            ob[(size_t)lane * 512 + c] = f2bf(v);
        }
    }
}

__device__ __forceinline__ void phase_lprep_conv(const PPv& p) {
    const int tid = threadIdx.x, bid = blockIdx.x, nb = gridDim.x;
    unsigned char* ws = p.gws();
    const bf16_t* PROJ = (const bf16_t*)(ws + OFF_PCONV);
    constexpr int PCOLS = 2048;
    bf16_t* L = (bf16_t*)(ws + OFF_L);
    for (int i = bid * 512 + tid; i < NRP * 32; i += nb * 512) {
        const int row = i >> 5, gq = i & 31;
        u32x4 w = (u32x4){0u, 0u, 0u, 0u};
        if (row < NR) {
            int ca, cb;
            if (gq < 8) { ca = 1536 + gq * 8; cb = ca + 64; }
            else if (gq < 16) { ca = 1536 + 128 + (gq - 8) * 8; cb = ca + 64; }
            else { ca = 1536 + 256 + (gq - 16) * 8; cb = ca + 128; }
            const u32x4 va = *(const u32x4*)(PROJ + (size_t)row * PCOLS + ca);
            const int pr = prev_row(row, 1);
            u32x4 vb = (u32x4){0u, 0u, 0u, 0u};
            if (pr >= 0) vb = *(const u32x4*)(PROJ + (size_t)pr * PCOLS + cb);
            float v[8] = {bflo(va.x) + bflo(vb.x), bfhi(va.x) + bfhi(vb.x), bflo(va.y) + bflo(vb.y), bfhi(va.y) + bfhi(vb.y), bflo(va.z) + bflo(vb.z), bfhi(va.z) + bfhi(vb.z), bflo(va.w) + bflo(vb.w), bfhi(va.w) + bfhi(vb.w)};
#pragma unroll
            for (int j = 0; j < 8; ++j) { if (gq < 8) v[j] = tanhf(v[j]); else if (gq >= 16) v[j] = sigmoidf_(v[j]); }
            w.x = cvt_pk_bf16(v[0], v[1]); w.y = cvt_pk_bf16(v[2], v[3]); w.z = cvt_pk_bf16(v[4], v[5]); w.w = cvt_pk_bf16(v[6], v[7]);
        }
        *(u32x4*)(L + (size_t)row * 256 + gq * 8) = w;
    }
    bf16_t* C = (bf16_t*)(ws + OFF_C);
    const float* cw = p.gin(24);
    for (int i = bid * 512 + tid; i < T * 64; i += nb * 512) {
        const int m = i >> 6, ch = (i & 63) * 8, row = NMETA + m;
        const int r1 = prev_row(row, 1), r2 = prev_row(row, 2);
        const bf16_t* p0 = PROJ + (size_t)row * PCOLS; const bf16_t* p1 = PROJ + (size_t)r1 * PCOLS; const bf16_t* p2 = PROJ + (size_t)r2 * PCOLS;
        const u32x4 vb = *(const u32x4*)(p0 + ch);
        const u32x4 c0 = *(const u32x4*)(p0 + 512 + ch), h0 = *(const u32x4*)(p0 + 1024 + ch);
        const u32x4 c1 = *(const u32x4*)(p1 + 512 + ch), h1 = *(const u32x4*)(p1 + 1024 + ch);
        const u32x4 c2 = *(const u32x4*)(p2 + 512 + ch), h2 = *(const u32x4*)(p2 + 1024 + ch);
        float o[8];
#pragma unroll
        for (int j = 0; j < 8; ++j) {
            const unsigned wb = j < 2 ? vb.x : j < 4 ? vb.y : j < 6 ? vb.z : vb.w;
            const unsigned wc0 = j < 2 ? c0.x : j < 4 ? c0.y : j < 6 ? c0.z : c0.w, wh0 = j < 2 ? h0.x : j < 4 ? h0.y : j < 6 ? h0.z : h0.w;
            const unsigned wc1 = j < 2 ? c1.x : j < 4 ? c1.y : j < 6 ? c1.z : c1.w, wh1 = j < 2 ? h1.x : j < 4 ? h1.y : j < 6 ? h1.z : h1.w;
            const unsigned wc2 = j < 2 ? c2.x : j < 4 ? c2.y : j < 6 ? c2.z : c2.w, wh2 = j < 2 ? h2.x : j < 4 ? h2.y : j < 6 ? h2.z : h2.w;
            const bool hi = j & 1;
            const float b = hi ? bfhi(wb) : bflo(wb);
            const float u0 = (hi ? bfhi(wc0) : bflo(wc0)) * (hi ? bfhi(wh0) : bflo(wh0));
            const float u1 = (hi ? bfhi(wc1) : bflo(wc1)) * (hi ? bfhi(wh1) : bflo(wh1));
            const float u2 = (hi ? bfhi(wc2) : bflo(wc2)) * (hi ? bfhi(wh2) : bflo(wh2));
            const float conv = cw[ch + j] * u2 + cw[512 + ch + j] * u1 + cw[1024 + ch + j] * u0;
            o[j] = b * conv;
        }
        u32x4 w; w.x = cvt_pk_bf16(o[0], o[1]); w.y = cvt_pk_bf16(o[2], o[3]); w.z = cvt_pk_bf16(o[4], o[5]); w.w = cvt_pk_bf16(o[6], o[7]);
        *(u32x4*)(C + (size_t)m * 512 + ch) = w;
    }
}

template <int CTRL> __device__ __forceinline__ float dppmov(float v) { return __builtin_bit_cast(float, __builtin_amdgcn_update_dpp(0, __builtin_bit_cast(int, v), CTRL, 0xF, 0xF, true)); }
__device__ __forceinline__ float wave_sum_dpp(float v) {
    v += dppmov<0xB1>(v);
    v += dppmov<0x4E>(v);
    v += dppmov<0x141>(v);
    v += dppmov<0x140>(v);
    { float c = v; asm volatile("v_nop\n\tv_nop\n\tv_permlane16_swap_b32 %0, %1\n\tv_nop" : "+v"(v), "+v"(c)); v += c; }
    { float c = v; asm volatile("v_nop\n\tv_nop\n\tv_permlane32_swap_b32 %0, %1\n\tv_nop" : "+v"(v), "+v"(c)); v += c; }
    return v;
}
typedef float f32x16 __attribute__((ext_vector_type(16)));

struct RawTok { bf16_t r, k, v, a, ld; };
__device__ __forceinline__ RawTok load_raw(const bf16_t* PRKV, const bf16_t* Ab, const bf16_t* LD, int row, int col) {
    RawTok q; const bf16_t* p0 = PRKV + (size_t)row * 1536 + col;
    q.r = p0[0]; q.k = p0[512]; q.v = p0[1024]; q.a = Ab[(size_t)row * 512 + col]; q.ld = LD[(size_t)row * 512 + col];
    return q;
}
__device__ __forceinline__ void unit_geom(int uid, int lane, int& b, int& h, int& c, int& col, int& row0) {
    const int bh = uid / NCHUNK; c = uid - bh * NCHUNK; b = bh >> 3; h = bh & 7; col = h * 64 + lane;
    row0 = c == 0 ? 0 : b * SEQ + c * 16;
}
__device__ __forceinline__ void phase_scanprep(const PPv& p, LAS unsigned char* lds) {
    const int tid = threadIdx.x, bid = blockIdx.x, nb = gridDim.x, lane = tid & 63, wave = tid >> 6;
    unsigned char* ws = p.gws();
    const bf16_t* PRKV = (const bf16_t*)(ws + OFF_PRKV);
    const bf16_t* LD = (const bf16_t*)(ws + OFF_LD);
    const bf16_t* Ab = (const bf16_t*)(ws + OFF_A);
    float* COEF = (float*)(ws + OFF_COEF);
    LAS unsigned char* wl = lds + wave * 13824;
    LAS bf16_t* AR = (LAS bf16_t*)wl;
    LAS bf16_t* BK = (LAS bf16_t*)(wl + 4608);
    LAS float* DM = (LAS float*)(wl + 9216);
    const int qperm = (lane & 32) | (((lane >> 2) & 3) << 3) | (((lane >> 4) & 1) << 2) | (lane & 3);
    int uid = bid * 8 + wave;
    if (uid >= NUNITS) return;
    int b, h, c, col, row0;
    unit_geom(uid, lane, b, h, c, col, row0);
    RawTok q[16], qn[16];
    bf16_t prr = 0, prk = 0, prv = 0, nprr = 0, nprk = 0, nprv = 0;
#pragma unroll
    for (int t = 0; t < 16; ++t) q[t] = load_raw(PRKV, Ab, LD, row0 + t, col);
    { const int pr = prev_row(row0, 1); if (pr >= 0) { const bf16_t* p1 = PRKV + (size_t)pr * 1536 + col; prr = p1[0]; prk = p1[512]; prv = p1[1024]; } }
    for (;;) {
        const float mur = p.gin(4)[col], muk = p.gin(5)[col], muv = p.gin(6)[col], kkw = p.gin(18)[col], kaw = p.gin(19)[col], rkw = p.gin(20)[col];
        const int nuid = uid + nb * 8; const bool has_next = nuid < NUNITS;
        int nb_ = b, nh = h, nc = c, ncol = col, nrow0 = row0;
        if (has_next) {
            unit_geom(nuid, lane, nb_, nh, nc, ncol, nrow0);
#pragma unroll
            for (int t = 0; t < 16; ++t) qn[t] = load_raw(PRKV, Ab, LD, nrow0 + t, ncol);
            nprr = 0; nprk = 0; nprv = 0;
            const int pr = prev_row(nrow0, 1); if (pr >= 0) { const bf16_t* p1 = PRKV + (size_t)pr * 1536 + ncol; nprr = p1[0]; nprk = p1[512]; nprv = p1[1024]; }
        }
        __builtin_amdgcn_sched_barrier(0);
        LAS float* PM = (LAS float*)wl;
        LAS float* RS = DM;
        {
            float rp = bf2f(prr), kp = bf2f(prk);
#pragma unroll
            for (int t = 0; t < 16; ++t) {
                const RawTok qq = q[t];
                const float r0 = bf2f(qq.r), k0 = bf2f(qq.k);
                const float r = r0 + (rp - r0) * mur, k = k0 + (kp - k0) * muk;
                rp = r0; kp = k0;
                const float a = bf2f(qq.a);
                const float kkv = k * kkw, k2 = k * (1.0f + (a - 1.0f) * kaw);
                PM[t * 68 + lane] = kkv * kkv; PM[(16 + t) * 68 + lane] = r * k2 * rkw;
            }
            asm volatile("" ::: "memory");
            const int rw = lane & 31, hf = lane >> 5;
            f32x4 s4 = (f32x4){0.f, 0.f, 0.f, 0.f};
#pragma unroll
            for (int i = 0; i < 8; ++i) s4 += *(const LAS f32x4*)(PM + rw * 68 + hf * 32 + i * 4);
            float sm = (s4[0] + s4[1]) + (s4[2] + s4[3]);
            { float c2 = sm; asm volatile("v_nop\n\tv_nop\n\tv_permlane32_swap_b32 %0, %1\n\tv_nop" : "+v"(sm), "+v"(c2)); sm += c2; }
            if (lane < 32) RS[lane] = sm;
            asm volatile("" ::: "memory");
            const float cfl = __shfl(sm, (lane & 15) + 16);
            if (lane < 16) COEF[(size_t)(row0 + lane) * 8 + h] = cfl;
        }
        __builtin_amdgcn_sched_barrier(0);
        float at[16], vt[16]; unsigned btp[8], ktp[8]; float bprev = 0.f, kprev = 0.f;
        float cl = 0.f;
        float rp = bf2f(prr), kp = bf2f(prk), vp = bf2f(prv);
        f32x4 n2v[4];
#pragma unroll
        for (int i = 0; i < 4; ++i) n2v[i] = *(const LAS f32x4*)(RS + 4 * i);
        asm volatile("" ::: "memory"); __builtin_amdgcn_sched_barrier(0);
#pragma unroll
        for (int t = 0; t < 16; ++t) {
            const RawTok qq = q[t];
            const float r0 = bf2f(qq.r), k0 = bf2f(qq.k), v0 = bf2f(qq.v);
            const float r = r0 + (rp - r0) * mur, k = k0 + (kp - k0) * muk, v = v0 + (vp - v0) * muv;
            rp = r0; kp = k0; vp = v0;
            const float a = bf2f(qq.a);
            const float kkv = k * kkw;
            const float kk = kkv * __builtin_amdgcn_rsqf(fmaxf(n2v[t >> 2][t & 3], 1e-24f));
            const float k2 = k * (1.0f + (a - 1.0f) * kaw);
            const float wcp = __expf(cl);
            cl += bf2f(qq.ld);
            const float wcn = __expf(cl), iw = __expf(-cl);
            const float btv = kk * a * iw, ktv = k2 * iw;
            at[t] = -kk * wcp; vt[t] = v;
            { const unsigned w = cvt_pk_bf16(at[t], r * wcn); AR[t * 72 + qperm] = (bf16_t)(w & 0xFFFFu); AR[(16 + t) * 72 + qperm] = (bf16_t)(w >> 16); }
            if (t & 1) {
                btp[t >> 1] = cvt_pk_bf16(bprev, btv); ktp[t >> 1] = cvt_pk_bf16(kprev, ktv);
                BK[(t - 1) * 72 + qperm] = (bf16_t)(btp[t >> 1] & 0xFFFFu); BK[t * 72 + qperm] = (bf16_t)(btp[t >> 1] >> 16);
                BK[(16 + t - 1) * 72 + qperm] = (bf16_t)(ktp[t >> 1] & 0xFFFFu); BK[(16 + t) * 72 + qperm] = (bf16_t)(ktp[t >> 1] >> 16);
            } else { bprev = btv; kprev = ktv; }
            if ((t & 3) == 3) __builtin_amdgcn_sched_barrier(0);
        }
        const float wcc = __expf(cl);
        {
            f32x16 dm;
#pragma unroll
            for (int i = 0; i < 16; ++i) dm[i] = 0.f;
            const int rr = lane & 31, hh = lane >> 5;
#pragma unroll
            for (int ks = 0; ks < 4; ++ks) {
                const bf16x8 fa = *(const LAS bf16x8*)(AR + rr * 72 + 16 * ks + 8 * hh);
                const bf16x8 fb = *(const LAS bf16x8*)(BK + rr * 72 + 16 * ks + 8 * hh);
                dm = __builtin_amdgcn_mfma_f32_32x32x16_bf16(fa, fb, dm, 0, 0, 0);
            }
#pragma unroll
            for (int reg = 0; reg < 16; ++reg) DM[((reg & 3) + 8 * (reg >> 2) + 4 * hh) * 36 + rr] = dm[reg];
        }
        __builtin_amdgcn_sched_barrier(0);
        float uh[16];
#pragma unroll
        for (int t = 0; t < 16; ++t) {
            float wv = at[t], uv = 0.f, wv2 = 0.f, uv2 = 0.f, uv3 = 0.f;
#pragma unroll
            for (int s4 = 0; s4 < 4; ++s4) {
                if (s4 * 4 < t) {
                    const f32x4 ab = *(const LAS f32x4*)(DM + t * 36 + s4 * 4), ak = *(const LAS f32x4*)(DM + t * 36 + 16 + s4 * 4);
#pragma unroll
                    for (int j = 0; j < 4; ++j) {
                        const int s_ = s4 * 4 + j;
                        if (s_ < t) {
                            if (j & 1) { wv2 += ab[j] * at[s_]; uv2 += ak[j] * vt[s_]; } else { wv += ab[j] * at[s_]; uv += ak[j] * vt[s_]; }
                            uv3 += ab[j] * uh[s_];
                        }
                    }
                }
            }
            wv += wv2; uv += uv2 + uv3;
            at[t] = wv; uh[t] = uv;
            asm volatile("" : "+v"(at[t]), "+v"(uh[t]));
        }
        __builtin_amdgcn_sched_barrier(0);
#pragma unroll
        for (int t = 0; t < 16; t += 2) { const unsigned w = cvt_pk_bf16(at[t], at[t + 1]); AR[t * 72 + qperm] = (bf16_t)(w & 0xFFFFu); AR[(t + 1) * 72 + qperm] = (bf16_t)(w >> 16); }
        unsigned char* rec = ws + OFF_CH + (size_t)uid * REC_BYTES;
#pragma unroll
        for (int i = 0; i < 2; ++i) {
            const int pc = i * 64 + lane, row = pc >> 3, part = pc & 7;
            *(u32x4*)(rec + RO_WH + pc * 16) = *(const LAS u32x4*)((LAS unsigned char*)AR + row * 144 + part * 16);
            *(u32x4*)(rec + RO_RT + pc * 16) = *(const LAS u32x4*)((LAS unsigned char*)AR + (16 + row) * 144 + part * 16);
        }
        {
            u32x4 w0, w1;
            w0.x = cvt_pk_bf16(uh[0], uh[1]); w0.y = cvt_pk_bf16(uh[2], uh[3]); w0.z = cvt_pk_bf16(uh[4], uh[5]); w0.w = cvt_pk_bf16(uh[6], uh[7]);
            w1.x = cvt_pk_bf16(uh[8], uh[9]); w1.y = cvt_pk_bf16(uh[10], uh[11]); w1.z = cvt_pk_bf16(uh[12], uh[13]); w1.w = cvt_pk_bf16(uh[14], uh[15]);
            *(u32x4*)(rec + RO_U0T + lane * 32) = w0; *(u32x4*)(rec + RO_U0T + lane * 32 + 16) = w1;
            w0.x = cvt_pk_bf16(vt[0], vt[1]); w0.y = cvt_pk_bf16(vt[2], vt[3]); w0.z = cvt_pk_bf16(vt[4], vt[5]); w0.w = cvt_pk_bf16(vt[6], vt[7]);
            w1.x = cvt_pk_bf16(vt[8], vt[9]); w1.y = cvt_pk_bf16(vt[10], vt[11]); w1.z = cvt_pk_bf16(vt[12], vt[13]); w1.w = cvt_pk_bf16(vt[14], vt[15]);
            *(u32x4*)(rec + RO_VT + lane * 32) = w0; *(u32x4*)(rec + RO_VT + lane * 32 + 16) = w1;
        }
#pragma unroll
        for (int g = 0; g < 4; ++g) {
            u32x4 w; w.x = btp[2 * g]; w.y = btp[2 * g + 1]; w.z = ktp[2 * g]; w.w = ktp[2 * g + 1];
            *(u32x4*)(rec + RO_BKT + lane * 64 + g * 16) = w;
        }
        {
            const int t = lane >> 2, g = lane & 3;
            const f32x4 rb = *(const LAS f32x4*)(DM + (16 + t) * 36 + 4 * g), rk = *(const LAS f32x4*)(DM + (16 + t) * 36 + 16 + 4 * g);
            float o[8];
#pragma unroll
            for (int j = 0; j < 4; ++j) { const bool keep = (4 * g + j) <= t; o[j] = keep ? rb[j] : 0.f; o[4 + j] = keep ? rk[j] : 0.f; }
            u32x4 w; w.x = cvt_pk_bf16(o[0], o[1]); w.y = cvt_pk_bf16(o[2], o[3]); w.z = cvt_pk_bf16(o[4], o[5]); w.w = cvt_pk_bf16(o[6], o[7]);
            *(u32x4*)(rec + RO_ARK + t * 64 + g * 16) = w;
        }
        *(float*)(rec + RO_WCC + lane * 4) = wcc;
        if (!has_next) break;
        uid = nuid; b = nb_; h = nh; c = nc; col = ncol; row0 = nrow0;
#pragma unroll
        for (int t = 0; t < 16; ++t) q[t] = qn[t];
        prr = nprr; prk = nprk; prv = nprv;
        __builtin_amdgcn_sched_barrier(0);
    }
}

__device__ __forceinline__ void convert_expert_weights(const PPv& p, LAS unsigned char* lds, int first, int stride);
struct RecOps { bf16x8 wA0, wA1, rA0, rA1, ark, bk[4]; u32x2 u0, vv; f32x4 wc[4]; };
__device__ __forceinline__ void load_ops(RecOps& o, LAS unsigned char* S, int vs, int fr, int g) {
    o.wA0 = *(const LAS bf16x8*)(S + RO_WH + fr * 128 + g * 16); o.wA1 = *(const LAS bf16x8*)(S + RO_WH + fr * 128 + 64 + g * 16);
    o.rA0 = *(const LAS bf16x8*)(S + RO_RT + fr * 128 + g * 16); o.rA1 = *(const LAS bf16x8*)(S + RO_RT + fr * 128 + 64 + g * 16);
    o.u0 = *(const LAS u32x2*)(S + RO_U0T + (16 * vs + fr) * 32 + g * 8);
    o.vv = *(const LAS u32x2*)(S + RO_VT + (16 * vs + fr) * 32 + g * 8);
    o.ark = *(const LAS bf16x8*)(S + RO_ARK + fr * 64 + g * 16);
#pragma unroll
    for (int m = 0; m < 4; ++m) { o.bk[m] = *(const LAS bf16x8*)(S + RO_BKT + (16 * m + fr) * 64 + g * 16); o.wc[m] = *(const LAS f32x4*)(S + RO_WCC + (16 * m + 4 * g) * 4); }
}
__device__ __forceinline__ void phase_recur(const PPv& p, LAS unsigned char* lds) {
    const int tid = threadIdx.x, bid = blockIdx.x, nb = gridDim.x, lane = tid & 63, wave = __builtin_amdgcn_readfirstlane(tid >> 6);
    unsigned char* ws = p.gws();
    if (bid >= 64) { convert_expert_weights(p, lds, bid - 64, nb - 64); return; }
    unsigned char* CHb = ws + OFF_CH + (size_t)(bid * NCHUNK) * REC_BYTES;
    constexpr int RSLOT = REC_BYTES, RN = 10, PF = 7;
#define R_BAR() do { asm volatile("s_waitcnt lgkmcnt(0)" ::: "memory"); __builtin_amdgcn_s_barrier(); asm volatile("" ::: "memory"); } while (0)
    if (wave >= 4) {
        const int lw = wave - 4;
#define R_ISSUE(x) do { \
            LAS unsigned char* _s = lds + ((x) % RN) * RSLOT; const unsigned char* _r = CHb + (size_t)(x) * REC_BYTES + lane * 16; \
            _Pragma("unroll") for (int _i = 0; _i < 3; ++_i) { const int _pc = lw + 4 * _i; __builtin_amdgcn_global_load_lds((const unsigned*)(_r + _pc * 1024), (LAS unsigned*)(_s + _pc * 1024), 16, 0, 0); } \
            if (lw == 0) __builtin_amdgcn_global_load_lds((const unsigned*)(_r + 12 * 1024), (LAS unsigned*)(_s + 12 * 1024), 16, 0, 0); \
            if (lw == 1) { if (lane < 16) __builtin_amdgcn_global_load_lds((const unsigned*)(_r + 13 * 1024), (LAS unsigned*)(_s + 13 * 1024), 16, 0, 0); } } while (0)
        for (int x = 0; x < PF; ++x) R_ISSUE(x);
        asm volatile("s_waitcnt vmcnt(0)" ::: "memory");
        R_BAR();
        for (int c = 0; c < NCHUNK; ++c) {
            const int x = c + PF;
            if (x < NCHUNK) R_ISSUE(x);
            if (x < NCHUNK) { if (lw < 2) asm volatile("s_waitcnt vmcnt(20)" ::: "memory"); else asm volatile("s_waitcnt vmcnt(15)" ::: "memory"); }
            else asm volatile("s_waitcnt vmcnt(0)" ::: "memory");
            R_BAR();
        }
#undef R_ISSUE
    } else {
        const int vs = wave, fr = lane & 15, g = lane >> 4;
        f32x4 H[4];
#pragma unroll
        for (int m = 0; m < 4; ++m) H[m] = (f32x4){0.f, 0.f, 0.f, 0.f};
        R_BAR();
        RecOps cur, nxt;
        load_ops(cur, lds, vs, fr, g);
        for (int c = 0; c < NCHUNK; ++c) {
            if (c + 1 < NCHUNK) load_ops(nxt, lds + ((c + 1) % RN) * RSLOT, vs, fr, g); else nxt = cur;
            u32x4 hb0, hb1;
            hb0.x = cvt_pk_bf16(H[0][0], H[0][1]); hb0.y = cvt_pk_bf16(H[0][2], H[0][3]); hb0.z = cvt_pk_bf16(H[1][0], H[1][1]); hb0.w = cvt_pk_bf16(H[1][2], H[1][3]);
            hb1.x = cvt_pk_bf16(H[2][0], H[2][1]); hb1.y = cvt_pk_bf16(H[2][2], H[2][3]); hb1.z = cvt_pk_bf16(H[3][0], H[3][1]); hb1.w = cvt_pk_bf16(H[3][2], H[3][3]);
            const bf16x8 hB0 = __builtin_bit_cast(bf16x8, hb0), hB1 = __builtin_bit_cast(bf16x8, hb1);
            f32x4 U = (f32x4){bflo(cur.u0.x), bfhi(cur.u0.x), bflo(cur.u0.y), bfhi(cur.u0.y)};
            U = __builtin_amdgcn_mfma_f32_16x16x32_bf16(cur.wA0, hB0, U, 0, 0, 0);
            U = __builtin_amdgcn_mfma_f32_16x16x32_bf16(cur.wA1, hB1, U, 0, 0, 0);
            f32x4 Y = (f32x4){0.f, 0.f, 0.f, 0.f};
            Y = __builtin_amdgcn_mfma_f32_16x16x32_bf16(cur.rA0, hB0, Y, 0, 0, 0);
            Y = __builtin_amdgcn_mfma_f32_16x16x32_bf16(cur.rA1, hB1, Y, 0, 0, 0);
            u32x4 uvw; uvw.x = cvt_pk_bf16(U[0], U[1]); uvw.y = cvt_pk_bf16(U[2], U[3]); uvw.z = cur.vv.x; uvw.w = cur.vv.y;
            const bf16x8 uv = __builtin_bit_cast(bf16x8, uvw);
            Y = __builtin_amdgcn_mfma_f32_16x16x32_bf16(cur.ark, uv, Y, 0, 0, 0);
#pragma unroll
            for (int m = 0; m < 4; ++m) { H[m] = __builtin_amdgcn_mfma_f32_16x16x32_bf16(cur.bk[m], uv, H[m], 0, 0, 0); H[m] *= cur.wc[m]; }
            u32x2 yw; yw.x = cvt_pk_bf16(Y[0], Y[1]); yw.y = cvt_pk_bf16(Y[2], Y[3]);
            *(u32x2*)(CHb + (size_t)c * REC_BYTES + RO_U0T + (16 * vs + fr) * 32 + g * 8) = yw;
            R_BAR();
            cur = nxt;
        }
    }
#undef R_BAR
}

__device__ __forceinline__ void phase_gn(const PPv& p) {
    const int tid = threadIdx.x, bid = blockIdx.x, nb = gridDim.x, lane = tid & 63, wave = tid >> 6;
    unsigned char* ws = p.gws();
    const bf16_t* Gb = (const bf16_t*)(ws + OFF_G); const float* COEF = (const float*)(ws + OFF_COEF);
    bf16_t* Z = (bf16_t*)(ws + OFF_Z);
    constexpr int NREAL = 64 * 256;
    for (int r0 = bid * 8 + wave; r0 < NREAL; r0 += nb * 16) {
        u32x4 y0[2], y1[2], v0[2], v1[2]; float cfv[2][16]; bf16_t ggv[2][16]; int colv[2], row0v[2], hv[2]; bool okv[2];
#pragma unroll
        for (int u = 0; u < 2; ++u) {
            const int r = r0 + u * nb * 8; okv[u] = r < NREAL;
            const int rr = okv[u] ? r : r0;
            const int bh = rr >> 8, c = (rr & 255) + 1, b = bh >> 3, h = bh & 7, uid = bh * NCHUNK + c;
            hv[u] = h; colv[u] = h * 64 + lane; row0v[u] = b * SEQ + c * 16;
            const unsigned char* rec = ws + OFF_CH + (size_t)uid * REC_BYTES;
            y0[u] = *(const u32x4*)(rec + RO_U0T + lane * 32); y1[u] = *(const u32x4*)(rec + RO_U0T + lane * 32 + 16);
            v0[u] = *(const u32x4*)(rec + RO_VT + lane * 32); v1[u] = *(const u32x4*)(rec + RO_VT + lane * 32 + 16);
#pragma unroll
            for (int t = 0; t < 16; ++t) { cfv[u][t] = COEF[(size_t)(row0v[u] + t) * 8 + h]; ggv[u][t] = Gb[(size_t)(row0v[u] + t) * 512 + colv[u]]; }
        }
#pragma unroll
        for (int u = 0; u < 2; ++u) {
            if (!okv[u]) continue;
            const int col = colv[u], row0 = row0v[u];
            const float lng = p.gin(21)[col], lnb = p.gin(22)[col];
            const unsigned yw[8] = {y0[u].x, y0[u].y, y0[u].z, y0[u].w, y1[u].x, y1[u].y, y1[u].z, y1[u].w}, vw[8] = {v0[u].x, v0[u].y, v0[u].z, v0[u].w, v1[u].x, v1[u].y, v1[u].z, v1[u].w};
#pragma unroll
            for (int t = 0; t < 16; ++t) {
                const float y = (t & 1) ? bfhi(yw[t >> 1]) : bflo(yw[t >> 1]);
                const float v = (t & 1) ? bfhi(vw[t >> 1]) : bflo(vw[t >> 1]);
                const float mean = wave_sum_dpp(y) * (1.0f / 64.0f);
                const float dlt = y - mean;
                const float var = wave_sum_dpp(dlt * dlt) * (1.0f / 64.0f);
                const float yn = dlt * rsqrtf(var + LNX_EPS) * lng + lnb;
                Z[(size_t)(row0 + t - NMETA) * 512 + col] = f2bf((yn + cfv[u][t] * v) * bf2f(ggv[u][t]));
            }
        }
    }
}

__device__ __forceinline__ void convert_expert_weights(const PPv& p, LAS unsigned char* lds, int first, int stride) {
    unsigned char* ws = p.gws();
    const int tid = threadIdx.x;
    LAS float* tile = (LAS float*)lds;
    const float* g2 = p.gin(27);
    unsigned char* WGU = ws + OFF_WGU; unsigned char* WD = ws + OFF_WD;
    constexpr int NBLK = NE * 3 * 64;
    const int lr = tid >> 6, lc = (tid & 63) * 4;
    f32x4 cur[8];
    int j = first;
    if (j >= NBLK) return;
    {
        const int mat = j >> 6, e = mat / 3, which = mat - 3 * e, bb = j & 63, kb = bb & 15, nbk = bb >> 4;
        const float* src = (which == 0 ? p.gin(30) : which == 1 ? p.gin(32) : p.gin(34)) + (size_t)e * 1024 * 1024 + (size_t)(kb * 64) * 1024 + nbk * 256;
#pragma unroll
        for (int i = 0; i < 8; ++i) cur[i] = __builtin_nontemporal_load((const f32x4*)(src + (size_t)(lr + 8 * i) * 1024 + lc));
    }
    for (;;) {
        const int jn = j + stride; const bool has_next = jn < NBLK;
        f32x4 nxt[8];
        if (has_next) {
            const int mat = jn >> 6, e = mat / 3, which = mat - 3 * e, bb = jn & 63, kb = bb & 15, nbk = bb >> 4;
            const float* src = (which == 0 ? p.gin(30) : which == 1 ? p.gin(32) : p.gin(34)) + (size_t)e * 1024 * 1024 + (size_t)(kb * 64) * 1024 + nbk * 256;
#pragma unroll
            for (int i = 0; i < 8; ++i) nxt[i] = __builtin_nontemporal_load((const f32x4*)(src + (size_t)(lr + 8 * i) * 1024 + lc));
        }
        const int mat = j >> 6, e = mat / 3, which = mat - 3 * e, bb = j & 63, kb = bb & 15, nbk = bb >> 4;
#pragma unroll
        for (int i = 0; i < 8; ++i) { LAS float* t = tile + (lr + 8 * i) * 257 + lc; t[0] = cur[i][0]; t[1] = cur[i][1]; t[2] = cur[i][2]; t[3] = cur[i][3]; }
        __syncthreads();
        {
            const int kq = tid & 7, k0 = kb * 64 + 8 * kq;
            float sc[8];
#pragma unroll
            for (int jj = 0; jj < 8; ++jj) sc[jj] = (which < 2 ? g2[k0 + jj] : 1.0f) * W8_SCALE;
#pragma unroll
            for (int i = 0; i < 4; ++i) {
                const int nn = (tid >> 3) + 64 * i, n = nbk * 256 + nn;
                float v[8];
#pragma unroll
                for (int jj = 0; jj < 8; ++jj) v[jj] = tile[(8 * kq + jj) * 257 + nn] * sc[jj];
                u32x2 w; w.x = pk4_fp8(v[0], v[1], v[2], v[3]); w.y = pk4_fp8(v[4], v[5], v[6], v[7]);
                unsigned char* dst = which < 2 ? WGU + (size_t)e * 2048 * 1024 + (size_t)(256 * (n >> 7) + 128 * which + (n & 127)) * 1024
                                               : WD + (size_t)e * 1024 * 1024 + (size_t)n * 1024;
                __builtin_nontemporal_store(w, (u32x2*)(dst + k0));
            }
        }
        __syncthreads();
        if (!has_next) break;
        j = jn;
#pragma unroll
        for (int i = 0; i < 8; ++i) cur[i] = nxt[i];
    }
}

__device__ __forceinline__ void phase_router(const PPv& p, LAS unsigned char* lds) {
    const int tid = threadIdx.x, bid = blockIdx.x, nb = gridDim.x, lane = tid & 63, wave = tid >> 6;
    unsigned char* ws = p.gws();
    const bf16_t* h1 = (const bf16_t*)(ws + OFF_HB2);
    const float* WRG = (const float*)(ws + OFF_WRG);
    const float* brt = p.gin(29);
    LAS float* slog = (LAS float*)lds;
    LAS float* srs = slog + 8 * 16 * 32;
    LAS int* lcnt = (LAS int*)(srs + 128);
    LAS int* gbase = lcnt + 32;
    LAS int* ltopi = gbase + 32;
    LAS int* lrank = ltopi + 512;
    int* TOPI = (int*)(ws + OFF_TOPI); float* TOPW = (float*)(ws + OFF_TOPW); int* RANK = (int*)(ws + OFF_RANK); float* RSTD2 = (float*)(ws + OFF_RSTD2);
    int* GCNT = (int*)(ws + OFF_GCNT);
    for (int tb = bid; tb < T / 128; tb += nb) {
        if (tid < 32) lcnt[tid] = 0;
        __syncthreads();
        const int t0 = tb * 128 + wave * 16;
        {
            const int row = lane & 15, kq = lane >> 4;
            const bf16_t* ap = h1 + (size_t)(t0 + row) * D + 4 * kq;
            const float* bp = WRG + (size_t)(4 * kq) * 32 + row;
            f32x4 acc0 = (f32x4){0.f, 0.f, 0.f, 0.f}, acc1 = acc0;
            float ss = 0.f;
            for (int j = 0; j < 64; ++j) {
                const u32x2 aw = *(const u32x2*)(ap + 16 * j);
                const f32x4 av = (f32x4){bflo(aw.x), bfhi(aw.x), bflo(aw.y), bfhi(aw.y)};
                ss += av[0] * av[0] + av[1] * av[1] + av[2] * av[2] + av[3] * av[3];
                const float* bj = bp + (size_t)(16 * j) * 32;
#pragma unroll
                for (int s = 0; s < 4; ++s) {
                    const float b0 = bj[s * 32], b1 = bj[s * 32 + 16];
                    acc0 = __builtin_amdgcn_mfma_f32_16x16x4f32(av[s], b0, acc0, 0, 0, 0);
                    acc1 = __builtin_amdgcn_mfma_f32_16x16x4f32(av[s], b1, acc1, 0, 0, 0);
                }
            }
            ss += __shfl_xor(ss, 16); ss += __shfl_xor(ss, 32);
#pragma unroll
            for (int reg = 0; reg < 4; ++reg) {
                slog[(wave * 16 + 4 * kq + reg) * 32 + row] = acc0[reg];
                slog[(wave * 16 + 4 * kq + reg) * 32 + 16 + row] = acc1[reg];
            }
            if (lane < 16) srs[wave * 16 + lane] = rsqrtf(ss * (1.0f / D) + NORM_EPS);
        }
        __syncthreads();
        if (lane < 16) {
            const int tl = wave * 16 + lane, t = tb * 128 + tl;
            const float rs = srs[tl];
            float lg[32];
#pragma unroll
            for (int e = 0; e < 32; ++e) lg[e] = slog[tl * 32 + e] * rs + brt[e];
            int ti[4]; float tv[4];
#pragma unroll
            for (int k = 0; k < 4; ++k) {
                float best = -3.0e38f; int bi = 0;
#pragma unroll
                for (int e = 0; e < 32; ++e) { const bool tk = lg[e] > best; best = tk ? lg[e] : best; bi = tk ? e : bi; }
                ti[k] = bi; tv[k] = best;
#pragma unroll
                for (int e = 0; e < 32; ++e) lg[e] = (e == bi) ? -3.0e38f : lg[e];
            }
            const float e0 = 1.0f, e1 = __expf(tv[1] - tv[0]), e2 = __expf(tv[2] - tv[0]), e3 = __expf(tv[3] - tv[0]);
            const float inv = 1.0f / (e0 + e1 + e2 + e3);
            *(f32x4*)(TOPW + (size_t)t * 4) = (f32x4){e0 * inv, e1 * inv, e2 * inv, e3 * inv};
            RSTD2[t] = rs;
#pragma unroll
            for (int k = 0; k < 4; ++k) { ltopi[tl * 4 + k] = ti[k]; lrank[tl * 4 + k] = __hip_atomic_fetch_add(lcnt + ti[k], 1, __ATOMIC_RELAXED, __HIP_MEMORY_SCOPE_WORKGROUP); }
        }
        __syncthreads();
        if (tid < 32) gbase[tid] = atomicAdd(GCNT + tid, lcnt[tid]);
        __syncthreads();
        {
            const int e = ltopi[tid];
            TOPI[(size_t)tb * 512 + tid] = e;
            RANK[(size_t)tb * 512 + tid] = gbase[e] + lrank[tid];
        }
        __syncthreads();
    }
}

__device__ __forceinline__ void phase_lists(const PPv& p, LAS unsigned char* lds) {
    const int tid = threadIdx.x, bid = blockIdx.x, nb = gridDim.x;
    unsigned char* ws = p.gws();
    LAS int* pstart = (LAS int*)lds;
    LAS int* cnt = pstart + 64;
    const int* GCNT = (const int*)(ws + OFF_GCNT);
    if (tid < 32) cnt[tid] = GCNT[tid];
    __syncthreads();
    if (tid == 0) { int s = 0; for (int e = 0; e < 32; ++e) { pstart[e] = s; s += ((cnt[e] + 255) >> 8) << 8; } pstart[32] = s; }
    __syncthreads();
    const int* TOPI = (const int*)(ws + OFF_TOPI); const float* TOPW = (const float*)(ws + OFF_TOPW); const int* RANK = (const int*)(ws + OFF_RANK); const float* RSTD2 = (const float*)(ws + OFF_RSTD2);
    int* ROWTOK = (int*)(ws + OFF_ROWTOK); int* ROWSLOT = (int*)(ws + OFF_ROWSLOT); float* ROWW = (float*)(ws + OFF_ROWW); float* ROWRS = (float*)(ws + OFF_ROWRS);
    for (int i = bid * 512 + tid; i < T * 4; i += nb * 512) {
        const int e = TOPI[i], pos = pstart[e] + RANK[i], t = i >> 2;
        ROWTOK[pos] = t; ROWSLOT[pos] = i; ROWW[pos] = TOPW[i]; ROWRS[pos] = RSTD2[t];
    }
    for (int e = bid; e < 32; e += nb) {
        for (int pos = pstart[e] + cnt[e] + tid; pos < pstart[e + 1]; pos += 512) { ROWTOK[pos] = 0; ROWSLOT[pos] = -1; ROWW[pos] = 0.f; ROWRS[pos] = 0.f; }
    }
    if (bid == 0) {
        int* TILEE = (int*)(ws + OFF_TILEE);
        const int ntiles = pstart[32] >> 8;
        for (int mt = tid; mt < ntiles; mt += 512) { int e = 0; for (int q = 0; q < 32; ++q) if (pstart[q] <= mt * 256) e = q; TILEE[mt] = e; }
        if (tid == 0) TILEE[1000] = ntiles;
    }
    __syncthreads();
}

__device__ __forceinline__ void phase_final(const PPv& p) {
    const int tid = threadIdx.x, bid = blockIdx.x, nb = gridDim.x, lane = tid & 63, wave = tid >> 6;
    unsigned char* ws = p.gws();
    const bf16_t* HB2 = (const bf16_t*)(ws + OFF_HB2);
    const unsigned char* Y8 = (const unsigned char*)p.gout();
    const float* gf = p.gin(36);
    const f32x4 ga0 = *(const f32x4*)(gf + 8 * lane), ga1 = *(const f32x4*)(gf + 8 * lane + 4), gb0 = *(const f32x4*)(gf + 512 + 8 * lane), gb1 = *(const f32x4*)(gf + 512 + 8 * lane + 4);
    for (int t0 = (bid * 8 + wave) * 2; t0 < T; t0 += nb * 16) {
        u32x4 ha[2], hb[2]; u32x2 ya[2][4], yb[2][4];
#pragma unroll
        for (int u = 0; u < 2; ++u) {
            const int t = t0 + u;
            ha[u] = __builtin_nontemporal_load((const u32x4*)(HB2 + (size_t)t * D + 8 * lane)); hb[u] = __builtin_nontemporal_load((const u32x4*)(HB2 + (size_t)t * D + 512 + 8 * lane));
#pragma unroll
            for (int k = 0; k < 4; ++k) { ya[u][k] = __builtin_nontemporal_load((const u32x2*)(Y8 + (size_t)(4 * t + k) * 1024 + 8 * lane)); yb[u][k] = __builtin_nontemporal_load((const u32x2*)(Y8 + (size_t)(4 * t + k) * 1024 + 512 + 8 * lane)); }
        }
#pragma unroll
        for (int u = 0; u < 2; ++u) {
            const int t = t0 + u;
            float va[8] = {bflo(ha[u].x), bfhi(ha[u].x), bflo(ha[u].y), bfhi(ha[u].y), bflo(ha[u].z), bfhi(ha[u].z), bflo(ha[u].w), bfhi(ha[u].w)};
            float vb[8] = {bflo(hb[u].x), bfhi(hb[u].x), bflo(hb[u].y), bfhi(hb[u].y), bflo(hb[u].z), bfhi(hb[u].z), bflo(hb[u].w), bfhi(hb[u].w)};
#pragma unroll
            for (int k = 0; k < 4; ++k) {
                const u32x2 a4 = ya[u][k], b4 = yb[u][k];
                { const f32x2 q0 = __builtin_amdgcn_cvt_pk_f32_fp8((int)a4.x, false), q1 = __builtin_amdgcn_cvt_pk_f32_fp8((int)a4.x, true), q2 = __builtin_amdgcn_cvt_pk_f32_fp8((int)a4.y, false), q3 = __builtin_amdgcn_cvt_pk_f32_fp8((int)a4.y, true);
                  va[0] += q0.x; va[1] += q0.y; va[2] += q1.x; va[3] += q1.y; va[4] += q2.x; va[5] += q2.y; va[6] += q3.x; va[7] += q3.y; }
                { const f32x2 q0 = __builtin_amdgcn_cvt_pk_f32_fp8((int)b4.x, false), q1 = __builtin_amdgcn_cvt_pk_f32_fp8((int)b4.x, true), q2 = __builtin_amdgcn_cvt_pk_f32_fp8((int)b4.y, false), q3 = __builtin_amdgcn_cvt_pk_f32_fp8((int)b4.y, true);
                  vb[0] += q0.x; vb[1] += q0.y; vb[2] += q1.x; vb[3] += q1.y; vb[4] += q2.x; vb[5] += q2.y; vb[6] += q3.x; vb[7] += q3.y; }
            }
            float ss = 0.f;
#pragma unroll
            for (int j = 0; j < 8; ++j) ss += va[j] * va[j] + vb[j] * vb[j];
            ss = wave_sum_dpp(ss);
            const float rs = rsqrtf(ss * (1.0f / D) + NORM_EPS);
            float* o = p.gout() + (size_t)t * D;
            __builtin_nontemporal_store((f32x4){va[0] * rs * ga0[0], va[1] * rs * ga0[1], va[2] * rs * ga0[2], va[3] * rs * ga0[3]}, (f32x4*)(o + 8 * lane));
            __builtin_nontemporal_store((f32x4){va[4] * rs * ga1[0], va[5] * rs * ga1[1], va[6] * rs * ga1[2], va[7] * rs * ga1[3]}, (f32x4*)(o + 8 * lane + 4));
            __builtin_nontemporal_store((f32x4){vb[0] * rs * gb0[0], vb[1] * rs * gb0[1], vb[2] * rs * gb0[2], vb[3] * rs * gb0[3]}, (f32x4*)(o + 512 + 8 * lane));
            __builtin_nontemporal_store((f32x4){vb[4] * rs * gb1[0], vb[5] * rs * gb1[1], vb[6] * rs * gb1[2], vb[7] * rs * gb1[3]}, (f32x4*)(o + 512 + 8 * lane + 4));
        }
    }
}

#define XB_TMO      128
#define XB_XCNT(j)  (256  + 64 * (j))
#define XB_XSUB(j)  (1280 + 64 * (j))
#define XB_XGEN(j)  (2304 + 64 * (j))
#define XB_TOP      3328
#define XB_TOPGEN   3392
#define XCD_BAR_WORDS 3456
#define XB_SPIN_CAP (1u << 18)
__device__ __forceinline__ unsigned xb_ld(unsigned* p)              { return __hip_atomic_load(p, __ATOMIC_RELAXED, __HIP_MEMORY_SCOPE_AGENT); }
__device__ __forceinline__ unsigned xb_add(unsigned* p, unsigned v) { return __hip_atomic_fetch_add(p, v, __ATOMIC_RELAXED, __HIP_MEMORY_SCOPE_AGENT); }
__device__ __forceinline__ unsigned xb_xcc_id() { return (unsigned)__builtin_amdgcn_s_getreg((3 << 11) | 20) & 0xFu; }
#define XB_SPIN(cond, bar) do { unsigned _sp = 0; while (cond) { __builtin_amdgcn_s_sleep(1); \
    if ((++_sp & 255u) == 0u) { if (xb_ld(&(bar)[XB_TMO])) break; if (_sp > XB_SPIN_CAP) { atomicAdd(&(bar)[XB_TMO], 1u); break; } } } } while (0)
struct XcdBarrier { unsigned* bar; unsigned x; volatile LAS unsigned* st; };
__device__ __forceinline__ XcdBarrier xcd_barrier_post(unsigned* bar, volatile LAS unsigned* st) {
    XcdBarrier b; b.bar = bar; b.x = xb_xcc_id(); b.st = st;
    if (threadIdx.x == 0) (void)xb_add(&bar[XB_XCNT(b.x)], 1u);
    return b;
}
__device__ __forceinline__ void xcd_barrier_complete(unsigned* bar, unsigned x, unsigned& nloc, unsigned& nx) {
    const unsigned G = gridDim.x * gridDim.y * gridDim.z;
    unsigned sum, cnt, mine, sp = 0u;
    for (;;) {
        sum = 0u; cnt = 0u; mine = 0u;
#pragma unroll
        for (unsigned j = 0; j < 16; ++j) { const unsigned c = xb_ld(&bar[XB_XCNT(j)]); sum += c; cnt += (c > 0u) ? 1u : 0u; mine = (j == x) ? c : mine; }
        if (sum == G) break;
        __builtin_amdgcn_s_sleep(1);
        if ((++sp & 255u) == 0u) { if (xb_ld(&bar[XB_TMO])) break; if (sp > XB_SPIN_CAP) { atomicAdd(&bar[XB_TMO], 1u); break; } }
    }
    nloc = mine > 0u ? mine : 1u; nx = cnt > 0u ? cnt : 1u;
}
__device__ __forceinline__ void xcd_barrier(const XcdBarrier& b) {
    asm volatile("s_waitcnt vmcnt(0)" ::: "memory");
    __syncthreads();
    if (threadIdx.x == 0) {
        unsigned* bar = b.bar;
        __builtin_amdgcn_s_waitcnt(0);
        unsigned nloc = b.st[0], nx = b.st[1];
        if (nloc == 0u) { xcd_barrier_complete(bar, b.x, nloc, nx); b.st[0] = nloc; b.st[1] = nx; }
        const unsigned old = xb_add(&bar[XB_XSUB(b.x)], 1u);
        const unsigned gen = old / nloc;
        if (old + 1u == (gen + 1u) * nloc) {
            __builtin_amdgcn_fence(__ATOMIC_RELEASE, "agent");
            asm volatile("s_waitcnt vmcnt(0)" ::: "memory");
            const unsigned og = xb_add(&bar[XB_TOP], 1u);
            const unsigned tg = og / nx;
            if (og + 1u == (tg + 1u) * nx) xb_add(&bar[XB_TOPGEN], 1u);
            else XB_SPIN(xb_ld(&bar[XB_TOPGEN]) == tg, bar);
            __builtin_amdgcn_fence(__ATOMIC_ACQUIRE, "agent");
            xb_add(&bar[XB_XGEN(b.x)], 1u);
            asm volatile("s_waitcnt vmcnt(0)" ::: "memory");
        } else {
            XB_SPIN(xb_ld(&bar[XB_XGEN(b.x)]) == gen, bar);
            __builtin_amdgcn_fence(__ATOMIC_ACQUIRE, "agent");
            asm volatile("s_waitcnt vmcnt(0)" ::: "memory");
        }
    }
    __syncthreads();
}

constexpr int N_PHASES = 15;
__global__ void __launch_bounds__(512, 2) mega(Params p) {
    extern __shared__ __attribute__((aligned(16))) unsigned char lds_raw[];
    LAS unsigned char* lds = (LAS unsigned char*)lds_raw;
    cg::grid_group grid = cg::this_grid();
    unsigned char* ws = getpp().gws();
    const int G = gridDim.x, bid = blockIdx.x;
#ifndef ONLY_PHASE
#define ONLY_PHASE -1
#endif
#define IN(k) ((ONLY_PHASE < 0 || ONLY_PHASE == (k)) && p.ph_lo <= (k) && (k) < p.ph_hi)
    volatile LAS unsigned* xst = (volatile LAS unsigned*)(lds + 163840 - 16);
    if (threadIdx.x < 4) xst[threadIdx.x] = 0u;
    __syncthreads();
    const XcdBarrier xbar = xcd_barrier_post((unsigned*)(ws + OFF_BAR), xst);
    if (p.ph_hi < 0) grid.sync();
#define SEAM(k) do { if ((k) + 1 < p.ph_hi) xcd_barrier(xbar); } while (0)
    if (IN(0)) { const PPv q = getpp(); phase_prep(q, lds); SEAM(0); }
    if (IN(1)) { const PPv q = getpp();
        phase_meta_proj(q, lds);
        StaticOrder S; S.init(ws + OFF_HB, ws + OFF_WIN, T, NCOLS1, 1024, G, bid);
        EpiProj E{(bf16_t*)(ws + OFF_PRKV), (bf16_t*)(ws + OFF_PCONV), (bf16_t*)q.gout(), (const float*)(ws + OFF_RSTD1)};
        gemm_phase<false>(lds, 1024, S, E);
        SEAM(1);
    }
    if (IN(2)) { const PPv q = getpp(); phase_lprep_conv(q); SEAM(2); }
    if (IN(3)) { const PPv q = getpp();
        phase_meta_lora(q);
        StaticOrder S; S.init(ws + OFF_L + (size_t)NMETA * 256 * 2, ws + OFF_W2, T, 1536, 256, G, bid);
        EpiL E{ws, q.gin(10), q.gin(13)};
        gemm_phase<false>(lds, 256, S, E);
        SEAM(3);
    }
    if (IN(4)) { const PPv q = getpp(); phase_scanprep(q, lds); SEAM(4); }
    if (IN(5)) { const PPv q = getpp(); phase_recur(q, lds); SEAM(5); }
    if (IN(6)) { const PPv q = getpp(); phase_gn(q); SEAM(6); }
    if (IN(7)) { const PPv q = getpp();
        MergeOrder S; S.so.init(ws + OFF_Z, ws + OFF_WR, T, 1024, 512, G, bid); S.A1 = (const char*)(ws + OFF_C); S.B1 = (const char*)(ws + OFF_WC);
        EpiMergeFused E{(bf16_t*)(ws + OFF_MERGED), (const bf16_t*)q.gout()};
        gemm_phase<false>(lds, 512, S, E);
        SEAM(7);
    }
    if (IN(9)) { const PPv q = getpp();
        StaticOrder S; S.init(ws + OFF_MERGED, ws + OFF_WO, T, 1024, 1024, G, bid);
        EpiO E{q.gin(0), q.gout(), (bf16_t*)(ws + OFF_HB2), ws + OFF_HB8};
        gemm_phase<false>(lds, 1024, S, E);
        SEAM(9);
    }
    if (IN(10)) { const PPv q = getpp(); phase_router(q, lds); SEAM(10); }
    if (IN(11)) { const PPv q = getpp(); phase_lists(q, lds); SEAM(11); }
    if (IN(12)) { const PPv q = getpp();
        const int* TILEE = (const int*)(ws + OFF_TILEE);
        MoeOrder S; S.A = (const char*)(ws + OFF_HB8); S.Bt = (const char*)(ws + OFF_WGU); S.K = 512; S.estride = (size_t)2048 * 1024;
        S.tile_e = TILEE; S.rowtok = (const int*)(ws + OFF_ROWTOK); S.ntiles = TILEE[1000]; S.nnt = 8; S.G = G; S.c = bid; S.gather = true;
        EpiMoe1 E{ws + OFF_ACT, (const float*)(ws + OFF_ROWRS), q.gin(31), q.gin(33)};
        gemm_phase<true, true>(lds, 512, S, E);
        SEAM(12);
    }
    if (IN(13)) { const PPv q = getpp();
        const int* TILEE = (const int*)(ws + OFF_TILEE);
        MoeOrder S; S.A = (const char*)(ws + OFF_ACT); S.Bt = (const char*)(ws + OFF_WD); S.K = 512; S.estride = (size_t)1024 * 1024;
        S.tile_e = TILEE; S.rowtok = nullptr; S.ntiles = TILEE[1000]; S.nnt = 4; S.G = G; S.c = bid; S.gather = false;
        EpiMoe2 E{(unsigned char*)q.gout(), (const int*)(ws + OFF_ROWSLOT), (const float*)(ws + OFF_ROWW), q.gin(35)};
        gemm_phase<false, true>(lds, 512, S, E);
        SEAM(13);
    }
    if (IN(14)) { const PPv q = getpp(); phase_final(q); }
}

extern "C" void kernel_launch(void* const* d_in, const int* in_sizes, int n_in, void* d_out, int out_size, void* d_ws, size_t ws_size,
                              hipStream_t stream) {
    constexpr size_t kDynLds = 160 * 1024;
    static int grid_blocks = 0;
    if (!grid_blocks) {
        int dev = 0, cus = 0, per_cu = 0;
        (void)hipGetDevice(&dev);
        (void)hipDeviceGetAttribute(&cus, hipDeviceAttributeMultiprocessorCount, dev);
        (void)hipFuncSetAttribute((const void*)mega, hipFuncAttributeMaxDynamicSharedMemorySize, (int)kDynLds);
        (void)hipOccupancyMaxActiveBlocksPerMultiprocessor(&per_cu, mega, 512, kDynLds);
        if (per_cu > 1) per_cu = 1;
        grid_blocks = cus * per_cu;
        fprintf(stderr, "cus=%d per_cu=%d ws_size=%zu need=%zu\n", cus, per_cu, ws_size, (size_t)WS_NEED);
    }
    if (ws_size < WS_NEED || n_in < 37 || grid_blocks < 128) { fprintf(stderr, "kernel_launch: unsupported configuration\n"); return; }
    Params p{};
    for (int i = 0; i < 37; ++i) p.in[i] = (const float*)d_in[i];
    p.out = (float*)d_out;
    p.ws = (unsigned char*)d_ws;
    p.ph_lo = 0; p.ph_hi = N_PHASES;
    (void)hipMemsetAsync((unsigned char*)d_ws + OFF_BAR, 0, 16384, stream);
    void* args[] = {&p};
    hipError_t e = hipLaunchCooperativeKernel((void*)mega, dim3(grid_blocks), dim3(512), args, kDynLds, stream);
    if (e != hipSuccess) fprintf(stderr, "cooperative launch failed: %s (grid %d)\n", hipGetErrorString(e), grid_blocks);
}
```

```cpp
#include <hip/hip_runtime.h>
#include <hip/hip_cooperative_groups.h>
#include <cstdio>
namespace cg = cooperative_groups;

#define LAS __attribute__((address_space(3)))
typedef unsigned short bf16_t;
typedef short bf16x8 __attribute__((ext_vector_type(8)));
typedef float f32x4 __attribute__((ext_vector_type(4)));
typedef float f32x2 __attribute__((ext_vector_type(2)));
typedef unsigned u32x4 __attribute__((ext_vector_type(4)));
typedef unsigned u32x2 __attribute__((ext_vector_type(2)));

constexpr int D = 1024, NBATCH = 8, SEQ = 4096, NMETA = 16;
constexpr int T = NBATCH * SEQ;
constexpr int NR = T + NMETA;
constexpr int NRP = 33024;
constexpr int PCOLS1 = 3584;
constexpr int NCOLS1 = 5632;
constexpr int NE = 32, TOPK = 4, DFF = 1024;
constexpr int MAXROWS = T * TOPK + NE * 256;
constexpr int MAXTILES = MAXROWS / 256;
constexpr float NORM_EPS = 1e-5f, LNX_EPS = 64e-5f;

constexpr int NCHUNK = 257, NUNITS = 64 * NCHUNK;
constexpr int REC_BYTES = 13568;
constexpr int RO_WH = 0, RO_RT = 2048, RO_U0T = 4096, RO_VT = 6144, RO_BKT = 8192, RO_ARK = 12288, RO_WCC = 13312;
constexpr int SLOT_BYTES = 15680, SO_G = 13568, SO_COEF = 15616, NSLOT = 9;
constexpr size_t SZ_ACT = (size_t)MAXROWS * 1024 * 2;
constexpr size_t SZ_WGU = (size_t)NE * 2048 * 1024 * 2;
constexpr size_t SZ_WD = (size_t)NE * 1024 * 1024 * 2;
constexpr size_t SZ_HB = (size_t)T * 1024 * 2;
constexpr size_t OFF_WGU = 0;
constexpr size_t OFF_HB8 = OFF_WGU + (size_t)NE * 2048 * 1024;
constexpr size_t OFF_WD = OFF_WGU + SZ_WGU;
constexpr size_t OFF_ACT = OFF_WD + SZ_WD;
constexpr size_t OFF_HB2 = OFF_ACT + SZ_ACT;
constexpr size_t OFF_RT = OFF_HB2 + SZ_HB;
constexpr size_t OFF_TOPI = OFF_RT;
constexpr size_t OFF_TOPW = OFF_TOPI + (size_t)T * 16;
constexpr size_t OFF_RANK = OFF_TOPW + (size_t)T * 16;
constexpr size_t OFF_RSTD2 = OFF_RANK + (size_t)T * 16;
constexpr size_t OFF_ROWTOK = OFF_RSTD2 + (size_t)T * 4;
constexpr size_t OFF_ROWSLOT = OFF_ROWTOK + (size_t)MAXROWS * 4;
constexpr size_t OFF_ROWW = OFF_ROWSLOT + (size_t)MAXROWS * 4;
constexpr size_t OFF_ROWRS = OFF_ROWW + (size_t)MAXROWS * 4;
constexpr size_t OFF_TILEE = OFF_ROWRS + (size_t)MAXROWS * 4;
constexpr size_t OFF_GCNT = OFF_TILEE + 4096;
constexpr size_t OFF_SM = OFF_GCNT + 256;
constexpr size_t OFF_WR = OFF_SM;
constexpr size_t OFF_WC = OFF_WR + (size_t)1024 * 512 * 2;
constexpr size_t OFF_WO = OFF_WC + (size_t)1024 * 512 * 2;
constexpr size_t OFF_W2 = OFF_WO + (size_t)1024 * 1024 * 2;
constexpr size_t OFF_RSTD1 = OFF_W2 + (size_t)1536 * 256 * 2;
constexpr size_t OFF_WRG = OFF_RSTD1 + (size_t)NRP * 4;
constexpr size_t OFF_BAR = OFF_WRG + (size_t)1024 * 32 * 4;
constexpr size_t WS_NEED = OFF_BAR + 16384;
constexpr size_t OFF_PRKV = 0;
constexpr size_t SZ_PRKV = (size_t)NR * 1536 * 2;
constexpr size_t OFF_LD = OFF_PRKV + SZ_PRKV;
constexpr size_t OFF_A = OFF_LD + (size_t)NRP * 512 * 4;
constexpr size_t OFF_CH = OFF_A + (size_t)NRP * 512 * 2;
constexpr size_t OFF_PCONV = OFF_CH;
constexpr size_t SZ_PCONV = (size_t)NR * 2048 * 2;
constexpr size_t OFF_HB = OFF_PCONV + SZ_PCONV;
constexpr size_t OFF_L = OFF_HB + SZ_HB;
constexpr size_t OFF_WIN = OFF_L + (size_t)NRP * 256 * 2;
constexpr size_t CH_END = OFF_WIN + (size_t)NCOLS1 * 1024 * 2;
constexpr size_t OFF_MERGED = OFF_CH;
constexpr size_t OFF_G = CH_END;
constexpr size_t OFF_C = OFF_G + (size_t)NRP * 512 * 2;
constexpr size_t OFF_Z = OFF_C + (size_t)T * 512 * 2;
constexpr size_t OFF_COEF = OFF_Z + (size_t)T * 512 * 2;
constexpr size_t EARLY_END = OFF_COEF + (size_t)NR * 8 * 4;
static_assert(EARLY_END <= OFF_RT, "early buffers overflow");
static_assert(OFF_CH + (size_t)NUNITS * REC_BYTES <= CH_END, "chunk records overflow");
static_assert(OFF_CH >= OFF_WD + SZ_WD, "expert weights (written during the scan) must not touch live scan buffers");
static_assert(OFF_MERGED + SZ_HB <= OFF_HB2, "layout");
static_assert(OFF_PRKV % 16 == 0 && OFF_LD % 16 == 0 && OFF_A % 16 == 0 && OFF_CH % 16 == 0 && OFF_HB % 16 == 0 && OFF_L % 16 == 0 && OFF_WIN % 16 == 0 && OFF_G % 16 == 0 && OFF_C % 16 == 0 && OFF_Z % 16 == 0 && OFF_COEF % 16 == 0, "align");

#define GAS __attribute__((address_space(1)))
#define CAS __attribute__((address_space(4)))
struct Params {
    const float* in[37];
    float* out;
    unsigned char* ws;
    int ph_lo, ph_hi;
};
struct ParamsD {
    const GAS float* in[37];
    GAS float* out;
    GAS unsigned char* ws;
    int ph_lo, ph_hi;
};
static_assert(sizeof(Params) == sizeof(ParamsD), "argument views");
struct PPv {
    const CAS ParamsD* k;
    __device__ __forceinline__ const float* gin(int i) const { return (const float*)k->in[i]; }
    __device__ __forceinline__ float* gout() const { return (float*)k->out; }
    __device__ __forceinline__ unsigned char* gws() const { return (unsigned char*)k->ws; }
};
__device__ __forceinline__ PPv getpp() { const CAS ParamsD* k = (const CAS ParamsD*)__builtin_amdgcn_kernarg_segment_ptr(); asm volatile("" : "+s"(k)); return PPv{k}; }

typedef __bf16 bf16x2v __attribute__((ext_vector_type(2)));
__device__ __forceinline__ unsigned cvt_pk_bf16(float lo, float hi) { const f32x2 v = {lo, hi}; return __builtin_bit_cast(unsigned, __builtin_convertvector(v, bf16x2v)); }
__device__ __forceinline__ unsigned pk4_fp8(float a, float b, float c, float d) { int w = __builtin_amdgcn_cvt_pk_fp8_f32(a, b, 0, false); w = __builtin_amdgcn_cvt_pk_fp8_f32(c, d, w, true); return (unsigned)w; }
constexpr float W8_SCALE = 32.0f, W8_INV = 1.0f / 32.0f;
__device__ __forceinline__ bf16_t f2bf(float f) { unsigned u = __float_as_uint(f); u += 0x7FFFu + ((u >> 16) & 1u); return (bf16_t)(u >> 16); }
__device__ __forceinline__ float bf2f(bf16_t b) { return __uint_as_float(((unsigned)b) << 16); }
__device__ __forceinline__ float bflo(unsigned w) { return __uint_as_float(w << 16); }
__device__ __forceinline__ float bfhi(unsigned w) { return __uint_as_float(w & 0xFFFF0000u); }
__device__ __forceinline__ float sigmoidf_(float x) { return __builtin_amdgcn_rcpf(1.0f + __expf(-x)); }
__device__ __forceinline__ float wave_sum(float v) {
#pragma unroll
    for (int o = 32; o >= 1; o >>= 1) v += __shfl_xor(v, o);
    return v;
}
__device__ __forceinline__ float wave_sum_dpp(float v);
__device__ __forceinline__ int prev_row(int row, int d) {
    if (row < NMETA) return row - d >= 0 ? row - d : -1;
    const int s = (row - NMETA) & (SEQ - 1);
    return s >= d ? row - d : NMETA + s - d;
}

constexpr int BM = 256, BK = 64, HALF = 128, HTB = HALF * BK * 2, STAGE_BYTES = 8 * HTB, NXCD = 8, WGM = 8;
__device__ __forceinline__ int lds_byte(int r, int c) { const int st = (r >> 4) * 2 + (c >> 5), rr = r & 15, cc = c & 31, ob = rr * 64 + cc * 2; return st * 1024 + (ob ^ (((ob >> 9) & 1) << 5)); }
__device__ __forceinline__ void stage_rc(int b, int& R, int& C) { const int st = b / 1024, sb = b % 1024, swz = sb ^ (((sb >> 9) & 1) << 5); R = (st >> 1) * 16 + swz / 64; C = (st & 1) * 32 + (swz % 64) / 2; }
__device__ __forceinline__ int perm32(int rho) { const int n = rho >> 4, i = rho & 15; return 8 * (i >> 2) + 4 * n + (i & 3); }

struct Unit { int pm, pn, aux; };

struct StaticOrder {
    const char* A; const char* Bt; int K;
    int nM, nN, nwg, G, c;
    __device__ void init(const void* A_, const void* Bt_, int M, int N, int K_, int G_, int c_) { A = (const char*)A_; Bt = (const char*)Bt_; K = K_; nM = M / BM; nN = N / BM; nwg = nM * nN; G = G_; c = c_; }
    __device__ bool next(int i, Unit& u) const {
        const long L = (long)i * G + c; if (L >= nwg) return false;
        int wgid = (int)L; { const int q = nwg / NXCD, r = nwg % NXCD, xcd = wgid % NXCD, off = wgid / NXCD; wgid = (xcd < r ? xcd * (q + 1) : r * (q + 1) + (xcd - r) * q) + off; }
        const int nig = WGM * nN, gid = wgid / nig, fm = gid * WGM, gsz = (nM - fm) < WGM ? (nM - fm) : WGM;
        u.pm = fm + ((wgid % nig) % gsz); u.pn = (wgid % nig) / gsz; u.aux = 0; return true;
    }
    __device__ __forceinline__ const char* a_ptr(const Unit& u) const { return A + (size_t)u.pm * 256 * K * 2; }
    __device__ __forceinline__ const char* b_ptr(const Unit& u) const { return Bt + (size_t)u.pn * 256 * K * 2; }
    __device__ __forceinline__ int gather_row(const Unit&, int) const { return 0; }
    __device__ __forceinline__ const void* gather_src(const Unit&, int) const { return nullptr; }
};
struct MoeOrder {
    const char* A; const char* Bt; int K; size_t estride;
    const int* tile_e; const int* rowtok; int ntiles, nnt, G, c; bool gather;
    __device__ bool next(int i, Unit& u) const {
        int mt, nt;
        if ((G & 7) == 0 && ((G >> 3) % nnt) == 0) {
            const int x = c & 7, j = c >> 3, per = (G >> 3) / nnt;
            mt = (i * 8 + x) * per + j / nnt; nt = j % nnt;
        } else { const long L = (long)i * G + c; mt = (int)(L / nnt); nt = (int)(L % nnt); }
        if (mt >= ntiles) return false;
        u.pm = mt; u.pn = nt; u.aux = tile_e[mt]; return true;
    }
    __device__ __forceinline__ const char* a_ptr(const Unit& u) const { return gather ? A : A + (size_t)u.pm * 256 * K * 2; }
    __device__ __forceinline__ const char* b_ptr(const Unit& u) const { return Bt + (size_t)u.aux * estride + (size_t)u.pn * 256 * K * 2; }
    __device__ __forceinline__ int gather_row(const Unit& u, int r) const { return rowtok[u.pm * 256 + r]; }
    __device__ __forceinline__ const void* gather_src(const Unit& u, int lane) const { return rowtok + u.pm * 256 + lane * 4; }
};

typedef int i32x4 __attribute__((ext_vector_type(4)));
typedef int i32x8 __attribute__((ext_vector_type(8)));
template <bool GATHER, bool FP8 = false, class Epi, class Sched>
__device__ __forceinline__ void gemm_phase(LAS unsigned char* lds, const int K_, const Sched& S, const Epi& E) {
    int K = K_; asm volatile("" : "+s"(K));
    const int tid = threadIdx.x, wid = __builtin_amdgcn_readfirstlane(tid >> 6), lane = tid & 63, wr = wid >> 2, wc = wid & 3, fr = lane & 15, fq = lane >> 4;
    const int nt = K / BK;
    unsigned voffA[2], voffB[2]; int Rr[2], Cc[2];
#pragma unroll
    for (int i = 0; i < 2; ++i) { int R, C; stage_rc(tid * 16 + i * 8192, R, C); const int Rb = (R & ~31) + perm32(R & 31);
        Rr[i] = R; Cc[i] = C; voffA[i] = (unsigned)(R * K + C) * 2u; voffB[i] = (unsigned)(Rb * K + C) * 2u; }
    const size_t kstep = (size_t)(BK * 2);
    const size_t hstep = (size_t)HALF * K * 2;
    const unsigned ldsw = (unsigned)wid * 1024u;
    const int aoff = lds_byte(wr * 64 + fr, fq * 8), boff = lds_byte(wc * 32 + fr, fq * 8);
    unsigned vgc[2][2], vgn[2][2];
    LAS unsigned char* const parbase = lds + STAGE_BYTES;
    constexpr int NPAR = Epi::NPAR;
#define G_PAR_ISSUE(unit, uidx, hasnx, nxunit) do { \
        LAS unsigned char* _ps = parbase + ((uidx) & 1) * 4096; \
        if (wid < NPAR) __builtin_amdgcn_global_load_lds((const unsigned*)E.par_src(unit, wid, lane), (LAS unsigned*)(_ps + wid * 1024), 16, 0, 0); \
        if (GATHER && (hasnx) && wid == NPAR) __builtin_amdgcn_global_load_lds((const unsigned*)S.gather_src(nxunit, lane), (LAS unsigned*)(_ps + NPAR * 1024), 16, 0, 0); } while (0)
#define G_CAT8(x0, x1) __builtin_shufflevector(__builtin_bit_cast(i32x4, x0), __builtin_bit_cast(i32x4, x1), 0, 1, 2, 3, 4, 5, 6, 7)
#define G_SA(b, h) (((b) * 2 + (h)) * HTB)
#define G_SB(b, h) ((4 + (b) * 2 + (h)) * HTB)
#define G_STAGE(bufoff, gbase, voff) do { _Pragma("unroll") for (int _i = 0; _i < 2; ++_i) \
        __builtin_amdgcn_global_load_lds((const unsigned*)((const char*)(gbase) + (voff)[_i]), (LAS unsigned*)(lds + (bufoff) + ldsw + _i * 8192), 16, 0, 0); } while (0)
#define G_STAGE_A(bufoff, kptr, h, VG) do { if (GATHER) { G_STAGE(bufoff, kptr, VG[h]); } else { G_STAGE(bufoff, (kptr) + (h) * hstep, voffA); } } while (0)
#define G_LDA(dst, b, h) do { _Pragma("unroll") for (int m = 0; m < 4; ++m) { \
        if (FP8) dst##8[m] = G_CAT8(*(const LAS bf16x8*)(lds + G_SA(b, h) + aoff + m * 2048), *(const LAS bf16x8*)(lds + G_SA(b, h) + aoff + m * 2048 + 1024)); \
        else { _Pragma("unroll") for (int k = 0; k < 2; ++k) dst[m][k] = *(const LAS bf16x8*)(lds + G_SA(b, h) + aoff + m * 2048 + k * 1024); } } } while (0)
#define G_LDB(dst, b, h) do { _Pragma("unroll") for (int n = 0; n < 2; ++n) { \
        if (FP8) dst##8[n] = G_CAT8(*(const LAS bf16x8*)(lds + G_SB(b, h) + boff + n * 2048), *(const LAS bf16x8*)(lds + G_SB(b, h) + boff + n * 2048 + 1024)); \
        else { _Pragma("unroll") for (int k = 0; k < 2; ++k) dst[n][k] = *(const LAS bf16x8*)(lds + G_SB(b, h) + boff + n * 2048 + k * 1024); } } } while (0)
#define G_MMA(ai, bj, At, Bt) do { __builtin_amdgcn_s_setprio(1); _Pragma("unroll") for (int m = 0; m < 4; ++m) _Pragma("unroll") for (int n = 0; n < 2; ++n) { \
        if (FP8) asm volatile("v_mfma_scale_f32_16x16x128_f8f6f4 %0, %1, %2, %0, %3, %3 op_sel_hi:[0,0,0]" : "+v"(acc[ai][bj][m][n]) : "v"(Bt##8[n]), "v"(At##8[m]), "v"(sc8)); \
        else { _Pragma("unroll") for (int k = 0; k < 2; ++k) acc[ai][bj][m][n] = __builtin_amdgcn_mfma_f32_16x16x32_bf16(Bt[n][k], At[m][k], acc[ai][bj][m][n], 0, 0, 0); } } \
        __builtin_amdgcn_s_setprio(0); } while (0)
#define G_WAIT_V(n) asm volatile("s_waitcnt vmcnt(" #n ")" ::: "memory")
#define G_WAIT_L(n) asm volatile("s_waitcnt lgkmcnt(" #n ")" ::: "memory")
#define G_BAR __builtin_amdgcn_s_barrier()
#define G_SCHED __builtin_amdgcn_sched_barrier(0)
    Unit cur, nxt;
    int ui = 0;
    if (!S.next(0, cur)) return;
    f32x4 acc[2][2][4][2];
#pragma unroll
    for (int a = 0; a < 2; ++a)
#pragma unroll
        for (int b = 0; b < 2; ++b)
#pragma unroll
            for (int m = 0; m < 4; ++m)
#pragma unroll
                for (int n = 0; n < 2; ++n) acc[a][b][m][n] = (f32x4){0.f, 0.f, 0.f, 0.f};
    bf16x8 At[4][2], B0[2][2], B1[2][2];
    i32x8 At8[4], B08[2], B18[2];
    int sc8 = 0x7F7F7F7F; asm volatile("" : "+v"(sc8));
    const char* cA = S.a_ptr(cur); const char* cB = S.b_ptr(cur);
    if (GATHER) {
#pragma unroll
        for (int h = 0; h < 2; ++h)
#pragma unroll
            for (int i = 0; i < 2; ++i) vgc[h][i] = (unsigned)(S.gather_row(cur, h * HALF + Rr[i]) * K + Cc[i]) * 2u;
    }
    { Unit n1; const bool hn1 = S.next(1, n1); G_PAR_ISSUE(cur, 0, hn1, n1); }
    G_STAGE(G_SB(0, 0), cB, voffB); G_STAGE_A(G_SA(0, 0), cA, 0, vgc); G_STAGE(G_SB(0, 1), cB + hstep, voffB); G_STAGE_A(G_SA(0, 1), cA, 1, vgc);
    if (wr == 1) G_BAR;
    G_WAIT_V(4); G_BAR;
    G_STAGE(G_SB(1, 0), cB + kstep, voffB); G_STAGE_A(G_SA(1, 0), cA + kstep, 0, vgc); G_STAGE(G_SB(1, 1), cB + hstep + kstep, voffB);
    G_WAIT_V(6); G_BAR;
    for (;;) {
        const bool has_next = S.next(ui + 1, nxt);
        const char* nA = has_next ? S.a_ptr(nxt) : cA; const char* nB = has_next ? S.b_ptr(nxt) : cB;
        if (ui > 0) G_PAR_ISSUE(cur, ui, has_next, nxt);
        if (GATHER) {
#pragma unroll
            for (int h = 0; h < 2; ++h)
#pragma unroll
                for (int i = 0; i < 2; ++i) vgn[h][i] = vgc[h][i];
        }
        for (int t = 0; t < nt; t += 2) {
            const bool last = (t == nt - 2);
            const char* a1 = cA + (size_t)(t + 1) * kstep;
            const char* a2 = last ? nA : cA + (size_t)(t + 2) * kstep; const char* b2 = last ? nB : cB + (size_t)(t + 2) * kstep;
            const char* a3 = a2 + kstep; const char* b3 = b2 + kstep;
            unsigned vg2[2][2];
            if (GATHER) {
#pragma unroll
                for (int h = 0; h < 2; ++h)
#pragma unroll
                    for (int i = 0; i < 2; ++i) vg2[h][i] = last ? vgn[h][i] : vgc[h][i];
            }
            G_LDB(B0, 0, 0); G_SCHED; G_LDA(At, 0, 0); G_STAGE_A(G_SA(1, 1), a1, 1, vgc);
            G_WAIT_L(8); G_BAR; G_WAIT_L(0); G_MMA(0, 0, At, B0); G_BAR; G_SCHED;
            G_LDB(B1, 0, 1); G_STAGE(G_SB(0, 0), b2, voffB);
            G_BAR; G_WAIT_L(0); G_MMA(0, 1, At, B1); G_BAR;
            G_LDA(At, 0, 1); G_STAGE_A(G_SA(0, 0), a2, 0, vg2);
            G_BAR; G_WAIT_L(0); G_MMA(1, 0, At, B0); G_BAR; G_SCHED;
            G_STAGE(G_SB(0, 1), b2 + hstep, voffB);
            G_WAIT_V(6); G_BAR; G_MMA(1, 1, At, B1); G_BAR;
            G_LDB(B0, 1, 0); G_SCHED; G_LDA(At, 1, 0); G_STAGE_A(G_SA(0, 1), a2, 1, vg2);
            G_WAIT_L(8); G_BAR; G_WAIT_L(0); G_MMA(0, 0, At, B0); G_BAR; G_SCHED;
            G_LDB(B1, 1, 1); G_STAGE(G_SB(1, 0), b3, voffB);
            G_BAR; G_WAIT_L(0); G_MMA(0, 1, At, B1); G_BAR;
            G_LDA(At, 1, 1); G_STAGE_A(G_SA(1, 0), a3, 0, vg2);
            G_BAR; G_WAIT_L(0); G_MMA(1, 0, At, B0); G_BAR; G_SCHED;
            G_STAGE(G_SB(1, 1), b3 + hstep, voffB);
            G_WAIT_V(6); G_BAR; G_MMA(1, 1, At, B1); G_BAR;
            if (GATHER && t == 0 && has_next) {
                const LAS int* rows = (const LAS int*)(parbase + (ui & 1) * 4096 + NPAR * 1024);
#pragma unroll
                for (int h = 0; h < 2; ++h)
#pragma unroll
                    for (int i = 0; i < 2; ++i) vgn[h][i] = (unsigned)(rows[h * HALF + Rr[i]] * K + Cc[i]) * 2u;
            }
        }
        if (FP8) asm volatile("s_nop 15\n\ts_nop 15" ::: "memory");
        const bool keep_acc = E(acc, cur, wr, wc, fr, fq, (const LAS unsigned char*)(parbase + (ui & 1) * 4096));
        if (!has_next) break;
        if (!keep_acc)
#pragma unroll
        for (int a = 0; a < 2; ++a)
#pragma unroll
            for (int b = 0; b < 2; ++b)
#pragma unroll
                for (int m = 0; m < 4; ++m)
#pragma unroll
                    for (int n = 0; n < 2; ++n) acc[a][b][m][n] = (f32x4){0.f, 0.f, 0.f, 0.f};
        cur = nxt; cA = nA; cB = nB; ++ui;
        if (GATHER) {
#pragma unroll
            for (int h = 0; h < 2; ++h)
#pragma unroll
                for (int i = 0; i < 2; ++i) vgc[h][i] = vgn[h][i];
        }
    }
    G_WAIT_V(0);
    if (wr == 0) G_BAR;
    G_BAR;
#undef G_PAR_ISSUE
#undef G_SA
#undef G_SB
#undef G_STAGE
#undef G_STAGE_A
#undef G_LDA
#undef G_LDB
#undef G_MMA
#undef G_CAT8
#undef G_WAIT_V
#undef G_WAIT_L
#undef G_BAR
#undef G_SCHED
}

struct EpiProj {
    bf16_t* prkv; bf16_t* pconv; bf16_t* gates; const float* rstd1;
    static constexpr int NPAR = 1;
    __device__ __forceinline__ const void* par_src(const Unit& u, int, int lane) const { return rstd1 + NMETA + u.pm * BM + lane * 4; }
    __device__ __forceinline__ bool operator()(const f32x4 (&acc)[2][2][4][2], const Unit& u, int wr, int wc, int fr, int fq, const LAS unsigned char* par) const {
        const int row0 = u.pm * BM + wr * 64 + fr;
        const bool isg = u.pn >= 14;
        float rsv[2][4];
#pragma unroll
        for (int ai = 0; ai < 2; ++ai)
#pragma unroll
            for (int m = 0; m < 4; ++m) rsv[ai][m] = ((const LAS float*)par)[wr * 64 + fr + ai * HALF + m * 16];
#pragma unroll
        for (int ai = 0; ai < 2; ++ai)
#pragma unroll
            for (int m = 0; m < 4; ++m) {
                const int row = row0 + ai * HALF + m * 16;
                const float rs = rsv[ai][m];
                bf16_t* rowp = isg ? gates + (size_t)row * 2048 + (u.pn - 14) * 256 + wc * 32 + 8 * fq
                             : (u.pn < 6 ? prkv + (size_t)(NMETA + row) * 1536 + u.pn * 256 : pconv + (size_t)(NMETA + row) * 2048 + (u.pn - 6) * 256) + wc * 32 + 8 * fq;
#pragma unroll
                for (int bj = 0; bj < 2; ++bj) {
                    f32x4 v0 = acc[ai][bj][m][0] * rs, v1 = acc[ai][bj][m][1] * rs;
                    if (isg) {
#pragma unroll
                        for (int j = 0; j < 4; ++j) { v0[j] = sigmoidf_(v0[j]); v1[j] = sigmoidf_(v1[j]); }
                    }
                    u32x4 w; w.x = cvt_pk_bf16(v0[0], v0[1]); w.y = cvt_pk_bf16(v0[2], v0[3]); w.z = cvt_pk_bf16(v1[0], v1[1]); w.w = cvt_pk_bf16(v1[2], v1[3]);
                    *(u32x4*)(rowp + bj * HALF) = w;
                }
            }
        return false;
    }
};
struct EpiL {
    static constexpr int NPAR = 0;
    __device__ __forceinline__ const void* par_src(const Unit&, int, int) const { return nullptr; }
    unsigned char* wsb; const float* w0; const float* a0;
    __device__ __forceinline__ bool operator()(const f32x4 (&acc)[2][2][4][2], const Unit& u, int wr, int wc, int fr, int fq, const LAS unsigned char* par) const {
        const int row0 = NMETA + u.pm * BM + wr * 64 + fr;
        const int seg = u.pn >> 1;
        const int cb = (u.pn & 1) * 256 + wc * 32 + 8 * fq;
        const float* bias = seg == 0 ? w0 : a0;
        f32x4 bv[2][2];
#pragma unroll
        for (int bj = 0; bj < 2; ++bj) {
            bv[bj][0] = seg < 2 ? *(const f32x4*)(bias + cb + bj * HALF) : (f32x4){0.f, 0.f, 0.f, 0.f};
            bv[bj][1] = seg < 2 ? *(const f32x4*)(bias + cb + bj * HALF + 4) : (f32x4){0.f, 0.f, 0.f, 0.f};
        }
        const float sc = seg == 0 ? -0.60653065971f : 1.0f;
        bf16_t* ob = (bf16_t*)(wsb + (seg == 0 ? OFF_LD : seg == 1 ? OFF_A : OFF_G));
#pragma unroll
        for (int ai = 0; ai < 2; ++ai)
#pragma unroll
            for (int m = 0; m < 4; ++m) {
                const int row = row0 + ai * HALF + m * 16;
#pragma unroll
                for (int bj = 0; bj < 2; ++bj) {
                    const int c = cb + bj * HALF;
                    f32x4 v0 = acc[ai][bj][m][0] + bv[bj][0], v1 = acc[ai][bj][m][1] + bv[bj][1];
                    if (seg < 2) {
#pragma unroll
                        for (int j = 0; j < 4; ++j) { v0[j] = sc * sigmoidf_(v0[j]); v1[j] = sc * sigmoidf_(v1[j]); }
                    }
                    {
                        u32x4 w; w.x = cvt_pk_bf16(v0[0], v0[1]); w.y = cvt_pk_bf16(v0[2], v0[3]); w.z = cvt_pk_bf16(v1[0], v1[1]); w.w = cvt_pk_bf16(v1[2], v1[3]);
                        *(u32x4*)(ob + (size_t)row * 512 + c) = w;
                    }
                }
            }
        return false;
    }
};
template <int SECOND> struct EpiMerge {
    static constexpr int NPAR = 0;
    __device__ __forceinline__ const void* par_src(const Unit&, int, int) const { return nullptr; }
    bf16_t* merged; const bf16_t* gates;
    __device__ __forceinline__ bool operator()(const f32x4 (&acc)[2][2][4][2], const Unit& u, int wr, int wc, int fr, int fq, const LAS unsigned char* par) const {
        const int row0 = u.pm * BM + wr * 64 + fr, col0 = u.pn * BM + wc * 32 + 8 * fq;
#pragma unroll
        for (int ai = 0; ai < 2; ++ai)
#pragma unroll
            for (int m = 0; m < 4; ++m) {
                const int row = row0 + ai * HALF + m * 16;
#pragma unroll
                for (int bj = 0; bj < 2; ++bj) {
                    const int c = col0 + bj * HALF;
                    const u32x4 gw = *(const u32x4*)(gates + (size_t)row * 2048 + SECOND * 1024 + c);
                    f32x4 g0 = (f32x4){bflo(gw.x), bfhi(gw.x), bflo(gw.y), bfhi(gw.y)}, g1 = (f32x4){bflo(gw.z), bfhi(gw.z), bflo(gw.w), bfhi(gw.w)};
                    f32x4 v0 = acc[ai][bj][m][0] * g0, v1 = acc[ai][bj][m][1] * g1;
                    bf16_t* p = merged + (size_t)row * 1024 + c;
                    if (SECOND) {
                        const u32x4 ow = *(const u32x4*)p;
                        v0 += (f32x4){bflo(ow.x), bfhi(ow.x), bflo(ow.y), bfhi(ow.y)}; v1 += (f32x4){bflo(ow.z), bfhi(ow.z), bflo(ow.w), bfhi(ow.w)};
                    }
                    u32x4 w; w.x = cvt_pk_bf16(v0[0], v0[1]); w.y = cvt_pk_bf16(v0[2], v0[3]); w.z = cvt_pk_bf16(v1[0], v1[1]); w.w = cvt_pk_bf16(v1[2], v1[3]);
                    *(u32x4*)p = w;
                }
            }
        return false;
    }
};
struct MergeOrder {
    StaticOrder so; const char* A1; const char* B1;
    __device__ bool next(int i, Unit& u) const { const bool ok = so.next(i >> 1, u); u.aux = i & 1; return ok; }
    __device__ __forceinline__ const char* a_ptr(const Unit& u) const { return (u.aux ? A1 : so.A) + (size_t)u.pm * 256 * so.K * 2; }
    __device__ __forceinline__ const char* b_ptr(const Unit& u) const { return (u.aux ? B1 : so.Bt) + (size_t)u.pn * 256 * so.K * 2; }
    __device__ __forceinline__ int gather_row(const Unit&, int) const { return 0; }
    __device__ __forceinline__ const void* gather_src(const Unit&, int) const { return nullptr; }
};
struct EpiMergeFused {
    static constexpr int NPAR = 0;
    __device__ __forceinline__ const void* par_src(const Unit&, int, int) const { return nullptr; }
    bf16_t* merged; const bf16_t* gates;
    __device__ __forceinline__ bool operator()(f32x4 (&acc)[2][2][4][2], const Unit& u, int wr, int wc, int fr, int fq, const LAS unsigned char* par) const {
        const int row0 = u.pm * BM + wr * 64 + fr, col0 = u.pn * BM + wc * 32 + 8 * fq;
#pragma unroll
        for (int ai = 0; ai < 2; ++ai) {
            u32x4 gbw[4][2], gaw[4][2];
#pragma unroll
            for (int m = 0; m < 4; ++m)
#pragma unroll
                for (int bj = 0; bj < 2; ++bj) {
                    const bf16_t* gp = gates + (size_t)(row0 + ai * HALF + m * 16) * 2048 + col0 + bj * HALF;
                    gbw[m][bj] = *(const u32x4*)(gp + 1024);
                    gaw[m][bj] = u.aux == 0 ? *(const u32x4*)gp : (u32x4){0u, 0u, 0u, 0u};
                }
#pragma unroll
            for (int m = 0; m < 4; ++m)
#pragma unroll
                for (int bj = 0; bj < 2; ++bj) {
                    const int row = row0 + ai * HALF + m * 16, c = col0 + bj * HALF;
                    f32x4 gb0 = (f32x4){bflo(gbw[m][bj].x), bfhi(gbw[m][bj].x), bflo(gbw[m][bj].y), bfhi(gbw[m][bj].y)}, gb1 = (f32x4){bflo(gbw[m][bj].z), bfhi(gbw[m][bj].z), bflo(gbw[m][bj].w), bfhi(gbw[m][bj].w)};
#pragma unroll
                    for (int j = 0; j < 4; ++j) { gb0[j] = fmaxf(gb0[j], 1e-6f); gb1[j] = fmaxf(gb1[j], 1e-6f); }
                    if (u.aux == 0) {
                        const f32x4 ga0 = (f32x4){bflo(gaw[m][bj].x), bfhi(gaw[m][bj].x), bflo(gaw[m][bj].y), bfhi(gaw[m][bj].y)}, ga1 = (f32x4){bflo(gaw[m][bj].z), bfhi(gaw[m][bj].z), bflo(gaw[m][bj].w), bfhi(gaw[m][bj].w)};
#pragma unroll
                        for (int j = 0; j < 4; ++j) { acc[ai][bj][m][0][j] *= ga0[j] * __builtin_amdgcn_rcpf(gb0[j]); acc[ai][bj][m][1][j] *= ga1[j] * __builtin_amdgcn_rcpf(gb1[j]); }
                    } else {
                        const f32x4 v0 = acc[ai][bj][m][0] * gb0, v1 = acc[ai][bj][m][1] * gb1;
                        u32x4 w; w.x = cvt_pk_bf16(v0[0], v0[1]); w.y = cvt_pk_bf16(v0[2], v0[3]); w.z = cvt_pk_bf16(v1[0], v1[1]); w.w = cvt_pk_bf16(v1[2], v1[3]);
                        *(u32x4*)(merged + (size_t)row * 1024 + c) = w;
                    }
                }
        }
        return u.aux == 0;
    }
};
struct EpiO {
    static constexpr int NPAR = 0;
    __device__ __forceinline__ const void* par_src(const Unit&, int, int) const { return nullptr; }
    const float* x; float* h1; bf16_t* hb2; unsigned char* hb8;
    __device__ __forceinline__ bool operator()(const f32x4 (&acc)[2][2][4][2], const Unit& u, int wr, int wc, int fr, int fq, const LAS unsigned char* par) const {
        const int row0 = u.pm * BM + wr * 64 + fr, col0 = u.pn * BM + wc * 32 + 8 * fq;
#pragma unroll
        for (int ai = 0; ai < 2; ++ai) {
            f32x4 xv[4][2][2];
#pragma unroll
            for (int m = 0; m < 4; ++m)
#pragma unroll
                for (int bj = 0; bj < 2; ++bj) {
                    const size_t o = (size_t)(row0 + ai * HALF + m * 16) * 1024 + col0 + bj * HALF;
                    xv[m][bj][0] = *(const f32x4*)(x + o); xv[m][bj][1] = *(const f32x4*)(x + o + 4);
                }
#pragma unroll
            for (int m = 0; m < 4; ++m)
#pragma unroll
                for (int bj = 0; bj < 2; ++bj) {
                    const size_t o = (size_t)(row0 + ai * HALF + m * 16) * 1024 + col0 + bj * HALF;
                    const f32x4 v0 = acc[ai][bj][m][0] + xv[m][bj][0], v1 = acc[ai][bj][m][1] + xv[m][bj][1];
                    u32x4 w; w.x = cvt_pk_bf16(v0[0], v0[1]); w.y = cvt_pk_bf16(v0[2], v0[3]); w.z = cvt_pk_bf16(v1[0], v1[1]); w.w = cvt_pk_bf16(v1[2], v1[3]);
                    *(u32x4*)(hb2 + o) = w;
                    u32x2 w8; w8.x = pk4_fp8(v0[0], v0[1], v0[2], v0[3]); w8.y = pk4_fp8(v1[0], v1[1], v1[2], v1[3]);
                    *(u32x2*)(hb8 + o) = w8;
                }
        }
        return false;
    }
};
struct EpiMoe1 {
    unsigned char* act; const float* rowrs; const float* bg; const float* bu;
    static constexpr int NPAR = 2;
    __device__ __forceinline__ const void* par_src(const Unit& u, int piece, int lane) const {
        if (piece == 0) return rowrs + u.pm * BM + lane * 4;
        return (lane < 32 ? bg : bu) + (size_t)u.aux * DFF + u.pn * 128 + (lane & 31) * 4;
    }
    __device__ __forceinline__ bool operator()(const f32x4 (&acc)[2][2][4][2], const Unit& u, int wr, int wc, int fr, int fq, const LAS unsigned char* par) const {
        const int row0 = u.pm * BM + wr * 64 + fr, ff0 = u.pn * 128 + wc * 32 + 8 * fq;
        const LAS float* bgp = (const LAS float*)(par + 1024) + wc * 32 + 8 * fq; const LAS float* bup = bgp + 128;
        const f32x4 bg0 = *(const LAS f32x4*)bgp, bg1 = *(const LAS f32x4*)(bgp + 4), bu0 = *(const LAS f32x4*)bup, bu1 = *(const LAS f32x4*)(bup + 4);
        float rsv[2][4];
#pragma unroll
        for (int ai = 0; ai < 2; ++ai)
#pragma unroll
            for (int m = 0; m < 4; ++m) rsv[ai][m] = ((const LAS float*)par)[wr * 64 + fr + ai * HALF + m * 16];
#pragma unroll
        for (int ai = 0; ai < 2; ++ai)
#pragma unroll
            for (int m = 0; m < 4; ++m) {
                const int row = row0 + ai * HALF + m * 16;
                const float rs = rsv[ai][m] * W8_INV;
                f32x4 g0 = acc[ai][0][m][0] * rs + bg0, g1 = acc[ai][0][m][1] * rs + bg1, u0 = acc[ai][1][m][0] * rs + bu0, u1 = acc[ai][1][m][1] * rs + bu1;
                f32x4 r0, r1;
#pragma unroll
                for (int j = 0; j < 4; ++j) {
                    { const float gt = fminf(g0[j], 7.0f), up = fminf(fmaxf(u0[j], -7.0f), 7.0f); r0[j] = (up + 1.0f) * gt * sigmoidf_(1.702f * gt); }
                    { const float gt = fminf(g1[j], 7.0f), up = fminf(fmaxf(u1[j], -7.0f), 7.0f); r1[j] = (up + 1.0f) * gt * sigmoidf_(1.702f * gt); }
                }
                u32x2 w; w.x = pk4_fp8(r0[0], r0[1], r0[2], r0[3]); w.y = pk4_fp8(r1[0], r1[1], r1[2], r1[3]);
                *(u32x2*)(act + (size_t)row * DFF + ff0) = w;
            }
        return false;
    }
};
struct EpiMoe2 {
    unsigned char* y8; const int* rowslot; const float* roww; const float* bd;
    static constexpr int NPAR = 3;
    __device__ __forceinline__ const void* par_src(const Unit& u, int piece, int lane) const {
        if (piece == 0) return rowslot + u.pm * BM + lane * 4;
        if (piece == 1) return roww + u.pm * BM + lane * 4;
        return bd + (size_t)u.aux * D + u.pn * BM + lane * 4;
    }
    __device__ __forceinline__ bool operator()(const f32x4 (&acc)[2][2][4][2], const Unit& u, int wr, int wc, int fr, int fq, const LAS unsigned char* par) const {
        const int row0 = u.pm * BM + wr * 64 + fr, col0 = u.pn * BM + wc * 32 + 8 * fq;
        const LAS float* bp = (const LAS float*)(par + 2048) + wc * 32 + 8 * fq;
        f32x4 bv[2][2];
#pragma unroll
        for (int bj = 0; bj < 2; ++bj) { bv[bj][0] = *(const LAS f32x4*)(bp + bj * HALF); bv[bj][1] = *(const LAS f32x4*)(bp + bj * HALF + 4); }
        int slotv[2][4]; float wv8[2][4];
#pragma unroll
        for (int ai = 0; ai < 2; ++ai)
#pragma unroll
            for (int m = 0; m < 4; ++m) { const int rl = wr * 64 + fr + ai * HALF + m * 16; slotv[ai][m] = ((const LAS int*)par)[rl]; wv8[ai][m] = ((const LAS float*)(par + 1024))[rl]; }
#pragma unroll
        for (int ai = 0; ai < 2; ++ai)
#pragma unroll
            for (int m = 0; m < 4; ++m) {
                const int slot = slotv[ai][m];
                if (slot >= 0) {
                    const float w8 = wv8[ai][m];
#pragma unroll
                    for (int bj = 0; bj < 2; ++bj) {
                        const f32x4 v0 = (acc[ai][bj][m][0] * W8_INV + bv[bj][0]) * w8, v1 = (acc[ai][bj][m][1] * W8_INV + bv[bj][1]) * w8;
                        u32x2 w; w.x = pk4_fp8(v0[0], v0[1], v0[2], v0[3]); w.y = pk4_fp8(v1[0], v1[1], v1[2], v1[3]);
                        *(u32x2*)(y8 + (size_t)slot * 1024 + col0 + bj * HALF) = w;
                    }
                }
            }
        return false;
    }
};

__device__ __forceinline__ void transpose_tile(LAS float* tile, const float* src, int ldsrc, int k0, int n0, bf16_t* dst, int ldd, int drow0, const float* sa, const float* mu, int mode, bool zero) {
    const int tid = threadIdx.x;
    if (!zero) {
#pragma unroll
        for (int i = 0; i < 2; ++i) {
            const int r = (tid >> 4) + 32 * i, c4 = (tid & 15) * 4;
            const f32x4 v = *(const f32x4*)(src + (size_t)(k0 + r) * ldsrc + n0 + c4);
            LAS float* t = tile + r * 65 + c4;
            t[0] = v[0]; t[1] = v[1]; t[2] = v[2]; t[3] = v[3];
        }
    }
    __syncthreads();
    {
        const int n = tid >> 3, kq = tid & 7;
        float v[8];
#pragma unroll
        for (int j = 0; j < 8; ++j) {
            const int k = k0 + 8 * kq + j;
            float s = sa ? sa[k] : 1.0f;
            if (mode == 1) s *= (1.0f - mu[k]);
            if (mode == 2) s *= mu[k];
            v[j] = zero ? 0.f : tile[(8 * kq + j) * 65 + n] * s;
        }
        u32x4 w; w.x = cvt_pk_bf16(v[0], v[1]); w.y = cvt_pk_bf16(v[2], v[3]); w.z = cvt_pk_bf16(v[4], v[5]); w.w = cvt_pk_bf16(v[6], v[7]);
        *(u32x4*)(dst + (size_t)(drow0 + n) * ldd + k0 + 8 * kq) = w;
    }
    __syncthreads();
}

__device__ __forceinline__ void phase_prep(const PPv& p, LAS unsigned char* lds) {
    const int tid = threadIdx.x, bid = blockIdx.x, nb = gridDim.x, lane = tid & 63, wave = tid >> 6;
    unsigned char* ws = p.gws();
    const float* x = p.gin(0); const float* meta = p.gin(1); const float* g1 = p.gin(2);
    if (bid == 0 && tid < 64) ((int*)(ws + OFF_GCNT))[tid] = 0;
    {
        bf16_t* HB = (bf16_t*)(ws + OFF_HB); float* rstd1 = (float*)(ws + OFF_RSTD1);
        for (int row0 = (bid * 8 + wave) * 4; row0 < NR; row0 += nb * 32) {
            f32x4 v[4][4];
#pragma unroll
            for (int u = 0; u < 4; ++u) {
                const int row = row0 + u < NR ? row0 + u : NR - 1;
                const float* src = row < NMETA ? meta + (size_t)row * D : x + (size_t)(row - NMETA) * D;
#pragma unroll
                for (int i = 0; i < 4; ++i) v[u][i] = __builtin_nontemporal_load((const f32x4*)(src + i * 256 + lane * 4));
            }
#pragma unroll
            for (int u = 0; u < 4; ++u) {
                const int row = row0 + u;
                if (row < NR) {
                    float ss = 0.f;
#pragma unroll
                    for (int i = 0; i < 4; ++i) ss += v[u][i][0] * v[u][i][0] + v[u][i][1] * v[u][i][1] + v[u][i][2] * v[u][i][2] + v[u][i][3] * v[u][i][3];
                    ss = wave_sum_dpp(ss);
                    if (lane == 0) rstd1[row] = rsqrtf(ss * (1.0f / D) + NORM_EPS);
                    if (row >= NMETA) {
                        bf16_t* d = HB + (size_t)(row - NMETA) * D;
#pragma unroll
                        for (int i = 0; i < 4; ++i) { u32x2 w; w.x = cvt_pk_bf16(v[u][i][0], v[u][i][1]); w.y = cvt_pk_bf16(v[u][i][2], v[u][i][3]); *(u32x2*)(d + i * 256 + lane * 4) = w; }
                    }
                }
            }
        }
    }
    LAS float* tile = (LAS float*)lds;
    {
        bf16_t* WIN = (bf16_t*)(ws + OFF_WIN);
        const float* w_in = p.gin(3);
        for (int j = bid; j < 16 * 88; j += nb) {
            const int kt = j & 15, ntile = j >> 4, n0 = ntile * 64;
            const float* src; int ld, sn0, mode = 0; const float* mu = nullptr;
            if (n0 < 3072) { src = w_in; ld = 5120; sn0 = n0; }
            else if (n0 < 3584) {
                const int seg = (n0 - 3072) >> 6;
                if (seg < 2) { src = p.gin(11); ld = 64; sn0 = 0; mu = p.gin(7); mode = 1 + seg; }
                else if (seg < 4) { src = p.gin(14); ld = 64; sn0 = 0; mu = p.gin(8); mode = 1 + (seg - 2); }
                else { src = p.gin(16); ld = 128; sn0 = (seg & 1) * 64; mu = p.gin(9); mode = seg < 6 ? 1 : 2; }
            } else { src = w_in; ld = 5120; sn0 = n0 - 512; }
            transpose_tile(tile, src, ld, kt * 64, sn0, WIN, 1024, n0, g1, mu, mode, false);
        }
        for (int j = bid; j < 2 * 128; j += nb) {
            const int which = j >> 7, jj = j & 127, kt = jj & 7, ntile = jj >> 3;
            transpose_tile(tile, which ? p.gin(25) : p.gin(23), 1024, kt * 64, ntile * 64, (bf16_t*)(ws + (which ? OFF_WC : OFF_WR)), 512, ntile * 64, nullptr, nullptr, 0, false);
        }
        for (int j = bid; j < 256; j += nb) {
            const int kt = j & 15, ntile = j >> 4;
            transpose_tile(tile, p.gin(26), 1024, kt * 64, ntile * 64, (bf16_t*)(ws + OFF_WO), 1024, ntile * 64, nullptr, nullptr, 0, false);
        }
        for (int j = bid; j < 96; j += nb) {
            const int kt = j & 3, ntile = j >> 2, seg = ntile >> 3, nn0 = (ntile & 7) * 64;
            const float* src = nullptr; int sk0 = 0; bool zero = true;
            if (seg == 0 && kt == 0) { src = p.gin(12); sk0 = 0; zero = false; }
            if (seg == 1 && kt == 1) { src = p.gin(15); sk0 = 0; zero = false; }
            if (seg == 2 && kt >= 2) { src = p.gin(17); sk0 = (kt - 2) * 64; zero = false; }
            const float* srcs = zero ? p.gin(12) : src + (size_t)(sk0 - kt * 64) * 512;
            transpose_tile(tile, srcs, 512, kt * 64, nn0, (bf16_t*)(ws + OFF_W2), 256, ntile * 64, nullptr, nullptr, 0, zero);
        }
        {
            float* WRG = (float*)(ws + OFF_WRG); const float* g2 = p.gin(27); const float* wr_ = p.gin(28);
            for (int i = bid * 512 + tid; i < 1024 * 32; i += nb * 512) WRG[i] = g2[i >> 5] * wr_[i];
        }
    }
}

__device__ __forceinline__ void phase_meta_proj(const PPv& p, LAS unsigned char* lds) {
    const int tid = threadIdx.x, bid = blockIdx.x, lane = tid & 63, wave = tid >> 6;
    unsigned char* ws = p.gws();
    LAS float* sm = (LAS float*)lds;
    const float* meta = p.gin(1);
    for (int i = tid; i < 16 * 256; i += 512) { const int r = i >> 8, c4 = (i & 255) * 4; const f32x4 v = *(const f32x4*)(meta + r * 1024 + c4); LAS float* d = sm + r * 1028 + c4; d[0] = v[0]; d[1] = v[1]; d[2] = v[2]; d[3] = v[3]; }
    __syncthreads();
    const float* rstd1 = (const float*)(ws + OFF_RSTD1);
    for (int nbase = bid * 14; nbase < PCOLS1; nbase += gridDim.x * 14) {
        for (int nn = wave; nn < 14; nn += 8) {
            const int n = nbase + nn;
            if (n >= PCOLS1) break;
            const bf16_t* wrow = (const bf16_t*)(ws + OFF_WIN) + (size_t)n * 1024;
            const u32x4 w0 = *(const u32x4*)(wrow + 8 * lane), w1 = *(const u32x4*)(wrow + 512 + 8 * lane);
            const float wf[16] = {bflo(w0.x), bfhi(w0.x), bflo(w0.y), bfhi(w0.y), bflo(w0.z), bfhi(w0.z), bflo(w0.w), bfhi(w0.w),
                                  bflo(w1.x), bfhi(w1.x), bflo(w1.y), bfhi(w1.y), bflo(w1.z), bfhi(w1.z), bflo(w1.w), bfhi(w1.w)};
            float outv = 0.f;
#pragma unroll
            for (int pr = 0; pr < 16; ++pr) {
                const LAS float* m0 = sm + pr * 1028 + 8 * lane;
                const f32x4 a0 = *(const LAS f32x4*)m0, a1 = *(const LAS f32x4*)(m0 + 4), a2 = *(const LAS f32x4*)(m0 + 512), a3 = *(const LAS f32x4*)(m0 + 516);
                float acc = a0[0] * wf[0] + a0[1] * wf[1] + a0[2] * wf[2] + a0[3] * wf[3] + a1[0] * wf[4] + a1[1] * wf[5] + a1[2] * wf[6] + a1[3] * wf[7]
                          + a2[0] * wf[8] + a2[1] * wf[9] + a2[2] * wf[10] + a2[3] * wf[11] + a3[0] * wf[12] + a3[1] * wf[13] + a3[2] * wf[14] + a3[3] * wf[15];
                acc = wave_sum_dpp(acc);
                outv = (lane == pr) ? acc * rstd1[pr] : outv;
            }
            if (lane < 16) {
                if (n < 1536) ((bf16_t*)(ws + OFF_PRKV))[(size_t)lane * 1536 + n] = f2bf(outv);
                else ((bf16_t*)(ws + OFF_PCONV))[(size_t)lane * 2048 + n - 1536] = f2bf(outv);
            }
        }
    }
    __syncthreads();
}

__device__ __forceinline__ void phase_meta_lora(const PPv& p) {
    const int tid = threadIdx.x, bid = blockIdx.x, nb = gridDim.x, lane = tid & 63, wave = tid >> 6;
    unsigned char* ws = p.gws();
    const bf16_t* L = (const bf16_t*)(ws + OFF_L); const bf16_t* W2 = (const bf16_t*)(ws + OFF_W2);
    for (int n = bid * 8 + wave; n < 1536; n += nb * 8) {
        const int seg = n >> 9, c = n & 511;
        const u32x2 wv = *(const u32x2*)(W2 + (size_t)n * 256 + 4 * lane);
        const float w0v = bflo(wv.x), w1v = bfhi(wv.x), w2v = bflo(wv.y), w3v = bfhi(wv.y);
        float outv = 0.f;
#pragma unroll
        for (int r = 0; r < 16; ++r) {
            const u32x2 lv = *(const u32x2*)(L + (size_t)r * 256 + 4 * lane);
            float acc = bflo(lv.x) * w0v + bfhi(lv.x) * w1v + bflo(lv.y) * w2v + bfhi(lv.y) * w3v;
            acc = wave_sum_dpp(acc);
            outv = (lane == r) ? acc : outv;
        }
        if (lane < 16) {
            float v = outv;
            if (seg == 0) v = -0.60653065971f * sigmoidf_(v + p.gin(10)[c]);
            if (seg == 1) v = sigmoidf_(v + p.gin(13)[c]);
            bf16_t* ob = (bf16_t*)(ws + (seg == 0 ? OFF_LD : seg == 1 ? OFF_A : OFF_G));
            ob[(size_t)lane * 512 + c] = f2bf(v);
        }
    }
}

__device__ __forceinline__ void phase_lprep_conv(const PPv& p) {
    const int tid = threadIdx.x, bid = blockIdx.x, nb = gridDim.x;
    unsigned char* ws = p.gws();
    const bf16_t* PROJ = (const bf16_t*)(ws + OFF_PCONV);
    constexpr int PCOLS = 2048;
    bf16_t* L = (bf16_t*)(ws + OFF_L);
    for (int i = bid * 512 + tid; i < NRP * 32; i += nb * 512) {
        const int row = i >> 5, gq = i & 31;
        u32x4 w = (u32x4){0u, 0u, 0u, 0u};
        if (row < NR) {
            int ca, cb;
            if (gq < 8) { ca = 1536 + gq * 8; cb = ca + 64; }
            else if (gq < 16) { ca = 1536 + 128 + (gq - 8) * 8; cb = ca + 64; }
            else { ca = 1536 + 256 + (gq - 16) * 8; cb = ca + 128; }
            const u32x4 va = *(const u32x4*)(PROJ + (size_t)row * PCOLS + ca);
            const int pr = prev_row(row, 1);
            u32x4 vb = (u32x4){0u, 0u, 0u, 0u};
            if (pr >= 0) vb = *(const u32x4*)(PROJ + (size_t)pr * PCOLS + cb);
            float v[8] = {bflo(va.x) + bflo(vb.x), bfhi(va.x) + bfhi(vb.x), bflo(va.y) + bflo(vb.y), bfhi(va.y) + bfhi(vb.y), bflo(va.z) + bflo(vb.z), bfhi(va.z) + bfhi(vb.z), bflo(va.w) + bflo(vb.w), bfhi(va.w) + bfhi(vb.w)};
#pragma unroll
            for (int j = 0; j < 8; ++j) { if (gq < 8) v[j] = tanhf(v[j]); else if (gq >= 16) v[j] = sigmoidf_(v[j]); }
            w.x = cvt_pk_bf16(v[0], v[1]); w.y = cvt_pk_bf16(v[2], v[3]); w.z = cvt_pk_bf16(v[4], v[5]); w.w = cvt_pk_bf16(v[6], v[7]);
        }
        *(u32x4*)(L + (size_t)row * 256 + gq * 8) = w;
    }
    bf16_t* C = (bf16_t*)(ws + OFF_C);
    const float* cw = p.gin(24);
    for (int i = bid * 512 + tid; i < T * 64; i += nb * 512) {
        const int m = i >> 6, ch = (i & 63) * 8, row = NMETA + m;
        const int r1 = prev_row(row, 1), r2 = prev_row(row, 2);
        const bf16_t* p0 = PROJ + (size_t)row * PCOLS; const bf16_t* p1 = PROJ + (size_t)r1 * PCOLS; const bf16_t* p2 = PROJ + (size_t)r2 * PCOLS;
        const u32x4 vb = *(const u32x4*)(p0 + ch);
        const u32x4 c0 = *(const u32x4*)(p0 + 512 + ch), h0 = *(const u32x4*)(p0 + 1024 + ch);
        const u32x4 c1 = *(const u32x4*)(p1 + 512 + ch), h1 = *(const u32x4*)(p1 + 1024 + ch);
        const u32x4 c2 = *(const u32x4*)(p2 + 512 + ch), h2 = *(const u32x4*)(p2 + 1024 + ch);
        float o[8];
#pragma unroll
        for (int j = 0; j < 8; ++j) {
            const unsigned wb = j < 2 ? vb.x : j < 4 ? vb.y : j < 6 ? vb.z : vb.w;
            const unsigned wc0 = j < 2 ? c0.x : j < 4 ? c0.y : j < 6 ? c0.z : c0.w, wh0 = j < 2 ? h0.x : j < 4 ? h0.y : j < 6 ? h0.z : h0.w;
            const unsigned wc1 = j < 2 ? c1.x : j < 4 ? c1.y : j < 6 ? c1.z : c1.w, wh1 = j < 2 ? h1.x : j < 4 ? h1.y : j < 6 ? h1.z : h1.w;
            const unsigned wc2 = j < 2 ? c2.x : j < 4 ? c2.y : j < 6 ? c2.z : c2.w, wh2 = j < 2 ? h2.x : j < 4 ? h2.y : j < 6 ? h2.z : h2.w;
            const bool hi = j & 1;
            const float b = hi ? bfhi(wb) : bflo(wb);
            const float u0 = (hi ? bfhi(wc0) : bflo(wc0)) * (hi ? bfhi(wh0) : bflo(wh0));
            const float u1 = (hi ? bfhi(wc1) : bflo(wc1)) * (hi ? bfhi(wh1) : bflo(wh1));
            const float u2 = (hi ? bfhi(wc2) : bflo(wc2)) * (hi ? bfhi(wh2) : bflo(wh2));
            const float conv = cw[ch + j] * u2 + cw[512 + ch + j] * u1 + cw[1024 + ch + j] * u0;
            o[j] = b * conv;
        }
        u32x4 w; w.x = cvt_pk_bf16(o[0], o[1]); w.y = cvt_pk_bf16(o[2], o[3]); w.z = cvt_pk_bf16(o[4], o[5]); w.w = cvt_pk_bf16(o[6], o[7]);
        *(u32x4*)(C + (size_t)m * 512 + ch) = w;
    }
}

template <int CTRL> __device__ __forceinline__ float dppmov(float v) { return __builtin_bit_cast(float, __builtin_amdgcn_update_dpp(0, __builtin_bit_cast(int, v), CTRL, 0xF, 0xF, true)); }
__device__ __forceinline__ float wave_sum_dpp(float v) {
    v += dppmov<0xB1>(v);
    v += dppmov<0x4E>(v);
    v += dppmov<0x141>(v);
    v += dppmov<0x140>(v);
    { float c = v; asm volatile("v_nop\n\tv_nop\n\tv_permlane16_swap_b32 %0, %1\n\tv_nop" : "+v"(v), "+v"(c)); v += c; }
    { float c = v; asm volatile("v_nop\n\tv_nop\n\tv_permlane32_swap_b32 %0, %1\n\tv_nop" : "+v"(v), "+v"(c)); v += c; }
    return v;
}
typedef float f32x16 __attribute__((ext_vector_type(16)));

struct RawTok { bf16_t r, k, v, a, ld; };
__device__ __forceinline__ RawTok load_raw(const bf16_t* PRKV, const bf16_t* Ab, const bf16_t* LD, int row, int col) {
    RawTok q; const bf16_t* p0 = PRKV + (size_t)row * 1536 + col;
    q.r = p0[0]; q.k = p0[512]; q.v = p0[1024]; q.a = Ab[(size_t)row * 512 + col]; q.ld = LD[(size_t)row * 512 + col];
    return q;
}
__device__ __forceinline__ void unit_geom(int uid, int lane, int& b, int& h, int& c, int& col, int& row0) {
    const int bh = uid / NCHUNK; c = uid - bh * NCHUNK; b = bh >> 3; h = bh & 7; col = h * 64 + lane;
    row0 = c == 0 ? 0 : b * SEQ + c * 16;
}
__device__ __forceinline__ void phase_scanprep(const PPv& p, LAS unsigned char* lds) {
    const int tid = threadIdx.x, bid = blockIdx.x, nb = gridDim.x, lane = tid & 63, wave = tid >> 6;
    unsigned char* ws = p.gws();
    const bf16_t* PRKV = (const bf16_t*)(ws + OFF_PRKV);
    const bf16_t* LD = (const bf16_t*)(ws + OFF_LD);
    const bf16_t* Ab = (const bf16_t*)(ws + OFF_A);
    float* COEF = (float*)(ws + OFF_COEF);
    LAS unsigned char* wl = lds + wave * 13824;
    LAS bf16_t* AR = (LAS bf16_t*)wl;
    LAS bf16_t* BK = (LAS bf16_t*)(wl + 4608);
    LAS float* DM = (LAS float*)(wl + 9216);
    const int qperm = (lane & 32) | (((lane >> 2) & 3) << 3) | (((lane >> 4) & 1) << 2) | (lane & 3);
    int uid = bid * 8 + wave;
    if (uid >= NUNITS) return;
    int b, h, c, col, row0;
    unit_geom(uid, lane, b, h, c, col, row0);
    RawTok q[16], qn[16];
    bf16_t prr = 0, prk = 0, prv = 0, nprr = 0, nprk = 0, nprv = 0;
#pragma unroll
    for (int t = 0; t < 16; ++t) q[t] = load_raw(PRKV, Ab, LD, row0 + t, col);
    { const int pr = prev_row(row0, 1); if (pr >= 0) { const bf16_t* p1 = PRKV + (size_t)pr * 1536 + col; prr = p1[0]; prk = p1[512]; prv = p1[1024]; } }
    for (;;) {
        const float mur = p.gin(4)[col], muk = p.gin(5)[col], muv = p.gin(6)[col], kkw = p.gin(18)[col], kaw = p.gin(19)[col], rkw = p.gin(20)[col];
        const int nuid = uid + nb * 8; const bool has_next = nuid < NUNITS;
        int nb_ = b, nh = h, nc = c, ncol = col, nrow0 = row0;
        if (has_next) {
            unit_geom(nuid, lane, nb_, nh, nc, ncol, nrow0);
#pragma unroll
            for (int t = 0; t < 16; ++t) qn[t] = load_raw(PRKV, Ab, LD, nrow0 + t, ncol);
            nprr = 0; nprk = 0; nprv = 0;
            const int pr = prev_row(nrow0, 1); if (pr >= 0) { const bf16_t* p1 = PRKV + (size_t)pr * 1536 + ncol; nprr = p1[0]; nprk = p1[512]; nprv = p1[1024]; }
        }
        __builtin_amdgcn_sched_barrier(0);
        LAS float* PM = (LAS float*)wl;
        LAS float* RS = DM;
        {
            float rp = bf2f(prr), kp = bf2f(prk);
#pragma unroll
            for (int t = 0; t < 16; ++t) {
                const RawTok qq = q[t];
                const float r0 = bf2f(qq.r), k0 = bf2f(qq.k);
                const float r = r0 + (rp - r0) * mur, k = k0 + (kp - k0) * muk;
                rp = r0; kp = k0;
                const float a = bf2f(qq.a);
                const float kkv = k * kkw, k2 = k * (1.0f + (a - 1.0f) * kaw);
                PM[t * 68 + lane] = kkv * kkv; PM[(16 + t) * 68 + lane] = r * k2 * rkw;
            }
            asm volatile("" ::: "memory");
            const int rw = lane & 31, hf = lane >> 5;
            f32x4 s4 = (f32x4){0.f, 0.f, 0.f, 0.f};
#pragma unroll
            for (int i = 0; i < 8; ++i) s4 += *(const LAS f32x4*)(PM + rw * 68 + hf * 32 + i * 4);
            float sm = (s4[0] + s4[1]) + (s4[2] + s4[3]);
            { float c2 = sm; asm volatile("v_nop\n\tv_nop\n\tv_permlane32_swap_b32 %0, %1\n\tv_nop" : "+v"(sm), "+v"(c2)); sm += c2; }
            if (lane < 32) RS[lane] = sm;
            asm volatile("" ::: "memory");
            const float cfl = __shfl(sm, (lane & 15) + 16);
            if (lane < 16) COEF[(size_t)(row0 + lane) * 8 + h] = cfl;
        }
        __builtin_amdgcn_sched_barrier(0);
        float at[16], vt[16]; unsigned btp[8], ktp[8]; float bprev = 0.f, kprev = 0.f;
        float cl = 0.f;
        float rp = bf2f(prr), kp = bf2f(prk), vp = bf2f(prv);
        f32x4 n2v[4];
#pragma unroll
        for (int i = 0; i < 4; ++i) n2v[i] = *(const LAS f32x4*)(RS + 4 * i);
        asm volatile("" ::: "memory"); __builtin_amdgcn_sched_barrier(0);
#pragma unroll
        for (int t = 0; t < 16; ++t) {
            const RawTok qq = q[t];
            const float r0 = bf2f(qq.r), k0 = bf2f(qq.k), v0 = bf2f(qq.v);
            const float r = r0 + (rp - r0) * mur, k = k0 + (kp - k0) * muk, v = v0 + (vp - v0) * muv;
            rp = r0; kp = k0; vp = v0;
            const float a = bf2f(qq.a);
            const float kkv = k * kkw;
            const float kk = kkv * __builtin_amdgcn_rsqf(fmaxf(n2v[t >> 2][t & 3], 1e-24f));
            const float k2 = k * (1.0f + (a - 1.0f) * kaw);
            const float wcp = __expf(cl);
            cl += bf2f(qq.ld);
            const float wcn = __expf(cl), iw = __expf(-cl);
            const float btv = kk * a * iw, ktv = k2 * iw;
            at[t] = -kk * wcp; vt[t] = v;
            { const unsigned w = cvt_pk_bf16(at[t], r * wcn); AR[t * 72 + qperm] = (bf16_t)(w & 0xFFFFu); AR[(16 + t) * 72 + qperm] = (bf16_t)(w >> 16); }
            if (t & 1) {
                btp[t >> 1] = cvt_pk_bf16(bprev, btv); ktp[t >> 1] = cvt_pk_bf16(kprev, ktv);
                BK[(t - 1) * 72 + qperm] = (bf16_t)(btp[t >> 1] & 0xFFFFu); BK[t * 72 + qperm] = (bf16_t)(btp[t >> 1] >> 16);
                BK[(16 + t - 1) * 72 + qperm] = (bf16_t)(ktp[t >> 1] & 0xFFFFu); BK[(16 + t) * 72 + qperm] = (bf16_t)(ktp[t >> 1] >> 16);
            } else { bprev = btv; kprev = ktv; }
            if ((t & 3) == 3) __builtin_amdgcn_sched_barrier(0);
        }
        const float wcc = __expf(cl);
        {
            f32x16 dm;
#pragma unroll
            for (int i = 0; i < 16; ++i) dm[i] = 0.f;
            const int rr = lane & 31, hh = lane >> 5;
#pragma unroll
            for (int ks = 0; ks < 4; ++ks) {
                const bf16x8 fa = *(const LAS bf16x8*)(AR + rr * 72 + 16 * ks + 8 * hh);
                const bf16x8 fb = *(const LAS bf16x8*)(BK + rr * 72 + 16 * ks + 8 * hh);
                dm = __builtin_amdgcn_mfma_f32_32x32x16_bf16(fa, fb, dm, 0, 0, 0);
            }
#pragma unroll
            for (int reg = 0; reg < 16; ++reg) DM[((reg & 3) + 8 * (reg >> 2) + 4 * hh) * 36 + rr] = dm[reg];
        }
        __builtin_amdgcn_sched_barrier(0);
        float uh[16];
#pragma unroll
        for (int t = 0; t < 16; ++t) {
            float wv = at[t], uv = 0.f, wv2 = 0.f, uv2 = 0.f, uv3 = 0.f;
#pragma unroll
            for (int s4 = 0; s4 < 4; ++s4) {
                if (s4 * 4 < t) {
                    const f32x4 ab = *(const LAS f32x4*)(DM + t * 36 + s4 * 4), ak = *(const LAS f32x4*)(DM + t * 36 + 16 + s4 * 4);
#pragma unroll
                    for (int j = 0; j < 4; ++j) {
                        const int s_ = s4 * 4 + j;
                        if (s_ < t) {
                            if (j & 1) { wv2 += ab[j] * at[s_]; uv2 += ak[j] * vt[s_]; } else { wv += ab[j] * at[s_]; uv += ak[j] * vt[s_]; }
                            uv3 += ab[j] * uh[s_];
                        }
                    }
                }
            }
            wv += wv2; uv += uv2 + uv3;
            at[t] = wv; uh[t] = uv;
            asm volatile("" : "+v"(at[t]), "+v"(uh[t]));
        }
        __builtin_amdgcn_sched_barrier(0);
#pragma unroll
        for (int t = 0; t < 16; t += 2) { const unsigned w = cvt_pk_bf16(at[t], at[t + 1]); AR[t * 72 + qperm] = (bf16_t)(w & 0xFFFFu); AR[(t + 1) * 72 + qperm] = (bf16_t)(w >> 16); }
        unsigned char* rec = ws + OFF_CH + (size_t)uid * REC_BYTES;
#pragma unroll
        for (int i = 0; i < 2; ++i) {
            const int pc = i * 64 + lane, row = pc >> 3, part = pc & 7;
            *(u32x4*)(rec + RO_WH + pc * 16) = *(const LAS u32x4*)((LAS unsigned char*)AR + row * 144 + part * 16);
            *(u32x4*)(rec + RO_RT + pc * 16) = *(const LAS u32x4*)((LAS unsigned char*)AR + (16 + row) * 144 + part * 16);
        }
        {
            u32x4 w0, w1;
            w0.x = cvt_pk_bf16(uh[0], uh[1]); w0.y = cvt_pk_bf16(uh[2], uh[3]); w0.z = cvt_pk_bf16(uh[4], uh[5]); w0.w = cvt_pk_bf16(uh[6], uh[7]);
            w1.x = cvt_pk_bf16(uh[8], uh[9]); w1.y = cvt_pk_bf16(uh[10], uh[11]); w1.z = cvt_pk_bf16(uh[12], uh[13]); w1.w = cvt_pk_bf16(uh[14], uh[15]);
            *(u32x4*)(rec + RO_U0T + lane * 32) = w0; *(u32x4*)(rec + RO_U0T + lane * 32 + 16) = w1;
            w0.x = cvt_pk_bf16(vt[0], vt[1]); w0.y = cvt_pk_bf16(vt[2], vt[3]); w0.z = cvt_pk_bf16(vt[4], vt[5]); w0.w = cvt_pk_bf16(vt[6], vt[7]);
            w1.x = cvt_pk_bf16(vt[8], vt[9]); w1.y = cvt_pk_bf16(vt[10], vt[11]); w1.z = cvt_pk_bf16(vt[12], vt[13]); w1.w = cvt_pk_bf16(vt[14], vt[15]);
            *(u32x4*)(rec + RO_VT + lane * 32) = w0; *(u32x4*)(rec + RO_VT + lane * 32 + 16) = w1;
        }
#pragma unroll
        for (int g = 0; g < 4; ++g) {
            u32x4 w; w.x = btp[2 * g]; w.y = btp[2 * g + 1]; w.z = ktp[2 * g]; w.w = ktp[2 * g + 1];
            *(u32x4*)(rec + RO_BKT + lane * 64 + g * 16) = w;
        }
        {
            const int t = lane >> 2, g = lane & 3;
            const f32x4 rb = *(const LAS f32x4*)(DM + (16 + t) * 36 + 4 * g), rk = *(const LAS f32x4*)(DM + (16 + t) * 36 + 16 + 4 * g);
            float o[8];
#pragma unroll
            for (int j = 0; j < 4; ++j) { const bool keep = (4 * g + j) <= t; o[j] = keep ? rb[j] : 0.f; o[4 + j] = keep ? rk[j] : 0.f; }
            u32x4 w; w.x = cvt_pk_bf16(o[0], o[1]); w.y = cvt_pk_bf16(o[2], o[3]); w.z = cvt_pk_bf16(o[4], o[5]); w.w = cvt_pk_bf16(o[6], o[7]);
            *(u32x4*)(rec + RO_ARK + t * 64 + g * 16) = w;
        }
        *(float*)(rec + RO_WCC + lane * 4) = wcc;
        if (!has_next) break;
        uid = nuid; b = nb_; h = nh; c = nc; col = ncol; row0 = nrow0;
#pragma unroll
        for (int t = 0; t < 16; ++t) q[t] = qn[t];
        prr = nprr; prk = nprk; prv = nprv;
        __builtin_amdgcn_sched_barrier(0);
    }
}

__device__ __forceinline__ void convert_expert_weights(const PPv& p, LAS unsigned char* lds, int first, int stride);
struct RecOps { bf16x8 wA0, wA1, rA0, rA1, ark, bk[4]; u32x2 u0, vv; f32x4 wc[4]; };
__device__ __forceinline__ void load_ops(RecOps& o, LAS unsigned char* S, int vs, int fr, int g) {
    o.wA0 = *(const LAS bf16x8*)(S + RO_WH + fr * 128 + g * 16); o.wA1 = *(const LAS bf16x8*)(S + RO_WH + fr * 128 + 64 + g * 16);
    o.rA0 = *(const LAS bf16x8*)(S + RO_RT + fr * 128 + g * 16); o.rA1 = *(const LAS bf16x8*)(S + RO_RT + fr * 128 + 64 + g * 16);
    o.u0 = *(const LAS u32x2*)(S + RO_U0T + (16 * vs + fr) * 32 + g * 8);
    o.vv = *(const LAS u32x2*)(S + RO_VT + (16 * vs + fr) * 32 + g * 8);
    o.ark = *(const LAS bf16x8*)(S + RO_ARK + fr * 64 + g * 16);
#pragma unroll
    for (int m = 0; m < 4; ++m) { o.bk[m] = *(const LAS bf16x8*)(S + RO_BKT + (16 * m + fr) * 64 + g * 16); o.wc[m] = *(const LAS f32x4*)(S + RO_WCC + (16 * m + 4 * g) * 4); }
}
__device__ __forceinline__ void phase_recur(const PPv& p, LAS unsigned char* lds) {
    const int tid = threadIdx.x, bid = blockIdx.x, nb = gridDim.x, lane = tid & 63, wave = __builtin_amdgcn_readfirstlane(tid >> 6);
    unsigned char* ws = p.gws();
    if (bid >= 64) { convert_expert_weights(p, lds, bid - 64, nb - 64); return; }
    unsigned char* CHb = ws + OFF_CH + (size_t)(bid * NCHUNK) * REC_BYTES;
    constexpr int RSLOT = REC_BYTES, RN = 10, PF = 7;
#define R_BAR() do { asm volatile("s_waitcnt lgkmcnt(0)" ::: "memory"); __builtin_amdgcn_s_barrier(); asm volatile("" ::: "memory"); } while (0)
    if (wave >= 4) {
        const int lw = wave - 4;
#define R_ISSUE(x) do { \
            LAS unsigned char* _s = lds + ((x) % RN) * RSLOT; const unsigned char* _r = CHb + (size_t)(x) * REC_BYTES + lane * 16; \
            _Pragma("unroll") for (int _i = 0; _i < 3; ++_i) { const int _pc = lw + 4 * _i; __builtin_amdgcn_global_load_lds((const unsigned*)(_r + _pc * 1024), (LAS unsigned*)(_s + _pc * 1024), 16, 0, 0); } \
            if (lw == 0) __builtin_amdgcn_global_load_lds((const unsigned*)(_r + 12 * 1024), (LAS unsigned*)(_s + 12 * 1024), 16, 0, 0); \
            if (lw == 1) { if (lane < 16) __builtin_amdgcn_global_load_lds((const unsigned*)(_r + 13 * 1024), (LAS unsigned*)(_s + 13 * 1024), 16, 0, 0); } } while (0)
        for (int x = 0; x < PF; ++x) R_ISSUE(x);
        asm volatile("s_waitcnt vmcnt(0)" ::: "memory");
        R_BAR();
        for (int c = 0; c < NCHUNK; ++c) {
            const int x = c + PF;
            if (x < NCHUNK) R_ISSUE(x);
            if (x < NCHUNK) { if (lw < 2) asm volatile("s_waitcnt vmcnt(20)" ::: "memory"); else asm volatile("s_waitcnt vmcnt(15)" ::: "memory"); }
            else asm volatile("s_waitcnt vmcnt(0)" ::: "memory");
            R_BAR();
        }
#undef R_ISSUE
    } else {
        const int vs = wave, fr = lane & 15, g = lane >> 4;
        f32x4 H[4];
#pragma unroll
        for (int m = 0; m < 4; ++m) H[m] = (f32x4){0.f, 0.f, 0.f, 0.f};
        R_BAR();
        RecOps cur, nxt;
        load_ops(cur, lds, vs, fr, g);
        for (int c = 0; c < NCHUNK; ++c) {
            if (c + 1 < NCHUNK) load_ops(nxt, lds + ((c + 1) % RN) * RSLOT, vs, fr, g); else nxt = cur;
            u32x4 hb0, hb1;
            hb0.x = cvt_pk_bf16(H[0][0], H[0][1]); hb0.y = cvt_pk_bf16(H[0][2], H[0][3]); hb0.z = cvt_pk_bf16(H[1][0], H[1][1]); hb0.w = cvt_pk_bf16(H[1][2], H[1][3]);
            hb1.x = cvt_pk_bf16(H[2][0], H[2][1]); hb1.y = cvt_pk_bf16(H[2][2], H[2][3]); hb1.z = cvt_pk_bf16(H[3][0], H[3][1]); hb1.w = cvt_pk_bf16(H[3][2], H[3][3]);
            const bf16x8 hB0 = __builtin_bit_cast(bf16x8, hb0), hB1 = __builtin_bit_cast(bf16x8, hb1);
            f32x4 U = (f32x4){bflo(cur.u0.x), bfhi(cur.u0.x), bflo(cur.u0.y), bfhi(cur.u0.y)};
            U = __builtin_amdgcn_mfma_f32_16x16x32_bf16(cur.wA0, hB0, U, 0, 0, 0);
            U = __builtin_amdgcn_mfma_f32_16x16x32_bf16(cur.wA1, hB1, U, 0, 0, 0);
            f32x4 Y = (f32x4){0.f, 0.f, 0.f, 0.f};
            Y = __builtin_amdgcn_mfma_f32_16x16x32_bf16(cur.rA0, hB0, Y, 0, 0, 0);
            Y = __builtin_amdgcn_mfma_f32_16x16x32_bf16(cur.rA1, hB1, Y, 0, 0, 0);
            u32x4 uvw; uvw.x = cvt_pk_bf16(U[0], U[1]); uvw.y = cvt_pk_bf16(U[2], U[3]); uvw.z = cur.vv.x; uvw.w = cur.vv.y;
            const bf16x8 uv = __builtin_bit_cast(bf16x8, uvw);
            Y = __builtin_amdgcn_mfma_f32_16x16x32_bf16(cur.ark, uv, Y, 0, 0, 0);
#pragma unroll
            for (int m = 0; m < 4; ++m) { H[m] = __builtin_amdgcn_mfma_f32_16x16x32_bf16(cur.bk[m], uv, H[m], 0, 0, 0); H[m] *= cur.wc[m]; }
            u32x2 yw; yw.x = cvt_pk_bf16(Y[0], Y[1]); yw.y = cvt_pk_bf16(Y[2], Y[3]);
            *(u32x2*)(CHb + (size_t)c * REC_BYTES + RO_U0T + (16 * vs + fr) * 32 + g * 8) = yw;
            R_BAR();
            cur = nxt;
        }
    }
#undef R_BAR
}

__device__ __forceinline__ void phase_gn(const PPv& p, LAS unsigned char* lds) {
    const int tid = threadIdx.x, bid = blockIdx.x, nb = gridDim.x, lane = tid & 63, wave = tid >> 6;
    unsigned char* ws = p.gws();
    LAS float* PM = (LAS float*)(lds + wave * 8960);
    LAS float* RS = PM + 32 * 68;
    const bf16_t* Gb = (const bf16_t*)(ws + OFF_G); const float* COEF = (const float*)(ws + OFF_COEF);
    bf16_t* Z = (bf16_t*)(ws + OFF_Z);
    constexpr int NREAL = 64 * 256;
    for (int r0 = bid * 8 + wave; r0 < NREAL; r0 += nb * 16) {
        u32x4 y0[2], y1[2], v0[2], v1[2]; float cfv[2][16]; bf16_t ggv[2][16]; int colv[2], row0v[2], hv[2]; bool okv[2];
#pragma unroll
        for (int u = 0; u < 2; ++u) {
            const int r = r0 + u * nb * 8; okv[u] = r < NREAL;
            const int rr = okv[u] ? r : r0;
            const int bh = rr >> 8, c = (rr & 255) + 1, b = bh >> 3, h = bh & 7, uid = bh * NCHUNK + c;
            hv[u] = h; colv[u] = h * 64 + lane; row0v[u] = b * SEQ + c * 16;
            const unsigned char* rec = ws + OFF_CH + (size_t)uid * REC_BYTES;
            y0[u] = *(const u32x4*)(rec + RO_U0T + lane * 32); y1[u] = *(const u32x4*)(rec + RO_U0T + lane * 32 + 16);
            v0[u] = *(const u32x4*)(rec + RO_VT + lane * 32); v1[u] = *(const u32x4*)(rec + RO_VT + lane * 32 + 16);
#pragma unroll
            for (int t = 0; t < 16; ++t) { cfv[u][t] = COEF[(size_t)(row0v[u] + t) * 8 + h]; ggv[u][t] = Gb[(size_t)(row0v[u] + t) * 512 + colv[u]]; }
        }
#pragma unroll
        for (int u = 0; u < 2; ++u) {
            if (!okv[u]) continue;
            const int col = colv[u], row0 = row0v[u];
            const float lng = p.gin(21)[col], lnb = p.gin(22)[col];
            const unsigned yw[8] = {y0[u].x, y0[u].y, y0[u].z, y0[u].w, y1[u].x, y1[u].y, y1[u].z, y1[u].w}, vw[8] = {v0[u].x, v0[u].y, v0[u].z, v0[u].w, v1[u].x, v1[u].y, v1[u].z, v1[u].w};
            asm volatile("" ::: "memory");
#pragma unroll
            for (int t = 0; t < 16; ++t) { const float y = (t & 1) ? bfhi(yw[t >> 1]) : bflo(yw[t >> 1]); PM[t * 68 + lane] = y; PM[(16 + t) * 68 + lane] = y * y; }
            asm volatile("" ::: "memory");
            {
                const int rw = lane & 31, hf = lane >> 5;
                f32x4 s4 = (f32x4){0.f, 0.f, 0.f, 0.f};
#pragma unroll
                for (int i = 0; i < 8; ++i) s4 += *(const LAS f32x4*)(PM + rw * 68 + hf * 32 + i * 4);
                float sm = (s4[0] + s4[1]) + (s4[2] + s4[3]);
                { float c2 = sm; asm volatile("v_nop\n\tv_nop\n\tv_permlane32_swap_b32 %0, %1\n\tv_nop" : "+v"(sm), "+v"(c2)); sm += c2; }
                if (lane < 32) RS[lane] = sm;
            }
            asm volatile("" ::: "memory");
            f32x4 s1v[4], s2v[4];
#pragma unroll
            for (int i = 0; i < 4; ++i) { s1v[i] = *(const LAS f32x4*)(RS + 4 * i); s2v[i] = *(const LAS f32x4*)(RS + 16 + 4 * i); }
            asm volatile("" ::: "memory");
#pragma unroll
            for (int t = 0; t < 16; ++t) {
                const float y = (t & 1) ? bfhi(yw[t >> 1]) : bflo(yw[t >> 1]);
                const float v = (t & 1) ? bfhi(vw[t >> 1]) : bflo(vw[t >> 1]);
                const float mean = s1v[t >> 2][t & 3] * (1.0f / 64.0f);
                const float dlt = y - mean;
                const float var = fmaxf(s2v[t >> 2][t & 3] * (1.0f / 64.0f) - mean * mean, 0.f);
                const float yn = dlt * rsqrtf(var + LNX_EPS) * lng + lnb;
                Z[(size_t)(row0 + t - NMETA) * 512 + col] = f2bf((yn + cfv[u][t] * v) * bf2f(ggv[u][t]));
            }
        }
    }
}

__device__ __forceinline__ void convert_expert_weights(const PPv& p, LAS unsigned char* lds, int first, int stride) {
    unsigned char* ws = p.gws();
    const int tid = threadIdx.x;
    LAS float* tile = (LAS float*)lds;
    const float* g2 = p.gin(27);
    unsigned char* WGU = ws + OFF_WGU; unsigned char* WD = ws + OFF_WD;
    constexpr int NBLK = NE * 3 * 64;
    const int lr = tid >> 6, lc = (tid & 63) * 4;
    f32x4 cur[8];
    int j = first;
    if (j >= NBLK) return;
    {
        const int mat = j >> 6, e = mat / 3, which = mat - 3 * e, bb = j & 63, kb = bb & 15, nbk = bb >> 4;
        const float* src = (which == 0 ? p.gin(30) : which == 1 ? p.gin(32) : p.gin(34)) + (size_t)e * 1024 * 1024 + (size_t)(kb * 64) * 1024 + nbk * 256;
#pragma unroll
        for (int i = 0; i < 8; ++i) cur[i] = __builtin_nontemporal_load((const f32x4*)(src + (size_t)(lr + 8 * i) * 1024 + lc));
    }
    for (;;) {
        const int jn = j + stride; const bool has_next = jn < NBLK;
        f32x4 nxt[8];
        if (has_next) {
            const int mat = jn >> 6, e = mat / 3, which = mat - 3 * e, bb = jn & 63, kb = bb & 15, nbk = bb >> 4;
            const float* src = (which == 0 ? p.gin(30) : which == 1 ? p.gin(32) : p.gin(34)) + (size_t)e * 1024 * 1024 + (size_t)(kb * 64) * 1024 + nbk * 256;
#pragma unroll
            for (int i = 0; i < 8; ++i) nxt[i] = __builtin_nontemporal_load((const f32x4*)(src + (size_t)(lr + 8 * i) * 1024 + lc));
        }
        const int mat = j >> 6, e = mat / 3, which = mat - 3 * e, bb = j & 63, kb = bb & 15, nbk = bb >> 4;
#pragma unroll
        for (int i = 0; i < 8; ++i) { LAS float* t = tile + (lr + 8 * i) * 257 + lc; t[0] = cur[i][0]; t[1] = cur[i][1]; t[2] = cur[i][2]; t[3] = cur[i][3]; }
        __syncthreads();
        {
            const int kq = tid & 7, k0 = kb * 64 + 8 * kq;
            float sc[8];
#pragma unroll
            for (int jj = 0; jj < 8; ++jj) sc[jj] = (which < 2 ? g2[k0 + jj] : 1.0f) * W8_SCALE;
#pragma unroll
            for (int i = 0; i < 4; ++i) {
                const int nn = (tid >> 3) + 64 * i, n = nbk * 256 + nn;
                float v[8];
#pragma unroll
                for (int jj = 0; jj < 8; ++jj) v[jj] = tile[(8 * kq + jj) * 257 + nn] * sc[jj];
                u32x2 w; w.x = pk4_fp8(v[0], v[1], v[2], v[3]); w.y = pk4_fp8(v[4], v[5], v[6], v[7]);
                unsigned char* dst = which < 2 ? WGU + (size_t)e * 2048 * 1024 + (size_t)(256 * (n >> 7) + 128 * which + (n & 127)) * 1024
                                               : WD + (size_t)e * 1024 * 1024 + (size_t)n * 1024;
                __builtin_nontemporal_store(w, (u32x2*)(dst + k0));
            }
        }
        __syncthreads();
        if (!has_next) break;
        j = jn;
#pragma unroll
        for (int i = 0; i < 8; ++i) cur[i] = nxt[i];
    }
}

__device__ __forceinline__ void phase_router(const PPv& p, LAS unsigned char* lds) {
    const int tid = threadIdx.x, bid = blockIdx.x, nb = gridDim.x, lane = tid & 63, wave = tid >> 6;
    unsigned char* ws = p.gws();
    const bf16_t* h1 = (const bf16_t*)(ws + OFF_HB2);
    const float* WRG = (const float*)(ws + OFF_WRG);
    const float* brt = p.gin(29);
    LAS float* slog = (LAS float*)lds;
    LAS float* srs = slog + 8 * 16 * 32;
    LAS int* lcnt = (LAS int*)(srs + 128);
    LAS int* gbase = lcnt + 32;
    LAS int* ltopi = gbase + 32;
    LAS int* lrank = ltopi + 512;
    int* TOPI = (int*)(ws + OFF_TOPI); float* TOPW = (float*)(ws + OFF_TOPW); int* RANK = (int*)(ws + OFF_RANK); float* RSTD2 = (float*)(ws + OFF_RSTD2);
    int* GCNT = (int*)(ws + OFF_GCNT);
    for (int tb = bid; tb < T / 128; tb += nb) {
        if (tid < 32) lcnt[tid] = 0;
        __syncthreads();
        const int t0 = tb * 128 + wave * 16;
        {
            const int row = lane & 15, kq = lane >> 4;
            const bf16_t* ap = h1 + (size_t)(t0 + row) * D + 4 * kq;
            const float* bp = WRG + (size_t)(4 * kq) * 32 + row;
            f32x4 acc0 = (f32x4){0.f, 0.f, 0.f, 0.f}, acc1 = acc0;
            float ss = 0.f;
            for (int j = 0; j < 64; ++j) {
                const u32x2 aw = *(const u32x2*)(ap + 16 * j);
                const f32x4 av = (f32x4){bflo(aw.x), bfhi(aw.x), bflo(aw.y), bfhi(aw.y)};
                ss += av[0] * av[0] + av[1] * av[1] + av[2] * av[2] + av[3] * av[3];
                const float* bj = bp + (size_t)(16 * j) * 32;
#pragma unroll
                for (int s = 0; s < 4; ++s) {
                    const float b0 = bj[s * 32], b1 = bj[s * 32 + 16];
                    acc0 = __builtin_amdgcn_mfma_f32_16x16x4f32(av[s], b0, acc0, 0, 0, 0);
                    acc1 = __builtin_amdgcn_mfma_f32_16x16x4f32(av[s], b1, acc1, 0, 0, 0);
                }
            }
            ss += __shfl_xor(ss, 16); ss += __shfl_xor(ss, 32);
#pragma unroll
            for (int reg = 0; reg < 4; ++reg) {
                slog[(wave * 16 + 4 * kq + reg) * 32 + row] = acc0[reg];
                slog[(wave * 16 + 4 * kq + reg) * 32 + 16 + row] = acc1[reg];
            }
            if (lane < 16) srs[wave * 16 + lane] = rsqrtf(ss * (1.0f / D) + NORM_EPS);
        }
        __syncthreads();
        if (lane < 16) {
            const int tl = wave * 16 + lane, t = tb * 128 + tl;
            const float rs = srs[tl];
            float lg[32];
#pragma unroll
            for (int e = 0; e < 32; ++e) lg[e] = slog[tl * 32 + e] * rs + brt[e];
            int ti[4]; float tv[4];
#pragma unroll
            for (int k = 0; k < 4; ++k) {
                float best = -3.0e38f; int bi = 0;
#pragma unroll
                for (int e = 0; e < 32; ++e) { const bool tk = lg[e] > best; best = tk ? lg[e] : best; bi = tk ? e : bi; }
                ti[k] = bi; tv[k] = best;
#pragma unroll
                for (int e = 0; e < 32; ++e) lg[e] = (e == bi) ? -3.0e38f : lg[e];
            }
            const float e0 = 1.0f, e1 = __expf(tv[1] - tv[0]), e2 = __expf(tv[2] - tv[0]), e3 = __expf(tv[3] - tv[0]);
            const float inv = 1.0f / (e0 + e1 + e2 + e3);
            *(f32x4*)(TOPW + (size_t)t * 4) = (f32x4){e0 * inv, e1 * inv, e2 * inv, e3 * inv};
            RSTD2[t] = rs;
#pragma unroll
            for (int k = 0; k < 4; ++k) { ltopi[tl * 4 + k] = ti[k]; lrank[tl * 4 + k] = __hip_atomic_fetch_add(lcnt + ti[k], 1, __ATOMIC_RELAXED, __HIP_MEMORY_SCOPE_WORKGROUP); }
        }
        __syncthreads();
        if (tid < 32) gbase[tid] = atomicAdd(GCNT + tid, lcnt[tid]);
        __syncthreads();
        {
            const int e = ltopi[tid];
            TOPI[(size_t)tb * 512 + tid] = e;
            RANK[(size_t)tb * 512 + tid] = gbase[e] + lrank[tid];
        }
        __syncthreads();
    }
}

__device__ __forceinline__ void phase_lists(const PPv& p, LAS unsigned char* lds) {
    const int tid = threadIdx.x, bid = blockIdx.x, nb = gridDim.x;
    unsigned char* ws = p.gws();
    LAS int* pstart = (LAS int*)lds;
    LAS int* cnt = pstart + 64;
    const int* GCNT = (const int*)(ws + OFF_GCNT);
    if (tid < 32) cnt[tid] = GCNT[tid];
    __syncthreads();
    if (tid == 0) { int s = 0; for (int e = 0; e < 32; ++e) { pstart[e] = s; s += ((cnt[e] + 255) >> 8) << 8; } pstart[32] = s; }
    __syncthreads();
    const int* TOPI = (const int*)(ws + OFF_TOPI); const float* TOPW = (const float*)(ws + OFF_TOPW); const int* RANK = (const int*)(ws + OFF_RANK); const float* RSTD2 = (const float*)(ws + OFF_RSTD2);
    int* ROWTOK = (int*)(ws + OFF_ROWTOK); int* ROWSLOT = (int*)(ws + OFF_ROWSLOT); float* ROWW = (float*)(ws + OFF_ROWW); float* ROWRS = (float*)(ws + OFF_ROWRS);
    for (int i = bid * 512 + tid; i < T * 4; i += nb * 512) {
        const int e = TOPI[i], pos = pstart[e] + RANK[i], t = i >> 2;
        ROWTOK[pos] = t; ROWSLOT[pos] = i; ROWW[pos] = TOPW[i]; ROWRS[pos] = RSTD2[t];
    }
    for (int e = bid; e < 32; e += nb) {
        for (int pos = pstart[e] + cnt[e] + tid; pos < pstart[e + 1]; pos += 512) { ROWTOK[pos] = 0; ROWSLOT[pos] = -1; ROWW[pos] = 0.f; ROWRS[pos] = 0.f; }
    }
    if (bid == 0) {
        int* TILEE = (int*)(ws + OFF_TILEE);
        const int ntiles = pstart[32] >> 8;
        for (int mt = tid; mt < ntiles; mt += 512) { int e = 0; for (int q = 0; q < 32; ++q) if (pstart[q] <= mt * 256) e = q; TILEE[mt] = e; }
        if (tid == 0) TILEE[1000] = ntiles;
    }
    __syncthreads();
}

__device__ __forceinline__ void phase_final(const PPv& p) {
    const int tid = threadIdx.x, bid = blockIdx.x, nb = gridDim.x, lane = tid & 63, wave = tid >> 6;
    unsigned char* ws = p.gws();
    const bf16_t* HB2 = (const bf16_t*)(ws + OFF_HB2);
    const unsigned char* Y8 = (const unsigned char*)p.gout();
    const float* gf = p.gin(36);
    const f32x4 ga0 = *(const f32x4*)(gf + 8 * lane), ga1 = *(const f32x4*)(gf + 8 * lane + 4), gb0 = *(const f32x4*)(gf + 512 + 8 * lane), gb1 = *(const f32x4*)(gf + 512 + 8 * lane + 4);
    for (int t0 = (bid * 8 + wave) * 2; t0 < T; t0 += nb * 16) {
        u32x4 ha[2], hb[2]; u32x2 ya[2][4], yb[2][4];
#pragma unroll
        for (int u = 0; u < 2; ++u) {
            const int t = t0 + u;
            ha[u] = __builtin_nontemporal_load((const u32x4*)(HB2 + (size_t)t * D + 8 * lane)); hb[u] = __builtin_nontemporal_load((const u32x4*)(HB2 + (size_t)t * D + 512 + 8 * lane));
#pragma unroll
            for (int k = 0; k < 4; ++k) { ya[u][k] = __builtin_nontemporal_load((const u32x2*)(Y8 + (size_t)(4 * t + k) * 1024 + 8 * lane)); yb[u][k] = __builtin_nontemporal_load((const u32x2*)(Y8 + (size_t)(4 * t + k) * 1024 + 512 + 8 * lane)); }
        }
#pragma unroll
        for (int u = 0; u < 2; ++u) {
            const int t = t0 + u;
            float va[8] = {bflo(ha[u].x), bfhi(ha[u].x), bflo(ha[u].y), bfhi(ha[u].y), bflo(ha[u].z), bfhi(ha[u].z), bflo(ha[u].w), bfhi(ha[u].w)};
            float vb[8] = {bflo(hb[u].x), bfhi(hb[u].x), bflo(hb[u].y), bfhi(hb[u].y), bflo(hb[u].z), bfhi(hb[u].z), bflo(hb[u].w), bfhi(hb[u].w)};
#pragma unroll
            for (int k = 0; k < 4; ++k) {
                const u32x2 a4 = ya[u][k], b4 = yb[u][k];
                { const f32x2 q0 = __builtin_amdgcn_cvt_pk_f32_fp8((int)a4.x, false), q1 = __builtin_amdgcn_cvt_pk_f32_fp8((int)a4.x, true), q2 = __builtin_amdgcn_cvt_pk_f32_fp8((int)a4.y, false), q3 = __builtin_amdgcn_cvt_pk_f32_fp8((int)a4.y, true);
                  va[0] += q0.x; va[1] += q0.y; va[2] += q1.x; va[3] += q1.y; va[4] += q2.x; va[5] += q2.y; va[6] += q3.x; va[7] += q3.y; }
                { const f32x2 q0 = __builtin_amdgcn_cvt_pk_f32_fp8((int)b4.x, false), q1 = __builtin_amdgcn_cvt_pk_f32_fp8((int)b4.x, true), q2 = __builtin_amdgcn_cvt_pk_f32_fp8((int)b4.y, false), q3 = __builtin_amdgcn_cvt_pk_f32_fp8((int)b4.y, true);
                  vb[0] += q0.x; vb[1] += q0.y; vb[2] += q1.x; vb[3] += q1.y; vb[4] += q2.x; vb[5] += q2.y; vb[6] += q3.x; vb[7] += q3.y; }
            }
            float ss = 0.f;
#pragma unroll
            for (int j = 0; j < 8; ++j) ss += va[j] * va[j] + vb[j] * vb[j];
            ss = wave_sum_dpp(ss);
            const float rs = rsqrtf(ss * (1.0f / D) + NORM_EPS);
            float* o = p.gout() + (size_t)t * D;
            __builtin_nontemporal_store((f32x4){va[0] * rs * ga0[0], va[1] * rs * ga0[1], va[2] * rs * ga0[2], va[3] * rs * ga0[3]}, (f32x4*)(o + 8 * lane));
            __builtin_nontemporal_store((f32x4){va[4] * rs * ga1[0], va[5] * rs * ga1[1], va[6] * rs * ga1[2], va[7] * rs * ga1[3]}, (f32x4*)(o + 8 * lane + 4));
            __builtin_nontemporal_store((f32x4){vb[0] * rs * gb0[0], vb[1] * rs * gb0[1], vb[2] * rs * gb0[2], vb[3] * rs * gb0[3]}, (f32x4*)(o + 512 + 8 * lane));
            __builtin_nontemporal_store((f32x4){vb[4] * rs * gb1[0], vb[5] * rs * gb1[1], vb[6] * rs * gb1[2], vb[7] * rs * gb1[3]}, (f32x4*)(o + 512 + 8 * lane + 4));
        }
    }
}

#define XB_TMO      128
#define XB_XCNT(j)  (256  + 64 * (j))
#define XB_XSUB(j)  (1280 + 64 * (j))
#define XB_XGEN(j)  (2304 + 64 * (j))
#define XB_TOP      3328
#define XB_TOPGEN   3392
#define XCD_BAR_WORDS 3456
#define XB_SPIN_CAP (1u << 18)
__device__ __forceinline__ unsigned xb_ld(unsigned* p)              { return __hip_atomic_load(p, __ATOMIC_RELAXED, __HIP_MEMORY_SCOPE_AGENT); }
__device__ __forceinline__ unsigned xb_add(unsigned* p, unsigned v) { return __hip_atomic_fetch_add(p, v, __ATOMIC_RELAXED, __HIP_MEMORY_SCOPE_AGENT); }
__device__ __forceinline__ unsigned xb_xcc_id() { return (unsigned)__builtin_amdgcn_s_getreg((3 << 11) | 20) & 0xFu; }
#define XB_SPIN(cond, bar) do { unsigned _sp = 0; while (cond) { __builtin_amdgcn_s_sleep(1); \
    if ((++_sp & 255u) == 0u) { if (xb_ld(&(bar)[XB_TMO])) break; if (_sp > XB_SPIN_CAP) { atomicAdd(&(bar)[XB_TMO], 1u); break; } } } } while (0)
struct XcdBarrier { unsigned* bar; unsigned x; volatile LAS unsigned* st; };
__device__ __forceinline__ XcdBarrier xcd_barrier_post(unsigned* bar, volatile LAS unsigned* st) {
    XcdBarrier b; b.bar = bar; b.x = xb_xcc_id(); b.st = st;
    if (threadIdx.x == 0) (void)xb_add(&bar[XB_XCNT(b.x)], 1u);
    return b;
}
__device__ __forceinline__ void xcd_barrier_complete(unsigned* bar, unsigned x, unsigned& nloc, unsigned& nx) {
    const unsigned G = gridDim.x * gridDim.y * gridDim.z;
    unsigned sum, cnt, mine, sp = 0u;
    for (;;) {
        sum = 0u; cnt = 0u; mine = 0u;
#pragma unroll
        for (unsigned j = 0; j < 16; ++j) { const unsigned c = xb_ld(&bar[XB_XCNT(j)]); sum += c; cnt += (c > 0u) ? 1u : 0u; mine = (j == x) ? c : mine; }
        if (sum == G) break;
        __builtin_amdgcn_s_sleep(1);
        if ((++sp & 255u) == 0u) { if (xb_ld(&bar[XB_TMO])) break; if (sp > XB_SPIN_CAP) { atomicAdd(&bar[XB_TMO], 1u); break; } }
    }
    nloc = mine > 0u ? mine : 1u; nx = cnt > 0u ? cnt : 1u;
}
__device__ __forceinline__ void xcd_barrier(const XcdBarrier& b) {
    asm volatile("s_waitcnt vmcnt(0)" ::: "memory");
    __syncthreads();
    if (threadIdx.x == 0) {
        unsigned* bar = b.bar;
        __builtin_amdgcn_s_waitcnt(0);
        unsigned nloc = b.st[0], nx = b.st[1];
        if (nloc == 0u) { xcd_barrier_complete(bar, b.x, nloc, nx); b.st[0] = nloc; b.st[1] = nx; }
        const unsigned old = xb_add(&bar[XB_XSUB(b.x)], 1u);
        const unsigned gen = old / nloc;
        if (old + 1u == (gen + 1u) * nloc) {
            __builtin_amdgcn_fence(__ATOMIC_RELEASE, "agent");
            asm volatile("s_waitcnt vmcnt(0)" ::: "memory");
            const unsigned og = xb_add(&bar[XB_TOP], 1u);
            const unsigned tg = og / nx;
            if (og + 1u == (tg + 1u) * nx) xb_add(&bar[XB_TOPGEN], 1u);
            else XB_SPIN(xb_ld(&bar[XB_TOPGEN]) == tg, bar);
            __builtin_amdgcn_fence(__ATOMIC_ACQUIRE, "agent");
            xb_add(&bar[XB_XGEN(b.x)], 1u);
            asm volatile("s_waitcnt vmcnt(0)" ::: "memory");
        } else {
            XB_SPIN(xb_ld(&bar[XB_XGEN(b.x)]) == gen, bar);
            __builtin_amdgcn_fence(__ATOMIC_ACQUIRE, "agent");
            asm volatile("s_waitcnt vmcnt(0)" ::: "memory");
        }
    }
    __syncthreads();
}

constexpr int N_PHASES = 15;
__global__ void __launch_bounds__(512, 2) mega(Params p) {
    extern __shared__ __attribute__((aligned(16))) unsigned char lds_raw[];
    LAS unsigned char* lds = (LAS unsigned char*)lds_raw;
    cg::grid_group grid = cg::this_grid();
    unsigned char* ws = getpp().gws();
    const int G = gridDim.x, bid = blockIdx.x;
#ifndef ONLY_PHASE
#define ONLY_PHASE -1
#endif
#define IN(k) ((ONLY_PHASE < 0 || ONLY_PHASE == (k)) && p.ph_lo <= (k) && (k) < p.ph_hi)
    volatile LAS unsigned* xst = (volatile LAS unsigned*)(lds + 163840 - 16);
    if (threadIdx.x < 4) xst[threadIdx.x] = 0u;
    __syncthreads();
    const XcdBarrier xbar = xcd_barrier_post((unsigned*)(ws + OFF_BAR), xst);
    if (p.ph_hi < 0) grid.sync();
#define SEAM(k) do { if ((k) + 1 < p.ph_hi) xcd_barrier(xbar); } while (0)
    if (IN(0)) { const PPv q = getpp(); phase_prep(q, lds); SEAM(0); }
    if (IN(1)) { const PPv q = getpp();
        phase_meta_proj(q, lds);
        StaticOrder S; S.init(ws + OFF_HB, ws + OFF_WIN, T, NCOLS1, 1024, G, bid);
        EpiProj E{(bf16_t*)(ws + OFF_PRKV), (bf16_t*)(ws + OFF_PCONV), (bf16_t*)q.gout(), (const float*)(ws + OFF_RSTD1)};
        gemm_phase<false>(lds, 1024, S, E);
        SEAM(1);
    }
    if (IN(2)) { const PPv q = getpp(); phase_lprep_conv(q); SEAM(2); }
    if (IN(3)) { const PPv q = getpp();
        phase_meta_lora(q);
        StaticOrder S; S.init(ws + OFF_L + (size_t)NMETA * 256 * 2, ws + OFF_W2, T, 1536, 256, G, bid);
        EpiL E{ws, q.gin(10), q.gin(13)};
        gemm_phase<false>(lds, 256, S, E);
        SEAM(3);
    }
    if (IN(4)) { const PPv q = getpp(); phase_scanprep(q, lds); SEAM(4); }
    if (IN(5)) { const PPv q = getpp(); phase_recur(q, lds); SEAM(5); }
    if (IN(6)) { const PPv q = getpp(); phase_gn(q, lds); SEAM(6); }
    if (IN(7)) { const PPv q = getpp();
        MergeOrder S; S.so.init(ws + OFF_Z, ws + OFF_WR, T, 1024, 512, G, bid); S.A1 = (const char*)(ws + OFF_C); S.B1 = (const char*)(ws + OFF_WC);
        EpiMergeFused E{(bf16_t*)(ws + OFF_MERGED), (const bf16_t*)q.gout()};
        gemm_phase<false>(lds, 512, S, E);
        SEAM(7);
    }
    if (IN(9)) { const PPv q = getpp();
        StaticOrder S; S.init(ws + OFF_MERGED, ws + OFF_WO, T, 1024, 1024, G, bid);
        EpiO E{q.gin(0), q.gout(), (bf16_t*)(ws + OFF_HB2), ws + OFF_HB8};
        gemm_phase<false>(lds, 1024, S, E);
        SEAM(9);
    }
    if (IN(10)) { const PPv q = getpp(); phase_router(q, lds); SEAM(10); }
    if (IN(11)) { const PPv q = getpp(); phase_lists(q, lds); SEAM(11); }
    if (IN(12)) { const PPv q = getpp();
        const int* TILEE = (const int*)(ws + OFF_TILEE);
        MoeOrder S; S.A = (const char*)(ws + OFF_HB8); S.Bt = (const char*)(ws + OFF_WGU); S.K = 512; S.estride = (size_t)2048 * 1024;
        S.tile_e = TILEE; S.rowtok = (const int*)(ws + OFF_ROWTOK); S.ntiles = TILEE[1000]; S.nnt = 8; S.G = G; S.c = bid; S.gather = true;
        EpiMoe1 E{ws + OFF_ACT, (const float*)(ws + OFF_ROWRS), q.gin(31), q.gin(33)};
        gemm_phase<true, true>(lds, 512, S, E);
        SEAM(12);
    }
    if (IN(13)) { const PPv q = getpp();
        const int* TILEE = (const int*)(ws + OFF_TILEE);
        MoeOrder S; S.A = (const char*)(ws + OFF_ACT); S.Bt = (const char*)(ws + OFF_WD); S.K = 512; S.estride = (size_t)1024 * 1024;
        S.tile_e = TILEE; S.rowtok = nullptr; S.ntiles = TILEE[1000]; S.nnt = 4; S.G = G; S.c = bid; S.gather = false;
        EpiMoe2 E{(unsigned char*)q.gout(), (const int*)(ws + OFF_ROWSLOT), (const float*)(ws + OFF_ROWW), q.gin(35)};
        gemm_phase<false, true>(lds, 512, S, E);
        SEAM(13);
    }
    if (IN(14)) { const PPv q = getpp(); phase_final(q); }
}

extern "C" void kernel_launch(void* const* d_in, const int* in_sizes, int n_in, void* d_out, int out_size, void* d_ws, size_t ws_size,
                              hipStream_t stream) {
    constexpr size_t kDynLds = 160 * 1024;
    static int grid_blocks = 0;
    if (!grid_blocks) {
        int dev = 0, cus = 0, per_cu = 0;
        (void)hipGetDevice(&dev);
        (void)hipDeviceGetAttribute(&cus, hipDeviceAttributeMultiprocessorCount, dev);
        (void)hipFuncSetAttribute((const void*)mega, hipFuncAttributeMaxDynamicSharedMemorySize, (int)kDynLds);
        (void)hipOccupancyMaxActiveBlocksPerMultiprocessor(&per_cu, mega, 512, kDynLds);
        if (per_cu > 1) per_cu = 1;
        grid_blocks = cus * per_cu;
        fprintf(stderr, "cus=%d per_cu=%d ws_size=%zu need=%zu\n", cus, per_cu, ws_size, (size_t)WS_NEED);
    }
    if (ws_size < WS_NEED || n_in < 37 || grid_blocks < 128) { fprintf(stderr, "kernel_launch: unsupported configuration\n"); return; }
    Params p{};
    for (int i = 0; i < 37; ++i) p.in[i] = (const float*)d_in[i];
    p.out = (float*)d_out;
    p.ws = (unsigned char*)d_ws;
    p.ph_lo = 0; p.ph_hi = N_PHASES;
    (void)hipMemsetAsync((unsigned char*)d_ws + OFF_BAR, 0, 16384, stream);
    void* args[] = {&p};
    hipError_t e = hipLaunchCooperativeKernel((void*)mega, dim3(grid_blocks), dim3(512), args, kDynLds, stream);
    if (e != hipSuccess) fprintf(stderr, "cooperative launch failed: %s (grid %d)\n", hipGetErrorString(e), grid_blocks);
}
```

```cpp
#include <hip/hip_runtime.h>
#include <hip/hip_cooperative_groups.h>
#include <cstdio>
namespace cg = cooperative_groups;

#define LAS __attribute__((address_space(3)))
typedef unsigned short bf16_t;
typedef short bf16x8 __attribute__((ext_vector_type(8)));
typedef float f32x4 __attribute__((ext_vector_type(4)));
typedef float f32x2 __attribute__((ext_vector_type(2)));
typedef unsigned u32x4 __attribute__((ext_vector_type(4)));
typedef unsigned u32x2 __attribute__((ext_vector_type(2)));

constexpr int D = 1024, NBATCH = 8, SEQ = 4096, NMETA = 16;
constexpr int T = NBATCH * SEQ;
constexpr int NR = T + NMETA;
constexpr int NRP = 33024;
constexpr int PCOLS1 = 3584;
constexpr int NCOLS1 = 5632;
constexpr int NE = 32, TOPK = 4, DFF = 1024;
constexpr int MAXROWS = T * TOPK + NE * 256;
constexpr int MAXTILES = MAXROWS / 256;
constexpr float NORM_EPS = 1e-5f, LNX_EPS = 64e-5f;

constexpr int NCHUNK = 257, NUNITS = 64 * NCHUNK;
constexpr int REC_BYTES = 13568;
constexpr int RO_WH = 0, RO_RT = 2048, RO_U0T = 4096, RO_VT = 6144, RO_BKT = 8192, RO_ARK = 12288, RO_WCC = 13312;
constexpr int SLOT_BYTES = 15680, SO_G = 13568, SO_COEF = 15616, NSLOT = 9;
constexpr size_t SZ_ACT = (size_t)MAXROWS * 1024 * 2;
constexpr size_t SZ_WGU = (size_t)NE * 2048 * 1024 * 2;
constexpr size_t SZ_WD = (size_t)NE * 1024 * 1024 * 2;
constexpr size_t SZ_HB = (size_t)T * 1024 * 2;
constexpr size_t OFF_WGU = 0;
constexpr size_t OFF_HB8 = OFF_WGU + (size_t)NE * 2048 * 1024;
constexpr size_t OFF_WD = OFF_WGU + SZ_WGU;
constexpr size_t OFF_ACT = OFF_WD + SZ_WD;
constexpr size_t OFF_HB2 = OFF_ACT + SZ_ACT;
constexpr size_t OFF_RT = OFF_HB2 + SZ_HB;
constexpr size_t OFF_TOPI = OFF_RT;
constexpr size_t OFF_TOPW = OFF_TOPI + (size_t)T * 16;
constexpr size_t OFF_RANK = OFF_TOPW + (size_t)T * 16;
constexpr size_t OFF_RSTD2 = OFF_RANK + (size_t)T * 16;
constexpr size_t OFF_ROWTOK = OFF_RSTD2 + (size_t)T * 4;
constexpr size_t OFF_ROWSLOT = OFF_ROWTOK + (size_t)MAXROWS * 4;
constexpr size_t OFF_ROWW = OFF_ROWSLOT + (size_t)MAXROWS * 4;
constexpr size_t OFF_ROWRS = OFF_ROWW + (size_t)MAXROWS * 4;
constexpr size_t OFF_TILEE = OFF_ROWRS + (size_t)MAXROWS * 4;
constexpr size_t OFF_GCNT = OFF_TILEE + 4096;
constexpr size_t OFF_SM = OFF_GCNT + 256;
constexpr size_t OFF_WR = OFF_SM;
constexpr size_t OFF_WC = OFF_WR + (size_t)1024 * 512 * 2;
constexpr size_t OFF_WO = OFF_WC + (size_t)1024 * 512 * 2;
constexpr size_t OFF_W2 = OFF_WO + (size_t)1024 * 1024 * 2;
constexpr size_t OFF_RSTD1 = OFF_W2 + (size_t)1536 * 256 * 2;
constexpr size_t OFF_WRG = OFF_RSTD1 + (size_t)NRP * 4;
constexpr size_t OFF_BAR = OFF_WRG + (size_t)1024 * 32 * 4;
constexpr size_t WS_NEED = OFF_BAR + 16384;
constexpr size_t OFF_PRKV = 0;
constexpr size_t SZ_PRKV = (size_t)NR * 1536 * 2;
constexpr size_t OFF_LD = OFF_PRKV + SZ_PRKV;
constexpr size_t OFF_A = OFF_LD + (size_t)NRP * 512 * 4;
constexpr size_t OFF_CH = OFF_A + (size_t)NRP * 512 * 2;
constexpr size_t OFF_PCONV = OFF_CH;
constexpr size_t SZ_PCONV = (size_t)NR * 2048 * 2;
constexpr size_t OFF_HB = OFF_PCONV + SZ_PCONV;
constexpr size_t OFF_L = OFF_HB + SZ_HB;
constexpr size_t OFF_WIN = OFF_L + (size_t)NRP * 256 * 2;
constexpr size_t CH_END = OFF_WIN + (size_t)NCOLS1 * 1024 * 2;
constexpr size_t OFF_MERGED = OFF_CH;
constexpr size_t OFF_G = CH_END;
constexpr size_t OFF_C = OFF_G + (size_t)NRP * 512 * 2;
constexpr size_t OFF_Z = OFF_C + (size_t)T * 512 * 2;
constexpr size_t OFF_COEF = OFF_Z + (size_t)T * 512 * 2;
constexpr size_t EARLY_END = OFF_COEF + (size_t)NR * 8 * 4;
static_assert(EARLY_END <= OFF_RT, "early buffers overflow");
static_assert(OFF_CH + (size_t)NUNITS * REC_BYTES <= CH_END, "chunk records overflow");
static_assert(OFF_CH >= OFF_WD + SZ_WD, "expert weights (written during the scan) must not touch live scan buffers");
static_assert(OFF_MERGED + SZ_HB <= OFF_HB2, "layout");
static_assert(OFF_PRKV % 16 == 0 && OFF_LD % 16 == 0 && OFF_A % 16 == 0 && OFF_CH % 16 == 0 && OFF_HB % 16 == 0 && OFF_L % 16 == 0 && OFF_WIN % 16 == 0 && OFF_G % 16 == 0 && OFF_C % 16 == 0 && OFF_Z % 16 == 0 && OFF_COEF % 16 == 0, "align");

#define GAS __attribute__((address_space(1)))
#define CAS __attribute__((address_space(4)))
struct Params {
    const float* in[37];
    float* out;
    unsigned char* ws;
    int ph_lo, ph_hi;
};
struct ParamsD {
    const GAS float* in[37];
    GAS float* out;
    GAS unsigned char* ws;
    int ph_lo, ph_hi;
};
static_assert(sizeof(Params) == sizeof(ParamsD), "argument views");
struct PPv {
    const CAS ParamsD* k;
    __device__ __forceinline__ const float* gin(int i) const { return (const float*)k->in[i]; }
    __device__ __forceinline__ float* gout() const { return (float*)k->out; }
    __device__ __forceinline__ unsigned char* gws() const { return (unsigned char*)k->ws; }
};
__device__ __forceinline__ PPv getpp() { const CAS ParamsD* k = (const CAS ParamsD*)__builtin_amdgcn_kernarg_segment_ptr(); asm volatile("" : "+s"(k)); return PPv{k}; }

typedef __bf16 bf16x2v __attribute__((ext_vector_type(2)));
__device__ __forceinline__ unsigned cvt_pk_bf16(float lo, float hi) { const f32x2 v = {lo, hi}; return __builtin_bit_cast(unsigned, __builtin_convertvector(v, bf16x2v)); }
__device__ __forceinline__ unsigned pk4_fp8(float a, float b, float c, float d) { int w = __builtin_amdgcn_cvt_pk_fp8_f32(a, b, 0, false); w = __builtin_amdgcn_cvt_pk_fp8_f32(c, d, w, true); return (unsigned)w; }
constexpr float W8_SCALE = 32.0f, W8_INV = 1.0f / 32.0f;
__device__ __forceinline__ bf16_t f2bf(float f) { unsigned u = __float_as_uint(f); u += 0x7FFFu + ((u >> 16) & 1u); return (bf16_t)(u >> 16); }
__device__ __forceinline__ float bf2f(bf16_t b) { return __uint_as_float(((unsigned)b) << 16); }
__device__ __forceinline__ float bflo(unsigned w) { return __uint_as_float(w << 16); }
__device__ __forceinline__ float bfhi(unsigned w) { return __uint_as_float(w & 0xFFFF0000u); }
__device__ __forceinline__ float sigmoidf_(float x) { return __builtin_amdgcn_rcpf(1.0f + __expf(-x)); }
__device__ __forceinline__ float wave_sum(float v) {
#pragma unroll
    for (int o = 32; o >= 1; o >>= 1) v += __shfl_xor(v, o);
    return v;
}
__device__ __forceinline__ float wave_sum_dpp(float v);
__device__ __forceinline__ int prev_row(int row, int d) {
    if (row < NMETA) return row - d >= 0 ? row - d : -1;
    const int s = (row - NMETA) & (SEQ - 1);
    return s >= d ? row - d : NMETA + s - d;
}

constexpr int BM = 256, BK = 64, HALF = 128, HTB = HALF * BK * 2, STAGE_BYTES = 8 * HTB, NXCD = 8, WGM = 8;
__device__ __forceinline__ int lds_byte(int r, int c) { const int st = (r >> 4) * 2 + (c >> 5), rr = r & 15, cc = c & 31, ob = rr * 64 + cc * 2; return st * 1024 + (ob ^ (((ob >> 9) & 1) << 5)); }
__device__ __forceinline__ void stage_rc(int b, int& R, int& C) { const int st = b / 1024, sb = b % 1024, swz = sb ^ (((sb >> 9) & 1) << 5); R = (st >> 1) * 16 + swz / 64; C = (st & 1) * 32 + (swz % 64) / 2; }
__device__ __forceinline__ int perm32(int rho) { const int n = rho >> 4, i = rho & 15; return 8 * (i >> 2) + 4 * n + (i & 3); }

struct Unit { int pm, pn, aux; };

struct StaticOrder {
    const char* A; const char* Bt; int K;
    int nM, nN, nwg, G, c;
    __device__ void init(const void* A_, const void* Bt_, int M, int N, int K_, int G_, int c_) { A = (const char*)A_; Bt = (const char*)Bt_; K = K_; nM = M / BM; nN = N / BM; nwg = nM * nN; G = G_; c = c_; }
    __device__ bool next(int i, Unit& u) const {
        const long L = (long)i * G + c; if (L >= nwg) return false;
        int wgid = (int)L; { const int q = nwg / NXCD, r = nwg % NXCD, xcd = wgid % NXCD, off = wgid / NXCD; wgid = (xcd < r ? xcd * (q + 1) : r * (q + 1) + (xcd - r) * q) + off; }
        const int nig = WGM * nN, gid = wgid / nig, fm = gid * WGM, gsz = (nM - fm) < WGM ? (nM - fm) : WGM;
        u.pm = fm + ((wgid % nig) % gsz); u.pn = (wgid % nig) / gsz; u.aux = 0; return true;
    }
    __device__ __forceinline__ const char* a_ptr(const Unit& u) const { return A + (size_t)u.pm * 256 * K * 2; }
    __device__ __forceinline__ const char* b_ptr(const Unit& u) const { return Bt + (size_t)u.pn * 256 * K * 2; }
    __device__ __forceinline__ int gather_row(const Unit&, int) const { return 0; }
    __device__ __forceinline__ const void* gather_src(const Unit&, int) const { return nullptr; }
};
struct MoeOrder {
    const char* A; const char* Bt; int K; size_t estride;
    const int* tile_e; const int* rowtok; int ntiles, nnt, G, c; bool gather;
    __device__ bool next(int i, Unit& u) const {
        int mt, nt;
        if ((G & 7) == 0 && ((G >> 3) % nnt) == 0) {
            const int x = c & 7, j = c >> 3, per = (G >> 3) / nnt;
            mt = (i * 8 + x) * per + j / nnt; nt = j % nnt;
        } else { const long L = (long)i * G + c; mt = (int)(L / nnt); nt = (int)(L % nnt); }
        if (mt >= ntiles) return false;
        u.pm = mt; u.pn = nt; u.aux = tile_e[mt]; return true;
    }
    __device__ __forceinline__ const char* a_ptr(const Unit& u) const { return gather ? A : A + (size_t)u.pm * 256 * K * 2; }
    __device__ __forceinline__ const char* b_ptr(const Unit& u) const { return Bt + (size_t)u.aux * estride + (size_t)u.pn * 256 * K * 2; }
    __device__ __forceinline__ int gather_row(const Unit& u, int r) const { return rowtok[u.pm * 256 + r]; }
    __device__ __forceinline__ const void* gather_src(const Unit& u, int lane) const { return rowtok + u.pm * 256 + lane * 4; }
};

typedef int i32x4 __attribute__((ext_vector_type(4)));
typedef int i32x8 __attribute__((ext_vector_type(8)));
template <bool GATHER, bool FP8 = false, class Epi, class Sched>
__device__ __forceinline__ void gemm_phase(LAS unsigned char* lds, const int K_, const Sched& S, const Epi& E) {
    int K = K_; asm volatile("" : "+s"(K));
    const int tid = threadIdx.x, wid = __builtin_amdgcn_readfirstlane(tid >> 6), lane = tid & 63, wr = wid >> 2, wc = wid & 3, fr = lane & 15, fq = lane >> 4;
    const int nt = K / BK;
    unsigned voffA[2], voffB[2]; int Rr[2], Cc[2];
#pragma unroll
    for (int i = 0; i < 2; ++i) { int R, C; stage_rc(tid * 16 + i * 8192, R, C); const int Rb = (R & ~31) + perm32(R & 31);
        Rr[i] = R; Cc[i] = C; voffA[i] = (unsigned)(R * K + C) * 2u; voffB[i] = (unsigned)(Rb * K + C) * 2u; }
    const size_t kstep = (size_t)(BK * 2);
    const size_t hstep = (size_t)HALF * K * 2;
    const unsigned ldsw = (unsigned)wid * 1024u;
    const int aoff = lds_byte(wr * 64 + fr, fq * 8), boff = lds_byte(wc * 32 + fr, fq * 8);
    unsigned vgc[2][2], vgn[2][2];
    LAS unsigned char* const parbase = lds + STAGE_BYTES;
    constexpr int NPAR = Epi::NPAR;
#define G_PAR_ISSUE(unit, uidx, hasnx, nxunit) do { \
        LAS unsigned char* _ps = parbase + ((uidx) & 1) * 4096; \
        if (wid < NPAR) __builtin_amdgcn_global_load_lds((const unsigned*)E.par_src(unit, wid, lane), (LAS unsigned*)(_ps + wid * 1024), 16, 0, 0); \
        if (GATHER && (hasnx) && wid == NPAR) __builtin_amdgcn_global_load_lds((const unsigned*)S.gather_src(nxunit, lane), (LAS unsigned*)(_ps + NPAR * 1024), 16, 0, 0); } while (0)
#define G_CAT8(x0, x1) __builtin_shufflevector(__builtin_bit_cast(i32x4, x0), __builtin_bit_cast(i32x4, x1), 0, 1, 2, 3, 4, 5, 6, 7)
#define G_SA(b, h) (((b) * 2 + (h)) * HTB)
#define G_SB(b, h) ((4 + (b) * 2 + (h)) * HTB)
#define G_STAGE(bufoff, gbase, voff) do { _Pragma("unroll") for (int _i = 0; _i < 2; ++_i) \
        __builtin_amdgcn_global_load_lds((const unsigned*)((const char*)(gbase) + (voff)[_i]), (LAS unsigned*)(lds + (bufoff) + ldsw + _i * 8192), 16, 0, 0); } while (0)
#define G_STAGE_A(bufoff, kptr, h, VG) do { if (GATHER) { G_STAGE(bufoff, kptr, VG[h]); } else { G_STAGE(bufoff, (kptr) + (h) * hstep, voffA); } } while (0)
#define G_LDA(dst, b, h) do { _Pragma("unroll") for (int m = 0; m < 4; ++m) { \
        if (FP8) dst##8[m] = G_CAT8(*(const LAS bf16x8*)(lds + G_SA(b, h) + aoff + m * 2048), *(const LAS bf16x8*)(lds + G_SA(b, h) + aoff + m * 2048 + 1024)); \
        else { _Pragma("unroll") for (int k = 0; k < 2; ++k) dst[m][k] = *(const LAS bf16x8*)(lds + G_SA(b, h) + aoff + m * 2048 + k * 1024); } } } while (0)
#define G_LDB(dst, b, h) do { _Pragma("unroll") for (int n = 0; n < 2; ++n) { \
        if (FP8) dst##8[n] = G_CAT8(*(const LAS bf16x8*)(lds + G_SB(b, h) + boff + n * 2048), *(const LAS bf16x8*)(lds + G_SB(b, h) + boff + n * 2048 + 1024)); \
        else { _Pragma("unroll") for (int k = 0; k < 2; ++k) dst[n][k] = *(const LAS bf16x8*)(lds + G_SB(b, h) + boff + n * 2048 + k * 1024); } } } while (0)
#define G_MMA(ai, bj, At, Bt) do { __builtin_amdgcn_s_setprio(1); _Pragma("unroll") for (int m = 0; m < 4; ++m) _Pragma("unroll") for (int n = 0; n < 2; ++n) { \
        if (FP8) asm volatile("v_mfma_scale_f32_16x16x128_f8f6f4 %0, %1, %2, %0, %3, %3 op_sel_hi:[0,0,0]" : "+v"(acc[ai][bj][m][n]) : "v"(Bt##8[n]), "v"(At##8[m]), "v"(sc8)); \
        else { _Pragma("unroll") for (int k = 0; k < 2; ++k) acc[ai][bj][m][n] = __builtin_amdgcn_mfma_f32_16x16x32_bf16(Bt[n][k], At[m][k], acc[ai][bj][m][n], 0, 0, 0); } } \
        __builtin_amdgcn_s_setprio(0); } while (0)
#define G_WAIT_V(n) asm volatile("s_waitcnt vmcnt(" #n ")" ::: "memory")
#define G_WAIT_L(n) asm volatile("s_waitcnt lgkmcnt(" #n ")" ::: "memory")
#define G_BAR __builtin_amdgcn_s_barrier()
#define G_SCHED __builtin_amdgcn_sched_barrier(0)
    Unit cur, nxt;
    int ui = 0;
    if (!S.next(0, cur)) return;
    f32x4 acc[2][2][4][2];
#pragma unroll
    for (int a = 0; a < 2; ++a)
#pragma unroll
        for (int b = 0; b < 2; ++b)
#pragma unroll
            for (int m = 0; m < 4; ++m)
#pragma unroll
                for (int n = 0; n < 2; ++n) acc[a][b][m][n] = (f32x4){0.f, 0.f, 0.f, 0.f};
    bf16x8 At[4][2], B0[2][2], B1[2][2];
    i32x8 At8[4], B08[2], B18[2];
    int sc8 = 0x7F7F7F7F; asm volatile("" : "+v"(sc8));
    const char* cA = S.a_ptr(cur); const char* cB = S.b_ptr(cur);
    if (GATHER) {
#pragma unroll
        for (int h = 0; h < 2; ++h)
#pragma unroll
            for (int i = 0; i < 2; ++i) vgc[h][i] = (unsigned)(S.gather_row(cur, h * HALF + Rr[i]) * K + Cc[i]) * 2u;
    }
    { Unit n1; const bool hn1 = S.next(1, n1); G_PAR_ISSUE(cur, 0, hn1, n1); }
    G_STAGE(G_SB(0, 0), cB, voffB); G_STAGE_A(G_SA(0, 0), cA, 0, vgc); G_STAGE(G_SB(0, 1), cB + hstep, voffB); G_STAGE_A(G_SA(0, 1), cA, 1, vgc);
    if (wr == 1) G_BAR;
    G_WAIT_V(4); G_BAR;
    G_STAGE(G_SB(1, 0), cB + kstep, voffB); G_STAGE_A(G_SA(1, 0), cA + kstep, 0, vgc); G_STAGE(G_SB(1, 1), cB + hstep + kstep, voffB);
    G_WAIT_V(6); G_BAR;
    for (;;) {
        const bool has_next = S.next(ui + 1, nxt);
        const char* nA = has_next ? S.a_ptr(nxt) : cA; const char* nB = has_next ? S.b_ptr(nxt) : cB;
        if (ui > 0) G_PAR_ISSUE(cur, ui, has_next, nxt);
        if (GATHER) {
#pragma unroll
            for (int h = 0; h < 2; ++h)
#pragma unroll
                for (int i = 0; i < 2; ++i) vgn[h][i] = vgc[h][i];
        }
        for (int t = 0; t < nt; t += 2) {
            const bool last = (t == nt - 2);
            const char* a1 = cA + (size_t)(t + 1) * kstep;
            const char* a2 = last ? nA : cA + (size_t)(t + 2) * kstep; const char* b2 = last ? nB : cB + (size_t)(t + 2) * kstep;
            const char* a3 = a2 + kstep; const char* b3 = b2 + kstep;
            unsigned vg2[2][2];
            if (GATHER) {
#pragma unroll
                for (int h = 0; h < 2; ++h)
#pragma unroll
                    for (int i = 0; i < 2; ++i) vg2[h][i] = last ? vgn[h][i] : vgc[h][i];
            }
            G_LDB(B0, 0, 0); G_SCHED; G_LDA(At, 0, 0); G_STAGE_A(G_SA(1, 1), a1, 1, vgc);
            G_WAIT_L(8); G_BAR; G_WAIT_L(0); G_MMA(0, 0, At, B0); G_BAR; G_SCHED;
            G_LDB(B1, 0, 1); G_STAGE(G_SB(0, 0), b2, voffB);
            G_BAR; G_WAIT_L(0); G_MMA(0, 1, At, B1); G_BAR;
            G_LDA(At, 0, 1); G_STAGE_A(G_SA(0, 0), a2, 0, vg2);
            G_BAR; G_WAIT_L(0); G_MMA(1, 0, At, B0); G_BAR; G_SCHED;
            G_STAGE(G_SB(0, 1), b2 + hstep, voffB);
            G_WAIT_V(6); G_BAR; G_MMA(1, 1, At, B1); G_BAR;
            G_LDB(B0, 1, 0); G_SCHED; G_LDA(At, 1, 0); G_STAGE_A(G_SA(0, 1), a2, 1, vg2);
            G_WAIT_L(8); G_BAR; G_WAIT_L(0); G_MMA(0, 0, At, B0); G_BAR; G_SCHED;
            G_LDB(B1, 1, 1); G_STAGE(G_SB(1, 0), b3, voffB);
            G_BAR; G_WAIT_L(0); G_MMA(0, 1, At, B1); G_BAR;
            G_LDA(At, 1, 1); G_STAGE_A(G_SA(1, 0), a3, 0, vg2);
            G_BAR; G_WAIT_L(0); G_MMA(1, 0, At, B0); G_BAR; G_SCHED;
            G_STAGE(G_SB(1, 1), b3 + hstep, voffB);
            G_WAIT_V(6); G_BAR; G_MMA(1, 1, At, B1); G_BAR;
            if (GATHER && t == 0 && has_next) {
                const LAS int* rows = (const LAS int*)(parbase + (ui & 1) * 4096 + NPAR * 1024);
#pragma unroll
                for (int h = 0; h < 2; ++h)
#pragma unroll
                    for (int i = 0; i < 2; ++i) vgn[h][i] = (unsigned)(rows[h * HALF + Rr[i]] * K + Cc[i]) * 2u;
            }
        }
        if (FP8) asm volatile("s_nop 15\n\ts_nop 15" ::: "memory");
        const bool keep_acc = E(acc, cur, wr, wc, fr, fq, (const LAS unsigned char*)(parbase + (ui & 1) * 4096));
        if (!has_next) break;
        if (!keep_acc)
#pragma unroll
        for (int a = 0; a < 2; ++a)
#pragma unroll
            for (int b = 0; b < 2; ++b)
#pragma unroll
                for (int m = 0; m < 4; ++m)
#pragma unroll
                    for (int n = 0; n < 2; ++n) acc[a][b][m][n] = (f32x4){0.f, 0.f, 0.f, 0.f};
        cur = nxt; cA = nA; cB = nB; ++ui;
        if (GATHER) {
#pragma unroll
            for (int h = 0; h < 2; ++h)
#pragma unroll
                for (int i = 0; i < 2; ++i) vgc[h][i] = vgn[h][i];
        }
    }
    G_WAIT_V(0);
    if (wr == 0) G_BAR;
    G_BAR;
#undef G_PAR_ISSUE
#undef G_SA
#undef G_SB
#undef G_STAGE
#undef G_STAGE_A
#undef G_LDA
#undef G_LDB
#undef G_MMA
#undef G_CAT8
#undef G_WAIT_V
#undef G_WAIT_L
#undef G_BAR
#undef G_SCHED
}

struct EpiProj {
    bf16_t* prkv; bf16_t* pconv; bf16_t* gates; const float* rstd1;
    static constexpr int NPAR = 1;
    __device__ __forceinline__ const void* par_src(const Unit& u, int, int lane) const { return rstd1 + NMETA + u.pm * BM + lane * 4; }
    __device__ __forceinline__ bool operator()(const f32x4 (&acc)[2][2][4][2], const Unit& u, int wr, int wc, int fr, int fq, const LAS unsigned char* par) const {
        const int row0 = u.pm * BM + wr * 64 + fr;
        const bool isg = u.pn >= 14;
        float rsv[2][4];
#pragma unroll
        for (int ai = 0; ai < 2; ++ai)
#pragma unroll
            for (int m = 0; m < 4; ++m) rsv[ai][m] = ((const LAS float*)par)[wr * 64 + fr + ai * HALF + m * 16];
#pragma unroll
        for (int ai = 0; ai < 2; ++ai)
#pragma unroll
            for (int m = 0; m < 4; ++m) {
                const int row = row0 + ai * HALF + m * 16;
                const float rs = rsv[ai][m];
                bf16_t* rowp = isg ? gates + (size_t)row * 2048 + (u.pn - 14) * 256 + wc * 32 + 8 * fq
                             : (u.pn < 6 ? prkv + (size_t)(NMETA + row) * 1536 + u.pn * 256 : pconv + (size_t)(NMETA + row) * 2048 + (u.pn - 6) * 256) + wc * 32 + 8 * fq;
#pragma unroll
                for (int bj = 0; bj < 2; ++bj) {
                    f32x4 v0 = acc[ai][bj][m][0] * rs, v1 = acc[ai][bj][m][1] * rs;
                    if (isg) {
#pragma unroll
                        for (int j = 0; j < 4; ++j) { v0[j] = sigmoidf_(v0[j]); v1[j] = sigmoidf_(v1[j]); }
                    }
                    u32x4 w; w.x = cvt_pk_bf16(v0[0], v0[1]); w.y = cvt_pk_bf16(v0[2], v0[3]); w.z = cvt_pk_bf16(v1[0], v1[1]); w.w = cvt_pk_bf16(v1[2], v1[3]);
                    *(u32x4*)(rowp + bj * HALF) = w;
                }
            }
        return false;
    }
};
struct EpiL {
    static constexpr int NPAR = 0;
    __device__ __forceinline__ const void* par_src(const Unit&, int, int) const { return nullptr; }
    unsigned char* wsb; const float* w0; const float* a0;
    __device__ __forceinline__ bool operator()(const f32x4 (&acc)[2][2][4][2], const Unit& u, int wr, int wc, int fr, int fq, const LAS unsigned char* par) const {
        const int row0 = NMETA + u.pm * BM + wr * 64 + fr;
        const int seg = u.pn >> 1;
        const int cb = (u.pn & 1) * 256 + wc * 32 + 8 * fq;
        const float* bias = seg == 0 ? w0 : a0;
        f32x4 bv[2][2];
#pragma unroll
        for (int bj = 0; bj < 2; ++bj) {
            bv[bj][0] = seg < 2 ? *(const f32x4*)(bias + cb + bj * HALF) : (f32x4){0.f, 0.f, 0.f, 0.f};
            bv[bj][1] = seg < 2 ? *(const f32x4*)(bias + cb + bj * HALF + 4) : (f32x4){0.f, 0.f, 0.f, 0.f};
        }
        const float sc = seg == 0 ? -0.60653065971f : 1.0f;
        bf16_t* ob = (bf16_t*)(wsb + (seg == 0 ? OFF_LD : seg == 1 ? OFF_A : OFF_G));
#pragma unroll
        for (int ai = 0; ai < 2; ++ai)
#pragma unroll
            for (int m = 0; m < 4; ++m) {
                const int row = row0 + ai * HALF + m * 16;
#pragma unroll
                for (int bj = 0; bj < 2; ++bj) {
                    const int c = cb + bj * HALF;
                    f32x4 v0 = acc[ai][bj][m][0] + bv[bj][0], v1 = acc[ai][bj][m][1] + bv[bj][1];
                    if (seg < 2) {
#pragma unroll
                        for (int j = 0; j < 4; ++j) { v0[j] = sc * sigmoidf_(v0[j]); v1[j] = sc * sigmoidf_(v1[j]); }
                    }
                    {
                        u32x4 w; w.x = cvt_pk_bf16(v0[0], v0[1]); w.y = cvt_pk_bf16(v0[2], v0[3]); w.z = cvt_pk_bf16(v1[0], v1[1]); w.w = cvt_pk_bf16(v1[2], v1[3]);
                        *(u32x4*)(ob + (size_t)row * 512 + c) = w;
                    }
                }
            }
        return false;
    }
};
template <int SECOND> struct EpiMerge {
    static constexpr int NPAR = 0;
    __device__ __forceinline__ const void* par_src(const Unit&, int, int) const { return nullptr; }
    bf16_t* merged; const bf16_t* gates;
    __device__ __forceinline__ bool operator()(const f32x4 (&acc)[2][2][4][2], const Unit& u, int wr, int wc, int fr, int fq, const LAS unsigned char* par) const {
        const int row0 = u.pm * BM + wr * 64 + fr, col0 = u.pn * BM + wc * 32 + 8 * fq;
#pragma unroll
        for (int ai = 0; ai < 2; ++ai)
#pragma unroll
            for (int m = 0; m < 4; ++m) {
                const int row = row0 + ai * HALF + m * 16;
#pragma unroll
                for (int bj = 0; bj < 2; ++bj) {
                    const int c = col0 + bj * HALF;
                    const u32x4 gw = *(const u32x4*)(gates + (size_t)row * 2048 + SECOND * 1024 + c);
                    f32x4 g0 = (f32x4){bflo(gw.x), bfhi(gw.x), bflo(gw.y), bfhi(gw.y)}, g1 = (f32x4){bflo(gw.z), bfhi(gw.z), bflo(gw.w), bfhi(gw.w)};
                    f32x4 v0 = acc[ai][bj][m][0] * g0, v1 = acc[ai][bj][m][1] * g1;
                    bf16_t* p = merged + (size_t)row * 1024 + c;
                    if (SECOND) {
                        const u32x4 ow = *(const u32x4*)p;
                        v0 += (f32x4){bflo(ow.x), bfhi(ow.x), bflo(ow.y), bfhi(ow.y)}; v1 += (f32x4){bflo(ow.z), bfhi(ow.z), bflo(ow.w), bfhi(ow.w)};
                    }
                    u32x4 w; w.x = cvt_pk_bf16(v0[0], v0[1]); w.y = cvt_pk_bf16(v0[2], v0[3]); w.z = cvt_pk_bf16(v1[0], v1[1]); w.w = cvt_pk_bf16(v1[2], v1[3]);
                    *(u32x4*)p = w;
                }
            }
        return false;
    }
};
struct MergeOrder {
    StaticOrder so; const char* A1; const char* B1;
    __device__ bool next(int i, Unit& u) const { const bool ok = so.next(i >> 1, u); u.aux = i & 1; return ok; }
    __device__ __forceinline__ const char* a_ptr(const Unit& u) const { return (u.aux ? A1 : so.A) + (size_t)u.pm * 256 * so.K * 2; }
    __device__ __forceinline__ const char* b_ptr(const Unit& u) const { return (u.aux ? B1 : so.Bt) + (size_t)u.pn * 256 * so.K * 2; }
    __device__ __forceinline__ int gather_row(const Unit&, int) const { return 0; }
    __device__ __forceinline__ const void* gather_src(const Unit&, int) const { return nullptr; }
};
struct EpiMergeFused {
    static constexpr int NPAR = 0;
    __device__ __forceinline__ const void* par_src(const Unit&, int, int) const { return nullptr; }
    bf16_t* merged; const bf16_t* gates;
    __device__ __forceinline__ bool operator()(f32x4 (&acc)[2][2][4][2], const Unit& u, int wr, int wc, int fr, int fq, const LAS unsigned char* par) const {
        const int row0 = u.pm * BM + wr * 64 + fr, col0 = u.pn * BM + wc * 32 + 8 * fq;
#pragma unroll
        for (int ai = 0; ai < 2; ++ai) {
            u32x4 gbw[4][2], gaw[4][2];
#pragma unroll
            for (int m = 0; m < 4; ++m)
#pragma unroll
                for (int bj = 0; bj < 2; ++bj) {
                    const bf16_t* gp = gates + (size_t)(row0 + ai * HALF + m * 16) * 2048 + col0 + bj * HALF;
                    gbw[m][bj] = *(const u32x4*)(gp + 1024);
                    gaw[m][bj] = u.aux == 0 ? *(const u32x4*)gp : (u32x4){0u, 0u, 0u, 0u};
                }
#pragma unroll
            for (int m = 0; m < 4; ++m)
#pragma unroll
                for (int bj = 0; bj < 2; ++bj) {
                    const int row = row0 + ai * HALF + m * 16, c = col0 + bj * HALF;
                    f32x4 gb0 = (f32x4){bflo(gbw[m][bj].x), bfhi(gbw[m][bj].x), bflo(gbw[m][bj].y), bfhi(gbw[m][bj].y)}, gb1 = (f32x4){bflo(gbw[m][bj].z), bfhi(gbw[m][bj].z), bflo(gbw[m][bj].w), bfhi(gbw[m][bj].w)};
#pragma unroll
                    for (int j = 0; j < 4; ++j) { gb0[j] = fmaxf(gb0[j], 1e-6f); gb1[j] = fmaxf(gb1[j], 1e-6f); }
                    if (u.aux == 0) {
                        const f32x4 ga0 = (f32x4){bflo(gaw[m][bj].x), bfhi(gaw[m][bj].x), bflo(gaw[m][bj].y), bfhi(gaw[m][bj].y)}, ga1 = (f32x4){bflo(gaw[m][bj].z), bfhi(gaw[m][bj].z), bflo(gaw[m][bj].w), bfhi(gaw[m][bj].w)};
#pragma unroll
                        for (int j = 0; j < 4; ++j) { acc[ai][bj][m][0][j] *= ga0[j] * __builtin_amdgcn_rcpf(gb0[j]); acc[ai][bj][m][1][j] *= ga1[j] * __builtin_amdgcn_rcpf(gb1[j]); }
                    } else {
                        const f32x4 v0 = acc[ai][bj][m][0] * gb0, v1 = acc[ai][bj][m][1] * gb1;
                        u32x4 w; w.x = cvt_pk_bf16(v0[0], v0[1]); w.y = cvt_pk_bf16(v0[2], v0[3]); w.z = cvt_pk_bf16(v1[0], v1[1]); w.w = cvt_pk_bf16(v1[2], v1[3]);
                        *(u32x4*)(merged + (size_t)row * 1024 + c) = w;
                    }
                }
        }
        return u.aux == 0;
    }
};
struct EpiO {
    static constexpr int NPAR = 0;
    __device__ __forceinline__ const void* par_src(const Unit&, int, int) const { return nullptr; }
    const float* x; float* h1; bf16_t* hb2; unsigned char* hb8;
    __device__ __forceinline__ bool operator()(const f32x4 (&acc)[2][2][4][2], const Unit& u, int wr, int wc, int fr, int fq, const LAS unsigned char* par) const {
        const int row0 = u.pm * BM + wr * 64 + fr, col0 = u.pn * BM + wc * 32 + 8 * fq;
#pragma unroll
        for (int ai = 0; ai < 2; ++ai) {
            f32x4 xv[4][2][2];
#pragma unroll
            for (int m = 0; m < 4; ++m)
#pragma unroll
                for (int bj = 0; bj < 2; ++bj) {
                    const size_t o = (size_t)(row0 + ai * HALF + m * 16) * 1024 + col0 + bj * HALF;
                    xv[m][bj][0] = *(const f32x4*)(x + o); xv[m][bj][1] = *(const f32x4*)(x + o + 4);
                }
#pragma unroll
            for (int m = 0; m < 4; ++m)
#pragma unroll
                for (int bj = 0; bj < 2; ++bj) {
                    const size_t o = (size_t)(row0 + ai * HALF + m * 16) * 1024 + col0 + bj * HALF;
                    const f32x4 v0 = acc[ai][bj][m][0] + xv[m][bj][0], v1 = acc[ai][bj][m][1] + xv[m][bj][1];
                    u32x4 w; w.x = cvt_pk_bf16(v0[0], v0[1]); w.y = cvt_pk_bf16(v0[2], v0[3]); w.z = cvt_pk_bf16(v1[0], v1[1]); w.w = cvt_pk_bf16(v1[2], v1[3]);
                    *(u32x4*)(hb2 + o) = w;
                    u32x2 w8; w8.x = pk4_fp8(v0[0], v0[1], v0[2], v0[3]); w8.y = pk4_fp8(v1[0], v1[1], v1[2], v1[3]);
                    *(u32x2*)(hb8 + o) = w8;
                }
        }
        return false;
    }
};
struct EpiMoe1 {
    unsigned char* act; const float* rowrs; const float* bg; const float* bu;
    static constexpr int NPAR = 2;
    __device__ __forceinline__ const void* par_src(const Unit& u, int piece, int lane) const {
        if (piece == 0) return rowrs + u.pm * BM + lane * 4;
        return (lane < 32 ? bg : bu) + (size_t)u.aux * DFF + u.pn * 128 + (lane & 31) * 4;
    }
    __device__ __forceinline__ bool operator()(const f32x4 (&acc)[2][2][4][2], const Unit& u, int wr, int wc, int fr, int fq, const LAS unsigned char* par) const {
        const int row0 = u.pm * BM + wr * 64 + fr, ff0 = u.pn * 128 + wc * 32 + 8 * fq;
        const LAS float* bgp = (const LAS float*)(par + 1024) + wc * 32 + 8 * fq; const LAS float* bup = bgp + 128;
        const f32x4 bg0 = *(const LAS f32x4*)bgp, bg1 = *(const LAS f32x4*)(bgp + 4), bu0 = *(const LAS f32x4*)bup, bu1 = *(const LAS f32x4*)(bup + 4);
        float rsv[2][4];
#pragma unroll
        for (int ai = 0; ai < 2; ++ai)
#pragma unroll
            for (int m = 0; m < 4; ++m) rsv[ai][m] = ((const LAS float*)par)[wr * 64 + fr + ai * HALF + m * 16];
#pragma unroll
        for (int ai = 0; ai < 2; ++ai)
#pragma unroll
            for (int m = 0; m < 4; ++m) {
                const int row = row0 + ai * HALF + m * 16;
                const float rs = rsv[ai][m] * W8_INV;
                f32x4 g0 = acc[ai][0][m][0] * rs + bg0, g1 = acc[ai][0][m][1] * rs + bg1, u0 = acc[ai][1][m][0] * rs + bu0, u1 = acc[ai][1][m][1] * rs + bu1;
                f32x4 r0, r1;
#pragma unroll
                for (int j = 0; j < 4; ++j) {
                    { const float gt = fminf(g0[j], 7.0f), up = fminf(fmaxf(u0[j], -7.0f), 7.0f); r0[j] = (up + 1.0f) * gt * sigmoidf_(1.702f * gt); }
                    { const float gt = fminf(g1[j], 7.0f), up = fminf(fmaxf(u1[j], -7.0f), 7.0f); r1[j] = (up + 1.0f) * gt * sigmoidf_(1.702f * gt); }
                }
                u32x2 w; w.x = pk4_fp8(r0[0], r0[1], r0[2], r0[3]); w.y = pk4_fp8(r1[0], r1[1], r1[2], r1[3]);
                *(u32x2*)(act + (size_t)row * DFF + ff0) = w;
            }
        return false;
    }
};
struct EpiMoe2 {
    unsigned char* y8; const int* rowslot; const float* roww; const float* bd;
    static constexpr int NPAR = 3;
    __device__ __forceinline__ const void* par_src(const Unit& u, int piece, int lane) const {
        if (piece == 0) return rowslot + u.pm * BM + lane * 4;
        if (piece == 1) return roww + u.pm * BM + lane * 4;
        return bd + (size_t)u.aux * D + u.pn * BM + lane * 4;
    }
    __device__ __forceinline__ bool operator()(const f32x4 (&acc)[2][2][4][2], const Unit& u, int wr, int wc, int fr, int fq, const LAS unsigned char* par) const {
        const int row0 = u.pm * BM + wr * 64 + fr, col0 = u.pn * BM + wc * 32 + 8 * fq;
        const LAS float* bp = (const LAS float*)(par + 2048) + wc * 32 + 8 * fq;
        f32x4 bv[2][2];
#pragma unroll
        for (int bj = 0; bj < 2; ++bj) { bv[bj][0] = *(const LAS f32x4*)(bp + bj * HALF); bv[bj][1] = *(const LAS f32x4*)(bp + bj * HALF + 4); }
        int slotv[2][4]; float wv8[2][4];
#pragma unroll
        for (int ai = 0; ai < 2; ++ai)
#pragma unroll
            for (int m = 0; m < 4; ++m) { const int rl = wr * 64 + fr + ai * HALF + m * 16; slotv[ai][m] = ((const LAS int*)par)[rl]; wv8[ai][m] = ((const LAS float*)(par + 1024))[rl]; }
#pragma unroll
        for (int ai = 0; ai < 2; ++ai)
#pragma unroll
            for (int m = 0; m < 4; ++m) {
                const int slot = slotv[ai][m];
                if (slot >= 0) {
                    const float w8 = wv8[ai][m];
#pragma unroll
                    for (int bj = 0; bj < 2; ++bj) {
                        const f32x4 v0 = (acc[ai][bj][m][0] * W8_INV + bv[bj][0]) * w8, v1 = (acc[ai][bj][m][1] * W8_INV + bv[bj][1]) * w8;
                        u32x2 w; w.x = pk4_fp8(v0[0], v0[1], v0[2], v0[3]); w.y = pk4_fp8(v1[0], v1[1], v1[2], v1[3]);
                        *(u32x2*)(y8 + (size_t)slot * 1024 + col0 + bj * HALF) = w;
                    }
                }
            }
        return false;
    }
};

__device__ __forceinline__ void transpose_tile(LAS float* tile, const float* src, int ldsrc, int k0, int n0, bf16_t* dst, int ldd, int drow0, const float* sa, const float* mu, int mode, bool zero) {
    const int tid = threadIdx.x;
    if (!zero) {
#pragma unroll
        for (int i = 0; i < 2; ++i) {
            const int r = (tid >> 4) + 32 * i, c4 = (tid & 15) * 4;
            const f32x4 v = *(const f32x4*)(src + (size_t)(k0 + r) * ldsrc + n0 + c4);
            LAS float* t = tile + r * 65 + c4;
            t[0] = v[0]; t[1] = v[1]; t[2] = v[2]; t[3] = v[3];
        }
    }
    __syncthreads();
    {
        const int n = tid >> 3, kq = tid & 7;
        float v[8];
#pragma unroll
        for (int j = 0; j < 8; ++j) {
            const int k = k0 + 8 * kq + j;
            float s = sa ? sa[k] : 1.0f;
            if (mode == 1) s *= (1.0f - mu[k]);
            if (mode == 2) s *= mu[k];
            v[j] = zero ? 0.f : tile[(8 * kq + j) * 65 + n] * s;
        }
        u32x4 w; w.x = cvt_pk_bf16(v[0], v[1]); w.y = cvt_pk_bf16(v[2], v[3]); w.z = cvt_pk_bf16(v[4], v[5]); w.w = cvt_pk_bf16(v[6], v[7]);
        *(u32x4*)(dst + (size_t)(drow0 + n) * ldd + k0 + 8 * kq) = w;
    }
    __syncthreads();
}

__device__ __forceinline__ void phase_prep(const PPv& p, LAS unsigned char* lds) {
    const int tid = threadIdx.x, bid = blockIdx.x, nb = gridDim.x, lane = tid & 63, wave = tid >> 6;
    unsigned char* ws = p.gws();
    const float* x = p.gin(0); const float* meta = p.gin(1); const float* g1 = p.gin(2);
    if (bid == 0 && tid < 64) ((int*)(ws + OFF_GCNT))[tid] = 0;
    {
        bf16_t* HB = (bf16_t*)(ws + OFF_HB); float* rstd1 = (float*)(ws + OFF_RSTD1);
        for (int row0 = (bid * 8 + wave) * 4; row0 < NR; row0 += nb * 32) {
            f32x4 v[4][4];
#pragma unroll
            for (int u = 0; u < 4; ++u) {
                const int row = row0 + u < NR ? row0 + u : NR - 1;
                const float* src = row < NMETA ? meta + (size_t)row * D : x + (size_t)(row - NMETA) * D;
#pragma unroll
                for (int i = 0; i < 4; ++i) v[u][i] = __builtin_nontemporal_load((const f32x4*)(src + i * 256 + lane * 4));
            }
#pragma unroll
            for (int u = 0; u < 4; ++u) {
                const int row = row0 + u;
                if (row < NR) {
                    float ss = 0.f;
#pragma unroll
                    for (int i = 0; i < 4; ++i) ss += v[u][i][0] * v[u][i][0] + v[u][i][1] * v[u][i][1] + v[u][i][2] * v[u][i][2] + v[u][i][3] * v[u][i][3];
                    ss = wave_sum_dpp(ss);
                    if (lane == 0) rstd1[row] = rsqrtf(ss * (1.0f / D) + NORM_EPS);
                    if (row >= NMETA) {
                        bf16_t* d = HB + (size_t)(row - NMETA) * D;
#pragma unroll
                        for (int i = 0; i < 4; ++i) { u32x2 w; w.x = cvt_pk_bf16(v[u][i][0], v[u][i][1]); w.y = cvt_pk_bf16(v[u][i][2], v[u][i][3]); *(u32x2*)(d + i * 256 + lane * 4) = w; }
                    }
                }
            }
        }
    }
    LAS float* tile = (LAS float*)lds;
    {
        bf16_t* WIN = (bf16_t*)(ws + OFF_WIN);
        const float* w_in = p.gin(3);
        for (int j = bid; j < 16 * 88; j += nb) {
            const int kt = j & 15, ntile = j >> 4, n0 = ntile * 64;
            const float* src; int ld, sn0, mode = 0; const float* mu = nullptr;
            if (n0 < 3072) { src = w_in; ld = 5120; sn0 = n0; }
            else if (n0 < 3584) {
                const int seg = (n0 - 3072) >> 6;
                if (seg < 2) { src = p.gin(11); ld = 64; sn0 = 0; mu = p.gin(7); mode = 1 + seg; }
                else if (seg < 4) { src = p.gin(14); ld = 64; sn0 = 0; mu = p.gin(8); mode = 1 + (seg - 2); }
                else { src = p.gin(16); ld = 128; sn0 = (seg & 1) * 64; mu = p.gin(9); mode = seg < 6 ? 1 : 2; }
            } else { src = w_in; ld = 5120; sn0 = n0 - 512; }
            transpose_tile(tile, src, ld, kt * 64, sn0, WIN, 1024, n0, g1, mu, mode, false);
        }
        for (int j = bid; j < 2 * 128; j += nb) {
            const int which = j >> 7, jj = j & 127, kt = jj & 7, ntile = jj >> 3;
            transpose_tile(tile, which ? p.gin(25) : p.gin(23), 1024, kt * 64, ntile * 64, (bf16_t*)(ws + (which ? OFF_WC : OFF_WR)), 512, ntile * 64, nullptr, nullptr, 0, false);
        }
        for (int j = bid; j < 256; j += nb) {
            const int kt = j & 15, ntile = j >> 4;
            transpose_tile(tile, p.gin(26), 1024, kt * 64, ntile * 64, (bf16_t*)(ws + OFF_WO), 1024, ntile * 64, nullptr, nullptr, 0, false);
        }
        for (int j = bid; j < 96; j += nb) {
            const int kt = j & 3, ntile = j >> 2, seg = ntile >> 3, nn0 = (ntile & 7) * 64;
            const float* src = nullptr; int sk0 = 0; bool zero = true;
            if (seg == 0 && kt == 0) { src = p.gin(12); sk0 = 0; zero = false; }
            if (seg == 1 && kt == 1) { src = p.gin(15); sk0 = 0; zero = false; }
            if (seg == 2 && kt >= 2) { src = p.gin(17); sk0 = (kt - 2) * 64; zero = false; }
            const float* srcs = zero ? p.gin(12) : src + (size_t)(sk0 - kt * 64) * 512;
            transpose_tile(tile, srcs, 512, kt * 64, nn0, (bf16_t*)(ws + OFF_W2), 256, ntile * 64, nullptr, nullptr, 0, zero);
        }
        {
            float* WRG = (float*)(ws + OFF_WRG); const float* g2 = p.gin(27); const float* wr_ = p.gin(28);
            for (int i = bid * 512 + tid; i < 1024 * 32; i += nb * 512) WRG[i] = g2[i >> 5] * wr_[i];
        }
    }
}

__device__ __forceinline__ void phase_meta_proj(const PPv& p, LAS unsigned char* lds) {
    const int tid = threadIdx.x, bid = blockIdx.x, lane = tid & 63, wave = tid >> 6;
    unsigned char* ws = p.gws();
    LAS float* sm = (LAS float*)lds;
    const float* meta = p.gin(1);
    for (int i = tid; i < 16 * 256; i += 512) { const int r = i >> 8, c4 = (i & 255) * 4; const f32x4 v = *(const f32x4*)(meta + r * 1024 + c4); LAS float* d = sm + r * 1028 + c4; d[0] = v[0]; d[1] = v[1]; d[2] = v[2]; d[3] = v[3]; }
    __syncthreads();
    const float* rstd1 = (const float*)(ws + OFF_RSTD1);
    for (int nbase = bid * 14; nbase < PCOLS1; nbase += gridDim.x * 14) {
        for (int nn = wave; nn < 14; nn += 8) {
            const int n = nbase + nn;
            if (n >= PCOLS1) break;
            const bf16_t* wrow = (const bf16_t*)(ws + OFF_WIN) + (size_t)n * 1024;
            const u32x4 w0 = *(const u32x4*)(wrow + 8 * lane), w1 = *(const u32x4*)(wrow + 512 + 8 * lane);
            const float wf[16] = {bflo(w0.x), bfhi(w0.x), bflo(w0.y), bfhi(w0.y), bflo(w0.z), bfhi(w0.z), bflo(w0.w), bfhi(w0.w),
                                  bflo(w1.x), bfhi(w1.x), bflo(w1.y), bfhi(w1.y), bflo(w1.z), bfhi(w1.z), bflo(w1.w), bfhi(w1.w)};
            float outv = 0.f;
#pragma unroll
            for (int pr = 0; pr < 16; ++pr) {
                const LAS float* m0 = sm + pr * 1028 + 8 * lane;
                const f32x4 a0 = *(const LAS f32x4*)m0, a1 = *(const LAS f32x4*)(m0 + 4), a2 = *(const LAS f32x4*)(m0 + 512), a3 = *(const LAS f32x4*)(m0 + 516);
                float acc = a0[0] * wf[0] + a0[1] * wf[1] + a0[2] * wf[2] + a0[3] * wf[3] + a1[0] * wf[4] + a1[1] * wf[5] + a1[2] * wf[6] + a1[3] * wf[7]
                          + a2[0] * wf[8] + a2[1] * wf[9] + a2[2] * wf[10] + a2[3] * wf[11] + a3[0] * wf[12] + a3[1] * wf[13] + a3[2] * wf[14] + a3[3] * wf[15];
                acc = wave_sum_dpp(acc);
                outv = (lane == pr) ? acc * rstd1[pr] : outv;
            }
            if (lane < 16) {
                if (n < 1536) ((bf16_t*)(ws + OFF_PRKV))[(size_t)lane * 1536 + n] = f2bf(outv);
                else ((bf16_t*)(ws + OFF_PCONV))[(size_t)lane * 2048 + n - 1536] = f2bf(outv);
            }
        }
    }
    __syncthreads();
}

__device__ __forceinline__ void phase_meta_lora(const PPv& p) {
    const int tid = threadIdx.x, bid = blockIdx.x, nb = gridDim.x, lane = tid & 63, wave = tid >> 6;
    unsigned char* ws = p.gws();
    const bf16_t* L = (const bf16_t*)(ws + OFF_L); const bf16_t* W2 = (const bf16_t*)(ws + OFF_W2);
    for (int n = bid * 8 + wave; n < 1536; n += nb * 8) {
        const int seg = n >> 9, c = n & 511;
        const u32x2 wv = *(const u32x2*)(W2 + (size_t)n * 256 + 4 * lane);
        const float w0v = bflo(wv.x), w1v = bfhi(wv.x), w2v = bflo(wv.y), w3v = bfhi(wv.y);
        float outv = 0.f;
#pragma unroll
        for (int r = 0; r < 16; ++r) {
            const u32x2 lv = *(const u32x2*)(L + (size_t)r * 256 + 4 * lane);
            float acc = bflo(lv.x) * w0v + bfhi(lv.x) * w1v + bflo(lv.y) * w2v + bfhi(lv.y) * w3v;
            acc = wave_sum_dpp(acc);
            outv = (lane == r) ? acc : outv;
        }
        if (lane < 16) {
            float v = outv;
            if (seg == 0) v = -0.60653065971f * sigmoidf_(v + p.gin(10)[c]);
            if (seg == 1) v = sigmoidf_(v + p.gin(13)[c]);
            bf16_t* ob = (bf16_t*)(ws + (seg == 0 ? OFF_LD : seg == 1 ? OFF_A : OFF_G));
            ob[(size_t)lane * 512 + c] = f2bf(v);
        }
    }
}

__device__ __forceinline__ void phase_lprep_conv(const PPv& p) {
    const int tid = threadIdx.x, bid = blockIdx.x, nb = gridDim.x;
    unsigned char* ws = p.gws();
    const bf16_t* PROJ = (const bf16_t*)(ws + OFF_PCONV);
    constexpr int PCOLS = 2048;
    bf16_t* L = (bf16_t*)(ws + OFF_L);
    for (int i = bid * 512 + tid; i < NRP * 32; i += nb * 512) {
        const int row = i >> 5, gq = i & 31;
        u32x4 w = (u32x4){0u, 0u, 0u, 0u};
        if (row < NR) {
            int ca, cb;
            if (gq < 8) { ca = 1536 + gq * 8; cb = ca + 64; }
            else if (gq < 16) { ca = 1536 + 128 + (gq - 8) * 8; cb = ca + 64; }
            else { ca = 1536 + 256 + (gq - 16) * 8; cb = ca + 128; }
            const u32x4 va = *(const u32x4*)(PROJ + (size_t)row * PCOLS + ca);
            const int pr = prev_row(row, 1);
            u32x4 vb = (u32x4){0u, 0u, 0u, 0u};
            if (pr >= 0) vb = *(const u32x4*)(PROJ + (size_t)pr * PCOLS + cb);
            float v[8] = {bflo(va.x) + bflo(vb.x), bfhi(va.x) + bfhi(vb.x), bflo(va.y) + bflo(vb.y), bfhi(va.y) + bfhi(vb.y), bflo(va.z) + bflo(vb.z), bfhi(va.z) + bfhi(vb.z), bflo(va.w) + bflo(vb.w), bfhi(va.w) + bfhi(vb.w)};
#pragma unroll
            for (int j = 0; j < 8; ++j) { if (gq < 8) v[j] = tanhf(v[j]); else if (gq >= 16) v[j] = sigmoidf_(v[j]); }
            w.x = cvt_pk_bf16(v[0], v[1]); w.y = cvt_pk_bf16(v[2], v[3]); w.z = cvt_pk_bf16(v[4], v[5]); w.w = cvt_pk_bf16(v[6], v[7]);
        }
        *(u32x4*)(L + (size_t)row * 256 + gq * 8) = w;
    }
    bf16_t* C = (bf16_t*)(ws + OFF_C);
    const float* cw = p.gin(24);
    for (int i = bid * 512 + tid; i < T * 64; i += nb * 512) {
        const int m = i >> 6, ch = (i & 63) * 8, row = NMETA + m;
        const int r1 = prev_row(row, 1), r2 = prev_row(row, 2);
        const bf16_t* p0 = PROJ + (size_t)row * PCOLS; const bf16_t* p1 = PROJ + (size_t)r1 * PCOLS; const bf16_t* p2 = PROJ + (size_t)r2 * PCOLS;
        const u32x4 vb = *(const u32x4*)(p0 + ch);
        const u32x4 c0 = *(const u32x4*)(p0 + 512 + ch), h0 = *(const u32x4*)(p0 + 1024 + ch);
        const u32x4 c1 = *(const u32x4*)(p1 + 512 + ch), h1 = *(const u32x4*)(p1 + 1024 + ch);
        const u32x4 c2 = *(const u32x4*)(p2 + 512 + ch), h2 = *(const u32x4*)(p2 + 1024 + ch);
        float o[8];
#pragma unroll
        for (int j = 0; j < 8; ++j) {
            const unsigned wb = j < 2 ? vb.x : j < 4 ? vb.y : j < 6 ? vb.z : vb.w;
            const unsigned wc0 = j < 2 ? c0.x : j < 4 ? c0.y : j < 6 ? c0.z : c0.w, wh0 = j < 2 ? h0.x : j < 4 ? h0.y : j < 6 ? h0.z : h0.w;
            const unsigned wc1 = j < 2 ? c1.x : j < 4 ? c1.y : j < 6 ? c1.z : c1.w, wh1 = j < 2 ? h1.x : j < 4 ? h1.y : j < 6 ? h1.z : h1.w;
            const unsigned wc2 = j < 2 ? c2.x : j < 4 ? c2.y : j < 6 ? c2.z : c2.w, wh2 = j < 2 ? h2.x : j < 4 ? h2.y : j < 6 ? h2.z : h2.w;
            const bool hi = j & 1;
            const float b = hi ? bfhi(wb) : bflo(wb);
            const float u0 = (hi ? bfhi(wc0) : bflo(wc0)) * (hi ? bfhi(wh0) : bflo(wh0));
            const float u1 = (hi ? bfhi(wc1) : bflo(wc1)) * (hi ? bfhi(wh1) : bflo(wh1));
            const float u2 = (hi ? bfhi(wc2) : bflo(wc2)) * (hi ? bfhi(wh2) : bflo(wh2));
            const float conv = cw[ch + j] * u2 + cw[512 + ch + j] * u1 + cw[1024 + ch + j] * u0;
            o[j] = b * conv;
        }
        u32x4 w; w.x = cvt_pk_bf16(o[0], o[1]); w.y = cvt_pk_bf16(o[2], o[3]); w.z = cvt_pk_bf16(o[4], o[5]); w.w = cvt_pk_bf16(o[6], o[7]);
        *(u32x4*)(C + (size_t)m * 512 + ch) = w;
    }
}

template <int CTRL> __device__ __forceinline__ float dppmov(float v) { return __builtin_bit_cast(float, __builtin_amdgcn_update_dpp(0, __builtin_bit_cast(int, v), CTRL, 0xF, 0xF, true)); }
__device__ __forceinline__ float wave_sum_dpp(float v) {
    v += dppmov<0xB1>(v);
    v += dppmov<0x4E>(v);
    v += dppmov<0x141>(v);
    v += dppmov<0x140>(v);
    { float c = v; asm volatile("v_nop\n\tv_nop\n\tv_permlane16_swap_b32 %0, %1\n\tv_nop" : "+v"(v), "+v"(c)); v += c; }
    { float c = v; asm volatile("v_nop\n\tv_nop\n\tv_permlane32_swap_b32 %0, %1\n\tv_nop" : "+v"(v), "+v"(c)); v += c; }
    return v;
}
typedef float f32x16 __attribute__((ext_vector_type(16)));

struct RawTok { bf16_t r, k, v, a, ld; };
__device__ __forceinline__ RawTok load_raw(const bf16_t* PRKV, const bf16_t* Ab, const bf16_t* LD, int row, int col) {
    RawTok q; const bf16_t* p0 = PRKV + (size_t)row * 1536 + col;
    q.r = p0[0]; q.k = p0[512]; q.v = p0[1024]; q.a = Ab[(size_t)row * 512 + col]; q.ld = LD[(size_t)row * 512 + col];
    return q;
}
__device__ __forceinline__ void unit_geom(int uid, int lane, int& b, int& h, int& c, int& col, int& row0) {
    const int bh = uid / NCHUNK; c = uid - bh * NCHUNK; b = bh >> 3; h = bh & 7; col = h * 64 + lane;
    row0 = c == 0 ? 0 : b * SEQ + c * 16;
}
__device__ __forceinline__ void phase_scanprep(const PPv& p, LAS unsigned char* lds) {
    const int tid = threadIdx.x, bid = blockIdx.x, nb = gridDim.x, lane = tid & 63, wave = tid >> 6;
    unsigned char* ws = p.gws();
    const bf16_t* PRKV = (const bf16_t*)(ws + OFF_PRKV);
    const bf16_t* LD = (const bf16_t*)(ws + OFF_LD);
    const bf16_t* Ab = (const bf16_t*)(ws + OFF_A);
    float* COEF = (float*)(ws + OFF_COEF);
    LAS unsigned char* wl = lds + wave * 13824;
    LAS bf16_t* AR = (LAS bf16_t*)wl;
    LAS bf16_t* BK = (LAS bf16_t*)(wl + 4608);
    LAS float* DM = (LAS float*)(wl + 9216);
    const int qperm = (lane & 32) | (((lane >> 2) & 3) << 3) | (((lane >> 4) & 1) << 2) | (lane & 3);
    int uid = bid * 8 + wave;
    if (uid >= NUNITS) return;
    int b, h, c, col, row0;
    unit_geom(uid, lane, b, h, c, col, row0);
    RawTok q[16], qn[16];
    bf16_t prr = 0, prk = 0, prv = 0, nprr = 0, nprk = 0, nprv = 0;
#pragma unroll
    for (int t = 0; t < 16; ++t) q[t] = load_raw(PRKV, Ab, LD, row0 + t, col);
    { const int pr = prev_row(row0, 1); if (pr >= 0) { const bf16_t* p1 = PRKV + (size_t)pr * 1536 + col; prr = p1[0]; prk = p1[512]; prv = p1[1024]; } }
    for (;;) {
        const float mur = p.gin(4)[col], muk = p.gin(5)[col], muv = p.gin(6)[col], kkw = p.gin(18)[col], kaw = p.gin(19)[col], rkw = p.gin(20)[col];
        const int nuid = uid + nb * 8; const bool has_next = nuid < NUNITS;
        int nb_ = b, nh = h, nc = c, ncol = col, nrow0 = row0;
        if (has_next) {
            unit_geom(nuid, lane, nb_, nh, nc, ncol, nrow0);
#pragma unroll
            for (int t = 0; t < 16; ++t) qn[t] = load_raw(PRKV, Ab, LD, nrow0 + t, ncol);
            nprr = 0; nprk = 0; nprv = 0;
            const int pr = prev_row(nrow0, 1); if (pr >= 0) { const bf16_t* p1 = PRKV + (size_t)pr * 1536 + ncol; nprr = p1[0]; nprk = p1[512]; nprv = p1[1024]; }
        }
        __builtin_amdgcn_sched_barrier(0);
        LAS float* PM = (LAS float*)wl;
        LAS float* RS = DM;
        {
            float rp = bf2f(prr), kp = bf2f(prk);
#pragma unroll
            for (int t = 0; t < 16; ++t) {
                const RawTok qq = q[t];
                const float r0 = bf2f(qq.r), k0 = bf2f(qq.k);
                const float r = r0 + (rp - r0) * mur, k = k0 + (kp - k0) * muk;
                rp = r0; kp = k0;
                const float a = bf2f(qq.a);
                const float kkv = k * kkw, k2 = k * (1.0f + (a - 1.0f) * kaw);
                PM[t * 68 + lane] = kkv * kkv; PM[(16 + t) * 68 + lane] = r * k2 * rkw;
            }
            asm volatile("" ::: "memory");
            const int rw = lane & 31, hf = lane >> 5;
            f32x4 s4 = (f32x4){0.f, 0.f, 0.f, 0.f};
#pragma unroll
            for (int i = 0; i < 8; ++i) s4 += *(const LAS f32x4*)(PM + rw * 68 + hf * 32 + i * 4);
            float sm = (s4[0] + s4[1]) + (s4[2] + s4[3]);
            { float c2 = sm; asm volatile("v_nop\n\tv_nop\n\tv_permlane32_swap_b32 %0, %1\n\tv_nop" : "+v"(sm), "+v"(c2)); sm += c2; }
            if (lane < 32) RS[lane] = sm;
            asm volatile("" ::: "memory");
            const float cfl = __shfl(sm, (lane & 15) + 16);
            if (lane < 16) COEF[(size_t)(row0 + lane) * 8 + h] = cfl;
        }
        __builtin_amdgcn_sched_barrier(0);
        float at[16], vt[16]; unsigned btp[8], ktp[8]; float bprev = 0.f, kprev = 0.f;
        float cl = 0.f;
        float rp = bf2f(prr), kp = bf2f(prk), vp = bf2f(prv);
        f32x4 n2v[4];
#pragma unroll
        for (int i = 0; i < 4; ++i) n2v[i] = *(const LAS f32x4*)(RS + 4 * i);
        asm volatile("" ::: "memory"); __builtin_amdgcn_sched_barrier(0);
#pragma unroll
        for (int t = 0; t < 16; ++t) {
            const RawTok qq = q[t];
            const float r0 = bf2f(qq.r), k0 = bf2f(qq.k), v0 = bf2f(qq.v);
            const float r = r0 + (rp - r0) * mur, k = k0 + (kp - k0) * muk, v = v0 + (vp - v0) * muv;
            rp = r0; kp = k0; vp = v0;
            const float a = bf2f(qq.a);
            const float kkv = k * kkw;
            const float kk = kkv * __builtin_amdgcn_rsqf(fmaxf(n2v[t >> 2][t & 3], 1e-24f));
            const float k2 = k * (1.0f + (a - 1.0f) * kaw);
            const float wcp = __expf(cl);
            cl += bf2f(qq.ld);
            const float wcn = __expf(cl), iw = __expf(-cl);
            const float btv = kk * a * iw, ktv = k2 * iw;
            at[t] = -kk * wcp; vt[t] = v;
            { const unsigned w = cvt_pk_bf16(at[t], r * wcn); AR[t * 72 + qperm] = (bf16_t)(w & 0xFFFFu); AR[(16 + t) * 72 + qperm] = (bf16_t)(w >> 16); }
            if (t & 1) {
                btp[t >> 1] = cvt_pk_bf16(bprev, btv); ktp[t >> 1] = cvt_pk_bf16(kprev, ktv);
                BK[(t - 1) * 72 + qperm] = (bf16_t)(btp[t >> 1] & 0xFFFFu); BK[t * 72 + qperm] = (bf16_t)(btp[t >> 1] >> 16);
                BK[(16 + t - 1) * 72 + qperm] = (bf16_t)(ktp[t >> 1] & 0xFFFFu); BK[(16 + t) * 72 + qperm] = (bf16_t)(ktp[t >> 1] >> 16);
            } else { bprev = btv; kprev = ktv; }
            if ((t & 3) == 3) __builtin_amdgcn_sched_barrier(0);
        }
        const float wcc = __expf(cl);
        {
            f32x16 dm;
#pragma unroll
            for (int i = 0; i < 16; ++i) dm[i] = 0.f;
            const int rr = lane & 31, hh = lane >> 5;
#pragma unroll
            for (int ks = 0; ks < 4; ++ks) {
                const bf16x8 fa = *(const LAS bf16x8*)(AR + rr * 72 + 16 * ks + 8 * hh);
                const bf16x8 fb = *(const LAS bf16x8*)(BK + rr * 72 + 16 * ks + 8 * hh);
                dm = __builtin_amdgcn_mfma_f32_32x32x16_bf16(fa, fb, dm, 0, 0, 0);
            }
#pragma unroll
            for (int reg = 0; reg < 16; ++reg) DM[((reg & 3) + 8 * (reg >> 2) + 4 * hh) * 36 + rr] = dm[reg];
        }
        __builtin_amdgcn_sched_barrier(0);
        float uh[16];
#pragma unroll
        for (int t = 0; t < 16; ++t) {
            float wv = at[t], uv = 0.f, wv2 = 0.f, uv2 = 0.f, uv3 = 0.f;
#pragma unroll
            for (int s4 = 0; s4 < 4; ++s4) {
                if (s4 * 4 < t) {
                    const f32x4 ab = *(const LAS f32x4*)(DM + t * 36 + s4 * 4), ak = *(const LAS f32x4*)(DM + t * 36 + 16 + s4 * 4);
#pragma unroll
                    for (int j = 0; j < 4; ++j) {
                        const int s_ = s4 * 4 + j;
                        if (s_ < t) {
                            if (j & 1) { wv2 += ab[j] * at[s_]; uv2 += ak[j] * vt[s_]; } else { wv += ab[j] * at[s_]; uv += ak[j] * vt[s_]; }
                            uv3 += ab[j] * uh[s_];
                        }
                    }
                }
            }
            wv += wv2; uv += uv2 + uv3;
            at[t] = wv; uh[t] = uv;
            asm volatile("" : "+v"(at[t]), "+v"(uh[t]));
        }
        __builtin_amdgcn_sched_barrier(0);
#pragma unroll
        for (int t = 0; t < 16; t += 2) { const unsigned w = cvt_pk_bf16(at[t], at[t + 1]); AR[t * 72 + qperm] = (bf16_t)(w & 0xFFFFu); AR[(t + 1) * 72 + qperm] = (bf16_t)(w >> 16); }
        unsigned char* rec = ws + OFF_CH + (size_t)uid * REC_BYTES;
#pragma unroll
        for (int i = 0; i < 2; ++i) {
            const int pc = i * 64 + lane, row = pc >> 3, part = pc & 7;
            *(u32x4*)(rec + RO_WH + pc * 16) = *(const LAS u32x4*)((LAS unsigned char*)AR + row * 144 + part * 16);
            *(u32x4*)(rec + RO_RT + pc * 16) = *(const LAS u32x4*)((LAS unsigned char*)AR + (16 + row) * 144 + part * 16);
        }
        {
            u32x4 w0, w1;
            w0.x = cvt_pk_bf16(uh[0], uh[1]); w0.y = cvt_pk_bf16(uh[2], uh[3]); w0.z = cvt_pk_bf16(uh[4], uh[5]); w0.w = cvt_pk_bf16(uh[6], uh[7]);
            w1.x = cvt_pk_bf16(uh[8], uh[9]); w1.y = cvt_pk_bf16(uh[10], uh[11]); w1.z = cvt_pk_bf16(uh[12], uh[13]); w1.w = cvt_pk_bf16(uh[14], uh[15]);
            *(u32x4*)(rec + RO_U0T + lane * 32) = w0; *(u32x4*)(rec + RO_U0T + lane * 32 + 16) = w1;
            w0.x = cvt_pk_bf16(vt[0], vt[1]); w0.y = cvt_pk_bf16(vt[2], vt[3]); w0.z = cvt_pk_bf16(vt[4], vt[5]); w0.w = cvt_pk_bf16(vt[6], vt[7]);
            w1.x = cvt_pk_bf16(vt[8], vt[9]); w1.y = cvt_pk_bf16(vt[10], vt[11]); w1.z = cvt_pk_bf16(vt[12], vt[13]); w1.w = cvt_pk_bf16(vt[14], vt[15]);
            *(u32x4*)(rec + RO_VT + lane * 32) = w0; *(u32x4*)(rec + RO_VT + lane * 32 + 16) = w1;
        }
#pragma unroll
        for (int g = 0; g < 4; ++g) {
            u32x4 w; w.x = btp[2 * g]; w.y = btp[2 * g + 1]; w.z = ktp[2 * g]; w.w = ktp[2 * g + 1];
            *(u32x4*)(rec + RO_BKT + lane * 64 + g * 16) = w;
        }
        {
            const int t = lane >> 2, g = lane & 3;
            const f32x4 rb = *(const LAS f32x4*)(DM + (16 + t) * 36 + 4 * g), rk = *(const LAS f32x4*)(DM + (16 + t) * 36 + 16 + 4 * g);
            float o[8];
#pragma unroll
            for (int j = 0; j < 4; ++j) { const bool keep = (4 * g + j) <= t; o[j] = keep ? rb[j] : 0.f; o[4 + j] = keep ? rk[j] : 0.f; }
            u32x4 w; w.x = cvt_pk_bf16(o[0], o[1]); w.y = cvt_pk_bf16(o[2], o[3]); w.z = cvt_pk_bf16(o[4], o[5]); w.w = cvt_pk_bf16(o[6], o[7]);
            *(u32x4*)(rec + RO_ARK + t * 64 + g * 16) = w;
        }
        *(float*)(rec + RO_WCC + lane * 4) = wcc;
        if (!has_next) break;
        uid = nuid; b = nb_; h = nh; c = nc; col = ncol; row0 = nrow0;
#pragma unroll
        for (int t = 0; t < 16; ++t) q[t] = qn[t];
        prr = nprr; prk = nprk; prv = nprv;
        __builtin_amdgcn_sched_barrier(0);
    }
}

__device__ __forceinline__ void convert_expert_weights(const PPv& p, LAS unsigned char* lds, int first, int stride);
struct RecOps { bf16x8 wA0, wA1, rA0, rA1, ark, bk[4]; u32x2 u0, vv; f32x4 wc[4]; };
__device__ __forceinline__ void load_ops(RecOps& o, LAS unsigned char* S, int vs, int fr, int g) {
    o.wA0 = *(const LAS bf16x8*)(S + RO_WH + fr * 128 + g * 16); o.wA1 = *(const LAS bf16x8*)(S + RO_WH + fr * 128 + 64 + g * 16);
    o.rA0 = *(const LAS bf16x8*)(S + RO_RT + fr * 128 + g * 16); o.rA1 = *(const LAS bf16x8*)(S + RO_RT + fr * 128 + 64 + g * 16);
    o.u0 = *(const LAS u32x2*)(S + RO_U0T + (16 * vs + fr) * 32 + g * 8);
    o.vv = *(const LAS u32x2*)(S + RO_VT + (16 * vs + fr) * 32 + g * 8);
    o.ark = *(const LAS bf16x8*)(S + RO_ARK + fr * 64 + g * 16);
#pragma unroll
    for (int m = 0; m < 4; ++m) { o.bk[m] = *(const LAS bf16x8*)(S + RO_BKT + (16 * m + fr) * 64 + g * 16); o.wc[m] = *(const LAS f32x4*)(S + RO_WCC + (16 * m + 4 * g) * 4); }
}
__device__ __forceinline__ void phase_recur(const PPv& p, LAS unsigned char* lds) {
    const int tid = threadIdx.x, bid = blockIdx.x, nb = gridDim.x, lane = tid & 63, wave = __builtin_amdgcn_readfirstlane(tid >> 6);
    unsigned char* ws = p.gws();
    if (bid >= 64) { convert_expert_weights(p, lds, bid - 64, nb - 64); return; }
    unsigned char* CHb = ws + OFF_CH + (size_t)(bid * NCHUNK) * REC_BYTES;
    constexpr int RSLOT = REC_BYTES, RN = 11, PF = 8;
#define R_BAR() do { asm volatile("s_waitcnt lgkmcnt(0)" ::: "memory"); __builtin_amdgcn_s_barrier(); asm volatile("" ::: "memory"); } while (0)
    if (wave >= 4) {
        const int lw = wave - 4;
#define R_ISSUE(x) do { \
            LAS unsigned char* _s = lds + ((x) % RN) * RSLOT; const unsigned char* _r = CHb + (size_t)(x) * REC_BYTES + lane * 16; \
            _Pragma("unroll") for (int _i = 0; _i < 3; ++_i) { const int _pc = lw + 4 * _i; __builtin_amdgcn_global_load_lds((const unsigned*)(_r + _pc * 1024), (LAS unsigned*)(_s + _pc * 1024), 16, 0, 0); } \
            if (lw == 0) __builtin_amdgcn_global_load_lds((const unsigned*)(_r + 12 * 1024), (LAS unsigned*)(_s + 12 * 1024), 16, 0, 0); \
            if (lw == 1) { if (lane < 16) __builtin_amdgcn_global_load_lds((const unsigned*)(_r + 13 * 1024), (LAS unsigned*)(_s + 13 * 1024), 16, 0, 0); } } while (0)
        for (int x = 0; x < PF; ++x) R_ISSUE(x);
        asm volatile("s_waitcnt vmcnt(0)" ::: "memory");
        R_BAR();
        for (int c = 0; c < NCHUNK; ++c) {
            const int x = c + PF;
            if (x < NCHUNK) R_ISSUE(x);
            if (x < NCHUNK) { if (lw < 2) asm volatile("s_waitcnt vmcnt(24)" ::: "memory"); else asm volatile("s_waitcnt vmcnt(18)" ::: "memory"); }
            else asm volatile("s_waitcnt vmcnt(0)" ::: "memory");
            R_BAR();
        }
#undef R_ISSUE
    } else {
        const int vs = wave, fr = lane & 15, g = lane >> 4;
        f32x4 H[4];
#pragma unroll
        for (int m = 0; m < 4; ++m) H[m] = (f32x4){0.f, 0.f, 0.f, 0.f};
        R_BAR();
        RecOps cur, nxt;
        load_ops(cur, lds, vs, fr, g);
        for (int c = 0; c < NCHUNK; ++c) {
            if (c + 1 < NCHUNK) load_ops(nxt, lds + ((c + 1) % RN) * RSLOT, vs, fr, g); else nxt = cur;
            u32x4 hb0, hb1;
            hb0.x = cvt_pk_bf16(H[0][0], H[0][1]); hb0.y = cvt_pk_bf16(H[0][2], H[0][3]); hb0.z = cvt_pk_bf16(H[1][0], H[1][1]); hb0.w = cvt_pk_bf16(H[1][2], H[1][3]);
            hb1.x = cvt_pk_bf16(H[2][0], H[2][1]); hb1.y = cvt_pk_bf16(H[2][2], H[2][3]); hb1.z = cvt_pk_bf16(H[3][0], H[3][1]); hb1.w = cvt_pk_bf16(H[3][2], H[3][3]);
            const bf16x8 hB0 = __builtin_bit_cast(bf16x8, hb0), hB1 = __builtin_bit_cast(bf16x8, hb1);
            f32x4 U = (f32x4){bflo(cur.u0.x), bfhi(cur.u0.x), bflo(cur.u0.y), bfhi(cur.u0.y)};
            U = __builtin_amdgcn_mfma_f32_16x16x32_bf16(cur.wA0, hB0, U, 0, 0, 0);
            U = __builtin_amdgcn_mfma_f32_16x16x32_bf16(cur.wA1, hB1, U, 0, 0, 0);
            f32x4 Y = (f32x4){0.f, 0.f, 0.f, 0.f};
            Y = __builtin_amdgcn_mfma_f32_16x16x32_bf16(cur.rA0, hB0, Y, 0, 0, 0);
            Y = __builtin_amdgcn_mfma_f32_16x16x32_bf16(cur.rA1, hB1, Y, 0, 0, 0);
            u32x4 uvw; uvw.x = cvt_pk_bf16(U[0], U[1]); uvw.y = cvt_pk_bf16(U[2], U[3]); uvw.z = cur.vv.x; uvw.w = cur.vv.y;
            const bf16x8 uv = __builtin_bit_cast(bf16x8, uvw);
            Y = __builtin_amdgcn_mfma_f32_16x16x32_bf16(cur.ark, uv, Y, 0, 0, 0);
#pragma unroll
            for (int m = 0; m < 4; ++m) { H[m] = __builtin_amdgcn_mfma_f32_16x16x32_bf16(cur.bk[m], uv, H[m], 0, 0, 0); H[m] *= cur.wc[m]; }
            u32x2 yw; yw.x = cvt_pk_bf16(Y[0], Y[1]); yw.y = cvt_pk_bf16(Y[2], Y[3]);
            *(u32x2*)(CHb + (size_t)c * REC_BYTES + RO_U0T + (16 * vs + fr) * 32 + g * 8) = yw;
            R_BAR();
            cur = nxt;
        }
    }
#undef R_BAR
}

__device__ __forceinline__ void phase_gn(const PPv& p, LAS unsigned char* lds) {
    const int tid = threadIdx.x, bid = blockIdx.x, nb = gridDim.x, lane = tid & 63, wave = tid >> 6;
    unsigned char* ws = p.gws();
    LAS float* PM = (LAS float*)(lds + wave * 8960);
    LAS float* RS = PM + 32 * 68;
    const bf16_t* Gb = (const bf16_t*)(ws + OFF_G); const float* COEF = (const float*)(ws + OFF_COEF);
    bf16_t* Z = (bf16_t*)(ws + OFF_Z);
    constexpr int NREAL = 64 * 256;
    for (int r0 = bid * 8 + wave; r0 < NREAL; r0 += nb * 16) {
        u32x4 y0[2], y1[2], v0[2], v1[2]; float cfv[2][16]; bf16_t ggv[2][16]; int colv[2], row0v[2], hv[2]; bool okv[2];
#pragma unroll
        for (int u = 0; u < 2; ++u) {
            const int r = r0 + u * nb * 8; okv[u] = r < NREAL;
            const int rr = okv[u] ? r : r0;
            const int bh = rr >> 8, c = (rr & 255) + 1, b = bh >> 3, h = bh & 7, uid = bh * NCHUNK + c;
            hv[u] = h; colv[u] = h * 64 + lane; row0v[u] = b * SEQ + c * 16;
            const unsigned char* rec = ws + OFF_CH + (size_t)uid * REC_BYTES;
            y0[u] = *(const u32x4*)(rec + RO_U0T + lane * 32); y1[u] = *(const u32x4*)(rec + RO_U0T + lane * 32 + 16);
            v0[u] = *(const u32x4*)(rec + RO_VT + lane * 32); v1[u] = *(const u32x4*)(rec + RO_VT + lane * 32 + 16);
#pragma unroll
            for (int t = 0; t < 16; ++t) { cfv[u][t] = COEF[(size_t)(row0v[u] + t) * 8 + h]; ggv[u][t] = Gb[(size_t)(row0v[u] + t) * 512 + colv[u]]; }
        }
#pragma unroll
        for (int u = 0; u < 2; ++u) {
            if (!okv[u]) continue;
            const int col = colv[u], row0 = row0v[u];
            const float lng = p.gin(21)[col], lnb = p.gin(22)[col];
            const unsigned yw[8] = {y0[u].x, y0[u].y, y0[u].z, y0[u].w, y1[u].x, y1[u].y, y1[u].z, y1[u].w}, vw[8] = {v0[u].x, v0[u].y, v0[u].z, v0[u].w, v1[u].x, v1[u].y, v1[u].z, v1[u].w};
            asm volatile("" ::: "memory");
#pragma unroll
            for (int t = 0; t < 16; ++t) { const float y = (t & 1) ? bfhi(yw[t >> 1]) : bflo(yw[t >> 1]); PM[t * 68 + lane] = y; PM[(16 + t) * 68 + lane] = y * y; }
            asm volatile("" ::: "memory");
            {
                const int rw = lane & 31, hf = lane >> 5;
                f32x4 s4 = (f32x4){0.f, 0.f, 0.f, 0.f};
#pragma unroll
                for (int i = 0; i < 8; ++i) s4 += *(const LAS f32x4*)(PM + rw * 68 + hf * 32 + i * 4);
                float sm = (s4[0] + s4[1]) + (s4[2] + s4[3]);
                { float c2 = sm; asm volatile("v_nop\n\tv_nop\n\tv_permlane32_swap_b32 %0, %1\n\tv_nop" : "+v"(sm), "+v"(c2)); sm += c2; }
                if (lane < 32) RS[lane] = sm;
            }
            asm volatile("" ::: "memory");
            f32x4 s1v[4], s2v[4];
#pragma unroll
            for (int i = 0; i < 4; ++i) { s1v[i] = *(const LAS f32x4*)(RS + 4 * i); s2v[i] = *(const LAS f32x4*)(RS + 16 + 4 * i); }
            asm volatile("" ::: "memory");
#pragma unroll
            for (int t = 0; t < 16; ++t) {
                const float y = (t & 1) ? bfhi(yw[t >> 1]) : bflo(yw[t >> 1]);
                const float v = (t & 1) ? bfhi(vw[t >> 1]) : bflo(vw[t >> 1]);
                const float mean = s1v[t >> 2][t & 3] * (1.0f / 64.0f);
                const float dlt = y - mean;
                const float var = fmaxf(s2v[t >> 2][t & 3] * (1.0f / 64.0f) - mean * mean, 0.f);
                const float yn = dlt * rsqrtf(var + LNX_EPS) * lng + lnb;
                Z[(size_t)(row0 + t - NMETA) * 512 + col] = f2bf((yn + cfv[u][t] * v) * bf2f(ggv[u][t]));
            }
        }
    }
}

__device__ __forceinline__ void convert_expert_weights(const PPv& p, LAS unsigned char* lds, int first, int stride) {
    unsigned char* ws = p.gws();
    const int tid = threadIdx.x;
    LAS float* tile = (LAS float*)lds;
    const float* g2 = p.gin(27);
    unsigned char* WGU = ws + OFF_WGU; unsigned char* WD = ws + OFF_WD;
    constexpr int NBLK = NE * 3 * 64;
    const int lr = tid >> 6, lc = (tid & 63) * 4;
    f32x4 cur[8];
    int j = first;
    if (j >= NBLK) return;
    {
        const int mat = j >> 6, e = mat / 3, which = mat - 3 * e, bb = j & 63, kb = bb & 15, nbk = bb >> 4;
        const float* src = (which == 0 ? p.gin(30) : which == 1 ? p.gin(32) : p.gin(34)) + (size_t)e * 1024 * 1024 + (size_t)(kb * 64) * 1024 + nbk * 256;
#pragma unroll
        for (int i = 0; i < 8; ++i) cur[i] = __builtin_nontemporal_load((const f32x4*)(src + (size_t)(lr + 8 * i) * 1024 + lc));
    }
    for (;;) {
        const int jn = j + stride; const bool has_next = jn < NBLK;
        f32x4 nxt[8];
        if (has_next) {
            const int mat = jn >> 6, e = mat / 3, which = mat - 3 * e, bb = jn & 63, kb = bb & 15, nbk = bb >> 4;
            const float* src = (which == 0 ? p.gin(30) : which == 1 ? p.gin(32) : p.gin(34)) + (size_t)e * 1024 * 1024 + (size_t)(kb * 64) * 1024 + nbk * 256;
#pragma unroll
            for (int i = 0; i < 8; ++i) nxt[i] = __builtin_nontemporal_load((const f32x4*)(src + (size_t)(lr + 8 * i) * 1024 + lc));
        }
        const int mat = j >> 6, e = mat / 3, which = mat - 3 * e, bb = j & 63, kb = bb & 15, nbk = bb >> 4;
#pragma unroll
        for (int i = 0; i < 8; ++i) { LAS float* t = tile + (lr + 8 * i) * 257 + lc; t[0] = cur[i][0]; t[1] = cur[i][1]; t[2] = cur[i][2]; t[3] = cur[i][3]; }
        __syncthreads();
        {
            const int kq = tid & 7, k0 = kb * 64 + 8 * kq;
            float sc[8];
#pragma unroll
            for (int jj = 0; jj < 8; ++jj) sc[jj] = (which < 2 ? g2[k0 + jj] : 1.0f) * W8_SCALE;
#pragma unroll
            for (int i = 0; i < 4; ++i) {
                const int nn = (tid >> 3) + 64 * i, n = nbk * 256 + nn;
                float v[8];
#pragma unroll
                for (int jj = 0; jj < 8; ++jj) v[jj] = tile[(8 * kq + jj) * 257 + nn] * sc[jj];
                u32x2 w; w.x = pk4_fp8(v[0], v[1], v[2], v[3]); w.y = pk4_fp8(v[4], v[5], v[6], v[7]);
                unsigned char* dst = which < 2 ? WGU + (size_t)e * 2048 * 1024 + (size_t)(256 * (n >> 7) + 128 * which + (n & 127)) * 1024
                                               : WD + (size_t)e * 1024 * 1024 + (size_t)n * 1024;
                __builtin_nontemporal_store(w, (u32x2*)(dst + k0));
            }
        }
        __syncthreads();
        if (!has_next) break;
        j = jn;
#pragma unroll
        for (int i = 0; i < 8; ++i) cur[i] = nxt[i];
    }
}

__device__ __forceinline__ void phase_router(const PPv& p, LAS unsigned char* lds) {
    const int tid = threadIdx.x, bid = blockIdx.x, nb = gridDim.x, lane = tid & 63, wave = tid >> 6;
    unsigned char* ws = p.gws();
    const bf16_t* h1 = (const bf16_t*)(ws + OFF_HB2);
    const float* WRG = (const float*)(ws + OFF_WRG);
    const float* brt = p.gin(29);
    LAS float* slog = (LAS float*)lds;
    LAS float* srs = slog + 8 * 16 * 32;
    LAS int* lcnt = (LAS int*)(srs + 128);
    LAS int* gbase = lcnt + 32;
    LAS int* ltopi = gbase + 32;
    LAS int* lrank = ltopi + 512;
    int* TOPI = (int*)(ws + OFF_TOPI); float* TOPW = (float*)(ws + OFF_TOPW); int* RANK = (int*)(ws + OFF_RANK); float* RSTD2 = (float*)(ws + OFF_RSTD2);
    int* GCNT = (int*)(ws + OFF_GCNT);
    for (int tb = bid; tb < T / 128; tb += nb) {
        if (tid < 32) lcnt[tid] = 0;
        __syncthreads();
        const int t0 = tb * 128 + wave * 16;
        {
            const int row = lane & 15, kq = lane >> 4;
            const bf16_t* ap = h1 + (size_t)(t0 + row) * D + 4 * kq;
            const float* bp = WRG + (size_t)(4 * kq) * 32 + row;
            f32x4 acc0 = (f32x4){0.f, 0.f, 0.f, 0.f}, acc1 = acc0;
            float ss = 0.f;
            for (int j = 0; j < 64; ++j) {
                const u32x2 aw = *(const u32x2*)(ap + 16 * j);
                const f32x4 av = (f32x4){bflo(aw.x), bfhi(aw.x), bflo(aw.y), bfhi(aw.y)};
                ss += av[0] * av[0] + av[1] * av[1] + av[2] * av[2] + av[3] * av[3];
                const float* bj = bp + (size_t)(16 * j) * 32;
#pragma unroll
                for (int s = 0; s < 4; ++s) {
                    const float b0 = bj[s * 32], b1 = bj[s * 32 + 16];
                    acc0 = __builtin_amdgcn_mfma_f32_16x16x4f32(av[s], b0, acc0, 0, 0, 0);
                    acc1 = __builtin_amdgcn_mfma_f32_16x16x4f32(av[s], b1, acc1, 0, 0, 0);
                }
            }
            ss += __shfl_xor(ss, 16); ss += __shfl_xor(ss, 32);
#pragma unroll
            for (int reg = 0; reg < 4; ++reg) {
                slog[(wave * 16 + 4 * kq + reg) * 32 + row] = acc0[reg];
                slog[(wave * 16 + 4 * kq + reg) * 32 + 16 + row] = acc1[reg];
            }
            if (lane < 16) srs[wave * 16 + lane] = rsqrtf(ss * (1.0f / D) + NORM_EPS);
        }
        __syncthreads();
        if (lane < 16) {
            const int tl = wave * 16 + lane, t = tb * 128 + tl;
            const float rs = srs[tl];
            float lg[32];
#pragma unroll
            for (int e = 0; e < 32; ++e) lg[e] = slog[tl * 32 + e] * rs + brt[e];
            int ti[4]; float tv[4];
#pragma unroll
            for (int k = 0; k < 4; ++k) {
                float best = -3.0e38f; int bi = 0;
#pragma unroll
                for (int e = 0; e < 32; ++e) { const bool tk = lg[e] > best; best = tk ? lg[e] : best; bi = tk ? e : bi; }
                ti[k] = bi; tv[k] = best;
#pragma unroll
                for (int e = 0; e < 32; ++e) lg[e] = (e == bi) ? -3.0e38f : lg[e];
            }
            const float e0 = 1.0f, e1 = __expf(tv[1] - tv[0]), e2 = __expf(tv[2] - tv[0]), e3 = __expf(tv[3] - tv[0]);
            const float inv = 1.0f / (e0 + e1 + e2 + e3);
            *(f32x4*)(TOPW + (size_t)t * 4) = (f32x4){e0 * inv, e1 * inv, e2 * inv, e3 * inv};
            RSTD2[t] = rs;
#pragma unroll
            for (int k = 0; k < 4; ++k) { ltopi[tl * 4 + k] = ti[k]; lrank[tl * 4 + k] = __hip_atomic_fetch_add(lcnt + ti[k], 1, __ATOMIC_RELAXED, __HIP_MEMORY_SCOPE_WORKGROUP); }
        }
        __syncthreads();
        if (tid < 32) gbase[tid] = atomicAdd(GCNT + tid, lcnt[tid]);
        __syncthreads();
        {
            const int e = ltopi[tid];
            TOPI[(size_t)tb * 512 + tid] = e;
            RANK[(size_t)tb * 512 + tid] = gbase[e] + lrank[tid];
        }
        __syncthreads();
    }
}

__device__ __forceinline__ void phase_lists(const PPv& p, LAS unsigned char* lds) {
    const int tid = threadIdx.x, bid = blockIdx.x, nb = gridDim.x;
    unsigned char* ws = p.gws();
    LAS int* pstart = (LAS int*)lds;
    LAS int* cnt = pstart + 64;
    const int* GCNT = (const int*)(ws + OFF_GCNT);
    if (tid < 32) cnt[tid] = GCNT[tid];
    __syncthreads();
    if (tid == 0) { int s = 0; for (int e = 0; e < 32; ++e) { pstart[e] = s; s += ((cnt[e] + 255) >> 8) << 8; } pstart[32] = s; }
    __syncthreads();
    const int* TOPI = (const int*)(ws + OFF_TOPI); const float* TOPW = (const float*)(ws + OFF_TOPW); const int* RANK = (const int*)(ws + OFF_RANK); const float* RSTD2 = (const float*)(ws + OFF_RSTD2);
    int* ROWTOK = (int*)(ws + OFF_ROWTOK); int* ROWSLOT = (int*)(ws + OFF_ROWSLOT); float* ROWW = (float*)(ws + OFF_ROWW); float* ROWRS = (float*)(ws + OFF_ROWRS);
    for (int i = bid * 512 + tid; i < T * 4; i += nb * 512) {
        const int e = TOPI[i], pos = pstart[e] + RANK[i], t = i >> 2;
        ROWTOK[pos] = t; ROWSLOT[pos] = i; ROWW[pos] = TOPW[i]; ROWRS[pos] = RSTD2[t];
    }
    for (int e = bid; e < 32; e += nb) {
        for (int pos = pstart[e] + cnt[e] + tid; pos < pstart[e + 1]; pos += 512) { ROWTOK[pos] = 0; ROWSLOT[pos] = -1; ROWW[pos] = 0.f; ROWRS[pos] = 0.f; }
    }
    if (bid == 0) {
        int* TILEE = (int*)(ws + OFF_TILEE);
        const int ntiles = pstart[32] >> 8;
        for (int mt = tid; mt < ntiles; mt += 512) { int e = 0; for (int q = 0; q < 32; ++q) if (pstart[q] <= mt * 256) e = q; TILEE[mt] = e; }
        if (tid == 0) TILEE[1000] = ntiles;
    }
    __syncthreads();
}

__device__ __forceinline__ void phase_final(const PPv& p) {
    const int tid = threadIdx.x, bid = blockIdx.x, nb = gridDim.x, lane = tid & 63, wave = tid >> 6;
    unsigned char* ws = p.gws();
    const bf16_t* HB2 = (const bf16_t*)(ws + OFF_HB2);
    const unsigned char* Y8 = (const unsigned char*)p.gout();
    const float* gf = p.gin(36);
    const f32x4 ga0 = *(const f32x4*)(gf + 8 * lane), ga1 = *(const f32x4*)(gf + 8 * lane + 4), gb0 = *(const f32x4*)(gf + 512 + 8 * lane), gb1 = *(const f32x4*)(gf + 512 + 8 * lane + 4);
    for (int t0 = (bid * 8 + wave) * 2; t0 < T; t0 += nb * 16) {
        u32x4 ha[2], hb[2]; u32x2 ya[2][4], yb[2][4];
#pragma unroll
        for (int u = 0; u < 2; ++u) {
            const int t = t0 + u;
            ha[u] = __builtin_nontemporal_load((const u32x4*)(HB2 + (size_t)t * D + 8 * lane)); hb[u] = __builtin_nontemporal_load((const u32x4*)(HB2 + (size_t)t * D + 512 + 8 * lane));
#pragma unroll
            for (int k = 0; k < 4; ++k) { ya[u][k] = __builtin_nontemporal_load((const u32x2*)(Y8 + (size_t)(4 * t + k) * 1024 + 8 * lane)); yb[u][k] = __builtin_nontemporal_load((const u32x2*)(Y8 + (size_t)(4 * t + k) * 1024 + 512 + 8 * lane)); }
        }
#pragma unroll
        for (int u = 0; u < 2; ++u) {
            const int t = t0 + u;
            float va[8] = {bflo(ha[u].x), bfhi(ha[u].x), bflo(ha[u].y), bfhi(ha[u].y), bflo(ha[u].z), bfhi(ha[u].z), bflo(ha[u].w), bfhi(ha[u].w)};
            float vb[8] = {bflo(hb[u].x), bfhi(hb[u].x), bflo(hb[u].y), bfhi(hb[u].y), bflo(hb[u].z), bfhi(hb[u].z), bflo(hb[u].w), bfhi(hb[u].w)};
#pragma unroll
            for (int k = 0; k < 4; ++k) {
                const u32x2 a4 = ya[u][k], b4 = yb[u][k];
                { const f32x2 q0 = __builtin_amdgcn_cvt_pk_f32_fp8((int)a4.x, false), q1 = __builtin_amdgcn_cvt_pk_f32_fp8((int)a4.x, true), q2 = __builtin_amdgcn_cvt_pk_f32_fp8((int)a4.y, false), q3 = __builtin_amdgcn_cvt_pk_f32_fp8((int)a4.y, true);
                  va[0] += q0.x; va[1] += q0.y; va[2] += q1.x; va[3] += q1.y; va[4] += q2.x; va[5] += q2.y; va[6] += q3.x; va[7] += q3.y; }
                { const f32x2 q0 = __builtin_amdgcn_cvt_pk_f32_fp8((int)b4.x, false), q1 = __builtin_amdgcn_cvt_pk_f32_fp8((int)b4.x, true), q2 = __builtin_amdgcn_cvt_pk_f32_fp8((int)b4.y, false), q3 = __builtin_amdgcn_cvt_pk_f32_fp8((int)b4.y, true);
                  vb[0] += q0.x; vb[1] += q0.y; vb[2] += q1.x; vb[3] += q1.y; vb[4] += q2.x; vb[5] += q2.y; vb[6] += q3.x; vb[7] += q3.y; }
            }
            float ss = 0.f;
#pragma unroll
            for (int j = 0; j < 8; ++j) ss += va[j] * va[j] + vb[j] * vb[j];
            ss = wave_sum_dpp(ss);
            const float rs = rsqrtf(ss * (1.0f / D) + NORM_EPS);
            float* o = p.gout() + (size_t)t * D;
            __builtin_nontemporal_store((f32x4){va[0] * rs * ga0[0], va[1] * rs * ga0[1], va[2] * rs * ga0[2], va[3] * rs * ga0[3]}, (f32x4*)(o + 8 * lane));
            __builtin_nontemporal_store((f32x4){va[4] * rs * ga1[0], va[5] * rs * ga1[1], va[6] * rs * ga1[2], va[7] * rs * ga1[3]}, (f32x4*)(o + 8 * lane + 4));
            __builtin_nontemporal_store((f32x4){vb[0] * rs * gb0[0], vb[1] * rs * gb0[1], vb[2] * rs * gb0[2], vb[3] * rs * gb0[3]}, (f32x4*)(o + 512 + 8 * lane));
            __builtin_nontemporal_store((f32x4){vb[4] * rs * gb1[0], vb[5] * rs * gb1[1], vb[6] * rs * gb1[2], vb[7] * rs * gb1[3]}, (f32x4*)(o + 512 + 8 * lane + 4));
        }
    }
}

#define XB_TMO      128
#define XB_XCNT(j)  (256  + 64 * (j))
#define XB_XSUB(j)  (1280 + 64 * (j))
#define XB_XGEN(j)  (2304 + 64 * (j))
#define XB_TOP      3328
#define XB_TOPGEN   3392
#define XCD_BAR_WORDS 3456
#define XB_SPIN_CAP (1u << 18)
__device__ __forceinline__ unsigned xb_ld(unsigned* p)              { return __hip_atomic_load(p, __ATOMIC_RELAXED, __HIP_MEMORY_SCOPE_AGENT); }
__device__ __forceinline__ unsigned xb_add(unsigned* p, unsigned v) { return __hip_atomic_fetch_add(p, v, __ATOMIC_RELAXED, __HIP_MEMORY_SCOPE_AGENT); }
__device__ __forceinline__ unsigned xb_xcc_id() { return (unsigned)__builtin_amdgcn_s_getreg((3 << 11) | 20) & 0xFu; }
#define XB_SPIN(cond, bar) do { unsigned _sp = 0; while (cond) { __builtin_amdgcn_s_sleep(1); \
    if ((++_sp & 255u) == 0u) { if (xb_ld(&(bar)[XB_TMO])) break; if (_sp > XB_SPIN_CAP) { atomicAdd(&(bar)[XB_TMO], 1u); break; } } } } while (0)
struct XcdBarrier { unsigned* bar; unsigned x; volatile LAS unsigned* st; };
__device__ __forceinline__ XcdBarrier xcd_barrier_post(unsigned* bar, volatile LAS unsigned* st) {
    XcdBarrier b; b.bar = bar; b.x = xb_xcc_id(); b.st = st;
    if (threadIdx.x == 0) (void)xb_add(&bar[XB_XCNT(b.x)], 1u);
    return b;
}
__device__ __forceinline__ void xcd_barrier_complete(unsigned* bar, unsigned x, unsigned& nloc, unsigned& nx) {
    const unsigned G = gridDim.x * gridDim.y * gridDim.z;
    unsigned sum, cnt, mine, sp = 0u;
    for (;;) {
        sum = 0u; cnt = 0u; mine = 0u;
#pragma unroll
        for (unsigned j = 0; j < 16; ++j) { const unsigned c = xb_ld(&bar[XB_XCNT(j)]); sum += c; cnt += (c > 0u) ? 1u : 0u; mine = (j == x) ? c : mine; }
        if (sum == G) break;
        __builtin_amdgcn_s_sleep(1);
        if ((++sp & 255u) == 0u) { if (xb_ld(&bar[XB_TMO])) break; if (sp > XB_SPIN_CAP) { atomicAdd(&bar[XB_TMO], 1u); break; } }
    }
    nloc = mine > 0u ? mine : 1u; nx = cnt > 0u ? cnt : 1u;
}
__device__ __forceinline__ void xcd_barrier(const XcdBarrier& b) {
    asm volatile("s_waitcnt vmcnt(0)" ::: "memory");
    __syncthreads();
    if (threadIdx.x == 0) {
        unsigned* bar = b.bar;
        __builtin_amdgcn_s_waitcnt(0);
        unsigned nloc = b.st[0], nx = b.st[1];
        if (nloc == 0u) { xcd_barrier_complete(bar, b.x, nloc, nx); b.st[0] = nloc; b.st[1] = nx; }
        const unsigned old = xb_add(&bar[XB_XSUB(b.x)], 1u);
        const unsigned gen = old / nloc;
        if (old + 1u == (gen + 1u) * nloc) {
            __builtin_amdgcn_fence(__ATOMIC_RELEASE, "agent");
            asm volatile("s_waitcnt vmcnt(0)" ::: "memory");
            const unsigned og = xb_add(&bar[XB_TOP], 1u);
            const unsigned tg = og / nx;
            if (og + 1u == (tg + 1u) * nx) xb_add(&bar[XB_TOPGEN], 1u);
            else XB_SPIN(xb_ld(&bar[XB_TOPGEN]) == tg, bar);
            __builtin_amdgcn_fence(__ATOMIC_ACQUIRE, "agent");
            xb_add(&bar[XB_XGEN(b.x)], 1u);
            asm volatile("s_waitcnt vmcnt(0)" ::: "memory");
        } else {
            XB_SPIN(xb_ld(&bar[XB_XGEN(b.x)]) == gen, bar);
            __builtin_amdgcn_fence(__ATOMIC_ACQUIRE, "agent");
            asm volatile("s_waitcnt vmcnt(0)" ::: "memory");
        }
    }
    __syncthreads();
}

constexpr int N_PHASES = 15;
__global__ void __launch_bounds__(512, 2) mega(Params p) {
    extern __shared__ __attribute__((aligned(16))) unsigned char lds_raw[];
    LAS unsigned char* lds = (LAS unsigned char*)lds_raw;
    cg::grid_group grid = cg::this_grid();
    unsigned char* ws = getpp().gws();
    const int G = gridDim.x, bid = blockIdx.x;
#ifndef ONLY_PHASE
#define ONLY_PHASE -1
#endif
#define IN(k) ((ONLY_PHASE < 0 || ONLY_PHASE == (k)) && p.ph_lo <= (k) && (k) < p.ph_hi)
    volatile LAS unsigned* xst = (volatile LAS unsigned*)(lds + 163840 - 16);
    if (threadIdx.x < 4) xst[threadIdx.x] = 0u;
    __syncthreads();
    const XcdBarrier xbar = xcd_barrier_post((unsigned*)(ws + OFF_BAR), xst);
    if (p.ph_hi < 0) grid.sync();
#define SEAM(k) do { if ((k) + 1 < p.ph_hi) xcd_barrier(xbar); } while (0)
    if (IN(0)) { const PPv q = getpp(); phase_prep(q, lds); SEAM(0); }
    if (IN(1)) { const PPv q = getpp();
        phase_meta_proj(q, lds);
        StaticOrder S; S.init(ws + OFF_HB, ws + OFF_WIN, T, NCOLS1, 1024, G, bid);
        EpiProj E{(bf16_t*)(ws + OFF_PRKV), (bf16_t*)(ws + OFF_PCONV), (bf16_t*)q.gout(), (const float*)(ws + OFF_RSTD1)};
        gemm_phase<false>(lds, 1024, S, E);
        SEAM(1);
    }
    if (IN(2)) { const PPv q = getpp(); phase_lprep_conv(q); SEAM(2); }
    if (IN(3)) { const PPv q = getpp();
        phase_meta_lora(q);
        StaticOrder S; S.init(ws + OFF_L + (size_t)NMETA * 256 * 2, ws + OFF_W2, T, 1536, 256, G, bid);
        EpiL E{ws, q.gin(10), q.gin(13)};
        gemm_phase<false>(lds, 256, S, E);
        SEAM(3);
    }
    if (IN(4)) { const PPv q = getpp(); phase_scanprep(q, lds); SEAM(4); }
    if (IN(5)) { const PPv q = getpp(); phase_recur(q, lds); SEAM(5); }
    if (IN(6)) { const PPv q = getpp(); phase_gn(q, lds); SEAM(6); }
    if (IN(7)) { const PPv q = getpp();
        MergeOrder S; S.so.init(ws + OFF_Z, ws + OFF_WR, T, 1024, 512, G, bid); S.A1 = (const char*)(ws + OFF_C); S.B1 = (const char*)(ws + OFF_WC);
        EpiMergeFused E{(bf16_t*)(ws + OFF_MERGED), (const bf16_t*)q.gout()};
        gemm_phase<false>(lds, 512, S, E);
        SEAM(7);
    }
    if (IN(9)) { const PPv q = getpp();
        StaticOrder S; S.init(ws + OFF_MERGED, ws + OFF_WO, T, 1024, 1024, G, bid);
        EpiO E{q.gin(0), q.gout(), (bf16_t*)(ws + OFF_HB2), ws + OFF_HB8};
        gemm_phase<false>(lds, 1024, S, E);
        SEAM(9);
    }
    if (IN(10)) { const PPv q = getpp(); phase_router(q, lds); SEAM(10); }
    if (IN(11)) { const PPv q = getpp(); phase_lists(q, lds); SEAM(11); }
    if (IN(12)) { const PPv q = getpp();
        const int* TILEE = (const int*)(ws + OFF_TILEE);
        MoeOrder S; S.A = (const char*)(ws + OFF_HB8); S.Bt = (const char*)(ws + OFF_WGU); S.K = 512; S.estride = (size_t)2048 * 1024;
        S.tile_e = TILEE; S.rowtok = (const int*)(ws + OFF_ROWTOK); S.ntiles = TILEE[1000]; S.nnt = 8; S.G = G; S.c = bid; S.gather = true;
        EpiMoe1 E{ws + OFF_ACT, (const float*)(ws + OFF_ROWRS), q.gin(31), q.gin(33)};
        gemm_phase<true, true>(lds, 512, S, E);
        SEAM(12);
    }
    if (IN(13)) { const PPv q = getpp();
        const int* TILEE = (const int*)(ws + OFF_TILEE);
        MoeOrder S; S.A = (const char*)(ws + OFF_ACT); S.Bt = (const char*)(ws + OFF_WD); S.K = 512; S.estride = (size_t)1024 * 1024;
        S.tile_e = TILEE; S.rowtok = nullptr; S.ntiles = TILEE[1000]; S.nnt = 4; S.G = G; S.c = bid; S.gather = false;
        EpiMoe2 E{(unsigned char*)q.gout(), (const int*)(ws + OFF_ROWSLOT), (const float*)(ws + OFF_ROWW), q.gin(35)};
        gemm_phase<false, true>(lds, 512, S, E);
        SEAM(13);
    }
    if (IN(14)) { const PPv q = getpp(); phase_final(q); }
}

extern "C" void kernel_launch(void* const* d_in, const int* in_sizes, int n_in, void* d_out, int out_size, void* d_ws, size_t ws_size,
                              hipStream_t stream) {
    constexpr size_t kDynLds = 160 * 1024;
    static int grid_blocks = 0;
    if (!grid_blocks) {
        int dev = 0, cus = 0, per_cu = 0;
        (void)hipGetDevice(&dev);
        (void)hipDeviceGetAttribute(&cus, hipDeviceAttributeMultiprocessorCount, dev);
        (void)hipFuncSetAttribute((const void*)mega, hipFuncAttributeMaxDynamicSharedMemorySize, (int)kDynLds);
        (void)hipOccupancyMaxActiveBlocksPerMultiprocessor(&per_cu, mega, 512, kDynLds);
        if (per_cu > 1) per_cu = 1;
        grid_blocks = cus * per_cu;
        fprintf(stderr, "cus=%d per_cu=%d ws_size=%zu need=%zu\n", cus, per_cu, ws_size, (size_t)WS_NEED);
    }
    if (ws_size < WS_NEED || n_in < 37 || grid_blocks < 128) { fprintf(stderr, "kernel_launch: unsupported configuration\n"); return; }
    Params p{};
    for (int i = 0; i < 37; ++i) p.in[i] = (const float*)d_in[i];
    p.out = (float*)d_out;
    p.ws = (unsigned char*)d_ws;
    p.ph_lo = 0; p.ph_hi = N_PHASES;
    (void)hipMemsetAsync((unsigned char*)d_ws + OFF_BAR, 0, 16384, stream);
    void* args[] = {&p};
    hipError_t e = hipLaunchCooperativeKernel((void*)mega, dim3(grid_blocks), dim3(512), args, kDynLds, stream);
    if (e != hipSuccess) fprintf(stderr, "cooperative launch failed: %s (grid %d)\n", hipGetErrorString(e), grid_blocks);
}
```

```cpp
#include <hip/hip_runtime.h>
#include <hip/hip_cooperative_groups.h>
#include <cstdio>
namespace cg = cooperative_groups;

#define LAS __attribute__((address_space(3)))
typedef unsigned short bf16_t;
typedef short bf16x8 __attribute__((ext_vector_type(8)));
typedef float f32x4 __attribute__((ext_vector_type(4)));
typedef float f32x2 __attribute__((ext_vector_type(2)));
typedef unsigned u32x4 __attribute__((ext_vector_type(4)));
typedef unsigned u32x2 __attribute__((ext_vector_type(2)));
#define LO2(v) __builtin_shufflevector(v, v, 0, 1)
#define HI2(v) __builtin_shufflevector(v, v, 2, 3)

constexpr int D = 1024, NBATCH = 8, SEQ = 4096, NMETA = 16;
constexpr int T = NBATCH * SEQ;
constexpr int NR = T + NMETA;
constexpr int NRP = 33024;
constexpr int PCOLS1 = 3584;
constexpr int NCOLS1 = 5632;
constexpr int NE = 32, TOPK = 4, DFF = 1024;
constexpr int MAXROWS = T * TOPK + NE * 256;
constexpr int MAXTILES = MAXROWS / 256;
constexpr float NORM_EPS = 1e-5f, LNX_EPS = 64e-5f;

constexpr int NCHUNK = 257, NUNITS = 64 * NCHUNK;
constexpr int REC_BYTES = 13568;
constexpr int RO_WH = 0, RO_RT = 2048, RO_U0T = 4096, RO_VT = 6144, RO_BKT = 8192, RO_ARK = 12288, RO_WCC = 13312;
constexpr int SLOT_BYTES = 15680, SO_G = 13568, SO_COEF = 15616, NSLOT = 9;
constexpr size_t SZ_ACT = (size_t)MAXROWS * 1024 * 2;
constexpr size_t SZ_WGU = (size_t)NE * 2048 * 1024 * 2;
constexpr size_t SZ_WD = (size_t)NE * 1024 * 1024 * 2;
constexpr size_t SZ_HB = (size_t)T * 1024 * 2;
constexpr size_t OFF_WGU = 0;
constexpr size_t OFF_HB8 = OFF_WGU + (size_t)NE * 2048 * 1024;
constexpr size_t OFF_WD = OFF_WGU + SZ_WGU;
constexpr size_t OFF_ACT = OFF_WD + SZ_WD;
constexpr size_t OFF_HB2 = OFF_ACT + SZ_ACT;
constexpr size_t OFF_RT = OFF_HB2 + SZ_HB;
constexpr size_t OFF_TOPI = OFF_RT;
constexpr size_t OFF_TOPW = OFF_TOPI + (size_t)T * 16;
constexpr size_t OFF_RANK = OFF_TOPW + (size_t)T * 16;
constexpr size_t OFF_RSTD2 = OFF_RANK + (size_t)T * 16;
constexpr size_t OFF_ROWTOK = OFF_RSTD2 + (size_t)T * 4;
constexpr size_t OFF_ROWSLOT = OFF_ROWTOK + (size_t)MAXROWS * 4;
constexpr size_t OFF_ROWW = OFF_ROWSLOT + (size_t)MAXROWS * 4;
constexpr size_t OFF_ROWRS = OFF_ROWW + (size_t)MAXROWS * 4;
constexpr size_t OFF_TILEE = OFF_ROWRS + (size_t)MAXROWS * 4;
constexpr size_t OFF_GCNT = OFF_TILEE + 4096;
constexpr size_t OFF_SM = OFF_GCNT + 256;
constexpr size_t OFF_WR = OFF_SM;
constexpr size_t OFF_WC = OFF_WR + (size_t)1024 * 512 * 2;
constexpr size_t OFF_WO = OFF_WC + (size_t)1024 * 512 * 2;
constexpr size_t OFF_W2 = OFF_WO + (size_t)1024 * 1024 * 2;
constexpr size_t OFF_RSTD1 = OFF_W2 + (size_t)1536 * 256 * 2;
constexpr size_t OFF_WRG = OFF_RSTD1 + (size_t)NRP * 4;
constexpr size_t OFF_BAR = OFF_WRG + (size_t)1024 * 32 * 4;
constexpr size_t WS_NEED = OFF_BAR + 16384;
constexpr size_t OFF_PRKV = 0;
constexpr size_t SZ_PRKV = (size_t)NR * 1536 * 2;
constexpr size_t OFF_LD = OFF_PRKV + SZ_PRKV;
constexpr size_t OFF_A = OFF_LD + (size_t)NRP * 512 * 4;
constexpr size_t OFF_CH = OFF_A + (size_t)NRP * 512 * 2;
constexpr size_t OFF_PCONV = OFF_CH;
constexpr size_t SZ_PCONV = (size_t)NR * 2048 * 2;
constexpr size_t OFF_HB = OFF_PCONV + SZ_PCONV;
constexpr size_t OFF_L = OFF_HB + SZ_HB;
constexpr size_t OFF_WIN = OFF_L + (size_t)NRP * 256 * 2;
constexpr size_t CH_END = OFF_WIN + (size_t)NCOLS1 * 1024 * 2;
constexpr size_t OFF_MERGED = OFF_CH;
constexpr size_t OFF_G = CH_END;
constexpr size_t OFF_C = OFF_G + (size_t)NRP * 512 * 2;
constexpr size_t OFF_Z = OFF_C + (size_t)T * 512 * 2;
constexpr size_t OFF_COEF = OFF_Z + (size_t)T * 512 * 2;
constexpr size_t EARLY_END = OFF_COEF + (size_t)NR * 8 * 4;
static_assert(EARLY_END <= OFF_RT, "early buffers overflow");
static_assert(OFF_CH + (size_t)NUNITS * REC_BYTES <= CH_END, "chunk records overflow");
static_assert(OFF_CH >= OFF_WD + SZ_WD, "expert weights (written during the scan) must not touch live scan buffers");
static_assert(OFF_MERGED + SZ_HB <= OFF_HB2, "layout");
static_assert(OFF_PRKV % 16 == 0 && OFF_LD % 16 == 0 && OFF_A % 16 == 0 && OFF_CH % 16 == 0 && OFF_HB % 16 == 0 && OFF_L % 16 == 0 && OFF_WIN % 16 == 0 && OFF_G % 16 == 0 && OFF_C % 16 == 0 && OFF_Z % 16 == 0 && OFF_COEF % 16 == 0, "align");

#define GAS __attribute__((address_space(1)))
#define CAS __attribute__((address_space(4)))
struct Params {
    const float* in[37];
    float* out;
    unsigned char* ws;
    int ph_lo, ph_hi;
};
struct ParamsD {
    const GAS float* in[37];
    GAS float* out;
    GAS unsigned char* ws;
    int ph_lo, ph_hi;
};
static_assert(sizeof(Params) == sizeof(ParamsD), "argument views");
struct PPv {
    const CAS ParamsD* k;
    __device__ __forceinline__ const float* gin(int i) const { return (const float*)k->in[i]; }
    __device__ __forceinline__ float* gout() const { return (float*)k->out; }
    __device__ __forceinline__ unsigned char* gws() const { return (unsigned char*)k->ws; }
};
__device__ __forceinline__ PPv getpp() { const CAS ParamsD* k = (const CAS ParamsD*)__builtin_amdgcn_kernarg_segment_ptr(); asm volatile("" : "+s"(k)); return PPv{k}; }

typedef __bf16 bf16x2v __attribute__((ext_vector_type(2)));
__device__ __forceinline__ unsigned cvt_pk_bf16(float lo, float hi) { const f32x2 v = {lo, hi}; return __builtin_bit_cast(unsigned, __builtin_convertvector(v, bf16x2v)); }
__device__ __forceinline__ unsigned pk4_fp8(float a, float b, float c, float d) { int w = __builtin_amdgcn_cvt_pk_fp8_f32(a, b, 0, false); w = __builtin_amdgcn_cvt_pk_fp8_f32(c, d, w, true); return (unsigned)w; }
constexpr float W8_SCALE = 32.0f, W8_INV = 1.0f / 32.0f;
__device__ __forceinline__ bf16_t f2bf(float f) { unsigned u = __float_as_uint(f); u += 0x7FFFu + ((u >> 16) & 1u); return (bf16_t)(u >> 16); }
__device__ __forceinline__ float bf2f(bf16_t b) { return __uint_as_float(((unsigned)b) << 16); }
__device__ __forceinline__ float bflo(unsigned w) { return __uint_as_float(w << 16); }
__device__ __forceinline__ float bfhi(unsigned w) { return __uint_as_float(w & 0xFFFF0000u); }
__device__ __forceinline__ float sigmoidf_(float x) { return __builtin_amdgcn_rcpf(1.0f + __expf(-x)); }
__device__ __forceinline__ float wave_sum(float v) {
#pragma unroll
    for (int o = 32; o >= 1; o >>= 1) v += __shfl_xor(v, o);
    return v;
}
__device__ __forceinline__ float wave_sum_dpp(float v);
__device__ __forceinline__ int prev_row(int row, int d) {
    if (row < NMETA) return row - d >= 0 ? row - d : -1;
    const int s = (row - NMETA) & (SEQ - 1);
    return s >= d ? row - d : NMETA + s - d;
}

constexpr int BM = 256, BK = 64, HALF = 128, HTB = HALF * BK * 2, STAGE_BYTES = 8 * HTB, NXCD = 8, WGM = 8;
__device__ __forceinline__ int lds_byte(int r, int c) { const int st = (r >> 4) * 2 + (c >> 5), rr = r & 15, cc = c & 31, ob = rr * 64 + cc * 2; return st * 1024 + (ob ^ (((ob >> 9) & 1) << 5)); }
__device__ __forceinline__ void stage_rc(int b, int& R, int& C) { const int st = b / 1024, sb = b % 1024, swz = sb ^ (((sb >> 9) & 1) << 5); R = (st >> 1) * 16 + swz / 64; C = (st & 1) * 32 + (swz % 64) / 2; }
__device__ __forceinline__ int perm32(int rho) { const int n = rho >> 4, i = rho & 15; return 8 * (i >> 2) + 4 * n + (i & 3); }

struct Unit { int pm, pn, aux; };

struct StaticOrder {
    const char* A; const char* Bt; int K;
    int nM, nN, nwg, G, c;
    __device__ void init(const void* A_, const void* Bt_, int M, int N, int K_, int G_, int c_) { A = (const char*)A_; Bt = (const char*)Bt_; K = K_; nM = M / BM; nN = N / BM; nwg = nM * nN; G = G_; c = c_; }
    __device__ bool next(int i, Unit& u) const {
        const long L = (long)i * G + c; if (L >= nwg) return false;
        int wgid = (int)L; { const int q = nwg / NXCD, r = nwg % NXCD, xcd = wgid % NXCD, off = wgid / NXCD; wgid = (xcd < r ? xcd * (q + 1) : r * (q + 1) + (xcd - r) * q) + off; }
        const int nig = WGM * nN, gid = wgid / nig, fm = gid * WGM, gsz = (nM - fm) < WGM ? (nM - fm) : WGM;
        u.pm = fm + ((wgid % nig) % gsz); u.pn = (wgid % nig) / gsz; u.aux = 0; return true;
    }
    __device__ __forceinline__ const char* a_ptr(const Unit& u) const { return A + (size_t)u.pm * 256 * K * 2; }
    __device__ __forceinline__ const char* b_ptr(const Unit& u) const { return Bt + (size_t)u.pn * 256 * K * 2; }
    __device__ __forceinline__ int gather_row(const Unit&, int) const { return 0; }
    __device__ __forceinline__ const void* gather_src(const Unit&, int) const { return nullptr; }
};
struct MoeOrder {
    const char* A; const char* Bt; int K; size_t estride;
    const int* tile_e; const int* rowtok; int ntiles, nnt, G, c; bool gather;
    __device__ bool next(int i, Unit& u) const {
        int mt, nt;
        if ((G & 7) == 0 && ((G >> 3) % nnt) == 0) {
            const int x = c & 7, j = c >> 3, per = (G >> 3) / nnt;
            mt = (i * 8 + x) * per + j / nnt; nt = j % nnt;
        } else { const long L = (long)i * G + c; mt = (int)(L / nnt); nt = (int)(L % nnt); }
        if (mt >= ntiles) return false;
        u.pm = mt; u.pn = nt; u.aux = tile_e[mt]; return true;
    }
    __device__ __forceinline__ const char* a_ptr(const Unit& u) const { return gather ? A : A + (size_t)u.pm * 256 * K * 2; }
    __device__ __forceinline__ const char* b_ptr(const Unit& u) const { return Bt + (size_t)u.aux * estride + (size_t)u.pn * 256 * K * 2; }
    __device__ __forceinline__ int gather_row(const Unit& u, int r) const { return rowtok[u.pm * 256 + r]; }
    __device__ __forceinline__ const void* gather_src(const Unit& u, int lane) const { return rowtok + u.pm * 256 + lane * 4; }
};

typedef int i32x4 __attribute__((ext_vector_type(4)));
typedef int i32x8 __attribute__((ext_vector_type(8)));
template <bool GATHER, bool FP8 = false, class Epi, class Sched>
__device__ __forceinline__ void gemm_phase(LAS unsigned char* lds, const int K_, const Sched& S, const Epi& E) {
    int K = K_; asm volatile("" : "+s"(K));
    const int tid = threadIdx.x, wid = __builtin_amdgcn_readfirstlane(tid >> 6), lane = tid & 63, wr = wid >> 2, wc = wid & 3, fr = lane & 15, fq = lane >> 4;
    const int nt = K / BK;
    unsigned voffA[2], voffB[2]; int Rr[2], Cc[2];
#pragma unroll
    for (int i = 0; i < 2; ++i) { int R, C; stage_rc(tid * 16 + i * 8192, R, C); const int Rb = (R & ~31) + perm32(R & 31);
        Rr[i] = R; Cc[i] = C; voffA[i] = (unsigned)(R * K + C) * 2u; voffB[i] = (unsigned)(Rb * K + C) * 2u; }
    const size_t kstep = (size_t)(BK * 2);
    const size_t hstep = (size_t)HALF * K * 2;
    const unsigned ldsw = (unsigned)wid * 1024u;
    const int aoff = lds_byte(wr * 64 + fr, fq * 8), boff = lds_byte(wc * 32 + fr, fq * 8);
    unsigned vgc[2][2], vgn[2][2];
    LAS unsigned char* const parbase = lds + STAGE_BYTES;
    constexpr int NPAR = Epi::NPAR;
#define G_PAR_ISSUE(unit, uidx, hasnx, nxunit) do { \
        LAS unsigned char* _ps = parbase + ((uidx) & 1) * 4096; \
        if (wid < NPAR) __builtin_amdgcn_global_load_lds((const unsigned*)E.par_src(unit, wid, lane), (LAS unsigned*)(_ps + wid * 1024), 16, 0, 0); \
        if (GATHER && (hasnx) && wid == NPAR) __builtin_amdgcn_global_load_lds((const unsigned*)S.gather_src(nxunit, lane), (LAS unsigned*)(_ps + NPAR * 1024), 16, 0, 0); } while (0)
#define G_CAT8(x0, x1) __builtin_shufflevector(__builtin_bit_cast(i32x4, x0), __builtin_bit_cast(i32x4, x1), 0, 1, 2, 3, 4, 5, 6, 7)
#define G_SA(b, h) (((b) * 2 + (h)) * HTB)
#define G_SB(b, h) ((4 + (b) * 2 + (h)) * HTB)
#define G_STAGE(bufoff, gbase, voff) do { _Pragma("unroll") for (int _i = 0; _i < 2; ++_i) \
        __builtin_amdgcn_global_load_lds((const unsigned*)((const char*)(gbase) + (voff)[_i]), (LAS unsigned*)(lds + (bufoff) + ldsw + _i * 8192), 16, 0, 0); } while (0)
#define G_STAGE_A(bufoff, kptr, h, VG) do { if (GATHER) { G_STAGE(bufoff, kptr, VG[h]); } else { G_STAGE(bufoff, (kptr) + (h) * hstep, voffA); } } while (0)
#define G_LDA(dst, b, h) do { _Pragma("unroll") for (int m = 0; m < 4; ++m) { \
        if (FP8) dst##8[m] = G_CAT8(*(const LAS bf16x8*)(lds + G_SA(b, h) + aoff + m * 2048), *(const LAS bf16x8*)(lds + G_SA(b, h) + aoff + m * 2048 + 1024)); \
        else { _Pragma("unroll") for (int k = 0; k < 2; ++k) dst[m][k] = *(const LAS bf16x8*)(lds + G_SA(b, h) + aoff + m * 2048 + k * 1024); } } } while (0)
#define G_LDB(dst, b, h) do { _Pragma("unroll") for (int n = 0; n < 2; ++n) { \
        if (FP8) dst##8[n] = G_CAT8(*(const LAS bf16x8*)(lds + G_SB(b, h) + boff + n * 2048), *(const LAS bf16x8*)(lds + G_SB(b, h) + boff + n * 2048 + 1024)); \
        else { _Pragma("unroll") for (int k = 0; k < 2; ++k) dst[n][k] = *(const LAS bf16x8*)(lds + G_SB(b, h) + boff + n * 2048 + k * 1024); } } } while (0)
#define G_MMA(ai, bj, At, Bt) do { __builtin_amdgcn_s_setprio(1); _Pragma("unroll") for (int m = 0; m < 4; ++m) _Pragma("unroll") for (int n = 0; n < 2; ++n) { \
        if (FP8) asm volatile("v_mfma_scale_f32_16x16x128_f8f6f4 %0, %1, %2, %0, %3, %3 op_sel_hi:[0,0,0]" : "+v"(acc[ai][bj][m][n]) : "v"(Bt##8[n]), "v"(At##8[m]), "v"(sc8)); \
        else { _Pragma("unroll") for (int k = 0; k < 2; ++k) acc[ai][bj][m][n] = __builtin_amdgcn_mfma_f32_16x16x32_bf16(Bt[n][k], At[m][k], acc[ai][bj][m][n], 0, 0, 0); } } \
        __builtin_amdgcn_s_setprio(0); } while (0)
#define G_WAIT_V(n) asm volatile("s_waitcnt vmcnt(" #n ")" ::: "memory")
#define G_WAIT_L(n) asm volatile("s_waitcnt lgkmcnt(" #n ")" ::: "memory")
#define G_BAR __builtin_amdgcn_s_barrier()
#define G_SCHED __builtin_amdgcn_sched_barrier(0)
    Unit cur, nxt;
    int ui = 0;
    if (!S.next(0, cur)) return;
    f32x4 acc[2][2][4][2];
#pragma unroll
    for (int a = 0; a < 2; ++a)
#pragma unroll
        for (int b = 0; b < 2; ++b)
#pragma unroll
            for (int m = 0; m < 4; ++m)
#pragma unroll
                for (int n = 0; n < 2; ++n) acc[a][b][m][n] = (f32x4){0.f, 0.f, 0.f, 0.f};
    bf16x8 At[4][2], B0[2][2], B1[2][2];
    i32x8 At8[4], B08[2], B18[2];
    int sc8 = 0x7F7F7F7F; asm volatile("" : "+v"(sc8));
    const char* cA = S.a_ptr(cur); const char* cB = S.b_ptr(cur);
    if (GATHER) {
#pragma unroll
        for (int h = 0; h < 2; ++h)
#pragma unroll
            for (int i = 0; i < 2; ++i) vgc[h][i] = (unsigned)(S.gather_row(cur, h * HALF + Rr[i]) * K + Cc[i]) * 2u;
    }
    { Unit n1; const bool hn1 = S.next(1, n1); G_PAR_ISSUE(cur, 0, hn1, n1); }
    G_STAGE(G_SB(0, 0), cB, voffB); G_STAGE_A(G_SA(0, 0), cA, 0, vgc); G_STAGE(G_SB(0, 1), cB + hstep, voffB); G_STAGE_A(G_SA(0, 1), cA, 1, vgc);
    if (wr == 1) G_BAR;
    G_WAIT_V(4); G_BAR;
    G_STAGE(G_SB(1, 0), cB + kstep, voffB); G_STAGE_A(G_SA(1, 0), cA + kstep, 0, vgc); G_STAGE(G_SB(1, 1), cB + hstep + kstep, voffB);
    G_WAIT_V(6); G_BAR;
    for (;;) {
        const bool has_next = S.next(ui + 1, nxt);
        const char* nA = has_next ? S.a_ptr(nxt) : cA; const char* nB = has_next ? S.b_ptr(nxt) : cB;
        if (ui > 0) G_PAR_ISSUE(cur, ui, has_next, nxt);
        if (GATHER) {
#pragma unroll
            for (int h = 0; h < 2; ++h)
#pragma unroll
                for (int i = 0; i < 2; ++i) vgn[h][i] = vgc[h][i];
        }
        for (int t = 0; t < nt; t += 2) {
            const bool last = (t == nt - 2);
            const char* a1 = cA + (size_t)(t + 1) * kstep;
            const char* a2 = last ? nA : cA + (size_t)(t + 2) * kstep; const char* b2 = last ? nB : cB + (size_t)(t + 2) * kstep;
            const char* a3 = a2 + kstep; const char* b3 = b2 + kstep;
            unsigned vg2[2][2];
            if (GATHER) {
#pragma unroll
                for (int h = 0; h < 2; ++h)
#pragma unroll
                    for (int i = 0; i < 2; ++i) vg2[h][i] = last ? vgn[h][i] : vgc[h][i];
            }
            G_LDB(B0, 0, 0); G_SCHED; G_LDA(At, 0, 0); G_STAGE_A(G_SA(1, 1), a1, 1, vgc);
            G_WAIT_L(8); G_BAR; G_WAIT_L(0); G_MMA(0, 0, At, B0); G_BAR; G_SCHED;
            G_LDB(B1, 0, 1); G_STAGE(G_SB(0, 0), b2, voffB);
            G_BAR; G_WAIT_L(0); G_MMA(0, 1, At, B1); G_BAR;
            G_LDA(At, 0, 1); G_STAGE_A(G_SA(0, 0), a2, 0, vg2);
            G_BAR; G_WAIT_L(0); G_MMA(1, 0, At, B0); G_BAR; G_SCHED;
            G_STAGE(G_SB(0, 1), b2 + hstep, voffB);
            G_WAIT_V(6); G_BAR; G_MMA(1, 1, At, B1); G_BAR;
            G_LDB(B0, 1, 0); G_SCHED; G_LDA(At, 1, 0); G_STAGE_A(G_SA(0, 1), a2, 1, vg2);
            G_WAIT_L(8); G_BAR; G_WAIT_L(0); G_MMA(0, 0, At, B0); G_BAR; G_SCHED;
            G_LDB(B1, 1, 1); G_STAGE(G_SB(1, 0), b3, voffB);
            G_BAR; G_WAIT_L(0); G_MMA(0, 1, At, B1); G_BAR;
            G_LDA(At, 1, 1); G_STAGE_A(G_SA(1, 0), a3, 0, vg2);
            G_BAR; G_WAIT_L(0); G_MMA(1, 0, At, B0); G_BAR; G_SCHED;
            G_STAGE(G_SB(1, 1), b3 + hstep, voffB);
            G_WAIT_V(6); G_BAR; G_MMA(1, 1, At, B1); G_BAR;
            if (GATHER && t == 0 && has_next) {
                const LAS int* rows = (const LAS int*)(parbase + (ui & 1) * 4096 + NPAR * 1024);
#pragma unroll
                for (int h = 0; h < 2; ++h)
#pragma unroll
                    for (int i = 0; i < 2; ++i) vgn[h][i] = (unsigned)(rows[h * HALF + Rr[i]] * K + Cc[i]) * 2u;
            }
        }
        if (FP8) asm volatile("s_nop 15\n\ts_nop 15" ::: "memory");
        const bool keep_acc = E(acc, cur, wr, wc, fr, fq, (const LAS unsigned char*)(parbase + (ui & 1) * 4096));
        if (!has_next) break;
        if (!keep_acc)
#pragma unroll
        for (int a = 0; a < 2; ++a)
#pragma unroll
            for (int b = 0; b < 2; ++b)
#pragma unroll
                for (int m = 0; m < 4; ++m)
#pragma unroll
                    for (int n = 0; n < 2; ++n) acc[a][b][m][n] = (f32x4){0.f, 0.f, 0.f, 0.f};
        cur = nxt; cA = nA; cB = nB; ++ui;
        if (GATHER) {
#pragma unroll
            for (int h = 0; h < 2; ++h)
#pragma unroll
                for (int i = 0; i < 2; ++i) vgc[h][i] = vgn[h][i];
        }
    }
    G_WAIT_V(0);
    if (wr == 0) G_BAR;
    G_BAR;
#undef G_PAR_ISSUE
#undef G_SA
#undef G_SB
#undef G_STAGE
#undef G_STAGE_A
#undef G_LDA
#undef G_LDB
#undef G_MMA
#undef G_CAT8
#undef G_WAIT_V
#undef G_WAIT_L
#undef G_BAR
#undef G_SCHED
}

struct EpiProj {
    bf16_t* prkv; bf16_t* pconv; bf16_t* gates; const float* rstd1;
    static constexpr int NPAR = 1;
    __device__ __forceinline__ const void* par_src(const Unit& u, int, int lane) const { return rstd1 + NMETA + u.pm * BM + lane * 4; }
    __device__ __forceinline__ bool operator()(const f32x4 (&acc)[2][2][4][2], const Unit& u, int wr, int wc, int fr, int fq, const LAS unsigned char* par) const {
        const int row0 = u.pm * BM + wr * 64 + fr;
        const bool isg = u.pn >= 14;
        float rsv[2][4];
#pragma unroll
        for (int ai = 0; ai < 2; ++ai)
#pragma unroll
            for (int m = 0; m < 4; ++m) rsv[ai][m] = ((const LAS float*)par)[wr * 64 + fr + ai * HALF + m * 16];
#pragma unroll
        for (int ai = 0; ai < 2; ++ai)
#pragma unroll
            for (int m = 0; m < 4; ++m) {
                const int row = row0 + ai * HALF + m * 16;
                const float rs = isg ? rsv[ai][m] * -1.44269504089f : rsv[ai][m]; const f32x2 rs2 = {rs, rs}, one2 = {1.0f, 1.0f};
                bf16_t* rowp = isg ? gates + (size_t)row * 2048 + (u.pn - 14) * 256 + wc * 32 + 8 * fq
                             : (u.pn < 6 ? prkv + (size_t)(NMETA + row) * 1536 + u.pn * 256 : pconv + (size_t)(NMETA + row) * 2048 + (u.pn - 6) * 256) + wc * 32 + 8 * fq;
#pragma unroll
                for (int bj = 0; bj < 2; ++bj) {
                    const f32x4 a0 = acc[ai][bj][m][0], a1 = acc[ai][bj][m][1];
                    f32x2 p[4] = {LO2(a0) * rs2, HI2(a0) * rs2, LO2(a1) * rs2, HI2(a1) * rs2};
                    if (isg) {
#pragma unroll
                        for (int q = 0; q < 4; ++q) { const f32x2 e = {__builtin_amdgcn_exp2f(p[q][0]), __builtin_amdgcn_exp2f(p[q][1])}; const f32x2 d = e + one2; p[q] = (f32x2){__builtin_amdgcn_rcpf(d[0]), __builtin_amdgcn_rcpf(d[1])}; }
                    }
                    u32x4 w; w.x = cvt_pk_bf16(p[0][0], p[0][1]); w.y = cvt_pk_bf16(p[1][0], p[1][1]); w.z = cvt_pk_bf16(p[2][0], p[2][1]); w.w = cvt_pk_bf16(p[3][0], p[3][1]);
                    *(u32x4*)(rowp + bj * HALF) = w;
                }
            }
        return false;
    }
};
struct EpiL {
    static constexpr int NPAR = 0;
    __device__ __forceinline__ const void* par_src(const Unit&, int, int) const { return nullptr; }
    unsigned char* wsb; const float* w0; const float* a0;
    __device__ __forceinline__ bool operator()(const f32x4 (&acc)[2][2][4][2], const Unit& u, int wr, int wc, int fr, int fq, const LAS unsigned char* par) const {
        const int row0 = NMETA + u.pm * BM + wr * 64 + fr;
        const int seg = u.pn >> 1;
        const int cb = (u.pn & 1) * 256 + wc * 32 + 8 * fq;
        const float* bias = seg == 0 ? w0 : a0;
        f32x4 bv[2][2];
#pragma unroll
        for (int bj = 0; bj < 2; ++bj) {
            bv[bj][0] = seg < 2 ? *(const f32x4*)(bias + cb + bj * HALF) : (f32x4){0.f, 0.f, 0.f, 0.f};
            bv[bj][1] = seg < 2 ? *(const f32x4*)(bias + cb + bj * HALF + 4) : (f32x4){0.f, 0.f, 0.f, 0.f};
        }
        const float sc = seg == 0 ? -0.60653065971f : 1.0f;
        bf16_t* ob = (bf16_t*)(wsb + (seg == 0 ? OFF_LD : seg == 1 ? OFF_A : OFF_G));
#pragma unroll
        for (int ai = 0; ai < 2; ++ai)
#pragma unroll
            for (int m = 0; m < 4; ++m) {
                const int row = row0 + ai * HALF + m * 16;
#pragma unroll
                for (int bj = 0; bj < 2; ++bj) {
                    const int c = cb + bj * HALF;
                    f32x4 v0 = acc[ai][bj][m][0] + bv[bj][0], v1 = acc[ai][bj][m][1] + bv[bj][1];
                    if (seg < 2) {
#pragma unroll
                        for (int j = 0; j < 4; ++j) { v0[j] = sc * sigmoidf_(v0[j]); v1[j] = sc * sigmoidf_(v1[j]); }
                    }
                    {
                        u32x4 w; w.x = cvt_pk_bf16(v0[0], v0[1]); w.y = cvt_pk_bf16(v0[2], v0[3]); w.z = cvt_pk_bf16(v1[0], v1[1]); w.w = cvt_pk_bf16(v1[2], v1[3]);
                        *(u32x4*)(ob + (size_t)row * 512 + c) = w;
                    }
                }
            }
        return false;
    }
};
template <int SECOND> struct EpiMerge {
    static constexpr int NPAR = 0;
    __device__ __forceinline__ const void* par_src(const Unit&, int, int) const { return nullptr; }
    bf16_t* merged; const bf16_t* gates;
    __device__ __forceinline__ bool operator()(const f32x4 (&acc)[2][2][4][2], const Unit& u, int wr, int wc, int fr, int fq, const LAS unsigned char* par) const {
        const int row0 = u.pm * BM + wr * 64 + fr, col0 = u.pn * BM + wc * 32 + 8 * fq;
#pragma unroll
        for (int ai = 0; ai < 2; ++ai)
#pragma unroll
            for (int m = 0; m < 4; ++m) {
                const int row = row0 + ai * HALF + m * 16;
#pragma unroll
                for (int bj = 0; bj < 2; ++bj) {
                    const int c = col0 + bj * HALF;
                    const u32x4 gw = *(const u32x4*)(gates + (size_t)row * 2048 + SECOND * 1024 + c);
                    f32x4 g0 = (f32x4){bflo(gw.x), bfhi(gw.x), bflo(gw.y), bfhi(gw.y)}, g1 = (f32x4){bflo(gw.z), bfhi(gw.z), bflo(gw.w), bfhi(gw.w)};
                    f32x4 v0 = acc[ai][bj][m][0] * g0, v1 = acc[ai][bj][m][1] * g1;
                    bf16_t* p = merged + (size_t)row * 1024 + c;
                    if (SECOND) {
                        const u32x4 ow = *(const u32x4*)p;
                        v0 += (f32x4){bflo(ow.x), bfhi(ow.x), bflo(ow.y), bfhi(ow.y)}; v1 += (f32x4){bflo(ow.z), bfhi(ow.z), bflo(ow.w), bfhi(ow.w)};
                    }
                    u32x4 w; w.x = cvt_pk_bf16(v0[0], v0[1]); w.y = cvt_pk_bf16(v0[2], v0[3]); w.z = cvt_pk_bf16(v1[0], v1[1]); w.w = cvt_pk_bf16(v1[2], v1[3]);
                    *(u32x4*)p = w;
                }
            }
        return false;
    }
};
struct MergeOrder {
    StaticOrder so; const char* A1; const char* B1;
    __device__ bool next(int i, Unit& u) const { const bool ok = so.next(i >> 1, u); u.aux = i & 1; return ok; }
    __device__ __forceinline__ const char* a_ptr(const Unit& u) const { return (u.aux ? A1 : so.A) + (size_t)u.pm * 256 * so.K * 2; }
    __device__ __forceinline__ const char* b_ptr(const Unit& u) const { return (u.aux ? B1 : so.Bt) + (size_t)u.pn * 256 * so.K * 2; }
    __device__ __forceinline__ int gather_row(const Unit&, int) const { return 0; }
    __device__ __forceinline__ const void* gather_src(const Unit&, int) const { return nullptr; }
};
struct EpiMergeFused {
    static constexpr int NPAR = 0;
    __device__ __forceinline__ const void* par_src(const Unit&, int, int) const { return nullptr; }
    bf16_t* merged; const bf16_t* gates;
    __device__ __forceinline__ bool operator()(f32x4 (&acc)[2][2][4][2], const Unit& u, int wr, int wc, int fr, int fq, const LAS unsigned char* par) const {
        const int row0 = u.pm * BM + wr * 64 + fr, col0 = u.pn * BM + wc * 32 + 8 * fq;
#pragma unroll
        for (int ai = 0; ai < 2; ++ai) {
            u32x4 gbw[4][2], gaw[4][2];
#pragma unroll
            for (int m = 0; m < 4; ++m)
#pragma unroll
                for (int bj = 0; bj < 2; ++bj) {
                    const bf16_t* gp = gates + (size_t)(row0 + ai * HALF + m * 16) * 2048 + col0 + bj * HALF;
                    gbw[m][bj] = *(const u32x4*)(gp + 1024);
                    gaw[m][bj] = u.aux == 0 ? *(const u32x4*)gp : (u32x4){0u, 0u, 0u, 0u};
                }
#pragma unroll
            for (int m = 0; m < 4; ++m)
#pragma unroll
                for (int bj = 0; bj < 2; ++bj) {
                    const int row = row0 + ai * HALF + m * 16, c = col0 + bj * HALF;
                    f32x2 gbp[4], res[4];
#pragma unroll
                    for (int q = 0; q < 4; ++q) { const unsigned wq = gbw[m][bj][q]; gbp[q] = (f32x2){fmaxf(bflo(wq), 1e-6f), fmaxf(bfhi(wq), 1e-6f)}; }
                    if (u.aux == 0) {
#pragma unroll
                        for (int q = 0; q < 4; ++q) {
                            const unsigned wq = gaw[m][bj][q];
                            const f32x2 gap = {bflo(wq), bfhi(wq)}, rc = {__builtin_amdgcn_rcpf(gbp[q][0]), __builtin_amdgcn_rcpf(gbp[q][1])};
                            const f32x2 sc = gap * rc;
                            f32x4& a4 = acc[ai][bj][m][q >> 1];
                            if (q & 1) { const f32x2 t = HI2(a4) * sc; a4[2] = t[0]; a4[3] = t[1]; } else { const f32x2 t = LO2(a4) * sc; a4[0] = t[0]; a4[1] = t[1]; }
                        }
                    } else {
#pragma unroll
                        for (int q = 0; q < 4; ++q) { const f32x4 a4 = acc[ai][bj][m][q >> 1]; res[q] = ((q & 1) ? HI2(a4) : LO2(a4)) * gbp[q]; }
                        u32x4 w; w.x = cvt_pk_bf16(res[0][0], res[0][1]); w.y = cvt_pk_bf16(res[1][0], res[1][1]); w.z = cvt_pk_bf16(res[2][0], res[2][1]); w.w = cvt_pk_bf16(res[3][0], res[3][1]);
                        *(u32x4*)(merged + (size_t)row * 1024 + c) = w;
                    }
                }
        }
        return u.aux == 0;
    }
};
struct EpiO {
    static constexpr int NPAR = 0;
    __device__ __forceinline__ const void* par_src(const Unit&, int, int) const { return nullptr; }
    const float* x; float* h1; bf16_t* hb2; unsigned char* hb8;
    __device__ __forceinline__ bool operator()(const f32x4 (&acc)[2][2][4][2], const Unit& u, int wr, int wc, int fr, int fq, const LAS unsigned char* par) const {
        const int row0 = u.pm * BM + wr * 64 + fr, col0 = u.pn * BM + wc * 32 + 8 * fq;
#pragma unroll
        for (int ai = 0; ai < 2; ++ai) {
            f32x4 xv[4][2][2];
#pragma unroll
            for (int m = 0; m < 4; ++m)
#pragma unroll
                for (int bj = 0; bj < 2; ++bj) {
                    const size_t o = (size_t)(row0 + ai * HALF + m * 16) * 1024 + col0 + bj * HALF;
                    xv[m][bj][0] = *(const f32x4*)(x + o); xv[m][bj][1] = *(const f32x4*)(x + o + 4);
                }
#pragma unroll
            for (int m = 0; m < 4; ++m)
#pragma unroll
                for (int bj = 0; bj < 2; ++bj) {
                    const size_t o = (size_t)(row0 + ai * HALF + m * 16) * 1024 + col0 + bj * HALF;
                    const f32x4 a0 = acc[ai][bj][m][0], a1 = acc[ai][bj][m][1];
                    const f32x2 p0 = LO2(a0) + LO2(xv[m][bj][0]), p1 = HI2(a0) + HI2(xv[m][bj][0]), p2 = LO2(a1) + LO2(xv[m][bj][1]), p3 = HI2(a1) + HI2(xv[m][bj][1]);
                    u32x4 w; w.x = cvt_pk_bf16(p0[0], p0[1]); w.y = cvt_pk_bf16(p1[0], p1[1]); w.z = cvt_pk_bf16(p2[0], p2[1]); w.w = cvt_pk_bf16(p3[0], p3[1]);
                    *(u32x4*)(hb2 + o) = w;
                    u32x2 w8; w8.x = pk4_fp8(p0[0], p0[1], p1[0], p1[1]); w8.y = pk4_fp8(p2[0], p2[1], p3[0], p3[1]);
                    *(u32x2*)(hb8 + o) = w8;
                }
        }
        return false;
    }
};
struct EpiMoe1 {
    unsigned char* act; const float* rowrs; const float* bg; const float* bu;
    static constexpr int NPAR = 2;
    __device__ __forceinline__ const void* par_src(const Unit& u, int piece, int lane) const {
        if (piece == 0) return rowrs + u.pm * BM + lane * 4;
        return (lane < 32 ? bg : bu) + (size_t)u.aux * DFF + u.pn * 128 + (lane & 31) * 4;
    }
    __device__ __forceinline__ bool operator()(const f32x4 (&acc)[2][2][4][2], const Unit& u, int wr, int wc, int fr, int fq, const LAS unsigned char* par) const {
        const int row0 = u.pm * BM + wr * 64 + fr, ff0 = u.pn * 128 + wc * 32 + 8 * fq;
        const LAS float* bgp = (const LAS float*)(par + 1024) + wc * 32 + 8 * fq; const LAS float* bup = bgp + 128;
        const f32x4 bg0 = *(const LAS f32x4*)bgp, bg1 = *(const LAS f32x4*)(bgp + 4), bu0 = *(const LAS f32x4*)bup, bu1 = *(const LAS f32x4*)(bup + 4);
        const f32x2 bgv[4] = {LO2(bg0), HI2(bg0), LO2(bg1), HI2(bg1)}, buv[4] = {LO2(bu0), HI2(bu0), LO2(bu1), HI2(bu1)};
        const f32x2 one2 = {1.0f, 1.0f}, kexp = {-1.702f * 1.44269504089f, -1.702f * 1.44269504089f};
        float rsv[2][4];
#pragma unroll
        for (int ai = 0; ai < 2; ++ai)
#pragma unroll
            for (int m = 0; m < 4; ++m) rsv[ai][m] = ((const LAS float*)par)[wr * 64 + fr + ai * HALF + m * 16];
#pragma unroll
        for (int ai = 0; ai < 2; ++ai)
#pragma unroll
            for (int m = 0; m < 4; ++m) {
                const int row = row0 + ai * HALF + m * 16;
                const float rs = rsv[ai][m] * W8_INV;
                const f32x2 rs2 = {rs, rs};
                f32x2 res[4];
#pragma unroll
                for (int q = 0; q < 4; ++q) {
                    const f32x4 ag4 = acc[ai][0][m][q >> 1], au4 = acc[ai][1][m][q >> 1];
                    const f32x2 ag = (q & 1) ? HI2(ag4) : LO2(ag4), au = (q & 1) ? HI2(au4) : LO2(au4);
                    const f32x2 g = ag * rs2 + bgv[q], uu = au * rs2 + buv[q];
                    const f32x2 gt = {fminf(g[0], 7.0f), fminf(g[1], 7.0f)};
                    const f32x2 up = {fminf(fmaxf(uu[0], -7.0f), 7.0f), fminf(fmaxf(uu[1], -7.0f), 7.0f)};
                    const f32x2 z = gt * kexp;
                    const f32x2 e = {__builtin_amdgcn_exp2f(z[0]), __builtin_amdgcn_exp2f(z[1])};
                    const f32x2 d = e + one2;
                    const f32x2 sg = {__builtin_amdgcn_rcpf(d[0]), __builtin_amdgcn_rcpf(d[1])};
                    res[q] = ((up + one2) * gt) * sg;
                }
                u32x2 w; w.x = pk4_fp8(res[0][0], res[0][1], res[1][0], res[1][1]); w.y = pk4_fp8(res[2][0], res[2][1], res[3][0], res[3][1]);
                *(u32x2*)(act + (size_t)row * DFF + ff0) = w;
            }
        return false;
    }
};
struct EpiMoe2 {
    unsigned char* y8; const int* rowslot; const float* roww; const float* bd;
    static constexpr int NPAR = 3;
    __device__ __forceinline__ const void* par_src(const Unit& u, int piece, int lane) const {
        if (piece == 0) return rowslot + u.pm * BM + lane * 4;
        if (piece == 1) return roww + u.pm * BM + lane * 4;
        return bd + (size_t)u.aux * D + u.pn * BM + lane * 4;
    }
    __device__ __forceinline__ bool operator()(const f32x4 (&acc)[2][2][4][2], const Unit& u, int wr, int wc, int fr, int fq, const LAS unsigned char* par) const {
        const int row0 = u.pm * BM + wr * 64 + fr, col0 = u.pn * BM + wc * 32 + 8 * fq;
        const LAS float* bp = (const LAS float*)(par + 2048) + wc * 32 + 8 * fq;
        f32x4 bv[2][2];
#pragma unroll
        for (int bj = 0; bj < 2; ++bj) { bv[bj][0] = *(const LAS f32x4*)(bp + bj * HALF); bv[bj][1] = *(const LAS f32x4*)(bp + bj * HALF + 4); }
        int slotv[2][4]; float wv8[2][4];
#pragma unroll
        for (int ai = 0; ai < 2; ++ai)
#pragma unroll
            for (int m = 0; m < 4; ++m) { const int rl = wr * 64 + fr + ai * HALF + m * 16; slotv[ai][m] = ((const LAS int*)par)[rl]; wv8[ai][m] = ((const LAS float*)(par + 1024))[rl]; }
#pragma unroll
        for (int ai = 0; ai < 2; ++ai)
#pragma unroll
            for (int m = 0; m < 4; ++m) {
                const int slot = slotv[ai][m];
                if (slot >= 0) {
                    const float w8 = wv8[ai][m]; const f32x2 w2 = {w8, w8}, inv2 = {W8_INV, W8_INV};
#pragma unroll
                    for (int bj = 0; bj < 2; ++bj) {
                        const f32x4 a0 = acc[ai][bj][m][0], a1 = acc[ai][bj][m][1];
                        const f32x2 p0 = (LO2(a0) * inv2 + LO2(bv[bj][0])) * w2, p1 = (HI2(a0) * inv2 + HI2(bv[bj][0])) * w2, p2 = (LO2(a1) * inv2 + LO2(bv[bj][1])) * w2, p3 = (HI2(a1) * inv2 + HI2(bv[bj][1])) * w2;
                        u32x2 w; w.x = pk4_fp8(p0[0], p0[1], p1[0], p1[1]); w.y = pk4_fp8(p2[0], p2[1], p3[0], p3[1]);
                        *(u32x2*)(y8 + (size_t)slot * 1024 + col0 + bj * HALF) = w;
                    }
                }
            }
        return false;
    }
};

__device__ __forceinline__ void transpose_tile(LAS float* tile, const float* src, int ldsrc, int k0, int n0, bf16_t* dst, int ldd, int drow0, const float* sa, const float* mu, int mode, bool zero) {
    const int tid = threadIdx.x;
    if (!zero) {
#pragma unroll
        for (int i = 0; i < 2; ++i) {
            const int r = (tid >> 4) + 32 * i, c4 = (tid & 15) * 4;
            const f32x4 v = *(const f32x4*)(src + (size_t)(k0 + r) * ldsrc + n0 + c4);
            LAS float* t = tile + r * 65 + c4;
            t[0] = v[0]; t[1] = v[1]; t[2] = v[2]; t[3] = v[3];
        }
    }
    __syncthreads();
    {
        const int n = tid >> 3, kq = tid & 7;
        float v[8];
#pragma unroll
        for (int j = 0; j < 8; ++j) {
            const int k = k0 + 8 * kq + j;
            float s = sa ? sa[k] : 1.0f;
            if (mode == 1) s *= (1.0f - mu[k]);
            if (mode == 2) s *= mu[k];
            v[j] = zero ? 0.f : tile[(8 * kq + j) * 65 + n] * s;
        }
        u32x4 w; w.x = cvt_pk_bf16(v[0], v[1]); w.y = cvt_pk_bf16(v[2], v[3]); w.z = cvt_pk_bf16(v[4], v[5]); w.w = cvt_pk_bf16(v[6], v[7]);
        *(u32x4*)(dst + (size_t)(drow0 + n) * ldd + k0 + 8 * kq) = w;
    }
    __syncthreads();
}

__device__ __forceinline__ void phase_prep(const PPv& p, LAS unsigned char* lds) {
    const int tid = threadIdx.x, bid = blockIdx.x, nb = gridDim.x, lane = tid & 63, wave = tid >> 6;
    unsigned char* ws = p.gws();
    const float* x = p.gin(0); const float* meta = p.gin(1); const float* g1 = p.gin(2);
    if (bid == 0 && tid < 64) ((int*)(ws + OFF_GCNT))[tid] = 0;
    {
        bf16_t* HB = (bf16_t*)(ws + OFF_HB); float* rstd1 = (float*)(ws + OFF_RSTD1);
        for (int row0 = (bid * 8 + wave) * 4; row0 < NR; row0 += nb * 32) {
            f32x4 v[4][4];
#pragma unroll
            for (int u = 0; u < 4; ++u) {
                const int row = row0 + u < NR ? row0 + u : NR - 1;
                const float* src = row < NMETA ? meta + (size_t)row * D : x + (size_t)(row - NMETA) * D;
#pragma unroll
                for (int i = 0; i < 4; ++i) v[u][i] = __builtin_nontemporal_load((const f32x4*)(src + i * 256 + lane * 4));
            }
#pragma unroll
            for (int u = 0; u < 4; ++u) {
                const int row = row0 + u;
                if (row < NR) {
                    float ss = 0.f;
#pragma unroll
                    for (int i = 0; i < 4; ++i) ss += v[u][i][0] * v[u][i][0] + v[u][i][1] * v[u][i][1] + v[u][i][2] * v[u][i][2] + v[u][i][3] * v[u][i][3];
                    ss = wave_sum_dpp(ss);
                    if (lane == 0) rstd1[row] = rsqrtf(ss * (1.0f / D) + NORM_EPS);
                    if (row >= NMETA) {
                        bf16_t* d = HB + (size_t)(row - NMETA) * D;
#pragma unroll
                        for (int i = 0; i < 4; ++i) { u32x2 w; w.x = cvt_pk_bf16(v[u][i][0], v[u][i][1]); w.y = cvt_pk_bf16(v[u][i][2], v[u][i][3]); *(u32x2*)(d + i * 256 + lane * 4) = w; }
                    }
                }
            }
        }
    }
    LAS float* tile = (LAS float*)lds;
    {
        bf16_t* WIN = (bf16_t*)(ws + OFF_WIN);
        const float* w_in = p.gin(3);
        for (int j = bid; j < 16 * 88; j += nb) {
            const int kt = j & 15, ntile = j >> 4, n0 = ntile * 64;
            const float* src; int ld, sn0, mode = 0; const float* mu = nullptr;
            if (n0 < 3072) { src = w_in; ld = 5120; sn0 = n0; }
            else if (n0 < 3584) {
                const int seg = (n0 - 3072) >> 6;
                if (seg < 2) { src = p.gin(11); ld = 64; sn0 = 0; mu = p.gin(7); mode = 1 + seg; }
                else if (seg < 4) { src = p.gin(14); ld = 64; sn0 = 0; mu = p.gin(8); mode = 1 + (seg - 2); }
                else { src = p.gin(16); ld = 128; sn0 = (seg & 1) * 64; mu = p.gin(9); mode = seg < 6 ? 1 : 2; }
            } else { src = w_in; ld = 5120; sn0 = n0 - 512; }
            transpose_tile(tile, src, ld, kt * 64, sn0, WIN, 1024, n0, g1, mu, mode, false);
        }
        for (int j = bid; j < 2 * 128; j += nb) {
            const int which = j >> 7, jj = j & 127, kt = jj & 7, ntile = jj >> 3;
            transpose_tile(tile, which ? p.gin(25) : p.gin(23), 1024, kt * 64, ntile * 64, (bf16_t*)(ws + (which ? OFF_WC : OFF_WR)), 512, ntile * 64, nullptr, nullptr, 0, false);
        }
        for (int j = bid; j < 256; j += nb) {
            const int kt = j & 15, ntile = j >> 4;
            transpose_tile(tile, p.gin(26), 1024, kt * 64, ntile * 64, (bf16_t*)(ws + OFF_WO), 1024, ntile * 64, nullptr, nullptr, 0, false);
        }
        for (int j = bid; j < 96; j += nb) {
            const int kt = j & 3, ntile = j >> 2, seg = ntile >> 3, nn0 = (ntile & 7) * 64;
            const float* src = nullptr; int sk0 = 0; bool zero = true;
            if (seg == 0 && kt == 0) { src = p.gin(12); sk0 = 0; zero = false; }
            if (seg == 1 && kt == 1) { src = p.gin(15); sk0 = 0; zero = false; }
            if (seg == 2 && kt >= 2) { src = p.gin(17); sk0 = (kt - 2) * 64; zero = false; }
            const float* srcs = zero ? p.gin(12) : src + (size_t)(sk0 - kt * 64) * 512;
            transpose_tile(tile, srcs, 512, kt * 64, nn0, (bf16_t*)(ws + OFF_W2), 256, ntile * 64, nullptr, nullptr, 0, zero);
        }
        {
            float* WRG = (float*)(ws + OFF_WRG); const float* g2 = p.gin(27); const float* wr_ = p.gin(28);
            for (int i = bid * 512 + tid; i < 1024 * 32; i += nb * 512) WRG[i] = g2[i >> 5] * wr_[i];
        }
    }
}

__device__ __forceinline__ void phase_meta_proj(const PPv& p, LAS unsigned char* lds) {
    const int tid = threadIdx.x, bid = blockIdx.x, lane = tid & 63, wave = tid >> 6;
    unsigned char* ws = p.gws();
    LAS float* sm = (LAS float*)lds;
    const float* meta = p.gin(1);
    for (int i = tid; i < 16 * 256; i += 512) { const int r = i >> 8, c4 = (i & 255) * 4; const f32x4 v = *(const f32x4*)(meta + r * 1024 + c4); LAS float* d = sm + r * 1028 + c4; d[0] = v[0]; d[1] = v[1]; d[2] = v[2]; d[3] = v[3]; }
    __syncthreads();
    const float* rstd1 = (const float*)(ws + OFF_RSTD1);
    for (int nbase = bid * 14; nbase < PCOLS1; nbase += gridDim.x * 14) {
        for (int nn = wave; nn < 14; nn += 8) {
            const int n = nbase + nn;
            if (n >= PCOLS1) break;
            const bf16_t* wrow = (const bf16_t*)(ws + OFF_WIN) + (size_t)n * 1024;
            const u32x4 w0 = *(const u32x4*)(wrow + 8 * lane), w1 = *(const u32x4*)(wrow + 512 + 8 * lane);
            const float wf[16] = {bflo(w0.x), bfhi(w0.x), bflo(w0.y), bfhi(w0.y), bflo(w0.z), bfhi(w0.z), bflo(w0.w), bfhi(w0.w),
                                  bflo(w1.x), bfhi(w1.x), bflo(w1.y), bfhi(w1.y), bflo(w1.z), bfhi(w1.z), bflo(w1.w), bfhi(w1.w)};
            float outv = 0.f;
#pragma unroll
            for (int pr = 0; pr < 16; ++pr) {
                const LAS float* m0 = sm + pr * 1028 + 8 * lane;
                const f32x4 a0 = *(const LAS f32x4*)m0, a1 = *(const LAS f32x4*)(m0 + 4), a2 = *(const LAS f32x4*)(m0 + 512), a3 = *(const LAS f32x4*)(m0 + 516);
                float acc = a0[0] * wf[0] + a0[1] * wf[1] + a0[2] * wf[2] + a0[3] * wf[3] + a1[0] * wf[4] + a1[1] * wf[5] + a1[2] * wf[6] + a1[3] * wf[7]
                          + a2[0] * wf[8] + a2[1] * wf[9] + a2[2] * wf[10] + a2[3] * wf[11] + a3[0] * wf[12] + a3[1] * wf[13] + a3[2] * wf[14] + a3[3] * wf[15];
                acc = wave_sum_dpp(acc);
                outv = (lane == pr) ? acc * rstd1[pr] : outv;
            }
            if (lane < 16) {
                if (n < 1536) ((bf16_t*)(ws + OFF_PRKV))[(size_t)lane * 1536 + n] = f2bf(outv);
                else ((bf16_t*)(ws + OFF_PCONV))[(size_t)lane * 2048 + n - 1536] = f2bf(outv);
            }
        }
    }
    __syncthreads();
}

__device__ __forceinline__ void phase_meta_lora(const PPv& p) {
    const int tid = threadIdx.x, bid = blockIdx.x, nb = gridDim.x, lane = tid & 63, wave = tid >> 6;
    unsigned char* ws = p.gws();
    const bf16_t* L = (const bf16_t*)(ws + OFF_L); const bf16_t* W2 = (const bf16_t*)(ws + OFF_W2);
    for (int n = bid * 8 + wave; n < 1536; n += nb * 8) {
        const int seg = n >> 9, c = n & 511;
        const u32x2 wv = *(const u32x2*)(W2 + (size_t)n * 256 + 4 * lane);
        const float w0v = bflo(wv.x), w1v = bfhi(wv.x), w2v = bflo(wv.y), w3v = bfhi(wv.y);
        float outv = 0.f;
#pragma unroll
        for (int r = 0; r < 16; ++r) {
            const u32x2 lv = *(const u32x2*)(L + (size_t)r * 256 + 4 * lane);
            float acc = bflo(lv.x) * w0v + bfhi(lv.x) * w1v + bflo(lv.y) * w2v + bfhi(lv.y) * w3v;
            acc = wave_sum_dpp(acc);
            outv = (lane == r) ? acc : outv;
        }
        if (lane < 16) {
            float v = outv;
            if (seg == 0) v = -0.60653065971f * sigmoidf_(v + p.gin(10)[c]);
            if (seg == 1) v = sigmoidf_(v + p.gin(13)[c]);
            bf16_t* ob = (bf16_t*)(ws + (seg == 0 ? OFF_LD : seg == 1 ? OFF_A : OFF_G));
            ob[(size_t)lane * 512 + c] = f2bf(v);
        }
    }
}

__device__ __forceinline__ void phase_lprep_conv(const PPv& p) {
    const int tid = threadIdx.x, bid = blockIdx.x, nb = gridDim.x;
    unsigned char* ws = p.gws();
    const bf16_t* PROJ = (const bf16_t*)(ws + OFF_PCONV);
    constexpr int PCOLS = 2048;
    bf16_t* L = (bf16_t*)(ws + OFF_L);
    for (int i = bid * 512 + tid; i < NRP * 32; i += nb * 512) {
        const int row = i >> 5, gq = i & 31;
        u32x4 w = (u32x4){0u, 0u, 0u, 0u};
        if (row < NR) {
            int ca, cb;
            if (gq < 8) { ca = 1536 + gq * 8; cb = ca + 64; }
            else if (gq < 16) { ca = 1536 + 128 + (gq - 8) * 8; cb = ca + 64; }
            else { ca = 1536 + 256 + (gq - 16) * 8; cb = ca + 128; }
            const u32x4 va = *(const u32x4*)(PROJ + (size_t)row * PCOLS + ca);
            const int pr = prev_row(row, 1);
            u32x4 vb = (u32x4){0u, 0u, 0u, 0u};
            if (pr >= 0) vb = *(const u32x4*)(PROJ + (size_t)pr * PCOLS + cb);
            float v[8] = {bflo(va.x) + bflo(vb.x), bfhi(va.x) + bfhi(vb.x), bflo(va.y) + bflo(vb.y), bfhi(va.y) + bfhi(vb.y), bflo(va.z) + bflo(vb.z), bfhi(va.z) + bfhi(vb.z), bflo(va.w) + bflo(vb.w), bfhi(va.w) + bfhi(vb.w)};
#pragma unroll
            for (int j = 0; j < 8; ++j) { if (gq < 8) v[j] = tanhf(v[j]); else if (gq >= 16) v[j] = sigmoidf_(v[j]); }
            w.x = cvt_pk_bf16(v[0], v[1]); w.y = cvt_pk_bf16(v[2], v[3]); w.z = cvt_pk_bf16(v[4], v[5]); w.w = cvt_pk_bf16(v[6], v[7]);
        }
        *(u32x4*)(L + (size_t)row * 256 + gq * 8) = w;
    }
    bf16_t* C = (bf16_t*)(ws + OFF_C);
    const float* cw = p.gin(24);
    for (int i = bid * 512 + tid; i < T * 64; i += nb * 512) {
        const int m = i >> 6, ch = (i & 63) * 8, row = NMETA + m;
        const int r1 = prev_row(row, 1), r2 = prev_row(row, 2);
        const bf16_t* p0 = PROJ + (size_t)row * PCOLS; const bf16_t* p1 = PROJ + (size_t)r1 * PCOLS; const bf16_t* p2 = PROJ + (size_t)r2 * PCOLS;
        const u32x4 vb = *(const u32x4*)(p0 + ch);
        const u32x4 c0 = *(const u32x4*)(p0 + 512 + ch), h0 = *(const u32x4*)(p0 + 1024 + ch);
        const u32x4 c1 = *(const u32x4*)(p1 + 512 + ch), h1 = *(const u32x4*)(p1 + 1024 + ch);
        const u32x4 c2 = *(const u32x4*)(p2 + 512 + ch), h2 = *(const u32x4*)(p2 + 1024 + ch);
        float o[8];
#pragma unroll
        for (int j = 0; j < 8; ++j) {
            const unsigned wb = j < 2 ? vb.x : j < 4 ? vb.y : j < 6 ? vb.z : vb.w;
            const unsigned wc0 = j < 2 ? c0.x : j < 4 ? c0.y : j < 6 ? c0.z : c0.w, wh0 = j < 2 ? h0.x : j < 4 ? h0.y : j < 6 ? h0.z : h0.w;
            const unsigned wc1 = j < 2 ? c1.x : j < 4 ? c1.y : j < 6 ? c1.z : c1.w, wh1 = j < 2 ? h1.x : j < 4 ? h1.y : j < 6 ? h1.z : h1.w;
            const unsigned wc2 = j < 2 ? c2.x : j < 4 ? c2.y : j < 6 ? c2.z : c2.w, wh2 = j < 2 ? h2.x : j < 4 ? h2.y : j < 6 ? h2.z : h2.w;
            const bool hi = j & 1;
            const float b = hi ? bfhi(wb) : bflo(wb);
            const float u0 = (hi ? bfhi(wc0) : bflo(wc0)) * (hi ? bfhi(wh0) : bflo(wh0));
            const float u1 = (hi ? bfhi(wc1) : bflo(wc1)) * (hi ? bfhi(wh1) : bflo(wh1));
            const float u2 = (hi ? bfhi(wc2) : bflo(wc2)) * (hi ? bfhi(wh2) : bflo(wh2));
            const float conv = cw[ch + j] * u2 + cw[512 + ch + j] * u1 + cw[1024 + ch + j] * u0;
            o[j] = b * conv;
        }
        u32x4 w; w.x = cvt_pk_bf16(o[0], o[1]); w.y = cvt_pk_bf16(o[2], o[3]); w.z = cvt_pk_bf16(o[4], o[5]); w.w = cvt_pk_bf16(o[6], o[7]);
        *(u32x4*)(C + (size_t)m * 512 + ch) = w;
    }
}

template <int CTRL> __device__ __forceinline__ float dppmov(float v) { return __builtin_bit_cast(float, __builtin_amdgcn_update_dpp(0, __builtin_bit_cast(int, v), CTRL, 0xF, 0xF, true)); }
__device__ __forceinline__ float wave_sum_dpp(float v) {
    v += dppmov<0xB1>(v);
    v += dppmov<0x4E>(v);
    v += dppmov<0x141>(v);
    v += dppmov<0x140>(v);
    { float c = v; asm volatile("v_nop\n\tv_nop\n\tv_permlane16_swap_b32 %0, %1\n\tv_nop" : "+v"(v), "+v"(c)); v += c; }
    { float c = v; asm volatile("v_nop\n\tv_nop\n\tv_permlane32_swap_b32 %0, %1\n\tv_nop" : "+v"(v), "+v"(c)); v += c; }
    return v;
}
typedef float f32x16 __attribute__((ext_vector_type(16)));

struct RawTok { bf16_t r, k, v, a, ld; };
__device__ __forceinline__ RawTok load_raw(const bf16_t* PRKV, const bf16_t* Ab, const bf16_t* LD, int row, int col) {
    RawTok q; const bf16_t* p0 = PRKV + (size_t)row * 1536 + col;
    q.r = p0[0]; q.k = p0[512]; q.v = p0[1024]; q.a = Ab[(size_t)row * 512 + col]; q.ld = LD[(size_t)row * 512 + col];
    return q;
}
__device__ __forceinline__ void unit_geom(int uid, int lane, int& b, int& h, int& c, int& col, int& row0) {
    const int bh = uid / NCHUNK; c = uid - bh * NCHUNK; b = bh >> 3; h = bh & 7; col = h * 64 + lane;
    row0 = c == 0 ? 0 : b * SEQ + c * 16;
}
__device__ __forceinline__ void phase_scanprep(const PPv& p, LAS unsigned char* lds) {
    const int tid = threadIdx.x, bid = blockIdx.x, nb = gridDim.x, lane = tid & 63, wave = tid >> 6;
    unsigned char* ws = p.gws();
    const bf16_t* PRKV = (const bf16_t*)(ws + OFF_PRKV);
    const bf16_t* LD = (const bf16_t*)(ws + OFF_LD);
    const bf16_t* Ab = (const bf16_t*)(ws + OFF_A);
    float* COEF = (float*)(ws + OFF_COEF);
    LAS unsigned char* wl = lds + wave * 13824;
    LAS bf16_t* AR = (LAS bf16_t*)wl;
    LAS bf16_t* BK = (LAS bf16_t*)(wl + 4608);
    LAS float* DM = (LAS float*)(wl + 9216);
    const int qperm = (lane & 32) | (((lane >> 2) & 3) << 3) | (((lane >> 4) & 1) << 2) | (lane & 3);
    int uid = bid * 8 + wave;
    if (uid >= NUNITS) return;
    int b, h, c, col, row0;
    unit_geom(uid, lane, b, h, c, col, row0);
    RawTok q[16], qn[16];
    bf16_t prr = 0, prk = 0, prv = 0, nprr = 0, nprk = 0, nprv = 0;
#pragma unroll
    for (int t = 0; t < 16; ++t) q[t] = load_raw(PRKV, Ab, LD, row0 + t, col);
    { const int pr = prev_row(row0, 1); if (pr >= 0) { const bf16_t* p1 = PRKV + (size_t)pr * 1536 + col; prr = p1[0]; prk = p1[512]; prv = p1[1024]; } }
    for (;;) {
        const float mur = p.gin(4)[col], muk = p.gin(5)[col], muv = p.gin(6)[col], kkw = p.gin(18)[col], kaw = p.gin(19)[col], rkw = p.gin(20)[col];
        const int nuid = uid + nb * 8; const bool has_next = nuid < NUNITS;
        int nb_ = b, nh = h, nc = c, ncol = col, nrow0 = row0;
        if (has_next) {
            unit_geom(nuid, lane, nb_, nh, nc, ncol, nrow0);
#pragma unroll
            for (int t = 0; t < 16; ++t) qn[t] = load_raw(PRKV, Ab, LD, nrow0 + t, ncol);
            nprr = 0; nprk = 0; nprv = 0;
            const int pr = prev_row(nrow0, 1); if (pr >= 0) { const bf16_t* p1 = PRKV + (size_t)pr * 1536 + ncol; nprr = p1[0]; nprk = p1[512]; nprv = p1[1024]; }
        }
        __builtin_amdgcn_sched_barrier(0);
        LAS float* PM = (LAS float*)wl;
        LAS float* RS = DM;
        {
            float rp = bf2f(prr), kp = bf2f(prk);
#pragma unroll
            for (int t = 0; t < 16; ++t) {
                const RawTok qq = q[t];
                const float r0 = bf2f(qq.r), k0 = bf2f(qq.k);
                const float r = r0 + (rp - r0) * mur, k = k0 + (kp - k0) * muk;
                rp = r0; kp = k0;
                const float a = bf2f(qq.a);
                const float kkv = k * kkw, k2 = k * (1.0f + (a - 1.0f) * kaw);
                PM[t * 68 + lane] = kkv * kkv; PM[(16 + t) * 68 + lane] = r * k2 * rkw;
            }
            asm volatile("" ::: "memory");
            const int rw = lane & 31, hf = lane >> 5;
            f32x4 s4 = (f32x4){0.f, 0.f, 0.f, 0.f};
#pragma unroll
            for (int i = 0; i < 8; ++i) s4 += *(const LAS f32x4*)(PM + rw * 68 + hf * 32 + i * 4);
            float sm = (s4[0] + s4[1]) + (s4[2] + s4[3]);
            { float c2 = sm; asm volatile("v_nop\n\tv_nop\n\tv_permlane32_swap_b32 %0, %1\n\tv_nop" : "+v"(sm), "+v"(c2)); sm += c2; }
            if (lane < 32) RS[lane] = sm;
            asm volatile("" ::: "memory");
            const float cfl = __shfl(sm, (lane & 15) + 16);
            if (lane < 16) COEF[(size_t)(row0 + lane) * 8 + h] = cfl;
        }
        __builtin_amdgcn_sched_barrier(0);
        float at[16], vt[16]; unsigned btp[8], ktp[8]; float bprev = 0.f, kprev = 0.f;
        float cl = 0.f;
        float rp = bf2f(prr), kp = bf2f(prk), vp = bf2f(prv);
        f32x4 n2v[4];
#pragma unroll
        for (int i = 0; i < 4; ++i) n2v[i] = *(const LAS f32x4*)(RS + 4 * i);
        asm volatile("" ::: "memory"); __builtin_amdgcn_sched_barrier(0);
#pragma unroll
        for (int t = 0; t < 16; ++t) {
            const RawTok qq = q[t];
            const float r0 = bf2f(qq.r), k0 = bf2f(qq.k), v0 = bf2f(qq.v);
            const float r = r0 + (rp - r0) * mur, k = k0 + (kp - k0) * muk, v = v0 + (vp - v0) * muv;
            rp = r0; kp = k0; vp = v0;
            const float a = bf2f(qq.a);
            const float kkv = k * kkw;
            const float kk = kkv * __builtin_amdgcn_rsqf(fmaxf(n2v[t >> 2][t & 3], 1e-24f));
            const float k2 = k * (1.0f + (a - 1.0f) * kaw);
            const float wcp = __expf(cl);
            cl += bf2f(qq.ld);
            const float wcn = __expf(cl), iw = __expf(-cl);
            const float btv = kk * a * iw, ktv = k2 * iw;
            at[t] = -kk * wcp; vt[t] = v;
            { const unsigned w = cvt_pk_bf16(at[t], r * wcn); AR[t * 72 + qperm] = (bf16_t)(w & 0xFFFFu); AR[(16 + t) * 72 + qperm] = (bf16_t)(w >> 16); }
            if (t & 1) {
                btp[t >> 1] = cvt_pk_bf16(bprev, btv); ktp[t >> 1] = cvt_pk_bf16(kprev, ktv);
                BK[(t - 1) * 72 + qperm] = (bf16_t)(btp[t >> 1] & 0xFFFFu); BK[t * 72 + qperm] = (bf16_t)(btp[t >> 1] >> 16);
                BK[(16 + t - 1) * 72 + qperm] = (bf16_t)(ktp[t >> 1] & 0xFFFFu); BK[(16 + t) * 72 + qperm] = (bf16_t)(ktp[t >> 1] >> 16);
            } else { bprev = btv; kprev = ktv; }
            if ((t & 3) == 3) __builtin_amdgcn_sched_barrier(0);
        }
        const float wcc = __expf(cl);
        {
            f32x16 dm;
#pragma unroll
            for (int i = 0; i < 16; ++i) dm[i] = 0.f;
            const int rr = lane & 31, hh = lane >> 5;
#pragma unroll
            for (int ks = 0; ks < 4; ++ks) {
                const bf16x8 fa = *(const LAS bf16x8*)(AR + rr * 72 + 16 * ks + 8 * hh);
                const bf16x8 fb = *(const LAS bf16x8*)(BK + rr * 72 + 16 * ks + 8 * hh);
                dm = __builtin_amdgcn_mfma_f32_32x32x16_bf16(fa, fb, dm, 0, 0, 0);
            }
#pragma unroll
            for (int reg = 0; reg < 16; ++reg) DM[((reg & 3) + 8 * (reg >> 2) + 4 * hh) * 36 + rr] = dm[reg];
        }
        __builtin_amdgcn_sched_barrier(0);
        float uh[16];
#pragma unroll
        for (int t = 0; t < 16; ++t) {
            float wv = at[t], uv = 0.f, wv2 = 0.f, uv2 = 0.f, uv3 = 0.f;
#pragma unroll
            for (int s4 = 0; s4 < 4; ++s4) {
                if (s4 * 4 < t) {
                    const f32x4 ab = *(const LAS f32x4*)(DM + t * 36 + s4 * 4), ak = *(const LAS f32x4*)(DM + t * 36 + 16 + s4 * 4);
#pragma unroll
                    for (int j = 0; j < 4; ++j) {
                        const int s_ = s4 * 4 + j;
                        if (s_ < t) {
                            if (j & 1) { wv2 += ab[j] * at[s_]; uv2 += ak[j] * vt[s_]; } else { wv += ab[j] * at[s_]; uv += ak[j] * vt[s_]; }
                            uv3 += ab[j] * uh[s_];
                        }
                    }
                }
            }
            wv += wv2; uv += uv2 + uv3;
            at[t] = wv; uh[t] = uv;
            asm volatile("" : "+v"(at[t]), "+v"(uh[t]));
        }
        __builtin_amdgcn_sched_barrier(0);
#pragma unroll
        for (int t = 0; t < 16; t += 2) { const unsigned w = cvt_pk_bf16(at[t], at[t + 1]); AR[t * 72 + qperm] = (bf16_t)(w & 0xFFFFu); AR[(t + 1) * 72 + qperm] = (bf16_t)(w >> 16); }
        unsigned char* rec = ws + OFF_CH + (size_t)uid * REC_BYTES;
#pragma unroll
        for (int i = 0; i < 2; ++i) {
            const int pc = i * 64 + lane, row = pc >> 3, part = pc & 7;
            *(u32x4*)(rec + RO_WH + pc * 16) = *(const LAS u32x4*)((LAS unsigned char*)AR + row * 144 + part * 16);
            *(u32x4*)(rec + RO_RT + pc * 16) = *(const LAS u32x4*)((LAS unsigned char*)AR + (16 + row) * 144 + part * 16);
        }
        {
            u32x4 w0, w1;
            w0.x = cvt_pk_bf16(uh[0], uh[1]); w0.y = cvt_pk_bf16(uh[2], uh[3]); w0.z = cvt_pk_bf16(uh[4], uh[5]); w0.w = cvt_pk_bf16(uh[6], uh[7]);
            w1.x = cvt_pk_bf16(uh[8], uh[9]); w1.y = cvt_pk_bf16(uh[10], uh[11]); w1.z = cvt_pk_bf16(uh[12], uh[13]); w1.w = cvt_pk_bf16(uh[14], uh[15]);
            *(u32x4*)(rec + RO_U0T + lane * 32) = w0; *(u32x4*)(rec + RO_U0T + lane * 32 + 16) = w1;
            w0.x = cvt_pk_bf16(vt[0], vt[1]); w0.y = cvt_pk_bf16(vt[2], vt[3]); w0.z = cvt_pk_bf16(vt[4], vt[5]); w0.w = cvt_pk_bf16(vt[6], vt[7]);
            w1.x = cvt_pk_bf16(vt[8], vt[9]); w1.y = cvt_pk_bf16(vt[10], vt[11]); w1.z = cvt_pk_bf16(vt[12], vt[13]); w1.w = cvt_pk_bf16(vt[14], vt[15]);
            *(u32x4*)(rec + RO_VT + lane * 32) = w0; *(u32x4*)(rec + RO_VT + lane * 32 + 16) = w1;
        }
#pragma unroll
        for (int g = 0; g < 4; ++g) {
            u32x4 w; w.x = btp[2 * g]; w.y = btp[2 * g + 1]; w.z = ktp[2 * g]; w.w = ktp[2 * g + 1];
            *(u32x4*)(rec + RO_BKT + lane * 64 + g * 16) = w;
        }
        {
            const int t = lane >> 2, g = lane & 3;
            const f32x4 rb = *(const LAS f32x4*)(DM + (16 + t) * 36 + 4 * g), rk = *(const LAS f32x4*)(DM + (16 + t) * 36 + 16 + 4 * g);
            float o[8];
#pragma unroll
            for (int j = 0; j < 4; ++j) { const bool keep = (4 * g + j) <= t; o[j] = keep ? rb[j] : 0.f; o[4 + j] = keep ? rk[j] : 0.f; }
            u32x4 w; w.x = cvt_pk_bf16(o[0], o[1]); w.y = cvt_pk_bf16(o[2], o[3]); w.z = cvt_pk_bf16(o[4], o[5]); w.w = cvt_pk_bf16(o[6], o[7]);
            *(u32x4*)(rec + RO_ARK + t * 64 + g * 16) = w;
        }
        *(float*)(rec + RO_WCC + lane * 4) = wcc;
        if (!has_next) break;
        uid = nuid; b = nb_; h = nh; c = nc; col = ncol; row0 = nrow0;
#pragma unroll
        for (int t = 0; t < 16; ++t) q[t] = qn[t];
        prr = nprr; prk = nprk; prv = nprv;
        __builtin_amdgcn_sched_barrier(0);
    }
}

__device__ __forceinline__ void convert_expert_weights(const PPv& p, LAS unsigned char* lds, int first, int stride);
struct RecOps { bf16x8 wA0, wA1, rA0, rA1, ark, bk[4]; u32x2 u0, vv; f32x4 wc[4]; };
__device__ __forceinline__ void load_ops(RecOps& o, LAS unsigned char* S, int vs, int fr, int g) {
    o.wA0 = *(const LAS bf16x8*)(S + RO_WH + fr * 128 + g * 16); o.wA1 = *(const LAS bf16x8*)(S + RO_WH + fr * 128 + 64 + g * 16);
    o.rA0 = *(const LAS bf16x8*)(S + RO_RT + fr * 128 + g * 16); o.rA1 = *(const LAS bf16x8*)(S + RO_RT + fr * 128 + 64 + g * 16);
    o.u0 = *(const LAS u32x2*)(S + RO_U0T + (16 * vs + fr) * 32 + g * 8);
    o.vv = *(const LAS u32x2*)(S + RO_VT + (16 * vs + fr) * 32 + g * 8);
    o.ark = *(const LAS bf16x8*)(S + RO_ARK + fr * 64 + g * 16);
#pragma unroll
    for (int m = 0; m < 4; ++m) { o.bk[m] = *(const LAS bf16x8*)(S + RO_BKT + (16 * m + fr) * 64 + g * 16); o.wc[m] = *(const LAS f32x4*)(S + RO_WCC + (16 * m + 4 * g) * 4); }
}
__device__ __forceinline__ void phase_recur(const PPv& p, LAS unsigned char* lds) {
    const int tid = threadIdx.x, bid = blockIdx.x, nb = gridDim.x, lane = tid & 63, wave = __builtin_amdgcn_readfirstlane(tid >> 6);
    unsigned char* ws = p.gws();
    if (bid >= 64) { convert_expert_weights(p, lds, bid - 64, nb - 64); return; }
    unsigned char* CHb = ws + OFF_CH + (size_t)(bid * NCHUNK) * REC_BYTES;
    constexpr int RSLOT = REC_BYTES, RN = 11, PF = 8;
#define R_BAR() do { asm volatile("s_waitcnt lgkmcnt(0)" ::: "memory"); __builtin_amdgcn_s_barrier(); asm volatile("" ::: "memory"); } while (0)
    if (wave >= 4) {
        const int lw = wave - 4;
#define R_ISSUE(x) do { \
            LAS unsigned char* _s = lds + ((x) % RN) * RSLOT; const unsigned char* _r = CHb + (size_t)(x) * REC_BYTES + lane * 16; \
            _Pragma("unroll") for (int _i = 0; _i < 3; ++_i) { const int _pc = lw + 4 * _i; __builtin_amdgcn_global_load_lds((const unsigned*)(_r + _pc * 1024), (LAS unsigned*)(_s + _pc * 1024), 16, 0, 0); } \
            if (lw == 0) __builtin_amdgcn_global_load_lds((const unsigned*)(_r + 12 * 1024), (LAS unsigned*)(_s + 12 * 1024), 16, 0, 0); \
            if (lw == 1) { if (lane < 16) __builtin_amdgcn_global_load_lds((const unsigned*)(_r + 13 * 1024), (LAS unsigned*)(_s + 13 * 1024), 16, 0, 0); } } while (0)
        for (int x = 0; x < PF; ++x) R_ISSUE(x);
        asm volatile("s_waitcnt vmcnt(0)" ::: "memory");
        R_BAR();
        for (int c = 0; c < NCHUNK; ++c) {
            const int x = c + PF;
            if (x < NCHUNK) R_ISSUE(x);
            if (x < NCHUNK) { if (lw < 2) asm volatile("s_waitcnt vmcnt(24)" ::: "memory"); else asm volatile("s_waitcnt vmcnt(18)" ::: "memory"); }
            else asm volatile("s_waitcnt vmcnt(0)" ::: "memory");
            R_BAR();
        }
#undef R_ISSUE
    } else {
        const int vs = wave, fr = lane & 15, g = lane >> 4;
        f32x4 H[4];
#pragma unroll
        for (int m = 0; m < 4; ++m) H[m] = (f32x4){0.f, 0.f, 0.f, 0.f};
        R_BAR();
        RecOps cur, nxt;
        load_ops(cur, lds, vs, fr, g);
        for (int c = 0; c < NCHUNK; ++c) {
            if (c + 1 < NCHUNK) load_ops(nxt, lds + ((c + 1) % RN) * RSLOT, vs, fr, g); else nxt = cur;
            u32x4 hb0, hb1;
            hb0.x = cvt_pk_bf16(H[0][0], H[0][1]); hb0.y = cvt_pk_bf16(H[0][2], H[0][3]); hb0.z = cvt_pk_bf16(H[1][0], H[1][1]); hb0.w = cvt_pk_bf16(H[1][2], H[1][3]);
            hb1.x = cvt_pk_bf16(H[2][0], H[2][1]); hb1.y = cvt_pk_bf16(H[2][2], H[2][3]); hb1.z = cvt_pk_bf16(H[3][0], H[3][1]); hb1.w = cvt_pk_bf16(H[3][2], H[3][3]);
            const bf16x8 hB0 = __builtin_bit_cast(bf16x8, hb0), hB1 = __builtin_bit_cast(bf16x8, hb1);
            f32x4 U = (f32x4){bflo(cur.u0.x), bfhi(cur.u0.x), bflo(cur.u0.y), bfhi(cur.u0.y)};
            U = __builtin_amdgcn_mfma_f32_16x16x32_bf16(cur.wA0, hB0, U, 0, 0, 0);
            U = __builtin_amdgcn_mfma_f32_16x16x32_bf16(cur.wA1, hB1, U, 0, 0, 0);
            f32x4 Y = (f32x4){0.f, 0.f, 0.f, 0.f};
            Y = __builtin_amdgcn_mfma_f32_16x16x32_bf16(cur.rA0, hB0, Y, 0, 0, 0);
            Y = __builtin_amdgcn_mfma_f32_16x16x32_bf16(cur.rA1, hB1, Y, 0, 0, 0);
            u32x4 uvw; uvw.x = cvt_pk_bf16(U[0], U[1]); uvw.y = cvt_pk_bf16(U[2], U[3]); uvw.z = cur.vv.x; uvw.w = cur.vv.y;
            const bf16x8 uv = __builtin_bit_cast(bf16x8, uvw);
            Y = __builtin_amdgcn_mfma_f32_16x16x32_bf16(cur.ark, uv, Y, 0, 0, 0);
#pragma unroll
            for (int m = 0; m < 4; ++m) { H[m] = __builtin_amdgcn_mfma_f32_16x16x32_bf16(cur.bk[m], uv, H[m], 0, 0, 0); H[m] *= cur.wc[m]; }
            u32x2 yw; yw.x = cvt_pk_bf16(Y[0], Y[1]); yw.y = cvt_pk_bf16(Y[2], Y[3]);
            *(u32x2*)(CHb + (size_t)c * REC_BYTES + RO_U0T + (16 * vs + fr) * 32 + g * 8) = yw;
            R_BAR();
            cur = nxt;
        }
    }
#undef R_BAR
}

__device__ __forceinline__ void phase_gn(const PPv& p, LAS unsigned char* lds) {
    const int tid = threadIdx.x, bid = blockIdx.x, nb = gridDim.x, lane = tid & 63, wave = tid >> 6;
    unsigned char* ws = p.gws();
    LAS float* PM = (LAS float*)(lds + wave * 8960);
    LAS float* RS = PM + 32 * 68;
    const bf16_t* Gb = (const bf16_t*)(ws + OFF_G); const float* COEF = (const float*)(ws + OFF_COEF);
    bf16_t* Z = (bf16_t*)(ws + OFF_Z);
    constexpr int NREAL = 64 * 256;
    for (int r0 = bid * 8 + wave; r0 < NREAL; r0 += nb * 16) {
        u32x4 y0[2], y1[2], v0[2], v1[2]; float cfv[2][16]; bf16_t ggv[2][16]; int colv[2], row0v[2], hv[2]; bool okv[2];
#pragma unroll
        for (int u = 0; u < 2; ++u) {
            const int r = r0 + u * nb * 8; okv[u] = r < NREAL;
            const int rr = okv[u] ? r : r0;
            const int bh = rr >> 8, c = (rr & 255) + 1, b = bh >> 3, h = bh & 7, uid = bh * NCHUNK + c;
            hv[u] = h; colv[u] = h * 64 + lane; row0v[u] = b * SEQ + c * 16;
            const unsigned char* rec = ws + OFF_CH + (size_t)uid * REC_BYTES;
            y0[u] = *(const u32x4*)(rec + RO_U0T + lane * 32); y1[u] = *(const u32x4*)(rec + RO_U0T + lane * 32 + 16);
            v0[u] = *(const u32x4*)(rec + RO_VT + lane * 32); v1[u] = *(const u32x4*)(rec + RO_VT + lane * 32 + 16);
#pragma unroll
            for (int t = 0; t < 16; ++t) { cfv[u][t] = COEF[(size_t)(row0v[u] + t) * 8 + h]; ggv[u][t] = Gb[(size_t)(row0v[u] + t) * 512 + colv[u]]; }
        }
#pragma unroll
        for (int u = 0; u < 2; ++u) {
            if (!okv[u]) continue;
            const int col = colv[u], row0 = row0v[u];
            const float lng = p.gin(21)[col], lnb = p.gin(22)[col];
            const unsigned yw[8] = {y0[u].x, y0[u].y, y0[u].z, y0[u].w, y1[u].x, y1[u].y, y1[u].z, y1[u].w}, vw[8] = {v0[u].x, v0[u].y, v0[u].z, v0[u].w, v1[u].x, v1[u].y, v1[u].z, v1[u].w};
            asm volatile("" ::: "memory");
#pragma unroll
            for (int t = 0; t < 16; ++t) { const float y = (t & 1) ? bfhi(yw[t >> 1]) : bflo(yw[t >> 1]); PM[t * 68 + lane] = y; PM[(16 + t) * 68 + lane] = y * y; }
            asm volatile("" ::: "memory");
            {
                const int rw = lane & 31, hf = lane >> 5;
                f32x4 s4 = (f32x4){0.f, 0.f, 0.f, 0.f};
#pragma unroll
                for (int i = 0; i < 8; ++i) s4 += *(const LAS f32x4*)(PM + rw * 68 + hf * 32 + i * 4);
                float sm = (s4[0] + s4[1]) + (s4[2] + s4[3]);
                { float c2 = sm; asm volatile("v_nop\n\tv_nop\n\tv_permlane32_swap_b32 %0, %1\n\tv_nop" : "+v"(sm), "+v"(c2)); sm += c2; }
                if (lane < 32) RS[lane] = sm;
            }
            asm volatile("" ::: "memory");
            f32x4 s1v[4], s2v[4];
#pragma unroll
            for (int i = 0; i < 4; ++i) { s1v[i] = *(const LAS f32x4*)(RS + 4 * i); s2v[i] = *(const LAS f32x4*)(RS + 16 + 4 * i); }
            asm volatile("" ::: "memory");
#pragma unroll
            for (int t = 0; t < 16; ++t) {
                const float y = (t & 1) ? bfhi(yw[t >> 1]) : bflo(yw[t >> 1]);
                const float v = (t & 1) ? bfhi(vw[t >> 1]) : bflo(vw[t >> 1]);
                const float mean = s1v[t >> 2][t & 3] * (1.0f / 64.0f);
                const float dlt = y - mean;
                const float var = fmaxf(s2v[t >> 2][t & 3] * (1.0f / 64.0f) - mean * mean, 0.f);
                const float yn = dlt * rsqrtf(var + LNX_EPS) * lng + lnb;
                Z[(size_t)(row0 + t - NMETA) * 512 + col] = f2bf((yn + cfv[u][t] * v) * bf2f(ggv[u][t]));
            }
        }
    }
}

__device__ __forceinline__ void convert_expert_weights(const PPv& p, LAS unsigned char* lds, int first, int stride) {
    unsigned char* ws = p.gws();
    const int tid = threadIdx.x;
    LAS float* tile = (LAS float*)lds;
    const float* g2 = p.gin(27);
    unsigned char* WGU = ws + OFF_WGU; unsigned char* WD = ws + OFF_WD;
    constexpr int NBLK = NE * 3 * 64;
    const int lr = tid >> 6, lc = (tid & 63) * 4;
    f32x4 cur[8];
    int j = first;
    if (j >= NBLK) return;
    {
        const int mat = j >> 6, e = mat / 3, which = mat - 3 * e, bb = j & 63, kb = bb & 15, nbk = bb >> 4;
        const float* src = (which == 0 ? p.gin(30) : which == 1 ? p.gin(32) : p.gin(34)) + (size_t)e * 1024 * 1024 + (size_t)(kb * 64) * 1024 + nbk * 256;
#pragma unroll
        for (int i = 0; i < 8; ++i) cur[i] = __builtin_nontemporal_load((const f32x4*)(src + (size_t)(lr + 8 * i) * 1024 + lc));
    }
    for (;;) {
        const int jn = j + stride; const bool has_next = jn < NBLK;
        f32x4 nxt[8];
        if (has_next) {
            const int mat = jn >> 6, e = mat / 3, which = mat - 3 * e, bb = jn & 63, kb = bb & 15, nbk = bb >> 4;
            const float* src = (which == 0 ? p.gin(30) : which == 1 ? p.gin(32) : p.gin(34)) + (size_t)e * 1024 * 1024 + (size_t)(kb * 64) * 1024 + nbk * 256;
#pragma unroll
            for (int i = 0; i < 8; ++i) nxt[i] = __builtin_nontemporal_load((const f32x4*)(src + (size_t)(lr + 8 * i) * 1024 + lc));
        }
        const int mat = j >> 6, e = mat / 3, which = mat - 3 * e, bb = j & 63, kb = bb & 15, nbk = bb >> 4;
#pragma unroll
        for (int i = 0; i < 8; ++i) { LAS float* t = tile + (lr + 8 * i) * 257 + lc; t[0] = cur[i][0]; t[1] = cur[i][1]; t[2] = cur[i][2]; t[3] = cur[i][3]; }
        __syncthreads();
        {
            const int kq = tid & 7, k0 = kb * 64 + 8 * kq;
            float sc[8];
#pragma unroll
            for (int jj = 0; jj < 8; ++jj) sc[jj] = (which < 2 ? g2[k0 + jj] : 1.0f) * W8_SCALE;
#pragma unroll
            for (int i = 0; i < 4; ++i) {
                const int nn = (tid >> 3) + 64 * i, n = nbk * 256 + nn;
                float v[8];
#pragma unroll
                for (int jj = 0; jj < 8; ++jj) v[jj] = tile[(8 * kq + jj) * 257 + nn] * sc[jj];
                u32x2 w; w.x = pk4_fp8(v[0], v[1], v[2], v[3]); w.y = pk4_fp8(v[4], v[5], v[6], v[7]);
                unsigned char* dst = which < 2 ? WGU + (size_t)e * 2048 * 1024 + (size_t)(256 * (n >> 7) + 128 * which + (n & 127)) * 1024
                                               : WD + (size_t)e * 1024 * 1024 + (size_t)n * 1024;
                __builtin_nontemporal_store(w, (u32x2*)(dst + k0));
            }
        }
        __syncthreads();
        if (!has_next) break;
        j = jn;
#pragma unroll
        for (int i = 0; i < 8; ++i) cur[i] = nxt[i];
    }
}

__device__ __forceinline__ void phase_router(const PPv& p, LAS unsigned char* lds) {
    const int tid = threadIdx.x, bid = blockIdx.x, nb = gridDim.x, lane = tid & 63, wave = tid >> 6;
    unsigned char* ws = p.gws();
    const bf16_t* h1 = (const bf16_t*)(ws + OFF_HB2);
    const float* WRG = (const float*)(ws + OFF_WRG);
    const float* brt = p.gin(29);
    LAS float* slog = (LAS float*)lds;
    LAS float* srs = slog + 8 * 16 * 32;
    LAS int* lcnt = (LAS int*)(srs + 128);
    LAS int* gbase = lcnt + 32;
    LAS int* ltopi = gbase + 32;
    LAS int* lrank = ltopi + 512;
    int* TOPI = (int*)(ws + OFF_TOPI); float* TOPW = (float*)(ws + OFF_TOPW); int* RANK = (int*)(ws + OFF_RANK); float* RSTD2 = (float*)(ws + OFF_RSTD2);
    int* GCNT = (int*)(ws + OFF_GCNT);
    for (int tb = bid; tb < T / 128; tb += nb) {
        if (tid < 32) lcnt[tid] = 0;
        __syncthreads();
        const int t0 = tb * 128 + wave * 16;
        {
            const int row = lane & 15, kq = lane >> 4;
            const bf16_t* ap = h1 + (size_t)(t0 + row) * D + 4 * kq;
            const float* bp = WRG + (size_t)(4 * kq) * 32 + row;
            f32x4 acc0 = (f32x4){0.f, 0.f, 0.f, 0.f}, acc1 = acc0;
            float ss = 0.f;
            for (int j = 0; j < 64; ++j) {
                const u32x2 aw = *(const u32x2*)(ap + 16 * j);
                const f32x4 av = (f32x4){bflo(aw.x), bfhi(aw.x), bflo(aw.y), bfhi(aw.y)};
                ss += av[0] * av[0] + av[1] * av[1] + av[2] * av[2] + av[3] * av[3];
                const float* bj = bp + (size_t)(16 * j) * 32;
#pragma unroll
                for (int s = 0; s < 4; ++s) {
                    const float b0 = bj[s * 32], b1 = bj[s * 32 + 16];
                    acc0 = __builtin_amdgcn_mfma_f32_16x16x4f32(av[s], b0, acc0, 0, 0, 0);
                    acc1 = __builtin_amdgcn_mfma_f32_16x16x4f32(av[s], b1, acc1, 0, 0, 0);
                }
            }
            ss += __shfl_xor(ss, 16); ss += __shfl_xor(ss, 32);
#pragma unroll
            for (int reg = 0; reg < 4; ++reg) {
                slog[(wave * 16 + 4 * kq + reg) * 32 + row] = acc0[reg];
                slog[(wave * 16 + 4 * kq + reg) * 32 + 16 + row] = acc1[reg];
            }
            if (lane < 16) srs[wave * 16 + lane] = rsqrtf(ss * (1.0f / D) + NORM_EPS);
        }
        __syncthreads();
        if (lane < 16) {
            const int tl = wave * 16 + lane, t = tb * 128 + tl;
            const float rs = srs[tl];
            float lg[32];
#pragma unroll
            for (int e = 0; e < 32; ++e) lg[e] = slog[tl * 32 + e] * rs + brt[e];
            int ti[4]; float tv[4];
#pragma unroll
            for (int k = 0; k < 4; ++k) {
                float best = -3.0e38f; int bi = 0;
#pragma unroll
                for (int e = 0; e < 32; ++e) { const bool tk = lg[e] > best; best = tk ? lg[e] : best; bi = tk ? e : bi; }
                ti[k] = bi; tv[k] = best;
#pragma unroll
                for (int e = 0; e < 32; ++e) lg[e] = (e == bi) ? -3.0e38f : lg[e];
            }
            const float e0 = 1.0f, e1 = __expf(tv[1] - tv[0]), e2 = __expf(tv[2] - tv[0]), e3 = __expf(tv[3] - tv[0]);
            const float inv = 1.0f / (e0 + e1 + e2 + e3);
            *(f32x4*)(TOPW + (size_t)t * 4) = (f32x4){e0 * inv, e1 * inv, e2 * inv, e3 * inv};
            RSTD2[t] = rs;
#pragma unroll
            for (int k = 0; k < 4; ++k) { ltopi[tl * 4 + k] = ti[k]; lrank[tl * 4 + k] = __hip_atomic_fetch_add(lcnt + ti[k], 1, __ATOMIC_RELAXED, __HIP_MEMORY_SCOPE_WORKGROUP); }
        }
        __syncthreads();
        if (tid < 32) gbase[tid] = atomicAdd(GCNT + tid, lcnt[tid]);
        __syncthreads();
        {
            const int e = ltopi[tid];
            TOPI[(size_t)tb * 512 + tid] = e;
            RANK[(size_t)tb * 512 + tid] = gbase[e] + lrank[tid];
        }
        __syncthreads();
    }
}

__device__ __forceinline__ void phase_lists(const PPv& p, LAS unsigned char* lds) {
    const int tid = threadIdx.x, bid = blockIdx.x, nb = gridDim.x;
    unsigned char* ws = p.gws();
    LAS int* pstart = (LAS int*)lds;
    LAS int* cnt = pstart + 64;
    const int* GCNT = (const int*)(ws + OFF_GCNT);
    if (tid < 32) cnt[tid] = GCNT[tid];
    __syncthreads();
    if (tid == 0) { int s = 0; for (int e = 0; e < 32; ++e) { pstart[e] = s; s += ((cnt[e] + 255) >> 8) << 8; } pstart[32] = s; }
    __syncthreads();
    const int* TOPI = (const int*)(ws + OFF_TOPI); const float* TOPW = (const float*)(ws + OFF_TOPW); const int* RANK = (const int*)(ws + OFF_RANK); const float* RSTD2 = (const float*)(ws + OFF_RSTD2);
    int* ROWTOK = (int*)(ws + OFF_ROWTOK); int* ROWSLOT = (int*)(ws + OFF_ROWSLOT); float* ROWW = (float*)(ws + OFF_ROWW); float* ROWRS = (float*)(ws + OFF_ROWRS);
    for (int i = bid * 512 + tid; i < T * 4; i += nb * 512) {
        const int e = TOPI[i], pos = pstart[e] + RANK[i], t = i >> 2;
        ROWTOK[pos] = t; ROWSLOT[pos] = i; ROWW[pos] = TOPW[i]; ROWRS[pos] = RSTD2[t];
    }
    for (int e = bid; e < 32; e += nb) {
        for (int pos = pstart[e] + cnt[e] + tid; pos < pstart[e + 1]; pos += 512) { ROWTOK[pos] = 0; ROWSLOT[pos] = -1; ROWW[pos] = 0.f; ROWRS[pos] = 0.f; }
    }
    if (bid == 0) {
        int* TILEE = (int*)(ws + OFF_TILEE);
        const int ntiles = pstart[32] >> 8;
        for (int mt = tid; mt < ntiles; mt += 512) { int e = 0; for (int q = 0; q < 32; ++q) if (pstart[q] <= mt * 256) e = q; TILEE[mt] = e; }
        if (tid == 0) TILEE[1000] = ntiles;
    }
    __syncthreads();
}

__device__ __forceinline__ void phase_final(const PPv& p) {
    const int tid = threadIdx.x, bid = blockIdx.x, nb = gridDim.x, lane = tid & 63, wave = tid >> 6;
    unsigned char* ws = p.gws();
    const bf16_t* HB2 = (const bf16_t*)(ws + OFF_HB2);
    const unsigned char* Y8 = (const unsigned char*)p.gout();
    const float* gf = p.gin(36);
    const f32x4 ga0 = *(const f32x4*)(gf + 8 * lane), ga1 = *(const f32x4*)(gf + 8 * lane + 4), gb0 = *(const f32x4*)(gf + 512 + 8 * lane), gb1 = *(const f32x4*)(gf + 512 + 8 * lane + 4);
    for (int t0 = (bid * 8 + wave) * 2; t0 < T; t0 += nb * 16) {
        u32x4 ha[2], hb[2]; u32x2 ya[2][4], yb[2][4];
#pragma unroll
        for (int u = 0; u < 2; ++u) {
            const int t = t0 + u;
            ha[u] = __builtin_nontemporal_load((const u32x4*)(HB2 + (size_t)t * D + 8 * lane)); hb[u] = __builtin_nontemporal_load((const u32x4*)(HB2 + (size_t)t * D + 512 + 8 * lane));
#pragma unroll
            for (int k = 0; k < 4; ++k) { ya[u][k] = __builtin_nontemporal_load((const u32x2*)(Y8 + (size_t)(4 * t + k) * 1024 + 8 * lane)); yb[u][k] = __builtin_nontemporal_load((const u32x2*)(Y8 + (size_t)(4 * t + k) * 1024 + 512 + 8 * lane)); }
        }
#pragma unroll
        for (int u = 0; u < 2; ++u) {
            const int t = t0 + u;
            float va[8] = {bflo(ha[u].x), bfhi(ha[u].x), bflo(ha[u].y), bfhi(ha[u].y), bflo(ha[u].z), bfhi(ha[u].z), bflo(ha[u].w), bfhi(ha[u].w)};
            float vb[8] = {bflo(hb[u].x), bfhi(hb[u].x), bflo(hb[u].y), bfhi(hb[u].y), bflo(hb[u].z), bfhi(hb[u].z), bflo(hb[u].w), bfhi(hb[u].w)};
#pragma unroll
            for (int k = 0; k < 4; ++k) {
                const u32x2 a4 = ya[u][k], b4 = yb[u][k];
                { const f32x2 q0 = __builtin_amdgcn_cvt_pk_f32_fp8((int)a4.x, false), q1 = __builtin_amdgcn_cvt_pk_f32_fp8((int)a4.x, true), q2 = __builtin_amdgcn_cvt_pk_f32_fp8((int)a4.y, false), q3 = __builtin_amdgcn_cvt_pk_f32_fp8((int)a4.y, true);
                  va[0] += q0.x; va[1] += q0.y; va[2] += q1.x; va[3] += q1.y; va[4] += q2.x; va[5] += q2.y; va[6] += q3.x; va[7] += q3.y; }
                { const f32x2 q0 = __builtin_amdgcn_cvt_pk_f32_fp8((int)b4.x, false), q1 = __builtin_amdgcn_cvt_pk_f32_fp8((int)b4.x, true), q2 = __builtin_amdgcn_cvt_pk_f32_fp8((int)b4.y, false), q3 = __builtin_amdgcn_cvt_pk_f32_fp8((int)b4.y, true);
                  vb[0] += q0.x; vb[1] += q0.y; vb[2] += q1.x; vb[3] += q1.y; vb[4] += q2.x; vb[5] += q2.y; vb[6] += q3.x; vb[7] += q3.y; }
            }
            float ss = 0.f;
#pragma unroll
            for (int j = 0; j < 8; ++j) ss += va[j] * va[j] + vb[j] * vb[j];
            ss = wave_sum_dpp(ss);
            const float rs = rsqrtf(ss * (1.0f / D) + NORM_EPS);
            float* o = p.gout() + (size_t)t * D;
            __builtin_nontemporal_store((f32x4){va[0] * rs * ga0[0], va[1] * rs * ga0[1], va[2] * rs * ga0[2], va[3] * rs * ga0[3]}, (f32x4*)(o + 8 * lane));
            __builtin_nontemporal_store((f32x4){va[4] * rs * ga1[0], va[5] * rs * ga1[1], va[6] * rs * ga1[2], va[7] * rs * ga1[3]}, (f32x4*)(o + 8 * lane + 4));
            __builtin_nontemporal_store((f32x4){vb[0] * rs * gb0[0], vb[1] * rs * gb0[1], vb[2] * rs * gb0[2], vb[3] * rs * gb0[3]}, (f32x4*)(o + 512 + 8 * lane));
            __builtin_nontemporal_store((f32x4){vb[4] * rs * gb1[0], vb[5] * rs * gb1[1], vb[6] * rs * gb1[2], vb[7] * rs * gb1[3]}, (f32x4*)(o + 512 + 8 * lane + 4));
        }
    }
}

#define XB_TMO      128
#define XB_XCNT(j)  (256  + 64 * (j))
#define XB_XSUB(j)  (1280 + 64 * (j))
#define XB_XGEN(j)  (2304 + 64 * (j))
#define XB_TOP      3328
#define XB_TOPGEN   3392
#define XCD_BAR_WORDS 3456
#define XB_SPIN_CAP (1u << 18)
__device__ __forceinline__ unsigned xb_ld(unsigned* p)              { return __hip_atomic_load(p, __ATOMIC_RELAXED, __HIP_MEMORY_SCOPE_AGENT); }
__device__ __forceinline__ unsigned xb_add(unsigned* p, unsigned v) { return __hip_atomic_fetch_add(p, v, __ATOMIC_RELAXED, __HIP_MEMORY_SCOPE_AGENT); }
__device__ __forceinline__ unsigned xb_xcc_id() { return (unsigned)__builtin_amdgcn_s_getreg((3 << 11) | 20) & 0xFu; }
#define XB_SPIN(cond, bar) do { unsigned _sp = 0; while (cond) { __builtin_amdgcn_s_sleep(1); \
    if ((++_sp & 255u) == 0u) { if (xb_ld(&(bar)[XB_TMO])) break; if (_sp > XB_SPIN_CAP) { atomicAdd(&(bar)[XB_TMO], 1u); break; } } } } while (0)
struct XcdBarrier { unsigned* bar; unsigned x; volatile LAS unsigned* st; };
__device__ __forceinline__ XcdBarrier xcd_barrier_post(unsigned* bar, volatile LAS unsigned* st) {
    XcdBarrier b; b.bar = bar; b.x = xb_xcc_id(); b.st = st;
    if (threadIdx.x == 0) (void)xb_add(&bar[XB_XCNT(b.x)], 1u);
    return b;
}
__device__ __forceinline__ void xcd_barrier_complete(unsigned* bar, unsigned x, unsigned& nloc, unsigned& nx) {
    const unsigned G = gridDim.x * gridDim.y * gridDim.z;
    unsigned sum, cnt, mine, sp = 0u;
    for (;;) {
        sum = 0u; cnt = 0u; mine = 0u;
#pragma unroll
        for (unsigned j = 0; j < 16; ++j) { const unsigned c = xb_ld(&bar[XB_XCNT(j)]); sum += c; cnt += (c > 0u) ? 1u : 0u; mine = (j == x) ? c : mine; }
        if (sum == G) break;
        __builtin_amdgcn_s_sleep(1);
        if ((++sp & 255u) == 0u) { if (xb_ld(&bar[XB_TMO])) break; if (sp > XB_SPIN_CAP) { atomicAdd(&bar[XB_TMO], 1u); break; } }
    }
    nloc = mine > 0u ? mine : 1u; nx = cnt > 0u ? cnt : 1u;
}
__device__ __forceinline__ void xcd_barrier(const XcdBarrier& b) {
    asm volatile("s_waitcnt vmcnt(0)" ::: "memory");
    __syncthreads();
    if (threadIdx.x == 0) {
        unsigned* bar = b.bar;
        __builtin_amdgcn_s_waitcnt(0);
        unsigned nloc = b.st[0], nx = b.st[1];
        if (nloc == 0u) { xcd_barrier_complete(bar, b.x, nloc, nx); b.st[0] = nloc; b.st[1] = nx; }
        const unsigned old = xb_add(&bar[XB_XSUB(b.x)], 1u);
        const unsigned gen = old / nloc;
        if (old + 1u == (gen + 1u) * nloc) {
            __builtin_amdgcn_fence(__ATOMIC_RELEASE, "agent");
            asm volatile("s_waitcnt vmcnt(0)" ::: "memory");
            const unsigned og = xb_add(&bar[XB_TOP], 1u);
            const unsigned tg = og / nx;
            if (og + 1u == (tg + 1u) * nx) xb_add(&bar[XB_TOPGEN], 1u);
            else XB_SPIN(xb_ld(&bar[XB_TOPGEN]) == tg, bar);
            __builtin_amdgcn_fence(__ATOMIC_ACQUIRE, "agent");
            xb_add(&bar[XB_XGEN(b.x)], 1u);
            asm volatile("s_waitcnt vmcnt(0)" ::: "memory");
        } else {
            XB_SPIN(xb_ld(&bar[XB_XGEN(b.x)]) == gen, bar);
            __builtin_amdgcn_fence(__ATOMIC_ACQUIRE, "agent");
            asm volatile("s_waitcnt vmcnt(0)" ::: "memory");
        }
    }
    __syncthreads();
}

constexpr int N_PHASES = 15;
__global__ void __launch_bounds__(512, 2) mega(Params p) {
    extern __shared__ __attribute__((aligned(16))) unsigned char lds_raw[];
    LAS unsigned char* lds = (LAS unsigned char*)lds_raw;
    cg::grid_group grid = cg::this_grid();
    unsigned char* ws = getpp().gws();
    const int G = gridDim.x, bid = blockIdx.x;
#ifndef ONLY_PHASE
#define ONLY_PHASE -1
#endif
#define IN(k) ((ONLY_PHASE < 0 || ONLY_PHASE == (k)) && p.ph_lo <= (k) && (k) < p.ph_hi)
    volatile LAS unsigned* xst = (volatile LAS unsigned*)(lds + 163840 - 16);
    if (threadIdx.x < 4) xst[threadIdx.x] = 0u;
    __syncthreads();
    const XcdBarrier xbar = xcd_barrier_post((unsigned*)(ws + OFF_BAR), xst);
    if (p.ph_hi < 0) grid.sync();
#define SEAM(k) do { if ((k) + 1 < p.ph_hi) xcd_barrier(xbar); } while (0)
    if (IN(0)) { const PPv q = getpp(); phase_prep(q, lds); SEAM(0); }
    if (IN(1)) { const PPv q = getpp();
        phase_meta_proj(q, lds);
        StaticOrder S; S.init(ws + OFF_HB, ws + OFF_WIN, T, NCOLS1, 1024, G, bid);
        EpiProj E{(bf16_t*)(ws + OFF_PRKV), (bf16_t*)(ws + OFF_PCONV), (bf16_t*)q.gout(), (const float*)(ws + OFF_RSTD1)};
        gemm_phase<false>(lds, 1024, S, E);
        SEAM(1);
    }
    if (IN(2)) { const PPv q = getpp(); phase_lprep_conv(q); SEAM(2); }
    if (IN(3)) { const PPv q = getpp();
        phase_meta_lora(q);
        StaticOrder S; S.init(ws + OFF_L + (size_t)NMETA * 256 * 2, ws + OFF_W2, T, 1536, 256, G, bid);
        EpiL E{ws, q.gin(10), q.gin(13)};
        gemm_phase<false>(lds, 256, S, E);
        SEAM(3);
    }
    if (IN(4)) { const PPv q = getpp(); phase_scanprep(q, lds); SEAM(4); }
    if (IN(5)) { const PPv q = getpp(); phase_recur(q, lds); SEAM(5); }
    if (IN(6)) { const PPv q = getpp(); phase_gn(q, lds); SEAM(6); }
    if (IN(7)) { const PPv q = getpp();
        MergeOrder S; S.so.init(ws + OFF_Z, ws + OFF_WR, T, 1024, 512, G, bid); S.A1 = (const char*)(ws + OFF_C); S.B1 = (const char*)(ws + OFF_WC);
        EpiMergeFused E{(bf16_t*)(ws + OFF_MERGED), (const bf16_t*)q.gout()};
        gemm_phase<false>(lds, 512, S, E);
        SEAM(7);
    }
    if (IN(9)) { const PPv q = getpp();
        StaticOrder S; S.init(ws + OFF_MERGED, ws + OFF_WO, T, 1024, 1024, G, bid);
        EpiO E{q.gin(0), q.gout(), (bf16_t*)(ws + OFF_HB2), ws + OFF_HB8};
        gemm_phase<false>(lds, 1024, S, E);
        SEAM(9);
    }
    if (IN(10)) { const PPv q = getpp(); phase_router(q, lds); SEAM(10); }
    if (IN(11)) { const PPv q = getpp(); phase_lists(q, lds); SEAM(11); }
    if (IN(12)) { const PPv q = getpp();
        const int* TILEE = (const int*)(ws + OFF_TILEE);
        MoeOrder S; S.A = (const char*)(ws + OFF_HB8); S.Bt = (const char*)(ws + OFF_WGU); S.K = 512; S.estride = (size_t)2048 * 1024;
        S.tile_e = TILEE; S.rowtok = (const int*)(ws + OFF_ROWTOK); S.ntiles = TILEE[1000]; S.nnt = 8; S.G = G; S.c = bid; S.gather = true;
        EpiMoe1 E{ws + OFF_ACT, (const float*)(ws + OFF_ROWRS), q.gin(31), q.gin(33)};
        gemm_phase<true, true>(lds, 512, S, E);
        SEAM(12);
    }
    if (IN(13)) { const PPv q = getpp();
        const int* TILEE = (const int*)(ws + OFF_TILEE);
        MoeOrder S; S.A = (const char*)(ws + OFF_ACT); S.Bt = (const char*)(ws + OFF_WD); S.K = 512; S.estride = (size_t)1024 * 1024;
        S.tile_e = TILEE; S.rowtok = nullptr; S.ntiles = TILEE[1000]; S.nnt = 4; S.G = G; S.c = bid; S.gather = false;
        EpiMoe2 E{(unsigned char*)q.gout(), (const int*)(ws + OFF_ROWSLOT), (const float*)(ws + OFF_ROWW), q.gin(35)};
        gemm_phase<false, true>(lds, 512, S, E);
        SEAM(13);
    }
    if (IN(14)) { const PPv q = getpp(); phase_final(q); }
}

extern "C" void kernel_launch(void* const* d_in, const int* in_sizes, int n_in, void* d_out, int out_size, void* d_ws, size_t ws_size,
                              hipStream_t stream) {
    constexpr size_t kDynLds = 160 * 1024;
    static int grid_blocks = 0;
    if (!grid_blocks) {
        int dev = 0, cus = 0, per_cu = 0;
        (void)hipGetDevice(&dev);
        (void)hipDeviceGetAttribute(&cus, hipDeviceAttributeMultiprocessorCount, dev);
        (void)hipFuncSetAttribute((const void*)mega, hipFuncAttributeMaxDynamicSharedMemorySize, (int)kDynLds);
        (void)hipOccupancyMaxActiveBlocksPerMultiprocessor(&per_cu, mega, 512, kDynLds);
        if (per_cu > 1) per_cu = 1;
        grid_blocks = cus * per_cu;
        fprintf(stderr, "cus=%d per_cu=%d ws_size=%zu need=%zu\n", cus, per_cu, ws_size, (size_t)WS_NEED);
    }
    if (ws_size < WS_NEED || n_in < 37 || grid_blocks < 128) { fprintf(stderr, "kernel_launch: unsupported configuration\n"); return; }
    Params p{};
    for (int i = 0; i < 37; ++i) p.in[i] = (const float*)d_in[i];
    p.out = (float*)d_out;
    p.ws = (unsigned char*)d_ws;
    p.ph_lo = 0; p.ph_hi = N_PHASES;
    (void)hipMemsetAsync((unsigned char*)d_ws + OFF_BAR, 0, 16384, stream);
    void* args[] = {&p};
    hipError_t e = hipLaunchCooperativeKernel((void*)mega, dim3(grid_blocks), dim3(512), args, kDynLds, stream);
    if (e != hipSuccess) fprintf(stderr, "cooperative launch failed: %s (grid %d)\n", hipGetErrorString(e), grid_blocks);
}
```

```cpp
#include <hip/hip_runtime.h>
#include <hip/hip_cooperative_groups.h>
#include <cstdio>
namespace cg = cooperative_groups;

#define LAS __attribute__((address_space(3)))
typedef unsigned short bf16_t;
typedef short bf16x8 __attribute__((ext_vector_type(8)));
typedef float f32x4 __attribute__((ext_vector_type(4)));
typedef float f32x2 __attribute__((ext_vector_type(2)));
typedef unsigned u32x4 __attribute__((ext_vector_type(4)));
typedef unsigned u32x2 __attribute__((ext_vector_type(2)));
#define LO2(v) __builtin_shufflevector(v, v, 0, 1)
#define HI2(v) __builtin_shufflevector(v, v, 2, 3)

constexpr int D = 1024, NBATCH = 8, SEQ = 4096, NMETA = 16;
constexpr int T = NBATCH * SEQ;
constexpr int NR = T + NMETA;
constexpr int NRP = 33024;
constexpr int PCOLS1 = 3584;
constexpr int NCOLS1 = 5632;
constexpr int NE = 32, TOPK = 4, DFF = 1024;
constexpr int MAXROWS = T * TOPK + NE * 256;
constexpr int MAXTILES = MAXROWS / 256;
constexpr float NORM_EPS = 1e-5f, LNX_EPS = 64e-5f;

constexpr int NCHUNK = 257, NUNITS = 64 * NCHUNK;
constexpr int REC_BYTES = 13568;
constexpr int RO_WH = 0, RO_RT = 2048, RO_U0T = 4096, RO_VT = 6144, RO_BKT = 8192, RO_ARK = 12288, RO_WCC = 13312;
constexpr int SLOT_BYTES = 15680, SO_G = 13568, SO_COEF = 15616, NSLOT = 9;
constexpr size_t SZ_ACT = (size_t)MAXROWS * 1024 * 2;
constexpr size_t SZ_WGU = (size_t)NE * 2048 * 1024 * 2;
constexpr size_t SZ_WD = (size_t)NE * 1024 * 1024 * 2;
constexpr size_t SZ_HB = (size_t)T * 1024 * 2;
constexpr size_t OFF_WGU = 0;
constexpr size_t OFF_HB8 = OFF_WGU + (size_t)NE * 2048 * 1024;
constexpr size_t OFF_WD = OFF_WGU + SZ_WGU;
constexpr size_t OFF_ACT = OFF_WD + SZ_WD;
constexpr size_t OFF_HB2 = OFF_ACT + SZ_ACT;
constexpr size_t OFF_RT = OFF_HB2 + SZ_HB;
constexpr size_t OFF_TOPI = OFF_RT;
constexpr size_t OFF_TOPW = OFF_TOPI + (size_t)T * 16;
constexpr size_t OFF_RANK = OFF_TOPW + (size_t)T * 16;
constexpr size_t OFF_RSTD2 = OFF_RANK + (size_t)T * 16;
constexpr size_t OFF_ROWTOK = OFF_RSTD2 + (size_t)T * 4;
constexpr size_t OFF_ROWSLOT = OFF_ROWTOK + (size_t)MAXROWS * 4;
constexpr size_t OFF_ROWW = OFF_ROWSLOT + (size_t)MAXROWS * 4;
constexpr size_t OFF_ROWRS = OFF_ROWW + (size_t)MAXROWS * 4;
constexpr size_t OFF_TILEE = OFF_ROWRS + (size_t)MAXROWS * 4;
constexpr size_t OFF_GCNT = OFF_TILEE + 4096;
constexpr size_t OFF_SM = OFF_GCNT + 256;
constexpr size_t OFF_WR = OFF_SM;
constexpr size_t OFF_WC = OFF_WR + (size_t)1024 * 512 * 2;
constexpr size_t OFF_WO = OFF_WC + (size_t)1024 * 512 * 2;
constexpr size_t OFF_W2 = OFF_WO + (size_t)1024 * 1024 * 2;
constexpr size_t OFF_RSTD1 = OFF_W2 + (size_t)1536 * 256 * 2;
constexpr size_t OFF_WRG = OFF_RSTD1 + (size_t)NRP * 4;
constexpr size_t OFF_BAR = OFF_WRG + (size_t)1024 * 32 * 4;
constexpr size_t WS_NEED = OFF_BAR + 16384;
constexpr size_t OFF_PRKV = 0;
constexpr size_t SZ_PRKV = (size_t)NR * 1536 * 2;
constexpr size_t OFF_LD = OFF_PRKV + SZ_PRKV;
constexpr size_t OFF_A = OFF_LD + (size_t)NRP * 512 * 4;
constexpr size_t OFF_X8 = OFF_LD;
constexpr size_t OFF_WIN8 = OFF_X8 + (size_t)T * 1024;
static_assert(OFF_WIN8 + (size_t)2048 * 1024 <= OFF_A, "layout");
constexpr size_t OFF_CH = OFF_A + (size_t)NRP * 512 * 2;
constexpr size_t OFF_PCONV = OFF_CH;
constexpr size_t SZ_PCONV = (size_t)NR * 2048 * 2;
constexpr size_t OFF_HB = OFF_PCONV + SZ_PCONV;
constexpr size_t OFF_L = OFF_HB + SZ_HB;
constexpr size_t OFF_WIN = OFF_L + (size_t)NRP * 256 * 2;
constexpr size_t CH_END = OFF_WIN + (size_t)NCOLS1 * 1024 * 2;
constexpr size_t OFF_MERGED = OFF_CH;
constexpr size_t OFF_G = CH_END;
constexpr size_t OFF_C = OFF_G + (size_t)NRP * 512 * 2;
constexpr size_t OFF_Z = OFF_C + (size_t)T * 512 * 2;
constexpr size_t OFF_COEF = OFF_Z + (size_t)T * 512 * 2;
constexpr size_t EARLY_END = OFF_COEF + (size_t)NR * 8 * 4;
static_assert(EARLY_END <= OFF_RT, "early buffers overflow");
static_assert(OFF_CH + (size_t)NUNITS * REC_BYTES <= CH_END, "chunk records overflow");
static_assert(OFF_CH >= OFF_WD + SZ_WD, "expert weights (written during the scan) must not touch live scan buffers");
static_assert(OFF_MERGED + SZ_HB <= OFF_HB2, "layout");
static_assert(OFF_PRKV % 16 == 0 && OFF_LD % 16 == 0 && OFF_A % 16 == 0 && OFF_CH % 16 == 0 && OFF_HB % 16 == 0 && OFF_L % 16 == 0 && OFF_WIN % 16 == 0 && OFF_G % 16 == 0 && OFF_C % 16 == 0 && OFF_Z % 16 == 0 && OFF_COEF % 16 == 0, "align");

#define GAS __attribute__((address_space(1)))
#define CAS __attribute__((address_space(4)))
struct Params {
    const float* in[37];
    float* out;
    unsigned char* ws;
    int ph_lo, ph_hi;
};
struct ParamsD {
    const GAS float* in[37];
    GAS float* out;
    GAS unsigned char* ws;
    int ph_lo, ph_hi;
};
static_assert(sizeof(Params) == sizeof(ParamsD), "argument views");
struct PPv {
    const CAS ParamsD* k;
    __device__ __forceinline__ const float* gin(int i) const { return (const float*)k->in[i]; }
    __device__ __forceinline__ float* gout() const { return (float*)k->out; }
    __device__ __forceinline__ unsigned char* gws() const { return (unsigned char*)k->ws; }
};
__device__ __forceinline__ PPv getpp() { const CAS ParamsD* k = (const CAS ParamsD*)__builtin_amdgcn_kernarg_segment_ptr(); asm volatile("" : "+s"(k)); return PPv{k}; }

typedef __bf16 bf16x2v __attribute__((ext_vector_type(2)));
__device__ __forceinline__ unsigned cvt_pk_bf16(float lo, float hi) { const f32x2 v = {lo, hi}; return __builtin_bit_cast(unsigned, __builtin_convertvector(v, bf16x2v)); }
__device__ __forceinline__ unsigned pk4_fp8(float a, float b, float c, float d) { int w = __builtin_amdgcn_cvt_pk_fp8_f32(a, b, 0, false); w = __builtin_amdgcn_cvt_pk_fp8_f32(c, d, w, true); return (unsigned)w; }
constexpr float W8_SCALE = 32.0f, W8_INV = 1.0f / 32.0f;
__device__ __forceinline__ bf16_t f2bf(float f) { unsigned u = __float_as_uint(f); u += 0x7FFFu + ((u >> 16) & 1u); return (bf16_t)(u >> 16); }
__device__ __forceinline__ float bf2f(bf16_t b) { return __uint_as_float(((unsigned)b) << 16); }
__device__ __forceinline__ float bflo(unsigned w) { return __uint_as_float(w << 16); }
__device__ __forceinline__ float bfhi(unsigned w) { return __uint_as_float(w & 0xFFFF0000u); }
__device__ __forceinline__ float sigmoidf_(float x) { return __builtin_amdgcn_rcpf(1.0f + __expf(-x)); }
__device__ __forceinline__ float wave_sum(float v) {
#pragma unroll
    for (int o = 32; o >= 1; o >>= 1) v += __shfl_xor(v, o);
    return v;
}
__device__ __forceinline__ float wave_sum_dpp(float v);
__device__ __forceinline__ int prev_row(int row, int d) {
    if (row < NMETA) return row - d >= 0 ? row - d : -1;
    const int s = (row - NMETA) & (SEQ - 1);
    return s >= d ? row - d : NMETA + s - d;
}

constexpr int BM = 256, BK = 64, HALF = 128, HTB = HALF * BK * 2, STAGE_BYTES = 8 * HTB, NXCD = 8, WGM = 8;
__device__ __forceinline__ int lds_byte(int r, int c) { const int st = (r >> 4) * 2 + (c >> 5), rr = r & 15, cc = c & 31, ob = rr * 64 + cc * 2; return st * 1024 + (ob ^ (((ob >> 9) & 1) << 5)); }
__device__ __forceinline__ void stage_rc(int b, int& R, int& C) { const int st = b / 1024, sb = b % 1024, swz = sb ^ (((sb >> 9) & 1) << 5); R = (st >> 1) * 16 + swz / 64; C = (st & 1) * 32 + (swz % 64) / 2; }
__device__ __forceinline__ int perm32(int rho) { const int n = rho >> 4, i = rho & 15; return 8 * (i >> 2) + 4 * n + (i & 3); }

struct Unit { int pm, pn, aux; };

struct StaticOrder {
    const char* A; const char* Bt; int K;
    int nM, nN, nwg, G, c;
    __device__ void init(const void* A_, const void* Bt_, int M, int N, int K_, int G_, int c_) { A = (const char*)A_; Bt = (const char*)Bt_; K = K_; nM = M / BM; nN = N / BM; nwg = nM * nN; G = G_; c = c_; }
    __device__ bool next(int i, Unit& u) const {
        const long L = (long)i * G + c; if (L >= nwg) return false;
        int wgid = (int)L; { const int q = nwg / NXCD, r = nwg % NXCD, xcd = wgid % NXCD, off = wgid / NXCD; wgid = (xcd < r ? xcd * (q + 1) : r * (q + 1) + (xcd - r) * q) + off; }
        const int nig = WGM * nN, gid = wgid / nig, fm = gid * WGM, gsz = (nM - fm) < WGM ? (nM - fm) : WGM;
        u.pm = fm + ((wgid % nig) % gsz); u.pn = (wgid % nig) / gsz; u.aux = 0; return true;
    }
    __device__ __forceinline__ const char* a_ptr(const Unit& u) const { return A + (size_t)u.pm * 256 * K * 2; }
    __device__ __forceinline__ const char* b_ptr(const Unit& u) const { return Bt + (size_t)u.pn * 256 * K * 2; }
    __device__ __forceinline__ int gather_row(const Unit&, int) const { return 0; }
    __device__ __forceinline__ const void* gather_src(const Unit&, int) const { return nullptr; }
};
struct MoeOrder {
    const char* A; const char* Bt; int K; size_t estride;
    const int* tile_e; const int* rowtok; int ntiles, nnt, G, c; bool gather;
    __device__ bool next(int i, Unit& u) const {
        int mt, nt;
        if ((G & 7) == 0 && ((G >> 3) % nnt) == 0) {
            const int x = c & 7, j = c >> 3, per = (G >> 3) / nnt;
            mt = (i * 8 + x) * per + j / nnt; nt = j % nnt;
        } else { const long L = (long)i * G + c; mt = (int)(L / nnt); nt = (int)(L % nnt); }
        if (mt >= ntiles) return false;
        u.pm = mt; u.pn = nt; u.aux = tile_e[mt]; return true;
    }
    __device__ __forceinline__ const char* a_ptr(const Unit& u) const { return gather ? A : A + (size_t)u.pm * 256 * K * 2; }
    __device__ __forceinline__ const char* b_ptr(const Unit& u) const { return Bt + (size_t)u.aux * estride + (size_t)u.pn * 256 * K * 2; }
    __device__ __forceinline__ int gather_row(const Unit& u, int r) const { return rowtok[u.pm * 256 + r]; }
    __device__ __forceinline__ const void* gather_src(const Unit& u, int lane) const { return rowtok + u.pm * 256 + lane * 4; }
};

typedef int i32x4 __attribute__((ext_vector_type(4)));
typedef int i32x8 __attribute__((ext_vector_type(8)));
template <bool GATHER, bool FP8 = false, class Epi, class Sched>
__device__ __forceinline__ void gemm_phase(LAS unsigned char* lds, const int K_, const Sched& S, const Epi& E) {
    int K = K_; asm volatile("" : "+s"(K));
    const int tid = threadIdx.x, wid = __builtin_amdgcn_readfirstlane(tid >> 6), lane = tid & 63, wr = wid >> 2, wc = wid & 3, fr = lane & 15, fq = lane >> 4;
    const int nt = K / BK;
    unsigned voffA[2], voffB[2]; int Rr[2], Cc[2];
#pragma unroll
    for (int i = 0; i < 2; ++i) { int R, C; stage_rc(tid * 16 + i * 8192, R, C); const int Rb = (R & ~31) + perm32(R & 31);
        Rr[i] = R; Cc[i] = C; voffA[i] = (unsigned)(R * K + C) * 2u; voffB[i] = (unsigned)(Rb * K + C) * 2u; }
    const size_t kstep = (size_t)(BK * 2);
    const size_t hstep = (size_t)HALF * K * 2;
    const unsigned ldsw = (unsigned)wid * 1024u;
    const int aoff = lds_byte(wr * 64 + fr, fq * 8), boff = lds_byte(wc * 32 + fr, fq * 8);
    unsigned vgc[2][2], vgn[2][2];
    LAS unsigned char* const parbase = lds + STAGE_BYTES;
    constexpr int NPAR = Epi::NPAR;
#define G_PAR_ISSUE(unit, uidx, hasnx, nxunit) do { \
        LAS unsigned char* _ps = parbase + ((uidx) & 1) * 4096; \
        if (wid < NPAR) __builtin_amdgcn_global_load_lds((const unsigned*)E.par_src(unit, wid, lane), (LAS unsigned*)(_ps + wid * 1024), 16, 0, 0); \
        if (GATHER && (hasnx) && wid == NPAR) __builtin_amdgcn_global_load_lds((const unsigned*)S.gather_src(nxunit, lane), (LAS unsigned*)(_ps + NPAR * 1024), 16, 0, 0); } while (0)
#define G_CAT8(x0, x1) __builtin_shufflevector(__builtin_bit_cast(i32x4, x0), __builtin_bit_cast(i32x4, x1), 0, 1, 2, 3, 4, 5, 6, 7)
#define G_SA(b, h) (((b) * 2 + (h)) * HTB)
#define G_SB(b, h) ((4 + (b) * 2 + (h)) * HTB)
#define G_STAGE(bufoff, gbase, voff) do { _Pragma("unroll") for (int _i = 0; _i < 2; ++_i) \
        __builtin_amdgcn_global_load_lds((const unsigned*)((const char*)(gbase) + (voff)[_i]), (LAS unsigned*)(lds + (bufoff) + ldsw + _i * 8192), 16, 0, 0); } while (0)
#define G_STAGE_A(bufoff, kptr, h, VG) do { if (GATHER) { G_STAGE(bufoff, kptr, VG[h]); } else { G_STAGE(bufoff, (kptr) + (h) * hstep, voffA); } } while (0)
#define G_LDA(dst, b, h) do { _Pragma("unroll") for (int m = 0; m < 4; ++m) { \
        if (FP8) dst##8[m] = G_CAT8(*(const LAS bf16x8*)(lds + G_SA(b, h) + aoff + m * 2048), *(const LAS bf16x8*)(lds + G_SA(b, h) + aoff + m * 2048 + 1024)); \
        else { _Pragma("unroll") for (int k = 0; k < 2; ++k) dst[m][k] = *(const LAS bf16x8*)(lds + G_SA(b, h) + aoff + m * 2048 + k * 1024); } } } while (0)
#define G_LDB(dst, b, h) do { _Pragma("unroll") for (int n = 0; n < 2; ++n) { \
        if (FP8) dst##8[n] = G_CAT8(*(const LAS bf16x8*)(lds + G_SB(b, h) + boff + n * 2048), *(const LAS bf16x8*)(lds + G_SB(b, h) + boff + n * 2048 + 1024)); \
        else { _Pragma("unroll") for (int k = 0; k < 2; ++k) dst[n][k] = *(const LAS bf16x8*)(lds + G_SB(b, h) + boff + n * 2048 + k * 1024); } } } while (0)
#define G_MMA(ai, bj, At, Bt) do { __builtin_amdgcn_s_setprio(1); _Pragma("unroll") for (int m = 0; m < 4; ++m) _Pragma("unroll") for (int n = 0; n < 2; ++n) { \
        if (FP8) asm volatile("v_mfma_scale_f32_16x16x128_f8f6f4 %0, %1, %2, %0, %3, %3 op_sel_hi:[0,0,0]" : "+v"(acc[ai][bj][m][n]) : "v"(Bt##8[n]), "v"(At##8[m]), "v"(sc8)); \
        else { _Pragma("unroll") for (int k = 0; k < 2; ++k) acc[ai][bj][m][n] = __builtin_amdgcn_mfma_f32_16x16x32_bf16(Bt[n][k], At[m][k], acc[ai][bj][m][n], 0, 0, 0); } } \
        __builtin_amdgcn_s_setprio(0); } while (0)
#define G_WAIT_V(n) asm volatile("s_waitcnt vmcnt(" #n ")" ::: "memory")
#define G_WAIT_L(n) asm volatile("s_waitcnt lgkmcnt(" #n ")" ::: "memory")
#define G_BAR __builtin_amdgcn_s_barrier()
#define G_SCHED __builtin_amdgcn_sched_barrier(0)
    Unit cur, nxt;
    int ui = 0;
    if (!S.next(0, cur)) return;
    f32x4 acc[2][2][4][2];
#pragma unroll
    for (int a = 0; a < 2; ++a)
#pragma unroll
        for (int b = 0; b < 2; ++b)
#pragma unroll
            for (int m = 0; m < 4; ++m)
#pragma unroll
                for (int n = 0; n < 2; ++n) acc[a][b][m][n] = (f32x4){0.f, 0.f, 0.f, 0.f};
    bf16x8 At[4][2], B0[2][2], B1[2][2];
    i32x8 At8[4], B08[2], B18[2];
    int sc8 = 0x7F7F7F7F; asm volatile("" : "+v"(sc8));
    const char* cA = S.a_ptr(cur); const char* cB = S.b_ptr(cur);
    if (GATHER) {
#pragma unroll
        for (int h = 0; h < 2; ++h)
#pragma unroll
            for (int i = 0; i < 2; ++i) vgc[h][i] = (unsigned)(S.gather_row(cur, h * HALF + Rr[i]) * K + Cc[i]) * 2u;
    }
    { Unit n1; const bool hn1 = S.next(1, n1); G_PAR_ISSUE(cur, 0, hn1, n1); }
    G_STAGE(G_SB(0, 0), cB, voffB); G_STAGE_A(G_SA(0, 0), cA, 0, vgc); G_STAGE(G_SB(0, 1), cB + hstep, voffB); G_STAGE_A(G_SA(0, 1), cA, 1, vgc);
    if (wr == 1) G_BAR;
    G_WAIT_V(4); G_BAR;
    G_STAGE(G_SB(1, 0), cB + kstep, voffB); G_STAGE_A(G_SA(1, 0), cA + kstep, 0, vgc); G_STAGE(G_SB(1, 1), cB + hstep + kstep, voffB);
    G_WAIT_V(6); G_BAR;
    for (;;) {
        const bool has_next = S.next(ui + 1, nxt);
        const char* nA = has_next ? S.a_ptr(nxt) : cA; const char* nB = has_next ? S.b_ptr(nxt) : cB;
        if (ui > 0) G_PAR_ISSUE(cur, ui, has_next, nxt);
        if (GATHER) {
#pragma unroll
            for (int h = 0; h < 2; ++h)
#pragma unroll
                for (int i = 0; i < 2; ++i) vgn[h][i] = vgc[h][i];
        }
        for (int t = 0; t < nt; t += 2) {
            const bool last = (t == nt - 2);
            const char* a1 = cA + (size_t)(t + 1) * kstep;
            const char* a2 = last ? nA : cA + (size_t)(t + 2) * kstep; const char* b2 = last ? nB : cB + (size_t)(t + 2) * kstep;
            const char* a3 = a2 + kstep; const char* b3 = b2 + kstep;
            unsigned vg2[2][2];
            if (GATHER) {
#pragma unroll
                for (int h = 0; h < 2; ++h)
#pragma unroll
                    for (int i = 0; i < 2; ++i) vg2[h][i] = last ? vgn[h][i] : vgc[h][i];
            }
            G_LDB(B0, 0, 0); G_SCHED; G_LDA(At, 0, 0); G_STAGE_A(G_SA(1, 1), a1, 1, vgc);
            G_WAIT_L(8); G_BAR; G_WAIT_L(0); G_MMA(0, 0, At, B0); G_BAR; G_SCHED;
            G_LDB(B1, 0, 1); G_STAGE(G_SB(0, 0), b2, voffB);
            G_BAR; G_WAIT_L(0); G_MMA(0, 1, At, B1); G_BAR;
            G_LDA(At, 0, 1); G_STAGE_A(G_SA(0, 0), a2, 0, vg2);
            G_BAR; G_WAIT_L(0); G_MMA(1, 0, At, B0); G_BAR; G_SCHED;
            G_STAGE(G_SB(0, 1), b2 + hstep, voffB);
            G_WAIT_V(6); G_BAR; G_MMA(1, 1, At, B1); G_BAR;
            G_LDB(B0, 1, 0); G_SCHED; G_LDA(At, 1, 0); G_STAGE_A(G_SA(0, 1), a2, 1, vg2);
            G_WAIT_L(8); G_BAR; G_WAIT_L(0); G_MMA(0, 0, At, B0); G_BAR; G_SCHED;
            G_LDB(B1, 1, 1); G_STAGE(G_SB(1, 0), b3, voffB);
            G_BAR; G_WAIT_L(0); G_MMA(0, 1, At, B1); G_BAR;
            G_LDA(At, 1, 1); G_STAGE_A(G_SA(1, 0), a3, 0, vg2);
            G_BAR; G_WAIT_L(0); G_MMA(1, 0, At, B0); G_BAR; G_SCHED;
            G_STAGE(G_SB(1, 1), b3 + hstep, voffB);
            G_WAIT_V(6); G_BAR; G_MMA(1, 1, At, B1); G_BAR;
            if (GATHER && t == 0 && has_next) {
                const LAS int* rows = (const LAS int*)(parbase + (ui & 1) * 4096 + NPAR * 1024);
#pragma unroll
                for (int h = 0; h < 2; ++h)
#pragma unroll
                    for (int i = 0; i < 2; ++i) vgn[h][i] = (unsigned)(rows[h * HALF + Rr[i]] * K + Cc[i]) * 2u;
            }
        }
        if (FP8) asm volatile("s_nop 15\n\ts_nop 15" ::: "memory");
        const bool keep_acc = E(acc, cur, wr, wc, fr, fq, (const LAS unsigned char*)(parbase + (ui & 1) * 4096));
        if (!has_next) break;
        if (!keep_acc)
#pragma unroll
        for (int a = 0; a < 2; ++a)
#pragma unroll
            for (int b = 0; b < 2; ++b)
#pragma unroll
                for (int m = 0; m < 4; ++m)
#pragma unroll
                    for (int n = 0; n < 2; ++n) acc[a][b][m][n] = (f32x4){0.f, 0.f, 0.f, 0.f};
        cur = nxt; cA = nA; cB = nB; ++ui;
        if (GATHER) {
#pragma unroll
            for (int h = 0; h < 2; ++h)
#pragma unroll
                for (int i = 0; i < 2; ++i) vgc[h][i] = vgn[h][i];
        }
    }
    G_WAIT_V(0);
    if (wr == 0) G_BAR;
    G_BAR;
#undef G_PAR_ISSUE
#undef G_SA
#undef G_SB
#undef G_STAGE
#undef G_STAGE_A
#undef G_LDA
#undef G_LDB
#undef G_MMA
#undef G_CAT8
#undef G_WAIT_V
#undef G_WAIT_L
#undef G_BAR
#undef G_SCHED
}

struct EpiProj {
    bf16_t* prkv; bf16_t* pconv; bf16_t* gates; const float* rstd1; int pn0; float osc;
    static constexpr int NPAR = 1;
    __device__ __forceinline__ const void* par_src(const Unit& u, int, int lane) const { return rstd1 + NMETA + u.pm * BM + lane * 4; }
    __device__ __forceinline__ bool operator()(const f32x4 (&acc)[2][2][4][2], const Unit& u, int wr, int wc, int fr, int fq, const LAS unsigned char* par) const {
        const int row0 = u.pm * BM + wr * 64 + fr;
        const int pn = u.pn + pn0;
        const bool isg = pn >= 14;
        float rsv[2][4];
#pragma unroll
        for (int ai = 0; ai < 2; ++ai)
#pragma unroll
            for (int m = 0; m < 4; ++m) rsv[ai][m] = ((const LAS float*)par)[wr * 64 + fr + ai * HALF + m * 16] * osc;
#pragma unroll
        for (int ai = 0; ai < 2; ++ai)
#pragma unroll
            for (int m = 0; m < 4; ++m) {
                const int row = row0 + ai * HALF + m * 16;
                const float rs = isg ? rsv[ai][m] * -1.44269504089f : rsv[ai][m]; const f32x2 rs2 = {rs, rs}, one2 = {1.0f, 1.0f};
                bf16_t* rowp = isg ? gates + (size_t)row * 2048 + (pn - 14) * 256 + wc * 32 + 8 * fq
                             : (pn < 6 ? prkv + (size_t)(NMETA + row) * 1536 + pn * 256 : pconv + (size_t)(NMETA + row) * 2048 + (pn - 6) * 256) + wc * 32 + 8 * fq;
#pragma unroll
                for (int bj = 0; bj < 2; ++bj) {
                    const f32x4 a0 = acc[ai][bj][m][0], a1 = acc[ai][bj][m][1];
                    f32x2 p[4] = {LO2(a0) * rs2, HI2(a0) * rs2, LO2(a1) * rs2, HI2(a1) * rs2};
                    if (isg) {
#pragma unroll
                        for (int q = 0; q < 4; ++q) { const f32x2 e = {__builtin_amdgcn_exp2f(p[q][0]), __builtin_amdgcn_exp2f(p[q][1])}; const f32x2 d = e + one2; p[q] = (f32x2){__builtin_amdgcn_rcpf(d[0]), __builtin_amdgcn_rcpf(d[1])}; }
                    }
                    u32x4 w; w.x = cvt_pk_bf16(p[0][0], p[0][1]); w.y = cvt_pk_bf16(p[1][0], p[1][1]); w.z = cvt_pk_bf16(p[2][0], p[2][1]); w.w = cvt_pk_bf16(p[3][0], p[3][1]);
                    *(u32x4*)(rowp + bj * HALF) = w;
                }
            }
        return false;
    }
};
struct EpiL {
    static constexpr int NPAR = 0;
    __device__ __forceinline__ const void* par_src(const Unit&, int, int) const { return nullptr; }
    unsigned char* wsb; const float* w0; const float* a0;
    __device__ __forceinline__ bool operator()(const f32x4 (&acc)[2][2][4][2], const Unit& u, int wr, int wc, int fr, int fq, const LAS unsigned char* par) const {
        const int row0 = NMETA + u.pm * BM + wr * 64 + fr;
        const int seg = u.pn >> 1;
        const int cb = (u.pn & 1) * 256 + wc * 32 + 8 * fq;
        const float* bias = seg == 0 ? w0 : a0;
        f32x4 bv[2][2];
#pragma unroll
        for (int bj = 0; bj < 2; ++bj) {
            bv[bj][0] = seg < 2 ? *(const f32x4*)(bias + cb + bj * HALF) : (f32x4){0.f, 0.f, 0.f, 0.f};
            bv[bj][1] = seg < 2 ? *(const f32x4*)(bias + cb + bj * HALF + 4) : (f32x4){0.f, 0.f, 0.f, 0.f};
        }
        const float sc = seg == 0 ? -0.60653065971f : 1.0f;
        bf16_t* ob = (bf16_t*)(wsb + (seg == 0 ? OFF_LD : seg == 1 ? OFF_A : OFF_G));
#pragma unroll
        for (int ai = 0; ai < 2; ++ai)
#pragma unroll
            for (int m = 0; m < 4; ++m) {
                const int row = row0 + ai * HALF + m * 16;
#pragma unroll
                for (int bj = 0; bj < 2; ++bj) {
                    const int c = cb + bj * HALF;
                    f32x4 v0 = acc[ai][bj][m][0] + bv[bj][0], v1 = acc[ai][bj][m][1] + bv[bj][1];
                    if (seg < 2) {
#pragma unroll
                        for (int j = 0; j < 4; ++j) { v0[j] = sc * sigmoidf_(v0[j]); v1[j] = sc * sigmoidf_(v1[j]); }
                    }
                    {
                        u32x4 w; w.x = cvt_pk_bf16(v0[0], v0[1]); w.y = cvt_pk_bf16(v0[2], v0[3]); w.z = cvt_pk_bf16(v1[0], v1[1]); w.w = cvt_pk_bf16(v1[2], v1[3]);
                        *(u32x4*)(ob + (size_t)row * 512 + c) = w;
                    }
                }
            }
        return false;
    }
};
template <int SECOND> struct EpiMerge {
    static constexpr int NPAR = 0;
    __device__ __forceinline__ const void* par_src(const Unit&, int, int) const { return nullptr; }
    bf16_t* merged; const bf16_t* gates;
    __device__ __forceinline__ bool operator()(const f32x4 (&acc)[2][2][4][2], const Unit& u, int wr, int wc, int fr, int fq, const LAS unsigned char* par) const {
        const int row0 = u.pm * BM + wr * 64 + fr, col0 = u.pn * BM + wc * 32 + 8 * fq;
#pragma unroll
        for (int ai = 0; ai < 2; ++ai)
#pragma unroll
            for (int m = 0; m < 4; ++m) {
                const int row = row0 + ai * HALF + m * 16;
#pragma unroll
                for (int bj = 0; bj < 2; ++bj) {
                    const int c = col0 + bj * HALF;
                    const u32x4 gw = *(const u32x4*)(gates + (size_t)row * 2048 + SECOND * 1024 + c);
                    f32x4 g0 = (f32x4){bflo(gw.x), bfhi(gw.x), bflo(gw.y), bfhi(gw.y)}, g1 = (f32x4){bflo(gw.z), bfhi(gw.z), bflo(gw.w), bfhi(gw.w)};
                    f32x4 v0 = acc[ai][bj][m][0] * g0, v1 = acc[ai][bj][m][1] * g1;
                    bf16_t* p = merged + (size_t)row * 1024 + c;
                    if (SECOND) {
                        const u32x4 ow = *(const u32x4*)p;
                        v0 += (f32x4){bflo(ow.x), bfhi(ow.x), bflo(ow.y), bfhi(ow.y)}; v1 += (f32x4){bflo(ow.z), bfhi(ow.z), bflo(ow.w), bfhi(ow.w)};
                    }
                    u32x4 w; w.x = cvt_pk_bf16(v0[0], v0[1]); w.y = cvt_pk_bf16(v0[2], v0[3]); w.z = cvt_pk_bf16(v1[0], v1[1]); w.w = cvt_pk_bf16(v1[2], v1[3]);
                    *(u32x4*)p = w;
                }
            }
        return false;
    }
};
struct MergeOrder {
    StaticOrder so; const char* A1; const char* B1;
    __device__ bool next(int i, Unit& u) const { const bool ok = so.next(i >> 1, u); u.aux = i & 1; return ok; }
    __device__ __forceinline__ const char* a_ptr(const Unit& u) const { return (u.aux ? A1 : so.A) + (size_t)u.pm * 256 * so.K * 2; }
    __device__ __forceinline__ const char* b_ptr(const Unit& u) const { return (u.aux ? B1 : so.Bt) + (size_t)u.pn * 256 * so.K * 2; }
    __device__ __forceinline__ int gather_row(const Unit&, int) const { return 0; }
    __device__ __forceinline__ const void* gather_src(const Unit&, int) const { return nullptr; }
};
struct EpiMergeFused {
    static constexpr int NPAR = 0;
    __device__ __forceinline__ const void* par_src(const Unit&, int, int) const { return nullptr; }
    bf16_t* merged; const bf16_t* gates;
    __device__ __forceinline__ bool operator()(f32x4 (&acc)[2][2][4][2], const Unit& u, int wr, int wc, int fr, int fq, const LAS unsigned char* par) const {
        const int row0 = u.pm * BM + wr * 64 + fr, col0 = u.pn * BM + wc * 32 + 8 * fq;
#pragma unroll
        for (int ai = 0; ai < 2; ++ai) {
            u32x4 gbw[4][2], gaw[4][2];
#pragma unroll
            for (int m = 0; m < 4; ++m)
#pragma unroll
                for (int bj = 0; bj < 2; ++bj) {
                    const bf16_t* gp = gates + (size_t)(row0 + ai * HALF + m * 16) * 2048 + col0 + bj * HALF;
                    gbw[m][bj] = *(const u32x4*)(gp + 1024);
                    gaw[m][bj] = u.aux == 0 ? *(const u32x4*)gp : (u32x4){0u, 0u, 0u, 0u};
                }
#pragma unroll
            for (int m = 0; m < 4; ++m)
#pragma unroll
                for (int bj = 0; bj < 2; ++bj) {
                    const int row = row0 + ai * HALF + m * 16, c = col0 + bj * HALF;
                    f32x2 gbp[4], res[4];
#pragma unroll
                    for (int q = 0; q < 4; ++q) { const unsigned wq = gbw[m][bj][q]; gbp[q] = (f32x2){fmaxf(bflo(wq), 1e-6f), fmaxf(bfhi(wq), 1e-6f)}; }
                    if (u.aux == 0) {
#pragma unroll
                        for (int q = 0; q < 4; ++q) {
                            const unsigned wq = gaw[m][bj][q];
                            const f32x2 gap = {bflo(wq), bfhi(wq)}, rc = {__builtin_amdgcn_rcpf(gbp[q][0]), __builtin_amdgcn_rcpf(gbp[q][1])};
                            const f32x2 sc = gap * rc;
                            f32x4& a4 = acc[ai][bj][m][q >> 1];
                            if (q & 1) { const f32x2 t = HI2(a4) * sc; a4[2] = t[0]; a4[3] = t[1]; } else { const f32x2 t = LO2(a4) * sc; a4[0] = t[0]; a4[1] = t[1]; }
                        }
                    } else {
#pragma unroll
                        for (int q = 0; q < 4; ++q) { const f32x4 a4 = acc[ai][bj][m][q >> 1]; res[q] = ((q & 1) ? HI2(a4) : LO2(a4)) * gbp[q]; }
                        u32x4 w; w.x = cvt_pk_bf16(res[0][0], res[0][1]); w.y = cvt_pk_bf16(res[1][0], res[1][1]); w.z = cvt_pk_bf16(res[2][0], res[2][1]); w.w = cvt_pk_bf16(res[3][0], res[3][1]);
                        *(u32x4*)(merged + (size_t)row * 1024 + c) = w;
                    }
                }
        }
        return u.aux == 0;
    }
};
struct EpiO {
    static constexpr int NPAR = 0;
    __device__ __forceinline__ const void* par_src(const Unit&, int, int) const { return nullptr; }
    const float* x; float* h1; bf16_t* hb2; unsigned char* hb8;
    __device__ __forceinline__ bool operator()(const f32x4 (&acc)[2][2][4][2], const Unit& u, int wr, int wc, int fr, int fq, const LAS unsigned char* par) const {
        const int row0 = u.pm * BM + wr * 64 + fr, col0 = u.pn * BM + wc * 32 + 8 * fq;
#pragma unroll
        for (int ai = 0; ai < 2; ++ai) {
            f32x4 xv[4][2][2];
#pragma unroll
            for (int m = 0; m < 4; ++m)
#pragma unroll
                for (int bj = 0; bj < 2; ++bj) {
                    const size_t o = (size_t)(row0 + ai * HALF + m * 16) * 1024 + col0 + bj * HALF;
                    xv[m][bj][0] = *(const f32x4*)(x + o); xv[m][bj][1] = *(const f32x4*)(x + o + 4);
                }
#pragma unroll
            for (int m = 0; m < 4; ++m)
#pragma unroll
                for (int bj = 0; bj < 2; ++bj) {
                    const size_t o = (size_t)(row0 + ai * HALF + m * 16) * 1024 + col0 + bj * HALF;
                    const f32x4 a0 = acc[ai][bj][m][0], a1 = acc[ai][bj][m][1];
                    const f32x2 p0 = LO2(a0) + LO2(xv[m][bj][0]), p1 = HI2(a0) + HI2(xv[m][bj][0]), p2 = LO2(a1) + LO2(xv[m][bj][1]), p3 = HI2(a1) + HI2(xv[m][bj][1]);
                    u32x4 w; w.x = cvt_pk_bf16(p0[0], p0[1]); w.y = cvt_pk_bf16(p1[0], p1[1]); w.z = cvt_pk_bf16(p2[0], p2[1]); w.w = cvt_pk_bf16(p3[0], p3[1]);
                    *(u32x4*)(hb2 + o) = w;
                    u32x2 w8; w8.x = pk4_fp8(p0[0], p0[1], p1[0], p1[1]); w8.y = pk4_fp8(p2[0], p2[1], p3[0], p3[1]);
                    *(u32x2*)(hb8 + o) = w8;
                }
        }
        return false;
    }
};
struct EpiMoe1 {
    unsigned char* act; const float* rowrs; const float* bg; const float* bu;
    static constexpr int NPAR = 2;
    __device__ __forceinline__ const void* par_src(const Unit& u, int piece, int lane) const {
        if (piece == 0) return rowrs + u.pm * BM + lane * 4;
        return (lane < 32 ? bg : bu) + (size_t)u.aux * DFF + u.pn * 128 + (lane & 31) * 4;
    }
    __device__ __forceinline__ bool operator()(const f32x4 (&acc)[2][2][4][2], const Unit& u, int wr, int wc, int fr, int fq, const LAS unsigned char* par) const {
        const int row0 = u.pm * BM + wr * 64 + fr, ff0 = u.pn * 128 + wc * 32 + 8 * fq;
        const LAS float* bgp = (const LAS float*)(par + 1024) + wc * 32 + 8 * fq; const LAS float* bup = bgp + 128;
        const f32x4 bg0 = *(const LAS f32x4*)bgp, bg1 = *(const LAS f32x4*)(bgp + 4), bu0 = *(const LAS f32x4*)bup, bu1 = *(const LAS f32x4*)(bup + 4);
        constexpr float KE = -1.702f * 1.44269504089f;
        const f32x2 ke2 = {KE, KE}, ike2 = {1.0f / KE, 1.0f / KE}, one2 = {1.0f, 1.0f};
        const f32x2 bgv[4] = {LO2(bg0) * ke2, HI2(bg0) * ke2, LO2(bg1) * ke2, HI2(bg1) * ke2}, buv[4] = {LO2(bu0), HI2(bu0), LO2(bu1), HI2(bu1)};
        float rsv[2][4];
#pragma unroll
        for (int ai = 0; ai < 2; ++ai)
#pragma unroll
            for (int m = 0; m < 4; ++m) rsv[ai][m] = ((const LAS float*)par)[wr * 64 + fr + ai * HALF + m * 16];
#pragma unroll
        for (int ai = 0; ai < 2; ++ai)
#pragma unroll
            for (int m = 0; m < 4; ++m) {
                const int row = row0 + ai * HALF + m * 16;
                const float rs = rsv[ai][m] * W8_INV;
                const f32x2 rs2 = {rs, rs}, rsk2 = {rs * KE, rs * KE};
                f32x2 res[4];
#pragma unroll
                for (int q = 0; q < 4; ++q) {
                    const f32x4 ag4 = acc[ai][0][m][q >> 1], au4 = acc[ai][1][m][q >> 1];
                    const f32x2 ag = (q & 1) ? HI2(ag4) : LO2(ag4), au = (q & 1) ? HI2(au4) : LO2(au4);
                    const f32x2 gk = ag * rsk2 + bgv[q], uu = au * rs2 + buv[q];
                    const f32x2 z = {fmaxf(gk[0], 7.0f * KE), fmaxf(gk[1], 7.0f * KE)};
                    const f32x2 up = {fminf(fmaxf(uu[0], -7.0f), 7.0f), fminf(fmaxf(uu[1], -7.0f), 7.0f)};
                    const f32x2 e = {__builtin_amdgcn_exp2f(z[0]), __builtin_amdgcn_exp2f(z[1])};
                    const f32x2 d = e + one2;
                    const f32x2 sg = {__builtin_amdgcn_rcpf(d[0]), __builtin_amdgcn_rcpf(d[1])};
                    res[q] = ((up * ike2 + ike2) * z) * sg;
                }
                u32x2 w; w.x = pk4_fp8(res[0][0], res[0][1], res[1][0], res[1][1]); w.y = pk4_fp8(res[2][0], res[2][1], res[3][0], res[3][1]);
                *(u32x2*)(act + (size_t)row * DFF + ff0) = w;
            }
        return false;
    }
};
struct EpiMoe2 {
    unsigned char* y8; const int* rowslot; const float* roww; const float* bd;
    static constexpr int NPAR = 3;
    __device__ __forceinline__ const void* par_src(const Unit& u, int piece, int lane) const {
        if (piece == 0) return rowslot + u.pm * BM + lane * 4;
        if (piece == 1) return roww + u.pm * BM + lane * 4;
        return bd + (size_t)u.aux * D + u.pn * BM + lane * 4;
    }
    __device__ __forceinline__ bool operator()(const f32x4 (&acc)[2][2][4][2], const Unit& u, int wr, int wc, int fr, int fq, const LAS unsigned char* par) const {
        const int row0 = u.pm * BM + wr * 64 + fr, col0 = u.pn * BM + wc * 32 + 8 * fq;
        const LAS float* bp = (const LAS float*)(par + 2048) + wc * 32 + 8 * fq;
        f32x4 bv[2][2];
#pragma unroll
        for (int bj = 0; bj < 2; ++bj) { bv[bj][0] = *(const LAS f32x4*)(bp + bj * HALF); bv[bj][1] = *(const LAS f32x4*)(bp + bj * HALF + 4); }
        int slotv[2][4]; float wv8[2][4];
#pragma unroll
        for (int ai = 0; ai < 2; ++ai)
#pragma unroll
            for (int m = 0; m < 4; ++m) { const int rl = wr * 64 + fr + ai * HALF + m * 16; slotv[ai][m] = ((const LAS int*)par)[rl]; wv8[ai][m] = ((const LAS float*)(par + 1024))[rl]; }
#pragma unroll
        for (int ai = 0; ai < 2; ++ai)
#pragma unroll
            for (int m = 0; m < 4; ++m) {
                const int slot = slotv[ai][m];
                if (slot >= 0) {
                    const float w8 = wv8[ai][m]; const f32x2 w2 = {w8, w8}, inv2 = {W8_INV, W8_INV};
#pragma unroll
                    for (int bj = 0; bj < 2; ++bj) {
                        const f32x4 a0 = acc[ai][bj][m][0], a1 = acc[ai][bj][m][1];
                        const f32x2 p0 = (LO2(a0) * inv2 + LO2(bv[bj][0])) * w2, p1 = (HI2(a0) * inv2 + HI2(bv[bj][0])) * w2, p2 = (LO2(a1) * inv2 + LO2(bv[bj][1])) * w2, p3 = (HI2(a1) * inv2 + HI2(bv[bj][1])) * w2;
                        u32x2 w; w.x = pk4_fp8(p0[0], p0[1], p1[0], p1[1]); w.y = pk4_fp8(p2[0], p2[1], p3[0], p3[1]);
                        *(u32x2*)(y8 + (size_t)slot * 1024 + col0 + bj * HALF) = w;
                    }
                }
            }
        return false;
    }
};

__device__ __forceinline__ void transpose_tile(LAS float* tile, const float* src, int ldsrc, int k0, int n0, bf16_t* dst, int ldd, int drow0, const float* sa, const float* mu, int mode, bool zero, unsigned char* dst8 = nullptr, int drow8 = 0) {
    const int tid = threadIdx.x;
    if (!zero) {
#pragma unroll
        for (int i = 0; i < 2; ++i) {
            const int r = (tid >> 4) + 32 * i, c4 = (tid & 15) * 4;
            const f32x4 v = *(const f32x4*)(src + (size_t)(k0 + r) * ldsrc + n0 + c4);
            LAS float* t = tile + r * 65 + c4;
            t[0] = v[0]; t[1] = v[1]; t[2] = v[2]; t[3] = v[3];
        }
    }
    __syncthreads();
    {
        const int n = tid >> 3, kq = tid & 7;
        float v[8];
#pragma unroll
        for (int j = 0; j < 8; ++j) {
            const int k = k0 + 8 * kq + j;
            float s = sa ? sa[k] : 1.0f;
            if (mode == 1) s *= (1.0f - mu[k]);
            if (mode == 2) s *= mu[k];
            v[j] = zero ? 0.f : tile[(8 * kq + j) * 65 + n] * s;
        }
        u32x4 w; w.x = cvt_pk_bf16(v[0], v[1]); w.y = cvt_pk_bf16(v[2], v[3]); w.z = cvt_pk_bf16(v[4], v[5]); w.w = cvt_pk_bf16(v[6], v[7]);
        *(u32x4*)(dst + (size_t)(drow0 + n) * ldd + k0 + 8 * kq) = w;
        if (dst8) { u32x2 w8; w8.x = pk4_fp8(v[0] * W8_SCALE, v[1] * W8_SCALE, v[2] * W8_SCALE, v[3] * W8_SCALE); w8.y = pk4_fp8(v[4] * W8_SCALE, v[5] * W8_SCALE, v[6] * W8_SCALE, v[7] * W8_SCALE); *(u32x2*)(dst8 + (size_t)(drow8 + n) * ldd + k0 + 8 * kq) = w8; }
    }
    __syncthreads();
}

__device__ __forceinline__ void phase_prep(const PPv& p, LAS unsigned char* lds) {
    const int tid = threadIdx.x, bid = blockIdx.x, nb = gridDim.x, lane = tid & 63, wave = tid >> 6;
    unsigned char* ws = p.gws();
    const float* x = p.gin(0); const float* meta = p.gin(1); const float* g1 = p.gin(2);
    if (bid == 0 && tid < 64) ((int*)(ws + OFF_GCNT))[tid] = 0;
    {
        bf16_t* HB = (bf16_t*)(ws + OFF_HB); float* rstd1 = (float*)(ws + OFF_RSTD1);
        for (int row0 = (bid * 8 + wave) * 4; row0 < NR; row0 += nb * 32) {
            f32x4 v[4][4];
#pragma unroll
            for (int u = 0; u < 4; ++u) {
                const int row = row0 + u < NR ? row0 + u : NR - 1;
                const float* src = row < NMETA ? meta + (size_t)row * D : x + (size_t)(row - NMETA) * D;
#pragma unroll
                for (int i = 0; i < 4; ++i) v[u][i] = __builtin_nontemporal_load((const f32x4*)(src + i * 256 + lane * 4));
            }
#pragma unroll
            for (int u = 0; u < 4; ++u) {
                const int row = row0 + u;
                if (row < NR) {
                    float ss = 0.f;
#pragma unroll
                    for (int i = 0; i < 4; ++i) ss += v[u][i][0] * v[u][i][0] + v[u][i][1] * v[u][i][1] + v[u][i][2] * v[u][i][2] + v[u][i][3] * v[u][i][3];
                    ss = wave_sum_dpp(ss);
                    if (lane == 0) rstd1[row] = rsqrtf(ss * (1.0f / D) + NORM_EPS);
                    if (row >= NMETA) {
                        bf16_t* d = HB + (size_t)(row - NMETA) * D;
#pragma unroll
                        for (int i = 0; i < 4; ++i) { u32x2 w; w.x = cvt_pk_bf16(v[u][i][0], v[u][i][1]); w.y = cvt_pk_bf16(v[u][i][2], v[u][i][3]); *(u32x2*)(d + i * 256 + lane * 4) = w;
                            *(unsigned*)(ws + OFF_X8 + (size_t)(row - NMETA) * D + i * 256 + lane * 4) = pk4_fp8(v[u][i][0], v[u][i][1], v[u][i][2], v[u][i][3]); }
                    }
                }
            }
        }
    }
    LAS float* tile = (LAS float*)lds;
    {
        bf16_t* WIN = (bf16_t*)(ws + OFF_WIN);
        const float* w_in = p.gin(3);
        for (int j = bid; j < 16 * 88; j += nb) {
            const int kt = j & 15, ntile = j >> 4, n0 = ntile * 64;
            const float* src; int ld, sn0, mode = 0; const float* mu = nullptr;
            if (n0 < 3072) { src = w_in; ld = 5120; sn0 = n0; }
            else if (n0 < 3584) {
                const int seg = (n0 - 3072) >> 6;
                if (seg < 2) { src = p.gin(11); ld = 64; sn0 = 0; mu = p.gin(7); mode = 1 + seg; }
                else if (seg < 4) { src = p.gin(14); ld = 64; sn0 = 0; mu = p.gin(8); mode = 1 + (seg - 2); }
                else { src = p.gin(16); ld = 128; sn0 = (seg & 1) * 64; mu = p.gin(9); mode = seg < 6 ? 1 : 2; }
            } else { src = w_in; ld = 5120; sn0 = n0 - 512; }
            transpose_tile(tile, src, ld, kt * 64, sn0, WIN, 1024, n0, g1, mu, mode, false, n0 >= 3584 ? ws + OFF_WIN8 : nullptr, n0 - 3584);
        }
        for (int j = bid; j < 2 * 128; j += nb) {
            const int which = j >> 7, jj = j & 127, kt = jj & 7, ntile = jj >> 3;
            transpose_tile(tile, which ? p.gin(25) : p.gin(23), 1024, kt * 64, ntile * 64, (bf16_t*)(ws + (which ? OFF_WC : OFF_WR)), 512, ntile * 64, nullptr, nullptr, 0, false);
        }
        for (int j = bid; j < 256; j += nb) {
            const int kt = j & 15, ntile = j >> 4;
            transpose_tile(tile, p.gin(26), 1024, kt * 64, ntile * 64, (bf16_t*)(ws + OFF_WO), 1024, ntile * 64, nullptr, nullptr, 0, false);
        }
        for (int j = bid; j < 96; j += nb) {
            const int kt = j & 3, ntile = j >> 2, seg = ntile >> 3, nn0 = (ntile & 7) * 64;
            const float* src = nullptr; int sk0 = 0; bool zero = true;
            if (seg == 0 && kt == 0) { src = p.gin(12); sk0 = 0; zero = false; }
            if (seg == 1 && kt == 1) { src = p.gin(15); sk0 = 0; zero = false; }
            if (seg == 2 && kt >= 2) { src = p.gin(17); sk0 = (kt - 2) * 64; zero = false; }
            const float* srcs = zero ? p.gin(12) : src + (size_t)(sk0 - kt * 64) * 512;
            transpose_tile(tile, srcs, 512, kt * 64, nn0, (bf16_t*)(ws + OFF_W2), 256, ntile * 64, nullptr, nullptr, 0, zero);
        }
        {
            float* WRG = (float*)(ws + OFF_WRG); const float* g2 = p.gin(27); const float* wr_ = p.gin(28);
            for (int i = bid * 512 + tid; i < 1024 * 32; i += nb * 512) WRG[i] = g2[i >> 5] * wr_[i];
        }
    }
}

__device__ __forceinline__ void phase_meta_proj(const PPv& p, LAS unsigned char* lds) {
    const int tid = threadIdx.x, bid = blockIdx.x, lane = tid & 63, wave = tid >> 6;
    unsigned char* ws = p.gws();
    LAS float* sm = (LAS float*)lds;
    const float* meta = p.gin(1);
    for (int i = tid; i < 16 * 256; i += 512) { const int r = i >> 8, c4 = (i & 255) * 4; const f32x4 v = *(const f32x4*)(meta + r * 1024 + c4); LAS float* d = sm + r * 1028 + c4; d[0] = v[0]; d[1] = v[1]; d[2] = v[2]; d[3] = v[3]; }
    __syncthreads();
    const float* rstd1 = (const float*)(ws + OFF_RSTD1);
    for (int nbase = bid * 14; nbase < PCOLS1; nbase += gridDim.x * 14) {
        for (int nn = wave; nn < 14; nn += 8) {
            const int n = nbase + nn;
            if (n >= PCOLS1) break;
            const bf16_t* wrow = (const bf16_t*)(ws + OFF_WIN) + (size_t)n * 1024;
            const u32x4 w0 = *(const u32x4*)(wrow + 8 * lane), w1 = *(const u32x4*)(wrow + 512 + 8 * lane);
            const float wf[16] = {bflo(w0.x), bfhi(w0.x), bflo(w0.y), bfhi(w0.y), bflo(w0.z), bfhi(w0.z), bflo(w0.w), bfhi(w0.w),
                                  bflo(w1.x), bfhi(w1.x), bflo(w1.y), bfhi(w1.y), bflo(w1.z), bfhi(w1.z), bflo(w1.w), bfhi(w1.w)};
            float outv = 0.f;
#pragma unroll
            for (int pr = 0; pr < 16; ++pr) {
                const LAS float* m0 = sm + pr * 1028 + 8 * lane;
                const f32x4 a0 = *(const LAS f32x4*)m0, a1 = *(const LAS f32x4*)(m0 + 4), a2 = *(const LAS f32x4*)(m0 + 512), a3 = *(const LAS f32x4*)(m0 + 516);
                float acc = a0[0] * wf[0] + a0[1] * wf[1] + a0[2] * wf[2] + a0[3] * wf[3] + a1[0] * wf[4] + a1[1] * wf[5] + a1[2] * wf[6] + a1[3] * wf[7]
                          + a2[0] * wf[8] + a2[1] * wf[9] + a2[2] * wf[10] + a2[3] * wf[11] + a3[0] * wf[12] + a3[1] * wf[13] + a3[2] * wf[14] + a3[3] * wf[15];
                acc = wave_sum_dpp(acc);
                outv = (lane == pr) ? acc * rstd1[pr] : outv;
            }
            if (lane < 16) {
                if (n < 1536) ((bf16_t*)(ws + OFF_PRKV))[(size_t)lane * 1536 + n] = f2bf(outv);
                else ((bf16_t*)(ws + OFF_PCONV))[(size_t)lane * 2048 + n - 1536] = f2bf(outv);
            }
        }
    }
    __syncthreads();
}

__device__ __forceinline__ void phase_meta_lora(const PPv& p) {
    const int tid = threadIdx.x, bid = blockIdx.x, nb = gridDim.x, lane = tid & 63, wave = tid >> 6;
    unsigned char* ws = p.gws();
    const bf16_t* L = (const bf16_t*)(ws + OFF_L); const bf16_t* W2 = (const bf16_t*)(ws + OFF_W2);
    for (int n = bid * 8 + wave; n < 1536; n += nb * 8) {
        const int seg = n >> 9, c = n & 511;
        const u32x2 wv = *(const u32x2*)(W2 + (size_t)n * 256 + 4 * lane);
        const float w0v = bflo(wv.x), w1v = bfhi(wv.x), w2v = bflo(wv.y), w3v = bfhi(wv.y);
        float outv = 0.f;
#pragma unroll
        for (int r = 0; r < 16; ++r) {
            const u32x2 lv = *(const u32x2*)(L + (size_t)r * 256 + 4 * lane);
            float acc = bflo(lv.x) * w0v + bfhi(lv.x) * w1v + bflo(lv.y) * w2v + bfhi(lv.y) * w3v;
            acc = wave_sum_dpp(acc);
            outv = (lane == r) ? acc : outv;
        }
        if (lane < 16) {
            float v = outv;
            if (seg == 0) v = -0.60653065971f * sigmoidf_(v + p.gin(10)[c]);
            if (seg == 1) v = sigmoidf_(v + p.gin(13)[c]);
            bf16_t* ob = (bf16_t*)(ws + (seg == 0 ? OFF_LD : seg == 1 ? OFF_A : OFF_G));
            ob[(size_t)lane * 512 + c] = f2bf(v);
        }
    }
}

__device__ __forceinline__ void phase_lprep_conv(const PPv& p) {
    const int tid = threadIdx.x, bid = blockIdx.x, nb = gridDim.x;
    unsigned char* ws = p.gws();
    const bf16_t* PROJ = (const bf16_t*)(ws + OFF_PCONV);
    constexpr int PCOLS = 2048;
    bf16_t* L = (bf16_t*)(ws + OFF_L);
    for (int i = bid * 512 + tid; i < NRP * 32; i += nb * 512) {
        const int row = i >> 5, gq = i & 31;
        u32x4 w = (u32x4){0u, 0u, 0u, 0u};
        if (row < NR) {
            int ca, cb;
            if (gq < 8) { ca = 1536 + gq * 8; cb = ca + 64; }
            else if (gq < 16) { ca = 1536 + 128 + (gq - 8) * 8; cb = ca + 64; }
            else { ca = 1536 + 256 + (gq - 16) * 8; cb = ca + 128; }
            const u32x4 va = *(const u32x4*)(PROJ + (size_t)row * PCOLS + ca);
            const int pr = prev_row(row, 1);
            u32x4 vb = (u32x4){0u, 0u, 0u, 0u};
            if (pr >= 0) vb = *(const u32x4*)(PROJ + (size_t)pr * PCOLS + cb);
            float v[8] = {bflo(va.x) + bflo(vb.x), bfhi(va.x) + bfhi(vb.x), bflo(va.y) + bflo(vb.y), bfhi(va.y) + bfhi(vb.y), bflo(va.z) + bflo(vb.z), bfhi(va.z) + bfhi(vb.z), bflo(va.w) + bflo(vb.w), bfhi(va.w) + bfhi(vb.w)};
#pragma unroll
            for (int j = 0; j < 8; ++j) { if (gq < 8) v[j] = tanhf(v[j]); else if (gq >= 16) v[j] = sigmoidf_(v[j]); }
            w.x = cvt_pk_bf16(v[0], v[1]); w.y = cvt_pk_bf16(v[2], v[3]); w.z = cvt_pk_bf16(v[4], v[5]); w.w = cvt_pk_bf16(v[6], v[7]);
        }
        *(u32x4*)(L + (size_t)row * 256 + gq * 8) = w;
    }
    bf16_t* C = (bf16_t*)(ws + OFF_C);
    const float* cw = p.gin(24);
    for (int i = bid * 512 + tid; i < T * 64; i += nb * 512) {
        const int m = i >> 6, ch = (i & 63) * 8, row = NMETA + m;
        const int r1 = prev_row(row, 1), r2 = prev_row(row, 2);
        const bf16_t* p0 = PROJ + (size_t)row * PCOLS; const bf16_t* p1 = PROJ + (size_t)r1 * PCOLS; const bf16_t* p2 = PROJ + (size_t)r2 * PCOLS;
        const u32x4 vb = *(const u32x4*)(p0 + ch);
        const u32x4 c0 = *(const u32x4*)(p0 + 512 + ch), h0 = *(const u32x4*)(p0 + 1024 + ch);
        const u32x4 c1 = *(const u32x4*)(p1 + 512 + ch), h1 = *(const u32x4*)(p1 + 1024 + ch);
        const u32x4 c2 = *(const u32x4*)(p2 + 512 + ch), h2 = *(const u32x4*)(p2 + 1024 + ch);
        float o[8];
#pragma unroll
        for (int j = 0; j < 8; ++j) {
            const unsigned wb = j < 2 ? vb.x : j < 4 ? vb.y : j < 6 ? vb.z : vb.w;
            const unsigned wc0 = j < 2 ? c0.x : j < 4 ? c0.y : j < 6 ? c0.z : c0.w, wh0 = j < 2 ? h0.x : j < 4 ? h0.y : j < 6 ? h0.z : h0.w;
            const unsigned wc1 = j < 2 ? c1.x : j < 4 ? c1.y : j < 6 ? c1.z : c1.w, wh1 = j < 2 ? h1.x : j < 4 ? h1.y : j < 6 ? h1.z : h1.w;
            const unsigned wc2 = j < 2 ? c2.x : j < 4 ? c2.y : j < 6 ? c2.z : c2.w, wh2 = j < 2 ? h2.x : j < 4 ? h2.y : j < 6 ? h2.z : h2.w;
            const bool hi = j & 1;
            const float b = hi ? bfhi(wb) : bflo(wb);
            const float u0 = (hi ? bfhi(wc0) : bflo(wc0)) * (hi ? bfhi(wh0) : bflo(wh0));
            const float u1 = (hi ? bfhi(wc1) : bflo(wc1)) * (hi ? bfhi(wh1) : bflo(wh1));
            const float u2 = (hi ? bfhi(wc2) : bflo(wc2)) * (hi ? bfhi(wh2) : bflo(wh2));
            const float conv = cw[ch + j] * u2 + cw[512 + ch + j] * u1 + cw[1024 + ch + j] * u0;
            o[j] = b * conv;
        }
        u32x4 w; w.x = cvt_pk_bf16(o[0], o[1]); w.y = cvt_pk_bf16(o[2], o[3]); w.z = cvt_pk_bf16(o[4], o[5]); w.w = cvt_pk_bf16(o[6], o[7]);
        *(u32x4*)(C + (size_t)m * 512 + ch) = w;
    }
}

template <int CTRL> __device__ __forceinline__ float dppmov(float v) { return __builtin_bit_cast(float, __builtin_amdgcn_update_dpp(0, __builtin_bit_cast(int, v), CTRL, 0xF, 0xF, true)); }
__device__ __forceinline__ float wave_sum_dpp(float v) {
    v += dppmov<0xB1>(v);
    v += dppmov<0x4E>(v);
    v += dppmov<0x141>(v);
    v += dppmov<0x140>(v);
    { float c = v; asm volatile("v_nop\n\tv_nop\n\tv_permlane16_swap_b32 %0, %1\n\tv_nop" : "+v"(v), "+v"(c)); v += c; }
    { float c = v; asm volatile("v_nop\n\tv_nop\n\tv_permlane32_swap_b32 %0, %1\n\tv_nop" : "+v"(v), "+v"(c)); v += c; }
    return v;
}
typedef float f32x16 __attribute__((ext_vector_type(16)));

struct RawTok { bf16_t r, k, v, a, ld; };
__device__ __forceinline__ RawTok load_raw(const bf16_t* PRKV, const bf16_t* Ab, const bf16_t* LD, int row, int col) {
    RawTok q; const bf16_t* p0 = PRKV + (size_t)row * 1536 + col;
    q.r = p0[0]; q.k = p0[512]; q.v = p0[1024]; q.a = Ab[(size_t)row * 512 + col]; q.ld = LD[(size_t)row * 512 + col];
    return q;
}
__device__ __forceinline__ void unit_geom(int uid, int lane, int& b, int& h, int& c, int& col, int& row0) {
    const int bh = uid / NCHUNK; c = uid - bh * NCHUNK; b = bh >> 3; h = bh & 7; col = h * 64 + lane;
    row0 = c == 0 ? 0 : b * SEQ + c * 16;
}
__device__ __forceinline__ void phase_scanprep(const PPv& p, LAS unsigned char* lds) {
    const int tid = threadIdx.x, bid = blockIdx.x, nb = gridDim.x, lane = tid & 63, wave = tid >> 6;
    unsigned char* ws = p.gws();
    const bf16_t* PRKV = (const bf16_t*)(ws + OFF_PRKV);
    const bf16_t* LD = (const bf16_t*)(ws + OFF_LD);
    const bf16_t* Ab = (const bf16_t*)(ws + OFF_A);
    float* COEF = (float*)(ws + OFF_COEF);
    LAS unsigned char* wl = lds + wave * 13824;
    LAS bf16_t* AR = (LAS bf16_t*)wl;
    LAS bf16_t* BK = (LAS bf16_t*)(wl + 4608);
    LAS float* DM = (LAS float*)(wl + 9216);
    const int qperm = (lane & 32) | (((lane >> 2) & 3) << 3) | (((lane >> 4) & 1) << 2) | (lane & 3);
    int uid = bid * 8 + wave;
    if (uid >= NUNITS) return;
    int b, h, c, col, row0;
    unit_geom(uid, lane, b, h, c, col, row0);
    RawTok q[16], qn[16];
    bf16_t prr = 0, prk = 0, prv = 0, nprr = 0, nprk = 0, nprv = 0;
#pragma unroll
    for (int t = 0; t < 16; ++t) q[t] = load_raw(PRKV, Ab, LD, row0 + t, col);
    { const int pr = prev_row(row0, 1); if (pr >= 0) { const bf16_t* p1 = PRKV + (size_t)pr * 1536 + col; prr = p1[0]; prk = p1[512]; prv = p1[1024]; } }
    for (;;) {
        const float mur = p.gin(4)[col], muk = p.gin(5)[col], muv = p.gin(6)[col], kkw = p.gin(18)[col], kaw = p.gin(19)[col], rkw = p.gin(20)[col];
        const int nuid = uid + nb * 8; const bool has_next = nuid < NUNITS;
        int nb_ = b, nh = h, nc = c, ncol = col, nrow0 = row0;
        if (has_next) {
            unit_geom(nuid, lane, nb_, nh, nc, ncol, nrow0);
#pragma unroll
            for (int t = 0; t < 16; ++t) qn[t] = load_raw(PRKV, Ab, LD, nrow0 + t, ncol);
            nprr = 0; nprk = 0; nprv = 0;
            const int pr = prev_row(nrow0, 1); if (pr >= 0) { const bf16_t* p1 = PRKV + (size_t)pr * 1536 + ncol; nprr = p1[0]; nprk = p1[512]; nprv = p1[1024]; }
        }
        __builtin_amdgcn_sched_barrier(0);
        LAS float* PM = (LAS float*)wl;
        LAS float* RS = DM;
        {
            float rp = bf2f(prr), kp = bf2f(prk);
#pragma unroll
            for (int t = 0; t < 16; ++t) {
                const RawTok qq = q[t];
                const float r0 = bf2f(qq.r), k0 = bf2f(qq.k);
                const float r = r0 + (rp - r0) * mur, k = k0 + (kp - k0) * muk;
                rp = r0; kp = k0;
                const float a = bf2f(qq.a);
                const float kkv = k * kkw, k2 = k * (1.0f + (a - 1.0f) * kaw);
                PM[t * 68 + lane] = kkv * kkv; PM[(16 + t) * 68 + lane] = r * k2 * rkw;
            }
            asm volatile("" ::: "memory");
            const int rw = lane & 31, hf = lane >> 5;
            f32x4 s4 = (f32x4){0.f, 0.f, 0.f, 0.f};
#pragma unroll
            for (int i = 0; i < 8; ++i) s4 += *(const LAS f32x4*)(PM + rw * 68 + hf * 32 + i * 4);
            float sm = (s4[0] + s4[1]) + (s4[2] + s4[3]);
            { float c2 = sm; asm volatile("v_nop\n\tv_nop\n\tv_permlane32_swap_b32 %0, %1\n\tv_nop" : "+v"(sm), "+v"(c2)); sm += c2; }
            if (lane < 32) RS[lane] = sm;
            asm volatile("" ::: "memory");
            const float cfl = __shfl(sm, (lane & 15) + 16);
            if (lane < 16) COEF[(size_t)(row0 + lane) * 8 + h] = cfl;
        }
        __builtin_amdgcn_sched_barrier(0);
        float at[16], vt[16]; unsigned btp[8], ktp[8]; float bprev = 0.f, kprev = 0.f;
        float cl = 0.f;
        float rp = bf2f(prr), kp = bf2f(prk), vp = bf2f(prv);
        f32x4 n2v[4];
#pragma unroll
        for (int i = 0; i < 4; ++i) n2v[i] = *(const LAS f32x4*)(RS + 4 * i);
        asm volatile("" ::: "memory"); __builtin_amdgcn_sched_barrier(0);
#pragma unroll
        for (int t = 0; t < 16; ++t) {
            const RawTok qq = q[t];
            const float r0 = bf2f(qq.r), k0 = bf2f(qq.k), v0 = bf2f(qq.v);
            const float r = r0 + (rp - r0) * mur, k = k0 + (kp - k0) * muk, v = v0 + (vp - v0) * muv;
            rp = r0; kp = k0; vp = v0;
            const float a = bf2f(qq.a);
            const float kkv = k * kkw;
            const float kk = kkv * __builtin_amdgcn_rsqf(fmaxf(n2v[t >> 2][t & 3], 1e-24f));
            const float k2 = k * (1.0f + (a - 1.0f) * kaw);
            const float wcp = __expf(cl);
            cl += bf2f(qq.ld);
            const float wcn = __expf(cl), iw = __expf(-cl);
            const float btv = kk * a * iw, ktv = k2 * iw;
            at[t] = -kk * wcp; vt[t] = v;
            { const unsigned w = cvt_pk_bf16(at[t], r * wcn); AR[t * 72 + qperm] = (bf16_t)(w & 0xFFFFu); AR[(16 + t) * 72 + qperm] = (bf16_t)(w >> 16); }
            if (t & 1) {
                btp[t >> 1] = cvt_pk_bf16(bprev, btv); ktp[t >> 1] = cvt_pk_bf16(kprev, ktv);
                BK[(t - 1) * 72 + qperm] = (bf16_t)(btp[t >> 1] & 0xFFFFu); BK[t * 72 + qperm] = (bf16_t)(btp[t >> 1] >> 16);
                BK[(16 + t - 1) * 72 + qperm] = (bf16_t)(ktp[t >> 1] & 0xFFFFu); BK[(16 + t) * 72 + qperm] = (bf16_t)(ktp[t >> 1] >> 16);
            } else { bprev = btv; kprev = ktv; }
            if ((t & 3) == 3) __builtin_amdgcn_sched_barrier(0);
        }
        const float wcc = __expf(cl);
        {
            f32x16 dm;
#pragma unroll
            for (int i = 0; i < 16; ++i) dm[i] = 0.f;
            const int rr = lane & 31, hh = lane >> 5;
#pragma unroll
            for (int ks = 0; ks < 4; ++ks) {
                const bf16x8 fa = *(const LAS bf16x8*)(AR + rr * 72 + 16 * ks + 8 * hh);
                const bf16x8 fb = *(const LAS bf16x8*)(BK + rr * 72 + 16 * ks + 8 * hh);
                dm = __builtin_amdgcn_mfma_f32_32x32x16_bf16(fa, fb, dm, 0, 0, 0);
            }
#pragma unroll
            for (int reg = 0; reg < 16; ++reg) DM[((reg & 3) + 8 * (reg >> 2) + 4 * hh) * 36 + rr] = dm[reg];
        }
        __builtin_amdgcn_sched_barrier(0);
        float uh[16];
#pragma unroll
        for (int t = 0; t < 16; ++t) {
            float wv = at[t], uv = 0.f, wv2 = 0.f, uv2 = 0.f, uv3 = 0.f;
#pragma unroll
            for (int s4 = 0; s4 < 4; ++s4) {
                if (s4 * 4 < t) {
                    const f32x4 ab = *(const LAS f32x4*)(DM + t * 36 + s4 * 4), ak = *(const LAS f32x4*)(DM + t * 36 + 16 + s4 * 4);
#pragma unroll
                    for (int j = 0; j < 4; ++j) {
                        const int s_ = s4 * 4 + j;
                        if (s_ < t) {
                            if (j & 1) { wv2 += ab[j] * at[s_]; uv2 += ak[j] * vt[s_]; } else { wv += ab[j] * at[s_]; uv += ak[j] * vt[s_]; }
                            uv3 += ab[j] * uh[s_];
                        }
                    }
                }
            }
            wv += wv2; uv += uv2 + uv3;
            at[t] = wv; uh[t] = uv;
            asm volatile("" : "+v"(at[t]), "+v"(uh[t]));
        }
        __builtin_amdgcn_sched_barrier(0);
#pragma unroll
        for (int t = 0; t < 16; t += 2) { const unsigned w = cvt_pk_bf16(at[t], at[t + 1]); AR[t * 72 + qperm] = (bf16_t)(w & 0xFFFFu); AR[(t + 1) * 72 + qperm] = (bf16_t)(w >> 16); }
        unsigned char* rec = ws + OFF_CH + (size_t)uid * REC_BYTES;
#pragma unroll
        for (int i = 0; i < 2; ++i) {
            const int pc = i * 64 + lane, row = pc >> 3, part = pc & 7;
            *(u32x4*)(rec + RO_WH + pc * 16) = *(const LAS u32x4*)((LAS unsigned char*)AR + row * 144 + part * 16);
            *(u32x4*)(rec + RO_RT + pc * 16) = *(const LAS u32x4*)((LAS unsigned char*)AR + (16 + row) * 144 + part * 16);
        }
        {
            u32x4 w0, w1;
            w0.x = cvt_pk_bf16(uh[0], uh[1]); w0.y = cvt_pk_bf16(uh[2], uh[3]); w0.z = cvt_pk_bf16(uh[4], uh[5]); w0.w = cvt_pk_bf16(uh[6], uh[7]);
            w1.x = cvt_pk_bf16(uh[8], uh[9]); w1.y = cvt_pk_bf16(uh[10], uh[11]); w1.z = cvt_pk_bf16(uh[12], uh[13]); w1.w = cvt_pk_bf16(uh[14], uh[15]);
            *(u32x4*)(rec + RO_U0T + lane * 32) = w0; *(u32x4*)(rec + RO_U0T + lane * 32 + 16) = w1;
            w0.x = cvt_pk_bf16(vt[0], vt[1]); w0.y = cvt_pk_bf16(vt[2], vt[3]); w0.z = cvt_pk_bf16(vt[4], vt[5]); w0.w = cvt_pk_bf16(vt[6], vt[7]);
            w1.x = cvt_pk_bf16(vt[8], vt[9]); w1.y = cvt_pk_bf16(vt[10], vt[11]); w1.z = cvt_pk_bf16(vt[12], vt[13]); w1.w = cvt_pk_bf16(vt[14], vt[15]);
            *(u32x4*)(rec + RO_VT + lane * 32) = w0; *(u32x4*)(rec + RO_VT + lane * 32 + 16) = w1;
        }
#pragma unroll
        for (int g = 0; g < 4; ++g) {
            u32x4 w; w.x = btp[2 * g]; w.y = btp[2 * g + 1]; w.z = ktp[2 * g]; w.w = ktp[2 * g + 1];
            *(u32x4*)(rec + RO_BKT + lane * 64 + g * 16) = w;
        }
        {
            const int t = lane >> 2, g = lane & 3;
            const f32x4 rb = *(const LAS f32x4*)(DM + (16 + t) * 36 + 4 * g), rk = *(const LAS f32x4*)(DM + (16 + t) * 36 + 16 + 4 * g);
            float o[8];
#pragma unroll
            for (int j = 0; j < 4; ++j) { const bool keep = (4 * g + j) <= t; o[j] = keep ? rb[j] : 0.f; o[4 + j] = keep ? rk[j] : 0.f; }
            u32x4 w; w.x = cvt_pk_bf16(o[0], o[1]); w.y = cvt_pk_bf16(o[2], o[3]); w.z = cvt_pk_bf16(o[4], o[5]); w.w = cvt_pk_bf16(o[6], o[7]);
            *(u32x4*)(rec + RO_ARK + t * 64 + g * 16) = w;
        }
        *(float*)(rec + RO_WCC + lane * 4) = wcc;
        if (!has_next) break;
        uid = nuid; b = nb_; h = nh; c = nc; col = ncol; row0 = nrow0;
#pragma unroll
        for (int t = 0; t < 16; ++t) q[t] = qn[t];
        prr = nprr; prk = nprk; prv = nprv;
        __builtin_amdgcn_sched_barrier(0);
    }
}

__device__ __forceinline__ void convert_expert_weights(const PPv& p, LAS unsigned char* lds, int first, int stride);
struct RecOps { bf16x8 wA0, wA1, rA0, rA1, ark, bk[4]; u32x2 u0, vv; f32x4 wc[4]; };
__device__ __forceinline__ void load_ops(RecOps& o, LAS unsigned char* S, int vs, int fr, int g) {
    o.wA0 = *(const LAS bf16x8*)(S + RO_WH + fr * 128 + g * 16); o.wA1 = *(const LAS bf16x8*)(S + RO_WH + fr * 128 + 64 + g * 16);
    o.rA0 = *(const LAS bf16x8*)(S + RO_RT + fr * 128 + g * 16); o.rA1 = *(const LAS bf16x8*)(S + RO_RT + fr * 128 + 64 + g * 16);
    o.u0 = *(const LAS u32x2*)(S + RO_U0T + (16 * vs + fr) * 32 + g * 8);
    o.vv = *(const LAS u32x2*)(S + RO_VT + (16 * vs + fr) * 32 + g * 8);
    o.ark = *(const LAS bf16x8*)(S + RO_ARK + fr * 64 + g * 16);
#pragma unroll
    for (int m = 0; m < 4; ++m) { o.bk[m] = *(const LAS bf16x8*)(S + RO_BKT + (16 * m + fr) * 64 + g * 16); o.wc[m] = *(const LAS f32x4*)(S + RO_WCC + (16 * m + 4 * g) * 4); }
}
__device__ __forceinline__ void phase_recur(const PPv& p, LAS unsigned char* lds) {
    const int tid = threadIdx.x, bid = blockIdx.x, nb = gridDim.x, lane = tid & 63, wave = __builtin_amdgcn_readfirstlane(tid >> 6);
    unsigned char* ws = p.gws();
    if (bid >= 64) { convert_expert_weights(p, lds, bid - 64, nb - 64); return; }
    unsigned char* CHb = ws + OFF_CH + (size_t)(bid * NCHUNK) * REC_BYTES;
    constexpr int RSLOT = REC_BYTES, RN = 11, PF = 8;
#define R_BAR() do { asm volatile("s_waitcnt lgkmcnt(0)" ::: "memory"); __builtin_amdgcn_s_barrier(); asm volatile("" ::: "memory"); } while (0)
    if (wave >= 4) {
        const int lw = wave - 4;
#define R_ISSUE(x) do { \
            LAS unsigned char* _s = lds + ((x) % RN) * RSLOT; const unsigned char* _r = CHb + (size_t)(x) * REC_BYTES + lane * 16; \
            _Pragma("unroll") for (int _i = 0; _i < 3; ++_i) { const int _pc = lw + 4 * _i; __builtin_amdgcn_global_load_lds((const unsigned*)(_r + _pc * 1024), (LAS unsigned*)(_s + _pc * 1024), 16, 0, 0); } \
            if (lw == 0) __builtin_amdgcn_global_load_lds((const unsigned*)(_r + 12 * 1024), (LAS unsigned*)(_s + 12 * 1024), 16, 0, 0); \
            if (lw == 1) { if (lane < 16) __builtin_amdgcn_global_load_lds((const unsigned*)(_r + 13 * 1024), (LAS unsigned*)(_s + 13 * 1024), 16, 0, 0); } } while (0)
        for (int x = 0; x < PF; ++x) R_ISSUE(x);
        asm volatile("s_waitcnt vmcnt(0)" ::: "memory");
        R_BAR();
        for (int c = 0; c < NCHUNK; ++c) {
            const int x = c + PF;
            if (x < NCHUNK) R_ISSUE(x);
            if (x < NCHUNK) { if (lw < 2) asm volatile("s_waitcnt vmcnt(24)" ::: "memory"); else asm volatile("s_waitcnt vmcnt(18)" ::: "memory"); }
            else asm volatile("s_waitcnt vmcnt(0)" ::: "memory");
            R_BAR();
        }
#undef R_ISSUE
    } else {
        const int vs = wave, fr = lane & 15, g = lane >> 4;
        f32x4 H[4];
#pragma unroll
        for (int m = 0; m < 4; ++m) H[m] = (f32x4){0.f, 0.f, 0.f, 0.f};
        R_BAR();
        RecOps cur, nxt;
        load_ops(cur, lds, vs, fr, g);
        for (int c = 0; c < NCHUNK; ++c) {
            if (c + 1 < NCHUNK) load_ops(nxt, lds + ((c + 1) % RN) * RSLOT, vs, fr, g); else nxt = cur;
            u32x4 hb0, hb1;
            hb0.x = cvt_pk_bf16(H[0][0], H[0][1]); hb0.y = cvt_pk_bf16(H[0][2], H[0][3]); hb0.z = cvt_pk_bf16(H[1][0], H[1][1]); hb0.w = cvt_pk_bf16(H[1][2], H[1][3]);
            hb1.x = cvt_pk_bf16(H[2][0], H[2][1]); hb1.y = cvt_pk_bf16(H[2][2], H[2][3]); hb1.z = cvt_pk_bf16(H[3][0], H[3][1]); hb1.w = cvt_pk_bf16(H[3][2], H[3][3]);
            const bf16x8 hB0 = __builtin_bit_cast(bf16x8, hb0), hB1 = __builtin_bit_cast(bf16x8, hb1);
            f32x4 U = (f32x4){bflo(cur.u0.x), bfhi(cur.u0.x), bflo(cur.u0.y), bfhi(cur.u0.y)};
            U = __builtin_amdgcn_mfma_f32_16x16x32_bf16(cur.wA0, hB0, U, 0, 0, 0);
            U = __builtin_amdgcn_mfma_f32_16x16x32_bf16(cur.wA1, hB1, U, 0, 0, 0);
            f32x4 Y = (f32x4){0.f, 0.f, 0.f, 0.f};
            Y = __builtin_amdgcn_mfma_f32_16x16x32_bf16(cur.rA0, hB0, Y, 0, 0, 0);
            Y = __builtin_amdgcn_mfma_f32_16x16x32_bf16(cur.rA1, hB1, Y, 0, 0, 0);
            u32x4 uvw; uvw.x = cvt_pk_bf16(U[0], U[1]); uvw.y = cvt_pk_bf16(U[2], U[3]); uvw.z = cur.vv.x; uvw.w = cur.vv.y;
            const bf16x8 uv = __builtin_bit_cast(bf16x8, uvw);
            Y = __builtin_amdgcn_mfma_f32_16x16x32_bf16(cur.ark, uv, Y, 0, 0, 0);
#pragma unroll
            for (int m = 0; m < 4; ++m) { H[m] = __builtin_amdgcn_mfma_f32_16x16x32_bf16(cur.bk[m], uv, H[m], 0, 0, 0); H[m] *= cur.wc[m]; }
            u32x2 yw; yw.x = cvt_pk_bf16(Y[0], Y[1]); yw.y = cvt_pk_bf16(Y[2], Y[3]);
            *(u32x2*)(CHb + (size_t)c * REC_BYTES + RO_U0T + (16 * vs + fr) * 32 + g * 8) = yw;
            R_BAR();
            cur = nxt;
        }
    }
#undef R_BAR
}

__device__ __forceinline__ void phase_gn(const PPv& p, LAS unsigned char* lds) {
    const int tid = threadIdx.x, bid = blockIdx.x, nb = gridDim.x, lane = tid & 63, wave = tid >> 6;
    unsigned char* ws = p.gws();
    LAS float* PM = (LAS float*)(lds + wave * 8960);
    LAS float* RS = PM + 32 * 68;
    const bf16_t* Gb = (const bf16_t*)(ws + OFF_G); const float* COEF = (const float*)(ws + OFF_COEF);
    bf16_t* Z = (bf16_t*)(ws + OFF_Z);
    constexpr int NREAL = 64 * 256;
    for (int r0 = bid * 8 + wave; r0 < NREAL; r0 += nb * 16) {
        u32x4 y0[2], y1[2], v0[2], v1[2]; float cfv[2][16]; bf16_t ggv[2][16]; int colv[2], row0v[2], hv[2]; bool okv[2];
#pragma unroll
        for (int u = 0; u < 2; ++u) {
            const int r = r0 + u * nb * 8; okv[u] = r < NREAL;
            const int rr = okv[u] ? r : r0;
            const int bh = rr >> 8, c = (rr & 255) + 1, b = bh >> 3, h = bh & 7, uid = bh * NCHUNK + c;
            hv[u] = h; colv[u] = h * 64 + lane; row0v[u] = b * SEQ + c * 16;
            const unsigned char* rec = ws + OFF_CH + (size_t)uid * REC_BYTES;
            y0[u] = *(const u32x4*)(rec + RO_U0T + lane * 32); y1[u] = *(const u32x4*)(rec + RO_U0T + lane * 32 + 16);
            v0[u] = *(const u32x4*)(rec + RO_VT + lane * 32); v1[u] = *(const u32x4*)(rec + RO_VT + lane * 32 + 16);
#pragma unroll
            for (int t = 0; t < 16; ++t) { cfv[u][t] = COEF[(size_t)(row0v[u] + t) * 8 + h]; ggv[u][t] = Gb[(size_t)(row0v[u] + t) * 512 + colv[u]]; }
        }
#pragma unroll
        for (int u = 0; u < 2; ++u) {
            if (!okv[u]) continue;
            const int col = colv[u], row0 = row0v[u];
            const float lng = p.gin(21)[col], lnb = p.gin(22)[col];
            const unsigned yw[8] = {y0[u].x, y0[u].y, y0[u].z, y0[u].w, y1[u].x, y1[u].y, y1[u].z, y1[u].w}, vw[8] = {v0[u].x, v0[u].y, v0[u].z, v0[u].w, v1[u].x, v1[u].y, v1[u].z, v1[u].w};
            asm volatile("" ::: "memory");
#pragma unroll
            for (int t = 0; t < 16; ++t) { const float y = (t & 1) ? bfhi(yw[t >> 1]) : bflo(yw[t >> 1]); PM[t * 68 + lane] = y; PM[(16 + t) * 68 + lane] = y * y; }
            asm volatile("" ::: "memory");
            {
                const int rw = lane & 31, hf = lane >> 5;
                f32x4 s4 = (f32x4){0.f, 0.f, 0.f, 0.f};
#pragma unroll
                for (int i = 0; i < 8; ++i) s4 += *(const LAS f32x4*)(PM + rw * 68 + hf * 32 + i * 4);
                float sm = (s4[0] + s4[1]) + (s4[2] + s4[3]);
                { float c2 = sm; asm volatile("v_nop\n\tv_nop\n\tv_permlane32_swap_b32 %0, %1\n\tv_nop" : "+v"(sm), "+v"(c2)); sm += c2; }
                if (lane < 32) RS[lane] = sm;
            }
            asm volatile("" ::: "memory");
            f32x4 s1v[4], s2v[4];
#pragma unroll
            for (int i = 0; i < 4; ++i) { s1v[i] = *(const LAS f32x4*)(RS + 4 * i); s2v[i] = *(const LAS f32x4*)(RS + 16 + 4 * i); }
            asm volatile("" ::: "memory");
#pragma unroll
            for (int t = 0; t < 16; ++t) {
                const float y = (t & 1) ? bfhi(yw[t >> 1]) : bflo(yw[t >> 1]);
                const float v = (t & 1) ? bfhi(vw[t >> 1]) : bflo(vw[t >> 1]);
                const float mean = s1v[t >> 2][t & 3] * (1.0f / 64.0f);
                const float dlt = y - mean;
                const float var = fmaxf(s2v[t >> 2][t & 3] * (1.0f / 64.0f) - mean * mean, 0.f);
                const float yn = dlt * rsqrtf(var + LNX_EPS) * lng + lnb;
                Z[(size_t)(row0 + t - NMETA) * 512 + col] = f2bf((yn + cfv[u][t] * v) * bf2f(ggv[u][t]));
            }
        }
    }
}

__device__ __forceinline__ void convert_expert_weights(const PPv& p, LAS unsigned char* lds, int first, int stride) {
    unsigned char* ws = p.gws();
    const int tid = threadIdx.x;
    LAS float* tile = (LAS float*)lds;
    const float* g2 = p.gin(27);
    unsigned char* WGU = ws + OFF_WGU; unsigned char* WD = ws + OFF_WD;
    constexpr int NBLK = NE * 3 * 64;
    const int lr = tid >> 6, lc = (tid & 63) * 4;
    f32x4 cur[8];
    int j = first;
    if (j >= NBLK) return;
    {
        const int mat = j >> 6, e = mat / 3, which = mat - 3 * e, bb = j & 63, kb = bb & 15, nbk = bb >> 4;
        const float* src = (which == 0 ? p.gin(30) : which == 1 ? p.gin(32) : p.gin(34)) + (size_t)e * 1024 * 1024 + (size_t)(kb * 64) * 1024 + nbk * 256;
#pragma unroll
        for (int i = 0; i < 8; ++i) cur[i] = __builtin_nontemporal_load((const f32x4*)(src + (size_t)(lr + 8 * i) * 1024 + lc));
    }
    for (;;) {
        const int jn = j + stride; const bool has_next = jn < NBLK;
        f32x4 nxt[8];
        if (has_next) {
            const int mat = jn >> 6, e = mat / 3, which = mat - 3 * e, bb = jn & 63, kb = bb & 15, nbk = bb >> 4;
            const float* src = (which == 0 ? p.gin(30) : which == 1 ? p.gin(32) : p.gin(34)) + (size_t)e * 1024 * 1024 + (size_t)(kb * 64) * 1024 + nbk * 256;
#pragma unroll
            for (int i = 0; i < 8; ++i) nxt[i] = __builtin_nontemporal_load((const f32x4*)(src + (size_t)(lr + 8 * i) * 1024 + lc));
        }
        const int mat = j >> 6, e = mat / 3, which = mat - 3 * e, bb = j & 63, kb = bb & 15, nbk = bb >> 4;
#pragma unroll
        for (int i = 0; i < 8; ++i) { LAS float* t = tile + (lr + 8 * i) * 257 + lc; t[0] = cur[i][0]; t[1] = cur[i][1]; t[2] = cur[i][2]; t[3] = cur[i][3]; }
        __syncthreads();
        {
            const int kq = tid & 7, k0 = kb * 64 + 8 * kq;
            float sc[8];
#pragma unroll
            for (int jj = 0; jj < 8; ++jj) sc[jj] = (which < 2 ? g2[k0 + jj] : 1.0f) * W8_SCALE;
#pragma unroll
            for (int i = 0; i < 4; ++i) {
                const int nn = (tid >> 3) + 64 * i, n = nbk * 256 + nn;
                float v[8];
#pragma unroll
                for (int jj = 0; jj < 8; ++jj) v[jj] = tile[(8 * kq + jj) * 257 + nn] * sc[jj];
                u32x2 w; w.x = pk4_fp8(v[0], v[1], v[2], v[3]); w.y = pk4_fp8(v[4], v[5], v[6], v[7]);
                unsigned char* dst = which < 2 ? WGU + (size_t)e * 2048 * 1024 + (size_t)(256 * (n >> 7) + 128 * which + (n & 127)) * 1024
                                               : WD + (size_t)e * 1024 * 1024 + (size_t)n * 1024;
                __builtin_nontemporal_store(w, (u32x2*)(dst + k0));
            }
        }
        __syncthreads();
        if (!has_next) break;
        j = jn;
#pragma unroll
        for (int i = 0; i < 8; ++i) cur[i] = nxt[i];
    }
}

__device__ __forceinline__ void phase_router(const PPv& p, LAS unsigned char* lds) {
    const int tid = threadIdx.x, bid = blockIdx.x, nb = gridDim.x, lane = tid & 63, wave = tid >> 6;
    unsigned char* ws = p.gws();
    const bf16_t* h1 = (const bf16_t*)(ws + OFF_HB2);
    const float* WRG = (const float*)(ws + OFF_WRG);
    const float* brt = p.gin(29);
    LAS float* slog = (LAS float*)lds;
    LAS float* srs = slog + 8 * 16 * 32;
    LAS int* lcnt = (LAS int*)(srs + 128);
    LAS int* gbase = lcnt + 32;
    LAS int* ltopi = gbase + 32;
    LAS int* lrank = ltopi + 512;
    int* TOPI = (int*)(ws + OFF_TOPI); float* TOPW = (float*)(ws + OFF_TOPW); int* RANK = (int*)(ws + OFF_RANK); float* RSTD2 = (float*)(ws + OFF_RSTD2);
    int* GCNT = (int*)(ws + OFF_GCNT);
    for (int tb = bid; tb < T / 128; tb += nb) {
        if (tid < 32) lcnt[tid] = 0;
        __syncthreads();
        const int t0 = tb * 128 + wave * 16;
        {
            const int row = lane & 15, kq = lane >> 4;
            const bf16_t* ap = h1 + (size_t)(t0 + row) * D + 4 * kq;
            const float* bp = WRG + (size_t)(4 * kq) * 32 + row;
            f32x4 acc0 = (f32x4){0.f, 0.f, 0.f, 0.f}, acc1 = acc0;
            float ss = 0.f;
            for (int j = 0; j < 64; ++j) {
                const u32x2 aw = *(const u32x2*)(ap + 16 * j);
                const f32x4 av = (f32x4){bflo(aw.x), bfhi(aw.x), bflo(aw.y), bfhi(aw.y)};
                ss += av[0] * av[0] + av[1] * av[1] + av[2] * av[2] + av[3] * av[3];
                const float* bj = bp + (size_t)(16 * j) * 32;
#pragma unroll
                for (int s = 0; s < 4; ++s) {
                    const float b0 = bj[s * 32], b1 = bj[s * 32 + 16];
                    acc0 = __builtin_amdgcn_mfma_f32_16x16x4f32(av[s], b0, acc0, 0, 0, 0);
                    acc1 = __builtin_amdgcn_mfma_f32_16x16x4f32(av[s], b1, acc1, 0, 0, 0);
                }
            }
            ss += __shfl_xor(ss, 16); ss += __shfl_xor(ss, 32);
#pragma unroll
            for (int reg = 0; reg < 4; ++reg) {
                slog[(wave * 16 + 4 * kq + reg) * 32 + row] = acc0[reg];
                slog[(wave * 16 + 4 * kq + reg) * 32 + 16 + row] = acc1[reg];
            }
            if (lane < 16) srs[wave * 16 + lane] = rsqrtf(ss * (1.0f / D) + NORM_EPS);
        }
        __syncthreads();
        if (lane < 16) {
            const int tl = wave * 16 + lane, t = tb * 128 + tl;
            const float rs = srs[tl];
            float lg[32];
#pragma unroll
            for (int e = 0; e < 32; ++e) lg[e] = slog[tl * 32 + e] * rs + brt[e];
            int ti[4]; float tv[4];
#pragma unroll
            for (int k = 0; k < 4; ++k) {
                float best = -3.0e38f; int bi = 0;
#pragma unroll
                for (int e = 0; e < 32; ++e) { const bool tk = lg[e] > best; best = tk ? lg[e] : best; bi = tk ? e : bi; }
                ti[k] = bi; tv[k] = best;
#pragma unroll
                for (int e = 0; e < 32; ++e) lg[e] = (e == bi) ? -3.0e38f : lg[e];
            }
            const float e0 = 1.0f, e1 = __expf(tv[1] - tv[0]), e2 = __expf(tv[2] - tv[0]), e3 = __expf(tv[3] - tv[0]);
            const float inv = 1.0f / (e0 + e1 + e2 + e3);
            *(f32x4*)(TOPW + (size_t)t * 4) = (f32x4){e0 * inv, e1 * inv, e2 * inv, e3 * inv};
            RSTD2[t] = rs;
#pragma unroll
            for (int k = 0; k < 4; ++k) { ltopi[tl * 4 + k] = ti[k]; lrank[tl * 4 + k] = __hip_atomic_fetch_add(lcnt + ti[k], 1, __ATOMIC_RELAXED, __HIP_MEMORY_SCOPE_WORKGROUP); }
        }
        __syncthreads();
        if (tid < 32) gbase[tid] = atomicAdd(GCNT + tid, lcnt[tid]);
        __syncthreads();
        {
            const int e = ltopi[tid];
            TOPI[(size_t)tb * 512 + tid] = e;
            RANK[(size_t)tb * 512 + tid] = gbase[e] + lrank[tid];
        }
        __syncthreads();
    }
}

__device__ __forceinline__ void phase_lists(const PPv& p, LAS unsigned char* lds) {
    const int tid = threadIdx.x, bid = blockIdx.x, nb = gridDim.x;
    unsigned char* ws = p.gws();
    LAS int* pstart = (LAS int*)lds;
    LAS int* cnt = pstart + 64;
    const int* GCNT = (const int*)(ws + OFF_GCNT);
    if (tid < 32) cnt[tid] = GCNT[tid];
    __syncthreads();
    if (tid == 0) { int s = 0; for (int e = 0; e < 32; ++e) { pstart[e] = s; s += ((cnt[e] + 255) >> 8) << 8; } pstart[32] = s; }
    __syncthreads();
    const int* TOPI = (const int*)(ws + OFF_TOPI); const float* TOPW = (const float*)(ws + OFF_TOPW); const int* RANK = (const int*)(ws + OFF_RANK); const float* RSTD2 = (const float*)(ws + OFF_RSTD2);
    int* ROWTOK = (int*)(ws + OFF_ROWTOK); int* ROWSLOT = (int*)(ws + OFF_ROWSLOT); float* ROWW = (float*)(ws + OFF_ROWW); float* ROWRS = (float*)(ws + OFF_ROWRS);
    for (int i = bid * 512 + tid; i < T * 4; i += nb * 512) {
        const int e = TOPI[i], pos = pstart[e] + RANK[i], t = i >> 2;
        ROWTOK[pos] = t; ROWSLOT[pos] = i; ROWW[pos] = TOPW[i]; ROWRS[pos] = RSTD2[t];
    }
    for (int e = bid; e < 32; e += nb) {
        for (int pos = pstart[e] + cnt[e] + tid; pos < pstart[e + 1]; pos += 512) { ROWTOK[pos] = 0; ROWSLOT[pos] = -1; ROWW[pos] = 0.f; ROWRS[pos] = 0.f; }
    }
    if (bid == 0) {
        int* TILEE = (int*)(ws + OFF_TILEE);
        const int ntiles = pstart[32] >> 8;
        for (int mt = tid; mt < ntiles; mt += 512) { int e = 0; for (int q = 0; q < 32; ++q) if (pstart[q] <= mt * 256) e = q; TILEE[mt] = e; }
        if (tid == 0) TILEE[1000] = ntiles;
    }
    __syncthreads();
}

__device__ __forceinline__ void phase_final(const PPv& p) {
    const int tid = threadIdx.x, bid = blockIdx.x, nb = gridDim.x, lane = tid & 63, wave = tid >> 6;
    unsigned char* ws = p.gws();
    const bf16_t* HB2 = (const bf16_t*)(ws + OFF_HB2);
    const unsigned char* Y8 = (const unsigned char*)p.gout();
    const float* gf = p.gin(36);
    const f32x4 ga0 = *(const f32x4*)(gf + 8 * lane), ga1 = *(const f32x4*)(gf + 8 * lane + 4), gb0 = *(const f32x4*)(gf + 512 + 8 * lane), gb1 = *(const f32x4*)(gf + 512 + 8 * lane + 4);
    for (int t0 = (bid * 8 + wave) * 2; t0 < T; t0 += nb * 16) {
        u32x4 ha[2], hb[2]; u32x2 ya[2][4], yb[2][4];
#pragma unroll
        for (int u = 0; u < 2; ++u) {
            const int t = t0 + u;
            ha[u] = __builtin_nontemporal_load((const u32x4*)(HB2 + (size_t)t * D + 8 * lane)); hb[u] = __builtin_nontemporal_load((const u32x4*)(HB2 + (size_t)t * D + 512 + 8 * lane));
#pragma unroll
            for (int k = 0; k < 4; ++k) { ya[u][k] = __builtin_nontemporal_load((const u32x2*)(Y8 + (size_t)(4 * t + k) * 1024 + 8 * lane)); yb[u][k] = __builtin_nontemporal_load((const u32x2*)(Y8 + (size_t)(4 * t + k) * 1024 + 512 + 8 * lane)); }
        }
#pragma unroll
        for (int u = 0; u < 2; ++u) {
            const int t = t0 + u;
            float va[8] = {bflo(ha[u].x), bfhi(ha[u].x), bflo(ha[u].y), bfhi(ha[u].y), bflo(ha[u].z), bfhi(ha[u].z), bflo(ha[u].w), bfhi(ha[u].w)};
            float vb[8] = {bflo(hb[u].x), bfhi(hb[u].x), bflo(hb[u].y), bfhi(hb[u].y), bflo(hb[u].z), bfhi(hb[u].z), bflo(hb[u].w), bfhi(hb[u].w)};
#pragma unroll
            for (int k = 0; k < 4; ++k) {
                const u32x2 a4 = ya[u][k], b4 = yb[u][k];
                { const f32x2 q0 = __builtin_amdgcn_cvt_pk_f32_fp8((int)a4.x, false), q1 = __builtin_amdgcn_cvt_pk_f32_fp8((int)a4.x, true), q2 = __builtin_amdgcn_cvt_pk_f32_fp8((int)a4.y, false), q3 = __builtin_amdgcn_cvt_pk_f32_fp8((int)a4.y, true);
                  va[0] += q0.x; va[1] += q0.y; va[2] += q1.x; va[3] += q1.y; va[4] += q2.x; va[5] += q2.y; va[6] += q3.x; va[7] += q3.y; }
                { const f32x2 q0 = __builtin_amdgcn_cvt_pk_f32_fp8((int)b4.x, false), q1 = __builtin_amdgcn_cvt_pk_f32_fp8((int)b4.x, true), q2 = __builtin_amdgcn_cvt_pk_f32_fp8((int)b4.y, false), q3 = __builtin_amdgcn_cvt_pk_f32_fp8((int)b4.y, true);
                  vb[0] += q0.x; vb[1] += q0.y; vb[2] += q1.x; vb[3] += q1.y; vb[4] += q2.x; vb[5] += q2.y; vb[6] += q3.x; vb[7] += q3.y; }
            }
            float ss = 0.f;
#pragma unroll
            for (int j = 0; j < 8; ++j) ss += va[j] * va[j] + vb[j] * vb[j];
            ss = wave_sum_dpp(ss);
            const float rs = rsqrtf(ss * (1.0f / D) + NORM_EPS);
            float* o = p.gout() + (size_t)t * D;
            __builtin_nontemporal_store((f32x4){va[0] * rs * ga0[0], va[1] * rs * ga0[1], va[2] * rs * ga0[2], va[3] * rs * ga0[3]}, (f32x4*)(o + 8 * lane));
            __builtin_nontemporal_store((f32x4){va[4] * rs * ga1[0], va[5] * rs * ga1[1], va[6] * rs * ga1[2], va[7] * rs * ga1[3]}, (f32x4*)(o + 8 * lane + 4));
            __builtin_nontemporal_store((f32x4){vb[0] * rs * gb0[0], vb[1] * rs * gb0[1], vb[2] * rs * gb0[2], vb[3] * rs * gb0[3]}, (f32x4*)(o + 512 + 8 * lane));
            __builtin_nontemporal_store((f32x4){vb[4] * rs * gb1[0], vb[5] * rs * gb1[1], vb[6] * rs * gb1[2], vb[7] * rs * gb1[3]}, (f32x4*)(o + 512 + 8 * lane + 4));
        }
    }
}

#define XB_TMO      128
#define XB_XCNT(j)  (256  + 64 * (j))
#define XB_XSUB(j)  (1280 + 64 * (j))
#define XB_XGEN(j)  (2304 + 64 * (j))
#define XB_TOP      3328
#define XB_TOPGEN   3392
#define XCD_BAR_WORDS 3456
#define XB_SPIN_CAP (1u << 18)
__device__ __forceinline__ unsigned xb_ld(unsigned* p)              { return __hip_atomic_load(p, __ATOMIC_RELAXED, __HIP_MEMORY_SCOPE_AGENT); }
__device__ __forceinline__ unsigned xb_add(unsigned* p, unsigned v) { return __hip_atomic_fetch_add(p, v, __ATOMIC_RELAXED, __HIP_MEMORY_SCOPE_AGENT); }
__device__ __forceinline__ unsigned xb_xcc_id() { return (unsigned)__builtin_amdgcn_s_getreg((3 << 11) | 20) & 0xFu; }
#define XB_SPIN(cond, bar) do { unsigned _sp = 0; while (cond) { __builtin_amdgcn_s_sleep(1); \
    if ((++_sp & 255u) == 0u) { if (xb_ld(&(bar)[XB_TMO])) break; if (_sp > XB_SPIN_CAP) { atomicAdd(&(bar)[XB_TMO], 1u); break; } } } } while (0)
struct XcdBarrier { unsigned* bar; unsigned x; volatile LAS unsigned* st; };
__device__ __forceinline__ XcdBarrier xcd_barrier_post(unsigned* bar, volatile LAS unsigned* st) {
    XcdBarrier b; b.bar = bar; b.x = xb_xcc_id(); b.st = st;
    if (threadIdx.x == 0) (void)xb_add(&bar[XB_XCNT(b.x)], 1u);
    return b;
}
__device__ __forceinline__ void xcd_barrier_complete(unsigned* bar, unsigned x, unsigned& nloc, unsigned& nx) {
    const unsigned G = gridDim.x * gridDim.y * gridDim.z;
    unsigned sum, cnt, mine, sp = 0u;
    for (;;) {
        sum = 0u; cnt = 0u; mine = 0u;
#pragma unroll
        for (unsigned j = 0; j < 16; ++j) { const unsigned c = xb_ld(&bar[XB_XCNT(j)]); sum += c; cnt += (c > 0u) ? 1u : 0u; mine = (j == x) ? c : mine; }
        if (sum == G) break;
        __builtin_amdgcn_s_sleep(1);
        if ((++sp & 255u) == 0u) { if (xb_ld(&bar[XB_TMO])) break; if (sp > XB_SPIN_CAP) { atomicAdd(&bar[XB_TMO], 1u); break; } }
    }
    nloc = mine > 0u ? mine : 1u; nx = cnt > 0u ? cnt : 1u;
}
__device__ __forceinline__ void xcd_barrier(const XcdBarrier& b) {
    asm volatile("s_waitcnt vmcnt(0)" ::: "memory");
    __syncthreads();
    if (threadIdx.x == 0) {
        unsigned* bar = b.bar;
        __builtin_amdgcn_s_waitcnt(0);
        unsigned nloc = b.st[0], nx = b.st[1];
        if (nloc == 0u) { xcd_barrier_complete(bar, b.x, nloc, nx); b.st[0] = nloc; b.st[1] = nx; }
        const unsigned old = xb_add(&bar[XB_XSUB(b.x)], 1u);
        const unsigned gen = old / nloc;
        if (old + 1u == (gen + 1u) * nloc) {
            __builtin_amdgcn_fence(__ATOMIC_RELEASE, "agent");
            asm volatile("s_waitcnt vmcnt(0)" ::: "memory");
            const unsigned og = xb_add(&bar[XB_TOP], 1u);
            const unsigned tg = og / nx;
            if (og + 1u == (tg + 1u) * nx) xb_add(&bar[XB_TOPGEN], 1u);
            else XB_SPIN(xb_ld(&bar[XB_TOPGEN]) == tg, bar);
            __builtin_amdgcn_fence(__ATOMIC_ACQUIRE, "agent");
            xb_add(&bar[XB_XGEN(b.x)], 1u);
            asm volatile("s_waitcnt vmcnt(0)" ::: "memory");
        } else {
            XB_SPIN(xb_ld(&bar[XB_XGEN(b.x)]) == gen, bar);
            __builtin_amdgcn_fence(__ATOMIC_ACQUIRE, "agent");
            asm volatile("s_waitcnt vmcnt(0)" ::: "memory");
        }
    }
    __syncthreads();
}

constexpr int N_PHASES = 15;
__global__ void __launch_bounds__(512, 2) mega(Params p) {
    extern __shared__ __attribute__((aligned(16))) unsigned char lds_raw[];
    LAS unsigned char* lds = (LAS unsigned char*)lds_raw;
    cg::grid_group grid = cg::this_grid();
    unsigned char* ws = getpp().gws();
    const int G = gridDim.x, bid = blockIdx.x;
#ifndef ONLY_PHASE
#define ONLY_PHASE -1
#endif
#define IN(k) ((ONLY_PHASE < 0 || ONLY_PHASE == (k)) && p.ph_lo <= (k) && (k) < p.ph_hi)
    volatile LAS unsigned* xst = (volatile LAS unsigned*)(lds + 163840 - 16);
    if (threadIdx.x < 4) xst[threadIdx.x] = 0u;
    __syncthreads();
    const XcdBarrier xbar = xcd_barrier_post((unsigned*)(ws + OFF_BAR), xst);
    if (p.ph_hi < 0) grid.sync();
#define SEAM(k) do { if ((k) + 1 < p.ph_hi) xcd_barrier(xbar); } while (0)
    if (IN(0)) { const PPv q = getpp(); phase_prep(q, lds); SEAM(0); }
    if (IN(1)) { const PPv q = getpp();
        phase_meta_proj(q, lds);
        {
            StaticOrder S; S.init(ws + OFF_HB, ws + OFF_WIN, T, 14 * 256, 1024, G, bid);
            EpiProj E{(bf16_t*)(ws + OFF_PRKV), (bf16_t*)(ws + OFF_PCONV), (bf16_t*)q.gout(), (const float*)(ws + OFF_RSTD1), 0, 1.0f};
            gemm_phase<false>(lds, 1024, S, E);
        }
        {
            StaticOrder S; S.init(ws + OFF_X8, ws + OFF_WIN8, T, 8 * 256, 512, G, bid);
            EpiProj E{(bf16_t*)(ws + OFF_PRKV), (bf16_t*)(ws + OFF_PCONV), (bf16_t*)q.gout(), (const float*)(ws + OFF_RSTD1), 14, W8_INV};
            gemm_phase<false, true>(lds, 512, S, E);
        }
        SEAM(1);
    }
    if (IN(2)) { const PPv q = getpp(); phase_lprep_conv(q); SEAM(2); }
    if (IN(3)) { const PPv q = getpp();
        phase_meta_lora(q);
        StaticOrder S; S.init(ws + OFF_L + (size_t)NMETA * 256 * 2, ws + OFF_W2, T, 1536, 256, G, bid);
        EpiL E{ws, q.gin(10), q.gin(13)};
        gemm_phase<false>(lds, 256, S, E);
        SEAM(3);
    }
    if (IN(4)) { const PPv q = getpp(); phase_scanprep(q, lds); SEAM(4); }
    if (IN(5)) { const PPv q = getpp(); phase_recur(q, lds); SEAM(5); }
    if (IN(6)) { const PPv q = getpp(); phase_gn(q, lds); SEAM(6); }
    if (IN(7)) { const PPv q = getpp();
        MergeOrder S; S.so.init(ws + OFF_Z, ws + OFF_WR, T, 1024, 512, G, bid); S.A1 = (const char*)(ws + OFF_C); S.B1 = (const char*)(ws + OFF_WC);
        EpiMergeFused E{(bf16_t*)(ws + OFF_MERGED), (const bf16_t*)q.gout()};
        gemm_phase<false>(lds, 512, S, E);
        SEAM(7);
    }
    if (IN(9)) { const PPv q = getpp();
        StaticOrder S; S.init(ws + OFF_MERGED, ws + OFF_WO, T, 1024, 1024, G, bid);
        EpiO E{q.gin(0), q.gout(), (bf16_t*)(ws + OFF_HB2), ws + OFF_HB8};
        gemm_phase<false>(lds, 1024, S, E);
        SEAM(9);
    }
    if (IN(10)) { const PPv q = getpp(); phase_router(q, lds); SEAM(10); }
    if (IN(11)) { const PPv q = getpp(); phase_lists(q, lds); SEAM(11); }
    if (IN(12)) { const PPv q = getpp();
        const int* TILEE = (const int*)(ws + OFF_TILEE);
        MoeOrder S; S.A = (const char*)(ws + OFF_HB8); S.Bt = (const char*)(ws + OFF_WGU); S.K = 512; S.estride = (size_t)2048 * 1024;
        S.tile_e = TILEE; S.rowtok = (const int*)(ws + OFF_ROWTOK); S.ntiles = TILEE[1000]; S.nnt = 8; S.G = G; S.c = bid; S.gather = true;
        EpiMoe1 E{ws + OFF_ACT, (const float*)(ws + OFF_ROWRS), q.gin(31), q.gin(33)};
        gemm_phase<true, true>(lds, 512, S, E);
        SEAM(12);
    }
    if (IN(13)) { const PPv q = getpp();
        const int* TILEE = (const int*)(ws + OFF_TILEE);
        MoeOrder S; S.A = (const char*)(ws + OFF_ACT); S.Bt = (const char*)(ws + OFF_WD); S.K = 512; S.estride = (size_t)1024 * 1024;
        S.tile_e = TILEE; S.rowtok = nullptr; S.ntiles = TILEE[1000]; S.nnt = 4; S.G = G; S.c = bid; S.gather = false;
        EpiMoe2 E{(unsigned char*)q.gout(), (const int*)(ws + OFF_ROWSLOT), (const float*)(ws + OFF_ROWW), q.gin(35)};
        gemm_phase<false, true>(lds, 512, S, E);
        SEAM(13);
    }
    if (IN(14)) { const PPv q = getpp(); phase_final(q); }
}

extern "C" void kernel_launch(void* const* d_in, const int* in_sizes, int n_in, void* d_out, int out_size, void* d_ws, size_t ws_size,
                              hipStream_t stream) {
    constexpr size_t kDynLds = 160 * 1024;
    static int grid_blocks = 0;
    if (!grid_blocks) {
        int dev = 0, cus = 0, per_cu = 0;
        (void)hipGetDevice(&dev);
        (void)hipDeviceGetAttribute(&cus, hipDeviceAttributeMultiprocessorCount, dev);
        (void)hipFuncSetAttribute((const void*)mega, hipFuncAttributeMaxDynamicSharedMemorySize, (int)kDynLds);
        (void)hipOccupancyMaxActiveBlocksPerMultiprocessor(&per_cu, mega, 512, kDynLds);
        if (per_cu > 1) per_cu = 1;
        grid_blocks = cus * per_cu;
        fprintf(stderr, "cus=%d per_cu=%d ws_size=%zu need=%zu\n", cus, per_cu, ws_size, (size_t)WS_NEED);
    }
    if (ws_size < WS_NEED || n_in < 37 || grid_blocks < 128) { fprintf(stderr, "kernel_launch: unsupported configuration\n"); return; }
    Params p{};
    for (int i = 0; i < 37; ++i) p.in[i] = (const float*)d_in[i];
    p.out = (float*)d_out;
    p.ws = (unsigned char*)d_ws;
    p.ph_lo = 0; p.ph_hi = N_PHASES;
    (void)hipMemsetAsync((unsigned char*)d_ws + OFF_BAR, 0, 16384, stream);
    void* args[] = {&p};
    hipError_t e = hipLaunchCooperativeKernel((void*)mega, dim3(grid_blocks), dim3(512), args, kDynLds, stream);
    if (e != hipSuccess) fprintf(stderr, "cooperative launch failed: %s (grid %d)\n", hipGetErrorString(e), grid_blocks);
}
```

```cpp
#include <hip/hip_runtime.h>
#include <hip/hip_cooperative_groups.h>
#include <cstdio>
namespace cg = cooperative_groups;

#define LAS __attribute__((address_space(3)))
typedef unsigned short bf16_t;
typedef short bf16x8 __attribute__((ext_vector_type(8)));
typedef float f32x4 __attribute__((ext_vector_type(4)));
typedef float f32x2 __attribute__((ext_vector_type(2)));
typedef unsigned u32x4 __attribute__((ext_vector_type(4)));
typedef unsigned u32x2 __attribute__((ext_vector_type(2)));
#define LO2(v) __builtin_shufflevector(v, v, 0, 1)
#define HI2(v) __builtin_shufflevector(v, v, 2, 3)

constexpr int D = 1024, NBATCH = 8, SEQ = 4096, NMETA = 16;
constexpr int T = NBATCH * SEQ;
constexpr int NR = T + NMETA;
constexpr int NRP = 33024;
constexpr int PCOLS1 = 3584;
constexpr int NCOLS1 = 5632;
constexpr int NE = 32, TOPK = 4, DFF = 1024;
constexpr int MAXROWS = T * TOPK + NE * 256;
constexpr int MAXTILES = MAXROWS / 256;
constexpr float NORM_EPS = 1e-5f, LNX_EPS = 64e-5f;

constexpr int NCHUNK = 257, NUNITS = 64 * NCHUNK;
constexpr int REC_BYTES = 13568;
constexpr int RO_WH = 0, RO_RT = 2048, RO_U0T = 4096, RO_VT = 6144, RO_BKT = 8192, RO_ARK = 12288, RO_WCC = 13312;
constexpr int SLOT_BYTES = 15680, SO_G = 13568, SO_COEF = 15616, NSLOT = 9;
constexpr size_t SZ_ACT = (size_t)MAXROWS * 1024 * 2;
constexpr size_t SZ_WGU = (size_t)NE * 2048 * 1024 * 2;
constexpr size_t SZ_WD = (size_t)NE * 1024 * 1024 * 2;
constexpr size_t SZ_HB = (size_t)T * 1024 * 2;
constexpr size_t OFF_WGU = 0;
constexpr size_t OFF_HB8 = OFF_WGU + (size_t)NE * 2048 * 1024;
constexpr size_t OFF_WD = OFF_WGU + SZ_WGU;
constexpr size_t OFF_ACT = OFF_WD + SZ_WD;
constexpr size_t OFF_HB2 = OFF_ACT + SZ_ACT;
constexpr size_t OFF_RT = OFF_HB2 + SZ_HB;
constexpr size_t OFF_TOPI = OFF_RT;
constexpr size_t OFF_TOPW = OFF_TOPI + (size_t)T * 16;
constexpr size_t OFF_RANK = OFF_TOPW + (size_t)T * 16;
constexpr size_t OFF_RSTD2 = OFF_RANK + (size_t)T * 16;
constexpr size_t OFF_ROWTOK = OFF_RSTD2 + (size_t)T * 4;
constexpr size_t OFF_ROWSLOT = OFF_ROWTOK + (size_t)MAXROWS * 4;
constexpr size_t OFF_ROWW = OFF_ROWSLOT + (size_t)MAXROWS * 4;
constexpr size_t OFF_ROWRS = OFF_ROWW + (size_t)MAXROWS * 4;
constexpr size_t OFF_TILEE = OFF_ROWRS + (size_t)MAXROWS * 4;
constexpr size_t OFF_GCNT = OFF_TILEE + 4096;
constexpr size_t OFF_SM = OFF_GCNT + 256;
constexpr size_t OFF_WR = OFF_SM;
constexpr size_t OFF_WC = OFF_WR + (size_t)1024 * 512 * 2;
constexpr size_t OFF_WO = OFF_WC + (size_t)1024 * 512 * 2;
constexpr size_t OFF_W2 = OFF_WO + (size_t)1024 * 1024 * 2;
constexpr size_t OFF_RSTD1 = OFF_W2 + (size_t)1536 * 256 * 2;
constexpr size_t OFF_WRG = OFF_RSTD1 + (size_t)NRP * 4;
constexpr size_t OFF_BAR = OFF_WRG + (size_t)1024 * 32 * 4;
constexpr size_t WS_NEED = OFF_BAR + 16384;
constexpr size_t OFF_PRKV = 0;
constexpr size_t SZ_PRKV = (size_t)NR * 1536 * 2;
constexpr size_t OFF_LD = OFF_PRKV + SZ_PRKV;
constexpr size_t OFF_A = OFF_LD + (size_t)NRP * 512 * 4;
constexpr size_t OFF_X8 = OFF_LD;
constexpr size_t OFF_WIN8 = OFF_X8 + (size_t)T * 1024;
static_assert(OFF_WIN8 + (size_t)2048 * 1024 <= OFF_A, "layout");
constexpr size_t OFF_CH = OFF_A + (size_t)NRP * 512 * 2;
constexpr size_t OFF_PCONV = OFF_CH;
constexpr size_t SZ_PCONV = (size_t)NR * 2048 * 2;
constexpr size_t OFF_HB = OFF_PCONV + SZ_PCONV;
constexpr size_t OFF_L = OFF_HB + SZ_HB;
constexpr size_t OFF_WIN = OFF_L + (size_t)NRP * 256 * 2;
constexpr size_t CH_END = OFF_WIN + (size_t)NCOLS1 * 1024 * 2;
constexpr size_t OFF_MERGED = OFF_CH;
constexpr size_t OFF_G = CH_END;
constexpr size_t OFF_C = OFF_G + (size_t)NRP * 512 * 2;
constexpr size_t OFF_Z = OFF_C + (size_t)T * 512 * 2;
constexpr size_t OFF_COEF = OFF_Z + (size_t)T * 512 * 2;
constexpr size_t EARLY_END = OFF_COEF + (size_t)NR * 8 * 4;
static_assert(EARLY_END <= OFF_RT, "early buffers overflow");
static_assert(OFF_CH + (size_t)NUNITS * REC_BYTES <= CH_END, "chunk records overflow");
static_assert(OFF_CH >= OFF_WD + SZ_WD, "expert weights (written during the scan) must not touch live scan buffers");
static_assert(OFF_MERGED + SZ_HB <= OFF_HB2, "layout");
static_assert(OFF_PRKV % 16 == 0 && OFF_LD % 16 == 0 && OFF_A % 16 == 0 && OFF_CH % 16 == 0 && OFF_HB % 16 == 0 && OFF_L % 16 == 0 && OFF_WIN % 16 == 0 && OFF_G % 16 == 0 && OFF_C % 16 == 0 && OFF_Z % 16 == 0 && OFF_COEF % 16 == 0, "align");

#define GAS __attribute__((address_space(1)))
#define CAS __attribute__((address_space(4)))
struct Params {
    const float* in[37];
    float* out;
    unsigned char* ws;
    int ph_lo, ph_hi;
};
struct ParamsD {
    const GAS float* in[37];
    GAS float* out;
    GAS unsigned char* ws;
    int ph_lo, ph_hi;
};
static_assert(sizeof(Params) == sizeof(ParamsD), "argument views");
struct PPv {
    const CAS ParamsD* k;
    __device__ __forceinline__ const float* gin(int i) const { return (const float*)k->in[i]; }
    __device__ __forceinline__ float* gout() const { return (float*)k->out; }
    __device__ __forceinline__ unsigned char* gws() const { return (unsigned char*)k->ws; }
};
__device__ __forceinline__ PPv getpp() { const CAS ParamsD* k = (const CAS ParamsD*)__builtin_amdgcn_kernarg_segment_ptr(); asm volatile("" : "+s"(k)); return PPv{k}; }

typedef __bf16 bf16x2v __attribute__((ext_vector_type(2)));
__device__ __forceinline__ unsigned cvt_pk_bf16(float lo, float hi) { const f32x2 v = {lo, hi}; return __builtin_bit_cast(unsigned, __builtin_convertvector(v, bf16x2v)); }
__device__ __forceinline__ unsigned pk4_fp8(float a, float b, float c, float d) { int w = __builtin_amdgcn_cvt_pk_fp8_f32(a, b, 0, false); w = __builtin_amdgcn_cvt_pk_fp8_f32(c, d, w, true); return (unsigned)w; }
constexpr float W8_SCALE = 32.0f, W8_INV = 1.0f / 32.0f;
__device__ __forceinline__ bf16_t f2bf(float f) { unsigned u = __float_as_uint(f); u += 0x7FFFu + ((u >> 16) & 1u); return (bf16_t)(u >> 16); }
__device__ __forceinline__ float bf2f(bf16_t b) { return __uint_as_float(((unsigned)b) << 16); }
__device__ __forceinline__ float bflo(unsigned w) { return __uint_as_float(w << 16); }
__device__ __forceinline__ float bfhi(unsigned w) { return __uint_as_float(w & 0xFFFF0000u); }
__device__ __forceinline__ float sigmoidf_(float x) { return __builtin_amdgcn_rcpf(1.0f + __expf(-x)); }
__device__ __forceinline__ float wave_sum(float v) {
#pragma unroll
    for (int o = 32; o >= 1; o >>= 1) v += __shfl_xor(v, o);
    return v;
}
__device__ __forceinline__ float wave_sum_dpp(float v);
__device__ __forceinline__ int prev_row(int row, int d) {
    if (row < NMETA) return row - d >= 0 ? row - d : -1;
    const int s = (row - NMETA) & (SEQ - 1);
    return s >= d ? row - d : NMETA + s - d;
}

constexpr int BM = 256, BK = 64, HALF = 128, HTB = HALF * BK * 2, STAGE_BYTES = 8 * HTB, NXCD = 8, WGM = 8;
__device__ __forceinline__ int lds_byte(int r, int c) { const int st = (r >> 4) * 2 + (c >> 5), rr = r & 15, cc = c & 31, ob = rr * 64 + cc * 2; return st * 1024 + (ob ^ (((ob >> 9) & 1) << 5)); }
__device__ __forceinline__ void stage_rc(int b, int& R, int& C) { const int st = b / 1024, sb = b % 1024, swz = sb ^ (((sb >> 9) & 1) << 5); R = (st >> 1) * 16 + swz / 64; C = (st & 1) * 32 + (swz % 64) / 2; }
__device__ __forceinline__ int perm32(int rho) { const int n = rho >> 4, i = rho & 15; return 8 * (i >> 2) + 4 * n + (i & 3); }

struct Unit { int pm, pn, aux; };

struct StaticOrder {
    const char* A; const char* Bt; int K;
    int nM, nN, nwg, G, c;
    __device__ void init(const void* A_, const void* Bt_, int M, int N, int K_, int G_, int c_) { A = (const char*)A_; Bt = (const char*)Bt_; K = K_; nM = M / BM; nN = N / BM; nwg = nM * nN; G = G_; c = c_; }
    __device__ bool next(int i, Unit& u) const {
        const long L = (long)i * G + c; if (L >= nwg) return false;
        int wgid = (int)L; { const int q = nwg / NXCD, r = nwg % NXCD, xcd = wgid % NXCD, off = wgid / NXCD; wgid = (xcd < r ? xcd * (q + 1) : r * (q + 1) + (xcd - r) * q) + off; }
        const int nig = WGM * nN, gid = wgid / nig, fm = gid * WGM, gsz = (nM - fm) < WGM ? (nM - fm) : WGM;
        u.pm = fm + ((wgid % nig) % gsz); u.pn = (wgid % nig) / gsz; u.aux = 0; return true;
    }
    __device__ __forceinline__ const char* a_ptr(const Unit& u) const { return A + (size_t)u.pm * 256 * K * 2; }
    __device__ __forceinline__ const char* b_ptr(const Unit& u) const { return Bt + (size_t)u.pn * 256 * K * 2; }
    __device__ __forceinline__ int gather_row(const Unit&, int) const { return 0; }
    __device__ __forceinline__ const void* gather_src(const Unit&, int) const { return nullptr; }
};
struct MoeOrder {
    const char* A; const char* Bt; int K; size_t estride;
    const int* tile_e; const int* rowtok; int ntiles, nnt, G, c; bool gather;
    __device__ bool next(int i, Unit& u) const {
        int mt, nt;
        if ((G & 7) == 0 && ((G >> 3) % nnt) == 0) {
            const int x = c & 7, j = c >> 3, per = (G >> 3) / nnt;
            mt = (i * 8 + x) * per + j / nnt; nt = j % nnt;
        } else { const long L = (long)i * G + c; mt = (int)(L / nnt); nt = (int)(L % nnt); }
        if (mt >= ntiles) return false;
        u.pm = mt; u.pn = nt; u.aux = tile_e[mt]; return true;
    }
    __device__ __forceinline__ const char* a_ptr(const Unit& u) const { return gather ? A : A + (size_t)u.pm * 256 * K * 2; }
    __device__ __forceinline__ const char* b_ptr(const Unit& u) const { return Bt + (size_t)u.aux * estride + (size_t)u.pn * 256 * K * 2; }
    __device__ __forceinline__ int gather_row(const Unit& u, int r) const { return rowtok[u.pm * 256 + r]; }
    __device__ __forceinline__ const void* gather_src(const Unit& u, int lane) const { return rowtok + u.pm * 256 + lane * 4; }
};

typedef int i32x4 __attribute__((ext_vector_type(4)));
typedef int i32x8 __attribute__((ext_vector_type(8)));
template <bool GATHER, bool FP8 = false, class Epi, class Sched>
__device__ __forceinline__ void gemm_phase(LAS unsigned char* lds, const int K_, const Sched& S, const Epi& E) {
    int K = K_; asm volatile("" : "+s"(K));
    const int tid = threadIdx.x, wid = __builtin_amdgcn_readfirstlane(tid >> 6), lane = tid & 63, wr = wid >> 2, wc = wid & 3, fr = lane & 15, fq = lane >> 4;
    const int nt = K / BK;
    unsigned voffA[2], voffB[2]; int Rr[2], Cc[2];
#pragma unroll
    for (int i = 0; i < 2; ++i) { int R, C; stage_rc(tid * 16 + i * 8192, R, C); const int Rb = (R & ~31) + perm32(R & 31);
        Rr[i] = R; Cc[i] = C; voffA[i] = (unsigned)(R * K + C) * 2u; voffB[i] = (unsigned)(Rb * K + C) * 2u; }
    const size_t kstep = (size_t)(BK * 2);
    const size_t hstep = (size_t)HALF * K * 2;
    const unsigned ldsw = (unsigned)wid * 1024u;
    const int aoff = lds_byte(wr * 64 + fr, fq * 8), boff = lds_byte(wc * 32 + fr, fq * 8);
    unsigned vgc[2][2], vgn[2][2];
    LAS unsigned char* const parbase = lds + STAGE_BYTES;
    constexpr int NPAR = Epi::NPAR;
#define G_PAR_ISSUE(unit, uidx, hasnx, nxunit) do { \
        LAS unsigned char* _ps = parbase + ((uidx) & 1) * 4096; \
        if (wid < NPAR) __builtin_amdgcn_global_load_lds((const unsigned*)E.par_src(unit, wid, lane), (LAS unsigned*)(_ps + wid * 1024), 16, 0, 0); \
        if (GATHER && (hasnx) && wid == NPAR) __builtin_amdgcn_global_load_lds((const unsigned*)S.gather_src(nxunit, lane), (LAS unsigned*)(_ps + NPAR * 1024), 16, 0, 0); } while (0)
#define G_CAT8(x0, x1) __builtin_shufflevector(__builtin_bit_cast(i32x4, x0), __builtin_bit_cast(i32x4, x1), 0, 1, 2, 3, 4, 5, 6, 7)
#define G_SA(b, h) (((b) * 2 + (h)) * HTB)
#define G_SB(b, h) ((4 + (b) * 2 + (h)) * HTB)
#define G_STAGE(bufoff, gbase, voff) do { _Pragma("unroll") for (int _i = 0; _i < 2; ++_i) \
        __builtin_amdgcn_global_load_lds((const unsigned*)((const char*)(gbase) + (voff)[_i]), (LAS unsigned*)(lds + (bufoff) + ldsw + _i * 8192), 16, 0, 0); } while (0)
#define G_STAGE_A(bufoff, kptr, h, VG) do { if (GATHER) { G_STAGE(bufoff, kptr, VG[h]); } else { G_STAGE(bufoff, (kptr) + (h) * hstep, voffA); } } while (0)
#define G_LDA(dst, b, h) do { _Pragma("unroll") for (int m = 0; m < 4; ++m) { \
        if (FP8) dst##8[m] = G_CAT8(*(const LAS bf16x8*)(lds + G_SA(b, h) + aoff + m * 2048), *(const LAS bf16x8*)(lds + G_SA(b, h) + aoff + m * 2048 + 1024)); \
        else { _Pragma("unroll") for (int k = 0; k < 2; ++k) dst[m][k] = *(const LAS bf16x8*)(lds + G_SA(b, h) + aoff + m * 2048 + k * 1024); } } } while (0)
#define G_LDB(dst, b, h) do { _Pragma("unroll") for (int n = 0; n < 2; ++n) { \
        if (FP8) dst##8[n] = G_CAT8(*(const LAS bf16x8*)(lds + G_SB(b, h) + boff + n * 2048), *(const LAS bf16x8*)(lds + G_SB(b, h) + boff + n * 2048 + 1024)); \
        else { _Pragma("unroll") for (int k = 0; k < 2; ++k) dst[n][k] = *(const LAS bf16x8*)(lds + G_SB(b, h) + boff + n * 2048 + k * 1024); } } } while (0)
#define G_MMA(ai, bj, At, Bt) do { __builtin_amdgcn_s_setprio(1); _Pragma("unroll") for (int m = 0; m < 4; ++m) _Pragma("unroll") for (int n = 0; n < 2; ++n) { \
        if (FP8) asm volatile("v_mfma_scale_f32_16x16x128_f8f6f4 %0, %1, %2, %0, %3, %3 op_sel_hi:[0,0,0]" : "+v"(acc[ai][bj][m][n]) : "v"(Bt##8[n]), "v"(At##8[m]), "v"(sc8)); \
        else { _Pragma("unroll") for (int k = 0; k < 2; ++k) acc[ai][bj][m][n] = __builtin_amdgcn_mfma_f32_16x16x32_bf16(Bt[n][k], At[m][k], acc[ai][bj][m][n], 0, 0, 0); } } \
        __builtin_amdgcn_s_setprio(0); } while (0)
#define G_WAIT_V(n) asm volatile("s_waitcnt vmcnt(" #n ")" ::: "memory")
#define G_WAIT_L(n) asm volatile("s_waitcnt lgkmcnt(" #n ")" ::: "memory")
#define G_BAR __builtin_amdgcn_s_barrier()
#define G_SCHED __builtin_amdgcn_sched_barrier(0)
    Unit cur, nxt;
    int ui = 0;
    if (!S.next(0, cur)) return;
    f32x4 acc[2][2][4][2];
#pragma unroll
    for (int a = 0; a < 2; ++a)
#pragma unroll
        for (int b = 0; b < 2; ++b)
#pragma unroll
            for (int m = 0; m < 4; ++m)
#pragma unroll
                for (int n = 0; n < 2; ++n) acc[a][b][m][n] = (f32x4){0.f, 0.f, 0.f, 0.f};
    bf16x8 At[4][2], B0[2][2], B1[2][2];
    i32x8 At8[4], B08[2], B18[2];
    int sc8 = 0x7F7F7F7F; asm volatile("" : "+v"(sc8));
    const char* cA = S.a_ptr(cur); const char* cB = S.b_ptr(cur);
    if (GATHER) {
#pragma unroll
        for (int h = 0; h < 2; ++h)
#pragma unroll
            for (int i = 0; i < 2; ++i) vgc[h][i] = (unsigned)(S.gather_row(cur, h * HALF + Rr[i]) * K + Cc[i]) * 2u;
    }
    { Unit n1; const bool hn1 = S.next(1, n1); G_PAR_ISSUE(cur, 0, hn1, n1); }
    G_STAGE(G_SB(0, 0), cB, voffB); G_STAGE_A(G_SA(0, 0), cA, 0, vgc); G_STAGE(G_SB(0, 1), cB + hstep, voffB); G_STAGE_A(G_SA(0, 1), cA, 1, vgc);
    if (wr == 1) G_BAR;
    G_WAIT_V(4); G_BAR;
    G_STAGE(G_SB(1, 0), cB + kstep, voffB); G_STAGE_A(G_SA(1, 0), cA + kstep, 0, vgc); G_STAGE(G_SB(1, 1), cB + hstep + kstep, voffB);
    G_WAIT_V(6); G_BAR;
    for (;;) {
        const bool has_next = S.next(ui + 1, nxt);
        const char* nA = has_next ? S.a_ptr(nxt) : cA; const char* nB = has_next ? S.b_ptr(nxt) : cB;
        if (ui > 0) G_PAR_ISSUE(cur, ui, has_next, nxt);
        if (GATHER) {
#pragma unroll
            for (int h = 0; h < 2; ++h)
#pragma unroll
                for (int i = 0; i < 2; ++i) vgn[h][i] = vgc[h][i];
        }
        for (int t = 0; t < nt; t += 2) {
            const bool last = (t == nt - 2);
            const char* a1 = cA + (size_t)(t + 1) * kstep;
            const char* a2 = last ? nA : cA + (size_t)(t + 2) * kstep; const char* b2 = last ? nB : cB + (size_t)(t + 2) * kstep;
            const char* a3 = a2 + kstep; const char* b3 = b2 + kstep;
            unsigned vg2[2][2];
            if (GATHER) {
#pragma unroll
                for (int h = 0; h < 2; ++h)
#pragma unroll
                    for (int i = 0; i < 2; ++i) vg2[h][i] = last ? vgn[h][i] : vgc[h][i];
            }
            G_LDB(B0, 0, 0); G_SCHED; G_LDA(At, 0, 0); G_STAGE_A(G_SA(1, 1), a1, 1, vgc);
            G_WAIT_L(8); G_BAR; G_WAIT_L(0); G_MMA(0, 0, At, B0); G_BAR; G_SCHED;
            G_LDB(B1, 0, 1); G_STAGE(G_SB(0, 0), b2, voffB);
            G_BAR; G_WAIT_L(0); G_MMA(0, 1, At, B1); G_BAR;
            G_LDA(At, 0, 1); G_STAGE_A(G_SA(0, 0), a2, 0, vg2);
            G_BAR; G_WAIT_L(0); G_MMA(1, 0, At, B0); G_BAR; G_SCHED;
            G_STAGE(G_SB(0, 1), b2 + hstep, voffB);
            G_WAIT_V(6); G_BAR; G_MMA(1, 1, At, B1); G_BAR;
            G_LDB(B0, 1, 0); G_SCHED; G_LDA(At, 1, 0); G_STAGE_A(G_SA(0, 1), a2, 1, vg2);
            G_WAIT_L(8); G_BAR; G_WAIT_L(0); G_MMA(0, 0, At, B0); G_BAR; G_SCHED;
            G_LDB(B1, 1, 1); G_STAGE(G_SB(1, 0), b3, voffB);
            G_BAR; G_WAIT_L(0); G_MMA(0, 1, At, B1); G_BAR;
            G_LDA(At, 1, 1); G_STAGE_A(G_SA(1, 0), a3, 0, vg2);
            G_BAR; G_WAIT_L(0); G_MMA(1, 0, At, B0); G_BAR; G_SCHED;
            G_STAGE(G_SB(1, 1), b3 + hstep, voffB);
            G_WAIT_V(6); G_BAR; G_MMA(1, 1, At, B1); G_BAR;
            if (GATHER && t == 0 && has_next) {
                const LAS int* rows = (const LAS int*)(parbase + (ui & 1) * 4096 + NPAR * 1024);
#pragma unroll
                for (int h = 0; h < 2; ++h)
#pragma unroll
                    for (int i = 0; i < 2; ++i) vgn[h][i] = (unsigned)(rows[h * HALF + Rr[i]] * K + Cc[i]) * 2u;
            }
        }
        if (FP8) asm volatile("s_nop 15\n\ts_nop 15" ::: "memory");
        const bool keep_acc = E(acc, cur, wr, wc, fr, fq, (const LAS unsigned char*)(parbase + (ui & 1) * 4096));
        if (!has_next) break;
        if (!keep_acc)
#pragma unroll
        for (int a = 0; a < 2; ++a)
#pragma unroll
            for (int b = 0; b < 2; ++b)
#pragma unroll
                for (int m = 0; m < 4; ++m)
#pragma unroll
                    for (int n = 0; n < 2; ++n) acc[a][b][m][n] = (f32x4){0.f, 0.f, 0.f, 0.f};
        cur = nxt; cA = nA; cB = nB; ++ui;
        if (GATHER) {
#pragma unroll
            for (int h = 0; h < 2; ++h)
#pragma unroll
                for (int i = 0; i < 2; ++i) vgc[h][i] = vgn[h][i];
        }
    }
    G_WAIT_V(0);
    if (wr == 0) G_BAR;
    G_BAR;
#undef G_PAR_ISSUE
#undef G_SA
#undef G_SB
#undef G_STAGE
#undef G_STAGE_A
#undef G_LDA
#undef G_LDB
#undef G_MMA
#undef G_CAT8
#undef G_WAIT_V
#undef G_WAIT_L
#undef G_BAR
#undef G_SCHED
}

struct EpiProj {
    bf16_t* prkv; bf16_t* pconv; bf16_t* gates; const float* rstd1; int pn0; float osc;
    static constexpr int NPAR = 1;
    __device__ __forceinline__ const void* par_src(const Unit& u, int, int lane) const { return rstd1 + NMETA + u.pm * BM + lane * 4; }
    __device__ __forceinline__ bool operator()(const f32x4 (&acc)[2][2][4][2], const Unit& u, int wr, int wc, int fr, int fq, const LAS unsigned char* par) const {
        const int row0 = u.pm * BM + wr * 64 + fr;
        const int pn = u.pn + pn0;
        const bool isg = pn >= 14, isu = pn >= 8 && pn < 12;
        float rsv[2][4];
#pragma unroll
        for (int ai = 0; ai < 2; ++ai)
#pragma unroll
            for (int m = 0; m < 4; ++m) rsv[ai][m] = ((const LAS float*)par)[wr * 64 + fr + ai * HALF + m * 16] * osc;
#pragma unroll
        for (int ai = 0; ai < 2; ++ai)
#pragma unroll
            for (int m = 0; m < 4; ++m) {
                const int row = row0 + ai * HALF + m * 16;
                const float rs = isg ? rsv[ai][m] * -1.44269504089f : rsv[ai][m]; const f32x2 rs2 = {rs, rs}, one2 = {1.0f, 1.0f};
                bf16_t* rowp = isg ? gates + (size_t)row * 2048 + (pn - 14) * 256 + wc * 32 + 8 * fq
                             : (pn < 6 ? prkv + (size_t)(NMETA + row) * 1536 + pn * 256 : pconv + (size_t)(NMETA + row) * 2048 + (pn - 6) * 256) + wc * 32 + 8 * fq;
                if (isu) {
                    const f32x4 c0 = acc[ai][0][m][0], c1 = acc[ai][0][m][1], h0 = acc[ai][1][m][0], h1 = acc[ai][1][m][1];
                    const f32x2 rr2 = rs2 * rs2;
                    const f32x2 p0 = (LO2(c0) * LO2(h0)) * rr2, p1 = (HI2(c0) * HI2(h0)) * rr2, p2 = (LO2(c1) * LO2(h1)) * rr2, p3 = (HI2(c1) * HI2(h1)) * rr2;
                    u32x4 w; w.x = cvt_pk_bf16(p0[0], p0[1]); w.y = cvt_pk_bf16(p1[0], p1[1]); w.z = cvt_pk_bf16(p2[0], p2[1]); w.w = cvt_pk_bf16(p3[0], p3[1]);
                    *(u32x4*)(pconv + (size_t)(NMETA + row) * 2048 + 512 + (pn - 8) * 128 + wc * 32 + 8 * fq) = w;
                } else
#pragma unroll
                for (int bj = 0; bj < 2; ++bj) {
                    const f32x4 a0 = acc[ai][bj][m][0], a1 = acc[ai][bj][m][1];
                    f32x2 p[4] = {LO2(a0) * rs2, HI2(a0) * rs2, LO2(a1) * rs2, HI2(a1) * rs2};
                    if (isg) {
#pragma unroll
                        for (int q = 0; q < 4; ++q) { const f32x2 e = {__builtin_amdgcn_exp2f(p[q][0]), __builtin_amdgcn_exp2f(p[q][1])}; const f32x2 d = e + one2; p[q] = (f32x2){__builtin_amdgcn_rcpf(d[0]), __builtin_amdgcn_rcpf(d[1])}; }
                    }
                    u32x4 w; w.x = cvt_pk_bf16(p[0][0], p[0][1]); w.y = cvt_pk_bf16(p[1][0], p[1][1]); w.z = cvt_pk_bf16(p[2][0], p[2][1]); w.w = cvt_pk_bf16(p[3][0], p[3][1]);
                    *(u32x4*)(rowp + bj * HALF) = w;
                }
            }
        return false;
    }
};
struct EpiL {
    static constexpr int NPAR = 0;
    __device__ __forceinline__ const void* par_src(const Unit&, int, int) const { return nullptr; }
    unsigned char* wsb; const float* w0; const float* a0;
    __device__ __forceinline__ bool operator()(const f32x4 (&acc)[2][2][4][2], const Unit& u, int wr, int wc, int fr, int fq, const LAS unsigned char* par) const {
        const int row0 = NMETA + u.pm * BM + wr * 64 + fr;
        const int seg = u.pn >> 1;
        const int cb = (u.pn & 1) * 256 + wc * 32 + 8 * fq;
        const float* bias = seg == 0 ? w0 : a0;
        f32x4 bv[2][2];
#pragma unroll
        for (int bj = 0; bj < 2; ++bj) {
            bv[bj][0] = seg < 2 ? *(const f32x4*)(bias + cb + bj * HALF) : (f32x4){0.f, 0.f, 0.f, 0.f};
            bv[bj][1] = seg < 2 ? *(const f32x4*)(bias + cb + bj * HALF + 4) : (f32x4){0.f, 0.f, 0.f, 0.f};
        }
        const float sc = seg == 0 ? -0.60653065971f : 1.0f;
        bf16_t* ob = (bf16_t*)(wsb + (seg == 0 ? OFF_LD : seg == 1 ? OFF_A : OFF_G));
#pragma unroll
        for (int ai = 0; ai < 2; ++ai)
#pragma unroll
            for (int m = 0; m < 4; ++m) {
                const int row = row0 + ai * HALF + m * 16;
#pragma unroll
                for (int bj = 0; bj < 2; ++bj) {
                    const int c = cb + bj * HALF;
                    f32x4 v0 = acc[ai][bj][m][0] + bv[bj][0], v1 = acc[ai][bj][m][1] + bv[bj][1];
                    if (seg < 2) {
#pragma unroll
                        for (int j = 0; j < 4; ++j) { v0[j] = sc * sigmoidf_(v0[j]); v1[j] = sc * sigmoidf_(v1[j]); }
                    }
                    {
                        u32x4 w; w.x = cvt_pk_bf16(v0[0], v0[1]); w.y = cvt_pk_bf16(v0[2], v0[3]); w.z = cvt_pk_bf16(v1[0], v1[1]); w.w = cvt_pk_bf16(v1[2], v1[3]);
                        *(u32x4*)(ob + (size_t)row * 512 + c) = w;
                    }
                }
            }
        return false;
    }
};
template <int SECOND> struct EpiMerge {
    static constexpr int NPAR = 0;
    __device__ __forceinline__ const void* par_src(const Unit&, int, int) const { return nullptr; }
    bf16_t* merged; const bf16_t* gates;
    __device__ __forceinline__ bool operator()(const f32x4 (&acc)[2][2][4][2], const Unit& u, int wr, int wc, int fr, int fq, const LAS unsigned char* par) const {
        const int row0 = u.pm * BM + wr * 64 + fr, col0 = u.pn * BM + wc * 32 + 8 * fq;
#pragma unroll
        for (int ai = 0; ai < 2; ++ai)
#pragma unroll
            for (int m = 0; m < 4; ++m) {
                const int row = row0 + ai * HALF + m * 16;
#pragma unroll
                for (int bj = 0; bj < 2; ++bj) {
                    const int c = col0 + bj * HALF;
                    const u32x4 gw = *(const u32x4*)(gates + (size_t)row * 2048 + SECOND * 1024 + c);
                    f32x4 g0 = (f32x4){bflo(gw.x), bfhi(gw.x), bflo(gw.y), bfhi(gw.y)}, g1 = (f32x4){bflo(gw.z), bfhi(gw.z), bflo(gw.w), bfhi(gw.w)};
                    f32x4 v0 = acc[ai][bj][m][0] * g0, v1 = acc[ai][bj][m][1] * g1;
                    bf16_t* p = merged + (size_t)row * 1024 + c;
                    if (SECOND) {
                        const u32x4 ow = *(const u32x4*)p;
                        v0 += (f32x4){bflo(ow.x), bfhi(ow.x), bflo(ow.y), bfhi(ow.y)}; v1 += (f32x4){bflo(ow.z), bfhi(ow.z), bflo(ow.w), bfhi(ow.w)};
                    }
                    u32x4 w; w.x = cvt_pk_bf16(v0[0], v0[1]); w.y = cvt_pk_bf16(v0[2], v0[3]); w.z = cvt_pk_bf16(v1[0], v1[1]); w.w = cvt_pk_bf16(v1[2], v1[3]);
                    *(u32x4*)p = w;
                }
            }
        return false;
    }
};
struct MergeOrder {
    StaticOrder so; const char* A1; const char* B1;
    __device__ bool next(int i, Unit& u) const { const bool ok = so.next(i >> 1, u); u.aux = i & 1; return ok; }
    __device__ __forceinline__ const char* a_ptr(const Unit& u) const { return (u.aux ? A1 : so.A) + (size_t)u.pm * 256 * so.K * 2; }
    __device__ __forceinline__ const char* b_ptr(const Unit& u) const { return (u.aux ? B1 : so.Bt) + (size_t)u.pn * 256 * so.K * 2; }
    __device__ __forceinline__ int gather_row(const Unit&, int) const { return 0; }
    __device__ __forceinline__ const void* gather_src(const Unit&, int) const { return nullptr; }
};
struct EpiMergeFused {
    static constexpr int NPAR = 0;
    __device__ __forceinline__ const void* par_src(const Unit&, int, int) const { return nullptr; }
    bf16_t* merged; const bf16_t* gates;
    __device__ __forceinline__ bool operator()(f32x4 (&acc)[2][2][4][2], const Unit& u, int wr, int wc, int fr, int fq, const LAS unsigned char* par) const {
        const int row0 = u.pm * BM + wr * 64 + fr, col0 = u.pn * BM + wc * 32 + 8 * fq;
#pragma unroll
        for (int ai = 0; ai < 2; ++ai) {
            u32x4 gbw[4][2], gaw[4][2];
#pragma unroll
            for (int m = 0; m < 4; ++m)
#pragma unroll
                for (int bj = 0; bj < 2; ++bj) {
                    const bf16_t* gp = gates + (size_t)(row0 + ai * HALF + m * 16) * 2048 + col0 + bj * HALF;
                    gbw[m][bj] = *(const u32x4*)(gp + 1024);
                    gaw[m][bj] = u.aux == 0 ? *(const u32x4*)gp : (u32x4){0u, 0u, 0u, 0u};
                }
#pragma unroll
            for (int m = 0; m < 4; ++m)
#pragma unroll
                for (int bj = 0; bj < 2; ++bj) {
                    const int row = row0 + ai * HALF + m * 16, c = col0 + bj * HALF;
                    f32x2 gbp[4], res[4];
#pragma unroll
                    for (int q = 0; q < 4; ++q) { const unsigned wq = gbw[m][bj][q]; gbp[q] = (f32x2){fmaxf(bflo(wq), 1e-6f), fmaxf(bfhi(wq), 1e-6f)}; }
                    if (u.aux == 0) {
#pragma unroll
                        for (int q = 0; q < 4; ++q) {
                            const unsigned wq = gaw[m][bj][q];
                            const f32x2 gap = {bflo(wq), bfhi(wq)}, rc = {__builtin_amdgcn_rcpf(gbp[q][0]), __builtin_amdgcn_rcpf(gbp[q][1])};
                            const f32x2 sc = gap * rc;
                            f32x4& a4 = acc[ai][bj][m][q >> 1];
                            if (q & 1) { const f32x2 t = HI2(a4) * sc; a4[2] = t[0]; a4[3] = t[1]; } else { const f32x2 t = LO2(a4) * sc; a4[0] = t[0]; a4[1] = t[1]; }
                        }
                    } else {
#pragma unroll
                        for (int q = 0; q < 4; ++q) { const f32x4 a4 = acc[ai][bj][m][q >> 1]; res[q] = ((q & 1) ? HI2(a4) : LO2(a4)) * gbp[q]; }
                        u32x4 w; w.x = cvt_pk_bf16(res[0][0], res[0][1]); w.y = cvt_pk_bf16(res[1][0], res[1][1]); w.z = cvt_pk_bf16(res[2][0], res[2][1]); w.w = cvt_pk_bf16(res[3][0], res[3][1]);
                        *(u32x4*)(merged + (size_t)row * 1024 + c) = w;
                    }
                }
        }
        return u.aux == 0;
    }
};
struct EpiO {
    static constexpr int NPAR = 0;
    __device__ __forceinline__ const void* par_src(const Unit&, int, int) const { return nullptr; }
    const float* x; float* h1; bf16_t* hb2; unsigned char* hb8;
    __device__ __forceinline__ bool operator()(const f32x4 (&acc)[2][2][4][2], const Unit& u, int wr, int wc, int fr, int fq, const LAS unsigned char* par) const {
        const int row0 = u.pm * BM + wr * 64 + fr, col0 = u.pn * BM + wc * 32 + 8 * fq;
#pragma unroll
        for (int ai = 0; ai < 2; ++ai) {
            f32x4 xv[4][2][2];
#pragma unroll
            for (int m = 0; m < 4; ++m)
#pragma unroll
                for (int bj = 0; bj < 2; ++bj) {
                    const size_t o = (size_t)(row0 + ai * HALF + m * 16) * 1024 + col0 + bj * HALF;
                    xv[m][bj][0] = *(const f32x4*)(x + o); xv[m][bj][1] = *(const f32x4*)(x + o + 4);
                }
#pragma unroll
            for (int m = 0; m < 4; ++m)
#pragma unroll
                for (int bj = 0; bj < 2; ++bj) {
                    const size_t o = (size_t)(row0 + ai * HALF + m * 16) * 1024 + col0 + bj * HALF;
                    const f32x4 a0 = acc[ai][bj][m][0], a1 = acc[ai][bj][m][1];
                    const f32x2 p0 = LO2(a0) + LO2(xv[m][bj][0]), p1 = HI2(a0) + HI2(xv[m][bj][0]), p2 = LO2(a1) + LO2(xv[m][bj][1]), p3 = HI2(a1) + HI2(xv[m][bj][1]);
                    u32x4 w; w.x = cvt_pk_bf16(p0[0], p0[1]); w.y = cvt_pk_bf16(p1[0], p1[1]); w.z = cvt_pk_bf16(p2[0], p2[1]); w.w = cvt_pk_bf16(p3[0], p3[1]);
                    *(u32x4*)(hb2 + o) = w;
                    u32x2 w8; w8.x = pk4_fp8(p0[0], p0[1], p1[0], p1[1]); w8.y = pk4_fp8(p2[0], p2[1], p3[0], p3[1]);
                    *(u32x2*)(hb8 + o) = w8;
                }
        }
        return false;
    }
};
struct EpiMoe1 {
    unsigned char* act; const float* rowrs; const float* bg; const float* bu;
    static constexpr int NPAR = 2;
    __device__ __forceinline__ const void* par_src(const Unit& u, int piece, int lane) const {
        if (piece == 0) return rowrs + u.pm * BM + lane * 4;
        return (lane < 32 ? bg : bu) + (size_t)u.aux * DFF + u.pn * 128 + (lane & 31) * 4;
    }
    __device__ __forceinline__ bool operator()(const f32x4 (&acc)[2][2][4][2], const Unit& u, int wr, int wc, int fr, int fq, const LAS unsigned char* par) const {
        const int row0 = u.pm * BM + wr * 64 + fr, ff0 = u.pn * 128 + wc * 32 + 8 * fq;
        const LAS float* bgp = (const LAS float*)(par + 1024) + wc * 32 + 8 * fq; const LAS float* bup = bgp + 128;
        const f32x4 bg0 = *(const LAS f32x4*)bgp, bg1 = *(const LAS f32x4*)(bgp + 4), bu0 = *(const LAS f32x4*)bup, bu1 = *(const LAS f32x4*)(bup + 4);
        constexpr float KE = -1.702f * 1.44269504089f;
        const f32x2 ke2 = {KE, KE}, ike2 = {1.0f / KE, 1.0f / KE}, one2 = {1.0f, 1.0f};
        const f32x2 bgv[4] = {LO2(bg0) * ke2, HI2(bg0) * ke2, LO2(bg1) * ke2, HI2(bg1) * ke2}, buv[4] = {LO2(bu0), HI2(bu0), LO2(bu1), HI2(bu1)};
        float rsv[2][4];
#pragma unroll
        for (int ai = 0; ai < 2; ++ai)
#pragma unroll
            for (int m = 0; m < 4; ++m) rsv[ai][m] = ((const LAS float*)par)[wr * 64 + fr + ai * HALF + m * 16];
#pragma unroll
        for (int ai = 0; ai < 2; ++ai)
#pragma unroll
            for (int m = 0; m < 4; ++m) {
                const int row = row0 + ai * HALF + m * 16;
                const float rs = rsv[ai][m] * W8_INV;
                const f32x2 rs2 = {rs, rs}, rsk2 = {rs * KE, rs * KE};
                f32x2 res[4];
#pragma unroll
                for (int q = 0; q < 4; ++q) {
                    const f32x4 ag4 = acc[ai][0][m][q >> 1], au4 = acc[ai][1][m][q >> 1];
                    const f32x2 ag = (q & 1) ? HI2(ag4) : LO2(ag4), au = (q & 1) ? HI2(au4) : LO2(au4);
                    const f32x2 gk = ag * rsk2 + bgv[q], uu = au * rs2 + buv[q];
                    const f32x2 z = {fmaxf(gk[0], 7.0f * KE), fmaxf(gk[1], 7.0f * KE)};
                    const f32x2 up = {fminf(fmaxf(uu[0], -7.0f), 7.0f), fminf(fmaxf(uu[1], -7.0f), 7.0f)};
                    const f32x2 e = {__builtin_amdgcn_exp2f(z[0]), __builtin_amdgcn_exp2f(z[1])};
                    const f32x2 d = e + one2;
                    const f32x2 sg = {__builtin_amdgcn_rcpf(d[0]), __builtin_amdgcn_rcpf(d[1])};
                    res[q] = ((up * ike2 + ike2) * z) * sg;
                }
                u32x2 w; w.x = pk4_fp8(res[0][0], res[0][1], res[1][0], res[1][1]); w.y = pk4_fp8(res[2][0], res[2][1], res[3][0], res[3][1]);
                *(u32x2*)(act + (size_t)row * DFF + ff0) = w;
            }
        return false;
    }
};
struct EpiMoe2 {
    unsigned char* y8; const int* rowslot; const float* roww; const float* bd;
    static constexpr int NPAR = 3;
    __device__ __forceinline__ const void* par_src(const Unit& u, int piece, int lane) const {
        if (piece == 0) return rowslot + u.pm * BM + lane * 4;
        if (piece == 1) return roww + u.pm * BM + lane * 4;
        return bd + (size_t)u.aux * D + u.pn * BM + lane * 4;
    }
    __device__ __forceinline__ bool operator()(const f32x4 (&acc)[2][2][4][2], const Unit& u, int wr, int wc, int fr, int fq, const LAS unsigned char* par) const {
        const int row0 = u.pm * BM + wr * 64 + fr, col0 = u.pn * BM + wc * 32 + 8 * fq;
        const LAS float* bp = (const LAS float*)(par + 2048) + wc * 32 + 8 * fq;
        f32x4 bv[2][2];
#pragma unroll
        for (int bj = 0; bj < 2; ++bj) { bv[bj][0] = *(const LAS f32x4*)(bp + bj * HALF); bv[bj][1] = *(const LAS f32x4*)(bp + bj * HALF + 4); }
        int slotv[2][4]; float wv8[2][4];
#pragma unroll
        for (int ai = 0; ai < 2; ++ai)
#pragma unroll
            for (int m = 0; m < 4; ++m) { const int rl = wr * 64 + fr + ai * HALF + m * 16; slotv[ai][m] = ((const LAS int*)par)[rl]; wv8[ai][m] = ((const LAS float*)(par + 1024))[rl]; }
#pragma unroll
        for (int ai = 0; ai < 2; ++ai)
#pragma unroll
            for (int m = 0; m < 4; ++m) {
                const int slot = slotv[ai][m];
                if (slot >= 0) {
                    const float w8 = wv8[ai][m]; const f32x2 w2 = {w8, w8}, inv2 = {W8_INV, W8_INV};
#pragma unroll
                    for (int bj = 0; bj < 2; ++bj) {
                        const f32x4 a0 = acc[ai][bj][m][0], a1 = acc[ai][bj][m][1];
                        const f32x2 p0 = (LO2(a0) * inv2 + LO2(bv[bj][0])) * w2, p1 = (HI2(a0) * inv2 + HI2(bv[bj][0])) * w2, p2 = (LO2(a1) * inv2 + LO2(bv[bj][1])) * w2, p3 = (HI2(a1) * inv2 + HI2(bv[bj][1])) * w2;
                        u32x2 w; w.x = pk4_fp8(p0[0], p0[1], p1[0], p1[1]); w.y = pk4_fp8(p2[0], p2[1], p3[0], p3[1]);
                        *(u32x2*)(y8 + (size_t)slot * 1024 + col0 + bj * HALF) = w;
                    }
                }
            }
        return false;
    }
};

__device__ __forceinline__ void transpose_tile(LAS float* tile, const float* src, int ldsrc, int k0, int n0, bf16_t* dst, int ldd, int drow0, const float* sa, const float* mu, int mode, bool zero, unsigned char* dst8 = nullptr, int drow8 = 0) {
    const int tid = threadIdx.x;
    if (!zero) {
#pragma unroll
        for (int i = 0; i < 2; ++i) {
            const int r = (tid >> 4) + 32 * i, c4 = (tid & 15) * 4;
            const f32x4 v = *(const f32x4*)(src + (size_t)(k0 + r) * ldsrc + n0 + c4);
            LAS float* t = tile + r * 65 + c4;
            t[0] = v[0]; t[1] = v[1]; t[2] = v[2]; t[3] = v[3];
        }
    }
    __syncthreads();
    {
        const int n = tid >> 3, kq = tid & 7;
        float v[8];
#pragma unroll
        for (int j = 0; j < 8; ++j) {
            const int k = k0 + 8 * kq + j;
            float s = sa ? sa[k] : 1.0f;
            if (mode == 1) s *= (1.0f - mu[k]);
            if (mode == 2) s *= mu[k];
            v[j] = zero ? 0.f : tile[(8 * kq + j) * 65 + n] * s;
        }
        u32x4 w; w.x = cvt_pk_bf16(v[0], v[1]); w.y = cvt_pk_bf16(v[2], v[3]); w.z = cvt_pk_bf16(v[4], v[5]); w.w = cvt_pk_bf16(v[6], v[7]);
        *(u32x4*)(dst + (size_t)(drow0 + n) * ldd + k0 + 8 * kq) = w;
        if (dst8) { u32x2 w8; w8.x = pk4_fp8(v[0] * W8_SCALE, v[1] * W8_SCALE, v[2] * W8_SCALE, v[3] * W8_SCALE); w8.y = pk4_fp8(v[4] * W8_SCALE, v[5] * W8_SCALE, v[6] * W8_SCALE, v[7] * W8_SCALE); *(u32x2*)(dst8 + (size_t)(drow8 + n) * ldd + k0 + 8 * kq) = w8; }
    }
    __syncthreads();
}

__device__ __forceinline__ void phase_prep(const PPv& p, LAS unsigned char* lds) {
    const int tid = threadIdx.x, bid = blockIdx.x, nb = gridDim.x, lane = tid & 63, wave = tid >> 6;
    unsigned char* ws = p.gws();
    const float* x = p.gin(0); const float* meta = p.gin(1); const float* g1 = p.gin(2);
    if (bid == 0 && tid < 64) ((int*)(ws + OFF_GCNT))[tid] = 0;
    {
        bf16_t* HB = (bf16_t*)(ws + OFF_HB); float* rstd1 = (float*)(ws + OFF_RSTD1);
        for (int row0 = (bid * 8 + wave) * 4; row0 < NR; row0 += nb * 32) {
            f32x4 v[4][4];
#pragma unroll
            for (int u = 0; u < 4; ++u) {
                const int row = row0 + u < NR ? row0 + u : NR - 1;
                const float* src = row < NMETA ? meta + (size_t)row * D : x + (size_t)(row - NMETA) * D;
#pragma unroll
                for (int i = 0; i < 4; ++i) v[u][i] = __builtin_nontemporal_load((const f32x4*)(src + i * 256 + lane * 4));
            }
#pragma unroll
            for (int u = 0; u < 4; ++u) {
                const int row = row0 + u;
                if (row < NR) {
                    float ss = 0.f;
#pragma unroll
                    for (int i = 0; i < 4; ++i) ss += v[u][i][0] * v[u][i][0] + v[u][i][1] * v[u][i][1] + v[u][i][2] * v[u][i][2] + v[u][i][3] * v[u][i][3];
                    ss = wave_sum_dpp(ss);
                    if (lane == 0) rstd1[row] = rsqrtf(ss * (1.0f / D) + NORM_EPS);
                    if (row >= NMETA) {
                        bf16_t* d = HB + (size_t)(row - NMETA) * D;
#pragma unroll
                        for (int i = 0; i < 4; ++i) { u32x2 w; w.x = cvt_pk_bf16(v[u][i][0], v[u][i][1]); w.y = cvt_pk_bf16(v[u][i][2], v[u][i][3]); *(u32x2*)(d + i * 256 + lane * 4) = w;
                            *(unsigned*)(ws + OFF_X8 + (size_t)(row - NMETA) * D + i * 256 + lane * 4) = pk4_fp8(v[u][i][0], v[u][i][1], v[u][i][2], v[u][i][3]); }
                    }
                }
            }
        }
    }
    LAS float* tile = (LAS float*)lds;
    {
        bf16_t* WIN = (bf16_t*)(ws + OFF_WIN);
        const float* w_in = p.gin(3);
        for (int j = bid; j < 16 * 88; j += nb) {
            const int kt = j & 15, ntile = j >> 4, n0 = ntile * 64;
            const float* src; int ld, sn0, mode = 0; const float* mu = nullptr;
            if (n0 < 3072) { src = w_in; ld = 5120; sn0 = n0;
                if (n0 >= 2048) { const int qq = (n0 - 2048) >> 8, j0 = (n0 - 2048) & 255; sn0 = j0 < 128 ? 2048 + qq * 128 + j0 : 2560 + qq * 128 + (j0 - 128); } }
            else if (n0 < 3584) {
                const int seg = (n0 - 3072) >> 6;
                if (seg < 2) { src = p.gin(11); ld = 64; sn0 = 0; mu = p.gin(7); mode = 1 + seg; }
                else if (seg < 4) { src = p.gin(14); ld = 64; sn0 = 0; mu = p.gin(8); mode = 1 + (seg - 2); }
                else { src = p.gin(16); ld = 128; sn0 = (seg & 1) * 64; mu = p.gin(9); mode = seg < 6 ? 1 : 2; }
            } else { src = w_in; ld = 5120; sn0 = n0 - 512; }
            transpose_tile(tile, src, ld, kt * 64, sn0, WIN, 1024, n0, g1, mu, mode, false, n0 >= 3584 ? ws + OFF_WIN8 : nullptr, n0 - 3584);
        }
        for (int j = bid; j < 2 * 128; j += nb) {
            const int which = j >> 7, jj = j & 127, kt = jj & 7, ntile = jj >> 3;
            transpose_tile(tile, which ? p.gin(25) : p.gin(23), 1024, kt * 64, ntile * 64, (bf16_t*)(ws + (which ? OFF_WC : OFF_WR)), 512, ntile * 64, nullptr, nullptr, 0, false);
        }
        for (int j = bid; j < 256; j += nb) {
            const int kt = j & 15, ntile = j >> 4;
            transpose_tile(tile, p.gin(26), 1024, kt * 64, ntile * 64, (bf16_t*)(ws + OFF_WO), 1024, ntile * 64, nullptr, nullptr, 0, false);
        }
        for (int j = bid; j < 96; j += nb) {
            const int kt = j & 3, ntile = j >> 2, seg = ntile >> 3, nn0 = (ntile & 7) * 64;
            const float* src = nullptr; int sk0 = 0; bool zero = true;
            if (seg == 0 && kt == 0) { src = p.gin(12); sk0 = 0; zero = false; }
            if (seg == 1 && kt == 1) { src = p.gin(15); sk0 = 0; zero = false; }
            if (seg == 2 && kt >= 2) { src = p.gin(17); sk0 = (kt - 2) * 64; zero = false; }
            const float* srcs = zero ? p.gin(12) : src + (size_t)(sk0 - kt * 64) * 512;
            transpose_tile(tile, srcs, 512, kt * 64, nn0, (bf16_t*)(ws + OFF_W2), 256, ntile * 64, nullptr, nullptr, 0, zero);
        }
        {
            float* WRG = (float*)(ws + OFF_WRG); const float* g2 = p.gin(27); const float* wr_ = p.gin(28);
            for (int i = bid * 512 + tid; i < 1024 * 32; i += nb * 512) WRG[i] = g2[i >> 5] * wr_[i];
        }
    }
}

__device__ __forceinline__ void phase_meta_proj(const PPv& p, LAS unsigned char* lds) {
    const int tid = threadIdx.x, bid = blockIdx.x, lane = tid & 63, wave = tid >> 6;
    unsigned char* ws = p.gws();
    LAS float* sm = (LAS float*)lds;
    const float* meta = p.gin(1);
    for (int i = tid; i < 16 * 256; i += 512) { const int r = i >> 8, c4 = (i & 255) * 4; const f32x4 v = *(const f32x4*)(meta + r * 1024 + c4); LAS float* d = sm + r * 1028 + c4; d[0] = v[0]; d[1] = v[1]; d[2] = v[2]; d[3] = v[3]; }
    __syncthreads();
    const float* rstd1 = (const float*)(ws + OFF_RSTD1);
    for (int nbase = bid * 14; nbase < PCOLS1; nbase += gridDim.x * 14) {
        for (int nn = wave; nn < 14; nn += 8) {
            const int n = nbase + nn;
            if (n >= PCOLS1) break;
            const bool inu = n >= 2048 && n < 3072;
            if (inu && ((n - 2048) & 128)) continue;
            float outp = 1.0f;
#pragma unroll 1
            for (int rep = 0; rep < (inu ? 2 : 1); ++rep) {
            const bf16_t* wrow = (const bf16_t*)(ws + OFF_WIN) + (size_t)(n + rep * 128) * 1024;
            const u32x4 w0 = *(const u32x4*)(wrow + 8 * lane), w1 = *(const u32x4*)(wrow + 512 + 8 * lane);
            const float wf[16] = {bflo(w0.x), bfhi(w0.x), bflo(w0.y), bfhi(w0.y), bflo(w0.z), bfhi(w0.z), bflo(w0.w), bfhi(w0.w),
                                  bflo(w1.x), bfhi(w1.x), bflo(w1.y), bfhi(w1.y), bflo(w1.z), bfhi(w1.z), bflo(w1.w), bfhi(w1.w)};
            float outv = 0.f;
#pragma unroll
            for (int pr = 0; pr < 16; ++pr) {
                const LAS float* m0 = sm + pr * 1028 + 8 * lane;
                const f32x4 a0 = *(const LAS f32x4*)m0, a1 = *(const LAS f32x4*)(m0 + 4), a2 = *(const LAS f32x4*)(m0 + 512), a3 = *(const LAS f32x4*)(m0 + 516);
                float acc = a0[0] * wf[0] + a0[1] * wf[1] + a0[2] * wf[2] + a0[3] * wf[3] + a1[0] * wf[4] + a1[1] * wf[5] + a1[2] * wf[6] + a1[3] * wf[7]
                          + a2[0] * wf[8] + a2[1] * wf[9] + a2[2] * wf[10] + a2[3] * wf[11] + a3[0] * wf[12] + a3[1] * wf[13] + a3[2] * wf[14] + a3[3] * wf[15];
                acc = wave_sum_dpp(acc);
                outv = (lane == pr) ? acc * rstd1[pr] : outv;
            }
            outp *= outv;
            }
            if (lane < 16) {
                if (n < 1536) ((bf16_t*)(ws + OFF_PRKV))[(size_t)lane * 1536 + n] = f2bf(outp);
                else if (inu) ((bf16_t*)(ws + OFF_PCONV))[(size_t)lane * 2048 + 512 + ((n - 2048) >> 8) * 128 + ((n - 2048) & 127)] = f2bf(outp);
                else ((bf16_t*)(ws + OFF_PCONV))[(size_t)lane * 2048 + n - 1536] = f2bf(outp);
            }
        }
    }
    __syncthreads();
}

__device__ __forceinline__ void phase_meta_lora(const PPv& p) {
    const int tid = threadIdx.x, bid = blockIdx.x, nb = gridDim.x, lane = tid & 63, wave = tid >> 6;
    unsigned char* ws = p.gws();
    const bf16_t* L = (const bf16_t*)(ws + OFF_L); const bf16_t* W2 = (const bf16_t*)(ws + OFF_W2);
    for (int n = bid * 8 + wave; n < 1536; n += nb * 8) {
        const int seg = n >> 9, c = n & 511;
        const u32x2 wv = *(const u32x2*)(W2 + (size_t)n * 256 + 4 * lane);
        const float w0v = bflo(wv.x), w1v = bfhi(wv.x), w2v = bflo(wv.y), w3v = bfhi(wv.y);
        float outv = 0.f;
#pragma unroll
        for (int r = 0; r < 16; ++r) {
            const u32x2 lv = *(const u32x2*)(L + (size_t)r * 256 + 4 * lane);
            float acc = bflo(lv.x) * w0v + bfhi(lv.x) * w1v + bflo(lv.y) * w2v + bfhi(lv.y) * w3v;
            acc = wave_sum_dpp(acc);
            outv = (lane == r) ? acc : outv;
        }
        if (lane < 16) {
            float v = outv;
            if (seg == 0) v = -0.60653065971f * sigmoidf_(v + p.gin(10)[c]);
            if (seg == 1) v = sigmoidf_(v + p.gin(13)[c]);
            bf16_t* ob = (bf16_t*)(ws + (seg == 0 ? OFF_LD : seg == 1 ? OFF_A : OFF_G));
            ob[(size_t)lane * 512 + c] = f2bf(v);
        }
    }
}

__device__ __forceinline__ void phase_lprep_conv(const PPv& p) {
    const int tid = threadIdx.x, bid = blockIdx.x, nb = gridDim.x;
    unsigned char* ws = p.gws();
    const bf16_t* PROJ = (const bf16_t*)(ws + OFF_PCONV);
    constexpr int PCOLS = 2048;
    bf16_t* L = (bf16_t*)(ws + OFF_L);
    for (int i = bid * 512 + tid; i < NRP * 32; i += nb * 512) {
        const int row = i >> 5, gq = i & 31;
        u32x4 w = (u32x4){0u, 0u, 0u, 0u};
        if (row < NR) {
            int ca, cb;
            if (gq < 8) { ca = 1536 + gq * 8; cb = ca + 64; }
            else if (gq < 16) { ca = 1536 + 128 + (gq - 8) * 8; cb = ca + 64; }
            else { ca = 1536 + 256 + (gq - 16) * 8; cb = ca + 128; }
            const u32x4 va = *(const u32x4*)(PROJ + (size_t)row * PCOLS + ca);
            const int pr = prev_row(row, 1);
            u32x4 vb = (u32x4){0u, 0u, 0u, 0u};
            if (pr >= 0) vb = *(const u32x4*)(PROJ + (size_t)pr * PCOLS + cb);
            float v[8] = {bflo(va.x) + bflo(vb.x), bfhi(va.x) + bfhi(vb.x), bflo(va.y) + bflo(vb.y), bfhi(va.y) + bfhi(vb.y), bflo(va.z) + bflo(vb.z), bfhi(va.z) + bfhi(vb.z), bflo(va.w) + bflo(vb.w), bfhi(va.w) + bfhi(vb.w)};
#pragma unroll
            for (int j = 0; j < 8; ++j) { if (gq < 8) v[j] = tanhf(v[j]); else if (gq >= 16) v[j] = sigmoidf_(v[j]); }
            w.x = cvt_pk_bf16(v[0], v[1]); w.y = cvt_pk_bf16(v[2], v[3]); w.z = cvt_pk_bf16(v[4], v[5]); w.w = cvt_pk_bf16(v[6], v[7]);
        }
        *(u32x4*)(L + (size_t)row * 256 + gq * 8) = w;
    }
    bf16_t* C = (bf16_t*)(ws + OFF_C);
    const float* cw = p.gin(24);
    for (int i = bid * 512 + tid; i < T * 64; i += nb * 512) {
        const int m = i >> 6, ch = (i & 63) * 8, row = NMETA + m;
        const int r1 = prev_row(row, 1), r2 = prev_row(row, 2);
        const bf16_t* p0 = PROJ + (size_t)row * PCOLS; const bf16_t* p1 = PROJ + (size_t)r1 * PCOLS; const bf16_t* p2 = PROJ + (size_t)r2 * PCOLS;
        const u32x4 vb = *(const u32x4*)(p0 + ch);
        const u32x4 c0 = *(const u32x4*)(p0 + 512 + ch), c1 = *(const u32x4*)(p1 + 512 + ch), c2 = *(const u32x4*)(p2 + 512 + ch);
        float o[8];
#pragma unroll
        for (int j = 0; j < 8; ++j) {
            const unsigned wb = j < 2 ? vb.x : j < 4 ? vb.y : j < 6 ? vb.z : vb.w;
            const unsigned wc0 = j < 2 ? c0.x : j < 4 ? c0.y : j < 6 ? c0.z : c0.w;
            const unsigned wc1 = j < 2 ? c1.x : j < 4 ? c1.y : j < 6 ? c1.z : c1.w;
            const unsigned wc2 = j < 2 ? c2.x : j < 4 ? c2.y : j < 6 ? c2.z : c2.w;
            const bool hi = j & 1;
            const float b = hi ? bfhi(wb) : bflo(wb);
            const float u0 = hi ? bfhi(wc0) : bflo(wc0), u1 = hi ? bfhi(wc1) : bflo(wc1), u2 = hi ? bfhi(wc2) : bflo(wc2);
            const float conv = cw[ch + j] * u2 + cw[512 + ch + j] * u1 + cw[1024 + ch + j] * u0;
            o[j] = b * conv;
        }
        u32x4 w; w.x = cvt_pk_bf16(o[0], o[1]); w.y = cvt_pk_bf16(o[2], o[3]); w.z = cvt_pk_bf16(o[4], o[5]); w.w = cvt_pk_bf16(o[6], o[7]);
        *(u32x4*)(C + (size_t)m * 512 + ch) = w;
    }
}

template <int CTRL> __device__ __forceinline__ float dppmov(float v) { return __builtin_bit_cast(float, __builtin_amdgcn_update_dpp(0, __builtin_bit_cast(int, v), CTRL, 0xF, 0xF, true)); }
__device__ __forceinline__ float wave_sum_dpp(float v) {
    v += dppmov<0xB1>(v);
    v += dppmov<0x4E>(v);
    v += dppmov<0x141>(v);
    v += dppmov<0x140>(v);
    { float c = v; asm volatile("v_nop\n\tv_nop\n\tv_permlane16_swap_b32 %0, %1\n\tv_nop" : "+v"(v), "+v"(c)); v += c; }
    { float c = v; asm volatile("v_nop\n\tv_nop\n\tv_permlane32_swap_b32 %0, %1\n\tv_nop" : "+v"(v), "+v"(c)); v += c; }
    return v;
}
typedef float f32x16 __attribute__((ext_vector_type(16)));

struct RawTok { bf16_t r, k, v, a, ld; };
__device__ __forceinline__ RawTok load_raw(const bf16_t* PRKV, const bf16_t* Ab, const bf16_t* LD, int row, int col) {
    RawTok q; const bf16_t* p0 = PRKV + (size_t)row * 1536 + col;
    q.r = p0[0]; q.k = p0[512]; q.v = p0[1024]; q.a = Ab[(size_t)row * 512 + col]; q.ld = LD[(size_t)row * 512 + col];
    return q;
}
__device__ __forceinline__ void unit_geom(int uid, int lane, int& b, int& h, int& c, int& col, int& row0) {
    const int bh = uid / NCHUNK; c = uid - bh * NCHUNK; b = bh >> 3; h = bh & 7; col = h * 64 + lane;
    row0 = c == 0 ? 0 : b * SEQ + c * 16;
}
__device__ __forceinline__ void phase_scanprep(const PPv& p, LAS unsigned char* lds) {
    const int tid = threadIdx.x, bid = blockIdx.x, nb = gridDim.x, lane = tid & 63, wave = tid >> 6;
    unsigned char* ws = p.gws();
    const bf16_t* PRKV = (const bf16_t*)(ws + OFF_PRKV);
    const bf16_t* LD = (const bf16_t*)(ws + OFF_LD);
    const bf16_t* Ab = (const bf16_t*)(ws + OFF_A);
    float* COEF = (float*)(ws + OFF_COEF);
    LAS unsigned char* wl = lds + wave * 13824;
    LAS bf16_t* AR = (LAS bf16_t*)wl;
    LAS bf16_t* BK = (LAS bf16_t*)(wl + 4608);
    LAS float* DM = (LAS float*)(wl + 9216);
    const int qperm = (lane & 32) | (((lane >> 2) & 3) << 3) | (((lane >> 4) & 1) << 2) | (lane & 3);
    int uid = bid * 8 + wave;
    if (uid >= NUNITS) return;
    int b, h, c, col, row0;
    unit_geom(uid, lane, b, h, c, col, row0);
    RawTok q[16], qn[16];
    bf16_t prr = 0, prk = 0, prv = 0, nprr = 0, nprk = 0, nprv = 0;
#pragma unroll
    for (int t = 0; t < 16; ++t) q[t] = load_raw(PRKV, Ab, LD, row0 + t, col);
    { const int pr = prev_row(row0, 1); if (pr >= 0) { const bf16_t* p1 = PRKV + (size_t)pr * 1536 + col; prr = p1[0]; prk = p1[512]; prv = p1[1024]; } }
    for (;;) {
        const float mur = p.gin(4)[col], muk = p.gin(5)[col], muv = p.gin(6)[col], kkw = p.gin(18)[col], kaw = p.gin(19)[col], rkw = p.gin(20)[col];
        const int nuid = uid + nb * 8; const bool has_next = nuid < NUNITS;
        int nb_ = b, nh = h, nc = c, ncol = col, nrow0 = row0;
        if (has_next) {
            unit_geom(nuid, lane, nb_, nh, nc, ncol, nrow0);
#pragma unroll
            for (int t = 0; t < 16; ++t) qn[t] = load_raw(PRKV, Ab, LD, nrow0 + t, ncol);
            nprr = 0; nprk = 0; nprv = 0;
            const int pr = prev_row(nrow0, 1); if (pr >= 0) { const bf16_t* p1 = PRKV + (size_t)pr * 1536 + ncol; nprr = p1[0]; nprk = p1[512]; nprv = p1[1024]; }
        }
        __builtin_amdgcn_sched_barrier(0);
        LAS float* PM = (LAS float*)wl;
        LAS float* RS = DM;
        {
            float rp = bf2f(prr), kp = bf2f(prk);
#pragma unroll
            for (int t = 0; t < 16; ++t) {
                const RawTok qq = q[t];
                const float r0 = bf2f(qq.r), k0 = bf2f(qq.k);
                const float r = r0 + (rp - r0) * mur, k = k0 + (kp - k0) * muk;
                rp = r0; kp = k0;
                const float a = bf2f(qq.a);
                const float kkv = k * kkw, k2 = k * (1.0f + (a - 1.0f) * kaw);
                PM[t * 68 + lane] = kkv * kkv; PM[(16 + t) * 68 + lane] = r * k2 * rkw;
            }
            asm volatile("" ::: "memory");
            const int rw = lane & 31, hf = lane >> 5;
            f32x4 s4 = (f32x4){0.f, 0.f, 0.f, 0.f};
#pragma unroll
            for (int i = 0; i < 8; ++i) s4 += *(const LAS f32x4*)(PM + rw * 68 + hf * 32 + i * 4);
            float sm = (s4[0] + s4[1]) + (s4[2] + s4[3]);
            { float c2 = sm; asm volatile("v_nop\n\tv_nop\n\tv_permlane32_swap_b32 %0, %1\n\tv_nop" : "+v"(sm), "+v"(c2)); sm += c2; }
            if (lane < 32) RS[lane] = sm;
            asm volatile("" ::: "memory");
            const float cfl = __shfl(sm, (lane & 15) + 16);
            if (lane < 16) COEF[(size_t)(row0 + lane) * 8 + h] = cfl;
        }
        __builtin_amdgcn_sched_barrier(0);
        float at[16], vt[16]; unsigned btp[8], ktp[8]; float bprev = 0.f, kprev = 0.f;
        float cl = 0.f;
        float rp = bf2f(prr), kp = bf2f(prk), vp = bf2f(prv);
        f32x4 n2v[4];
#pragma unroll
        for (int i = 0; i < 4; ++i) n2v[i] = *(const LAS f32x4*)(RS + 4 * i);
        asm volatile("" ::: "memory"); __builtin_amdgcn_sched_barrier(0);
#pragma unroll
        for (int t = 0; t < 16; ++t) {
            const RawTok qq = q[t];
            const float r0 = bf2f(qq.r), k0 = bf2f(qq.k), v0 = bf2f(qq.v);
            const float r = r0 + (rp - r0) * mur, k = k0 + (kp - k0) * muk, v = v0 + (vp - v0) * muv;
            rp = r0; kp = k0; vp = v0;
            const float a = bf2f(qq.a);
            const float kkv = k * kkw;
            const float kk = kkv * __builtin_amdgcn_rsqf(fmaxf(n2v[t >> 2][t & 3], 1e-24f));
            const float k2 = k * (1.0f + (a - 1.0f) * kaw);
            const float wcp = __expf(cl);
            cl += bf2f(qq.ld);
            const float wcn = __expf(cl), iw = __expf(-cl);
            const float btv = kk * a * iw, ktv = k2 * iw;
            at[t] = -kk * wcp; vt[t] = v;
            { const unsigned w = cvt_pk_bf16(at[t], r * wcn); AR[t * 72 + qperm] = (bf16_t)(w & 0xFFFFu); AR[(16 + t) * 72 + qperm] = (bf16_t)(w >> 16); }
            if (t & 1) {
                btp[t >> 1] = cvt_pk_bf16(bprev, btv); ktp[t >> 1] = cvt_pk_bf16(kprev, ktv);
                BK[(t - 1) * 72 + qperm] = (bf16_t)(btp[t >> 1] & 0xFFFFu); BK[t * 72 + qperm] = (bf16_t)(btp[t >> 1] >> 16);
                BK[(16 + t - 1) * 72 + qperm] = (bf16_t)(ktp[t >> 1] & 0xFFFFu); BK[(16 + t) * 72 + qperm] = (bf16_t)(ktp[t >> 1] >> 16);
            } else { bprev = btv; kprev = ktv; }
            if ((t & 3) == 3) __builtin_amdgcn_sched_barrier(0);
        }
        const float wcc = __expf(cl);
        {
            f32x16 dm;
#pragma unroll
            for (int i = 0; i < 16; ++i) dm[i] = 0.f;
            const int rr = lane & 31, hh = lane >> 5;
#pragma unroll
            for (int ks = 0; ks < 4; ++ks) {
                const bf16x8 fa = *(const LAS bf16x8*)(AR + rr * 72 + 16 * ks + 8 * hh);
                const bf16x8 fb = *(const LAS bf16x8*)(BK + rr * 72 + 16 * ks + 8 * hh);
                dm = __builtin_amdgcn_mfma_f32_32x32x16_bf16(fa, fb, dm, 0, 0, 0);
            }
#pragma unroll
            for (int reg = 0; reg < 16; ++reg) DM[((reg & 3) + 8 * (reg >> 2) + 4 * hh) * 36 + rr] = dm[reg];
        }
        __builtin_amdgcn_sched_barrier(0);
        float uh[16];
#pragma unroll
        for (int t = 0; t < 16; ++t) {
            float wv = at[t], uv = 0.f, wv2 = 0.f, uv2 = 0.f, uv3 = 0.f;
#pragma unroll
            for (int s4 = 0; s4 < 4; ++s4) {
                if (s4 * 4 < t) {
                    const f32x4 ab = *(const LAS f32x4*)(DM + t * 36 + s4 * 4), ak = *(const LAS f32x4*)(DM + t * 36 + 16 + s4 * 4);
#pragma unroll
                    for (int j = 0; j < 4; ++j) {
                        const int s_ = s4 * 4 + j;
                        if (s_ < t) {
                            if (j & 1) { wv2 += ab[j] * at[s_]; uv2 += ak[j] * vt[s_]; } else { wv += ab[j] * at[s_]; uv += ak[j] * vt[s_]; }
                            uv3 += ab[j] * uh[s_];
                        }
                    }
                }
            }
            wv += wv2; uv += uv2 + uv3;
            at[t] = wv; uh[t] = uv;
            asm volatile("" : "+v"(at[t]), "+v"(uh[t]));
        }
        __builtin_amdgcn_sched_barrier(0);
#pragma unroll
        for (int t = 0; t < 16; t += 2) { const unsigned w = cvt_pk_bf16(at[t], at[t + 1]); AR[t * 72 + qperm] = (bf16_t)(w & 0xFFFFu); AR[(t + 1) * 72 + qperm] = (bf16_t)(w >> 16); }
        unsigned char* rec = ws + OFF_CH + (size_t)uid * REC_BYTES;
#pragma unroll
        for (int i = 0; i < 2; ++i) {
            const int pc = i * 64 + lane, row = pc >> 3, part = pc & 7;
            *(u32x4*)(rec + RO_WH + pc * 16) = *(const LAS u32x4*)((LAS unsigned char*)AR + row * 144 + part * 16);
            *(u32x4*)(rec + RO_RT + pc * 16) = *(const LAS u32x4*)((LAS unsigned char*)AR + (16 + row) * 144 + part * 16);
        }
        {
            u32x4 w0, w1;
            w0.x = cvt_pk_bf16(uh[0], uh[1]); w0.y = cvt_pk_bf16(uh[2], uh[3]); w0.z = cvt_pk_bf16(uh[4], uh[5]); w0.w = cvt_pk_bf16(uh[6], uh[7]);
            w1.x = cvt_pk_bf16(uh[8], uh[9]); w1.y = cvt_pk_bf16(uh[10], uh[11]); w1.z = cvt_pk_bf16(uh[12], uh[13]); w1.w = cvt_pk_bf16(uh[14], uh[15]);
            *(u32x4*)(rec + RO_U0T + lane * 32) = w0; *(u32x4*)(rec + RO_U0T + lane * 32 + 16) = w1;
            w0.x = cvt_pk_bf16(vt[0], vt[1]); w0.y = cvt_pk_bf16(vt[2], vt[3]); w0.z = cvt_pk_bf16(vt[4], vt[5]); w0.w = cvt_pk_bf16(vt[6], vt[7]);
            w1.x = cvt_pk_bf16(vt[8], vt[9]); w1.y = cvt_pk_bf16(vt[10], vt[11]); w1.z = cvt_pk_bf16(vt[12], vt[13]); w1.w = cvt_pk_bf16(vt[14], vt[15]);
            *(u32x4*)(rec + RO_VT + lane * 32) = w0; *(u32x4*)(rec + RO_VT + lane * 32 + 16) = w1;
        }
#pragma unroll
        for (int g = 0; g < 4; ++g) {
            u32x4 w; w.x = btp[2 * g]; w.y = btp[2 * g + 1]; w.z = ktp[2 * g]; w.w = ktp[2 * g + 1];
            *(u32x4*)(rec + RO_BKT + lane * 64 + g * 16) = w;
        }
        {
            const int t = lane >> 2, g = lane & 3;
            const f32x4 rb = *(const LAS f32x4*)(DM + (16 + t) * 36 + 4 * g), rk = *(const LAS f32x4*)(DM + (16 + t) * 36 + 16 + 4 * g);
            float o[8];
#pragma unroll
            for (int j = 0; j < 4; ++j) { const bool keep = (4 * g + j) <= t; o[j] = keep ? rb[j] : 0.f; o[4 + j] = keep ? rk[j] : 0.f; }
            u32x4 w; w.x = cvt_pk_bf16(o[0], o[1]); w.y = cvt_pk_bf16(o[2], o[3]); w.z = cvt_pk_bf16(o[4], o[5]); w.w = cvt_pk_bf16(o[6], o[7]);
            *(u32x4*)(rec + RO_ARK + t * 64 + g * 16) = w;
        }
        *(float*)(rec + RO_WCC + lane * 4) = wcc;
        if (!has_next) break;
        uid = nuid; b = nb_; h = nh; c = nc; col = ncol; row0 = nrow0;
#pragma unroll
        for (int t = 0; t < 16; ++t) q[t] = qn[t];
        prr = nprr; prk = nprk; prv = nprv;
        __builtin_amdgcn_sched_barrier(0);
    }
}

__device__ __forceinline__ void convert_expert_weights(const PPv& p, LAS unsigned char* lds, int first, int stride);
struct RecOps { bf16x8 wA0, wA1, rA0, rA1, ark, bk[4]; u32x2 u0, vv; f32x4 wc[4]; };
__device__ __forceinline__ void load_ops(RecOps& o, LAS unsigned char* S, int vs, int fr, int g) {
    o.wA0 = *(const LAS bf16x8*)(S + RO_WH + fr * 128 + g * 16); o.wA1 = *(const LAS bf16x8*)(S + RO_WH + fr * 128 + 64 + g * 16);
    o.rA0 = *(const LAS bf16x8*)(S + RO_RT + fr * 128 + g * 16); o.rA1 = *(const LAS bf16x8*)(S + RO_RT + fr * 128 + 64 + g * 16);
    o.u0 = *(const LAS u32x2*)(S + RO_U0T + (16 * vs + fr) * 32 + g * 8);
    o.vv = *(const LAS u32x2*)(S + RO_VT + (16 * vs + fr) * 32 + g * 8);
    o.ark = *(const LAS bf16x8*)(S + RO_ARK + fr * 64 + g * 16);
#pragma unroll
    for (int m = 0; m < 4; ++m) { o.bk[m] = *(const LAS bf16x8*)(S + RO_BKT + (16 * m + fr) * 64 + g * 16); o.wc[m] = *(const LAS f32x4*)(S + RO_WCC + (16 * m + 4 * g) * 4); }
}
__device__ __forceinline__ void phase_recur(const PPv& p, LAS unsigned char* lds) {
    const int tid = threadIdx.x, bid = blockIdx.x, nb = gridDim.x, lane = tid & 63, wave = __builtin_amdgcn_readfirstlane(tid >> 6);
    unsigned char* ws = p.gws();
    if (bid >= 64) { convert_expert_weights(p, lds, bid - 64, nb - 64); return; }
    unsigned char* CHb = ws + OFF_CH + (size_t)(bid * NCHUNK) * REC_BYTES;
    constexpr int RSLOT = REC_BYTES, RN = 11, PF = 8;
#define R_BAR() do { asm volatile("s_waitcnt lgkmcnt(0)" ::: "memory"); __builtin_amdgcn_s_barrier(); asm volatile("" ::: "memory"); } while (0)
    if (wave >= 4) {
        const int lw = wave - 4;
#define R_ISSUE(x) do { \
            LAS unsigned char* _s = lds + ((x) % RN) * RSLOT; const unsigned char* _r = CHb + (size_t)(x) * REC_BYTES + lane * 16; \
            _Pragma("unroll") for (int _i = 0; _i < 3; ++_i) { const int _pc = lw + 4 * _i; __builtin_amdgcn_global_load_lds((const unsigned*)(_r + _pc * 1024), (LAS unsigned*)(_s + _pc * 1024), 16, 0, 0); } \
            if (lw == 0) __builtin_amdgcn_global_load_lds((const unsigned*)(_r + 12 * 1024), (LAS unsigned*)(_s + 12 * 1024), 16, 0, 0); \
            if (lw == 1) { if (lane < 16) __builtin_amdgcn_global_load_lds((const unsigned*)(_r + 13 * 1024), (LAS unsigned*)(_s + 13 * 1024), 16, 0, 0); } } while (0)
        for (int x = 0; x < PF; ++x) R_ISSUE(x);
        asm volatile("s_waitcnt vmcnt(0)" ::: "memory");
        R_BAR();
        for (int c = 0; c < NCHUNK; ++c) {
            const int x = c + PF;
            if (x < NCHUNK) R_ISSUE(x);
            if (x < NCHUNK) { if (lw < 2) asm volatile("s_waitcnt vmcnt(24)" ::: "memory"); else asm volatile("s_waitcnt vmcnt(18)" ::: "memory"); }
            else asm volatile("s_waitcnt vmcnt(0)" ::: "memory");
            R_BAR();
        }
#undef R_ISSUE
    } else {
        const int vs = wave, fr = lane & 15, g = lane >> 4;
        f32x4 H[4];
#pragma unroll
        for (int m = 0; m < 4; ++m) H[m] = (f32x4){0.f, 0.f, 0.f, 0.f};
        R_BAR();
        RecOps cur, nxt;
        load_ops(cur, lds, vs, fr, g);
        for (int c = 0; c < NCHUNK; ++c) {
            if (c + 1 < NCHUNK) load_ops(nxt, lds + ((c + 1) % RN) * RSLOT, vs, fr, g); else nxt = cur;
            u32x4 hb0, hb1;
            hb0.x = cvt_pk_bf16(H[0][0], H[0][1]); hb0.y = cvt_pk_bf16(H[0][2], H[0][3]); hb0.z = cvt_pk_bf16(H[1][0], H[1][1]); hb0.w = cvt_pk_bf16(H[1][2], H[1][3]);
            hb1.x = cvt_pk_bf16(H[2][0], H[2][1]); hb1.y = cvt_pk_bf16(H[2][2], H[2][3]); hb1.z = cvt_pk_bf16(H[3][0], H[3][1]); hb1.w = cvt_pk_bf16(H[3][2], H[3][3]);
            const bf16x8 hB0 = __builtin_bit_cast(bf16x8, hb0), hB1 = __builtin_bit_cast(bf16x8, hb1);
            f32x4 U = (f32x4){bflo(cur.u0.x), bfhi(cur.u0.x), bflo(cur.u0.y), bfhi(cur.u0.y)};
            U = __builtin_amdgcn_mfma_f32_16x16x32_bf16(cur.wA0, hB0, U, 0, 0, 0);
            U = __builtin_amdgcn_mfma_f32_16x16x32_bf16(cur.wA1, hB1, U, 0, 0, 0);
            f32x4 Y = (f32x4){0.f, 0.f, 0.f, 0.f};
            Y = __builtin_amdgcn_mfma_f32_16x16x32_bf16(cur.rA0, hB0, Y, 0, 0, 0);
            Y = __builtin_amdgcn_mfma_f32_16x16x32_bf16(cur.rA1, hB1, Y, 0, 0, 0);
            u32x4 uvw; uvw.x = cvt_pk_bf16(U[0], U[1]); uvw.y = cvt_pk_bf16(U[2], U[3]); uvw.z = cur.vv.x; uvw.w = cur.vv.y;
            const bf16x8 uv = __builtin_bit_cast(bf16x8, uvw);
            Y = __builtin_amdgcn_mfma_f32_16x16x32_bf16(cur.ark, uv, Y, 0, 0, 0);
#pragma unroll
            for (int m = 0; m < 4; ++m) { H[m] = __builtin_amdgcn_mfma_f32_16x16x32_bf16(cur.bk[m], uv, H[m], 0, 0, 0); H[m] *= cur.wc[m]; }
            u32x2 yw; yw.x = cvt_pk_bf16(Y[0], Y[1]); yw.y = cvt_pk_bf16(Y[2], Y[3]);
            *(u32x2*)(CHb + (size_t)c * REC_BYTES + RO_U0T + (16 * vs + fr) * 32 + g * 8) = yw;
            R_BAR();
            cur = nxt;
        }
    }
#undef R_BAR
}

__device__ __forceinline__ void phase_gn(const PPv& p, LAS unsigned char* lds) {
    const int tid = threadIdx.x, bid = blockIdx.x, nb = gridDim.x, lane = tid & 63, wave = tid >> 6;
    unsigned char* ws = p.gws();
    LAS float* PM = (LAS float*)(lds + wave * 8960);
    LAS float* RS = PM + 32 * 68;
    const bf16_t* Gb = (const bf16_t*)(ws + OFF_G); const float* COEF = (const float*)(ws + OFF_COEF);
    bf16_t* Z = (bf16_t*)(ws + OFF_Z);
    constexpr int NREAL = 64 * 256;
    for (int r0 = bid * 8 + wave; r0 < NREAL; r0 += nb * 16) {
        u32x4 y0[2], y1[2], v0[2], v1[2]; float cfv[2][16]; bf16_t ggv[2][16]; int colv[2], row0v[2], hv[2]; bool okv[2];
#pragma unroll
        for (int u = 0; u < 2; ++u) {
            const int r = r0 + u * nb * 8; okv[u] = r < NREAL;
            const int rr = okv[u] ? r : r0;
            const int bh = rr >> 8, c = (rr & 255) + 1, b = bh >> 3, h = bh & 7, uid = bh * NCHUNK + c;
            hv[u] = h; colv[u] = h * 64 + lane; row0v[u] = b * SEQ + c * 16;
            const unsigned char* rec = ws + OFF_CH + (size_t)uid * REC_BYTES;
            y0[u] = *(const u32x4*)(rec + RO_U0T + lane * 32); y1[u] = *(const u32x4*)(rec + RO_U0T + lane * 32 + 16);
            v0[u] = *(const u32x4*)(rec + RO_VT + lane * 32); v1[u] = *(const u32x4*)(rec + RO_VT + lane * 32 + 16);
#pragma unroll
            for (int t = 0; t < 16; ++t) { cfv[u][t] = COEF[(size_t)(row0v[u] + t) * 8 + h]; ggv[u][t] = Gb[(size_t)(row0v[u] + t) * 512 + colv[u]]; }
        }
#pragma unroll
        for (int u = 0; u < 2; ++u) {
            if (!okv[u]) continue;
            const int col = colv[u], row0 = row0v[u];
            const float lng = p.gin(21)[col], lnb = p.gin(22)[col];
            const unsigned yw[8] = {y0[u].x, y0[u].y, y0[u].z, y0[u].w, y1[u].x, y1[u].y, y1[u].z, y1[u].w}, vw[8] = {v0[u].x, v0[u].y, v0[u].z, v0[u].w, v1[u].x, v1[u].y, v1[u].z, v1[u].w};
            asm volatile("" ::: "memory");
#pragma unroll
            for (int t = 0; t < 16; ++t) { const float y = (t & 1) ? bfhi(yw[t >> 1]) : bflo(yw[t >> 1]); PM[t * 68 + lane] = y; PM[(16 + t) * 68 + lane] = y * y; }
            asm volatile("" ::: "memory");
            {
                const int rw = lane & 31, hf = lane >> 5;
                f32x4 s4 = (f32x4){0.f, 0.f, 0.f, 0.f};
#pragma unroll
                for (int i = 0; i < 8; ++i) s4 += *(const LAS f32x4*)(PM + rw * 68 + hf * 32 + i * 4);
                float sm = (s4[0] + s4[1]) + (s4[2] + s4[3]);
                { float c2 = sm; asm volatile("v_nop\n\tv_nop\n\tv_permlane32_swap_b32 %0, %1\n\tv_nop" : "+v"(sm), "+v"(c2)); sm += c2; }
                if (lane < 32) RS[lane] = sm;
            }
            asm volatile("" ::: "memory");
            f32x4 s1v[4], s2v[4];
#pragma unroll
            for (int i = 0; i < 4; ++i) { s1v[i] = *(const LAS f32x4*)(RS + 4 * i); s2v[i] = *(const LAS f32x4*)(RS + 16 + 4 * i); }
            asm volatile("" ::: "memory");
#pragma unroll
            for (int t = 0; t < 16; ++t) {
                const float y = (t & 1) ? bfhi(yw[t >> 1]) : bflo(yw[t >> 1]);
                const float v = (t & 1) ? bfhi(vw[t >> 1]) : bflo(vw[t >> 1]);
                const float mean = s1v[t >> 2][t & 3] * (1.0f / 64.0f);
                const float dlt = y - mean;
                const float var = fmaxf(s2v[t >> 2][t & 3] * (1.0f / 64.0f) - mean * mean, 0.f);
                const float yn = dlt * rsqrtf(var + LNX_EPS) * lng + lnb;
                Z[(size_t)(row0 + t - NMETA) * 512 + col] = f2bf((yn + cfv[u][t] * v) * bf2f(ggv[u][t]));
            }
        }
    }
}

__device__ __forceinline__ void convert_expert_weights(const PPv& p, LAS unsigned char* lds, int first, int stride) {
    unsigned char* ws = p.gws();
    const int tid = threadIdx.x;
    LAS float* tile = (LAS float*)lds;
    const float* g2 = p.gin(27);
    unsigned char* WGU = ws + OFF_WGU; unsigned char* WD = ws + OFF_WD;
    constexpr int NBLK = NE * 3 * 64;
    const int lr = tid >> 6, lc = (tid & 63) * 4;
    f32x4 cur[8];
    int j = first;
    if (j >= NBLK) return;
    {
        const int mat = j >> 6, e = mat / 3, which = mat - 3 * e, bb = j & 63, kb = bb & 15, nbk = bb >> 4;
        const float* src = (which == 0 ? p.gin(30) : which == 1 ? p.gin(32) : p.gin(34)) + (size_t)e * 1024 * 1024 + (size_t)(kb * 64) * 1024 + nbk * 256;
#pragma unroll
        for (int i = 0; i < 8; ++i) cur[i] = __builtin_nontemporal_load((const f32x4*)(src + (size_t)(lr + 8 * i) * 1024 + lc));
    }
    for (;;) {
        const int jn = j + stride; const bool has_next = jn < NBLK;
        f32x4 nxt[8];
        if (has_next) {
            const int mat = jn >> 6, e = mat / 3, which = mat - 3 * e, bb = jn & 63, kb = bb & 15, nbk = bb >> 4;
            const float* src = (which == 0 ? p.gin(30) : which == 1 ? p.gin(32) : p.gin(34)) + (size_t)e * 1024 * 1024 + (size_t)(kb * 64) * 1024 + nbk * 256;
#pragma unroll
            for (int i = 0; i < 8; ++i) nxt[i] = __builtin_nontemporal_load((const f32x4*)(src + (size_t)(lr + 8 * i) * 1024 + lc));
        }
        const int mat = j >> 6, e = mat / 3, which = mat - 3 * e, bb = j & 63, kb = bb & 15, nbk = bb >> 4;
#pragma unroll
        for (int i = 0; i < 8; ++i) { LAS float* t = tile + (lr + 8 * i) * 257 + lc; t[0] = cur[i][0]; t[1] = cur[i][1]; t[2] = cur[i][2]; t[3] = cur[i][3]; }
        __syncthreads();
        {
            const int kq = tid & 7, k0 = kb * 64 + 8 * kq;
            float sc[8];
#pragma unroll
            for (int jj = 0; jj < 8; ++jj) sc[jj] = (which < 2 ? g2[k0 + jj] : 1.0f) * W8_SCALE;
#pragma unroll
            for (int i = 0; i < 4; ++i) {
                const int nn = (tid >> 3) + 64 * i, n = nbk * 256 + nn;
                float v[8];
#pragma unroll
                for (int jj = 0; jj < 8; ++jj) v[jj] = tile[(8 * kq + jj) * 257 + nn] * sc[jj];
                u32x2 w; w.x = pk4_fp8(v[0], v[1], v[2], v[3]); w.y = pk4_fp8(v[4], v[5], v[6], v[7]);
                unsigned char* dst = which < 2 ? WGU + (size_t)e * 2048 * 1024 + (size_t)(256 * (n >> 7) + 128 * which + (n & 127)) * 1024
                                               : WD + (size_t)e * 1024 * 1024 + (size_t)n * 1024;
                __builtin_nontemporal_store(w, (u32x2*)(dst + k0));
            }
        }
        __syncthreads();
        if (!has_next) break;
        j = jn;
#pragma unroll
        for (int i = 0; i < 8; ++i) cur[i] = nxt[i];
    }
}

__device__ __forceinline__ void phase_router(const PPv& p, LAS unsigned char* lds) {
    const int tid = threadIdx.x, bid = blockIdx.x, nb = gridDim.x, lane = tid & 63, wave = tid >> 6;
    unsigned char* ws = p.gws();
    const bf16_t* h1 = (const bf16_t*)(ws + OFF_HB2);
    const float* WRG = (const float*)(ws + OFF_WRG);
    const float* brt = p.gin(29);
    LAS float* slog = (LAS float*)lds;
    LAS float* srs = slog + 8 * 16 * 32;
    LAS int* lcnt = (LAS int*)(srs + 128);
    LAS int* gbase = lcnt + 32;
    LAS int* ltopi = gbase + 32;
    LAS int* lrank = ltopi + 512;
    int* TOPI = (int*)(ws + OFF_TOPI); float* TOPW = (float*)(ws + OFF_TOPW); int* RANK = (int*)(ws + OFF_RANK); float* RSTD2 = (float*)(ws + OFF_RSTD2);
    int* GCNT = (int*)(ws + OFF_GCNT);
    for (int tb = bid; tb < T / 128; tb += nb) {
        if (tid < 32) lcnt[tid] = 0;
        __syncthreads();
        const int t0 = tb * 128 + wave * 16;
        {
            const int row = lane & 15, kq = lane >> 4;
            const bf16_t* ap = h1 + (size_t)(t0 + row) * D + 4 * kq;
            const float* bp = WRG + (size_t)(4 * kq) * 32 + row;
            f32x4 acc0 = (f32x4){0.f, 0.f, 0.f, 0.f}, acc1 = acc0;
            float ss = 0.f;
            for (int j = 0; j < 64; ++j) {
                const u32x2 aw = *(const u32x2*)(ap + 16 * j);
                const f32x4 av = (f32x4){bflo(aw.x), bfhi(aw.x), bflo(aw.y), bfhi(aw.y)};
                ss += av[0] * av[0] + av[1] * av[1] + av[2] * av[2] + av[3] * av[3];
                const float* bj = bp + (size_t)(16 * j) * 32;
#pragma unroll
                for (int s = 0; s < 4; ++s) {
                    const float b0 = bj[s * 32], b1 = bj[s * 32 + 16];
                    acc0 = __builtin_amdgcn_mfma_f32_16x16x4f32(av[s], b0, acc0, 0, 0, 0);
                    acc1 = __builtin_amdgcn_mfma_f32_16x16x4f32(av[s], b1, acc1, 0, 0, 0);
                }
            }
            ss += __shfl_xor(ss, 16); ss += __shfl_xor(ss, 32);
#pragma unroll
            for (int reg = 0; reg < 4; ++reg) {
                slog[(wave * 16 + 4 * kq + reg) * 32 + row] = acc0[reg];
                slog[(wave * 16 + 4 * kq + reg) * 32 + 16 + row] = acc1[reg];
            }
            if (lane < 16) srs[wave * 16 + lane] = rsqrtf(ss * (1.0f / D) + NORM_EPS);
        }
        __syncthreads();
        if (lane < 16) {
            const int tl = wave * 16 + lane, t = tb * 128 + tl;
            const float rs = srs[tl];
            float lg[32];
#pragma unroll
            for (int e = 0; e < 32; ++e) lg[e] = slog[tl * 32 + e] * rs + brt[e];
            int ti[4]; float tv[4];
#pragma unroll
            for (int k = 0; k < 4; ++k) {
                float best = -3.0e38f; int bi = 0;
#pragma unroll
                for (int e = 0; e < 32; ++e) { const bool tk = lg[e] > best; best = tk ? lg[e] : best; bi = tk ? e : bi; }
                ti[k] = bi; tv[k] = best;
#pragma unroll
                for (int e = 0; e < 32; ++e) lg[e] = (e == bi) ? -3.0e38f : lg[e];
            }
            const float e0 = 1.0f, e1 = __expf(tv[1] - tv[0]), e2 = __expf(tv[2] - tv[0]), e3 = __expf(tv[3] - tv[0]);
            const float inv = 1.0f / (e0 + e1 + e2 + e3);
            *(f32x4*)(TOPW + (size_t)t * 4) = (f32x4){e0 * inv, e1 * inv, e2 * inv, e3 * inv};
            RSTD2[t] = rs;
#pragma unroll
            for (int k = 0; k < 4; ++k) { ltopi[tl * 4 + k] = ti[k]; lrank[tl * 4 + k] = __hip_atomic_fetch_add(lcnt + ti[k], 1, __ATOMIC_RELAXED, __HIP_MEMORY_SCOPE_WORKGROUP); }
        }
        __syncthreads();
        if (tid < 32) gbase[tid] = atomicAdd(GCNT + tid, lcnt[tid]);
        __syncthreads();
        {
            const int e = ltopi[tid];
            TOPI[(size_t)tb * 512 + tid] = e;
            RANK[(size_t)tb * 512 + tid] = gbase[e] + lrank[tid];
        }
        __syncthreads();
    }
}

__device__ __forceinline__ void phase_lists(const PPv& p, LAS unsigned char* lds) {
    const int tid = threadIdx.x, bid = blockIdx.x, nb = gridDim.x;
    unsigned char* ws = p.gws();
    LAS int* pstart = (LAS int*)lds;
    LAS int* cnt = pstart + 64;
    const int* GCNT = (const int*)(ws + OFF_GCNT);
    if (tid < 32) cnt[tid] = GCNT[tid];
    __syncthreads();
    if (tid == 0) { int s = 0; for (int e = 0; e < 32; ++e) { pstart[e] = s; s += ((cnt[e] + 255) >> 8) << 8; } pstart[32] = s; }
    __syncthreads();
    const int* TOPI = (const int*)(ws + OFF_TOPI); const float* TOPW = (const float*)(ws + OFF_TOPW); const int* RANK = (const int*)(ws + OFF_RANK); const float* RSTD2 = (const float*)(ws + OFF_RSTD2);
    int* ROWTOK = (int*)(ws + OFF_ROWTOK); int* ROWSLOT = (int*)(ws + OFF_ROWSLOT); float* ROWW = (float*)(ws + OFF_ROWW); float* ROWRS = (float*)(ws + OFF_ROWRS);
    for (int i = bid * 512 + tid; i < T * 4; i += nb * 512) {
        const int e = TOPI[i], pos = pstart[e] + RANK[i], t = i >> 2;
        ROWTOK[pos] = t; ROWSLOT[pos] = i; ROWW[pos] = TOPW[i]; ROWRS[pos] = RSTD2[t];
    }
    for (int e = bid; e < 32; e += nb) {
        for (int pos = pstart[e] + cnt[e] + tid; pos < pstart[e + 1]; pos += 512) { ROWTOK[pos] = 0; ROWSLOT[pos] = -1; ROWW[pos] = 0.f; ROWRS[pos] = 0.f; }
    }
    if (bid == 0) {
        int* TILEE = (int*)(ws + OFF_TILEE);
        const int ntiles = pstart[32] >> 8;
        for (int mt = tid; mt < ntiles; mt += 512) { int e = 0; for (int q = 0; q < 32; ++q) if (pstart[q] <= mt * 256) e = q; TILEE[mt] = e; }
        if (tid == 0) TILEE[1000] = ntiles;
    }
    __syncthreads();
}

__device__ __forceinline__ void phase_final(const PPv& p) {
    const int tid = threadIdx.x, bid = blockIdx.x, nb = gridDim.x, lane = tid & 63, wave = tid >> 6;
    unsigned char* ws = p.gws();
    const bf16_t* HB2 = (const bf16_t*)(ws + OFF_HB2);
    const unsigned char* Y8 = (const unsigned char*)p.gout();
    const float* gf = p.gin(36);
    const f32x4 ga0 = *(const f32x4*)(gf + 8 * lane), ga1 = *(const f32x4*)(gf + 8 * lane + 4), gb0 = *(const f32x4*)(gf + 512 + 8 * lane), gb1 = *(const f32x4*)(gf + 512 + 8 * lane + 4);
    for (int t0 = (bid * 8 + wave) * 2; t0 < T; t0 += nb * 16) {
        u32x4 ha[2], hb[2]; u32x2 ya[2][4], yb[2][4];
#pragma unroll
        for (int u = 0; u < 2; ++u) {
            const int t = t0 + u;
            ha[u] = __builtin_nontemporal_load((const u32x4*)(HB2 + (size_t)t * D + 8 * lane)); hb[u] = __builtin_nontemporal_load((const u32x4*)(HB2 + (size_t)t * D + 512 + 8 * lane));
#pragma unroll
            for (int k = 0; k < 4; ++k) { ya[u][k] = __builtin_nontemporal_load((const u32x2*)(Y8 + (size_t)(4 * t + k) * 1024 + 8 * lane)); yb[u][k] = __builtin_nontemporal_load((const u32x2*)(Y8 + (size_t)(4 * t + k) * 1024 + 512 + 8 * lane)); }
        }
#pragma unroll
        for (int u = 0; u < 2; ++u) {
            const int t = t0 + u;
            float va[8] = {bflo(ha[u].x), bfhi(ha[u].x), bflo(ha[u].y), bfhi(ha[u].y), bflo(ha[u].z), bfhi(ha[u].z), bflo(ha[u].w), bfhi(ha[u].w)};
            float vb[8] = {bflo(hb[u].x), bfhi(hb[u].x), bflo(hb[u].y), bfhi(hb[u].y), bflo(hb[u].z), bfhi(hb[u].z), bflo(hb[u].w), bfhi(hb[u].w)};
#pragma unroll
            for (int k = 0; k < 4; ++k) {
                const u32x2 a4 = ya[u][k], b4 = yb[u][k];
                { const f32x2 q0 = __builtin_amdgcn_cvt_pk_f32_fp8((int)a4.x, false), q1 = __builtin_amdgcn_cvt_pk_f32_fp8((int)a4.x, true), q2 = __builtin_amdgcn_cvt_pk_f32_fp8((int)a4.y, false), q3 = __builtin_amdgcn_cvt_pk_f32_fp8((int)a4.y, true);
                  va[0] += q0.x; va[1] += q0.y; va[2] += q1.x; va[3] += q1.y; va[4] += q2.x; va[5] += q2.y; va[6] += q3.x; va[7] += q3.y; }
                { const f32x2 q0 = __builtin_amdgcn_cvt_pk_f32_fp8((int)b4.x, false), q1 = __builtin_amdgcn_cvt_pk_f32_fp8((int)b4.x, true), q2 = __builtin_amdgcn_cvt_pk_f32_fp8((int)b4.y, false), q3 = __builtin_amdgcn_cvt_pk_f32_fp8((int)b4.y, true);
                  vb[0] += q0.x; vb[1] += q0.y; vb[2] += q1.x; vb[3] += q1.y; vb[4] += q2.x; vb[5] += q2.y; vb[6] += q3.x; vb[7] += q3.y; }
            }
            float ss = 0.f;
#pragma unroll
            for (int j = 0; j < 8; ++j) ss += va[j] * va[j] + vb[j] * vb[j];
            ss = wave_sum_dpp(ss);
            const float rs = rsqrtf(ss * (1.0f / D) + NORM_EPS);
            float* o = p.gout() + (size_t)t * D;
            __builtin_nontemporal_store((f32x4){va[0] * rs * ga0[0], va[1] * rs * ga0[1], va[2] * rs * ga0[2], va[3] * rs * ga0[3]}, (f32x4*)(o + 8 * lane));
            __builtin_nontemporal_store((f32x4){va[4] * rs * ga1[0], va[5] * rs * ga1[1], va[6] * rs * ga1[2], va[7] * rs * ga1[3]}, (f32x4*)(o + 8 * lane + 4));
            __builtin_nontemporal_store((f32x4){vb[0] * rs * gb0[0], vb[1] * rs * gb0[1], vb[2] * rs * gb0[2], vb[3] * rs * gb0[3]}, (f32x4*)(o + 512 + 8 * lane));
            __builtin_nontemporal_store((f32x4){vb[4] * rs * gb1[0], vb[5] * rs * gb1[1], vb[6] * rs * gb1[2], vb[7] * rs * gb1[3]}, (f32x4*)(o + 512 + 8 * lane + 4));
        }
    }
}

#define XB_TMO      128
#define XB_XCNT(j)  (256  + 64 * (j))
#define XB_XSUB(j)  (1280 + 64 * (j))
#define XB_XGEN(j)  (2304 + 64 * (j))
#define XB_TOP      3328
#define XB_TOPGEN   3392
#define XCD_BAR_WORDS 3456
#define XB_SPIN_CAP (1u << 18)
__device__ __forceinline__ unsigned xb_ld(unsigned* p)              { return __hip_atomic_load(p, __ATOMIC_RELAXED, __HIP_MEMORY_SCOPE_AGENT); }
__device__ __forceinline__ unsigned xb_add(unsigned* p, unsigned v) { return __hip_atomic_fetch_add(p, v, __ATOMIC_RELAXED, __HIP_MEMORY_SCOPE_AGENT); }
__device__ __forceinline__ unsigned xb_xcc_id() { return (unsigned)__builtin_amdgcn_s_getreg((3 << 11) | 20) & 0xFu; }
#define XB_SPIN(cond, bar) do { unsigned _sp = 0; while (cond) { __builtin_amdgcn_s_sleep(1); \
    if ((++_sp & 255u) == 0u) { if (xb_ld(&(bar)[XB_TMO])) break; if (_sp > XB_SPIN_CAP) { atomicAdd(&(bar)[XB_TMO], 1u); break; } } } } while (0)
struct XcdBarrier { unsigned* bar; unsigned x; volatile LAS unsigned* st; };
__device__ __forceinline__ XcdBarrier xcd_barrier_post(unsigned* bar, volatile LAS unsigned* st) {
    XcdBarrier b; b.bar = bar; b.x = xb_xcc_id(); b.st = st;
    if (threadIdx.x == 0) (void)xb_add(&bar[XB_XCNT(b.x)], 1u);
    return b;
}
__device__ __forceinline__ void xcd_barrier_complete(unsigned* bar, unsigned x, unsigned& nloc, unsigned& nx) {
    const unsigned G = gridDim.x * gridDim.y * gridDim.z;
    unsigned sum, cnt, mine, sp = 0u;
    for (;;) {
        sum = 0u; cnt = 0u; mine = 0u;
#pragma unroll
        for (unsigned j = 0; j < 16; ++j) { const unsigned c = xb_ld(&bar[XB_XCNT(j)]); sum += c; cnt += (c > 0u) ? 1u : 0u; mine = (j == x) ? c : mine; }
        if (sum == G) break;
        __builtin_amdgcn_s_sleep(1);
        if ((++sp & 255u) == 0u) { if (xb_ld(&bar[XB_TMO])) break; if (sp > XB_SPIN_CAP) { atomicAdd(&bar[XB_TMO], 1u); break; } }
    }
    nloc = mine > 0u ? mine : 1u; nx = cnt > 0u ? cnt : 1u;
}
__device__ __forceinline__ void xcd_barrier(const XcdBarrier& b) {
    asm volatile("s_waitcnt vmcnt(0)" ::: "memory");
    __syncthreads();
    if (threadIdx.x == 0) {
        unsigned* bar = b.bar;
        __builtin_amdgcn_s_waitcnt(0);
        unsigned nloc = b.st[0], nx = b.st[1];
        if (nloc == 0u) { xcd_barrier_complete(bar, b.x, nloc, nx); b.st[0] = nloc; b.st[1] = nx; }
        const unsigned old = xb_add(&bar[XB_XSUB(b.x)], 1u);
        const unsigned gen = old / nloc;
        if (old + 1u == (gen + 1u) * nloc) {
            __builtin_amdgcn_fence(__ATOMIC_RELEASE, "agent");
            asm volatile("s_waitcnt vmcnt(0)" ::: "memory");
            const unsigned og = xb_add(&bar[XB_TOP], 1u);
            const unsigned tg = og / nx;
            if (og + 1u == (tg + 1u) * nx) xb_add(&bar[XB_TOPGEN], 1u);
            else XB_SPIN(xb_ld(&bar[XB_TOPGEN]) == tg, bar);
            __builtin_amdgcn_fence(__ATOMIC_ACQUIRE, "agent");
            xb_add(&bar[XB_XGEN(b.x)], 1u);
            asm volatile("s_waitcnt vmcnt(0)" ::: "memory");
        } else {
            XB_SPIN(xb_ld(&bar[XB_XGEN(b.x)]) == gen, bar);
            __builtin_amdgcn_fence(__ATOMIC_ACQUIRE, "agent");
            asm volatile("s_waitcnt vmcnt(0)" ::: "memory");
        }
    }
    __syncthreads();
}

constexpr int N_PHASES = 15;
__global__ void __launch_bounds__(512, 2) mega(Params p) {
    extern __shared__ __attribute__((aligned(16))) unsigned char lds_raw[];
    LAS unsigned char* lds = (LAS unsigned char*)lds_raw;
    cg::grid_group grid = cg::this_grid();
    unsigned char* ws = getpp().gws();
    const int G = gridDim.x, bid = blockIdx.x;
#ifndef ONLY_PHASE
#define ONLY_PHASE -1
#endif
#define IN(k) ((ONLY_PHASE < 0 || ONLY_PHASE == (k)) && p.ph_lo <= (k) && (k) < p.ph_hi)
    volatile LAS unsigned* xst = (volatile LAS unsigned*)(lds + 163840 - 16);
    if (threadIdx.x < 4) xst[threadIdx.x] = 0u;
    __syncthreads();
    const XcdBarrier xbar = xcd_barrier_post((unsigned*)(ws + OFF_BAR), xst);
    if (p.ph_hi < 0) grid.sync();
#define SEAM(k) do { if ((k) + 1 < p.ph_hi) xcd_barrier(xbar); } while (0)
    if (IN(0)) { const PPv q = getpp(); phase_prep(q, lds); SEAM(0); }
    if (IN(1)) { const PPv q = getpp();
        phase_meta_proj(q, lds);
        {
            StaticOrder S; S.init(ws + OFF_HB, ws + OFF_WIN, T, 14 * 256, 1024, G, bid);
            EpiProj E{(bf16_t*)(ws + OFF_PRKV), (bf16_t*)(ws + OFF_PCONV), (bf16_t*)q.gout(), (const float*)(ws + OFF_RSTD1), 0, 1.0f};
            gemm_phase<false>(lds, 1024, S, E);
        }
        {
            StaticOrder S; S.init(ws + OFF_X8, ws + OFF_WIN8, T, 8 * 256, 512, G, bid);
            EpiProj E{(bf16_t*)(ws + OFF_PRKV), (bf16_t*)(ws + OFF_PCONV), (bf16_t*)q.gout(), (const float*)(ws + OFF_RSTD1), 14, W8_INV};
            gemm_phase<false, true>(lds, 512, S, E);
        }
        SEAM(1);
    }
    if (IN(2)) { const PPv q = getpp(); phase_lprep_conv(q); SEAM(2); }
    if (IN(3)) { const PPv q = getpp();
        phase_meta_lora(q);
        StaticOrder S; S.init(ws + OFF_L + (size_t)NMETA * 256 * 2, ws + OFF_W2, T, 1536, 256, G, bid);
        EpiL E{ws, q.gin(10), q.gin(13)};
        gemm_phase<false>(lds, 256, S, E);
        SEAM(3);
    }
    if (IN(4)) { const PPv q = getpp(); phase_scanprep(q, lds); SEAM(4); }
    if (IN(5)) { const PPv q = getpp(); phase_recur(q, lds); SEAM(5); }
    if (IN(6)) { const PPv q = getpp(); phase_gn(q, lds); SEAM(6); }
    if (IN(7)) { const PPv q = getpp();
        MergeOrder S; S.so.init(ws + OFF_Z, ws + OFF_WR, T, 1024, 512, G, bid); S.A1 = (const char*)(ws + OFF_C); S.B1 = (const char*)(ws + OFF_WC);
        EpiMergeFused E{(bf16_t*)(ws + OFF_MERGED), (const bf16_t*)q.gout()};
        gemm_phase<false>(lds, 512, S, E);
        SEAM(7);
    }
    if (IN(9)) { const PPv q = getpp();
        StaticOrder S; S.init(ws + OFF_MERGED, ws + OFF_WO, T, 1024, 1024, G, bid);
        EpiO E{q.gin(0), q.gout(), (bf16_t*)(ws + OFF_HB2), ws + OFF_HB8};
        gemm_phase<false>(lds, 1024, S, E);
        SEAM(9);
    }
    if (IN(10)) { const PPv q = getpp(); phase_router(q, lds); SEAM(10); }
    if (IN(11)) { const PPv q = getpp(); phase_lists(q, lds); SEAM(11); }
    if (IN(12)) { const PPv q = getpp();
        const int* TILEE = (const int*)(ws + OFF_TILEE);
        MoeOrder S; S.A = (const char*)(ws + OFF_HB8); S.Bt = (const char*)(ws + OFF_WGU); S.K = 512; S.estride = (size_t)2048 * 1024;
        S.tile_e = TILEE; S.rowtok = (const int*)(ws + OFF_ROWTOK); S.ntiles = TILEE[1000]; S.nnt = 8; S.G = G; S.c = bid; S.gather = true;
        EpiMoe1 E{ws + OFF_ACT, (const float*)(ws + OFF_ROWRS), q.gin(31), q.gin(33)};
        gemm_phase<true, true>(lds, 512, S, E);
        SEAM(12);
    }
    if (IN(13)) { const PPv q = getpp();
        const int* TILEE = (const int*)(ws + OFF_TILEE);
        MoeOrder S; S.A = (const char*)(ws + OFF_ACT); S.Bt = (const char*)(ws + OFF_WD); S.K = 512; S.estride = (size_t)1024 * 1024;
        S.tile_e = TILEE; S.rowtok = nullptr; S.ntiles = TILEE[1000]; S.nnt = 4; S.G = G; S.c = bid; S.gather = false;
        EpiMoe2 E{(unsigned char*)q.gout(), (const int*)(ws + OFF_ROWSLOT), (const float*)(ws + OFF_ROWW), q.gin(35)};
        gemm_phase<false, true>(lds, 512, S, E);
        SEAM(13);
    }
    if (IN(14)) { const PPv q = getpp(); phase_final(q); }
}

extern "C" void kernel_launch(void* const* d_in, const int* in_sizes, int n_in, void* d_out, int out_size, void* d_ws, size_t ws_size,
                              hipStream_t stream) {
    constexpr size_t kDynLds = 160 * 1024;
    static int grid_blocks = 0;
    if (!grid_blocks) {
        int dev = 0, cus = 0, per_cu = 0;
        (void)hipGetDevice(&dev);
        (void)hipDeviceGetAttribute(&cus, hipDeviceAttributeMultiprocessorCount, dev);
        (void)hipFuncSetAttribute((const void*)mega, hipFuncAttributeMaxDynamicSharedMemorySize, (int)kDynLds);
        (void)hipOccupancyMaxActiveBlocksPerMultiprocessor(&per_cu, mega, 512, kDynLds);
        if (per_cu > 1) per_cu = 1;
        grid_blocks = cus * per_cu;
        fprintf(stderr, "cus=%d per_cu=%d ws_size=%zu need=%zu\n", cus, per_cu, ws_size, (size_t)WS_NEED);
    }
    if (ws_size < WS_NEED || n_in < 37 || grid_blocks < 128) { fprintf(stderr, "kernel_launch: unsupported configuration\n"); return; }
    Params p{};
    for (int i = 0; i < 37; ++i) p.in[i] = (const float*)d_in[i];
    p.out = (float*)d_out;
    p.ws = (unsigned char*)d_ws;
    p.ph_lo = 0; p.ph_hi = N_PHASES;
    (void)hipMemsetAsync((unsigned char*)d_ws + OFF_BAR, 0, 16384, stream);
    void* args[] = {&p};
    hipError_t e = hipLaunchCooperativeKernel((void*)mega, dim3(grid_blocks), dim3(512), args, kDynLds, stream);
    if (e != hipSuccess) fprintf(stderr, "cooperative launch failed: %s (grid %d)\n", hipGetErrorString(e), grid_blocks);
}
```

```cpp
#include <hip/hip_runtime.h>
#include <hip/hip_cooperative_groups.h>
#include <cstdio>
namespace cg = cooperative_groups;

#define LAS __attribute__((address_space(3)))
typedef unsigned short bf16_t;
typedef short bf16x8 __attribute__((ext_vector_type(8)));
typedef float f32x4 __attribute__((ext_vector_type(4)));
typedef float f32x2 __attribute__((ext_vector_type(2)));
typedef unsigned u32x4 __attribute__((ext_vector_type(4)));
typedef unsigned u32x2 __attribute__((ext_vector_type(2)));
#define LO2(v) __builtin_shufflevector(v, v, 0, 1)
#define HI2(v) __builtin_shufflevector(v, v, 2, 3)

constexpr int D = 1024, NBATCH = 8, SEQ = 4096, NMETA = 16;
constexpr int T = NBATCH * SEQ;
constexpr int NR = T + NMETA;
constexpr int NRP = 33024;
constexpr int PCOLS1 = 3584;
constexpr int NCOLS1 = 5632;
constexpr int NE = 32, TOPK = 4, DFF = 1024;
constexpr int MAXROWS = T * TOPK + NE * 256;
constexpr int MAXTILES = MAXROWS / 256;
constexpr float NORM_EPS = 1e-5f, LNX_EPS = 64e-5f;

constexpr int NCHUNK = 257, NUNITS = 64 * NCHUNK;
constexpr int REC_BYTES = 13568;
constexpr int RO_WH = 0, RO_RT = 2048, RO_U0T = 4096, RO_VT = 6144, RO_BKT = 8192, RO_ARK = 12288, RO_WCC = 13312;
constexpr int SLOT_BYTES = 15680, SO_G = 13568, SO_COEF = 15616, NSLOT = 9;
constexpr size_t SZ_ACT = (size_t)MAXROWS * 1024 * 2;
constexpr size_t SZ_WGU = (size_t)NE * 2048 * 1024 * 2;
constexpr size_t SZ_WD = (size_t)NE * 1024 * 1024 * 2;
constexpr size_t SZ_HB = (size_t)T * 1024 * 2;
constexpr size_t OFF_WGU = 0;
constexpr size_t OFF_HB8 = OFF_WGU + (size_t)NE * 2048 * 1024;
constexpr size_t OFF_WD = OFF_WGU + SZ_WGU;
constexpr size_t OFF_ACT = OFF_WD + SZ_WD;
constexpr size_t OFF_HB2 = OFF_ACT + SZ_ACT;
constexpr size_t OFF_RT = OFF_HB2 + SZ_HB;
constexpr size_t OFF_TOPI = OFF_RT;
constexpr size_t OFF_TOPW = OFF_TOPI + (size_t)T * 16;
constexpr size_t OFF_RANK = OFF_TOPW + (size_t)T * 16;
constexpr size_t OFF_RSTD2 = OFF_RANK + (size_t)T * 16;
constexpr size_t OFF_ROWTOK = OFF_RSTD2 + (size_t)T * 4;
constexpr size_t OFF_ROWSLOT = OFF_ROWTOK + (size_t)MAXROWS * 4;
constexpr size_t OFF_ROWW = OFF_ROWSLOT + (size_t)MAXROWS * 4;
constexpr size_t OFF_ROWRS = OFF_ROWW + (size_t)MAXROWS * 4;
constexpr size_t OFF_TILEE = OFF_ROWRS + (size_t)MAXROWS * 4;
constexpr size_t OFF_GCNT = OFF_TILEE + 4096;
constexpr size_t OFF_SM = OFF_GCNT + 256;
constexpr size_t OFF_WR = OFF_SM;
constexpr size_t OFF_WC = OFF_WR + (size_t)1024 * 512 * 2;
constexpr size_t OFF_WO = OFF_WC + (size_t)1024 * 512 * 2;
constexpr size_t OFF_W2 = OFF_WO + (size_t)1024 * 1024 * 2;
constexpr size_t OFF_RSTD1 = OFF_W2 + (size_t)1536 * 256 * 2;
constexpr size_t OFF_WRG = OFF_RSTD1 + (size_t)NRP * 4;
constexpr size_t OFF_BAR = OFF_WRG + (size_t)1024 * 32 * 4;
constexpr size_t WS_NEED = OFF_BAR + 16384;
constexpr size_t OFF_PRKV = 0;
constexpr size_t SZ_PRKV = (size_t)NR * 1536 * 2;
constexpr size_t OFF_LD = OFF_PRKV + SZ_PRKV;
constexpr size_t OFF_A = OFF_LD + (size_t)NRP * 512 * 4;
constexpr size_t OFF_X8 = OFF_LD;
constexpr size_t OFF_WIN8 = OFF_X8 + (size_t)T * 1024;
static_assert(OFF_WIN8 + (size_t)2048 * 1024 <= OFF_A, "layout");
constexpr size_t OFF_CH = OFF_A + (size_t)NRP * 512 * 2;
constexpr size_t OFF_PCONV = OFF_CH;
constexpr size_t SZ_PCONV = (size_t)NR * 2048 * 2;
constexpr size_t OFF_HB = OFF_PCONV + SZ_PCONV;
constexpr size_t OFF_L = OFF_HB + SZ_HB;
constexpr size_t OFF_WIN = OFF_L + (size_t)NRP * 256 * 2;
constexpr size_t CH_END = OFF_WIN + (size_t)NCOLS1 * 1024 * 2;
constexpr size_t OFF_MERGED = OFF_CH;
constexpr size_t OFF_G = CH_END;
constexpr size_t OFF_C = OFF_G + (size_t)NRP * 512 * 2;
constexpr size_t OFF_Z = OFF_C + (size_t)T * 512 * 2;
constexpr size_t OFF_COEF = OFF_Z + (size_t)T * 512 * 2;
constexpr size_t EARLY_END = OFF_COEF + (size_t)NR * 8 * 4;
static_assert(EARLY_END <= OFF_RT, "early buffers overflow");
static_assert(OFF_CH + (size_t)NUNITS * REC_BYTES <= CH_END, "chunk records overflow");
static_assert(OFF_CH >= OFF_WD + SZ_WD, "expert weights (written during the scan) must not touch live scan buffers");
static_assert(OFF_MERGED + SZ_HB <= OFF_HB2, "layout");
static_assert(OFF_PRKV % 16 == 0 && OFF_LD % 16 == 0 && OFF_A % 16 == 0 && OFF_CH % 16 == 0 && OFF_HB % 16 == 0 && OFF_L % 16 == 0 && OFF_WIN % 16 == 0 && OFF_G % 16 == 0 && OFF_C % 16 == 0 && OFF_Z % 16 == 0 && OFF_COEF % 16 == 0, "align");

#define GAS __attribute__((address_space(1)))
#define CAS __attribute__((address_space(4)))
struct Params {
    const float* in[37];
    float* out;
    unsigned char* ws;
    int ph_lo, ph_hi;
};
struct ParamsD {
    const GAS float* in[37];
    GAS float* out;
    GAS unsigned char* ws;
    int ph_lo, ph_hi;
};
static_assert(sizeof(Params) == sizeof(ParamsD), "argument views");
struct PPv {
    const CAS ParamsD* k;
    __device__ __forceinline__ const float* gin(int i) const { return (const float*)k->in[i]; }
    __device__ __forceinline__ float* gout() const { return (float*)k->out; }
    __device__ __forceinline__ unsigned char* gws() const { return (unsigned char*)k->ws; }
};
__device__ __forceinline__ PPv getpp() { const CAS ParamsD* k = (const CAS ParamsD*)__builtin_amdgcn_kernarg_segment_ptr(); asm volatile("" : "+s"(k)); return PPv{k}; }

typedef __bf16 bf16x2v __attribute__((ext_vector_type(2)));
__device__ __forceinline__ unsigned cvt_pk_bf16(float lo, float hi) { const f32x2 v = {lo, hi}; return __builtin_bit_cast(unsigned, __builtin_convertvector(v, bf16x2v)); }
__device__ __forceinline__ unsigned pk4_fp8(float a, float b, float c, float d) { int w = __builtin_amdgcn_cvt_pk_fp8_f32(a, b, 0, false); w = __builtin_amdgcn_cvt_pk_fp8_f32(c, d, w, true); return (unsigned)w; }
constexpr float W8_SCALE = 32.0f, W8_INV = 1.0f / 32.0f;
__device__ __forceinline__ bf16_t f2bf(float f) { unsigned u = __float_as_uint(f); u += 0x7FFFu + ((u >> 16) & 1u); return (bf16_t)(u >> 16); }
__device__ __forceinline__ float bf2f(bf16_t b) { return __uint_as_float(((unsigned)b) << 16); }
__device__ __forceinline__ float bflo(unsigned w) { return __uint_as_float(w << 16); }
__device__ __forceinline__ float bfhi(unsigned w) { return __uint_as_float(w & 0xFFFF0000u); }
__device__ __forceinline__ float sigmoidf_(float x) { return __builtin_amdgcn_rcpf(1.0f + __expf(-x)); }
__device__ __forceinline__ float wave_sum(float v) {
#pragma unroll
    for (int o = 32; o >= 1; o >>= 1) v += __shfl_xor(v, o);
    return v;
}
__device__ __forceinline__ float wave_sum_dpp(float v);
__device__ __forceinline__ int prev_row(int row, int d) {
    if (row < NMETA) return row - d >= 0 ? row - d : -1;
    const int s = (row - NMETA) & (SEQ - 1);
    return s >= d ? row - d : NMETA + s - d;
}

constexpr int BM = 256, BK = 64, HALF = 128, HTB = HALF * BK * 2, STAGE_BYTES = 8 * HTB, NXCD = 8, WGM = 8;
__device__ __forceinline__ int lds_byte(int r, int c) { const int st = (r >> 4) * 2 + (c >> 5), rr = r & 15, cc = c & 31, ob = rr * 64 + cc * 2; return st * 1024 + (ob ^ (((ob >> 9) & 1) << 5)); }
__device__ __forceinline__ void stage_rc(int b, int& R, int& C) { const int st = b / 1024, sb = b % 1024, swz = sb ^ (((sb >> 9) & 1) << 5); R = (st >> 1) * 16 + swz / 64; C = (st & 1) * 32 + (swz % 64) / 2; }
__device__ __forceinline__ int perm32(int rho) { const int n = rho >> 4, i = rho & 15; return 8 * (i >> 2) + 4 * n + (i & 3); }

struct Unit { int pm, pn, aux; };

struct StaticOrder {
    const char* A; const char* Bt; int K;
    int nM, nN, nwg, G, c;
    __device__ void init(const void* A_, const void* Bt_, int M, int N, int K_, int G_, int c_) { A = (const char*)A_; Bt = (const char*)Bt_; K = K_; nM = M / BM; nN = N / BM; nwg = nM * nN; G = G_; c = c_; }
    __device__ bool next(int i, Unit& u) const {
        const long L = (long)i * G + c; if (L >= nwg) return false;
        int wgid = (int)L; { const int q = nwg / NXCD, r = nwg % NXCD, xcd = wgid % NXCD, off = wgid / NXCD; wgid = (xcd < r ? xcd * (q + 1) : r * (q + 1) + (xcd - r) * q) + off; }
        const int nig = WGM * nN, gid = wgid / nig, fm = gid * WGM, gsz = (nM - fm) < WGM ? (nM - fm) : WGM;
        u.pm = fm + ((wgid % nig) % gsz); u.pn = (wgid % nig) / gsz; u.aux = 0; return true;
    }
    __device__ __forceinline__ const char* a_ptr(const Unit& u) const { return A + (size_t)u.pm * 256 * K * 2; }
    __device__ __forceinline__ const char* b_ptr(const Unit& u) const { return Bt + (size_t)u.pn * 256 * K * 2; }
    __device__ __forceinline__ int gather_row(const Unit&, int) const { return 0; }
    __device__ __forceinline__ const void* gather_src(const Unit&, int) const { return nullptr; }
};
struct MoeOrder {
    const char* A; const char* Bt; int K; size_t estride;
    const int* tile_e; const int* rowtok; int ntiles, nnt, G, c; bool gather;
    __device__ bool next(int i, Unit& u) const {
        int mt, nt;
        if ((G & 7) == 0 && ((G >> 3) % nnt) == 0) {
            const int x = c & 7, j = c >> 3, per = (G >> 3) / nnt;
            mt = (i * 8 + x) * per + j / nnt; nt = j % nnt;
        } else { const long L = (long)i * G + c; mt = (int)(L / nnt); nt = (int)(L % nnt); }
        if (mt >= ntiles) return false;
        u.pm = mt; u.pn = nt; u.aux = tile_e[mt]; return true;
    }
    __device__ __forceinline__ const char* a_ptr(const Unit& u) const { return gather ? A : A + (size_t)u.pm * 256 * K * 2; }
    __device__ __forceinline__ const char* b_ptr(const Unit& u) const { return Bt + (size_t)u.aux * estride + (size_t)u.pn * 256 * K * 2; }
    __device__ __forceinline__ int gather_row(const Unit& u, int r) const { return rowtok[u.pm * 256 + r]; }
    __device__ __forceinline__ const void* gather_src(const Unit& u, int lane) const { return rowtok + u.pm * 256 + lane * 4; }
};

typedef int i32x4 __attribute__((ext_vector_type(4)));
typedef int i32x8 __attribute__((ext_vector_type(8)));
template <bool GATHER, bool FP8 = false, class Epi, class Sched>
__device__ __forceinline__ void gemm_phase(LAS unsigned char* lds, const int K_, const Sched& S, const Epi& E) {
    int K = K_; asm volatile("" : "+s"(K));
    const int tid = threadIdx.x, wid = __builtin_amdgcn_readfirstlane(tid >> 6), lane = tid & 63, wr = wid >> 2, wc = wid & 3, fr = lane & 15, fq = lane >> 4;
    const int nt = K / BK;
    unsigned voffA[2], voffB[2]; int Rr[2], Cc[2];
#pragma unroll
    for (int i = 0; i < 2; ++i) { int R, C; stage_rc(tid * 16 + i * 8192, R, C); const int Rb = (R & ~31) + perm32(R & 31);
        Rr[i] = R; Cc[i] = C; voffA[i] = (unsigned)(R * K + C) * 2u; voffB[i] = (unsigned)(Rb * K + C) * 2u; }
    const size_t kstep = (size_t)(BK * 2);
    const size_t hstep = (size_t)HALF * K * 2;
    const unsigned ldsw = (unsigned)wid * 1024u;
    const int aoff = lds_byte(wr * 64 + fr, fq * 8), boff = lds_byte(wc * 32 + fr, fq * 8);
    unsigned vgc[2][2], vgn[2][2];
    LAS unsigned char* const parbase = lds + STAGE_BYTES;
    constexpr int NPAR = Epi::NPAR;
#define G_PAR_ISSUE(unit, uidx, hasnx, nxunit) do { \
        LAS unsigned char* _ps = parbase + ((uidx) & 1) * 4096; \
        if (wid < NPAR) __builtin_amdgcn_global_load_lds((const unsigned*)E.par_src(unit, wid, lane), (LAS unsigned*)(_ps + wid * 1024), 16, 0, 0); \
        if (GATHER && (hasnx) && wid == NPAR) __builtin_amdgcn_global_load_lds((const unsigned*)S.gather_src(nxunit, lane), (LAS unsigned*)(_ps + NPAR * 1024), 16, 0, 0); } while (0)
#define G_CAT8(x0, x1) __builtin_shufflevector(__builtin_bit_cast(i32x4, x0), __builtin_bit_cast(i32x4, x1), 0, 1, 2, 3, 4, 5, 6, 7)
#define G_SA(b, h) (((b) * 2 + (h)) * HTB)
#define G_SB(b, h) ((4 + (b) * 2 + (h)) * HTB)
#define G_STAGE(bufoff, gbase, voff) do { _Pragma("unroll") for (int _i = 0; _i < 2; ++_i) \
        __builtin_amdgcn_global_load_lds((const unsigned*)((const char*)(gbase) + (voff)[_i]), (LAS unsigned*)(lds + (bufoff) + ldsw + _i * 8192), 16, 0, 0); } while (0)
#define G_STAGE_A(bufoff, kptr, h, VG) do { if (GATHER) { G_STAGE(bufoff, kptr, VG[h]); } else { G_STAGE(bufoff, (kptr) + (h) * hstep, voffA); } } while (0)
#define G_LDA(dst, b, h) do { _Pragma("unroll") for (int m = 0; m < 4; ++m) { \
        if (FP8) dst##8[m] = G_CAT8(*(const LAS bf16x8*)(lds + G_SA(b, h) + aoff + m * 2048), *(const LAS bf16x8*)(lds + G_SA(b, h) + aoff + m * 2048 + 1024)); \
        else { _Pragma("unroll") for (int k = 0; k < 2; ++k) dst[m][k] = *(const LAS bf16x8*)(lds + G_SA(b, h) + aoff + m * 2048 + k * 1024); } } } while (0)
#define G_LDB(dst, b, h) do { _Pragma("unroll") for (int n = 0; n < 2; ++n) { \
        if (FP8) dst##8[n] = G_CAT8(*(const LAS bf16x8*)(lds + G_SB(b, h) + boff + n * 2048), *(const LAS bf16x8*)(lds + G_SB(b, h) + boff + n * 2048 + 1024)); \
        else { _Pragma("unroll") for (int k = 0; k < 2; ++k) dst[n][k] = *(const LAS bf16x8*)(lds + G_SB(b, h) + boff + n * 2048 + k * 1024); } } } while (0)
#define G_MMA(ai, bj, At, Bt) do { __builtin_amdgcn_s_setprio(1); _Pragma("unroll") for (int m = 0; m < 4; ++m) _Pragma("unroll") for (int n = 0; n < 2; ++n) { \
        if (FP8) asm volatile("v_mfma_scale_f32_16x16x128_f8f6f4 %0, %1, %2, %0, %3, %3 op_sel_hi:[0,0,0]" : "+v"(acc[ai][bj][m][n]) : "v"(Bt##8[n]), "v"(At##8[m]), "v"(sc8)); \
        else { _Pragma("unroll") for (int k = 0; k < 2; ++k) acc[ai][bj][m][n] = __builtin_amdgcn_mfma_f32_16x16x32_bf16(Bt[n][k], At[m][k], acc[ai][bj][m][n], 0, 0, 0); } } \
        __builtin_amdgcn_s_setprio(0); } while (0)
#define G_WAIT_V(n) asm volatile("s_waitcnt vmcnt(" #n ")" ::: "memory")
#define G_WAIT_L(n) asm volatile("s_waitcnt lgkmcnt(" #n ")" ::: "memory")
#define G_BAR __builtin_amdgcn_s_barrier()
#define G_SCHED __builtin_amdgcn_sched_barrier(0)
    Unit cur, nxt;
    int ui = 0;
    if (!S.next(0, cur)) return;
    f32x4 acc[2][2][4][2];
#pragma unroll
    for (int a = 0; a < 2; ++a)
#pragma unroll
        for (int b = 0; b < 2; ++b)
#pragma unroll
            for (int m = 0; m < 4; ++m)
#pragma unroll
                for (int n = 0; n < 2; ++n) acc[a][b][m][n] = (f32x4){0.f, 0.f, 0.f, 0.f};
    bf16x8 At[4][2], B0[2][2], B1[2][2];
    i32x8 At8[4], B08[2], B18[2];
    int sc8 = 0x7F7F7F7F; asm volatile("" : "+v"(sc8));
    const char* cA = S.a_ptr(cur); const char* cB = S.b_ptr(cur);
    if (GATHER) {
#pragma unroll
        for (int h = 0; h < 2; ++h)
#pragma unroll
            for (int i = 0; i < 2; ++i) vgc[h][i] = (unsigned)(S.gather_row(cur, h * HALF + Rr[i]) * K + Cc[i]) * 2u;
    }
    { Unit n1; const bool hn1 = S.next(1, n1); G_PAR_ISSUE(cur, 0, hn1, n1); }
    G_STAGE(G_SB(0, 0), cB, voffB); G_STAGE_A(G_SA(0, 0), cA, 0, vgc); G_STAGE(G_SB(0, 1), cB + hstep, voffB); G_STAGE_A(G_SA(0, 1), cA, 1, vgc);
    if (wr == 1) G_BAR;
    G_WAIT_V(4); G_BAR;
    G_STAGE(G_SB(1, 0), cB + kstep, voffB); G_STAGE_A(G_SA(1, 0), cA + kstep, 0, vgc); G_STAGE(G_SB(1, 1), cB + hstep + kstep, voffB);
    G_WAIT_V(6); G_BAR;
    for (;;) {
        const bool has_next = S.next(ui + 1, nxt);
        const char* nA = has_next ? S.a_ptr(nxt) : cA; const char* nB = has_next ? S.b_ptr(nxt) : cB;
        if (ui > 0) G_PAR_ISSUE(cur, ui, has_next, nxt);
        if (GATHER) {
#pragma unroll
            for (int h = 0; h < 2; ++h)
#pragma unroll
                for (int i = 0; i < 2; ++i) vgn[h][i] = vgc[h][i];
        }
        for (int t = 0; t < nt; t += 2) {
            const bool last = (t == nt - 2);
            const char* a1 = cA + (size_t)(t + 1) * kstep;
            const char* a2 = last ? nA : cA + (size_t)(t + 2) * kstep; const char* b2 = last ? nB : cB + (size_t)(t + 2) * kstep;
            const char* a3 = a2 + kstep; const char* b3 = b2 + kstep;
            unsigned vg2[2][2];
            if (GATHER) {
#pragma unroll
                for (int h = 0; h < 2; ++h)
#pragma unroll
                    for (int i = 0; i < 2; ++i) vg2[h][i] = last ? vgn[h][i] : vgc[h][i];
            }
            G_LDB(B0, 0, 0); G_SCHED; G_LDA(At, 0, 0); G_STAGE_A(G_SA(1, 1), a1, 1, vgc);
            G_WAIT_L(8); G_BAR; G_WAIT_L(0); G_MMA(0, 0, At, B0); G_BAR; G_SCHED;
            G_LDB(B1, 0, 1); G_STAGE(G_SB(0, 0), b2, voffB);
            G_BAR; G_WAIT_L(0); G_MMA(0, 1, At, B1); G_BAR;
            G_LDA(At, 0, 1); G_STAGE_A(G_SA(0, 0), a2, 0, vg2);
            G_BAR; G_WAIT_L(0); G_MMA(1, 0, At, B0); G_BAR; G_SCHED;
            G_STAGE(G_SB(0, 1), b2 + hstep, voffB);
            G_WAIT_V(6); G_BAR; G_MMA(1, 1, At, B1); G_BAR;
            G_LDB(B0, 1, 0); G_SCHED; G_LDA(At, 1, 0); G_STAGE_A(G_SA(0, 1), a2, 1, vg2);
            G_WAIT_L(8); G_BAR; G_WAIT_L(0); G_MMA(0, 0, At, B0); G_BAR; G_SCHED;
            G_LDB(B1, 1, 1); G_STAGE(G_SB(1, 0), b3, voffB);
            G_BAR; G_WAIT_L(0); G_MMA(0, 1, At, B1); G_BAR;
            G_LDA(At, 1, 1); G_STAGE_A(G_SA(1, 0), a3, 0, vg2);
            G_BAR; G_WAIT_L(0); G_MMA(1, 0, At, B0); G_BAR; G_SCHED;
            G_STAGE(G_SB(1, 1), b3 + hstep, voffB);
            G_WAIT_V(6); G_BAR; G_MMA(1, 1, At, B1); G_BAR;
            if (GATHER && t == 0 && has_next) {
                const LAS int* rows = (const LAS int*)(parbase + (ui & 1) * 4096 + NPAR * 1024);
#pragma unroll
                for (int h = 0; h < 2; ++h)
#pragma unroll
                    for (int i = 0; i < 2; ++i) vgn[h][i] = (unsigned)(rows[h * HALF + Rr[i]] * K + Cc[i]) * 2u;
            }
        }
        if (FP8) asm volatile("s_nop 15\n\ts_nop 15" ::: "memory");
        const bool keep_acc = E(acc, cur, wr, wc, fr, fq, (const LAS unsigned char*)(parbase + (ui & 1) * 4096));
        if (!has_next) break;
        if (!keep_acc)
#pragma unroll
        for (int a = 0; a < 2; ++a)
#pragma unroll
            for (int b = 0; b < 2; ++b)
#pragma unroll
                for (int m = 0; m < 4; ++m)
#pragma unroll
                    for (int n = 0; n < 2; ++n) acc[a][b][m][n] = (f32x4){0.f, 0.f, 0.f, 0.f};
        cur = nxt; cA = nA; cB = nB; ++ui;
        if (GATHER) {
#pragma unroll
            for (int h = 0; h < 2; ++h)
#pragma unroll
                for (int i = 0; i < 2; ++i) vgc[h][i] = vgn[h][i];
        }
    }
    G_WAIT_V(0);
    if (wr == 0) G_BAR;
    G_BAR;
#undef G_PAR_ISSUE
#undef G_SA
#undef G_SB
#undef G_STAGE
#undef G_STAGE_A
#undef G_LDA
#undef G_LDB
#undef G_MMA
#undef G_CAT8
#undef G_WAIT_V
#undef G_WAIT_L
#undef G_BAR
#undef G_SCHED
}

struct EpiProj {
    bf16_t* prkv; bf16_t* pconv; unsigned char* gates; const float* rstd1; int pn0; float osc;
    static constexpr int NPAR = 1;
    __device__ __forceinline__ const void* par_src(const Unit& u, int, int lane) const { return rstd1 + NMETA + u.pm * BM + lane * 4; }
    __device__ __forceinline__ bool operator()(const f32x4 (&acc)[2][2][4][2], const Unit& u, int wr, int wc, int fr, int fq, const LAS unsigned char* par) const {
        const int row0 = u.pm * BM + wr * 64 + fr;
        const int pn = u.pn + pn0;
        const bool isg = pn >= 14, isu = pn >= 8 && pn < 12;
        float rsv[2][4];
#pragma unroll
        for (int ai = 0; ai < 2; ++ai)
#pragma unroll
            for (int m = 0; m < 4; ++m) rsv[ai][m] = ((const LAS float*)par)[wr * 64 + fr + ai * HALF + m * 16] * osc;
#pragma unroll
        for (int ai = 0; ai < 2; ++ai)
#pragma unroll
            for (int m = 0; m < 4; ++m) {
                const int row = row0 + ai * HALF + m * 16;
                const float rs = isg ? rsv[ai][m] * -1.44269504089f : rsv[ai][m]; const f32x2 rs2 = {rs, rs}, one2 = {1.0f, 1.0f};
                bf16_t* rowp = (pn < 6 ? prkv + (size_t)(NMETA + row) * 1536 + pn * 256 : pconv + (size_t)(NMETA + row) * 2048 + (pn - 6) * 256) + wc * 32 + 8 * fq;
                if (isu) {
                    const f32x4 c0 = acc[ai][0][m][0], c1 = acc[ai][0][m][1], h0 = acc[ai][1][m][0], h1 = acc[ai][1][m][1];
                    const f32x2 rr2 = rs2 * rs2;
                    const f32x2 p0 = (LO2(c0) * LO2(h0)) * rr2, p1 = (HI2(c0) * HI2(h0)) * rr2, p2 = (LO2(c1) * LO2(h1)) * rr2, p3 = (HI2(c1) * HI2(h1)) * rr2;
                    u32x4 w; w.x = cvt_pk_bf16(p0[0], p0[1]); w.y = cvt_pk_bf16(p1[0], p1[1]); w.z = cvt_pk_bf16(p2[0], p2[1]); w.w = cvt_pk_bf16(p3[0], p3[1]);
                    *(u32x4*)(pconv + (size_t)(NMETA + row) * 2048 + 512 + (pn - 8) * 128 + wc * 32 + 8 * fq) = w;
                } else
#pragma unroll
                for (int bj = 0; bj < 2; ++bj) {
                    const f32x4 a0 = acc[ai][bj][m][0], a1 = acc[ai][bj][m][1];
                    f32x2 p[4] = {LO2(a0) * rs2, HI2(a0) * rs2, LO2(a1) * rs2, HI2(a1) * rs2};
                    if (isg) {
                        unsigned wq[2] = {0u, 0u};
#pragma unroll
                        for (int q = 0; q < 4; ++q) {
                            const f32x2 e = {__builtin_amdgcn_exp2f(p[q][0]), __builtin_amdgcn_exp2f(p[q][1])}; const f32x2 d = e + one2;
                            const f32x2 sg = {__builtin_amdgcn_rcpf(d[0]), __builtin_amdgcn_rcpf(d[1])}, t = sg * (f32x2){255.0f, 255.0f};
                            wq[q >> 1] = __builtin_amdgcn_cvt_pk_u8_f32(fmaxf(__builtin_rintf(t[0]), 1.0f), 2 * (q & 1), wq[q >> 1]);
                            wq[q >> 1] = __builtin_amdgcn_cvt_pk_u8_f32(fmaxf(__builtin_rintf(t[1]), 1.0f), 2 * (q & 1) + 1, wq[q >> 1]);
                        }
                        u32x2 w8; w8.x = wq[0]; w8.y = wq[1];
                        *(u32x2*)((unsigned char*)gates + (size_t)row * 2048 + (pn - 14) * 256 + wc * 32 + 8 * fq + bj * HALF) = w8;
                        continue;
                    }
                    u32x4 w; w.x = cvt_pk_bf16(p[0][0], p[0][1]); w.y = cvt_pk_bf16(p[1][0], p[1][1]); w.z = cvt_pk_bf16(p[2][0], p[2][1]); w.w = cvt_pk_bf16(p[3][0], p[3][1]);
                    *(u32x4*)(rowp + bj * HALF) = w;
                }
            }
        return false;
    }
};
struct EpiL {
    static constexpr int NPAR = 0;
    __device__ __forceinline__ const void* par_src(const Unit&, int, int) const { return nullptr; }
    unsigned char* wsb; const float* w0; const float* a0;
    __device__ __forceinline__ bool operator()(const f32x4 (&acc)[2][2][4][2], const Unit& u, int wr, int wc, int fr, int fq, const LAS unsigned char* par) const {
        const int row0 = NMETA + u.pm * BM + wr * 64 + fr;
        const int seg = u.pn >> 1;
        const int cb = (u.pn & 1) * 256 + wc * 32 + 8 * fq;
        const float* bias = seg == 0 ? w0 : a0;
        f32x4 bv[2][2];
#pragma unroll
        for (int bj = 0; bj < 2; ++bj) {
            bv[bj][0] = seg < 2 ? *(const f32x4*)(bias + cb + bj * HALF) : (f32x4){0.f, 0.f, 0.f, 0.f};
            bv[bj][1] = seg < 2 ? *(const f32x4*)(bias + cb + bj * HALF + 4) : (f32x4){0.f, 0.f, 0.f, 0.f};
        }
        const float sc = seg == 0 ? -0.60653065971f : 1.0f;
        bf16_t* ob = (bf16_t*)(wsb + (seg == 0 ? OFF_LD : seg == 1 ? OFF_A : OFF_G));
#pragma unroll
        for (int ai = 0; ai < 2; ++ai)
#pragma unroll
            for (int m = 0; m < 4; ++m) {
                const int row = row0 + ai * HALF + m * 16;
#pragma unroll
                for (int bj = 0; bj < 2; ++bj) {
                    const int c = cb + bj * HALF;
                    f32x4 v0 = acc[ai][bj][m][0] + bv[bj][0], v1 = acc[ai][bj][m][1] + bv[bj][1];
                    if (seg < 2) {
#pragma unroll
                        for (int j = 0; j < 4; ++j) { v0[j] = sc * sigmoidf_(v0[j]); v1[j] = sc * sigmoidf_(v1[j]); }
                    }
                    {
                        u32x4 w; w.x = cvt_pk_bf16(v0[0], v0[1]); w.y = cvt_pk_bf16(v0[2], v0[3]); w.z = cvt_pk_bf16(v1[0], v1[1]); w.w = cvt_pk_bf16(v1[2], v1[3]);
                        *(u32x4*)(ob + (size_t)row * 512 + c) = w;
                    }
                }
            }
        return false;
    }
};
struct MergeOrder {
    StaticOrder so; const char* A1; const char* B1;
    __device__ bool next(int i, Unit& u) const { const bool ok = so.next(i >> 1, u); u.aux = i & 1; return ok; }
    __device__ __forceinline__ const char* a_ptr(const Unit& u) const { return (u.aux ? A1 : so.A) + (size_t)u.pm * 256 * so.K * 2; }
    __device__ __forceinline__ const char* b_ptr(const Unit& u) const { return (u.aux ? B1 : so.Bt) + (size_t)u.pn * 256 * so.K * 2; }
    __device__ __forceinline__ int gather_row(const Unit&, int) const { return 0; }
    __device__ __forceinline__ const void* gather_src(const Unit&, int) const { return nullptr; }
};
struct EpiMergeFused {
    static constexpr int NPAR = 0;
    __device__ __forceinline__ const void* par_src(const Unit&, int, int) const { return nullptr; }
    bf16_t* merged; const unsigned char* gates;
    __device__ __forceinline__ bool operator()(f32x4 (&acc)[2][2][4][2], const Unit& u, int wr, int wc, int fr, int fq, const LAS unsigned char* par) const {
        const int row0 = u.pm * BM + wr * 64 + fr, col0 = u.pn * BM + wc * 32 + 8 * fq;
#pragma unroll
        for (int ai = 0; ai < 2; ++ai) {
            u32x2 gbw[4][2], gaw[4][2];
#pragma unroll
            for (int m = 0; m < 4; ++m)
#pragma unroll
                for (int bj = 0; bj < 2; ++bj) {
                    const unsigned char* gp = gates + (size_t)(row0 + ai * HALF + m * 16) * 2048 + col0 + bj * HALF;
                    gbw[m][bj] = *(const u32x2*)(gp + 1024);
                    gaw[m][bj] = u.aux == 0 ? *(const u32x2*)gp : (u32x2){0u, 0u};
                }
#pragma unroll
            for (int m = 0; m < 4; ++m)
#pragma unroll
                for (int bj = 0; bj < 2; ++bj) {
                    const int row = row0 + ai * HALF + m * 16, c = col0 + bj * HALF;
                    f32x2 gbp[4], res[4];
#pragma unroll
                    for (int q = 0; q < 4; ++q) { const unsigned wq = gbw[m][bj][q >> 1] >> (16 * (q & 1)); gbp[q] = (f32x2){(float)(wq & 0xffu), (float)((wq >> 8) & 0xffu)}; }
                    if (u.aux == 0) {
#pragma unroll
                        for (int q = 0; q < 4; ++q) {
                            const unsigned wq = gaw[m][bj][q >> 1] >> (16 * (q & 1));
                            const f32x2 gap = {(float)(wq & 0xffu), (float)((wq >> 8) & 0xffu)}, rc = {__builtin_amdgcn_rcpf(gbp[q][0]), __builtin_amdgcn_rcpf(gbp[q][1])};
                            const f32x2 sc = gap * rc;
                            f32x4& a4 = acc[ai][bj][m][q >> 1];
                            if (q & 1) { const f32x2 t = HI2(a4) * sc; a4[2] = t[0]; a4[3] = t[1]; } else { const f32x2 t = LO2(a4) * sc; a4[0] = t[0]; a4[1] = t[1]; }
                        }
                    } else {
#pragma unroll
                        for (int q = 0; q < 4; ++q) { const f32x4 a4 = acc[ai][bj][m][q >> 1]; res[q] = ((q & 1) ? HI2(a4) : LO2(a4)) * (gbp[q] * (f32x2){1.0f / 255.0f, 1.0f / 255.0f}); }
                        u32x4 w; w.x = cvt_pk_bf16(res[0][0], res[0][1]); w.y = cvt_pk_bf16(res[1][0], res[1][1]); w.z = cvt_pk_bf16(res[2][0], res[2][1]); w.w = cvt_pk_bf16(res[3][0], res[3][1]);
                        *(u32x4*)(merged + (size_t)row * 1024 + c) = w;
                    }
                }
        }
        return u.aux == 0;
    }
};
struct EpiO {
    static constexpr int NPAR = 0;
    __device__ __forceinline__ const void* par_src(const Unit&, int, int) const { return nullptr; }
    const float* x; float* h1; bf16_t* hb2; unsigned char* hb8;
    __device__ __forceinline__ bool operator()(const f32x4 (&acc)[2][2][4][2], const Unit& u, int wr, int wc, int fr, int fq, const LAS unsigned char* par) const {
        const int row0 = u.pm * BM + wr * 64 + fr, col0 = u.pn * BM + wc * 32 + 8 * fq;
#pragma unroll
        for (int ai = 0; ai < 2; ++ai) {
            f32x4 xv[4][2][2];
#pragma unroll
            for (int m = 0; m < 4; ++m)
#pragma unroll
                for (int bj = 0; bj < 2; ++bj) {
                    const size_t o = (size_t)(row0 + ai * HALF + m * 16) * 1024 + col0 + bj * HALF;
                    xv[m][bj][0] = *(const f32x4*)(x + o); xv[m][bj][1] = *(const f32x4*)(x + o + 4);
                }
#pragma unroll
            for (int m = 0; m < 4; ++m)
#pragma unroll
                for (int bj = 0; bj < 2; ++bj) {
                    const size_t o = (size_t)(row0 + ai * HALF + m * 16) * 1024 + col0 + bj * HALF;
                    const f32x4 a0 = acc[ai][bj][m][0], a1 = acc[ai][bj][m][1];
                    const f32x2 p0 = LO2(a0) + LO2(xv[m][bj][0]), p1 = HI2(a0) + HI2(xv[m][bj][0]), p2 = LO2(a1) + LO2(xv[m][bj][1]), p3 = HI2(a1) + HI2(xv[m][bj][1]);
                    u32x4 w; w.x = cvt_pk_bf16(p0[0], p0[1]); w.y = cvt_pk_bf16(p1[0], p1[1]); w.z = cvt_pk_bf16(p2[0], p2[1]); w.w = cvt_pk_bf16(p3[0], p3[1]);
                    *(u32x4*)(hb2 + o) = w;
                    u32x2 w8; w8.x = pk4_fp8(p0[0], p0[1], p1[0], p1[1]); w8.y = pk4_fp8(p2[0], p2[1], p3[0], p3[1]);
                    *(u32x2*)(hb8 + o) = w8;
                }
        }
        return false;
    }
};
struct EpiMoe1 {
    unsigned char* act; const float* rowrs; const float* bg; const float* bu;
    static constexpr int NPAR = 2;
    __device__ __forceinline__ const void* par_src(const Unit& u, int piece, int lane) const {
        if (piece == 0) return rowrs + u.pm * BM + lane * 4;
        return (lane < 32 ? bg : bu) + (size_t)u.aux * DFF + u.pn * 128 + (lane & 31) * 4;
    }
    __device__ __forceinline__ bool operator()(const f32x4 (&acc)[2][2][4][2], const Unit& u, int wr, int wc, int fr, int fq, const LAS unsigned char* par) const {
        const int row0 = u.pm * BM + wr * 64 + fr, ff0 = u.pn * 128 + wc * 32 + 8 * fq;
        const LAS float* bgp = (const LAS float*)(par + 1024) + wc * 32 + 8 * fq; const LAS float* bup = bgp + 128;
        const f32x4 bg0 = *(const LAS f32x4*)bgp, bg1 = *(const LAS f32x4*)(bgp + 4), bu0 = *(const LAS f32x4*)bup, bu1 = *(const LAS f32x4*)(bup + 4);
        constexpr float KE = -1.702f * 1.44269504089f;
        const f32x2 ke2 = {KE, KE}, ike2 = {1.0f / KE, 1.0f / KE}, one2 = {1.0f, 1.0f};
        const f32x2 bgv[4] = {LO2(bg0) * ke2, HI2(bg0) * ke2, LO2(bg1) * ke2, HI2(bg1) * ke2}, buv[4] = {LO2(bu0), HI2(bu0), LO2(bu1), HI2(bu1)};
        float rsv[2][4];
#pragma unroll
        for (int ai = 0; ai < 2; ++ai)
#pragma unroll
            for (int m = 0; m < 4; ++m) rsv[ai][m] = ((const LAS float*)par)[wr * 64 + fr + ai * HALF + m * 16];
#pragma unroll
        for (int ai = 0; ai < 2; ++ai)
#pragma unroll
            for (int m = 0; m < 4; ++m) {
                const int row = row0 + ai * HALF + m * 16;
                const float rs = rsv[ai][m] * W8_INV;
                const f32x2 rs2 = {rs, rs}, rsk2 = {rs * KE, rs * KE};
                f32x2 res[4];
#pragma unroll
                for (int q = 0; q < 4; ++q) {
                    const f32x4 ag4 = acc[ai][0][m][q >> 1], au4 = acc[ai][1][m][q >> 1];
                    const f32x2 ag = (q & 1) ? HI2(ag4) : LO2(ag4), au = (q & 1) ? HI2(au4) : LO2(au4);
                    const f32x2 gk = ag * rsk2 + bgv[q], uu = au * rs2 + buv[q];
                    const f32x2 z = {fmaxf(gk[0], 7.0f * KE), fmaxf(gk[1], 7.0f * KE)};
                    const f32x2 up = {fminf(fmaxf(uu[0], -7.0f), 7.0f), fminf(fmaxf(uu[1], -7.0f), 7.0f)};
                    const f32x2 e = {__builtin_amdgcn_exp2f(z[0]), __builtin_amdgcn_exp2f(z[1])};
                    const f32x2 d = e + one2;
                    const f32x2 sg = {__builtin_amdgcn_rcpf(d[0]), __builtin_amdgcn_rcpf(d[1])};
                    res[q] = ((up * ike2 + ike2) * z) * sg;
                }
                u32x2 w; w.x = pk4_fp8(res[0][0], res[0][1], res[1][0], res[1][1]); w.y = pk4_fp8(res[2][0], res[2][1], res[3][0], res[3][1]);
                *(u32x2*)(act + (size_t)row * DFF + ff0) = w;
            }
        return false;
    }
};
struct EpiMoe2 {
    unsigned char* y8; const int* rowslot; const float* roww; const float* bd;
    static constexpr int NPAR = 3;
    __device__ __forceinline__ const void* par_src(const Unit& u, int piece, int lane) const {
        if (piece == 0) return rowslot + u.pm * BM + lane * 4;
        if (piece == 1) return roww + u.pm * BM + lane * 4;
        return bd + (size_t)u.aux * D + u.pn * BM + lane * 4;
    }
    __device__ __forceinline__ bool operator()(const f32x4 (&acc)[2][2][4][2], const Unit& u, int wr, int wc, int fr, int fq, const LAS unsigned char* par) const {
        const int row0 = u.pm * BM + wr * 64 + fr, col0 = u.pn * BM + wc * 32 + 8 * fq;
        const LAS float* bp = (const LAS float*)(par + 2048) + wc * 32 + 8 * fq;
        f32x4 bv[2][2];
#pragma unroll
        for (int bj = 0; bj < 2; ++bj) { bv[bj][0] = *(const LAS f32x4*)(bp + bj * HALF); bv[bj][1] = *(const LAS f32x4*)(bp + bj * HALF + 4); }
        int slotv[2][4]; float wv8[2][4];
#pragma unroll
        for (int ai = 0; ai < 2; ++ai)
#pragma unroll
            for (int m = 0; m < 4; ++m) { const int rl = wr * 64 + fr + ai * HALF + m * 16; slotv[ai][m] = ((const LAS int*)par)[rl]; wv8[ai][m] = ((const LAS float*)(par + 1024))[rl]; }
#pragma unroll
        for (int ai = 0; ai < 2; ++ai)
#pragma unroll
            for (int m = 0; m < 4; ++m) {
                const int slot = slotv[ai][m];
                if (slot >= 0) {
                    const float w8 = wv8[ai][m]; const f32x2 w2 = {w8, w8}, inv2 = {W8_INV, W8_INV};
#pragma unroll
                    for (int bj = 0; bj < 2; ++bj) {
                        const f32x4 a0 = acc[ai][bj][m][0], a1 = acc[ai][bj][m][1];
                        const f32x2 p0 = (LO2(a0) * inv2 + LO2(bv[bj][0])) * w2, p1 = (HI2(a0) * inv2 + HI2(bv[bj][0])) * w2, p2 = (LO2(a1) * inv2 + LO2(bv[bj][1])) * w2, p3 = (HI2(a1) * inv2 + HI2(bv[bj][1])) * w2;
                        u32x2 w; w.x = pk4_fp8(p0[0], p0[1], p1[0], p1[1]); w.y = pk4_fp8(p2[0], p2[1], p3[0], p3[1]);
                        *(u32x2*)(y8 + (size_t)slot * 1024 + col0 + bj * HALF) = w;
                    }
                }
            }
        return false;
    }
};

__device__ __forceinline__ void transpose_tile(LAS float* tile, const float* src, int ldsrc, int k0, int n0, bf16_t* dst, int ldd, int drow0, const float* sa, const float* mu, int mode, bool zero, unsigned char* dst8 = nullptr, int drow8 = 0) {
    const int tid = threadIdx.x;
    if (!zero) {
#pragma unroll
        for (int i = 0; i < 2; ++i) {
            const int r = (tid >> 4) + 32 * i, c4 = (tid & 15) * 4;
            const f32x4 v = *(const f32x4*)(src + (size_t)(k0 + r) * ldsrc + n0 + c4);
            LAS float* t = tile + r * 65 + c4;
            t[0] = v[0]; t[1] = v[1]; t[2] = v[2]; t[3] = v[3];
        }
    }
    __syncthreads();
    {
        const int n = tid >> 3, kq = tid & 7;
        float v[8];
#pragma unroll
        for (int j = 0; j < 8; ++j) {
            const int k = k0 + 8 * kq + j;
            float s = sa ? sa[k] : 1.0f;
            if (mode == 1) s *= (1.0f - mu[k]);
            if (mode == 2) s *= mu[k];
            v[j] = zero ? 0.f : tile[(8 * kq + j) * 65 + n] * s;
        }
        u32x4 w; w.x = cvt_pk_bf16(v[0], v[1]); w.y = cvt_pk_bf16(v[2], v[3]); w.z = cvt_pk_bf16(v[4], v[5]); w.w = cvt_pk_bf16(v[6], v[7]);
        *(u32x4*)(dst + (size_t)(drow0 + n) * ldd + k0 + 8 * kq) = w;
        if (dst8) { u32x2 w8; w8.x = pk4_fp8(v[0] * W8_SCALE, v[1] * W8_SCALE, v[2] * W8_SCALE, v[3] * W8_SCALE); w8.y = pk4_fp8(v[4] * W8_SCALE, v[5] * W8_SCALE, v[6] * W8_SCALE, v[7] * W8_SCALE); *(u32x2*)(dst8 + (size_t)(drow8 + n) * ldd + k0 + 8 * kq) = w8; }
    }
    __syncthreads();
}

__device__ __forceinline__ void phase_prep(const PPv& p, LAS unsigned char* lds) {
    const int tid = threadIdx.x, bid = blockIdx.x, nb = gridDim.x, lane = tid & 63, wave = tid >> 6;
    unsigned char* ws = p.gws();
    const float* x = p.gin(0); const float* meta = p.gin(1); const float* g1 = p.gin(2);
    if (bid == 0 && tid < 64) ((int*)(ws + OFF_GCNT))[tid] = 0;
    {
        bf16_t* HB = (bf16_t*)(ws + OFF_HB); float* rstd1 = (float*)(ws + OFF_RSTD1);
        for (int row0 = (bid * 8 + wave) * 4; row0 < NR; row0 += nb * 32) {
            f32x4 v[4][4];
#pragma unroll
            for (int u = 0; u < 4; ++u) {
                const int row = row0 + u < NR ? row0 + u : NR - 1;
                const float* src = row < NMETA ? meta + (size_t)row * D : x + (size_t)(row - NMETA) * D;
#pragma unroll
                for (int i = 0; i < 4; ++i) v[u][i] = __builtin_nontemporal_load((const f32x4*)(src + i * 256 + lane * 4));
            }
#pragma unroll
            for (int u = 0; u < 4; ++u) {
                const int row = row0 + u;
                if (row < NR) {
                    float ss = 0.f;
#pragma unroll
                    for (int i = 0; i < 4; ++i) ss += v[u][i][0] * v[u][i][0] + v[u][i][1] * v[u][i][1] + v[u][i][2] * v[u][i][2] + v[u][i][3] * v[u][i][3];
                    ss = wave_sum_dpp(ss);
                    if (lane == 0) rstd1[row] = rsqrtf(ss * (1.0f / D) + NORM_EPS);
                    if (row >= NMETA) {
                        bf16_t* d = HB + (size_t)(row - NMETA) * D;
#pragma unroll
                        for (int i = 0; i < 4; ++i) { u32x2 w; w.x = cvt_pk_bf16(v[u][i][0], v[u][i][1]); w.y = cvt_pk_bf16(v[u][i][2], v[u][i][3]); *(u32x2*)(d + i * 256 + lane * 4) = w;
                            *(unsigned*)(ws + OFF_X8 + (size_t)(row - NMETA) * D + i * 256 + lane * 4) = pk4_fp8(v[u][i][0], v[u][i][1], v[u][i][2], v[u][i][3]); }
                    }
                }
            }
        }
    }
    LAS float* tile = (LAS float*)lds;
    {
        bf16_t* WIN = (bf16_t*)(ws + OFF_WIN);
        const float* w_in = p.gin(3);
        for (int j = bid; j < 16 * 88; j += nb) {
            const int kt = j & 15, ntile = j >> 4, n0 = ntile * 64;
            const float* src; int ld, sn0, mode = 0; const float* mu = nullptr;
            if (n0 < 3072) { src = w_in; ld = 5120; sn0 = n0;
                if (n0 >= 2048) { const int qq = (n0 - 2048) >> 8, j0 = (n0 - 2048) & 255; sn0 = j0 < 128 ? 2048 + qq * 128 + j0 : 2560 + qq * 128 + (j0 - 128); } }
            else if (n0 < 3584) {
                const int seg = (n0 - 3072) >> 6;
                if (seg < 2) { src = p.gin(11); ld = 64; sn0 = 0; mu = p.gin(7); mode = 1 + seg; }
                else if (seg < 4) { src = p.gin(14); ld = 64; sn0 = 0; mu = p.gin(8); mode = 1 + (seg - 2); }
                else { src = p.gin(16); ld = 128; sn0 = (seg & 1) * 64; mu = p.gin(9); mode = seg < 6 ? 1 : 2; }
            } else { src = w_in; ld = 5120; sn0 = n0 - 512; }
            transpose_tile(tile, src, ld, kt * 64, sn0, WIN, 1024, n0, g1, mu, mode, false, n0 >= 3584 ? ws + OFF_WIN8 : nullptr, n0 - 3584);
        }
        for (int j = bid; j < 2 * 128; j += nb) {
            const int which = j >> 7, jj = j & 127, kt = jj & 7, ntile = jj >> 3;
            transpose_tile(tile, which ? p.gin(25) : p.gin(23), 1024, kt * 64, ntile * 64, (bf16_t*)(ws + (which ? OFF_WC : OFF_WR)), 512, ntile * 64, nullptr, nullptr, 0, false);
        }
        for (int j = bid; j < 256; j += nb) {
            const int kt = j & 15, ntile = j >> 4;
            transpose_tile(tile, p.gin(26), 1024, kt * 64, ntile * 64, (bf16_t*)(ws + OFF_WO), 1024, ntile * 64, nullptr, nullptr, 0, false);
        }
        for (int j = bid; j < 96; j += nb) {
            const int kt = j & 3, ntile = j >> 2, seg = ntile >> 3, nn0 = (ntile & 7) * 64;
            const float* src = nullptr; int sk0 = 0; bool zero = true;
            if (seg == 0 && kt == 0) { src = p.gin(12); sk0 = 0; zero = false; }
            if (seg == 1 && kt == 1) { src = p.gin(15); sk0 = 0; zero = false; }
            if (seg == 2 && kt >= 2) { src = p.gin(17); sk0 = (kt - 2) * 64; zero = false; }
            const float* srcs = zero ? p.gin(12) : src + (size_t)(sk0 - kt * 64) * 512;
            transpose_tile(tile, srcs, 512, kt * 64, nn0, (bf16_t*)(ws + OFF_W2), 256, ntile * 64, nullptr, nullptr, 0, zero);
        }
        {
            float* WRG = (float*)(ws + OFF_WRG); const float* g2 = p.gin(27); const float* wr_ = p.gin(28);
            for (int i = bid * 512 + tid; i < 1024 * 32; i += nb * 512) WRG[i] = g2[i >> 5] * wr_[i];
        }
    }
}

__device__ __forceinline__ void phase_meta_proj(const PPv& p, LAS unsigned char* lds) {
    const int tid = threadIdx.x, bid = blockIdx.x, lane = tid & 63, wave = tid >> 6;
    unsigned char* ws = p.gws();
    LAS float* sm = (LAS float*)lds;
    const float* meta = p.gin(1);
    for (int i = tid; i < 16 * 256; i += 512) { const int r = i >> 8, c4 = (i & 255) * 4; const f32x4 v = *(const f32x4*)(meta + r * 1024 + c4); LAS float* d = sm + r * 1028 + c4; d[0] = v[0]; d[1] = v[1]; d[2] = v[2]; d[3] = v[3]; }
    __syncthreads();
    const float* rstd1 = (const float*)(ws + OFF_RSTD1);
    for (int nbase = bid * 14; nbase < PCOLS1; nbase += gridDim.x * 14) {
        for (int nn = wave; nn < 14; nn += 8) {
            const int n = nbase + nn;
            if (n >= PCOLS1) break;
            const bool inu = n >= 2048 && n < 3072;
            if (inu && ((n - 2048) & 128)) continue;
            float outp = 1.0f;
#pragma unroll 1
            for (int rep = 0; rep < (inu ? 2 : 1); ++rep) {
            const bf16_t* wrow = (const bf16_t*)(ws + OFF_WIN) + (size_t)(n + rep * 128) * 1024;
            const u32x4 w0 = *(const u32x4*)(wrow + 8 * lane), w1 = *(const u32x4*)(wrow + 512 + 8 * lane);
            const float wf[16] = {bflo(w0.x), bfhi(w0.x), bflo(w0.y), bfhi(w0.y), bflo(w0.z), bfhi(w0.z), bflo(w0.w), bfhi(w0.w),
                                  bflo(w1.x), bfhi(w1.x), bflo(w1.y), bfhi(w1.y), bflo(w1.z), bfhi(w1.z), bflo(w1.w), bfhi(w1.w)};
            float outv = 0.f;
#pragma unroll
            for (int pr = 0; pr < 16; ++pr) {
                const LAS float* m0 = sm + pr * 1028 + 8 * lane;
                const f32x4 a0 = *(const LAS f32x4*)m0, a1 = *(const LAS f32x4*)(m0 + 4), a2 = *(const LAS f32x4*)(m0 + 512), a3 = *(const LAS f32x4*)(m0 + 516);
                float acc = a0[0] * wf[0] + a0[1] * wf[1] + a0[2] * wf[2] + a0[3] * wf[3] + a1[0] * wf[4] + a1[1] * wf[5] + a1[2] * wf[6] + a1[3] * wf[7]
                          + a2[0] * wf[8] + a2[1] * wf[9] + a2[2] * wf[10] + a2[3] * wf[11] + a3[0] * wf[12] + a3[1] * wf[13] + a3[2] * wf[14] + a3[3] * wf[15];
                acc = wave_sum_dpp(acc);
                outv = (lane == pr) ? acc * rstd1[pr] : outv;
            }
            outp *= outv;
            }
            if (lane < 16) {
                if (n < 1536) ((bf16_t*)(ws + OFF_PRKV))[(size_t)lane * 1536 + n] = f2bf(outp);
                else if (inu) ((bf16_t*)(ws + OFF_PCONV))[(size_t)lane * 2048 + 512 + ((n - 2048) >> 8) * 128 + ((n - 2048) & 127)] = f2bf(outp);
                else ((bf16_t*)(ws + OFF_PCONV))[(size_t)lane * 2048 + n - 1536] = f2bf(outp);
            }
        }
    }
    __syncthreads();
}

__device__ __forceinline__ void phase_meta_lora(const PPv& p) {
    const int tid = threadIdx.x, bid = blockIdx.x, nb = gridDim.x, lane = tid & 63, wave = tid >> 6;
    unsigned char* ws = p.gws();
    const bf16_t* L = (const bf16_t*)(ws + OFF_L); const bf16_t* W2 = (const bf16_t*)(ws + OFF_W2);
    for (int n = bid * 8 + wave; n < 1536; n += nb * 8) {
        const int seg = n >> 9, c = n & 511;
        const u32x2 wv = *(const u32x2*)(W2 + (size_t)n * 256 + 4 * lane);
        const float w0v = bflo(wv.x), w1v = bfhi(wv.x), w2v = bflo(wv.y), w3v = bfhi(wv.y);
        float outv = 0.f;
#pragma unroll
        for (int r = 0; r < 16; ++r) {
            const u32x2 lv = *(const u32x2*)(L + (size_t)r * 256 + 4 * lane);
            float acc = bflo(lv.x) * w0v + bfhi(lv.x) * w1v + bflo(lv.y) * w2v + bfhi(lv.y) * w3v;
            acc = wave_sum_dpp(acc);
            outv = (lane == r) ? acc : outv;
        }
        if (lane < 16) {
            float v = outv;
            if (seg == 0) v = -0.60653065971f * sigmoidf_(v + p.gin(10)[c]);
            if (seg == 1) v = sigmoidf_(v + p.gin(13)[c]);
            bf16_t* ob = (bf16_t*)(ws + (seg == 0 ? OFF_LD : seg == 1 ? OFF_A : OFF_G));
            ob[(size_t)lane * 512 + c] = f2bf(v);
        }
    }
}

__device__ __forceinline__ void phase_lprep_conv(const PPv& p) {
    const int tid = threadIdx.x, bid = blockIdx.x, nb = gridDim.x;
    unsigned char* ws = p.gws();
    const bf16_t* PROJ = (const bf16_t*)(ws + OFF_PCONV);
    constexpr int PCOLS = 2048;
    bf16_t* L = (bf16_t*)(ws + OFF_L);
    for (int i = bid * 512 + tid; i < NRP * 32; i += nb * 512) {
        const int row = i >> 5, gq = i & 31;
        u32x4 w = (u32x4){0u, 0u, 0u, 0u};
        if (row < NR) {
            int ca, cb;
            if (gq < 8) { ca = 1536 + gq * 8; cb = ca + 64; }
            else if (gq < 16) { ca = 1536 + 128 + (gq - 8) * 8; cb = ca + 64; }
            else { ca = 1536 + 256 + (gq - 16) * 8; cb = ca + 128; }
            const u32x4 va = *(const u32x4*)(PROJ + (size_t)row * PCOLS + ca);
            const int pr = prev_row(row, 1);
            u32x4 vb = (u32x4){0u, 0u, 0u, 0u};
            if (pr >= 0) vb = *(const u32x4*)(PROJ + (size_t)pr * PCOLS + cb);
            float v[8] = {bflo(va.x) + bflo(vb.x), bfhi(va.x) + bfhi(vb.x), bflo(va.y) + bflo(vb.y), bfhi(va.y) + bfhi(vb.y), bflo(va.z) + bflo(vb.z), bfhi(va.z) + bfhi(vb.z), bflo(va.w) + bflo(vb.w), bfhi(va.w) + bfhi(vb.w)};
#pragma unroll
            for (int j = 0; j < 8; ++j) { if (gq < 8) v[j] = tanhf(v[j]); else if (gq >= 16) v[j] = sigmoidf_(v[j]); }
            w.x = cvt_pk_bf16(v[0], v[1]); w.y = cvt_pk_bf16(v[2], v[3]); w.z = cvt_pk_bf16(v[4], v[5]); w.w = cvt_pk_bf16(v[6], v[7]);
        }
        *(u32x4*)(L + (size_t)row * 256 + gq * 8) = w;
    }
    bf16_t* C = (bf16_t*)(ws + OFF_C);
    const float* cw = p.gin(24);
    for (int i = bid * 512 + tid; i < T * 64; i += nb * 512) {
        const int m = i >> 6, ch = (i & 63) * 8, row = NMETA + m;
        const int r1 = prev_row(row, 1), r2 = prev_row(row, 2);
        const bf16_t* p0 = PROJ + (size_t)row * PCOLS; const bf16_t* p1 = PROJ + (size_t)r1 * PCOLS; const bf16_t* p2 = PROJ + (size_t)r2 * PCOLS;
        const u32x4 vb = *(const u32x4*)(p0 + ch);
        const u32x4 c0 = *(const u32x4*)(p0 + 512 + ch), c1 = *(const u32x4*)(p1 + 512 + ch), c2 = *(const u32x4*)(p2 + 512 + ch);
        float o[8];
#pragma unroll
        for (int j = 0; j < 8; ++j) {
            const unsigned wb = j < 2 ? vb.x : j < 4 ? vb.y : j < 6 ? vb.z : vb.w;
            const unsigned wc0 = j < 2 ? c0.x : j < 4 ? c0.y : j < 6 ? c0.z : c0.w;
            const unsigned wc1 = j < 2 ? c1.x : j < 4 ? c1.y : j < 6 ? c1.z : c1.w;
            const unsigned wc2 = j < 2 ? c2.x : j < 4 ? c2.y : j < 6 ? c2.z : c2.w;
            const bool hi = j & 1;
            const float b = hi ? bfhi(wb) : bflo(wb);
            const float u0 = hi ? bfhi(wc0) : bflo(wc0), u1 = hi ? bfhi(wc1) : bflo(wc1), u2 = hi ? bfhi(wc2) : bflo(wc2);
            const float conv = cw[ch + j] * u2 + cw[512 + ch + j] * u1 + cw[1024 + ch + j] * u0;
            o[j] = b * conv;
        }
        u32x4 w; w.x = cvt_pk_bf16(o[0], o[1]); w.y = cvt_pk_bf16(o[2], o[3]); w.z = cvt_pk_bf16(o[4], o[5]); w.w = cvt_pk_bf16(o[6], o[7]);
        *(u32x4*)(C + (size_t)m * 512 + ch) = w;
    }
}

template <int CTRL> __device__ __forceinline__ float dppmov(float v) { return __builtin_bit_cast(float, __builtin_amdgcn_update_dpp(0, __builtin_bit_cast(int, v), CTRL, 0xF, 0xF, true)); }
__device__ __forceinline__ float wave_sum_dpp(float v) {
    v += dppmov<0xB1>(v);
    v += dppmov<0x4E>(v);
    v += dppmov<0x141>(v);
    v += dppmov<0x140>(v);
    { float c = v; asm volatile("v_nop\n\tv_nop\n\tv_permlane16_swap_b32 %0, %1\n\tv_nop" : "+v"(v), "+v"(c)); v += c; }
    { float c = v; asm volatile("v_nop\n\tv_nop\n\tv_permlane32_swap_b32 %0, %1\n\tv_nop" : "+v"(v), "+v"(c)); v += c; }
    return v;
}
typedef float f32x16 __attribute__((ext_vector_type(16)));

struct RawTok { bf16_t r, k, v, a, ld; };
__device__ __forceinline__ RawTok load_raw(const bf16_t* PRKV, const bf16_t* Ab, const bf16_t* LD, int row, int col) {
    RawTok q; const bf16_t* p0 = PRKV + (size_t)row * 1536 + col;
    q.r = p0[0]; q.k = p0[512]; q.v = p0[1024]; q.a = Ab[(size_t)row * 512 + col]; q.ld = LD[(size_t)row * 512 + col];
    return q;
}
__device__ __forceinline__ void unit_geom(int uid, int lane, int& b, int& h, int& c, int& col, int& row0) {
    const int bh = uid / NCHUNK; c = uid - bh * NCHUNK; b = bh >> 3; h = bh & 7; col = h * 64 + lane;
    row0 = c == 0 ? 0 : b * SEQ + c * 16;
}
__device__ __forceinline__ void phase_scanprep(const PPv& p, LAS unsigned char* lds) {
    const int tid = threadIdx.x, bid = blockIdx.x, nb = gridDim.x, lane = tid & 63, wave = tid >> 6;
    unsigned char* ws = p.gws();
    const bf16_t* PRKV = (const bf16_t*)(ws + OFF_PRKV);
    const bf16_t* LD = (const bf16_t*)(ws + OFF_LD);
    const bf16_t* Ab = (const bf16_t*)(ws + OFF_A);
    float* COEF = (float*)(ws + OFF_COEF);
    LAS unsigned char* wl = lds + wave * 13824;
    LAS bf16_t* AR = (LAS bf16_t*)wl;
    LAS bf16_t* BK = (LAS bf16_t*)(wl + 4608);
    LAS float* DM = (LAS float*)(wl + 9216);
    const int qperm = (lane & 32) | (((lane >> 2) & 3) << 3) | (((lane >> 4) & 1) << 2) | (lane & 3);
    int uid = bid * 8 + wave;
    if (uid >= NUNITS) return;
    int b, h, c, col, row0;
    unit_geom(uid, lane, b, h, c, col, row0);
    RawTok q[16], qn[16];
    bf16_t prr = 0, prk = 0, prv = 0, nprr = 0, nprk = 0, nprv = 0;
#pragma unroll
    for (int t = 0; t < 16; ++t) q[t] = load_raw(PRKV, Ab, LD, row0 + t, col);
    { const int pr = prev_row(row0, 1); if (pr >= 0) { const bf16_t* p1 = PRKV + (size_t)pr * 1536 + col; prr = p1[0]; prk = p1[512]; prv = p1[1024]; } }
    for (;;) {
        const float mur = p.gin(4)[col], muk = p.gin(5)[col], muv = p.gin(6)[col], kkw = p.gin(18)[col], kaw = p.gin(19)[col], rkw = p.gin(20)[col];
        const int nuid = uid + nb * 8; const bool has_next = nuid < NUNITS;
        int nb_ = b, nh = h, nc = c, ncol = col, nrow0 = row0;
        if (has_next) {
            unit_geom(nuid, lane, nb_, nh, nc, ncol, nrow0);
#pragma unroll
            for (int t = 0; t < 16; ++t) qn[t] = load_raw(PRKV, Ab, LD, nrow0 + t, ncol);
            nprr = 0; nprk = 0; nprv = 0;
            const int pr = prev_row(nrow0, 1); if (pr >= 0) { const bf16_t* p1 = PRKV + (size_t)pr * 1536 + ncol; nprr = p1[0]; nprk = p1[512]; nprv = p1[1024]; }
        }
        __builtin_amdgcn_sched_barrier(0);
        LAS float* PM = (LAS float*)wl;
        LAS float* RS = DM;
        {
            float rp = bf2f(prr), kp = bf2f(prk);
#pragma unroll
            for (int t = 0; t < 16; ++t) {
                const RawTok qq = q[t];
                const float r0 = bf2f(qq.r), k0 = bf2f(qq.k);
                const float r = r0 + (rp - r0) * mur, k = k0 + (kp - k0) * muk;
                rp = r0; kp = k0;
                const float a = bf2f(qq.a);
                const float kkv = k * kkw, k2 = k * (1.0f + (a - 1.0f) * kaw);
                PM[t * 68 + lane] = kkv * kkv; PM[(16 + t) * 68 + lane] = r * k2 * rkw;
            }
            asm volatile("" ::: "memory");
            const int rw = lane & 31, hf = lane >> 5;
            f32x4 s4 = (f32x4){0.f, 0.f, 0.f, 0.f};
#pragma unroll
            for (int i = 0; i < 8; ++i) s4 += *(const LAS f32x4*)(PM + rw * 68 + hf * 32 + i * 4);
            float sm = (s4[0] + s4[1]) + (s4[2] + s4[3]);
            { float c2 = sm; asm volatile("v_nop\n\tv_nop\n\tv_permlane32_swap_b32 %0, %1\n\tv_nop" : "+v"(sm), "+v"(c2)); sm += c2; }
            if (lane < 32) RS[lane] = sm;
            asm volatile("" ::: "memory");
            const float cfl = __shfl(sm, (lane & 15) + 16);
            if (lane < 16) COEF[(size_t)(row0 + lane) * 8 + h] = cfl;
        }
        __builtin_amdgcn_sched_barrier(0);
        float at[16], vt[16]; unsigned btp[8], ktp[8]; float bprev = 0.f, kprev = 0.f;
        float cl = 0.f;
        float rp = bf2f(prr), kp = bf2f(prk), vp = bf2f(prv);
        f32x4 n2v[4];
#pragma unroll
        for (int i = 0; i < 4; ++i) n2v[i] = *(const LAS f32x4*)(RS + 4 * i);
        asm volatile("" ::: "memory"); __builtin_amdgcn_sched_barrier(0);
#pragma unroll
        for (int t = 0; t < 16; ++t) {
            const RawTok qq = q[t];
            const float r0 = bf2f(qq.r), k0 = bf2f(qq.k), v0 = bf2f(qq.v);
            const float r = r0 + (rp - r0) * mur, k = k0 + (kp - k0) * muk, v = v0 + (vp - v0) * muv;
            rp = r0; kp = k0; vp = v0;
            const float a = bf2f(qq.a);
            const float kkv = k * kkw;
            const float kk = kkv * __builtin_amdgcn_rsqf(fmaxf(n2v[t >> 2][t & 3], 1e-24f));
            const float k2 = k * (1.0f + (a - 1.0f) * kaw);
            const float wcp = __expf(cl);
            cl += bf2f(qq.ld);
            const float wcn = __expf(cl), iw = __expf(-cl);
            const float btv = kk * a * iw, ktv = k2 * iw;
            at[t] = -kk * wcp; vt[t] = v;
            { const unsigned w = cvt_pk_bf16(at[t], r * wcn); AR[t * 72 + qperm] = (bf16_t)(w & 0xFFFFu); AR[(16 + t) * 72 + qperm] = (bf16_t)(w >> 16); }
            if (t & 1) {
                btp[t >> 1] = cvt_pk_bf16(bprev, btv); ktp[t >> 1] = cvt_pk_bf16(kprev, ktv);
                BK[(t - 1) * 72 + qperm] = (bf16_t)(btp[t >> 1] & 0xFFFFu); BK[t * 72 + qperm] = (bf16_t)(btp[t >> 1] >> 16);
                BK[(16 + t - 1) * 72 + qperm] = (bf16_t)(ktp[t >> 1] & 0xFFFFu); BK[(16 + t) * 72 + qperm] = (bf16_t)(ktp[t >> 1] >> 16);
            } else { bprev = btv; kprev = ktv; }
            if ((t & 3) == 3) __builtin_amdgcn_sched_barrier(0);
        }
        const float wcc = __expf(cl);
        {
            f32x16 dm;
#pragma unroll
            for (int i = 0; i < 16; ++i) dm[i] = 0.f;
            const int rr = lane & 31, hh = lane >> 5;
#pragma unroll
            for (int ks = 0; ks < 4; ++ks) {
                const bf16x8 fa = *(const LAS bf16x8*)(AR + rr * 72 + 16 * ks + 8 * hh);
                const bf16x8 fb = *(const LAS bf16x8*)(BK + rr * 72 + 16 * ks + 8 * hh);
                dm = __builtin_amdgcn_mfma_f32_32x32x16_bf16(fa, fb, dm, 0, 0, 0);
            }
#pragma unroll
            for (int reg = 0; reg < 16; ++reg) DM[((reg & 3) + 8 * (reg >> 2) + 4 * hh) * 36 + rr] = dm[reg];
        }
        __builtin_amdgcn_sched_barrier(0);
        float uh[16];
#pragma unroll
        for (int t = 0; t < 16; ++t) {
            float wv = at[t], uv = 0.f, wv2 = 0.f, uv2 = 0.f, uv3 = 0.f;
#pragma unroll
            for (int s4 = 0; s4 < 4; ++s4) {
                if (s4 * 4 < t) {
                    const f32x4 ab = *(const LAS f32x4*)(DM + t * 36 + s4 * 4), ak = *(const LAS f32x4*)(DM + t * 36 + 16 + s4 * 4);
#pragma unroll
                    for (int j = 0; j < 4; ++j) {
                        const int s_ = s4 * 4 + j;
                        if (s_ < t) {
                            if (j & 1) { wv2 += ab[j] * at[s_]; uv2 += ak[j] * vt[s_]; } else { wv += ab[j] * at[s_]; uv += ak[j] * vt[s_]; }
                            uv3 += ab[j] * uh[s_];
                        }
                    }
                }
            }
            wv += wv2; uv += uv2 + uv3;
            at[t] = wv; uh[t] = uv;
            asm volatile("" : "+v"(at[t]), "+v"(uh[t]));
        }
        __builtin_amdgcn_sched_barrier(0);
#pragma unroll
        for (int t = 0; t < 16; t += 2) { const unsigned w = cvt_pk_bf16(at[t], at[t + 1]); AR[t * 72 + qperm] = (bf16_t)(w & 0xFFFFu); AR[(t + 1) * 72 + qperm] = (bf16_t)(w >> 16); }
        unsigned char* rec = ws + OFF_CH + (size_t)uid * REC_BYTES;
#pragma unroll
        for (int i = 0; i < 2; ++i) {
            const int pc = i * 64 + lane, row = pc >> 3, part = pc & 7;
            *(u32x4*)(rec + RO_WH + pc * 16) = *(const LAS u32x4*)((LAS unsigned char*)AR + row * 144 + part * 16);
            *(u32x4*)(rec + RO_RT + pc * 16) = *(const LAS u32x4*)((LAS unsigned char*)AR + (16 + row) * 144 + part * 16);
        }
        {
            u32x4 w0, w1;
            w0.x = cvt_pk_bf16(uh[0], uh[1]); w0.y = cvt_pk_bf16(uh[2], uh[3]); w0.z = cvt_pk_bf16(uh[4], uh[5]); w0.w = cvt_pk_bf16(uh[6], uh[7]);
            w1.x = cvt_pk_bf16(uh[8], uh[9]); w1.y = cvt_pk_bf16(uh[10], uh[11]); w1.z = cvt_pk_bf16(uh[12], uh[13]); w1.w = cvt_pk_bf16(uh[14], uh[15]);
            *(u32x4*)(rec + RO_U0T + lane * 32) = w0; *(u32x4*)(rec + RO_U0T + lane * 32 + 16) = w1;
            w0.x = cvt_pk_bf16(vt[0], vt[1]); w0.y = cvt_pk_bf16(vt[2], vt[3]); w0.z = cvt_pk_bf16(vt[4], vt[5]); w0.w = cvt_pk_bf16(vt[6], vt[7]);
            w1.x = cvt_pk_bf16(vt[8], vt[9]); w1.y = cvt_pk_bf16(vt[10], vt[11]); w1.z = cvt_pk_bf16(vt[12], vt[13]); w1.w = cvt_pk_bf16(vt[14], vt[15]);
            *(u32x4*)(rec + RO_VT + lane * 32) = w0; *(u32x4*)(rec + RO_VT + lane * 32 + 16) = w1;
        }
#pragma unroll
        for (int g = 0; g < 4; ++g) {
            u32x4 w; w.x = btp[2 * g]; w.y = btp[2 * g + 1]; w.z = ktp[2 * g]; w.w = ktp[2 * g + 1];
            *(u32x4*)(rec + RO_BKT + lane * 64 + g * 16) = w;
        }
        {
            const int t = lane >> 2, g = lane & 3;
            const f32x4 rb = *(const LAS f32x4*)(DM + (16 + t) * 36 + 4 * g), rk = *(const LAS f32x4*)(DM + (16 + t) * 36 + 16 + 4 * g);
            float o[8];
#pragma unroll
            for (int j = 0; j < 4; ++j) { const bool keep = (4 * g + j) <= t; o[j] = keep ? rb[j] : 0.f; o[4 + j] = keep ? rk[j] : 0.f; }
            u32x4 w; w.x = cvt_pk_bf16(o[0], o[1]); w.y = cvt_pk_bf16(o[2], o[3]); w.z = cvt_pk_bf16(o[4], o[5]); w.w = cvt_pk_bf16(o[6], o[7]);
            *(u32x4*)(rec + RO_ARK + t * 64 + g * 16) = w;
        }
        *(float*)(rec + RO_WCC + lane * 4) = wcc;
        if (!has_next) break;
        uid = nuid; b = nb_; h = nh; c = nc; col = ncol; row0 = nrow0;
#pragma unroll
        for (int t = 0; t < 16; ++t) q[t] = qn[t];
        prr = nprr; prk = nprk; prv = nprv;
        __builtin_amdgcn_sched_barrier(0);
    }
}

__device__ __forceinline__ void convert_expert_weights(const PPv& p, LAS unsigned char* lds, int first, int stride);
struct RecOps { bf16x8 wA0, wA1, rA0, rA1, ark, bk[4]; u32x2 u0, vv; f32x4 wc[4]; };
__device__ __forceinline__ void load_ops(RecOps& o, LAS unsigned char* S, int vs, int fr, int g) {
    o.wA0 = *(const LAS bf16x8*)(S + RO_WH + fr * 128 + g * 16); o.wA1 = *(const LAS bf16x8*)(S + RO_WH + fr * 128 + 64 + g * 16);
    o.rA0 = *(const LAS bf16x8*)(S + RO_RT + fr * 128 + g * 16); o.rA1 = *(const LAS bf16x8*)(S + RO_RT + fr * 128 + 64 + g * 16);
    o.u0 = *(const LAS u32x2*)(S + RO_U0T + (16 * vs + fr) * 32 + g * 8);
    o.vv = *(const LAS u32x2*)(S + RO_VT + (16 * vs + fr) * 32 + g * 8);
    o.ark = *(const LAS bf16x8*)(S + RO_ARK + fr * 64 + g * 16);
#pragma unroll
    for (int m = 0; m < 4; ++m) { o.bk[m] = *(const LAS bf16x8*)(S + RO_BKT + (16 * m + fr) * 64 + g * 16); o.wc[m] = *(const LAS f32x4*)(S + RO_WCC + (16 * m + 4 * g) * 4); }
}
__device__ __forceinline__ void phase_recur(const PPv& p, LAS unsigned char* lds) {
    const int tid = threadIdx.x, bid = blockIdx.x, nb = gridDim.x, lane = tid & 63, wave = __builtin_amdgcn_readfirstlane(tid >> 6);
    unsigned char* ws = p.gws();
    if (bid >= 64) { convert_expert_weights(p, lds, bid - 64, nb - 64); return; }
    unsigned char* CHb = ws + OFF_CH + (size_t)(bid * NCHUNK) * REC_BYTES;
    constexpr int RSLOT = REC_BYTES, RN = 11, PF = 8;
#define R_BAR() do { asm volatile("s_waitcnt lgkmcnt(0)" ::: "memory"); __builtin_amdgcn_s_barrier(); asm volatile("" ::: "memory"); } while (0)
    if (wave >= 4) {
        const int lw = wave - 4;
#define R_ISSUE(x) do { \
            LAS unsigned char* _s = lds + ((x) % RN) * RSLOT; const unsigned char* _r = CHb + (size_t)(x) * REC_BYTES + lane * 16; \
            _Pragma("unroll") for (int _i = 0; _i < 3; ++_i) { const int _pc = lw + 4 * _i; __builtin_amdgcn_global_load_lds((const unsigned*)(_r + _pc * 1024), (LAS unsigned*)(_s + _pc * 1024), 16, 0, 0); } \
            if (lw == 0) __builtin_amdgcn_global_load_lds((const unsigned*)(_r + 12 * 1024), (LAS unsigned*)(_s + 12 * 1024), 16, 0, 0); \
            if (lw == 1) { if (lane < 16) __builtin_amdgcn_global_load_lds((const unsigned*)(_r + 13 * 1024), (LAS unsigned*)(_s + 13 * 1024), 16, 0, 0); } } while (0)
        for (int x = 0; x < PF; ++x) R_ISSUE(x);
        asm volatile("s_waitcnt vmcnt(0)" ::: "memory");
        R_BAR();
        for (int c = 0; c < NCHUNK; ++c) {
            const int x = c + PF;
            if (x < NCHUNK) R_ISSUE(x);
            if (x < NCHUNK) { if (lw < 2) asm volatile("s_waitcnt vmcnt(24)" ::: "memory"); else asm volatile("s_waitcnt vmcnt(18)" ::: "memory"); }
            else asm volatile("s_waitcnt vmcnt(0)" ::: "memory");
            R_BAR();
        }
#undef R_ISSUE
    } else {
        const int vs = wave, fr = lane & 15, g = lane >> 4;
        f32x4 H[4];
#pragma unroll
        for (int m = 0; m < 4; ++m) H[m] = (f32x4){0.f, 0.f, 0.f, 0.f};
        R_BAR();
        RecOps cur, nxt;
        load_ops(cur, lds, vs, fr, g);
        for (int c = 0; c < NCHUNK; ++c) {
            if (c + 1 < NCHUNK) load_ops(nxt, lds + ((c + 1) % RN) * RSLOT, vs, fr, g); else nxt = cur;
            u32x4 hb0, hb1;
            hb0.x = cvt_pk_bf16(H[0][0], H[0][1]); hb0.y = cvt_pk_bf16(H[0][2], H[0][3]); hb0.z = cvt_pk_bf16(H[1][0], H[1][1]); hb0.w = cvt_pk_bf16(H[1][2], H[1][3]);
            hb1.x = cvt_pk_bf16(H[2][0], H[2][1]); hb1.y = cvt_pk_bf16(H[2][2], H[2][3]); hb1.z = cvt_pk_bf16(H[3][0], H[3][1]); hb1.w = cvt_pk_bf16(H[3][2], H[3][3]);
            const bf16x8 hB0 = __builtin_bit_cast(bf16x8, hb0), hB1 = __builtin_bit_cast(bf16x8, hb1);
            f32x4 U = (f32x4){bflo(cur.u0.x), bfhi(cur.u0.x), bflo(cur.u0.y), bfhi(cur.u0.y)};
            U = __builtin_amdgcn_mfma_f32_16x16x32_bf16(cur.wA0, hB0, U, 0, 0, 0);
            U = __builtin_amdgcn_mfma_f32_16x16x32_bf16(cur.wA1, hB1, U, 0, 0, 0);
            f32x4 Y = (f32x4){0.f, 0.f, 0.f, 0.f};
            Y = __builtin_amdgcn_mfma_f32_16x16x32_bf16(cur.rA0, hB0, Y, 0, 0, 0);
            Y = __builtin_amdgcn_mfma_f32_16x16x32_bf16(cur.rA1, hB1, Y, 0, 0, 0);
            u32x4 uvw; uvw.x = cvt_pk_bf16(U[0], U[1]); uvw.y = cvt_pk_bf16(U[2], U[3]); uvw.z = cur.vv.x; uvw.w = cur.vv.y;
            const bf16x8 uv = __builtin_bit_cast(bf16x8, uvw);
            Y = __builtin_amdgcn_mfma_f32_16x16x32_bf16(cur.ark, uv, Y, 0, 0, 0);
#pragma unroll
            for (int m = 0; m < 4; ++m) { H[m] = __builtin_amdgcn_mfma_f32_16x16x32_bf16(cur.bk[m], uv, H[m], 0, 0, 0); H[m] *= cur.wc[m]; }
            u32x2 yw; yw.x = cvt_pk_bf16(Y[0], Y[1]); yw.y = cvt_pk_bf16(Y[2], Y[3]);
            *(u32x2*)(CHb + (size_t)c * REC_BYTES + RO_U0T + (16 * vs + fr) * 32 + g * 8) = yw;
            R_BAR();
            cur = nxt;
        }
    }
#undef R_BAR
}

__device__ __forceinline__ void phase_gn(const PPv& p, LAS unsigned char* lds) {
    const int tid = threadIdx.x, bid = blockIdx.x, nb = gridDim.x, lane = tid & 63, wave = tid >> 6;
    unsigned char* ws = p.gws();
    LAS float* PM = (LAS float*)(lds + wave * 8960);
    LAS float* RS = PM + 32 * 68;
    const bf16_t* Gb = (const bf16_t*)(ws + OFF_G); const float* COEF = (const float*)(ws + OFF_COEF);
    bf16_t* Z = (bf16_t*)(ws + OFF_Z);
    constexpr int NREAL = 64 * 256;
    for (int r0 = bid * 8 + wave; r0 < NREAL; r0 += nb * 16) {
        u32x4 y0[2], y1[2], v0[2], v1[2]; float cfv[2][16]; bf16_t ggv[2][16]; int colv[2], row0v[2], hv[2]; bool okv[2];
#pragma unroll
        for (int u = 0; u < 2; ++u) {
            const int r = r0 + u * nb * 8; okv[u] = r < NREAL;
            const int rr = okv[u] ? r : r0;
            const int bh = rr >> 8, c = (rr & 255) + 1, b = bh >> 3, h = bh & 7, uid = bh * NCHUNK + c;
            hv[u] = h; colv[u] = h * 64 + lane; row0v[u] = b * SEQ + c * 16;
            const unsigned char* rec = ws + OFF_CH + (size_t)uid * REC_BYTES;
            y0[u] = *(const u32x4*)(rec + RO_U0T + lane * 32); y1[u] = *(const u32x4*)(rec + RO_U0T + lane * 32 + 16);
            v0[u] = *(const u32x4*)(rec + RO_VT + lane * 32); v1[u] = *(const u32x4*)(rec + RO_VT + lane * 32 + 16);
#pragma unroll
            for (int t = 0; t < 16; ++t) { cfv[u][t] = COEF[(size_t)(row0v[u] + t) * 8 + h]; ggv[u][t] = Gb[(size_t)(row0v[u] + t) * 512 + colv[u]]; }
        }
#pragma unroll
        for (int u = 0; u < 2; ++u) {
            if (!okv[u]) continue;
            const int col = colv[u], row0 = row0v[u];
            const float lng = p.gin(21)[col], lnb = p.gin(22)[col];
            const unsigned yw[8] = {y0[u].x, y0[u].y, y0[u].z, y0[u].w, y1[u].x, y1[u].y, y1[u].z, y1[u].w}, vw[8] = {v0[u].x, v0[u].y, v0[u].z, v0[u].w, v1[u].x, v1[u].y, v1[u].z, v1[u].w};
            asm volatile("" ::: "memory");
#pragma unroll
            for (int t = 0; t < 16; ++t) { const float y = (t & 1) ? bfhi(yw[t >> 1]) : bflo(yw[t >> 1]); PM[t * 68 + lane] = y; PM[(16 + t) * 68 + lane] = y * y; }
            asm volatile("" ::: "memory");
            {
                const int rw = lane & 31, hf = lane >> 5;
                f32x4 s4 = (f32x4){0.f, 0.f, 0.f, 0.f};
#pragma unroll
                for (int i = 0; i < 8; ++i) s4 += *(const LAS f32x4*)(PM + rw * 68 + hf * 32 + i * 4);
                float sm = (s4[0] + s4[1]) + (s4[2] + s4[3]);
                { float c2 = sm; asm volatile("v_nop\n\tv_nop\n\tv_permlane32_swap_b32 %0, %1\n\tv_nop" : "+v"(sm), "+v"(c2)); sm += c2; }
                if (lane < 32) RS[lane] = sm;
            }
            asm volatile("" ::: "memory");
            f32x4 s1v[4], s2v[4];
#pragma unroll
            for (int i = 0; i < 4; ++i) { s1v[i] = *(const LAS f32x4*)(RS + 4 * i); s2v[i] = *(const LAS f32x4*)(RS + 16 + 4 * i); }
            asm volatile("" ::: "memory");
#pragma unroll
            for (int t = 0; t < 16; ++t) {
                const float y = (t & 1) ? bfhi(yw[t >> 1]) : bflo(yw[t >> 1]);
                const float v = (t & 1) ? bfhi(vw[t >> 1]) : bflo(vw[t >> 1]);
                const float mean = s1v[t >> 2][t & 3] * (1.0f / 64.0f);
                const float dlt = y - mean;
                const float var = fmaxf(s2v[t >> 2][t & 3] * (1.0f / 64.0f) - mean * mean, 0.f);
                const float yn = dlt * rsqrtf(var + LNX_EPS) * lng + lnb;
                Z[(size_t)(row0 + t - NMETA) * 512 + col] = f2bf((yn + cfv[u][t] * v) * bf2f(ggv[u][t]));
            }
        }
    }
}

__device__ __forceinline__ void convert_expert_weights(const PPv& p, LAS unsigned char* lds, int first, int stride) {
    unsigned char* ws = p.gws();
    const int tid = threadIdx.x;
    LAS float* tile = (LAS float*)lds;
    const float* g2 = p.gin(27);
    unsigned char* WGU = ws + OFF_WGU; unsigned char* WD = ws + OFF_WD;
    constexpr int NBLK = NE * 3 * 64;
    const int lr = tid >> 6, lc = (tid & 63) * 4;
    f32x4 cur[8];
    int j = first;
    if (j >= NBLK) return;
    {
        const int mat = j >> 6, e = mat / 3, which = mat - 3 * e, bb = j & 63, kb = bb & 15, nbk = bb >> 4;
        const float* src = (which == 0 ? p.gin(30) : which == 1 ? p.gin(32) : p.gin(34)) + (size_t)e * 1024 * 1024 + (size_t)(kb * 64) * 1024 + nbk * 256;
#pragma unroll
        for (int i = 0; i < 8; ++i) cur[i] = __builtin_nontemporal_load((const f32x4*)(src + (size_t)(lr + 8 * i) * 1024 + lc));
    }
    for (;;) {
        const int jn = j + stride; const bool has_next = jn < NBLK;
        f32x4 nxt[8];
        if (has_next) {
            const int mat = jn >> 6, e = mat / 3, which = mat - 3 * e, bb = jn & 63, kb = bb & 15, nbk = bb >> 4;
            const float* src = (which == 0 ? p.gin(30) : which == 1 ? p.gin(32) : p.gin(34)) + (size_t)e * 1024 * 1024 + (size_t)(kb * 64) * 1024 + nbk * 256;
#pragma unroll
            for (int i = 0; i < 8; ++i) nxt[i] = __builtin_nontemporal_load((const f32x4*)(src + (size_t)(lr + 8 * i) * 1024 + lc));
        }
        const int mat = j >> 6, e = mat / 3, which = mat - 3 * e, bb = j & 63, kb = bb & 15, nbk = bb >> 4;
#pragma unroll
        for (int i = 0; i < 8; ++i) { LAS float* t = tile + (lr + 8 * i) * 257 + lc; t[0] = cur[i][0]; t[1] = cur[i][1]; t[2] = cur[i][2]; t[3] = cur[i][3]; }
        __syncthreads();
        {
            const int kq = tid & 7, k0 = kb * 64 + 8 * kq;
            float sc[8];
#pragma unroll
            for (int jj = 0; jj < 8; ++jj) sc[jj] = (which < 2 ? g2[k0 + jj] : 1.0f) * W8_SCALE;
#pragma unroll
            for (int i = 0; i < 4; ++i) {
                const int nn = (tid >> 3) + 64 * i, n = nbk * 256 + nn;
                float v[8];
#pragma unroll
                for (int jj = 0; jj < 8; ++jj) v[jj] = tile[(8 * kq + jj) * 257 + nn] * sc[jj];
                u32x2 w; w.x = pk4_fp8(v[0], v[1], v[2], v[3]); w.y = pk4_fp8(v[4], v[5], v[6], v[7]);
                unsigned char* dst = which < 2 ? WGU + (size_t)e * 2048 * 1024 + (size_t)(256 * (n >> 7) + 128 * which + (n & 127)) * 1024
                                               : WD + (size_t)e * 1024 * 1024 + (size_t)n * 1024;
                __builtin_nontemporal_store(w, (u32x2*)(dst + k0));
            }
        }
        __syncthreads();
        if (!has_next) break;
        j = jn;
#pragma unroll
        for (int i = 0; i < 8; ++i) cur[i] = nxt[i];
    }
}

__device__ __forceinline__ void phase_router(const PPv& p, LAS unsigned char* lds) {
    const int tid = threadIdx.x, bid = blockIdx.x, nb = gridDim.x, lane = tid & 63, wave = tid >> 6;
    unsigned char* ws = p.gws();
    const bf16_t* h1 = (const bf16_t*)(ws + OFF_HB2);
    const float* WRG = (const float*)(ws + OFF_WRG);
    const float* brt = p.gin(29);
    LAS float* slog = (LAS float*)lds;
    LAS float* srs = slog + 8 * 16 * 32;
    LAS int* lcnt = (LAS int*)(srs + 128);
    LAS int* gbase = lcnt + 32;
    LAS int* ltopi = gbase + 32;
    LAS int* lrank = ltopi + 512;
    int* TOPI = (int*)(ws + OFF_TOPI); float* TOPW = (float*)(ws + OFF_TOPW); int* RANK = (int*)(ws + OFF_RANK); float* RSTD2 = (float*)(ws + OFF_RSTD2);
    int* GCNT = (int*)(ws + OFF_GCNT);
    for (int tb = bid; tb < T / 128; tb += nb) {
        if (tid < 32) lcnt[tid] = 0;
        __syncthreads();
        const int t0 = tb * 128 + wave * 16;
        {
            const int row = lane & 15, kq = lane >> 4;
            const bf16_t* ap = h1 + (size_t)(t0 + row) * D + 4 * kq;
            const float* bp = WRG + (size_t)(4 * kq) * 32 + row;
            f32x4 acc0 = (f32x4){0.f, 0.f, 0.f, 0.f}, acc1 = acc0;
            float ss = 0.f;
            for (int j = 0; j < 64; ++j) {
                const u32x2 aw = *(const u32x2*)(ap + 16 * j);
                const f32x4 av = (f32x4){bflo(aw.x), bfhi(aw.x), bflo(aw.y), bfhi(aw.y)};
                ss += av[0] * av[0] + av[1] * av[1] + av[2] * av[2] + av[3] * av[3];
                const float* bj = bp + (size_t)(16 * j) * 32;
#pragma unroll
                for (int s = 0; s < 4; ++s) {
                    const float b0 = bj[s * 32], b1 = bj[s * 32 + 16];
                    acc0 = __builtin_amdgcn_mfma_f32_16x16x4f32(av[s], b0, acc0, 0, 0, 0);
                    acc1 = __builtin_amdgcn_mfma_f32_16x16x4f32(av[s], b1, acc1, 0, 0, 0);
                }
            }
            ss += __shfl_xor(ss, 16); ss += __shfl_xor(ss, 32);
#pragma unroll
            for (int reg = 0; reg < 4; ++reg) {
                slog[(wave * 16 + 4 * kq + reg) * 32 + row] = acc0[reg];
                slog[(wave * 16 + 4 * kq + reg) * 32 + 16 + row] = acc1[reg];
            }
            if (lane < 16) srs[wave * 16 + lane] = rsqrtf(ss * (1.0f / D) + NORM_EPS);
        }
        __syncthreads();
        if (lane < 16) {
            const int tl = wave * 16 + lane, t = tb * 128 + tl;
            const float rs = srs[tl];
            float lg[32];
#pragma unroll
            for (int e = 0; e < 32; ++e) lg[e] = slog[tl * 32 + e] * rs + brt[e];
            int ti[4]; float tv[4];
#pragma unroll
            for (int k = 0; k < 4; ++k) {
                float best = -3.0e38f; int bi = 0;
#pragma unroll
                for (int e = 0; e < 32; ++e) { const bool tk = lg[e] > best; best = tk ? lg[e] : best; bi = tk ? e : bi; }
                ti[k] = bi; tv[k] = best;
#pragma unroll
                for (int e = 0; e < 32; ++e) lg[e] = (e == bi) ? -3.0e38f : lg[e];
            }
            const float e0 = 1.0f, e1 = __expf(tv[1] - tv[0]), e2 = __expf(tv[2] - tv[0]), e3 = __expf(tv[3] - tv[0]);
            const float inv = 1.0f / (e0 + e1 + e2 + e3);
            *(f32x4*)(TOPW + (size_t)t * 4) = (f32x4){e0 * inv, e1 * inv, e2 * inv, e3 * inv};
            RSTD2[t] = rs;
#pragma unroll
            for (int k = 0; k < 4; ++k) { ltopi[tl * 4 + k] = ti[k]; lrank[tl * 4 + k] = __hip_atomic_fetch_add(lcnt + ti[k], 1, __ATOMIC_RELAXED, __HIP_MEMORY_SCOPE_WORKGROUP); }
        }
        __syncthreads();
        if (tid < 32) gbase[tid] = atomicAdd(GCNT + tid, lcnt[tid]);
        __syncthreads();
        {
            const int e = ltopi[tid];
            TOPI[(size_t)tb * 512 + tid] = e;
            RANK[(size_t)tb * 512 + tid] = gbase[e] + lrank[tid];
        }
        __syncthreads();
    }
}

__device__ __forceinline__ void phase_lists(const PPv& p, LAS unsigned char* lds) {
    const int tid = threadIdx.x, bid = blockIdx.x, nb = gridDim.x;
    unsigned char* ws = p.gws();
    LAS int* pstart = (LAS int*)lds;
    LAS int* cnt = pstart + 64;
    const int* GCNT = (const int*)(ws + OFF_GCNT);
    if (tid < 32) cnt[tid] = GCNT[tid];
    __syncthreads();
    if (tid == 0) { int s = 0; for (int e = 0; e < 32; ++e) { pstart[e] = s; s += ((cnt[e] + 255) >> 8) << 8; } pstart[32] = s; }
    __syncthreads();
    const int* TOPI = (const int*)(ws + OFF_TOPI); const float* TOPW = (const float*)(ws + OFF_TOPW); const int* RANK = (const int*)(ws + OFF_RANK); const float* RSTD2 = (const float*)(ws + OFF_RSTD2);
    int* ROWTOK = (int*)(ws + OFF_ROWTOK); int* ROWSLOT = (int*)(ws + OFF_ROWSLOT); float* ROWW = (float*)(ws + OFF_ROWW); float* ROWRS = (float*)(ws + OFF_ROWRS);
    for (int i = bid * 512 + tid; i < T * 4; i += nb * 512) {
        const int e = TOPI[i], pos = pstart[e] + RANK[i], t = i >> 2;
        ROWTOK[pos] = t; ROWSLOT[pos] = i; ROWW[pos] = TOPW[i]; ROWRS[pos] = RSTD2[t];
    }
    for (int e = bid; e < 32; e += nb) {
        for (int pos = pstart[e] + cnt[e] + tid; pos < pstart[e + 1]; pos += 512) { ROWTOK[pos] = 0; ROWSLOT[pos] = -1; ROWW[pos] = 0.f; ROWRS[pos] = 0.f; }
    }
    if (bid == 0) {
        int* TILEE = (int*)(ws + OFF_TILEE);
        const int ntiles = pstart[32] >> 8;
        for (int mt = tid; mt < ntiles; mt += 512) { int e = 0; for (int q = 0; q < 32; ++q) if (pstart[q] <= mt * 256) e = q; TILEE[mt] = e; }
        if (tid == 0) TILEE[1000] = ntiles;
    }
    __syncthreads();
}

__device__ __forceinline__ void phase_final(const PPv& p) {
    const int tid = threadIdx.x, bid = blockIdx.x, nb = gridDim.x, lane = tid & 63, wave = tid >> 6;
    unsigned char* ws = p.gws();
    const bf16_t* HB2 = (const bf16_t*)(ws + OFF_HB2);
    const unsigned char* Y8 = (const unsigned char*)p.gout();
    const float* gf = p.gin(36);
    const f32x4 ga0 = *(const f32x4*)(gf + 8 * lane), ga1 = *(const f32x4*)(gf + 8 * lane + 4), gb0 = *(const f32x4*)(gf + 512 + 8 * lane), gb1 = *(const f32x4*)(gf + 512 + 8 * lane + 4);
    for (int t0 = (bid * 8 + wave) * 2; t0 < T; t0 += nb * 16) {
        u32x4 ha[2], hb[2]; u32x2 ya[2][4], yb[2][4];
#pragma unroll
        for (int u = 0; u < 2; ++u) {
            const int t = t0 + u;
            ha[u] = __builtin_nontemporal_load((const u32x4*)(HB2 + (size_t)t * D + 8 * lane)); hb[u] = __builtin_nontemporal_load((const u32x4*)(HB2 + (size_t)t * D + 512 + 8 * lane));
#pragma unroll
            for (int k = 0; k < 4; ++k) { ya[u][k] = __builtin_nontemporal_load((const u32x2*)(Y8 + (size_t)(4 * t + k) * 1024 + 8 * lane)); yb[u][k] = __builtin_nontemporal_load((const u32x2*)(Y8 + (size_t)(4 * t + k) * 1024 + 512 + 8 * lane)); }
        }
#pragma unroll
        for (int u = 0; u < 2; ++u) {
            const int t = t0 + u;
            float va[8] = {bflo(ha[u].x), bfhi(ha[u].x), bflo(ha[u].y), bfhi(ha[u].y), bflo(ha[u].z), bfhi(ha[u].z), bflo(ha[u].w), bfhi(ha[u].w)};
            float vb[8] = {bflo(hb[u].x), bfhi(hb[u].x), bflo(hb[u].y), bfhi(hb[u].y), bflo(hb[u].z), bfhi(hb[u].z), bflo(hb[u].w), bfhi(hb[u].w)};
#pragma unroll
            for (int k = 0; k < 4; ++k) {
                const u32x2 a4 = ya[u][k], b4 = yb[u][k];
                { const f32x2 q0 = __builtin_amdgcn_cvt_pk_f32_fp8((int)a4.x, false), q1 = __builtin_amdgcn_cvt_pk_f32_fp8((int)a4.x, true), q2 = __builtin_amdgcn_cvt_pk_f32_fp8((int)a4.y, false), q3 = __builtin_amdgcn_cvt_pk_f32_fp8((int)a4.y, true);
                  va[0] += q0.x; va[1] += q0.y; va[2] += q1.x; va[3] += q1.y; va[4] += q2.x; va[5] += q2.y; va[6] += q3.x; va[7] += q3.y; }
                { const f32x2 q0 = __builtin_amdgcn_cvt_pk_f32_fp8((int)b4.x, false), q1 = __builtin_amdgcn_cvt_pk_f32_fp8((int)b4.x, true), q2 = __builtin_amdgcn_cvt_pk_f32_fp8((int)b4.y, false), q3 = __builtin_amdgcn_cvt_pk_f32_fp8((int)b4.y, true);
                  vb[0] += q0.x; vb[1] += q0.y; vb[2] += q1.x; vb[3] += q1.y; vb[4] += q2.x; vb[5] += q2.y; vb[6] += q3.x; vb[7] += q3.y; }
            }
            float ss = 0.f;
#pragma unroll
            for (int j = 0; j < 8; ++j) ss += va[j] * va[j] + vb[j] * vb[j];
            ss = wave_sum_dpp(ss);
            const float rs = rsqrtf(ss * (1.0f / D) + NORM_EPS);
            float* o = p.gout() + (size_t)t * D;
            __builtin_nontemporal_store((f32x4){va[0] * rs * ga0[0], va[1] * rs * ga0[1], va[2] * rs * ga0[2], va[3] * rs * ga0[3]}, (f32x4*)(o + 8 * lane));
            __builtin_nontemporal_store((f32x4){va[4] * rs * ga1[0], va[5] * rs * ga1[1], va[6] * rs * ga1[2], va[7] * rs * ga1[3]}, (f32x4*)(o + 8 * lane + 4));
            __builtin_nontemporal_store((f32x4){vb[0] * rs * gb0[0], vb[1] * rs * gb0[1], vb[2] * rs * gb0[2], vb[3] * rs * gb0[3]}, (f32x4*)(o + 512 + 8 * lane));
            __builtin_nontemporal_store((f32x4){vb[4] * rs * gb1[0], vb[5] * rs * gb1[1], vb[6] * rs * gb1[2], vb[7] * rs * gb1[3]}, (f32x4*)(o + 512 + 8 * lane + 4));
        }
    }
}

#define XB_TMO      128
#define XB_XCNT(j)  (256  + 64 * (j))
#define XB_XSUB(j)  (1280 + 64 * (j))
#define XB_XGEN(j)  (2304 + 64 * (j))
#define XB_TOP      3328
#define XB_TOPGEN   3392
#define XCD_BAR_WORDS 3456
#define XB_SPIN_CAP (1u << 18)
__device__ __forceinline__ unsigned xb_ld(unsigned* p)              { return __hip_atomic_load(p, __ATOMIC_RELAXED, __HIP_MEMORY_SCOPE_AGENT); }
__device__ __forceinline__ unsigned xb_add(unsigned* p, unsigned v) { return __hip_atomic_fetch_add(p, v, __ATOMIC_RELAXED, __HIP_MEMORY_SCOPE_AGENT); }
__device__ __forceinline__ unsigned xb_xcc_id() { return (unsigned)__builtin_amdgcn_s_getreg((3 << 11) | 20) & 0xFu; }
#define XB_SPIN(cond, bar) do { unsigned _sp = 0; while (cond) { __builtin_amdgcn_s_sleep(1); \
    if ((++_sp & 255u) == 0u) { if (xb_ld(&(bar)[XB_TMO])) break; if (_sp > XB_SPIN_CAP) { atomicAdd(&(bar)[XB_TMO], 1u); break; } } } } while (0)
struct XcdBarrier { unsigned* bar; unsigned x; volatile LAS unsigned* st; };
__device__ __forceinline__ XcdBarrier xcd_barrier_post(unsigned* bar, volatile LAS unsigned* st) {
    XcdBarrier b; b.bar = bar; b.x = xb_xcc_id(); b.st = st;
    if (threadIdx.x == 0) (void)xb_add(&bar[XB_XCNT(b.x)], 1u);
    return b;
}
__device__ __forceinline__ void xcd_barrier_complete(unsigned* bar, unsigned x, unsigned& nloc, unsigned& nx) {
    const unsigned G = gridDim.x * gridDim.y * gridDim.z;
    unsigned sum, cnt, mine, sp = 0u;
    for (;;) {
        sum = 0u; cnt = 0u; mine = 0u;
#pragma unroll
        for (unsigned j = 0; j < 16; ++j) { const unsigned c = xb_ld(&bar[XB_XCNT(j)]); sum += c; cnt += (c > 0u) ? 1u : 0u; mine = (j == x) ? c : mine; }
        if (sum == G) break;
        __builtin_amdgcn_s_sleep(1);
        if ((++sp & 255u) == 0u) { if (xb_ld(&bar[XB_TMO])) break; if (sp > XB_SPIN_CAP) { atomicAdd(&bar[XB_TMO], 1u); break; } }
    }
    nloc = mine > 0u ? mine : 1u; nx = cnt > 0u ? cnt : 1u;
}
__device__ __forceinline__ void xcd_barrier(const XcdBarrier& b) {
    asm volatile("s_waitcnt vmcnt(0)" ::: "memory");
    __syncthreads();
    if (threadIdx.x == 0) {
        unsigned* bar = b.bar;
        __builtin_amdgcn_s_waitcnt(0);
        unsigned nloc = b.st[0], nx = b.st[1];
        if (nloc == 0u) { xcd_barrier_complete(bar, b.x, nloc, nx); b.st[0] = nloc; b.st[1] = nx; }
        const unsigned old = xb_add(&bar[XB_XSUB(b.x)], 1u);
        const unsigned gen = old / nloc;
        if (old + 1u == (gen + 1u) * nloc) {
            __builtin_amdgcn_fence(__ATOMIC_RELEASE, "agent");
            asm volatile("s_waitcnt vmcnt(0)" ::: "memory");
            const unsigned og = xb_add(&bar[XB_TOP], 1u);
            const unsigned tg = og / nx;
            if (og + 1u == (tg + 1u) * nx) xb_add(&bar[XB_TOPGEN], 1u);
            else XB_SPIN(xb_ld(&bar[XB_TOPGEN]) == tg, bar);
            __builtin_amdgcn_fence(__ATOMIC_ACQUIRE, "agent");
            xb_add(&bar[XB_XGEN(b.x)], 1u);
            asm volatile("s_waitcnt vmcnt(0)" ::: "memory");
        } else {
            XB_SPIN(xb_ld(&bar[XB_XGEN(b.x)]) == gen, bar);
            __builtin_amdgcn_fence(__ATOMIC_ACQUIRE, "agent");
            asm volatile("s_waitcnt vmcnt(0)" ::: "memory");
        }
    }
    __syncthreads();
}

constexpr int N_PHASES = 15;
__global__ void __launch_bounds__(512, 2) mega(Params p) {
    extern __shared__ __attribute__((aligned(16))) unsigned char lds_raw[];
    LAS unsigned char* lds = (LAS unsigned char*)lds_raw;
    cg::grid_group grid = cg::this_grid();
    unsigned char* ws = getpp().gws();
    const int G = gridDim.x, bid = blockIdx.x;
#ifndef ONLY_PHASE
#define ONLY_PHASE -1
#endif
#define IN(k) ((ONLY_PHASE < 0 || ONLY_PHASE == (k)) && p.ph_lo <= (k) && (k) < p.ph_hi)
    volatile LAS unsigned* xst = (volatile LAS unsigned*)(lds + 163840 - 16);
    if (threadIdx.x < 4) xst[threadIdx.x] = 0u;
    __syncthreads();
    const XcdBarrier xbar = xcd_barrier_post((unsigned*)(ws + OFF_BAR), xst);
    if (p.ph_hi < 0) grid.sync();
#define SEAM(k) do { if ((k) + 1 < p.ph_hi) xcd_barrier(xbar); } while (0)
    if (IN(0)) { const PPv q = getpp(); phase_prep(q, lds); SEAM(0); }
    if (IN(1)) { const PPv q = getpp();
        phase_meta_proj(q, lds);
        {
            StaticOrder S; S.init(ws + OFF_HB, ws + OFF_WIN, T, 14 * 256, 1024, G, bid);
            EpiProj E{(bf16_t*)(ws + OFF_PRKV), (bf16_t*)(ws + OFF_PCONV), (unsigned char*)q.gout(), (const float*)(ws + OFF_RSTD1), 0, 1.0f};
            gemm_phase<false>(lds, 1024, S, E);
        }
        {
            StaticOrder S; S.init(ws + OFF_X8, ws + OFF_WIN8, T, 8 * 256, 512, G, bid);
            EpiProj E{(bf16_t*)(ws + OFF_PRKV), (bf16_t*)(ws + OFF_PCONV), (unsigned char*)q.gout(), (const float*)(ws + OFF_RSTD1), 14, W8_INV};
            gemm_phase<false, true>(lds, 512, S, E);
        }
        SEAM(1);
    }
    if (IN(2)) { const PPv q = getpp(); phase_lprep_conv(q); SEAM(2); }
    if (IN(3)) { const PPv q = getpp();
        phase_meta_lora(q);
        StaticOrder S; S.init(ws + OFF_L + (size_t)NMETA * 256 * 2, ws + OFF_W2, T, 1536, 256, G, bid);
        EpiL E{ws, q.gin(10), q.gin(13)};
        gemm_phase<false>(lds, 256, S, E);
        SEAM(3);
    }
    if (IN(4)) { const PPv q = getpp(); phase_scanprep(q, lds); SEAM(4); }
    if (IN(5)) { const PPv q = getpp(); phase_recur(q, lds); SEAM(5); }
    if (IN(6)) { const PPv q = getpp(); phase_gn(q, lds); SEAM(6); }
    if (IN(7)) { const PPv q = getpp();
        MergeOrder S; S.so.init(ws + OFF_Z, ws + OFF_WR, T, 1024, 512, G, bid); S.A1 = (const char*)(ws + OFF_C); S.B1 = (const char*)(ws + OFF_WC);
        EpiMergeFused E{(bf16_t*)(ws + OFF_MERGED), (const unsigned char*)q.gout()};
        gemm_phase<false>(lds, 512, S, E);
        SEAM(7);
    }
    if (IN(9)) { const PPv q = getpp();
        StaticOrder S; S.init(ws + OFF_MERGED, ws + OFF_WO, T, 1024, 1024, G, bid);
        EpiO E{q.gin(0), q.gout(), (bf16_t*)(ws + OFF_HB2), ws + OFF_HB8};
        gemm_phase<false>(lds, 1024, S, E);
        SEAM(9);
    }
    if (IN(10)) { const PPv q = getpp(); phase_router(q, lds); SEAM(10); }
    if (IN(11)) { const PPv q = getpp(); phase_lists(q, lds); SEAM(11); }
    if (IN(12)) { const PPv q = getpp();
        const int* TILEE = (const int*)(ws + OFF_TILEE);
        MoeOrder S; S.A = (const char*)(ws + OFF_HB8); S.Bt = (const char*)(ws + OFF_WGU); S.K = 512; S.estride = (size_t)2048 * 1024;
        S.tile_e = TILEE; S.rowtok = (const int*)(ws + OFF_ROWTOK); S.ntiles = TILEE[1000]; S.nnt = 8; S.G = G; S.c = bid; S.gather = true;
        EpiMoe1 E{ws + OFF_ACT, (const float*)(ws + OFF_ROWRS), q.gin(31), q.gin(33)};
        gemm_phase<true, true>(lds, 512, S, E);
        SEAM(12);
    }
    if (IN(13)) { const PPv q = getpp();
        const int* TILEE = (const int*)(ws + OFF_TILEE);
        MoeOrder S; S.A = (const char*)(ws + OFF_ACT); S.Bt = (const char*)(ws + OFF_WD); S.K = 512; S.estride = (size_t)1024 * 1024;
        S.tile_e = TILEE; S.rowtok = nullptr; S.ntiles = TILEE[1000]; S.nnt = 4; S.G = G; S.c = bid; S.gather = false;
        EpiMoe2 E{(unsigned char*)q.gout(), (const int*)(ws + OFF_ROWSLOT), (const float*)(ws + OFF_ROWW), q.gin(35)};
        gemm_phase<false, true>(lds, 512, S, E);
        SEAM(13);
    }
    if (IN(14)) { const PPv q = getpp(); phase_final(q); }
}

extern "C" void kernel_launch(void* const* d_in, const int* in_sizes, int n_in, void* d_out, int out_size, void* d_ws, size_t ws_size,
                              hipStream_t stream) {
    constexpr size_t kDynLds = 160 * 1024;
    static int grid_blocks = 0;
    if (!grid_blocks) {
        int dev = 0, cus = 0, per_cu = 0;
        (void)hipGetDevice(&dev);
        (void)hipDeviceGetAttribute(&cus, hipDeviceAttributeMultiprocessorCount, dev);
        (void)hipFuncSetAttribute((const void*)mega, hipFuncAttributeMaxDynamicSharedMemorySize, (int)kDynLds);
        (void)hipOccupancyMaxActiveBlocksPerMultiprocessor(&per_cu, mega, 512, kDynLds);
        if (per_cu > 1) per_cu = 1;
        grid_blocks = cus * per_cu;
        fprintf(stderr, "cus=%d per_cu=%d ws_size=%zu need=%zu\n", cus, per_cu, ws_size, (size_t)WS_NEED);
    }
    if (ws_size < WS_NEED || n_in < 37 || grid_blocks < 128) { fprintf(stderr, "kernel_launch: unsupported configuration\n"); return; }
    Params p{};
    for (int i = 0; i < 37; ++i) p.in[i] = (const float*)d_in[i];
    p.out = (float*)d_out;
    p.ws = (unsigned char*)d_ws;
    p.ph_lo = 0; p.ph_hi = N_PHASES;
    (void)hipMemsetAsync((unsigned char*)d_ws + OFF_BAR, 0, 16384, stream);
    void* args[] = {&p};
    hipError_t e = hipLaunchCooperativeKernel((void*)mega, dim3(grid_blocks), dim3(512), args, kDynLds, stream);
    if (e != hipSuccess) fprintf(stderr, "cooperative launch failed: %s (grid %d)\n", hipGetErrorString(e), grid_blocks);
}
```

```cpp
#include <hip/hip_runtime.h>
#include <hip/hip_cooperative_groups.h>
#include <cstdio>
namespace cg = cooperative_groups;

#define LAS __attribute__((address_space(3)))
typedef unsigned short bf16_t;
typedef short bf16x8 __attribute__((ext_vector_type(8)));
typedef float f32x4 __attribute__((ext_vector_type(4)));
typedef float f32x2 __attribute__((ext_vector_type(2)));
typedef unsigned u32x4 __attribute__((ext_vector_type(4)));
typedef unsigned u32x2 __attribute__((ext_vector_type(2)));
#define LO2(v) __builtin_shufflevector(v, v, 0, 1)
#define HI2(v) __builtin_shufflevector(v, v, 2, 3)

constexpr int D = 1024, NBATCH = 8, SEQ = 4096, NMETA = 16;
constexpr int T = NBATCH * SEQ;
constexpr int NR = T + NMETA;
constexpr int NRP = 33024;
constexpr int PCOLS1 = 3584;
constexpr int NCOLS1 = 5632;
constexpr int NE = 32, TOPK = 4, DFF = 1024;
constexpr int MAXROWS = T * TOPK + NE * 256;
constexpr int MAXTILES = MAXROWS / 256;
constexpr float NORM_EPS = 1e-5f, LNX_EPS = 64e-5f;

constexpr int NCHUNK = 257, NUNITS = 64 * NCHUNK;
constexpr int REC_BYTES = 13568;
constexpr int RO_WH = 0, RO_RT = 2048, RO_U0T = 4096, RO_VT = 6144, RO_BKT = 8192, RO_ARK = 12288, RO_WCC = 13312;
constexpr int SLOT_BYTES = 15680, SO_G = 13568, SO_COEF = 15616, NSLOT = 9;
constexpr size_t SZ_ACT = (size_t)MAXROWS * 1024 * 2;
constexpr size_t SZ_WGU = (size_t)NE * 2048 * 1024 * 2;
constexpr size_t SZ_WD = (size_t)NE * 1024 * 1024 * 2;
constexpr size_t SZ_HB = (size_t)T * 1024 * 2;
constexpr size_t OFF_WGU = 0;
constexpr size_t OFF_HB8 = OFF_WGU + (size_t)NE * 2048 * 1024;
constexpr size_t OFF_WD = OFF_WGU + SZ_WGU;
constexpr size_t OFF_ACT = OFF_WD + SZ_WD;
constexpr size_t OFF_HB2 = OFF_ACT + SZ_ACT;
constexpr size_t OFF_RT = OFF_HB2 + SZ_HB;
constexpr size_t OFF_TOPI = OFF_RT;
constexpr size_t OFF_TOPW = OFF_TOPI + (size_t)T * 16;
constexpr size_t OFF_RANK = OFF_TOPW + (size_t)T * 16;
constexpr size_t OFF_RSTD2 = OFF_RANK + (size_t)T * 16;
constexpr size_t OFF_ROWTOK = OFF_RSTD2 + (size_t)T * 4;
constexpr size_t OFF_ROWSLOT = OFF_ROWTOK + (size_t)MAXROWS * 4;
constexpr size_t OFF_ROWW = OFF_ROWSLOT + (size_t)MAXROWS * 4;
constexpr size_t OFF_ROWRS = OFF_ROWW + (size_t)MAXROWS * 4;
constexpr size_t OFF_TILEE = OFF_ROWRS + (size_t)MAXROWS * 4;
constexpr size_t OFF_GCNT = OFF_TILEE + 4096;
constexpr size_t OFF_SM = OFF_GCNT + 256;
constexpr size_t OFF_WR = OFF_SM;
constexpr size_t OFF_WC = OFF_WR + (size_t)1024 * 512 * 2;
constexpr size_t OFF_WO = OFF_WC + (size_t)1024 * 512 * 2;
constexpr size_t OFF_W2 = OFF_WO + (size_t)1024 * 1024 * 2;
constexpr size_t OFF_RSTD1 = OFF_W2 + (size_t)1536 * 256 * 2;
constexpr size_t OFF_WRG = OFF_RSTD1 + (size_t)NRP * 4;
constexpr size_t OFF_BAR = OFF_WRG + (size_t)1024 * 32 * 4;
constexpr size_t WS_NEED = OFF_BAR + 16384;
constexpr size_t OFF_PRKV = 0;
constexpr size_t SZ_PRKV = (size_t)NR * 1536 * 2;
constexpr size_t OFF_LD = OFF_PRKV + SZ_PRKV;
constexpr size_t OFF_A = OFF_LD + (size_t)NRP * 512 * 4;
constexpr size_t OFF_X8 = OFF_LD;
constexpr size_t OFF_WIN8 = OFF_X8 + (size_t)T * 1024;
static_assert(OFF_WIN8 + (size_t)2048 * 1024 <= OFF_A, "layout");
constexpr size_t OFF_CH = OFF_A + (size_t)NRP * 512 * 2;
constexpr size_t OFF_PCONV = OFF_CH;
constexpr size_t SZ_PCONV = (size_t)NR * 2048 * 2;
constexpr size_t OFF_HB = OFF_PCONV + SZ_PCONV;
constexpr size_t OUT_XB = (size_t)T * 2048;
constexpr size_t OFF_L = OFF_HB + SZ_HB;
constexpr size_t OFF_WIN = OFF_L + (size_t)NRP * 256 * 2;
constexpr size_t CH_END = OFF_WIN + (size_t)NCOLS1 * 1024 * 2;
constexpr size_t OFF_MERGED = OFF_CH;
constexpr size_t OFF_G = CH_END;
constexpr size_t OFF_C = OFF_G + (size_t)NRP * 512 * 2;
constexpr size_t OFF_Z = OFF_C + (size_t)T * 512 * 2;
constexpr size_t OFF_COEF = OFF_Z + (size_t)T * 512 * 2;
constexpr size_t EARLY_END = OFF_COEF + (size_t)NR * 8 * 4;
static_assert(EARLY_END <= OFF_RT, "early buffers overflow");
static_assert(OFF_CH + (size_t)NUNITS * REC_BYTES <= CH_END, "chunk records overflow");
static_assert(OFF_CH >= OFF_WD + SZ_WD, "expert weights (written during the scan) must not touch live scan buffers");
static_assert(OFF_MERGED + SZ_HB <= OFF_HB2, "layout");
static_assert(OFF_PRKV % 16 == 0 && OFF_LD % 16 == 0 && OFF_A % 16 == 0 && OFF_CH % 16 == 0 && OFF_HB % 16 == 0 && OFF_L % 16 == 0 && OFF_WIN % 16 == 0 && OFF_G % 16 == 0 && OFF_C % 16 == 0 && OFF_Z % 16 == 0 && OFF_COEF % 16 == 0, "align");

#define GAS __attribute__((address_space(1)))
#define CAS __attribute__((address_space(4)))
struct Params {
    const float* in[37];
    float* out;
    unsigned char* ws;
    int ph_lo, ph_hi;
};
struct ParamsD {
    const GAS float* in[37];
    GAS float* out;
    GAS unsigned char* ws;
    int ph_lo, ph_hi;
};
static_assert(sizeof(Params) == sizeof(ParamsD), "argument views");
struct PPv {
    const CAS ParamsD* k;
    __device__ __forceinline__ const float* gin(int i) const { return (const float*)k->in[i]; }
    __device__ __forceinline__ float* gout() const { return (float*)k->out; }
    __device__ __forceinline__ unsigned char* gws() const { return (unsigned char*)k->ws; }
};
__device__ __forceinline__ PPv getpp() { const CAS ParamsD* k = (const CAS ParamsD*)__builtin_amdgcn_kernarg_segment_ptr(); asm volatile("" : "+s"(k)); return PPv{k}; }

typedef __bf16 bf16x2v __attribute__((ext_vector_type(2)));
__device__ __forceinline__ unsigned cvt_pk_bf16(float lo, float hi) { const f32x2 v = {lo, hi}; return __builtin_bit_cast(unsigned, __builtin_convertvector(v, bf16x2v)); }
__device__ __forceinline__ unsigned pk4_fp8(float a, float b, float c, float d) { int w = __builtin_amdgcn_cvt_pk_fp8_f32(a, b, 0, false); w = __builtin_amdgcn_cvt_pk_fp8_f32(c, d, w, true); return (unsigned)w; }
constexpr float W8_SCALE = 32.0f, W8_INV = 1.0f / 32.0f;
__device__ __forceinline__ bf16_t f2bf(float f) { unsigned u = __float_as_uint(f); u += 0x7FFFu + ((u >> 16) & 1u); return (bf16_t)(u >> 16); }
__device__ __forceinline__ float bf2f(bf16_t b) { return __uint_as_float(((unsigned)b) << 16); }
__device__ __forceinline__ float bflo(unsigned w) { return __uint_as_float(w << 16); }
__device__ __forceinline__ float bfhi(unsigned w) { return __uint_as_float(w & 0xFFFF0000u); }
__device__ __forceinline__ float sigmoidf_(float x) { return __builtin_amdgcn_rcpf(1.0f + __expf(-x)); }
__device__ __forceinline__ float wave_sum(float v) {
#pragma unroll
    for (int o = 32; o >= 1; o >>= 1) v += __shfl_xor(v, o);
    return v;
}
__device__ __forceinline__ float wave_sum_dpp(float v);
__device__ __forceinline__ int prev_row(int row, int d) {
    if (row < NMETA) return row - d >= 0 ? row - d : -1;
    const int s = (row - NMETA) & (SEQ - 1);
    return s >= d ? row - d : NMETA + s - d;
}

constexpr int BM = 256, BK = 64, HALF = 128, HTB = HALF * BK * 2, STAGE_BYTES = 8 * HTB, NXCD = 8, WGM = 8;
__device__ __forceinline__ int lds_byte(int r, int c) { const int st = (r >> 4) * 2 + (c >> 5), rr = r & 15, cc = c & 31, ob = rr * 64 + cc * 2; return st * 1024 + (ob ^ (((ob >> 9) & 1) << 5)); }
__device__ __forceinline__ void stage_rc(int b, int& R, int& C) { const int st = b / 1024, sb = b % 1024, swz = sb ^ (((sb >> 9) & 1) << 5); R = (st >> 1) * 16 + swz / 64; C = (st & 1) * 32 + (swz % 64) / 2; }
__device__ __forceinline__ int perm32(int rho) { const int n = rho >> 4, i = rho & 15; return 8 * (i >> 2) + 4 * n + (i & 3); }

struct Unit { int pm, pn, aux; };

struct StaticOrder {
    const char* A; const char* Bt; int K;
    int nM, nN, nwg, G, c;
    __device__ void init(const void* A_, const void* Bt_, int M, int N, int K_, int G_, int c_) { A = (const char*)A_; Bt = (const char*)Bt_; K = K_; nM = M / BM; nN = N / BM; nwg = nM * nN; G = G_; c = c_; }
    __device__ bool next(int i, Unit& u) const {
        const long L = (long)i * G + c; if (L >= nwg) return false;
        int wgid = (int)L; { const int q = nwg / NXCD, r = nwg % NXCD, xcd = wgid % NXCD, off = wgid / NXCD; wgid = (xcd < r ? xcd * (q + 1) : r * (q + 1) + (xcd - r) * q) + off; }
        const int nig = WGM * nN, gid = wgid / nig, fm = gid * WGM, gsz = (nM - fm) < WGM ? (nM - fm) : WGM;
        u.pm = fm + ((wgid % nig) % gsz); u.pn = (wgid % nig) / gsz; u.aux = 0; return true;
    }
    __device__ __forceinline__ const char* a_ptr(const Unit& u) const { return A + (size_t)u.pm * 256 * K * 2; }
    __device__ __forceinline__ const char* b_ptr(const Unit& u) const { return Bt + (size_t)u.pn * 256 * K * 2; }
    __device__ __forceinline__ int gather_row(const Unit&, int) const { return 0; }
    __device__ __forceinline__ const void* gather_src(const Unit&, int) const { return nullptr; }
};
struct MoeOrder {
    const char* A; const char* Bt; int K; size_t estride;
    const int* tile_e; const int* rowtok; int ntiles, nnt, G, c; bool gather;
    __device__ bool next(int i, Unit& u) const {
        int mt, nt;
        if ((G & 7) == 0 && ((G >> 3) % nnt) == 0) {
            const int x = c & 7, j = c >> 3, per = (G >> 3) / nnt;
            mt = (i * 8 + x) * per + j / nnt; nt = j % nnt;
        } else { const long L = (long)i * G + c; mt = (int)(L / nnt); nt = (int)(L % nnt); }
        if (mt >= ntiles) return false;
        u.pm = mt; u.pn = nt; u.aux = tile_e[mt]; return true;
    }
    __device__ __forceinline__ const char* a_ptr(const Unit& u) const { return gather ? A : A + (size_t)u.pm * 256 * K * 2; }
    __device__ __forceinline__ const char* b_ptr(const Unit& u) const { return Bt + (size_t)u.aux * estride + (size_t)u.pn * 256 * K * 2; }
    __device__ __forceinline__ int gather_row(const Unit& u, int r) const { return rowtok[u.pm * 256 + r]; }
    __device__ __forceinline__ const void* gather_src(const Unit& u, int lane) const { return rowtok + u.pm * 256 + lane * 4; }
};

typedef int i32x4 __attribute__((ext_vector_type(4)));
typedef int i32x8 __attribute__((ext_vector_type(8)));
template <bool GATHER, bool FP8 = false, class Epi, class Sched>
__device__ __forceinline__ void gemm_phase(LAS unsigned char* lds, const int K_, const Sched& S, const Epi& E) {
    int K = K_; asm volatile("" : "+s"(K));
    const int tid = threadIdx.x, wid = __builtin_amdgcn_readfirstlane(tid >> 6), lane = tid & 63, wr = wid >> 2, wc = wid & 3, fr = lane & 15, fq = lane >> 4;
    const int nt = K / BK;
    unsigned voffA[2], voffB[2]; int Rr[2], Cc[2];
#pragma unroll
    for (int i = 0; i < 2; ++i) { int R, C; stage_rc(tid * 16 + i * 8192, R, C); const int Rb = (R & ~31) + perm32(R & 31);
        Rr[i] = R; Cc[i] = C; voffA[i] = (unsigned)(R * K + C) * 2u; voffB[i] = (unsigned)(Rb * K + C) * 2u; }
    const size_t kstep = (size_t)(BK * 2);
    const size_t hstep = (size_t)HALF * K * 2;
    const unsigned ldsw = (unsigned)wid * 1024u;
    const int aoff = lds_byte(wr * 64 + fr, fq * 8), boff = lds_byte(wc * 32 + fr, fq * 8);
    unsigned vgc[2][2], vgn[2][2];
    LAS unsigned char* const parbase = lds + STAGE_BYTES;
    constexpr int NPAR = Epi::NPAR;
#define G_PAR_ISSUE(unit, uidx, hasnx, nxunit) do { \
        LAS unsigned char* _ps = parbase + ((uidx) & 1) * 4096; \
        if (wid < NPAR) __builtin_amdgcn_global_load_lds((const unsigned*)E.par_src(unit, wid, lane), (LAS unsigned*)(_ps + wid * 1024), 16, 0, 0); \
        if (GATHER && (hasnx) && wid == NPAR) __builtin_amdgcn_global_load_lds((const unsigned*)S.gather_src(nxunit, lane), (LAS unsigned*)(_ps + NPAR * 1024), 16, 0, 0); } while (0)
#define G_CAT8(x0, x1) __builtin_shufflevector(__builtin_bit_cast(i32x4, x0), __builtin_bit_cast(i32x4, x1), 0, 1, 2, 3, 4, 5, 6, 7)
#define G_SA(b, h) (((b) * 2 + (h)) * HTB)
#define G_SB(b, h) ((4 + (b) * 2 + (h)) * HTB)
#define G_STAGE(bufoff, gbase, voff) do { _Pragma("unroll") for (int _i = 0; _i < 2; ++_i) \
        __builtin_amdgcn_global_load_lds((const unsigned*)((const char*)(gbase) + (voff)[_i]), (LAS unsigned*)(lds + (bufoff) + ldsw + _i * 8192), 16, 0, 0); } while (0)
#define G_STAGE_A(bufoff, kptr, h, VG) do { if (GATHER) { G_STAGE(bufoff, kptr, VG[h]); } else { G_STAGE(bufoff, (kptr) + (h) * hstep, voffA); } } while (0)
#define G_LDA(dst, b, h) do { _Pragma("unroll") for (int m = 0; m < 4; ++m) { \
        if (FP8) dst##8[m] = G_CAT8(*(const LAS bf16x8*)(lds + G_SA(b, h) + aoff + m * 2048), *(const LAS bf16x8*)(lds + G_SA(b, h) + aoff + m * 2048 + 1024)); \
        else { _Pragma("unroll") for (int k = 0; k < 2; ++k) dst[m][k] = *(const LAS bf16x8*)(lds + G_SA(b, h) + aoff + m * 2048 + k * 1024); } } } while (0)
#define G_LDB(dst, b, h) do { _Pragma("unroll") for (int n = 0; n < 2; ++n) { \
        if (FP8) dst##8[n] = G_CAT8(*(const LAS bf16x8*)(lds + G_SB(b, h) + boff + n * 2048), *(const LAS bf16x8*)(lds + G_SB(b, h) + boff + n * 2048 + 1024)); \
        else { _Pragma("unroll") for (int k = 0; k < 2; ++k) dst[n][k] = *(const LAS bf16x8*)(lds + G_SB(b, h) + boff + n * 2048 + k * 1024); } } } while (0)
#define G_MMA(ai, bj, At, Bt) do { __builtin_amdgcn_s_setprio(1); _Pragma("unroll") for (int m = 0; m < 4; ++m) _Pragma("unroll") for (int n = 0; n < 2; ++n) { \
        if (FP8) asm volatile("v_mfma_scale_f32_16x16x128_f8f6f4 %0, %1, %2, %0, %3, %3 op_sel_hi:[0,0,0]" : "+v"(acc[ai][bj][m][n]) : "v"(Bt##8[n]), "v"(At##8[m]), "v"(sc8)); \
        else { _Pragma("unroll") for (int k = 0; k < 2; ++k) acc[ai][bj][m][n] = __builtin_amdgcn_mfma_f32_16x16x32_bf16(Bt[n][k], At[m][k], acc[ai][bj][m][n], 0, 0, 0); } } \
        __builtin_amdgcn_s_setprio(0); } while (0)
#define G_WAIT_V(n) asm volatile("s_waitcnt vmcnt(" #n ")" ::: "memory")
#define G_WAIT_L(n) asm volatile("s_waitcnt lgkmcnt(" #n ")" ::: "memory")
#define G_BAR __builtin_amdgcn_s_barrier()
#define G_SCHED __builtin_amdgcn_sched_barrier(0)
    Unit cur, nxt;
    int ui = 0;
    if (!S.next(0, cur)) return;
    f32x4 acc[2][2][4][2];
#pragma unroll
    for (int a = 0; a < 2; ++a)
#pragma unroll
        for (int b = 0; b < 2; ++b)
#pragma unroll
            for (int m = 0; m < 4; ++m)
#pragma unroll
                for (int n = 0; n < 2; ++n) acc[a][b][m][n] = (f32x4){0.f, 0.f, 0.f, 0.f};
    bf16x8 At[4][2], B0[2][2], B1[2][2];
    i32x8 At8[4], B08[2], B18[2];
    int sc8 = 0x7F7F7F7F; asm volatile("" : "+v"(sc8));
    const char* cA = S.a_ptr(cur); const char* cB = S.b_ptr(cur);
    if (GATHER) {
#pragma unroll
        for (int h = 0; h < 2; ++h)
#pragma unroll
            for (int i = 0; i < 2; ++i) vgc[h][i] = (unsigned)(S.gather_row(cur, h * HALF + Rr[i]) * K + Cc[i]) * 2u;
    }
    { Unit n1; const bool hn1 = S.next(1, n1); G_PAR_ISSUE(cur, 0, hn1, n1); }
    G_STAGE(G_SB(0, 0), cB, voffB); G_STAGE_A(G_SA(0, 0), cA, 0, vgc); G_STAGE(G_SB(0, 1), cB + hstep, voffB); G_STAGE_A(G_SA(0, 1), cA, 1, vgc);
    if (wr == 1) G_BAR;
    G_WAIT_V(4); G_BAR;
    G_STAGE(G_SB(1, 0), cB + kstep, voffB); G_STAGE_A(G_SA(1, 0), cA + kstep, 0, vgc); G_STAGE(G_SB(1, 1), cB + hstep + kstep, voffB);
    G_WAIT_V(6); G_BAR;
    for (;;) {
        const bool has_next = S.next(ui + 1, nxt);
        const char* nA = has_next ? S.a_ptr(nxt) : cA; const char* nB = has_next ? S.b_ptr(nxt) : cB;
        if (ui > 0) G_PAR_ISSUE(cur, ui, has_next, nxt);
        if (GATHER) {
#pragma unroll
            for (int h = 0; h < 2; ++h)
#pragma unroll
                for (int i = 0; i < 2; ++i) vgn[h][i] = vgc[h][i];
        }
        for (int t = 0; t < nt; t += 2) {
            const bool last = (t == nt - 2);
            const char* a1 = cA + (size_t)(t + 1) * kstep;
            const char* a2 = last ? nA : cA + (size_t)(t + 2) * kstep; const char* b2 = last ? nB : cB + (size_t)(t + 2) * kstep;
            const char* a3 = a2 + kstep; const char* b3 = b2 + kstep;
            unsigned vg2[2][2];
            if (GATHER) {
#pragma unroll
                for (int h = 0; h < 2; ++h)
#pragma unroll
                    for (int i = 0; i < 2; ++i) vg2[h][i] = last ? vgn[h][i] : vgc[h][i];
            }
            G_LDB(B0, 0, 0); G_SCHED; G_LDA(At, 0, 0); G_STAGE_A(G_SA(1, 1), a1, 1, vgc);
            G_WAIT_L(8); G_BAR; G_WAIT_L(0); G_MMA(0, 0, At, B0); G_BAR; G_SCHED;
            G_LDB(B1, 0, 1); G_STAGE(G_SB(0, 0), b2, voffB);
            G_BAR; G_WAIT_L(0); G_MMA(0, 1, At, B1); G_BAR;
            G_LDA(At, 0, 1); G_STAGE_A(G_SA(0, 0), a2, 0, vg2);
            G_BAR; G_WAIT_L(0); G_MMA(1, 0, At, B0); G_BAR; G_SCHED;
            G_STAGE(G_SB(0, 1), b2 + hstep, voffB);
            G_WAIT_V(6); G_BAR; G_MMA(1, 1, At, B1); G_BAR;
            G_LDB(B0, 1, 0); G_SCHED; G_LDA(At, 1, 0); G_STAGE_A(G_SA(0, 1), a2, 1, vg2);
            G_WAIT_L(8); G_BAR; G_WAIT_L(0); G_MMA(0, 0, At, B0); G_BAR; G_SCHED;
            G_LDB(B1, 1, 1); G_STAGE(G_SB(1, 0), b3, voffB);
            G_BAR; G_WAIT_L(0); G_MMA(0, 1, At, B1); G_BAR;
            G_LDA(At, 1, 1); G_STAGE_A(G_SA(1, 0), a3, 0, vg2);
            G_BAR; G_WAIT_L(0); G_MMA(1, 0, At, B0); G_BAR; G_SCHED;
            G_STAGE(G_SB(1, 1), b3 + hstep, voffB);
            G_WAIT_V(6); G_BAR; G_MMA(1, 1, At, B1); G_BAR;
            if (GATHER && t == 0 && has_next) {
                const LAS int* rows = (const LAS int*)(parbase + (ui & 1) * 4096 + NPAR * 1024);
#pragma unroll
                for (int h = 0; h < 2; ++h)
#pragma unroll
                    for (int i = 0; i < 2; ++i) vgn[h][i] = (unsigned)(rows[h * HALF + Rr[i]] * K + Cc[i]) * 2u;
            }
        }
        if (FP8) asm volatile("s_nop 15\n\ts_nop 15" ::: "memory");
        const bool keep_acc = E(acc, cur, wr, wc, fr, fq, (const LAS unsigned char*)(parbase + (ui & 1) * 4096));
        if (!has_next) break;
        if (!keep_acc)
#pragma unroll
        for (int a = 0; a < 2; ++a)
#pragma unroll
            for (int b = 0; b < 2; ++b)
#pragma unroll
                for (int m = 0; m < 4; ++m)
#pragma unroll
                    for (int n = 0; n < 2; ++n) acc[a][b][m][n] = (f32x4){0.f, 0.f, 0.f, 0.f};
        cur = nxt; cA = nA; cB = nB; ++ui;
        if (GATHER) {
#pragma unroll
            for (int h = 0; h < 2; ++h)
#pragma unroll
                for (int i = 0; i < 2; ++i) vgc[h][i] = vgn[h][i];
        }
    }
    G_WAIT_V(0);
    if (wr == 0) G_BAR;
    G_BAR;
#undef G_PAR_ISSUE
#undef G_SA
#undef G_SB
#undef G_STAGE
#undef G_STAGE_A
#undef G_LDA
#undef G_LDB
#undef G_MMA
#undef G_CAT8
#undef G_WAIT_V
#undef G_WAIT_L
#undef G_BAR
#undef G_SCHED
}

__device__ __forceinline__ float dpp_prev_row(float prev, float cur) {
    const int pb = __builtin_amdgcn_update_dpp(0, __builtin_bit_cast(int, prev), 0x121, 0xF, 0xF, false);
    return __builtin_bit_cast(float, __builtin_amdgcn_update_dpp(pb, __builtin_bit_cast(int, cur), 0x111, 0xF, 0xF, false));
}
struct EpiProj {
    bf16_t* prkv; bf16_t* pconv; unsigned char* gates; const float* rstd1; int pn0; float osc; bf16_t* lact;
    static constexpr int NPAR = 1;
    __device__ __forceinline__ const void* par_src(const Unit& u, int, int lane) const { return rstd1 + NMETA + u.pm * BM + lane * 4; }
    __device__ __forceinline__ bool operator()(const f32x4 (&acc)[2][2][4][2], const Unit& u, int wr, int wc, int fr, int fq, const LAS unsigned char* par) const {
        const int row0 = u.pm * BM + wr * 64 + fr;
        const int pn = u.pn + pn0;
        const bool isg = pn >= 14, isu = pn >= 8 && pn < 12, isl = pn == 12 || pn == 13;
        float rsv[2][4];
#pragma unroll
        for (int ai = 0; ai < 2; ++ai)
#pragma unroll
            for (int m = 0; m < 4; ++m) rsv[ai][m] = ((const LAS float*)par)[wr * 64 + fr + ai * HALF + m * 16] * osc;
        if (isl) {
            const int kind = pn == 13 ? 2 : (wc < 2 ? 0 : 1);
#pragma unroll
            for (int ai = 0; ai < 2; ++ai) {
                f32x2 p2s[4][4];
#pragma unroll
                for (int m = 0; m < 4; ++m) {
                    const f32x2 rs2 = {rsv[ai][m], rsv[ai][m]};
#pragma unroll
                    for (int q = 0; q < 4; ++q) { const f32x4 a4 = acc[ai][1][m][q >> 1]; p2s[m][q] = ((q & 1) ? HI2(a4) : LO2(a4)) * rs2; }
                }
#pragma unroll
                for (int m = 0; m < 4; ++m) {
                    const int row = row0 + ai * HALF + m * 16;
                    const f32x2 rs2 = {rsv[ai][m], rsv[ai][m]};
                    f32x2 p1[4], lv[4];
#pragma unroll
                    for (int q = 0; q < 4; ++q) {
                        const f32x4 a4 = acc[ai][0][m][q >> 1]; p1[q] = ((q & 1) ? HI2(a4) : LO2(a4)) * rs2;
                        const f32x2 pvb = p2s[m > 0 ? m - 1 : 0][q], pcb = p2s[m][q];
                        const f32x2 sh = {dpp_prev_row(pvb.x, pcb.x), dpp_prev_row(pvb.y, pcb.y)};
                        f32x2 x = p1[q] + sh;
                        if (kind == 0) { const f32x2 z = x * (f32x2){2.88539008178f, 2.88539008178f}; const f32x2 e = {__builtin_amdgcn_exp2f(z[0]), __builtin_amdgcn_exp2f(z[1])}; const f32x2 d = e + (f32x2){1.0f, 1.0f};
                                         x = (f32x2){1.0f, 1.0f} - (f32x2){2.0f, 2.0f} * (f32x2){__builtin_amdgcn_rcpf(d[0]), __builtin_amdgcn_rcpf(d[1])}; }
                        if (kind == 2) { const f32x2 z = x * (f32x2){-1.44269504089f, -1.44269504089f}; const f32x2 e = {__builtin_amdgcn_exp2f(z[0]), __builtin_amdgcn_exp2f(z[1])}; const f32x2 d = e + (f32x2){1.0f, 1.0f};
                                         x = (f32x2){__builtin_amdgcn_rcpf(d[0]), __builtin_amdgcn_rcpf(d[1])}; }
                        lv[q] = x;
                    }
                    u32x4 w; w.x = cvt_pk_bf16(lv[0][0], lv[0][1]); w.y = cvt_pk_bf16(lv[1][0], lv[1][1]); w.z = cvt_pk_bf16(lv[2][0], lv[2][1]); w.w = cvt_pk_bf16(lv[3][0], lv[3][1]);
                    *(u32x4*)(lact + (size_t)(NMETA + row) * 256 + (pn - 12) * 128 + wc * 32 + 8 * fq) = w;
                    bf16_t* rawp = pconv + (size_t)(NMETA + row) * 2048 + (pn - 6) * 256 + wc * 32 + 8 * fq;
                    if (m == 0 && fr == 0) { u32x4 r1; r1.x = cvt_pk_bf16(p1[0][0], p1[0][1]); r1.y = cvt_pk_bf16(p1[1][0], p1[1][1]); r1.z = cvt_pk_bf16(p1[2][0], p1[2][1]); r1.w = cvt_pk_bf16(p1[3][0], p1[3][1]); *(u32x4*)rawp = r1; }
                    if (m == 3 && fr == 15) { u32x4 r2; r2.x = cvt_pk_bf16(p2s[3][0][0], p2s[3][0][1]); r2.y = cvt_pk_bf16(p2s[3][1][0], p2s[3][1][1]); r2.z = cvt_pk_bf16(p2s[3][2][0], p2s[3][2][1]); r2.w = cvt_pk_bf16(p2s[3][3][0], p2s[3][3][1]); *(u32x4*)(rawp + HALF) = r2; }
                }
            }
            return false;
        }
#pragma unroll
        for (int ai = 0; ai < 2; ++ai)
#pragma unroll
            for (int m = 0; m < 4; ++m) {
                const int row = row0 + ai * HALF + m * 16;
                const float rs = isg ? rsv[ai][m] * -1.44269504089f : rsv[ai][m]; const f32x2 rs2 = {rs, rs}, one2 = {1.0f, 1.0f};
                bf16_t* rowp = (pn < 6 ? prkv + (size_t)(NMETA + row) * 1536 + pn * 256 : pconv + (size_t)(NMETA + row) * 2048 + (pn - 6) * 256) + wc * 32 + 8 * fq;
                if (isu) {
                    const f32x4 c0 = acc[ai][0][m][0], c1 = acc[ai][0][m][1], h0 = acc[ai][1][m][0], h1 = acc[ai][1][m][1];
                    const f32x2 rr2 = rs2 * rs2;
                    const f32x2 p0 = (LO2(c0) * LO2(h0)) * rr2, p1 = (HI2(c0) * HI2(h0)) * rr2, p2 = (LO2(c1) * LO2(h1)) * rr2, p3 = (HI2(c1) * HI2(h1)) * rr2;
                    u32x4 w; w.x = cvt_pk_bf16(p0[0], p0[1]); w.y = cvt_pk_bf16(p1[0], p1[1]); w.z = cvt_pk_bf16(p2[0], p2[1]); w.w = cvt_pk_bf16(p3[0], p3[1]);
                    *(u32x4*)(pconv + (size_t)(NMETA + row) * 2048 + 512 + (pn - 8) * 128 + wc * 32 + 8 * fq) = w;
                } else
#pragma unroll
                for (int bj = 0; bj < 2; ++bj) {
                    const f32x4 a0 = acc[ai][bj][m][0], a1 = acc[ai][bj][m][1];
                    f32x2 p[4] = {LO2(a0) * rs2, HI2(a0) * rs2, LO2(a1) * rs2, HI2(a1) * rs2};
                    if (isg) {
                        unsigned wq[2] = {0u, 0u};
#pragma unroll
                        for (int q = 0; q < 4; ++q) {
                            const f32x2 e = {__builtin_amdgcn_exp2f(p[q][0]), __builtin_amdgcn_exp2f(p[q][1])}; const f32x2 d = e + one2;
                            const f32x2 sg = {__builtin_amdgcn_rcpf(d[0]), __builtin_amdgcn_rcpf(d[1])}, t = sg * (f32x2){255.0f, 255.0f};
                            wq[q >> 1] = __builtin_amdgcn_cvt_pk_u8_f32(fmaxf(__builtin_rintf(t[0]), 1.0f), 2 * (q & 1), wq[q >> 1]);
                            wq[q >> 1] = __builtin_amdgcn_cvt_pk_u8_f32(fmaxf(__builtin_rintf(t[1]), 1.0f), 2 * (q & 1) + 1, wq[q >> 1]);
                        }
                        u32x2 w8; w8.x = wq[0]; w8.y = wq[1];
                        *(u32x2*)((unsigned char*)gates + (size_t)row * 2048 + (pn - 14) * 256 + wc * 32 + 8 * fq + bj * HALF) = w8;
                        continue;
                    }
                    u32x4 w; w.x = cvt_pk_bf16(p[0][0], p[0][1]); w.y = cvt_pk_bf16(p[1][0], p[1][1]); w.z = cvt_pk_bf16(p[2][0], p[2][1]); w.w = cvt_pk_bf16(p[3][0], p[3][1]);
                    *(u32x4*)(rowp + bj * HALF) = w;
                }
            }
        return false;
    }
};
struct EpiL {
    static constexpr int NPAR = 0;
    __device__ __forceinline__ const void* par_src(const Unit&, int, int) const { return nullptr; }
    unsigned char* wsb; const float* w0; const float* a0;
    __device__ __forceinline__ bool operator()(const f32x4 (&acc)[2][2][4][2], const Unit& u, int wr, int wc, int fr, int fq, const LAS unsigned char* par) const {
        const int row0 = NMETA + u.pm * BM + wr * 64 + fr;
        const int seg = u.pn >> 1;
        const int cb = (u.pn & 1) * 256 + wc * 32 + 8 * fq;
        const float* bias = seg == 0 ? w0 : a0;
        f32x4 bv[2][2];
#pragma unroll
        for (int bj = 0; bj < 2; ++bj) {
            bv[bj][0] = seg < 2 ? *(const f32x4*)(bias + cb + bj * HALF) : (f32x4){0.f, 0.f, 0.f, 0.f};
            bv[bj][1] = seg < 2 ? *(const f32x4*)(bias + cb + bj * HALF + 4) : (f32x4){0.f, 0.f, 0.f, 0.f};
        }
        const float sc = seg == 0 ? -0.60653065971f : 1.0f;
        bf16_t* ob = (bf16_t*)(wsb + (seg == 0 ? OFF_LD : seg == 1 ? OFF_A : OFF_G));
#pragma unroll
        for (int ai = 0; ai < 2; ++ai)
#pragma unroll
            for (int m = 0; m < 4; ++m) {
                const int row = row0 + ai * HALF + m * 16;
#pragma unroll
                for (int bj = 0; bj < 2; ++bj) {
                    const int c = cb + bj * HALF;
                    f32x4 v0 = acc[ai][bj][m][0] + bv[bj][0], v1 = acc[ai][bj][m][1] + bv[bj][1];
                    if (seg < 2) {
#pragma unroll
                        for (int j = 0; j < 4; ++j) { v0[j] = sc * sigmoidf_(v0[j]); v1[j] = sc * sigmoidf_(v1[j]); }
                    }
                    {
                        u32x4 w; w.x = cvt_pk_bf16(v0[0], v0[1]); w.y = cvt_pk_bf16(v0[2], v0[3]); w.z = cvt_pk_bf16(v1[0], v1[1]); w.w = cvt_pk_bf16(v1[2], v1[3]);
                        *(u32x4*)(ob + (size_t)row * 512 + c) = w;
                    }
                }
            }
        return false;
    }
};
struct MergeOrder {
    StaticOrder so; const char* A1; const char* B1;
    __device__ bool next(int i, Unit& u) const { const bool ok = so.next(i >> 1, u); u.aux = i & 1; return ok; }
    __device__ __forceinline__ const char* a_ptr(const Unit& u) const { return (u.aux ? A1 : so.A) + (size_t)u.pm * 256 * so.K * 2; }
    __device__ __forceinline__ const char* b_ptr(const Unit& u) const { return (u.aux ? B1 : so.Bt) + (size_t)u.pn * 256 * so.K * 2; }
    __device__ __forceinline__ int gather_row(const Unit&, int) const { return 0; }
    __device__ __forceinline__ const void* gather_src(const Unit&, int) const { return nullptr; }
};
struct EpiMergeFused {
    static constexpr int NPAR = 0;
    __device__ __forceinline__ const void* par_src(const Unit&, int, int) const { return nullptr; }
    bf16_t* merged; const unsigned char* gates;
    __device__ __forceinline__ bool operator()(f32x4 (&acc)[2][2][4][2], const Unit& u, int wr, int wc, int fr, int fq, const LAS unsigned char* par) const {
        const int row0 = u.pm * BM + wr * 64 + fr, col0 = u.pn * BM + wc * 32 + 8 * fq;
#pragma unroll
        for (int ai = 0; ai < 2; ++ai) {
            u32x2 gbw[4][2], gaw[4][2];
#pragma unroll
            for (int m = 0; m < 4; ++m)
#pragma unroll
                for (int bj = 0; bj < 2; ++bj) {
                    const unsigned char* gp = gates + (size_t)(row0 + ai * HALF + m * 16) * 2048 + col0 + bj * HALF;
                    gbw[m][bj] = *(const u32x2*)(gp + 1024);
                    gaw[m][bj] = u.aux == 0 ? *(const u32x2*)gp : (u32x2){0u, 0u};
                }
#pragma unroll
            for (int m = 0; m < 4; ++m)
#pragma unroll
                for (int bj = 0; bj < 2; ++bj) {
                    const int row = row0 + ai * HALF + m * 16, c = col0 + bj * HALF;
                    f32x2 gbp[4], res[4];
#pragma unroll
                    for (int q = 0; q < 4; ++q) { const unsigned wq = gbw[m][bj][q >> 1] >> (16 * (q & 1)); gbp[q] = (f32x2){(float)(wq & 0xffu), (float)((wq >> 8) & 0xffu)}; }
                    if (u.aux == 0) {
#pragma unroll
                        for (int q = 0; q < 4; ++q) {
                            const unsigned wq = gaw[m][bj][q >> 1] >> (16 * (q & 1));
                            const f32x2 gap = {(float)(wq & 0xffu), (float)((wq >> 8) & 0xffu)}, rc = {__builtin_amdgcn_rcpf(gbp[q][0]), __builtin_amdgcn_rcpf(gbp[q][1])};
                            const f32x2 sc = gap * rc;
                            f32x4& a4 = acc[ai][bj][m][q >> 1];
                            if (q & 1) { const f32x2 t = HI2(a4) * sc; a4[2] = t[0]; a4[3] = t[1]; } else { const f32x2 t = LO2(a4) * sc; a4[0] = t[0]; a4[1] = t[1]; }
                        }
                    } else {
#pragma unroll
                        for (int q = 0; q < 4; ++q) { const f32x4 a4 = acc[ai][bj][m][q >> 1]; res[q] = ((q & 1) ? HI2(a4) : LO2(a4)) * (gbp[q] * (f32x2){1.0f / 255.0f, 1.0f / 255.0f}); }
                        u32x4 w; w.x = cvt_pk_bf16(res[0][0], res[0][1]); w.y = cvt_pk_bf16(res[1][0], res[1][1]); w.z = cvt_pk_bf16(res[2][0], res[2][1]); w.w = cvt_pk_bf16(res[3][0], res[3][1]);
                        *(u32x4*)(merged + (size_t)row * 1024 + c) = w;
                    }
                }
        }
        return u.aux == 0;
    }
};
struct EpiO {
    static constexpr int NPAR = 0;
    __device__ __forceinline__ const void* par_src(const Unit&, int, int) const { return nullptr; }
    const bf16_t* x; float* h1; bf16_t* hb2; unsigned char* hb8;
    __device__ __forceinline__ bool operator()(const f32x4 (&acc)[2][2][4][2], const Unit& u, int wr, int wc, int fr, int fq, const LAS unsigned char* par) const {
        const int row0 = u.pm * BM + wr * 64 + fr, col0 = u.pn * BM + wc * 32 + 8 * fq;
#pragma unroll
        for (int ai = 0; ai < 2; ++ai) {
            u32x4 xw[4][2];
#pragma unroll
            for (int m = 0; m < 4; ++m)
#pragma unroll
                for (int bj = 0; bj < 2; ++bj) xw[m][bj] = *(const u32x4*)(x + (size_t)(row0 + ai * HALF + m * 16) * 1024 + col0 + bj * HALF);
#pragma unroll
            for (int m = 0; m < 4; ++m)
#pragma unroll
                for (int bj = 0; bj < 2; ++bj) {
                    const size_t o = (size_t)(row0 + ai * HALF + m * 16) * 1024 + col0 + bj * HALF;
                    const f32x4 a0 = acc[ai][bj][m][0], a1 = acc[ai][bj][m][1];
                    const u32x4 xq = xw[m][bj];
                    const f32x2 p0 = LO2(a0) + (f32x2){bflo(xq.x), bfhi(xq.x)}, p1 = HI2(a0) + (f32x2){bflo(xq.y), bfhi(xq.y)}, p2 = LO2(a1) + (f32x2){bflo(xq.z), bfhi(xq.z)}, p3 = HI2(a1) + (f32x2){bflo(xq.w), bfhi(xq.w)};
                    u32x4 w; w.x = cvt_pk_bf16(p0[0], p0[1]); w.y = cvt_pk_bf16(p1[0], p1[1]); w.z = cvt_pk_bf16(p2[0], p2[1]); w.w = cvt_pk_bf16(p3[0], p3[1]);
                    *(u32x4*)(hb2 + o) = w;
                    u32x2 w8; w8.x = pk4_fp8(p0[0], p0[1], p1[0], p1[1]); w8.y = pk4_fp8(p2[0], p2[1], p3[0], p3[1]);
                    *(u32x2*)(hb8 + o) = w8;
                }
        }
        return false;
    }
};
struct EpiMoe1 {
    unsigned char* act; const float* rowrs; const float* bg; const float* bu;
    static constexpr int NPAR = 2;
    __device__ __forceinline__ const void* par_src(const Unit& u, int piece, int lane) const {
        if (piece == 0) return rowrs + u.pm * BM + lane * 4;
        return (lane < 32 ? bg : bu) + (size_t)u.aux * DFF + u.pn * 128 + (lane & 31) * 4;
    }
    __device__ __forceinline__ bool operator()(const f32x4 (&acc)[2][2][4][2], const Unit& u, int wr, int wc, int fr, int fq, const LAS unsigned char* par) const {
        const int row0 = u.pm * BM + wr * 64 + fr, ff0 = u.pn * 128 + wc * 32 + 8 * fq;
        const LAS float* bgp = (const LAS float*)(par + 1024) + wc * 32 + 8 * fq; const LAS float* bup = bgp + 128;
        const f32x4 bg0 = *(const LAS f32x4*)bgp, bg1 = *(const LAS f32x4*)(bgp + 4), bu0 = *(const LAS f32x4*)bup, bu1 = *(const LAS f32x4*)(bup + 4);
        constexpr float KE = -1.702f * 1.44269504089f;
        const f32x2 ke2 = {KE, KE}, ike2 = {1.0f / KE, 1.0f / KE}, one2 = {1.0f, 1.0f};
        const f32x2 bgv[4] = {LO2(bg0) * ke2, HI2(bg0) * ke2, LO2(bg1) * ke2, HI2(bg1) * ke2}, buv[4] = {LO2(bu0), HI2(bu0), LO2(bu1), HI2(bu1)};
        float rsv[2][4];
#pragma unroll
        for (int ai = 0; ai < 2; ++ai)
#pragma unroll
            for (int m = 0; m < 4; ++m) rsv[ai][m] = ((const LAS float*)par)[wr * 64 + fr + ai * HALF + m * 16];
#pragma unroll
        for (int ai = 0; ai < 2; ++ai)
#pragma unroll
            for (int m = 0; m < 4; ++m) {
                const int row = row0 + ai * HALF + m * 16;
                const float rs = rsv[ai][m] * W8_INV;
                const f32x2 rs2 = {rs, rs}, rsk2 = {rs * KE, rs * KE};
                f32x2 res[4];
#pragma unroll
                for (int q = 0; q < 4; ++q) {
                    const f32x4 ag4 = acc[ai][0][m][q >> 1], au4 = acc[ai][1][m][q >> 1];
                    const f32x2 ag = (q & 1) ? HI2(ag4) : LO2(ag4), au = (q & 1) ? HI2(au4) : LO2(au4);
                    const f32x2 gk = ag * rsk2 + bgv[q], uu = au * rs2 + buv[q];
                    const f32x2 z = {fmaxf(gk[0], 7.0f * KE), fmaxf(gk[1], 7.0f * KE)};
                    const f32x2 up = {fminf(fmaxf(uu[0], -7.0f), 7.0f), fminf(fmaxf(uu[1], -7.0f), 7.0f)};
                    const f32x2 e = {__builtin_amdgcn_exp2f(z[0]), __builtin_amdgcn_exp2f(z[1])};
                    const f32x2 d = e + one2;
                    const f32x2 sg = {__builtin_amdgcn_rcpf(d[0]), __builtin_amdgcn_rcpf(d[1])};
                    res[q] = ((up * ike2 + ike2) * z) * sg;
                }
                u32x2 w; w.x = pk4_fp8(res[0][0], res[0][1], res[1][0], res[1][1]); w.y = pk4_fp8(res[2][0], res[2][1], res[3][0], res[3][1]);
                *(u32x2*)(act + (size_t)row * DFF + ff0) = w;
            }
        return false;
    }
};
struct EpiMoe2 {
    unsigned char* y8; const int* rowslot; const float* roww; const float* bd;
    static constexpr int NPAR = 3;
    __device__ __forceinline__ const void* par_src(const Unit& u, int piece, int lane) const {
        if (piece == 0) return rowslot + u.pm * BM + lane * 4;
        if (piece == 1) return roww + u.pm * BM + lane * 4;
        return bd + (size_t)u.aux * D + u.pn * BM + lane * 4;
    }
    __device__ __forceinline__ bool operator()(const f32x4 (&acc)[2][2][4][2], const Unit& u, int wr, int wc, int fr, int fq, const LAS unsigned char* par) const {
        const int row0 = u.pm * BM + wr * 64 + fr, col0 = u.pn * BM + wc * 32 + 8 * fq;
        const LAS float* bp = (const LAS float*)(par + 2048) + wc * 32 + 8 * fq;
        f32x4 bv[2][2];
#pragma unroll
        for (int bj = 0; bj < 2; ++bj) { bv[bj][0] = *(const LAS f32x4*)(bp + bj * HALF); bv[bj][1] = *(const LAS f32x4*)(bp + bj * HALF + 4); }
        int slotv[2][4]; float wv8[2][4];
#pragma unroll
        for (int ai = 0; ai < 2; ++ai)
#pragma unroll
            for (int m = 0; m < 4; ++m) { const int rl = wr * 64 + fr + ai * HALF + m * 16; slotv[ai][m] = ((const LAS int*)par)[rl]; wv8[ai][m] = ((const LAS float*)(par + 1024))[rl]; }
#pragma unroll
        for (int ai = 0; ai < 2; ++ai)
#pragma unroll
            for (int m = 0; m < 4; ++m) {
                const int slot = slotv[ai][m];
                if (slot >= 0) {
                    const float w8 = wv8[ai][m]; const f32x2 w2 = {w8, w8}, inv2 = {W8_INV, W8_INV};
#pragma unroll
                    for (int bj = 0; bj < 2; ++bj) {
                        const f32x4 a0 = acc[ai][bj][m][0], a1 = acc[ai][bj][m][1];
                        const f32x2 p0 = (LO2(a0) * inv2 + LO2(bv[bj][0])) * w2, p1 = (HI2(a0) * inv2 + HI2(bv[bj][0])) * w2, p2 = (LO2(a1) * inv2 + LO2(bv[bj][1])) * w2, p3 = (HI2(a1) * inv2 + HI2(bv[bj][1])) * w2;
                        u32x2 w; w.x = pk4_fp8(p0[0], p0[1], p1[0], p1[1]); w.y = pk4_fp8(p2[0], p2[1], p3[0], p3[1]);
                        *(u32x2*)(y8 + (size_t)slot * 1024 + col0 + bj * HALF) = w;
                    }
                }
            }
        return false;
    }
};

__device__ __forceinline__ void transpose_tile(LAS float* tile, const float* src, int ldsrc, int k0, int n0, bf16_t* dst, int ldd, int drow0, const float* sa, const float* mu, int mode, bool zero, unsigned char* dst8 = nullptr, int drow8 = 0) {
    const int tid = threadIdx.x;
    if (!zero) {
#pragma unroll
        for (int i = 0; i < 2; ++i) {
            const int r = (tid >> 4) + 32 * i, c4 = (tid & 15) * 4;
            const f32x4 v = *(const f32x4*)(src + (size_t)(k0 + r) * ldsrc + n0 + c4);
            LAS float* t = tile + r * 65 + c4;
            t[0] = v[0]; t[1] = v[1]; t[2] = v[2]; t[3] = v[3];
        }
    }
    __syncthreads();
    {
        const int n = tid >> 3, kq = tid & 7;
        float v[8];
#pragma unroll
        for (int j = 0; j < 8; ++j) {
            const int k = k0 + 8 * kq + j;
            float s = sa ? sa[k] : 1.0f;
            if (mode == 1) s *= (1.0f - mu[k]);
            if (mode == 2) s *= mu[k];
            v[j] = zero ? 0.f : tile[(8 * kq + j) * 65 + n] * s;
        }
        u32x4 w; w.x = cvt_pk_bf16(v[0], v[1]); w.y = cvt_pk_bf16(v[2], v[3]); w.z = cvt_pk_bf16(v[4], v[5]); w.w = cvt_pk_bf16(v[6], v[7]);
        *(u32x4*)(dst + (size_t)(drow0 + n) * ldd + k0 + 8 * kq) = w;
        if (dst8) { u32x2 w8; w8.x = pk4_fp8(v[0] * W8_SCALE, v[1] * W8_SCALE, v[2] * W8_SCALE, v[3] * W8_SCALE); w8.y = pk4_fp8(v[4] * W8_SCALE, v[5] * W8_SCALE, v[6] * W8_SCALE, v[7] * W8_SCALE); *(u32x2*)(dst8 + (size_t)(drow8 + n) * ldd + k0 + 8 * kq) = w8; }
    }
    __syncthreads();
}

__device__ __forceinline__ void phase_prep(const PPv& p, LAS unsigned char* lds) {
    const int tid = threadIdx.x, bid = blockIdx.x, nb = gridDim.x, lane = tid & 63, wave = tid >> 6;
    unsigned char* ws = p.gws();
    const float* x = p.gin(0); const float* meta = p.gin(1); const float* g1 = p.gin(2);
    if (bid == 0 && tid < 64) ((int*)(ws + OFF_GCNT))[tid] = 0;
    {
        bf16_t* HB = (bf16_t*)((unsigned char*)p.gout() + OUT_XB); float* rstd1 = (float*)(ws + OFF_RSTD1);
        for (int row0 = (bid * 8 + wave) * 4; row0 < NR; row0 += nb * 32) {
            f32x4 v[4][4];
#pragma unroll
            for (int u = 0; u < 4; ++u) {
                const int row = row0 + u < NR ? row0 + u : NR - 1;
                const float* src = row < NMETA ? meta + (size_t)row * D : x + (size_t)(row - NMETA) * D;
#pragma unroll
                for (int i = 0; i < 4; ++i) v[u][i] = __builtin_nontemporal_load((const f32x4*)(src + i * 256 + lane * 4));
            }
#pragma unroll
            for (int u = 0; u < 4; ++u) {
                const int row = row0 + u;
                if (row < NR) {
                    float ss = 0.f;
#pragma unroll
                    for (int i = 0; i < 4; ++i) ss += v[u][i][0] * v[u][i][0] + v[u][i][1] * v[u][i][1] + v[u][i][2] * v[u][i][2] + v[u][i][3] * v[u][i][3];
                    ss = wave_sum_dpp(ss);
                    if (lane == 0) rstd1[row] = rsqrtf(ss * (1.0f / D) + NORM_EPS);
                    if (row >= NMETA) {
                        bf16_t* d = HB + (size_t)(row - NMETA) * D;
#pragma unroll
                        for (int i = 0; i < 4; ++i) { u32x2 w; w.x = cvt_pk_bf16(v[u][i][0], v[u][i][1]); w.y = cvt_pk_bf16(v[u][i][2], v[u][i][3]); *(u32x2*)(d + i * 256 + lane * 4) = w;
                            *(unsigned*)(ws + OFF_X8 + (size_t)(row - NMETA) * D + i * 256 + lane * 4) = pk4_fp8(v[u][i][0], v[u][i][1], v[u][i][2], v[u][i][3]); }
                    }
                }
            }
        }
    }
    LAS float* tile = (LAS float*)lds;
    {
        bf16_t* WIN = (bf16_t*)(ws + OFF_WIN);
        const float* w_in = p.gin(3);
        for (int j = bid; j < 16 * 88; j += nb) {
            const int kt = j & 15, ntile = j >> 4, n0 = ntile * 64;
            const float* src; int ld, sn0, mode = 0; const float* mu = nullptr;
            if (n0 < 3072) { src = w_in; ld = 5120; sn0 = n0;
                if (n0 >= 2048) { const int qq = (n0 - 2048) >> 8, j0 = (n0 - 2048) & 255; sn0 = j0 < 128 ? 2048 + qq * 128 + j0 : 2560 + qq * 128 + (j0 - 128); } }
            else if (n0 < 3584) {
                const int seg = (n0 - 3072) >> 6;
                if (seg < 4) { const bool isa = seg & 1; src = isa ? p.gin(14) : p.gin(11); ld = 64; sn0 = 0; mu = isa ? p.gin(8) : p.gin(7); mode = 1 + (seg >> 1); }
                else { src = p.gin(16); ld = 128; sn0 = (seg & 1) * 64; mu = p.gin(9); mode = seg < 6 ? 1 : 2; }
            } else { src = w_in; ld = 5120; sn0 = n0 - 512; }
            transpose_tile(tile, src, ld, kt * 64, sn0, WIN, 1024, n0, g1, mu, mode, false, n0 >= 3584 ? ws + OFF_WIN8 : nullptr, n0 - 3584);
        }
        for (int j = bid; j < 2 * 128; j += nb) {
            const int which = j >> 7, jj = j & 127, kt = jj & 7, ntile = jj >> 3;
            transpose_tile(tile, which ? p.gin(25) : p.gin(23), 1024, kt * 64, ntile * 64, (bf16_t*)(ws + (which ? OFF_WC : OFF_WR)), 512, ntile * 64, nullptr, nullptr, 0, false);
        }
        for (int j = bid; j < 256; j += nb) {
            const int kt = j & 15, ntile = j >> 4;
            transpose_tile(tile, p.gin(26), 1024, kt * 64, ntile * 64, (bf16_t*)(ws + OFF_WO), 1024, ntile * 64, nullptr, nullptr, 0, false);
        }
        for (int j = bid; j < 96; j += nb) {
            const int kt = j & 3, ntile = j >> 2, seg = ntile >> 3, nn0 = (ntile & 7) * 64;
            const float* src = nullptr; int sk0 = 0; bool zero = true;
            if (seg == 0 && kt == 0) { src = p.gin(12); sk0 = 0; zero = false; }
            if (seg == 1 && kt == 1) { src = p.gin(15); sk0 = 0; zero = false; }
            if (seg == 2 && kt >= 2) { src = p.gin(17); sk0 = (kt - 2) * 64; zero = false; }
            const float* srcs = zero ? p.gin(12) : src + (size_t)(sk0 - kt * 64) * 512;
            transpose_tile(tile, srcs, 512, kt * 64, nn0, (bf16_t*)(ws + OFF_W2), 256, ntile * 64, nullptr, nullptr, 0, zero);
        }
        {
            bf16_t* WRB = (bf16_t*)(ws + OFF_WRG); const float* g2 = p.gin(27); const float* wr_ = p.gin(28);
            for (int i = bid * 512 + tid; i < 1024 * 32; i += nb * 512) {
                const int k = i >> 5, e = i & 31; const float w = g2[k] * wr_[i]; const bf16_t hi = f2bf(w);
                WRB[(size_t)e * 1024 + k] = hi; WRB[(size_t)(32 + e) * 1024 + k] = f2bf(w - bf2f(hi));
            }
        }
    }
}

__device__ __forceinline__ void phase_meta_proj(const PPv& p, LAS unsigned char* lds) {
    const int tid = threadIdx.x, bid = blockIdx.x, lane = tid & 63, wave = tid >> 6;
    unsigned char* ws = p.gws();
    LAS float* sm = (LAS float*)lds;
    const float* meta = p.gin(1);
    for (int i = tid; i < 16 * 256; i += 512) { const int r = i >> 8, c4 = (i & 255) * 4; const f32x4 v = *(const f32x4*)(meta + r * 1024 + c4); LAS float* d = sm + r * 1028 + c4; d[0] = v[0]; d[1] = v[1]; d[2] = v[2]; d[3] = v[3]; }
    __syncthreads();
    const float* rstd1 = (const float*)(ws + OFF_RSTD1);
    for (int nbase = bid * 14; nbase < PCOLS1; nbase += gridDim.x * 14) {
        for (int nn = wave; nn < 14; nn += 8) {
            const int n = nbase + nn;
            if (n >= PCOLS1) break;
            const bool inu = n >= 2048 && n < 3072;
            if (inu && ((n - 2048) & 128)) continue;
            float outp = 1.0f;
#pragma unroll 1
            for (int rep = 0; rep < (inu ? 2 : 1); ++rep) {
            const bf16_t* wrow = (const bf16_t*)(ws + OFF_WIN) + (size_t)(n + rep * 128) * 1024;
            const u32x4 w0 = *(const u32x4*)(wrow + 8 * lane), w1 = *(const u32x4*)(wrow + 512 + 8 * lane);
            const float wf[16] = {bflo(w0.x), bfhi(w0.x), bflo(w0.y), bfhi(w0.y), bflo(w0.z), bfhi(w0.z), bflo(w0.w), bfhi(w0.w),
                                  bflo(w1.x), bfhi(w1.x), bflo(w1.y), bfhi(w1.y), bflo(w1.z), bfhi(w1.z), bflo(w1.w), bfhi(w1.w)};
            float outv = 0.f;
#pragma unroll
            for (int pr = 0; pr < 16; ++pr) {
                const LAS float* m0 = sm + pr * 1028 + 8 * lane;
                const f32x4 a0 = *(const LAS f32x4*)m0, a1 = *(const LAS f32x4*)(m0 + 4), a2 = *(const LAS f32x4*)(m0 + 512), a3 = *(const LAS f32x4*)(m0 + 516);
                float acc = a0[0] * wf[0] + a0[1] * wf[1] + a0[2] * wf[2] + a0[3] * wf[3] + a1[0] * wf[4] + a1[1] * wf[5] + a1[2] * wf[6] + a1[3] * wf[7]
                          + a2[0] * wf[8] + a2[1] * wf[9] + a2[2] * wf[10] + a2[3] * wf[11] + a3[0] * wf[12] + a3[1] * wf[13] + a3[2] * wf[14] + a3[3] * wf[15];
                acc = wave_sum_dpp(acc);
                outv = (lane == pr) ? acc * rstd1[pr] : outv;
            }
            outp *= outv;
            }
            if (lane < 16) {
                if (n < 1536) ((bf16_t*)(ws + OFF_PRKV))[(size_t)lane * 1536 + n] = f2bf(outp);
                else if (inu) ((bf16_t*)(ws + OFF_PCONV))[(size_t)lane * 2048 + 512 + ((n - 2048) >> 8) * 128 + ((n - 2048) & 127)] = f2bf(outp);
                else ((bf16_t*)(ws + OFF_PCONV))[(size_t)lane * 2048 + n - 1536] = f2bf(outp);
            }
        }
    }
    __syncthreads();
}

__device__ __forceinline__ void phase_meta_lora(const PPv& p) {
    const int tid = threadIdx.x, bid = blockIdx.x, nb = gridDim.x, lane = tid & 63, wave = tid >> 6;
    unsigned char* ws = p.gws();
    const bf16_t* L = (const bf16_t*)(ws + OFF_L); const bf16_t* W2 = (const bf16_t*)(ws + OFF_W2);
    for (int n = bid * 8 + wave; n < 1536; n += nb * 8) {
        const int seg = n >> 9, c = n & 511;
        const u32x2 wv = *(const u32x2*)(W2 + (size_t)n * 256 + 4 * lane);
        const float w0v = bflo(wv.x), w1v = bfhi(wv.x), w2v = bflo(wv.y), w3v = bfhi(wv.y);
        float outv = 0.f;
#pragma unroll
        for (int r = 0; r < 16; ++r) {
            const u32x2 lv = *(const u32x2*)(L + (size_t)r * 256 + 4 * lane);
            float acc = bflo(lv.x) * w0v + bfhi(lv.x) * w1v + bflo(lv.y) * w2v + bfhi(lv.y) * w3v;
            acc = wave_sum_dpp(acc);
            outv = (lane == r) ? acc : outv;
        }
        if (lane < 16) {
            float v = outv;
            if (seg == 0) v = -0.60653065971f * sigmoidf_(v + p.gin(10)[c]);
            if (seg == 1) v = sigmoidf_(v + p.gin(13)[c]);
            bf16_t* ob = (bf16_t*)(ws + (seg == 0 ? OFF_LD : seg == 1 ? OFF_A : OFF_G));
            ob[(size_t)lane * 512 + c] = f2bf(v);
        }
    }
}

__device__ __forceinline__ void phase_lprep_conv(const PPv& p) {
    const int tid = threadIdx.x, bid = blockIdx.x, nb = gridDim.x;
    unsigned char* ws = p.gws();
    const bf16_t* PROJ = (const bf16_t*)(ws + OFF_PCONV);
    constexpr int PCOLS = 2048;
    bf16_t* L = (bf16_t*)(ws + OFF_L);
    for (int i = bid * 512 + tid; i < (NMETA + T / 64) * 32; i += nb * 512) {
        const int ri = i >> 5, gq = i & 31, row = ri < NMETA ? ri : NMETA + (ri - NMETA) * 64;
        u32x4 w = (u32x4){0u, 0u, 0u, 0u};
        {
            int ca, cb;
            if (gq < 8) { ca = 1536 + gq * 8; cb = ca + 128; }
            else if (gq < 16) { ca = 1536 + 64 + (gq - 8) * 8; cb = ca + 128; }
            else { ca = 1536 + 256 + (gq - 16) * 8; cb = ca + 128; }
            const u32x4 va = *(const u32x4*)(PROJ + (size_t)row * PCOLS + ca);
            const int pr = prev_row(row, 1);
            u32x4 vb = (u32x4){0u, 0u, 0u, 0u};
            if (pr >= 0) vb = *(const u32x4*)(PROJ + (size_t)pr * PCOLS + cb);
            float v[8] = {bflo(va.x) + bflo(vb.x), bfhi(va.x) + bfhi(vb.x), bflo(va.y) + bflo(vb.y), bfhi(va.y) + bfhi(vb.y), bflo(va.z) + bflo(vb.z), bfhi(va.z) + bfhi(vb.z), bflo(va.w) + bflo(vb.w), bfhi(va.w) + bfhi(vb.w)};
#pragma unroll
            for (int j = 0; j < 8; ++j) { if (gq < 8) v[j] = tanhf(v[j]); else if (gq >= 16) v[j] = sigmoidf_(v[j]); }
            w.x = cvt_pk_bf16(v[0], v[1]); w.y = cvt_pk_bf16(v[2], v[3]); w.z = cvt_pk_bf16(v[4], v[5]); w.w = cvt_pk_bf16(v[6], v[7]);
        }
        *(u32x4*)(L + (size_t)row * 256 + gq * 8) = w;
    }
    bf16_t* C = (bf16_t*)(ws + OFF_C);
    const float* cw = p.gin(24);
    for (int i = bid * 512 + tid; i < T * 64; i += nb * 512) {
        const int m = i >> 6, ch = (i & 63) * 8, row = NMETA + m;
        const int r1 = prev_row(row, 1), r2 = prev_row(row, 2);
        const bf16_t* p0 = PROJ + (size_t)row * PCOLS; const bf16_t* p1 = PROJ + (size_t)r1 * PCOLS; const bf16_t* p2 = PROJ + (size_t)r2 * PCOLS;
        const u32x4 vb = *(const u32x4*)(p0 + ch);
        const u32x4 c0 = *(const u32x4*)(p0 + 512 + ch), c1 = *(const u32x4*)(p1 + 512 + ch), c2 = *(const u32x4*)(p2 + 512 + ch);
        float o[8];
#pragma unroll
        for (int j = 0; j < 8; ++j) {
            const unsigned wb = j < 2 ? vb.x : j < 4 ? vb.y : j < 6 ? vb.z : vb.w;
            const unsigned wc0 = j < 2 ? c0.x : j < 4 ? c0.y : j < 6 ? c0.z : c0.w;
            const unsigned wc1 = j < 2 ? c1.x : j < 4 ? c1.y : j < 6 ? c1.z : c1.w;
            const unsigned wc2 = j < 2 ? c2.x : j < 4 ? c2.y : j < 6 ? c2.z : c2.w;
            const bool hi = j & 1;
            const float b = hi ? bfhi(wb) : bflo(wb);
            const float u0 = hi ? bfhi(wc0) : bflo(wc0), u1 = hi ? bfhi(wc1) : bflo(wc1), u2 = hi ? bfhi(wc2) : bflo(wc2);
            const float conv = cw[ch + j] * u2 + cw[512 + ch + j] * u1 + cw[1024 + ch + j] * u0;
            o[j] = b * conv;
        }
        u32x4 w; w.x = cvt_pk_bf16(o[0], o[1]); w.y = cvt_pk_bf16(o[2], o[3]); w.z = cvt_pk_bf16(o[4], o[5]); w.w = cvt_pk_bf16(o[6], o[7]);
        *(u32x4*)(C + (size_t)m * 512 + ch) = w;
    }
}

template <int CTRL> __device__ __forceinline__ float dppmov(float v) { return __builtin_bit_cast(float, __builtin_amdgcn_update_dpp(0, __builtin_bit_cast(int, v), CTRL, 0xF, 0xF, true)); }
__device__ __forceinline__ float wave_sum_dpp(float v) {
    v += dppmov<0xB1>(v);
    v += dppmov<0x4E>(v);
    v += dppmov<0x141>(v);
    v += dppmov<0x140>(v);
    { float c = v; asm volatile("v_nop\n\tv_nop\n\tv_permlane16_swap_b32 %0, %1\n\tv_nop" : "+v"(v), "+v"(c)); v += c; }
    { float c = v; asm volatile("v_nop\n\tv_nop\n\tv_permlane32_swap_b32 %0, %1\n\tv_nop" : "+v"(v), "+v"(c)); v += c; }
    return v;
}
typedef float f32x16 __attribute__((ext_vector_type(16)));

struct RawTok { bf16_t r, k, v, a, ld; };
__device__ __forceinline__ RawTok load_raw(const bf16_t* PRKV, const bf16_t* Ab, const bf16_t* LD, int row, int col) {
    RawTok q; const bf16_t* p0 = PRKV + (size_t)row * 1536 + col;
    q.r = p0[0]; q.k = p0[512]; q.v = p0[1024]; q.a = Ab[(size_t)row * 512 + col]; q.ld = LD[(size_t)row * 512 + col];
    return q;
}
__device__ __forceinline__ void unit_geom(int uid, int lane, int& b, int& h, int& c, int& col, int& row0) {
    const int bh = uid / NCHUNK; c = uid - bh * NCHUNK; b = bh >> 3; h = bh & 7; col = h * 64 + lane;
    row0 = c == 0 ? 0 : b * SEQ + c * 16;
}
__device__ __forceinline__ void phase_scanprep(const PPv& p, LAS unsigned char* lds) {
    const int tid = threadIdx.x, bid = blockIdx.x, nb = gridDim.x, lane = tid & 63, wave = tid >> 6;
    unsigned char* ws = p.gws();
    const bf16_t* PRKV = (const bf16_t*)(ws + OFF_PRKV);
    const bf16_t* LD = (const bf16_t*)(ws + OFF_LD);
    const bf16_t* Ab = (const bf16_t*)(ws + OFF_A);
    float* COEF = (float*)(ws + OFF_COEF);
    LAS unsigned char* wl = lds + wave * 13824;
    LAS bf16_t* AR = (LAS bf16_t*)wl;
    LAS bf16_t* BK = (LAS bf16_t*)(wl + 4608);
    LAS float* DM = (LAS float*)(wl + 9216);
    const int qperm = (lane & 32) | (((lane >> 2) & 3) << 3) | (((lane >> 4) & 1) << 2) | (lane & 3);
    int uid = bid * 8 + wave;
    if (uid >= NUNITS) return;
    int b, h, c, col, row0;
    unit_geom(uid, lane, b, h, c, col, row0);
    RawTok q[16], qn[16];
    bf16_t prr = 0, prk = 0, prv = 0, nprr = 0, nprk = 0, nprv = 0;
#pragma unroll
    for (int t = 0; t < 16; ++t) q[t] = load_raw(PRKV, Ab, LD, row0 + t, col);
    { const int pr = prev_row(row0, 1); if (pr >= 0) { const bf16_t* p1 = PRKV + (size_t)pr * 1536 + col; prr = p1[0]; prk = p1[512]; prv = p1[1024]; } }
    for (;;) {
        const float mur = p.gin(4)[col], muk = p.gin(5)[col], muv = p.gin(6)[col], kkw = p.gin(18)[col], kaw = p.gin(19)[col], rkw = p.gin(20)[col];
        const int nuid = uid + nb * 8; const bool has_next = nuid < NUNITS;
        int nb_ = b, nh = h, nc = c, ncol = col, nrow0 = row0;
        if (has_next) {
            unit_geom(nuid, lane, nb_, nh, nc, ncol, nrow0);
#pragma unroll
            for (int t = 0; t < 16; ++t) qn[t] = load_raw(PRKV, Ab, LD, nrow0 + t, ncol);
            nprr = 0; nprk = 0; nprv = 0;
            const int pr = prev_row(nrow0, 1); if (pr >= 0) { const bf16_t* p1 = PRKV + (size_t)pr * 1536 + ncol; nprr = p1[0]; nprk = p1[512]; nprv = p1[1024]; }
        }
        __builtin_amdgcn_sched_barrier(0);
        LAS float* PM = (LAS float*)wl;
        LAS float* RS = DM;
        {
            float rp = bf2f(prr), kp = bf2f(prk);
#pragma unroll
            for (int t = 0; t < 16; ++t) {
                const RawTok qq = q[t];
                const float r0 = bf2f(qq.r), k0 = bf2f(qq.k);
                const float r = r0 + (rp - r0) * mur, k = k0 + (kp - k0) * muk;
                rp = r0; kp = k0;
                const float a = bf2f(qq.a);
                const float kkv = k * kkw, k2 = k * (1.0f + (a - 1.0f) * kaw);
                PM[t * 68 + lane] = kkv * kkv; PM[(16 + t) * 68 + lane] = r * k2 * rkw;
            }
            asm volatile("" ::: "memory");
            const int rw = lane & 31, hf = lane >> 5;
            f32x4 s4 = (f32x4){0.f, 0.f, 0.f, 0.f};
#pragma unroll
            for (int i = 0; i < 8; ++i) s4 += *(const LAS f32x4*)(PM + rw * 68 + hf * 32 + i * 4);
            float sm = (s4[0] + s4[1]) + (s4[2] + s4[3]);
            { float c2 = sm; asm volatile("v_nop\n\tv_nop\n\tv_permlane32_swap_b32 %0, %1\n\tv_nop" : "+v"(sm), "+v"(c2)); sm += c2; }
            if (lane < 32) RS[lane] = sm;
            asm volatile("" ::: "memory");
            const float cfl = __shfl(sm, (lane & 15) + 16);
            if (lane < 16) COEF[(size_t)(row0 + lane) * 8 + h] = cfl;
        }
        __builtin_amdgcn_sched_barrier(0);
        float at[16], vt[16]; unsigned btp[8], ktp[8]; float bprev = 0.f, kprev = 0.f;
        float cl = 0.f;
        float rp = bf2f(prr), kp = bf2f(prk), vp = bf2f(prv);
        f32x4 n2v[4];
#pragma unroll
        for (int i = 0; i < 4; ++i) n2v[i] = *(const LAS f32x4*)(RS + 4 * i);
        asm volatile("" ::: "memory"); __builtin_amdgcn_sched_barrier(0);
#pragma unroll
        for (int t = 0; t < 16; ++t) {
            const RawTok qq = q[t];
            const float r0 = bf2f(qq.r), k0 = bf2f(qq.k), v0 = bf2f(qq.v);
            const float r = r0 + (rp - r0) * mur, k = k0 + (kp - k0) * muk, v = v0 + (vp - v0) * muv;
            rp = r0; kp = k0; vp = v0;
            const float a = bf2f(qq.a);
            const float kkv = k * kkw;
            const float kk = kkv * __builtin_amdgcn_rsqf(fmaxf(n2v[t >> 2][t & 3], 1e-24f));
            const float k2 = k * (1.0f + (a - 1.0f) * kaw);
            const float wcp = __expf(cl);
            cl += bf2f(qq.ld);
            const float wcn = __expf(cl), iw = __expf(-cl);
            const float btv = kk * a * iw, ktv = k2 * iw;
            at[t] = -kk * wcp; vt[t] = v;
            { const unsigned w = cvt_pk_bf16(at[t], r * wcn); AR[t * 72 + qperm] = (bf16_t)(w & 0xFFFFu); AR[(16 + t) * 72 + qperm] = (bf16_t)(w >> 16); }
            if (t & 1) {
                btp[t >> 1] = cvt_pk_bf16(bprev, btv); ktp[t >> 1] = cvt_pk_bf16(kprev, ktv);
                BK[(t - 1) * 72 + qperm] = (bf16_t)(btp[t >> 1] & 0xFFFFu); BK[t * 72 + qperm] = (bf16_t)(btp[t >> 1] >> 16);
                BK[(16 + t - 1) * 72 + qperm] = (bf16_t)(ktp[t >> 1] & 0xFFFFu); BK[(16 + t) * 72 + qperm] = (bf16_t)(ktp[t >> 1] >> 16);
            } else { bprev = btv; kprev = ktv; }
            if ((t & 3) == 3) __builtin_amdgcn_sched_barrier(0);
        }
        const float wcc = __expf(cl);
        {
            f32x16 dm;
#pragma unroll
            for (int i = 0; i < 16; ++i) dm[i] = 0.f;
            const int rr = lane & 31, hh = lane >> 5;
#pragma unroll
            for (int ks = 0; ks < 4; ++ks) {
                const bf16x8 fa = *(const LAS bf16x8*)(AR + rr * 72 + 16 * ks + 8 * hh);
                const bf16x8 fb = *(const LAS bf16x8*)(BK + rr * 72 + 16 * ks + 8 * hh);
                dm = __builtin_amdgcn_mfma_f32_32x32x16_bf16(fa, fb, dm, 0, 0, 0);
            }
#pragma unroll
            for (int reg = 0; reg < 16; ++reg) DM[((reg & 3) + 8 * (reg >> 2) + 4 * hh) * 36 + rr] = dm[reg];
        }
        __builtin_amdgcn_sched_barrier(0);
        float uh[16];
#pragma unroll
        for (int t = 0; t < 16; ++t) {
            float wv = at[t], uv = 0.f, wv2 = 0.f, uv2 = 0.f, uv3 = 0.f;
#pragma unroll
            for (int s4 = 0; s4 < 4; ++s4) {
                if (s4 * 4 < t) {
                    const f32x4 ab = *(const LAS f32x4*)(DM + t * 36 + s4 * 4), ak = *(const LAS f32x4*)(DM + t * 36 + 16 + s4 * 4);
#pragma unroll
                    for (int j = 0; j < 4; ++j) {
                        const int s_ = s4 * 4 + j;
                        if (s_ < t) {
                            if (j & 1) { wv2 += ab[j] * at[s_]; uv2 += ak[j] * vt[s_]; } else { wv += ab[j] * at[s_]; uv += ak[j] * vt[s_]; }
                            uv3 += ab[j] * uh[s_];
                        }
                    }
                }
            }
            wv += wv2; uv += uv2 + uv3;
            at[t] = wv; uh[t] = uv;
            asm volatile("" : "+v"(at[t]), "+v"(uh[t]));
        }
        __builtin_amdgcn_sched_barrier(0);
#pragma unroll
        for (int t = 0; t < 16; t += 2) { const unsigned w = cvt_pk_bf16(at[t], at[t + 1]); AR[t * 72 + qperm] = (bf16_t)(w & 0xFFFFu); AR[(t + 1) * 72 + qperm] = (bf16_t)(w >> 16); }
        unsigned char* rec = ws + OFF_CH + (size_t)uid * REC_BYTES;
#pragma unroll
        for (int i = 0; i < 2; ++i) {
            const int pc = i * 64 + lane, row = pc >> 3, part = pc & 7;
            *(u32x4*)(rec + RO_WH + pc * 16) = *(const LAS u32x4*)((LAS unsigned char*)AR + row * 144 + part * 16);
            *(u32x4*)(rec + RO_RT + pc * 16) = *(const LAS u32x4*)((LAS unsigned char*)AR + (16 + row) * 144 + part * 16);
        }
        {
            u32x4 w0, w1;
            w0.x = cvt_pk_bf16(uh[0], uh[1]); w0.y = cvt_pk_bf16(uh[2], uh[3]); w0.z = cvt_pk_bf16(uh[4], uh[5]); w0.w = cvt_pk_bf16(uh[6], uh[7]);
            w1.x = cvt_pk_bf16(uh[8], uh[9]); w1.y = cvt_pk_bf16(uh[10], uh[11]); w1.z = cvt_pk_bf16(uh[12], uh[13]); w1.w = cvt_pk_bf16(uh[14], uh[15]);
            *(u32x4*)(rec + RO_U0T + lane * 32) = w0; *(u32x4*)(rec + RO_U0T + lane * 32 + 16) = w1;
            w0.x = cvt_pk_bf16(vt[0], vt[1]); w0.y = cvt_pk_bf16(vt[2], vt[3]); w0.z = cvt_pk_bf16(vt[4], vt[5]); w0.w = cvt_pk_bf16(vt[6], vt[7]);
            w1.x = cvt_pk_bf16(vt[8], vt[9]); w1.y = cvt_pk_bf16(vt[10], vt[11]); w1.z = cvt_pk_bf16(vt[12], vt[13]); w1.w = cvt_pk_bf16(vt[14], vt[15]);
            *(u32x4*)(rec + RO_VT + lane * 32) = w0; *(u32x4*)(rec + RO_VT + lane * 32 + 16) = w1;
        }
#pragma unroll
        for (int g = 0; g < 4; ++g) {
            u32x4 w; w.x = btp[2 * g]; w.y = btp[2 * g + 1]; w.z = ktp[2 * g]; w.w = ktp[2 * g + 1];
            *(u32x4*)(rec + RO_BKT + lane * 64 + g * 16) = w;
        }
        {
            const int t = lane >> 2, g = lane & 3;
            const f32x4 rb = *(const LAS f32x4*)(DM + (16 + t) * 36 + 4 * g), rk = *(const LAS f32x4*)(DM + (16 + t) * 36 + 16 + 4 * g);
            float o[8];
#pragma unroll
            for (int j = 0; j < 4; ++j) { const bool keep = (4 * g + j) <= t; o[j] = keep ? rb[j] : 0.f; o[4 + j] = keep ? rk[j] : 0.f; }
            u32x4 w; w.x = cvt_pk_bf16(o[0], o[1]); w.y = cvt_pk_bf16(o[2], o[3]); w.z = cvt_pk_bf16(o[4], o[5]); w.w = cvt_pk_bf16(o[6], o[7]);
            *(u32x4*)(rec + RO_ARK + t * 64 + g * 16) = w;
        }
        *(float*)(rec + RO_WCC + lane * 4) = wcc;
        if (!has_next) break;
        uid = nuid; b = nb_; h = nh; c = nc; col = ncol; row0 = nrow0;
#pragma unroll
        for (int t = 0; t < 16; ++t) q[t] = qn[t];
        prr = nprr; prk = nprk; prv = nprv;
        __builtin_amdgcn_sched_barrier(0);
    }
}

__device__ __forceinline__ void convert_expert_weights(const PPv& p, LAS unsigned char* lds, int first, int stride);
struct RecOps { bf16x8 wA0, wA1, rA0, rA1, ark, bk[4]; u32x2 u0, vv; f32x4 wc[4]; };
__device__ __forceinline__ void load_ops(RecOps& o, LAS unsigned char* S, int vs, int fr, int g) {
    o.wA0 = *(const LAS bf16x8*)(S + RO_WH + fr * 128 + g * 16); o.wA1 = *(const LAS bf16x8*)(S + RO_WH + fr * 128 + 64 + g * 16);
    o.rA0 = *(const LAS bf16x8*)(S + RO_RT + fr * 128 + g * 16); o.rA1 = *(const LAS bf16x8*)(S + RO_RT + fr * 128 + 64 + g * 16);
    o.u0 = *(const LAS u32x2*)(S + RO_U0T + (16 * vs + fr) * 32 + g * 8);
    o.vv = *(const LAS u32x2*)(S + RO_VT + (16 * vs + fr) * 32 + g * 8);
    o.ark = *(const LAS bf16x8*)(S + RO_ARK + fr * 64 + g * 16);
#pragma unroll
    for (int m = 0; m < 4; ++m) { o.bk[m] = *(const LAS bf16x8*)(S + RO_BKT + (16 * m + fr) * 64 + g * 16); o.wc[m] = *(const LAS f32x4*)(S + RO_WCC + (16 * m + 4 * g) * 4); }
}
__device__ __forceinline__ void phase_recur(const PPv& p, LAS unsigned char* lds) {
    const int tid = threadIdx.x, bid = blockIdx.x, nb = gridDim.x, lane = tid & 63, wave = __builtin_amdgcn_readfirstlane(tid >> 6);
    unsigned char* ws = p.gws();
    if (bid >= 64) { convert_expert_weights(p, lds, bid - 64, nb - 64); return; }
    unsigned char* CHb = ws + OFF_CH + (size_t)(bid * NCHUNK) * REC_BYTES;
    constexpr int RSLOT = REC_BYTES, RN = 11, PF = 8;
#define R_BAR() do { asm volatile("s_waitcnt lgkmcnt(0)" ::: "memory"); __builtin_amdgcn_s_barrier(); asm volatile("" ::: "memory"); } while (0)
    if (wave >= 4) {
        const int lw = wave - 4;
#define R_ISSUE(x) do { \
            LAS unsigned char* _s = lds + ((x) % RN) * RSLOT; const unsigned char* _r = CHb + (size_t)(x) * REC_BYTES + lane * 16; \
            _Pragma("unroll") for (int _i = 0; _i < 3; ++_i) { const int _pc = lw + 4 * _i; __builtin_amdgcn_global_load_lds((const unsigned*)(_r + _pc * 1024), (LAS unsigned*)(_s + _pc * 1024), 16, 0, 0); } \
            if (lw == 0) __builtin_amdgcn_global_load_lds((const unsigned*)(_r + 12 * 1024), (LAS unsigned*)(_s + 12 * 1024), 16, 0, 0); \
            if (lw == 1) { if (lane < 16) __builtin_amdgcn_global_load_lds((const unsigned*)(_r + 13 * 1024), (LAS unsigned*)(_s + 13 * 1024), 16, 0, 0); } } while (0)
        for (int x = 0; x < PF; ++x) R_ISSUE(x);
        asm volatile("s_waitcnt vmcnt(0)" ::: "memory");
        R_BAR();
        for (int c = 0; c < NCHUNK; ++c) {
            const int x = c + PF;
            if (x < NCHUNK) R_ISSUE(x);
            if (x < NCHUNK) { if (lw < 2) asm volatile("s_waitcnt vmcnt(24)" ::: "memory"); else asm volatile("s_waitcnt vmcnt(18)" ::: "memory"); }
            else asm volatile("s_waitcnt vmcnt(0)" ::: "memory");
            R_BAR();
        }
#undef R_ISSUE
    } else {
        const int vs = wave, fr = lane & 15, g = lane >> 4;
        f32x4 H[4];
#pragma unroll
        for (int m = 0; m < 4; ++m) H[m] = (f32x4){0.f, 0.f, 0.f, 0.f};
        R_BAR();
        RecOps cur, nxt;
        load_ops(cur, lds, vs, fr, g);
        for (int c = 0; c < NCHUNK; ++c) {
            if (c + 1 < NCHUNK) load_ops(nxt, lds + ((c + 1) % RN) * RSLOT, vs, fr, g); else nxt = cur;
            u32x4 hb0, hb1;
            hb0.x = cvt_pk_bf16(H[0][0], H[0][1]); hb0.y = cvt_pk_bf16(H[0][2], H[0][3]); hb0.z = cvt_pk_bf16(H[1][0], H[1][1]); hb0.w = cvt_pk_bf16(H[1][2], H[1][3]);
            hb1.x = cvt_pk_bf16(H[2][0], H[2][1]); hb1.y = cvt_pk_bf16(H[2][2], H[2][3]); hb1.z = cvt_pk_bf16(H[3][0], H[3][1]); hb1.w = cvt_pk_bf16(H[3][2], H[3][3]);
            const bf16x8 hB0 = __builtin_bit_cast(bf16x8, hb0), hB1 = __builtin_bit_cast(bf16x8, hb1);
            f32x4 U = (f32x4){bflo(cur.u0.x), bfhi(cur.u0.x), bflo(cur.u0.y), bfhi(cur.u0.y)};
            U = __builtin_amdgcn_mfma_f32_16x16x32_bf16(cur.wA0, hB0, U, 0, 0, 0);
            U = __builtin_amdgcn_mfma_f32_16x16x32_bf16(cur.wA1, hB1, U, 0, 0, 0);
            f32x4 Y = (f32x4){0.f, 0.f, 0.f, 0.f};
            Y = __builtin_amdgcn_mfma_f32_16x16x32_bf16(cur.rA0, hB0, Y, 0, 0, 0);
            Y = __builtin_amdgcn_mfma_f32_16x16x32_bf16(cur.rA1, hB1, Y, 0, 0, 0);
            u32x4 uvw; uvw.x = cvt_pk_bf16(U[0], U[1]); uvw.y = cvt_pk_bf16(U[2], U[3]); uvw.z = cur.vv.x; uvw.w = cur.vv.y;
            const bf16x8 uv = __builtin_bit_cast(bf16x8, uvw);
            Y = __builtin_amdgcn_mfma_f32_16x16x32_bf16(cur.ark, uv, Y, 0, 0, 0);
#pragma unroll
            for (int m = 0; m < 4; ++m) { H[m] = __builtin_amdgcn_mfma_f32_16x16x32_bf16(cur.bk[m], uv, H[m], 0, 0, 0); H[m] *= cur.wc[m]; }
            u32x2 yw; yw.x = cvt_pk_bf16(Y[0], Y[1]); yw.y = cvt_pk_bf16(Y[2], Y[3]);
            *(u32x2*)(CHb + (size_t)c * REC_BYTES + RO_U0T + (16 * vs + fr) * 32 + g * 8) = yw;
            R_BAR();
            cur = nxt;
        }
    }
#undef R_BAR
}

__device__ __forceinline__ void phase_gn(const PPv& p, LAS unsigned char* lds) {
    const int tid = threadIdx.x, bid = blockIdx.x, nb = gridDim.x, lane = tid & 63, wave = tid >> 6;
    unsigned char* ws = p.gws();
    LAS float* PM = (LAS float*)(lds + wave * 8960);
    LAS float* RS = PM + 32 * 68;
    const bf16_t* Gb = (const bf16_t*)(ws + OFF_G); const float* COEF = (const float*)(ws + OFF_COEF);
    bf16_t* Z = (bf16_t*)(ws + OFF_Z);
    constexpr int NREAL = 64 * 256;
    for (int r0 = bid * 8 + wave; r0 < NREAL; r0 += nb * 16) {
        u32x4 y0[2], y1[2], v0[2], v1[2]; float cfv[2][16]; bf16_t ggv[2][16]; int colv[2], row0v[2], hv[2]; bool okv[2];
#pragma unroll
        for (int u = 0; u < 2; ++u) {
            const int r = r0 + u * nb * 8; okv[u] = r < NREAL;
            const int rr = okv[u] ? r : r0;
            const int bh = rr >> 8, c = (rr & 255) + 1, b = bh >> 3, h = bh & 7, uid = bh * NCHUNK + c;
            hv[u] = h; colv[u] = h * 64 + lane; row0v[u] = b * SEQ + c * 16;
            const unsigned char* rec = ws + OFF_CH + (size_t)uid * REC_BYTES;
            y0[u] = *(const u32x4*)(rec + RO_U0T + lane * 32); y1[u] = *(const u32x4*)(rec + RO_U0T + lane * 32 + 16);
            v0[u] = *(const u32x4*)(rec + RO_VT + lane * 32); v1[u] = *(const u32x4*)(rec + RO_VT + lane * 32 + 16);
#pragma unroll
            for (int t = 0; t < 16; ++t) { cfv[u][t] = COEF[(size_t)(row0v[u] + t) * 8 + h]; ggv[u][t] = Gb[(size_t)(row0v[u] + t) * 512 + colv[u]]; }
        }
#pragma unroll
        for (int u = 0; u < 2; ++u) {
            if (!okv[u]) continue;
            const int col = colv[u], row0 = row0v[u];
            const float lng = p.gin(21)[col], lnb = p.gin(22)[col];
            const unsigned yw[8] = {y0[u].x, y0[u].y, y0[u].z, y0[u].w, y1[u].x, y1[u].y, y1[u].z, y1[u].w}, vw[8] = {v0[u].x, v0[u].y, v0[u].z, v0[u].w, v1[u].x, v1[u].y, v1[u].z, v1[u].w};
            asm volatile("" ::: "memory");
#pragma unroll
            for (int t = 0; t < 16; ++t) { const float y = (t & 1) ? bfhi(yw[t >> 1]) : bflo(yw[t >> 1]); PM[t * 68 + lane] = y; PM[(16 + t) * 68 + lane] = y * y; }
            asm volatile("" ::: "memory");
            {
                const int rw = lane & 31, hf = lane >> 5;
                f32x4 s4 = (f32x4){0.f, 0.f, 0.f, 0.f};
#pragma unroll
                for (int i = 0; i < 8; ++i) s4 += *(const LAS f32x4*)(PM + rw * 68 + hf * 32 + i * 4);
                float sm = (s4[0] + s4[1]) + (s4[2] + s4[3]);
                { float c2 = sm; asm volatile("v_nop\n\tv_nop\n\tv_permlane32_swap_b32 %0, %1\n\tv_nop" : "+v"(sm), "+v"(c2)); sm += c2; }
                if (lane < 32) RS[lane] = sm;
            }
            asm volatile("" ::: "memory");
            f32x4 s1v[4], s2v[4];
#pragma unroll
            for (int i = 0; i < 4; ++i) { s1v[i] = *(const LAS f32x4*)(RS + 4 * i); s2v[i] = *(const LAS f32x4*)(RS + 16 + 4 * i); }
            asm volatile("" ::: "memory");
#pragma unroll
            for (int t = 0; t < 16; ++t) {
                const float y = (t & 1) ? bfhi(yw[t >> 1]) : bflo(yw[t >> 1]);
                const float v = (t & 1) ? bfhi(vw[t >> 1]) : bflo(vw[t >> 1]);
                const float mean = s1v[t >> 2][t & 3] * (1.0f / 64.0f);
                const float dlt = y - mean;
                const float var = fmaxf(s2v[t >> 2][t & 3] * (1.0f / 64.0f) - mean * mean, 0.f);
                const float yn = dlt * rsqrtf(var + LNX_EPS) * lng + lnb;
                Z[(size_t)(row0 + t - NMETA) * 512 + col] = f2bf((yn + cfv[u][t] * v) * bf2f(ggv[u][t]));
            }
        }
    }
}

__device__ __forceinline__ void convert_expert_weights(const PPv& p, LAS unsigned char* lds, int first, int stride) {
    unsigned char* ws = p.gws();
    const int tid = threadIdx.x;
    LAS float* tile = (LAS float*)lds;
    const float* g2 = p.gin(27);
    unsigned char* WGU = ws + OFF_WGU; unsigned char* WD = ws + OFF_WD;
    constexpr int NBLK = NE * 3 * 64;
    const int lr = tid >> 6, lc = (tid & 63) * 4;
    f32x4 cur[8];
    int j = first;
    if (j >= NBLK) return;
    {
        const int mat = j >> 6, e = mat / 3, which = mat - 3 * e, bb = j & 63, kb = bb & 15, nbk = bb >> 4;
        const float* src = (which == 0 ? p.gin(30) : which == 1 ? p.gin(32) : p.gin(34)) + (size_t)e * 1024 * 1024 + (size_t)(kb * 64) * 1024 + nbk * 256;
#pragma unroll
        for (int i = 0; i < 8; ++i) cur[i] = __builtin_nontemporal_load((const f32x4*)(src + (size_t)(lr + 8 * i) * 1024 + lc));
    }
    for (;;) {
        const int jn = j + stride; const bool has_next = jn < NBLK;
        f32x4 nxt[8];
        if (has_next) {
            const int mat = jn >> 6, e = mat / 3, which = mat - 3 * e, bb = jn & 63, kb = bb & 15, nbk = bb >> 4;
            const float* src = (which == 0 ? p.gin(30) : which == 1 ? p.gin(32) : p.gin(34)) + (size_t)e * 1024 * 1024 + (size_t)(kb * 64) * 1024 + nbk * 256;
#pragma unroll
            for (int i = 0; i < 8; ++i) nxt[i] = __builtin_nontemporal_load((const f32x4*)(src + (size_t)(lr + 8 * i) * 1024 + lc));
        }
        const int mat = j >> 6, e = mat / 3, which = mat - 3 * e, bb = j & 63, kb = bb & 15, nbk = bb >> 4;
#pragma unroll
        for (int i = 0; i < 8; ++i) { LAS float* t = tile + (lr + 8 * i) * 257 + lc; t[0] = cur[i][0]; t[1] = cur[i][1]; t[2] = cur[i][2]; t[3] = cur[i][3]; }
        __syncthreads();
        {
            const int kq = tid & 7, k0 = kb * 64 + 8 * kq;
            float sc[8];
#pragma unroll
            for (int jj = 0; jj < 8; ++jj) sc[jj] = (which < 2 ? g2[k0 + jj] : 1.0f) * W8_SCALE;
#pragma unroll
            for (int i = 0; i < 4; ++i) {
                const int nn = (tid >> 3) + 64 * i, n = nbk * 256 + nn;
                float v[8];
#pragma unroll
                for (int jj = 0; jj < 8; ++jj) v[jj] = tile[(8 * kq + jj) * 257 + nn] * sc[jj];
                u32x2 w; w.x = pk4_fp8(v[0], v[1], v[2], v[3]); w.y = pk4_fp8(v[4], v[5], v[6], v[7]);
                unsigned char* dst = which < 2 ? WGU + (size_t)e * 2048 * 1024 + (size_t)(256 * (n >> 7) + 128 * which + (n & 127)) * 1024
                                               : WD + (size_t)e * 1024 * 1024 + (size_t)n * 1024;
                __builtin_nontemporal_store(w, (u32x2*)(dst + k0));
            }
        }
        __syncthreads();
        if (!has_next) break;
        j = jn;
#pragma unroll
        for (int i = 0; i < 8; ++i) cur[i] = nxt[i];
    }
}

__device__ __forceinline__ void phase_router(const PPv& p, LAS unsigned char* lds) {
    const int tid = threadIdx.x, bid = blockIdx.x, nb = gridDim.x, lane = tid & 63, wave = tid >> 6;
    unsigned char* ws = p.gws();
    const bf16_t* h1 = (const bf16_t*)(ws + OFF_HB2);
    const bf16_t* WRB = (const bf16_t*)(ws + OFF_WRG);
    const float* brt = p.gin(29);
    LAS float* slog = (LAS float*)lds;
    LAS float* srs = slog + 8 * 16 * 32;
    LAS int* lcnt = (LAS int*)(srs + 128);
    LAS int* gbase = lcnt + 32;
    LAS int* ltopi = gbase + 32;
    LAS int* lrank = ltopi + 512;
    int* TOPI = (int*)(ws + OFF_TOPI); float* TOPW = (float*)(ws + OFF_TOPW); int* RANK = (int*)(ws + OFF_RANK); float* RSTD2 = (float*)(ws + OFF_RSTD2);
    int* GCNT = (int*)(ws + OFF_GCNT);
    for (int tb = bid; tb < T / 128; tb += nb) {
        if (tid < 32) lcnt[tid] = 0;
        __syncthreads();
        const int t0 = tb * 128 + wave * 16;
        {
            const int row = lane & 15, kq = lane >> 4;
            const bf16_t* ap = h1 + (size_t)(t0 + row) * D + 8 * kq;
            const bf16_t* bp = WRB + (size_t)row * 1024 + 8 * kq;
            f32x4 acc0 = (f32x4){0.f, 0.f, 0.f, 0.f}, acc1 = acc0;
            float ss = 0.f;
#pragma unroll 4
            for (int ks = 0; ks < 32; ++ks) {
                const u32x4 aw = *(const u32x4*)(ap + ks * 32);
                const bf16x8 b0h = *(const bf16x8*)(bp + ks * 32), b1h = *(const bf16x8*)(bp + 16 * 1024 + ks * 32);
                const bf16x8 b0l = *(const bf16x8*)(bp + 32 * 1024 + ks * 32), b1l = *(const bf16x8*)(bp + 48 * 1024 + ks * 32);
                ss += bflo(aw.x) * bflo(aw.x) + bfhi(aw.x) * bfhi(aw.x) + bflo(aw.y) * bflo(aw.y) + bfhi(aw.y) * bfhi(aw.y)
                    + bflo(aw.z) * bflo(aw.z) + bfhi(aw.z) * bfhi(aw.z) + bflo(aw.w) * bflo(aw.w) + bfhi(aw.w) * bfhi(aw.w);
                const bf16x8 av = __builtin_bit_cast(bf16x8, aw);
                acc0 = __builtin_amdgcn_mfma_f32_16x16x32_bf16(av, b0h, acc0, 0, 0, 0);
                acc1 = __builtin_amdgcn_mfma_f32_16x16x32_bf16(av, b1h, acc1, 0, 0, 0);
                acc0 = __builtin_amdgcn_mfma_f32_16x16x32_bf16(av, b0l, acc0, 0, 0, 0);
                acc1 = __builtin_amdgcn_mfma_f32_16x16x32_bf16(av, b1l, acc1, 0, 0, 0);
            }
            ss += __shfl_xor(ss, 16); ss += __shfl_xor(ss, 32);
#pragma unroll
            for (int reg = 0; reg < 4; ++reg) {
                slog[(wave * 16 + 4 * kq + reg) * 32 + row] = acc0[reg];
                slog[(wave * 16 + 4 * kq + reg) * 32 + 16 + row] = acc1[reg];
            }
            if (lane < 16) srs[wave * 16 + lane] = rsqrtf(ss * (1.0f / D) + NORM_EPS);
        }
        __syncthreads();
        if (lane < 16) {
            const int tl = wave * 16 + lane, t = tb * 128 + tl;
            const float rs = srs[tl];
            float lg[32];
#pragma unroll
            for (int e = 0; e < 32; ++e) lg[e] = slog[tl * 32 + e] * rs + brt[e];
            int ti[4]; float tv[4];
#pragma unroll
            for (int k = 0; k < 4; ++k) {
                float best = -3.0e38f; int bi = 0;
#pragma unroll
                for (int e = 0; e < 32; ++e) { const bool tk = lg[e] > best; best = tk ? lg[e] : best; bi = tk ? e : bi; }
                ti[k] = bi; tv[k] = best;
#pragma unroll
                for (int e = 0; e < 32; ++e) lg[e] = (e == bi) ? -3.0e38f : lg[e];
            }
            const float e0 = 1.0f, e1 = __expf(tv[1] - tv[0]), e2 = __expf(tv[2] - tv[0]), e3 = __expf(tv[3] - tv[0]);
            const float inv = 1.0f / (e0 + e1 + e2 + e3);
            *(f32x4*)(TOPW + (size_t)t * 4) = (f32x4){e0 * inv, e1 * inv, e2 * inv, e3 * inv};
            RSTD2[t] = rs;
#pragma unroll
            for (int k = 0; k < 4; ++k) { ltopi[tl * 4 + k] = ti[k]; lrank[tl * 4 + k] = __hip_atomic_fetch_add(lcnt + ti[k], 1, __ATOMIC_RELAXED, __HIP_MEMORY_SCOPE_WORKGROUP); }
        }
        __syncthreads();
        if (tid < 32) gbase[tid] = atomicAdd(GCNT + tid, lcnt[tid]);
        __syncthreads();
        {
            const int e = ltopi[tid];
            TOPI[(size_t)tb * 512 + tid] = e;
            RANK[(size_t)tb * 512 + tid] = gbase[e] + lrank[tid];
        }
        __syncthreads();
    }
}

__device__ __forceinline__ void phase_lists(const PPv& p, LAS unsigned char* lds) {
    const int tid = threadIdx.x, bid = blockIdx.x, nb = gridDim.x;
    unsigned char* ws = p.gws();
    LAS int* pstart = (LAS int*)lds;
    LAS int* cnt = pstart + 64;
    const int* GCNT = (const int*)(ws + OFF_GCNT);
    if (tid < 32) cnt[tid] = GCNT[tid];
    __syncthreads();
    if (tid == 0) { int s = 0; for (int e = 0; e < 32; ++e) { pstart[e] = s; s += ((cnt[e] + 255) >> 8) << 8; } pstart[32] = s; }
    __syncthreads();
    const int* TOPI = (const int*)(ws + OFF_TOPI); const float* TOPW = (const float*)(ws + OFF_TOPW); const int* RANK = (const int*)(ws + OFF_RANK); const float* RSTD2 = (const float*)(ws + OFF_RSTD2);
    int* ROWTOK = (int*)(ws + OFF_ROWTOK); int* ROWSLOT = (int*)(ws + OFF_ROWSLOT); float* ROWW = (float*)(ws + OFF_ROWW); float* ROWRS = (float*)(ws + OFF_ROWRS);
    for (int i = bid * 512 + tid; i < T * 4; i += nb * 512) {
        const int e = TOPI[i], pos = pstart[e] + RANK[i], t = i >> 2;
        ROWTOK[pos] = t; ROWSLOT[pos] = i; ROWW[pos] = TOPW[i]; ROWRS[pos] = RSTD2[t];
    }
    for (int e = bid; e < 32; e += nb) {
        for (int pos = pstart[e] + cnt[e] + tid; pos < pstart[e + 1]; pos += 512) { ROWTOK[pos] = 0; ROWSLOT[pos] = -1; ROWW[pos] = 0.f; ROWRS[pos] = 0.f; }
    }
    if (bid == 0) {
        int* TILEE = (int*)(ws + OFF_TILEE);
        const int ntiles = pstart[32] >> 8;
        for (int mt = tid; mt < ntiles; mt += 512) { int e = 0; for (int q = 0; q < 32; ++q) if (pstart[q] <= mt * 256) e = q; TILEE[mt] = e; }
        if (tid == 0) TILEE[1000] = ntiles;
    }
    __syncthreads();
}

__device__ __forceinline__ void phase_final(const PPv& p) {
    const int tid = threadIdx.x, bid = blockIdx.x, nb = gridDim.x, lane = tid & 63, wave = tid >> 6;
    unsigned char* ws = p.gws();
    const bf16_t* HB2 = (const bf16_t*)(ws + OFF_HB2);
    const unsigned char* Y8 = (const unsigned char*)p.gout();
    const float* gf = p.gin(36);
    const f32x4 ga0 = *(const f32x4*)(gf + 8 * lane), ga1 = *(const f32x4*)(gf + 8 * lane + 4), gb0 = *(const f32x4*)(gf + 512 + 8 * lane), gb1 = *(const f32x4*)(gf + 512 + 8 * lane + 4);
    for (int t0 = (bid * 8 + wave) * 2; t0 < T; t0 += nb * 16) {
        u32x4 ha[2], hb[2]; u32x2 ya[2][4], yb[2][4];
#pragma unroll
        for (int u = 0; u < 2; ++u) {
            const int t = t0 + u;
            ha[u] = __builtin_nontemporal_load((const u32x4*)(HB2 + (size_t)t * D + 8 * lane)); hb[u] = __builtin_nontemporal_load((const u32x4*)(HB2 + (size_t)t * D + 512 + 8 * lane));
#pragma unroll
            for (int k = 0; k < 4; ++k) { ya[u][k] = __builtin_nontemporal_load((const u32x2*)(Y8 + (size_t)(4 * t + k) * 1024 + 8 * lane)); yb[u][k] = __builtin_nontemporal_load((const u32x2*)(Y8 + (size_t)(4 * t + k) * 1024 + 512 + 8 * lane)); }
        }
#pragma unroll
        for (int u = 0; u < 2; ++u) {
            const int t = t0 + u;
            float va[8] = {bflo(ha[u].x), bfhi(ha[u].x), bflo(ha[u].y), bfhi(ha[u].y), bflo(ha[u].z), bfhi(ha[u].z), bflo(ha[u].w), bfhi(ha[u].w)};
            float vb[8] = {bflo(hb[u].x), bfhi(hb[u].x), bflo(hb[u].y), bfhi(hb[u].y), bflo(hb[u].z), bfhi(hb[u].z), bflo(hb[u].w), bfhi(hb[u].w)};
#pragma unroll
            for (int k = 0; k < 4; ++k) {
                const u32x2 a4 = ya[u][k], b4 = yb[u][k];
                { const f32x2 q0 = __builtin_amdgcn_cvt_pk_f32_fp8((int)a4.x, false), q1 = __builtin_amdgcn_cvt_pk_f32_fp8((int)a4.x, true), q2 = __builtin_amdgcn_cvt_pk_f32_fp8((int)a4.y, false), q3 = __builtin_amdgcn_cvt_pk_f32_fp8((int)a4.y, true);
                  va[0] += q0.x; va[1] += q0.y; va[2] += q1.x; va[3] += q1.y; va[4] += q2.x; va[5] += q2.y; va[6] += q3.x; va[7] += q3.y; }
                { const f32x2 q0 = __builtin_amdgcn_cvt_pk_f32_fp8((int)b4.x, false), q1 = __builtin_amdgcn_cvt_pk_f32_fp8((int)b4.x, true), q2 = __builtin_amdgcn_cvt_pk_f32_fp8((int)b4.y, false), q3 = __builtin_amdgcn_cvt_pk_f32_fp8((int)b4.y, true);
                  vb[0] += q0.x; vb[1] += q0.y; vb[2] += q1.x; vb[3] += q1.y; vb[4] += q2.x; vb[5] += q2.y; vb[6] += q3.x; vb[7] += q3.y; }
            }
            float ss = 0.f;
#pragma unroll
            for (int j = 0; j < 8; ++j) ss += va[j] * va[j] + vb[j] * vb[j];
            ss = wave_sum_dpp(ss);
            const float rs = rsqrtf(ss * (1.0f / D) + NORM_EPS);
            float* o = p.gout() + (size_t)t * D;
            __builtin_nontemporal_store((f32x4){va[0] * rs * ga0[0], va[1] * rs * ga0[1], va[2] * rs * ga0[2], va[3] * rs * ga0[3]}, (f32x4*)(o + 8 * lane));
            __builtin_nontemporal_store((f32x4){va[4] * rs * ga1[0], va[5] * rs * ga1[1], va[6] * rs * ga1[2], va[7] * rs * ga1[3]}, (f32x4*)(o + 8 * lane + 4));
            __builtin_nontemporal_store((f32x4){vb[0] * rs * gb0[0], vb[1] * rs * gb0[1], vb[2] * rs * gb0[2], vb[3] * rs * gb0[3]}, (f32x4*)(o + 512 + 8 * lane));
            __builtin_nontemporal_store((f32x4){vb[4] * rs * gb1[0], vb[5] * rs * gb1[1], vb[6] * rs * gb1[2], vb[7] * rs * gb1[3]}, (f32x4*)(o + 512 + 8 * lane + 4));
        }
    }
}

#define XB_TMO      128
#define XB_XCNT(j)  (256  + 64 * (j))
#define XB_XSUB(j)  (1280 + 64 * (j))
#define XB_XGEN(j)  (2304 + 64 * (j))
#define XB_TOP      3328
#define XB_TOPGEN   3392
#define XCD_BAR_WORDS 3456
#define XB_SPIN_CAP (1u << 18)
__device__ __forceinline__ unsigned xb_ld(unsigned* p)              { return __hip_atomic_load(p, __ATOMIC_RELAXED, __HIP_MEMORY_SCOPE_AGENT); }
__device__ __forceinline__ unsigned xb_add(unsigned* p, unsigned v) { return __hip_atomic_fetch_add(p, v, __ATOMIC_RELAXED, __HIP_MEMORY_SCOPE_AGENT); }
__device__ __forceinline__ unsigned xb_xcc_id() { return (unsigned)__builtin_amdgcn_s_getreg((3 << 11) | 20) & 0xFu; }
#define XB_SPIN(cond, bar) do { unsigned _sp = 0; while (cond) { __builtin_amdgcn_s_sleep(1); \
    if ((++_sp & 255u) == 0u) { if (xb_ld(&(bar)[XB_TMO])) break; if (_sp > XB_SPIN_CAP) { atomicAdd(&(bar)[XB_TMO], 1u); break; } } } } while (0)
struct XcdBarrier { unsigned* bar; unsigned x; volatile LAS unsigned* st; };
__device__ __forceinline__ XcdBarrier xcd_barrier_post(unsigned* bar, volatile LAS unsigned* st) {
    XcdBarrier b; b.bar = bar; b.x = xb_xcc_id(); b.st = st;
    if (threadIdx.x == 0) (void)xb_add(&bar[XB_XCNT(b.x)], 1u);
    return b;
}
__device__ __forceinline__ void xcd_barrier_complete(unsigned* bar, unsigned x, unsigned& nloc, unsigned& nx) {
    const unsigned G = gridDim.x * gridDim.y * gridDim.z;
    unsigned sum, cnt, mine, sp = 0u;
    for (;;) {
        sum = 0u; cnt = 0u; mine = 0u;
#pragma unroll
        for (unsigned j = 0; j < 16; ++j) { const unsigned c = xb_ld(&bar[XB_XCNT(j)]); sum += c; cnt += (c > 0u) ? 1u : 0u; mine = (j == x) ? c : mine; }
        if (sum == G) break;
        __builtin_amdgcn_s_sleep(1);
        if ((++sp & 255u) == 0u) { if (xb_ld(&bar[XB_TMO])) break; if (sp > XB_SPIN_CAP) { atomicAdd(&bar[XB_TMO], 1u); break; } }
    }
    nloc = mine > 0u ? mine : 1u; nx = cnt > 0u ? cnt : 1u;
}
__device__ __forceinline__ void xcd_barrier(const XcdBarrier& b) {
    asm volatile("s_waitcnt vmcnt(0)" ::: "memory");
    __syncthreads();
    if (threadIdx.x == 0) {
        unsigned* bar = b.bar;
        __builtin_amdgcn_s_waitcnt(0);
        unsigned nloc = b.st[0], nx = b.st[1];
        if (nloc == 0u) { xcd_barrier_complete(bar, b.x, nloc, nx); b.st[0] = nloc; b.st[1] = nx; }
        const unsigned old = xb_add(&bar[XB_XSUB(b.x)], 1u);
        const unsigned gen = old / nloc;
        if (old + 1u == (gen + 1u) * nloc) {
            __builtin_amdgcn_fence(__ATOMIC_RELEASE, "agent");
            asm volatile("s_waitcnt vmcnt(0)" ::: "memory");
            const unsigned og = xb_add(&bar[XB_TOP], 1u);
            const unsigned tg = og / nx;
            if (og + 1u == (tg + 1u) * nx) xb_add(&bar[XB_TOPGEN], 1u);
            else XB_SPIN(xb_ld(&bar[XB_TOPGEN]) == tg, bar);
            __builtin_amdgcn_fence(__ATOMIC_ACQUIRE, "agent");
            xb_add(&bar[XB_XGEN(b.x)], 1u);
            asm volatile("s_waitcnt vmcnt(0)" ::: "memory");
        } else {
            XB_SPIN(xb_ld(&bar[XB_XGEN(b.x)]) == gen, bar);
            __builtin_amdgcn_fence(__ATOMIC_ACQUIRE, "agent");
            asm volatile("s_waitcnt vmcnt(0)" ::: "memory");
        }
    }
    __syncthreads();
}

constexpr int N_PHASES = 15;
__global__ void __launch_bounds__(512, 2) mega(Params p) {
    extern __shared__ __attribute__((aligned(16))) unsigned char lds_raw[];
    LAS unsigned char* lds = (LAS unsigned char*)lds_raw;
    cg::grid_group grid = cg::this_grid();
    unsigned char* ws = getpp().gws();
    const int G = gridDim.x, bid = blockIdx.x;
#ifndef ONLY_PHASE
#define ONLY_PHASE -1
#endif
#define IN(k) ((ONLY_PHASE < 0 || ONLY_PHASE == (k)) && p.ph_lo <= (k) && (k) < p.ph_hi)
    volatile LAS unsigned* xst = (volatile LAS unsigned*)(lds + 163840 - 16);
    if (threadIdx.x < 4) xst[threadIdx.x] = 0u;
    __syncthreads();
    const XcdBarrier xbar = xcd_barrier_post((unsigned*)(ws + OFF_BAR), xst);
    if (p.ph_hi < 0) grid.sync();
#define SEAM(k) do { if ((k) + 1 < p.ph_hi) xcd_barrier(xbar); } while (0)
    if (IN(0)) { const PPv q = getpp(); phase_prep(q, lds); SEAM(0); }
    if (IN(1)) { const PPv q = getpp();
        phase_meta_proj(q, lds);
        {
            StaticOrder S; S.init((unsigned char*)q.gout() + OUT_XB, ws + OFF_WIN, T, 14 * 256, 1024, G, bid);
            EpiProj E{(bf16_t*)(ws + OFF_PRKV), (bf16_t*)(ws + OFF_PCONV), (unsigned char*)q.gout(), (const float*)(ws + OFF_RSTD1), 0, 1.0f, (bf16_t*)(ws + OFF_L)};
            gemm_phase<false>(lds, 1024, S, E);
        }
        {
            StaticOrder S; S.init(ws + OFF_X8, ws + OFF_WIN8, T, 8 * 256, 512, G, bid);
            EpiProj E{(bf16_t*)(ws + OFF_PRKV), (bf16_t*)(ws + OFF_PCONV), (unsigned char*)q.gout(), (const float*)(ws + OFF_RSTD1), 14, W8_INV, (bf16_t*)(ws + OFF_L)};
            gemm_phase<false, true>(lds, 512, S, E);
        }
        SEAM(1);
    }
    if (IN(2)) { const PPv q = getpp(); phase_lprep_conv(q); SEAM(2); }
    if (IN(3)) { const PPv q = getpp();
        phase_meta_lora(q);
        StaticOrder S; S.init(ws + OFF_L + (size_t)NMETA * 256 * 2, ws + OFF_W2, T, 1536, 256, G, bid);
        EpiL E{ws, q.gin(10), q.gin(13)};
        gemm_phase<false>(lds, 256, S, E);
        SEAM(3);
    }
    if (IN(4)) { const PPv q = getpp(); phase_scanprep(q, lds); SEAM(4); }
    if (IN(5)) { const PPv q = getpp(); phase_recur(q, lds); SEAM(5); }
    if (IN(6)) { const PPv q = getpp(); phase_gn(q, lds); SEAM(6); }
    if (IN(7)) { const PPv q = getpp();
        MergeOrder S; S.so.init(ws + OFF_Z, ws + OFF_WR, T, 1024, 512, G, bid); S.A1 = (const char*)(ws + OFF_C); S.B1 = (const char*)(ws + OFF_WC);
        EpiMergeFused E{(bf16_t*)(ws + OFF_MERGED), (const unsigned char*)q.gout()};
        gemm_phase<false>(lds, 512, S, E);
        SEAM(7);
    }
    if (IN(9)) { const PPv q = getpp();
        StaticOrder S; S.init(ws + OFF_MERGED, ws + OFF_WO, T, 1024, 1024, G, bid);
        EpiO E{(const bf16_t*)((unsigned char*)q.gout() + OUT_XB), q.gout(), (bf16_t*)(ws + OFF_HB2), ws + OFF_HB8};
        gemm_phase<false>(lds, 1024, S, E);
        SEAM(9);
    }
    if (IN(10)) { const PPv q = getpp(); phase_router(q, lds); SEAM(10); }
    if (IN(11)) { const PPv q = getpp(); phase_lists(q, lds); SEAM(11); }
    if (IN(12)) { const PPv q = getpp();
        const int* TILEE = (const int*)(ws + OFF_TILEE);
        MoeOrder S; S.A = (const char*)(ws + OFF_HB8); S.Bt = (const char*)(ws + OFF_WGU); S.K = 512; S.estride = (size_t)2048 * 1024;
        S.tile_e = TILEE; S.rowtok = (const int*)(ws + OFF_ROWTOK); S.ntiles = TILEE[1000]; S.nnt = 8; S.G = G; S.c = bid; S.gather = true;
        EpiMoe1 E{ws + OFF_ACT, (const float*)(ws + OFF_ROWRS), q.gin(31), q.gin(33)};
        gemm_phase<true, true>(lds, 512, S, E);
        SEAM(12);
    }
    if (IN(13)) { const PPv q = getpp();
        const int* TILEE = (const int*)(ws + OFF_TILEE);
        MoeOrder S; S.A = (const char*)(ws + OFF_ACT); S.Bt = (const char*)(ws + OFF_WD); S.K = 512; S.estride = (size_t)1024 * 1024;
        S.tile_e = TILEE; S.rowtok = nullptr; S.ntiles = TILEE[1000]; S.nnt = 4; S.G = G; S.c = bid; S.gather = false;
        EpiMoe2 E{(unsigned char*)q.gout(), (const int*)(ws + OFF_ROWSLOT), (const float*)(ws + OFF_ROWW), q.gin(35)};
        gemm_phase<false, true>(lds, 512, S, E);
        SEAM(13);
    }
    if (IN(14)) { const PPv q = getpp(); phase_final(q); }
}

extern "C" void kernel_launch(void* const* d_in, const int* in_sizes, int n_in, void* d_out, int out_size, void* d_ws, size_t ws_size,
                              hipStream_t stream) {
    constexpr size_t kDynLds = 160 * 1024;
    static int grid_blocks = 0;
    if (!grid_blocks) {
        int dev = 0, cus = 0, per_cu = 0;
        (void)hipGetDevice(&dev);
        (void)hipDeviceGetAttribute(&cus, hipDeviceAttributeMultiprocessorCount, dev);
        (void)hipFuncSetAttribute((const void*)mega, hipFuncAttributeMaxDynamicSharedMemorySize, (int)kDynLds);
        (void)hipOccupancyMaxActiveBlocksPerMultiprocessor(&per_cu, mega, 512, kDynLds);
        if (per_cu > 1) per_cu = 1;
        grid_blocks = cus * per_cu;
        fprintf(stderr, "cus=%d per_cu=%d ws_size=%zu need=%zu\n", cus, per_cu, ws_size, (size_t)WS_NEED);
    }
    if (ws_size < WS_NEED || n_in < 37 || grid_blocks < 128) { fprintf(stderr, "kernel_launch: unsupported configuration\n"); return; }
    Params p{};
    for (int i = 0; i < 37; ++i) p.in[i] = (const float*)d_in[i];
    p.out = (float*)d_out;
    p.ws = (unsigned char*)d_ws;
    p.ph_lo = 0; p.ph_hi = N_PHASES;
    (void)hipMemsetAsync((unsigned char*)d_ws + OFF_BAR, 0, 16384, stream);
    void* args[] = {&p};
    hipError_t e = hipLaunchCooperativeKernel((void*)mega, dim3(grid_blocks), dim3(512), args, kDynLds, stream);
    if (e != hipSuccess) fprintf(stderr, "cooperative launch failed: %s (grid %d)\n", hipGetErrorString(e), grid_blocks);
}
```

```cpp
#include <hip/hip_runtime.h>
#include <hip/hip_cooperative_groups.h>
#include <cstdio>
namespace cg = cooperative_groups;

#define LAS __attribute__((address_space(3)))
typedef unsigned short bf16_t;
typedef short bf16x8 __attribute__((ext_vector_type(8)));
typedef float f32x4 __attribute__((ext_vector_type(4)));
typedef float f32x2 __attribute__((ext_vector_type(2)));
typedef unsigned u32x4 __attribute__((ext_vector_type(4)));
typedef unsigned u32x2 __attribute__((ext_vector_type(2)));
#define LO2(v) __builtin_shufflevector(v, v, 0, 1)
#define HI2(v) __builtin_shufflevector(v, v, 2, 3)

constexpr int D = 1024, NBATCH = 8, SEQ = 4096, NMETA = 16;
constexpr int T = NBATCH * SEQ;
constexpr int NR = T + NMETA;
constexpr int NRP = 33024;
constexpr int PCOLS1 = 3584;
constexpr int Q8T = 0;
constexpr int NCOLS1 = 5632;
constexpr int NE = 32, TOPK = 4, DFF = 1024;
constexpr int MAXROWS = T * TOPK + NE * 256;
constexpr int MAXTILES = MAXROWS / 256;
constexpr float NORM_EPS = 1e-5f, LNX_EPS = 64e-5f;

constexpr int NCHUNK = 257, NUNITS = 64 * NCHUNK;
constexpr int REC_BYTES = 13568;
constexpr int RO_WH = 0, RO_RT = 2048, RO_U0T = 4096, RO_VT = 6144, RO_BKT = 8192, RO_ARK = 12288, RO_WCC = 13312;
#define SWZ8(r) (((r) >> 1) & 7)
#define SWZ4(r) ((0x78 >> (2 * (((r) >> 2) & 3))) & 3)
#define SWZ2(r) ((((r) >> 3) & 1) << 1)
constexpr int SLOT_BYTES = 15680, SO_G = 13568, SO_COEF = 15616, NSLOT = 9;
constexpr size_t SZ_ACT = (size_t)MAXROWS * 1024 * 2;
constexpr size_t SZ_WGU = (size_t)NE * 2048 * 1024 * 2;
constexpr size_t SZ_WD = (size_t)NE * 1024 * 1024 * 2;
constexpr size_t SZ_HB = (size_t)T * 1024 * 2;
constexpr size_t OFF_WGU = 0;
constexpr size_t OFF_HB8 = OFF_WGU + (size_t)NE * 2048 * 1024;
constexpr size_t OFF_WD = OFF_WGU + SZ_WGU;
constexpr size_t OFF_ACT = OFF_WD + SZ_WD;
constexpr size_t OFF_HB2 = OFF_ACT + SZ_ACT;
constexpr size_t OFF_RT = OFF_HB2 + SZ_HB;
constexpr size_t OFF_TOPI = OFF_RT;
constexpr size_t OFF_TOPW = OFF_TOPI + (size_t)T * 16;
constexpr size_t OFF_RANK = OFF_TOPW + (size_t)T * 16;
constexpr size_t OFF_RSTD2 = OFF_RANK + (size_t)T * 16;
constexpr size_t OFF_ROWTOK = OFF_RSTD2 + (size_t)T * 4;
constexpr size_t OFF_ROWSLOT = OFF_ROWTOK + (size_t)MAXROWS * 4;
constexpr size_t OFF_ROWW = OFF_ROWSLOT + (size_t)MAXROWS * 4;
constexpr size_t OFF_ROWRS = OFF_ROWW + (size_t)MAXROWS * 4;
constexpr size_t OFF_TILEE = OFF_ROWRS + (size_t)MAXROWS * 4;
constexpr size_t OFF_GCNT = OFF_TILEE + 4096;
constexpr size_t OFF_SM = OFF_GCNT + 256;
constexpr size_t OFF_WR = OFF_SM;
constexpr size_t OFF_WC = OFF_WR + (size_t)1024 * 512 * 2;
constexpr size_t OFF_WO = OFF_WC + (size_t)1024 * 512 * 2;
constexpr size_t OFF_W2 = OFF_WO + (size_t)1024 * 1024 * 2;
constexpr size_t OFF_RSTD1 = OFF_W2 + (size_t)1536 * 256 * 2;
constexpr size_t OFF_WRG = OFF_RSTD1 + (size_t)NRP * 4;
constexpr size_t OFF_BAR = OFF_WRG + (size_t)1024 * 32 * 4;
constexpr size_t OFF_WO8 = OFF_BAR + 16384;
constexpr size_t WS_NEED = OFF_WO8 + (size_t)1024 * 1024;
constexpr size_t OFF_PRKV = 0;
constexpr size_t SZ_PRKV = (size_t)NR * 1536 * 2;
constexpr size_t OFF_LD = OFF_PRKV + SZ_PRKV;
constexpr size_t OFF_A = OFF_LD + (size_t)NRP * 512 * 4;
constexpr size_t OFF_X8 = OFF_LD;
constexpr size_t OFF_WIN8 = OFF_X8 + (size_t)T * 1024;
static_assert(OFF_WIN8 + (size_t)4096 * 1024 <= OFF_A, "layout");
constexpr size_t OFF_CH = OFF_A + (size_t)NRP * 512 * 2;
constexpr size_t OFF_PCONV = OFF_CH;
constexpr size_t SZ_PCONV = (size_t)NR * 2048 * 2;
constexpr size_t OFF_HB = OFF_PCONV + SZ_PCONV;
constexpr size_t OUT_XB = (size_t)T * 2048;
constexpr size_t OFF_L = OFF_HB + SZ_HB;
constexpr size_t OFF_WIN = OFF_L + (size_t)NRP * 256 * 2;
constexpr size_t CH_END = OFF_WIN + (size_t)NCOLS1 * 1024 * 2;
constexpr size_t OFF_MERGED = OFF_CH;
constexpr size_t OFF_G = CH_END;
constexpr size_t OFF_C = OFF_G + (size_t)NRP * 512 * 2;
constexpr size_t OFF_Z = OFF_C + (size_t)T * 512 * 2;
constexpr size_t OFF_COEF = OFF_Z + (size_t)T * 512 * 2;
constexpr size_t EARLY_END = OFF_COEF + (size_t)NR * 8 * 4;
static_assert(EARLY_END <= OFF_RT, "early buffers overflow");
static_assert(OFF_CH + (size_t)NUNITS * REC_BYTES <= CH_END, "chunk records overflow");
static_assert(OFF_CH >= OFF_WD + SZ_WD, "expert weights (written during the scan) must not touch live scan buffers");
static_assert(OFF_MERGED + SZ_HB <= OFF_HB2, "layout");
static_assert(OFF_PRKV % 16 == 0 && OFF_LD % 16 == 0 && OFF_A % 16 == 0 && OFF_CH % 16 == 0 && OFF_HB % 16 == 0 && OFF_L % 16 == 0 && OFF_WIN % 16 == 0 && OFF_G % 16 == 0 && OFF_C % 16 == 0 && OFF_Z % 16 == 0 && OFF_COEF % 16 == 0, "align");

#define GAS __attribute__((address_space(1)))
#define CAS __attribute__((address_space(4)))
struct Params {
    const float* in[37];
    float* out;
    unsigned char* ws;
    int ph_lo, ph_hi;
};
struct ParamsD {
    const GAS float* in[37];
    GAS float* out;
    GAS unsigned char* ws;
    int ph_lo, ph_hi;
};
static_assert(sizeof(Params) == sizeof(ParamsD), "argument views");
struct PPv {
    const CAS ParamsD* k;
    __device__ __forceinline__ const float* gin(int i) const { return (const float*)k->in[i]; }
    __device__ __forceinline__ float* gout() const { return (float*)k->out; }
    __device__ __forceinline__ unsigned char* gws() const { return (unsigned char*)k->ws; }
};
__device__ __forceinline__ PPv getpp() { const CAS ParamsD* k = (const CAS ParamsD*)__builtin_amdgcn_kernarg_segment_ptr(); asm volatile("" : "+s"(k)); return PPv{k}; }

typedef __bf16 bf16x2v __attribute__((ext_vector_type(2)));
__device__ __forceinline__ unsigned cvt_pk_bf16(float lo, float hi) { const f32x2 v = {lo, hi}; return __builtin_bit_cast(unsigned, __builtin_convertvector(v, bf16x2v)); }
__device__ __forceinline__ unsigned pk4_fp8(float a, float b, float c, float d) { int w = __builtin_amdgcn_cvt_pk_fp8_f32(a, b, 0, false); w = __builtin_amdgcn_cvt_pk_fp8_f32(c, d, w, true); return (unsigned)w; }
constexpr float W8_SCALE = 32.0f, W8_INV = 1.0f / 32.0f;
__device__ __forceinline__ bf16_t f2bf(float f) { unsigned u = __float_as_uint(f); u += 0x7FFFu + ((u >> 16) & 1u); return (bf16_t)(u >> 16); }
__device__ __forceinline__ float bf2f(bf16_t b) { return __uint_as_float(((unsigned)b) << 16); }
__device__ __forceinline__ float bflo(unsigned w) { return __uint_as_float(w << 16); }
__device__ __forceinline__ float bfhi(unsigned w) { return __uint_as_float(w & 0xFFFF0000u); }
__device__ __forceinline__ float sigmoidf_(float x) { return __builtin_amdgcn_rcpf(1.0f + __expf(-x)); }
__device__ __forceinline__ float wave_sum(float v) {
#pragma unroll
    for (int o = 32; o >= 1; o >>= 1) v += __shfl_xor(v, o);
    return v;
}
__device__ __forceinline__ float wave_sum_dpp(float v);
__device__ __forceinline__ int prev_row(int row, int d) {
    if (row < NMETA) return row - d >= 0 ? row - d : -1;
    const int s = (row - NMETA) & (SEQ - 1);
    return s >= d ? row - d : NMETA + s - d;
}

constexpr int BM = 256, BK = 64, HALF = 128, HTB = HALF * BK * 2, STAGE_BYTES = 8 * HTB, NXCD = 8, WGM = 8;
__device__ __forceinline__ int lds_byte(int r, int c) { const int st = (r >> 4) * 2 + (c >> 5), rr = r & 15, cc = c & 31, ob = rr * 64 + cc * 2; return st * 1024 + (ob ^ (((ob >> 9) & 1) << 5)); }
__device__ __forceinline__ void stage_rc(int b, int& R, int& C) { const int st = b / 1024, sb = b % 1024, swz = sb ^ (((sb >> 9) & 1) << 5); R = (st >> 1) * 16 + swz / 64; C = (st & 1) * 32 + (swz % 64) / 2; }
__device__ __forceinline__ int perm32(int rho) { const int n = rho >> 4, i = rho & 15; return 8 * (i >> 2) + 4 * n + (i & 3); }

struct Unit { int pm, pn, aux; };

struct StaticOrder {
    const char* A; const char* Bt; int K;
    int nM, nN, nwg, G, c;
    __device__ void init(const void* A_, const void* Bt_, int M, int N, int K_, int G_, int c_) { A = (const char*)A_; Bt = (const char*)Bt_; K = K_; nM = M / BM; nN = N / BM; nwg = nM * nN; G = G_; c = c_; }
    __device__ bool next(int i, Unit& u) const {
        const long L = (long)i * G + c; if (L >= nwg) return false;
        int wgid = (int)L; { const int q = nwg / NXCD, r = nwg % NXCD, xcd = wgid % NXCD, off = wgid / NXCD; wgid = (xcd < r ? xcd * (q + 1) : r * (q + 1) + (xcd - r) * q) + off; }
        const int nig = WGM * nN, gid = wgid / nig, fm = gid * WGM, gsz = (nM - fm) < WGM ? (nM - fm) : WGM;
        u.pm = fm + ((wgid % nig) % gsz); u.pn = (wgid % nig) / gsz; u.aux = 0; return true;
    }
    __device__ __forceinline__ const char* a_ptr(const Unit& u) const { return A + (size_t)u.pm * 256 * K * 2; }
    __device__ __forceinline__ const char* b_ptr(const Unit& u) const { return Bt + (size_t)u.pn * 256 * K * 2; }
    __device__ __forceinline__ int gather_row(const Unit&, int) const { return 0; }
    __device__ __forceinline__ const void* gather_src(const Unit&, int) const { return nullptr; }
};
struct MoeOrder {
    const char* A; const char* Bt; int K; size_t estride;
    const int* tile_e; const int* rowtok; int ntiles, nnt, G, c; bool gather;
    __device__ bool next(int i, Unit& u) const {
        int mt, nt;
        if ((G & 7) == 0 && ((G >> 3) % nnt) == 0) {
            const int x = c & 7, j = c >> 3, per = (G >> 3) / nnt;
            mt = (i + 1) * 8 * per <= ntiles ? (i * 8 + x) * per + j / nnt : i * 8 * per + (j / nnt) * 8 + x; nt = j % nnt;
        } else { const long L = (long)i * G + c; mt = (int)(L / nnt); nt = (int)(L % nnt); }
        if (mt >= ntiles) return false;
        u.pm = mt; u.pn = nt; u.aux = tile_e[mt]; return true;
    }
    __device__ __forceinline__ const char* a_ptr(const Unit& u) const { return gather ? A : A + (size_t)u.pm * 256 * K * 2; }
    __device__ __forceinline__ const char* b_ptr(const Unit& u) const { return Bt + (size_t)u.aux * estride + (size_t)u.pn * 256 * K * 2; }
    __device__ __forceinline__ int gather_row(const Unit& u, int r) const { return rowtok[u.pm * 256 + r]; }
    __device__ __forceinline__ const void* gather_src(const Unit& u, int lane) const { return rowtok + u.pm * 256 + lane * 4; }
};

struct ProjOrder {
    StaticOrder so; int split, off0, off1; bool bcompact;
    __device__ bool next(int i, Unit& u) const { const bool ok = so.next(i, u); u.aux = u.pn; u.pn += (u.pn < split ? off0 : off1); return ok; }
    __device__ __forceinline__ const char* a_ptr(const Unit& u) const { return so.a_ptr(u); }
    __device__ __forceinline__ const char* b_ptr(const Unit& u) const { return so.Bt + (size_t)(bcompact ? u.aux : u.pn) * 256 * so.K * 2; }
    __device__ __forceinline__ int gather_row(const Unit&, int) const { return 0; }
    __device__ __forceinline__ const void* gather_src(const Unit&, int) const { return nullptr; }
};
typedef int i32x4 __attribute__((ext_vector_type(4)));
typedef int i32x8 __attribute__((ext_vector_type(8)));
template <bool GATHER, bool FP8 = false, class Epi, class Sched>
__device__ __forceinline__ void gemm_phase(LAS unsigned char* lds, const int K_, const Sched& S, const Epi& E) {
    int K = K_; asm volatile("" : "+s"(K));
    const int tid = threadIdx.x, wid = __builtin_amdgcn_readfirstlane(tid >> 6), lane = tid & 63, wr = wid >> 2, wc = wid & 3, fr = lane & 15, fq = lane >> 4;
    const int nt = K / BK;
    unsigned voffA[2], voffB[2]; int Rr[2], Cc[2];
#pragma unroll
    for (int i = 0; i < 2; ++i) { int R, C; stage_rc(tid * 16 + i * 8192, R, C); const int Rb = (R & ~31) + perm32(R & 31);
        Rr[i] = R; Cc[i] = C; voffA[i] = (unsigned)(R * K + C) * 2u; voffB[i] = (unsigned)(Rb * K + C) * 2u; }
    const size_t kstep = (size_t)(BK * 2);
    const size_t hstep = (size_t)HALF * K * 2;
    const unsigned ldsw = (unsigned)wid * 1024u;
    const int aoff = lds_byte(wr * 64 + fr, fq * 8), boff = lds_byte(wc * 32 + fr, fq * 8);
    unsigned vgc[2][2], vgn[2][2];
    LAS unsigned char* const parbase = lds + STAGE_BYTES;
    constexpr int NPAR = Epi::NPAR;
#define G_PAR_ISSUE(unit, uidx, hasnx, nxunit) do { \
        LAS unsigned char* _ps = parbase + ((uidx) & 1) * 4096; \
        if (wid < NPAR) __builtin_amdgcn_global_load_lds((const unsigned*)E.par_src(unit, wid, lane), (LAS unsigned*)(_ps + wid * 1024), 16, 0, 0); \
        if (GATHER && (hasnx) && wid == NPAR) __builtin_amdgcn_global_load_lds((const unsigned*)S.gather_src(nxunit, lane), (LAS unsigned*)(_ps + NPAR * 1024), 16, 0, 0); } while (0)
#define G_CAT8(x0, x1) __builtin_shufflevector(__builtin_bit_cast(i32x4, x0), __builtin_bit_cast(i32x4, x1), 0, 1, 2, 3, 4, 5, 6, 7)
#define G_SA(b, h) (((b) * 2 + (h)) * HTB)
#define G_SB(b, h) ((4 + (b) * 2 + (h)) * HTB)
#define G_STAGE(bufoff, gbase, voff) do { _Pragma("unroll") for (int _i = 0; _i < 2; ++_i) \
        __builtin_amdgcn_global_load_lds((const unsigned*)((const char*)(gbase) + (voff)[_i]), (LAS unsigned*)(lds + (bufoff) + ldsw + _i * 8192), 16, 0, 0); } while (0)
#define G_STAGE_A(bufoff, kptr, h, VG) do { if (GATHER) { G_STAGE(bufoff, kptr, VG[h]); } else { G_STAGE(bufoff, (kptr) + (h) * hstep, voffA); } } while (0)
#define G_LDA(dst, b, h) do { _Pragma("unroll") for (int m = 0; m < 4; ++m) { \
        if (FP8) dst##8[m] = G_CAT8(*(const LAS bf16x8*)(lds + G_SA(b, h) + aoff + m * 2048), *(const LAS bf16x8*)(lds + G_SA(b, h) + aoff + m * 2048 + 1024)); \
        else { _Pragma("unroll") for (int k = 0; k < 2; ++k) dst[m][k] = *(const LAS bf16x8*)(lds + G_SA(b, h) + aoff + m * 2048 + k * 1024); } } } while (0)
#define G_LDB(dst, b, h) do { _Pragma("unroll") for (int n = 0; n < 2; ++n) { \
        if (FP8) dst##8[n] = G_CAT8(*(const LAS bf16x8*)(lds + G_SB(b, h) + boff + n * 2048), *(const LAS bf16x8*)(lds + G_SB(b, h) + boff + n * 2048 + 1024)); \
        else { _Pragma("unroll") for (int k = 0; k < 2; ++k) dst[n][k] = *(const LAS bf16x8*)(lds + G_SB(b, h) + boff + n * 2048 + k * 1024); } } } while (0)
#define G_MMA(ai, bj, At, Bt) do { __builtin_amdgcn_s_setprio(1); _Pragma("unroll") for (int m = 0; m < 4; ++m) _Pragma("unroll") for (int n = 0; n < 2; ++n) { \
        if (FP8) asm volatile("v_mfma_scale_f32_16x16x128_f8f6f4 %0, %1, %2, %0, %3, %3 op_sel_hi:[0,0,0]" : "+v"(acc[ai][bj][m][n]) : "v"(Bt##8[n]), "v"(At##8[m]), "v"(sc8)); \
        else { _Pragma("unroll") for (int k = 0; k < 2; ++k) acc[ai][bj][m][n] = __builtin_amdgcn_mfma_f32_16x16x32_bf16(Bt[n][k], At[m][k], acc[ai][bj][m][n], 0, 0, 0); } } \
        __builtin_amdgcn_s_setprio(0); } while (0)
#define G_WAIT_V(n) asm volatile("s_waitcnt vmcnt(" #n ")" ::: "memory")
#define G_WAIT_VI(n) asm volatile("s_waitcnt vmcnt(%0)" :: "n"(n) : "memory")
#define G_WAIT_L(n) asm volatile("s_waitcnt lgkmcnt(" #n ")" ::: "memory")
#define G_BAR __builtin_amdgcn_s_barrier()
#define G_SCHED __builtin_amdgcn_sched_barrier(0)
    Unit cur, nxt;
    int ui = 0;
    constexpr int NVM = Epi::NVM;
    if (!S.next(0, cur)) return;
    f32x4 acc[2][2][4][2];
#pragma unroll
    for (int a = 0; a < 2; ++a)
#pragma unroll
        for (int b = 0; b < 2; ++b)
#pragma unroll
            for (int m = 0; m < 4; ++m)
#pragma unroll
                for (int n = 0; n < 2; ++n) acc[a][b][m][n] = (f32x4){0.f, 0.f, 0.f, 0.f};
    bf16x8 At[4][2], B0[2][2], B1[2][2];
    i32x8 At8[4], B08[2], B18[2];
    int sc8 = 0x7F7F7F7F; asm volatile("" : "+v"(sc8));
    const char* cA = S.a_ptr(cur); const char* cB = S.b_ptr(cur);
    if (GATHER) {
#pragma unroll
        for (int h = 0; h < 2; ++h)
#pragma unroll
            for (int i = 0; i < 2; ++i) vgc[h][i] = (unsigned)(S.gather_row(cur, h * HALF + Rr[i]) * K + Cc[i]) * 2u;
    }
    { Unit n1; const bool hn1 = S.next(1, n1); G_PAR_ISSUE(cur, 0, hn1, n1); }
    G_STAGE(G_SB(0, 0), cB, voffB); G_STAGE_A(G_SA(0, 0), cA, 0, vgc); G_STAGE(G_SB(0, 1), cB + hstep, voffB); G_STAGE_A(G_SA(0, 1), cA, 1, vgc);
    if (wr == 1) G_BAR;
    G_WAIT_V(4); G_BAR;
    G_STAGE(G_SB(1, 0), cB + kstep, voffB); G_STAGE_A(G_SA(1, 0), cA + kstep, 0, vgc); G_STAGE(G_SB(1, 1), cB + hstep + kstep, voffB); G_STAGE_A(G_SA(1, 1), cA + kstep, 1, vgc);
    G_WAIT_V(8); G_BAR;
    for (;;) {
        const bool has_next = S.next(ui + 1, nxt);
        const char* nA = has_next ? S.a_ptr(nxt) : cA; const char* nB = has_next ? S.b_ptr(nxt) : cB;
        if (ui > 0) G_PAR_ISSUE(cur, ui, has_next, nxt);
        if (GATHER) {
#pragma unroll
            for (int h = 0; h < 2; ++h)
#pragma unroll
                for (int i = 0; i < 2; ++i) vgn[h][i] = vgc[h][i];
        }
        for (int t = 0; t < nt; t += 2) {
            const bool last = (t == nt - 2);
            const char* a2 = last ? nA : cA + (size_t)(t + 2) * kstep; const char* b2 = last ? nB : cB + (size_t)(t + 2) * kstep;
            const char* a3 = a2 + kstep; const char* b3 = b2 + kstep;
            unsigned vg2[2][2];
            if (GATHER) {
#pragma unroll
                for (int h = 0; h < 2; ++h)
#pragma unroll
                    for (int i = 0; i < 2; ++i) vg2[h][i] = last ? vgn[h][i] : vgc[h][i];
            }
            G_LDB(B0, 0, 0); G_SCHED; G_LDA(At, 0, 0);
            G_WAIT_L(8); G_BAR; G_WAIT_L(0); G_MMA(0, 0, At, B0); G_BAR; G_SCHED;
            G_LDB(B1, 0, 1); G_STAGE(G_SB(0, 0), b2, voffB);
            G_BAR; G_WAIT_L(0); G_MMA(0, 1, At, B1); G_BAR;
            G_LDA(At, 0, 1); G_STAGE_A(G_SA(0, 0), a2, 0, vg2);
            G_BAR; G_WAIT_L(0); G_MMA(1, 0, At, B0); G_BAR; G_SCHED;
            G_STAGE(G_SB(0, 1), b2 + hstep, voffB);
            {
                const int relax = __builtin_amdgcn_readfirstlane((t == 0 && ui > 0) ? 1 : 0);
                asm volatile("s_cmp_lg_u32 %0, 0\n\ts_cbranch_scc1 .Lrelax_%=\n\ts_waitcnt vmcnt(6)\n\ts_branch .Ldone_%=\n.Lrelax_%=:\n\ts_waitcnt vmcnt(%1)\n.Ldone_%=:" :: "s"(relax), "n"(6 + NVM) : "scc", "memory");
            }
            G_BAR; G_MMA(1, 1, At, B1); G_BAR;
            G_LDB(B0, 1, 0); G_SCHED; G_LDA(At, 1, 0); G_STAGE_A(G_SA(0, 1), a2, 1, vg2);
            G_WAIT_L(8); G_BAR; G_WAIT_L(0); G_MMA(0, 0, At, B0); G_BAR; G_SCHED;
            G_LDB(B1, 1, 1); G_STAGE(G_SB(1, 0), b3, voffB);
            G_BAR; G_WAIT_L(0); G_MMA(0, 1, At, B1); G_BAR;
            G_LDA(At, 1, 1); G_STAGE_A(G_SA(1, 0), a3, 0, vg2);
            G_BAR; G_WAIT_L(0); G_MMA(1, 0, At, B0); G_BAR; G_SCHED;
            G_STAGE(G_SB(1, 1), b3 + hstep, voffB);
            G_WAIT_V(6); G_BAR; G_MMA(1, 1, At, B1); G_BAR;
            if (GATHER) { unsigned vge[2]; vge[0] = last ? vgn[1][0] : vgc[1][0]; vge[1] = last ? vgn[1][1] : vgc[1][1]; G_STAGE(G_SA(1, 1), a3, vge); }
            else G_STAGE(G_SA(1, 1), a3 + hstep, voffA);
            if (GATHER && t == 0 && has_next) {
                const LAS int* rows = (const LAS int*)(parbase + (ui & 1) * 4096 + NPAR * 1024);
#pragma unroll
                for (int h = 0; h < 2; ++h)
#pragma unroll
                    for (int i = 0; i < 2; ++i) vgn[h][i] = (unsigned)(rows[h * HALF + Rr[i]] * K + Cc[i]) * 2u;
            }
        }
        if (FP8) asm volatile("s_nop 15\n\ts_nop 15" ::: "memory");
        const bool keep_acc = E(acc, cur, wr, wc, fr, fq, (const LAS unsigned char*)(parbase + (ui & 1) * 4096));
        if (!has_next) break;
        if (!keep_acc)
#pragma unroll
        for (int a = 0; a < 2; ++a)
#pragma unroll
            for (int b = 0; b < 2; ++b)
#pragma unroll
                for (int m = 0; m < 4; ++m)
#pragma unroll
                    for (int n = 0; n < 2; ++n) acc[a][b][m][n] = (f32x4){0.f, 0.f, 0.f, 0.f};
        cur = nxt; cA = nA; cB = nB; ++ui;
        if (GATHER) {
#pragma unroll
            for (int h = 0; h < 2; ++h)
#pragma unroll
                for (int i = 0; i < 2; ++i) vgc[h][i] = vgn[h][i];
        }
    }
    G_WAIT_V(0);
    if (wr == 0) G_BAR;
    G_BAR;
#undef G_PAR_ISSUE
#undef G_SA
#undef G_SB
#undef G_STAGE
#undef G_STAGE_A
#undef G_LDA
#undef G_LDB
#undef G_MMA
#undef G_CAT8
#undef G_WAIT_V
#undef G_WAIT_L
#undef G_BAR
#undef G_SCHED
}

__device__ __forceinline__ u32x4 pair16(u32x2 a, u32x2 b) {
    unsigned ax = a.x, ay = a.y, bx = b.x, by = b.y;
    asm volatile("v_nop\n\tv_nop\n\tv_permlane16_swap_b32 %0, %1\n\tv_nop" : "+v"(ax), "+v"(bx));
    asm volatile("v_nop\n\tv_nop\n\tv_permlane16_swap_b32 %0, %1\n\tv_nop" : "+v"(ay), "+v"(by));
    u32x4 w; w.x = ax; w.y = ay; w.z = bx; w.w = by; return w;
}
__device__ __forceinline__ float dpp_prev_row(float prev, float cur) {
    const int pb = __builtin_amdgcn_update_dpp(0, __builtin_bit_cast(int, prev), 0x121, 0xF, 0xF, false);
    return __builtin_bit_cast(float, __builtin_amdgcn_update_dpp(pb, __builtin_bit_cast(int, cur), 0x111, 0xF, 0xF, false));
}
struct EpiProj {
    bf16_t* prkv; bf16_t* pconv; unsigned char* gates; const float* rstd1; int pn0; float osc; bf16_t* lact; bf16_t* cbr; const float* cw;
    static constexpr int NPAR = 1;
    static constexpr int NVM = 8;
    __device__ __forceinline__ const void* par_src(const Unit& u, int, int lane) const { return rstd1 + NMETA + u.pm * BM + lane * 4; }
    __device__ __forceinline__ bool operator()(const f32x4 (&acc)[2][2][4][2], const Unit& u, int wr, int wc, int fr, int fq, const LAS unsigned char* par) const {
        const int row0 = u.pm * BM + wr * 64 + fr;
        const int pn = u.pn + pn0;
        const bool isg = pn >= 14, isq = pn >= 4 && pn < 12, isl = pn == 12 || pn == 13;
        float rsv[2][4];
#pragma unroll
        for (int ai = 0; ai < 2; ++ai)
#pragma unroll
            for (int m = 0; m < 4; ++m) rsv[ai][m] = ((const LAS float*)par)[wr * 64 + fr + ai * HALF + m * 16] * osc;
        if (isg) {
            const bool oddq = fq & 1;
            const f32x2 one2 = {1.0f, 1.0f};
#pragma unroll
            for (int ai = 0; ai < 2; ++ai)
#pragma unroll
                for (int mp = 0; mp < 4; mp += 2)
#pragma unroll
                    for (int bj = 0; bj < 2; ++bj) {
                        u32x2 wm[2];
#pragma unroll
                        for (int mm = 0; mm < 2; ++mm) {
                            const int m = mp + mm;
                            const float rs = rsv[ai][m] * -1.44269504089f; const f32x2 rs2 = {rs, rs};
                            const f32x4 a0 = acc[ai][bj][m][0], a1 = acc[ai][bj][m][1];
                            const f32x2 p[4] = {LO2(a0) * rs2, HI2(a0) * rs2, LO2(a1) * rs2, HI2(a1) * rs2};
                            unsigned wq[2] = {0u, 0u};
#pragma unroll
                            for (int q = 0; q < 4; ++q) {
                                const f32x2 e = {__builtin_amdgcn_exp2f(p[q][0]), __builtin_amdgcn_exp2f(p[q][1])}; const f32x2 d = e + one2;
                                const f32x2 sg = {__builtin_amdgcn_rcpf(d[0]), __builtin_amdgcn_rcpf(d[1])}, t = sg * (f32x2){255.0f, 255.0f};
                                wq[q >> 1] = __builtin_amdgcn_cvt_pk_u8_f32(fmaxf(__builtin_rintf(t[0]), 1.0f), 2 * (q & 1), wq[q >> 1]);
                                wq[q >> 1] = __builtin_amdgcn_cvt_pk_u8_f32(fmaxf(__builtin_rintf(t[1]), 1.0f), 2 * (q & 1) + 1, wq[q >> 1]);
                            }
                            wm[mm].x = wq[0]; wm[mm].y = wq[1];
                        }
                        const u32x4 w = pair16(wm[0], wm[1]);
                        *(u32x4*)((unsigned char*)gates + (size_t)(row0 + ai * HALF + (mp + (oddq ? 1 : 0)) * 16) * 2048 + (pn - 14) * 256 + wc * 32 + 8 * fq - (oddq ? 8 : 0) + bj * HALF) = w;
                    }
            return false;
        }
        if (isq) {
            const int chn = 64 * (pn - 4) + 16 * wc + 4 * fq;
            const f32x4 w0 = *(const f32x4*)(cw + chn), w1 = *(const f32x4*)(cw + 512 + chn), w2 = *(const f32x4*)(cw + 1024 + chn);
#pragma unroll
            for (int ai = 0; ai < 2; ++ai) {
                f32x4 uu[4], u1p = (f32x4){0.f, 0.f, 0.f, 0.f};
                u32x2 wcq[4], wvq[4];
#pragma unroll
                for (int m = 0; m < 4; ++m) { const float rr = rsv[ai][m] * rsv[ai][m]; uu[m] = (acc[ai][0][m][1] * acc[ai][1][m][0]) * rr; }
#pragma unroll
                for (int m = 0; m < 4; ++m) {
                    const int row = row0 + ai * HALF + m * 16;
                    const float rs = rsv[ai][m];
                    const f32x4 up = uu[m > 0 ? m - 1 : 0], uc = uu[m];
                    const f32x4 u1 = {dpp_prev_row(up.x, uc.x), dpp_prev_row(up.y, uc.y), dpp_prev_row(up.z, uc.z), dpp_prev_row(up.w, uc.w)};
                    const f32x4 q1 = m > 0 ? u1p : u1;
                    const f32x4 u2 = {dpp_prev_row(q1.x, u1.x), dpp_prev_row(q1.y, u1.y), dpp_prev_row(q1.z, u1.z), dpp_prev_row(q1.w, u1.w)};
                    u1p = u1;
                    const f32x4 cv = w0 * u2 + w1 * u1 + w2 * uc;
                    const f32x4 cb = acc[ai][0][m][0] * rs, co = cb * cv, vv = acc[ai][1][m][1] * rs;
                    wcq[m].x = cvt_pk_bf16(co[0], co[1]); wcq[m].y = cvt_pk_bf16(co[2], co[3]);
                    wvq[m].x = cvt_pk_bf16(vv[0], vv[1]); wvq[m].y = cvt_pk_bf16(vv[2], vv[3]);
                    bf16_t* rawp = pconv + (size_t)(NMETA + row) * 2048 + chn;
                    if ((m == 0 && fr < 2) || (m == 3 && fr >= 14)) { u32x2 wu_; wu_.x = cvt_pk_bf16(uc[0], uc[1]); wu_.y = cvt_pk_bf16(uc[2], uc[3]); *(u32x2*)(rawp + 512) = wu_; }
                    if (m == 0 && fr < 2) { u32x2 wb_; wb_.x = cvt_pk_bf16(cb[0], cb[1]); wb_.y = cvt_pk_bf16(cb[2], cb[3]); *(u32x2*)rawp = wb_; }
                }
#pragma unroll
                for (int mp = 0; mp < 4; mp += 2) {
                    const bool oddq = fq & 1;
                    const int rowp_ = row0 + ai * HALF + (mp + (oddq ? 1 : 0)) * 16, chp = chn - (oddq ? 4 : 0);
                    const u32x4 wcw = pair16(wcq[mp], wcq[mp + 1]), wvw = pair16(wvq[mp], wvq[mp + 1]);
                    *(u32x4*)(cbr + (size_t)rowp_ * 512 + chp) = wcw;
                    *(u32x4*)(prkv + (size_t)(NMETA + rowp_) * 1536 + 1024 + chp) = wvw;
                }
            }
            return false;
        }
        if (isl) {
            const int kind = pn == 13 ? 2 : (wc < 2 ? 0 : 1);
#pragma unroll
            for (int ai = 0; ai < 2; ++ai) {
                f32x2 p2s[4][4];
#pragma unroll
                for (int m = 0; m < 4; ++m) {
                    const f32x2 rs2 = {rsv[ai][m], rsv[ai][m]};
#pragma unroll
                    for (int q = 0; q < 4; ++q) { const f32x4 a4 = acc[ai][1][m][q >> 1]; p2s[m][q] = ((q & 1) ? HI2(a4) : LO2(a4)) * rs2; }
                }
#pragma unroll
                for (int m = 0; m < 4; ++m) {
                    const int row = row0 + ai * HALF + m * 16;
                    const f32x2 rs2 = {rsv[ai][m], rsv[ai][m]};
                    f32x2 p1[4], lv[4];
#pragma unroll
                    for (int q = 0; q < 4; ++q) {
                        const f32x4 a4 = acc[ai][0][m][q >> 1]; p1[q] = ((q & 1) ? HI2(a4) : LO2(a4)) * rs2;
                        const f32x2 pvb = p2s[m > 0 ? m - 1 : 0][q], pcb = p2s[m][q];
                        const f32x2 sh = {dpp_prev_row(pvb.x, pcb.x), dpp_prev_row(pvb.y, pcb.y)};
                        f32x2 x = p1[q] + sh;
                        if (kind == 0) { const f32x2 z = x * (f32x2){2.88539008178f, 2.88539008178f}; const f32x2 e = {__builtin_amdgcn_exp2f(z[0]), __builtin_amdgcn_exp2f(z[1])}; const f32x2 d = e + (f32x2){1.0f, 1.0f};
                                         x = (f32x2){1.0f, 1.0f} - (f32x2){2.0f, 2.0f} * (f32x2){__builtin_amdgcn_rcpf(d[0]), __builtin_amdgcn_rcpf(d[1])}; }
                        if (kind == 2) { const f32x2 z = x * (f32x2){-1.44269504089f, -1.44269504089f}; const f32x2 e = {__builtin_amdgcn_exp2f(z[0]), __builtin_amdgcn_exp2f(z[1])}; const f32x2 d = e + (f32x2){1.0f, 1.0f};
                                         x = (f32x2){__builtin_amdgcn_rcpf(d[0]), __builtin_amdgcn_rcpf(d[1])}; }
                        lv[q] = x;
                    }
                    u32x4 w; w.x = cvt_pk_bf16(lv[0][0], lv[0][1]); w.y = cvt_pk_bf16(lv[1][0], lv[1][1]); w.z = cvt_pk_bf16(lv[2][0], lv[2][1]); w.w = cvt_pk_bf16(lv[3][0], lv[3][1]);
                    *(u32x4*)(lact + (size_t)(NMETA + row) * 256 + (pn - 12) * 128 + wc * 32 + 8 * fq) = w;
                    bf16_t* rawp = pconv + (size_t)(NMETA + row) * 2048 + (pn - 6) * 256 + wc * 32 + 8 * fq;
                    if (m == 0 && fr == 0) { u32x4 r1; r1.x = cvt_pk_bf16(p1[0][0], p1[0][1]); r1.y = cvt_pk_bf16(p1[1][0], p1[1][1]); r1.z = cvt_pk_bf16(p1[2][0], p1[2][1]); r1.w = cvt_pk_bf16(p1[3][0], p1[3][1]); *(u32x4*)rawp = r1; }
                    if (m == 3 && fr == 15) { u32x4 r2; r2.x = cvt_pk_bf16(p2s[3][0][0], p2s[3][0][1]); r2.y = cvt_pk_bf16(p2s[3][1][0], p2s[3][1][1]); r2.z = cvt_pk_bf16(p2s[3][2][0], p2s[3][2][1]); r2.w = cvt_pk_bf16(p2s[3][3][0], p2s[3][3][1]); *(u32x4*)(rawp + HALF) = r2; }
                }
            }
            return false;
        }
#pragma unroll
        for (int ai = 0; ai < 2; ++ai)
#pragma unroll
            for (int m = 0; m < 4; ++m) {
                const int row = row0 + ai * HALF + m * 16;
                const float rs = isg ? rsv[ai][m] * -1.44269504089f : rsv[ai][m]; const f32x2 rs2 = {rs, rs}, one2 = {1.0f, 1.0f};
                bf16_t* rowp = (pn < 6 ? prkv + (size_t)(NMETA + row) * 1536 + pn * 256 : pconv + (size_t)(NMETA + row) * 2048 + (pn - 6) * 256) + wc * 32 + 8 * fq;
#pragma unroll
                for (int bj = 0; bj < 2; ++bj) {
                    const f32x4 a0 = acc[ai][bj][m][0], a1 = acc[ai][bj][m][1];
                    f32x2 p[4] = {LO2(a0) * rs2, HI2(a0) * rs2, LO2(a1) * rs2, HI2(a1) * rs2};
                    if (isg) {
                        unsigned wq[2] = {0u, 0u};
#pragma unroll
                        for (int q = 0; q < 4; ++q) {
                            const f32x2 e = {__builtin_amdgcn_exp2f(p[q][0]), __builtin_amdgcn_exp2f(p[q][1])}; const f32x2 d = e + one2;
                            const f32x2 sg = {__builtin_amdgcn_rcpf(d[0]), __builtin_amdgcn_rcpf(d[1])}, t = sg * (f32x2){255.0f, 255.0f};
                            wq[q >> 1] = __builtin_amdgcn_cvt_pk_u8_f32(fmaxf(__builtin_rintf(t[0]), 1.0f), 2 * (q & 1), wq[q >> 1]);
                            wq[q >> 1] = __builtin_amdgcn_cvt_pk_u8_f32(fmaxf(__builtin_rintf(t[1]), 1.0f), 2 * (q & 1) + 1, wq[q >> 1]);
                        }
                        u32x2 w8; w8.x = wq[0]; w8.y = wq[1];
                        *(u32x2*)((unsigned char*)gates + (size_t)row * 2048 + (pn - 14) * 256 + wc * 32 + 8 * fq + bj * HALF) = w8;
                        continue;
                    }
                    u32x4 w; w.x = cvt_pk_bf16(p[0][0], p[0][1]); w.y = cvt_pk_bf16(p[1][0], p[1][1]); w.z = cvt_pk_bf16(p[2][0], p[2][1]); w.w = cvt_pk_bf16(p[3][0], p[3][1]);
                    *(u32x4*)(rowp + bj * HALF) = w;
                }
            }
        return false;
    }
};
struct EpiL {
    static constexpr int NPAR = 0;
    static constexpr int NVM = 16;
    __device__ __forceinline__ const void* par_src(const Unit&, int, int) const { return nullptr; }
    unsigned char* wsb; const float* w0; const float* a0;
    __device__ __forceinline__ bool operator()(const f32x4 (&acc)[2][2][4][2], const Unit& u, int wr, int wc, int fr, int fq, const LAS unsigned char* par) const {
        const int row0 = NMETA + u.pm * BM + wr * 64 + fr;
        const int seg = u.pn >> 1;
        const int cb = (u.pn & 1) * 256 + wc * 32 + 8 * fq;
        const float* bias = seg == 0 ? w0 : a0;
        f32x4 bv[2][2];
#pragma unroll
        for (int bj = 0; bj < 2; ++bj) {
            bv[bj][0] = seg < 2 ? *(const f32x4*)(bias + cb + bj * HALF) : (f32x4){0.f, 0.f, 0.f, 0.f};
            bv[bj][1] = seg < 2 ? *(const f32x4*)(bias + cb + bj * HALF + 4) : (f32x4){0.f, 0.f, 0.f, 0.f};
        }
        const float sc = seg == 0 ? -0.60653065971f : 1.0f;
        bf16_t* ob = (bf16_t*)(wsb + (seg == 0 ? OFF_LD : seg == 1 ? OFF_A : OFF_G));
#pragma unroll
        for (int ai = 0; ai < 2; ++ai)
#pragma unroll
            for (int m = 0; m < 4; ++m) {
                const int row = row0 + ai * HALF + m * 16;
#pragma unroll
                for (int bj = 0; bj < 2; ++bj) {
                    const int c = cb + bj * HALF;
                    f32x4 v0 = acc[ai][bj][m][0] + bv[bj][0], v1 = acc[ai][bj][m][1] + bv[bj][1];
                    if (seg < 2) {
#pragma unroll
                        for (int j = 0; j < 4; ++j) { v0[j] = sc * sigmoidf_(v0[j]); v1[j] = sc * sigmoidf_(v1[j]); }
                    }
                    {
                        u32x4 w; w.x = cvt_pk_bf16(v0[0], v0[1]); w.y = cvt_pk_bf16(v0[2], v0[3]); w.z = cvt_pk_bf16(v1[0], v1[1]); w.w = cvt_pk_bf16(v1[2], v1[3]);
                        *(u32x4*)(ob + (size_t)row * 512 + c) = w;
                    }
                }
            }
        return false;
    }
};
struct MergeOrder {
    StaticOrder so; const char* A1; const char* B1;
    __device__ bool next(int i, Unit& u) const { const bool ok = so.next(i >> 1, u); u.aux = i & 1; return ok; }
    __device__ __forceinline__ const char* a_ptr(const Unit& u) const { return (u.aux ? A1 : so.A) + (size_t)u.pm * 256 * so.K * 2; }
    __device__ __forceinline__ const char* b_ptr(const Unit& u) const { return (u.aux ? B1 : so.Bt) + (size_t)u.pn * 256 * so.K * 2; }
    __device__ __forceinline__ int gather_row(const Unit&, int) const { return 0; }
    __device__ __forceinline__ const void* gather_src(const Unit&, int) const { return nullptr; }
};
struct EpiMergeFused {
    static constexpr int NPAR = 0;
    static constexpr int NVM = 24;
    __device__ __forceinline__ const void* par_src(const Unit&, int, int) const { return nullptr; }
    unsigned char* merged; const unsigned char* gates;
    __device__ __forceinline__ bool operator()(f32x4 (&acc)[2][2][4][2], const Unit& u, int wr, int wc, int fr, int fq, const LAS unsigned char* par) const {
        const int row0 = u.pm * BM + wr * 64 + fr, col0 = u.pn * BM + wc * 32 + 8 * fq;
#pragma unroll
        for (int ai = 0; ai < 2; ++ai) {
            u32x2 gbw[4][2], gaw[4][2];
            u32x2 w8q[4][2];
#pragma unroll
            for (int m = 0; m < 4; ++m)
#pragma unroll
                for (int bj = 0; bj < 2; ++bj) {
                    const unsigned char* gp = gates + (size_t)(row0 + ai * HALF + m * 16) * 2048 + col0 + bj * HALF;
                    gbw[m][bj] = *(const u32x2*)(gp + 1024);
                    gaw[m][bj] = u.aux == 0 ? *(const u32x2*)gp : (u32x2){0u, 0u};
                }
#pragma unroll
            for (int m = 0; m < 4; ++m)
#pragma unroll
                for (int bj = 0; bj < 2; ++bj) {
                    const int row = row0 + ai * HALF + m * 16, c = col0 + bj * HALF;
                    f32x2 gbp[4], res[4];
#pragma unroll
                    for (int q = 0; q < 4; ++q) { const unsigned wq = gbw[m][bj][q >> 1] >> (16 * (q & 1)); gbp[q] = (f32x2){(float)(wq & 0xffu), (float)((wq >> 8) & 0xffu)}; }
                    if (u.aux == 0) {
#pragma unroll
                        for (int q = 0; q < 4; ++q) {
                            const unsigned wq = gaw[m][bj][q >> 1] >> (16 * (q & 1));
                            const f32x2 gap = {(float)(wq & 0xffu), (float)((wq >> 8) & 0xffu)}, rc = {__builtin_amdgcn_rcpf(gbp[q][0]), __builtin_amdgcn_rcpf(gbp[q][1])};
                            const f32x2 sc = gap * rc;
                            f32x4& a4 = acc[ai][bj][m][q >> 1];
                            if (q & 1) { const f32x2 t = HI2(a4) * sc; a4[2] = t[0]; a4[3] = t[1]; } else { const f32x2 t = LO2(a4) * sc; a4[0] = t[0]; a4[1] = t[1]; }
                        }
                    } else {
#pragma unroll
                        for (int q = 0; q < 4; ++q) { const f32x4 a4 = acc[ai][bj][m][q >> 1]; res[q] = ((q & 1) ? HI2(a4) : LO2(a4)) * (gbp[q] * (f32x2){1.0f / 255.0f, 1.0f / 255.0f}); }
                        w8q[m][bj].x = pk4_fp8(res[0][0], res[0][1], res[1][0], res[1][1]); w8q[m][bj].y = pk4_fp8(res[2][0], res[2][1], res[3][0], res[3][1]);
                    }
                }
            if (u.aux != 0) {
#pragma unroll
                for (int mp = 0; mp < 4; mp += 2)
#pragma unroll
                    for (int bj = 0; bj < 2; ++bj) {
                        const bool oddq = fq & 1;
                        const size_t o = (size_t)(row0 + ai * HALF + (mp + (oddq ? 1 : 0)) * 16) * 1024 + col0 - (oddq ? 8 : 0) + bj * HALF;
                        *(u32x4*)(merged + o) = pair16(w8q[mp][bj], w8q[mp + 1][bj]);
                    }
            }
        }
        return u.aux == 0;
    }
};
struct EpiO {
    static constexpr int NPAR = 0;
    static constexpr int NVM = 40;
    __device__ __forceinline__ const void* par_src(const Unit&, int, int) const { return nullptr; }
    const bf16_t* x; float* h1; bf16_t* hb2; unsigned char* hb8; float osc;
    __device__ __forceinline__ bool operator()(const f32x4 (&acc)[2][2][4][2], const Unit& u, int wr, int wc, int fr, int fq, const LAS unsigned char* par) const {
        const int row0 = u.pm * BM + wr * 64 + fr, col0 = u.pn * BM + wc * 32 + 8 * fq;
#pragma unroll
        for (int ai = 0; ai < 2; ++ai) {
            u32x2 w8q[4][2];
            u32x4 xw[4][2];
#pragma unroll
            for (int m = 0; m < 4; ++m)
#pragma unroll
                for (int bj = 0; bj < 2; ++bj) xw[m][bj] = *(const u32x4*)(x + (size_t)(row0 + ai * HALF + m * 16) * 1024 + col0 + bj * HALF);
#pragma unroll
            for (int m = 0; m < 4; ++m)
#pragma unroll
                for (int bj = 0; bj < 2; ++bj) {
                    const size_t o = (size_t)(row0 + ai * HALF + m * 16) * 1024 + col0 + bj * HALF;
                    const f32x4 a0 = acc[ai][bj][m][0], a1 = acc[ai][bj][m][1];
                    const u32x4 xq = xw[m][bj];
                    const f32x2 os2 = {osc, osc};
                    const f32x2 p0 = LO2(a0) * os2 + (f32x2){bflo(xq.x), bfhi(xq.x)}, p1 = HI2(a0) * os2 + (f32x2){bflo(xq.y), bfhi(xq.y)}, p2 = LO2(a1) * os2 + (f32x2){bflo(xq.z), bfhi(xq.z)}, p3 = HI2(a1) * os2 + (f32x2){bflo(xq.w), bfhi(xq.w)};
                    u32x4 w; w.x = cvt_pk_bf16(p0[0], p0[1]); w.y = cvt_pk_bf16(p1[0], p1[1]); w.z = cvt_pk_bf16(p2[0], p2[1]); w.w = cvt_pk_bf16(p3[0], p3[1]);
                    *(u32x4*)(hb2 + o) = w;
                    w8q[m][bj].x = pk4_fp8(p0[0], p0[1], p1[0], p1[1]); w8q[m][bj].y = pk4_fp8(p2[0], p2[1], p3[0], p3[1]);
                }
#pragma unroll
            for (int mp = 0; mp < 4; mp += 2)
#pragma unroll
                for (int bj = 0; bj < 2; ++bj) {
                    const bool oddq = fq & 1;
                    const size_t o = (size_t)(row0 + ai * HALF + (mp + (oddq ? 1 : 0)) * 16) * 1024 + col0 - (oddq ? 8 : 0) + bj * HALF;
                    *(u32x4*)(hb8 + o) = pair16(w8q[mp][bj], w8q[mp + 1][bj]);
                }
        }
        return false;
    }
};
struct EpiMoe1 {
    unsigned char* act; const float* rowrs; const float* bg; const float* bu;
    static constexpr int NVM = 4;
    static constexpr int NPAR = 2;
    __device__ __forceinline__ const void* par_src(const Unit& u, int piece, int lane) const {
        if (piece == 0) return rowrs + u.pm * BM + lane * 4;
        int l = lane; asm volatile("" : "+v"(l));
        return (l < 32 ? bg : bu) + (size_t)u.aux * DFF + u.pn * 128 + (l & 31) * 4;
    }
    __device__ __forceinline__ bool operator()(const f32x4 (&acc)[2][2][4][2], const Unit& u, int wr, int wc, int fr, int fq, const LAS unsigned char* par) const {
        const int row0 = u.pm * BM + wr * 64 + fr, ff0 = u.pn * 128 + wc * 32 + 8 * fq;
        const LAS float* bgp = (const LAS float*)(par + 1024) + wc * 32 + 8 * fq; const LAS float* bup = bgp + 128;
        const f32x4 bg0 = *(const LAS f32x4*)bgp, bg1 = *(const LAS f32x4*)(bgp + 4), bu0 = *(const LAS f32x4*)bup, bu1 = *(const LAS f32x4*)(bup + 4);
        constexpr float KE = -1.702f * 1.44269504089f;
        const f32x2 ke2 = {KE, KE}, ike2 = {1.0f / KE, 1.0f / KE}, one2 = {1.0f, 1.0f};
        const f32x2 bgv[4] = {LO2(bg0) * ke2, HI2(bg0) * ke2, LO2(bg1) * ke2, HI2(bg1) * ke2}, buv[4] = {LO2(bu0), HI2(bu0), LO2(bu1), HI2(bu1)};
        float rsv[2][4];
#pragma unroll
        for (int ai = 0; ai < 2; ++ai)
#pragma unroll
            for (int m = 0; m < 4; ++m) rsv[ai][m] = ((const LAS float*)par)[wr * 64 + fr + ai * HALF + m * 16];
        const bool oddq = fq & 1;
#pragma unroll
        for (int ai = 0; ai < 2; ++ai)
#pragma unroll
            for (int mp = 0; mp < 4; mp += 2) {
                u32x2 wm[2];
#pragma unroll
                for (int mm = 0; mm < 2; ++mm) {
                const int m = mp + mm;
                const float rs = rsv[ai][m] * W8_INV;
                const f32x2 rs2 = {rs, rs}, rsk2 = {rs * KE, rs * KE};
                f32x2 res[4];
#pragma unroll
                for (int q = 0; q < 4; ++q) {
                    const f32x4 ag4 = acc[ai][0][m][q >> 1], au4 = acc[ai][1][m][q >> 1];
                    const f32x2 ag = (q & 1) ? HI2(ag4) : LO2(ag4), au = (q & 1) ? HI2(au4) : LO2(au4);
                    const f32x2 gk = ag * rsk2 + bgv[q], uu = au * rs2 + buv[q];
                    const f32x2 z = {fmaxf(gk[0], 7.0f * KE), fmaxf(gk[1], 7.0f * KE)};
                    const f32x2 up = {fminf(fmaxf(uu[0], -7.0f), 7.0f), fminf(fmaxf(uu[1], -7.0f), 7.0f)};
                    const f32x2 e = {__builtin_amdgcn_exp2f(z[0]), __builtin_amdgcn_exp2f(z[1])};
                    const f32x2 d = e + one2;
                    const f32x2 sg = {__builtin_amdgcn_rcpf(d[0]), __builtin_amdgcn_rcpf(d[1])};
                    res[q] = ((up * ike2 + ike2) * z) * sg;
                }
                wm[mm].x = pk4_fp8(res[0][0], res[0][1], res[1][0], res[1][1]); wm[mm].y = pk4_fp8(res[2][0], res[2][1], res[3][0], res[3][1]);
                }
                const u32x4 w = pair16(wm[0], wm[1]);
                *(u32x4*)(act + (size_t)(row0 + ai * HALF + (mp + (oddq ? 1 : 0)) * 16) * DFF + ff0 - (oddq ? 8 : 0)) = w;
            }
        return false;
    }
};
struct EpiMoe2 {
    unsigned char* y8; const int* rowslot; const float* roww; const float* bd; unsigned char* dummy;
    static constexpr int NVM = 8;
    static constexpr int NPAR = 3;
    __device__ __forceinline__ const void* par_src(const Unit& u, int piece, int lane) const {
        if (piece == 0) return rowslot + u.pm * BM + lane * 4;
        if (piece == 1) return roww + u.pm * BM + lane * 4;
        return bd + (size_t)u.aux * D + u.pn * BM + lane * 4;
    }
    __device__ __forceinline__ bool operator()(const f32x4 (&acc)[2][2][4][2], const Unit& u, int wr, int wc, int fr, int fq, const LAS unsigned char* par) const {
        const int row0 = u.pm * BM + wr * 64 + fr, col0 = u.pn * BM + wc * 32 + 8 * fq;
        const LAS float* bp = (const LAS float*)(par + 2048) + wc * 32 + 8 * fq;
        f32x4 bv[2][2];
#pragma unroll
        for (int bj = 0; bj < 2; ++bj) { bv[bj][0] = *(const LAS f32x4*)(bp + bj * HALF); bv[bj][1] = *(const LAS f32x4*)(bp + bj * HALF + 4); }
        int slotv[2][4]; float wv8[2][4];
#pragma unroll
        for (int ai = 0; ai < 2; ++ai)
#pragma unroll
            for (int m = 0; m < 4; ++m) { const int rl = wr * 64 + fr + ai * HALF + m * 16; slotv[ai][m] = ((const LAS int*)par)[rl]; wv8[ai][m] = ((const LAS float*)(par + 1024))[rl]; }
        const bool oddq = fq & 1;
        const int colw = col0 - (oddq ? 8 : 0);
#pragma unroll
        for (int ai = 0; ai < 2; ++ai)
#pragma unroll
            for (int mp = 0; mp < 4; mp += 2) {
                int s0_ = slotv[ai][mp], s1_ = slotv[ai][mp + 1]; asm volatile("" : "+v"(s0_), "+v"(s1_));
                const int slot = oddq ? s1_ : s0_;
#pragma unroll
                for (int bj = 0; bj < 2; ++bj) {
                    u32x2 wm[2];
#pragma unroll
                    for (int mm = 0; mm < 2; ++mm) {
                        const int m = mp + mm;
                        const float w8 = wv8[ai][m]; const f32x2 w2 = {w8, w8}, inv2 = {W8_INV, W8_INV};
                        const f32x4 a0 = acc[ai][bj][m][0], a1 = acc[ai][bj][m][1];
                        const f32x2 p0 = (LO2(a0) * inv2 + LO2(bv[bj][0])) * w2, p1 = (HI2(a0) * inv2 + HI2(bv[bj][0])) * w2, p2 = (LO2(a1) * inv2 + LO2(bv[bj][1])) * w2, p3 = (HI2(a1) * inv2 + HI2(bv[bj][1])) * w2;
                        wm[mm].x = pk4_fp8(p0[0], p0[1], p1[0], p1[1]); wm[mm].y = pk4_fp8(p2[0], p2[1], p3[0], p3[1]);
                    }
                    unsigned ax = wm[0].x, ay = wm[0].y, bx = wm[1].x, by = wm[1].y;
                    asm volatile("v_nop\n\tv_nop\n\tv_permlane16_swap_b32 %0, %1\n\tv_nop" : "+v"(ax), "+v"(bx));
                    asm volatile("v_nop\n\tv_nop\n\tv_permlane16_swap_b32 %0, %1\n\tv_nop" : "+v"(ay), "+v"(by));
                    { u32x4 w; w.x = ax; w.y = ay; w.z = bx; w.w = by; *(u32x4*)((slot >= 0 ? y8 + (size_t)slot * 1024 : dummy) + colw + bj * HALF) = w; }
                }
            }
        return false;
    }
};

__device__ __forceinline__ void transpose_tile(LAS float* tile, const float* src, int ldsrc, int k0, int n0, bf16_t* dst, int ldd, int drow0, const float* sa, const float* mu, int mode, bool zero, unsigned char* dst8 = nullptr, int drow8 = 0, int n0b = -1) {
    const int tid = threadIdx.x;
    if (!zero) {
#pragma unroll
        for (int i = 0; i < 2; ++i) {
            const int r = (tid >> 4) + 32 * i, c4 = (tid & 15) * 4;
            const int g4 = tid & 15, scol = n0b < 0 ? n0 + c4 : ((g4 & 1) ? n0b : n0) + 4 * (g4 >> 1);
            const f32x4 v = *(const f32x4*)(src + (size_t)(k0 + r) * ldsrc + scol);
            LAS float* t = tile + r * 65 + c4;
            t[0] = v[0]; t[1] = v[1]; t[2] = v[2]; t[3] = v[3];
        }
    }
    __syncthreads();
    {
        const int n = tid >> 3, kq = tid & 7;
        float v[8];
#pragma unroll
        for (int j = 0; j < 8; ++j) {
            const int k = k0 + 8 * kq + j;
            float s = sa ? sa[k] : 1.0f;
            if (mode == 1) s *= (1.0f - mu[k]);
            if (mode == 2) s *= mu[k];
            v[j] = zero ? 0.f : tile[(8 * kq + j) * 65 + n] * s;
        }
        u32x4 w; w.x = cvt_pk_bf16(v[0], v[1]); w.y = cvt_pk_bf16(v[2], v[3]); w.z = cvt_pk_bf16(v[4], v[5]); w.w = cvt_pk_bf16(v[6], v[7]);
        *(u32x4*)(dst + (size_t)(drow0 + n) * ldd + k0 + 8 * kq) = w;
        if (dst8) { u32x2 w8; w8.x = pk4_fp8(v[0] * W8_SCALE, v[1] * W8_SCALE, v[2] * W8_SCALE, v[3] * W8_SCALE); w8.y = pk4_fp8(v[4] * W8_SCALE, v[5] * W8_SCALE, v[6] * W8_SCALE, v[7] * W8_SCALE); *(u32x2*)(dst8 + (size_t)(drow8 + n) * ldd + k0 + 8 * kq) = w8; }
    }
    __syncthreads();
}

__device__ __forceinline__ void phase_prep(const PPv& p, LAS unsigned char* lds) {
    const int tid = threadIdx.x, bid = blockIdx.x, nb = gridDim.x, lane = tid & 63, wave = tid >> 6;
    unsigned char* ws = p.gws();
    const float* x = p.gin(0); const float* meta = p.gin(1); const float* g1 = p.gin(2);
    if (bid == 0 && tid < 64) ((int*)(ws + OFF_GCNT))[tid] = 0;
    {
        bf16_t* HB = (bf16_t*)((unsigned char*)p.gout() + OUT_XB); float* rstd1 = (float*)(ws + OFF_RSTD1);
        for (int row0 = (bid * 8 + wave) * 4; row0 < NR; row0 += nb * 32) {
            f32x4 v[4][4];
#pragma unroll
            for (int u = 0; u < 4; ++u) {
                const int row = row0 + u < NR ? row0 + u : NR - 1;
                const float* src = row < NMETA ? meta + (size_t)row * D : x + (size_t)(row - NMETA) * D;
#pragma unroll
                for (int i = 0; i < 4; ++i) v[u][i] = __builtin_nontemporal_load((const f32x4*)(src + i * 256 + lane * 4));
            }
#pragma unroll
            for (int u = 0; u < 4; ++u) {
                const int row = row0 + u;
                if (row < NR) {
                    float ss = 0.f;
#pragma unroll
                    for (int i = 0; i < 4; ++i) ss += v[u][i][0] * v[u][i][0] + v[u][i][1] * v[u][i][1] + v[u][i][2] * v[u][i][2] + v[u][i][3] * v[u][i][3];
                    ss = wave_sum_dpp(ss);
                    if (lane == 0) rstd1[row] = rsqrtf(ss * (1.0f / D) + NORM_EPS);
                    if (row >= NMETA) {
                        bf16_t* d = HB + (size_t)(row - NMETA) * D;
#pragma unroll
                        for (int i = 0; i < 4; ++i) { u32x2 w; w.x = cvt_pk_bf16(v[u][i][0], v[u][i][1]); w.y = cvt_pk_bf16(v[u][i][2], v[u][i][3]); *(u32x2*)(d + i * 256 + lane * 4) = w;
                            *(unsigned*)(ws + OFF_X8 + (size_t)(row - NMETA) * D + i * 256 + lane * 4) = pk4_fp8(v[u][i][0], v[u][i][1], v[u][i][2], v[u][i][3]); }
                    }
                }
            }
        }
    }
    LAS float* tile = (LAS float*)lds;
    {
        bf16_t* WIN = (bf16_t*)(ws + OFF_WIN);
        const float* w_in = p.gin(3);
        for (int j = bid; j < 16 * 88; j += nb) {
            const int kt = j & 15, ntile = j >> 4, n0 = ntile * 64;
            const float* src; int ld, sn0, mode = 0; const float* mu = nullptr;
            int sn0b = -1;
            if (n0 < 3072) { src = w_in; ld = 5120; sn0 = n0;
                if (n0 >= 1024) { const int tq = (n0 - 1024) >> 8, bjq = ((n0 - 1024) >> 7) & 1, wcp = ((n0 - 1024) >> 6) & 1, ch0 = 64 * tq + 32 * wcp;
                                  sn0 = (bjq ? 2560 : 1536) + ch0; sn0b = (bjq ? 1024 : 2048) + ch0; } }
            else if (n0 < 3584) {
                const int seg = (n0 - 3072) >> 6;
                if (seg < 4) { const bool isa = seg & 1; src = isa ? p.gin(14) : p.gin(11); ld = 64; sn0 = 0; mu = isa ? p.gin(8) : p.gin(7); mode = 1 + (seg >> 1); }
                else { src = p.gin(16); ld = 128; sn0 = (seg & 1) * 64; mu = p.gin(9); mode = seg < 6 ? 1 : 2; }
            } else { src = w_in; ld = 5120; sn0 = n0 - 512; }
            const bool q8 = n0 >= (12 - Q8T) * 256 && n0 < 3072, g8 = n0 >= 3584;
            transpose_tile(tile, src, ld, kt * 64, sn0, WIN, 1024, n0, g1, mu, mode, false, (q8 || g8) ? ws + OFF_WIN8 : nullptr, q8 ? n0 - (12 - Q8T) * 256 : n0 - 3584 + Q8T * 256, sn0b);
        }
        for (int j = bid; j < 2 * 128; j += nb) {
            const int which = j >> 7, jj = j & 127, kt = jj & 7, ntile = jj >> 3;
            transpose_tile(tile, which ? p.gin(25) : p.gin(23), 1024, kt * 64, ntile * 64, (bf16_t*)(ws + (which ? OFF_WC : OFF_WR)), 512, ntile * 64, nullptr, nullptr, 0, false);
        }
        for (int j = bid; j < 256; j += nb) {
            const int kt = j & 15, ntile = j >> 4;
            transpose_tile(tile, p.gin(26), 1024, kt * 64, ntile * 64, (bf16_t*)(ws + OFF_WO), 1024, ntile * 64, nullptr, nullptr, 0, false, ws + OFF_WO8, ntile * 64);
        }
        for (int j = bid; j < 96; j += nb) {
            const int kt = j & 3, ntile = j >> 2, seg = ntile >> 3, nn0 = (ntile & 7) * 64;
            const float* src = nullptr; int sk0 = 0; bool zero = true;
            if (seg == 0 && kt == 0) { src = p.gin(12); sk0 = 0; zero = false; }
            if (seg == 1 && kt == 1) { src = p.gin(15); sk0 = 0; zero = false; }
            if (seg == 2 && kt >= 2) { src = p.gin(17); sk0 = (kt - 2) * 64; zero = false; }
            const float* srcs = zero ? p.gin(12) : src + (size_t)(sk0 - kt * 64) * 512;
            transpose_tile(tile, srcs, 512, kt * 64, nn0, (bf16_t*)(ws + OFF_W2), 256, ntile * 64, nullptr, nullptr, 0, zero);
        }
        {
            bf16_t* WRB = (bf16_t*)(ws + OFF_WRG); const float* g2 = p.gin(27); const float* wr_ = p.gin(28);
            for (int i = bid * 512 + tid; i < 1024 * 32; i += nb * 512) {
                const int k = i >> 5, e = i & 31; const float w = g2[k] * wr_[i]; const bf16_t hi = f2bf(w);
                WRB[(size_t)e * 1024 + k] = hi; WRB[(size_t)(32 + e) * 1024 + k] = f2bf(w - bf2f(hi));
            }
        }
    }
}

__device__ __forceinline__ void phase_meta_proj(const PPv& p, LAS unsigned char* lds) {
    const int tid = threadIdx.x, bid = blockIdx.x, lane = tid & 63, wave = tid >> 6;
    unsigned char* ws = p.gws();
    LAS float* sm = (LAS float*)lds;
    const float* meta = p.gin(1);
    for (int i = tid; i < 16 * 256; i += 512) { const int r = i >> 8, c4 = (i & 255) * 4; const f32x4 v = *(const f32x4*)(meta + r * 1024 + c4); LAS float* d = sm + r * 1028 + c4; d[0] = v[0]; d[1] = v[1]; d[2] = v[2]; d[3] = v[3]; }
    __syncthreads();
    const float* rstd1 = (const float*)(ws + OFF_RSTD1);
    for (int nbase = bid * 14; nbase < PCOLS1; nbase += gridDim.x * 14) {
        for (int nn = wave; nn < 14; nn += 8) {
            const int n = nbase + nn;
            if (n >= PCOLS1) break;
            const bool inq = n >= 1024 && n < 3072;
            const int cq = (n - 1024) & 255, qn = inq ? ((cq >> 7) << 1) | ((cq >> 2) & 1) : -1, chq = 64 * ((n - 1024) >> 8) + 16 * ((cq >> 5) & 3) + 4 * ((cq >> 3) & 3) + (cq & 3);
            const bool inu = qn == 1;
            if (qn == 2) continue;
            float outp = 1.0f;
#pragma unroll 1
            for (int rep = 0; rep < (inu ? 2 : 1); ++rep) {
            const bf16_t* wrow = (const bf16_t*)(ws + OFF_WIN) + (size_t)(n + rep * 124) * 1024;
            const u32x4 w0 = *(const u32x4*)(wrow + 8 * lane), w1 = *(const u32x4*)(wrow + 512 + 8 * lane);
            const float wf[16] = {bflo(w0.x), bfhi(w0.x), bflo(w0.y), bfhi(w0.y), bflo(w0.z), bfhi(w0.z), bflo(w0.w), bfhi(w0.w),
                                  bflo(w1.x), bfhi(w1.x), bflo(w1.y), bfhi(w1.y), bflo(w1.z), bfhi(w1.z), bflo(w1.w), bfhi(w1.w)};
            float outv = 0.f;
#pragma unroll
            for (int pr = 0; pr < 16; ++pr) {
                const LAS float* m0 = sm + pr * 1028 + 8 * lane;
                const f32x4 a0 = *(const LAS f32x4*)m0, a1 = *(const LAS f32x4*)(m0 + 4), a2 = *(const LAS f32x4*)(m0 + 512), a3 = *(const LAS f32x4*)(m0 + 516);
                float acc = a0[0] * wf[0] + a0[1] * wf[1] + a0[2] * wf[2] + a0[3] * wf[3] + a1[0] * wf[4] + a1[1] * wf[5] + a1[2] * wf[6] + a1[3] * wf[7]
                          + a2[0] * wf[8] + a2[1] * wf[9] + a2[2] * wf[10] + a2[3] * wf[11] + a3[0] * wf[12] + a3[1] * wf[13] + a3[2] * wf[14] + a3[3] * wf[15];
                acc = wave_sum_dpp(acc);
                outv = (lane == pr) ? acc * rstd1[pr] : outv;
            }
            outp *= outv;
            }
            if (lane < 16) {
                if (n < 1024) ((bf16_t*)(ws + OFF_PRKV))[(size_t)lane * 1536 + n] = f2bf(outp);
                else if (qn == 3) ((bf16_t*)(ws + OFF_PRKV))[(size_t)lane * 1536 + 1024 + chq] = f2bf(outp);
                else if (qn == 1) ((bf16_t*)(ws + OFF_PCONV))[(size_t)lane * 2048 + 512 + chq] = f2bf(outp);
                else if (qn == 0) ((bf16_t*)(ws + OFF_PCONV))[(size_t)lane * 2048 + chq] = f2bf(outp);
                else ((bf16_t*)(ws + OFF_PCONV))[(size_t)lane * 2048 + n - 1536] = f2bf(outp);
            }
        }
    }
    __syncthreads();
}

__device__ __forceinline__ void phase_meta_lora(const PPv& p) {
    const int tid = threadIdx.x, bid = blockIdx.x, nb = gridDim.x, lane = tid & 63, wave = tid >> 6;
    unsigned char* ws = p.gws();
    const bf16_t* L = (const bf16_t*)(ws + OFF_L); const bf16_t* W2 = (const bf16_t*)(ws + OFF_W2);
    for (int n = bid * 8 + wave; n < 1536; n += nb * 8) {
        const int seg = n >> 9, c = n & 511;
        const u32x2 wv = *(const u32x2*)(W2 + (size_t)n * 256 + 4 * lane);
        const float w0v = bflo(wv.x), w1v = bfhi(wv.x), w2v = bflo(wv.y), w3v = bfhi(wv.y);
        float outv = 0.f;
#pragma unroll
        for (int r = 0; r < 16; ++r) {
            const u32x2 lv = *(const u32x2*)(L + (size_t)r * 256 + 4 * lane);
            float acc = bflo(lv.x) * w0v + bfhi(lv.x) * w1v + bflo(lv.y) * w2v + bfhi(lv.y) * w3v;
            acc = wave_sum_dpp(acc);
            outv = (lane == r) ? acc : outv;
        }
        if (lane < 16) {
            float v = outv;
            if (seg == 0) v = -0.60653065971f * sigmoidf_(v + p.gin(10)[c]);
            if (seg == 1) v = sigmoidf_(v + p.gin(13)[c]);
            bf16_t* ob = (bf16_t*)(ws + (seg == 0 ? OFF_LD : seg == 1 ? OFF_A : OFF_G));
            ob[(size_t)lane * 512 + c] = f2bf(v);
        }
    }
}

__device__ __forceinline__ void lprep_task(const bf16_t* PROJ, bf16_t* L, int row, int gq) {
    constexpr int PCOLS = 2048;
    int ca, cb;
    if (gq < 8) { ca = 1536 + gq * 8; cb = ca + 128; }
    else if (gq < 16) { ca = 1536 + 64 + (gq - 8) * 8; cb = ca + 128; }
    else { ca = 1536 + 256 + (gq - 16) * 8; cb = ca + 128; }
    const u32x4 va = *(const u32x4*)(PROJ + (size_t)row * PCOLS + ca);
    const int pr = prev_row(row, 1);
    u32x4 vb = (u32x4){0u, 0u, 0u, 0u};
    if (pr >= 0) vb = *(const u32x4*)(PROJ + (size_t)pr * PCOLS + cb);
    float v[8] = {bflo(va.x) + bflo(vb.x), bfhi(va.x) + bfhi(vb.x), bflo(va.y) + bflo(vb.y), bfhi(va.y) + bfhi(vb.y), bflo(va.z) + bflo(vb.z), bfhi(va.z) + bfhi(vb.z), bflo(va.w) + bflo(vb.w), bfhi(va.w) + bfhi(vb.w)};
#pragma unroll
    for (int j = 0; j < 8; ++j) { if (gq < 8) v[j] = tanhf(v[j]); else if (gq >= 16) v[j] = sigmoidf_(v[j]); }
    u32x4 w; w.x = cvt_pk_bf16(v[0], v[1]); w.y = cvt_pk_bf16(v[2], v[3]); w.z = cvt_pk_bf16(v[4], v[5]); w.w = cvt_pk_bf16(v[6], v[7]);
    *(u32x4*)(L + (size_t)row * 256 + gq * 8) = w;
}
template <class Sched> __device__ __forceinline__ void phase_lfix_local(const PPv& p, const Sched& S) {
    const int tid = threadIdx.x;
    unsigned char* ws = p.gws();
    const bf16_t* PROJ = (const bf16_t*)(ws + OFF_PCONV);
    bf16_t* L = (bf16_t*)(ws + OFF_L);
    lprep_task(PROJ, L, tid >> 5, tid & 31);
    for (int i = tid >> 7; ; i += 4) { Unit u; if (!S.next(i, u)) break; lprep_task(PROJ, L, NMETA + u.pm * 256 + 64 * ((tid >> 5) & 3), tid & 31); }
    asm volatile("s_waitcnt vmcnt(0)" ::: "memory");
    __syncthreads();
}
__device__ __forceinline__ void phase_conv_fix(const PPv& p) {
    const int tid = threadIdx.x, bid = blockIdx.x, nb = gridDim.x;
    unsigned char* ws = p.gws();
    const bf16_t* PROJ = (const bf16_t*)(ws + OFF_PCONV);
    constexpr int PCOLS = 2048;
    bf16_t* C = (bf16_t*)(ws + OFF_C);
    const float* cw = p.gin(24);
    for (int i = bid * 512 + tid; i < (T / 64) * 128; i += nb * 512) {
        const int m = 64 * (i >> 7) + ((i >> 6) & 1), ch = (i & 63) * 8, row = NMETA + m;
        const int r1 = prev_row(row, 1), r2 = prev_row(row, 2);
        const bf16_t* p0 = PROJ + (size_t)row * PCOLS; const bf16_t* p1 = PROJ + (size_t)r1 * PCOLS; const bf16_t* p2 = PROJ + (size_t)r2 * PCOLS;
        const u32x4 vb = *(const u32x4*)(p0 + ch);
        const u32x4 c0 = *(const u32x4*)(p0 + 512 + ch), c1 = *(const u32x4*)(p1 + 512 + ch), c2 = *(const u32x4*)(p2 + 512 + ch);
        float o[8];
#pragma unroll
        for (int j = 0; j < 8; ++j) {
            const unsigned wb = j < 2 ? vb.x : j < 4 ? vb.y : j < 6 ? vb.z : vb.w;
            const unsigned wc0 = j < 2 ? c0.x : j < 4 ? c0.y : j < 6 ? c0.z : c0.w;
            const unsigned wc1 = j < 2 ? c1.x : j < 4 ? c1.y : j < 6 ? c1.z : c1.w;
            const unsigned wc2 = j < 2 ? c2.x : j < 4 ? c2.y : j < 6 ? c2.z : c2.w;
            const bool hi = j & 1;
            const float b = hi ? bfhi(wb) : bflo(wb);
            const float u0 = hi ? bfhi(wc0) : bflo(wc0), u1 = hi ? bfhi(wc1) : bflo(wc1), u2 = hi ? bfhi(wc2) : bflo(wc2);
            const float conv = cw[ch + j] * u2 + cw[512 + ch + j] * u1 + cw[1024 + ch + j] * u0;
            o[j] = b * conv;
        }
        u32x4 w; w.x = cvt_pk_bf16(o[0], o[1]); w.y = cvt_pk_bf16(o[2], o[3]); w.z = cvt_pk_bf16(o[4], o[5]); w.w = cvt_pk_bf16(o[6], o[7]);
        *(u32x4*)(C + (size_t)m * 512 + ch) = w;
    }
}

template <int CTRL> __device__ __forceinline__ float dppmov(float v) { return __builtin_bit_cast(float, __builtin_amdgcn_update_dpp(0, __builtin_bit_cast(int, v), CTRL, 0xF, 0xF, true)); }
__device__ __forceinline__ float wave_sum_dpp(float v) {
    v += dppmov<0xB1>(v);
    v += dppmov<0x4E>(v);
    v += dppmov<0x141>(v);
    v += dppmov<0x140>(v);
    { float c = v; asm volatile("v_nop\n\tv_nop\n\tv_permlane16_swap_b32 %0, %1\n\tv_nop" : "+v"(v), "+v"(c)); v += c; }
    { float c = v; asm volatile("v_nop\n\tv_nop\n\tv_permlane32_swap_b32 %0, %1\n\tv_nop" : "+v"(v), "+v"(c)); v += c; }
    return v;
}
typedef float f32x16 __attribute__((ext_vector_type(16)));

struct RawTok { bf16_t r, k, v, a, ld; };
__device__ __forceinline__ RawTok load_raw(const bf16_t* PRKV, const bf16_t* Ab, const bf16_t* LD, int row, int col) {
    RawTok q; const bf16_t* p0 = PRKV + (size_t)row * 1536 + col;
    q.r = p0[0]; q.k = p0[512]; q.v = p0[1024]; q.a = Ab[(size_t)row * 512 + col]; q.ld = LD[(size_t)row * 512 + col];
    return q;
}
__device__ __forceinline__ void wide_load(u32x4 (&w)[10], const bf16_t* PRKV, const bf16_t* Ab, const bf16_t* LD, int row0, int h, int lane) {
    const int rr = lane >> 3, pc = (lane & 7) * 8;
#pragma unroll
    for (int i = 0; i < 2; ++i) {
        const size_t row = (size_t)(row0 + rr + 8 * i);
        const bf16_t* p0 = PRKV + row * 1536 + h * 64 + pc;
        w[0 + i] = __builtin_nontemporal_load((const u32x4*)p0); w[2 + i] = __builtin_nontemporal_load((const u32x4*)(p0 + 512)); w[4 + i] = __builtin_nontemporal_load((const u32x4*)(p0 + 1024));
        w[6 + i] = __builtin_nontemporal_load((const u32x4*)(Ab + row * 512 + h * 64 + pc)); w[8 + i] = __builtin_nontemporal_load((const u32x4*)(LD + row * 512 + h * 64 + pc));
    }
}
__device__ __forceinline__ void unit_geom(int uid, int lane, int& b, int& h, int& c, int& col, int& row0) {
    const int bh = uid / NCHUNK; c = uid - bh * NCHUNK; b = bh >> 3; h = bh & 7; col = h * 64 + lane;
    row0 = c == 0 ? 0 : b * SEQ + c * 16;
}
__device__ __forceinline__ void phase_scanprep(const PPv& p, LAS unsigned char* lds) {
    const int tid = threadIdx.x, bid = blockIdx.x, nb = gridDim.x, lane = tid & 63, wave = tid >> 6;
    unsigned char* ws = p.gws();
    const bf16_t* PRKV = (const bf16_t*)(ws + OFF_PRKV);
    const bf16_t* LD = (const bf16_t*)(ws + OFF_LD);
    const bf16_t* Ab = (const bf16_t*)(ws + OFF_A);
    float* COEF = (float*)(ws + OFF_COEF);
    LAS unsigned char* wl = lds + wave * 13824;
    LAS bf16_t* AR = (LAS bf16_t*)wl;
    LAS bf16_t* BK = (LAS bf16_t*)(wl + 4608);
    LAS float* DM = (LAS float*)(wl + 9216);
    const int qperm = (lane & 32) | (((lane >> 2) & 3) << 3) | (((lane >> 4) & 1) << 2) | (lane & 3);
    int uid = wave * nb + bid;
    if (uid >= NUNITS) return;
    int b, h, c, col, row0;
    unit_geom(uid, lane, b, h, c, col, row0);
    RawTok q[16];
    u32x4 wv[10];
    LAS unsigned char* ST = lds + 8 * 13824 + wave * 2048;
    bf16_t prr = 0, prk = 0, prv = 0, nprr = 0, nprk = 0, nprv = 0;
    wide_load(wv, PRKV, Ab, LD, row0, h, lane);
    { const int pr = prev_row(row0, 1); if (pr >= 0) { const bf16_t* p1 = PRKV + (size_t)pr * 1536 + col; prr = p1[0]; prk = p1[512]; prv = p1[1024]; } }
    for (;;) {
#define SP_STAGE(arr, field) do { \
            *(LAS u32x4*)(ST + (lane >> 3) * 128 + (lane & 7) * 16) = wv[2 * (arr)]; *(LAS u32x4*)(ST + ((lane >> 3) + 8) * 128 + (lane & 7) * 16) = wv[2 * (arr) + 1]; \
            _Pragma("unroll") for (int t = 0; t < 16; ++t) q[t].field = *(const LAS bf16_t*)(ST + t * 128 + lane * 2); } while (0)
        SP_STAGE(0, r); SP_STAGE(1, k); SP_STAGE(2, v); SP_STAGE(3, a); SP_STAGE(4, ld);
#undef SP_STAGE
        const float mur = p.gin(4)[col], muk = p.gin(5)[col], muv = p.gin(6)[col], kkw = p.gin(18)[col], kaw = p.gin(19)[col], rkw = p.gin(20)[col];
        const int nuid = uid + nb * 8; const bool has_next = nuid < NUNITS;
        int nb_ = b, nh = h, nc = c, ncol = col, nrow0 = row0;
        if (has_next) {
            unit_geom(nuid, lane, nb_, nh, nc, ncol, nrow0);
            wide_load(wv, PRKV, Ab, LD, nrow0, nh, lane);
            nprr = 0; nprk = 0; nprv = 0;
            const int pr = prev_row(nrow0, 1); if (pr >= 0) { const bf16_t* p1 = PRKV + (size_t)pr * 1536 + ncol; nprr = p1[0]; nprk = p1[512]; nprv = p1[1024]; }
        }
        __builtin_amdgcn_sched_barrier(0);
        LAS float* PM = (LAS float*)wl;
        LAS float* RS = DM;
        {
            float rp = bf2f(prr), kp = bf2f(prk);
#pragma unroll
            for (int t = 0; t < 16; ++t) {
                const RawTok qq = q[t];
                const float r0 = bf2f(qq.r), k0 = bf2f(qq.k);
                const float r = r0 + (rp - r0) * mur, k = k0 + (kp - k0) * muk;
                rp = r0; kp = k0;
                const float a = bf2f(qq.a);
                const float kkv = k * kkw, k2 = k * (1.0f + (a - 1.0f) * kaw);
                PM[t * 68 + lane] = kkv * kkv; PM[(16 + t) * 68 + lane] = r * k2 * rkw;
            }
            asm volatile("" ::: "memory");
            const int rw = lane & 31, hf = lane >> 5;
            f32x4 s4 = (f32x4){0.f, 0.f, 0.f, 0.f};
#pragma unroll
            for (int i = 0; i < 8; ++i) s4 += *(const LAS f32x4*)(PM + rw * 68 + hf * 32 + i * 4);
            float sm = (s4[0] + s4[1]) + (s4[2] + s4[3]);
            { float c2 = sm; asm volatile("v_nop\n\tv_nop\n\tv_permlane32_swap_b32 %0, %1\n\tv_nop" : "+v"(sm), "+v"(c2)); sm += c2; }
            if (lane < 32) RS[lane] = sm;
            asm volatile("" ::: "memory");
            const float cfl = __shfl(sm, (lane & 15) + 16);
            if (lane < 16) COEF[(size_t)(row0 + lane) * 8 + h] = cfl;
        }
        __builtin_amdgcn_sched_barrier(0);
        float at[16], vt[16]; unsigned btp[8], ktp[8]; float bprev = 0.f, kprev = 0.f;
        float cl = 0.f;
        float rp = bf2f(prr), kp = bf2f(prk), vp = bf2f(prv);
        f32x4 n2v[4];
#pragma unroll
        for (int i = 0; i < 4; ++i) n2v[i] = *(const LAS f32x4*)(RS + 4 * i);
        asm volatile("" ::: "memory"); __builtin_amdgcn_sched_barrier(0);
#pragma unroll
        for (int t = 0; t < 16; ++t) {
            const RawTok qq = q[t];
            const float r0 = bf2f(qq.r), k0 = bf2f(qq.k), v0 = bf2f(qq.v);
            const float r = r0 + (rp - r0) * mur, k = k0 + (kp - k0) * muk, v = v0 + (vp - v0) * muv;
            rp = r0; kp = k0; vp = v0;
            const float a = bf2f(qq.a);
            const float kkv = k * kkw;
            const float kk = kkv * __builtin_amdgcn_rsqf(fmaxf(n2v[t >> 2][t & 3], 1e-24f));
            const float k2 = k * (1.0f + (a - 1.0f) * kaw);
            const float wcp = __expf(cl);
            cl += bf2f(qq.ld);
            const float wcn = __expf(cl), iw = __expf(-cl);
            const float btv = kk * a * iw, ktv = k2 * iw;
            at[t] = -kk * wcp; vt[t] = v;
            { const unsigned w = cvt_pk_bf16(at[t], r * wcn); AR[t * 72 + qperm] = (bf16_t)(w & 0xFFFFu); AR[(16 + t) * 72 + qperm] = (bf16_t)(w >> 16); }
            if (t & 1) {
                btp[t >> 1] = cvt_pk_bf16(bprev, btv); ktp[t >> 1] = cvt_pk_bf16(kprev, ktv);
                BK[(t - 1) * 72 + qperm] = (bf16_t)(btp[t >> 1] & 0xFFFFu); BK[t * 72 + qperm] = (bf16_t)(btp[t >> 1] >> 16);
                BK[(16 + t - 1) * 72 + qperm] = (bf16_t)(ktp[t >> 1] & 0xFFFFu); BK[(16 + t) * 72 + qperm] = (bf16_t)(ktp[t >> 1] >> 16);
            } else { bprev = btv; kprev = ktv; }
            if ((t & 3) == 3) __builtin_amdgcn_sched_barrier(0);
        }
        const float wcc = __expf(cl);
        {
            f32x16 dm;
#pragma unroll
            for (int i = 0; i < 16; ++i) dm[i] = 0.f;
            const int rr = lane & 31, hh = lane >> 5;
#pragma unroll
            for (int ks = 0; ks < 4; ++ks) {
                const bf16x8 fa = *(const LAS bf16x8*)(AR + rr * 72 + 16 * ks + 8 * hh);
                const bf16x8 fb = *(const LAS bf16x8*)(BK + rr * 72 + 16 * ks + 8 * hh);
                dm = __builtin_amdgcn_mfma_f32_32x32x16_bf16(fa, fb, dm, 0, 0, 0);
            }
#pragma unroll
            for (int reg = 0; reg < 16; ++reg) DM[((reg & 3) + 8 * (reg >> 2) + 4 * hh) * 36 + rr] = dm[reg];
        }
        __builtin_amdgcn_sched_barrier(0);
        float uh[16];
#pragma unroll
        for (int t = 0; t < 16; ++t) {
            float wv = at[t], uv = 0.f, wv2 = 0.f, uv2 = 0.f, uv3 = 0.f;
#pragma unroll
            for (int s4 = 0; s4 < 4; ++s4) {
                if (s4 * 4 < t) {
                    const f32x4 ab = *(const LAS f32x4*)(DM + t * 36 + s4 * 4), ak = *(const LAS f32x4*)(DM + t * 36 + 16 + s4 * 4);
#pragma unroll
                    for (int j = 0; j < 4; ++j) {
                        const int s_ = s4 * 4 + j;
                        if (s_ < t) {
                            if (j & 1) { wv2 += ab[j] * at[s_]; uv2 += ak[j] * vt[s_]; } else { wv += ab[j] * at[s_]; uv += ak[j] * vt[s_]; }
                            uv3 += ab[j] * uh[s_];
                        }
                    }
                }
            }
            wv += wv2; uv += uv2 + uv3;
            at[t] = wv; uh[t] = uv;
            asm volatile("" : "+v"(at[t]), "+v"(uh[t]));
        }
        __builtin_amdgcn_sched_barrier(0);
#pragma unroll
        for (int t = 0; t < 16; t += 2) { const unsigned w = cvt_pk_bf16(at[t], at[t + 1]); AR[t * 72 + qperm] = (bf16_t)(w & 0xFFFFu); AR[(t + 1) * 72 + qperm] = (bf16_t)(w >> 16); }
        unsigned char* rec = ws + OFF_CH + (size_t)uid * REC_BYTES;
#pragma unroll
        for (int i = 0; i < 2; ++i) {
            const int pc = i * 64 + lane, row = pc >> 3, part = pc & 7;
            *(u32x4*)(rec + RO_WH + row * 128 + (part ^ SWZ8(row)) * 16) = *(const LAS u32x4*)((LAS unsigned char*)AR + row * 144 + part * 16);
            *(u32x4*)(rec + RO_RT + row * 128 + (part ^ SWZ8(row)) * 16) = *(const LAS u32x4*)((LAS unsigned char*)AR + (16 + row) * 144 + part * 16);
        }
        {
            u32x4 w0, w1;
            w0.x = cvt_pk_bf16(uh[0], uh[1]); w0.y = cvt_pk_bf16(uh[2], uh[3]); w0.z = cvt_pk_bf16(uh[4], uh[5]); w0.w = cvt_pk_bf16(uh[6], uh[7]);
            w1.x = cvt_pk_bf16(uh[8], uh[9]); w1.y = cvt_pk_bf16(uh[10], uh[11]); w1.z = cvt_pk_bf16(uh[12], uh[13]); w1.w = cvt_pk_bf16(uh[14], uh[15]);
            const int hsw = (lane & 8) ? 16 : 0;
            *(u32x4*)(rec + RO_U0T + lane * 32 + hsw) = w0; *(u32x4*)(rec + RO_U0T + lane * 32 + (16 - hsw)) = w1;
            w0.x = cvt_pk_bf16(vt[0], vt[1]); w0.y = cvt_pk_bf16(vt[2], vt[3]); w0.z = cvt_pk_bf16(vt[4], vt[5]); w0.w = cvt_pk_bf16(vt[6], vt[7]);
            w1.x = cvt_pk_bf16(vt[8], vt[9]); w1.y = cvt_pk_bf16(vt[10], vt[11]); w1.z = cvt_pk_bf16(vt[12], vt[13]); w1.w = cvt_pk_bf16(vt[14], vt[15]);
            *(u32x4*)(rec + RO_VT + lane * 32 + hsw) = w0; *(u32x4*)(rec + RO_VT + lane * 32 + (16 - hsw)) = w1;
        }
#pragma unroll
        for (int g = 0; g < 4; ++g) {
            u32x4 w; w.x = btp[2 * g]; w.y = btp[2 * g + 1]; w.z = ktp[2 * g]; w.w = ktp[2 * g + 1];
            *(u32x4*)(rec + RO_BKT + lane * 64 + (g ^ SWZ4(lane & 15)) * 16) = w;
        }
        {
            const int t = lane >> 2, g = lane & 3;
            const f32x4 rb = *(const LAS f32x4*)(DM + (16 + t) * 36 + 4 * g), rk = *(const LAS f32x4*)(DM + (16 + t) * 36 + 16 + 4 * g);
            float o[8];
#pragma unroll
            for (int j = 0; j < 4; ++j) { const bool keep = (4 * g + j) <= t; o[j] = keep ? rb[j] : 0.f; o[4 + j] = keep ? rk[j] : 0.f; }
            u32x4 w; w.x = cvt_pk_bf16(o[0], o[1]); w.y = cvt_pk_bf16(o[2], o[3]); w.z = cvt_pk_bf16(o[4], o[5]); w.w = cvt_pk_bf16(o[6], o[7]);
            *(u32x4*)(rec + RO_ARK + t * 64 + (g ^ SWZ4(t)) * 16) = w;
        }
        *(float*)(rec + RO_WCC + lane * 4) = wcc;
        if (!has_next) break;
        uid = nuid; b = nb_; h = nh; c = nc; col = ncol; row0 = nrow0;
        prr = nprr; prk = nprk; prv = nprv;
        __builtin_amdgcn_sched_barrier(0);
    }
}

__device__ __forceinline__ void convert_expert_weights(const PPv& p, LAS unsigned char* lds, int first, int stride);
struct RecOps { bf16x8 wA0, wA1, rA0, rA1, ark, bk[4]; u32x2 u0, vv; f32x4 wc[4]; };
__device__ __forceinline__ void load_ops(RecOps& o, LAS unsigned char* S, int vs, int fr, int g) {
    const int p8 = (g ^ SWZ8(fr)) * 16, p4 = (g ^ SWZ4(fr)) * 16, p2 = (g ^ SWZ2(fr)) * 8;
    o.wA0 = *(const LAS bf16x8*)(S + RO_WH + fr * 128 + p8); o.wA1 = *(const LAS bf16x8*)(S + RO_WH + fr * 128 + (p8 ^ 64));
    o.rA0 = *(const LAS bf16x8*)(S + RO_RT + fr * 128 + p8); o.rA1 = *(const LAS bf16x8*)(S + RO_RT + fr * 128 + (p8 ^ 64));
    o.u0 = *(const LAS u32x2*)(S + RO_U0T + (16 * vs + fr) * 32 + p2);
    o.vv = *(const LAS u32x2*)(S + RO_VT + (16 * vs + fr) * 32 + p2);
    o.ark = *(const LAS bf16x8*)(S + RO_ARK + fr * 64 + p4);
#pragma unroll
    for (int m = 0; m < 4; ++m) { o.bk[m] = *(const LAS bf16x8*)(S + RO_BKT + (16 * m + fr) * 64 + p4); o.wc[m] = *(const LAS f32x4*)(S + RO_WCC + (16 * m + 4 * g) * 4); }
}
__device__ __forceinline__ void phase_recur(const PPv& p, LAS unsigned char* lds) {
    const int tid = threadIdx.x, bid = blockIdx.x, nb = gridDim.x, lane = tid & 63, wave = __builtin_amdgcn_readfirstlane(tid >> 6);
    unsigned char* ws = p.gws();
    if (bid >= 64) { convert_expert_weights(p, lds, bid - 64, nb - 64); return; }
    unsigned char* CHb = ws + OFF_CH + (size_t)(bid * NCHUNK) * REC_BYTES;
    constexpr int RSLOT = REC_BYTES, RN = 11, PF = 8;
#define R_BAR() do { asm volatile("s_waitcnt lgkmcnt(0)" ::: "memory"); __builtin_amdgcn_s_barrier(); asm volatile("" ::: "memory"); } while (0)
    if (wave >= 4) {
        const int lw = wave - 4;
#define R_ISSUE(x) do { \
            LAS unsigned char* _s = lds + ((x) % RN) * RSLOT; const unsigned char* _r = CHb + (size_t)(x) * REC_BYTES + lane * 16; \
            _Pragma("unroll") for (int _i = 0; _i < 3; ++_i) { const int _pc = lw + 4 * _i; __builtin_amdgcn_global_load_lds((const unsigned*)(_r + _pc * 1024), (LAS unsigned*)(_s + _pc * 1024), 16, 0, 0); } \
            if (lw == 0) __builtin_amdgcn_global_load_lds((const unsigned*)(_r + 12 * 1024), (LAS unsigned*)(_s + 12 * 1024), 16, 0, 0); \
            if (lw == 1) { if (lane < 16) __builtin_amdgcn_global_load_lds((const unsigned*)(_r + 13 * 1024), (LAS unsigned*)(_s + 13 * 1024), 16, 0, 0); } } while (0)
        for (int x = 0; x < PF; ++x) R_ISSUE(x);
        asm volatile("s_waitcnt vmcnt(0)" ::: "memory");
        R_BAR();
        for (int c = 0; c < NCHUNK; ++c) {
            const int x = c + PF;
            if (x < NCHUNK) R_ISSUE(x);
            if (x < NCHUNK) { if (lw < 2) asm volatile("s_waitcnt vmcnt(24)" ::: "memory"); else asm volatile("s_waitcnt vmcnt(18)" ::: "memory"); }
            else asm volatile("s_waitcnt vmcnt(0)" ::: "memory");
            R_BAR();
        }
#undef R_ISSUE
    } else {
        const int vs = wave, fr = lane & 15, g = lane >> 4;
        f32x4 H[4];
#pragma unroll
        for (int m = 0; m < 4; ++m) H[m] = (f32x4){0.f, 0.f, 0.f, 0.f};
        R_BAR();
        RecOps cur, nxt;
        load_ops(cur, lds, vs, fr, g);
        for (int c = 0; c < NCHUNK; ++c) {
            if (c + 1 < NCHUNK) load_ops(nxt, lds + ((c + 1) % RN) * RSLOT, vs, fr, g); else nxt = cur;
            u32x4 hb0, hb1;
            hb0.x = cvt_pk_bf16(H[0][0], H[0][1]); hb0.y = cvt_pk_bf16(H[0][2], H[0][3]); hb0.z = cvt_pk_bf16(H[1][0], H[1][1]); hb0.w = cvt_pk_bf16(H[1][2], H[1][3]);
            hb1.x = cvt_pk_bf16(H[2][0], H[2][1]); hb1.y = cvt_pk_bf16(H[2][2], H[2][3]); hb1.z = cvt_pk_bf16(H[3][0], H[3][1]); hb1.w = cvt_pk_bf16(H[3][2], H[3][3]);
            const bf16x8 hB0 = __builtin_bit_cast(bf16x8, hb0), hB1 = __builtin_bit_cast(bf16x8, hb1);
            f32x4 U = (f32x4){bflo(cur.u0.x), bfhi(cur.u0.x), bflo(cur.u0.y), bfhi(cur.u0.y)};
            U = __builtin_amdgcn_mfma_f32_16x16x32_bf16(cur.wA0, hB0, U, 0, 0, 0);
            U = __builtin_amdgcn_mfma_f32_16x16x32_bf16(cur.wA1, hB1, U, 0, 0, 0);
            f32x4 Y = (f32x4){0.f, 0.f, 0.f, 0.f};
            Y = __builtin_amdgcn_mfma_f32_16x16x32_bf16(cur.rA0, hB0, Y, 0, 0, 0);
            Y = __builtin_amdgcn_mfma_f32_16x16x32_bf16(cur.rA1, hB1, Y, 0, 0, 0);
            u32x4 uvw; uvw.x = cvt_pk_bf16(U[0], U[1]); uvw.y = cvt_pk_bf16(U[2], U[3]); uvw.z = cur.vv.x; uvw.w = cur.vv.y;
            const bf16x8 uv = __builtin_bit_cast(bf16x8, uvw);
            Y = __builtin_amdgcn_mfma_f32_16x16x32_bf16(cur.ark, uv, Y, 0, 0, 0);
#pragma unroll
            for (int m = 0; m < 4; ++m) { H[m] = __builtin_amdgcn_mfma_f32_16x16x32_bf16(cur.bk[m], uv, H[m], 0, 0, 0); H[m] *= cur.wc[m]; }
            u32x2 yw; yw.x = cvt_pk_bf16(Y[0], Y[1]); yw.y = cvt_pk_bf16(Y[2], Y[3]);
            *(u32x2*)(CHb + (size_t)c * REC_BYTES + RO_U0T + (16 * vs + fr) * 32 + (g ^ SWZ2(fr)) * 8) = yw;
            R_BAR();
            cur = nxt;
        }
    }
#undef R_BAR
}

__device__ __forceinline__ void phase_gn(const PPv& p, LAS unsigned char* lds) {
    const int tid = threadIdx.x, bid = blockIdx.x, nb = gridDim.x, lane = tid & 63, wave = tid >> 6;
    unsigned char* ws = p.gws();
    LAS float* PM = (LAS float*)(lds + wave * 8960);
    LAS float* RS = PM + 32 * 68;
    const bf16_t* Gb = (const bf16_t*)(ws + OFF_G); const float* COEF = (const float*)(ws + OFF_COEF);
    bf16_t* Z = (bf16_t*)(ws + OFF_Z);
    constexpr int NREAL = 64 * 256;
    for (int r0 = bid * 8 + wave; r0 < NREAL; r0 += nb * 16) {
        u32x4 y0[2], y1[2], v0[2], v1[2]; float cfv[2][16]; bf16_t ggv[2][16]; int colv[2], row0v[2], hv[2]; bool okv[2];
#pragma unroll
        for (int u = 0; u < 2; ++u) {
            const int r = r0 + u * nb * 8; okv[u] = r < NREAL;
            const int rr = okv[u] ? r : r0;
            const int bh = rr >> 8, c = (rr & 255) + 1, b = bh >> 3, h = bh & 7, uid = bh * NCHUNK + c;
            hv[u] = h; colv[u] = h * 64 + lane; row0v[u] = b * SEQ + c * 16;
            const unsigned char* rec = ws + OFF_CH + (size_t)uid * REC_BYTES;
            const int hsw = (lane & 8) ? 16 : 0;
            y0[u] = *(const u32x4*)(rec + RO_U0T + lane * 32 + hsw); y1[u] = *(const u32x4*)(rec + RO_U0T + lane * 32 + (16 - hsw));
            v0[u] = *(const u32x4*)(rec + RO_VT + lane * 32 + hsw); v1[u] = *(const u32x4*)(rec + RO_VT + lane * 32 + (16 - hsw));
#pragma unroll
            for (int t = 0; t < 16; ++t) { cfv[u][t] = COEF[(size_t)(row0v[u] + t) * 8 + h]; ggv[u][t] = Gb[(size_t)(row0v[u] + t) * 512 + colv[u]]; }
        }
#pragma unroll
        for (int u = 0; u < 2; ++u) {
            if (!okv[u]) continue;
            const int col = colv[u], row0 = row0v[u];
            const float lng = p.gin(21)[col], lnb = p.gin(22)[col];
            const unsigned yw[8] = {y0[u].x, y0[u].y, y0[u].z, y0[u].w, y1[u].x, y1[u].y, y1[u].z, y1[u].w}, vw[8] = {v0[u].x, v0[u].y, v0[u].z, v0[u].w, v1[u].x, v1[u].y, v1[u].z, v1[u].w};
            asm volatile("" ::: "memory");
#pragma unroll
            for (int t = 0; t < 16; ++t) { const float y = (t & 1) ? bfhi(yw[t >> 1]) : bflo(yw[t >> 1]); PM[t * 68 + lane] = y; PM[(16 + t) * 68 + lane] = y * y; }
            asm volatile("" ::: "memory");
            {
                const int rw = lane & 31, hf = lane >> 5;
                f32x4 s4 = (f32x4){0.f, 0.f, 0.f, 0.f};
#pragma unroll
                for (int i = 0; i < 8; ++i) s4 += *(const LAS f32x4*)(PM + rw * 68 + hf * 32 + i * 4);
                float sm = (s4[0] + s4[1]) + (s4[2] + s4[3]);
                { float c2 = sm; asm volatile("v_nop\n\tv_nop\n\tv_permlane32_swap_b32 %0, %1\n\tv_nop" : "+v"(sm), "+v"(c2)); sm += c2; }
                if (lane < 32) RS[lane] = sm;
            }
            asm volatile("" ::: "memory");
            f32x4 s1v[4], s2v[4];
#pragma unroll
            for (int i = 0; i < 4; ++i) { s1v[i] = *(const LAS f32x4*)(RS + 4 * i); s2v[i] = *(const LAS f32x4*)(RS + 16 + 4 * i); }
            asm volatile("" ::: "memory");
#pragma unroll
            for (int t = 0; t < 16; ++t) {
                const float y = (t & 1) ? bfhi(yw[t >> 1]) : bflo(yw[t >> 1]);
                const float v = (t & 1) ? bfhi(vw[t >> 1]) : bflo(vw[t >> 1]);
                const float mean = s1v[t >> 2][t & 3] * (1.0f / 64.0f);
                const float dlt = y - mean;
                const float var = fmaxf(s2v[t >> 2][t & 3] * (1.0f / 64.0f) - mean * mean, 0.f);
                const float yn = dlt * rsqrtf(var + LNX_EPS) * lng + lnb;
                Z[(size_t)(row0 + t - NMETA) * 512 + col] = f2bf((yn + cfv[u][t] * v) * bf2f(ggv[u][t]));
            }
        }
    }
}

__device__ __forceinline__ void convert_expert_weights(const PPv& p, LAS unsigned char* lds, int first, int stride) {
    unsigned char* ws = p.gws();
    const int tid = threadIdx.x;
    LAS float* tile = (LAS float*)lds;
    const float* g2 = p.gin(27);
    unsigned char* WGU = ws + OFF_WGU; unsigned char* WD = ws + OFF_WD;
    constexpr int NBLK = NE * 3 * 64;
    const int lr = tid >> 6, lc = (tid & 63) * 4;
#define CV_LOAD(dst, jj) do { const int mat_ = (jj) >> 6, e_ = mat_ / 3, which_ = mat_ - 3 * e_, bb_ = (jj) & 63, kb_ = bb_ & 15, nbk_ = bb_ >> 4; \
        const float* src_ = (which_ == 0 ? p.gin(30) : which_ == 1 ? p.gin(32) : p.gin(34)) + (size_t)e_ * 1024 * 1024 + (size_t)(kb_ * 64) * 1024 + nbk_ * 256; \
        _Pragma("unroll") for (int i = 0; i < 8; ++i) dst[i] = __builtin_nontemporal_load((const f32x4*)(src_ + (size_t)(lr + 8 * i) * 1024 + lc)); } while (0)
#define CV_ITEM(it) (first + ((it) < nit ? (it) : nit - 1) * stride)
#define CV_STEP(set, it) do { \
        const int jj = CV_ITEM(it), mat = jj >> 6, e = mat / 3, which = mat - 3 * e, bb = jj & 63, kb = bb & 15, nbk = bb >> 4; \
        _Pragma("unroll") for (int i = 0; i < 8; ++i) { LAS float* t = tile + (lr + 8 * i) * 257 + lc; t[0] = set[i][0]; t[1] = set[i][1]; t[2] = set[i][2]; t[3] = set[i][3]; } \
        __syncthreads(); \
        CV_LOAD(set, CV_ITEM((it) + 4)); \
        { const int kq = tid & 7, k0 = kb * 64 + 8 * kq; \
          float sc[8]; \
          _Pragma("unroll") for (int jq = 0; jq < 8; ++jq) sc[jq] = (which < 2 ? g2l[k0 + jq] : 1.0f) * W8_SCALE; \
          _Pragma("unroll") for (int i = 0; i < 4; ++i) { \
              const int nn = (tid >> 3) + 64 * i, n = nbk * 256 + nn; \
              float v[8]; \
              _Pragma("unroll") for (int jq = 0; jq < 8; ++jq) v[jq] = tile[(8 * kq + jq) * 257 + nn] * sc[jq]; \
              u32x2 w; w.x = pk4_fp8(v[0], v[1], v[2], v[3]); w.y = pk4_fp8(v[4], v[5], v[6], v[7]); \
              unsigned char* dst = which < 2 ? WGU + (size_t)e * 2048 * 1024 + (size_t)(256 * (n >> 7) + 128 * which + (n & 127)) * 1024 \
                                             : WD + (size_t)e * 1024 * 1024 + (size_t)n * 1024; \
              __builtin_nontemporal_store(w, (u32x2*)(dst + k0)); } } \
        __syncthreads(); } while (0)
    if (first >= NBLK) return;
    const int nit = (NBLK - first + stride - 1) / stride;
    LAS float* g2l = tile + 64 * 257 + 64;
    for (int i = tid; i < 1024; i += 512) g2l[i] = g2[i];
    __syncthreads();
    f32x4 sa[8], sb[8], sc3[8], sd[8];
    CV_LOAD(sa, CV_ITEM(0)); CV_LOAD(sb, CV_ITEM(1)); CV_LOAD(sc3, CV_ITEM(2)); CV_LOAD(sd, CV_ITEM(3));
    for (int it = 0; it < nit; it += 4) { CV_STEP(sa, it); CV_STEP(sb, it + 1); CV_STEP(sc3, it + 2); CV_STEP(sd, it + 3); }
#undef CV_ITEM
#undef CV_LOAD
#undef CV_STEP
}

__device__ __forceinline__ void phase_router(const PPv& p, LAS unsigned char* lds) {
    const int tid = threadIdx.x, bid = blockIdx.x, nb = gridDim.x, lane = tid & 63, wave = tid >> 6;
    unsigned char* ws = p.gws();
    const bf16_t* h1 = (const bf16_t*)(ws + OFF_HB2);
    const bf16_t* WRB = (const bf16_t*)(ws + OFF_WRG);
    const float* brt = p.gin(29);
    LAS float* slog = (LAS float*)lds;
    LAS float* srs = slog + 8 * 16 * 32;
    LAS int* lcnt = (LAS int*)(srs + 128);
    LAS int* gbase = lcnt + 32;
    LAS int* ltopi = gbase + 32;
    LAS int* lrank = ltopi + 512;
    int* TOPI = (int*)(ws + OFF_TOPI); float* TOPW = (float*)(ws + OFF_TOPW); int* RANK = (int*)(ws + OFF_RANK); float* RSTD2 = (float*)(ws + OFF_RSTD2);
    int* GCNT = (int*)(ws + OFF_GCNT);
    LAS unsigned char* WL = lds + 24576;
    constexpr int WLS = 2064;
    if (bid < T / 128) {
#pragma unroll
        for (int i = 0; i < 16; ++i) { const int r = wave * 8 + (i >> 1), hf = i & 1;
            __builtin_amdgcn_global_load_lds((const unsigned*)((const unsigned char*)WRB + (size_t)r * 2048 + hf * 1024 + lane * 16), (LAS unsigned*)(WL + r * WLS + hf * 1024), 16, 0, 0); }
        asm volatile("s_waitcnt vmcnt(0)" ::: "memory");
    }
    for (int tb = bid; tb < T / 128; tb += nb) {
        if (tid < 32) lcnt[tid] = 0;
        __syncthreads();
        const int t0 = tb * 128 + wave * 16;
        {
            const int row = lane & 15, kq = lane >> 4;
            const bf16_t* ap = h1 + (size_t)(t0 + row) * D + 8 * kq;
            const LAS unsigned char* bp = WL + row * WLS + 16 * kq;
            f32x4 acc0 = (f32x4){0.f, 0.f, 0.f, 0.f}, acc1 = acc0;
            float ss = 0.f;
#pragma unroll 4
            for (int ks = 0; ks < 32; ++ks) {
                const u32x4 aw = *(const u32x4*)(ap + ks * 32);
                const bf16x8 b0h = *(const LAS bf16x8*)(bp + ks * 64), b1h = *(const LAS bf16x8*)(bp + 16 * WLS + ks * 64);
                const bf16x8 b0l = *(const LAS bf16x8*)(bp + 32 * WLS + ks * 64), b1l = *(const LAS bf16x8*)(bp + 48 * WLS + ks * 64);
                ss += bflo(aw.x) * bflo(aw.x) + bfhi(aw.x) * bfhi(aw.x) + bflo(aw.y) * bflo(aw.y) + bfhi(aw.y) * bfhi(aw.y)
                    + bflo(aw.z) * bflo(aw.z) + bfhi(aw.z) * bfhi(aw.z) + bflo(aw.w) * bflo(aw.w) + bfhi(aw.w) * bfhi(aw.w);
                const bf16x8 av = __builtin_bit_cast(bf16x8, aw);
                acc0 = __builtin_amdgcn_mfma_f32_16x16x32_bf16(av, b0h, acc0, 0, 0, 0);
                acc1 = __builtin_amdgcn_mfma_f32_16x16x32_bf16(av, b1h, acc1, 0, 0, 0);
                acc0 = __builtin_amdgcn_mfma_f32_16x16x32_bf16(av, b0l, acc0, 0, 0, 0);
                acc1 = __builtin_amdgcn_mfma_f32_16x16x32_bf16(av, b1l, acc1, 0, 0, 0);
            }
            ss += __shfl_xor(ss, 16); ss += __shfl_xor(ss, 32);
#pragma unroll
            for (int reg = 0; reg < 4; ++reg) {
                slog[(wave * 16 + 4 * kq + reg) * 32 + row] = acc0[reg];
                slog[(wave * 16 + 4 * kq + reg) * 32 + 16 + row] = acc1[reg];
            }
            if (lane < 16) srs[wave * 16 + lane] = rsqrtf(ss * (1.0f / D) + NORM_EPS);
        }
        __syncthreads();
        if (lane < 16) {
            const int tl = wave * 16 + lane, t = tb * 128 + tl;
            const float rs = srs[tl];
            float lg[32];
#pragma unroll
            for (int e = 0; e < 32; ++e) lg[e] = slog[tl * 32 + e] * rs + brt[e];
            int ti[4]; float tv[4];
#pragma unroll
            for (int k = 0; k < 4; ++k) {
                float best = -3.0e38f; int bi = 0;
#pragma unroll
                for (int e = 0; e < 32; ++e) { const bool tk = lg[e] > best; best = tk ? lg[e] : best; bi = tk ? e : bi; }
                ti[k] = bi; tv[k] = best;
#pragma unroll
                for (int e = 0; e < 32; ++e) lg[e] = (e == bi) ? -3.0e38f : lg[e];
            }
            const float e0 = 1.0f, e1 = __expf(tv[1] - tv[0]), e2 = __expf(tv[2] - tv[0]), e3 = __expf(tv[3] - tv[0]);
            const float inv = 1.0f / (e0 + e1 + e2 + e3);
            *(f32x4*)(TOPW + (size_t)t * 4) = (f32x4){e0 * inv, e1 * inv, e2 * inv, e3 * inv};
            RSTD2[t] = rs;
#pragma unroll
            for (int k = 0; k < 4; ++k) { ltopi[tl * 4 + k] = ti[k]; lrank[tl * 4 + k] = __hip_atomic_fetch_add(lcnt + ti[k], 1, __ATOMIC_RELAXED, __HIP_MEMORY_SCOPE_WORKGROUP); }
        }
        __syncthreads();
        if (tid < 32) gbase[tid] = atomicAdd(GCNT + tid, lcnt[tid]);
        __syncthreads();
        {
            const int e = ltopi[tid];
            TOPI[(size_t)tb * 512 + tid] = e;
            RANK[(size_t)tb * 512 + tid] = gbase[e] + lrank[tid];
        }
        __syncthreads();
    }
}

__device__ __forceinline__ void phase_lists(const PPv& p, LAS unsigned char* lds) {
    const int tid = threadIdx.x, bid = blockIdx.x, nb = gridDim.x;
    unsigned char* ws = p.gws();
    LAS int* pstart = (LAS int*)lds;
    LAS int* cnt = pstart + 64;
    const int* GCNT = (const int*)(ws + OFF_GCNT);
    if (tid < 32) cnt[tid] = GCNT[tid];
    __syncthreads();
    if (tid == 0) { int s = 0; for (int e = 0; e < 32; ++e) { pstart[e] = s; s += ((cnt[e] + 255) >> 8) << 8; } pstart[32] = s; }
    __syncthreads();
    const int* TOPI = (const int*)(ws + OFF_TOPI); const float* TOPW = (const float*)(ws + OFF_TOPW); const int* RANK = (const int*)(ws + OFF_RANK); const float* RSTD2 = (const float*)(ws + OFF_RSTD2);
    int* ROWTOK = (int*)(ws + OFF_ROWTOK); int* ROWSLOT = (int*)(ws + OFF_ROWSLOT); float* ROWW = (float*)(ws + OFF_ROWW); float* ROWRS = (float*)(ws + OFF_ROWRS);
    for (int i = bid * 512 + tid; i < T * 4; i += nb * 512) {
        const int e = TOPI[i], pos = pstart[e] + RANK[i], t = i >> 2;
        ROWTOK[pos] = t; ROWSLOT[pos] = i; ROWW[pos] = TOPW[i]; ROWRS[pos] = RSTD2[t];
    }
    for (int e = bid; e < 32; e += nb) {
        for (int pos = pstart[e] + cnt[e] + tid; pos < pstart[e + 1]; pos += 512) { ROWTOK[pos] = 0; ROWSLOT[pos] = -1; ROWW[pos] = 0.f; ROWRS[pos] = 0.f; }
    }
    if (bid == 0) {
        int* TILEE = (int*)(ws + OFF_TILEE);
        const int ntiles = pstart[32] >> 8;
        for (int mt = tid; mt < ntiles; mt += 512) { int e = 0; for (int q = 0; q < 32; ++q) if (pstart[q] <= mt * 256) e = q; TILEE[mt] = e; }
        if (tid == 0) TILEE[1000] = ntiles;
    }
    __syncthreads();
}

__device__ __forceinline__ void phase_final(const PPv& p, LAS unsigned char* lds) {
    const int tid = threadIdx.x, bid = blockIdx.x, nb = gridDim.x, lane = tid & 63, wave = tid >> 6;
    unsigned char* ws = p.gws();
    const bf16_t* HB2 = (const bf16_t*)(ws + OFF_HB2);
    const unsigned char* Y8 = (const unsigned char*)p.gout();
    const float* gf = p.gin(36);
    LAS unsigned char* SW = lds + wave * 4096 + 32 * lane; const int sx = ((lane >> 3) & 1) * 16;
    const LAS unsigned char* SR = lds + wave * 4096 + 16 * (lane ^ ((lane >> 4) & 1));
    const f32x4 ga0 = *(const f32x4*)(gf + 8 * lane), ga1 = *(const f32x4*)(gf + 8 * lane + 4), gb0 = *(const f32x4*)(gf + 512 + 8 * lane), gb1 = *(const f32x4*)(gf + 512 + 8 * lane + 4);
    for (int t0 = (bid * 8 + wave) * 2; t0 < T; t0 += nb * 16) {
        u32x4 ha[2], hb[2]; u32x2 ya[2][4], yb[2][4];
#pragma unroll
        for (int u = 0; u < 2; ++u) {
            const int t = t0 + u;
            ha[u] = __builtin_nontemporal_load((const u32x4*)(HB2 + (size_t)t * D + 8 * lane)); hb[u] = __builtin_nontemporal_load((const u32x4*)(HB2 + (size_t)t * D + 512 + 8 * lane));
#pragma unroll
            for (int k = 0; k < 4; ++k) { ya[u][k] = __builtin_nontemporal_load((const u32x2*)(Y8 + (size_t)(4 * t + k) * 1024 + 8 * lane)); yb[u][k] = __builtin_nontemporal_load((const u32x2*)(Y8 + (size_t)(4 * t + k) * 1024 + 512 + 8 * lane)); }
        }
#pragma unroll
        for (int u = 0; u < 2; ++u) {
            const int t = t0 + u;
            float va[8] = {bflo(ha[u].x), bfhi(ha[u].x), bflo(ha[u].y), bfhi(ha[u].y), bflo(ha[u].z), bfhi(ha[u].z), bflo(ha[u].w), bfhi(ha[u].w)};
            float vb[8] = {bflo(hb[u].x), bfhi(hb[u].x), bflo(hb[u].y), bfhi(hb[u].y), bflo(hb[u].z), bfhi(hb[u].z), bflo(hb[u].w), bfhi(hb[u].w)};
#pragma unroll
            for (int k = 0; k < 4; ++k) {
                const u32x2 a4 = ya[u][k], b4 = yb[u][k];
                { const f32x2 q0 = __builtin_amdgcn_cvt_pk_f32_fp8((int)a4.x, false), q1 = __builtin_amdgcn_cvt_pk_f32_fp8((int)a4.x, true), q2 = __builtin_amdgcn_cvt_pk_f32_fp8((int)a4.y, false), q3 = __builtin_amdgcn_cvt_pk_f32_fp8((int)a4.y, true);
                  va[0] += q0.x; va[1] += q0.y; va[2] += q1.x; va[3] += q1.y; va[4] += q2.x; va[5] += q2.y; va[6] += q3.x; va[7] += q3.y; }
                { const f32x2 q0 = __builtin_amdgcn_cvt_pk_f32_fp8((int)b4.x, false), q1 = __builtin_amdgcn_cvt_pk_f32_fp8((int)b4.x, true), q2 = __builtin_amdgcn_cvt_pk_f32_fp8((int)b4.y, false), q3 = __builtin_amdgcn_cvt_pk_f32_fp8((int)b4.y, true);
                  vb[0] += q0.x; vb[1] += q0.y; vb[2] += q1.x; vb[3] += q1.y; vb[4] += q2.x; vb[5] += q2.y; vb[6] += q3.x; vb[7] += q3.y; }
            }
            float ss = 0.f;
#pragma unroll
            for (int j = 0; j < 8; ++j) ss += va[j] * va[j] + vb[j] * vb[j];
            ss = wave_sum_dpp(ss);
            const float rs = rsqrtf(ss * (1.0f / D) + NORM_EPS);
            *(LAS f32x4*)(SW + sx) = (f32x4){va[0] * rs * ga0[0], va[1] * rs * ga0[1], va[2] * rs * ga0[2], va[3] * rs * ga0[3]};
            *(LAS f32x4*)(SW + (sx ^ 16)) = (f32x4){va[4] * rs * ga1[0], va[5] * rs * ga1[1], va[6] * rs * ga1[2], va[7] * rs * ga1[3]};
            *(LAS f32x4*)(SW + 2048 + sx) = (f32x4){vb[0] * rs * gb0[0], vb[1] * rs * gb0[1], vb[2] * rs * gb0[2], vb[3] * rs * gb0[3]};
            *(LAS f32x4*)(SW + 2048 + (sx ^ 16)) = (f32x4){vb[4] * rs * gb1[0], vb[5] * rs * gb1[1], vb[6] * rs * gb1[2], vb[7] * rs * gb1[3]};
            float* o = p.gout() + (size_t)t * D + 4 * lane;
            const f32x4 o0 = *(const LAS f32x4*)SR, o1 = *(const LAS f32x4*)(SR + 1024), o2 = *(const LAS f32x4*)(SR + 2048), o3 = *(const LAS f32x4*)(SR + 3072);
            __builtin_nontemporal_store(o0, (f32x4*)o); __builtin_nontemporal_store(o1, (f32x4*)(o + 256));
            __builtin_nontemporal_store(o2, (f32x4*)(o + 512)); __builtin_nontemporal_store(o3, (f32x4*)(o + 768));
        }
    }
}

#define XB_TMO      128
#define XB_XCNT(j)  (256  + 64 * (j))
#define XB_XSUB(j)  (1280 + 64 * (j))
#define XB_XGEN(j)  (2304 + 64 * (j))
#define XB_TOP      3328
#define XB_TOPGEN   3392
#define XCD_BAR_WORDS 3456
#define XB_SPIN_CAP (1u << 18)
__device__ __forceinline__ unsigned xb_ld(unsigned* p)              { return __hip_atomic_load(p, __ATOMIC_RELAXED, __HIP_MEMORY_SCOPE_AGENT); }
__device__ __forceinline__ unsigned xb_add(unsigned* p, unsigned v) { return __hip_atomic_fetch_add(p, v, __ATOMIC_RELAXED, __HIP_MEMORY_SCOPE_AGENT); }
__device__ __forceinline__ unsigned xb_xcc_id() { return (unsigned)__builtin_amdgcn_s_getreg((3 << 11) | 20) & 0xFu; }
#define XB_SPIN(cond, bar) do { unsigned _sp = 0; while (cond) { __builtin_amdgcn_s_sleep(1); \
    if ((++_sp & 255u) == 0u) { if (xb_ld(&(bar)[XB_TMO])) break; if (_sp > XB_SPIN_CAP) { atomicAdd(&(bar)[XB_TMO], 1u); break; } } } } while (0)
struct XcdBarrier { unsigned* bar; unsigned x; volatile LAS unsigned* st; };
__device__ __forceinline__ XcdBarrier xcd_barrier_post(unsigned* bar, volatile LAS unsigned* st) {
    XcdBarrier b; b.bar = bar; b.x = xb_xcc_id(); b.st = st;
    if (threadIdx.x == 0) (void)xb_add(&bar[XB_XCNT(b.x)], 1u);
    return b;
}
__device__ __forceinline__ void xcd_barrier_complete(unsigned* bar, unsigned x, unsigned& nloc, unsigned& nx) {
    const unsigned G = gridDim.x * gridDim.y * gridDim.z;
    unsigned sum, cnt, mine, sp = 0u;
    for (;;) {
        sum = 0u; cnt = 0u; mine = 0u;
#pragma unroll
        for (unsigned j = 0; j < 16; ++j) { const unsigned c = xb_ld(&bar[XB_XCNT(j)]); sum += c; cnt += (c > 0u) ? 1u : 0u; mine = (j == x) ? c : mine; }
        if (sum == G) break;
        __builtin_amdgcn_s_sleep(1);
        if ((++sp & 255u) == 0u) { if (xb_ld(&bar[XB_TMO])) break; if (sp > XB_SPIN_CAP) { atomicAdd(&bar[XB_TMO], 1u); break; } }
    }
    nloc = mine > 0u ? mine : 1u; nx = cnt > 0u ? cnt : 1u;
}
__device__ __forceinline__ void xcd_barrier(const XcdBarrier& b) {
    asm volatile("s_waitcnt vmcnt(0)" ::: "memory");
    __syncthreads();
    if (threadIdx.x == 0) {
        unsigned* bar = b.bar;
        __builtin_amdgcn_s_waitcnt(0);
        unsigned nloc = b.st[0], nx = b.st[1];
        if (nloc == 0u) { xcd_barrier_complete(bar, b.x, nloc, nx); b.st[0] = nloc; b.st[1] = nx; }
        const unsigned old = xb_add(&bar[XB_XSUB(b.x)], 1u);
        const unsigned gen = old / nloc;
        if (old + 1u == (gen + 1u) * nloc) {
            __builtin_amdgcn_fence(__ATOMIC_RELEASE, "agent");
            asm volatile("s_waitcnt vmcnt(0)" ::: "memory");
            const unsigned og = xb_add(&bar[XB_TOP], 1u);
            const unsigned tg = og / nx;
            if (og + 1u == (tg + 1u) * nx) xb_add(&bar[XB_TOPGEN], 1u);
            else XB_SPIN(xb_ld(&bar[XB_TOPGEN]) == tg, bar);
            __builtin_amdgcn_fence(__ATOMIC_ACQUIRE, "agent");
            xb_add(&bar[XB_XGEN(b.x)], 1u);
            asm volatile("s_waitcnt vmcnt(0)" ::: "memory");
        } else {
            XB_SPIN(xb_ld(&bar[XB_XGEN(b.x)]) == gen, bar);
            __builtin_amdgcn_fence(__ATOMIC_ACQUIRE, "agent");
            asm volatile("s_waitcnt vmcnt(0)" ::: "memory");
        }
    }
    __syncthreads();
}

constexpr int N_PHASES = 15;
__global__ void __launch_bounds__(512, 2) mega(Params p) {
    extern __shared__ __attribute__((aligned(16))) unsigned char lds_raw[];
    LAS unsigned char* lds = (LAS unsigned char*)lds_raw;
    cg::grid_group grid = cg::this_grid();
    unsigned char* ws = getpp().gws();
    const int G = gridDim.x, bid = blockIdx.x;
#ifndef ONLY_PHASE
#define ONLY_PHASE -1
#endif
#define IN(k) ((ONLY_PHASE < 0 || ONLY_PHASE == (k)) && p.ph_lo <= (k) && (k) < p.ph_hi)
    volatile LAS unsigned* xst = (volatile LAS unsigned*)(lds + 163840 - 16);
    if (threadIdx.x < 4) xst[threadIdx.x] = 0u;
    __syncthreads();
    const XcdBarrier xbar = xcd_barrier_post((unsigned*)(ws + OFF_BAR), xst);
    if (p.ph_hi < 0) grid.sync();
#define SEAM(k) do { if ((k) + 1 < p.ph_hi) xcd_barrier(xbar); } while (0)
    if (IN(0)) { const PPv q = getpp(); phase_prep(q, lds); SEAM(0); }
    if (IN(1)) { const PPv q = getpp();
        phase_meta_proj(q, lds);
        {
            ProjOrder S; S.so.init((unsigned char*)q.gout() + OUT_XB, ws + OFF_WIN, T, (14 - Q8T) * 256, 1024, G, bid); S.split = 12 - Q8T; S.off0 = 0; S.off1 = Q8T; S.bcompact = false;
            EpiProj E{(bf16_t*)(ws + OFF_PRKV), (bf16_t*)(ws + OFF_PCONV), (unsigned char*)q.gout(), (const float*)(ws + OFF_RSTD1), 0, 1.0f, (bf16_t*)(ws + OFF_L), (bf16_t*)(ws + OFF_C), q.gin(24)};
            gemm_phase<false>(lds, 1024, S, E);
        }
        {
            ProjOrder S; S.so.init(ws + OFF_X8, ws + OFF_WIN8, T, (Q8T + 8) * 256, 512, G, bid); S.split = Q8T; S.off0 = 12 - Q8T; S.off1 = 14 - Q8T; S.bcompact = true;
            EpiProj E{(bf16_t*)(ws + OFF_PRKV), (bf16_t*)(ws + OFF_PCONV), (unsigned char*)q.gout(), (const float*)(ws + OFF_RSTD1), 0, W8_INV, (bf16_t*)(ws + OFF_L), (bf16_t*)(ws + OFF_C), q.gin(24)};
            gemm_phase<false, true>(lds, 512, S, E);
        }
        SEAM(1);
    }
    if (IN(3)) { const PPv q = getpp();
        StaticOrder S; S.init(ws + OFF_L + (size_t)NMETA * 256 * 2, ws + OFF_W2, T, 1536, 256, G, bid);
        phase_lfix_local(q, S);
        phase_meta_lora(q);
        EpiL E{ws, q.gin(10), q.gin(13)};
        gemm_phase<false>(lds, 256, S, E);
        phase_conv_fix(q);
        SEAM(3);
    }
    if (IN(4)) { const PPv q = getpp(); phase_scanprep(q, lds); SEAM(4); }
    if (IN(5)) { const PPv q = getpp(); phase_recur(q, lds); SEAM(5); }
    if (IN(6)) { const PPv q = getpp(); phase_gn(q, lds); SEAM(6); }
    if (IN(7)) { const PPv q = getpp();
        MergeOrder S; S.so.init(ws + OFF_Z, ws + OFF_WR, T, 1024, 512, G, bid); S.A1 = (const char*)(ws + OFF_C); S.B1 = (const char*)(ws + OFF_WC);
        EpiMergeFused E{ws + OFF_MERGED, (const unsigned char*)q.gout()};
        gemm_phase<false>(lds, 512, S, E);
        SEAM(7);
    }
    if (IN(9)) { const PPv q = getpp();
        StaticOrder S; S.init(ws + OFF_MERGED, ws + OFF_WO8, T, 1024, 512, G, bid);
        EpiO E{(const bf16_t*)((unsigned char*)q.gout() + OUT_XB), q.gout(), (bf16_t*)(ws + OFF_HB2), ws + OFF_HB8, W8_INV};
        gemm_phase<false, true>(lds, 512, S, E);
        SEAM(9);
    }
    if (IN(10)) { const PPv q = getpp(); phase_router(q, lds); SEAM(10); }
    if (IN(11)) { const PPv q = getpp(); phase_lists(q, lds); SEAM(11); }
    if (IN(12)) { const PPv q = getpp();
        const int* TILEE = (const int*)(ws + OFF_TILEE);
        MoeOrder S; S.A = (const char*)(ws + OFF_HB8); S.Bt = (const char*)(ws + OFF_WGU); S.K = 512; S.estride = (size_t)2048 * 1024;
        S.tile_e = TILEE; S.rowtok = (const int*)(ws + OFF_ROWTOK); S.ntiles = TILEE[1000]; S.nnt = 8; S.G = G; S.c = bid; S.gather = true;
        EpiMoe1 E{ws + OFF_ACT, (const float*)(ws + OFF_ROWRS), q.gin(31), q.gin(33)};
        gemm_phase<true, true>(lds, 512, S, E);
        SEAM(12);
    }
    if (IN(13)) { const PPv q = getpp();
        const int* TILEE = (const int*)(ws + OFF_TILEE);
        MoeOrder S; S.A = (const char*)(ws + OFF_ACT); S.Bt = (const char*)(ws + OFF_WD); S.K = 512; S.estride = (size_t)1024 * 1024;
        S.tile_e = TILEE; S.rowtok = nullptr; S.ntiles = TILEE[1000]; S.nnt = 4; S.G = G; S.c = bid; S.gather = false;
        EpiMoe2 E{(unsigned char*)q.gout(), (const int*)(ws + OFF_ROWSLOT), (const float*)(ws + OFF_ROWW), q.gin(35), ws + OFF_TOPI};
        gemm_phase<false, true>(lds, 512, S, E);
        SEAM(13);
    }
    if (IN(14)) { const PPv q = getpp(); phase_final(q, lds); }
}

extern "C" void kernel_launch(void* const* d_in, const int* in_sizes, int n_in, void* d_out, int out_size, void* d_ws, size_t ws_size,
                              hipStream_t stream) {
    constexpr size_t kDynLds = 160 * 1024;
    static int grid_blocks = 0;
    if (!grid_blocks) {
        int dev = 0, cus = 0, per_cu = 0;
        (void)hipGetDevice(&dev);
        (void)hipDeviceGetAttribute(&cus, hipDeviceAttributeMultiprocessorCount, dev);
        (void)hipFuncSetAttribute((const void*)mega, hipFuncAttributeMaxDynamicSharedMemorySize, (int)kDynLds);
        (void)hipOccupancyMaxActiveBlocksPerMultiprocessor(&per_cu, mega, 512, kDynLds);
        if (per_cu > 1) per_cu = 1;
        grid_blocks = cus * per_cu;
        fprintf(stderr, "cus=%d per_cu=%d ws_size=%zu need=%zu\n", cus, per_cu, ws_size, (size_t)WS_NEED);
    }
    if (ws_size < WS_NEED || n_in < 37 || grid_blocks < 128) { fprintf(stderr, "kernel_launch: unsupported configuration\n"); return; }
    Params p{};
    for (int i = 0; i < 37; ++i) p.in[i] = (const float*)d_in[i];
    p.out = (float*)d_out;
    p.ws = (unsigned char*)d_ws;
    p.ph_lo = 0; p.ph_hi = N_PHASES;
    (void)hipMemsetAsync((unsigned char*)d_ws + OFF_BAR, 0, 16384, stream);
    void* args[] = {&p};
    hipError_t e = hipLaunchCooperativeKernel((void*)mega, dim3(grid_blocks), dim3(512), args, kDynLds, stream);
    if (e != hipSuccess) fprintf(stderr, "cooperative launch failed: %s (grid %d)\n", hipGetErrorString(e), grid_blocks);
}
```
